# Optimizing an MI355X kernel written in HIP

```python
import math
import jax, jax.numpy as jnp
from jax import lax
import numpy as np

D_MODEL = 1024
BATCH = 4
SEQ = 8192
DEPTH = 1

HEAD_DIM = 64
N_HEADS = D_MODEL // HEAD_DIM
H_A = N_HEADS // 2
H_B = N_HEADS - H_A
G_B = 2
R_B = H_B // G_B
BLK_A = 256
TOPK_A = 3
QC_A = 32
CMP_LEN = 32
CMP_STRIDE = 16
CMP_HIDDEN = 256
SEL_BLK = 64
SEL_TOPK = 16
WINDOW = 512
QC_B = 64
N_BUCKETS = 32
MAX_DIST = 128
FFN_HIDDEN = ((8 * D_MODEL // 3 + 255) // 256) * 256
ADA_CHUNKS = 6
PAD_MULT = 256
W_IN_COLS = 3 * H_A * HEAD_DIM + H_B * HEAD_DIM + 6 * G_B * HEAD_DIM + 3 * H_B
NEG = -1e30
BIG = 1e9
EPS = 1e-6

kernel_name = 'hymba_moba_nsa_t5bias_adaln_swiglu'


def rmsnorm(x, g):
    xf = x.astype(jnp.float32)
    y = xf * lax.rsqrt(jnp.mean(xf * xf, axis=-1, keepdims=True) + EPS)
    return (y * g.astype(jnp.float32)).astype(x.dtype)


def t5_bucket(dist):
    max_exact = N_BUCKETS // 2
    d = jnp.maximum(dist, 0)
    df = jnp.maximum(d, 1).astype(jnp.float32)
    large = max_exact + (jnp.log(df / max_exact) / math.log(MAX_DIST / max_exact)
                         * (N_BUCKETS - max_exact)).astype(jnp.int32)
    large = jnp.minimum(large, N_BUCKETS - 1)
    return jnp.where(d < max_exact, d, large)


def masked_softmax(logits, mask):
    z = jnp.where(mask, logits.astype(jnp.float32), NEG)
    p = jax.nn.softmax(z, axis=-1)
    return jnp.where(mask, p, 0.0)


def moba_attention(q, k, v, tab):
    B, H, Sp, D = q.shape
    nb = Sp // BLK_A
    n_sel = max(1, min(TOPK_A, nb - 1))
    scale = D ** -0.5
    kb = k.reshape(B, H, nb, BLK_A, D)
    vb = v.reshape(B, H, nb, BLK_A, D)
    kmean = jnp.mean(kb.astype(jnp.float32), axis=3)
    bi = jnp.arange(B)[:, None, None, None]
    hi = jnp.arange(H)[None, :, None, None]
    blk_ids = jnp.arange(nb)
    offs = jnp.arange(BLK_A)
    n_chunks = Sp // QC_A
    q_chunks = q.reshape(B, H, n_chunks, QC_A, D).transpose(2, 0, 1, 3, 4)

    def chunk(args):
        ci, qc = args
        pos_q = ci * QC_A + jnp.arange(QC_A)
        own = (ci * QC_A) // BLK_A
        s = jnp.einsum('bhqd,bhnd->bhqn', qc.astype(jnp.float32), kmean)
        s = jnp.where(blk_ids < own, s, -jnp.inf)
        top_s, top_i = lax.top_k(s, n_sel)
        sel_ok = jnp.isfinite(top_s)
        kg = kb[bi, hi, top_i]
        vg = vb[bi, hi, top_i]
        key_pos = top_i[..., None] * BLK_A + offs
        l_sel = jnp.einsum('bhqd,bhqnkd->bhqnk', qc, kg).astype(jnp.float32) * scale
        l_sel = l_sel + tab[hi[..., None], t5_bucket(pos_q[:, None, None] - key_pos)]
        l_sel = l_sel.reshape(B, H, QC_A, n_sel * BLK_A)
        m_sel = jnp.broadcast_to(sel_ok[..., None], (B, H, QC_A, n_sel, BLK_A)).reshape(B, H, QC_A, n_sel * BLK_A)
        k_own = lax.dynamic_slice_in_dim(k, own * BLK_A, BLK_A, axis=2)
        v_own = lax.dynamic_slice_in_dim(v, own * BLK_A, BLK_A, axis=2)
        own_pos = own * BLK_A + offs
        l_own = jnp.einsum('bhqd,bhkd->bhqk', qc, k_own).astype(jnp.float32) * scale
        l_own = l_own + tab[:, t5_bucket(pos_q[:, None] - own_pos[None, :])]
        m_own = jnp.broadcast_to(own_pos[None, :] <= pos_q[:, None], l_own.shape)
        p = masked_softmax(jnp.concatenate([l_sel, l_own], axis=-1),
                           jnp.concatenate([m_sel, m_own], axis=-1)).astype(v.dtype)
        p_sel, p_own = p[..., :n_sel * BLK_A], p[..., n_sel * BLK_A:]
        return (jnp.einsum('bhqk,bhqkd->bhqd', p_sel, vg.reshape(B, H, QC_A, n_sel * BLK_A, D))
                + jnp.einsum('bhqk,bhkd->bhqd', p_own, v_own))

    out = lax.map(chunk, (jnp.arange(n_chunks), q_chunks))
    return out.transpose(1, 0, 3, 2, 4).reshape(B, Sp, H * D)


def compress(kv, pe, w1, w2):
    B, G, Sp, D = kv.shape
    n_cmp = (Sp - CMP_LEN) // CMP_STRIDE + 1
    idx = jnp.arange(n_cmp)[:, None] * CMP_STRIDE + jnp.arange(CMP_LEN)[None, :]
    blocks = kv[:, :, idx] + pe
    hid = jax.nn.gelu(blocks.reshape(B, G, n_cmp, CMP_LEN * D) @ w1)
    return hid @ w2


def nsa_attention(q, k_cmp, v_cmp, k_sel, v_sel, k_win, v_win, gates, tab):
    B, G, R, Sp, D = q.shape
    scale = D ** -0.5
    n_cmp = k_cmp.shape[2]
    nb = Sp // SEL_BLK
    n_sel = min(SEL_TOPK, nb)
    cmp_end = jnp.arange(n_cmp) * CMP_STRIDE + CMP_LEN - 1
    cs = jnp.arange(n_cmp)[:, None] * CMP_STRIDE
    ss = jnp.arange(nb)[None, :] * SEL_BLK
    overlap = ((cs < ss + SEL_BLK) & (cs + CMP_LEN > ss)).astype(jnp.float32)
    ksb = k_sel.reshape(B, G, nb, SEL_BLK, D)
    vsb = v_sel.reshape(B, G, nb, SEL_BLK, D)
    k_win_p = jnp.pad(k_win, ((0, 0), (0, 0), (WINDOW, 0), (0, 0)))
    v_win_p = jnp.pad(v_win, ((0, 0), (0, 0), (WINDOW, 0), (0, 0)))
    bi = jnp.arange(B)[:, None, None, None]
    gi = jnp.arange(G)[None, :, None, None]
    hb = jnp.arange(H_B).reshape(1, G, R, 1, 1)
    blk_ids = jnp.arange(nb)
    offs = jnp.arange(SEL_BLK)
    win_offs = jnp.arange(WINDOW + QC_B)
    n_chunks = Sp // QC_B
    q_chunks = q.reshape(B, G, R, n_chunks, QC_B, D).transpose(3, 0, 1, 2, 4, 5)
    g_chunks = gates.reshape(B, G, R, n_chunks, QC_B, 3).transpose(3, 0, 1, 2, 4, 5)

    def chunk(args):
        ci, qc, gc = args
        pos_q = ci * QC_B + jnp.arange(QC_B)
        l_c = jnp.einsum('bgrqd,bgnd->bgrqn', qc, k_cmp).astype(jnp.float32) * scale
        p_c = masked_softmax(l_c, cmp_end[None, :] <= pos_q[:, None])
        o_c = jnp.einsum('bgrqn,bgnd->bgrqd', p_c.astype(v_cmp.dtype), v_cmp)
        imp = jnp.einsum('bgrqn,nj->bgqj', p_c, overlap)
        cur = pos_q // SEL_BLK
        ok = blk_ids[None, :] <= cur[:, None]
        forced = (blk_ids[None, :] == 0) | (blk_ids[None, :] == cur[:, None]) | (blk_ids[None, :] == cur[:, None] - 1)
        score = jnp.where(ok, jnp.where(forced, BIG, imp), -jnp.inf)
        top_s, top_i = lax.top_k(score, n_sel)
        sel_ok = jnp.isfinite(top_s)
        kg = ksb[bi, gi, top_i]
        vg = vsb[bi, gi, top_i]
        n_keys = n_sel * SEL_BLK
        key_pos = (top_i[..., None] * SEL_BLK + offs).reshape(B, G, QC_B, n_keys)
        l_s = jnp.einsum('bgrqd,bgqnkd->bgrqnk', qc, kg).reshape(B, G, R, QC_B, n_keys).astype(jnp.float32) * scale
        l_s = l_s + tab[hb, t5_bucket(pos_q[:, None] - key_pos)[:, :, None]]
        m_s = ((key_pos <= pos_q[:, None]) & jnp.repeat(sel_ok, SEL_BLK, axis=-1))[:, :, None]
        p_s = masked_softmax(l_s, m_s).astype(v_sel.dtype)
        o_s = jnp.einsum('bgrqk,bgqkd->bgrqd', p_s, vg.reshape(B, G, QC_B, n_keys, D))
        kw = lax.dynamic_slice_in_dim(k_win_p, ci * QC_B, WINDOW + QC_B, axis=2)
        vw = lax.dynamic_slice_in_dim(v_win_p, ci * QC_B, WINDOW + QC_B, axis=2)
        w_pos = ci * QC_B - WINDOW + win_offs
        dist = pos_q[:, None] - w_pos[None, :]
        m_w = (dist >= 0) & (dist < WINDOW) & (w_pos[None, :] >= 0)
        l_w = jnp.einsum('bgrqd,bgkd->bgrqk', qc, kw).astype(jnp.float32) * scale
        l_w = l_w + tab[:, t5_bucket(dist)].reshape(G, R, QC_B, WINDOW + QC_B)
        p_w = masked_softmax(l_w, m_w).astype(v_win.dtype)
        o_w = jnp.einsum('bgrqk,bgkd->bgrqd', p_w, vw)
        return gc[..., 0:1] * o_c + gc[..., 1:2] * o_s + gc[..., 2:3] * o_w

    out = lax.map(chunk, (jnp.arange(n_chunks), q_chunks, g_chunks))
    return out.transpose(1, 0, 4, 2, 3, 5).reshape(B, Sp, G * R * D)


def setup_inputs(seed: int = 0) -> dict:
    key = jax.random.key(seed)
    ks = jax.random.split(key, 24)
    L, D, DH = DEPTH, D_MODEL, HEAD_DIM

    def nrm(k, shape, s):
        return jax.random.normal(k, shape, jnp.float32) * s

    def gain(k, shape):
        return 1.0 + 0.05 * jax.random.normal(k, shape, jnp.float32)

    return {
        'x': nrm(ks[0], (BATCH, SEQ, D), 1.0),
        'c': nrm(ks[1], (BATCH, D), 1.0),
        'rel_bias': nrm(ks[2], (N_BUCKETS, N_HEADS), 0.5),
        'w_ada': nrm(ks[3], (L, D, ADA_CHUNKS * D), 0.5 * D ** -0.5),
        'b_ada': nrm(ks[4], (L, ADA_CHUNKS * D), 0.01),
        'g_mix': gain(ks[5], (L, D)),
        'w_in': nrm(ks[6], (L, D, W_IN_COLS), D ** -0.5),
        'q_norm_a': gain(ks[7], (L, DH)),
        'k_norm_a': gain(ks[8], (L, DH)),
        'q_norm_b': gain(ks[9], (L, DH)),
        'k_norm_cmp': gain(ks[10], (L, DH)),
        'k_norm_sel': gain(ks[11], (L, DH)),
        'k_norm_win': gain(ks[12], (L, DH)),
        'cmp_pe_k': nrm(ks[13], (L, CMP_LEN, DH), 0.5),
        'cmp_w1_k': nrm(ks[14], (L, CMP_LEN * DH, CMP_HIDDEN), (CMP_LEN * DH) ** -0.5),
        'cmp_w2_k': nrm(ks[15], (L, CMP_HIDDEN, DH), CMP_HIDDEN ** -0.5),
        'cmp_pe_v': nrm(ks[16], (L, CMP_LEN, DH), 0.5),
        'cmp_w1_v': nrm(ks[17], (L, CMP_LEN * DH, CMP_HIDDEN), (CMP_LEN * DH) ** -0.5),
        'cmp_w2_v': nrm(ks[18], (L, CMP_HIDDEN, DH), CMP_HIDDEN ** -0.5),
        'w_out': nrm(ks[19], (L, D, D), D ** -0.5),
        'g_ffn': gain(ks[20], (L, D)),
        'w_gu': nrm(ks[21], (L, D, 2 * FFN_HIDDEN), D ** -0.5),
        'w_down': nrm(ks[22], (L, FFN_HIDDEN, D), FFN_HIDDEN ** -0.5),
    }


def reference(x, c, rel_bias, w_ada, b_ada, g_mix, w_in, q_norm_a, k_norm_a, q_norm_b,
              k_norm_cmp, k_norm_sel, k_norm_win, cmp_pe_k, cmp_w1_k, cmp_w2_k,
              cmp_pe_v, cmp_w1_v, cmp_w2_v, w_out, g_ffn, w_gu, w_down):
    B, S, D = x.shape
    DH = HEAD_DIM
    Sp = -(-S // PAD_MULT) * PAD_MULT
    tab = rel_bias.T
    tab_a, tab_b = tab[:H_A], tab[H_A:]
    sizes = [H_A * DH] * 3 + [H_B * DH] + [G_B * DH] * 6 + [3 * H_B]
    split_at = [int(v) for v in np.cumsum(sizes)[:-1]]

    def heads_a(t):
        return t.reshape(B, Sp, H_A, DH).transpose(0, 2, 1, 3)

    def kv_heads(t):
        return t.reshape(B, Sp, G_B, DH).transpose(0, 2, 1, 3)

    for l in range(DEPTH):
        mod = jax.nn.silu(c) @ w_ada[l] + b_ada[l]
        sh_m, sc_m, gt_m, sh_f, sc_f, gt_f = jnp.split(mod, ADA_CHUNKS, axis=-1)
        h = rmsnorm(x, g_mix[l]) * (1.0 + sc_m[:, None]) + sh_m[:, None]
        h = jnp.pad(h, ((0, 0), (0, Sp - S), (0, 0)))
        proj = h @ w_in[l]
        qa, ka, va, qb, kc, vc, ksl, vsl, kwn, vwn, gl = jnp.split(proj, split_at, axis=-1)
        qa = rmsnorm(heads_a(qa), q_norm_a[l])
        ka = rmsnorm(heads_a(ka), k_norm_a[l])
        o_a = moba_attention(qa, ka, heads_a(va), tab_a)
        qb = rmsnorm(qb.reshape(B, Sp, G_B, R_B, DH).transpose(0, 2, 3, 1, 4), q_norm_b[l])
        k_cmp = rmsnorm(compress(kv_heads(kc), cmp_pe_k[l], cmp_w1_k[l], cmp_w2_k[l]), k_norm_cmp[l])
        v_cmp = compress(kv_heads(vc), cmp_pe_v[l], cmp_w1_v[l], cmp_w2_v[l])
        k_s = rmsnorm(kv_heads(ksl), k_norm_sel[l])
        k_w = rmsnorm(kv_heads(kwn), k_norm_win[l])
        gates = jax.nn.sigmoid(gl.reshape(B, Sp, G_B, R_B, 3).transpose(0, 2, 3, 1, 4))
        o_b = nsa_attention(qb, k_cmp, v_cmp, k_s, kv_heads(vsl), k_w, kv_heads(vwn), gates, tab_b)
        mix = jnp.concatenate([o_a, o_b], axis=-1)[:, :S]
        x = x + gt_m[:, None] * (mix @ w_out[l])
        h = rmsnorm(x, g_ffn[l]) * (1.0 + sc_f[:, None]) + sh_f[:, None]
        gate, up = jnp.split(h @ w_gu[l], 2, axis=-1)
        x = x + gt_f[:, None] * ((jax.nn.silu(gate) * up) @ w_down[l])
    return x
```

```cpp
#include <hip/hip_runtime.h>
#include <math.h>
#include <stdint.h>

namespace nv {
constexpr int B = 4, S = 8192, D = 1024, T = B * S;
constexpr int DH = 64, HA = 8, HB = 8, G = 2, R = 4;
constexpr int NCOL = 2840;
constexpr int C_QA = 0, C_KA = 512, C_VA = 1024, C_QB = 1536, C_KC = 2048, C_VC = 2176, C_KS = 2304, C_VS = 2432, C_KW = 2560, C_VW = 2688, C_GL = 2816;
constexpr int NBA = 32, NCMP = 511, NSB = 128, FF = 2816;
constexpr float EPS = 1e-6f;

__device__ __forceinline__ int t5_bucket(int d) {
    d = d < 0 ? 0 : d;
    if (d < 16) return d;
    int b = 16;
    b += (d >= 19); b += (d >= 21); b += (d >= 24); b += (d >= 27); b += (d >= 31); b += (d >= 35); b += (d >= 40); b += (d >= 46);
    b += (d >= 52); b += (d >= 59); b += (d >= 67); b += (d >= 77); b += (d >= 87); b += (d >= 99); b += (d >= 113);
    return b;
}
__device__ __forceinline__ float wave_sum(float v) {
#pragma unroll
    for (int o = 1; o < 64; o <<= 1) v += __shfl_xor(v, o);
    return v;
}
__device__ __forceinline__ float wave_max(float v) {
#pragma unroll
    for (int o = 1; o < 64; o <<= 1) v = fmaxf(v, __shfl_xor(v, o));
    return v;
}
__device__ __forceinline__ float silu_f(float v) { return v / (1.f + expf(-v)); }
__device__ __forceinline__ float sigmoid_f(float v) { return 1.f / (1.f + expf(-v)); }
__device__ __forceinline__ float gelu_tanh(float v) { return 0.5f * v * (1.f + tanhf(0.7978845608028654f * (v + 0.044715f * v * v * v))); }

__global__ __launch_bounds__(256) void k_mod(const float* __restrict__ c, const float* __restrict__ w_ada, const float* __restrict__ b_ada, float* __restrict__ mod) {
    __shared__ float sc[B][D];
    for (int i = threadIdx.x; i < B * D; i += 256) sc[i / D][i % D] = silu_f(c[i]);
    __syncthreads();
    const int n = blockIdx.x * 256 + threadIdx.x;
    float acc[B] = {0.f, 0.f, 0.f, 0.f};
    for (int k = 0; k < D; ++k) { const float w = w_ada[(size_t)k * (6 * D) + n];
#pragma unroll
        for (int b = 0; b < B; ++b) acc[b] += sc[b][k] * w; }
#pragma unroll
    for (int b = 0; b < B; ++b) mod[b * 6 * D + n] = acc[b] + b_ada[n];
}
__global__ __launch_bounds__(256) void k_norm(const float* __restrict__ in, const float* __restrict__ g, const float* __restrict__ mod, int sh_off, int sc_off, float* __restrict__ out) {
    const int row = blockIdx.x * 4 + (threadIdx.x >> 6), lane = threadIdx.x & 63, b = row / S;
    const float4* ip = (const float4*)(in + (size_t)row * D);
    float4 v[4]; float ss = 0.f;
#pragma unroll
    for (int j = 0; j < 4; ++j) { v[j] = ip[lane + 64 * j]; ss += v[j].x * v[j].x + v[j].y * v[j].y + v[j].z * v[j].z + v[j].w * v[j].w; }
    ss = wave_sum(ss);
    const float rs = rsqrtf(ss * (1.f / D) + EPS);
    const float* sh = mod + b * 6 * D + sh_off; const float* sc = mod + b * 6 * D + sc_off;
    float4* op = (float4*)(out + (size_t)row * D);
#pragma unroll
    for (int j = 0; j < 4; ++j) { const int c0 = (lane + 64 * j) * 4; float4 o;
        o.x = v[j].x * rs * g[c0 + 0] * (1.f + sc[c0 + 0]) + sh[c0 + 0];
        o.y = v[j].y * rs * g[c0 + 1] * (1.f + sc[c0 + 1]) + sh[c0 + 1];
        o.z = v[j].z * rs * g[c0 + 2] * (1.f + sc[c0 + 2]) + sh[c0 + 2];
        o.w = v[j].w * rs * g[c0 + 3] * (1.f + sc[c0 + 3]) + sh[c0 + 3];
        op[lane + 64 * j] = o; }
}
struct GemmEpi { float* C; int ldc; const float* x; const float* gt; };
template <int MODE>
__global__ __launch_bounds__(256) void k_gemm(const float* __restrict__ A, int lda, const float* __restrict__ Bm, int ldb, int M, int N, int K, GemmEpi e) {
    __shared__ float As[16][68];
    __shared__ float Bs[16][68];
    __shared__ float Bs2[MODE == 2 ? 16 : 1][68];
    const int t = threadIdx.x, tx = t & 15, ty = t >> 4;
    const int m0 = blockIdx.y * 64, n0 = blockIdx.x * 64;
    float acc[4][4], acc2[4][4];
#pragma unroll
    for (int i = 0; i < 4; ++i)
#pragma unroll
        for (int j = 0; j < 4; ++j) { acc[i][j] = 0.f; acc2[i][j] = 0.f; }
    const int ar = t >> 2, akq = (t & 3) * 4, bk = t >> 4, bnq = (t & 15) * 4;
    for (int k0 = 0; k0 < K; k0 += 16) {
        const float4 av = *(const float4*)(A + (size_t)(m0 + ar) * lda + k0 + akq);
        As[akq + 0][ar] = av.x; As[akq + 1][ar] = av.y; As[akq + 2][ar] = av.z; As[akq + 3][ar] = av.w;
        float4 bv = make_float4(0.f, 0.f, 0.f, 0.f);
        if (n0 + bnq + 3 < N) bv = *(const float4*)(Bm + (size_t)(k0 + bk) * ldb + n0 + bnq);
        *(float4*)&Bs[bk][bnq] = bv;
        if (MODE == 2) { const float4 bv2 = *(const float4*)(Bm + (size_t)(k0 + bk) * ldb + N + n0 + bnq); *(float4*)&Bs2[bk][bnq] = bv2; }
        __syncthreads();
#pragma unroll
        for (int k = 0; k < 16; ++k) {
            const float4 a4 = *(const float4*)&As[k][ty * 4]; const float4 b4 = *(const float4*)&Bs[k][tx * 4];
            const float a[4] = {a4.x, a4.y, a4.z, a4.w}, b[4] = {b4.x, b4.y, b4.z, b4.w};
#pragma unroll
            for (int i = 0; i < 4; ++i)
#pragma unroll
                for (int j = 0; j < 4; ++j) acc[i][j] += a[i] * b[j];
            if (MODE == 2) { const float4 c4 = *(const float4*)&Bs2[k][tx * 4]; const float c[4] = {c4.x, c4.y, c4.z, c4.w};
#pragma unroll
                for (int i = 0; i < 4; ++i)
#pragma unroll
                    for (int j = 0; j < 4; ++j) acc2[i][j] += a[i] * c[j]; }
        }
        __syncthreads();
    }
#pragma unroll
    for (int i = 0; i < 4; ++i)
#pragma unroll
        for (int j = 0; j < 4; ++j) {
            const int row = m0 + ty * 4 + i, col = n0 + tx * 4 + j;
            if (col < N) {
                const float v = acc[i][j]; const size_t o = (size_t)row * e.ldc + col; const int b = row / S;
                if (MODE == 0) e.C[o] = v;
                else if (MODE == 1) e.C[o] = e.x[o] + e.gt[b * 6 * D + col] * v;
                else if (MODE == 2) e.C[o] = silu_f(v) * acc2[i][j];
                else e.C[o] = e.C[o] + e.gt[b * 6 * D + col] * v;
            }
        }
}
__global__ __launch_bounds__(256) void k_qknorm(float* __restrict__ proj, const float* qna, const float* kna, const float* qnb, const float* knsel, const float* knwin) {
    const int row = blockIdx.x * 4 + (threadIdx.x >> 6), lane = threadIdx.x & 63;
    float* p = proj + (size_t)row * NCOL;
    for (int s = 0; s < 28; ++s) {
        int col; const float* g;
        if (s < 8) { col = C_QA + s * 64; g = qna; } else if (s < 16) { col = C_KA + (s - 8) * 64; g = kna; } else if (s < 24) { col = C_QB + (s - 16) * 64; g = qnb; }
        else if (s < 26) { col = C_KS + (s - 24) * 64; g = knsel; } else { col = C_KW + (s - 26) * 64; g = knwin; }
        const float v = p[col + lane]; const float ss = wave_sum(v * v);
        p[col + lane] = v * rsqrtf(ss * (1.f / 64.f) + EPS) * g[lane];
    }
    if (lane < 24) p[C_GL + lane] = sigmoid_f(p[C_GL + lane]);
}
__global__ __launch_bounds__(64) void k_kmean(const float* __restrict__ proj, float* __restrict__ kmean) {
    const int j = blockIdx.x % NBA, h = (blockIdx.x / NBA) % HA, b = blockIdx.x / (NBA * HA), d = threadIdx.x;
    float s = 0.f;
    for (int t = 0; t < 256; ++t) s += proj[(size_t)(b * S + j * 256 + t) * NCOL + C_KA + h * 64 + d];
    kmean[(size_t)blockIdx.x * 64 + d] = s * (1.f / 256.f);
}
__device__ __forceinline__ float dot64(const float* __restrict__ qs, const float* __restrict__ kr) {
    float acc = 0.f;
#pragma unroll
    for (int i = 0; i < 16; ++i) { const float4 kv = ((const float4*)kr)[i]; const float4 qv = ((const float4*)qs)[i]; acc += qv.x * kv.x; acc += qv.y * kv.y; acc += qv.z * kv.z; acc += qv.w * kv.w; }
    return acc;
}
__global__ __launch_bounds__(256) void k_moba(const float* __restrict__ proj, const float* __restrict__ kmean, const float* __restrict__ rel_bias, float* __restrict__ mix) {
    __shared__ __attribute__((aligned(16))) float qs_[4][64];
    __shared__ float ps_[4][1024];
    const int w = threadIdx.x >> 6, lane = threadIdx.x & 63;
    const int task = blockIdx.x * 4 + w; const int q = task % S, h = (task / S) % HA, b = task / (S * HA);
    float* qs = qs_[w]; float* ps = ps_[w];
    const size_t tok = (size_t)b * S + q;
    qs[lane] = proj[tok * NCOL + C_QA + h * 64 + lane];
    __syncthreads();
    const int own = q >> 8;
    float sg = -INFINITY;
    if (lane < own) sg = dot64(qs, kmean + ((size_t)(b * HA + h) * NBA + lane) * 64);
    int selblk[4];
#pragma unroll
    for (int it = 0; it < 3; ++it) {
        const float m = wave_max(sg);
        const unsigned long long bal = __ballot(sg == m);
        const int idx = __ffsll((long long)bal) - 1;
        if (m == -INFINITY) selblk[it] = -1; else { selblk[it] = idx; if (lane == idx) sg = -INFINITY; }
    }
    selblk[3] = own;
    float lg[16]; float mx = -INFINITY;
#pragma unroll
    for (int i = 0; i < 16; ++i) {
        const int slot = i >> 2, off = (i & 3) * 64 + lane; const int blk = selblk[slot];
        bool valid = blk >= 0; const int kp = (blk < 0 ? 0 : blk) * 256 + off;
        if (slot == 3) valid = kp <= q;
        float l = -INFINITY;
        if (valid) l = dot64(qs, proj + ((size_t)b * S + kp) * NCOL + C_KA + h * 64) * 0.125f + rel_bias[t5_bucket(q - kp) * 16 + h];
        lg[i] = l; mx = fmaxf(mx, l);
    }
    mx = wave_max(mx);
    float sum = 0.f;
#pragma unroll
    for (int i = 0; i < 16; ++i) { lg[i] = (lg[i] == -INFINITY) ? 0.f : expf(lg[i] - mx); sum += lg[i]; }
    sum = wave_sum(sum);
    const float inv = 1.f / sum;
#pragma unroll
    for (int i = 0; i < 16; ++i) ps[i * 64 + lane] = lg[i] * inv;
    __syncthreads();
    float acc = 0.f;
#pragma unroll
    for (int slot = 0; slot < 4; ++slot) { const int blk = selblk[slot]; if (blk < 0) continue;
        const float* vb = proj + ((size_t)b * S + blk * 256) * NCOL + C_VA + h * 64 + lane;
        const int lim = (slot == 3) ? (q - own * 256 + 1) : 256;
        for (int off = 0; off < lim; ++off) acc += ps[slot * 256 + off] * vb[(size_t)off * NCOL]; }
    mix[tok * D + h * 64 + lane] = acc;
}
__global__ __launch_bounds__(256) void k_compress(const float* __restrict__ proj, const float* __restrict__ pe_k, const float* __restrict__ w1k, const float* __restrict__ w2k,
                                                  const float* __restrict__ pe_v, const float* __restrict__ w1v, const float* __restrict__ w2v, const float* __restrict__ kncmp,
                                                  float* __restrict__ kcmp, float* __restrict__ vcmp) {
    __shared__ float vec[2048]; __shared__ float hid[256];
    const int isv = blockIdx.y; const int n = blockIdx.x % NCMP, g = (blockIdx.x / NCMP) % G, b = blockIdx.x / (NCMP * G);
    const float* pe = isv ? pe_v : pe_k; const float* w1 = isv ? w1v : w1k; const float* w2 = isv ? w2v : w2k;
    const int col = (isv ? C_VC : C_KC) + g * 64; const int t = threadIdx.x;
    for (int i = t; i < 2048; i += 256) { const int l = i >> 6, d = i & 63; vec[i] = proj[((size_t)b * S + 16 * n + l) * NCOL + col + d] + pe[i]; }
    __syncthreads();
    float a = 0.f;
    for (int i = 0; i < 2048; ++i) a += vec[i] * w1[(size_t)i * 256 + t];
    hid[t] = gelu_tanh(a);
    __syncthreads();
    if (t < 64) { float o = 0.f;
        for (int k = 0; k < 256; ++k) o += hid[k] * w2[k * 64 + t];
        const size_t oi = ((size_t)(b * G + g) * NCMP + n) * 64 + t;
        if (isv) vcmp[oi] = o; else { const float ss = wave_sum(o * o); kcmp[oi] = o * rsqrtf(ss * (1.f / 64.f) + EPS) * kncmp[t]; } }
}
__global__ __launch_bounds__(256) void k_nsa_cmp(const float* __restrict__ proj, const float* __restrict__ kcmp, const float* __restrict__ vcmp, float* __restrict__ mix, int* __restrict__ sel) {
    __shared__ __attribute__((aligned(16))) float qs_[4][64];
    __shared__ float pc[4][512]; __shared__ float score[128];
    const int r = threadIdx.x >> 6, lane = threadIdx.x & 63;
    const int q = blockIdx.x % S, g = (blockIdx.x / S) % G, b = blockIdx.x / (S * G); const int hb = g * 4 + r;
    const size_t tok = (size_t)b * S + q;
    qs_[r][lane] = proj[tok * NCOL + C_QB + hb * 64 + lane];
    __syncthreads();
    const int nvalid = q >= 31 ? ((q - 31) / 16 + 1 > NCMP ? NCMP : (q - 31) / 16 + 1) : 0;
    const float* kc = kcmp + (size_t)(b * G + g) * NCMP * 64; const float* vc = vcmp + (size_t)(b * G + g) * NCMP * 64;
    float lg[8]; float mx = -INFINITY;
#pragma unroll
    for (int i = 0; i < 8; ++i) { const int n = lane + 64 * i; float l = -INFINITY; if (n < nvalid) l = dot64(qs_[r], kc + (size_t)n * 64) * 0.125f; lg[i] = l; mx = fmaxf(mx, l); }
    mx = wave_max(mx); float sum = 0.f;
#pragma unroll
    for (int i = 0; i < 8; ++i) { lg[i] = (lg[i] == -INFINITY) ? 0.f : expf(lg[i] - mx); sum += lg[i]; }
    sum = wave_sum(sum); const float inv = sum > 0.f ? 1.f / sum : 0.f;
#pragma unroll
    for (int i = 0; i < 8; ++i) pc[r][lane + 64 * i] = lg[i] * inv;
    __syncthreads();
    float acc = 0.f;
    for (int n = 0; n < nvalid; ++n) acc += pc[r][n] * vc[(size_t)n * 64 + lane];
    mix[tok * D + 512 + hb * 64 + lane] = proj[tok * NCOL + C_GL + hb * 3 + 0] * acc;
    const int cur = q >> 6;
    if (threadIdx.x < 128) { const int j = threadIdx.x; float imp = 0.f;
        for (int n = 4 * j - 1; n <= 4 * j + 3; ++n) if (n >= 0 && n < NCMP) imp += pc[0][n] + pc[1][n] + pc[2][n] + pc[3][n];
        const bool ok = j <= cur, forced = (j == 0) || (j == cur) || (j == cur - 1);
        score[j] = ok ? (forced ? 1e9f : imp) : -INFINITY; }
    __syncthreads();
    if (r == 0) { float a = score[lane], c = score[lane + 64];
        int* so = sel + ((size_t)(b * G + g) * S + q) * 16;
        for (int it = 0; it < 16; ++it) {
            const float m = wave_max(fmaxf(a, c));
            int idx = -1;
            if (m != -INFINITY) { const unsigned long long ba = __ballot(a == m);
                if (ba) { idx = __ffsll((long long)ba) - 1; if (lane == idx) a = -INFINITY; }
                else { const unsigned long long bc = __ballot(c == m); idx = 64 + __ffsll((long long)bc) - 1; if (lane == idx - 64) c = -INFINITY; } }
            if (lane == 0) so[it] = idx; } }
}
__global__ __launch_bounds__(256) void k_nsa_sel(const float* __restrict__ proj, const int* __restrict__ sel, const float* __restrict__ rel_bias, float* __restrict__ mix) {
    __shared__ __attribute__((aligned(16))) float qs_[4][64];
    __shared__ float ps_[4][1024];
    const int r = threadIdx.x >> 6, lane = threadIdx.x & 63;
    const int q = blockIdx.x % S, g = (blockIdx.x / S) % G, b = blockIdx.x / (S * G); const int hb = g * 4 + r;
    const size_t tok = (size_t)b * S + q;
    qs_[r][lane] = proj[tok * NCOL + C_QB + hb * 64 + lane];
    __syncthreads();
    const int* so = sel + ((size_t)(b * G + g) * S + q) * 16;
    float lg[16]; float mx = -INFINITY; int blks[16];
#pragma unroll
    for (int i = 0; i < 16; ++i) { const int blk = so[i]; blks[i] = blk; const int kp = (blk < 0 ? 0 : blk) * 64 + lane; const bool valid = blk >= 0 && kp <= q;
        float l = -INFINITY;
        if (valid) l = dot64(qs_[r], proj + ((size_t)b * S + kp) * NCOL + C_KS + g * 64) * 0.125f + rel_bias[t5_bucket(q - kp) * 16 + 8 + hb];
        lg[i] = l; mx = fmaxf(mx, l); }
    mx = wave_max(mx); float sum = 0.f;
#pragma unroll
    for (int i = 0; i < 16; ++i) { lg[i] = (lg[i] == -INFINITY) ? 0.f : expf(lg[i] - mx); sum += lg[i]; }
    sum = wave_sum(sum); const float inv = 1.f / sum;
#pragma unroll
    for (int i = 0; i < 16; ++i) ps_[r][i * 64 + lane] = lg[i] * inv;
    __syncthreads();
    float acc = 0.f;
#pragma unroll
    for (int i = 0; i < 16; ++i) { const int blk = blks[i]; if (blk < 0) continue;
        const float* vb = proj + ((size_t)b * S + blk * 64) * NCOL + C_VS + g * 64 + lane;
        for (int off = 0; off < 64; ++off) if (blk * 64 + off <= q) acc += ps_[r][i * 64 + off] * vb[(size_t)off * NCOL]; }
    mix[tok * D + 512 + hb * 64 + lane] += proj[tok * NCOL + C_GL + hb * 3 + 1] * acc;
}
__global__ __launch_bounds__(256) void k_nsa_win(const float* __restrict__ proj, const float* __restrict__ rel_bias, float* __restrict__ mix) {
    __shared__ __attribute__((aligned(16))) float qs_[4][64];
    __shared__ float ps_[4][512];
    const int r = threadIdx.x >> 6, lane = threadIdx.x & 63;
    const int q = blockIdx.x % S, g = (blockIdx.x / S) % G, b = blockIdx.x / (S * G); const int hb = g * 4 + r;
    const size_t tok = (size_t)b * S + q;
    qs_[r][lane] = proj[tok * NCOL + C_QB + hb * 64 + lane];
    __syncthreads();
    float lg[8]; float mx = -INFINITY;
#pragma unroll
    for (int i = 0; i < 8; ++i) { const int kk = lane + 64 * i; const int kp = q - 511 + kk; float l = -INFINITY;
        if (kp >= 0) l = dot64(qs_[r], proj + ((size_t)b * S + kp) * NCOL + C_KW + g * 64) * 0.125f + rel_bias[t5_bucket(q - kp) * 16 + 8 + hb];
        lg[i] = l; mx = fmaxf(mx, l); }
    mx = wave_max(mx); float sum = 0.f;
#pragma unroll
    for (int i = 0; i < 8; ++i) { lg[i] = (lg[i] == -INFINITY) ? 0.f : expf(lg[i] - mx); sum += lg[i]; }
    sum = wave_sum(sum); const float inv = 1.f / sum;
#pragma unroll
    for (int i = 0; i < 8; ++i) ps_[r][i * 64 + lane] = lg[i] * inv;
    __syncthreads();
    float acc = 0.f;
    for (int kk = 0; kk < 512; ++kk) { const int kp = q - 511 + kk; if (kp < 0) continue; acc += ps_[r][kk] * proj[((size_t)b * S + kp) * NCOL + C_VW + g * 64 + lane]; }
    mix[tok * D + 512 + hb * 64 + lane] += proj[tok * NCOL + C_GL + hb * 3 + 2] * acc;
}
}

extern "C" void kernel_launch(void* const* d_in, const int* in_sizes, int n_in, void* d_out, int out_size, void* d_ws, size_t ws_size, hipStream_t stream) {
    using namespace nv;
    const float* x = (const float*)d_in[0]; const float* c = (const float*)d_in[1]; const float* rel_bias = (const float*)d_in[2];
    const float* w_ada = (const float*)d_in[3]; const float* b_ada = (const float*)d_in[4]; const float* g_mix = (const float*)d_in[5];
    const float* w_in = (const float*)d_in[6]; const float* qna = (const float*)d_in[7]; const float* kna = (const float*)d_in[8];
    const float* qnb = (const float*)d_in[9]; const float* kncmp = (const float*)d_in[10]; const float* knsel = (const float*)d_in[11];
    const float* knwin = (const float*)d_in[12]; const float* pe_k = (const float*)d_in[13]; const float* w1k = (const float*)d_in[14];
    const float* w2k = (const float*)d_in[15]; const float* pe_v = (const float*)d_in[16]; const float* w1v = (const float*)d_in[17];
    const float* w2v = (const float*)d_in[18]; const float* w_out = (const float*)d_in[19]; const float* g_ffn = (const float*)d_in[20];
    const float* w_gu = (const float*)d_in[21]; const float* w_down = (const float*)d_in[22];
    float* out = (float*)d_out; char* ws = (char*)d_ws;
    const size_t MiB = 1u << 20;
    if (ws_size < 500 * MiB) return;
    float* mod = (float*)(ws); float* kmean = (float*)(ws + 1 * MiB); float* kcmp = (float*)(ws + 2 * MiB); float* vcmp = (float*)(ws + 4 * MiB);
    int* sel = (int*)(ws + 6 * MiB); float* bufA = (float*)(ws + 16 * MiB); float* proj = (float*)(ws + 144 * MiB);
    k_mod<<<6 * D / 256, 256, 0, stream>>>(c, w_ada, b_ada, mod);
    k_norm<<<T / 4, 256, 0, stream>>>(x, g_mix, mod, 0, D, bufA);
    { GemmEpi e{proj, NCOL, nullptr, nullptr}; k_gemm<0><<<dim3((NCOL + 63) / 64, T / 64), 256, 0, stream>>>(bufA, D, w_in, NCOL, T, NCOL, D, e); }
    k_qknorm<<<T / 4, 256, 0, stream>>>(proj, qna, kna, qnb, knsel, knwin);
    k_kmean<<<B * HA * NBA, 64, 0, stream>>>(proj, kmean);
    k_moba<<<B * HA * S / 4, 256, 0, stream>>>(proj, kmean, rel_bias, bufA);
    k_compress<<<dim3(B * G * NCMP, 2), 256, 0, stream>>>(proj, pe_k, w1k, w2k, pe_v, w1v, w2v, kncmp, kcmp, vcmp);
    k_nsa_cmp<<<B * G * S, 256, 0, stream>>>(proj, kcmp, vcmp, bufA, sel);
    k_nsa_sel<<<B * G * S, 256, 0, stream>>>(proj, sel, rel_bias, bufA);
    k_nsa_win<<<B * G * S, 256, 0, stream>>>(proj, rel_bias, bufA);
    { GemmEpi e{out, D, x, mod + 2 * D}; k_gemm<1><<<dim3(D / 64, T / 64), 256, 0, stream>>>(bufA, D, w_out, D, T, D, D, e); }
    k_norm<<<T / 4, 256, 0, stream>>>(out, g_ffn, mod, 3 * D, 4 * D, bufA);
    { GemmEpi e{proj, FF, nullptr, nullptr}; k_gemm<2><<<dim3(FF / 64, T / 64), 256, 0, stream>>>(bufA, D, w_gu, 2 * FF, T, FF, D, e); }
    { GemmEpi e{out, D, nullptr, mod + 5 * D}; k_gemm<3><<<dim3(D / 64, T / 64), 256, 0, stream>>>(proj, FF, w_down, D, T, D, FF, e); }
}
```

```cpp
#include <hip/hip_runtime.h>
#include <hip/hip_cooperative_groups.h>
#include <cstdint>
#include <cstdio>
namespace cg = cooperative_groups;
#define HYBRID 0
namespace pg8 {
#define PG8_LAS __attribute__((address_space(3)))
typedef unsigned short bf16_t;
typedef short bf16x8 __attribute__((ext_vector_type(8)));
typedef float f32x4 __attribute__((ext_vector_type(4)));
typedef unsigned u32x4 __attribute__((ext_vector_type(4)));
constexpr int BM = 256, BK = 64, HALF = 128, HTB = HALF * BK * 2  , STAGE_BYTES = 8 * HTB, NXCD = 8, WGM = 8;

__host__ __device__ __forceinline__ int lds_byte(int r, int c) { const int st = (r >> 4) * 2 + (c >> 5), rr = r & 15, cc = c & 31, ob = rr * 64 + cc * 2; return st * 1024 + (ob ^ (((ob >> 9) & 1) << 5)); }
__host__ __device__ __forceinline__ void stage_rc(int b, int& R, int& C) { const int st = b / 1024, sb = b % 1024, swz = sb ^ (((sb >> 9) & 1) << 5); R = (st >> 1) * 16 + swz / 64; C = (st & 1) * 32 + (swz % 64) / 2; }
__host__ __device__ __forceinline__ int perm32(int rho) { const int n = rho >> 4, i = rho & 15; return 8 * (i >> 2) + 4 * n + (i & 3); }

struct Unit { int pm, pn; };
struct Gemm { const bf16_t* A; const bf16_t* Bt; int M, N, K; };

struct StaticOrder {
    int nM, nN, nwg, G, c;
    __host__ __device__ void init(int M, int N, int G_, int c_) { nM = M / BM; nN = N / BM; nwg = nM * nN; G = G_; c = c_; }
    __host__ __device__ bool next(int i, Unit& u) const {
        const long L = (long)i * G + c; if (L >= nwg) return false;
        int wgid = (int)L; { const int q = nwg / NXCD, r = nwg % NXCD, xcd = wgid % NXCD, off = wgid / NXCD; wgid = (xcd < r ? xcd * (q + 1) : r * (q + 1) + (xcd - r) * q) + off; }
        const int nig = WGM * nN, gid = wgid / nig, fm = gid * WGM, gsz = (nM - fm) < WGM ? (nM - fm) : WGM;
        u.pm = fm + ((wgid % nig) % gsz); u.pn = (wgid % nig) / gsz; return true;
    }
    __device__ __forceinline__ void a_ready(const Unit&) const {}
    __device__ __forceinline__ void done(const Unit&) const {}
};

__device__ __forceinline__ unsigned cvt_pk_bf16(float lo, float hi) { unsigned r; asm volatile("v_cvt_pk_bf16_f32 %0, %1, %2" : "=v"(r) : "v"(lo), "v"(hi)); return r; }
typedef float f32x2 __attribute__((ext_vector_type(2)));
template <class Epi, class Sched, bool ALIGN_EPI = false, bool SP2 = false>
__device__ __forceinline__ void gemm_phase(PG8_LAS unsigned char* lds, const Gemm g, const Sched& S, const Epi& E) {
    const int tid = threadIdx.x, wid = __builtin_amdgcn_readfirstlane(tid >> 6), lane = tid & 63, wr = wid >> 2, wc = wid & 3, fr = lane & 15, fq = lane >> 4;
    const int K = g.K, nt = K / BK;
    unsigned voffA[2], voffB[2];
#pragma unroll
    for (int i = 0; i < 2; ++i) { int R, C; stage_rc(tid * 16 + i * 8192, R, C); const int Rb = Epi::PERM ? ((R & ~31) + perm32(R & 31)) : R;
        voffA[i] = (unsigned)(R * K + C) * 2u; voffB[i] = (unsigned)(Rb * K + C) * 2u; }
    const size_t kstep = (size_t)(BK * 2);
    const size_t hstep = (size_t)HALF * K * 2;
    const size_t tstep = 2 * hstep;
    const unsigned ldsw = (unsigned)wid * 1024u;
    const int aoff = lds_byte(wr * 64 + fr, fq * 8), boff = lds_byte(wc * 32 + fr, fq * 8);
#define PG8_SA(b, h) (((b) * 2 + (h)) * HTB)
#define PG8_SB(b, h) ((4 + (b) * 2 + (h)) * HTB)
#define PG8_STAGE(bufoff, gbase, voff) do { _Pragma("unroll") for (int _i = 0; _i < 2; ++_i) \
        __builtin_amdgcn_global_load_lds((const unsigned*)((const char*)(gbase) + (voff)[_i]), (PG8_LAS unsigned*)(lds + (bufoff) + ldsw + _i * 8192), 16, 0, 0); } while (0)
#define PG8_LDA(dst, b, h) do { _Pragma("unroll") for (int m = 0; m < 4; ++m) _Pragma("unroll") for (int k = 0; k < 2; ++k) dst[m][k] = *(const PG8_LAS bf16x8*)(lds + PG8_SA(b, h) + aoff + m * 2048 + k * 1024); } while (0)
#define PG8_LDB(dst, b, h) do { _Pragma("unroll") for (int n = 0; n < 2; ++n) _Pragma("unroll") for (int k = 0; k < 2; ++k) dst[n][k] = *(const PG8_LAS bf16x8*)(lds + PG8_SB(b, h) + boff + n * 2048 + k * 1024); } while (0)
#define PG8_MMA(ai, bj, At, Bt) do { __builtin_amdgcn_s_setprio(1); _Pragma("unroll") for (int m = 0; m < 4; ++m) _Pragma("unroll") for (int n = 0; n < 2; ++n) _Pragma("unroll") for (int k = 0; k < 2; ++k) \
        acc[ai][bj][m][n] = __builtin_amdgcn_mfma_f32_16x16x32_bf16(Bt[n][k], At[m][k], acc[ai][bj][m][n], 0, 0, 0); __builtin_amdgcn_s_setprio(0); } while (0)
#define PG8_WAIT_V(n) asm volatile("s_waitcnt vmcnt(" #n ")" ::: "memory")
#define PG8_WAIT_L(n) asm volatile("s_waitcnt lgkmcnt(" #n ")" ::: "memory")
#define PG8_BAR __builtin_amdgcn_s_barrier()
#define PG8_SCHED __builtin_amdgcn_sched_barrier(0)
    Unit cur, nxt; int ui = 0;
    if (!S.next(0, cur)) return;
    f32x4 acc[2][2][4][2];
#pragma unroll
    for (int a = 0; a < 2; ++a)
#pragma unroll
        for (int b = 0; b < 2; ++b)
#pragma unroll
            for (int m = 0; m < 4; ++m)
#pragma unroll
                for (int n = 0; n < 2; ++n) acc[a][b][m][n] = (f32x4){0.f, 0.f, 0.f, 0.f};
    bf16x8 At[4][2], B0[2][2], B1[2][2];
    const char* cA = (const char*)g.A + (size_t)cur.pm * tstep; const char* cB = (const char*)g.Bt + (size_t)cur.pn * tstep;
    S.a_ready(cur);
    if constexpr (SP2) {
        PG8_STAGE(PG8_SB(0, 0), cB, voffB); PG8_STAGE(PG8_SB(0, 1), cB + hstep, voffB); PG8_STAGE(PG8_SA(0, 0), cA, voffA); PG8_STAGE(PG8_SA(0, 1), cA + hstep, voffA);
        if (wr == 1) PG8_BAR;
        PG8_WAIT_V(2); PG8_BAR;
        PG8_STAGE(PG8_SB(1, 0), cB + kstep, voffB); PG8_STAGE(PG8_SA(1, 0), cA + kstep, voffA); PG8_STAGE(PG8_SB(1, 1), cB + hstep + kstep, voffB);
        PG8_WAIT_V(6); PG8_BAR;
    } else {
        PG8_STAGE(PG8_SB(0, 0), cB, voffB); PG8_STAGE(PG8_SA(0, 0), cA, voffA); PG8_STAGE(PG8_SB(0, 1), cB + hstep, voffB); PG8_STAGE(PG8_SA(0, 1), cA + hstep, voffA);
        if (wr == 1) PG8_BAR;
        PG8_WAIT_V(4); PG8_BAR;
        PG8_STAGE(PG8_SB(1, 0), cB + kstep, voffB); PG8_STAGE(PG8_SA(1, 0), cA + kstep, voffA); PG8_STAGE(PG8_SB(1, 1), cB + hstep + kstep, voffB);
        PG8_WAIT_V(6); PG8_BAR;
    }
    for (;;) {
        const bool has_next = S.next(ui + 1, nxt);
        const char* nA = has_next ? (const char*)g.A + (size_t)nxt.pm * tstep : cA; const char* nB = has_next ? (const char*)g.Bt + (size_t)nxt.pn * tstep : cB;
        for (int t = 0; t < nt; t += 2) {
            const bool last = (t == nt - 2);
            const char* a1 = cA + (size_t)(t + 1) * kstep;
            const char* a2 = last ? nA : cA + (size_t)(t + 2) * kstep; const char* b2 = last ? nB : cB + (size_t)(t + 2) * kstep;
            const char* a3 = a2 + kstep; const char* b3 = b2 + kstep;
            if (last && has_next) S.a_ready(nxt);
            if constexpr (SP2) {
            PG8_LDB(B0, 0, 0); PG8_LDB(B1, 0, 1); PG8_SCHED; PG8_LDA(At, 0, 0); PG8_STAGE(PG8_SA(1, 1), a1 + hstep, voffA);
            PG8_WAIT_V(8); PG8_WAIT_L(0); PG8_BAR; PG8_MMA(0, 0, At, B0); PG8_MMA(0, 1, At, B1); PG8_BAR; PG8_SCHED;
            PG8_LDA(At, 0, 1); PG8_STAGE(PG8_SB(0, 0), b2, voffB); PG8_STAGE(PG8_SB(0, 1), b2 + hstep, voffB); PG8_STAGE(PG8_SA(0, 0), a2, voffA);
            PG8_WAIT_V(8); PG8_WAIT_L(0); PG8_BAR; PG8_MMA(1, 0, At, B0); PG8_MMA(1, 1, At, B1); PG8_BAR; PG8_SCHED;
            PG8_LDB(B0, 1, 0); PG8_LDB(B1, 1, 1); PG8_SCHED; PG8_LDA(At, 1, 0); PG8_STAGE(PG8_SA(0, 1), a2 + hstep, voffA);
            PG8_WAIT_V(8); PG8_WAIT_L(0); PG8_BAR; PG8_MMA(0, 0, At, B0); PG8_MMA(0, 1, At, B1); PG8_BAR; PG8_SCHED;
            PG8_LDA(At, 1, 1); PG8_STAGE(PG8_SB(1, 0), b3, voffB); PG8_STAGE(PG8_SB(1, 1), b3 + hstep, voffB); PG8_STAGE(PG8_SA(1, 0), a3, voffA);
            PG8_WAIT_V(8); PG8_WAIT_L(0); PG8_BAR; PG8_MMA(1, 0, At, B0); PG8_MMA(1, 1, At, B1); PG8_BAR; PG8_SCHED;
            } else {
            PG8_LDB(B0, 0, 0); PG8_SCHED; PG8_LDA(At, 0, 0); PG8_STAGE(PG8_SA(1, 1), a1 + hstep, voffA);
            PG8_WAIT_L(8); PG8_BAR; PG8_WAIT_L(0); PG8_MMA(0, 0, At, B0); PG8_BAR; PG8_SCHED;
            PG8_LDB(B1, 0, 1); PG8_STAGE(PG8_SB(0, 0), b2, voffB);
            PG8_BAR; PG8_WAIT_L(0); PG8_MMA(0, 1, At, B1); PG8_BAR;
            PG8_LDA(At, 0, 1); PG8_STAGE(PG8_SA(0, 0), a2, voffA);
            PG8_BAR; PG8_WAIT_L(0); PG8_MMA(1, 0, At, B0); PG8_BAR; PG8_SCHED;
            PG8_STAGE(PG8_SB(0, 1), b2 + hstep, voffB);
            PG8_WAIT_V(6); PG8_BAR; PG8_MMA(1, 1, At, B1); PG8_BAR;
            PG8_LDB(B0, 1, 0); PG8_SCHED; PG8_LDA(At, 1, 0); PG8_STAGE(PG8_SA(0, 1), a2 + hstep, voffA);
            PG8_WAIT_L(8); PG8_BAR; PG8_WAIT_L(0); PG8_MMA(0, 0, At, B0); PG8_BAR; PG8_SCHED;
            PG8_LDB(B1, 1, 1); PG8_STAGE(PG8_SB(1, 0), b3, voffB);
            PG8_BAR; PG8_WAIT_L(0); PG8_MMA(0, 1, At, B1); PG8_BAR;
            PG8_LDA(At, 1, 1); PG8_STAGE(PG8_SA(1, 0), a3, voffA);
            PG8_BAR; PG8_WAIT_L(0); PG8_MMA(1, 0, At, B0); PG8_BAR; PG8_SCHED;
            PG8_STAGE(PG8_SB(1, 1), b3 + hstep, voffB);
            PG8_WAIT_V(6); PG8_BAR; PG8_MMA(1, 1, At, B1); PG8_BAR;
            }
        }
        if constexpr (ALIGN_EPI) { if (wr == 0) PG8_BAR; }
        if constexpr (!Epi::AFTER_DRAIN) { E(acc, cur, wr, wc, fr, fq); S.done(cur); }
        if (!has_next) break;
#pragma unroll
        for (int a = 0; a < 2; ++a)
#pragma unroll
            for (int b = 0; b < 2; ++b)
#pragma unroll
                for (int m = 0; m < 4; ++m)
#pragma unroll
                    for (int n = 0; n < 2; ++n) acc[a][b][m][n] = (f32x4){0.f, 0.f, 0.f, 0.f};
        cur = nxt; cA = nA; cB = nB; ++ui;
        if constexpr (ALIGN_EPI) { if (wr == 1) PG8_BAR; }
    }
    PG8_WAIT_V(0);
    if constexpr (!ALIGN_EPI) { if (wr == 0) PG8_BAR; }
    PG8_BAR;
    if constexpr (Epi::AFTER_DRAIN) { E.fused(acc, cur, wr, wc, fr, fq, lds, wid, lane); S.done(cur); }
#undef PG8_SA
#undef PG8_SB
#undef PG8_STAGE
#undef PG8_LDA
#undef PG8_LDB
#undef PG8_MMA
#undef PG8_WAIT_V
#undef PG8_WAIT_L
#undef PG8_BAR
#undef PG8_SCHED
}
}
namespace pg8 {
typedef unsigned u32x2v __attribute__((ext_vector_type(2)));
constexpr int TOK_S = 8192;
constexpr float QK_EPS = 1e-6f;
constexpr float C2 = 0.125f * 1.4426950408889634f;
__device__ __forceinline__ float sigmoid_fast(float v) { return 1.f / (1.f + __expf(-v)); }
__device__ __forceinline__ float silu_fast(float v) { return v / (1.f + __expf(-v)); }

struct EpiInProj {
    static constexpr bool PERM = true, AFTER_DRAIN = false;
    bf16_t* qkv;
    float* gates;
    float* kmean_part;
    const float *qna, *kna, *qnb, *knsel, *knwin;
    __device__ __forceinline__ void operator()(const f32x4 (&acc)[2][2][4][2], const Unit& u, int wr, int wc, int fr, int fq) const {
        const int slot = u.pn * 4 + wc;
        if (slot > 44) return;
        const int b = u.pm >> 5, blk = u.pm & 31, pos0 = blk * 256 + wr * 64 + fr;
        if (slot == 44) {
            if (fq < 3) {
#pragma unroll
                for (int ai = 0; ai < 2; ++ai)
#pragma unroll
                    for (int m = 0; m < 4; ++m) { const size_t tok = (size_t)b * TOK_S + pos0 + ai * HALF + m * 16; float* gp = gates + tok * 24 + 8 * fq;
                        const f32x4 v0 = acc[ai][0][m][0], v1 = acc[ai][0][m][1];
                        *(f32x4*)gp = (f32x4){sigmoid_fast(v0[0]), sigmoid_fast(v0[1]), sigmoid_fast(v0[2]), sigmoid_fast(v0[3])};
                        *(f32x4*)(gp + 4) = (f32x4){sigmoid_fast(v1[0]), sigmoid_fast(v1[1]), sigmoid_fast(v1[2]), sigmoid_fast(v1[3])}; }
            }
            return;
        }
        const float* gain = nullptr; float qscale = 1.f; bool is_ka = false; bf16_t* dst;
        constexpr size_t BIG = (size_t)4 * 8 * TOK_S * 64, SMALL = (size_t)4 * 2 * TOK_S * 64;
        if (slot < 32) { const int kind = slot >> 3, head = slot & 7; dst = qkv + kind * BIG + ((size_t)(b * 8 + head) * TOK_S) * 64;
            if (kind == 0) { gain = qna; qscale = C2; } else if (kind == 1) { gain = kna; is_ka = true; } else if (kind == 3) { gain = qnb; qscale = C2; } }
        else { const int kind = (slot - 32) >> 1, g = slot & 1; dst = qkv + 4 * BIG + kind * SMALL + ((size_t)(b * 2 + g) * TOK_S) * 64;
            if (kind == 2) gain = knsel; else if (kind == 4) gain = knwin; }
        float gv[16];
#pragma unroll
        for (int i = 0; i < 16; ++i) gv[i] = gain ? gain[(i >> 3) * 32 + 8 * fq + (i & 7)] * qscale : 1.f;
        float cs[16];
#pragma unroll
        for (int i = 0; i < 16; ++i) cs[i] = 0.f;
#pragma unroll
        for (int ai = 0; ai < 2; ++ai)
#pragma unroll
            for (int m = 0; m < 4; ++m) {
                float v[16];
#pragma unroll
                for (int bj = 0; bj < 2; ++bj)
#pragma unroll
                    for (int n = 0; n < 2; ++n)
#pragma unroll
                        for (int j = 0; j < 4; ++j) v[bj * 8 + n * 4 + j] = acc[ai][bj][m][n][j];
                if (gain) { float ss = 0.f;
#pragma unroll
                    for (int i = 0; i < 16; ++i) ss += v[i] * v[i];
                    ss += __shfl_xor(ss, 16); ss += __shfl_xor(ss, 32);
                    const float rs = rsqrtf(ss * (1.f / 64.f) + QK_EPS);
#pragma unroll
                    for (int i = 0; i < 16; ++i) v[i] *= rs * gv[i]; }
                if (is_ka) {
#pragma unroll
                    for (int i = 0; i < 16; ++i) cs[i] += v[i]; }
                bf16_t* rp = dst + (size_t)(pos0 + ai * HALF + m * 16) * 64 + 8 * fq;
                u32x4 w0, w1;
                w0.x = cvt_pk_bf16(v[0], v[1]); w0.y = cvt_pk_bf16(v[2], v[3]); w0.z = cvt_pk_bf16(v[4], v[5]); w0.w = cvt_pk_bf16(v[6], v[7]);
                w1.x = cvt_pk_bf16(v[8], v[9]); w1.y = cvt_pk_bf16(v[10], v[11]); w1.z = cvt_pk_bf16(v[12], v[13]); w1.w = cvt_pk_bf16(v[14], v[15]);
                *(u32x4*)rp = w0; *(u32x4*)(rp + 32) = w1;
            }
        if (is_ka) {
#pragma unroll
            for (int i = 0; i < 16; ++i) { float s = cs[i]; s += __shfl_xor(s, 1); s += __shfl_xor(s, 2); s += __shfl_xor(s, 4); s += __shfl_xor(s, 8); cs[i] = s; }
            if (fr == 0) { float* kp = kmean_part + ((size_t)((b * 8 + (slot & 7)) * 32 + blk) * 2 + wr) * 64 + 8 * fq;
                *(f32x4*)kp = (f32x4){cs[0], cs[1], cs[2], cs[3]}; *(f32x4*)(kp + 4) = (f32x4){cs[4], cs[5], cs[6], cs[7]};
                *(f32x4*)(kp + 32) = (f32x4){cs[8], cs[9], cs[10], cs[11]}; *(f32x4*)(kp + 36) = (f32x4){cs[12], cs[13], cs[14], cs[15]}; }
        }
    }
};
struct EpiOutProj {
    static constexpr bool PERM = false, AFTER_DRAIN = false;
    const float* x; float* out; const float* gt;
    __device__ __forceinline__ void operator()(const f32x4 (&acc)[2][2][4][2], const Unit& u, int wr, int wc, int fr, int fq) const {
        const int b = u.pm >> 5; const int col0 = u.pn * BM + wc * 32 + 4 * fq; const float* gtb = gt + (size_t)b * 6144;
#pragma unroll
        for (int bj = 0; bj < 2; ++bj)
#pragma unroll
            for (int n = 0; n < 2; ++n) { const int c = col0 + bj * HALF + n * 16; const f32x4 g4 = *(const f32x4*)(gtb + c);
#pragma unroll
                for (int ai = 0; ai < 2; ++ai)
#pragma unroll
                    for (int m = 0; m < 4; ++m) { const size_t off = (size_t)(u.pm * BM + ai * HALF + wr * 64 + m * 16 + fr) * 1024 + c;
                        const f32x4 xv = *(const f32x4*)(x + off); *(f32x4*)(out + off) = xv + g4 * acc[ai][bj][m][n]; } }
    }
};
struct EpiGateUp {
    static constexpr bool PERM = true, AFTER_DRAIN = false;
    bf16_t* act;
    __device__ __forceinline__ void operator()(const f32x4 (&acc)[2][2][4][2], const Unit& u, int wr, int wc, int fr, int fq) const {
        const int h0 = u.pn * 128 + wc * 32 + 8 * fq;
#pragma unroll
        for (int ai = 0; ai < 2; ++ai)
#pragma unroll
            for (int m = 0; m < 4; ++m) { const size_t row = (size_t)(u.pm * BM + ai * HALF + wr * 64 + m * 16 + fr);
                const f32x4 g0 = acc[ai][0][m][0], g1 = acc[ai][0][m][1], u0 = acc[ai][1][m][0], u1 = acc[ai][1][m][1];
                u32x4 w;
                w.x = cvt_pk_bf16(silu_fast(g0[0]) * u0[0], silu_fast(g0[1]) * u0[1]); w.y = cvt_pk_bf16(silu_fast(g0[2]) * u0[2], silu_fast(g0[3]) * u0[3]);
                w.z = cvt_pk_bf16(silu_fast(g1[0]) * u1[0], silu_fast(g1[1]) * u1[1]); w.w = cvt_pk_bf16(silu_fast(g1[2]) * u1[2], silu_fast(g1[3]) * u1[3]);
                *(u32x4*)(act + row * 2816 + h0) = w; }
    }
};
struct EpiDown {
    static constexpr bool PERM = false, AFTER_DRAIN = false;
    float* out; const float* gt;
    __device__ __forceinline__ void operator()(const f32x4 (&acc)[2][2][4][2], const Unit& u, int wr, int wc, int fr, int fq) const {
        const int b = u.pm >> 5; const int col0 = u.pn * BM + wc * 32 + 4 * fq; const float* gtb = gt + (size_t)b * 6144;
#pragma unroll
        for (int bj = 0; bj < 2; ++bj)
#pragma unroll
            for (int n = 0; n < 2; ++n) { const int c = col0 + bj * HALF + n * 16; const f32x4 g4 = *(const f32x4*)(gtb + c);
#pragma unroll
                for (int ai = 0; ai < 2; ++ai)
#pragma unroll
                    for (int m = 0; m < 4; ++m) { const size_t off = (size_t)(u.pm * BM + ai * HALF + wr * 64 + m * 16 + fr) * 1024 + c;
                        const f32x4 xv = *(const f32x4*)(out + off); *(f32x4*)(out + off) = xv + g4 * acc[ai][bj][m][n]; } }
    }
};
}
constexpr int NWAVES = 8, NTHREADS = 512;
constexpr int BATCH = 4, SEQ = 8192, DM = 1024, TOK = BATCH * SEQ, NIN = 2840, NIN_PAD = 3072, FF = 2816, NCMP = 511;
constexpr size_t MiB = 1u << 20;
constexpr size_t WS_CTL = 0, CTL_ZERO_BYTES = 64 * 1024;
constexpr size_t WS_MODP = 1 * MiB;
constexpr size_t WS_MOD = 2 * MiB;
constexpr size_t WS_CBP = 2 * MiB + 512 * 1024;
constexpr size_t WS_KMP = 3 * MiB;
constexpr size_t WS_WIN = 6 * MiB, WS_WOUT = 12 * MiB, WS_WGU = 14 * MiB, WS_WDN = 25 * MiB;
constexpr size_t WS_W1K = 31 * MiB, WS_W1V = 32 * MiB, WS_W2K = 33 * MiB, WS_W2V = 33 * MiB + 64 * 1024;
constexpr size_t WS_KCMP = 34 * MiB, WS_VCMP = 35 * MiB;
constexpr size_t WS_GATES = 36 * MiB;
constexpr size_t WS_H = 40 * MiB;
constexpr size_t WS_MIX = 104 * MiB;
constexpr size_t WS_QKV = 168 * MiB;
constexpr size_t WS_ACT = WS_QKV;
constexpr size_t WS_END = 344 * MiB;
constexpr size_t QKV_BIG = (size_t)4 * 8 * SEQ * 64, QKV_SMALL = (size_t)4 * 2 * SEQ * 64;
constexpr int RING_BYTES = 131072, LDS_BYTES = 147456;
constexpr int N_PHASES = 9;

#define GAS __attribute__((address_space(1)))
#define LAS __attribute__((address_space(3)))
typedef unsigned short bf16;
typedef unsigned v4u __attribute__((ext_vector_type(4)));
typedef float f32x4 __attribute__((ext_vector_type(4)));
#define LDS_WAIT() asm volatile("s_waitcnt lgkmcnt(0)" ::: "memory")
#define VM_WAIT() asm volatile("s_waitcnt vmcnt(0)" ::: "memory")
__device__ __forceinline__ unsigned f2bf(float f) { unsigned u = __builtin_bit_cast(unsigned, f); return (u + 0x7fffu + ((u >> 16) & 1u)) >> 16; }
__device__ __forceinline__ unsigned pk2(float lo, float hi) { return f2bf(lo) | (f2bf(hi) << 16); }
__device__ __forceinline__ float bf2f(bf16 v) { return __builtin_bit_cast(float, (unsigned)v << 16); }
__device__ __forceinline__ float wave_sum(float v) {
#pragma unroll
    for (int o = 1; o < 64; o <<= 1) v += __shfl_xor(v, o);
    return v;
}
struct Args { const float* in[23]; float* out; unsigned char* ws; int ph_lo, ph_hi; };
struct Frame { LAS unsigned char* lds; int tid, lane, wave, vcu, G; };

struct MapId { __device__ __forceinline__ int operator()(int n) const { return n; } };
struct MapWin { __device__ __forceinline__ int operator()(int n) const { const int s = n >> 6, d = n & 63; return 256 * (s >> 2) + 128 * (d >> 5) + 32 * (s & 3) + (d & 31); } };
struct MapWgu { __device__ __forceinline__ int operator()(int n) const { const int up = n >= FF, hdn = up ? n - FF : n; return 256 * (hdn >> 7) + 128 * up + (hdn & 127); } };
template <class Map>
__device__ __forceinline__ void transpose_item(const float* __restrict__ W, int K, int N, bf16* WT, LAS float* scr, int item, int lane, const Map& map) {
    const int nblk = (N + 31) / 32, kb = item / nblk, nb = item % nblk, k0 = 64 * kb, n0 = 32 * nb;
    const bool nin = n0 + (lane & 31) < N;
#pragma unroll 8
    for (int i = 0; i < 32; ++i) { const int kk = 2 * i + (lane >> 5); scr[kk * 33 + (lane & 31)] = nin ? W[(size_t)(k0 + kk) * N + n0 + (lane & 31)] : 0.f; }
    LDS_WAIT(); asm volatile("" ::: "memory");
    const int c = lane & 7;
#pragma unroll
    for (int j = 0; j < 4; ++j) { const int n = (lane >> 3) + 8 * j; const LAS float* s = scr + (8 * c) * 33 + n;
        v4u o; o.x = pk2(s[0 * 33], s[1 * 33]); o.y = pk2(s[2 * 33], s[3 * 33]); o.z = pk2(s[4 * 33], s[5 * 33]); o.w = pk2(s[6 * 33], s[7 * 33]);
        if (n0 + n < N) *(GAS v4u*)(WT + (size_t)map(n0 + n) * K + k0 + 8 * c) = o; }
    LDS_WAIT(); asm volatile("" ::: "memory");
}
__device__ __forceinline__ float silu_acc(float v) { return v / (1.f + expf(-v)); }
__device__ __forceinline__ void phase_prologue_a(Frame& F, const Args& a) {
    LAS float* scr = (LAS float*)(F.lds + F.wave * 16384);
    const int gw = F.vcu * NWAVES + F.wave, NGW = F.G * NWAVES;
    unsigned char* ws = a.ws;
    constexpr int I_IN = (DM / 64) * ((NIN + 31) / 32), I_OUT = (DM / 64) * (DM / 32), I_GU = (DM / 64) * (2 * FF / 32), I_DN = (FF / 64) * (DM / 32), I_W1 = (2048 / 64) * (256 / 32), I_W2 = (256 / 64) * (64 / 32);
    constexpr int NITEMS = I_IN + I_OUT + I_GU + I_DN + 2 * I_W1 + 2 * I_W2;
    for (int it = gw; it < NITEMS; it += NGW) {
        int r = it;
        if (r < I_IN) { transpose_item(a.in[6], DM, NIN, (bf16*)(ws + WS_WIN), scr, r, F.lane, MapWin()); continue; } r -= I_IN;
        if (r < I_OUT) { transpose_item(a.in[19], DM, DM, (bf16*)(ws + WS_WOUT), scr, r, F.lane, MapId()); continue; } r -= I_OUT;
        if (r < I_GU) { transpose_item(a.in[21], DM, 2 * FF, (bf16*)(ws + WS_WGU), scr, r, F.lane, MapWgu()); continue; } r -= I_GU;
        if (r < I_DN) { transpose_item(a.in[22], FF, DM, (bf16*)(ws + WS_WDN), scr, r, F.lane, MapId()); continue; } r -= I_DN;
        if (r < I_W1) { transpose_item(a.in[14], 2048, 256, (bf16*)(ws + WS_W1K), scr, r, F.lane, MapId()); continue; } r -= I_W1;
        if (r < I_W1) { transpose_item(a.in[17], 2048, 256, (bf16*)(ws + WS_W1V), scr, r, F.lane, MapId()); continue; } r -= I_W1;
        if (r < I_W2) { transpose_item(a.in[15], 256, 64, (bf16*)(ws + WS_W2K), scr, r, F.lane, MapId()); continue; } r -= I_W2;
        transpose_item(a.in[18], 256, 64, (bf16*)(ws + WS_W2V), scr, r, F.lane, MapId());
    }
    const float* c = a.in[1]; const float* w_ada = a.in[3]; float* modp = (float*)(ws + WS_MODP);
    for (int t = NGW - 1 - gw; t < 96 * 8; t += NGW) { const int cg_ = t % 96, ks = t / 96; const int n = cg_ * 64 + F.lane;
        float acc0 = 0.f, acc1 = 0.f, acc2 = 0.f, acc3 = 0.f;
#pragma unroll 8
        for (int k = ks * 128; k < ks * 128 + 128; ++k) { const float w = w_ada[(size_t)k * 6144 + n];
            acc0 += silu_acc(c[k]) * w; acc1 += silu_acc(c[DM + k]) * w; acc2 += silu_acc(c[2 * DM + k]) * w; acc3 += silu_acc(c[3 * DM + k]) * w; }
        float* o = modp + (size_t)ks * 4 * 6144 + n; o[0] = acc0; o[6144] = acc1; o[2 * 6144] = acc2; o[3 * 6144] = acc3; }
    float* cbp = (float*)(ws + WS_CBP);
    for (int t = NGW / 2 - 1 - gw; t >= 0 && t < 256; t += NGW) { const int kv = t & 1, cg_ = (t >> 1) & 3, ic = t >> 3; const int n = cg_ * 64 + F.lane;
        const float* pe = kv ? a.in[16] : a.in[13]; const float* w1 = kv ? a.in[17] : a.in[14]; float acc = 0.f;
#pragma unroll 8
        for (int i = ic * 64; i < ic * 64 + 64; ++i) acc += pe[i] * w1[(size_t)i * 256 + n];
        cbp[(ic * 2 + kv) * 256 + n] = acc; }
}
__device__ __forceinline__ void norm_rows(Frame& F, const float* in, const f32x4 (&gs)[4], const f32x4 (&sh)[4], bf16* out) {
    for (int i = 0; i < 16; ++i) { const int row = F.vcu * 128 + F.wave * 16 + i;
        const GAS f32x4* xr = (const GAS f32x4*)(in + (size_t)row * DM) + F.lane;
        f32x4 v[4]; float ss = 0.f;
#pragma unroll
        for (int j = 0; j < 4; ++j) { v[j] = xr[64 * j]; ss += (v[j].x * v[j].x + v[j].y * v[j].y) + (v[j].z * v[j].z + v[j].w * v[j].w); }
        const float rs = rsqrtf(wave_sum(ss) * (1.f / DM) + 1e-6f);
        GAS unsigned long long* o8 = (GAS unsigned long long*)(out + (size_t)row * DM) + F.lane;
#pragma unroll
        for (int j = 0; j < 4; ++j) { const f32x4 y = v[j] * rs * gs[j] + sh[j]; o8[64 * j] = (unsigned long long)pk2(y.x, y.y) | ((unsigned long long)pk2(y.z, y.w) << 32); } }
}
__device__ __forceinline__ void phase_prologue_b(Frame& F, const Args& a) {
    unsigned char* ws = a.ws; const float* modp = (const float*)(ws + WS_MODP); const float* b_ada = a.in[4];
    if (F.wave == 0 && F.vcu < 96) { const int n = F.vcu * 64 + F.lane; float* mod = (float*)(ws + WS_MOD);
        for (int b = 0; b < 4; ++b) { float s = 0.f;
#pragma unroll
            for (int ks = 0; ks < 8; ++ks) s += modp[((size_t)ks * 4 + b) * 6144 + n];
            mod[b * 6144 + n] = s + b_ada[n]; } }
    const int b = F.vcu >> 6; const float* g = a.in[5];
    f32x4 gs[4], sh[4];
#pragma unroll
    for (int j = 0; j < 4; ++j) { const int c0 = 4 * F.lane + 256 * j; f32x4 s0 = {0.f, 0.f, 0.f, 0.f}, s1 = {0.f, 0.f, 0.f, 0.f};
#pragma unroll
        for (int ks = 0; ks < 8; ++ks) { s0 += *(const f32x4*)(modp + ((size_t)ks * 4 + b) * 6144 + c0); s1 += *(const f32x4*)(modp + ((size_t)ks * 4 + b) * 6144 + DM + c0); }
        s0 += *(const f32x4*)(b_ada + c0); s1 += *(const f32x4*)(b_ada + DM + c0);
        sh[j] = s0; gs[j] = *(const f32x4*)(g + c0) * (s1 + 1.0f); }
    norm_rows(F, a.in[0], gs, sh, (bf16*)(ws + WS_H));
}
__device__ __forceinline__ void phase_norm2(Frame& F, const Args& a) {
    unsigned char* ws = a.ws; const int b = F.vcu >> 6; const float* mod = (const float*)(ws + WS_MOD) + (size_t)b * 6144; const float* g = a.in[20];
    f32x4 gs[4], sh[4];
#pragma unroll
    for (int j = 0; j < 4; ++j) { const int c0 = 4 * F.lane + 256 * j; sh[j] = *(const f32x4*)(mod + 3 * DM + c0); gs[j] = *(const f32x4*)(g + c0) * (*(const f32x4*)(mod + 4 * DM + c0) + 1.0f); }
    norm_rows(F, a.out, gs, sh, (bf16*)(ws + WS_H));
}
namespace att {
using bf16x8 = __attribute__((ext_vector_type(8))) short;
using s16x4 = __attribute__((ext_vector_type(4))) short;
using f32x16 = __attribute__((ext_vector_type(16))) float;
using u32x4 = __attribute__((ext_vector_type(4))) unsigned;
typedef LAS const char* lds_cptr;
typedef short v4i16_t __attribute__((ext_vector_type(4)));
constexpr int SLOT = 16384, LDS_OST = 49152, LDS_LUT = 81920, LDS_IMP = 83968, LDS_SELM = 116736, LDS_MISC = 117760, LDS_WSF = 118016, LDS_ATT_END = 120064;
constexpr float LOG2E = 1.4426950408889634f;
#define MFMA32(a, b, c) __builtin_amdgcn_mfma_f32_32x32x16_bf16(a, b, c, 0, 0, 0)
#define ATT_WAIT_BAR(N) asm volatile("s_waitcnt vmcnt(" #N ") lgkmcnt(0)\n\ts_barrier" ::: "memory")
__device__ __forceinline__ void glds16(const void* gsrc, unsigned lds_dst) { unsigned keep;
    asm volatile("s_mov_b32 %0, m0\n\ts_mov_b32 m0, %2\n\ts_nop 0\n\tglobal_load_lds_dwordx4 %1, off\n\ts_mov_b32 m0, %0" : "=&s"(keep) : "v"(gsrc), "s"(lds_dst) : "memory"); }
typedef float f32x2_t __attribute__((ext_vector_type(2))); typedef __bf16 bf16x2_t __attribute__((ext_vector_type(2)));
__device__ __forceinline__ unsigned cvtpk(float lo, float hi) { f32x2_t v = {lo, hi}; bf16x2_t b = __builtin_convertvector(v, bf16x2_t); return __builtin_bit_cast(unsigned, b); }
__device__ __forceinline__ s16x4 vtr(lds_cptr p) { return __builtin_bit_cast(s16x4, __builtin_amdgcn_ds_read_tr16_b64_v4i16((LAS v4i16_t*)p)); }
__device__ __forceinline__ int t5_bucket(int d) {
    if (d < 16) return d;
    int b = 16;
    b += (d >= 19); b += (d >= 21); b += (d >= 24); b += (d >= 27); b += (d >= 31); b += (d >= 35); b += (d >= 40); b += (d >= 46);
    b += (d >= 52); b += (d >= 59); b += (d >= 67); b += (d >= 77); b += (d >= 87); b += (d >= 99); b += (d >= 113);
    return b;
}
struct Ctx {
    LAS char* lds; unsigned lds0; int lane, r32, hi, wid;
    int koff, voff;
    unsigned kdst, vdst;
    lds_cptr kp0, vp0;
    LAS float* wsf;
    float m2;
};
__device__ __forceinline__ Ctx make_ctx(LAS unsigned char* lds, int tid) {
    Ctx c; c.lds = (LAS char*)lds; c.lds0 = (unsigned)(uintptr_t)lds; c.lane = tid & 63; c.r32 = c.lane & 31; c.hi = c.lane >> 5; c.wid = __builtin_amdgcn_readfirstlane(tid >> 6);
    c.koff = c.lane * 64 + c.wid * 8; c.voff = (16 * (c.wid & 3) + (c.lane >> 2)) * 64 + (c.wid >> 2) * 32 + (c.lane & 3) * 8;
    c.kdst = c.lds0 + c.wid * 1024; c.vdst = c.lds0 + 8192 + c.wid * 1024;
    c.kp0 = (lds_cptr)c.lds + c.hi * 1024 + c.r32 * 16;
    c.vp0 = (lds_cptr)c.lds + 8192 + ((c.lane >> 4) & 1) * 32 + (c.lane & 3) * 8 + (4 * c.hi + ((c.lane & 15) >> 2)) * 64;
    c.wsf = (LAS float*)(c.lds + LDS_WSF) + c.wid * 64; c.m2 = 0.f;
    return c;
}
template <bool HASV, class Fn>
__device__ __forceinline__ void run_stream(const Ctx& c, const bf16* Kb, const bf16* Vb, int t0, int t1, Fn&& fn) {
    const int n = t1 - t0; if (n <= 0) return;
    const bf16* ks = Kb + c.koff; const bf16* vs = Vb + c.voff;
#define ATT_ISSUE(t, so) do { glds16(ks + (size_t)(t) * 4096, (unsigned)__builtin_amdgcn_readfirstlane(c.kdst + (so))); if (HASV) glds16(vs + (size_t)(t) * 4096, (unsigned)__builtin_amdgcn_readfirstlane(c.vdst + (so))); } while (0)
    ATT_ISSUE(t0, 0); if (n > 1) ATT_ISSUE(t0 + 1, SLOT);
    int slot = 0, slot2 = 2 * SLOT;
    for (int i = 0; i < n; ++i) {
        if (i + 1 < n) { if (HASV) ATT_WAIT_BAR(2); else ATT_WAIT_BAR(1); } else ATT_WAIT_BAR(0);
        if (i + 2 < n) ATT_ISSUE(t0 + i + 2, slot2);
        fn(t0 + i, slot);
        slot = (slot == 2 * SLOT) ? 0 : slot + SLOT; slot2 = (slot2 == 2 * SLOT) ? 0 : slot2 + SLOT;
    }
    asm volatile("s_waitcnt lgkmcnt(0)\n\ts_barrier" ::: "memory");
#undef ATT_ISSUE
}
__device__ __forceinline__ void qk_tile(f32x16& s0, f32x16& s1, lds_cptr kp, const bf16x8 (&qr)[4]) {
    bf16x8 kf[8];
#pragma unroll
    for (int d0 = 0; d0 < 4; ++d0) { kf[2 * d0] = *(const LAS bf16x8*)(kp + d0 * 2048); kf[2 * d0 + 1] = *(const LAS bf16x8*)(kp + d0 * 2048 + 512); }
    const f32x16 z = {};
    s0 = MFMA32(kf[0], qr[0], z); s1 = MFMA32(kf[1], qr[0], z);
#pragma unroll
    for (int d0 = 1; d0 < 4; ++d0) { s0 = MFMA32(kf[2 * d0], qr[d0], s0); s1 = MFMA32(kf[2 * d0 + 1], qr[d0], s1); }
}
__device__ __forceinline__ void pv_tile(f32x16 (&o)[2], lds_cptr vp, const f32x16& p0, const f32x16& p1) {
    u32x4 pw0 = {cvtpk(p0[0], p0[1]), cvtpk(p0[2], p0[3]), cvtpk(p0[4], p0[5]), cvtpk(p0[6], p0[7])}, pw1 = {cvtpk(p0[8], p0[9]), cvtpk(p0[10], p0[11]), cvtpk(p0[12], p0[13]), cvtpk(p0[14], p0[15])};
    u32x4 pw2 = {cvtpk(p1[0], p1[1]), cvtpk(p1[2], p1[3]), cvtpk(p1[4], p1[5]), cvtpk(p1[6], p1[7])}, pw3 = {cvtpk(p1[8], p1[9]), cvtpk(p1[10], p1[11]), cvtpk(p1[12], p1[13]), cvtpk(p1[14], p1[15])};
    s16x4 vlo[8], vhi[8];
#pragma unroll
    for (int i = 0; i < 8; ++i) { vlo[i] = vtr(vp + ((i >> 2) * 4096 + (i & 3) * 1024)); vhi[i] = vtr(vp + ((i >> 2) * 4096 + (i & 3) * 1024 + 512)); }
#define ATT_VFR(i) (bf16x8){vlo[i][0], vlo[i][1], vlo[i][2], vlo[i][3], vhi[i][0], vhi[i][1], vhi[i][2], vhi[i][3]}
    o[0] = MFMA32(__builtin_bit_cast(bf16x8, pw0), ATT_VFR(0), o[0]); o[1] = MFMA32(__builtin_bit_cast(bf16x8, pw0), ATT_VFR(4), o[1]);
    o[0] = MFMA32(__builtin_bit_cast(bf16x8, pw1), ATT_VFR(1), o[0]); o[1] = MFMA32(__builtin_bit_cast(bf16x8, pw1), ATT_VFR(5), o[1]);
    o[0] = MFMA32(__builtin_bit_cast(bf16x8, pw2), ATT_VFR(2), o[0]); o[1] = MFMA32(__builtin_bit_cast(bf16x8, pw2), ATT_VFR(6), o[1]);
    o[0] = MFMA32(__builtin_bit_cast(bf16x8, pw3), ATT_VFR(3), o[0]); o[1] = MFMA32(__builtin_bit_cast(bf16x8, pw3), ATT_VFR(7), o[1]);
#undef ATT_VFR
}
__device__ __forceinline__ float rowsum32(const f32x16& p0, const f32x16& p1) { float a = 0.f, b = 0.f;
#pragma unroll
    for (int r = 0; r < 16; ++r) { a += p0[r]; b += p1[r]; }
    return a + b; }
__device__ __forceinline__ void hook_const(f32x16& s0, f32x16& s1, float cb, bool pred) {
#pragma unroll
    for (int r = 0; r < 16; ++r) { s0[r] = pred ? __builtin_amdgcn_exp2f(s0[r] + cb) : 0.f; s1[r] = pred ? __builtin_amdgcn_exp2f(s1[r] + cb) : 0.f; } }
__device__ __forceinline__ void hook_general(f32x16& s0, f32x16& s1, int base, int win, const LAS float* lut, bool pred) {
#pragma unroll
    for (int r = 0; r < 16; ++r) { const int d0 = base - ((r & 3) + 8 * (r >> 2)), d1 = d0 - 32;
        const bool v0 = pred && d0 >= 0 && d0 < win, v1 = pred && d1 >= 0 && d1 < win;
        const float b0 = lut[min(max(d0, 0), 113)], b1 = lut[min(max(d1, 0), 113)];
        s0[r] = v0 ? __builtin_amdgcn_exp2f(s0[r] + b0) : 0.f; s1[r] = v1 ? __builtin_amdgcn_exp2f(s1[r] + b1) : 0.f; } }
__device__ __forceinline__ void hook_cmp(f32x16& s0, f32x16& s1, int nrel  , float cb, float scale) {
#pragma unroll
    for (int r = 0; r < 16; ++r) { const int c0 = (r & 3) + 8 * (r >> 2);
        s0[r] = (c0 <= nrel) ? __builtin_amdgcn_exp2f(s0[r] + cb) * scale : 0.f; s1[r] = (c0 + 32 <= nrel) ? __builtin_amdgcn_exp2f(s1[r] + cb) * scale : 0.f; } }
__device__ __forceinline__ void row_factors(const Ctx& c, float f, float (&fr)[16]) {
    asm volatile("s_waitcnt lgkmcnt(0)" ::: "memory");
    if (c.hi == 0) c.wsf[c.r32] = f;
    asm volatile("s_waitcnt lgkmcnt(0)" ::: "memory");
#pragma unroll
    for (int r = 0; r < 16; ++r) fr[r] = c.wsf[(r & 3) + 8 * (r >> 2) + 4 * c.hi];
    asm volatile("s_waitcnt lgkmcnt(0)" ::: "memory");
}
__device__ __forceinline__ float pair_sum(float v) { auto rr = __builtin_amdgcn_permlane32_swap(__float_as_uint(v), __float_as_uint(v), false, false); return __uint_as_float(rr[0]) + __uint_as_float(rr[1]); }
template <class RowOff>
__device__ __forceinline__ void store_rows(const Ctx& c, const f32x16 (&o)[2], bf16* dst, RowOff&& rowoff) {
    LAS bf16* stg = (LAS bf16*)(c.lds + LDS_OST) + c.wid * 2048;
#pragma unroll
    for (int r = 0; r < 16; ++r) { const int orow = (r & 3) + 8 * (r >> 2) + 4 * c.hi;
#pragma unroll
        for (int d0 = 0; d0 < 2; ++d0) stg[orow * 64 + d0 * 32 + c.r32] = (bf16)f2bf(o[d0][r]); }
    asm volatile("s_waitcnt lgkmcnt(0)" ::: "memory");
#pragma unroll
    for (int i = 0; i < 4; ++i) { const int row = i * 8 + (c.lane >> 3), ch = c.lane & 7; const u32x4 v = *(const LAS u32x4*)(stg + row * 64 + ch * 8); *(u32x4*)(dst + rowoff(row) + ch * 8) = v; }
    asm volatile("s_waitcnt lgkmcnt(0)" ::: "memory");
}
struct AttnPtrs { const bf16* qkv; const float* kmp; const float* gates; const bf16* kcmp; const bf16* vcmp; const float* rel_bias; bf16* mix; };

__device__ __forceinline__ void moba_item(const Ctx& c, const AttnPtrs& P, int b, int h, int i) {
    const int q0 = 256 * i + 32 * c.wid, qpos = q0 + c.r32;
    const bf16* QA = P.qkv + ((size_t)(b * 8 + h) * SEQ) * 64; const bf16* KA = QA + QKV_BIG; const bf16* VA = QA + 2 * QKV_BIG;
    bf16x8 qr[4];
#pragma unroll
    for (int d0 = 0; d0 < 4; ++d0) qr[d0] = *(const bf16x8*)(QA + (size_t)qpos * 64 + d0 * 16 + c.hi * 8);
    LAS float* lut = (LAS float*)(c.lds + LDS_LUT);
    if (threadIdx.x < 114) lut[threadIdx.x] = P.rel_bias[t5_bucket(threadIdx.x) * 16 + h] * LOG2E - c.m2;
    unsigned selmask = 0u;
    if (i > 0) {
        bf16x8 kmf[4];
        const float* kp = P.kmp + ((size_t)((b * 8 + h) * 32 + c.r32) * 2) * 64;
#pragma unroll
        for (int d0 = 0; d0 < 4; ++d0) { const f32x4 a0 = *(const f32x4*)(kp + d0 * 16 + c.hi * 8), a1 = *(const f32x4*)(kp + d0 * 16 + c.hi * 8 + 4), b0 = *(const f32x4*)(kp + 64 + d0 * 16 + c.hi * 8), b1 = *(const f32x4*)(kp + 64 + d0 * 16 + c.hi * 8 + 4);
            const f32x4 m0 = (a0 + b0) * (1.f / 256.f), m1 = (a1 + b1) * (1.f / 256.f);
            u32x4 w = {cvtpk(m0[0], m0[1]), cvtpk(m0[2], m0[3]), cvtpk(m1[0], m1[1]), cvtpk(m1[2], m1[3])}; kmf[d0] = __builtin_bit_cast(bf16x8, w); }
        f32x16 sg = {};
#pragma unroll
        for (int d0 = 0; d0 < 4; ++d0) sg = MFMA32(kmf[d0], qr[d0], sg);
        float v[16];
#pragma unroll
        for (int r = 0; r < 16; ++r) v[r] = ((r & 3) + 8 * (r >> 2) + 4 * c.hi < i) ? sg[r] : -INFINITY;
#pragma unroll
        for (int it = 0; it < 3; ++it) {
            float m = v[0]; int jb = 4 * c.hi;
#pragma unroll
            for (int r = 1; r < 16; ++r) { const int j = (r & 3) + 8 * (r >> 2) + 4 * c.hi; if (v[r] > m) { m = v[r]; jb = j; } }
            auto rm = __builtin_amdgcn_permlane32_swap(__float_as_uint(m), __float_as_uint(m), false, false);
            auto rj = __builtin_amdgcn_permlane32_swap((unsigned)jb, (unsigned)jb, false, false);
            const float mo = __uint_as_float(c.hi ? rm[0] : rm[1]); const int jo = (int)(c.hi ? rj[0] : rj[1]);
            const bool mine = (m > mo) || (m == mo && jb < jo);
            const float mw = mine ? m : mo; const int jw = mine ? jb : jo;
            if (mw > -INFINITY) { selmask |= 1u << jw;
#pragma unroll
                for (int r = 0; r < 16; ++r) if ((r & 3) + 8 * (r >> 2) + 4 * c.hi == jw) v[r] = -INFINITY; }
        }
    }
    asm volatile("s_waitcnt lgkmcnt(0)\n\ts_barrier" ::: "memory");
    const float cb31 = lut[113];
    f32x16 o[2]; o[0] = f32x16{}; o[1] = f32x16{}; float l_reg = 0.f;
    run_stream<true>(c, KA, VA, 0, 4 * i + 4, [&](int t, int slot) {
        const int key0 = 64 * t, blk = t >> 2;
        const int dmax = q0 + 31 - key0, dmin = q0 - key0 - 63;
        if (dmax < 0) return;
        const bool pred = (blk == i) || ((selmask >> blk) & 1u);
        if (!__any(pred)) return;
        f32x16 s0, s1; qk_tile(s0, s1, c.kp0 + slot, qr);
        if (dmin >= 113) hook_const(s0, s1, cb31, pred); else hook_general(s0, s1, qpos - key0 - 4 * c.hi, 1 << 30, lut, pred);
        l_reg += rowsum32(s0, s1);
        pv_tile(o, c.vp0 + slot, s0, s1);
    });
    const float L = pair_sum(l_reg); float fr[16]; row_factors(c, 1.f / L, fr);
#pragma unroll
    for (int r = 0; r < 16; ++r) { o[0][r] *= fr[r]; o[1][r] *= fr[r]; }
    bf16* dst = P.mix + ((size_t)b * SEQ + q0) * DM + h * 64;
    store_rows(c, o, dst, [](int row) { return (size_t)row * DM; });
    asm volatile("s_waitcnt lgkmcnt(0)\n\ts_barrier" ::: "memory");
}

__device__ __forceinline__ void nsa_item(const Ctx& c, const AttnPtrs& P, int b, int g, int ci) {
    const int ql = 8 * c.wid + (c.r32 >> 2), rh = c.r32 & 3, qpos = 64 * ci + ql, hb = 4 * g + rh;
    const int qw0 = 64 * ci + 8 * c.wid;
    const bf16* QB = P.qkv + 3 * QKV_BIG + ((size_t)(b * 8 + hb) * SEQ) * 64;
    const bf16* KS = P.qkv + 4 * QKV_BIG + 2 * QKV_SMALL + ((size_t)(b * 2 + g) * SEQ) * 64; const bf16* VS = KS + QKV_SMALL; const bf16* KW = KS + 2 * QKV_SMALL; const bf16* VW = KS + 3 * QKV_SMALL;
    const bf16* KC = P.kcmp + (size_t)(b * 2 + g) * 512 * 64; const bf16* VC = P.vcmp + (size_t)(b * 2 + g) * 512 * 64;
    bf16x8 qr[4];
#pragma unroll
    for (int d0 = 0; d0 < 4; ++d0) qr[d0] = *(const bf16x8*)(QB + (size_t)qpos * 64 + d0 * 16 + c.hi * 8);
    const float* gp = P.gates + ((size_t)b * SEQ + qpos) * 24 + hb * 3; const float g0 = gp[0], g1 = gp[1], g2 = gp[2];
    LAS float* lutall = (LAS float*)(c.lds + LDS_LUT);
    if (threadIdx.x < 456) { const int hh = threadIdx.x / 114, d = threadIdx.x % 114; lutall[hh * 128 + d] = P.rel_bias[t5_bucket(d) * 16 + 8 + 4 * g + hh] * LOG2E - c.m2; }
    const LAS float* lut = lutall + rh * 128;
    LAS float* imp = (LAS float*)(c.lds + LDS_IMP);
    LAS unsigned* selm = (LAS unsigned*)(c.lds + LDS_SELM);
    f32x16 o[2]; float l_reg; float fr[16];
    LAS float* park = (LAS float*)(c.lds + LDS_OST) + c.wid * 1024 + c.lane;
    LAS float* park1 = (LAS float*)(c.lds + LDS_IMP) + c.wid * 1024 + c.lane;
    const int nct = (4 * ci + 3 + 63) >> 6;
    const int nlim = (qpos >= 31) ? ((qpos - 31) >> 4) : -1;
    l_reg = 0.f;
    run_stream<false>(c, KC, VC, 0, nct, [&](int t, int slot) {
        f32x16 s0, s1; qk_tile(s0, s1, c.kp0 + slot, qr);
        hook_cmp(s0, s1, nlim - 64 * t - 4 * c.hi, -c.m2, 1.f);
        l_reg += rowsum32(s0, s1);
    });
    const float Lc = pair_sum(l_reg); const float invLc = Lc > 0.f ? 1.f / Lc : 0.f;
    o[0] = f32x16{}; o[1] = f32x16{};
    {
        float carry = 0.f;
        run_stream<true>(c, KC, VC, 0, nct, [&](int t, int slot) {
            f32x16 s0, s1; qk_tile(s0, s1, c.kp0 + slot, qr);
            hook_cmp(s0, s1, nlim - 64 * t - 4 * c.hi, -c.m2, invLc);
#pragma unroll
            for (int half = 0; half < 2; ++half) {
                float g4[4], e[4];
#pragma unroll
                for (int a = 0; a < 4; ++a) { const float x0 = half ? s1[4 * a] : s0[4 * a], x1 = half ? s1[4 * a + 1] : s0[4 * a + 1], x2 = half ? s1[4 * a + 2] : s0[4 * a + 2], x3 = half ? s1[4 * a + 3] : s0[4 * a + 3];
                    float gs = (x0 + x1) + (x2 + x3), es = x3;
                    gs += __shfl_xor(gs, 1); gs += __shfl_xor(gs, 2); es += __shfl_xor(es, 1); es += __shfl_xor(es, 2);
                    g4[a] = gs; e[a] = es; }
                float x[4];
#pragma unroll
                for (int a = 0; a < 4; ++a) { auto rr = __builtin_amdgcn_permlane32_swap(__float_as_uint(e[a]), __float_as_uint(e[a]), false, false); x[a] = __uint_as_float(c.hi ? rr[0] : rr[1]); }
                const int jb = 16 * t + 8 * half;
                float iv[4];
                if (c.hi) {
#pragma unroll
                    for (int a = 0; a < 4; ++a) iv[a] = g4[a] + x[a]; }
                else { iv[0] = g4[0] + carry; iv[1] = g4[1] + x[0]; iv[2] = g4[2] + x[1]; iv[3] = g4[3] + x[2]; carry = x[3]; }
                if (rh == 0) {
#pragma unroll
                    for (int a = 0; a < 4; ++a) imp[ql * 128 + jb + 2 * a + c.hi] = iv[a]; }
            }
#pragma unroll
            for (int r = 0; r < 16; ++r) { s0[r] *= g0; s1[r] *= g0; }
            pv_tile(o, c.vp0 + slot, s0, s1);
        });
    }
    {
        asm volatile("s_waitcnt lgkmcnt(0)\n\ts_barrier" ::: "memory");
        const int qq = 8 * c.wid + (c.lane >> 3), cc = c.lane & 7;
        unsigned m0 = 0u, m1 = 0u, m2w = 0u, m3 = 0u;
        if (ci <= 15) { m0 = (ci == 31) ? 0xffffffffu : ((2u << ci) - 1u); }
        else {
            float v[16];
#pragma unroll
            for (int k = 0; k < 16; ++k) { const int j = cc + 8 * k; v[k] = (j >= 1 && j <= ci - 2) ? imp[qq * 128 + j] : -INFINITY; }
            for (int it = 0; it < 13; ++it) {
                float m = v[0]; int jb = cc;
#pragma unroll
                for (int k = 1; k < 16; ++k) if (v[k] > m) { m = v[k]; jb = cc + 8 * k; }
#pragma unroll
                for (int sft = 1; sft < 8; sft <<= 1) { const float mo = __shfl_xor(m, sft); const int jo = __shfl_xor(jb, sft); if (mo > m || (mo == m && jo < jb)) { m = mo; jb = jo; } }
                if (m > -INFINITY) { const unsigned bit = 1u << (jb & 31); const int wsel = jb >> 5;
                    m0 |= (wsel == 0) ? bit : 0u; m1 |= (wsel == 1) ? bit : 0u; m2w |= (wsel == 2) ? bit : 0u; m3 |= (wsel == 3) ? bit : 0u;
#pragma unroll
                    for (int k = 0; k < 16; ++k) if (cc + 8 * k == jb) v[k] = -INFINITY; }
            }
            m0 |= 1u;
#pragma unroll
            for (int z = 0; z < 2; ++z) { const int jf = ci - z; const unsigned bit = 1u << (jf & 31); const int wsel = jf >> 5;
                m0 |= (wsel == 0) ? bit : 0u; m1 |= (wsel == 1) ? bit : 0u; m2w |= (wsel == 2) ? bit : 0u; m3 |= (wsel == 3) ? bit : 0u; }
        }
        if (cc == 0) { selm[qq * 4 + 0] = m0; selm[qq * 4 + 1] = m1; selm[qq * 4 + 2] = m2w; selm[qq * 4 + 3] = m3; }
        asm volatile("s_waitcnt lgkmcnt(0)\n\ts_barrier" ::: "memory");
    }
    const float cb31 = lut[113];
#pragma unroll
    for (int r = 0; r < 16; ++r) { park[r * 64] = o[0][r]; park1[r * 64] = o[1][r]; }
    {
        const unsigned w0 = selm[ql * 4 + 0], w1 = selm[ql * 4 + 1], w2 = selm[ql * 4 + 2], w3 = selm[ql * 4 + 3];
        o[0] = f32x16{}; o[1] = f32x16{}; l_reg = 0.f;
        run_stream<true>(c, KS, VS, 0, ci + 1, [&](int t, int slot) {
            const int key0 = 64 * t; const unsigned wsel = (t < 32) ? w0 : (t < 64) ? w1 : (t < 96) ? w2 : w3;
            const bool pred = (wsel >> (t & 31)) & 1u;
            if (!__any(pred)) return;
            f32x16 s0, s1; qk_tile(s0, s1, c.kp0 + slot, qr);
            const int dmin = qw0 - key0 - 63;
            if (dmin >= 113) hook_const(s0, s1, cb31, pred); else hook_general(s0, s1, qpos - key0 - 4 * c.hi, 1 << 30, lut, pred);
            l_reg += rowsum32(s0, s1);
            pv_tile(o, c.vp0 + slot, s0, s1);
        });
        const float Ls = pair_sum(l_reg);
        row_factors(c, g1 / Ls, fr);
#pragma unroll
        for (int r = 0; r < 16; ++r) { park[r * 64] += o[0][r] * fr[r]; park1[r * 64] += o[1][r] * fr[r]; }
    }
    {
        o[0] = f32x16{}; o[1] = f32x16{}; l_reg = 0.f;
        run_stream<true>(c, KW, VW, ci >= 8 ? ci - 8 : 0, ci + 1, [&](int t, int slot) {
            const int key0 = 64 * t;
            f32x16 s0, s1; qk_tile(s0, s1, c.kp0 + slot, qr);
            const int dmin = qw0 - key0 - 63, dmax = qw0 + 7 - key0;
            if (dmin >= 113 && dmax < 512) hook_const(s0, s1, cb31, true); else hook_general(s0, s1, qpos - key0 - 4 * c.hi, 512, lut, true);
            l_reg += rowsum32(s0, s1);
            pv_tile(o, c.vp0 + slot, s0, s1);
        });
        const float Lw = pair_sum(l_reg);
        row_factors(c, g2 / Lw, fr);
#pragma unroll
        for (int r = 0; r < 16; ++r) { o[0][r] = park[r * 64] + o[0][r] * fr[r]; o[1][r] = park1[r * 64] + o[1][r] * fr[r]; }
        asm volatile("s_waitcnt lgkmcnt(0)" ::: "memory");
    }
    bf16* dst = P.mix + ((size_t)b * SEQ + 64 * ci + 8 * c.wid) * DM + 512 + g * 256;
    store_rows(c, o, dst, [](int row) { return (size_t)(row >> 2) * DM + (row & 3) * 64; });
    asm volatile("s_waitcnt lgkmcnt(0)\n\ts_barrier" ::: "memory");
}

__device__ __forceinline__ void attn_phase(LAS unsigned char* lds, const AttnPtrs& P, unsigned* qcounter, const float* gqa, const float* gka, const float* gqb, const float* gkc, const float* gks, const float* gkw) {
    Ctx c = make_ctx(lds, threadIdx.x);
    LAS unsigned* misc = (LAS unsigned*)(c.lds + LDS_MISC);
    { float gq = fmaxf(fabsf(gqa[c.lane]), fabsf(gqb[c.lane])), gk = fmaxf(fmaxf(fabsf(gka[c.lane]), fabsf(gkc[c.lane])), fmaxf(fabsf(gks[c.lane]), fabsf(gkw[c.lane])));
      float bm = 0.f;
#pragma unroll
      for (int i = 0; i < 8; ++i) bm = fmaxf(bm, fabsf(P.rel_bias[c.lane + 64 * i]));
#pragma unroll
      for (int o_ = 1; o_ < 64; o_ <<= 1) { gq = fmaxf(gq, __shfl_xor(gq, o_)); gk = fmaxf(gk, __shfl_xor(gk, o_)); bm = fmaxf(bm, __shfl_xor(bm, o_)); }
      c.m2 = (8.f * gq * gk * 1.02f + bm) * LOG2E + 0.5f; }
    for (;;) {
        if (threadIdx.x == 0) misc[0] = __hip_atomic_fetch_add(qcounter, 1u, __ATOMIC_RELAXED, __HIP_MEMORY_SCOPE_AGENT);
        asm volatile("s_waitcnt vmcnt(0) lgkmcnt(0)\n\ts_barrier" ::: "memory");
        const unsigned k = misc[0];
        asm volatile("s_waitcnt lgkmcnt(0)\n\ts_barrier" ::: "memory");
        if (k >= 2048u) break;
        const int blk = k >> 6, idx = k & 63;
        if (idx < 32) moba_item(c, P, idx >> 3, idx & 7, 31 - blk);
        else { const int s = 127 - 4 * blk - ((idx - 32) >> 3), bg = (idx - 32) & 7; nsa_item(c, P, bg >> 1, bg & 1, s); }
    }
}
#undef MFMA32
#undef ATT_WAIT_BAR
}
namespace cmpr {
using bf16x8 = __attribute__((ext_vector_type(8))) short;
using f32x16 = __attribute__((ext_vector_type(16))) float;
constexpr int HID_PITCH = 528;
__device__ __forceinline__ float gelu_tanh(float v) { const float u = fminf(fmaxf(0.7978845608028654f * (v + 0.044715f * v * v * v), -15.f), 15.f); const float e = __expf(2.f * u); return 0.5f * v * (1.f + (e - 1.f) / (e + 1.f)); }
__device__ __forceinline__ void compress_unit(LAS unsigned char* lds, int unit, const bf16* qkv, const bf16* w1k, const bf16* w1v, const bf16* w2k, const bf16* w2v, const float* cbp, const float* kncmp, bf16* kcmp, bf16* vcmp) {
    const int tid = threadIdx.x, lane = tid & 63, r32 = lane & 31, hi = lane >> 5; const int wid = __builtin_amdgcn_readfirstlane(tid >> 6);
    const int kv = unit & 1, u = (unit >> 1) & 15, bg = unit >> 5;
    const bf16* src = qkv + 4 * QKV_BIG + (kv ? QKV_SMALL : 0) + (size_t)bg * SEQ * 64;
    const bf16* w1 = kv ? w1v : w1k; const bf16* w2 = kv ? w2v : w2k;
    const int n0 = 32 * u; const int nn = min(n0 + r32, NCMP - 1);
    const bf16* ap = src + (size_t)nn * 1024 + 8 * hi; const bf16* bp = w1 + (size_t)(32 * wid + r32) * 2048 + 8 * hi;
    f32x16 acc = {};
#pragma unroll 8
    for (int kk = 0; kk < 128; ++kk) { const bf16x8 a = *(const bf16x8*)(ap + 16 * kk), bfr = *(const bf16x8*)(bp + 16 * kk); acc = __builtin_amdgcn_mfma_f32_32x32x16_bf16(a, bfr, acc, 0, 0, 0); }
    float cb = 0.f;
#pragma unroll 8
    for (int ic = 0; ic < 32; ++ic) cb += cbp[(ic * 2 + kv) * 256 + 32 * wid + r32];
    LAS unsigned char* hidL = lds;
#pragma unroll
    for (int r = 0; r < 16; ++r) { const int n = (r & 3) + 8 * (r >> 2) + 4 * hi; *(LAS bf16*)(hidL + n * HID_PITCH + (32 * wid + r32) * 2) = (bf16)f2bf(gelu_tanh(acc[r] + cb)); }
    asm volatile("s_waitcnt lgkmcnt(0)\n\ts_barrier" ::: "memory");
    if (wid == 0) {
        f32x16 o0 = {}, o1 = {};
#pragma unroll 4
        for (int kk = 0; kk < 16; ++kk) { const bf16x8 hb = *(const LAS bf16x8*)(hidL + r32 * HID_PITCH + (16 * kk + 8 * hi) * 2);
            const bf16x8 a0 = *(const bf16x8*)(w2 + (size_t)r32 * 256 + 16 * kk + 8 * hi), a1 = *(const bf16x8*)(w2 + (size_t)(32 + r32) * 256 + 16 * kk + 8 * hi);
            o0 = __builtin_amdgcn_mfma_f32_32x32x16_bf16(a0, hb, o0, 0, 0, 0); o1 = __builtin_amdgcn_mfma_f32_32x32x16_bf16(a1, hb, o1, 0, 0, 0); }
        float rs = 1.f;
        if (!kv) { float ss = 0.f;
#pragma unroll
            for (int r = 0; r < 16; ++r) ss += o0[r] * o0[r] + o1[r] * o1[r];
            auto rr = __builtin_amdgcn_permlane32_swap(__float_as_uint(ss), __float_as_uint(ss), false, false); ss = __uint_as_float(rr[0]) + __uint_as_float(rr[1]);
            rs = rsqrtf(ss * (1.f / 64.f) + 1e-6f); }
        const int n = n0 + r32; bf16* dst = (kv ? vcmp : kcmp) + ((size_t)bg * 512 + n) * 64;
#pragma unroll
        for (int r = 0; r < 16; ++r) { const int d = (r & 3) + 8 * (r >> 2) + 4 * hi;
            float v0 = o0[r] * rs, v1 = o1[r] * rs; if (!kv) { v0 *= kncmp[d]; v1 *= kncmp[d + 32]; }
            if (n >= NCMP) { v0 = 0.f; v1 = 0.f; }
            dst[d] = (bf16)f2bf(v0); dst[d + 32] = (bf16)f2bf(v1); }
    }
    asm volatile("s_waitcnt lgkmcnt(0)\n\ts_barrier" ::: "memory");
}
}
__global__ void __launch_bounds__(NTHREADS, 2) mk_fwd(Args a) {
    extern __shared__ __attribute__((aligned(16))) unsigned char lds[];
    Frame F;
    F.lds = (LAS unsigned char*)lds;
    F.tid = threadIdx.x; F.lane = F.tid & 63; F.wave = __builtin_amdgcn_readfirstlane(F.tid >> 6);
    F.G = gridDim.x; { const int bx = blockIdx.x; F.vcu = (F.G % 8 == 0) ? (bx % 8) * (F.G / 8) + bx / 8 : bx; }
    cg::grid_group grid = cg::this_grid();
    unsigned char* ws = a.ws;
    const int lo = a.ph_lo, hi = a.ph_hi;
#define IN(k) (lo <= (k) && (k) < hi)
#define SEAM(k) do { if (IN(k) && IN((k) + 1)) grid.sync(); } while (0)
    if (IN(0)) { phase_prologue_a(F, a); } SEAM(0);
    if (IN(1)) { phase_prologue_b(F, a); } SEAM(1);
    if (IN(2)) {
        pg8::Gemm g{(const pg8::bf16_t*)(ws + WS_H), (const pg8::bf16_t*)(ws + WS_WIN), TOK, NIN_PAD, DM}; pg8::StaticOrder S; S.init(TOK, NIN_PAD, F.G, (int)blockIdx.x);
        pg8::EpiInProj E{(pg8::bf16_t*)(ws + WS_QKV), (float*)(ws + WS_GATES), (float*)(ws + WS_KMP), a.in[7], a.in[8], a.in[9], a.in[11], a.in[12]};
        pg8::gemm_phase<pg8::EpiInProj, pg8::StaticOrder, true, true>(F.lds, g, S, E);
    } SEAM(2);
    if (IN(3)) {
        for (int unit = F.vcu; unit < 256; unit += F.G)
            cmpr::compress_unit(F.lds, unit, (const bf16*)(ws + WS_QKV), (const bf16*)(ws + WS_W1K), (const bf16*)(ws + WS_W1V), (const bf16*)(ws + WS_W2K), (const bf16*)(ws + WS_W2V),
                                (const float*)(ws + WS_CBP), a.in[10], (bf16*)(ws + WS_KCMP), (bf16*)(ws + WS_VCMP));
    } SEAM(3);
    if (IN(4)) {
        att::AttnPtrs P{(const bf16*)(ws + WS_QKV), (const float*)(ws + WS_KMP), (const float*)(ws + WS_GATES), (const bf16*)(ws + WS_KCMP), (const bf16*)(ws + WS_VCMP), a.in[2], (bf16*)(ws + WS_MIX)};
        att::attn_phase(F.lds, P, (unsigned*)(ws + WS_CTL) + 64, a.in[7], a.in[8], a.in[9], a.in[10], a.in[11], a.in[12]);
    } SEAM(4);
    if (IN(5)) {
        pg8::Gemm g{(const pg8::bf16_t*)(ws + WS_MIX), (const pg8::bf16_t*)(ws + WS_WOUT), TOK, DM, DM}; pg8::StaticOrder S; S.init(TOK, DM, F.G, (int)blockIdx.x);
        pg8::EpiOutProj E{a.in[0], a.out, (const float*)(ws + WS_MOD) + 2 * DM};
        pg8::gemm_phase<pg8::EpiOutProj, pg8::StaticOrder, true, true>(F.lds, g, S, E);
    } SEAM(5);
    if (IN(6)) { phase_norm2(F, a); } SEAM(6);
    if (IN(7)) {
        pg8::Gemm g{(const pg8::bf16_t*)(ws + WS_H), (const pg8::bf16_t*)(ws + WS_WGU), TOK, 2 * FF, DM}; pg8::StaticOrder S; S.init(TOK, 2 * FF, F.G, (int)blockIdx.x);
        pg8::EpiGateUp E{(pg8::bf16_t*)(ws + WS_ACT)};
        pg8::gemm_phase<pg8::EpiGateUp, pg8::StaticOrder, true, true>(F.lds, g, S, E);
    } SEAM(7);
    if (IN(8)) {
        pg8::Gemm g{(const pg8::bf16_t*)(ws + WS_ACT), (const pg8::bf16_t*)(ws + WS_WDN), TOK, DM, FF}; pg8::StaticOrder S; S.init(TOK, DM, F.G, (int)blockIdx.x);
        pg8::EpiDown E{a.out, (const float*)(ws + WS_MOD) + 5 * DM};
        pg8::gemm_phase<pg8::EpiDown, pg8::StaticOrder, true, true>(F.lds, g, S, E);
    }
#undef IN
#undef SEAM
}

static void launch_phases(const Args& base, int lo, int hi, int grid, hipStream_t stream) {
    Args a = base; a.ph_lo = lo; a.ph_hi = hi;
    if (hi - lo > 1) { void* args[] = {&a}; (void)hipLaunchCooperativeKernel((const void*)mk_fwd, dim3(grid), dim3(NTHREADS), args, LDS_BYTES, stream); }
    else hipLaunchKernelGGL(mk_fwd, dim3(grid), dim3(NTHREADS), LDS_BYTES, stream, a);
}
extern "C" void kernel_launch(void* const* d_in, const int* in_sizes, int n_in, void* d_out, int out_size, void* d_ws, size_t ws_size, hipStream_t stream) {
    static int grid = 0;
    if (grid == 0) {
        int dev = 0, cus = 0, per_cu = 0;
        if (n_in != 23 || ws_size < 420 * MiB || hipGetDevice(&dev) != hipSuccess || hipDeviceGetAttribute(&cus, hipDeviceAttributeMultiprocessorCount, dev) != hipSuccess) { grid = -1; return; }
        if (hipFuncSetAttribute((const void*)mk_fwd, hipFuncAttributeMaxDynamicSharedMemorySize, LDS_BYTES) != hipSuccess) { grid = -1; return; }
        if (hipOccupancyMaxActiveBlocksPerMultiprocessor(&per_cu, (const void*)mk_fwd, NTHREADS, LDS_BYTES) != hipSuccess || per_cu < 1) { grid = -1; return; }
        grid = cus;
    }
    if (grid < 0) return;
    (void)hipMemsetAsync((char*)d_ws + WS_CTL, 0, CTL_ZERO_BYTES, stream);
    Args a{};
    for (int i = 0; i < 23; ++i) a.in[i] = (const float*)d_in[i];
    a.out = (float*)d_out; a.ws = (unsigned char*)d_ws;
    unsigned char* ws = (unsigned char*)d_ws;
#if HYBRID == 1
    launch_phases(a, 0, 1, grid, stream); launch_phases(a, 1, 2, grid, stream); launch_phases(a, 2, 3, grid, stream);
    const bf16* qkv = (const bf16*)(ws + WS_QKV); bf16* mix = (bf16*)(ws + WS_MIX); bf16* kcmp = (bf16*)(ws + WS_KCMP); bf16* vcmp = (bf16*)(ws + WS_VCMP);
    int* sel = (int*)(ws + 344 * MiB); float* obuf = (float*)(ws + 348 * MiB); const float* gates = (const float*)(ws + WS_GATES);
    nq::k_compress<<<dim3(4 * 2 * 512, 2), 256, 0, stream>>>(qkv, a.in[13], a.in[14], a.in[15], a.in[16], a.in[17], a.in[18], a.in[10], kcmp, vcmp);
    nq::k_moba<<<4 * 8 * SEQ / 4, 256, 0, stream>>>(qkv, (const float*)(ws + WS_KMP), a.in[2], mix);
    nq::k_nsa_cmp<<<4 * 2 * SEQ, 256, 0, stream>>>(qkv, kcmp, vcmp, gates, obuf, sel);
    nq::k_nsa_sel<<<4 * 2 * SEQ, 256, 0, stream>>>(qkv, sel, a.in[2], gates, obuf);
    nq::k_nsa_win<<<4 * 2 * SEQ, 256, 0, stream>>>(qkv, a.in[2], gates, obuf, mix);
    launch_phases(a, 5, 6, grid, stream); launch_phases(a, 6, 7, grid, stream); launch_phases(a, 7, 8, grid, stream); launch_phases(a, 8, 9, grid, stream);
#elif HYBRID == 2
    launch_phases(a, 0, 1, grid, stream); launch_phases(a, 1, 2, grid, stream); launch_phases(a, 2, 3, grid, stream);
    nq::k_compress<<<dim3(4 * 2 * 512, 2), 256, 0, stream>>>((const bf16*)(ws + WS_QKV), a.in[13], a.in[14], a.in[15], a.in[16], a.in[17], a.in[18], a.in[10], (bf16*)(ws + WS_KCMP), (bf16*)(ws + WS_VCMP));
    launch_phases(a, 4, 5, grid, stream);
    launch_phases(a, 5, 6, grid, stream); launch_phases(a, 6, 7, grid, stream); launch_phases(a, 7, 8, grid, stream); launch_phases(a, 8, 9, grid, stream);
#elif HYBRID == 3
    for (int p = 0; p < N_PHASES; ++p) launch_phases(a, p, p + 1, grid, stream);
#else
    launch_phases(a, 0, N_PHASES, grid, stream);
#endif
}
```

```cpp
#include <hip/hip_runtime.h>
#include <hip/hip_cooperative_groups.h>
#include <cstdint>
#include <cstdio>
namespace cg = cooperative_groups;
#define HYBRID 0
namespace pg8 {
#define PG8_LAS __attribute__((address_space(3)))
typedef unsigned short bf16_t;
typedef short bf16x8 __attribute__((ext_vector_type(8)));
typedef float f32x4 __attribute__((ext_vector_type(4)));
typedef unsigned u32x4 __attribute__((ext_vector_type(4)));
constexpr int BM = 256, BK = 64, HALF = 128, HTB = HALF * BK * 2  , STAGE_BYTES = 8 * HTB, NXCD = 8, WGM = 8;

__host__ __device__ __forceinline__ int lds_byte(int r, int c) { const int st = (r >> 4) * 2 + (c >> 5), rr = r & 15, cc = c & 31, ob = rr * 64 + cc * 2; return st * 1024 + (ob ^ (((ob >> 9) & 1) << 5)); }
__host__ __device__ __forceinline__ void stage_rc(int b, int& R, int& C) { const int st = b / 1024, sb = b % 1024, swz = sb ^ (((sb >> 9) & 1) << 5); R = (st >> 1) * 16 + swz / 64; C = (st & 1) * 32 + (swz % 64) / 2; }
__host__ __device__ __forceinline__ int perm32(int rho) { const int n = rho >> 4, i = rho & 15; return 8 * (i >> 2) + 4 * n + (i & 3); }

struct Unit { int pm, pn; };
struct Gemm { const bf16_t* A; const bf16_t* Bt; int M, N, K; };

struct StaticOrder {
    int nM, nN, nwg, G, c;
    __host__ __device__ void init(int M, int N, int G_, int c_) { nM = M / BM; nN = N / BM; nwg = nM * nN; G = G_; c = c_; }
    __host__ __device__ bool next(int i, Unit& u) const {
        const long L = (long)i * G + c; if (L >= nwg) return false;
        int wgid = (int)L; { const int q = nwg / NXCD, r = nwg % NXCD, xcd = wgid % NXCD, off = wgid / NXCD; wgid = (xcd < r ? xcd * (q + 1) : r * (q + 1) + (xcd - r) * q) + off; }
        const int nig = WGM * nN, gid = wgid / nig, fm = gid * WGM, gsz = (nM - fm) < WGM ? (nM - fm) : WGM;
        u.pm = fm + ((wgid % nig) % gsz); u.pn = (wgid % nig) / gsz; return true;
    }
    __device__ __forceinline__ void a_ready(const Unit&) const {}
    __device__ __forceinline__ void done(const Unit&) const {}
};

__device__ __forceinline__ unsigned cvt_pk_bf16(float lo, float hi) { unsigned r; asm volatile("v_cvt_pk_bf16_f32 %0, %1, %2" : "=v"(r) : "v"(lo), "v"(hi)); return r; }
typedef float f32x2 __attribute__((ext_vector_type(2)));
template <class Epi, class Sched, bool ALIGN_EPI = false, bool SP2 = false>
__device__ __forceinline__ void gemm_phase(PG8_LAS unsigned char* lds, const Gemm g, const Sched& S, const Epi& E) {
    const int tid = threadIdx.x, wid = __builtin_amdgcn_readfirstlane(tid >> 6), lane = tid & 63, wr = wid >> 2, wc = wid & 3, fr = lane & 15, fq = lane >> 4;
    const int K = g.K, nt = K / BK;
    unsigned voffA[2], voffB[2];
#pragma unroll
    for (int i = 0; i < 2; ++i) { int R, C; stage_rc(tid * 16 + i * 8192, R, C); const int Rb = Epi::PERM ? ((R & ~31) + perm32(R & 31)) : R;
        voffA[i] = (unsigned)(R * K + C) * 2u; voffB[i] = (unsigned)(Rb * K + C) * 2u; }
    const size_t kstep = (size_t)(BK * 2);
    const size_t hstep = (size_t)HALF * K * 2;
    const size_t tstep = 2 * hstep;
    const unsigned ldsw = (unsigned)wid * 1024u;
    const int aoff = lds_byte(wr * 64 + fr, fq * 8), boff = lds_byte(wc * 32 + fr, fq * 8);
#define PG8_SA(b, h) (((b) * 2 + (h)) * HTB)
#define PG8_SB(b, h) ((4 + (b) * 2 + (h)) * HTB)
#define PG8_STAGE(bufoff, gbase, voff) do { _Pragma("unroll") for (int _i = 0; _i < 2; ++_i) \
        __builtin_amdgcn_global_load_lds((const unsigned*)((const char*)(gbase) + (voff)[_i]), (PG8_LAS unsigned*)(lds + (bufoff) + ldsw + _i * 8192), 16, 0, 0); } while (0)
#define PG8_LDA(dst, b, h) do { _Pragma("unroll") for (int m = 0; m < 4; ++m) _Pragma("unroll") for (int k = 0; k < 2; ++k) dst[m][k] = *(const PG8_LAS bf16x8*)(lds + PG8_SA(b, h) + aoff + m * 2048 + k * 1024); } while (0)
#define PG8_LDB(dst, b, h) do { _Pragma("unroll") for (int n = 0; n < 2; ++n) _Pragma("unroll") for (int k = 0; k < 2; ++k) dst[n][k] = *(const PG8_LAS bf16x8*)(lds + PG8_SB(b, h) + boff + n * 2048 + k * 1024); } while (0)
#define PG8_MMA(ai, bj, At, Bt) do { __builtin_amdgcn_s_setprio(1); _Pragma("unroll") for (int m = 0; m < 4; ++m) _Pragma("unroll") for (int n = 0; n < 2; ++n) _Pragma("unroll") for (int k = 0; k < 2; ++k) \
        acc[ai][bj][m][n] = __builtin_amdgcn_mfma_f32_16x16x32_bf16(Bt[n][k], At[m][k], acc[ai][bj][m][n], 0, 0, 0); __builtin_amdgcn_s_setprio(0); } while (0)
#define PG8_WAIT_V(n) asm volatile("s_waitcnt vmcnt(" #n ")" ::: "memory")
#define PG8_WAIT_L(n) asm volatile("s_waitcnt lgkmcnt(" #n ")" ::: "memory")
#define PG8_BAR __builtin_amdgcn_s_barrier()
#define PG8_SCHED __builtin_amdgcn_sched_barrier(0)
    Unit cur, nxt; int ui = 0;
    if (!S.next(0, cur)) return;
    f32x4 acc[2][2][4][2];
#pragma unroll
    for (int a = 0; a < 2; ++a)
#pragma unroll
        for (int b = 0; b < 2; ++b)
#pragma unroll
            for (int m = 0; m < 4; ++m)
#pragma unroll
                for (int n = 0; n < 2; ++n) acc[a][b][m][n] = (f32x4){0.f, 0.f, 0.f, 0.f};
    bf16x8 At[4][2], B0[2][2], B1[2][2];
    const char* cA = (const char*)g.A + (size_t)cur.pm * tstep; const char* cB = (const char*)g.Bt + (size_t)cur.pn * tstep;
    S.a_ready(cur);
    if constexpr (SP2) {
        PG8_STAGE(PG8_SB(0, 0), cB, voffB); PG8_STAGE(PG8_SB(0, 1), cB + hstep, voffB); PG8_STAGE(PG8_SA(0, 0), cA, voffA); PG8_STAGE(PG8_SA(0, 1), cA + hstep, voffA);
        if (wr == 1) PG8_BAR;
        PG8_WAIT_V(2); PG8_BAR;
        PG8_STAGE(PG8_SB(1, 0), cB + kstep, voffB); PG8_STAGE(PG8_SA(1, 0), cA + kstep, voffA); PG8_STAGE(PG8_SB(1, 1), cB + hstep + kstep, voffB);
        PG8_WAIT_V(6); PG8_BAR;
    } else {
        PG8_STAGE(PG8_SB(0, 0), cB, voffB); PG8_STAGE(PG8_SA(0, 0), cA, voffA); PG8_STAGE(PG8_SB(0, 1), cB + hstep, voffB); PG8_STAGE(PG8_SA(0, 1), cA + hstep, voffA);
        if (wr == 1) PG8_BAR;
        PG8_WAIT_V(4); PG8_BAR;
        PG8_STAGE(PG8_SB(1, 0), cB + kstep, voffB); PG8_STAGE(PG8_SA(1, 0), cA + kstep, voffA); PG8_STAGE(PG8_SB(1, 1), cB + hstep + kstep, voffB);
        PG8_WAIT_V(6); PG8_BAR;
    }
    for (;;) {
        const bool has_next = S.next(ui + 1, nxt);
        const char* nA = has_next ? (const char*)g.A + (size_t)nxt.pm * tstep : cA; const char* nB = has_next ? (const char*)g.Bt + (size_t)nxt.pn * tstep : cB;
        for (int t = 0; t < nt; t += 2) {
            const bool last = (t == nt - 2);
            const char* a1 = cA + (size_t)(t + 1) * kstep;
            const char* a2 = last ? nA : cA + (size_t)(t + 2) * kstep; const char* b2 = last ? nB : cB + (size_t)(t + 2) * kstep;
            const char* a3 = a2 + kstep; const char* b3 = b2 + kstep;
            if (last && has_next) S.a_ready(nxt);
            if constexpr (SP2) {
            PG8_LDB(B0, 0, 0); PG8_LDB(B1, 0, 1); PG8_SCHED; PG8_LDA(At, 0, 0); PG8_STAGE(PG8_SA(1, 1), a1 + hstep, voffA);
            PG8_WAIT_V(8); PG8_WAIT_L(0); PG8_BAR; PG8_MMA(0, 0, At, B0); PG8_MMA(0, 1, At, B1); PG8_BAR; PG8_SCHED;
            PG8_LDA(At, 0, 1); PG8_STAGE(PG8_SB(0, 0), b2, voffB); PG8_STAGE(PG8_SB(0, 1), b2 + hstep, voffB); PG8_STAGE(PG8_SA(0, 0), a2, voffA);
            PG8_WAIT_V(8); PG8_WAIT_L(0); PG8_BAR; PG8_MMA(1, 0, At, B0); PG8_MMA(1, 1, At, B1); PG8_BAR; PG8_SCHED;
            PG8_LDB(B0, 1, 0); PG8_LDB(B1, 1, 1); PG8_SCHED; PG8_LDA(At, 1, 0); PG8_STAGE(PG8_SA(0, 1), a2 + hstep, voffA);
            PG8_WAIT_V(8); PG8_WAIT_L(0); PG8_BAR; PG8_MMA(0, 0, At, B0); PG8_MMA(0, 1, At, B1); PG8_BAR; PG8_SCHED;
            PG8_LDA(At, 1, 1); PG8_STAGE(PG8_SB(1, 0), b3, voffB); PG8_STAGE(PG8_SB(1, 1), b3 + hstep, voffB); PG8_STAGE(PG8_SA(1, 0), a3, voffA);
            PG8_WAIT_V(8); PG8_WAIT_L(0); PG8_BAR; PG8_MMA(1, 0, At, B0); PG8_MMA(1, 1, At, B1); PG8_BAR; PG8_SCHED;
            } else {
            PG8_LDB(B0, 0, 0); PG8_SCHED; PG8_LDA(At, 0, 0); PG8_STAGE(PG8_SA(1, 1), a1 + hstep, voffA);
            PG8_WAIT_L(8); PG8_BAR; PG8_WAIT_L(0); PG8_MMA(0, 0, At, B0); PG8_BAR; PG8_SCHED;
            PG8_LDB(B1, 0, 1); PG8_STAGE(PG8_SB(0, 0), b2, voffB);
            PG8_BAR; PG8_WAIT_L(0); PG8_MMA(0, 1, At, B1); PG8_BAR;
            PG8_LDA(At, 0, 1); PG8_STAGE(PG8_SA(0, 0), a2, voffA);
            PG8_BAR; PG8_WAIT_L(0); PG8_MMA(1, 0, At, B0); PG8_BAR; PG8_SCHED;
            PG8_STAGE(PG8_SB(0, 1), b2 + hstep, voffB);
            PG8_WAIT_V(6); PG8_BAR; PG8_MMA(1, 1, At, B1); PG8_BAR;
            PG8_LDB(B0, 1, 0); PG8_SCHED; PG8_LDA(At, 1, 0); PG8_STAGE(PG8_SA(0, 1), a2 + hstep, voffA);
            PG8_WAIT_L(8); PG8_BAR; PG8_WAIT_L(0); PG8_MMA(0, 0, At, B0); PG8_BAR; PG8_SCHED;
            PG8_LDB(B1, 1, 1); PG8_STAGE(PG8_SB(1, 0), b3, voffB);
            PG8_BAR; PG8_WAIT_L(0); PG8_MMA(0, 1, At, B1); PG8_BAR;
            PG8_LDA(At, 1, 1); PG8_STAGE(PG8_SA(1, 0), a3, voffA);
            PG8_BAR; PG8_WAIT_L(0); PG8_MMA(1, 0, At, B0); PG8_BAR; PG8_SCHED;
            PG8_STAGE(PG8_SB(1, 1), b3 + hstep, voffB);
            PG8_WAIT_V(6); PG8_BAR; PG8_MMA(1, 1, At, B1); PG8_BAR;
            }
        }
        if constexpr (ALIGN_EPI) { if (wr == 0) PG8_BAR; }
        if constexpr (!Epi::AFTER_DRAIN) { E(acc, cur, wr, wc, fr, fq); S.done(cur); }
        if (!has_next) break;
#pragma unroll
        for (int a = 0; a < 2; ++a)
#pragma unroll
            for (int b = 0; b < 2; ++b)
#pragma unroll
                for (int m = 0; m < 4; ++m)
#pragma unroll
                    for (int n = 0; n < 2; ++n) acc[a][b][m][n] = (f32x4){0.f, 0.f, 0.f, 0.f};
        cur = nxt; cA = nA; cB = nB; ++ui;
        if constexpr (ALIGN_EPI) { if (wr == 1) PG8_BAR; }
    }
    PG8_WAIT_V(0);
    if constexpr (!ALIGN_EPI) { if (wr == 0) PG8_BAR; }
    PG8_BAR;
    if constexpr (Epi::AFTER_DRAIN) { E.fused(acc, cur, wr, wc, fr, fq, lds, wid, lane); S.done(cur); }
#undef PG8_SA
#undef PG8_SB
#undef PG8_STAGE
#undef PG8_LDA
#undef PG8_LDB
#undef PG8_MMA
#undef PG8_WAIT_V
#undef PG8_WAIT_L
#undef PG8_BAR
#undef PG8_SCHED
}
}
namespace pg8 {
typedef unsigned u32x2v __attribute__((ext_vector_type(2)));
constexpr int TOK_S = 8192;
constexpr float QK_EPS = 1e-6f;
constexpr float C2 = 0.125f * 1.4426950408889634f;
__device__ __forceinline__ float sigmoid_fast(float v) { return 1.f / (1.f + __expf(-v)); }
__device__ __forceinline__ float silu_fast(float v) { return v / (1.f + __expf(-v)); }

struct EpiInProj {
    static constexpr bool PERM = true, AFTER_DRAIN = false;
    bf16_t* qkv;
    float* gates;
    float* kmean_part;
    const float *qna, *kna, *qnb, *knsel, *knwin;
    __device__ __forceinline__ void operator()(const f32x4 (&acc)[2][2][4][2], const Unit& u, int wr, int wc, int fr, int fq) const {
        const int slot = u.pn * 4 + wc;
        if (slot > 44) return;
        const int b = u.pm >> 5, blk = u.pm & 31, pos0 = blk * 256 + wr * 64 + fr;
        if (slot == 44) {
            if (fq < 3) {
#pragma unroll
                for (int ai = 0; ai < 2; ++ai)
#pragma unroll
                    for (int m = 0; m < 4; ++m) { const size_t tok = (size_t)b * TOK_S + pos0 + ai * HALF + m * 16; float* gp = gates + tok * 24 + 8 * fq;
                        const f32x4 v0 = acc[ai][0][m][0], v1 = acc[ai][0][m][1];
                        *(f32x4*)gp = (f32x4){sigmoid_fast(v0[0]), sigmoid_fast(v0[1]), sigmoid_fast(v0[2]), sigmoid_fast(v0[3])};
                        *(f32x4*)(gp + 4) = (f32x4){sigmoid_fast(v1[0]), sigmoid_fast(v1[1]), sigmoid_fast(v1[2]), sigmoid_fast(v1[3])}; }
            }
            return;
        }
        const float* gain = nullptr; float qscale = 1.f; bool is_ka = false; bf16_t* dst;
        constexpr size_t BIG = (size_t)4 * 8 * TOK_S * 64, SMALL = (size_t)4 * 2 * TOK_S * 64;
        if (slot < 32) { const int kind = slot >> 3, head = slot & 7; dst = qkv + kind * BIG + ((size_t)(b * 8 + head) * TOK_S) * 64;
            if (kind == 0) { gain = qna; qscale = C2; } else if (kind == 1) { gain = kna; is_ka = true; } else if (kind == 3) { gain = qnb; qscale = C2; } }
        else { const int kind = (slot - 32) >> 1, g = slot & 1; dst = qkv + 4 * BIG + kind * SMALL + ((size_t)(b * 2 + g) * TOK_S) * 64;
            if (kind == 2) gain = knsel; else if (kind == 4) gain = knwin; }
        float gv[16];
#pragma unroll
        for (int i = 0; i < 16; ++i) gv[i] = gain ? gain[(i >> 3) * 32 + 8 * fq + (i & 7)] * qscale : 1.f;
        float cs[16];
#pragma unroll
        for (int i = 0; i < 16; ++i) cs[i] = 0.f;
#pragma unroll
        for (int ai = 0; ai < 2; ++ai)
#pragma unroll
            for (int m = 0; m < 4; ++m) {
                float v[16];
#pragma unroll
                for (int bj = 0; bj < 2; ++bj)
#pragma unroll
                    for (int n = 0; n < 2; ++n)
#pragma unroll
                        for (int j = 0; j < 4; ++j) v[bj * 8 + n * 4 + j] = acc[ai][bj][m][n][j];
                if (gain) { float ss = 0.f;
#pragma unroll
                    for (int i = 0; i < 16; ++i) ss += v[i] * v[i];
                    ss += __shfl_xor(ss, 16); ss += __shfl_xor(ss, 32);
                    const float rs = rsqrtf(ss * (1.f / 64.f) + QK_EPS);
#pragma unroll
                    for (int i = 0; i < 16; ++i) v[i] *= rs * gv[i]; }
                if (is_ka) {
#pragma unroll
                    for (int i = 0; i < 16; ++i) cs[i] += v[i]; }
                bf16_t* rp = dst + (size_t)(pos0 + ai * HALF + m * 16) * 64 + 8 * fq;
                u32x4 w0, w1;
                w0.x = cvt_pk_bf16(v[0], v[1]); w0.y = cvt_pk_bf16(v[2], v[3]); w0.z = cvt_pk_bf16(v[4], v[5]); w0.w = cvt_pk_bf16(v[6], v[7]);
                w1.x = cvt_pk_bf16(v[8], v[9]); w1.y = cvt_pk_bf16(v[10], v[11]); w1.z = cvt_pk_bf16(v[12], v[13]); w1.w = cvt_pk_bf16(v[14], v[15]);
                *(u32x4*)rp = w0; *(u32x4*)(rp + 32) = w1;
            }
        if (is_ka) {
#pragma unroll
            for (int i = 0; i < 16; ++i) { float s = cs[i]; s += __shfl_xor(s, 1); s += __shfl_xor(s, 2); s += __shfl_xor(s, 4); s += __shfl_xor(s, 8); cs[i] = s; }
            if (fr == 0) { float* kp = kmean_part + ((size_t)((b * 8 + (slot & 7)) * 32 + blk) * 2 + wr) * 64 + 8 * fq;
                *(f32x4*)kp = (f32x4){cs[0], cs[1], cs[2], cs[3]}; *(f32x4*)(kp + 4) = (f32x4){cs[4], cs[5], cs[6], cs[7]};
                *(f32x4*)(kp + 32) = (f32x4){cs[8], cs[9], cs[10], cs[11]}; *(f32x4*)(kp + 36) = (f32x4){cs[12], cs[13], cs[14], cs[15]}; }
        }
    }
};
struct EpiOutProj {
    static constexpr bool PERM = false, AFTER_DRAIN = false;
    const float* x; float* out; const float* gt;
    __device__ __forceinline__ void operator()(const f32x4 (&acc)[2][2][4][2], const Unit& u, int wr, int wc, int fr, int fq) const {
        const int b = u.pm >> 5; const int col0 = u.pn * BM + wc * 32 + 4 * fq; const float* gtb = gt + (size_t)b * 6144;
#pragma unroll
        for (int bj = 0; bj < 2; ++bj)
#pragma unroll
            for (int n = 0; n < 2; ++n) { const int c = col0 + bj * HALF + n * 16; const f32x4 g4 = *(const f32x4*)(gtb + c);
#pragma unroll
                for (int ai = 0; ai < 2; ++ai)
#pragma unroll
                    for (int m = 0; m < 4; ++m) { const size_t off = (size_t)(u.pm * BM + ai * HALF + wr * 64 + m * 16 + fr) * 1024 + c;
                        const f32x4 xv = *(const f32x4*)(x + off); *(f32x4*)(out + off) = xv + g4 * acc[ai][bj][m][n]; } }
    }
};
struct EpiGateUp {
    static constexpr bool PERM = true, AFTER_DRAIN = false;
    bf16_t* act;
    __device__ __forceinline__ void operator()(const f32x4 (&acc)[2][2][4][2], const Unit& u, int wr, int wc, int fr, int fq) const {
        const int h0 = u.pn * 128 + wc * 32 + 8 * fq;
#pragma unroll
        for (int ai = 0; ai < 2; ++ai)
#pragma unroll
            for (int m = 0; m < 4; ++m) { const size_t row = (size_t)(u.pm * BM + ai * HALF + wr * 64 + m * 16 + fr);
                const f32x4 g0 = acc[ai][0][m][0], g1 = acc[ai][0][m][1], u0 = acc[ai][1][m][0], u1 = acc[ai][1][m][1];
                u32x4 w;
                w.x = cvt_pk_bf16(silu_fast(g0[0]) * u0[0], silu_fast(g0[1]) * u0[1]); w.y = cvt_pk_bf16(silu_fast(g0[2]) * u0[2], silu_fast(g0[3]) * u0[3]);
                w.z = cvt_pk_bf16(silu_fast(g1[0]) * u1[0], silu_fast(g1[1]) * u1[1]); w.w = cvt_pk_bf16(silu_fast(g1[2]) * u1[2], silu_fast(g1[3]) * u1[3]);
                *(u32x4*)(act + row * 2816 + h0) = w; }
    }
};
struct EpiDown {
    static constexpr bool PERM = false, AFTER_DRAIN = false;
    float* out; const float* gt;
    __device__ __forceinline__ void operator()(const f32x4 (&acc)[2][2][4][2], const Unit& u, int wr, int wc, int fr, int fq) const {
        const int b = u.pm >> 5; const int col0 = u.pn * BM + wc * 32 + 4 * fq; const float* gtb = gt + (size_t)b * 6144;
#pragma unroll
        for (int bj = 0; bj < 2; ++bj)
#pragma unroll
            for (int n = 0; n < 2; ++n) { const int c = col0 + bj * HALF + n * 16; const f32x4 g4 = *(const f32x4*)(gtb + c);
#pragma unroll
                for (int ai = 0; ai < 2; ++ai)
#pragma unroll
                    for (int m = 0; m < 4; ++m) { const size_t off = (size_t)(u.pm * BM + ai * HALF + wr * 64 + m * 16 + fr) * 1024 + c;
                        const f32x4 xv = *(const f32x4*)(out + off); *(f32x4*)(out + off) = xv + g4 * acc[ai][bj][m][n]; } }
    }
};
}
constexpr int NWAVES = 8, NTHREADS = 512;
constexpr int BATCH = 4, SEQ = 8192, DM = 1024, TOK = BATCH * SEQ, NIN = 2840, NIN_PAD = 3072, FF = 2816, NCMP = 511;
constexpr size_t MiB = 1u << 20;
constexpr size_t WS_CTL = 0, CTL_ZERO_BYTES = 64 * 1024;
constexpr size_t WS_MODP = 1 * MiB;
constexpr size_t WS_MOD = 2 * MiB;
constexpr size_t WS_CBP = 2 * MiB + 512 * 1024;
constexpr size_t WS_KMP = 3 * MiB;
constexpr size_t WS_WIN = 6 * MiB, WS_WOUT = 12 * MiB, WS_WGU = 14 * MiB, WS_WDN = 25 * MiB;
constexpr size_t WS_W1K = 31 * MiB, WS_W1V = 32 * MiB, WS_W2K = 33 * MiB, WS_W2V = 33 * MiB + 64 * 1024;
constexpr size_t WS_KCMP = 34 * MiB, WS_VCMP = 35 * MiB;
constexpr size_t WS_GATES = 36 * MiB;
constexpr size_t WS_H = 40 * MiB;
constexpr size_t WS_MIX = 104 * MiB;
constexpr size_t WS_QKV = 168 * MiB;
constexpr size_t WS_ACT = WS_QKV;
constexpr size_t WS_END = 344 * MiB;
constexpr size_t WS_PARTO = 344 * MiB;
constexpr size_t WS_PARTL = 444 * MiB;
constexpr size_t WS_SELG = 448 * MiB;
constexpr size_t QKV_BIG = (size_t)4 * 8 * SEQ * 64, QKV_SMALL = (size_t)4 * 2 * SEQ * 64;
constexpr int RING_BYTES = 131072, LDS_BYTES = 147456;
constexpr int N_PHASES = 10;

#define GAS __attribute__((address_space(1)))
#define LAS __attribute__((address_space(3)))
typedef unsigned short bf16;
typedef unsigned v4u __attribute__((ext_vector_type(4)));
typedef float f32x4 __attribute__((ext_vector_type(4)));
#define LDS_WAIT() asm volatile("s_waitcnt lgkmcnt(0)" ::: "memory")
#define VM_WAIT() asm volatile("s_waitcnt vmcnt(0)" ::: "memory")
__device__ __forceinline__ unsigned f2bf(float f) { unsigned u = __builtin_bit_cast(unsigned, f); return (u + 0x7fffu + ((u >> 16) & 1u)) >> 16; }
__device__ __forceinline__ unsigned pk2(float lo, float hi) { return f2bf(lo) | (f2bf(hi) << 16); }
__device__ __forceinline__ float bf2f(bf16 v) { return __builtin_bit_cast(float, (unsigned)v << 16); }
__device__ __forceinline__ float wave_sum(float v) {
#pragma unroll
    for (int o = 1; o < 64; o <<= 1) v += __shfl_xor(v, o);
    return v;
}
struct Args { const float* in[23]; float* out; unsigned char* ws; int ph_lo, ph_hi; };
struct Frame { LAS unsigned char* lds; int tid, lane, wave, vcu, G; };

struct MapId { __device__ __forceinline__ int operator()(int n) const { return n; } };
struct MapWin { __device__ __forceinline__ int operator()(int n) const { const int s = n >> 6, d = n & 63; return 256 * (s >> 2) + 128 * (d >> 5) + 32 * (s & 3) + (d & 31); } };
struct MapWgu { __device__ __forceinline__ int operator()(int n) const { const int up = n >= FF, hdn = up ? n - FF : n; return 256 * (hdn >> 7) + 128 * up + (hdn & 127); } };
template <class Map>
__device__ __forceinline__ void transpose_item(const float* __restrict__ W, int K, int N, bf16* WT, LAS float* scr, int item, int lane, const Map& map) {
    const int nblk = (N + 31) / 32, kb = item / nblk, nb = item % nblk, k0 = 64 * kb, n0 = 32 * nb;
    const bool nin = n0 + (lane & 31) < N;
#pragma unroll 8
    for (int i = 0; i < 32; ++i) { const int kk = 2 * i + (lane >> 5); scr[kk * 33 + (lane & 31)] = nin ? W[(size_t)(k0 + kk) * N + n0 + (lane & 31)] : 0.f; }
    LDS_WAIT(); asm volatile("" ::: "memory");
    const int c = lane & 7;
#pragma unroll
    for (int j = 0; j < 4; ++j) { const int n = (lane >> 3) + 8 * j; const LAS float* s = scr + (8 * c) * 33 + n;
        v4u o; o.x = pk2(s[0 * 33], s[1 * 33]); o.y = pk2(s[2 * 33], s[3 * 33]); o.z = pk2(s[4 * 33], s[5 * 33]); o.w = pk2(s[6 * 33], s[7 * 33]);
        if (n0 + n < N) *(GAS v4u*)(WT + (size_t)map(n0 + n) * K + k0 + 8 * c) = o; }
    LDS_WAIT(); asm volatile("" ::: "memory");
}
__device__ __forceinline__ float silu_acc(float v) { return v / (1.f + expf(-v)); }
__device__ __forceinline__ void phase_prologue_a(Frame& F, const Args& a) {
    LAS float* scr = (LAS float*)(F.lds + F.wave * 16384);
    const int gw = F.vcu * NWAVES + F.wave, NGW = F.G * NWAVES;
    unsigned char* ws = a.ws;
    constexpr int I_IN = (DM / 64) * ((NIN + 31) / 32), I_OUT = (DM / 64) * (DM / 32), I_GU = (DM / 64) * (2 * FF / 32), I_DN = (FF / 64) * (DM / 32), I_W1 = (2048 / 64) * (256 / 32), I_W2 = (256 / 64) * (64 / 32);
    constexpr int NITEMS = I_IN + I_OUT + I_GU + I_DN + 2 * I_W1 + 2 * I_W2;
    for (int it = gw; it < NITEMS; it += NGW) {
        int r = it;
        if (r < I_IN) { transpose_item(a.in[6], DM, NIN, (bf16*)(ws + WS_WIN), scr, r, F.lane, MapWin()); continue; } r -= I_IN;
        if (r < I_OUT) { transpose_item(a.in[19], DM, DM, (bf16*)(ws + WS_WOUT), scr, r, F.lane, MapId()); continue; } r -= I_OUT;
        if (r < I_GU) { transpose_item(a.in[21], DM, 2 * FF, (bf16*)(ws + WS_WGU), scr, r, F.lane, MapWgu()); continue; } r -= I_GU;
        if (r < I_DN) { transpose_item(a.in[22], FF, DM, (bf16*)(ws + WS_WDN), scr, r, F.lane, MapId()); continue; } r -= I_DN;
        if (r < I_W1) { transpose_item(a.in[14], 2048, 256, (bf16*)(ws + WS_W1K), scr, r, F.lane, MapId()); continue; } r -= I_W1;
        if (r < I_W1) { transpose_item(a.in[17], 2048, 256, (bf16*)(ws + WS_W1V), scr, r, F.lane, MapId()); continue; } r -= I_W1;
        if (r < I_W2) { transpose_item(a.in[15], 256, 64, (bf16*)(ws + WS_W2K), scr, r, F.lane, MapId()); continue; } r -= I_W2;
        transpose_item(a.in[18], 256, 64, (bf16*)(ws + WS_W2V), scr, r, F.lane, MapId());
    }
    const float* c = a.in[1]; const float* w_ada = a.in[3]; float* modp = (float*)(ws + WS_MODP);
    for (int t = NGW - 1 - gw; t < 96 * 8; t += NGW) { const int cg_ = t % 96, ks = t / 96; const int n = cg_ * 64 + F.lane;
        float acc0 = 0.f, acc1 = 0.f, acc2 = 0.f, acc3 = 0.f;
#pragma unroll 8
        for (int k = ks * 128; k < ks * 128 + 128; ++k) { const float w = w_ada[(size_t)k * 6144 + n];
            acc0 += silu_acc(c[k]) * w; acc1 += silu_acc(c[DM + k]) * w; acc2 += silu_acc(c[2 * DM + k]) * w; acc3 += silu_acc(c[3 * DM + k]) * w; }
        float* o = modp + (size_t)ks * 4 * 6144 + n; o[0] = acc0; o[6144] = acc1; o[2 * 6144] = acc2; o[3 * 6144] = acc3; }
    float* cbp = (float*)(ws + WS_CBP);
    for (int t = NGW / 2 - 1 - gw; t >= 0 && t < 256; t += NGW) { const int kv = t & 1, cg_ = (t >> 1) & 3, ic = t >> 3; const int n = cg_ * 64 + F.lane;
        const float* pe = kv ? a.in[16] : a.in[13]; const float* w1 = kv ? a.in[17] : a.in[14]; float acc = 0.f;
#pragma unroll 8
        for (int i = ic * 64; i < ic * 64 + 64; ++i) acc += pe[i] * w1[(size_t)i * 256 + n];
        cbp[(ic * 2 + kv) * 256 + n] = acc; }
}
__device__ __forceinline__ void norm_rows(Frame& F, const float* in, const f32x4 (&gs)[4], const f32x4 (&sh)[4], bf16* out) {
    for (int i = 0; i < 16; ++i) { const int row = F.vcu * 128 + F.wave * 16 + i;
        const GAS f32x4* xr = (const GAS f32x4*)(in + (size_t)row * DM) + F.lane;
        f32x4 v[4]; float ss = 0.f;
#pragma unroll
        for (int j = 0; j < 4; ++j) { v[j] = xr[64 * j]; ss += (v[j].x * v[j].x + v[j].y * v[j].y) + (v[j].z * v[j].z + v[j].w * v[j].w); }
        const float rs = rsqrtf(wave_sum(ss) * (1.f / DM) + 1e-6f);
        GAS unsigned long long* o8 = (GAS unsigned long long*)(out + (size_t)row * DM) + F.lane;
#pragma unroll
        for (int j = 0; j < 4; ++j) { const f32x4 y = v[j] * rs * gs[j] + sh[j]; o8[64 * j] = (unsigned long long)pk2(y.x, y.y) | ((unsigned long long)pk2(y.z, y.w) << 32); } }
}
__device__ __forceinline__ void phase_prologue_b(Frame& F, const Args& a) {
    unsigned char* ws = a.ws; const float* modp = (const float*)(ws + WS_MODP); const float* b_ada = a.in[4];
    if (F.wave == 0 && F.vcu < 96) { const int n = F.vcu * 64 + F.lane; float* mod = (float*)(ws + WS_MOD);
        for (int b = 0; b < 4; ++b) { float s = 0.f;
#pragma unroll
            for (int ks = 0; ks < 8; ++ks) s += modp[((size_t)ks * 4 + b) * 6144 + n];
            mod[b * 6144 + n] = s + b_ada[n]; } }
    const int b = F.vcu >> 6; const float* g = a.in[5];
    f32x4 gs[4], sh[4];
#pragma unroll
    for (int j = 0; j < 4; ++j) { const int c0 = 4 * F.lane + 256 * j; f32x4 s0 = {0.f, 0.f, 0.f, 0.f}, s1 = {0.f, 0.f, 0.f, 0.f};
#pragma unroll
        for (int ks = 0; ks < 8; ++ks) { s0 += *(const f32x4*)(modp + ((size_t)ks * 4 + b) * 6144 + c0); s1 += *(const f32x4*)(modp + ((size_t)ks * 4 + b) * 6144 + DM + c0); }
        s0 += *(const f32x4*)(b_ada + c0); s1 += *(const f32x4*)(b_ada + DM + c0);
        sh[j] = s0; gs[j] = *(const f32x4*)(g + c0) * (s1 + 1.0f); }
    norm_rows(F, a.in[0], gs, sh, (bf16*)(ws + WS_H));
}
__device__ __forceinline__ void phase_norm2(Frame& F, const Args& a) {
    unsigned char* ws = a.ws; const int b = F.vcu >> 6; const float* mod = (const float*)(ws + WS_MOD) + (size_t)b * 6144; const float* g = a.in[20];
    f32x4 gs[4], sh[4];
#pragma unroll
    for (int j = 0; j < 4; ++j) { const int c0 = 4 * F.lane + 256 * j; sh[j] = *(const f32x4*)(mod + 3 * DM + c0); gs[j] = *(const f32x4*)(g + c0) * (*(const f32x4*)(mod + 4 * DM + c0) + 1.0f); }
    norm_rows(F, a.out, gs, sh, (bf16*)(ws + WS_H));
}
#define ATT_NS att
#ifndef ATT_ABL
#define ATT_ABL 0
#endif
#ifndef ATT_STAGGER
#define ATT_STAGGER 0
#endif
namespace ATT_NS {
using bf16x8 = __attribute__((ext_vector_type(8))) short;
using s16x4 = __attribute__((ext_vector_type(4))) short;
using f32x16 = __attribute__((ext_vector_type(16))) float;
using u32x4 = __attribute__((ext_vector_type(4))) unsigned;
typedef LAS const char* lds_cptr;
typedef short v4i16_t __attribute__((ext_vector_type(4)));
constexpr int SLOT = 16384, NSLOT = 4, LDS_OST = 65536, LDS_LUT = 98304, LDS_IMP = 100352, LDS_SELM = 133120, LDS_MISC = 134144, LDS_WSF = 134400, LDS_ATT_END = 136448;
constexpr float LOG2E = 1.4426950408889634f;
#define MFMA32(a, b, c) __builtin_amdgcn_mfma_f32_32x32x16_bf16(a, b, c, 0, 0, 0)
#define ATT_WAIT_BAR(N) asm volatile("s_waitcnt vmcnt(" #N ") lgkmcnt(0)\n\ts_barrier" ::: "memory")
__device__ __forceinline__ void glds16(const void* gsrc, unsigned lds_dst) { unsigned keep;
    asm volatile("s_mov_b32 %0, m0\n\ts_mov_b32 m0, %2\n\ts_nop 0\n\tglobal_load_lds_dwordx4 %1, off\n\ts_mov_b32 m0, %0" : "=&s"(keep) : "v"(gsrc), "s"(lds_dst) : "memory"); }
typedef float f32x2_t __attribute__((ext_vector_type(2))); typedef __bf16 bf16x2_t __attribute__((ext_vector_type(2)));
__device__ __forceinline__ unsigned cvtpk(float lo, float hi) { f32x2_t v = {lo, hi}; bf16x2_t b = __builtin_convertvector(v, bf16x2_t); return __builtin_bit_cast(unsigned, b); }
__device__ __forceinline__ s16x4 vtr(lds_cptr p) { return __builtin_bit_cast(s16x4, __builtin_amdgcn_ds_read_tr16_b64_v4i16((LAS v4i16_t*)p)); }
__device__ __forceinline__ int t5_bucket(int d) {
    if (d < 16) return d;
    int b = 16;
    b += (d >= 19); b += (d >= 21); b += (d >= 24); b += (d >= 27); b += (d >= 31); b += (d >= 35); b += (d >= 40); b += (d >= 46);
    b += (d >= 52); b += (d >= 59); b += (d >= 67); b += (d >= 77); b += (d >= 87); b += (d >= 99); b += (d >= 113);
    return b;
}
struct Ctx { LAS char* lds; int wid; int lane, r32, hi; };
__device__ __forceinline__ int fresh_lane() { int l; asm volatile("v_mbcnt_lo_u32_b32 %0, -1, 0\n\tv_mbcnt_hi_u32_b32 %0, -1, %0" : "=v"(l)); return l; }
__device__ __forceinline__ Ctx make_ctx(LAS unsigned char* lds, int tid) {
    Ctx c; c.lds = (LAS char*)lds; c.wid = __builtin_amdgcn_readfirstlane(tid >> 6); c.lane = tid & 63; c.r32 = c.lane & 31; c.hi = c.lane >> 5; return c;
}
template <bool HASV, class QK, class SM>
__device__ __forceinline__ void run_stream(const Ctx& c, const bf16* Kb, const bf16* Vb, int t0, int t1, QK&& qk, SM&& sm) {
    const int n = t1 - t0; if (n <= 0) return;
    const int lane = fresh_lane(), r32 = lane & 31, hi = lane >> 5; const unsigned lds0 = (unsigned)(uintptr_t)c.lds;
    const bf16* ks = Kb + (lane * 64 + c.wid * 8); const bf16* vs = Vb + ((16 * (c.wid & 3) + (lane >> 2)) * 64 + (c.wid >> 2) * 32 + (lane & 3) * 8);
    const unsigned kdst = lds0 + c.wid * 1024, vdst = lds0 + 8192 + c.wid * 1024;
    const lds_cptr kp0 = (lds_cptr)c.lds + hi * 1024 + r32 * 16;
    const lds_cptr vp0 = (lds_cptr)c.lds + 8192 + ((lane >> 4) & 1) * 32 + (lane & 3) * 8 + (4 * hi + ((lane & 15) >> 2)) * 64;
#define ATT_ISSUE(t, so) do { if (ATT_ABL & 4) break; glds16(ks + (size_t)(t) * 4096, (unsigned)__builtin_amdgcn_readfirstlane(kdst + (so))); if (HASV) glds16(vs + (size_t)(t) * 4096, (unsigned)__builtin_amdgcn_readfirstlane(vdst + (so))); } while (0)
    ATT_ISSUE(t0, 0); if (n > 1) ATT_ISSUE(t0 + 1, SLOT);
    const bool late = ATT_STAGGER && __builtin_amdgcn_readfirstlane(c.wid) >= 4;
    f32x16 s0 = {}, s1 = {};
    int slot = 0, slotp = 3 * SLOT, slot2 = 2 * SLOT;
    if (!late) {
        for (int i = 0; i < n; ++i) {
            if (i + 1 < n) { if (HASV) ATT_WAIT_BAR(2); else ATT_WAIT_BAR(1); } else ATT_WAIT_BAR(0);
            if (i + 2 < n) ATT_ISSUE(t0 + i + 2, slot2);
            if (!(ATT_ABL & 1)) qk(t0 + i, kp0 + slot, s0, s1); if (!(ATT_ABL & 2)) sm(t0 + i, vp0 + slot, s0, s1);
            slot = (slot == 3 * SLOT) ? 0 : slot + SLOT; slot2 = (slot2 == 3 * SLOT) ? 0 : slot2 + SLOT;
        }
    } else {
        for (int i = 0; i < n; ++i) {
            if (i + 1 < n) { if (HASV) ATT_WAIT_BAR(2); else ATT_WAIT_BAR(1); } else ATT_WAIT_BAR(0);
            if (i + 2 < n) ATT_ISSUE(t0 + i + 2, slot2);
            if (i > 0 && !(ATT_ABL & 2)) sm(t0 + i - 1, vp0 + slotp, s0, s1);
            if (!(ATT_ABL & 1)) qk(t0 + i, kp0 + slot, s0, s1);
            slotp = slot; slot = (slot == 3 * SLOT) ? 0 : slot + SLOT; slot2 = (slot2 == 3 * SLOT) ? 0 : slot2 + SLOT;
        }
        if (!(ATT_ABL & 2)) sm(t0 + n - 1, vp0 + slotp, s0, s1);
    }
    asm volatile("s_waitcnt lgkmcnt(0)\n\ts_barrier" ::: "memory");
#undef ATT_ISSUE
}
__device__ __forceinline__ void qk_tile(f32x16& s0, f32x16& s1, lds_cptr kp, const bf16x8 (&qr)[4]) {
    bf16x8 kf[8];
#pragma unroll
    for (int d0 = 0; d0 < 4; ++d0) { kf[2 * d0] = *(const LAS bf16x8*)(kp + d0 * 2048); kf[2 * d0 + 1] = *(const LAS bf16x8*)(kp + d0 * 2048 + 512); }
    const f32x16 z = {};
    s0 = MFMA32(kf[0], qr[0], z); s1 = MFMA32(kf[1], qr[0], z);
#pragma unroll
    for (int d0 = 1; d0 < 4; ++d0) { s0 = MFMA32(kf[2 * d0], qr[d0], s0); s1 = MFMA32(kf[2 * d0 + 1], qr[d0], s1); }
}
template <bool MASK>
__device__ __forceinline__ void pv_tile(f32x16 (&o)[2], lds_cptr vp, const f32x16& p0, const f32x16& p1, unsigned mask) {
    if (ATT_ABL & 8) { o[0][0] += p0[0] + p1[5]; return; }
    u32x4 pw0 = {cvtpk(p0[0], p0[1]), cvtpk(p0[2], p0[3]), cvtpk(p0[4], p0[5]), cvtpk(p0[6], p0[7])}, pw1 = {cvtpk(p0[8], p0[9]), cvtpk(p0[10], p0[11]), cvtpk(p0[12], p0[13]), cvtpk(p0[14], p0[15])};
    u32x4 pw2 = {cvtpk(p1[0], p1[1]), cvtpk(p1[2], p1[3]), cvtpk(p1[4], p1[5]), cvtpk(p1[6], p1[7])}, pw3 = {cvtpk(p1[8], p1[9]), cvtpk(p1[10], p1[11]), cvtpk(p1[12], p1[13]), cvtpk(p1[14], p1[15])};
    if (MASK) { pw0 &= mask; pw1 &= mask; pw2 &= mask; pw3 &= mask; }
    if (ATT_ABL & 64) { o[0] = MFMA32(__builtin_bit_cast(bf16x8, pw0), __builtin_bit_cast(bf16x8, pw1), o[0]); o[1] = MFMA32(__builtin_bit_cast(bf16x8, pw2), __builtin_bit_cast(bf16x8, pw3), o[1]); return; }
    s16x4 vlo[8], vhi[8];
#pragma unroll
    for (int i = 0; i < 8; ++i) { vlo[i] = vtr(vp + ((i >> 2) * 4096 + (i & 3) * 1024)); vhi[i] = vtr(vp + ((i >> 2) * 4096 + (i & 3) * 1024 + 512)); }
#define ATT_VFR(i) (bf16x8){vlo[i][0], vlo[i][1], vlo[i][2], vlo[i][3], vhi[i][0], vhi[i][1], vhi[i][2], vhi[i][3]}
    o[0] = MFMA32(__builtin_bit_cast(bf16x8, pw0), ATT_VFR(0), o[0]); o[1] = MFMA32(__builtin_bit_cast(bf16x8, pw0), ATT_VFR(4), o[1]);
    o[0] = MFMA32(__builtin_bit_cast(bf16x8, pw1), ATT_VFR(1), o[0]); o[1] = MFMA32(__builtin_bit_cast(bf16x8, pw1), ATT_VFR(5), o[1]);
    o[0] = MFMA32(__builtin_bit_cast(bf16x8, pw2), ATT_VFR(2), o[0]); o[1] = MFMA32(__builtin_bit_cast(bf16x8, pw2), ATT_VFR(6), o[1]);
    o[0] = MFMA32(__builtin_bit_cast(bf16x8, pw3), ATT_VFR(3), o[0]); o[1] = MFMA32(__builtin_bit_cast(bf16x8, pw3), ATT_VFR(7), o[1]);
#undef ATT_VFR
}
__device__ __forceinline__ float rowsum32(const f32x16& p0, const f32x16& p1) { if (ATT_ABL & 32) return p0[0]; float a = p0[0] + p1[0], b = p0[1] + p1[1];
#pragma unroll
    for (int r = 2; r < 16; r += 2) { a += p0[r]; asm volatile("" : "+v"(a)); b += p0[r + 1]; asm volatile("" : "+v"(b)); a += p1[r]; asm volatile("" : "+v"(a)); b += p1[r + 1]; asm volatile("" : "+v"(b)); }
    return a + b; }
__device__ __forceinline__ void hook_exp(f32x16& s0, f32x16& s1) {
    if (ATT_ABL & 16) return;
#pragma unroll
    for (int r = 0; r < 16; ++r) { s0[r] = __builtin_amdgcn_exp2f(s0[r]); s1[r] = __builtin_amdgcn_exp2f(s1[r]); } }
__device__ __forceinline__ void hook_general(f32x16& s0, f32x16& s1, int base, int win, const LAS float* lut, bool pred) {
    const int inval = 114;
    asm volatile("" : "+v"(base));
#pragma unroll
    for (int r = 0; r < 16; ++r) { const int d0 = base - ((r & 3) + 8 * (r >> 2)), d1 = d0 - 32;
        const int i0 = (pred && (unsigned)d0 < (unsigned)win) ? min(d0, 113) : inval, i1 = (pred && (unsigned)d1 < (unsigned)win) ? min(d1, 113) : inval;
        s0[r] = __builtin_amdgcn_exp2f(s0[r] + lut[i0]); s1[r] = __builtin_amdgcn_exp2f(s1[r] + lut[i1]); } }
__device__ __forceinline__ void hook_cmp(f32x16& s0, f32x16& s1, int nrel  , float cb) {
    asm volatile("" : "+v"(nrel));
#pragma unroll
    for (int r = 0; r < 16; ++r) { const int c0 = (r & 3) + 8 * (r >> 2);
        s0[r] = __builtin_amdgcn_exp2f(s0[r] + ((c0 <= nrel) ? cb : -INFINITY)); s1[r] = __builtin_amdgcn_exp2f(s1[r] + ((c0 + 32 <= nrel) ? cb : -INFINITY)); } }
__device__ __forceinline__ void row_factors(const Ctx& c, float f, float (&fr)[16]) {
    const int lane = fresh_lane(), r32 = lane & 31, hi = lane >> 5; LAS float* wsf = (LAS float*)(c.lds + LDS_WSF) + c.wid * 64;
    asm volatile("s_waitcnt lgkmcnt(0)" ::: "memory");
    if (hi == 0) wsf[r32] = f;
    asm volatile("s_waitcnt lgkmcnt(0)" ::: "memory");
#pragma unroll
    for (int r = 0; r < 16; ++r) fr[r] = wsf[(r & 3) + 8 * (r >> 2) + 4 * hi];
    asm volatile("s_waitcnt lgkmcnt(0)" ::: "memory");
}
__device__ __forceinline__ float pair_sum(float v) { auto rr = __builtin_amdgcn_permlane32_swap(__float_as_uint(v), __float_as_uint(v), false, false); return __uint_as_float(rr[0]) + __uint_as_float(rr[1]); }
template <class RowOff>
__device__ __forceinline__ void store_rows(const Ctx& c, const f32x16 (&o)[2], bf16* dst, RowOff&& rowoff) {
    LAS bf16* stg = (LAS bf16*)(c.lds + LDS_OST) + c.wid * 2048;
    const int lane = fresh_lane(), r32 = lane & 31, hi = lane >> 5;
#pragma unroll
    for (int r = 0; r < 16; ++r) { const int orow = (r & 3) + 8 * (r >> 2) + 4 * hi;
#pragma unroll
        for (int d0 = 0; d0 < 2; ++d0) stg[orow * 64 + d0 * 32 + r32] = (bf16)f2bf(o[d0][r]); }
    asm volatile("s_waitcnt lgkmcnt(0)" ::: "memory");
#pragma unroll
    for (int i = 0; i < 4; ++i) { const int row = i * 8 + (lane >> 3), ch = lane & 7; const u32x4 v = *(const LAS u32x4*)(stg + row * 64 + ch * 8); *(u32x4*)(dst + rowoff(row) + ch * 8) = v; }
    asm volatile("s_waitcnt lgkmcnt(0)" ::: "memory");
}
struct AttnPtrs { const bf16* qkv; const float* kmp; const float* gates; const bf16* kcmp; const bf16* vcmp; const float* rel_bias; bf16* mix; unsigned* selg; bf16* part_o; float* part_l; };

__device__ __forceinline__ unsigned moba_gate32(const AttnPtrs& P, int b, int h, int i, const bf16x8 (&qr)[4], int r32, int hi) {
    unsigned selmask = 0u;
    if (i > 0) {
        bf16x8 kmf[4];
        const float* kp = P.kmp + ((size_t)((b * 8 + h) * 32 + r32) * 2) * 64;
#pragma unroll
        for (int d0 = 0; d0 < 4; ++d0) { const f32x4 a0 = *(const f32x4*)(kp + d0 * 16 + hi * 8), a1 = *(const f32x4*)(kp + d0 * 16 + hi * 8 + 4), b0 = *(const f32x4*)(kp + 64 + d0 * 16 + hi * 8), b1 = *(const f32x4*)(kp + 64 + d0 * 16 + hi * 8 + 4);
            const f32x4 m0 = (a0 + b0) * (1.f / 256.f), m1 = (a1 + b1) * (1.f / 256.f);
            u32x4 w = {cvtpk(m0[0], m0[1]), cvtpk(m0[2], m0[3]), cvtpk(m1[0], m1[1]), cvtpk(m1[2], m1[3])}; kmf[d0] = __builtin_bit_cast(bf16x8, w); }
        f32x16 sg = {};
#pragma unroll
        for (int d0 = 0; d0 < 4; ++d0) sg = MFMA32(kmf[d0], qr[d0], sg);
        float v[16];
#pragma unroll
        for (int r = 0; r < 16; ++r) v[r] = ((r & 3) + 8 * (r >> 2) + 4 * hi < i) ? sg[r] : -INFINITY;
#pragma unroll
        for (int it = 0; it < 3; ++it) {
            float m = v[0]; int jb = 4 * hi;
#pragma unroll
            for (int r = 1; r < 16; ++r) { const int j = (r & 3) + 8 * (r >> 2) + 4 * hi; if (v[r] > m) { m = v[r]; jb = j; } }
            auto rm = __builtin_amdgcn_permlane32_swap(__float_as_uint(m), __float_as_uint(m), false, false);
            auto rj = __builtin_amdgcn_permlane32_swap((unsigned)jb, (unsigned)jb, false, false);
            const float mo = __uint_as_float(hi ? rm[0] : rm[1]); const int jo = (int)(hi ? rj[0] : rj[1]);
            const bool mine = (m > mo) || (m == mo && jb < jo);
            const float mw = mine ? m : mo; const int jw = mine ? jb : jo;
            if (mw > -INFINITY) { selmask |= 1u << jw;
#pragma unroll
                for (int r = 0; r < 16; ++r) if ((r & 3) + 8 * (r >> 2) + 4 * hi == jw) v[r] = -INFINITY; }
        }
    }
    return selmask;
}
__device__ __forceinline__ void moba_gate_phase(const AttnPtrs& P, int vcu, int G, int tid) {
    const int lane = tid & 63, r32 = lane & 31, hi = lane >> 5; const int wid = __builtin_amdgcn_readfirstlane(tid >> 6);
    for (int task = vcu * 8 + wid; task < 8192; task += G * 8) { const int w = task & 7, i = (task >> 3) & 31, bh = task >> 8; const int qpos = 256 * i + 32 * w + r32;
        const bf16* QA = P.qkv + ((size_t)bh * SEQ) * 64;
        bf16x8 qr[4];
#pragma unroll
        for (int d0 = 0; d0 < 4; ++d0) qr[d0] = *(const bf16x8*)(QA + (size_t)qpos * 64 + d0 * 16 + hi * 8);
        const unsigned m = moba_gate32(P, bh >> 3, bh & 7, i, qr, r32, hi);
        if (hi == 0) P.selg[(size_t)bh * SEQ + qpos] = m; }
}
__device__ __forceinline__ void moba_lut(const Ctx& c, const AttnPtrs& P, int h) {
    LAS float* lut = (LAS float*)(c.lds + LDS_LUT);
    if (threadIdx.x < 115) lut[threadIdx.x] = (threadIdx.x == 114) ? -INFINITY : (P.rel_bias[t5_bucket(threadIdx.x) * 16 + h] - P.rel_bias[31 * 16 + h]) * LOG2E;
}
__device__ __forceinline__ void moba_past_item(const Ctx& c, const AttnPtrs& P, int b, int h, int j) {
    const int bh = b * 8 + h, tid = threadIdx.x;
    const bf16* QA = P.qkv + ((size_t)bh * SEQ) * 64; const bf16* KA = QA + QKV_BIG + (size_t)256 * j * 64; const bf16* VA = QA + 2 * QKV_BIG + (size_t)256 * j * 64;
    moba_lut(c, P, h);
    const LAS float* lut = (const LAS float*)(c.lds + LDS_LUT);
    { const int lane = fresh_lane(); const unsigned lds0 = (unsigned)(uintptr_t)c.lds;
      const bf16* ks = KA + (lane * 64 + c.wid * 8); const bf16* vs = VA + ((16 * (c.wid & 3) + (lane >> 2)) * 64 + (c.wid >> 2) * 32 + (lane & 3) * 8);
#pragma unroll
      for (int tt = 0; tt < 4; ++tt) { glds16(ks + tt * 4096, (unsigned)__builtin_amdgcn_readfirstlane(lds0 + c.wid * 1024 + tt * SLOT)); glds16(vs + tt * 4096, (unsigned)__builtin_amdgcn_readfirstlane(lds0 + 8192 + c.wid * 1024 + tt * SLOT)); } }
    LAS unsigned short* list = (LAS unsigned short*)(c.lds + LDS_IMP);
    LAS unsigned* wcnt = (LAS unsigned*)(c.lds + LDS_MISC) + 8;
    const unsigned* sg = P.selg + (size_t)bh * SEQ;
    int total = 0;
    for (int base = (j + 1) * 256; base < SEQ; base += 512) {
        const int q = base + tid; const unsigned m = (q < SEQ) ? sg[q] : 0u; const bool sel = (m >> j) & 1u;
        const unsigned long long bal = __ballot(sel);
        if ((tid & 63) == 0) wcnt[c.wid] = (unsigned)__popcll(bal);
        asm volatile("s_waitcnt vmcnt(0) lgkmcnt(0)\n\ts_barrier" ::: "memory");
        int off = total, tot = 0;
#pragma unroll
        for (int w = 0; w < 8; ++w) { const int v = (int)wcnt[w]; off += (w < c.wid) ? v : 0; tot += v; }
        if (sel) list[off + __popcll(bal & ((1ull << (tid & 63)) - 1ull))] = (unsigned short)(q | (__popc(m & ((1u << j) - 1u)) << 13));
        total += tot;
        asm volatile("s_waitcnt lgkmcnt(0)\n\ts_barrier" ::: "memory");
    }
    total = __builtin_amdgcn_readfirstlane(total);
    { const int npad = (32 - (total & 31)) & 31; if (tid < npad) list[total + tid] = 0xFFFFu; }
    const int nchunks = (total + 31) >> 5;
    asm volatile("s_waitcnt vmcnt(0) lgkmcnt(0)\n\ts_barrier" ::: "memory");
    for (int ch = c.wid; ch < nchunks; ch += 8) {
        const int lane = fresh_lane(), r32 = lane & 31, hi = lane >> 5;
        const lds_cptr kp0 = (lds_cptr)c.lds + hi * 1024 + r32 * 16;
        const lds_cptr vp0 = (lds_cptr)c.lds + 8192 + ((lane >> 4) & 1) * 32 + (lane & 3) * 8 + (4 * hi + ((lane & 15) >> 2)) * 64;
        const unsigned e = list[32 * ch + r32]; const bool valid = e != 0xFFFFu; const int q = valid ? (int)(e & 0x1FFFu) : SEQ - 1;
        bf16x8 qr[4];
#pragma unroll
        for (int d0 = 0; d0 < 4; ++d0) qr[d0] = *(const bf16x8*)(QA + (size_t)q * 64 + d0 * 16 + hi * 8);
        asm volatile("" : "+v"(qr[0]), "+v"(qr[1]), "+v"(qr[2]), "+v"(qr[3]));
        const bool anynear = __any(valid && (q >> 8) == j + 1);
        f32x16 o[2]; o[0] = f32x16{}; o[1] = f32x16{}; float l_reg = 0.f;
#pragma unroll 1
        for (int tt = 0; tt < 4; ++tt) { f32x16 s0, s1; qk_tile(s0, s1, kp0 + tt * SLOT, qr);
            if (anynear) hook_general(s0, s1, q - (256 * j + 64 * tt) - 4 * hi, 1 << 30, lut, true); else hook_exp(s0, s1);
            l_reg += rowsum32(s0, s1);
            pv_tile<false>(o, vp0 + tt * SLOT, s0, s1, 0u); }
        const float L = pair_sum(l_reg);
        if (hi == 0 && valid) P.part_l[((size_t)bh * SEQ + q) * 3 + (e >> 13)] = L;
        LAS bf16* stg = (LAS bf16*)(c.lds + LDS_OST) + c.wid * 2048;
#pragma unroll
        for (int r = 0; r < 16; ++r) { const int orow = (r & 3) + 8 * (r >> 2) + 4 * hi;
#pragma unroll
            for (int d0 = 0; d0 < 2; ++d0) stg[orow * 64 + d0 * 32 + r32] = (bf16)f2bf(o[d0][r]); }
        asm volatile("s_waitcnt lgkmcnt(0)" ::: "memory");
#pragma unroll
        for (int it = 0; it < 4; ++it) { const int row = it * 8 + (lane >> 3), chn = lane & 7; const unsigned e2 = list[32 * ch + row];
            const u32x4 v = *(const LAS u32x4*)(stg + row * 64 + chn * 8);
            if (e2 != 0xFFFFu) *(u32x4*)(P.part_o + (((size_t)bh * SEQ + (e2 & 0x1FFFu)) * 3 + (e2 >> 13)) * 64 + chn * 8) = v; }
        asm volatile("s_waitcnt lgkmcnt(0)" ::: "memory");
    }
    asm volatile("s_waitcnt lgkmcnt(0)\n\ts_barrier" ::: "memory");
}
__device__ __forceinline__ void moba_own_item(const Ctx& c, const AttnPtrs& P, int b, int h, int i) {
    const int bh = b * 8 + h; const int q0 = 256 * i + 32 * c.wid, qpos = q0 + c.r32;
    const bf16* QA = P.qkv + ((size_t)bh * SEQ) * 64; const bf16* KA = QA + QKV_BIG; const bf16* VA = QA + 2 * QKV_BIG;
    bf16x8 qr[4];
#pragma unroll
    for (int d0 = 0; d0 < 4; ++d0) qr[d0] = *(const bf16x8*)(QA + (size_t)qpos * 64 + d0 * 16 + c.hi * 8);
    asm volatile("" : "+v"(qr[0]), "+v"(qr[1]), "+v"(qr[2]), "+v"(qr[3]));
    moba_lut(c, P, h);
    const LAS float* lut = (const LAS float*)(c.lds + LDS_LUT);
    asm volatile("s_waitcnt lgkmcnt(0)\n\ts_barrier" ::: "memory");
    f32x16 o[2]; o[0] = f32x16{}; o[1] = f32x16{}; float l_reg = 0.f;
    run_stream<true>(c, KA, VA, 4 * i, 4 * i + 4,
        [&](int t, lds_cptr kp, f32x16& s0, f32x16& s1) { if (q0 + 31 - 64 * t < 0) return; qk_tile(s0, s1, kp, qr); },
        [&](int t, lds_cptr vp, f32x16& s0, f32x16& s1) { const int key0 = 64 * t; if (q0 + 31 - key0 < 0) return;
            hook_general(s0, s1, qpos - key0 - 4 * c.hi, 1 << 30, lut, true); l_reg += rowsum32(s0, s1); pv_tile<false>(o, vp, s0, s1, 0u); });
    const float Lown = pair_sum(l_reg);
    const int lane = fresh_lane(), r32 = lane & 31, hi = lane >> 5;
    LAS float* stgf = (LAS float*)c.lds + c.wid * 2048;
    LAS float* wsf = (LAS float*)(c.lds + LDS_WSF) + c.wid * 64;
#pragma unroll
    for (int r = 0; r < 16; ++r) { const int orow = (r & 3) + 8 * (r >> 2) + 4 * hi;
#pragma unroll
        for (int d0 = 0; d0 < 2; ++d0) stgf[orow * 64 + d0 * 32 + r32] = o[d0][r]; }
    if (hi == 0) wsf[r32] = Lown;
    asm volatile("s_waitcnt lgkmcnt(0)" ::: "memory");
#pragma unroll
    for (int it = 0; it < 4; ++it) { const int row = it * 8 + (lane >> 3), chn = lane & 7; const int q = 256 * i + 32 * c.wid + row;
        const size_t qi = (size_t)bh * SEQ + q; const int ns = __popc(P.selg[qi]);
        float Lt = wsf[row]; f32x4 a0 = *(const LAS f32x4*)(stgf + row * 64 + chn * 8), a1 = *(const LAS f32x4*)(stgf + row * 64 + chn * 8 + 4);
#pragma unroll
        for (int sidx = 0; sidx < 3; ++sidx) if (sidx < ns) { Lt += P.part_l[qi * 3 + sidx]; const u32x4 pv = *(const u32x4*)(P.part_o + (qi * 3 + sidx) * 64 + chn * 8);
            a0 += (f32x4){__uint_as_float(pv.x << 16), __uint_as_float(pv.x & 0xffff0000u), __uint_as_float(pv.y << 16), __uint_as_float(pv.y & 0xffff0000u)};
            a1 += (f32x4){__uint_as_float(pv.z << 16), __uint_as_float(pv.z & 0xffff0000u), __uint_as_float(pv.w << 16), __uint_as_float(pv.w & 0xffff0000u)}; }
        const float inv = 1.f / Lt; a0 *= inv; a1 *= inv;
        const u32x4 w = {cvtpk(a0[0], a0[1]), cvtpk(a0[2], a0[3]), cvtpk(a1[0], a1[1]), cvtpk(a1[2], a1[3])};
        *(u32x4*)(P.mix + ((size_t)b * SEQ + q) * DM + h * 64 + chn * 8) = w; }
    asm volatile("s_waitcnt lgkmcnt(0)\n\ts_barrier" ::: "memory");
}

__device__ __forceinline__ void nsa_item(const Ctx& c, const AttnPtrs& P, int b, int g, int ci) {
    const int ql = 8 * c.wid + (c.r32 >> 2), rh = c.r32 & 3, qpos = 64 * ci + ql, hb = 4 * g + rh;
    const int qw0 = 64 * ci + 8 * c.wid;
    const bf16* QB = P.qkv + 3 * QKV_BIG + ((size_t)(b * 8 + hb) * SEQ) * 64;
    const bf16* KS = P.qkv + 4 * QKV_BIG + 2 * QKV_SMALL + ((size_t)(b * 2 + g) * SEQ) * 64; const bf16* VS = KS + QKV_SMALL; const bf16* KW = KS + 2 * QKV_SMALL; const bf16* VW = KS + 3 * QKV_SMALL;
    const bf16* KC = P.kcmp + (size_t)(b * 2 + g) * 512 * 64; const bf16* VC = P.vcmp + (size_t)(b * 2 + g) * 512 * 64;
    bf16x8 qr[4];
#pragma unroll
    for (int d0 = 0; d0 < 4; ++d0) qr[d0] = *(const bf16x8*)(QB + (size_t)qpos * 64 + d0 * 16 + c.hi * 8);
    const float* gp = P.gates + ((size_t)b * SEQ + qpos) * 24 + hb * 3; float g0 = gp[0], g1 = gp[1], g2 = gp[2];
    asm volatile("" : "+v"(qr[0]), "+v"(qr[1]), "+v"(qr[2]), "+v"(qr[3]), "+v"(g0), "+v"(g1), "+v"(g2));
    LAS float* lutall = (LAS float*)(c.lds + LDS_LUT);
    if (threadIdx.x < 460) { const int hh = threadIdx.x / 115, d = threadIdx.x % 115; lutall[hh * 128 + d] = (d == 114) ? -INFINITY : (P.rel_bias[t5_bucket(d) * 16 + 8 + 4 * g + hh] - P.rel_bias[31 * 16 + 8 + 4 * g + hh]) * LOG2E; }
    const LAS float* lut = lutall + rh * 128;
    LAS float* imp = (LAS float*)(c.lds + LDS_IMP);
    LAS unsigned* selm = (LAS unsigned*)(c.lds + LDS_SELM);
    f32x16 o[2]; float l_reg; float fr[16];
    LAS float* park = (LAS float*)(c.lds + LDS_OST) + c.wid * 1024 + c.lane;
    LAS float* park1 = (LAS float*)(c.lds + LDS_IMP) + c.wid * 1024 + c.lane;
    const int nct = (4 * ci + 3 + 63) >> 6;
    const int nlim = (qpos >= 31) ? ((qpos - 31) >> 4) : -1;
    l_reg = 0.f;
    run_stream<false>(c, KC, VC, 0, nct,
        [&](int t, lds_cptr kp, f32x16& s0, f32x16& s1) { qk_tile(s0, s1, kp, qr); },
        [&](int t, lds_cptr vp, f32x16& s0, f32x16& s1) { hook_cmp(s0, s1, nlim - 64 * t - 4 * c.hi, 0.f); l_reg += rowsum32(s0, s1); });
    const float Lc = pair_sum(l_reg); const float cbn = Lc > 0.f ? -__builtin_amdgcn_logf(Lc) : -INFINITY;
    o[0] = f32x16{}; o[1] = f32x16{};
    {
        float carry = 0.f;
        run_stream<true>(c, KC, VC, 0, nct,
          [&](int t, lds_cptr kp, f32x16& s0, f32x16& s1) { qk_tile(s0, s1, kp, qr); },
          [&](int t, lds_cptr vp, f32x16& s0, f32x16& s1) {
            hook_cmp(s0, s1, nlim - 64 * t - 4 * c.hi, cbn);
#pragma unroll
            for (int half = 0; half < 2; ++half) {
                float g4[4], e[4];
#pragma unroll
                for (int a = 0; a < 4; ++a) { const float x0 = half ? s1[4 * a] : s0[4 * a], x1 = half ? s1[4 * a + 1] : s0[4 * a + 1], x2 = half ? s1[4 * a + 2] : s0[4 * a + 2], x3 = half ? s1[4 * a + 3] : s0[4 * a + 3];
                    float gs = (x0 + x1) + (x2 + x3), es = x3;
                    gs += __shfl_xor(gs, 1); gs += __shfl_xor(gs, 2); es += __shfl_xor(es, 1); es += __shfl_xor(es, 2);
                    g4[a] = gs; e[a] = es; }
                float x[4];
#pragma unroll
                for (int a = 0; a < 4; ++a) { auto rr = __builtin_amdgcn_permlane32_swap(__float_as_uint(e[a]), __float_as_uint(e[a]), false, false); x[a] = __uint_as_float(c.hi ? rr[0] : rr[1]); }
                const int jb = 16 * t + 8 * half;
                float iv[4];
                if (c.hi) {
#pragma unroll
                    for (int a = 0; a < 4; ++a) iv[a] = g4[a] + x[a]; }
                else { iv[0] = g4[0] + carry; iv[1] = g4[1] + x[0]; iv[2] = g4[2] + x[1]; iv[3] = g4[3] + x[2]; carry = x[3]; }
                if (rh == 0) {
#pragma unroll
                    for (int a = 0; a < 4; ++a) imp[ql * 128 + jb + 2 * a + c.hi] = iv[a]; }
            }
            pv_tile<false>(o, vp, s0, s1, 0u);
        });
    }
    {
        asm volatile("s_waitcnt lgkmcnt(0)\n\ts_barrier" ::: "memory");
        const int qq = 8 * c.wid + (c.lane >> 3), cc = c.lane & 7;
        unsigned m0 = 0u, m1 = 0u, m2w = 0u, m3 = 0u;
        if (ci <= 15) { m0 = (ci == 31) ? 0xffffffffu : ((2u << ci) - 1u); }
        else {
            float v[16];
#pragma unroll
            for (int k = 0; k < 16; ++k) { const int j = cc + 8 * k; v[k] = (j >= 1 && j <= ci - 2) ? imp[qq * 128 + j] : -INFINITY; }
            for (int it = 0; it < 13; ++it) {
                float m = v[0]; int jb = cc;
#pragma unroll
                for (int k = 1; k < 16; ++k) if (v[k] > m) { m = v[k]; jb = cc + 8 * k; }
#pragma unroll
                for (int sft = 1; sft < 8; sft <<= 1) { const float mo = __shfl_xor(m, sft); const int jo = __shfl_xor(jb, sft); if (mo > m || (mo == m && jo < jb)) { m = mo; jb = jo; } }
                if (m > -INFINITY) { const unsigned bit = 1u << (jb & 31); const int wsel = jb >> 5;
                    m0 |= (wsel == 0) ? bit : 0u; m1 |= (wsel == 1) ? bit : 0u; m2w |= (wsel == 2) ? bit : 0u; m3 |= (wsel == 3) ? bit : 0u;
#pragma unroll
                    for (int k = 0; k < 16; ++k) if (cc + 8 * k == jb) v[k] = -INFINITY; }
            }
            m0 |= 1u;
#pragma unroll
            for (int z = 0; z < 2; ++z) { const int jf = ci - z; const unsigned bit = 1u << (jf & 31); const int wsel = jf >> 5;
                m0 |= (wsel == 0) ? bit : 0u; m1 |= (wsel == 1) ? bit : 0u; m2w |= (wsel == 2) ? bit : 0u; m3 |= (wsel == 3) ? bit : 0u; }
        }
        if (cc == 0) { selm[qq * 4 + 0] = m0; selm[qq * 4 + 1] = m1; selm[qq * 4 + 2] = m2w; selm[qq * 4 + 3] = m3; }
        asm volatile("s_waitcnt lgkmcnt(0)\n\ts_barrier" ::: "memory");
    }
    row_factors(c, g0, fr);
#pragma unroll
    for (int r = 0; r < 16; ++r) { park[r * 64] = o[0][r] * fr[r]; park1[r * 64] = o[1][r] * fr[r]; }
    {
        const unsigned w0 = selm[ql * 4 + 0], w1 = selm[ql * 4 + 1], w2 = selm[ql * 4 + 2], w3 = selm[ql * 4 + 3];
        o[0] = f32x16{}; o[1] = f32x16{}; l_reg = 0.f;
        auto sel_pred = [&](int t) -> bool { const unsigned wsel = (t < 32) ? w0 : (t < 64) ? w1 : (t < 96) ? w2 : w3; return (wsel >> (t & 31)) & 1u; };
        run_stream<true>(c, KS, VS, 0, ci + 1,
            [&](int t, lds_cptr kp, f32x16& s0, f32x16& s1) { if (!__any(sel_pred(t))) return; qk_tile(s0, s1, kp, qr); },
            [&](int t, lds_cptr vp, f32x16& s0, f32x16& s1) { const bool pred = sel_pred(t); if (!__any(pred)) return; const int key0 = 64 * t;
                if (qw0 - key0 - 63 >= 113) { hook_exp(s0, s1); const float rs = rowsum32(s0, s1); l_reg += pred ? rs : 0.f;
                    if (__all(pred)) pv_tile<false>(o, vp, s0, s1, 0u); else pv_tile<true>(o, vp, s0, s1, pred ? 0xffffffffu : 0u); }
                else { hook_general(s0, s1, qpos - key0 - 4 * c.hi, 1 << 30, lut, pred); l_reg += rowsum32(s0, s1); pv_tile<false>(o, vp, s0, s1, 0u); } });
        const float Ls = pair_sum(l_reg);
        row_factors(c, g1 / Ls, fr);
#pragma unroll
        for (int r = 0; r < 16; ++r) { park[r * 64] += o[0][r] * fr[r]; park1[r * 64] += o[1][r] * fr[r]; }
    }
    {
        o[0] = f32x16{}; o[1] = f32x16{}; l_reg = 0.f;
        run_stream<true>(c, KW, VW, ci >= 8 ? ci - 8 : 0, ci + 1,
            [&](int t, lds_cptr kp, f32x16& s0, f32x16& s1) { qk_tile(s0, s1, kp, qr); },
            [&](int t, lds_cptr vp, f32x16& s0, f32x16& s1) { const int key0 = 64 * t;
                if (qw0 - key0 - 63 >= 113 && qw0 + 7 - key0 < 512) hook_exp(s0, s1); else hook_general(s0, s1, qpos - key0 - 4 * c.hi, 512, lut, true);
                l_reg += rowsum32(s0, s1);
                pv_tile<false>(o, vp, s0, s1, 0u); });
        const float Lw = pair_sum(l_reg);
        row_factors(c, g2 / Lw, fr);
#pragma unroll
        for (int r = 0; r < 16; ++r) { o[0][r] = park[r * 64] + o[0][r] * fr[r]; o[1][r] = park1[r * 64] + o[1][r] * fr[r]; }
        asm volatile("s_waitcnt lgkmcnt(0)" ::: "memory");
    }
    bf16* dst = P.mix + ((size_t)b * SEQ + 64 * ci + 8 * c.wid) * DM + 512 + g * 256;
    store_rows(c, o, dst, [](int row) { return (size_t)(row >> 2) * DM + (row & 3) * 64; });
    asm volatile("s_waitcnt lgkmcnt(0)\n\ts_barrier" ::: "memory");
}

__device__ __forceinline__ void attn_phase(LAS unsigned char* lds, const AttnPtrs& P, unsigned* qcounter) {
    Ctx c = make_ctx(lds, threadIdx.x);
    LAS unsigned* misc = (LAS unsigned*)(c.lds + LDS_MISC);
    for (;;) {
        if (threadIdx.x == 0) misc[0] = __hip_atomic_fetch_add(qcounter, 1u, __ATOMIC_RELAXED, __HIP_MEMORY_SCOPE_AGENT);
        asm volatile("s_waitcnt vmcnt(0) lgkmcnt(0)\n\ts_barrier" ::: "memory");
        const unsigned k = misc[0];
        asm volatile("s_waitcnt lgkmcnt(0)\n\ts_barrier" ::: "memory");
        if (k >= 2016u) break;
        if (k < 512u) { const int s_ = 127 - (int)(k >> 3), bg = k & 7; nsa_item(c, P, bg >> 1, bg & 1, s_); }
        else if (k < 1504u) { const int kk = (int)k - 512, j = kk >> 5, bh = kk & 31; moba_past_item(c, P, bh >> 3, bh & 7, j); }
        else { const int kk = (int)k - 1504; const int s_ = 63 - (kk >> 3), bg = kk & 7; nsa_item(c, P, bg >> 1, bg & 1, s_); }
    }
}
__device__ __forceinline__ void moba_merge_phase(LAS unsigned char* lds, const AttnPtrs& P, int vcu, int G) {
    Ctx c = make_ctx(lds, threadIdx.x);
    for (int k = vcu; k < 1024; k += G) moba_own_item(c, P, k >> 8, (k >> 5) & 7, k & 31);
}
#undef MFMA32
#undef ATT_WAIT_BAR
}
namespace cmpr {
using bf16x8 = __attribute__((ext_vector_type(8))) short;
using f32x16 = __attribute__((ext_vector_type(16))) float;
constexpr int HID_PITCH = 528;
__device__ __forceinline__ float gelu_tanh(float v) { const float u = fminf(fmaxf(0.7978845608028654f * (v + 0.044715f * v * v * v), -15.f), 15.f); const float e = __expf(2.f * u); return 0.5f * v * (1.f + (e - 1.f) / (e + 1.f)); }
__device__ __forceinline__ void compress_unit(LAS unsigned char* lds, int unit, const bf16* qkv, const bf16* w1k, const bf16* w1v, const bf16* w2k, const bf16* w2v, const float* cbp, const float* kncmp, bf16* kcmp, bf16* vcmp) {
    const int tid = threadIdx.x, lane = tid & 63, r32 = lane & 31, hi = lane >> 5; const int wid = __builtin_amdgcn_readfirstlane(tid >> 6);
    const int kv = unit & 1, u = (unit >> 1) & 15, bg = unit >> 5;
    const bf16* src = qkv + 4 * QKV_BIG + (kv ? QKV_SMALL : 0) + (size_t)bg * SEQ * 64;
    const bf16* w1 = kv ? w1v : w1k; const bf16* w2 = kv ? w2v : w2k;
    const int n0 = 32 * u; const int nn = min(n0 + r32, NCMP - 1);
    const bf16* ap = src + (size_t)nn * 1024 + 8 * hi; const bf16* bp = w1 + (size_t)(32 * wid + r32) * 2048 + 8 * hi;
    f32x16 acc = {};
#pragma unroll 8
    for (int kk = 0; kk < 128; ++kk) { const bf16x8 a = *(const bf16x8*)(ap + 16 * kk), bfr = *(const bf16x8*)(bp + 16 * kk); acc = __builtin_amdgcn_mfma_f32_32x32x16_bf16(a, bfr, acc, 0, 0, 0); }
    float cb = 0.f;
#pragma unroll 8
    for (int ic = 0; ic < 32; ++ic) cb += cbp[(ic * 2 + kv) * 256 + 32 * wid + r32];
    LAS unsigned char* hidL = lds;
#pragma unroll
    for (int r = 0; r < 16; ++r) { const int n = (r & 3) + 8 * (r >> 2) + 4 * hi; *(LAS bf16*)(hidL + n * HID_PITCH + (32 * wid + r32) * 2) = (bf16)f2bf(gelu_tanh(acc[r] + cb)); }
    asm volatile("s_waitcnt lgkmcnt(0)\n\ts_barrier" ::: "memory");
    if (wid == 0) {
        f32x16 o0 = {}, o1 = {};
#pragma unroll 4
        for (int kk = 0; kk < 16; ++kk) { const bf16x8 hb = *(const LAS bf16x8*)(hidL + r32 * HID_PITCH + (16 * kk + 8 * hi) * 2);
            const bf16x8 a0 = *(const bf16x8*)(w2 + (size_t)r32 * 256 + 16 * kk + 8 * hi), a1 = *(const bf16x8*)(w2 + (size_t)(32 + r32) * 256 + 16 * kk + 8 * hi);
            o0 = __builtin_amdgcn_mfma_f32_32x32x16_bf16(a0, hb, o0, 0, 0, 0); o1 = __builtin_amdgcn_mfma_f32_32x32x16_bf16(a1, hb, o1, 0, 0, 0); }
        float rs = 1.f;
        if (!kv) { float ss = 0.f;
#pragma unroll
            for (int r = 0; r < 16; ++r) ss += o0[r] * o0[r] + o1[r] * o1[r];
            auto rr = __builtin_amdgcn_permlane32_swap(__float_as_uint(ss), __float_as_uint(ss), false, false); ss = __uint_as_float(rr[0]) + __uint_as_float(rr[1]);
            rs = rsqrtf(ss * (1.f / 64.f) + 1e-6f); }
        const int n = n0 + r32; bf16* dst = (kv ? vcmp : kcmp) + ((size_t)bg * 512 + n) * 64;
#pragma unroll
        for (int r = 0; r < 16; ++r) { const int d = (r & 3) + 8 * (r >> 2) + 4 * hi;
            float v0 = o0[r] * rs, v1 = o1[r] * rs; if (!kv) { v0 *= kncmp[d]; v1 *= kncmp[d + 32]; }
            if (n >= NCMP) { v0 = 0.f; v1 = 0.f; }
            dst[d] = (bf16)f2bf(v0); dst[d + 32] = (bf16)f2bf(v1); }
    }
    asm volatile("s_waitcnt lgkmcnt(0)\n\ts_barrier" ::: "memory");
}
}
__global__ void __launch_bounds__(NTHREADS, 2) mk_fwd(Args a) {
    extern __shared__ __attribute__((aligned(16))) unsigned char lds[];
    Frame F;
    F.lds = (LAS unsigned char*)lds;
    F.tid = threadIdx.x; F.lane = F.tid & 63; F.wave = __builtin_amdgcn_readfirstlane(F.tid >> 6);
    F.G = gridDim.x; { const int bx = blockIdx.x; F.vcu = (F.G % 8 == 0) ? (bx % 8) * (F.G / 8) + bx / 8 : bx; }
    cg::grid_group grid = cg::this_grid();
    unsigned char* ws = a.ws;
    const int lo = a.ph_lo, hi = a.ph_hi;
    const att::AttnPtrs P{(const bf16*)(ws + WS_QKV), (const float*)(ws + WS_KMP), (const float*)(ws + WS_GATES), (const bf16*)(ws + WS_KCMP), (const bf16*)(ws + WS_VCMP), a.in[2], (bf16*)(ws + WS_MIX),
                          (unsigned*)(ws + WS_SELG), (bf16*)(ws + WS_PARTO), (float*)(ws + WS_PARTL)};
#define IN(k) (lo <= (k) && (k) < hi)
#define SEAM(k) do { if (IN(k) && IN((k) + 1)) grid.sync(); } while (0)
    if (IN(0)) { phase_prologue_a(F, a); } SEAM(0);
    if (IN(1)) { phase_prologue_b(F, a); } SEAM(1);
    if (IN(2)) {
        pg8::Gemm g{(const pg8::bf16_t*)(ws + WS_H), (const pg8::bf16_t*)(ws + WS_WIN), TOK, NIN_PAD, DM}; pg8::StaticOrder S; S.init(TOK, NIN_PAD, F.G, (int)blockIdx.x);
        pg8::EpiInProj E{(pg8::bf16_t*)(ws + WS_QKV), (float*)(ws + WS_GATES), (float*)(ws + WS_KMP), a.in[7], a.in[8], a.in[9], a.in[11], a.in[12]};
        pg8::gemm_phase<pg8::EpiInProj, pg8::StaticOrder, true, true>(F.lds, g, S, E);
    } SEAM(2);
    if (IN(3)) {
        att::moba_gate_phase(P, F.vcu, F.G, F.tid);
        for (int unit = F.vcu; unit < 256; unit += F.G)
            cmpr::compress_unit(F.lds, unit, (const bf16*)(ws + WS_QKV), (const bf16*)(ws + WS_W1K), (const bf16*)(ws + WS_W1V), (const bf16*)(ws + WS_W2K), (const bf16*)(ws + WS_W2V),
                                (const float*)(ws + WS_CBP), a.in[10], (bf16*)(ws + WS_KCMP), (bf16*)(ws + WS_VCMP));
    } SEAM(3);
    if (IN(4)) {
                att::attn_phase(F.lds, P, (unsigned*)(ws + WS_CTL) + 64);
    } SEAM(4);
    if (IN(5)) { att::moba_merge_phase(F.lds, P, F.vcu, F.G); } SEAM(5);
    if (IN(6)) {
        pg8::Gemm g{(const pg8::bf16_t*)(ws + WS_MIX), (const pg8::bf16_t*)(ws + WS_WOUT), TOK, DM, DM}; pg8::StaticOrder S; S.init(TOK, DM, F.G, (int)blockIdx.x);
        pg8::EpiOutProj E{a.in[0], a.out, (const float*)(ws + WS_MOD) + 2 * DM};
        pg8::gemm_phase<pg8::EpiOutProj, pg8::StaticOrder, true, true>(F.lds, g, S, E);
    } SEAM(6);
    if (IN(7)) { phase_norm2(F, a); } SEAM(7);
    if (IN(8)) {
        pg8::Gemm g{(const pg8::bf16_t*)(ws + WS_H), (const pg8::bf16_t*)(ws + WS_WGU), TOK, 2 * FF, DM}; pg8::StaticOrder S; S.init(TOK, 2 * FF, F.G, (int)blockIdx.x);
        pg8::EpiGateUp E{(pg8::bf16_t*)(ws + WS_ACT)};
        pg8::gemm_phase<pg8::EpiGateUp, pg8::StaticOrder, true, true>(F.lds, g, S, E);
    } SEAM(8);
    if (IN(9)) {
        pg8::Gemm g{(const pg8::bf16_t*)(ws + WS_ACT), (const pg8::bf16_t*)(ws + WS_WDN), TOK, DM, FF}; pg8::StaticOrder S; S.init(TOK, DM, F.G, (int)blockIdx.x);
        pg8::EpiDown E{a.out, (const float*)(ws + WS_MOD) + 5 * DM};
        pg8::gemm_phase<pg8::EpiDown, pg8::StaticOrder, true, true>(F.lds, g, S, E);
    }
#undef IN
#undef SEAM
}

static void launch_phases(const Args& base, int lo, int hi, int grid, hipStream_t stream) {
    Args a = base; a.ph_lo = lo; a.ph_hi = hi;
    if (hi - lo > 1) { void* args[] = {&a}; (void)hipLaunchCooperativeKernel((const void*)mk_fwd, dim3(grid), dim3(NTHREADS), args, LDS_BYTES, stream); }
    else hipLaunchKernelGGL(mk_fwd, dim3(grid), dim3(NTHREADS), LDS_BYTES, stream, a);
}
extern "C" void kernel_launch(void* const* d_in, const int* in_sizes, int n_in, void* d_out, int out_size, void* d_ws, size_t ws_size, hipStream_t stream) {
    static int grid = 0;
    if (grid == 0) {
        int dev = 0, cus = 0, per_cu = 0;
        if (n_in != 23 || ws_size < 452 * MiB || hipGetDevice(&dev) != hipSuccess || hipDeviceGetAttribute(&cus, hipDeviceAttributeMultiprocessorCount, dev) != hipSuccess) { grid = -1; return; }
        if (hipFuncSetAttribute((const void*)mk_fwd, hipFuncAttributeMaxDynamicSharedMemorySize, LDS_BYTES) != hipSuccess) { grid = -1; return; }
        if (hipOccupancyMaxActiveBlocksPerMultiprocessor(&per_cu, (const void*)mk_fwd, NTHREADS, LDS_BYTES) != hipSuccess || per_cu < 1) { grid = -1; return; }
        grid = cus;
    }
    if (grid < 0) return;
    (void)hipMemsetAsync((char*)d_ws + WS_CTL, 0, CTL_ZERO_BYTES, stream);
    Args a{};
    for (int i = 0; i < 23; ++i) a.in[i] = (const float*)d_in[i];
    a.out = (float*)d_out; a.ws = (unsigned char*)d_ws;
    unsigned char* ws = (unsigned char*)d_ws;
#if HYBRID == 1
    launch_phases(a, 0, 1, grid, stream); launch_phases(a, 1, 2, grid, stream); launch_phases(a, 2, 3, grid, stream);
    const bf16* qkv = (const bf16*)(ws + WS_QKV); bf16* mix = (bf16*)(ws + WS_MIX); bf16* kcmp = (bf16*)(ws + WS_KCMP); bf16* vcmp = (bf16*)(ws + WS_VCMP);
    int* sel = (int*)(ws + 344 * MiB); float* obuf = (float*)(ws + 348 * MiB); const float* gates = (const float*)(ws + WS_GATES);
    nq::k_compress<<<dim3(4 * 2 * 512, 2), 256, 0, stream>>>(qkv, a.in[13], a.in[14], a.in[15], a.in[16], a.in[17], a.in[18], a.in[10], kcmp, vcmp);
    nq::k_moba<<<4 * 8 * SEQ / 4, 256, 0, stream>>>(qkv, (const float*)(ws + WS_KMP), a.in[2], mix);
    nq::k_nsa_cmp<<<4 * 2 * SEQ, 256, 0, stream>>>(qkv, kcmp, vcmp, gates, obuf, sel);
    nq::k_nsa_sel<<<4 * 2 * SEQ, 256, 0, stream>>>(qkv, sel, a.in[2], gates, obuf);
    nq::k_nsa_win<<<4 * 2 * SEQ, 256, 0, stream>>>(qkv, a.in[2], gates, obuf, mix);
    launch_phases(a, 5, 6, grid, stream); launch_phases(a, 6, 7, grid, stream); launch_phases(a, 7, 8, grid, stream); launch_phases(a, 8, 9, grid, stream);
#elif HYBRID == 2
    launch_phases(a, 0, 1, grid, stream); launch_phases(a, 1, 2, grid, stream); launch_phases(a, 2, 3, grid, stream);
    nq::k_compress<<<dim3(4 * 2 * 512, 2), 256, 0, stream>>>((const bf16*)(ws + WS_QKV), a.in[13], a.in[14], a.in[15], a.in[16], a.in[17], a.in[18], a.in[10], (bf16*)(ws + WS_KCMP), (bf16*)(ws + WS_VCMP));
    launch_phases(a, 4, 5, grid, stream);
    launch_phases(a, 5, 6, grid, stream); launch_phases(a, 6, 7, grid, stream); launch_phases(a, 7, 8, grid, stream); launch_phases(a, 8, 9, grid, stream);
#elif HYBRID == 3
    for (int p = 0; p < N_PHASES; ++p) { launch_phases(a, p, p + 1, grid, stream);
#if defined(ABL_REPS)
        if (p == 3) { static bool once = false; if (!once) { once = true; (void)hipFuncSetAttribute((const void*)k_attn_abl, hipFuncAttributeMaxDynamicSharedMemorySize, LDS_BYTES); }
            for (int r = 0; r < ABL_REPS; ++r) { (void)hipMemsetAsync((char*)d_ws + WS_CTL + 512, 0, 4, stream); hipLaunchKernelGGL(k_attn_abl, dim3(grid), dim3(NTHREADS), LDS_BYTES, stream, a); } }
#endif
#if defined(TIME_PHASE)
        if (p == TIME_PHASE) { for (int r = 0; r < TIME_REPS; ++r) { (void)hipMemsetAsync((char*)d_ws + WS_CTL, 0, CTL_ZERO_BYTES, stream); launch_phases(a, p, p + 1, grid, stream); } }
#endif
    }
#else
    launch_phases(a, 0, N_PHASES, grid, stream);
#endif
}
```

```cpp
#include <hip/hip_runtime.h>
#include <hip/hip_cooperative_groups.h>
#include <cstdint>
#include <cstdio>
namespace cg = cooperative_groups;
#define HYBRID 0
namespace pg8 {
#define PG8_LAS __attribute__((address_space(3)))
typedef unsigned short bf16_t;
typedef short bf16x8 __attribute__((ext_vector_type(8)));
typedef float f32x4 __attribute__((ext_vector_type(4)));
typedef unsigned u32x4 __attribute__((ext_vector_type(4)));
constexpr int BM = 256, BK = 64, HALF = 128, HTB = HALF * BK * 2  , STAGE_BYTES = 8 * HTB, NXCD = 8, WGM = 8;

__host__ __device__ __forceinline__ int lds_byte(int r, int c) { const int st = (r >> 4) * 2 + (c >> 5), rr = r & 15, cc = c & 31, ob = rr * 64 + cc * 2; return st * 1024 + (ob ^ (((ob >> 9) & 1) << 5)); }
__host__ __device__ __forceinline__ void stage_rc(int b, int& R, int& C) { const int st = b / 1024, sb = b % 1024, swz = sb ^ (((sb >> 9) & 1) << 5); R = (st >> 1) * 16 + swz / 64; C = (st & 1) * 32 + (swz % 64) / 2; }
__host__ __device__ __forceinline__ int perm32(int rho) { const int n = rho >> 4, i = rho & 15; return 8 * (i >> 2) + 4 * n + (i & 3); }

struct Unit { int pm, pn; };
struct Gemm { const bf16_t* A; const bf16_t* Bt; int M, N, K; };

struct StaticOrder {
    int nM, nN, nwg, G, c;
    __host__ __device__ void init(int M, int N, int G_, int c_) { nM = M / BM; nN = N / BM; nwg = nM * nN; G = G_; c = c_; }
    __host__ __device__ bool next(int i, Unit& u) const {
        const long L = (long)i * G + c; if (L >= nwg) return false;
        int wgid = (int)L; { const int q = nwg / NXCD, r = nwg % NXCD, xcd = wgid % NXCD, off = wgid / NXCD; wgid = (xcd < r ? xcd * (q + 1) : r * (q + 1) + (xcd - r) * q) + off; }
        const int nig = WGM * nN, gid = wgid / nig, fm = gid * WGM, gsz = (nM - fm) < WGM ? (nM - fm) : WGM;
        u.pm = fm + ((wgid % nig) % gsz); u.pn = (wgid % nig) / gsz; return true;
    }
    __device__ __forceinline__ void a_ready(const Unit&) const {}
    __device__ __forceinline__ void done(const Unit&) const {}
};

__device__ __forceinline__ unsigned cvt_pk_bf16(float lo, float hi) { unsigned r; asm volatile("v_cvt_pk_bf16_f32 %0, %1, %2" : "=v"(r) : "v"(lo), "v"(hi)); return r; }
typedef float f32x2 __attribute__((ext_vector_type(2)));
template <class Epi, class Sched, bool ALIGN_EPI = false, bool SP2 = false>
__device__ __forceinline__ void gemm_phase(PG8_LAS unsigned char* lds, const Gemm g, const Sched& S, const Epi& E) {
    const int tid = threadIdx.x, wid = __builtin_amdgcn_readfirstlane(tid >> 6), lane = tid & 63, wr = wid >> 2, wc = wid & 3, fr = lane & 15, fq = lane >> 4;
    const int K = g.K, nt = K / BK;
    unsigned voffA[2], voffB[2];
#pragma unroll
    for (int i = 0; i < 2; ++i) { int R, C; stage_rc(tid * 16 + i * 8192, R, C); const int Rb = Epi::PERM ? ((R & ~31) + perm32(R & 31)) : R;
        voffA[i] = (unsigned)(R * K + C) * 2u; voffB[i] = (unsigned)(Rb * K + C) * 2u; }
    const size_t kstep = (size_t)(BK * 2);
    const size_t hstep = (size_t)HALF * K * 2;
    const size_t tstep = 2 * hstep;
    const unsigned ldsw = (unsigned)wid * 1024u;
    const int aoff = lds_byte(wr * 64 + fr, fq * 8), boff = lds_byte(wc * 32 + fr, fq * 8);
#define PG8_SA(b, h) (((b) * 2 + (h)) * HTB)
#define PG8_SB(b, h) ((4 + (b) * 2 + (h)) * HTB)
#define PG8_STAGE(bufoff, gbase, voff) do { _Pragma("unroll") for (int _i = 0; _i < 2; ++_i) \
        __builtin_amdgcn_global_load_lds((const unsigned*)((const char*)(gbase) + (voff)[_i]), (PG8_LAS unsigned*)(lds + (bufoff) + ldsw + _i * 8192), 16, 0, 0); } while (0)
#define PG8_LDA(dst, b, h) do { _Pragma("unroll") for (int m = 0; m < 4; ++m) _Pragma("unroll") for (int k = 0; k < 2; ++k) dst[m][k] = *(const PG8_LAS bf16x8*)(lds + PG8_SA(b, h) + aoff + m * 2048 + k * 1024); } while (0)
#define PG8_LDB(dst, b, h) do { _Pragma("unroll") for (int n = 0; n < 2; ++n) _Pragma("unroll") for (int k = 0; k < 2; ++k) dst[n][k] = *(const PG8_LAS bf16x8*)(lds + PG8_SB(b, h) + boff + n * 2048 + k * 1024); } while (0)
#define PG8_MMA(ai, bj, At, Bt) do { __builtin_amdgcn_s_setprio(1); _Pragma("unroll") for (int m = 0; m < 4; ++m) _Pragma("unroll") for (int n = 0; n < 2; ++n) _Pragma("unroll") for (int k = 0; k < 2; ++k) \
        acc[ai][bj][m][n] = __builtin_amdgcn_mfma_f32_16x16x32_bf16(Bt[n][k], At[m][k], acc[ai][bj][m][n], 0, 0, 0); __builtin_amdgcn_s_setprio(0); } while (0)
#define PG8_WAIT_V(n) asm volatile("s_waitcnt vmcnt(" #n ")" ::: "memory")
#define PG8_WAIT_L(n) asm volatile("s_waitcnt lgkmcnt(" #n ")" ::: "memory")
#define PG8_BAR __builtin_amdgcn_s_barrier()
#define PG8_SCHED __builtin_amdgcn_sched_barrier(0)
    Unit cur, nxt; int ui = 0;
    if (!S.next(0, cur)) return;
    f32x4 acc[2][2][4][2];
#pragma unroll
    for (int a = 0; a < 2; ++a)
#pragma unroll
        for (int b = 0; b < 2; ++b)
#pragma unroll
            for (int m = 0; m < 4; ++m)
#pragma unroll
                for (int n = 0; n < 2; ++n) acc[a][b][m][n] = (f32x4){0.f, 0.f, 0.f, 0.f};
    bf16x8 At[4][2], B0[2][2], B1[2][2];
    const char* cA = (const char*)g.A + (size_t)cur.pm * tstep; const char* cB = (const char*)g.Bt + (size_t)cur.pn * tstep;
    S.a_ready(cur);
    if constexpr (SP2) {
        PG8_STAGE(PG8_SB(0, 0), cB, voffB); PG8_STAGE(PG8_SB(0, 1), cB + hstep, voffB); PG8_STAGE(PG8_SA(0, 0), cA, voffA); PG8_STAGE(PG8_SA(0, 1), cA + hstep, voffA);
        if (wr == 1) PG8_BAR;
        PG8_WAIT_V(2); PG8_BAR;
        PG8_STAGE(PG8_SB(1, 0), cB + kstep, voffB); PG8_STAGE(PG8_SA(1, 0), cA + kstep, voffA); PG8_STAGE(PG8_SB(1, 1), cB + hstep + kstep, voffB);
        PG8_WAIT_V(6); PG8_BAR;
    } else {
        PG8_STAGE(PG8_SB(0, 0), cB, voffB); PG8_STAGE(PG8_SA(0, 0), cA, voffA); PG8_STAGE(PG8_SB(0, 1), cB + hstep, voffB); PG8_STAGE(PG8_SA(0, 1), cA + hstep, voffA);
        if (wr == 1) PG8_BAR;
        PG8_WAIT_V(4); PG8_BAR;
        PG8_STAGE(PG8_SB(1, 0), cB + kstep, voffB); PG8_STAGE(PG8_SA(1, 0), cA + kstep, voffA); PG8_STAGE(PG8_SB(1, 1), cB + hstep + kstep, voffB);
        PG8_WAIT_V(6); PG8_BAR;
    }
    for (;;) {
        const bool has_next = S.next(ui + 1, nxt);
        const char* nA = has_next ? (const char*)g.A + (size_t)nxt.pm * tstep : cA; const char* nB = has_next ? (const char*)g.Bt + (size_t)nxt.pn * tstep : cB;
        for (int t = 0; t < nt; t += 2) {
            const bool last = (t == nt - 2);
            const char* a1 = cA + (size_t)(t + 1) * kstep;
            const char* a2 = last ? nA : cA + (size_t)(t + 2) * kstep; const char* b2 = last ? nB : cB + (size_t)(t + 2) * kstep;
            const char* a3 = a2 + kstep; const char* b3 = b2 + kstep;
            if (last && has_next) S.a_ready(nxt);
            if constexpr (SP2) {
            PG8_LDB(B0, 0, 0); PG8_LDB(B1, 0, 1); PG8_SCHED; PG8_LDA(At, 0, 0); PG8_STAGE(PG8_SA(1, 1), a1 + hstep, voffA);
            PG8_WAIT_V(8); PG8_WAIT_L(0); PG8_BAR; PG8_MMA(0, 0, At, B0); PG8_MMA(0, 1, At, B1); PG8_BAR; PG8_SCHED;
            PG8_LDA(At, 0, 1); PG8_STAGE(PG8_SB(0, 0), b2, voffB); PG8_STAGE(PG8_SB(0, 1), b2 + hstep, voffB); PG8_STAGE(PG8_SA(0, 0), a2, voffA);
            PG8_WAIT_V(8); PG8_WAIT_L(0); PG8_BAR; PG8_MMA(1, 0, At, B0); PG8_MMA(1, 1, At, B1); PG8_BAR; PG8_SCHED;
            PG8_LDB(B0, 1, 0); PG8_LDB(B1, 1, 1); PG8_SCHED; PG8_LDA(At, 1, 0); PG8_STAGE(PG8_SA(0, 1), a2 + hstep, voffA);
            PG8_WAIT_V(8); PG8_WAIT_L(0); PG8_BAR; PG8_MMA(0, 0, At, B0); PG8_MMA(0, 1, At, B1); PG8_BAR; PG8_SCHED;
            PG8_LDA(At, 1, 1); PG8_STAGE(PG8_SB(1, 0), b3, voffB); PG8_STAGE(PG8_SB(1, 1), b3 + hstep, voffB); PG8_STAGE(PG8_SA(1, 0), a3, voffA);
            PG8_WAIT_V(8); PG8_WAIT_L(0); PG8_BAR; PG8_MMA(1, 0, At, B0); PG8_MMA(1, 1, At, B1); PG8_BAR; PG8_SCHED;
            } else {
            PG8_LDB(B0, 0, 0); PG8_SCHED; PG8_LDA(At, 0, 0); PG8_STAGE(PG8_SA(1, 1), a1 + hstep, voffA);
            PG8_WAIT_L(8); PG8_BAR; PG8_WAIT_L(0); PG8_MMA(0, 0, At, B0); PG8_BAR; PG8_SCHED;
            PG8_LDB(B1, 0, 1); PG8_STAGE(PG8_SB(0, 0), b2, voffB);
            PG8_BAR; PG8_WAIT_L(0); PG8_MMA(0, 1, At, B1); PG8_BAR;
            PG8_LDA(At, 0, 1); PG8_STAGE(PG8_SA(0, 0), a2, voffA);
            PG8_BAR; PG8_WAIT_L(0); PG8_MMA(1, 0, At, B0); PG8_BAR; PG8_SCHED;
            PG8_STAGE(PG8_SB(0, 1), b2 + hstep, voffB);
            PG8_WAIT_V(6); PG8_BAR; PG8_MMA(1, 1, At, B1); PG8_BAR;
            PG8_LDB(B0, 1, 0); PG8_SCHED; PG8_LDA(At, 1, 0); PG8_STAGE(PG8_SA(0, 1), a2 + hstep, voffA);
            PG8_WAIT_L(8); PG8_BAR; PG8_WAIT_L(0); PG8_MMA(0, 0, At, B0); PG8_BAR; PG8_SCHED;
            PG8_LDB(B1, 1, 1); PG8_STAGE(PG8_SB(1, 0), b3, voffB);
            PG8_BAR; PG8_WAIT_L(0); PG8_MMA(0, 1, At, B1); PG8_BAR;
            PG8_LDA(At, 1, 1); PG8_STAGE(PG8_SA(1, 0), a3, voffA);
            PG8_BAR; PG8_WAIT_L(0); PG8_MMA(1, 0, At, B0); PG8_BAR; PG8_SCHED;
            PG8_STAGE(PG8_SB(1, 1), b3 + hstep, voffB);
            PG8_WAIT_V(6); PG8_BAR; PG8_MMA(1, 1, At, B1); PG8_BAR;
            }
        }
        if constexpr (ALIGN_EPI) { if (wr == 0) PG8_BAR; }
        if constexpr (!Epi::AFTER_DRAIN) { E(acc, cur, wr, wc, fr, fq); S.done(cur); }
        if (!has_next) break;
#pragma unroll
        for (int a = 0; a < 2; ++a)
#pragma unroll
            for (int b = 0; b < 2; ++b)
#pragma unroll
                for (int m = 0; m < 4; ++m)
#pragma unroll
                    for (int n = 0; n < 2; ++n) acc[a][b][m][n] = (f32x4){0.f, 0.f, 0.f, 0.f};
        cur = nxt; cA = nA; cB = nB; ++ui;
        if constexpr (ALIGN_EPI) { if (wr == 1) PG8_BAR; }
    }
    PG8_WAIT_V(0);
    if constexpr (!ALIGN_EPI) { if (wr == 0) PG8_BAR; }
    PG8_BAR;
    if constexpr (Epi::AFTER_DRAIN) { E.fused(acc, cur, wr, wc, fr, fq, lds, wid, lane); S.done(cur); }
#undef PG8_SA
#undef PG8_SB
#undef PG8_STAGE
#undef PG8_LDA
#undef PG8_LDB
#undef PG8_MMA
#undef PG8_WAIT_V
#undef PG8_WAIT_L
#undef PG8_BAR
#undef PG8_SCHED
}
}
namespace pg8 {
typedef unsigned u32x2v __attribute__((ext_vector_type(2)));
constexpr int TOK_S = 8192;
constexpr float QK_EPS = 1e-6f;
constexpr float C2 = 0.125f * 1.4426950408889634f;
__device__ __forceinline__ float sigmoid_fast(float v) { return 1.f / (1.f + __expf(-v)); }
__device__ __forceinline__ float silu_fast(float v) { return v / (1.f + __expf(-v)); }

struct EpiInProj {
    static constexpr bool PERM = true, AFTER_DRAIN = false;
    bf16_t* qkv;
    float* gates;
    float* kmean_part;
    const float *qna, *kna, *qnb, *knsel, *knwin;
    __device__ __forceinline__ void operator()(const f32x4 (&acc)[2][2][4][2], const Unit& u, int wr, int wc, int fr, int fq) const {
        const int slot = u.pn * 4 + wc;
        if (slot > 44) return;
        const int b = u.pm >> 5, blk = u.pm & 31, pos0 = blk * 256 + wr * 64 + fr;
        if (slot == 44) {
            if (fq < 3) {
#pragma unroll
                for (int ai = 0; ai < 2; ++ai)
#pragma unroll
                    for (int m = 0; m < 4; ++m) { const size_t tok = (size_t)b * TOK_S + pos0 + ai * HALF + m * 16; float* gp = gates + tok * 24 + 8 * fq;
                        const f32x4 v0 = acc[ai][0][m][0], v1 = acc[ai][0][m][1];
                        *(f32x4*)gp = (f32x4){sigmoid_fast(v0[0]), sigmoid_fast(v0[1]), sigmoid_fast(v0[2]), sigmoid_fast(v0[3])};
                        *(f32x4*)(gp + 4) = (f32x4){sigmoid_fast(v1[0]), sigmoid_fast(v1[1]), sigmoid_fast(v1[2]), sigmoid_fast(v1[3])}; }
            }
            return;
        }
        const float* gain = nullptr; float qscale = 1.f; bool is_ka = false; bf16_t* dst;
        constexpr size_t BIG = (size_t)4 * 8 * TOK_S * 64, SMALL = (size_t)4 * 2 * TOK_S * 64;
        if (slot < 32) { const int kind = slot >> 3, head = slot & 7; dst = qkv + kind * BIG + ((size_t)(b * 8 + head) * TOK_S) * 64;
            if (kind == 0) { gain = qna; qscale = C2; } else if (kind == 1) { gain = kna; is_ka = true; } else if (kind == 3) { gain = qnb; qscale = C2; } }
        else { const int kind = (slot - 32) >> 1, g = slot & 1; dst = qkv + 4 * BIG + kind * SMALL + ((size_t)(b * 2 + g) * TOK_S) * 64;
            if (kind == 2) gain = knsel; else if (kind == 4) gain = knwin; }
        float gv[16];
#pragma unroll
        for (int i = 0; i < 16; ++i) gv[i] = gain ? gain[(i >> 3) * 32 + 8 * fq + (i & 7)] * qscale : 1.f;
        float cs[16];
#pragma unroll
        for (int i = 0; i < 16; ++i) cs[i] = 0.f;
#pragma unroll
        for (int ai = 0; ai < 2; ++ai)
#pragma unroll
            for (int m = 0; m < 4; ++m) {
                float v[16];
#pragma unroll
                for (int bj = 0; bj < 2; ++bj)
#pragma unroll
                    for (int n = 0; n < 2; ++n)
#pragma unroll
                        for (int j = 0; j < 4; ++j) v[bj * 8 + n * 4 + j] = acc[ai][bj][m][n][j];
                if (gain) { float ss = 0.f;
#pragma unroll
                    for (int i = 0; i < 16; ++i) ss += v[i] * v[i];
                    ss += __shfl_xor(ss, 16); ss += __shfl_xor(ss, 32);
                    const float rs = rsqrtf(ss * (1.f / 64.f) + QK_EPS);
#pragma unroll
                    for (int i = 0; i < 16; ++i) v[i] *= rs * gv[i]; }
                if (is_ka) {
#pragma unroll
                    for (int i = 0; i < 16; ++i) cs[i] += v[i]; }
                bf16_t* rp = dst + (size_t)(pos0 + ai * HALF + m * 16) * 64 + 8 * fq;
                u32x4 w0, w1;
                w0.x = cvt_pk_bf16(v[0], v[1]); w0.y = cvt_pk_bf16(v[2], v[3]); w0.z = cvt_pk_bf16(v[4], v[5]); w0.w = cvt_pk_bf16(v[6], v[7]);
                w1.x = cvt_pk_bf16(v[8], v[9]); w1.y = cvt_pk_bf16(v[10], v[11]); w1.z = cvt_pk_bf16(v[12], v[13]); w1.w = cvt_pk_bf16(v[14], v[15]);
                *(u32x4*)rp = w0; *(u32x4*)(rp + 32) = w1;
            }
        if (is_ka) {
#pragma unroll
            for (int i = 0; i < 16; ++i) { float s = cs[i]; s += __shfl_xor(s, 1); s += __shfl_xor(s, 2); s += __shfl_xor(s, 4); s += __shfl_xor(s, 8); cs[i] = s; }
            if (fr == 0) { float* kp = kmean_part + ((size_t)((b * 8 + (slot & 7)) * 32 + blk) * 2 + wr) * 64 + 8 * fq;
                *(f32x4*)kp = (f32x4){cs[0], cs[1], cs[2], cs[3]}; *(f32x4*)(kp + 4) = (f32x4){cs[4], cs[5], cs[6], cs[7]};
                *(f32x4*)(kp + 32) = (f32x4){cs[8], cs[9], cs[10], cs[11]}; *(f32x4*)(kp + 36) = (f32x4){cs[12], cs[13], cs[14], cs[15]}; }
        }
    }
};
struct EpiOutProj {
    static constexpr bool PERM = false, AFTER_DRAIN = false;
    const float* x; float* out; const float* gt;
    __device__ __forceinline__ void operator()(const f32x4 (&acc)[2][2][4][2], const Unit& u, int wr, int wc, int fr, int fq) const {
        const int b = u.pm >> 5; const int col0 = u.pn * BM + wc * 32 + 4 * fq; const float* gtb = gt + (size_t)b * 6144;
#pragma unroll
        for (int bj = 0; bj < 2; ++bj)
#pragma unroll
            for (int n = 0; n < 2; ++n) { const int c = col0 + bj * HALF + n * 16; const f32x4 g4 = *(const f32x4*)(gtb + c);
#pragma unroll
                for (int ai = 0; ai < 2; ++ai)
#pragma unroll
                    for (int m = 0; m < 4; ++m) { const size_t off = (size_t)(u.pm * BM + ai * HALF + wr * 64 + m * 16 + fr) * 1024 + c;
                        const f32x4 xv = *(const f32x4*)(x + off); *(f32x4*)(out + off) = xv + g4 * acc[ai][bj][m][n]; } }
    }
};
struct EpiGateUp {
    static constexpr bool PERM = true, AFTER_DRAIN = false;
    bf16_t* act;
    __device__ __forceinline__ void operator()(const f32x4 (&acc)[2][2][4][2], const Unit& u, int wr, int wc, int fr, int fq) const {
        const int h0 = u.pn * 128 + wc * 32 + 8 * fq;
#pragma unroll
        for (int ai = 0; ai < 2; ++ai)
#pragma unroll
            for (int m = 0; m < 4; ++m) { const size_t row = (size_t)(u.pm * BM + ai * HALF + wr * 64 + m * 16 + fr);
                const f32x4 g0 = acc[ai][0][m][0], g1 = acc[ai][0][m][1], u0 = acc[ai][1][m][0], u1 = acc[ai][1][m][1];
                u32x4 w;
                w.x = cvt_pk_bf16(silu_fast(g0[0]) * u0[0], silu_fast(g0[1]) * u0[1]); w.y = cvt_pk_bf16(silu_fast(g0[2]) * u0[2], silu_fast(g0[3]) * u0[3]);
                w.z = cvt_pk_bf16(silu_fast(g1[0]) * u1[0], silu_fast(g1[1]) * u1[1]); w.w = cvt_pk_bf16(silu_fast(g1[2]) * u1[2], silu_fast(g1[3]) * u1[3]);
                *(u32x4*)(act + row * 2816 + h0) = w; }
    }
};
struct EpiDown {
    static constexpr bool PERM = false, AFTER_DRAIN = false;
    float* out; const float* gt;
    __device__ __forceinline__ void operator()(const f32x4 (&acc)[2][2][4][2], const Unit& u, int wr, int wc, int fr, int fq) const {
        const int b = u.pm >> 5; const int col0 = u.pn * BM + wc * 32 + 4 * fq; const float* gtb = gt + (size_t)b * 6144;
#pragma unroll
        for (int bj = 0; bj < 2; ++bj)
#pragma unroll
            for (int n = 0; n < 2; ++n) { const int c = col0 + bj * HALF + n * 16; const f32x4 g4 = *(const f32x4*)(gtb + c);
#pragma unroll
                for (int ai = 0; ai < 2; ++ai)
#pragma unroll
                    for (int m = 0; m < 4; ++m) { const size_t off = (size_t)(u.pm * BM + ai * HALF + wr * 64 + m * 16 + fr) * 1024 + c;
                        const f32x4 xv = *(const f32x4*)(out + off); *(f32x4*)(out + off) = xv + g4 * acc[ai][bj][m][n]; } }
    }
};
}
constexpr int NWAVES = 8, NTHREADS = 512;
constexpr int BATCH = 4, SEQ = 8192, DM = 1024, TOK = BATCH * SEQ, NIN = 2840, NIN_PAD = 3072, FF = 2816, NCMP = 511;
constexpr size_t MiB = 1u << 20;
constexpr size_t WS_CTL = 0, CTL_ZERO_BYTES = 64 * 1024;
constexpr size_t WS_MODP = 1 * MiB;
constexpr size_t WS_MOD = 2 * MiB;
constexpr size_t WS_CBP = 2 * MiB + 512 * 1024;
constexpr size_t WS_KMP = 3 * MiB;
constexpr size_t WS_WIN = 6 * MiB, WS_WOUT = 12 * MiB, WS_WGU = 14 * MiB, WS_WDN = 25 * MiB;
constexpr size_t WS_W1K = 31 * MiB, WS_W1V = 32 * MiB, WS_W2K = 33 * MiB, WS_W2V = 33 * MiB + 64 * 1024;
constexpr size_t WS_KCMP = 34 * MiB, WS_VCMP = 35 * MiB;
constexpr size_t WS_GATES = 36 * MiB;
constexpr size_t WS_H = 40 * MiB;
constexpr size_t WS_MIX = 104 * MiB;
constexpr size_t WS_QKV = 168 * MiB;
constexpr size_t WS_ACT = WS_QKV;
constexpr size_t WS_END = 344 * MiB;
constexpr size_t WS_PARTO = 344 * MiB;
constexpr size_t WS_PARTL = 444 * MiB;
constexpr size_t WS_SELG = 448 * MiB;
constexpr size_t QKV_BIG = (size_t)4 * 8 * SEQ * 64, QKV_SMALL = (size_t)4 * 2 * SEQ * 64;
constexpr int RING_BYTES = 131072, LDS_BYTES = 147456;
constexpr int N_PHASES = 10;

#define GAS __attribute__((address_space(1)))
#define LAS __attribute__((address_space(3)))
typedef unsigned short bf16;
typedef unsigned v4u __attribute__((ext_vector_type(4)));
typedef float f32x4 __attribute__((ext_vector_type(4)));
#define LDS_WAIT() asm volatile("s_waitcnt lgkmcnt(0)" ::: "memory")
#define VM_WAIT() asm volatile("s_waitcnt vmcnt(0)" ::: "memory")
__device__ __forceinline__ unsigned f2bf(float f) { unsigned u = __builtin_bit_cast(unsigned, f); return (u + 0x7fffu + ((u >> 16) & 1u)) >> 16; }
__device__ __forceinline__ unsigned pk2(float lo, float hi) { return f2bf(lo) | (f2bf(hi) << 16); }
__device__ __forceinline__ float bf2f(bf16 v) { return __builtin_bit_cast(float, (unsigned)v << 16); }
__device__ __forceinline__ float wave_sum(float v) {
#pragma unroll
    for (int o = 1; o < 64; o <<= 1) v += __shfl_xor(v, o);
    return v;
}
struct Args { const float* in[23]; float* out; unsigned char* ws; int ph_lo, ph_hi; };
struct Frame { LAS unsigned char* lds; int tid, lane, wave, vcu, G; };

struct MapId { __device__ __forceinline__ int operator()(int n) const { return n; } };
struct MapWin { __device__ __forceinline__ int operator()(int n) const { const int s = n >> 6, d = n & 63; return 256 * (s >> 2) + 128 * (d >> 5) + 32 * (s & 3) + (d & 31); } };
struct MapWgu { __device__ __forceinline__ int operator()(int n) const { const int up = n >= FF, hdn = up ? n - FF : n; return 256 * (hdn >> 7) + 128 * up + (hdn & 127); } };
template <class Map>
__device__ __forceinline__ void transpose_item(const float* __restrict__ W, int K, int N, bf16* WT, LAS float* scr, int item, int lane, const Map& map) {
    const int nblk = (N + 31) / 32, kb = item / nblk, nb = item % nblk, k0 = 64 * kb, n0 = 32 * nb;
    const bool nin = n0 + (lane & 31) < N;
#pragma unroll 8
    for (int i = 0; i < 32; ++i) { const int kk = 2 * i + (lane >> 5); scr[kk * 33 + (lane & 31)] = nin ? W[(size_t)(k0 + kk) * N + n0 + (lane & 31)] : 0.f; }
    LDS_WAIT(); asm volatile("" ::: "memory");
    const int c = lane & 7;
#pragma unroll
    for (int j = 0; j < 4; ++j) { const int n = (lane >> 3) + 8 * j; const LAS float* s = scr + (8 * c) * 33 + n;
        v4u o; o.x = pk2(s[0 * 33], s[1 * 33]); o.y = pk2(s[2 * 33], s[3 * 33]); o.z = pk2(s[4 * 33], s[5 * 33]); o.w = pk2(s[6 * 33], s[7 * 33]);
        if (n0 + n < N) *(GAS v4u*)(WT + (size_t)map(n0 + n) * K + k0 + 8 * c) = o; }
    LDS_WAIT(); asm volatile("" ::: "memory");
}
__device__ __forceinline__ float silu_acc(float v) { return v / (1.f + expf(-v)); }
__device__ __forceinline__ void phase_prologue_a(Frame& F, const Args& a) {
    LAS float* scr = (LAS float*)(F.lds + F.wave * 16384);
    const int gw = F.vcu * NWAVES + F.wave, NGW = F.G * NWAVES;
    unsigned char* ws = a.ws;
    constexpr int I_IN = (DM / 64) * ((NIN + 31) / 32), I_OUT = (DM / 64) * (DM / 32), I_GU = (DM / 64) * (2 * FF / 32), I_DN = (FF / 64) * (DM / 32), I_W1 = (2048 / 64) * (256 / 32), I_W2 = (256 / 64) * (64 / 32);
    constexpr int NITEMS = I_IN + I_OUT + I_GU + I_DN + 2 * I_W1 + 2 * I_W2;
    for (int it = gw; it < NITEMS; it += NGW) {
        int r = it;
        if (r < I_IN) { transpose_item(a.in[6], DM, NIN, (bf16*)(ws + WS_WIN), scr, r, F.lane, MapWin()); continue; } r -= I_IN;
        if (r < I_OUT) { transpose_item(a.in[19], DM, DM, (bf16*)(ws + WS_WOUT), scr, r, F.lane, MapId()); continue; } r -= I_OUT;
        if (r < I_GU) { transpose_item(a.in[21], DM, 2 * FF, (bf16*)(ws + WS_WGU), scr, r, F.lane, MapWgu()); continue; } r -= I_GU;
        if (r < I_DN) { transpose_item(a.in[22], FF, DM, (bf16*)(ws + WS_WDN), scr, r, F.lane, MapId()); continue; } r -= I_DN;
        if (r < I_W1) { transpose_item(a.in[14], 2048, 256, (bf16*)(ws + WS_W1K), scr, r, F.lane, MapId()); continue; } r -= I_W1;
        if (r < I_W1) { transpose_item(a.in[17], 2048, 256, (bf16*)(ws + WS_W1V), scr, r, F.lane, MapId()); continue; } r -= I_W1;
        if (r < I_W2) { transpose_item(a.in[15], 256, 64, (bf16*)(ws + WS_W2K), scr, r, F.lane, MapId()); continue; } r -= I_W2;
        transpose_item(a.in[18], 256, 64, (bf16*)(ws + WS_W2V), scr, r, F.lane, MapId());
    }
    const float* c = a.in[1]; const float* w_ada = a.in[3]; float* modp = (float*)(ws + WS_MODP);
    for (int t = NGW - 1 - gw; t < 96 * 8; t += NGW) { const int cg_ = t % 96, ks = t / 96; const int n = cg_ * 64 + F.lane;
        float acc0 = 0.f, acc1 = 0.f, acc2 = 0.f, acc3 = 0.f;
#pragma unroll 8
        for (int k = ks * 128; k < ks * 128 + 128; ++k) { const float w = w_ada[(size_t)k * 6144 + n];
            acc0 += silu_acc(c[k]) * w; acc1 += silu_acc(c[DM + k]) * w; acc2 += silu_acc(c[2 * DM + k]) * w; acc3 += silu_acc(c[3 * DM + k]) * w; }
        float* o = modp + (size_t)ks * 4 * 6144 + n; o[0] = acc0; o[6144] = acc1; o[2 * 6144] = acc2; o[3 * 6144] = acc3; }
    float* cbp = (float*)(ws + WS_CBP);
    for (int t = NGW / 2 - 1 - gw; t >= 0 && t < 256; t += NGW) { const int kv = t & 1, cg_ = (t >> 1) & 3, ic = t >> 3; const int n = cg_ * 64 + F.lane;
        const float* pe = kv ? a.in[16] : a.in[13]; const float* w1 = kv ? a.in[17] : a.in[14]; float acc = 0.f;
#pragma unroll 8
        for (int i = ic * 64; i < ic * 64 + 64; ++i) acc += pe[i] * w1[(size_t)i * 256 + n];
        cbp[(ic * 2 + kv) * 256 + n] = acc; }
}
__device__ __forceinline__ void norm_rows(Frame& F, const float* in, const f32x4 (&gs)[4], const f32x4 (&sh)[4], bf16* out) {
    for (int i = 0; i < 16; ++i) { const int row = F.vcu * 128 + F.wave * 16 + i;
        const GAS f32x4* xr = (const GAS f32x4*)(in + (size_t)row * DM) + F.lane;
        f32x4 v[4]; float ss = 0.f;
#pragma unroll
        for (int j = 0; j < 4; ++j) { v[j] = xr[64 * j]; ss += (v[j].x * v[j].x + v[j].y * v[j].y) + (v[j].z * v[j].z + v[j].w * v[j].w); }
        const float rs = rsqrtf(wave_sum(ss) * (1.f / DM) + 1e-6f);
        GAS unsigned long long* o8 = (GAS unsigned long long*)(out + (size_t)row * DM) + F.lane;
#pragma unroll
        for (int j = 0; j < 4; ++j) { const f32x4 y = v[j] * rs * gs[j] + sh[j]; o8[64 * j] = (unsigned long long)pk2(y.x, y.y) | ((unsigned long long)pk2(y.z, y.w) << 32); } }
}
__device__ __forceinline__ void phase_prologue_b(Frame& F, const Args& a) {
    unsigned char* ws = a.ws; const float* modp = (const float*)(ws + WS_MODP); const float* b_ada = a.in[4];
    if (F.wave == 0 && F.vcu < 96) { const int n = F.vcu * 64 + F.lane; float* mod = (float*)(ws + WS_MOD);
        for (int b = 0; b < 4; ++b) { float s = 0.f;
#pragma unroll
            for (int ks = 0; ks < 8; ++ks) s += modp[((size_t)ks * 4 + b) * 6144 + n];
            mod[b * 6144 + n] = s + b_ada[n]; } }
    const int b = F.vcu >> 6; const float* g = a.in[5];
    f32x4 gs[4], sh[4];
#pragma unroll
    for (int j = 0; j < 4; ++j) { const int c0 = 4 * F.lane + 256 * j; f32x4 s0 = {0.f, 0.f, 0.f, 0.f}, s1 = {0.f, 0.f, 0.f, 0.f};
#pragma unroll
        for (int ks = 0; ks < 8; ++ks) { s0 += *(const f32x4*)(modp + ((size_t)ks * 4 + b) * 6144 + c0); s1 += *(const f32x4*)(modp + ((size_t)ks * 4 + b) * 6144 + DM + c0); }
        s0 += *(const f32x4*)(b_ada + c0); s1 += *(const f32x4*)(b_ada + DM + c0);
        sh[j] = s0; gs[j] = *(const f32x4*)(g + c0) * (s1 + 1.0f); }
    norm_rows(F, a.in[0], gs, sh, (bf16*)(ws + WS_H));
}
__device__ __forceinline__ void phase_norm2(Frame& F, const Args& a) {
    unsigned char* ws = a.ws; const int b = F.vcu >> 6; const float* mod = (const float*)(ws + WS_MOD) + (size_t)b * 6144; const float* g = a.in[20];
    f32x4 gs[4], sh[4];
#pragma unroll
    for (int j = 0; j < 4; ++j) { const int c0 = 4 * F.lane + 256 * j; sh[j] = *(const f32x4*)(mod + 3 * DM + c0); gs[j] = *(const f32x4*)(g + c0) * (*(const f32x4*)(mod + 4 * DM + c0) + 1.0f); }
    norm_rows(F, a.out, gs, sh, (bf16*)(ws + WS_H));
}
#define XB_TMO      128
#define XB_XCNT(j)  (256  + 64 * (j))
#define XB_XSUB(j)  (1280 + 64 * (j))
#define XB_XGEN(j)  (2304 + 64 * (j))
#define XB_TOP      3328
#define XB_TOPGEN   3392
#define XCD_BAR_WORDS 3456
#define XB_SPIN_CAP (1u << 18)

__device__ __forceinline__ unsigned xb_ld(unsigned* p)              { return __hip_atomic_load(p, __ATOMIC_RELAXED, __HIP_MEMORY_SCOPE_AGENT); }
__device__ __forceinline__ unsigned xb_add(unsigned* p, unsigned v) { return __hip_atomic_fetch_add(p, v, __ATOMIC_RELAXED, __HIP_MEMORY_SCOPE_AGENT); }
__device__ __forceinline__ unsigned xb_xcc_id() { return (unsigned)__builtin_amdgcn_s_getreg((3 << 11) | 20) & 0xFu; }
#define XB_SPIN(cond, bar) do { unsigned _sp = 0; while (cond) { __builtin_amdgcn_s_sleep(1); \
    if ((++_sp & 255u) == 0u) { if (xb_ld(&(bar)[XB_TMO])) break; if (_sp > XB_SPIN_CAP) { atomicAdd(&(bar)[XB_TMO], 1u); break; } } } } while (0)

struct XcdBarrier {
    unsigned* bar; unsigned x;
    volatile LAS unsigned* st;
};

__device__ __forceinline__ XcdBarrier xcd_barrier_post(unsigned* bar, volatile LAS unsigned* st) {
    XcdBarrier b; b.bar = bar; b.x = xb_xcc_id(); b.st = st;
    if (threadIdx.x == 0) (void)xb_add(&bar[XB_XCNT(b.x)], 1u);
    return b;
}
__device__ __forceinline__ void xcd_barrier_complete(unsigned* bar, unsigned x, unsigned& nloc, unsigned& nx) {
    const unsigned G = gridDim.x * gridDim.y * gridDim.z;
    unsigned sum, cnt, mine, sp = 0u;
    for (;;) {
        sum = 0u; cnt = 0u; mine = 0u;
#pragma unroll
        for (unsigned j = 0; j < 16; ++j) { const unsigned c = xb_ld(&bar[XB_XCNT(j)]); sum += c; cnt += (c > 0u) ? 1u : 0u; mine = (j == x) ? c : mine; }
        if (sum == G) break;
        __builtin_amdgcn_s_sleep(1);
        if ((++sp & 255u) == 0u) { if (xb_ld(&bar[XB_TMO])) break; if (sp > XB_SPIN_CAP) { atomicAdd(&bar[XB_TMO], 1u); break; } }
    }
    nloc = mine > 0u ? mine : 1u; nx = cnt > 0u ? cnt : 1u;
}

__device__ __forceinline__ void xcd_barrier(const XcdBarrier& b) {
    asm volatile("s_waitcnt vmcnt(0)" ::: "memory");
    __syncthreads();
    if (threadIdx.x == 0) {
        unsigned* bar = b.bar;
        __builtin_amdgcn_s_waitcnt(0);
        unsigned nloc = b.st[0], nx = b.st[1];
        if (nloc == 0u) { xcd_barrier_complete(bar, b.x, nloc, nx); b.st[0] = nloc; b.st[1] = nx; }
        const unsigned old = xb_add(&bar[XB_XSUB(b.x)], 1u);
        const unsigned gen = old / nloc;
        if (old + 1u == (gen + 1u) * nloc) {
            __builtin_amdgcn_fence(__ATOMIC_RELEASE, "agent");
            asm volatile("s_waitcnt vmcnt(0)" ::: "memory");
            const unsigned og = xb_add(&bar[XB_TOP], 1u);
            const unsigned tg = og / nx;
            if (og + 1u == (tg + 1u) * nx) xb_add(&bar[XB_TOPGEN], 1u);
            else XB_SPIN(xb_ld(&bar[XB_TOPGEN]) == tg, bar);
            __builtin_amdgcn_fence(__ATOMIC_ACQUIRE, "agent");
            xb_add(&bar[XB_XGEN(b.x)], 1u);
            asm volatile("s_waitcnt vmcnt(0)" ::: "memory");
        } else {
            XB_SPIN(xb_ld(&bar[XB_XGEN(b.x)]) == gen, bar);
            __builtin_amdgcn_fence(__ATOMIC_ACQUIRE, "agent");
            asm volatile("s_waitcnt vmcnt(0)" ::: "memory");
        }
    }
    __syncthreads();
}
#define ATT_NS att
#ifndef ATT_ABL
#define ATT_ABL 0
#endif
#ifndef ATT_STAGGER
#define ATT_STAGGER 0
#endif
namespace ATT_NS {
using bf16x8 = __attribute__((ext_vector_type(8))) short;
using s16x4 = __attribute__((ext_vector_type(4))) short;
using f32x16 = __attribute__((ext_vector_type(16))) float;
using u32x4 = __attribute__((ext_vector_type(4))) unsigned;
typedef LAS const char* lds_cptr;
typedef short v4i16_t __attribute__((ext_vector_type(4)));
constexpr int SLOT = 16384, NSLOT = 4, LDS_OST = 65536, LDS_LUT = 98304, LDS_IMP = 100352, LDS_SELM = 133120, LDS_MISC = 134144, LDS_WSF = 134400, LDS_ATT_END = 136448;
constexpr float LOG2E = 1.4426950408889634f;
#define MFMA32(a, b, c) __builtin_amdgcn_mfma_f32_32x32x16_bf16(a, b, c, 0, 0, 0)
#define ATT_WAIT_BAR(N) asm volatile("s_waitcnt vmcnt(" #N ") lgkmcnt(0)\n\ts_barrier" ::: "memory")
__device__ __forceinline__ void glds16(const void* gsrc, unsigned lds_dst) { unsigned keep;
    asm volatile("s_mov_b32 %0, m0\n\ts_mov_b32 m0, %2\n\ts_nop 0\n\tglobal_load_lds_dwordx4 %1, off\n\ts_mov_b32 m0, %0" : "=&s"(keep) : "v"(gsrc), "s"(lds_dst) : "memory"); }
typedef float f32x2_t __attribute__((ext_vector_type(2))); typedef __bf16 bf16x2_t __attribute__((ext_vector_type(2)));
__device__ __forceinline__ unsigned cvtpk(float lo, float hi) { f32x2_t v = {lo, hi}; bf16x2_t b = __builtin_convertvector(v, bf16x2_t); return __builtin_bit_cast(unsigned, b); }
__device__ __forceinline__ s16x4 vtr(lds_cptr p) { return __builtin_bit_cast(s16x4, __builtin_amdgcn_ds_read_tr16_b64_v4i16((LAS v4i16_t*)p)); }
__device__ __forceinline__ int t5_bucket(int d) {
    if (d < 16) return d;
    int b = 16;
    b += (d >= 19); b += (d >= 21); b += (d >= 24); b += (d >= 27); b += (d >= 31); b += (d >= 35); b += (d >= 40); b += (d >= 46);
    b += (d >= 52); b += (d >= 59); b += (d >= 67); b += (d >= 77); b += (d >= 87); b += (d >= 99); b += (d >= 113);
    return b;
}
struct Ctx { LAS char* lds; int wid; int lane, r32, hi; };
__device__ __forceinline__ int fresh_lane() { int l; asm volatile("v_mbcnt_lo_u32_b32 %0, -1, 0\n\tv_mbcnt_hi_u32_b32 %0, -1, %0" : "=v"(l)); return l; }
__device__ __forceinline__ Ctx make_ctx(LAS unsigned char* lds, int tid) {
    Ctx c; c.lds = (LAS char*)lds; c.wid = __builtin_amdgcn_readfirstlane(tid >> 6); c.lane = tid & 63; c.r32 = c.lane & 31; c.hi = c.lane >> 5; return c;
}
template <bool HASV, class QK, class SM>
__device__ __forceinline__ void run_stream(const Ctx& c, const bf16* Kb, const bf16* Vb, int t0, int t1, QK&& qk, SM&& sm) {
    const int n = t1 - t0; if (n <= 0) return;
    const int lane = fresh_lane(), r32 = lane & 31, hi = lane >> 5; const unsigned lds0 = (unsigned)(uintptr_t)c.lds;
    const bf16* ks = Kb + (lane * 64 + c.wid * 8); const bf16* vs = Vb + ((16 * (c.wid & 3) + (lane >> 2)) * 64 + (c.wid >> 2) * 32 + (lane & 3) * 8);
    const unsigned kdst = lds0 + c.wid * 1024, vdst = lds0 + 8192 + c.wid * 1024;
    const lds_cptr kp0 = (lds_cptr)c.lds + hi * 1024 + r32 * 16;
    const lds_cptr vp0 = (lds_cptr)c.lds + 8192 + ((lane >> 4) & 1) * 32 + (lane & 3) * 8 + (4 * hi + ((lane & 15) >> 2)) * 64;
#define ATT_ISSUE(t, so) do { if (ATT_ABL & 4) break; glds16(ks + (size_t)(t) * 4096, (unsigned)__builtin_amdgcn_readfirstlane(kdst + (so))); if (HASV) glds16(vs + (size_t)(t) * 4096, (unsigned)__builtin_amdgcn_readfirstlane(vdst + (so))); } while (0)
    ATT_ISSUE(t0, 0); if (n > 1) ATT_ISSUE(t0 + 1, SLOT);
    const bool late = ATT_STAGGER && __builtin_amdgcn_readfirstlane(c.wid) >= 4;
    f32x16 s0 = {}, s1 = {};
    int slot = 0, slotp = 3 * SLOT, slot2 = 2 * SLOT;
    if (!late) {
        for (int i = 0; i < n; ++i) {
            if (i + 1 < n) { if (HASV) ATT_WAIT_BAR(2); else ATT_WAIT_BAR(1); } else ATT_WAIT_BAR(0);
            if (i + 2 < n) ATT_ISSUE(t0 + i + 2, slot2);
            if (!(ATT_ABL & 1)) qk(t0 + i, kp0 + slot, s0, s1); if (!(ATT_ABL & 2)) sm(t0 + i, vp0 + slot, s0, s1);
            slot = (slot == 3 * SLOT) ? 0 : slot + SLOT; slot2 = (slot2 == 3 * SLOT) ? 0 : slot2 + SLOT;
        }
    } else {
        for (int i = 0; i < n; ++i) {
            if (i + 1 < n) { if (HASV) ATT_WAIT_BAR(2); else ATT_WAIT_BAR(1); } else ATT_WAIT_BAR(0);
            if (i + 2 < n) ATT_ISSUE(t0 + i + 2, slot2);
            if (i > 0 && !(ATT_ABL & 2)) sm(t0 + i - 1, vp0 + slotp, s0, s1);
            if (!(ATT_ABL & 1)) qk(t0 + i, kp0 + slot, s0, s1);
            slotp = slot; slot = (slot == 3 * SLOT) ? 0 : slot + SLOT; slot2 = (slot2 == 3 * SLOT) ? 0 : slot2 + SLOT;
        }
        if (!(ATT_ABL & 2)) sm(t0 + n - 1, vp0 + slotp, s0, s1);
    }
    asm volatile("s_waitcnt lgkmcnt(0)\n\ts_barrier" ::: "memory");
#undef ATT_ISSUE
}
__device__ __forceinline__ void qk_tile(f32x16& s0, f32x16& s1, lds_cptr kp, const bf16x8 (&qr)[4]) {
    bf16x8 kf[8];
#pragma unroll
    for (int d0 = 0; d0 < 4; ++d0) { kf[2 * d0] = *(const LAS bf16x8*)(kp + d0 * 2048); kf[2 * d0 + 1] = *(const LAS bf16x8*)(kp + d0 * 2048 + 512); }
    const f32x16 z = {};
    s0 = MFMA32(kf[0], qr[0], z); s1 = MFMA32(kf[1], qr[0], z);
#pragma unroll
    for (int d0 = 1; d0 < 4; ++d0) { s0 = MFMA32(kf[2 * d0], qr[d0], s0); s1 = MFMA32(kf[2 * d0 + 1], qr[d0], s1); }
}
template <bool MASK>
__device__ __forceinline__ void pv_tile(f32x16 (&o)[2], lds_cptr vp, const f32x16& p0, const f32x16& p1, unsigned mask) {
    if (ATT_ABL & 8) { o[0][0] += p0[0] + p1[5]; return; }
    u32x4 pw0 = {cvtpk(p0[0], p0[1]), cvtpk(p0[2], p0[3]), cvtpk(p0[4], p0[5]), cvtpk(p0[6], p0[7])}, pw1 = {cvtpk(p0[8], p0[9]), cvtpk(p0[10], p0[11]), cvtpk(p0[12], p0[13]), cvtpk(p0[14], p0[15])};
    u32x4 pw2 = {cvtpk(p1[0], p1[1]), cvtpk(p1[2], p1[3]), cvtpk(p1[4], p1[5]), cvtpk(p1[6], p1[7])}, pw3 = {cvtpk(p1[8], p1[9]), cvtpk(p1[10], p1[11]), cvtpk(p1[12], p1[13]), cvtpk(p1[14], p1[15])};
    if (MASK) { pw0 &= mask; pw1 &= mask; pw2 &= mask; pw3 &= mask; }
    if (ATT_ABL & 64) { o[0] = MFMA32(__builtin_bit_cast(bf16x8, pw0), __builtin_bit_cast(bf16x8, pw1), o[0]); o[1] = MFMA32(__builtin_bit_cast(bf16x8, pw2), __builtin_bit_cast(bf16x8, pw3), o[1]); return; }
    s16x4 vlo[8], vhi[8];
#pragma unroll
    for (int i = 0; i < 8; ++i) { vlo[i] = vtr(vp + ((i >> 2) * 4096 + (i & 3) * 1024)); vhi[i] = vtr(vp + ((i >> 2) * 4096 + (i & 3) * 1024 + 512)); }
#define ATT_VFR(i) (bf16x8){vlo[i][0], vlo[i][1], vlo[i][2], vlo[i][3], vhi[i][0], vhi[i][1], vhi[i][2], vhi[i][3]}
    o[0] = MFMA32(__builtin_bit_cast(bf16x8, pw0), ATT_VFR(0), o[0]); o[1] = MFMA32(__builtin_bit_cast(bf16x8, pw0), ATT_VFR(4), o[1]);
    o[0] = MFMA32(__builtin_bit_cast(bf16x8, pw1), ATT_VFR(1), o[0]); o[1] = MFMA32(__builtin_bit_cast(bf16x8, pw1), ATT_VFR(5), o[1]);
    o[0] = MFMA32(__builtin_bit_cast(bf16x8, pw2), ATT_VFR(2), o[0]); o[1] = MFMA32(__builtin_bit_cast(bf16x8, pw2), ATT_VFR(6), o[1]);
    o[0] = MFMA32(__builtin_bit_cast(bf16x8, pw3), ATT_VFR(3), o[0]); o[1] = MFMA32(__builtin_bit_cast(bf16x8, pw3), ATT_VFR(7), o[1]);
#undef ATT_VFR
}
__device__ __forceinline__ float rowsum32(const f32x16& p0, const f32x16& p1) { if (ATT_ABL & 32) return p0[0]; float a = p0[0] + p1[0], b = p0[1] + p1[1];
#pragma unroll
    for (int r = 2; r < 16; r += 2) { a += p0[r]; asm volatile("" : "+v"(a)); b += p0[r + 1]; asm volatile("" : "+v"(b)); a += p1[r]; asm volatile("" : "+v"(a)); b += p1[r + 1]; asm volatile("" : "+v"(b)); }
    return a + b; }
__device__ __forceinline__ void hook_exp(f32x16& s0, f32x16& s1) {
    if (ATT_ABL & 16) return;
#pragma unroll
    for (int r = 0; r < 16; ++r) { s0[r] = __builtin_amdgcn_exp2f(s0[r]); s1[r] = __builtin_amdgcn_exp2f(s1[r]); } }
__device__ __forceinline__ void hook_general(f32x16& s0, f32x16& s1, int base, int win, const LAS float* lut, bool pred) {
    const int inval = 114;
    asm volatile("" : "+v"(base));
#pragma unroll
    for (int r = 0; r < 16; ++r) { const int d0 = base - ((r & 3) + 8 * (r >> 2)), d1 = d0 - 32;
        const int i0 = (pred && (unsigned)d0 < (unsigned)win) ? min(d0, 113) : inval, i1 = (pred && (unsigned)d1 < (unsigned)win) ? min(d1, 113) : inval;
        s0[r] = __builtin_amdgcn_exp2f(s0[r] + lut[i0]); s1[r] = __builtin_amdgcn_exp2f(s1[r] + lut[i1]); } }
__device__ __forceinline__ void hook_cmp(f32x16& s0, f32x16& s1, int nrel  , float cb) {
    asm volatile("" : "+v"(nrel));
#pragma unroll
    for (int r = 0; r < 16; ++r) { const int c0 = (r & 3) + 8 * (r >> 2);
        s0[r] = __builtin_amdgcn_exp2f(s0[r] + ((c0 <= nrel) ? cb : -INFINITY)); s1[r] = __builtin_amdgcn_exp2f(s1[r] + ((c0 + 32 <= nrel) ? cb : -INFINITY)); } }
__device__ __forceinline__ void row_factors(const Ctx& c, float f, float (&fr)[16]) {
    const int lane = fresh_lane(), r32 = lane & 31, hi = lane >> 5; LAS float* wsf = (LAS float*)(c.lds + LDS_WSF) + c.wid * 64;
    asm volatile("s_waitcnt lgkmcnt(0)" ::: "memory");
    if (hi == 0) wsf[r32] = f;
    asm volatile("s_waitcnt lgkmcnt(0)" ::: "memory");
#pragma unroll
    for (int r = 0; r < 16; ++r) fr[r] = wsf[(r & 3) + 8 * (r >> 2) + 4 * hi];
    asm volatile("s_waitcnt lgkmcnt(0)" ::: "memory");
}
__device__ __forceinline__ float pair_sum(float v) { auto rr = __builtin_amdgcn_permlane32_swap(__float_as_uint(v), __float_as_uint(v), false, false); return __uint_as_float(rr[0]) + __uint_as_float(rr[1]); }
template <class RowOff>
__device__ __forceinline__ void store_rows(const Ctx& c, const f32x16 (&o)[2], bf16* dst, RowOff&& rowoff) {
    LAS bf16* stg = (LAS bf16*)(c.lds + LDS_OST) + c.wid * 2048;
    const int lane = fresh_lane(), r32 = lane & 31, hi = lane >> 5;
#pragma unroll
    for (int r = 0; r < 16; ++r) { const int orow = (r & 3) + 8 * (r >> 2) + 4 * hi;
#pragma unroll
        for (int d0 = 0; d0 < 2; ++d0) stg[orow * 64 + d0 * 32 + r32] = (bf16)f2bf(o[d0][r]); }
    asm volatile("s_waitcnt lgkmcnt(0)" ::: "memory");
#pragma unroll
    for (int i = 0; i < 4; ++i) { const int row = i * 8 + (lane >> 3), ch = lane & 7; const u32x4 v = *(const LAS u32x4*)(stg + row * 64 + ch * 8); *(u32x4*)(dst + rowoff(row) + ch * 8) = v; }
    asm volatile("s_waitcnt lgkmcnt(0)" ::: "memory");
}
struct AttnPtrs { const bf16* qkv; const float* kmp; const float* gates; const bf16* kcmp; const bf16* vcmp; const float* rel_bias; bf16* mix; unsigned* selg; bf16* part_o; float* part_l; };

__device__ __forceinline__ unsigned moba_gate32(const AttnPtrs& P, int b, int h, int i, const bf16x8 (&qr)[4], int r32, int hi) {
    unsigned selmask = 0u;
    if (i > 0) {
        bf16x8 kmf[4];
        const float* kp = P.kmp + ((size_t)((b * 8 + h) * 32 + r32) * 2) * 64;
#pragma unroll
        for (int d0 = 0; d0 < 4; ++d0) { const f32x4 a0 = *(const f32x4*)(kp + d0 * 16 + hi * 8), a1 = *(const f32x4*)(kp + d0 * 16 + hi * 8 + 4), b0 = *(const f32x4*)(kp + 64 + d0 * 16 + hi * 8), b1 = *(const f32x4*)(kp + 64 + d0 * 16 + hi * 8 + 4);
            const f32x4 m0 = (a0 + b0) * (1.f / 256.f), m1 = (a1 + b1) * (1.f / 256.f);
            u32x4 w = {cvtpk(m0[0], m0[1]), cvtpk(m0[2], m0[3]), cvtpk(m1[0], m1[1]), cvtpk(m1[2], m1[3])}; kmf[d0] = __builtin_bit_cast(bf16x8, w); }
        f32x16 sg = {};
#pragma unroll
        for (int d0 = 0; d0 < 4; ++d0) sg = MFMA32(kmf[d0], qr[d0], sg);
        float v[16];
#pragma unroll
        for (int r = 0; r < 16; ++r) v[r] = ((r & 3) + 8 * (r >> 2) + 4 * hi < i) ? sg[r] : -INFINITY;
#pragma unroll
        for (int it = 0; it < 3; ++it) {
            float m = v[0]; int jb = 4 * hi;
#pragma unroll
            for (int r = 1; r < 16; ++r) { const int j = (r & 3) + 8 * (r >> 2) + 4 * hi; if (v[r] > m) { m = v[r]; jb = j; } }
            auto rm = __builtin_amdgcn_permlane32_swap(__float_as_uint(m), __float_as_uint(m), false, false);
            auto rj = __builtin_amdgcn_permlane32_swap((unsigned)jb, (unsigned)jb, false, false);
            const float mo = __uint_as_float(hi ? rm[0] : rm[1]); const int jo = (int)(hi ? rj[0] : rj[1]);
            const bool mine = (m > mo) || (m == mo && jb < jo);
            const float mw = mine ? m : mo; const int jw = mine ? jb : jo;
            if (mw > -INFINITY) { selmask |= 1u << jw;
#pragma unroll
                for (int r = 0; r < 16; ++r) if ((r & 3) + 8 * (r >> 2) + 4 * hi == jw) v[r] = -INFINITY; }
        }
    }
    return selmask;
}
__device__ __forceinline__ void moba_gate_phase(const AttnPtrs& P, int vcu, int G, int tid) {
    const int lane = tid & 63, r32 = lane & 31, hi = lane >> 5; const int wid = __builtin_amdgcn_readfirstlane(tid >> 6);
    for (int task = vcu * 8 + wid; task < 8192; task += G * 8) { const int w = task & 7, i = (task >> 3) & 31, bh = task >> 8; const int qpos = 256 * i + 32 * w + r32;
        const bf16* QA = P.qkv + ((size_t)bh * SEQ) * 64;
        bf16x8 qr[4];
#pragma unroll
        for (int d0 = 0; d0 < 4; ++d0) qr[d0] = *(const bf16x8*)(QA + (size_t)qpos * 64 + d0 * 16 + hi * 8);
        const unsigned m = moba_gate32(P, bh >> 3, bh & 7, i, qr, r32, hi);
        if (hi == 0) P.selg[(size_t)bh * SEQ + qpos] = m; }
}
__device__ __forceinline__ void moba_lut(const Ctx& c, const AttnPtrs& P, int h) {
    LAS float* lut = (LAS float*)(c.lds + LDS_LUT);
    if (threadIdx.x < 115) lut[threadIdx.x] = (threadIdx.x == 114) ? -INFINITY : (P.rel_bias[t5_bucket(threadIdx.x) * 16 + h] - P.rel_bias[31 * 16 + h]) * LOG2E;
}
__device__ __forceinline__ void moba_past_item(const Ctx& c, const AttnPtrs& P, int b, int h, int j) {
    const int bh = b * 8 + h, tid = threadIdx.x;
    const bf16* QA = P.qkv + ((size_t)bh * SEQ) * 64; const bf16* KA = QA + QKV_BIG + (size_t)256 * j * 64; const bf16* VA = QA + 2 * QKV_BIG + (size_t)256 * j * 64;
    moba_lut(c, P, h);
    const LAS float* lut = (const LAS float*)(c.lds + LDS_LUT);
    { const int lane = fresh_lane(); const unsigned lds0 = (unsigned)(uintptr_t)c.lds;
      const bf16* ks = KA + (lane * 64 + c.wid * 8); const bf16* vs = VA + ((16 * (c.wid & 3) + (lane >> 2)) * 64 + (c.wid >> 2) * 32 + (lane & 3) * 8);
#pragma unroll
      for (int tt = 0; tt < 4; ++tt) { glds16(ks + tt * 4096, (unsigned)__builtin_amdgcn_readfirstlane(lds0 + c.wid * 1024 + tt * SLOT)); glds16(vs + tt * 4096, (unsigned)__builtin_amdgcn_readfirstlane(lds0 + 8192 + c.wid * 1024 + tt * SLOT)); } }
    LAS unsigned short* list = (LAS unsigned short*)(c.lds + LDS_IMP);
    LAS unsigned* wcnt = (LAS unsigned*)(c.lds + LDS_MISC) + 8;
    const unsigned* sg = P.selg + (size_t)bh * SEQ;
    int total = 0;
    for (int base = (j + 1) * 256; base < SEQ; base += 512) {
        const int q = base + tid; const unsigned m = (q < SEQ) ? sg[q] : 0u; const bool sel = (m >> j) & 1u;
        const unsigned long long bal = __ballot(sel);
        if ((tid & 63) == 0) wcnt[c.wid] = (unsigned)__popcll(bal);
        asm volatile("s_waitcnt vmcnt(0) lgkmcnt(0)\n\ts_barrier" ::: "memory");
        int off = total, tot = 0;
#pragma unroll
        for (int w = 0; w < 8; ++w) { const int v = (int)wcnt[w]; off += (w < c.wid) ? v : 0; tot += v; }
        if (sel) list[off + __popcll(bal & ((1ull << (tid & 63)) - 1ull))] = (unsigned short)(q | (__popc(m & ((1u << j) - 1u)) << 13));
        total += tot;
        asm volatile("s_waitcnt lgkmcnt(0)\n\ts_barrier" ::: "memory");
    }
    total = __builtin_amdgcn_readfirstlane(total);
    { const int npad = (32 - (total & 31)) & 31; if (tid < npad) list[total + tid] = 0xFFFFu; }
    const int nchunks = (total + 31) >> 5;
    asm volatile("s_waitcnt vmcnt(0) lgkmcnt(0)\n\ts_barrier" ::: "memory");
    for (int ch = c.wid; ch < nchunks; ch += 8) {
        const int lane = fresh_lane(), r32 = lane & 31, hi = lane >> 5;
        const lds_cptr kp0 = (lds_cptr)c.lds + hi * 1024 + r32 * 16;
        const lds_cptr vp0 = (lds_cptr)c.lds + 8192 + ((lane >> 4) & 1) * 32 + (lane & 3) * 8 + (4 * hi + ((lane & 15) >> 2)) * 64;
        const unsigned e = list[32 * ch + r32]; const bool valid = e != 0xFFFFu; const int q = valid ? (int)(e & 0x1FFFu) : SEQ - 1;
        bf16x8 qr[4];
#pragma unroll
        for (int d0 = 0; d0 < 4; ++d0) qr[d0] = *(const bf16x8*)(QA + (size_t)q * 64 + d0 * 16 + hi * 8);
        asm volatile("" : "+v"(qr[0]), "+v"(qr[1]), "+v"(qr[2]), "+v"(qr[3]));
        const bool anynear = __any(valid && (q >> 8) == j + 1);
        f32x16 o[2]; o[0] = f32x16{}; o[1] = f32x16{}; float l_reg = 0.f;
#pragma unroll 1
        for (int tt = 0; tt < 4; ++tt) { f32x16 s0, s1; qk_tile(s0, s1, kp0 + tt * SLOT, qr);
            if (anynear) hook_general(s0, s1, q - (256 * j + 64 * tt) - 4 * hi, 1 << 30, lut, true); else hook_exp(s0, s1);
            l_reg += rowsum32(s0, s1);
            pv_tile<false>(o, vp0 + tt * SLOT, s0, s1, 0u); }
        const float L = pair_sum(l_reg);
        if (hi == 0 && valid) P.part_l[((size_t)bh * SEQ + q) * 3 + (e >> 13)] = L;
        LAS bf16* stg = (LAS bf16*)(c.lds + LDS_OST) + c.wid * 2048;
#pragma unroll
        for (int r = 0; r < 16; ++r) { const int orow = (r & 3) + 8 * (r >> 2) + 4 * hi;
#pragma unroll
            for (int d0 = 0; d0 < 2; ++d0) stg[orow * 64 + d0 * 32 + r32] = (bf16)f2bf(o[d0][r]); }
        asm volatile("s_waitcnt lgkmcnt(0)" ::: "memory");
#pragma unroll
        for (int it = 0; it < 4; ++it) { const int row = it * 8 + (lane >> 3), chn = lane & 7; const unsigned e2 = list[32 * ch + row];
            const u32x4 v = *(const LAS u32x4*)(stg + row * 64 + chn * 8);
            if (e2 != 0xFFFFu) *(u32x4*)(P.part_o + (((size_t)bh * SEQ + (e2 & 0x1FFFu)) * 3 + (e2 >> 13)) * 64 + chn * 8) = v; }
        asm volatile("s_waitcnt lgkmcnt(0)" ::: "memory");
    }
    asm volatile("s_waitcnt lgkmcnt(0)\n\ts_barrier" ::: "memory");
}
__device__ __forceinline__ void moba_own_item(const Ctx& c, const AttnPtrs& P, int b, int h, int i) {
    const int bh = b * 8 + h; const int q0 = 256 * i + 32 * c.wid, qpos = q0 + c.r32;
    const bf16* QA = P.qkv + ((size_t)bh * SEQ) * 64; const bf16* KA = QA + QKV_BIG; const bf16* VA = QA + 2 * QKV_BIG;
    bf16x8 qr[4];
#pragma unroll
    for (int d0 = 0; d0 < 4; ++d0) qr[d0] = *(const bf16x8*)(QA + (size_t)qpos * 64 + d0 * 16 + c.hi * 8);
    asm volatile("" : "+v"(qr[0]), "+v"(qr[1]), "+v"(qr[2]), "+v"(qr[3]));
    moba_lut(c, P, h);
    const LAS float* lut = (const LAS float*)(c.lds + LDS_LUT);
    asm volatile("s_waitcnt lgkmcnt(0)\n\ts_barrier" ::: "memory");
    f32x16 o[2]; o[0] = f32x16{}; o[1] = f32x16{}; float l_reg = 0.f;
    run_stream<true>(c, KA, VA, 4 * i, 4 * i + 4,
        [&](int t, lds_cptr kp, f32x16& s0, f32x16& s1) { if (q0 + 31 - 64 * t < 0) return; qk_tile(s0, s1, kp, qr); },
        [&](int t, lds_cptr vp, f32x16& s0, f32x16& s1) { const int key0 = 64 * t; if (q0 + 31 - key0 < 0) return;
            hook_general(s0, s1, qpos - key0 - 4 * c.hi, 1 << 30, lut, true); l_reg += rowsum32(s0, s1); pv_tile<false>(o, vp, s0, s1, 0u); });
    const float Lown = pair_sum(l_reg);
    const int lane = fresh_lane(), r32 = lane & 31, hi = lane >> 5;
    LAS float* stgf = (LAS float*)c.lds + c.wid * 2048;
    LAS float* wsf = (LAS float*)(c.lds + LDS_WSF) + c.wid * 64;
#pragma unroll
    for (int r = 0; r < 16; ++r) { const int orow = (r & 3) + 8 * (r >> 2) + 4 * hi;
#pragma unroll
        for (int d0 = 0; d0 < 2; ++d0) stgf[orow * 64 + d0 * 32 + r32] = o[d0][r]; }
    if (hi == 0) wsf[r32] = Lown;
    asm volatile("s_waitcnt lgkmcnt(0)" ::: "memory");
#pragma unroll
    for (int it = 0; it < 4; ++it) { const int row = it * 8 + (lane >> 3), chn = lane & 7; const int q = 256 * i + 32 * c.wid + row;
        const size_t qi = (size_t)bh * SEQ + q; const int ns = __popc(P.selg[qi]);
        float Lt = wsf[row]; f32x4 a0 = *(const LAS f32x4*)(stgf + row * 64 + chn * 8), a1 = *(const LAS f32x4*)(stgf + row * 64 + chn * 8 + 4);
#pragma unroll
        for (int sidx = 0; sidx < 3; ++sidx) if (sidx < ns) { Lt += P.part_l[qi * 3 + sidx]; const u32x4 pv = *(const u32x4*)(P.part_o + (qi * 3 + sidx) * 64 + chn * 8);
            a0 += (f32x4){__uint_as_float(pv.x << 16), __uint_as_float(pv.x & 0xffff0000u), __uint_as_float(pv.y << 16), __uint_as_float(pv.y & 0xffff0000u)};
            a1 += (f32x4){__uint_as_float(pv.z << 16), __uint_as_float(pv.z & 0xffff0000u), __uint_as_float(pv.w << 16), __uint_as_float(pv.w & 0xffff0000u)}; }
        const float inv = 1.f / Lt; a0 *= inv; a1 *= inv;
        const u32x4 w = {cvtpk(a0[0], a0[1]), cvtpk(a0[2], a0[3]), cvtpk(a1[0], a1[1]), cvtpk(a1[2], a1[3])};
        *(u32x4*)(P.mix + ((size_t)b * SEQ + q) * DM + h * 64 + chn * 8) = w; }
    asm volatile("s_waitcnt lgkmcnt(0)\n\ts_barrier" ::: "memory");
}

__device__ __forceinline__ void nsa_item(const Ctx& c, const AttnPtrs& P, int b, int g, int ci) {
    const int ql = 8 * c.wid + (c.r32 >> 2), rh = c.r32 & 3, qpos = 64 * ci + ql, hb = 4 * g + rh;
    const int qw0 = 64 * ci + 8 * c.wid;
    const bf16* QB = P.qkv + 3 * QKV_BIG + ((size_t)(b * 8 + hb) * SEQ) * 64;
    const bf16* KS = P.qkv + 4 * QKV_BIG + 2 * QKV_SMALL + ((size_t)(b * 2 + g) * SEQ) * 64; const bf16* VS = KS + QKV_SMALL; const bf16* KW = KS + 2 * QKV_SMALL; const bf16* VW = KS + 3 * QKV_SMALL;
    const bf16* KC = P.kcmp + (size_t)(b * 2 + g) * 512 * 64; const bf16* VC = P.vcmp + (size_t)(b * 2 + g) * 512 * 64;
    bf16x8 qr[4];
#pragma unroll
    for (int d0 = 0; d0 < 4; ++d0) qr[d0] = *(const bf16x8*)(QB + (size_t)qpos * 64 + d0 * 16 + c.hi * 8);
    const float* gp = P.gates + ((size_t)b * SEQ + qpos) * 24 + hb * 3; float g0 = gp[0], g1 = gp[1], g2 = gp[2];
    asm volatile("" : "+v"(qr[0]), "+v"(qr[1]), "+v"(qr[2]), "+v"(qr[3]), "+v"(g0), "+v"(g1), "+v"(g2));
    LAS float* lutall = (LAS float*)(c.lds + LDS_LUT);
    if (threadIdx.x < 460) { const int hh = threadIdx.x / 115, d = threadIdx.x % 115; lutall[hh * 128 + d] = (d == 114) ? -INFINITY : (P.rel_bias[t5_bucket(d) * 16 + 8 + 4 * g + hh] - P.rel_bias[31 * 16 + 8 + 4 * g + hh]) * LOG2E; }
    const LAS float* lut = lutall + rh * 128;
    LAS float* imp = (LAS float*)(c.lds + LDS_IMP);
    LAS unsigned* selm = (LAS unsigned*)(c.lds + LDS_SELM);
    f32x16 o[2]; float l_reg; float fr[16];
    LAS float* park = (LAS float*)(c.lds + LDS_OST) + c.wid * 1024 + c.lane;
    LAS float* park1 = (LAS float*)(c.lds + LDS_IMP) + c.wid * 1024 + c.lane;
    const int nct = (4 * ci + 3 + 63) >> 6;
    const int nlim = (qpos >= 31) ? ((qpos - 31) >> 4) : -1;
    l_reg = 0.f;
    run_stream<false>(c, KC, VC, 0, nct,
        [&](int t, lds_cptr kp, f32x16& s0, f32x16& s1) { qk_tile(s0, s1, kp, qr); },
        [&](int t, lds_cptr vp, f32x16& s0, f32x16& s1) { hook_cmp(s0, s1, nlim - 64 * t - 4 * c.hi, 0.f); l_reg += rowsum32(s0, s1); });
    const float Lc = pair_sum(l_reg); const float cbn = Lc > 0.f ? -__builtin_amdgcn_logf(Lc) : -INFINITY;
    o[0] = f32x16{}; o[1] = f32x16{};
    {
        float carry = 0.f;
        run_stream<true>(c, KC, VC, 0, nct,
          [&](int t, lds_cptr kp, f32x16& s0, f32x16& s1) { qk_tile(s0, s1, kp, qr); },
          [&](int t, lds_cptr vp, f32x16& s0, f32x16& s1) {
            hook_cmp(s0, s1, nlim - 64 * t - 4 * c.hi, cbn);
#pragma unroll
            for (int half = 0; half < 2; ++half) {
                float g4[4], e[4];
#pragma unroll
                for (int a = 0; a < 4; ++a) { const float x0 = half ? s1[4 * a] : s0[4 * a], x1 = half ? s1[4 * a + 1] : s0[4 * a + 1], x2 = half ? s1[4 * a + 2] : s0[4 * a + 2], x3 = half ? s1[4 * a + 3] : s0[4 * a + 3];
                    float gs = (x0 + x1) + (x2 + x3), es = x3;
                    gs += __shfl_xor(gs, 1); gs += __shfl_xor(gs, 2); es += __shfl_xor(es, 1); es += __shfl_xor(es, 2);
                    g4[a] = gs; e[a] = es; }
                float x[4];
#pragma unroll
                for (int a = 0; a < 4; ++a) { auto rr = __builtin_amdgcn_permlane32_swap(__float_as_uint(e[a]), __float_as_uint(e[a]), false, false); x[a] = __uint_as_float(c.hi ? rr[0] : rr[1]); }
                const int jb = 16 * t + 8 * half;
                float iv[4];
                if (c.hi) {
#pragma unroll
                    for (int a = 0; a < 4; ++a) iv[a] = g4[a] + x[a]; }
                else { iv[0] = g4[0] + carry; iv[1] = g4[1] + x[0]; iv[2] = g4[2] + x[1]; iv[3] = g4[3] + x[2]; carry = x[3]; }
                if (rh == 0) {
#pragma unroll
                    for (int a = 0; a < 4; ++a) imp[ql * 128 + jb + 2 * a + c.hi] = iv[a]; }
            }
            pv_tile<false>(o, vp, s0, s1, 0u);
        });
    }
    {
        asm volatile("s_waitcnt lgkmcnt(0)\n\ts_barrier" ::: "memory");
        const int qq = 8 * c.wid + (c.lane >> 3), cc = c.lane & 7;
        unsigned m0 = 0u, m1 = 0u, m2w = 0u, m3 = 0u;
        if (ci <= 15) { m0 = (ci == 31) ? 0xffffffffu : ((2u << ci) - 1u); }
        else {
            float v[16];
#pragma unroll
            for (int k = 0; k < 16; ++k) { const int j = cc + 8 * k; v[k] = (j >= 1 && j <= ci - 2) ? imp[qq * 128 + j] : -INFINITY; }
            for (int it = 0; it < 13; ++it) {
                float m = v[0]; int jb = cc;
#pragma unroll
                for (int k = 1; k < 16; ++k) if (v[k] > m) { m = v[k]; jb = cc + 8 * k; }
#pragma unroll
                for (int sft = 1; sft < 8; sft <<= 1) { const float mo = __shfl_xor(m, sft); const int jo = __shfl_xor(jb, sft); if (mo > m || (mo == m && jo < jb)) { m = mo; jb = jo; } }
                if (m > -INFINITY) { const unsigned bit = 1u << (jb & 31); const int wsel = jb >> 5;
                    m0 |= (wsel == 0) ? bit : 0u; m1 |= (wsel == 1) ? bit : 0u; m2w |= (wsel == 2) ? bit : 0u; m3 |= (wsel == 3) ? bit : 0u;
#pragma unroll
                    for (int k = 0; k < 16; ++k) if (cc + 8 * k == jb) v[k] = -INFINITY; }
            }
            m0 |= 1u;
#pragma unroll
            for (int z = 0; z < 2; ++z) { const int jf = ci - z; const unsigned bit = 1u << (jf & 31); const int wsel = jf >> 5;
                m0 |= (wsel == 0) ? bit : 0u; m1 |= (wsel == 1) ? bit : 0u; m2w |= (wsel == 2) ? bit : 0u; m3 |= (wsel == 3) ? bit : 0u; }
        }
        if (cc == 0) { selm[qq * 4 + 0] = m0; selm[qq * 4 + 1] = m1; selm[qq * 4 + 2] = m2w; selm[qq * 4 + 3] = m3; }
        asm volatile("s_waitcnt lgkmcnt(0)\n\ts_barrier" ::: "memory");
    }
    row_factors(c, g0, fr);
#pragma unroll
    for (int r = 0; r < 16; ++r) { park[r * 64] = o[0][r] * fr[r]; park1[r * 64] = o[1][r] * fr[r]; }
    {
        const unsigned w0 = selm[ql * 4 + 0], w1 = selm[ql * 4 + 1], w2 = selm[ql * 4 + 2], w3 = selm[ql * 4 + 3];
        o[0] = f32x16{}; o[1] = f32x16{}; l_reg = 0.f;
        auto sel_pred = [&](int t) -> bool { const unsigned wsel = (t < 32) ? w0 : (t < 64) ? w1 : (t < 96) ? w2 : w3; return (wsel >> (t & 31)) & 1u; };
        run_stream<true>(c, KS, VS, 0, ci + 1,
            [&](int t, lds_cptr kp, f32x16& s0, f32x16& s1) { if (!__any(sel_pred(t))) return; qk_tile(s0, s1, kp, qr); },
            [&](int t, lds_cptr vp, f32x16& s0, f32x16& s1) { const bool pred = sel_pred(t); if (!__any(pred)) return; const int key0 = 64 * t;
                if (qw0 - key0 - 63 >= 113) { hook_exp(s0, s1); const float rs = rowsum32(s0, s1); l_reg += pred ? rs : 0.f;
                    if (__all(pred)) pv_tile<false>(o, vp, s0, s1, 0u); else pv_tile<true>(o, vp, s0, s1, pred ? 0xffffffffu : 0u); }
                else { hook_general(s0, s1, qpos - key0 - 4 * c.hi, 1 << 30, lut, pred); l_reg += rowsum32(s0, s1); pv_tile<false>(o, vp, s0, s1, 0u); } });
        const float Ls = pair_sum(l_reg);
        row_factors(c, g1 / Ls, fr);
#pragma unroll
        for (int r = 0; r < 16; ++r) { park[r * 64] += o[0][r] * fr[r]; park1[r * 64] += o[1][r] * fr[r]; }
    }
    {
        o[0] = f32x16{}; o[1] = f32x16{}; l_reg = 0.f;
        run_stream<true>(c, KW, VW, ci >= 8 ? ci - 8 : 0, ci + 1,
            [&](int t, lds_cptr kp, f32x16& s0, f32x16& s1) { qk_tile(s0, s1, kp, qr); },
            [&](int t, lds_cptr vp, f32x16& s0, f32x16& s1) { const int key0 = 64 * t;
                if (qw0 - key0 - 63 >= 113 && qw0 + 7 - key0 < 512) hook_exp(s0, s1); else hook_general(s0, s1, qpos - key0 - 4 * c.hi, 512, lut, true);
                l_reg += rowsum32(s0, s1);
                pv_tile<false>(o, vp, s0, s1, 0u); });
        const float Lw = pair_sum(l_reg);
        row_factors(c, g2 / Lw, fr);
#pragma unroll
        for (int r = 0; r < 16; ++r) { o[0][r] = park[r * 64] + o[0][r] * fr[r]; o[1][r] = park1[r * 64] + o[1][r] * fr[r]; }
        asm volatile("s_waitcnt lgkmcnt(0)" ::: "memory");
    }
    bf16* dst = P.mix + ((size_t)b * SEQ + 64 * ci + 8 * c.wid) * DM + 512 + g * 256;
    store_rows(c, o, dst, [](int row) { return (size_t)(row >> 2) * DM + (row & 3) * 64; });
    asm volatile("s_waitcnt lgkmcnt(0)\n\ts_barrier" ::: "memory");
}

__device__ __forceinline__ void attn_phase(LAS unsigned char* lds, const AttnPtrs& P, unsigned* qcounter) {
    Ctx c = make_ctx(lds, threadIdx.x);
    LAS unsigned* misc = (LAS unsigned*)(c.lds + LDS_MISC);
    for (;;) {
        if (threadIdx.x == 0) misc[0] = __hip_atomic_fetch_add(qcounter, 1u, __ATOMIC_RELAXED, __HIP_MEMORY_SCOPE_AGENT);
        asm volatile("s_waitcnt vmcnt(0) lgkmcnt(0)\n\ts_barrier" ::: "memory");
        const unsigned k = misc[0];
        asm volatile("s_waitcnt lgkmcnt(0)\n\ts_barrier" ::: "memory");
        if (k >= 2016u) break;
        if (k < 512u) { const int s_ = 127 - (int)(k >> 3), bg = k & 7; nsa_item(c, P, bg >> 1, bg & 1, s_); }
        else if (k < 1504u) { const int kk = (int)k - 512, j = kk >> 5, bh = kk & 31; moba_past_item(c, P, bh >> 3, bh & 7, j); }
        else { const int kk = (int)k - 1504; const int s_ = 63 - (kk >> 3), bg = kk & 7; nsa_item(c, P, bg >> 1, bg & 1, s_); }
    }
}
__device__ __forceinline__ void moba_merge_phase(LAS unsigned char* lds, const AttnPtrs& P, int vcu, int G) {
    Ctx c = make_ctx(lds, threadIdx.x);
    for (int k = vcu; k < 1024; k += G) moba_own_item(c, P, k >> 8, (k >> 5) & 7, k & 31);
}
#undef MFMA32
#undef ATT_WAIT_BAR
}
namespace cmpr {
using bf16x8 = __attribute__((ext_vector_type(8))) short;
using f32x16 = __attribute__((ext_vector_type(16))) float;
constexpr int HID_PITCH = 528;
__device__ __forceinline__ float gelu_tanh(float v) { const float u = fminf(fmaxf(0.7978845608028654f * (v + 0.044715f * v * v * v), -15.f), 15.f); const float e = __expf(2.f * u); return 0.5f * v * (1.f + (e - 1.f) / (e + 1.f)); }
__device__ __forceinline__ void compress_unit(LAS unsigned char* lds, int unit, const bf16* qkv, const bf16* w1k, const bf16* w1v, const bf16* w2k, const bf16* w2v, const float* cbp, const float* kncmp, bf16* kcmp, bf16* vcmp) {
    const int tid = threadIdx.x, lane = tid & 63, r32 = lane & 31, hi = lane >> 5; const int wid = __builtin_amdgcn_readfirstlane(tid >> 6);
    const int kv = unit & 1, u = (unit >> 1) & 15, bg = unit >> 5;
    const bf16* src = qkv + 4 * QKV_BIG + (kv ? QKV_SMALL : 0) + (size_t)bg * SEQ * 64;
    const bf16* w1 = kv ? w1v : w1k; const bf16* w2 = kv ? w2v : w2k;
    const int n0 = 32 * u; const int nn = min(n0 + r32, NCMP - 1);
    const bf16* ap = src + (size_t)nn * 1024 + 8 * hi; const bf16* bp = w1 + (size_t)(32 * wid + r32) * 2048 + 8 * hi;
    f32x16 acc = {};
#pragma unroll 8
    for (int kk = 0; kk < 128; ++kk) { const bf16x8 a = *(const bf16x8*)(ap + 16 * kk), bfr = *(const bf16x8*)(bp + 16 * kk); acc = __builtin_amdgcn_mfma_f32_32x32x16_bf16(a, bfr, acc, 0, 0, 0); }
    float cb = 0.f;
#pragma unroll 8
    for (int ic = 0; ic < 32; ++ic) cb += cbp[(ic * 2 + kv) * 256 + 32 * wid + r32];
    LAS unsigned char* hidL = lds;
#pragma unroll
    for (int r = 0; r < 16; ++r) { const int n = (r & 3) + 8 * (r >> 2) + 4 * hi; *(LAS bf16*)(hidL + n * HID_PITCH + (32 * wid + r32) * 2) = (bf16)f2bf(gelu_tanh(acc[r] + cb)); }
    asm volatile("s_waitcnt lgkmcnt(0)\n\ts_barrier" ::: "memory");
    if (wid == 0) {
        f32x16 o0 = {}, o1 = {};
#pragma unroll 4
        for (int kk = 0; kk < 16; ++kk) { const bf16x8 hb = *(const LAS bf16x8*)(hidL + r32 * HID_PITCH + (16 * kk + 8 * hi) * 2);
            const bf16x8 a0 = *(const bf16x8*)(w2 + (size_t)r32 * 256 + 16 * kk + 8 * hi), a1 = *(const bf16x8*)(w2 + (size_t)(32 + r32) * 256 + 16 * kk + 8 * hi);
            o0 = __builtin_amdgcn_mfma_f32_32x32x16_bf16(a0, hb, o0, 0, 0, 0); o1 = __builtin_amdgcn_mfma_f32_32x32x16_bf16(a1, hb, o1, 0, 0, 0); }
        float rs = 1.f;
        if (!kv) { float ss = 0.f;
#pragma unroll
            for (int r = 0; r < 16; ++r) ss += o0[r] * o0[r] + o1[r] * o1[r];
            auto rr = __builtin_amdgcn_permlane32_swap(__float_as_uint(ss), __float_as_uint(ss), false, false); ss = __uint_as_float(rr[0]) + __uint_as_float(rr[1]);
            rs = rsqrtf(ss * (1.f / 64.f) + 1e-6f); }
        const int n = n0 + r32; bf16* dst = (kv ? vcmp : kcmp) + ((size_t)bg * 512 + n) * 64;
#pragma unroll
        for (int r = 0; r < 16; ++r) { const int d = (r & 3) + 8 * (r >> 2) + 4 * hi;
            float v0 = o0[r] * rs, v1 = o1[r] * rs; if (!kv) { v0 *= kncmp[d]; v1 *= kncmp[d + 32]; }
            if (n >= NCMP) { v0 = 0.f; v1 = 0.f; }
            dst[d] = (bf16)f2bf(v0); dst[d + 32] = (bf16)f2bf(v1); }
    }
    asm volatile("s_waitcnt lgkmcnt(0)\n\ts_barrier" ::: "memory");
}
}
__global__ void __launch_bounds__(NTHREADS, 2) mk_fwd(Args a) {
    extern __shared__ __attribute__((aligned(16))) unsigned char lds[];
    Frame F;
    F.lds = (LAS unsigned char*)lds;
    F.tid = threadIdx.x; F.lane = F.tid & 63; F.wave = __builtin_amdgcn_readfirstlane(F.tid >> 6);
    F.G = gridDim.x; { const int bx = blockIdx.x; F.vcu = (F.G % 8 == 0) ? (bx % 8) * (F.G / 8) + bx / 8 : bx; }
    cg::grid_group grid = cg::this_grid();
    volatile LAS unsigned* xst = (volatile LAS unsigned*)(F.lds + 147424);
    if (F.tid < 8) xst[F.tid] = 0u;
    __syncthreads();
    const XcdBarrier xbar = xcd_barrier_post((unsigned*)(a.ws + WS_CTL) + 4096, xst);
    unsigned char* ws = a.ws;
    const int lo = a.ph_lo, hi = a.ph_hi;
    const att::AttnPtrs P{(const bf16*)(ws + WS_QKV), (const float*)(ws + WS_KMP), (const float*)(ws + WS_GATES), (const bf16*)(ws + WS_KCMP), (const bf16*)(ws + WS_VCMP), a.in[2], (bf16*)(ws + WS_MIX),
                          (unsigned*)(ws + WS_SELG), (bf16*)(ws + WS_PARTO), (float*)(ws + WS_PARTL)};
#define IN(k) (lo <= (k) && (k) < hi)
#define SEAM(k) do { if (IN(k) && IN((k) + 1)) { if ((k) == 0) grid.sync(); else xcd_barrier(xbar); } } while (0)
    if (IN(0)) { phase_prologue_a(F, a); } SEAM(0);
    if (IN(1)) { phase_prologue_b(F, a); } SEAM(1);
    if (IN(2)) {
        pg8::Gemm g{(const pg8::bf16_t*)(ws + WS_H), (const pg8::bf16_t*)(ws + WS_WIN), TOK, NIN_PAD, DM}; pg8::StaticOrder S; S.init(TOK, NIN_PAD, F.G, (int)blockIdx.x);
        pg8::EpiInProj E{(pg8::bf16_t*)(ws + WS_QKV), (float*)(ws + WS_GATES), (float*)(ws + WS_KMP), a.in[7], a.in[8], a.in[9], a.in[11], a.in[12]};
        pg8::gemm_phase<pg8::EpiInProj, pg8::StaticOrder, true, true>(F.lds, g, S, E);
    } SEAM(2);
    if (IN(3)) {
        att::moba_gate_phase(P, F.vcu, F.G, F.tid);
        for (int unit = F.vcu; unit < 256; unit += F.G)
            cmpr::compress_unit(F.lds, unit, (const bf16*)(ws + WS_QKV), (const bf16*)(ws + WS_W1K), (const bf16*)(ws + WS_W1V), (const bf16*)(ws + WS_W2K), (const bf16*)(ws + WS_W2V),
                                (const float*)(ws + WS_CBP), a.in[10], (bf16*)(ws + WS_KCMP), (bf16*)(ws + WS_VCMP));
    } SEAM(3);
    if (IN(4)) {
                att::attn_phase(F.lds, P, (unsigned*)(ws + WS_CTL) + 64);
    } SEAM(4);
    if (IN(5)) { att::moba_merge_phase(F.lds, P, F.vcu, F.G); } SEAM(5);
    if (IN(6)) {
        pg8::Gemm g{(const pg8::bf16_t*)(ws + WS_MIX), (const pg8::bf16_t*)(ws + WS_WOUT), TOK, DM, DM}; pg8::StaticOrder S; S.init(TOK, DM, F.G, (int)blockIdx.x);
        pg8::EpiOutProj E{a.in[0], a.out, (const float*)(ws + WS_MOD) + 2 * DM};
        pg8::gemm_phase<pg8::EpiOutProj, pg8::StaticOrder, true, true>(F.lds, g, S, E);
    } SEAM(6);
    if (IN(7)) { phase_norm2(F, a); } SEAM(7);
    if (IN(8)) {
        pg8::Gemm g{(const pg8::bf16_t*)(ws + WS_H), (const pg8::bf16_t*)(ws + WS_WGU), TOK, 2 * FF, DM}; pg8::StaticOrder S; S.init(TOK, 2 * FF, F.G, (int)blockIdx.x);
        pg8::EpiGateUp E{(pg8::bf16_t*)(ws + WS_ACT)};
        pg8::gemm_phase<pg8::EpiGateUp, pg8::StaticOrder, true, true>(F.lds, g, S, E);
    } SEAM(8);
    if (IN(9)) {
        pg8::Gemm g{(const pg8::bf16_t*)(ws + WS_ACT), (const pg8::bf16_t*)(ws + WS_WDN), TOK, DM, FF}; pg8::StaticOrder S; S.init(TOK, DM, F.G, (int)blockIdx.x);
        pg8::EpiDown E{a.out, (const float*)(ws + WS_MOD) + 5 * DM};
        pg8::gemm_phase<pg8::EpiDown, pg8::StaticOrder, true, true>(F.lds, g, S, E);
    }
#undef IN
#undef SEAM
}

static void launch_phases(const Args& base, int lo, int hi, int grid, hipStream_t stream) {
    Args a = base; a.ph_lo = lo; a.ph_hi = hi;
    if (hi - lo > 1) { void* args[] = {&a}; (void)hipLaunchCooperativeKernel((const void*)mk_fwd, dim3(grid), dim3(NTHREADS), args, LDS_BYTES, stream); }
    else hipLaunchKernelGGL(mk_fwd, dim3(grid), dim3(NTHREADS), LDS_BYTES, stream, a);
}
extern "C" void kernel_launch(void* const* d_in, const int* in_sizes, int n_in, void* d_out, int out_size, void* d_ws, size_t ws_size, hipStream_t stream) {
    static int grid = 0;
    if (grid == 0) {
        int dev = 0, cus = 0, per_cu = 0;
        if (n_in != 23 || ws_size < 452 * MiB || hipGetDevice(&dev) != hipSuccess || hipDeviceGetAttribute(&cus, hipDeviceAttributeMultiprocessorCount, dev) != hipSuccess) { grid = -1; return; }
        if (hipFuncSetAttribute((const void*)mk_fwd, hipFuncAttributeMaxDynamicSharedMemorySize, LDS_BYTES) != hipSuccess) { grid = -1; return; }
        if (hipOccupancyMaxActiveBlocksPerMultiprocessor(&per_cu, (const void*)mk_fwd, NTHREADS, LDS_BYTES) != hipSuccess || per_cu < 1) { grid = -1; return; }
        grid = cus;
    }
    if (grid < 0) return;
    (void)hipMemsetAsync((char*)d_ws + WS_CTL, 0, CTL_ZERO_BYTES, stream);
    Args a{};
    for (int i = 0; i < 23; ++i) a.in[i] = (const float*)d_in[i];
    a.out = (float*)d_out; a.ws = (unsigned char*)d_ws;
    unsigned char* ws = (unsigned char*)d_ws;
#if HYBRID == 1
    launch_phases(a, 0, 1, grid, stream); launch_phases(a, 1, 2, grid, stream); launch_phases(a, 2, 3, grid, stream);
    const bf16* qkv = (const bf16*)(ws + WS_QKV); bf16* mix = (bf16*)(ws + WS_MIX); bf16* kcmp = (bf16*)(ws + WS_KCMP); bf16* vcmp = (bf16*)(ws + WS_VCMP);
    int* sel = (int*)(ws + 344 * MiB); float* obuf = (float*)(ws + 348 * MiB); const float* gates = (const float*)(ws + WS_GATES);
    nq::k_compress<<<dim3(4 * 2 * 512, 2), 256, 0, stream>>>(qkv, a.in[13], a.in[14], a.in[15], a.in[16], a.in[17], a.in[18], a.in[10], kcmp, vcmp);
    nq::k_moba<<<4 * 8 * SEQ / 4, 256, 0, stream>>>(qkv, (const float*)(ws + WS_KMP), a.in[2], mix);
    nq::k_nsa_cmp<<<4 * 2 * SEQ, 256, 0, stream>>>(qkv, kcmp, vcmp, gates, obuf, sel);
    nq::k_nsa_sel<<<4 * 2 * SEQ, 256, 0, stream>>>(qkv, sel, a.in[2], gates, obuf);
    nq::k_nsa_win<<<4 * 2 * SEQ, 256, 0, stream>>>(qkv, a.in[2], gates, obuf, mix);
    launch_phases(a, 5, 6, grid, stream); launch_phases(a, 6, 7, grid, stream); launch_phases(a, 7, 8, grid, stream); launch_phases(a, 8, 9, grid, stream);
#elif HYBRID == 2
    launch_phases(a, 0, 1, grid, stream); launch_phases(a, 1, 2, grid, stream); launch_phases(a, 2, 3, grid, stream);
    nq::k_compress<<<dim3(4 * 2 * 512, 2), 256, 0, stream>>>((const bf16*)(ws + WS_QKV), a.in[13], a.in[14], a.in[15], a.in[16], a.in[17], a.in[18], a.in[10], (bf16*)(ws + WS_KCMP), (bf16*)(ws + WS_VCMP));
    launch_phases(a, 4, 5, grid, stream);
    launch_phases(a, 5, 6, grid, stream); launch_phases(a, 6, 7, grid, stream); launch_phases(a, 7, 8, grid, stream); launch_phases(a, 8, 9, grid, stream);
#elif HYBRID == 3
    for (int p = 0; p < N_PHASES; ++p) { launch_phases(a, p, p + 1, grid, stream);
#if defined(ABL_REPS)
        if (p == 3) { static bool once = false; if (!once) { once = true; (void)hipFuncSetAttribute((const void*)k_attn_abl, hipFuncAttributeMaxDynamicSharedMemorySize, LDS_BYTES); }
            for (int r = 0; r < ABL_REPS; ++r) { (void)hipMemsetAsync((char*)d_ws + WS_CTL + 512, 0, 4, stream); hipLaunchKernelGGL(k_attn_abl, dim3(grid), dim3(NTHREADS), LDS_BYTES, stream, a); } }
#endif
#if defined(TIME_PHASE)
        if (p == TIME_PHASE) { for (int r = 0; r < TIME_REPS; ++r) { (void)hipMemsetAsync((char*)d_ws + WS_CTL, 0, CTL_ZERO_BYTES, stream); launch_phases(a, p, p + 1, grid, stream); } }
#endif
    }
#else
    launch_phases(a, 0, N_PHASES, grid, stream);
#endif
}
```

```cpp
#include <hip/hip_runtime.h>
#include <hip/hip_cooperative_groups.h>
#include <cstdint>
#include <cstdio>
namespace cg = cooperative_groups;
#define HYBRID 0
namespace pg8 {
#define PG8_LAS __attribute__((address_space(3)))
typedef unsigned short bf16_t;
typedef short bf16x8 __attribute__((ext_vector_type(8)));
typedef float f32x4 __attribute__((ext_vector_type(4)));
typedef unsigned u32x4 __attribute__((ext_vector_type(4)));
constexpr int BM = 256, BK = 64, HALF = 128, HTB = HALF * BK * 2  , STAGE_BYTES = 8 * HTB, NXCD = 8, WGM = 8;

__host__ __device__ __forceinline__ int lds_byte(int r, int c) { const int st = (r >> 4) * 2 + (c >> 5), rr = r & 15, cc = c & 31, ob = rr * 64 + cc * 2; return st * 1024 + (ob ^ (((ob >> 9) & 1) << 5)); }
__host__ __device__ __forceinline__ void stage_rc(int b, int& R, int& C) { const int st = b / 1024, sb = b % 1024, swz = sb ^ (((sb >> 9) & 1) << 5); R = (st >> 1) * 16 + swz / 64; C = (st & 1) * 32 + (swz % 64) / 2; }
__host__ __device__ __forceinline__ int perm32(int rho) { const int n = rho >> 4, i = rho & 15; return 8 * (i >> 2) + 4 * n + (i & 3); }

struct Unit { int pm, pn; };
struct Gemm { const bf16_t* A; const bf16_t* Bt; int M, N, K; };

struct StaticOrder {
    int nM, nN, nwg, G, c;
    __host__ __device__ void init(int M, int N, int G_, int c_) { nM = M / BM; nN = N / BM; nwg = nM * nN; G = G_; c = c_; }
    __host__ __device__ bool next(int i, Unit& u) const {
        const long L = (long)i * G + c; if (L >= nwg) return false;
        int wgid = (int)L; { const int q = nwg / NXCD, r = nwg % NXCD, xcd = wgid % NXCD, off = wgid / NXCD; wgid = (xcd < r ? xcd * (q + 1) : r * (q + 1) + (xcd - r) * q) + off; }
        const int nig = WGM * nN, gid = wgid / nig, fm = gid * WGM, gsz = (nM - fm) < WGM ? (nM - fm) : WGM;
        u.pm = fm + ((wgid % nig) % gsz); u.pn = (wgid % nig) / gsz; return true;
    }
    __device__ __forceinline__ void a_ready(const Unit&) const {}
    __device__ __forceinline__ void done(const Unit&) const {}
};

__device__ __forceinline__ unsigned cvt_pk_bf16(float lo, float hi) { unsigned r; asm volatile("v_cvt_pk_bf16_f32 %0, %1, %2" : "=v"(r) : "v"(lo), "v"(hi)); return r; }
typedef float f32x2 __attribute__((ext_vector_type(2)));
template <class Epi, class Sched, bool ALIGN_EPI = false, bool SP2 = false>
__device__ __forceinline__ void gemm_phase(PG8_LAS unsigned char* lds, const Gemm g, const Sched& S, const Epi& E) {
    const int tid = threadIdx.x, wid = __builtin_amdgcn_readfirstlane(tid >> 6), lane = tid & 63, wr = wid >> 2, wc = wid & 3, fr = lane & 15, fq = lane >> 4;
    const int K = g.K, nt = K / BK;
    unsigned voffA[2], voffB[2];
#pragma unroll
    for (int i = 0; i < 2; ++i) { int R, C; stage_rc(tid * 16 + i * 8192, R, C); const int Rb = Epi::PERM ? ((R & ~31) + perm32(R & 31)) : R;
        voffA[i] = (unsigned)(R * K + C) * 2u; voffB[i] = (unsigned)(Rb * K + C) * 2u; }
    const size_t kstep = (size_t)(BK * 2);
    const size_t hstep = (size_t)HALF * K * 2;
    const size_t tstep = 2 * hstep;
    const unsigned ldsw = (unsigned)wid * 1024u;
    const int aoff = lds_byte(wr * 64 + fr, fq * 8), boff = lds_byte(wc * 32 + fr, fq * 8);
#define PG8_SA(b, h) (((b) * 2 + (h)) * HTB)
#define PG8_SB(b, h) ((4 + (b) * 2 + (h)) * HTB)
#define PG8_STAGE(bufoff, gbase, voff) do { _Pragma("unroll") for (int _i = 0; _i < 2; ++_i) \
        __builtin_amdgcn_global_load_lds((const unsigned*)((const char*)(gbase) + (voff)[_i]), (PG8_LAS unsigned*)(lds + (bufoff) + ldsw + _i * 8192), 16, 0, 0); } while (0)
#define PG8_LDA(dst, b, h) do { _Pragma("unroll") for (int m = 0; m < 4; ++m) _Pragma("unroll") for (int k = 0; k < 2; ++k) dst[m][k] = *(const PG8_LAS bf16x8*)(lds + PG8_SA(b, h) + aoff + m * 2048 + k * 1024); } while (0)
#define PG8_LDB(dst, b, h) do { _Pragma("unroll") for (int n = 0; n < 2; ++n) _Pragma("unroll") for (int k = 0; k < 2; ++k) dst[n][k] = *(const PG8_LAS bf16x8*)(lds + PG8_SB(b, h) + boff + n * 2048 + k * 1024); } while (0)
#define PG8_MMA(ai, bj, At, Bt) do { __builtin_amdgcn_s_setprio(1); _Pragma("unroll") for (int m = 0; m < 4; ++m) _Pragma("unroll") for (int n = 0; n < 2; ++n) _Pragma("unroll") for (int k = 0; k < 2; ++k) \
        acc[ai][bj][m][n] = __builtin_amdgcn_mfma_f32_16x16x32_bf16(Bt[n][k], At[m][k], acc[ai][bj][m][n], 0, 0, 0); __builtin_amdgcn_s_setprio(0); } while (0)
#define PG8_WAIT_V(n) asm volatile("s_waitcnt vmcnt(" #n ")" ::: "memory")
#define PG8_WAIT_L(n) asm volatile("s_waitcnt lgkmcnt(" #n ")" ::: "memory")
#define PG8_BAR __builtin_amdgcn_s_barrier()
#define PG8_SCHED __builtin_amdgcn_sched_barrier(0)
    Unit cur, nxt; int ui = 0;
    if (!S.next(0, cur)) return;
    f32x4 acc[2][2][4][2];
#pragma unroll
    for (int a = 0; a < 2; ++a)
#pragma unroll
        for (int b = 0; b < 2; ++b)
#pragma unroll
            for (int m = 0; m < 4; ++m)
#pragma unroll
                for (int n = 0; n < 2; ++n) acc[a][b][m][n] = (f32x4){0.f, 0.f, 0.f, 0.f};
    bf16x8 At[4][2], B0[2][2], B1[2][2];
    const char* cA = (const char*)g.A + (size_t)cur.pm * tstep; const char* cB = (const char*)g.Bt + (size_t)cur.pn * tstep;
    S.a_ready(cur);
    if constexpr (SP2) {
        PG8_STAGE(PG8_SB(0, 0), cB, voffB); PG8_STAGE(PG8_SB(0, 1), cB + hstep, voffB); PG8_STAGE(PG8_SA(0, 0), cA, voffA); PG8_STAGE(PG8_SA(0, 1), cA + hstep, voffA);
        if (wr == 1) PG8_BAR;
        PG8_WAIT_V(2); PG8_BAR;
        PG8_STAGE(PG8_SB(1, 0), cB + kstep, voffB); PG8_STAGE(PG8_SA(1, 0), cA + kstep, voffA); PG8_STAGE(PG8_SB(1, 1), cB + hstep + kstep, voffB);
        PG8_WAIT_V(6); PG8_BAR;
    } else {
        PG8_STAGE(PG8_SB(0, 0), cB, voffB); PG8_STAGE(PG8_SA(0, 0), cA, voffA); PG8_STAGE(PG8_SB(0, 1), cB + hstep, voffB); PG8_STAGE(PG8_SA(0, 1), cA + hstep, voffA);
        if (wr == 1) PG8_BAR;
        PG8_WAIT_V(4); PG8_BAR;
        PG8_STAGE(PG8_SB(1, 0), cB + kstep, voffB); PG8_STAGE(PG8_SA(1, 0), cA + kstep, voffA); PG8_STAGE(PG8_SB(1, 1), cB + hstep + kstep, voffB);
        PG8_WAIT_V(6); PG8_BAR;
    }
    for (;;) {
        const bool has_next = S.next(ui + 1, nxt);
        const char* nA = has_next ? (const char*)g.A + (size_t)nxt.pm * tstep : cA; const char* nB = has_next ? (const char*)g.Bt + (size_t)nxt.pn * tstep : cB;
        for (int t = 0; t < nt; t += 2) {
            const bool last = (t == nt - 2);
            const char* a1 = cA + (size_t)(t + 1) * kstep;
            const char* a2 = last ? nA : cA + (size_t)(t + 2) * kstep; const char* b2 = last ? nB : cB + (size_t)(t + 2) * kstep;
            const char* a3 = a2 + kstep; const char* b3 = b2 + kstep;
            if (last && has_next) S.a_ready(nxt);
            if constexpr (SP2) {
            PG8_LDB(B0, 0, 0); PG8_LDB(B1, 0, 1); PG8_SCHED; PG8_LDA(At, 0, 0); PG8_STAGE(PG8_SA(1, 1), a1 + hstep, voffA);
            PG8_WAIT_V(8); PG8_WAIT_L(0); PG8_BAR; PG8_MMA(0, 0, At, B0); PG8_MMA(0, 1, At, B1); PG8_BAR; PG8_SCHED;
            PG8_LDA(At, 0, 1); PG8_STAGE(PG8_SB(0, 0), b2, voffB); PG8_STAGE(PG8_SB(0, 1), b2 + hstep, voffB); PG8_STAGE(PG8_SA(0, 0), a2, voffA);
            PG8_WAIT_V(8); PG8_WAIT_L(0); PG8_BAR; PG8_MMA(1, 0, At, B0); PG8_MMA(1, 1, At, B1); PG8_BAR; PG8_SCHED;
            PG8_LDB(B0, 1, 0); PG8_LDB(B1, 1, 1); PG8_SCHED; PG8_LDA(At, 1, 0); PG8_STAGE(PG8_SA(0, 1), a2 + hstep, voffA);
            PG8_WAIT_V(8); PG8_WAIT_L(0); PG8_BAR; PG8_MMA(0, 0, At, B0); PG8_MMA(0, 1, At, B1); PG8_BAR; PG8_SCHED;
            PG8_LDA(At, 1, 1); PG8_STAGE(PG8_SB(1, 0), b3, voffB); PG8_STAGE(PG8_SB(1, 1), b3 + hstep, voffB); PG8_STAGE(PG8_SA(1, 0), a3, voffA);
            PG8_WAIT_V(8); PG8_WAIT_L(0); PG8_BAR; PG8_MMA(1, 0, At, B0); PG8_MMA(1, 1, At, B1); PG8_BAR; PG8_SCHED;
            } else {
            PG8_LDB(B0, 0, 0); PG8_SCHED; PG8_LDA(At, 0, 0); PG8_STAGE(PG8_SA(1, 1), a1 + hstep, voffA);
            PG8_WAIT_L(8); PG8_BAR; PG8_WAIT_L(0); PG8_MMA(0, 0, At, B0); PG8_BAR; PG8_SCHED;
            PG8_LDB(B1, 0, 1); PG8_STAGE(PG8_SB(0, 0), b2, voffB);
            PG8_BAR; PG8_WAIT_L(0); PG8_MMA(0, 1, At, B1); PG8_BAR;
            PG8_LDA(At, 0, 1); PG8_STAGE(PG8_SA(0, 0), a2, voffA);
            PG8_BAR; PG8_WAIT_L(0); PG8_MMA(1, 0, At, B0); PG8_BAR; PG8_SCHED;
            PG8_STAGE(PG8_SB(0, 1), b2 + hstep, voffB);
            PG8_WAIT_V(6); PG8_BAR; PG8_MMA(1, 1, At, B1); PG8_BAR;
            PG8_LDB(B0, 1, 0); PG8_SCHED; PG8_LDA(At, 1, 0); PG8_STAGE(PG8_SA(0, 1), a2 + hstep, voffA);
            PG8_WAIT_L(8); PG8_BAR; PG8_WAIT_L(0); PG8_MMA(0, 0, At, B0); PG8_BAR; PG8_SCHED;
            PG8_LDB(B1, 1, 1); PG8_STAGE(PG8_SB(1, 0), b3, voffB);
            PG8_BAR; PG8_WAIT_L(0); PG8_MMA(0, 1, At, B1); PG8_BAR;
            PG8_LDA(At, 1, 1); PG8_STAGE(PG8_SA(1, 0), a3, voffA);
            PG8_BAR; PG8_WAIT_L(0); PG8_MMA(1, 0, At, B0); PG8_BAR; PG8_SCHED;
            PG8_STAGE(PG8_SB(1, 1), b3 + hstep, voffB);
            PG8_WAIT_V(6); PG8_BAR; PG8_MMA(1, 1, At, B1); PG8_BAR;
            }
        }
        if constexpr (ALIGN_EPI) { if (wr == 0) PG8_BAR; }
        if constexpr (!Epi::AFTER_DRAIN) { E(acc, cur, wr, wc, fr, fq); S.done(cur); }
        if (!has_next) break;
#pragma unroll
        for (int a = 0; a < 2; ++a)
#pragma unroll
            for (int b = 0; b < 2; ++b)
#pragma unroll
                for (int m = 0; m < 4; ++m)
#pragma unroll
                    for (int n = 0; n < 2; ++n) acc[a][b][m][n] = (f32x4){0.f, 0.f, 0.f, 0.f};
        cur = nxt; cA = nA; cB = nB; ++ui;
        if constexpr (ALIGN_EPI) { if (wr == 1) PG8_BAR; }
    }
    PG8_WAIT_V(0);
    if constexpr (!ALIGN_EPI) { if (wr == 0) PG8_BAR; }
    PG8_BAR;
    if constexpr (Epi::AFTER_DRAIN) { E.fused(acc, cur, wr, wc, fr, fq, lds, wid, lane); S.done(cur); }
#undef PG8_SA
#undef PG8_SB
#undef PG8_STAGE
#undef PG8_LDA
#undef PG8_LDB
#undef PG8_MMA
#undef PG8_WAIT_V
#undef PG8_WAIT_L
#undef PG8_BAR
#undef PG8_SCHED
}
}
namespace pg8 {
typedef unsigned u32x2v __attribute__((ext_vector_type(2)));
constexpr int TOK_S = 8192;
constexpr float QK_EPS = 1e-6f;
constexpr float C2 = 0.125f * 1.4426950408889634f;
__device__ __forceinline__ float sigmoid_fast(float v) { return 1.f / (1.f + __expf(-v)); }
__device__ __forceinline__ float silu_fast(float v) { return v / (1.f + __expf(-v)); }

struct EpiInProj {
    static constexpr bool PERM = true, AFTER_DRAIN = false;
    bf16_t* qkv;
    float* gates;
    float* kmean_part;
    const float *qna, *kna, *qnb, *knsel, *knwin;
    __device__ __forceinline__ void operator()(const f32x4 (&acc)[2][2][4][2], const Unit& u, int wr, int wc, int fr, int fq) const {
        const int slot = u.pn * 4 + wc;
        if (slot > 44) return;
        const int b = u.pm >> 5, blk = u.pm & 31, pos0 = blk * 256 + wr * 64 + fr;
        if (slot == 44) {
            if (fq < 3) {
#pragma unroll
                for (int ai = 0; ai < 2; ++ai)
#pragma unroll
                    for (int m = 0; m < 4; ++m) { const size_t tok = (size_t)b * TOK_S + pos0 + ai * HALF + m * 16; float* gp = gates + tok * 24 + 8 * fq;
                        const f32x4 v0 = acc[ai][0][m][0], v1 = acc[ai][0][m][1];
                        *(f32x4*)gp = (f32x4){sigmoid_fast(v0[0]), sigmoid_fast(v0[1]), sigmoid_fast(v0[2]), sigmoid_fast(v0[3])};
                        *(f32x4*)(gp + 4) = (f32x4){sigmoid_fast(v1[0]), sigmoid_fast(v1[1]), sigmoid_fast(v1[2]), sigmoid_fast(v1[3])}; }
            }
            return;
        }
        const float* gain = nullptr; float qscale = 1.f; bool is_ka = false; bf16_t* dst;
        constexpr size_t BIG = (size_t)4 * 8 * TOK_S * 64, SMALL = (size_t)4 * 2 * TOK_S * 64;
        if (slot < 32) { const int kind = slot >> 3, head = slot & 7; dst = qkv + kind * BIG + ((size_t)(b * 8 + head) * TOK_S) * 64;
            if (kind == 0) { gain = qna; qscale = C2; } else if (kind == 1) { gain = kna; is_ka = true; } else if (kind == 3) { gain = qnb; qscale = C2; } }
        else { const int kind = (slot - 32) >> 1, g = slot & 1; dst = qkv + 4 * BIG + kind * SMALL + ((size_t)(b * 2 + g) * TOK_S) * 64;
            if (kind == 2) gain = knsel; else if (kind == 4) gain = knwin; }
        float gv[16];
#pragma unroll
        for (int i = 0; i < 16; ++i) gv[i] = gain ? gain[(i >> 3) * 32 + 8 * fq + (i & 7)] * qscale : 1.f;
        float cs[16];
#pragma unroll
        for (int i = 0; i < 16; ++i) cs[i] = 0.f;
#pragma unroll
        for (int ai = 0; ai < 2; ++ai)
#pragma unroll
            for (int m = 0; m < 4; ++m) {
                float v[16];
#pragma unroll
                for (int bj = 0; bj < 2; ++bj)
#pragma unroll
                    for (int n = 0; n < 2; ++n)
#pragma unroll
                        for (int j = 0; j < 4; ++j) v[bj * 8 + n * 4 + j] = acc[ai][bj][m][n][j];
                if (gain) { float ss = 0.f;
#pragma unroll
                    for (int i = 0; i < 16; ++i) ss += v[i] * v[i];
                    ss += __shfl_xor(ss, 16); ss += __shfl_xor(ss, 32);
                    const float rs = rsqrtf(ss * (1.f / 64.f) + QK_EPS);
#pragma unroll
                    for (int i = 0; i < 16; ++i) v[i] *= rs * gv[i]; }
                if (is_ka) {
#pragma unroll
                    for (int i = 0; i < 16; ++i) cs[i] += v[i]; }
                bf16_t* rp = dst + (size_t)(pos0 + ai * HALF + m * 16) * 64 + 8 * fq;
                u32x4 w0, w1;
                w0.x = cvt_pk_bf16(v[0], v[1]); w0.y = cvt_pk_bf16(v[2], v[3]); w0.z = cvt_pk_bf16(v[4], v[5]); w0.w = cvt_pk_bf16(v[6], v[7]);
                w1.x = cvt_pk_bf16(v[8], v[9]); w1.y = cvt_pk_bf16(v[10], v[11]); w1.z = cvt_pk_bf16(v[12], v[13]); w1.w = cvt_pk_bf16(v[14], v[15]);
                *(u32x4*)rp = w0; *(u32x4*)(rp + 32) = w1;
            }
        if (is_ka) {
#pragma unroll
            for (int i = 0; i < 16; ++i) { float s = cs[i]; s += __shfl_xor(s, 1); s += __shfl_xor(s, 2); s += __shfl_xor(s, 4); s += __shfl_xor(s, 8); cs[i] = s; }
            if (fr == 0) { float* kp = kmean_part + ((size_t)((b * 8 + (slot & 7)) * 32 + blk) * 2 + wr) * 64 + 8 * fq;
                *(f32x4*)kp = (f32x4){cs[0], cs[1], cs[2], cs[3]}; *(f32x4*)(kp + 4) = (f32x4){cs[4], cs[5], cs[6], cs[7]};
                *(f32x4*)(kp + 32) = (f32x4){cs[8], cs[9], cs[10], cs[11]}; *(f32x4*)(kp + 36) = (f32x4){cs[12], cs[13], cs[14], cs[15]}; }
        }
    }
};
struct EpiOutProj {
    static constexpr bool PERM = false, AFTER_DRAIN = false;
    const float* x; float* out; const float* gt;
    __device__ __forceinline__ void operator()(const f32x4 (&acc)[2][2][4][2], const Unit& u, int wr, int wc, int fr, int fq) const {
        const int b = u.pm >> 5; const int col0 = u.pn * BM + wc * 32 + 4 * fq; const float* gtb = gt + (size_t)b * 6144;
#pragma unroll
        for (int bj = 0; bj < 2; ++bj)
#pragma unroll
            for (int n = 0; n < 2; ++n) { const int c = col0 + bj * HALF + n * 16; const f32x4 g4 = *(const f32x4*)(gtb + c);
#pragma unroll
                for (int ai = 0; ai < 2; ++ai)
#pragma unroll
                    for (int m = 0; m < 4; ++m) { const size_t off = (size_t)(u.pm * BM + ai * HALF + wr * 64 + m * 16 + fr) * 1024 + c;
                        const f32x4 xv = *(const f32x4*)(x + off); *(f32x4*)(out + off) = xv + g4 * acc[ai][bj][m][n]; } }
    }
};
struct EpiGateUp {
    static constexpr bool PERM = true, AFTER_DRAIN = false;
    bf16_t* act;
    __device__ __forceinline__ void operator()(const f32x4 (&acc)[2][2][4][2], const Unit& u, int wr, int wc, int fr, int fq) const {
        const int h0 = u.pn * 128 + wc * 32 + 8 * fq;
#pragma unroll
        for (int ai = 0; ai < 2; ++ai)
#pragma unroll
            for (int m = 0; m < 4; ++m) { const size_t row = (size_t)(u.pm * BM + ai * HALF + wr * 64 + m * 16 + fr);
                const f32x4 g0 = acc[ai][0][m][0], g1 = acc[ai][0][m][1], u0 = acc[ai][1][m][0], u1 = acc[ai][1][m][1];
                u32x4 w;
                w.x = cvt_pk_bf16(silu_fast(g0[0]) * u0[0], silu_fast(g0[1]) * u0[1]); w.y = cvt_pk_bf16(silu_fast(g0[2]) * u0[2], silu_fast(g0[3]) * u0[3]);
                w.z = cvt_pk_bf16(silu_fast(g1[0]) * u1[0], silu_fast(g1[1]) * u1[1]); w.w = cvt_pk_bf16(silu_fast(g1[2]) * u1[2], silu_fast(g1[3]) * u1[3]);
                *(u32x4*)(act + row * 2816 + h0) = w; }
    }
};
struct EpiDown {
    static constexpr bool PERM = false, AFTER_DRAIN = false;
    float* out; const float* gt;
    __device__ __forceinline__ void operator()(const f32x4 (&acc)[2][2][4][2], const Unit& u, int wr, int wc, int fr, int fq) const {
        const int b = u.pm >> 5; const int col0 = u.pn * BM + wc * 32 + 4 * fq; const float* gtb = gt + (size_t)b * 6144;
#pragma unroll
        for (int bj = 0; bj < 2; ++bj)
#pragma unroll
            for (int n = 0; n < 2; ++n) { const int c = col0 + bj * HALF + n * 16; const f32x4 g4 = *(const f32x4*)(gtb + c);
#pragma unroll
                for (int ai = 0; ai < 2; ++ai)
#pragma unroll
                    for (int m = 0; m < 4; ++m) { const size_t off = (size_t)(u.pm * BM + ai * HALF + wr * 64 + m * 16 + fr) * 1024 + c;
                        const f32x4 xv = *(const f32x4*)(out + off); *(f32x4*)(out + off) = xv + g4 * acc[ai][bj][m][n]; } }
    }
};
}
constexpr int NWAVES = 8, NTHREADS = 512;
constexpr int BATCH = 4, SEQ = 8192, DM = 1024, TOK = BATCH * SEQ, NIN = 2840, NIN_PAD = 3072, FF = 2816, NCMP = 511;
constexpr size_t MiB = 1u << 20;
constexpr size_t WS_CTL = 0, CTL_ZERO_BYTES = 64 * 1024;
constexpr size_t WS_MODP = 1 * MiB;
constexpr size_t WS_MOD = 2 * MiB;
constexpr size_t WS_CBP = 2 * MiB + 512 * 1024;
constexpr size_t WS_KMP = 3 * MiB;
constexpr size_t WS_BIAS2 = 4 * MiB;
constexpr size_t WS_SSP = 449 * MiB;
constexpr size_t WS_WIN = 6 * MiB, WS_WOUT = 12 * MiB, WS_WGU = 14 * MiB, WS_WDN = 25 * MiB;
constexpr size_t WS_W1K = 31 * MiB, WS_W1V = 32 * MiB, WS_W2K = 33 * MiB, WS_W2V = 33 * MiB + 64 * 1024;
constexpr size_t WS_KCMP = 34 * MiB, WS_VCMP = 35 * MiB;
constexpr size_t WS_GATES = 36 * MiB;
constexpr size_t WS_H = 40 * MiB;
constexpr size_t WS_MIX = 104 * MiB;
constexpr size_t WS_QKV = 168 * MiB;
constexpr size_t WS_ACT = WS_QKV;
constexpr size_t WS_END = 344 * MiB;
constexpr size_t WS_PARTO = 344 * MiB;
constexpr size_t WS_PARTL = 444 * MiB;
constexpr size_t WS_SELG = 448 * MiB;
constexpr size_t QKV_BIG = (size_t)4 * 8 * SEQ * 64, QKV_SMALL = (size_t)4 * 2 * SEQ * 64;
constexpr int RING_BYTES = 131072, LDS_BYTES = 147456;
constexpr int N_PHASES = 10;

#define GAS __attribute__((address_space(1)))
#define LAS __attribute__((address_space(3)))
typedef unsigned short bf16;
typedef unsigned v4u __attribute__((ext_vector_type(4)));
typedef float f32x4 __attribute__((ext_vector_type(4)));
#define LDS_WAIT() asm volatile("s_waitcnt lgkmcnt(0)" ::: "memory")
#define VM_WAIT() asm volatile("s_waitcnt vmcnt(0)" ::: "memory")
__device__ __forceinline__ unsigned f2bf(float f) { unsigned u = __builtin_bit_cast(unsigned, f); return (u + 0x7fffu + ((u >> 16) & 1u)) >> 16; }
__device__ __forceinline__ unsigned pk2(float lo, float hi) { return f2bf(lo) | (f2bf(hi) << 16); }
__device__ __forceinline__ float bf2f(bf16 v) { return __builtin_bit_cast(float, (unsigned)v << 16); }
__device__ __forceinline__ float wave_sum(float v) {
#pragma unroll
    for (int o = 1; o < 64; o <<= 1) v += __shfl_xor(v, o);
    return v;
}
struct Args { const float* in[23]; float* out; unsigned char* ws; int ph_lo, ph_hi; };
struct Frame { LAS unsigned char* lds; int tid, lane, wave, vcu, G; };

struct MapId { __device__ __forceinline__ int operator()(int n) const { return n; } };
struct MapWin { __device__ __forceinline__ int operator()(int n) const { const int s = n >> 6, d = n & 63; return 256 * (s >> 2) + 128 * (d >> 5) + 32 * (s & 3) + (d & 31); } };
struct MapWgu { __device__ __forceinline__ int operator()(int n) const { const int up = n >= FF, hdn = up ? n - FF : n; return 256 * (hdn >> 7) + 128 * up + (hdn & 127); } };
template <class Map>
__device__ __forceinline__ void transpose_item(const float* __restrict__ W, int K, int N, bf16* WT, LAS float* scr, int item, int lane, const Map& map) {
    const int nblk = (N + 31) / 32, kb = item / nblk, nb = item % nblk, k0 = 64 * kb, n0 = 32 * nb;
    const bool nin = n0 + (lane & 31) < N;
#pragma unroll 8
    for (int i = 0; i < 32; ++i) { const int kk = 2 * i + (lane >> 5); scr[kk * 33 + (lane & 31)] = nin ? W[(size_t)(k0 + kk) * N + n0 + (lane & 31)] : 0.f; }
    LDS_WAIT(); asm volatile("" ::: "memory");
    const int c = lane & 7;
#pragma unroll
    for (int j = 0; j < 4; ++j) { const int n = (lane >> 3) + 8 * j; const LAS float* s = scr + (8 * c) * 33 + n;
        v4u o; o.x = pk2(s[0 * 33], s[1 * 33]); o.y = pk2(s[2 * 33], s[3 * 33]); o.z = pk2(s[4 * 33], s[5 * 33]); o.w = pk2(s[6 * 33], s[7 * 33]);
        if (n0 + n < N) *(GAS v4u*)(WT + (size_t)map(n0 + n) * K + k0 + 8 * c) = o; }
    LDS_WAIT(); asm volatile("" ::: "memory");
}
__device__ __forceinline__ float silu_acc(float v) { return v / (1.f + expf(-v)); }
__device__ __forceinline__ void phase_prologue_a(Frame& F, const Args& a) {
    LAS float* scr = (LAS float*)(F.lds + F.wave * 16384);
    const int gw = F.vcu * NWAVES + F.wave, NGW = F.G * NWAVES;
    unsigned char* ws = a.ws;
    constexpr int I_IN = (DM / 64) * ((NIN + 31) / 32), I_OUT = (DM / 64) * (DM / 32), I_GU = (DM / 64) * (2 * FF / 32), I_DN = (FF / 64) * (DM / 32), I_W1 = (2048 / 64) * (256 / 32), I_W2 = (256 / 64) * (64 / 32);
    constexpr int NITEMS = I_IN + I_OUT + I_GU + I_DN + 2 * I_W1 + 2 * I_W2;
    for (int it = gw; it < NITEMS; it += NGW) {
        int r = it;
        if (r < I_IN) { transpose_item(a.in[6], DM, NIN, (bf16*)(ws + WS_WIN), scr, r, F.lane, MapWin()); continue; } r -= I_IN;
        if (r < I_OUT) { transpose_item(a.in[19], DM, DM, (bf16*)(ws + WS_WOUT), scr, r, F.lane, MapId()); continue; } r -= I_OUT;
        if (r < I_GU) { transpose_item(a.in[21], DM, 2 * FF, (bf16*)(ws + WS_WGU), scr, r, F.lane, MapWgu()); continue; } r -= I_GU;
        if (r < I_DN) { transpose_item(a.in[22], FF, DM, (bf16*)(ws + WS_WDN), scr, r, F.lane, MapId()); continue; } r -= I_DN;
        if (r < I_W1) { transpose_item(a.in[14], 2048, 256, (bf16*)(ws + WS_W1K), scr, r, F.lane, MapId()); continue; } r -= I_W1;
        if (r < I_W1) { transpose_item(a.in[17], 2048, 256, (bf16*)(ws + WS_W1V), scr, r, F.lane, MapId()); continue; } r -= I_W1;
        if (r < I_W2) { transpose_item(a.in[15], 256, 64, (bf16*)(ws + WS_W2K), scr, r, F.lane, MapId()); continue; } r -= I_W2;
        transpose_item(a.in[18], 256, 64, (bf16*)(ws + WS_W2V), scr, r, F.lane, MapId());
    }
    const float* c = a.in[1]; const float* w_ada = a.in[3]; float* modp = (float*)(ws + WS_MODP);
    for (int t = NGW - 1 - gw; t < 96 * 8; t += NGW) { const int cg_ = t % 96, ks = t / 96; const int n = cg_ * 64 + F.lane;
        float acc0 = 0.f, acc1 = 0.f, acc2 = 0.f, acc3 = 0.f;
#pragma unroll 8
        for (int k = ks * 128; k < ks * 128 + 128; ++k) { const float w = w_ada[(size_t)k * 6144 + n];
            acc0 += silu_acc(c[k]) * w; acc1 += silu_acc(c[DM + k]) * w; acc2 += silu_acc(c[2 * DM + k]) * w; acc3 += silu_acc(c[3 * DM + k]) * w; }
        float* o = modp + (size_t)ks * 4 * 6144 + n; o[0] = acc0; o[6144] = acc1; o[2 * 6144] = acc2; o[3 * 6144] = acc3; }
    float* cbp = (float*)(ws + WS_CBP);
    for (int t = NGW / 2 - 1 - gw; t >= 0 && t < 256; t += NGW) { const int kv = t & 1, cg_ = (t >> 1) & 3, ic = t >> 3; const int n = cg_ * 64 + F.lane;
        const float* pe = kv ? a.in[16] : a.in[13]; const float* w1 = kv ? a.in[17] : a.in[14]; float acc = 0.f;
#pragma unroll 8
        for (int i = ic * 64; i < ic * 64 + 64; ++i) acc += pe[i] * w1[(size_t)i * 256 + n];
        cbp[(ic * 2 + kv) * 256 + n] = acc; }
}
__device__ __forceinline__ void norm_rows(Frame& F, const float* in, const f32x4 (&gs)[4], const f32x4 (&sh)[4], bf16* out) {
    for (int i = 0; i < 16; ++i) { const int row = F.vcu * 128 + F.wave * 16 + i;
        const GAS f32x4* xr = (const GAS f32x4*)(in + (size_t)row * DM) + F.lane;
        f32x4 v[4]; float ss = 0.f;
#pragma unroll
        for (int j = 0; j < 4; ++j) { v[j] = xr[64 * j]; ss += (v[j].x * v[j].x + v[j].y * v[j].y) + (v[j].z * v[j].z + v[j].w * v[j].w); }
        const float rs = rsqrtf(wave_sum(ss) * (1.f / DM) + 1e-6f);
        GAS unsigned long long* o8 = (GAS unsigned long long*)(out + (size_t)row * DM) + F.lane;
#pragma unroll
        for (int j = 0; j < 4; ++j) { const f32x4 y = v[j] * rs * gs[j] + sh[j]; o8[64 * j] = (unsigned long long)pk2(y.x, y.y) | ((unsigned long long)pk2(y.z, y.w) << 32); } }
}
__device__ __forceinline__ void phase_prologue_b(Frame& F, const Args& a) {
    unsigned char* ws = a.ws; const float* modp = (const float*)(ws + WS_MODP); const float* b_ada = a.in[4];
    if (F.wave == 0 && F.vcu < 96) { const int n = F.vcu * 64 + F.lane; float* mod = (float*)(ws + WS_MOD);
        for (int b = 0; b < 4; ++b) { float s = 0.f;
#pragma unroll
            for (int ks = 0; ks < 8; ++ks) s += modp[((size_t)ks * 4 + b) * 6144 + n];
            mod[b * 6144 + n] = s + b_ada[n]; } }
    const int b = F.vcu >> 6; const float* g = a.in[5];
    f32x4 gs[4], sh[4];
#pragma unroll
    for (int j = 0; j < 4; ++j) { const int c0 = 4 * F.lane + 256 * j; f32x4 s0 = {0.f, 0.f, 0.f, 0.f}, s1 = {0.f, 0.f, 0.f, 0.f};
#pragma unroll
        for (int ks = 0; ks < 8; ++ks) { s0 += *(const f32x4*)(modp + ((size_t)ks * 4 + b) * 6144 + c0); s1 += *(const f32x4*)(modp + ((size_t)ks * 4 + b) * 6144 + DM + c0); }
        s0 += *(const f32x4*)(b_ada + c0); s1 += *(const f32x4*)(b_ada + DM + c0);
        sh[j] = s0; gs[j] = *(const f32x4*)(g + c0) * (s1 + 1.0f); }
    norm_rows(F, a.in[0], gs, sh, (bf16*)(ws + WS_H));
}
__device__ __forceinline__ void phase_norm2(Frame& F, const Args& a) {
    unsigned char* ws = a.ws; const int b = F.vcu >> 6; const float* mod = (const float*)(ws + WS_MOD) + (size_t)b * 6144; const float* g = a.in[20];
    f32x4 gs[4], sh[4];
#pragma unroll
    for (int j = 0; j < 4; ++j) { const int c0 = 4 * F.lane + 256 * j; sh[j] = *(const f32x4*)(mod + 3 * DM + c0); gs[j] = *(const f32x4*)(g + c0) * (*(const f32x4*)(mod + 4 * DM + c0) + 1.0f); }
    norm_rows(F, a.out, gs, sh, (bf16*)(ws + WS_H));
}

__device__ __forceinline__ void phase_bias2(Frame& F, const Args& a) {
    unsigned char* ws = a.ws; const float* mod = (const float*)(ws + WS_MOD); const bf16* wt = (const bf16*)(ws + WS_WGU); float* bias2 = (float*)(ws + WS_BIAS2);
    const int gw = F.vcu * NWAVES + F.wave, NGW = F.G * NWAVES;
    f32x4 sh[4][4];
#pragma unroll
    for (int bb = 0; bb < 4; ++bb)
#pragma unroll
        for (int j = 0; j < 4; ++j) sh[bb][j] = *(const f32x4*)(mod + (size_t)bb * 6144 + 3 * DM + 16 * F.lane + 4 * j);
    for (int c = gw; c < 2 * FF; c += NGW) {
        const v4u w0 = *(const GAS v4u*)(wt + (size_t)c * DM + 16 * F.lane), w1 = *(const GAS v4u*)(wt + (size_t)c * DM + 16 * F.lane + 8);
        const unsigned wu[8] = {w0.x, w0.y, w0.z, w0.w, w1.x, w1.y, w1.z, w1.w};
        float s[4] = {0.f, 0.f, 0.f, 0.f};
#pragma unroll
        for (int j = 0; j < 4; ++j) { const float e0 = __builtin_bit_cast(float, wu[2 * j] << 16), e1 = __builtin_bit_cast(float, wu[2 * j] & 0xffff0000u), e2 = __builtin_bit_cast(float, wu[2 * j + 1] << 16), e3 = __builtin_bit_cast(float, wu[2 * j + 1] & 0xffff0000u);
#pragma unroll
            for (int bb = 0; bb < 4; ++bb) s[bb] += (sh[bb][j][0] * e0 + sh[bb][j][1] * e1) + (sh[bb][j][2] * e2 + sh[bb][j][3] * e3); }
#pragma unroll
        for (int bb = 0; bb < 4; ++bb) { const float t = wave_sum(s[bb]); if (F.lane == 0) bias2[(size_t)bb * 2 * FF + c] = t; }
    }
}
#define XB_TMO      128
#define XB_XCNT(j)  (256  + 64 * (j))
#define XB_XSUB(j)  (1280 + 64 * (j))
#define XB_XGEN(j)  (2304 + 64 * (j))
#define XB_TOP      3328
#define XB_TOPGEN   3392
#define XCD_BAR_WORDS 3456
#define XB_SPIN_CAP (1u << 18)

__device__ __forceinline__ unsigned xb_ld(unsigned* p)              { return __hip_atomic_load(p, __ATOMIC_RELAXED, __HIP_MEMORY_SCOPE_AGENT); }
__device__ __forceinline__ unsigned xb_add(unsigned* p, unsigned v) { return __hip_atomic_fetch_add(p, v, __ATOMIC_RELAXED, __HIP_MEMORY_SCOPE_AGENT); }
__device__ __forceinline__ unsigned xb_xcc_id() { return (unsigned)__builtin_amdgcn_s_getreg((3 << 11) | 20) & 0xFu; }
#define XB_SPIN(cond, bar) do { unsigned _sp = 0; while (cond) { __builtin_amdgcn_s_sleep(1); \
    if ((++_sp & 255u) == 0u) { if (xb_ld(&(bar)[XB_TMO])) break; if (_sp > XB_SPIN_CAP) { atomicAdd(&(bar)[XB_TMO], 1u); break; } } } } while (0)

struct XcdBarrier {
    unsigned* bar; unsigned x;
    volatile LAS unsigned* st;
};

__device__ __forceinline__ XcdBarrier xcd_barrier_post(unsigned* bar, volatile LAS unsigned* st) {
    XcdBarrier b; b.bar = bar; b.x = xb_xcc_id(); b.st = st;
    if (threadIdx.x == 0) (void)xb_add(&bar[XB_XCNT(b.x)], 1u);
    return b;
}
__device__ __forceinline__ void xcd_barrier_complete(unsigned* bar, unsigned x, unsigned& nloc, unsigned& nx) {
    const unsigned G = gridDim.x * gridDim.y * gridDim.z;
    unsigned sum, cnt, mine, sp = 0u;
    for (;;) {
        sum = 0u; cnt = 0u; mine = 0u;
#pragma unroll
        for (unsigned j = 0; j < 16; ++j) { const unsigned c = xb_ld(&bar[XB_XCNT(j)]); sum += c; cnt += (c > 0u) ? 1u : 0u; mine = (j == x) ? c : mine; }
        if (sum == G) break;
        __builtin_amdgcn_s_sleep(1);
        if ((++sp & 255u) == 0u) { if (xb_ld(&bar[XB_TMO])) break; if (sp > XB_SPIN_CAP) { atomicAdd(&bar[XB_TMO], 1u); break; } }
    }
    nloc = mine > 0u ? mine : 1u; nx = cnt > 0u ? cnt : 1u;
}

__device__ __forceinline__ void xcd_barrier(const XcdBarrier& b) {
    asm volatile("s_waitcnt vmcnt(0)" ::: "memory");
    __syncthreads();
    if (threadIdx.x == 0) {
        unsigned* bar = b.bar;
        __builtin_amdgcn_s_waitcnt(0);
        unsigned nloc = b.st[0], nx = b.st[1];
        if (nloc == 0u) { xcd_barrier_complete(bar, b.x, nloc, nx); b.st[0] = nloc; b.st[1] = nx; }
        const unsigned old = xb_add(&bar[XB_XSUB(b.x)], 1u);
        const unsigned gen = old / nloc;
        if (old + 1u == (gen + 1u) * nloc) {
            __builtin_amdgcn_fence(__ATOMIC_RELEASE, "agent");
            asm volatile("s_waitcnt vmcnt(0)" ::: "memory");
            const unsigned og = xb_add(&bar[XB_TOP], 1u);
            const unsigned tg = og / nx;
            if (og + 1u == (tg + 1u) * nx) xb_add(&bar[XB_TOPGEN], 1u);
            else XB_SPIN(xb_ld(&bar[XB_TOPGEN]) == tg, bar);
            __builtin_amdgcn_fence(__ATOMIC_ACQUIRE, "agent");
            xb_add(&bar[XB_XGEN(b.x)], 1u);
            asm volatile("s_waitcnt vmcnt(0)" ::: "memory");
        } else {
            XB_SPIN(xb_ld(&bar[XB_XGEN(b.x)]) == gen, bar);
            __builtin_amdgcn_fence(__ATOMIC_ACQUIRE, "agent");
            asm volatile("s_waitcnt vmcnt(0)" ::: "memory");
        }
    }
    __syncthreads();
}
#define ATT_NS att
#ifndef ATT_ABL
#define ATT_ABL 0
#endif
#ifndef ATT_STAGGER
#define ATT_STAGGER 0
#endif
namespace ATT_NS {
using bf16x8 = __attribute__((ext_vector_type(8))) short;
using s16x4 = __attribute__((ext_vector_type(4))) short;
using f32x16 = __attribute__((ext_vector_type(16))) float;
using u32x4 = __attribute__((ext_vector_type(4))) unsigned;
typedef LAS const char* lds_cptr;
typedef short v4i16_t __attribute__((ext_vector_type(4)));
constexpr int SLOT = 16384, NSLOT = 4, LDS_OST = 65536, LDS_LUT = 98304, LDS_IMP = 100352, LDS_SELM = 133120, LDS_MISC = 134144, LDS_WSF = 134400, LDS_ATT_END = 136448;
constexpr float LOG2E = 1.4426950408889634f;
#define MFMA32(a, b, c) __builtin_amdgcn_mfma_f32_32x32x16_bf16(a, b, c, 0, 0, 0)
#define ATT_WAIT_BAR(N) asm volatile("s_waitcnt vmcnt(" #N ") lgkmcnt(0)\n\ts_barrier" ::: "memory")
__device__ __forceinline__ void glds16(const void* gsrc, unsigned lds_dst) { unsigned keep;
    asm volatile("s_mov_b32 %0, m0\n\ts_mov_b32 m0, %2\n\ts_nop 0\n\tglobal_load_lds_dwordx4 %1, off\n\ts_mov_b32 m0, %0" : "=&s"(keep) : "v"(gsrc), "s"(lds_dst) : "memory"); }
typedef float f32x2_t __attribute__((ext_vector_type(2))); typedef __bf16 bf16x2_t __attribute__((ext_vector_type(2)));
__device__ __forceinline__ unsigned cvtpk(float lo, float hi) { f32x2_t v = {lo, hi}; bf16x2_t b = __builtin_convertvector(v, bf16x2_t); return __builtin_bit_cast(unsigned, b); }
__device__ __forceinline__ s16x4 vtr(lds_cptr p) { return __builtin_bit_cast(s16x4, __builtin_amdgcn_ds_read_tr16_b64_v4i16((LAS v4i16_t*)p)); }
__device__ __forceinline__ int t5_bucket(int d) {
    if (d < 16) return d;
    int b = 16;
    b += (d >= 19); b += (d >= 21); b += (d >= 24); b += (d >= 27); b += (d >= 31); b += (d >= 35); b += (d >= 40); b += (d >= 46);
    b += (d >= 52); b += (d >= 59); b += (d >= 67); b += (d >= 77); b += (d >= 87); b += (d >= 99); b += (d >= 113);
    return b;
}
struct Ctx { LAS char* lds; int wid; int lane, r32, hi; };
__device__ __forceinline__ int fresh_lane() { int l; asm volatile("v_mbcnt_lo_u32_b32 %0, -1, 0\n\tv_mbcnt_hi_u32_b32 %0, -1, %0" : "=v"(l)); return l; }
__device__ __forceinline__ Ctx make_ctx(LAS unsigned char* lds, int tid) {
    Ctx c; c.lds = (LAS char*)lds; c.wid = __builtin_amdgcn_readfirstlane(tid >> 6); c.lane = tid & 63; c.r32 = c.lane & 31; c.hi = c.lane >> 5; return c;
}
template <bool HASV, class QK, class SM>
__device__ __forceinline__ void run_stream(const Ctx& c, const bf16* Kb, const bf16* Vb, int t0, int t1, QK&& qk, SM&& sm) {
    const int n = t1 - t0; if (n <= 0) return;
    const int lane = fresh_lane(), r32 = lane & 31, hi = lane >> 5; const unsigned lds0 = (unsigned)(uintptr_t)c.lds;
    const bf16* ks = Kb + (lane * 64 + c.wid * 8); const bf16* vs = Vb + ((16 * (c.wid & 3) + (lane >> 2)) * 64 + (c.wid >> 2) * 32 + (lane & 3) * 8);
    const unsigned kdst = lds0 + c.wid * 1024, vdst = lds0 + 8192 + c.wid * 1024;
    const lds_cptr kp0 = (lds_cptr)c.lds + hi * 1024 + r32 * 16;
    const lds_cptr vp0 = (lds_cptr)c.lds + 8192 + ((lane >> 4) & 1) * 32 + (lane & 3) * 8 + (4 * hi + ((lane & 15) >> 2)) * 64;
#define ATT_ISSUE(t, so) do { if (ATT_ABL & 4) break; glds16(ks + (size_t)(t) * 4096, (unsigned)__builtin_amdgcn_readfirstlane(kdst + (so))); if (HASV) glds16(vs + (size_t)(t) * 4096, (unsigned)__builtin_amdgcn_readfirstlane(vdst + (so))); } while (0)
    ATT_ISSUE(t0, 0); if (n > 1) ATT_ISSUE(t0 + 1, SLOT);
    const bool late = ATT_STAGGER && __builtin_amdgcn_readfirstlane(c.wid) >= 4;
    f32x16 s0 = {}, s1 = {};
    int slot = 0, slotp = 3 * SLOT, slot2 = 2 * SLOT;
    if (!late) {
        for (int i = 0; i < n; ++i) {
            if (i + 1 < n) { if (HASV) ATT_WAIT_BAR(2); else ATT_WAIT_BAR(1); } else ATT_WAIT_BAR(0);
            if (i + 2 < n) ATT_ISSUE(t0 + i + 2, slot2);
            if (!(ATT_ABL & 1)) qk(t0 + i, kp0 + slot, s0, s1); if (!(ATT_ABL & 2)) sm(t0 + i, vp0 + slot, s0, s1);
            slot = (slot == 3 * SLOT) ? 0 : slot + SLOT; slot2 = (slot2 == 3 * SLOT) ? 0 : slot2 + SLOT;
        }
    } else {
        for (int i = 0; i < n; ++i) {
            if (i + 1 < n) { if (HASV) ATT_WAIT_BAR(2); else ATT_WAIT_BAR(1); } else ATT_WAIT_BAR(0);
            if (i + 2 < n) ATT_ISSUE(t0 + i + 2, slot2);
            if (i > 0 && !(ATT_ABL & 2)) sm(t0 + i - 1, vp0 + slotp, s0, s1);
            if (!(ATT_ABL & 1)) qk(t0 + i, kp0 + slot, s0, s1);
            slotp = slot; slot = (slot == 3 * SLOT) ? 0 : slot + SLOT; slot2 = (slot2 == 3 * SLOT) ? 0 : slot2 + SLOT;
        }
        if (!(ATT_ABL & 2)) sm(t0 + n - 1, vp0 + slotp, s0, s1);
    }
    asm volatile("s_waitcnt lgkmcnt(0)\n\ts_barrier" ::: "memory");
#undef ATT_ISSUE
}
template <class FN1, class FN2>
__device__ __forceinline__ void run_stream_pairs(const Ctx& c, const bf16* Kb, const bf16* Vb, int t0, int t1, FN1&& fn1, FN2&& fn2) {
    const int n = t1 - t0; if (n <= 0) return;
    const int lane = fresh_lane(), r32 = lane & 31, hi = lane >> 5; const unsigned lds0 = (unsigned)(uintptr_t)c.lds;
    const bf16* ks = Kb + (lane * 64 + c.wid * 8); const bf16* vs = Vb + ((16 * (c.wid & 3) + (lane >> 2)) * 64 + (c.wid >> 2) * 32 + (lane & 3) * 8);
    const unsigned kdst = lds0 + c.wid * 1024, vdst = lds0 + 8192 + c.wid * 1024;
    const lds_cptr kp0 = (lds_cptr)c.lds + hi * 1024 + r32 * 16;
    const lds_cptr vp0 = (lds_cptr)c.lds + 8192 + ((lane >> 4) & 1) * 32 + (lane & 3) * 8 + (4 * hi + ((lane & 15) >> 2)) * 64;
#define ATT_ISSUE1(t, so) do { glds16(ks + (size_t)(t) * 4096, (unsigned)__builtin_amdgcn_readfirstlane(kdst + (so))); glds16(vs + (size_t)(t) * 4096, (unsigned)__builtin_amdgcn_readfirstlane(vdst + (so))); } while (0)
    ATT_ISSUE1(t0, 0); if (n > 1) ATT_ISSUE1(t0 + 1, SLOT);
    int base = 0;
    for (int i = 0; i < n; i += 2) {
        ATT_WAIT_BAR(0);
        const int nb = 2 * SLOT - base;
        if (i + 2 < n) ATT_ISSUE1(t0 + i + 2, nb); if (i + 3 < n) ATT_ISSUE1(t0 + i + 3, nb + SLOT);
        if (i + 1 < n) fn2(t0 + i, kp0 + base, vp0 + base, kp0 + base + SLOT, vp0 + base + SLOT); else fn1(t0 + i, kp0 + base, vp0 + base);
        base = nb;
    }
    asm volatile("s_waitcnt lgkmcnt(0)\n\ts_barrier" ::: "memory");
#undef ATT_ISSUE1
}
__device__ __forceinline__ void qk_tile(f32x16& s0, f32x16& s1, lds_cptr kp, const bf16x8 (&qr)[4]) {
    bf16x8 kf[8];
#pragma unroll
    for (int d0 = 0; d0 < 4; ++d0) { kf[2 * d0] = *(const LAS bf16x8*)(kp + d0 * 2048); kf[2 * d0 + 1] = *(const LAS bf16x8*)(kp + d0 * 2048 + 512); }
    const f32x16 z = {};
    s0 = MFMA32(kf[0], qr[0], z); s1 = MFMA32(kf[1], qr[0], z);
#pragma unroll
    for (int d0 = 1; d0 < 4; ++d0) { s0 = MFMA32(kf[2 * d0], qr[d0], s0); s1 = MFMA32(kf[2 * d0 + 1], qr[d0], s1); }
}
template <bool MASK>
__device__ __forceinline__ void pv_tile(f32x16 (&o)[2], lds_cptr vp, const f32x16& p0, const f32x16& p1, unsigned mask) {
    if (ATT_ABL & 8) { o[0][0] += p0[0] + p1[5]; return; }
    u32x4 pw0 = {cvtpk(p0[0], p0[1]), cvtpk(p0[2], p0[3]), cvtpk(p0[4], p0[5]), cvtpk(p0[6], p0[7])}, pw1 = {cvtpk(p0[8], p0[9]), cvtpk(p0[10], p0[11]), cvtpk(p0[12], p0[13]), cvtpk(p0[14], p0[15])};
    u32x4 pw2 = {cvtpk(p1[0], p1[1]), cvtpk(p1[2], p1[3]), cvtpk(p1[4], p1[5]), cvtpk(p1[6], p1[7])}, pw3 = {cvtpk(p1[8], p1[9]), cvtpk(p1[10], p1[11]), cvtpk(p1[12], p1[13]), cvtpk(p1[14], p1[15])};
    if (MASK) { pw0 &= mask; pw1 &= mask; pw2 &= mask; pw3 &= mask; }
    if (ATT_ABL & 64) { o[0] = MFMA32(__builtin_bit_cast(bf16x8, pw0), __builtin_bit_cast(bf16x8, pw1), o[0]); o[1] = MFMA32(__builtin_bit_cast(bf16x8, pw2), __builtin_bit_cast(bf16x8, pw3), o[1]); return; }
    s16x4 vlo[8], vhi[8];
#pragma unroll
    for (int i = 0; i < 8; ++i) { vlo[i] = vtr(vp + ((i >> 2) * 4096 + (i & 3) * 1024)); vhi[i] = vtr(vp + ((i >> 2) * 4096 + (i & 3) * 1024 + 512)); }
#define ATT_VFR(i) (bf16x8){vlo[i][0], vlo[i][1], vlo[i][2], vlo[i][3], vhi[i][0], vhi[i][1], vhi[i][2], vhi[i][3]}
    o[0] = MFMA32(__builtin_bit_cast(bf16x8, pw0), ATT_VFR(0), o[0]); o[1] = MFMA32(__builtin_bit_cast(bf16x8, pw0), ATT_VFR(4), o[1]);
    o[0] = MFMA32(__builtin_bit_cast(bf16x8, pw1), ATT_VFR(1), o[0]); o[1] = MFMA32(__builtin_bit_cast(bf16x8, pw1), ATT_VFR(5), o[1]);
    o[0] = MFMA32(__builtin_bit_cast(bf16x8, pw2), ATT_VFR(2), o[0]); o[1] = MFMA32(__builtin_bit_cast(bf16x8, pw2), ATT_VFR(6), o[1]);
    o[0] = MFMA32(__builtin_bit_cast(bf16x8, pw3), ATT_VFR(3), o[0]); o[1] = MFMA32(__builtin_bit_cast(bf16x8, pw3), ATT_VFR(7), o[1]);
#undef ATT_VFR
}
__device__ __forceinline__ float rowsum32(const f32x16& p0, const f32x16& p1) { if (ATT_ABL & 32) return p0[0]; float a = p0[0] + p1[0], b = p0[1] + p1[1];
#pragma unroll
    for (int r = 2; r < 16; r += 2) { a += p0[r]; asm volatile("" : "+v"(a)); b += p0[r + 1]; asm volatile("" : "+v"(b)); a += p1[r]; asm volatile("" : "+v"(a)); b += p1[r + 1]; asm volatile("" : "+v"(b)); }
    return a + b; }
__device__ __forceinline__ void hook_exp(f32x16& s0, f32x16& s1) {
    if (ATT_ABL & 16) return;
#pragma unroll
    for (int r = 0; r < 16; ++r) { s0[r] = __builtin_amdgcn_exp2f(s0[r]); s1[r] = __builtin_amdgcn_exp2f(s1[r]); } }
__device__ __forceinline__ void hook_general(f32x16& s0, f32x16& s1, int base, int win, const LAS float* lut, bool pred) {
    const int inval = 114;
    asm volatile("" : "+v"(base));
#pragma unroll
    for (int r = 0; r < 16; ++r) { const int d0 = base - ((r & 3) + 8 * (r >> 2)), d1 = d0 - 32;
        const int i0 = (pred && (unsigned)d0 < (unsigned)win) ? min(d0, 113) : inval, i1 = (pred && (unsigned)d1 < (unsigned)win) ? min(d1, 113) : inval;
        s0[r] = __builtin_amdgcn_exp2f(s0[r] + lut[i0]); s1[r] = __builtin_amdgcn_exp2f(s1[r] + lut[i1]); } }
__device__ __forceinline__ void hook_cmp(f32x16& s0, f32x16& s1, int nrel  , float cb) {
    asm volatile("" : "+v"(nrel));
#pragma unroll
    for (int r = 0; r < 16; ++r) { const int c0 = (r & 3) + 8 * (r >> 2);
        s0[r] = __builtin_amdgcn_exp2f(s0[r] + ((c0 <= nrel) ? cb : -INFINITY)); s1[r] = __builtin_amdgcn_exp2f(s1[r] + ((c0 + 32 <= nrel) ? cb : -INFINITY)); } }
__device__ __forceinline__ void row_factors(const Ctx& c, float f, float (&fr)[16]) {
    const int lane = fresh_lane(), r32 = lane & 31, hi = lane >> 5; LAS float* wsf = (LAS float*)(c.lds + LDS_WSF) + c.wid * 64;
    asm volatile("s_waitcnt lgkmcnt(0)" ::: "memory");
    if (hi == 0) wsf[r32] = f;
    asm volatile("s_waitcnt lgkmcnt(0)" ::: "memory");
#pragma unroll
    for (int r = 0; r < 16; ++r) fr[r] = wsf[(r & 3) + 8 * (r >> 2) + 4 * hi];
    asm volatile("s_waitcnt lgkmcnt(0)" ::: "memory");
}
__device__ __forceinline__ float pair_sum(float v) { auto rr = __builtin_amdgcn_permlane32_swap(__float_as_uint(v), __float_as_uint(v), false, false); return __uint_as_float(rr[0]) + __uint_as_float(rr[1]); }
template <class RowOff>
__device__ __forceinline__ void store_rows(const Ctx& c, const f32x16 (&o)[2], bf16* dst, RowOff&& rowoff) {
    LAS bf16* stg = (LAS bf16*)(c.lds + LDS_OST) + c.wid * 2048;
    const int lane = fresh_lane(), r32 = lane & 31, hi = lane >> 5;
#pragma unroll
    for (int r = 0; r < 16; ++r) { const int orow = (r & 3) + 8 * (r >> 2) + 4 * hi;
#pragma unroll
        for (int d0 = 0; d0 < 2; ++d0) stg[orow * 64 + d0 * 32 + r32] = (bf16)f2bf(o[d0][r]); }
    asm volatile("s_waitcnt lgkmcnt(0)" ::: "memory");
#pragma unroll
    for (int i = 0; i < 4; ++i) { const int row = i * 8 + (lane >> 3), ch = lane & 7; const u32x4 v = *(const LAS u32x4*)(stg + row * 64 + ch * 8); *(u32x4*)(dst + rowoff(row) + ch * 8) = v; }
    asm volatile("s_waitcnt lgkmcnt(0)" ::: "memory");
}
struct AttnPtrs { const bf16* qkv; const float* kmp; const float* gates; const bf16* kcmp; const bf16* vcmp; const float* rel_bias; bf16* mix; unsigned* selg; bf16* part_o; float* part_l; };

__device__ __forceinline__ unsigned moba_gate32(const AttnPtrs& P, int b, int h, int i, const bf16x8 (&qr)[4], int r32, int hi) {
    unsigned selmask = 0u;
    if (i > 0) {
        bf16x8 kmf[4];
        const float* kp = P.kmp + ((size_t)((b * 8 + h) * 32 + r32) * 2) * 64;
#pragma unroll
        for (int d0 = 0; d0 < 4; ++d0) { const f32x4 a0 = *(const f32x4*)(kp + d0 * 16 + hi * 8), a1 = *(const f32x4*)(kp + d0 * 16 + hi * 8 + 4), b0 = *(const f32x4*)(kp + 64 + d0 * 16 + hi * 8), b1 = *(const f32x4*)(kp + 64 + d0 * 16 + hi * 8 + 4);
            const f32x4 m0 = (a0 + b0) * (1.f / 256.f), m1 = (a1 + b1) * (1.f / 256.f);
            u32x4 w = {cvtpk(m0[0], m0[1]), cvtpk(m0[2], m0[3]), cvtpk(m1[0], m1[1]), cvtpk(m1[2], m1[3])}; kmf[d0] = __builtin_bit_cast(bf16x8, w); }
        f32x16 sg = {};
#pragma unroll
        for (int d0 = 0; d0 < 4; ++d0) sg = MFMA32(kmf[d0], qr[d0], sg);
        float v[16];
#pragma unroll
        for (int r = 0; r < 16; ++r) v[r] = ((r & 3) + 8 * (r >> 2) + 4 * hi < i) ? sg[r] : -INFINITY;
#pragma unroll
        for (int it = 0; it < 3; ++it) {
            float m = v[0]; int jb = 4 * hi;
#pragma unroll
            for (int r = 1; r < 16; ++r) { const int j = (r & 3) + 8 * (r >> 2) + 4 * hi; if (v[r] > m) { m = v[r]; jb = j; } }
            auto rm = __builtin_amdgcn_permlane32_swap(__float_as_uint(m), __float_as_uint(m), false, false);
            auto rj = __builtin_amdgcn_permlane32_swap((unsigned)jb, (unsigned)jb, false, false);
            const float mo = __uint_as_float(hi ? rm[0] : rm[1]); const int jo = (int)(hi ? rj[0] : rj[1]);
            const bool mine = (m > mo) || (m == mo && jb < jo);
            const float mw = mine ? m : mo; const int jw = mine ? jb : jo;
            if (mw > -INFINITY) { selmask |= 1u << jw;
#pragma unroll
                for (int r = 0; r < 16; ++r) if ((r & 3) + 8 * (r >> 2) + 4 * hi == jw) v[r] = -INFINITY; }
        }
    }
    return selmask;
}
__device__ __forceinline__ void moba_gate_phase(const AttnPtrs& P, int vcu, int G, int tid) {
    const int lane = tid & 63, r32 = lane & 31, hi = lane >> 5; const int wid = __builtin_amdgcn_readfirstlane(tid >> 6);
    for (int task = vcu * 8 + wid; task < 8192; task += G * 8) { const int w = task & 7, i = (task >> 3) & 31, bh = task >> 8; const int qpos = 256 * i + 32 * w + r32;
        const bf16* QA = P.qkv + ((size_t)bh * SEQ) * 64;
        bf16x8 qr[4];
#pragma unroll
        for (int d0 = 0; d0 < 4; ++d0) qr[d0] = *(const bf16x8*)(QA + (size_t)qpos * 64 + d0 * 16 + hi * 8);
        const unsigned m = moba_gate32(P, bh >> 3, bh & 7, i, qr, r32, hi);
        if (hi == 0) P.selg[(size_t)bh * SEQ + qpos] = m; }
}
__device__ __forceinline__ void moba_lut(const Ctx& c, const AttnPtrs& P, int h) {
    LAS float* lut = (LAS float*)(c.lds + LDS_LUT);
    if (threadIdx.x < 115) lut[threadIdx.x] = (threadIdx.x == 114) ? -INFINITY : (P.rel_bias[t5_bucket(threadIdx.x) * 16 + h] - P.rel_bias[31 * 16 + h]) * LOG2E;
}
__device__ __forceinline__ void moba_past_item(const Ctx& c, const AttnPtrs& P, int b, int h, int j) {
    const int bh = b * 8 + h, tid = threadIdx.x;
    const bf16* QA = P.qkv + ((size_t)bh * SEQ) * 64; const bf16* KA = QA + QKV_BIG + (size_t)256 * j * 64; const bf16* VA = QA + 2 * QKV_BIG + (size_t)256 * j * 64;
    moba_lut(c, P, h);
    const LAS float* lut = (const LAS float*)(c.lds + LDS_LUT);
    { const int lane = fresh_lane(); const unsigned lds0 = (unsigned)(uintptr_t)c.lds;
      const bf16* ks = KA + (lane * 64 + c.wid * 8); const bf16* vs = VA + ((16 * (c.wid & 3) + (lane >> 2)) * 64 + (c.wid >> 2) * 32 + (lane & 3) * 8);
#pragma unroll
      for (int tt = 0; tt < 4; ++tt) { glds16(ks + tt * 4096, (unsigned)__builtin_amdgcn_readfirstlane(lds0 + c.wid * 1024 + tt * SLOT)); glds16(vs + tt * 4096, (unsigned)__builtin_amdgcn_readfirstlane(lds0 + 8192 + c.wid * 1024 + tt * SLOT)); } }
    LAS unsigned short* list = (LAS unsigned short*)(c.lds + LDS_IMP);
    LAS unsigned* wcnt = (LAS unsigned*)(c.lds + LDS_MISC) + 8;
    const unsigned* sg = P.selg + (size_t)bh * SEQ;
    int total = 0;
    for (int base = (j + 1) * 256; base < SEQ; base += 512) {
        const int q = base + tid; const unsigned m = (q < SEQ) ? sg[q] : 0u; const bool sel = (m >> j) & 1u;
        const unsigned long long bal = __ballot(sel);
        if ((tid & 63) == 0) wcnt[c.wid] = (unsigned)__popcll(bal);
        asm volatile("s_waitcnt vmcnt(0) lgkmcnt(0)\n\ts_barrier" ::: "memory");
        int off = total, tot = 0;
#pragma unroll
        for (int w = 0; w < 8; ++w) { const int v = (int)wcnt[w]; off += (w < c.wid) ? v : 0; tot += v; }
        if (sel) list[off + __popcll(bal & ((1ull << (tid & 63)) - 1ull))] = (unsigned short)(q | (__popc(m & ((1u << j) - 1u)) << 13));
        total += tot;
        asm volatile("s_waitcnt lgkmcnt(0)\n\ts_barrier" ::: "memory");
    }
    total = __builtin_amdgcn_readfirstlane(total);
    { const int npad = (32 - (total & 31)) & 31; if (tid < npad) list[total + tid] = 0xFFFFu; }
    const int nchunks = (total + 31) >> 5;
    asm volatile("s_waitcnt vmcnt(0) lgkmcnt(0)\n\ts_barrier" ::: "memory");
    for (int ch = c.wid; ch < nchunks; ch += 8) {
        const int lane = fresh_lane(), r32 = lane & 31, hi = lane >> 5;
        const lds_cptr kp0 = (lds_cptr)c.lds + hi * 1024 + r32 * 16;
        const lds_cptr vp0 = (lds_cptr)c.lds + 8192 + ((lane >> 4) & 1) * 32 + (lane & 3) * 8 + (4 * hi + ((lane & 15) >> 2)) * 64;
        const unsigned e = list[32 * ch + r32]; const bool valid = e != 0xFFFFu; const int q = valid ? (int)(e & 0x1FFFu) : SEQ - 1;
        bf16x8 qr[4];
#pragma unroll
        for (int d0 = 0; d0 < 4; ++d0) qr[d0] = *(const bf16x8*)(QA + (size_t)q * 64 + d0 * 16 + hi * 8);
        asm volatile("" : "+v"(qr[0]), "+v"(qr[1]), "+v"(qr[2]), "+v"(qr[3]));
        const bool anynear = __any(valid && (q >> 8) == j + 1);
        f32x16 o[2]; o[0] = f32x16{}; o[1] = f32x16{}; float l_reg = 0.f;
#pragma unroll 1
        for (int tt = 0; tt < 4; ++tt) { f32x16 s0, s1; qk_tile(s0, s1, kp0 + tt * SLOT, qr);
            if (anynear) hook_general(s0, s1, q - (256 * j + 64 * tt) - 4 * hi, 1 << 30, lut, true); else hook_exp(s0, s1);
            l_reg += rowsum32(s0, s1);
            pv_tile<false>(o, vp0 + tt * SLOT, s0, s1, 0u); }
        const float L = pair_sum(l_reg);
        if (hi == 0 && valid) P.part_l[((size_t)bh * SEQ + q) * 3 + (e >> 13)] = L;
        LAS bf16* stg = (LAS bf16*)(c.lds + LDS_OST) + c.wid * 2048;
#pragma unroll
        for (int r = 0; r < 16; ++r) { const int orow = (r & 3) + 8 * (r >> 2) + 4 * hi;
#pragma unroll
            for (int d0 = 0; d0 < 2; ++d0) stg[orow * 64 + d0 * 32 + r32] = (bf16)f2bf(o[d0][r]); }
        asm volatile("s_waitcnt lgkmcnt(0)" ::: "memory");
#pragma unroll
        for (int it = 0; it < 4; ++it) { const int row = it * 8 + (lane >> 3), chn = lane & 7; const unsigned e2 = list[32 * ch + row];
            const u32x4 v = *(const LAS u32x4*)(stg + row * 64 + chn * 8);
            if (e2 != 0xFFFFu) *(u32x4*)(P.part_o + (((size_t)bh * SEQ + (e2 & 0x1FFFu)) * 3 + (e2 >> 13)) * 64 + chn * 8) = v; }
        asm volatile("s_waitcnt lgkmcnt(0)" ::: "memory");
    }
    asm volatile("s_waitcnt lgkmcnt(0)\n\ts_barrier" ::: "memory");
}
__device__ __forceinline__ void moba_own_item(const Ctx& c, const AttnPtrs& P, int b, int h, int i) {
    const int bh = b * 8 + h; const int q0 = 256 * i + 32 * c.wid, qpos = q0 + c.r32;
    const bf16* QA = P.qkv + ((size_t)bh * SEQ) * 64; const bf16* KA = QA + QKV_BIG; const bf16* VA = QA + 2 * QKV_BIG;
    bf16x8 qr[4];
#pragma unroll
    for (int d0 = 0; d0 < 4; ++d0) qr[d0] = *(const bf16x8*)(QA + (size_t)qpos * 64 + d0 * 16 + c.hi * 8);
    asm volatile("" : "+v"(qr[0]), "+v"(qr[1]), "+v"(qr[2]), "+v"(qr[3]));
    moba_lut(c, P, h);
    const LAS float* lut = (const LAS float*)(c.lds + LDS_LUT);
    asm volatile("s_waitcnt lgkmcnt(0)\n\ts_barrier" ::: "memory");
    f32x16 o[2]; o[0] = f32x16{}; o[1] = f32x16{}; float l_reg = 0.f;
    run_stream<true>(c, KA, VA, 4 * i, 4 * i + 4,
        [&](int t, lds_cptr kp, f32x16& s0, f32x16& s1) { if (q0 + 31 - 64 * t < 0) return; qk_tile(s0, s1, kp, qr); },
        [&](int t, lds_cptr vp, f32x16& s0, f32x16& s1) { const int key0 = 64 * t; if (q0 + 31 - key0 < 0) return;
            hook_general(s0, s1, qpos - key0 - 4 * c.hi, 1 << 30, lut, true); l_reg += rowsum32(s0, s1); pv_tile<false>(o, vp, s0, s1, 0u); });
    const float Lown = pair_sum(l_reg);
    const int lane = fresh_lane(), r32 = lane & 31, hi = lane >> 5;
    LAS float* stgf = (LAS float*)c.lds + c.wid * 2048;
    LAS float* wsf = (LAS float*)(c.lds + LDS_WSF) + c.wid * 64;
#pragma unroll
    for (int r = 0; r < 16; ++r) { const int orow = (r & 3) + 8 * (r >> 2) + 4 * hi;
#pragma unroll
        for (int d0 = 0; d0 < 2; ++d0) stgf[orow * 64 + d0 * 32 + r32] = o[d0][r]; }
    if (hi == 0) wsf[r32] = Lown;
    asm volatile("s_waitcnt lgkmcnt(0)" ::: "memory");
#pragma unroll
    for (int it = 0; it < 4; ++it) { const int row = it * 8 + (lane >> 3), chn = lane & 7; const int q = 256 * i + 32 * c.wid + row;
        const size_t qi = (size_t)bh * SEQ + q; const int ns = __popc(P.selg[qi]);
        float Lt = wsf[row]; f32x4 a0 = *(const LAS f32x4*)(stgf + row * 64 + chn * 8), a1 = *(const LAS f32x4*)(stgf + row * 64 + chn * 8 + 4);
#pragma unroll
        for (int sidx = 0; sidx < 3; ++sidx) if (sidx < ns) { Lt += P.part_l[qi * 3 + sidx]; const u32x4 pv = *(const u32x4*)(P.part_o + (qi * 3 + sidx) * 64 + chn * 8);
            a0 += (f32x4){__uint_as_float(pv.x << 16), __uint_as_float(pv.x & 0xffff0000u), __uint_as_float(pv.y << 16), __uint_as_float(pv.y & 0xffff0000u)};
            a1 += (f32x4){__uint_as_float(pv.z << 16), __uint_as_float(pv.z & 0xffff0000u), __uint_as_float(pv.w << 16), __uint_as_float(pv.w & 0xffff0000u)}; }
        const float inv = 1.f / Lt; a0 *= inv; a1 *= inv;
        const u32x4 w = {cvtpk(a0[0], a0[1]), cvtpk(a0[2], a0[3]), cvtpk(a1[0], a1[1]), cvtpk(a1[2], a1[3])};
        *(u32x4*)(P.mix + ((size_t)b * SEQ + q) * DM + h * 64 + chn * 8) = w; }
    asm volatile("s_waitcnt lgkmcnt(0)\n\ts_barrier" ::: "memory");
}

__device__ __forceinline__ void nsa_item(const Ctx& c, const AttnPtrs& P, int b, int g, int ci) {
    const int ql = 8 * c.wid + (c.r32 >> 2), rh = c.r32 & 3, qpos = 64 * ci + ql, hb = 4 * g + rh;
    const int qw0 = 64 * ci + 8 * c.wid;
    const bf16* QB = P.qkv + 3 * QKV_BIG + ((size_t)(b * 8 + hb) * SEQ) * 64;
    const bf16* KS = P.qkv + 4 * QKV_BIG + 2 * QKV_SMALL + ((size_t)(b * 2 + g) * SEQ) * 64; const bf16* VS = KS + QKV_SMALL; const bf16* KW = KS + 2 * QKV_SMALL; const bf16* VW = KS + 3 * QKV_SMALL;
    const bf16* KC = P.kcmp + (size_t)(b * 2 + g) * 512 * 64; const bf16* VC = P.vcmp + (size_t)(b * 2 + g) * 512 * 64;
    bf16x8 qr[4];
#pragma unroll
    for (int d0 = 0; d0 < 4; ++d0) qr[d0] = *(const bf16x8*)(QB + (size_t)qpos * 64 + d0 * 16 + c.hi * 8);
    const float* gp = P.gates + ((size_t)b * SEQ + qpos) * 24 + hb * 3; float g0 = gp[0], g1 = gp[1], g2 = gp[2];
    asm volatile("" : "+v"(qr[0]), "+v"(qr[1]), "+v"(qr[2]), "+v"(qr[3]), "+v"(g0), "+v"(g1), "+v"(g2));
    LAS float* lutall = (LAS float*)(c.lds + LDS_LUT);
    if (threadIdx.x < 460) { const int hh = threadIdx.x / 115, d = threadIdx.x % 115; lutall[hh * 128 + d] = (d == 114) ? -INFINITY : (P.rel_bias[t5_bucket(d) * 16 + 8 + 4 * g + hh] - P.rel_bias[31 * 16 + 8 + 4 * g + hh]) * LOG2E; }
    const LAS float* lut = lutall + rh * 128;
    LAS float* imp = (LAS float*)(c.lds + LDS_IMP);
    LAS unsigned* selm = (LAS unsigned*)(c.lds + LDS_SELM);
    f32x16 o[2]; float l_reg; float fr[16];
    LAS float* park = (LAS float*)(c.lds + LDS_OST) + c.wid * 1024 + c.lane;
    LAS float* park1 = (LAS float*)(c.lds + LDS_IMP) + c.wid * 1024 + c.lane;
    const int nct = (4 * ci + 3 + 63) >> 6;
    const int nlim = (qpos >= 31) ? ((qpos - 31) >> 4) : -1;
    l_reg = 0.f;
    run_stream<false>(c, KC, VC, 0, nct,
        [&](int t, lds_cptr kp, f32x16& s0, f32x16& s1) { qk_tile(s0, s1, kp, qr); },
        [&](int t, lds_cptr vp, f32x16& s0, f32x16& s1) { hook_cmp(s0, s1, nlim - 64 * t - 4 * c.hi, 0.f); l_reg += rowsum32(s0, s1); });
    const float Lc = pair_sum(l_reg); const float cbn = Lc > 0.f ? -__builtin_amdgcn_logf(Lc) : -INFINITY;
    o[0] = f32x16{}; o[1] = f32x16{};
    {
        float carry = 0.f;
        run_stream<true>(c, KC, VC, 0, nct,
          [&](int t, lds_cptr kp, f32x16& s0, f32x16& s1) { qk_tile(s0, s1, kp, qr); },
          [&](int t, lds_cptr vp, f32x16& s0, f32x16& s1) {
            hook_cmp(s0, s1, nlim - 64 * t - 4 * c.hi, cbn);
#pragma unroll
            for (int half = 0; half < 2; ++half) {
                float g4[4], e[4];
#pragma unroll
                for (int a = 0; a < 4; ++a) { const float x0 = half ? s1[4 * a] : s0[4 * a], x1 = half ? s1[4 * a + 1] : s0[4 * a + 1], x2 = half ? s1[4 * a + 2] : s0[4 * a + 2], x3 = half ? s1[4 * a + 3] : s0[4 * a + 3];
                    float gs = (x0 + x1) + (x2 + x3), es = x3;
                    gs += __shfl_xor(gs, 1); gs += __shfl_xor(gs, 2); es += __shfl_xor(es, 1); es += __shfl_xor(es, 2);
                    g4[a] = gs; e[a] = es; }
                float x[4];
#pragma unroll
                for (int a = 0; a < 4; ++a) { auto rr = __builtin_amdgcn_permlane32_swap(__float_as_uint(e[a]), __float_as_uint(e[a]), false, false); x[a] = __uint_as_float(c.hi ? rr[0] : rr[1]); }
                const int jb = 16 * t + 8 * half;
                float iv[4];
                if (c.hi) {
#pragma unroll
                    for (int a = 0; a < 4; ++a) iv[a] = g4[a] + x[a]; }
                else { iv[0] = g4[0] + carry; iv[1] = g4[1] + x[0]; iv[2] = g4[2] + x[1]; iv[3] = g4[3] + x[2]; carry = x[3]; }
                if (rh == 0) {
#pragma unroll
                    for (int a = 0; a < 4; ++a) imp[ql * 128 + jb + 2 * a + c.hi] = iv[a]; }
            }
            pv_tile<false>(o, vp, s0, s1, 0u);
        });
    }
    {
        asm volatile("s_waitcnt lgkmcnt(0)\n\ts_barrier" ::: "memory");
        const int qq = 8 * c.wid + (c.lane >> 3), cc = c.lane & 7;
        unsigned m0 = 0u, m1 = 0u, m2w = 0u, m3 = 0u;
        if (ci <= 15) { m0 = (ci == 31) ? 0xffffffffu : ((2u << ci) - 1u); }
        else {
            float v[16];
#pragma unroll
            for (int k = 0; k < 16; ++k) { const int j = cc + 8 * k; v[k] = (j >= 1 && j <= ci - 2) ? imp[qq * 128 + j] : -INFINITY; }
            for (int it = 0; it < 13; ++it) {
                float m = v[0]; int jb = cc;
#pragma unroll
                for (int k = 1; k < 16; ++k) if (v[k] > m) { m = v[k]; jb = cc + 8 * k; }
#pragma unroll
                for (int sft = 1; sft < 8; sft <<= 1) { const float mo = __shfl_xor(m, sft); const int jo = __shfl_xor(jb, sft); if (mo > m || (mo == m && jo < jb)) { m = mo; jb = jo; } }
                if (m > -INFINITY) { const unsigned bit = 1u << (jb & 31); const int wsel = jb >> 5;
                    m0 |= (wsel == 0) ? bit : 0u; m1 |= (wsel == 1) ? bit : 0u; m2w |= (wsel == 2) ? bit : 0u; m3 |= (wsel == 3) ? bit : 0u;
#pragma unroll
                    for (int k = 0; k < 16; ++k) if (cc + 8 * k == jb) v[k] = -INFINITY; }
            }
            m0 |= 1u;
#pragma unroll
            for (int z = 0; z < 2; ++z) { const int jf = ci - z; const unsigned bit = 1u << (jf & 31); const int wsel = jf >> 5;
                m0 |= (wsel == 0) ? bit : 0u; m1 |= (wsel == 1) ? bit : 0u; m2w |= (wsel == 2) ? bit : 0u; m3 |= (wsel == 3) ? bit : 0u; }
        }
        if (cc == 0) { selm[qq * 4 + 0] = m0; selm[qq * 4 + 1] = m1; selm[qq * 4 + 2] = m2w; selm[qq * 4 + 3] = m3; }
        asm volatile("s_waitcnt lgkmcnt(0)\n\ts_barrier" ::: "memory");
    }
    row_factors(c, g0, fr);
#pragma unroll
    for (int r = 0; r < 16; ++r) { park[r * 64] = o[0][r] * fr[r]; park1[r * 64] = o[1][r] * fr[r]; }
    {
        const unsigned w0 = selm[ql * 4 + 0], w1 = selm[ql * 4 + 1], w2 = selm[ql * 4 + 2], w3 = selm[ql * 4 + 3];
        o[0] = f32x16{}; o[1] = f32x16{}; l_reg = 0.f;
        auto sel_pred = [&](int t) -> bool { const unsigned wsel = (t < 32) ? w0 : (t < 64) ? w1 : (t < 96) ? w2 : w3; return (wsel >> (t & 31)) & 1u; };
        auto sel_one = [&](int t, lds_cptr kp, lds_cptr vp) { const bool pred = sel_pred(t); if (!__any(pred)) return; const int key0 = 64 * t;
            f32x16 s0, s1; qk_tile(s0, s1, kp, qr);
            if (qw0 - key0 - 63 >= 113) { hook_exp(s0, s1); const float rs = rowsum32(s0, s1); l_reg += pred ? rs : 0.f;
                if (__all(pred)) pv_tile<false>(o, vp, s0, s1, 0u); else pv_tile<true>(o, vp, s0, s1, pred ? 0xffffffffu : 0u); }
            else { hook_general(s0, s1, qpos - key0 - 4 * c.hi, 1 << 30, lut, pred); l_reg += rowsum32(s0, s1); pv_tile<false>(o, vp, s0, s1, 0u); } };
        run_stream_pairs(c, KS, VS, 0, ci + 1, sel_one,
            [&](int t, lds_cptr kpA, lds_cptr vpA, lds_cptr kpB, lds_cptr vpB) {
                if (qw0 - 64 * (t + 1) - 63 >= 113) {
                    const bool pa = sel_pred(t), pb = sel_pred(t + 1);
                    f32x16 a0, a1, b0, b1; qk_tile(a0, a1, kpA, qr); qk_tile(b0, b1, kpB, qr);
                    hook_exp(a0, a1); hook_exp(b0, b1);
                    const float ra = rowsum32(a0, a1), rb = rowsum32(b0, b1); l_reg += (pa ? ra : 0.f) + (pb ? rb : 0.f);
                    pv_tile<true>(o, vpA, a0, a1, pa ? 0xffffffffu : 0u); pv_tile<true>(o, vpB, b0, b1, pb ? 0xffffffffu : 0u);
                } else { sel_one(t, kpA, vpA); sel_one(t + 1, kpB, vpB); } });
        const float Ls = pair_sum(l_reg);
        row_factors(c, g1 / Ls, fr);
#pragma unroll
        for (int r = 0; r < 16; ++r) { park[r * 64] += o[0][r] * fr[r]; park1[r * 64] += o[1][r] * fr[r]; }
    }
    {
        o[0] = f32x16{}; o[1] = f32x16{}; l_reg = 0.f;
        run_stream<true>(c, KW, VW, ci >= 8 ? ci - 8 : 0, ci + 1,
            [&](int t, lds_cptr kp, f32x16& s0, f32x16& s1) { qk_tile(s0, s1, kp, qr); },
            [&](int t, lds_cptr vp, f32x16& s0, f32x16& s1) { const int key0 = 64 * t;
                if (qw0 - key0 - 63 >= 113 && qw0 + 7 - key0 < 512) hook_exp(s0, s1); else hook_general(s0, s1, qpos - key0 - 4 * c.hi, 512, lut, true);
                l_reg += rowsum32(s0, s1);
                pv_tile<false>(o, vp, s0, s1, 0u); });
        const float Lw = pair_sum(l_reg);
        row_factors(c, g2 / Lw, fr);
#pragma unroll
        for (int r = 0; r < 16; ++r) { o[0][r] = park[r * 64] + o[0][r] * fr[r]; o[1][r] = park1[r * 64] + o[1][r] * fr[r]; }
        asm volatile("s_waitcnt lgkmcnt(0)" ::: "memory");
    }
    bf16* dst = P.mix + ((size_t)b * SEQ + 64 * ci + 8 * c.wid) * DM + 512 + g * 256;
    store_rows(c, o, dst, [](int row) { return (size_t)(row >> 2) * DM + (row & 3) * 64; });
    asm volatile("s_waitcnt lgkmcnt(0)\n\ts_barrier" ::: "memory");
}

__device__ __forceinline__ void attn_phase(LAS unsigned char* lds, const AttnPtrs& P, unsigned* qcounter) {
    Ctx c = make_ctx(lds, threadIdx.x);
    LAS unsigned* misc = (LAS unsigned*)(c.lds + LDS_MISC);
    for (;;) {
        if (threadIdx.x == 0) misc[0] = __hip_atomic_fetch_add(qcounter, 1u, __ATOMIC_RELAXED, __HIP_MEMORY_SCOPE_AGENT);
        asm volatile("s_waitcnt vmcnt(0) lgkmcnt(0)\n\ts_barrier" ::: "memory");
        const unsigned k = misc[0];
        asm volatile("s_waitcnt lgkmcnt(0)\n\ts_barrier" ::: "memory");
        if (k >= 2016u) break;
        if (k < 512u) { const int s_ = 127 - (int)(k >> 3), bg = k & 7; nsa_item(c, P, bg >> 1, bg & 1, s_); }
        else if (k < 1504u) { const int kk = (int)k - 512, j = kk >> 5, bh = kk & 31; moba_past_item(c, P, bh >> 3, bh & 7, j); }
        else { const int kk = (int)k - 1504; const int s_ = 63 - (kk >> 3), bg = kk & 7; nsa_item(c, P, bg >> 1, bg & 1, s_); }
    }
}
__device__ __forceinline__ void moba_merge_phase(LAS unsigned char* lds, const AttnPtrs& P, int vcu, int G) {
    Ctx c = make_ctx(lds, threadIdx.x);
    for (int k = vcu; k < 1024; k += G) moba_own_item(c, P, k >> 8, (k >> 5) & 7, k & 31);
}
#undef MFMA32
#undef ATT_WAIT_BAR
}
namespace cmpr {
using bf16x8 = __attribute__((ext_vector_type(8))) short;
using f32x16 = __attribute__((ext_vector_type(16))) float;
constexpr int HID_PITCH = 528;
__device__ __forceinline__ float gelu_tanh(float v) { const float u = fminf(fmaxf(0.7978845608028654f * (v + 0.044715f * v * v * v), -15.f), 15.f); const float e = __expf(2.f * u); return 0.5f * v * (1.f + (e - 1.f) / (e + 1.f)); }
__device__ __forceinline__ void compress_unit(LAS unsigned char* lds, int unit, const bf16* qkv, const bf16* w1k, const bf16* w1v, const bf16* w2k, const bf16* w2v, const float* cbp, const float* kncmp, bf16* kcmp, bf16* vcmp) {
    const int tid = threadIdx.x, lane = tid & 63, r32 = lane & 31, hi = lane >> 5; const int wid = __builtin_amdgcn_readfirstlane(tid >> 6);
    const int kv = unit & 1, u = (unit >> 1) & 15, bg = unit >> 5;
    const bf16* src = qkv + 4 * QKV_BIG + (kv ? QKV_SMALL : 0) + (size_t)bg * SEQ * 64;
    const bf16* w1 = kv ? w1v : w1k; const bf16* w2 = kv ? w2v : w2k;
    const int n0 = 32 * u; const int nn = min(n0 + r32, NCMP - 1);
    const bf16* ap = src + (size_t)nn * 1024 + 8 * hi; const bf16* bp = w1 + (size_t)(32 * wid + r32) * 2048 + 8 * hi;
    f32x16 acc = {};
#pragma unroll 8
    for (int kk = 0; kk < 128; ++kk) { const bf16x8 a = *(const bf16x8*)(ap + 16 * kk), bfr = *(const bf16x8*)(bp + 16 * kk); acc = __builtin_amdgcn_mfma_f32_32x32x16_bf16(a, bfr, acc, 0, 0, 0); }
    float cb = 0.f;
#pragma unroll 8
    for (int ic = 0; ic < 32; ++ic) cb += cbp[(ic * 2 + kv) * 256 + 32 * wid + r32];
    LAS unsigned char* hidL = lds;
#pragma unroll
    for (int r = 0; r < 16; ++r) { const int n = (r & 3) + 8 * (r >> 2) + 4 * hi; *(LAS bf16*)(hidL + n * HID_PITCH + (32 * wid + r32) * 2) = (bf16)f2bf(gelu_tanh(acc[r] + cb)); }
    asm volatile("s_waitcnt lgkmcnt(0)\n\ts_barrier" ::: "memory");
    if (wid == 0) {
        f32x16 o0 = {}, o1 = {};
#pragma unroll 4
        for (int kk = 0; kk < 16; ++kk) { const bf16x8 hb = *(const LAS bf16x8*)(hidL + r32 * HID_PITCH + (16 * kk + 8 * hi) * 2);
            const bf16x8 a0 = *(const bf16x8*)(w2 + (size_t)r32 * 256 + 16 * kk + 8 * hi), a1 = *(const bf16x8*)(w2 + (size_t)(32 + r32) * 256 + 16 * kk + 8 * hi);
            o0 = __builtin_amdgcn_mfma_f32_32x32x16_bf16(a0, hb, o0, 0, 0, 0); o1 = __builtin_amdgcn_mfma_f32_32x32x16_bf16(a1, hb, o1, 0, 0, 0); }
        float rs = 1.f;
        if (!kv) { float ss = 0.f;
#pragma unroll
            for (int r = 0; r < 16; ++r) ss += o0[r] * o0[r] + o1[r] * o1[r];
            auto rr = __builtin_amdgcn_permlane32_swap(__float_as_uint(ss), __float_as_uint(ss), false, false); ss = __uint_as_float(rr[0]) + __uint_as_float(rr[1]);
            rs = rsqrtf(ss * (1.f / 64.f) + 1e-6f); }
        const int n = n0 + r32; bf16* dst = (kv ? vcmp : kcmp) + ((size_t)bg * 512 + n) * 64;
#pragma unroll
        for (int r = 0; r < 16; ++r) { const int d = (r & 3) + 8 * (r >> 2) + 4 * hi;
            float v0 = o0[r] * rs, v1 = o1[r] * rs; if (!kv) { v0 *= kncmp[d]; v1 *= kncmp[d + 32]; }
            if (n >= NCMP) { v0 = 0.f; v1 = 0.f; }
            dst[d] = (bf16)f2bf(v0); dst[d + 32] = (bf16)f2bf(v1); }
    }
    asm volatile("s_waitcnt lgkmcnt(0)\n\ts_barrier" ::: "memory");
}
}
__global__ void __launch_bounds__(NTHREADS, 2) mk_fwd(Args a) {
    extern __shared__ __attribute__((aligned(16))) unsigned char lds[];
    Frame F;
    F.lds = (LAS unsigned char*)lds;
    F.tid = threadIdx.x; F.lane = F.tid & 63; F.wave = __builtin_amdgcn_readfirstlane(F.tid >> 6);
    F.G = gridDim.x; { const int bx = blockIdx.x; F.vcu = (F.G % 8 == 0) ? (bx % 8) * (F.G / 8) + bx / 8 : bx; }
    cg::grid_group grid = cg::this_grid();
    volatile LAS unsigned* xst = (volatile LAS unsigned*)(F.lds + 147424);
    if (F.tid < 8) xst[F.tid] = 0u;
    __syncthreads();
    const XcdBarrier xbar = xcd_barrier_post((unsigned*)(a.ws + WS_CTL) + 4096, xst);
    unsigned char* ws = a.ws;
    const int lo = a.ph_lo, hi = a.ph_hi;
    const att::AttnPtrs P{(const bf16*)(ws + WS_QKV), (const float*)(ws + WS_KMP), (const float*)(ws + WS_GATES), (const bf16*)(ws + WS_KCMP), (const bf16*)(ws + WS_VCMP), a.in[2], (bf16*)(ws + WS_MIX),
                          (unsigned*)(ws + WS_SELG), (bf16*)(ws + WS_PARTO), (float*)(ws + WS_PARTL)};
#define IN(k) (lo <= (k) && (k) < hi)
#define SEAM(k) do { if (IN(k) && IN((k) + 1)) { if ((k) == 0) grid.sync(); else xcd_barrier(xbar); } } while (0)
    if (IN(0)) { phase_prologue_a(F, a); } SEAM(0);
    if (IN(1)) { phase_prologue_b(F, a); } SEAM(1);
    if (IN(2)) {
        pg8::Gemm g{(const pg8::bf16_t*)(ws + WS_H), (const pg8::bf16_t*)(ws + WS_WIN), TOK, NIN_PAD, DM}; pg8::StaticOrder S; S.init(TOK, NIN_PAD, F.G, (int)blockIdx.x);
        pg8::EpiInProj E{(pg8::bf16_t*)(ws + WS_QKV), (float*)(ws + WS_GATES), (float*)(ws + WS_KMP), a.in[7], a.in[8], a.in[9], a.in[11], a.in[12]};
        pg8::gemm_phase<pg8::EpiInProj, pg8::StaticOrder, true, true>(F.lds, g, S, E);
    } SEAM(2);
    if (IN(3)) {
        att::moba_gate_phase(P, F.vcu, F.G, F.tid);
        for (int unit = F.vcu; unit < 256; unit += F.G)
            cmpr::compress_unit(F.lds, unit, (const bf16*)(ws + WS_QKV), (const bf16*)(ws + WS_W1K), (const bf16*)(ws + WS_W1V), (const bf16*)(ws + WS_W2K), (const bf16*)(ws + WS_W2V),
                                (const float*)(ws + WS_CBP), a.in[10], (bf16*)(ws + WS_KCMP), (bf16*)(ws + WS_VCMP));
    } SEAM(3);
    if (IN(4)) {
                att::attn_phase(F.lds, P, (unsigned*)(ws + WS_CTL) + 64);
    } SEAM(4);
    if (IN(5)) { att::moba_merge_phase(F.lds, P, F.vcu, F.G); } SEAM(5);
    if (IN(6)) {
        pg8::Gemm g{(const pg8::bf16_t*)(ws + WS_MIX), (const pg8::bf16_t*)(ws + WS_WOUT), TOK, DM, DM}; pg8::StaticOrder S; S.init(TOK, DM, F.G, (int)blockIdx.x);
        pg8::EpiOutProj E{a.in[0], a.out, (const float*)(ws + WS_MOD) + 2 * DM};
        pg8::gemm_phase<pg8::EpiOutProj, pg8::StaticOrder, true, true>(F.lds, g, S, E);
    } SEAM(6);
    if (IN(7)) { phase_norm2(F, a); } SEAM(7);
    if (IN(8)) {
        pg8::Gemm g{(const pg8::bf16_t*)(ws + WS_H), (const pg8::bf16_t*)(ws + WS_WGU), TOK, 2 * FF, DM}; pg8::StaticOrder S; S.init(TOK, 2 * FF, F.G, (int)blockIdx.x);
        pg8::EpiGateUp E{(pg8::bf16_t*)(ws + WS_ACT)};
        pg8::gemm_phase<pg8::EpiGateUp, pg8::StaticOrder, true, true>(F.lds, g, S, E);
    } SEAM(8);
    if (IN(9)) {
        pg8::Gemm g{(const pg8::bf16_t*)(ws + WS_ACT), (const pg8::bf16_t*)(ws + WS_WDN), TOK, DM, FF}; pg8::StaticOrder S; S.init(TOK, DM, F.G, (int)blockIdx.x);
        pg8::EpiDown E{a.out, (const float*)(ws + WS_MOD) + 5 * DM};
        pg8::gemm_phase<pg8::EpiDown, pg8::StaticOrder, true, true>(F.lds, g, S, E);
    }
#undef IN
#undef SEAM
}

static void launch_phases(const Args& base, int lo, int hi, int grid, hipStream_t stream) {
    Args a = base; a.ph_lo = lo; a.ph_hi = hi;
    if (hi - lo > 1) { void* args[] = {&a}; (void)hipLaunchCooperativeKernel((const void*)mk_fwd, dim3(grid), dim3(NTHREADS), args, LDS_BYTES, stream); }
    else hipLaunchKernelGGL(mk_fwd, dim3(grid), dim3(NTHREADS), LDS_BYTES, stream, a);
}
extern "C" void kernel_launch(void* const* d_in, const int* in_sizes, int n_in, void* d_out, int out_size, void* d_ws, size_t ws_size, hipStream_t stream) {
    static int grid = 0;
    if (grid == 0) {
        int dev = 0, cus = 0, per_cu = 0;
        if (n_in != 23 || ws_size < 452 * MiB || hipGetDevice(&dev) != hipSuccess || hipDeviceGetAttribute(&cus, hipDeviceAttributeMultiprocessorCount, dev) != hipSuccess) { grid = -1; return; }
        if (hipFuncSetAttribute((const void*)mk_fwd, hipFuncAttributeMaxDynamicSharedMemorySize, LDS_BYTES) != hipSuccess) { grid = -1; return; }
        if (hipOccupancyMaxActiveBlocksPerMultiprocessor(&per_cu, (const void*)mk_fwd, NTHREADS, LDS_BYTES) != hipSuccess || per_cu < 1) { grid = -1; return; }
        grid = cus;
    }
    if (grid < 0) return;
    (void)hipMemsetAsync((char*)d_ws + WS_CTL, 0, CTL_ZERO_BYTES, stream);
    Args a{};
    for (int i = 0; i < 23; ++i) a.in[i] = (const float*)d_in[i];
    a.out = (float*)d_out; a.ws = (unsigned char*)d_ws;
    unsigned char* ws = (unsigned char*)d_ws;
#if HYBRID == 1
    launch_phases(a, 0, 1, grid, stream); launch_phases(a, 1, 2, grid, stream); launch_phases(a, 2, 3, grid, stream);
    const bf16* qkv = (const bf16*)(ws + WS_QKV); bf16* mix = (bf16*)(ws + WS_MIX); bf16* kcmp = (bf16*)(ws + WS_KCMP); bf16* vcmp = (bf16*)(ws + WS_VCMP);
    int* sel = (int*)(ws + 344 * MiB); float* obuf = (float*)(ws + 348 * MiB); const float* gates = (const float*)(ws + WS_GATES);
    nq::k_compress<<<dim3(4 * 2 * 512, 2), 256, 0, stream>>>(qkv, a.in[13], a.in[14], a.in[15], a.in[16], a.in[17], a.in[18], a.in[10], kcmp, vcmp);
    nq::k_moba<<<4 * 8 * SEQ / 4, 256, 0, stream>>>(qkv, (const float*)(ws + WS_KMP), a.in[2], mix);
    nq::k_nsa_cmp<<<4 * 2 * SEQ, 256, 0, stream>>>(qkv, kcmp, vcmp, gates, obuf, sel);
    nq::k_nsa_sel<<<4 * 2 * SEQ, 256, 0, stream>>>(qkv, sel, a.in[2], gates, obuf);
    nq::k_nsa_win<<<4 * 2 * SEQ, 256, 0, stream>>>(qkv, a.in[2], gates, obuf, mix);
    launch_phases(a, 5, 6, grid, stream); launch_phases(a, 6, 7, grid, stream); launch_phases(a, 7, 8, grid, stream); launch_phases(a, 8, 9, grid, stream);
#elif HYBRID == 2
    launch_phases(a, 0, 1, grid, stream); launch_phases(a, 1, 2, grid, stream); launch_phases(a, 2, 3, grid, stream);
    nq::k_compress<<<dim3(4 * 2 * 512, 2), 256, 0, stream>>>((const bf16*)(ws + WS_QKV), a.in[13], a.in[14], a.in[15], a.in[16], a.in[17], a.in[18], a.in[10], (bf16*)(ws + WS_KCMP), (bf16*)(ws + WS_VCMP));
    launch_phases(a, 4, 5, grid, stream);
    launch_phases(a, 5, 6, grid, stream); launch_phases(a, 6, 7, grid, stream); launch_phases(a, 7, 8, grid, stream); launch_phases(a, 8, 9, grid, stream);
#elif HYBRID == 3
    for (int p = 0; p < N_PHASES; ++p) { launch_phases(a, p, p + 1, grid, stream);
#if defined(ABL_REPS)
        if (p == 3) { static bool once = false; if (!once) { once = true; (void)hipFuncSetAttribute((const void*)k_attn_abl, hipFuncAttributeMaxDynamicSharedMemorySize, LDS_BYTES); }
            for (int r = 0; r < ABL_REPS; ++r) { (void)hipMemsetAsync((char*)d_ws + WS_CTL + 512, 0, 4, stream); hipLaunchKernelGGL(k_attn_abl, dim3(grid), dim3(NTHREADS), LDS_BYTES, stream, a); } }
#endif
#if defined(TIME_PHASE)
        if (p == TIME_PHASE) { for (int r = 0; r < TIME_REPS; ++r) { (void)hipMemsetAsync((char*)d_ws + WS_CTL, 0, CTL_ZERO_BYTES, stream); launch_phases(a, p, p + 1, grid, stream); } }
#endif
    }
#else
    launch_phases(a, 0, N_PHASES, grid, stream);
#endif
}
```

```cpp
#include <hip/hip_runtime.h>
#include <hip/hip_cooperative_groups.h>
#include <cstdint>
#include <cstdio>
namespace cg = cooperative_groups;
#define HYBRID 0
namespace pg8 {
#define PG8_LAS __attribute__((address_space(3)))
typedef unsigned short bf16_t;
typedef short bf16x8 __attribute__((ext_vector_type(8)));
typedef float f32x4 __attribute__((ext_vector_type(4)));
typedef unsigned u32x4 __attribute__((ext_vector_type(4)));
constexpr int BM = 256, BK = 64, HALF = 128, HTB = HALF * BK * 2  , STAGE_BYTES = 8 * HTB, NXCD = 8, WGM = 8;

__host__ __device__ __forceinline__ int lds_byte(int r, int c) { const int st = (r >> 4) * 2 + (c >> 5), rr = r & 15, cc = c & 31, ob = rr * 64 + cc * 2; return st * 1024 + (ob ^ (((ob >> 9) & 1) << 5)); }
__host__ __device__ __forceinline__ void stage_rc(int b, int& R, int& C) { const int st = b / 1024, sb = b % 1024, swz = sb ^ (((sb >> 9) & 1) << 5); R = (st >> 1) * 16 + swz / 64; C = (st & 1) * 32 + (swz % 64) / 2; }
__host__ __device__ __forceinline__ int perm32(int rho) { const int n = rho >> 4, i = rho & 15; return 8 * (i >> 2) + 4 * n + (i & 3); }

struct Unit { int pm, pn; };
struct Gemm { const bf16_t* A; const bf16_t* Bt; int M, N, K; };

struct StaticOrder {
    int nM, nN, nwg, G, c;
    __host__ __device__ void init(int M, int N, int G_, int c_) { nM = M / BM; nN = N / BM; nwg = nM * nN; G = G_; c = c_; }
    __host__ __device__ bool next(int i, Unit& u) const {
        const long L = (long)i * G + c; if (L >= nwg) return false;
        int wgid = (int)L; { const int q = nwg / NXCD, r = nwg % NXCD, xcd = wgid % NXCD, off = wgid / NXCD; wgid = (xcd < r ? xcd * (q + 1) : r * (q + 1) + (xcd - r) * q) + off; }
        const int nig = WGM * nN, gid = wgid / nig, fm = gid * WGM, gsz = (nM - fm) < WGM ? (nM - fm) : WGM;
        u.pm = fm + ((wgid % nig) % gsz); u.pn = (wgid % nig) / gsz; return true;
    }
    __device__ __forceinline__ void a_ready(const Unit&) const {}
    __device__ __forceinline__ void done(const Unit&) const {}
};

__device__ __forceinline__ unsigned cvt_pk_bf16(float lo, float hi) { unsigned r; asm volatile("v_cvt_pk_bf16_f32 %0, %1, %2" : "=v"(r) : "v"(lo), "v"(hi)); return r; }
typedef float f32x2 __attribute__((ext_vector_type(2)));
template <class Epi, class Sched, bool ALIGN_EPI = false, bool SP2 = false>
__device__ __forceinline__ void gemm_phase(PG8_LAS unsigned char* lds, const Gemm g, const Sched& S, const Epi& E) {
    const int tid = threadIdx.x, wid = __builtin_amdgcn_readfirstlane(tid >> 6), lane = tid & 63, wr = wid >> 2, wc = wid & 3, fr = lane & 15, fq = lane >> 4;
    const int K = g.K, nt = K / BK;
    unsigned voffA[2], voffB[2];
#pragma unroll
    for (int i = 0; i < 2; ++i) { int R, C; stage_rc(tid * 16 + i * 8192, R, C); const int Rb = Epi::PERM ? ((R & ~31) + perm32(R & 31)) : R;
        voffA[i] = (unsigned)(R * K + C) * 2u; voffB[i] = (unsigned)(Rb * K + C) * 2u; }
    const size_t kstep = (size_t)(BK * 2);
    const size_t hstep = (size_t)HALF * K * 2;
    const size_t tstep = 2 * hstep;
    const unsigned ldsw = (unsigned)wid * 1024u;
    const int aoff = lds_byte(wr * 64 + fr, fq * 8), boff = lds_byte(wc * 32 + fr, fq * 8);
#define PG8_SA(b, h) (((b) * 2 + (h)) * HTB)
#define PG8_SB(b, h) ((4 + (b) * 2 + (h)) * HTB)
#define PG8_STAGE(bufoff, gbase, voff) do { _Pragma("unroll") for (int _i = 0; _i < 2; ++_i) \
        __builtin_amdgcn_global_load_lds((const unsigned*)((const char*)(gbase) + (voff)[_i]), (PG8_LAS unsigned*)(lds + (bufoff) + ldsw + _i * 8192), 16, 0, 0); } while (0)
#define PG8_LDA(dst, b, h) do { _Pragma("unroll") for (int m = 0; m < 4; ++m) _Pragma("unroll") for (int k = 0; k < 2; ++k) dst[m][k] = *(const PG8_LAS bf16x8*)(lds + PG8_SA(b, h) + aoff + m * 2048 + k * 1024); } while (0)
#define PG8_LDB(dst, b, h) do { _Pragma("unroll") for (int n = 0; n < 2; ++n) _Pragma("unroll") for (int k = 0; k < 2; ++k) dst[n][k] = *(const PG8_LAS bf16x8*)(lds + PG8_SB(b, h) + boff + n * 2048 + k * 1024); } while (0)
#define PG8_MMA(ai, bj, At, Bt) do { __builtin_amdgcn_s_setprio(1); _Pragma("unroll") for (int m = 0; m < 4; ++m) _Pragma("unroll") for (int n = 0; n < 2; ++n) _Pragma("unroll") for (int k = 0; k < 2; ++k) \
        acc[ai][bj][m][n] = __builtin_amdgcn_mfma_f32_16x16x32_bf16(Bt[n][k], At[m][k], acc[ai][bj][m][n], 0, 0, 0); __builtin_amdgcn_s_setprio(0); } while (0)
#define PG8_WAIT_V(n) asm volatile("s_waitcnt vmcnt(" #n ")" ::: "memory")
#define PG8_WAIT_L(n) asm volatile("s_waitcnt lgkmcnt(" #n ")" ::: "memory")
#define PG8_BAR __builtin_amdgcn_s_barrier()
#define PG8_SCHED __builtin_amdgcn_sched_barrier(0)
    Unit cur, nxt; int ui = 0;
    if (!S.next(0, cur)) return;
    f32x4 acc[2][2][4][2];
#pragma unroll
    for (int a = 0; a < 2; ++a)
#pragma unroll
        for (int b = 0; b < 2; ++b)
#pragma unroll
            for (int m = 0; m < 4; ++m)
#pragma unroll
                for (int n = 0; n < 2; ++n) acc[a][b][m][n] = (f32x4){0.f, 0.f, 0.f, 0.f};
    bf16x8 At[4][2], B0[2][2], B1[2][2];
    const char* cA = (const char*)g.A + (size_t)cur.pm * tstep; const char* cB = (const char*)g.Bt + (size_t)cur.pn * tstep;
    S.a_ready(cur);
    if constexpr (SP2) {
        PG8_STAGE(PG8_SB(0, 0), cB, voffB); PG8_STAGE(PG8_SB(0, 1), cB + hstep, voffB); PG8_STAGE(PG8_SA(0, 0), cA, voffA); PG8_STAGE(PG8_SA(0, 1), cA + hstep, voffA);
        if (wr == 1) PG8_BAR;
        PG8_WAIT_V(2); PG8_BAR;
        PG8_STAGE(PG8_SB(1, 0), cB + kstep, voffB); PG8_STAGE(PG8_SA(1, 0), cA + kstep, voffA); PG8_STAGE(PG8_SB(1, 1), cB + hstep + kstep, voffB);
        PG8_WAIT_V(6); PG8_BAR;
    } else {
        PG8_STAGE(PG8_SB(0, 0), cB, voffB); PG8_STAGE(PG8_SA(0, 0), cA, voffA); PG8_STAGE(PG8_SB(0, 1), cB + hstep, voffB); PG8_STAGE(PG8_SA(0, 1), cA + hstep, voffA);
        if (wr == 1) PG8_BAR;
        PG8_WAIT_V(4); PG8_BAR;
        PG8_STAGE(PG8_SB(1, 0), cB + kstep, voffB); PG8_STAGE(PG8_SA(1, 0), cA + kstep, voffA); PG8_STAGE(PG8_SB(1, 1), cB + hstep + kstep, voffB);
        PG8_WAIT_V(6); PG8_BAR;
    }
    for (;;) {
        const bool has_next = S.next(ui + 1, nxt);
        const char* nA = has_next ? (const char*)g.A + (size_t)nxt.pm * tstep : cA; const char* nB = has_next ? (const char*)g.Bt + (size_t)nxt.pn * tstep : cB;
        for (int t = 0; t < nt; t += 2) {
            const bool last = (t == nt - 2);
            const char* a1 = cA + (size_t)(t + 1) * kstep;
            const char* a2 = last ? nA : cA + (size_t)(t + 2) * kstep; const char* b2 = last ? nB : cB + (size_t)(t + 2) * kstep;
            const char* a3 = a2 + kstep; const char* b3 = b2 + kstep;
            if (last && has_next) S.a_ready(nxt);
            if constexpr (SP2) {
            PG8_LDB(B0, 0, 0); PG8_LDB(B1, 0, 1); PG8_SCHED; PG8_LDA(At, 0, 0); PG8_STAGE(PG8_SA(1, 1), a1 + hstep, voffA);
            PG8_WAIT_V(8); PG8_WAIT_L(0); PG8_BAR; PG8_MMA(0, 0, At, B0); PG8_MMA(0, 1, At, B1); PG8_BAR; PG8_SCHED;
            PG8_LDA(At, 0, 1); PG8_STAGE(PG8_SB(0, 0), b2, voffB); PG8_STAGE(PG8_SB(0, 1), b2 + hstep, voffB); PG8_STAGE(PG8_SA(0, 0), a2, voffA);
            PG8_WAIT_V(8); PG8_WAIT_L(0); PG8_BAR; PG8_MMA(1, 0, At, B0); PG8_MMA(1, 1, At, B1); PG8_BAR; PG8_SCHED;
            PG8_LDB(B0, 1, 0); PG8_LDB(B1, 1, 1); PG8_SCHED; PG8_LDA(At, 1, 0); PG8_STAGE(PG8_SA(0, 1), a2 + hstep, voffA);
            PG8_WAIT_V(8); PG8_WAIT_L(0); PG8_BAR; PG8_MMA(0, 0, At, B0); PG8_MMA(0, 1, At, B1); PG8_BAR; PG8_SCHED;
            PG8_LDA(At, 1, 1); PG8_STAGE(PG8_SB(1, 0), b3, voffB); PG8_STAGE(PG8_SB(1, 1), b3 + hstep, voffB); PG8_STAGE(PG8_SA(1, 0), a3, voffA);
            PG8_WAIT_V(8); PG8_WAIT_L(0); PG8_BAR; PG8_MMA(1, 0, At, B0); PG8_MMA(1, 1, At, B1); PG8_BAR; PG8_SCHED;
            } else {
            PG8_LDB(B0, 0, 0); PG8_SCHED; PG8_LDA(At, 0, 0); PG8_STAGE(PG8_SA(1, 1), a1 + hstep, voffA);
            PG8_WAIT_L(8); PG8_BAR; PG8_WAIT_L(0); PG8_MMA(0, 0, At, B0); PG8_BAR; PG8_SCHED;
            PG8_LDB(B1, 0, 1); PG8_STAGE(PG8_SB(0, 0), b2, voffB);
            PG8_BAR; PG8_WAIT_L(0); PG8_MMA(0, 1, At, B1); PG8_BAR;
            PG8_LDA(At, 0, 1); PG8_STAGE(PG8_SA(0, 0), a2, voffA);
            PG8_BAR; PG8_WAIT_L(0); PG8_MMA(1, 0, At, B0); PG8_BAR; PG8_SCHED;
            PG8_STAGE(PG8_SB(0, 1), b2 + hstep, voffB);
            PG8_WAIT_V(6); PG8_BAR; PG8_MMA(1, 1, At, B1); PG8_BAR;
            PG8_LDB(B0, 1, 0); PG8_SCHED; PG8_LDA(At, 1, 0); PG8_STAGE(PG8_SA(0, 1), a2 + hstep, voffA);
            PG8_WAIT_L(8); PG8_BAR; PG8_WAIT_L(0); PG8_MMA(0, 0, At, B0); PG8_BAR; PG8_SCHED;
            PG8_LDB(B1, 1, 1); PG8_STAGE(PG8_SB(1, 0), b3, voffB);
            PG8_BAR; PG8_WAIT_L(0); PG8_MMA(0, 1, At, B1); PG8_BAR;
            PG8_LDA(At, 1, 1); PG8_STAGE(PG8_SA(1, 0), a3, voffA);
            PG8_BAR; PG8_WAIT_L(0); PG8_MMA(1, 0, At, B0); PG8_BAR; PG8_SCHED;
            PG8_STAGE(PG8_SB(1, 1), b3 + hstep, voffB);
            PG8_WAIT_V(6); PG8_BAR; PG8_MMA(1, 1, At, B1); PG8_BAR;
            }
        }
        if constexpr (ALIGN_EPI) { if (wr == 0) PG8_BAR; }
        if constexpr (!Epi::AFTER_DRAIN) { E(acc, cur, wr, wc, fr, fq); S.done(cur); }
        if (!has_next) break;
#pragma unroll
        for (int a = 0; a < 2; ++a)
#pragma unroll
            for (int b = 0; b < 2; ++b)
#pragma unroll
                for (int m = 0; m < 4; ++m)
#pragma unroll
                    for (int n = 0; n < 2; ++n) acc[a][b][m][n] = (f32x4){0.f, 0.f, 0.f, 0.f};
        cur = nxt; cA = nA; cB = nB; ++ui;
        if constexpr (ALIGN_EPI) { if (wr == 1) PG8_BAR; }
    }
    PG8_WAIT_V(0);
    if constexpr (!ALIGN_EPI) { if (wr == 0) PG8_BAR; }
    PG8_BAR;
    if constexpr (Epi::AFTER_DRAIN) { E.fused(acc, cur, wr, wc, fr, fq, lds, wid, lane); S.done(cur); }
#undef PG8_SA
#undef PG8_SB
#undef PG8_STAGE
#undef PG8_LDA
#undef PG8_LDB
#undef PG8_MMA
#undef PG8_WAIT_V
#undef PG8_WAIT_L
#undef PG8_BAR
#undef PG8_SCHED
}
}
namespace pg8 {
typedef unsigned u32x2v __attribute__((ext_vector_type(2)));
constexpr int TOK_S = 8192;
constexpr float QK_EPS = 1e-6f;
constexpr float C2 = 0.125f * 1.4426950408889634f;
__device__ __forceinline__ float sigmoid_fast(float v) { return 1.f / (1.f + __expf(-v)); }
__device__ __forceinline__ float silu_fast(float v) { return v / (1.f + __expf(-v)); }

struct EpiInProj {
    static constexpr bool PERM = true, AFTER_DRAIN = false;
    bf16_t* qkv;
    float* gates;
    float* kmean_part;
    const float *qna, *kna, *qnb, *knsel, *knwin;
    __device__ __forceinline__ void operator()(const f32x4 (&acc)[2][2][4][2], const Unit& u, int wr, int wc, int fr, int fq) const {
        const int slot = u.pn * 4 + wc;
        if (slot > 44) return;
        const int b = u.pm >> 5, blk = u.pm & 31, pos0 = blk * 256 + wr * 64 + fr;
        if (slot == 44) {
            if (fq < 3) {
#pragma unroll
                for (int ai = 0; ai < 2; ++ai)
#pragma unroll
                    for (int m = 0; m < 4; ++m) { const size_t tok = (size_t)b * TOK_S + pos0 + ai * HALF + m * 16; float* gp = gates + tok * 24 + 8 * fq;
                        const f32x4 v0 = acc[ai][0][m][0], v1 = acc[ai][0][m][1];
                        *(f32x4*)gp = (f32x4){sigmoid_fast(v0[0]), sigmoid_fast(v0[1]), sigmoid_fast(v0[2]), sigmoid_fast(v0[3])};
                        *(f32x4*)(gp + 4) = (f32x4){sigmoid_fast(v1[0]), sigmoid_fast(v1[1]), sigmoid_fast(v1[2]), sigmoid_fast(v1[3])}; }
            }
            return;
        }
        const float* gain = nullptr; float qscale = 1.f; bool is_ka = false; bf16_t* dst;
        constexpr size_t BIG = (size_t)4 * 8 * TOK_S * 64, SMALL = (size_t)4 * 2 * TOK_S * 64;
        if (slot < 32) { const int kind = slot >> 3, head = slot & 7; dst = qkv + kind * BIG + ((size_t)(b * 8 + head) * TOK_S) * 64;
            if (kind == 0) { gain = qna; qscale = C2; } else if (kind == 1) { gain = kna; is_ka = true; } else if (kind == 3) { gain = qnb; qscale = C2; } }
        else { const int kind = (slot - 32) >> 1, g = slot & 1; dst = qkv + 4 * BIG + kind * SMALL + ((size_t)(b * 2 + g) * TOK_S) * 64;
            if (kind == 2) gain = knsel; else if (kind == 4) gain = knwin; }
        float gv[16];
#pragma unroll
        for (int i = 0; i < 16; ++i) gv[i] = gain ? gain[(i >> 3) * 32 + 8 * fq + (i & 7)] * qscale : 1.f;
        float cs[16];
#pragma unroll
        for (int i = 0; i < 16; ++i) cs[i] = 0.f;
#pragma unroll
        for (int ai = 0; ai < 2; ++ai)
#pragma unroll
            for (int m = 0; m < 4; ++m) {
                float v[16];
#pragma unroll
                for (int bj = 0; bj < 2; ++bj)
#pragma unroll
                    for (int n = 0; n < 2; ++n)
#pragma unroll
                        for (int j = 0; j < 4; ++j) v[bj * 8 + n * 4 + j] = acc[ai][bj][m][n][j];
                if (gain) { float ss = 0.f;
#pragma unroll
                    for (int i = 0; i < 16; ++i) ss += v[i] * v[i];
                    ss += __shfl_xor(ss, 16); ss += __shfl_xor(ss, 32);
                    const float rs = rsqrtf(ss * (1.f / 64.f) + QK_EPS);
#pragma unroll
                    for (int i = 0; i < 16; ++i) v[i] *= rs * gv[i]; }
                if (is_ka) {
#pragma unroll
                    for (int i = 0; i < 16; ++i) cs[i] += v[i]; }
                bf16_t* rp = dst + (size_t)(pos0 + ai * HALF + m * 16) * 64 + 8 * fq;
                u32x4 w0, w1;
                w0.x = cvt_pk_bf16(v[0], v[1]); w0.y = cvt_pk_bf16(v[2], v[3]); w0.z = cvt_pk_bf16(v[4], v[5]); w0.w = cvt_pk_bf16(v[6], v[7]);
                w1.x = cvt_pk_bf16(v[8], v[9]); w1.y = cvt_pk_bf16(v[10], v[11]); w1.z = cvt_pk_bf16(v[12], v[13]); w1.w = cvt_pk_bf16(v[14], v[15]);
                *(u32x4*)rp = w0; *(u32x4*)(rp + 32) = w1;
            }
        if (is_ka) {
#pragma unroll
            for (int i = 0; i < 16; ++i) { float s = cs[i]; s += __shfl_xor(s, 1); s += __shfl_xor(s, 2); s += __shfl_xor(s, 4); s += __shfl_xor(s, 8); cs[i] = s; }
            if (fr == 0) { float* kp = kmean_part + ((size_t)((b * 8 + (slot & 7)) * 32 + blk) * 2 + wr) * 64 + 8 * fq;
                *(f32x4*)kp = (f32x4){cs[0], cs[1], cs[2], cs[3]}; *(f32x4*)(kp + 4) = (f32x4){cs[4], cs[5], cs[6], cs[7]};
                *(f32x4*)(kp + 32) = (f32x4){cs[8], cs[9], cs[10], cs[11]}; *(f32x4*)(kp + 36) = (f32x4){cs[12], cs[13], cs[14], cs[15]}; }
        }
    }
};
struct EpiOutProj {
    static constexpr bool PERM = false, AFTER_DRAIN = false;
    const float* x; float* out; const float* gt;
    __device__ __forceinline__ void operator()(const f32x4 (&acc)[2][2][4][2], const Unit& u, int wr, int wc, int fr, int fq) const {
        const int b = u.pm >> 5; const int col0 = u.pn * BM + wc * 32 + 4 * fq; const float* gtb = gt + (size_t)b * 6144;
#pragma unroll
        for (int bj = 0; bj < 2; ++bj)
#pragma unroll
            for (int n = 0; n < 2; ++n) { const int c = col0 + bj * HALF + n * 16; const f32x4 g4 = *(const f32x4*)(gtb + c);
#pragma unroll
                for (int ai = 0; ai < 2; ++ai)
#pragma unroll
                    for (int m = 0; m < 4; ++m) { const size_t off = (size_t)(u.pm * BM + ai * HALF + wr * 64 + m * 16 + fr) * 1024 + c;
                        const f32x4 xv = *(const f32x4*)(x + off); *(f32x4*)(out + off) = xv + g4 * acc[ai][bj][m][n]; } }
    }
};
struct EpiGateUp {
    static constexpr bool PERM = true, AFTER_DRAIN = false;
    bf16_t* act;
    __device__ __forceinline__ void operator()(const f32x4 (&acc)[2][2][4][2], const Unit& u, int wr, int wc, int fr, int fq) const {
        const int h0 = u.pn * 128 + wc * 32 + 8 * fq;
#pragma unroll
        for (int ai = 0; ai < 2; ++ai)
#pragma unroll
            for (int m = 0; m < 4; ++m) { const size_t row = (size_t)(u.pm * BM + ai * HALF + wr * 64 + m * 16 + fr);
                const f32x4 g0 = acc[ai][0][m][0], g1 = acc[ai][0][m][1], u0 = acc[ai][1][m][0], u1 = acc[ai][1][m][1];
                u32x4 w;
                w.x = cvt_pk_bf16(silu_fast(g0[0]) * u0[0], silu_fast(g0[1]) * u0[1]); w.y = cvt_pk_bf16(silu_fast(g0[2]) * u0[2], silu_fast(g0[3]) * u0[3]);
                w.z = cvt_pk_bf16(silu_fast(g1[0]) * u1[0], silu_fast(g1[1]) * u1[1]); w.w = cvt_pk_bf16(silu_fast(g1[2]) * u1[2], silu_fast(g1[3]) * u1[3]);
                *(u32x4*)(act + row * 2816 + h0) = w; }
    }
};
struct EpiDown {
    static constexpr bool PERM = false, AFTER_DRAIN = false;
    float* out; const float* gt;
    __device__ __forceinline__ void operator()(const f32x4 (&acc)[2][2][4][2], const Unit& u, int wr, int wc, int fr, int fq) const {
        const int b = u.pm >> 5; const int col0 = u.pn * BM + wc * 32 + 4 * fq; const float* gtb = gt + (size_t)b * 6144;
#pragma unroll
        for (int bj = 0; bj < 2; ++bj)
#pragma unroll
            for (int n = 0; n < 2; ++n) { const int c = col0 + bj * HALF + n * 16; const f32x4 g4 = *(const f32x4*)(gtb + c);
#pragma unroll
                for (int ai = 0; ai < 2; ++ai)
#pragma unroll
                    for (int m = 0; m < 4; ++m) { const size_t off = (size_t)(u.pm * BM + ai * HALF + wr * 64 + m * 16 + fr) * 1024 + c;
                        const f32x4 xv = *(const f32x4*)(out + off); *(f32x4*)(out + off) = xv + g4 * acc[ai][bj][m][n]; } }
    }
};
}
constexpr int NWAVES = 8, NTHREADS = 512;
constexpr int BATCH = 4, SEQ = 8192, DM = 1024, TOK = BATCH * SEQ, NIN = 2840, NIN_PAD = 3072, FF = 2816, NCMP = 511;
constexpr size_t MiB = 1u << 20;
constexpr size_t WS_CTL = 0, CTL_ZERO_BYTES = 64 * 1024;
constexpr size_t WS_MODP = 1 * MiB;
constexpr size_t WS_MOD = 2 * MiB;
constexpr size_t WS_CBP = 2 * MiB + 512 * 1024;
constexpr size_t WS_KMP = 3 * MiB;
constexpr size_t WS_BIAS2 = 4 * MiB;
constexpr size_t WS_SSP = 449 * MiB;
constexpr size_t WS_WIN = 6 * MiB, WS_WOUT = 12 * MiB, WS_WGU = 14 * MiB, WS_WDN = 25 * MiB;
constexpr size_t WS_W1K = 31 * MiB, WS_W1V = 32 * MiB, WS_W2K = 33 * MiB, WS_W2V = 33 * MiB + 64 * 1024;
constexpr size_t WS_KCMP = 34 * MiB, WS_VCMP = 35 * MiB;
constexpr size_t WS_GATES = 36 * MiB;
constexpr size_t WS_H = 40 * MiB;
constexpr size_t WS_MIX = 104 * MiB;
constexpr size_t WS_QKV = 168 * MiB;
constexpr size_t WS_ACT = WS_QKV;
constexpr size_t WS_END = 344 * MiB;
constexpr size_t WS_PARTO = 344 * MiB;
constexpr size_t WS_PARTL = 444 * MiB;
constexpr size_t WS_SELG = 448 * MiB;
constexpr size_t QKV_BIG = (size_t)4 * 8 * SEQ * 64, QKV_SMALL = (size_t)4 * 2 * SEQ * 64;
constexpr int RING_BYTES = 131072, LDS_BYTES = 147456;
constexpr int N_PHASES = 10;

#define GAS __attribute__((address_space(1)))
#define LAS __attribute__((address_space(3)))
typedef unsigned short bf16;
typedef unsigned v4u __attribute__((ext_vector_type(4)));
typedef float f32x4 __attribute__((ext_vector_type(4)));
#define LDS_WAIT() asm volatile("s_waitcnt lgkmcnt(0)" ::: "memory")
#define VM_WAIT() asm volatile("s_waitcnt vmcnt(0)" ::: "memory")
__device__ __forceinline__ unsigned f2bf(float f) { unsigned u = __builtin_bit_cast(unsigned, f); return (u + 0x7fffu + ((u >> 16) & 1u)) >> 16; }
__device__ __forceinline__ unsigned pk2(float lo, float hi) { return f2bf(lo) | (f2bf(hi) << 16); }
__device__ __forceinline__ float bf2f(bf16 v) { return __builtin_bit_cast(float, (unsigned)v << 16); }
__device__ __forceinline__ float wave_sum(float v) {
#pragma unroll
    for (int o = 1; o < 64; o <<= 1) v += __shfl_xor(v, o);
    return v;
}
struct Args { const float* in[23]; float* out; unsigned char* ws; int ph_lo, ph_hi; };
struct Frame { LAS unsigned char* lds; int tid, lane, wave, vcu, G; };

struct MapId { __device__ __forceinline__ int operator()(int n) const { return n; } };
struct MapWin { __device__ __forceinline__ int operator()(int n) const { const int s = n >> 6, d = n & 63; return 256 * (s >> 2) + 128 * (d >> 5) + 32 * (s & 3) + (d & 31); } };
struct MapWgu { __device__ __forceinline__ int operator()(int n) const { const int up = n >= FF, hdn = up ? n - FF : n; return 256 * (hdn >> 7) + 128 * up + (hdn & 127); } };
template <class Map>
__device__ __forceinline__ void transpose_item(const float* __restrict__ W, int K, int N, bf16* WT, LAS float* scr, int item, int lane, const Map& map) {
    const int nblk = (N + 63) / 64, kb = item / nblk, nb = item % nblk, k0 = 64 * kb, n0 = 64 * nb;
    const int nc = n0 + 4 * (lane & 15); const bool nin = nc < N;
    f32x4 v[16];
#pragma unroll
    for (int i = 0; i < 16; ++i) { const int kk = 4 * i + (lane >> 4); v[i] = nin ? *(const GAS f32x4*)(W + (size_t)(k0 + kk) * N + nc) : (f32x4){0.f, 0.f, 0.f, 0.f}; }
#pragma unroll
    for (int i = 0; i < 16; ++i) { const int kk = 4 * i + (lane >> 4); LAS float* d = scr + (4 * (lane & 15)) * 68 + kk; d[0] = v[i][0]; d[68] = v[i][1]; d[136] = v[i][2]; d[204] = v[i][3]; }
    LDS_WAIT(); asm volatile("" ::: "memory");
    const int c = lane & 7;
#pragma unroll
    for (int j = 0; j < 8; ++j) { const int n = (lane >> 3) + 8 * j; const LAS float* s = scr + n * 68 + 8 * c;
        const f32x4 a = *(const LAS f32x4*)s, bq = *(const LAS f32x4*)(s + 4);
        v4u o; o.x = pk2(a[0], a[1]); o.y = pk2(a[2], a[3]); o.z = pk2(bq[0], bq[1]); o.w = pk2(bq[2], bq[3]);
        if (n0 + n < N) *(GAS v4u*)(WT + (size_t)map(n0 + n) * K + k0 + 8 * c) = o; }
    LDS_WAIT(); asm volatile("" ::: "memory");
}
__device__ __forceinline__ float silu_acc(float v) { return v / (1.f + expf(-v)); }
__device__ __forceinline__ void phase_prologue_a(Frame& F, const Args& a) {
    LAS float* scr = (LAS float*)(F.lds + F.wave * 17408);
    const int gw = F.vcu * NWAVES + F.wave, NGW = F.G * NWAVES;
    unsigned char* ws = a.ws;
    constexpr int I_IN = (DM / 64) * ((NIN + 63) / 64), I_OUT = (DM / 64) * (DM / 64), I_GU = (DM / 64) * (2 * FF / 64), I_DN = (FF / 64) * (DM / 64), I_W1 = (2048 / 64) * (256 / 64), I_W2 = (256 / 64) * (64 / 64);
    constexpr int NITEMS = I_IN + I_OUT + I_GU + I_DN + 2 * I_W1 + 2 * I_W2;
    for (int it = gw; it < NITEMS; it += NGW) {
        int r = it;
        if (r < I_IN) { transpose_item(a.in[6], DM, NIN, (bf16*)(ws + WS_WIN), scr, r, F.lane, MapWin()); continue; } r -= I_IN;
        if (r < I_OUT) { transpose_item(a.in[19], DM, DM, (bf16*)(ws + WS_WOUT), scr, r, F.lane, MapId()); continue; } r -= I_OUT;
        if (r < I_GU) { transpose_item(a.in[21], DM, 2 * FF, (bf16*)(ws + WS_WGU), scr, r, F.lane, MapWgu()); continue; } r -= I_GU;
        if (r < I_DN) { transpose_item(a.in[22], FF, DM, (bf16*)(ws + WS_WDN), scr, r, F.lane, MapId()); continue; } r -= I_DN;
        if (r < I_W1) { transpose_item(a.in[14], 2048, 256, (bf16*)(ws + WS_W1K), scr, r, F.lane, MapId()); continue; } r -= I_W1;
        if (r < I_W1) { transpose_item(a.in[17], 2048, 256, (bf16*)(ws + WS_W1V), scr, r, F.lane, MapId()); continue; } r -= I_W1;
        if (r < I_W2) { transpose_item(a.in[15], 256, 64, (bf16*)(ws + WS_W2K), scr, r, F.lane, MapId()); continue; } r -= I_W2;
        transpose_item(a.in[18], 256, 64, (bf16*)(ws + WS_W2V), scr, r, F.lane, MapId());
    }
    const float* c = a.in[1]; const float* w_ada = a.in[3]; float* modp = (float*)(ws + WS_MODP);
    for (int t = NGW - 1 - gw; t < 96 * 8; t += NGW) { const int cg_ = t % 96, ks = t / 96; const int n = cg_ * 64 + F.lane;
        float acc0 = 0.f, acc1 = 0.f, acc2 = 0.f, acc3 = 0.f;
#pragma unroll
        for (int i = 0; i < 8; ++i) { const int idx = F.lane + 64 * i, bb = idx >> 7, kk = idx & 127; scr[kk * 4 + bb] = silu_acc(c[bb * DM + ks * 128 + kk]); }
        LDS_WAIT(); asm volatile("" ::: "memory");
#pragma unroll 8
        for (int k = 0; k < 128; ++k) { const float w = w_ada[(size_t)(ks * 128 + k) * 6144 + n]; const f32x4 sv = *(const LAS f32x4*)(scr + 4 * k);
            acc0 += sv[0] * w; acc1 += sv[1] * w; acc2 += sv[2] * w; acc3 += sv[3] * w; }
        LDS_WAIT(); asm volatile("" ::: "memory");
        float* o = modp + (size_t)ks * 4 * 6144 + n; o[0] = acc0; o[6144] = acc1; o[2 * 6144] = acc2; o[3 * 6144] = acc3; }
    float* cbp = (float*)(ws + WS_CBP);
    for (int t = NGW / 2 - 1 - gw; t >= 0 && t < 256; t += NGW) { const int kv = t & 1, cg_ = (t >> 1) & 3, ic = t >> 3; const int n = cg_ * 64 + F.lane;
        const float* pe = kv ? a.in[16] : a.in[13]; const float* w1 = kv ? a.in[17] : a.in[14]; float acc = 0.f;
#pragma unroll 8
        for (int i = ic * 64; i < ic * 64 + 64; ++i) acc += pe[i] * w1[(size_t)i * 256 + n];
        cbp[(ic * 2 + kv) * 256 + n] = acc; }
}
__device__ __forceinline__ void norm_rows(Frame& F, const float* in, const f32x4 (&gs)[4], const f32x4 (&sh)[4], bf16* out) {
    for (int i = 0; i < 16; ++i) { const int row = F.vcu * 128 + F.wave * 16 + i;
        const GAS f32x4* xr = (const GAS f32x4*)(in + (size_t)row * DM) + F.lane;
        f32x4 v[4]; float ss = 0.f;
#pragma unroll
        for (int j = 0; j < 4; ++j) { v[j] = xr[64 * j]; ss += (v[j].x * v[j].x + v[j].y * v[j].y) + (v[j].z * v[j].z + v[j].w * v[j].w); }
        const float rs = rsqrtf(wave_sum(ss) * (1.f / DM) + 1e-6f);
        GAS unsigned long long* o8 = (GAS unsigned long long*)(out + (size_t)row * DM) + F.lane;
#pragma unroll
        for (int j = 0; j < 4; ++j) { const f32x4 y = v[j] * rs * gs[j] + sh[j]; o8[64 * j] = (unsigned long long)pk2(y.x, y.y) | ((unsigned long long)pk2(y.z, y.w) << 32); } }
}
__device__ __forceinline__ void phase_prologue_b(Frame& F, const Args& a) {
    unsigned char* ws = a.ws; const float* modp = (const float*)(ws + WS_MODP); const float* b_ada = a.in[4];
    if (F.wave == 0 && F.vcu < 96) { const int n = F.vcu * 64 + F.lane; float* mod = (float*)(ws + WS_MOD);
        for (int b = 0; b < 4; ++b) { float s = 0.f;
#pragma unroll
            for (int ks = 0; ks < 8; ++ks) s += modp[((size_t)ks * 4 + b) * 6144 + n];
            mod[b * 6144 + n] = s + b_ada[n]; } }
    const int b = F.vcu >> 6; const float* g = a.in[5];
    f32x4 gs[4], sh[4];
#pragma unroll
    for (int j = 0; j < 4; ++j) { const int c0 = 4 * F.lane + 256 * j; f32x4 s0 = {0.f, 0.f, 0.f, 0.f}, s1 = {0.f, 0.f, 0.f, 0.f};
#pragma unroll
        for (int ks = 0; ks < 8; ++ks) { s0 += *(const f32x4*)(modp + ((size_t)ks * 4 + b) * 6144 + c0); s1 += *(const f32x4*)(modp + ((size_t)ks * 4 + b) * 6144 + DM + c0); }
        s0 += *(const f32x4*)(b_ada + c0); s1 += *(const f32x4*)(b_ada + DM + c0);
        sh[j] = s0; gs[j] = *(const f32x4*)(g + c0) * (s1 + 1.0f); }
    norm_rows(F, a.in[0], gs, sh, (bf16*)(ws + WS_H));
}
__device__ __forceinline__ void phase_norm2(Frame& F, const Args& a) {
    unsigned char* ws = a.ws; const int b = F.vcu >> 6; const float* mod = (const float*)(ws + WS_MOD) + (size_t)b * 6144; const float* g = a.in[20];
    f32x4 gs[4], sh[4];
#pragma unroll
    for (int j = 0; j < 4; ++j) { const int c0 = 4 * F.lane + 256 * j; sh[j] = *(const f32x4*)(mod + 3 * DM + c0); gs[j] = *(const f32x4*)(g + c0) * (*(const f32x4*)(mod + 4 * DM + c0) + 1.0f); }
    norm_rows(F, a.out, gs, sh, (bf16*)(ws + WS_H));
}

__device__ __forceinline__ void phase_bias2(Frame& F, const Args& a) {
    unsigned char* ws = a.ws; const float* mod = (const float*)(ws + WS_MOD); const bf16* wt = (const bf16*)(ws + WS_WGU); float* bias2 = (float*)(ws + WS_BIAS2);
    const int gw = F.vcu * NWAVES + F.wave, NGW = F.G * NWAVES;
    f32x4 sh[4][4];
#pragma unroll
    for (int bb = 0; bb < 4; ++bb)
#pragma unroll
        for (int j = 0; j < 4; ++j) sh[bb][j] = *(const f32x4*)(mod + (size_t)bb * 6144 + 3 * DM + 16 * F.lane + 4 * j);
    for (int c = gw; c < 2 * FF; c += NGW) {
        const v4u w0 = *(const GAS v4u*)(wt + (size_t)c * DM + 16 * F.lane), w1 = *(const GAS v4u*)(wt + (size_t)c * DM + 16 * F.lane + 8);
        const unsigned wu[8] = {w0.x, w0.y, w0.z, w0.w, w1.x, w1.y, w1.z, w1.w};
        float s[4] = {0.f, 0.f, 0.f, 0.f};
#pragma unroll
        for (int j = 0; j < 4; ++j) { const float e0 = __builtin_bit_cast(float, wu[2 * j] << 16), e1 = __builtin_bit_cast(float, wu[2 * j] & 0xffff0000u), e2 = __builtin_bit_cast(float, wu[2 * j + 1] << 16), e3 = __builtin_bit_cast(float, wu[2 * j + 1] & 0xffff0000u);
#pragma unroll
            for (int bb = 0; bb < 4; ++bb) s[bb] += (sh[bb][j][0] * e0 + sh[bb][j][1] * e1) + (sh[bb][j][2] * e2 + sh[bb][j][3] * e3); }
#pragma unroll
        for (int bb = 0; bb < 4; ++bb) { const float t = wave_sum(s[bb]); if (F.lane == 0) bias2[(size_t)bb * 2 * FF + c] = t; }
    }
}
#define XB_TMO      128
#define XB_XCNT(j)  (256  + 64 * (j))
#define XB_XSUB(j)  (1280 + 64 * (j))
#define XB_XGEN(j)  (2304 + 64 * (j))
#define XB_TOP      3328
#define XB_TOPGEN   3392
#define XCD_BAR_WORDS 3456
#define XB_SPIN_CAP (1u << 18)

__device__ __forceinline__ unsigned xb_ld(unsigned* p)              { return __hip_atomic_load(p, __ATOMIC_RELAXED, __HIP_MEMORY_SCOPE_AGENT); }
__device__ __forceinline__ unsigned xb_add(unsigned* p, unsigned v) { return __hip_atomic_fetch_add(p, v, __ATOMIC_RELAXED, __HIP_MEMORY_SCOPE_AGENT); }
__device__ __forceinline__ unsigned xb_xcc_id() { return (unsigned)__builtin_amdgcn_s_getreg((3 << 11) | 20) & 0xFu; }
#define XB_SPIN(cond, bar) do { unsigned _sp = 0; while (cond) { __builtin_amdgcn_s_sleep(1); \
    if ((++_sp & 255u) == 0u) { if (xb_ld(&(bar)[XB_TMO])) break; if (_sp > XB_SPIN_CAP) { atomicAdd(&(bar)[XB_TMO], 1u); break; } } } } while (0)

struct XcdBarrier {
    unsigned* bar; unsigned x;
    volatile LAS unsigned* st;
};

__device__ __forceinline__ XcdBarrier xcd_barrier_post(unsigned* bar, volatile LAS unsigned* st) {
    XcdBarrier b; b.bar = bar; b.x = xb_xcc_id(); b.st = st;
    if (threadIdx.x == 0) (void)xb_add(&bar[XB_XCNT(b.x)], 1u);
    return b;
}
__device__ __forceinline__ void xcd_barrier_complete(unsigned* bar, unsigned x, unsigned& nloc, unsigned& nx) {
    const unsigned G = gridDim.x * gridDim.y * gridDim.z;
    unsigned sum, cnt, mine, sp = 0u;
    for (;;) {
        sum = 0u; cnt = 0u; mine = 0u;
#pragma unroll
        for (unsigned j = 0; j < 16; ++j) { const unsigned c = xb_ld(&bar[XB_XCNT(j)]); sum += c; cnt += (c > 0u) ? 1u : 0u; mine = (j == x) ? c : mine; }
        if (sum == G) break;
        __builtin_amdgcn_s_sleep(1);
        if ((++sp & 255u) == 0u) { if (xb_ld(&bar[XB_TMO])) break; if (sp > XB_SPIN_CAP) { atomicAdd(&bar[XB_TMO], 1u); break; } }
    }
    nloc = mine > 0u ? mine : 1u; nx = cnt > 0u ? cnt : 1u;
}

__device__ __forceinline__ void xcd_barrier(const XcdBarrier& b) {
    asm volatile("s_waitcnt vmcnt(0)" ::: "memory");
    __syncthreads();
    if (threadIdx.x == 0) {
        unsigned* bar = b.bar;
        __builtin_amdgcn_s_waitcnt(0);
        unsigned nloc = b.st[0], nx = b.st[1];
        if (nloc == 0u) { xcd_barrier_complete(bar, b.x, nloc, nx); b.st[0] = nloc; b.st[1] = nx; }
        const unsigned old = xb_add(&bar[XB_XSUB(b.x)], 1u);
        const unsigned gen = old / nloc;
        if (old + 1u == (gen + 1u) * nloc) {
            __builtin_amdgcn_fence(__ATOMIC_RELEASE, "agent");
            asm volatile("s_waitcnt vmcnt(0)" ::: "memory");
            const unsigned og = xb_add(&bar[XB_TOP], 1u);
            const unsigned tg = og / nx;
            if (og + 1u == (tg + 1u) * nx) xb_add(&bar[XB_TOPGEN], 1u);
            else XB_SPIN(xb_ld(&bar[XB_TOPGEN]) == tg, bar);
            __builtin_amdgcn_fence(__ATOMIC_ACQUIRE, "agent");
            xb_add(&bar[XB_XGEN(b.x)], 1u);
            asm volatile("s_waitcnt vmcnt(0)" ::: "memory");
        } else {
            XB_SPIN(xb_ld(&bar[XB_XGEN(b.x)]) == gen, bar);
            __builtin_amdgcn_fence(__ATOMIC_ACQUIRE, "agent");
            asm volatile("s_waitcnt vmcnt(0)" ::: "memory");
        }
    }
    __syncthreads();
}
#define ATT_NS att
#ifndef ATT_ABL
#define ATT_ABL 0
#endif
#ifndef ATT_STAGGER
#define ATT_STAGGER 0
#endif
namespace ATT_NS {
using bf16x8 = __attribute__((ext_vector_type(8))) short;
using s16x4 = __attribute__((ext_vector_type(4))) short;
using f32x16 = __attribute__((ext_vector_type(16))) float;
using u32x4 = __attribute__((ext_vector_type(4))) unsigned;
typedef LAS const char* lds_cptr;
typedef short v4i16_t __attribute__((ext_vector_type(4)));
constexpr int SLOT = 16384, NSLOT = 4, LDS_OST = 65536, LDS_LUT = 98304, LDS_IMP = 100352, LDS_SELM = 133120, LDS_MISC = 134144, LDS_WSF = 134400, LDS_ATT_END = 136448;
constexpr float LOG2E = 1.4426950408889634f;
#define MFMA32(a, b, c) __builtin_amdgcn_mfma_f32_32x32x16_bf16(a, b, c, 0, 0, 0)
#define ATT_WAIT_BAR(N) asm volatile("s_waitcnt vmcnt(" #N ") lgkmcnt(0)\n\ts_barrier" ::: "memory")
__device__ __forceinline__ void glds16(const void* gsrc, unsigned lds_dst) { unsigned keep;
    asm volatile("s_mov_b32 %0, m0\n\ts_mov_b32 m0, %2\n\ts_nop 0\n\tglobal_load_lds_dwordx4 %1, off\n\ts_mov_b32 m0, %0" : "=&s"(keep) : "v"(gsrc), "s"(lds_dst) : "memory"); }
typedef float f32x2_t __attribute__((ext_vector_type(2))); typedef __bf16 bf16x2_t __attribute__((ext_vector_type(2)));
__device__ __forceinline__ unsigned cvtpk(float lo, float hi) { f32x2_t v = {lo, hi}; bf16x2_t b = __builtin_convertvector(v, bf16x2_t); return __builtin_bit_cast(unsigned, b); }
__device__ __forceinline__ s16x4 vtr(lds_cptr p) { return __builtin_bit_cast(s16x4, __builtin_amdgcn_ds_read_tr16_b64_v4i16((LAS v4i16_t*)p)); }
__device__ __forceinline__ int t5_bucket(int d) {
    if (d < 16) return d;
    int b = 16;
    b += (d >= 19); b += (d >= 21); b += (d >= 24); b += (d >= 27); b += (d >= 31); b += (d >= 35); b += (d >= 40); b += (d >= 46);
    b += (d >= 52); b += (d >= 59); b += (d >= 67); b += (d >= 77); b += (d >= 87); b += (d >= 99); b += (d >= 113);
    return b;
}
struct Ctx { LAS char* lds; int wid; int lane, r32, hi; };
__device__ __forceinline__ int fresh_lane() { int l; asm volatile("v_mbcnt_lo_u32_b32 %0, -1, 0\n\tv_mbcnt_hi_u32_b32 %0, -1, %0" : "=v"(l)); return l; }
__device__ __forceinline__ Ctx make_ctx(LAS unsigned char* lds, int tid) {
    Ctx c; c.lds = (LAS char*)lds; c.wid = __builtin_amdgcn_readfirstlane(tid >> 6); c.lane = tid & 63; c.r32 = c.lane & 31; c.hi = c.lane >> 5; return c;
}
template <bool HASV, class QK, class SM>
__device__ __forceinline__ void run_stream(const Ctx& c, const bf16* Kb, const bf16* Vb, int t0, int t1, QK&& qk, SM&& sm) {
    const int n = t1 - t0; if (n <= 0) return;
    const int lane = fresh_lane(), r32 = lane & 31, hi = lane >> 5; const unsigned lds0 = (unsigned)(uintptr_t)c.lds;
    const bf16* ks = Kb + (lane * 64 + c.wid * 8); const bf16* vs = Vb + ((16 * (c.wid & 3) + (lane >> 2)) * 64 + (c.wid >> 2) * 32 + (lane & 3) * 8);
    const unsigned kdst = lds0 + c.wid * 1024, vdst = lds0 + 8192 + c.wid * 1024;
    const lds_cptr kp0 = (lds_cptr)c.lds + hi * 1024 + r32 * 16;
    const lds_cptr vp0 = (lds_cptr)c.lds + 8192 + ((lane >> 4) & 1) * 32 + (lane & 3) * 8 + (4 * hi + ((lane & 15) >> 2)) * 64;
#define ATT_ISSUE(t, so) do { if (ATT_ABL & 4) break; glds16(ks + (size_t)(t) * 4096, (unsigned)__builtin_amdgcn_readfirstlane(kdst + (so))); if (HASV) glds16(vs + (size_t)(t) * 4096, (unsigned)__builtin_amdgcn_readfirstlane(vdst + (so))); } while (0)
    ATT_ISSUE(t0, 0); if (n > 1) ATT_ISSUE(t0 + 1, SLOT);
    const bool late = ATT_STAGGER && __builtin_amdgcn_readfirstlane(c.wid) >= 4;
    f32x16 s0 = {}, s1 = {};
    int slot = 0, slotp = 3 * SLOT, slot2 = 2 * SLOT;
    if (!late) {
        for (int i = 0; i < n; ++i) {
            if (i + 1 < n) { if (HASV) ATT_WAIT_BAR(2); else ATT_WAIT_BAR(1); } else ATT_WAIT_BAR(0);
            if (i + 2 < n) ATT_ISSUE(t0 + i + 2, slot2);
            if (!(ATT_ABL & 1)) qk(t0 + i, kp0 + slot, s0, s1); if (!(ATT_ABL & 2)) sm(t0 + i, vp0 + slot, s0, s1);
            slot = (slot == 3 * SLOT) ? 0 : slot + SLOT; slot2 = (slot2 == 3 * SLOT) ? 0 : slot2 + SLOT;
        }
    } else {
        for (int i = 0; i < n; ++i) {
            if (i + 1 < n) { if (HASV) ATT_WAIT_BAR(2); else ATT_WAIT_BAR(1); } else ATT_WAIT_BAR(0);
            if (i + 2 < n) ATT_ISSUE(t0 + i + 2, slot2);
            if (i > 0 && !(ATT_ABL & 2)) sm(t0 + i - 1, vp0 + slotp, s0, s1);
            if (!(ATT_ABL & 1)) qk(t0 + i, kp0 + slot, s0, s1);
            slotp = slot; slot = (slot == 3 * SLOT) ? 0 : slot + SLOT; slot2 = (slot2 == 3 * SLOT) ? 0 : slot2 + SLOT;
        }
        if (!(ATT_ABL & 2)) sm(t0 + n - 1, vp0 + slotp, s0, s1);
    }
    asm volatile("s_waitcnt lgkmcnt(0)\n\ts_barrier" ::: "memory");
#undef ATT_ISSUE
}
template <class FN1, class FN2>
__device__ __forceinline__ void run_stream_pairs(const Ctx& c, const bf16* Kb, const bf16* Vb, int t0, int t1, FN1&& fn1, FN2&& fn2) {
    const int n = t1 - t0; if (n <= 0) return;
    const int lane = fresh_lane(), r32 = lane & 31, hi = lane >> 5; const unsigned lds0 = (unsigned)(uintptr_t)c.lds;
    const bf16* ks = Kb + (lane * 64 + c.wid * 8); const bf16* vs = Vb + ((16 * (c.wid & 3) + (lane >> 2)) * 64 + (c.wid >> 2) * 32 + (lane & 3) * 8);
    const unsigned kdst = lds0 + c.wid * 1024, vdst = lds0 + 8192 + c.wid * 1024;
    const lds_cptr kp0 = (lds_cptr)c.lds + hi * 1024 + r32 * 16;
    const lds_cptr vp0 = (lds_cptr)c.lds + 8192 + ((lane >> 4) & 1) * 32 + (lane & 3) * 8 + (4 * hi + ((lane & 15) >> 2)) * 64;
#define ATT_ISSUE1(t, so) do { glds16(ks + (size_t)(t) * 4096, (unsigned)__builtin_amdgcn_readfirstlane(kdst + (so))); glds16(vs + (size_t)(t) * 4096, (unsigned)__builtin_amdgcn_readfirstlane(vdst + (so))); } while (0)
    ATT_ISSUE1(t0, 0); if (n > 1) ATT_ISSUE1(t0 + 1, SLOT);
    int base = 0;
    for (int i = 0; i < n; i += 2) {
        ATT_WAIT_BAR(0);
        const int nb = 2 * SLOT - base;
        if (i + 2 < n) ATT_ISSUE1(t0 + i + 2, nb); if (i + 3 < n) ATT_ISSUE1(t0 + i + 3, nb + SLOT);
        if (i + 1 < n) fn2(t0 + i, kp0 + base, vp0 + base, kp0 + base + SLOT, vp0 + base + SLOT); else fn1(t0 + i, kp0 + base, vp0 + base);
        base = nb;
    }
    asm volatile("s_waitcnt lgkmcnt(0)\n\ts_barrier" ::: "memory");
#undef ATT_ISSUE1
}
__device__ __forceinline__ void qk_tile(f32x16& s0, f32x16& s1, lds_cptr kp, const bf16x8 (&qr)[4]) {
    bf16x8 kf[8];
#pragma unroll
    for (int d0 = 0; d0 < 4; ++d0) { kf[2 * d0] = *(const LAS bf16x8*)(kp + d0 * 2048); kf[2 * d0 + 1] = *(const LAS bf16x8*)(kp + d0 * 2048 + 512); }
    const f32x16 z = {};
    s0 = MFMA32(kf[0], qr[0], z); s1 = MFMA32(kf[1], qr[0], z);
#pragma unroll
    for (int d0 = 1; d0 < 4; ++d0) { s0 = MFMA32(kf[2 * d0], qr[d0], s0); s1 = MFMA32(kf[2 * d0 + 1], qr[d0], s1); }
}
template <bool MASK>
__device__ __forceinline__ void pv_tile(f32x16 (&o)[2], lds_cptr vp, const f32x16& p0, const f32x16& p1, unsigned mask) {
    if (ATT_ABL & 8) { o[0][0] += p0[0] + p1[5]; return; }
    u32x4 pw0 = {cvtpk(p0[0], p0[1]), cvtpk(p0[2], p0[3]), cvtpk(p0[4], p0[5]), cvtpk(p0[6], p0[7])}, pw1 = {cvtpk(p0[8], p0[9]), cvtpk(p0[10], p0[11]), cvtpk(p0[12], p0[13]), cvtpk(p0[14], p0[15])};
    u32x4 pw2 = {cvtpk(p1[0], p1[1]), cvtpk(p1[2], p1[3]), cvtpk(p1[4], p1[5]), cvtpk(p1[6], p1[7])}, pw3 = {cvtpk(p1[8], p1[9]), cvtpk(p1[10], p1[11]), cvtpk(p1[12], p1[13]), cvtpk(p1[14], p1[15])};
    if (MASK) { pw0 &= mask; pw1 &= mask; pw2 &= mask; pw3 &= mask; }
    if (ATT_ABL & 64) { o[0] = MFMA32(__builtin_bit_cast(bf16x8, pw0), __builtin_bit_cast(bf16x8, pw1), o[0]); o[1] = MFMA32(__builtin_bit_cast(bf16x8, pw2), __builtin_bit_cast(bf16x8, pw3), o[1]); return; }
    s16x4 vlo[8], vhi[8];
#pragma unroll
    for (int i = 0; i < 8; ++i) { vlo[i] = vtr(vp + ((i >> 2) * 4096 + (i & 3) * 1024)); vhi[i] = vtr(vp + ((i >> 2) * 4096 + (i & 3) * 1024 + 512)); }
#define ATT_VFR(i) (bf16x8){vlo[i][0], vlo[i][1], vlo[i][2], vlo[i][3], vhi[i][0], vhi[i][1], vhi[i][2], vhi[i][3]}
    o[0] = MFMA32(__builtin_bit_cast(bf16x8, pw0), ATT_VFR(0), o[0]); o[1] = MFMA32(__builtin_bit_cast(bf16x8, pw0), ATT_VFR(4), o[1]);
    o[0] = MFMA32(__builtin_bit_cast(bf16x8, pw1), ATT_VFR(1), o[0]); o[1] = MFMA32(__builtin_bit_cast(bf16x8, pw1), ATT_VFR(5), o[1]);
    o[0] = MFMA32(__builtin_bit_cast(bf16x8, pw2), ATT_VFR(2), o[0]); o[1] = MFMA32(__builtin_bit_cast(bf16x8, pw2), ATT_VFR(6), o[1]);
    o[0] = MFMA32(__builtin_bit_cast(bf16x8, pw3), ATT_VFR(3), o[0]); o[1] = MFMA32(__builtin_bit_cast(bf16x8, pw3), ATT_VFR(7), o[1]);
#undef ATT_VFR
}
__device__ __forceinline__ float rowsum32(const f32x16& p0, const f32x16& p1) { if (ATT_ABL & 32) return p0[0]; float a = p0[0] + p1[0], b = p0[1] + p1[1];
#pragma unroll
    for (int r = 2; r < 16; r += 2) { a += p0[r]; asm volatile("" : "+v"(a)); b += p0[r + 1]; asm volatile("" : "+v"(b)); a += p1[r]; asm volatile("" : "+v"(a)); b += p1[r + 1]; asm volatile("" : "+v"(b)); }
    return a + b; }
__device__ __forceinline__ void hook_exp(f32x16& s0, f32x16& s1) {
    if (ATT_ABL & 16) return;
#pragma unroll
    for (int r = 0; r < 16; ++r) { s0[r] = __builtin_amdgcn_exp2f(s0[r]); s1[r] = __builtin_amdgcn_exp2f(s1[r]); } }
__device__ __forceinline__ void hook_general(f32x16& s0, f32x16& s1, int base, int win, const LAS float* lut, bool pred) {
    const int inval = 114;
    asm volatile("" : "+v"(base));
#pragma unroll
    for (int r = 0; r < 16; ++r) { const int d0 = base - ((r & 3) + 8 * (r >> 2)), d1 = d0 - 32;
        const int i0 = (pred && (unsigned)d0 < (unsigned)win) ? min(d0, 113) : inval, i1 = (pred && (unsigned)d1 < (unsigned)win) ? min(d1, 113) : inval;
        s0[r] = __builtin_amdgcn_exp2f(s0[r] + lut[i0]); s1[r] = __builtin_amdgcn_exp2f(s1[r] + lut[i1]); } }
__device__ __forceinline__ void hook_cmp(f32x16& s0, f32x16& s1, int nrel  , float cb) {
    asm volatile("" : "+v"(nrel));
#pragma unroll
    for (int r = 0; r < 16; ++r) { const int c0 = (r & 3) + 8 * (r >> 2);
        s0[r] = __builtin_amdgcn_exp2f(s0[r] + ((c0 <= nrel) ? cb : -INFINITY)); s1[r] = __builtin_amdgcn_exp2f(s1[r] + ((c0 + 32 <= nrel) ? cb : -INFINITY)); } }
__device__ __forceinline__ void row_factors(const Ctx& c, float f, float (&fr)[16]) {
    const int lane = fresh_lane(), r32 = lane & 31, hi = lane >> 5; LAS float* wsf = (LAS float*)(c.lds + LDS_WSF) + c.wid * 64;
    asm volatile("s_waitcnt lgkmcnt(0)" ::: "memory");
    if (hi == 0) wsf[r32] = f;
    asm volatile("s_waitcnt lgkmcnt(0)" ::: "memory");
#pragma unroll
    for (int r = 0; r < 16; ++r) fr[r] = wsf[(r & 3) + 8 * (r >> 2) + 4 * hi];
    asm volatile("s_waitcnt lgkmcnt(0)" ::: "memory");
}
__device__ __forceinline__ float pair_sum(float v) { auto rr = __builtin_amdgcn_permlane32_swap(__float_as_uint(v), __float_as_uint(v), false, false); return __uint_as_float(rr[0]) + __uint_as_float(rr[1]); }
template <class RowOff>
__device__ __forceinline__ void store_rows(const Ctx& c, const f32x16 (&o)[2], bf16* dst, RowOff&& rowoff) {
    LAS bf16* stg = (LAS bf16*)(c.lds + LDS_OST) + c.wid * 2048;
    const int lane = fresh_lane(), r32 = lane & 31, hi = lane >> 5;
#pragma unroll
    for (int r = 0; r < 16; ++r) { const int orow = (r & 3) + 8 * (r >> 2) + 4 * hi;
#pragma unroll
        for (int d0 = 0; d0 < 2; ++d0) stg[orow * 64 + d0 * 32 + r32] = (bf16)f2bf(o[d0][r]); }
    asm volatile("s_waitcnt lgkmcnt(0)" ::: "memory");
#pragma unroll
    for (int i = 0; i < 4; ++i) { const int row = i * 8 + (lane >> 3), ch = lane & 7; const u32x4 v = *(const LAS u32x4*)(stg + row * 64 + ch * 8); *(u32x4*)(dst + rowoff(row) + ch * 8) = v; }
    asm volatile("s_waitcnt lgkmcnt(0)" ::: "memory");
}
struct AttnPtrs { const bf16* qkv; const float* kmp; const float* gates; const bf16* kcmp; const bf16* vcmp; const float* rel_bias; bf16* mix; unsigned* selg; bf16* part_o; float* part_l; };

__device__ __forceinline__ unsigned moba_gate32(const AttnPtrs& P, int b, int h, int i, const bf16x8 (&qr)[4], int r32, int hi) {
    unsigned selmask = 0u;
    if (i > 0) {
        bf16x8 kmf[4];
        const float* kp = P.kmp + ((size_t)((b * 8 + h) * 32 + r32) * 2) * 64;
#pragma unroll
        for (int d0 = 0; d0 < 4; ++d0) { const f32x4 a0 = *(const f32x4*)(kp + d0 * 16 + hi * 8), a1 = *(const f32x4*)(kp + d0 * 16 + hi * 8 + 4), b0 = *(const f32x4*)(kp + 64 + d0 * 16 + hi * 8), b1 = *(const f32x4*)(kp + 64 + d0 * 16 + hi * 8 + 4);
            const f32x4 m0 = (a0 + b0) * (1.f / 256.f), m1 = (a1 + b1) * (1.f / 256.f);
            u32x4 w = {cvtpk(m0[0], m0[1]), cvtpk(m0[2], m0[3]), cvtpk(m1[0], m1[1]), cvtpk(m1[2], m1[3])}; kmf[d0] = __builtin_bit_cast(bf16x8, w); }
        f32x16 sg = {};
#pragma unroll
        for (int d0 = 0; d0 < 4; ++d0) sg = MFMA32(kmf[d0], qr[d0], sg);
        float v[16];
#pragma unroll
        for (int r = 0; r < 16; ++r) v[r] = ((r & 3) + 8 * (r >> 2) + 4 * hi < i) ? sg[r] : -INFINITY;
#pragma unroll
        for (int it = 0; it < 3; ++it) {
            float m = v[0]; int jb = 4 * hi;
#pragma unroll
            for (int r = 1; r < 16; ++r) { const int j = (r & 3) + 8 * (r >> 2) + 4 * hi; if (v[r] > m) { m = v[r]; jb = j; } }
            auto rm = __builtin_amdgcn_permlane32_swap(__float_as_uint(m), __float_as_uint(m), false, false);
            auto rj = __builtin_amdgcn_permlane32_swap((unsigned)jb, (unsigned)jb, false, false);
            const float mo = __uint_as_float(hi ? rm[0] : rm[1]); const int jo = (int)(hi ? rj[0] : rj[1]);
            const bool mine = (m > mo) || (m == mo && jb < jo);
            const float mw = mine ? m : mo; const int jw = mine ? jb : jo;
            if (mw > -INFINITY) { selmask |= 1u << jw;
#pragma unroll
                for (int r = 0; r < 16; ++r) if ((r & 3) + 8 * (r >> 2) + 4 * hi == jw) v[r] = -INFINITY; }
        }
    }
    return selmask;
}
__device__ __forceinline__ void moba_gate_phase(const AttnPtrs& P, int vcu, int G, int tid) {
    const int lane = tid & 63, r32 = lane & 31, hi = lane >> 5; const int wid = __builtin_amdgcn_readfirstlane(tid >> 6);
    for (int task = vcu * 8 + wid; task < 8192; task += G * 8) { const int w = task & 7, i = (task >> 3) & 31, bh = task >> 8; const int qpos = 256 * i + 32 * w + r32;
        const bf16* QA = P.qkv + ((size_t)bh * SEQ) * 64;
        bf16x8 qr[4];
#pragma unroll
        for (int d0 = 0; d0 < 4; ++d0) qr[d0] = *(const bf16x8*)(QA + (size_t)qpos * 64 + d0 * 16 + hi * 8);
        const unsigned m = moba_gate32(P, bh >> 3, bh & 7, i, qr, r32, hi);
        if (hi == 0) P.selg[(size_t)bh * SEQ + qpos] = m; }
}
__device__ __forceinline__ void moba_lut(const Ctx& c, const AttnPtrs& P, int h) {
    LAS float* lut = (LAS float*)(c.lds + LDS_LUT);
    if (threadIdx.x < 115) lut[threadIdx.x] = (threadIdx.x == 114) ? -INFINITY : (P.rel_bias[t5_bucket(threadIdx.x) * 16 + h] - P.rel_bias[31 * 16 + h]) * LOG2E;
}
__device__ __forceinline__ void moba_past_item(const Ctx& c, const AttnPtrs& P, int b, int h, int j) {
    const int bh = b * 8 + h, tid = threadIdx.x;
    const bf16* QA = P.qkv + ((size_t)bh * SEQ) * 64; const bf16* KA = QA + QKV_BIG + (size_t)256 * j * 64; const bf16* VA = QA + 2 * QKV_BIG + (size_t)256 * j * 64;
    moba_lut(c, P, h);
    const LAS float* lut = (const LAS float*)(c.lds + LDS_LUT);
    { const int lane = fresh_lane(); const unsigned lds0 = (unsigned)(uintptr_t)c.lds;
      const bf16* ks = KA + (lane * 64 + c.wid * 8); const bf16* vs = VA + ((16 * (c.wid & 3) + (lane >> 2)) * 64 + (c.wid >> 2) * 32 + (lane & 3) * 8);
#pragma unroll
      for (int tt = 0; tt < 4; ++tt) { glds16(ks + tt * 4096, (unsigned)__builtin_amdgcn_readfirstlane(lds0 + c.wid * 1024 + tt * SLOT)); glds16(vs + tt * 4096, (unsigned)__builtin_amdgcn_readfirstlane(lds0 + 8192 + c.wid * 1024 + tt * SLOT)); } }
    LAS unsigned short* list = (LAS unsigned short*)(c.lds + LDS_IMP);
    LAS unsigned* wcnt = (LAS unsigned*)(c.lds + LDS_MISC) + 8;
    const unsigned* sg = P.selg + (size_t)bh * SEQ;
    int total = 0;
    for (int base = (j + 1) * 256; base < SEQ; base += 512) {
        const int q = base + tid; const unsigned m = (q < SEQ) ? sg[q] : 0u; const bool sel = (m >> j) & 1u;
        const unsigned long long bal = __ballot(sel);
        if ((tid & 63) == 0) wcnt[c.wid] = (unsigned)__popcll(bal);
        asm volatile("s_waitcnt vmcnt(0) lgkmcnt(0)\n\ts_barrier" ::: "memory");
        int off = total, tot = 0;
#pragma unroll
        for (int w = 0; w < 8; ++w) { const int v = (int)wcnt[w]; off += (w < c.wid) ? v : 0; tot += v; }
        if (sel) list[off + __popcll(bal & ((1ull << (tid & 63)) - 1ull))] = (unsigned short)(q | (__popc(m & ((1u << j) - 1u)) << 13));
        total += tot;
        asm volatile("s_waitcnt lgkmcnt(0)\n\ts_barrier" ::: "memory");
    }
    total = __builtin_amdgcn_readfirstlane(total);
    { const int npad = (32 - (total & 31)) & 31; if (tid < npad) list[total + tid] = 0xFFFFu; }
    const int nchunks = (total + 31) >> 5;
    asm volatile("s_waitcnt vmcnt(0) lgkmcnt(0)\n\ts_barrier" ::: "memory");
    for (int ch = c.wid; ch < nchunks; ch += 8) {
        const int lane = fresh_lane(), r32 = lane & 31, hi = lane >> 5;
        const lds_cptr kp0 = (lds_cptr)c.lds + hi * 1024 + r32 * 16;
        const lds_cptr vp0 = (lds_cptr)c.lds + 8192 + ((lane >> 4) & 1) * 32 + (lane & 3) * 8 + (4 * hi + ((lane & 15) >> 2)) * 64;
        const unsigned e = list[32 * ch + r32]; const bool valid = e != 0xFFFFu; const int q = valid ? (int)(e & 0x1FFFu) : SEQ - 1;
        bf16x8 qr[4];
#pragma unroll
        for (int d0 = 0; d0 < 4; ++d0) qr[d0] = *(const bf16x8*)(QA + (size_t)q * 64 + d0 * 16 + hi * 8);
        asm volatile("" : "+v"(qr[0]), "+v"(qr[1]), "+v"(qr[2]), "+v"(qr[3]));
        const bool anynear = __any(valid && (q >> 8) == j + 1);
        f32x16 o[2]; o[0] = f32x16{}; o[1] = f32x16{}; float l_reg = 0.f;
#pragma unroll 1
        for (int tt = 0; tt < 4; ++tt) { f32x16 s0, s1; qk_tile(s0, s1, kp0 + tt * SLOT, qr);
            if (anynear) hook_general(s0, s1, q - (256 * j + 64 * tt) - 4 * hi, 1 << 30, lut, true); else hook_exp(s0, s1);
            l_reg += rowsum32(s0, s1);
            pv_tile<false>(o, vp0 + tt * SLOT, s0, s1, 0u); }
        const float L = pair_sum(l_reg);
        if (hi == 0 && valid) P.part_l[((size_t)bh * SEQ + q) * 3 + (e >> 13)] = L;
        LAS bf16* stg = (LAS bf16*)(c.lds + LDS_OST) + c.wid * 2048;
#pragma unroll
        for (int r = 0; r < 16; ++r) { const int orow = (r & 3) + 8 * (r >> 2) + 4 * hi;
#pragma unroll
            for (int d0 = 0; d0 < 2; ++d0) stg[orow * 64 + d0 * 32 + r32] = (bf16)f2bf(o[d0][r]); }
        asm volatile("s_waitcnt lgkmcnt(0)" ::: "memory");
#pragma unroll
        for (int it = 0; it < 4; ++it) { const int row = it * 8 + (lane >> 3), chn = lane & 7; const unsigned e2 = list[32 * ch + row];
            const u32x4 v = *(const LAS u32x4*)(stg + row * 64 + chn * 8);
            if (e2 != 0xFFFFu) *(u32x4*)(P.part_o + (((size_t)bh * SEQ + (e2 & 0x1FFFu)) * 3 + (e2 >> 13)) * 64 + chn * 8) = v; }
        asm volatile("s_waitcnt lgkmcnt(0)" ::: "memory");
    }
    asm volatile("s_waitcnt lgkmcnt(0)\n\ts_barrier" ::: "memory");
}
__device__ __forceinline__ void moba_own_item(const Ctx& c, const AttnPtrs& P, int b, int h, int i) {
    const int bh = b * 8 + h; const int q0 = 256 * i + 32 * c.wid, qpos = q0 + c.r32;
    const bf16* QA = P.qkv + ((size_t)bh * SEQ) * 64; const bf16* KA = QA + QKV_BIG; const bf16* VA = QA + 2 * QKV_BIG;
    bf16x8 qr[4];
#pragma unroll
    for (int d0 = 0; d0 < 4; ++d0) qr[d0] = *(const bf16x8*)(QA + (size_t)qpos * 64 + d0 * 16 + c.hi * 8);
    asm volatile("" : "+v"(qr[0]), "+v"(qr[1]), "+v"(qr[2]), "+v"(qr[3]));
    moba_lut(c, P, h);
    const LAS float* lut = (const LAS float*)(c.lds + LDS_LUT);
    asm volatile("s_waitcnt lgkmcnt(0)\n\ts_barrier" ::: "memory");
    f32x16 o[2]; o[0] = f32x16{}; o[1] = f32x16{}; float l_reg = 0.f;
    run_stream<true>(c, KA, VA, 4 * i, 4 * i + 4,
        [&](int t, lds_cptr kp, f32x16& s0, f32x16& s1) { if (q0 + 31 - 64 * t < 0) return; qk_tile(s0, s1, kp, qr); },
        [&](int t, lds_cptr vp, f32x16& s0, f32x16& s1) { const int key0 = 64 * t; if (q0 + 31 - key0 < 0) return;
            hook_general(s0, s1, qpos - key0 - 4 * c.hi, 1 << 30, lut, true); l_reg += rowsum32(s0, s1); pv_tile<false>(o, vp, s0, s1, 0u); });
    const float Lown = pair_sum(l_reg);
    const int lane = fresh_lane(), r32 = lane & 31, hi = lane >> 5;
    LAS float* stgf = (LAS float*)c.lds + c.wid * 2048;
    LAS float* wsf = (LAS float*)(c.lds + LDS_WSF) + c.wid * 64;
#pragma unroll
    for (int r = 0; r < 16; ++r) { const int orow = (r & 3) + 8 * (r >> 2) + 4 * hi;
#pragma unroll
        for (int d0 = 0; d0 < 2; ++d0) stgf[orow * 64 + d0 * 32 + r32] = o[d0][r]; }
    if (hi == 0) wsf[r32] = Lown;
    asm volatile("s_waitcnt lgkmcnt(0)" ::: "memory");
#pragma unroll
    for (int it = 0; it < 4; ++it) { const int row = it * 8 + (lane >> 3), chn = lane & 7; const int q = 256 * i + 32 * c.wid + row;
        const size_t qi = (size_t)bh * SEQ + q; const int ns = __popc(P.selg[qi]);
        float Lt = wsf[row]; f32x4 a0 = *(const LAS f32x4*)(stgf + row * 64 + chn * 8), a1 = *(const LAS f32x4*)(stgf + row * 64 + chn * 8 + 4);
#pragma unroll
        for (int sidx = 0; sidx < 3; ++sidx) if (sidx < ns) { Lt += P.part_l[qi * 3 + sidx]; const u32x4 pv = *(const u32x4*)(P.part_o + (qi * 3 + sidx) * 64 + chn * 8);
            a0 += (f32x4){__uint_as_float(pv.x << 16), __uint_as_float(pv.x & 0xffff0000u), __uint_as_float(pv.y << 16), __uint_as_float(pv.y & 0xffff0000u)};
            a1 += (f32x4){__uint_as_float(pv.z << 16), __uint_as_float(pv.z & 0xffff0000u), __uint_as_float(pv.w << 16), __uint_as_float(pv.w & 0xffff0000u)}; }
        const float inv = 1.f / Lt; a0 *= inv; a1 *= inv;
        const u32x4 w = {cvtpk(a0[0], a0[1]), cvtpk(a0[2], a0[3]), cvtpk(a1[0], a1[1]), cvtpk(a1[2], a1[3])};
        *(u32x4*)(P.mix + ((size_t)b * SEQ + q) * DM + h * 64 + chn * 8) = w; }
    asm volatile("s_waitcnt lgkmcnt(0)\n\ts_barrier" ::: "memory");
}

__device__ __forceinline__ void nsa_item(const Ctx& c, const AttnPtrs& P, int b, int g, int ci) {
    const int ql = 8 * c.wid + (c.r32 >> 2), rh = c.r32 & 3, qpos = 64 * ci + ql, hb = 4 * g + rh;
    const int qw0 = 64 * ci + 8 * c.wid;
    const bf16* QB = P.qkv + 3 * QKV_BIG + ((size_t)(b * 8 + hb) * SEQ) * 64;
    const bf16* KS = P.qkv + 4 * QKV_BIG + 2 * QKV_SMALL + ((size_t)(b * 2 + g) * SEQ) * 64; const bf16* VS = KS + QKV_SMALL; const bf16* KW = KS + 2 * QKV_SMALL; const bf16* VW = KS + 3 * QKV_SMALL;
    const bf16* KC = P.kcmp + (size_t)(b * 2 + g) * 512 * 64; const bf16* VC = P.vcmp + (size_t)(b * 2 + g) * 512 * 64;
    bf16x8 qr[4];
#pragma unroll
    for (int d0 = 0; d0 < 4; ++d0) qr[d0] = *(const bf16x8*)(QB + (size_t)qpos * 64 + d0 * 16 + c.hi * 8);
    const float* gp = P.gates + ((size_t)b * SEQ + qpos) * 24 + hb * 3; float g0 = gp[0], g1 = gp[1], g2 = gp[2];
    asm volatile("" : "+v"(qr[0]), "+v"(qr[1]), "+v"(qr[2]), "+v"(qr[3]), "+v"(g0), "+v"(g1), "+v"(g2));
    LAS float* lutall = (LAS float*)(c.lds + LDS_LUT);
    if (threadIdx.x < 460) { const int hh = threadIdx.x / 115, d = threadIdx.x % 115; lutall[hh * 128 + d] = (d == 114) ? -INFINITY : (P.rel_bias[t5_bucket(d) * 16 + 8 + 4 * g + hh] - P.rel_bias[31 * 16 + 8 + 4 * g + hh]) * LOG2E; }
    const LAS float* lut = lutall + rh * 128;
    LAS float* imp = (LAS float*)(c.lds + LDS_IMP);
    LAS unsigned* selm = (LAS unsigned*)(c.lds + LDS_SELM);
    f32x16 o[2]; float l_reg; float fr[16];
    LAS float* park = (LAS float*)(c.lds + LDS_OST) + c.wid * 1024 + c.lane;
    LAS float* park1 = (LAS float*)(c.lds + LDS_IMP) + c.wid * 1024 + c.lane;
    const int nct = (4 * ci + 3 + 63) >> 6;
    const int nlim = (qpos >= 31) ? ((qpos - 31) >> 4) : -1;
    l_reg = 0.f;
    run_stream<false>(c, KC, VC, 0, nct,
        [&](int t, lds_cptr kp, f32x16& s0, f32x16& s1) { qk_tile(s0, s1, kp, qr); },
        [&](int t, lds_cptr vp, f32x16& s0, f32x16& s1) { hook_cmp(s0, s1, nlim - 64 * t - 4 * c.hi, 0.f); l_reg += rowsum32(s0, s1); });
    const float Lc = pair_sum(l_reg); const float cbn = Lc > 0.f ? -__builtin_amdgcn_logf(Lc) : -INFINITY;
    o[0] = f32x16{}; o[1] = f32x16{};
    {
        float carry = 0.f;
        run_stream<true>(c, KC, VC, 0, nct,
          [&](int t, lds_cptr kp, f32x16& s0, f32x16& s1) { qk_tile(s0, s1, kp, qr); },
          [&](int t, lds_cptr vp, f32x16& s0, f32x16& s1) {
            hook_cmp(s0, s1, nlim - 64 * t - 4 * c.hi, cbn);
#pragma unroll
            for (int half = 0; half < 2; ++half) {
                float g4[4], e[4];
#pragma unroll
                for (int a = 0; a < 4; ++a) { const float x0 = half ? s1[4 * a] : s0[4 * a], x1 = half ? s1[4 * a + 1] : s0[4 * a + 1], x2 = half ? s1[4 * a + 2] : s0[4 * a + 2], x3 = half ? s1[4 * a + 3] : s0[4 * a + 3];
                    float gs = (x0 + x1) + (x2 + x3), es = x3;
                    gs += __shfl_xor(gs, 1); gs += __shfl_xor(gs, 2); es += __shfl_xor(es, 1); es += __shfl_xor(es, 2);
                    g4[a] = gs; e[a] = es; }
                float x[4];
#pragma unroll
                for (int a = 0; a < 4; ++a) { auto rr = __builtin_amdgcn_permlane32_swap(__float_as_uint(e[a]), __float_as_uint(e[a]), false, false); x[a] = __uint_as_float(c.hi ? rr[0] : rr[1]); }
                const int jb = 16 * t + 8 * half;
                float iv[4];
                if (c.hi) {
#pragma unroll
                    for (int a = 0; a < 4; ++a) iv[a] = g4[a] + x[a]; }
                else { iv[0] = g4[0] + carry; iv[1] = g4[1] + x[0]; iv[2] = g4[2] + x[1]; iv[3] = g4[3] + x[2]; carry = x[3]; }
                if (rh == 0) {
#pragma unroll
                    for (int a = 0; a < 4; ++a) imp[ql * 128 + jb + 2 * a + c.hi] = iv[a]; }
            }
            pv_tile<false>(o, vp, s0, s1, 0u);
        });
    }
    {
        asm volatile("s_waitcnt lgkmcnt(0)\n\ts_barrier" ::: "memory");
        const int qq = 8 * c.wid + (c.lane >> 3), cc = c.lane & 7;
        unsigned m0 = 0u, m1 = 0u, m2w = 0u, m3 = 0u;
        if (ci <= 15) { m0 = (ci == 31) ? 0xffffffffu : ((2u << ci) - 1u); }
        else {
            float v[16];
#pragma unroll
            for (int k = 0; k < 16; ++k) { const int j = cc + 8 * k; v[k] = (j >= 1 && j <= ci - 2) ? imp[qq * 128 + j] : -INFINITY; }
            for (int it = 0; it < 13; ++it) {
                float m = v[0]; int jb = cc;
#pragma unroll
                for (int k = 1; k < 16; ++k) if (v[k] > m) { m = v[k]; jb = cc + 8 * k; }
#pragma unroll
                for (int sft = 1; sft < 8; sft <<= 1) { const float mo = __shfl_xor(m, sft); const int jo = __shfl_xor(jb, sft); if (mo > m || (mo == m && jo < jb)) { m = mo; jb = jo; } }
                if (m > -INFINITY) { const unsigned bit = 1u << (jb & 31); const int wsel = jb >> 5;
                    m0 |= (wsel == 0) ? bit : 0u; m1 |= (wsel == 1) ? bit : 0u; m2w |= (wsel == 2) ? bit : 0u; m3 |= (wsel == 3) ? bit : 0u;
#pragma unroll
                    for (int k = 0; k < 16; ++k) if (cc + 8 * k == jb) v[k] = -INFINITY; }
            }
            m0 |= 1u;
#pragma unroll
            for (int z = 0; z < 2; ++z) { const int jf = ci - z; const unsigned bit = 1u << (jf & 31); const int wsel = jf >> 5;
                m0 |= (wsel == 0) ? bit : 0u; m1 |= (wsel == 1) ? bit : 0u; m2w |= (wsel == 2) ? bit : 0u; m3 |= (wsel == 3) ? bit : 0u; }
        }
        if (cc == 0) { selm[qq * 4 + 0] = m0; selm[qq * 4 + 1] = m1; selm[qq * 4 + 2] = m2w; selm[qq * 4 + 3] = m3; }
        asm volatile("s_waitcnt lgkmcnt(0)\n\ts_barrier" ::: "memory");
    }
    row_factors(c, g0, fr);
#pragma unroll
    for (int r = 0; r < 16; ++r) { park[r * 64] = o[0][r] * fr[r]; park1[r * 64] = o[1][r] * fr[r]; }
    {
        const unsigned w0 = selm[ql * 4 + 0], w1 = selm[ql * 4 + 1], w2 = selm[ql * 4 + 2], w3 = selm[ql * 4 + 3];
        o[0] = f32x16{}; o[1] = f32x16{}; l_reg = 0.f;
        auto sel_pred = [&](int t) -> bool { const unsigned wsel = (t < 32) ? w0 : (t < 64) ? w1 : (t < 96) ? w2 : w3; return (wsel >> (t & 31)) & 1u; };
        auto sel_one = [&](int t, lds_cptr kp, lds_cptr vp) { const bool pred = sel_pred(t); if (!__any(pred)) return; const int key0 = 64 * t;
            f32x16 s0, s1; qk_tile(s0, s1, kp, qr);
            if (qw0 - key0 - 63 >= 113) { hook_exp(s0, s1); const float rs = rowsum32(s0, s1); l_reg += pred ? rs : 0.f;
                if (__all(pred)) pv_tile<false>(o, vp, s0, s1, 0u); else pv_tile<true>(o, vp, s0, s1, pred ? 0xffffffffu : 0u); }
            else { hook_general(s0, s1, qpos - key0 - 4 * c.hi, 1 << 30, lut, pred); l_reg += rowsum32(s0, s1); pv_tile<false>(o, vp, s0, s1, 0u); } };
        run_stream_pairs(c, KS, VS, 0, ci + 1, sel_one,
            [&](int t, lds_cptr kpA, lds_cptr vpA, lds_cptr kpB, lds_cptr vpB) {
                if (qw0 - 64 * (t + 1) - 63 >= 113) {
                    const bool pa = sel_pred(t), pb = sel_pred(t + 1);
                    f32x16 a0, a1, b0, b1; qk_tile(a0, a1, kpA, qr); qk_tile(b0, b1, kpB, qr);
                    hook_exp(a0, a1); hook_exp(b0, b1);
                    const float ra = rowsum32(a0, a1), rb = rowsum32(b0, b1); l_reg += (pa ? ra : 0.f) + (pb ? rb : 0.f);
                    pv_tile<true>(o, vpA, a0, a1, pa ? 0xffffffffu : 0u); pv_tile<true>(o, vpB, b0, b1, pb ? 0xffffffffu : 0u);
                } else { sel_one(t, kpA, vpA); sel_one(t + 1, kpB, vpB); } });
        const float Ls = pair_sum(l_reg);
        row_factors(c, g1 / Ls, fr);
#pragma unroll
        for (int r = 0; r < 16; ++r) { park[r * 64] += o[0][r] * fr[r]; park1[r * 64] += o[1][r] * fr[r]; }
    }
    {
        o[0] = f32x16{}; o[1] = f32x16{}; l_reg = 0.f;
        run_stream<true>(c, KW, VW, ci >= 8 ? ci - 8 : 0, ci + 1,
            [&](int t, lds_cptr kp, f32x16& s0, f32x16& s1) { qk_tile(s0, s1, kp, qr); },
            [&](int t, lds_cptr vp, f32x16& s0, f32x16& s1) { const int key0 = 64 * t;
                if (qw0 - key0 - 63 >= 113 && qw0 + 7 - key0 < 512) hook_exp(s0, s1); else hook_general(s0, s1, qpos - key0 - 4 * c.hi, 512, lut, true);
                l_reg += rowsum32(s0, s1);
                pv_tile<false>(o, vp, s0, s1, 0u); });
        const float Lw = pair_sum(l_reg);
        row_factors(c, g2 / Lw, fr);
#pragma unroll
        for (int r = 0; r < 16; ++r) { o[0][r] = park[r * 64] + o[0][r] * fr[r]; o[1][r] = park1[r * 64] + o[1][r] * fr[r]; }
        asm volatile("s_waitcnt lgkmcnt(0)" ::: "memory");
    }
    bf16* dst = P.mix + ((size_t)b * SEQ + 64 * ci + 8 * c.wid) * DM + 512 + g * 256;
    store_rows(c, o, dst, [](int row) { return (size_t)(row >> 2) * DM + (row & 3) * 64; });
    asm volatile("s_waitcnt lgkmcnt(0)\n\ts_barrier" ::: "memory");
}

__device__ __forceinline__ void attn_phase(LAS unsigned char* lds, const AttnPtrs& P, unsigned* qcounter) {
    Ctx c = make_ctx(lds, threadIdx.x);
    LAS unsigned* misc = (LAS unsigned*)(c.lds + LDS_MISC);
    for (;;) {
        if (threadIdx.x == 0) misc[0] = __hip_atomic_fetch_add(qcounter, 1u, __ATOMIC_RELAXED, __HIP_MEMORY_SCOPE_AGENT);
        asm volatile("s_waitcnt vmcnt(0) lgkmcnt(0)\n\ts_barrier" ::: "memory");
        const unsigned k = misc[0];
        asm volatile("s_waitcnt lgkmcnt(0)\n\ts_barrier" ::: "memory");
        if (k >= 2016u) break;
        if (k < 512u) { const int s_ = 127 - (int)(k >> 3), bg = k & 7; nsa_item(c, P, bg >> 1, bg & 1, s_); }
        else if (k < 1504u) { const int kk = (int)k - 512, j = kk >> 5, bh = kk & 31; moba_past_item(c, P, bh >> 3, bh & 7, j); }
        else { const int kk = (int)k - 1504; const int s_ = 63 - (kk >> 3), bg = kk & 7; nsa_item(c, P, bg >> 1, bg & 1, s_); }
    }
}
__device__ __forceinline__ void moba_merge_phase(LAS unsigned char* lds, const AttnPtrs& P, int vcu, int G) {
    Ctx c = make_ctx(lds, threadIdx.x);
    for (int k = vcu; k < 1024; k += G) moba_own_item(c, P, k >> 8, (k >> 5) & 7, k & 31);
}
#undef MFMA32
#undef ATT_WAIT_BAR
}
namespace cmpr {
using bf16x8 = __attribute__((ext_vector_type(8))) short;
using f32x16 = __attribute__((ext_vector_type(16))) float;
constexpr int HID_PITCH = 528;
__device__ __forceinline__ float gelu_tanh(float v) { const float u = fminf(fmaxf(0.7978845608028654f * (v + 0.044715f * v * v * v), -15.f), 15.f); const float e = __expf(2.f * u); return 0.5f * v * (1.f + (e - 1.f) / (e + 1.f)); }
__device__ __forceinline__ void compress_unit(LAS unsigned char* lds, int unit, const bf16* qkv, const bf16* w1k, const bf16* w1v, const bf16* w2k, const bf16* w2v, const float* cbp, const float* kncmp, bf16* kcmp, bf16* vcmp) {
    const int tid = threadIdx.x, lane = tid & 63, r32 = lane & 31, hi = lane >> 5; const int wid = __builtin_amdgcn_readfirstlane(tid >> 6);
    const int kv = unit & 1, u = (unit >> 1) & 15, bg = unit >> 5;
    const bf16* src = qkv + 4 * QKV_BIG + (kv ? QKV_SMALL : 0) + (size_t)bg * SEQ * 64;
    const bf16* w1 = kv ? w1v : w1k; const bf16* w2 = kv ? w2v : w2k;
    const int n0 = 32 * u; const int nn = min(n0 + r32, NCMP - 1);
    const bf16* ap = src + (size_t)nn * 1024 + 8 * hi; const bf16* bp = w1 + (size_t)(32 * wid + r32) * 2048 + 8 * hi;
    f32x16 acc = {};
#pragma unroll 8
    for (int kk = 0; kk < 128; ++kk) { const bf16x8 a = *(const bf16x8*)(ap + 16 * kk), bfr = *(const bf16x8*)(bp + 16 * kk); acc = __builtin_amdgcn_mfma_f32_32x32x16_bf16(a, bfr, acc, 0, 0, 0); }
    float cb = 0.f;
#pragma unroll 8
    for (int ic = 0; ic < 32; ++ic) cb += cbp[(ic * 2 + kv) * 256 + 32 * wid + r32];
    LAS unsigned char* hidL = lds;
#pragma unroll
    for (int r = 0; r < 16; ++r) { const int n = (r & 3) + 8 * (r >> 2) + 4 * hi; *(LAS bf16*)(hidL + n * HID_PITCH + (32 * wid + r32) * 2) = (bf16)f2bf(gelu_tanh(acc[r] + cb)); }
    asm volatile("s_waitcnt lgkmcnt(0)\n\ts_barrier" ::: "memory");
    if (wid == 0) {
        f32x16 o0 = {}, o1 = {};
#pragma unroll 4
        for (int kk = 0; kk < 16; ++kk) { const bf16x8 hb = *(const LAS bf16x8*)(hidL + r32 * HID_PITCH + (16 * kk + 8 * hi) * 2);
            const bf16x8 a0 = *(const bf16x8*)(w2 + (size_t)r32 * 256 + 16 * kk + 8 * hi), a1 = *(const bf16x8*)(w2 + (size_t)(32 + r32) * 256 + 16 * kk + 8 * hi);
            o0 = __builtin_amdgcn_mfma_f32_32x32x16_bf16(a0, hb, o0, 0, 0, 0); o1 = __builtin_amdgcn_mfma_f32_32x32x16_bf16(a1, hb, o1, 0, 0, 0); }
        float rs = 1.f;
        if (!kv) { float ss = 0.f;
#pragma unroll
            for (int r = 0; r < 16; ++r) ss += o0[r] * o0[r] + o1[r] * o1[r];
            auto rr = __builtin_amdgcn_permlane32_swap(__float_as_uint(ss), __float_as_uint(ss), false, false); ss = __uint_as_float(rr[0]) + __uint_as_float(rr[1]);
            rs = rsqrtf(ss * (1.f / 64.f) + 1e-6f); }
        const int n = n0 + r32; bf16* dst = (kv ? vcmp : kcmp) + ((size_t)bg * 512 + n) * 64;
#pragma unroll
        for (int r = 0; r < 16; ++r) { const int d = (r & 3) + 8 * (r >> 2) + 4 * hi;
            float v0 = o0[r] * rs, v1 = o1[r] * rs; if (!kv) { v0 *= kncmp[d]; v1 *= kncmp[d + 32]; }
            if (n >= NCMP) { v0 = 0.f; v1 = 0.f; }
            dst[d] = (bf16)f2bf(v0); dst[d + 32] = (bf16)f2bf(v1); }
    }
    asm volatile("s_waitcnt lgkmcnt(0)\n\ts_barrier" ::: "memory");
}
}
__global__ void __launch_bounds__(NTHREADS, 2) mk_fwd(Args a) {
    extern __shared__ __attribute__((aligned(16))) unsigned char lds[];
    Frame F;
    F.lds = (LAS unsigned char*)lds;
    F.tid = threadIdx.x; F.lane = F.tid & 63; F.wave = __builtin_amdgcn_readfirstlane(F.tid >> 6);
    F.G = gridDim.x; { const int bx = blockIdx.x; F.vcu = (F.G % 8 == 0) ? (bx % 8) * (F.G / 8) + bx / 8 : bx; }
    cg::grid_group grid = cg::this_grid();
    volatile LAS unsigned* xst = (volatile LAS unsigned*)(F.lds + 147424);
    if (F.tid < 8) xst[F.tid] = 0u;
    __syncthreads();
    const XcdBarrier xbar = xcd_barrier_post((unsigned*)(a.ws + WS_CTL) + 4096, xst);
    unsigned char* ws = a.ws;
    const int lo = a.ph_lo, hi = a.ph_hi;
    const att::AttnPtrs P{(const bf16*)(ws + WS_QKV), (const float*)(ws + WS_KMP), (const float*)(ws + WS_GATES), (const bf16*)(ws + WS_KCMP), (const bf16*)(ws + WS_VCMP), a.in[2], (bf16*)(ws + WS_MIX),
                          (unsigned*)(ws + WS_SELG), (bf16*)(ws + WS_PARTO), (float*)(ws + WS_PARTL)};
#define IN(k) (lo <= (k) && (k) < hi)
#define SEAM(k) do { if (IN(k) && IN((k) + 1)) { if ((k) == 0) grid.sync(); else xcd_barrier(xbar); } } while (0)
    if (IN(0)) { phase_prologue_a(F, a); } SEAM(0);
    if (IN(1)) { phase_prologue_b(F, a); } SEAM(1);
    if (IN(2)) {
        pg8::Gemm g{(const pg8::bf16_t*)(ws + WS_H), (const pg8::bf16_t*)(ws + WS_WIN), TOK, NIN_PAD, DM}; pg8::StaticOrder S; S.init(TOK, NIN_PAD, F.G, (int)blockIdx.x);
        pg8::EpiInProj E{(pg8::bf16_t*)(ws + WS_QKV), (float*)(ws + WS_GATES), (float*)(ws + WS_KMP), a.in[7], a.in[8], a.in[9], a.in[11], a.in[12]};
        pg8::gemm_phase<pg8::EpiInProj, pg8::StaticOrder, true, true>(F.lds, g, S, E);
    } SEAM(2);
    if (IN(3)) {
        att::moba_gate_phase(P, F.vcu, F.G, F.tid);
        for (int unit = F.vcu; unit < 256; unit += F.G)
            cmpr::compress_unit(F.lds, unit, (const bf16*)(ws + WS_QKV), (const bf16*)(ws + WS_W1K), (const bf16*)(ws + WS_W1V), (const bf16*)(ws + WS_W2K), (const bf16*)(ws + WS_W2V),
                                (const float*)(ws + WS_CBP), a.in[10], (bf16*)(ws + WS_KCMP), (bf16*)(ws + WS_VCMP));
    } SEAM(3);
    if (IN(4)) {
                att::attn_phase(F.lds, P, (unsigned*)(ws + WS_CTL) + 64);
    } SEAM(4);
    if (IN(5)) { att::moba_merge_phase(F.lds, P, F.vcu, F.G); } SEAM(5);
    if (IN(6)) {
        pg8::Gemm g{(const pg8::bf16_t*)(ws + WS_MIX), (const pg8::bf16_t*)(ws + WS_WOUT), TOK, DM, DM}; pg8::StaticOrder S; S.init(TOK, DM, F.G, (int)blockIdx.x);
        pg8::EpiOutProj E{a.in[0], a.out, (const float*)(ws + WS_MOD) + 2 * DM};
        pg8::gemm_phase<pg8::EpiOutProj, pg8::StaticOrder, true, true>(F.lds, g, S, E);
    } SEAM(6);
    if (IN(7)) { phase_norm2(F, a); } SEAM(7);
    if (IN(8)) {
        pg8::Gemm g{(const pg8::bf16_t*)(ws + WS_H), (const pg8::bf16_t*)(ws + WS_WGU), TOK, 2 * FF, DM}; pg8::StaticOrder S; S.init(TOK, 2 * FF, F.G, (int)blockIdx.x);
        pg8::EpiGateUp E{(pg8::bf16_t*)(ws + WS_ACT)};
        pg8::gemm_phase<pg8::EpiGateUp, pg8::StaticOrder, true, true>(F.lds, g, S, E);
    } SEAM(8);
    if (IN(9)) {
        pg8::Gemm g{(const pg8::bf16_t*)(ws + WS_ACT), (const pg8::bf16_t*)(ws + WS_WDN), TOK, DM, FF}; pg8::StaticOrder S; S.init(TOK, DM, F.G, (int)blockIdx.x);
        pg8::EpiDown E{a.out, (const float*)(ws + WS_MOD) + 5 * DM};
        pg8::gemm_phase<pg8::EpiDown, pg8::StaticOrder, true, true>(F.lds, g, S, E);
    }
#undef IN
#undef SEAM
}

static void launch_phases(const Args& base, int lo, int hi, int grid, hipStream_t stream) {
    Args a = base; a.ph_lo = lo; a.ph_hi = hi;
    if (hi - lo > 1) { void* args[] = {&a}; (void)hipLaunchCooperativeKernel((const void*)mk_fwd, dim3(grid), dim3(NTHREADS), args, LDS_BYTES, stream); }
    else hipLaunchKernelGGL(mk_fwd, dim3(grid), dim3(NTHREADS), LDS_BYTES, stream, a);
}
extern "C" void kernel_launch(void* const* d_in, const int* in_sizes, int n_in, void* d_out, int out_size, void* d_ws, size_t ws_size, hipStream_t stream) {
    static int grid = 0;
    if (grid == 0) {
        int dev = 0, cus = 0, per_cu = 0;
        if (n_in != 23 || ws_size < 452 * MiB || hipGetDevice(&dev) != hipSuccess || hipDeviceGetAttribute(&cus, hipDeviceAttributeMultiprocessorCount, dev) != hipSuccess) { grid = -1; return; }
        if (hipFuncSetAttribute((const void*)mk_fwd, hipFuncAttributeMaxDynamicSharedMemorySize, LDS_BYTES) != hipSuccess) { grid = -1; return; }
        if (hipOccupancyMaxActiveBlocksPerMultiprocessor(&per_cu, (const void*)mk_fwd, NTHREADS, LDS_BYTES) != hipSuccess || per_cu < 1) { grid = -1; return; }
        grid = cus;
    }
    if (grid < 0) return;
    (void)hipMemsetAsync((char*)d_ws + WS_CTL, 0, CTL_ZERO_BYTES, stream);
    Args a{};
    for (int i = 0; i < 23; ++i) a.in[i] = (const float*)d_in[i];
    a.out = (float*)d_out; a.ws = (unsigned char*)d_ws;
    unsigned char* ws = (unsigned char*)d_ws;
#if HYBRID == 1
    launch_phases(a, 0, 1, grid, stream); launch_phases(a, 1, 2, grid, stream); launch_phases(a, 2, 3, grid, stream);
    const bf16* qkv = (const bf16*)(ws + WS_QKV); bf16* mix = (bf16*)(ws + WS_MIX); bf16* kcmp = (bf16*)(ws + WS_KCMP); bf16* vcmp = (bf16*)(ws + WS_VCMP);
    int* sel = (int*)(ws + 344 * MiB); float* obuf = (float*)(ws + 348 * MiB); const float* gates = (const float*)(ws + WS_GATES);
    nq::k_compress<<<dim3(4 * 2 * 512, 2), 256, 0, stream>>>(qkv, a.in[13], a.in[14], a.in[15], a.in[16], a.in[17], a.in[18], a.in[10], kcmp, vcmp);
    nq::k_moba<<<4 * 8 * SEQ / 4, 256, 0, stream>>>(qkv, (const float*)(ws + WS_KMP), a.in[2], mix);
    nq::k_nsa_cmp<<<4 * 2 * SEQ, 256, 0, stream>>>(qkv, kcmp, vcmp, gates, obuf, sel);
    nq::k_nsa_sel<<<4 * 2 * SEQ, 256, 0, stream>>>(qkv, sel, a.in[2], gates, obuf);
    nq::k_nsa_win<<<4 * 2 * SEQ, 256, 0, stream>>>(qkv, a.in[2], gates, obuf, mix);
    launch_phases(a, 5, 6, grid, stream); launch_phases(a, 6, 7, grid, stream); launch_phases(a, 7, 8, grid, stream); launch_phases(a, 8, 9, grid, stream);
#elif HYBRID == 2
    launch_phases(a, 0, 1, grid, stream); launch_phases(a, 1, 2, grid, stream); launch_phases(a, 2, 3, grid, stream);
    nq::k_compress<<<dim3(4 * 2 * 512, 2), 256, 0, stream>>>((const bf16*)(ws + WS_QKV), a.in[13], a.in[14], a.in[15], a.in[16], a.in[17], a.in[18], a.in[10], (bf16*)(ws + WS_KCMP), (bf16*)(ws + WS_VCMP));
    launch_phases(a, 4, 5, grid, stream);
    launch_phases(a, 5, 6, grid, stream); launch_phases(a, 6, 7, grid, stream); launch_phases(a, 7, 8, grid, stream); launch_phases(a, 8, 9, grid, stream);
#elif HYBRID == 3
    for (int p = 0; p < N_PHASES; ++p) { launch_phases(a, p, p + 1, grid, stream);
#if defined(ABL_REPS)
        if (p == 3) { static bool once = false; if (!once) { once = true; (void)hipFuncSetAttribute((const void*)k_attn_abl, hipFuncAttributeMaxDynamicSharedMemorySize, LDS_BYTES); }
            for (int r = 0; r < ABL_REPS; ++r) { (void)hipMemsetAsync((char*)d_ws + WS_CTL + 512, 0, 4, stream); hipLaunchKernelGGL(k_attn_abl, dim3(grid), dim3(NTHREADS), LDS_BYTES, stream, a); } }
#endif
#if defined(TIME_PHASE)
        if (p == TIME_PHASE) { for (int r = 0; r < TIME_REPS; ++r) { (void)hipMemsetAsync((char*)d_ws + WS_CTL, 0, CTL_ZERO_BYTES, stream); launch_phases(a, p, p + 1, grid, stream); } }
#endif
    }
#else
    launch_phases(a, 0, N_PHASES, grid, stream);
#endif
}
```

```cpp
#include <hip/hip_runtime.h>
#include <hip/hip_cooperative_groups.h>
#include <cstdint>
#include <cstdio>
namespace cg = cooperative_groups;
#define HYBRID 0
namespace pg8 {
#define PG8_LAS __attribute__((address_space(3)))
typedef unsigned short bf16_t;
typedef short bf16x8 __attribute__((ext_vector_type(8)));
typedef float f32x4 __attribute__((ext_vector_type(4)));
typedef unsigned u32x4 __attribute__((ext_vector_type(4)));
constexpr int BM = 256, BK = 64, HALF = 128, HTB = HALF * BK * 2  , STAGE_BYTES = 8 * HTB, NXCD = 8, WGM = 8;

__host__ __device__ __forceinline__ int lds_byte(int r, int c) { const int st = (r >> 4) * 2 + (c >> 5), rr = r & 15, cc = c & 31, ob = rr * 64 + cc * 2; return st * 1024 + (ob ^ (((ob >> 9) & 1) << 5)); }
__host__ __device__ __forceinline__ void stage_rc(int b, int& R, int& C) { const int st = b / 1024, sb = b % 1024, swz = sb ^ (((sb >> 9) & 1) << 5); R = (st >> 1) * 16 + swz / 64; C = (st & 1) * 32 + (swz % 64) / 2; }
__host__ __device__ __forceinline__ int perm32(int rho) { const int n = rho >> 4, i = rho & 15; return 8 * (i >> 2) + 4 * n + (i & 3); }

struct Unit { int pm, pn; };
struct Gemm { const bf16_t* A; const bf16_t* Bt; int M, N, K; };

struct StaticOrder {
    int nM, nN, nwg, G, c;
    __host__ __device__ void init(int M, int N, int G_, int c_) { nM = M / BM; nN = N / BM; nwg = nM * nN; G = G_; c = c_; }
    __host__ __device__ bool next(int i, Unit& u) const {
        const long L = (long)i * G + c; if (L >= nwg) return false;
        int wgid = (int)L; { const int q = nwg / NXCD, r = nwg % NXCD, xcd = wgid % NXCD, off = wgid / NXCD; wgid = (xcd < r ? xcd * (q + 1) : r * (q + 1) + (xcd - r) * q) + off; }
        const int nig = WGM * nN, gid = wgid / nig, fm = gid * WGM, gsz = (nM - fm) < WGM ? (nM - fm) : WGM;
        u.pm = fm + ((wgid % nig) % gsz); u.pn = (wgid % nig) / gsz; return true;
    }
    __device__ __forceinline__ void a_ready(const Unit&) const {}
    __device__ __forceinline__ void done(const Unit&) const {}
};

__device__ __forceinline__ unsigned cvt_pk_bf16(float lo, float hi) { unsigned r; asm volatile("v_cvt_pk_bf16_f32 %0, %1, %2" : "=v"(r) : "v"(lo), "v"(hi)); return r; }
typedef float f32x2 __attribute__((ext_vector_type(2)));
template <class Epi, class Sched, bool ALIGN_EPI = false, bool SP2 = false>
__device__ __forceinline__ void gemm_phase(PG8_LAS unsigned char* lds, const Gemm g, const Sched& S, const Epi& E) {
    const int tid = threadIdx.x, wid = __builtin_amdgcn_readfirstlane(tid >> 6), lane = tid & 63, wr = wid >> 2, wc = wid & 3, fr = lane & 15, fq = lane >> 4;
    const int K = g.K, nt = K / BK;
    unsigned voffA[2], voffB[2];
#pragma unroll
    for (int i = 0; i < 2; ++i) { int R, C; stage_rc(tid * 16 + i * 8192, R, C); const int Rb = Epi::PERM ? ((R & ~31) + perm32(R & 31)) : R;
        voffA[i] = (unsigned)(R * K + C) * 2u; voffB[i] = (unsigned)(Rb * K + C) * 2u; }
    const size_t kstep = (size_t)(BK * 2);
    const size_t hstep = (size_t)HALF * K * 2;
    const size_t tstep = 2 * hstep;
    const unsigned ldsw = (unsigned)wid * 1024u;
    const int aoff = lds_byte(wr * 64 + fr, fq * 8), boff = lds_byte(wc * 32 + fr, fq * 8);
#define PG8_SA(b, h) (((b) * 2 + (h)) * HTB)
#define PG8_SB(b, h) ((4 + (b) * 2 + (h)) * HTB)
#define PG8_STAGE(bufoff, gbase, voff) do { _Pragma("unroll") for (int _i = 0; _i < 2; ++_i) \
        __builtin_amdgcn_global_load_lds((const unsigned*)((const char*)(gbase) + (voff)[_i]), (PG8_LAS unsigned*)(lds + (bufoff) + ldsw + _i * 8192), 16, 0, 0); } while (0)
#define PG8_LDA(dst, b, h) do { _Pragma("unroll") for (int m = 0; m < 4; ++m) _Pragma("unroll") for (int k = 0; k < 2; ++k) dst[m][k] = *(const PG8_LAS bf16x8*)(lds + PG8_SA(b, h) + aoff + m * 2048 + k * 1024); } while (0)
#define PG8_LDB(dst, b, h) do { _Pragma("unroll") for (int n = 0; n < 2; ++n) _Pragma("unroll") for (int k = 0; k < 2; ++k) dst[n][k] = *(const PG8_LAS bf16x8*)(lds + PG8_SB(b, h) + boff + n * 2048 + k * 1024); } while (0)
#define PG8_MMA(ai, bj, At, Bt) do { __builtin_amdgcn_s_setprio(1); _Pragma("unroll") for (int m = 0; m < 4; ++m) _Pragma("unroll") for (int n = 0; n < 2; ++n) _Pragma("unroll") for (int k = 0; k < 2; ++k) \
        acc[ai][bj][m][n] = __builtin_amdgcn_mfma_f32_16x16x32_bf16(Bt[n][k], At[m][k], acc[ai][bj][m][n], 0, 0, 0); __builtin_amdgcn_s_setprio(0); } while (0)
#define PG8_WAIT_V(n) asm volatile("s_waitcnt vmcnt(" #n ")" ::: "memory")
#define PG8_WAIT_L(n) asm volatile("s_waitcnt lgkmcnt(" #n ")" ::: "memory")
#define PG8_BAR __builtin_amdgcn_s_barrier()
#define PG8_SCHED __builtin_amdgcn_sched_barrier(0)
    Unit cur, nxt; int ui = 0;
    if (!S.next(0, cur)) return;
    f32x4 acc[2][2][4][2];
#pragma unroll
    for (int a = 0; a < 2; ++a)
#pragma unroll
        for (int b = 0; b < 2; ++b)
#pragma unroll
            for (int m = 0; m < 4; ++m)
#pragma unroll
                for (int n = 0; n < 2; ++n) acc[a][b][m][n] = (f32x4){0.f, 0.f, 0.f, 0.f};
    bf16x8 At[4][2], B0[2][2], B1[2][2];
    const char* cA = (const char*)g.A + (size_t)cur.pm * tstep; const char* cB = (const char*)g.Bt + (size_t)cur.pn * tstep;
    S.a_ready(cur);
    if constexpr (SP2) {
        PG8_STAGE(PG8_SB(0, 0), cB, voffB); PG8_STAGE(PG8_SB(0, 1), cB + hstep, voffB); PG8_STAGE(PG8_SA(0, 0), cA, voffA); PG8_STAGE(PG8_SA(0, 1), cA + hstep, voffA);
        if (wr == 1) PG8_BAR;
        PG8_WAIT_V(2); PG8_BAR;
        PG8_STAGE(PG8_SB(1, 0), cB + kstep, voffB); PG8_STAGE(PG8_SA(1, 0), cA + kstep, voffA); PG8_STAGE(PG8_SB(1, 1), cB + hstep + kstep, voffB);
        PG8_WAIT_V(6); PG8_BAR;
    } else {
        PG8_STAGE(PG8_SB(0, 0), cB, voffB); PG8_STAGE(PG8_SA(0, 0), cA, voffA); PG8_STAGE(PG8_SB(0, 1), cB + hstep, voffB); PG8_STAGE(PG8_SA(0, 1), cA + hstep, voffA);
        if (wr == 1) PG8_BAR;
        PG8_WAIT_V(4); PG8_BAR;
        PG8_STAGE(PG8_SB(1, 0), cB + kstep, voffB); PG8_STAGE(PG8_SA(1, 0), cA + kstep, voffA); PG8_STAGE(PG8_SB(1, 1), cB + hstep + kstep, voffB);
        PG8_WAIT_V(6); PG8_BAR;
    }
    for (;;) {
        const bool has_next = S.next(ui + 1, nxt);
        const char* nA = has_next ? (const char*)g.A + (size_t)nxt.pm * tstep : cA; const char* nB = has_next ? (const char*)g.Bt + (size_t)nxt.pn * tstep : cB;
        for (int t = 0; t < nt; t += 2) {
            const bool last = (t == nt - 2);
            const char* a1 = cA + (size_t)(t + 1) * kstep;
            const char* a2 = last ? nA : cA + (size_t)(t + 2) * kstep; const char* b2 = last ? nB : cB + (size_t)(t + 2) * kstep;
            const char* a3 = a2 + kstep; const char* b3 = b2 + kstep;
            if (last && has_next) S.a_ready(nxt);
            if constexpr (SP2) {
            PG8_LDB(B0, 0, 0); PG8_LDB(B1, 0, 1); PG8_SCHED; PG8_LDA(At, 0, 0); PG8_STAGE(PG8_SA(1, 1), a1 + hstep, voffA);
            PG8_WAIT_V(8); PG8_WAIT_L(0); PG8_BAR; PG8_MMA(0, 0, At, B0); PG8_MMA(0, 1, At, B1); PG8_BAR; PG8_SCHED;
            PG8_LDA(At, 0, 1); PG8_STAGE(PG8_SB(0, 0), b2, voffB); PG8_STAGE(PG8_SB(0, 1), b2 + hstep, voffB); PG8_STAGE(PG8_SA(0, 0), a2, voffA);
            PG8_WAIT_V(8); PG8_WAIT_L(0); PG8_BAR; PG8_MMA(1, 0, At, B0); PG8_MMA(1, 1, At, B1); PG8_BAR; PG8_SCHED;
            PG8_LDB(B0, 1, 0); PG8_LDB(B1, 1, 1); PG8_SCHED; PG8_LDA(At, 1, 0); PG8_STAGE(PG8_SA(0, 1), a2 + hstep, voffA);
            PG8_WAIT_V(8); PG8_WAIT_L(0); PG8_BAR; PG8_MMA(0, 0, At, B0); PG8_MMA(0, 1, At, B1); PG8_BAR; PG8_SCHED;
            PG8_LDA(At, 1, 1); PG8_STAGE(PG8_SB(1, 0), b3, voffB); PG8_STAGE(PG8_SB(1, 1), b3 + hstep, voffB); PG8_STAGE(PG8_SA(1, 0), a3, voffA);
            PG8_WAIT_V(8); PG8_WAIT_L(0); PG8_BAR; PG8_MMA(1, 0, At, B0); PG8_MMA(1, 1, At, B1); PG8_BAR; PG8_SCHED;
            } else {
            PG8_LDB(B0, 0, 0); PG8_SCHED; PG8_LDA(At, 0, 0); PG8_STAGE(PG8_SA(1, 1), a1 + hstep, voffA);
            PG8_WAIT_L(8); PG8_BAR; PG8_WAIT_L(0); PG8_MMA(0, 0, At, B0); PG8_BAR; PG8_SCHED;
            PG8_LDB(B1, 0, 1); PG8_STAGE(PG8_SB(0, 0), b2, voffB);
            PG8_BAR; PG8_WAIT_L(0); PG8_MMA(0, 1, At, B1); PG8_BAR;
            PG8_LDA(At, 0, 1); PG8_STAGE(PG8_SA(0, 0), a2, voffA);
            PG8_BAR; PG8_WAIT_L(0); PG8_MMA(1, 0, At, B0); PG8_BAR; PG8_SCHED;
            PG8_STAGE(PG8_SB(0, 1), b2 + hstep, voffB);
            PG8_WAIT_V(6); PG8_BAR; PG8_MMA(1, 1, At, B1); PG8_BAR;
            PG8_LDB(B0, 1, 0); PG8_SCHED; PG8_LDA(At, 1, 0); PG8_STAGE(PG8_SA(0, 1), a2 + hstep, voffA);
            PG8_WAIT_L(8); PG8_BAR; PG8_WAIT_L(0); PG8_MMA(0, 0, At, B0); PG8_BAR; PG8_SCHED;
            PG8_LDB(B1, 1, 1); PG8_STAGE(PG8_SB(1, 0), b3, voffB);
            PG8_BAR; PG8_WAIT_L(0); PG8_MMA(0, 1, At, B1); PG8_BAR;
            PG8_LDA(At, 1, 1); PG8_STAGE(PG8_SA(1, 0), a3, voffA);
            PG8_BAR; PG8_WAIT_L(0); PG8_MMA(1, 0, At, B0); PG8_BAR; PG8_SCHED;
            PG8_STAGE(PG8_SB(1, 1), b3 + hstep, voffB);
            PG8_WAIT_V(6); PG8_BAR; PG8_MMA(1, 1, At, B1); PG8_BAR;
            }
        }
        if constexpr (ALIGN_EPI) { if (wr == 0) PG8_BAR; }
        if constexpr (!Epi::AFTER_DRAIN) { E(acc, cur, wr, wc, fr, fq); S.done(cur); }
        if (!has_next) break;
#pragma unroll
        for (int a = 0; a < 2; ++a)
#pragma unroll
            for (int b = 0; b < 2; ++b)
#pragma unroll
                for (int m = 0; m < 4; ++m)
#pragma unroll
                    for (int n = 0; n < 2; ++n) acc[a][b][m][n] = (f32x4){0.f, 0.f, 0.f, 0.f};
        cur = nxt; cA = nA; cB = nB; ++ui;
        if constexpr (ALIGN_EPI) { if (wr == 1) PG8_BAR; }
    }
    PG8_WAIT_V(0);
    if constexpr (!ALIGN_EPI) { if (wr == 0) PG8_BAR; }
    PG8_BAR;
    if constexpr (Epi::AFTER_DRAIN) { E.fused(acc, cur, wr, wc, fr, fq, lds, wid, lane); S.done(cur); }
#undef PG8_SA
#undef PG8_SB
#undef PG8_STAGE
#undef PG8_LDA
#undef PG8_LDB
#undef PG8_MMA
#undef PG8_WAIT_V
#undef PG8_WAIT_L
#undef PG8_BAR
#undef PG8_SCHED
}
}
namespace pg8 {
typedef unsigned u32x2v __attribute__((ext_vector_type(2)));
constexpr int TOK_S = 8192;
constexpr float QK_EPS = 1e-6f;
constexpr float C2 = 0.125f * 1.4426950408889634f;
__device__ __forceinline__ float sigmoid_fast(float v) { return 1.f / (1.f + __expf(-v)); }
__device__ __forceinline__ float silu_fast(float v) { return v / (1.f + __expf(-v)); }

struct EpiInProj {
    static constexpr bool PERM = true, AFTER_DRAIN = false;
    bf16_t* qkv;
    float* gates;
    float* kmean_part;
    const float *qna, *kna, *qnb, *knsel, *knwin;
    __device__ __forceinline__ void operator()(const f32x4 (&acc)[2][2][4][2], const Unit& u, int wr, int wc, int fr, int fq) const {
        const int slot = u.pn * 4 + wc;
        if (slot > 44) return;
        const int b = u.pm >> 5, blk = u.pm & 31, pos0 = blk * 256 + wr * 64 + fr;
        if (slot == 44) {
            if (fq < 3) {
#pragma unroll
                for (int ai = 0; ai < 2; ++ai)
#pragma unroll
                    for (int m = 0; m < 4; ++m) { const size_t tok = (size_t)b * TOK_S + pos0 + ai * HALF + m * 16; float* gp = gates + tok * 24 + 8 * fq;
                        const f32x4 v0 = acc[ai][0][m][0], v1 = acc[ai][0][m][1];
                        *(f32x4*)gp = (f32x4){sigmoid_fast(v0[0]), sigmoid_fast(v0[1]), sigmoid_fast(v0[2]), sigmoid_fast(v0[3])};
                        *(f32x4*)(gp + 4) = (f32x4){sigmoid_fast(v1[0]), sigmoid_fast(v1[1]), sigmoid_fast(v1[2]), sigmoid_fast(v1[3])}; }
            }
            return;
        }
        const float* gain = nullptr; float qscale = 1.f; bool is_ka = false; bf16_t* dst;
        constexpr size_t BIG = (size_t)4 * 8 * TOK_S * 64, SMALL = (size_t)4 * 2 * TOK_S * 64;
        if (slot < 32) { const int kind = slot >> 3, head = slot & 7; dst = qkv + kind * BIG + ((size_t)(b * 8 + head) * TOK_S) * 64;
            if (kind == 0) { gain = qna; qscale = C2; } else if (kind == 1) { gain = kna; is_ka = true; } else if (kind == 3) { gain = qnb; qscale = C2; } }
        else { const int kind = (slot - 32) >> 1, g = slot & 1; dst = qkv + 4 * BIG + kind * SMALL + ((size_t)(b * 2 + g) * TOK_S) * 64;
            if (kind == 2) gain = knsel; else if (kind == 4) gain = knwin; }
        float gv[16];
#pragma unroll
        for (int i = 0; i < 16; ++i) gv[i] = gain ? gain[(i >> 3) * 32 + 8 * fq + (i & 7)] * qscale : 1.f;
        float cs[16];
#pragma unroll
        for (int i = 0; i < 16; ++i) cs[i] = 0.f;
#pragma unroll
        for (int ai = 0; ai < 2; ++ai)
#pragma unroll
            for (int m = 0; m < 4; ++m) {
                float v[16];
#pragma unroll
                for (int bj = 0; bj < 2; ++bj)
#pragma unroll
                    for (int n = 0; n < 2; ++n)
#pragma unroll
                        for (int j = 0; j < 4; ++j) v[bj * 8 + n * 4 + j] = acc[ai][bj][m][n][j];
                if (gain) { float ss = 0.f;
#pragma unroll
                    for (int i = 0; i < 16; ++i) ss += v[i] * v[i];
                    ss += __shfl_xor(ss, 16); ss += __shfl_xor(ss, 32);
                    const float rs = rsqrtf(ss * (1.f / 64.f) + QK_EPS);
#pragma unroll
                    for (int i = 0; i < 16; ++i) v[i] *= rs * gv[i]; }
                if (is_ka) {
#pragma unroll
                    for (int i = 0; i < 16; ++i) cs[i] += v[i]; }
                bf16_t* rp = dst + (size_t)(pos0 + ai * HALF + m * 16) * 64 + 8 * fq;
                u32x4 w0, w1;
                w0.x = cvt_pk_bf16(v[0], v[1]); w0.y = cvt_pk_bf16(v[2], v[3]); w0.z = cvt_pk_bf16(v[4], v[5]); w0.w = cvt_pk_bf16(v[6], v[7]);
                w1.x = cvt_pk_bf16(v[8], v[9]); w1.y = cvt_pk_bf16(v[10], v[11]); w1.z = cvt_pk_bf16(v[12], v[13]); w1.w = cvt_pk_bf16(v[14], v[15]);
                *(u32x4*)rp = w0; *(u32x4*)(rp + 32) = w1;
            }
        if (is_ka) {
#pragma unroll
            for (int i = 0; i < 16; ++i) { float s = cs[i]; s += __shfl_xor(s, 1); s += __shfl_xor(s, 2); s += __shfl_xor(s, 4); s += __shfl_xor(s, 8); cs[i] = s; }
            if (fr == 0) { float* kp = kmean_part + ((size_t)((b * 8 + (slot & 7)) * 32 + blk) * 2 + wr) * 64 + 8 * fq;
                *(f32x4*)kp = (f32x4){cs[0], cs[1], cs[2], cs[3]}; *(f32x4*)(kp + 4) = (f32x4){cs[4], cs[5], cs[6], cs[7]};
                *(f32x4*)(kp + 32) = (f32x4){cs[8], cs[9], cs[10], cs[11]}; *(f32x4*)(kp + 36) = (f32x4){cs[12], cs[13], cs[14], cs[15]}; }
        }
    }
};
struct EpiOutProj {
    static constexpr bool PERM = false, AFTER_DRAIN = false;
    const float* x; float* out; const float* gt;
    __device__ __forceinline__ void operator()(const f32x4 (&acc)[2][2][4][2], const Unit& u, int wr, int wc, int fr, int fq) const {
        const int b = u.pm >> 5; const int col0 = u.pn * BM + wc * 32 + 4 * fq; const float* gtb = gt + (size_t)b * 6144;
#pragma unroll
        for (int bj = 0; bj < 2; ++bj)
#pragma unroll
            for (int n = 0; n < 2; ++n) { const int c = col0 + bj * HALF + n * 16; const f32x4 g4 = *(const f32x4*)(gtb + c);
#pragma unroll
                for (int ai = 0; ai < 2; ++ai)
#pragma unroll
                    for (int m = 0; m < 4; ++m) { const size_t off = (size_t)(u.pm * BM + ai * HALF + wr * 64 + m * 16 + fr) * 1024 + c;
                        const f32x4 xv = *(const f32x4*)(x + off); *(f32x4*)(out + off) = xv + g4 * acc[ai][bj][m][n]; } }
    }
};
struct EpiGateUp {
    static constexpr bool PERM = true, AFTER_DRAIN = false;
    bf16_t* act;
    __device__ __forceinline__ void operator()(const f32x4 (&acc)[2][2][4][2], const Unit& u, int wr, int wc, int fr, int fq) const {
        const int h0 = u.pn * 128 + wc * 32 + 8 * fq;
#pragma unroll
        for (int ai = 0; ai < 2; ++ai)
#pragma unroll
            for (int m = 0; m < 4; ++m) { const size_t row = (size_t)(u.pm * BM + ai * HALF + wr * 64 + m * 16 + fr);
                const f32x4 g0 = acc[ai][0][m][0], g1 = acc[ai][0][m][1], u0 = acc[ai][1][m][0], u1 = acc[ai][1][m][1];
                u32x4 w;
                w.x = cvt_pk_bf16(silu_fast(g0[0]) * u0[0], silu_fast(g0[1]) * u0[1]); w.y = cvt_pk_bf16(silu_fast(g0[2]) * u0[2], silu_fast(g0[3]) * u0[3]);
                w.z = cvt_pk_bf16(silu_fast(g1[0]) * u1[0], silu_fast(g1[1]) * u1[1]); w.w = cvt_pk_bf16(silu_fast(g1[2]) * u1[2], silu_fast(g1[3]) * u1[3]);
                *(u32x4*)(act + row * 2816 + h0) = w; }
    }
};
struct EpiDown {
    static constexpr bool PERM = false, AFTER_DRAIN = false;
    float* out; const float* gt;
    __device__ __forceinline__ void operator()(const f32x4 (&acc)[2][2][4][2], const Unit& u, int wr, int wc, int fr, int fq) const {
        const int b = u.pm >> 5; const int col0 = u.pn * BM + wc * 32 + 4 * fq; const float* gtb = gt + (size_t)b * 6144;
#pragma unroll
        for (int bj = 0; bj < 2; ++bj)
#pragma unroll
            for (int n = 0; n < 2; ++n) { const int c = col0 + bj * HALF + n * 16; const f32x4 g4 = *(const f32x4*)(gtb + c);
#pragma unroll
                for (int ai = 0; ai < 2; ++ai)
#pragma unroll
                    for (int m = 0; m < 4; ++m) { const size_t off = (size_t)(u.pm * BM + ai * HALF + wr * 64 + m * 16 + fr) * 1024 + c;
                        const f32x4 xv = *(const f32x4*)(out + off); *(f32x4*)(out + off) = xv + g4 * acc[ai][bj][m][n]; } }
    }
};
}
constexpr int NWAVES = 8, NTHREADS = 512;
constexpr int BATCH = 4, SEQ = 8192, DM = 1024, TOK = BATCH * SEQ, NIN = 2840, NIN_PAD = 3072, FF = 2816, NCMP = 511;
constexpr size_t MiB = 1u << 20;
constexpr size_t WS_CTL = 0, CTL_ZERO_BYTES = 64 * 1024;
constexpr size_t WS_MODP = 1 * MiB;
constexpr size_t WS_MOD = 2 * MiB;
constexpr size_t WS_CBP = 2 * MiB + 512 * 1024;
constexpr size_t WS_KMP = 3 * MiB;
constexpr size_t WS_BIAS2 = 4 * MiB;
constexpr size_t WS_SSP = 449 * MiB;
constexpr size_t WS_WIN = 6 * MiB, WS_WOUT = 12 * MiB, WS_WGU = 14 * MiB, WS_WDN = 25 * MiB;
constexpr size_t WS_W1K = 31 * MiB, WS_W1V = 32 * MiB, WS_W2K = 33 * MiB, WS_W2V = 33 * MiB + 64 * 1024;
constexpr size_t WS_KCMP = 34 * MiB, WS_VCMP = 35 * MiB;
constexpr size_t WS_GATES = 36 * MiB;
constexpr size_t WS_H = 40 * MiB;
constexpr size_t WS_MIX = 104 * MiB;
constexpr size_t WS_QKV = 168 * MiB;
constexpr size_t WS_ACT = WS_QKV;
constexpr size_t WS_END = 344 * MiB;
constexpr size_t WS_PARTO = 344 * MiB;
constexpr size_t WS_PARTL = 444 * MiB;
constexpr size_t WS_SELG = 448 * MiB;
constexpr size_t QKV_BIG = (size_t)4 * 8 * SEQ * 64, QKV_SMALL = (size_t)4 * 2 * SEQ * 64;
constexpr int RING_BYTES = 131072, LDS_BYTES = 147456;
constexpr int N_PHASES = 10;

#define GAS __attribute__((address_space(1)))
#define LAS __attribute__((address_space(3)))
typedef unsigned short bf16;
typedef unsigned v4u __attribute__((ext_vector_type(4)));
typedef float f32x4 __attribute__((ext_vector_type(4)));
#define LDS_WAIT() asm volatile("s_waitcnt lgkmcnt(0)" ::: "memory")
#define VM_WAIT() asm volatile("s_waitcnt vmcnt(0)" ::: "memory")
__device__ __forceinline__ unsigned f2bf(float f) { unsigned u = __builtin_bit_cast(unsigned, f); return (u + 0x7fffu + ((u >> 16) & 1u)) >> 16; }
__device__ __forceinline__ unsigned pk2(float lo, float hi) { return f2bf(lo) | (f2bf(hi) << 16); }
__device__ __forceinline__ float bf2f(bf16 v) { return __builtin_bit_cast(float, (unsigned)v << 16); }
__device__ __forceinline__ float wave_sum(float v) {
#pragma unroll
    for (int o = 1; o < 64; o <<= 1) v += __shfl_xor(v, o);
    return v;
}
struct Args { const float* in[23]; float* out; unsigned char* ws; int ph_lo, ph_hi; };
struct Frame { LAS unsigned char* lds; int tid, lane, wave, vcu, G; };

struct MapId { __device__ __forceinline__ size_t off(int n, int k, int K) const { return (size_t)n * K + k; } };
struct MapWin { __device__ __forceinline__ size_t off(int n, int k, int K) const { const int s = n >> 6, d = n & 63; return (size_t)(256 * (s >> 2) + 128 * (d >> 5) + 32 * (s & 3) + (d & 31)) * K + k; } };
struct MapWgu { __device__ __forceinline__ size_t off(int n, int k, int K) const { const int up = n >= FF, hdn = up ? n - FF : n; return (size_t)(256 * (hdn >> 7) + 128 * up + (hdn & 127)) * K + k; } };
struct MapFrag { __device__ __forceinline__ size_t off(int n, int k, int K) const { return ((size_t)((k >> 4) * 8 + (n >> 5)) * 64 + ((k >> 3) & 1) * 32 + (n & 31)) * 8 + (k & 7); } };
template <class Map>
__device__ __forceinline__ void transpose_item(const float* __restrict__ W, int K, int N, bf16* WT, LAS float* scr, int item, int lane, const Map& map) {
    const int nblk = (N + 63) / 64, kb = item / nblk, nb = item % nblk, k0 = 64 * kb, n0 = 64 * nb;
    const int nc = n0 + 4 * (lane & 15); const bool nin = nc < N;
    f32x4 v[16];
#pragma unroll
    for (int i = 0; i < 16; ++i) { const int kk = 4 * i + (lane >> 4); v[i] = nin ? *(const GAS f32x4*)(W + (size_t)(k0 + kk) * N + nc) : (f32x4){0.f, 0.f, 0.f, 0.f}; }
#pragma unroll
    for (int i = 0; i < 16; ++i) { const int kk = 4 * i + (lane >> 4); LAS float* d = scr + (4 * (lane & 15)) * 68 + kk; d[0] = v[i][0]; d[68] = v[i][1]; d[136] = v[i][2]; d[204] = v[i][3]; }
    LDS_WAIT(); asm volatile("" ::: "memory");
    const int c = lane & 7;
#pragma unroll
    for (int j = 0; j < 8; ++j) { const int n = (lane >> 3) + 8 * j; const LAS float* s = scr + n * 68 + 8 * c;
        const f32x4 a = *(const LAS f32x4*)s, bq = *(const LAS f32x4*)(s + 4);
        v4u o; o.x = pk2(a[0], a[1]); o.y = pk2(a[2], a[3]); o.z = pk2(bq[0], bq[1]); o.w = pk2(bq[2], bq[3]);
        if (n0 + n < N) *(GAS v4u*)(WT + map.off(n0 + n, k0 + 8 * c, K)) = o; }
    LDS_WAIT(); asm volatile("" ::: "memory");
}
__device__ __forceinline__ float silu_acc(float v) { return v / (1.f + expf(-v)); }
__device__ __forceinline__ void phase_prologue_a(Frame& F, const Args& a) {
    LAS float* scr = (LAS float*)(F.lds + F.wave * 17408);
    const int gw = F.vcu * NWAVES + F.wave, NGW = F.G * NWAVES;
    unsigned char* ws = a.ws;
    constexpr int I_IN = (DM / 64) * ((NIN + 63) / 64), I_OUT = (DM / 64) * (DM / 64), I_GU = (DM / 64) * (2 * FF / 64), I_DN = (FF / 64) * (DM / 64), I_W1 = (2048 / 64) * (256 / 64), I_W2 = (256 / 64) * (64 / 64);
    constexpr int NITEMS = I_IN + I_OUT + I_GU + I_DN + 2 * I_W1 + 2 * I_W2;
    for (int it = gw; it < NITEMS; it += NGW) {
        int r = it;
        if (r < I_IN) { transpose_item(a.in[6], DM, NIN, (bf16*)(ws + WS_WIN), scr, r, F.lane, MapWin()); continue; } r -= I_IN;
        if (r < I_OUT) { transpose_item(a.in[19], DM, DM, (bf16*)(ws + WS_WOUT), scr, r, F.lane, MapId()); continue; } r -= I_OUT;
        if (r < I_GU) { transpose_item(a.in[21], DM, 2 * FF, (bf16*)(ws + WS_WGU), scr, r, F.lane, MapWgu()); continue; } r -= I_GU;
        if (r < I_DN) { transpose_item(a.in[22], FF, DM, (bf16*)(ws + WS_WDN), scr, r, F.lane, MapId()); continue; } r -= I_DN;
        if (r < I_W1) { transpose_item(a.in[14], 2048, 256, (bf16*)(ws + WS_W1K), scr, r, F.lane, MapFrag()); continue; } r -= I_W1;
        if (r < I_W1) { transpose_item(a.in[17], 2048, 256, (bf16*)(ws + WS_W1V), scr, r, F.lane, MapFrag()); continue; } r -= I_W1;
        if (r < I_W2) { transpose_item(a.in[15], 256, 64, (bf16*)(ws + WS_W2K), scr, r, F.lane, MapId()); continue; } r -= I_W2;
        transpose_item(a.in[18], 256, 64, (bf16*)(ws + WS_W2V), scr, r, F.lane, MapId());
    }
    const float* c = a.in[1]; const float* w_ada = a.in[3]; float* modp = (float*)(ws + WS_MODP);
    for (int t = NGW - 1 - gw; t < 96 * 8; t += NGW) { const int cg_ = t % 96, ks = t / 96; const int n = cg_ * 64 + F.lane;
        float acc0 = 0.f, acc1 = 0.f, acc2 = 0.f, acc3 = 0.f;
#pragma unroll
        for (int i = 0; i < 8; ++i) { const int idx = F.lane + 64 * i, bb = idx >> 7, kk = idx & 127; scr[kk * 4 + bb] = silu_acc(c[bb * DM + ks * 128 + kk]); }
        LDS_WAIT(); asm volatile("" ::: "memory");
#pragma unroll 8
        for (int k = 0; k < 128; ++k) { const float w = w_ada[(size_t)(ks * 128 + k) * 6144 + n]; const f32x4 sv = *(const LAS f32x4*)(scr + 4 * k);
            acc0 += sv[0] * w; acc1 += sv[1] * w; acc2 += sv[2] * w; acc3 += sv[3] * w; }
        LDS_WAIT(); asm volatile("" ::: "memory");
        float* o = modp + (size_t)ks * 4 * 6144 + n; o[0] = acc0; o[6144] = acc1; o[2 * 6144] = acc2; o[3 * 6144] = acc3; }
    float* cbp = (float*)(ws + WS_CBP);
    for (int t = NGW / 2 - 1 - gw; t >= 0 && t < 256; t += NGW) { const int kv = t & 1, cg_ = (t >> 1) & 3, ic = t >> 3; const int n = cg_ * 64 + F.lane;
        const float* pe = kv ? a.in[16] : a.in[13]; const float* w1 = kv ? a.in[17] : a.in[14]; float acc = 0.f;
#pragma unroll 8
        for (int i = ic * 64; i < ic * 64 + 64; ++i) acc += pe[i] * w1[(size_t)i * 256 + n];
        cbp[(ic * 2 + kv) * 256 + n] = acc; }
}
__device__ __forceinline__ void norm_rows(Frame& F, const float* in, const f32x4 (&gs)[4], const f32x4 (&sh)[4], bf16* out) {
#pragma unroll 4
    for (int i = 0; i < 16; ++i) { const int row = F.vcu * 128 + F.wave * 16 + i;
        const GAS f32x4* xr = (const GAS f32x4*)(in + (size_t)row * DM) + F.lane;
        f32x4 v[4]; float ss = 0.f;
#pragma unroll
        for (int j = 0; j < 4; ++j) { v[j] = xr[64 * j]; ss += (v[j].x * v[j].x + v[j].y * v[j].y) + (v[j].z * v[j].z + v[j].w * v[j].w); }
        const float rs = rsqrtf(wave_sum(ss) * (1.f / DM) + 1e-6f);
        GAS unsigned long long* o8 = (GAS unsigned long long*)(out + (size_t)row * DM) + F.lane;
#pragma unroll
        for (int j = 0; j < 4; ++j) { const f32x4 y = v[j] * rs * gs[j] + sh[j]; o8[64 * j] = (unsigned long long)pk2(y.x, y.y) | ((unsigned long long)pk2(y.z, y.w) << 32); } }
}
__device__ __forceinline__ void phase_prologue_b(Frame& F, const Args& a) {
    unsigned char* ws = a.ws; const float* modp = (const float*)(ws + WS_MODP); const float* b_ada = a.in[4];
    if (F.wave == 0 && F.vcu < 96) { const int n = F.vcu * 64 + F.lane; float* mod = (float*)(ws + WS_MOD);
        for (int b = 0; b < 4; ++b) { float s = 0.f;
#pragma unroll
            for (int ks = 0; ks < 8; ++ks) s += modp[((size_t)ks * 4 + b) * 6144 + n];
            mod[b * 6144 + n] = s + b_ada[n]; } }
    const int b = F.vcu >> 6; const float* g = a.in[5];
    f32x4 gs[4], sh[4];
#pragma unroll
    for (int j = 0; j < 4; ++j) { const int c0 = 4 * F.lane + 256 * j; f32x4 s0 = {0.f, 0.f, 0.f, 0.f}, s1 = {0.f, 0.f, 0.f, 0.f};
#pragma unroll
        for (int ks = 0; ks < 8; ++ks) { s0 += *(const f32x4*)(modp + ((size_t)ks * 4 + b) * 6144 + c0); s1 += *(const f32x4*)(modp + ((size_t)ks * 4 + b) * 6144 + DM + c0); }
        s0 += *(const f32x4*)(b_ada + c0); s1 += *(const f32x4*)(b_ada + DM + c0);
        sh[j] = s0; gs[j] = *(const f32x4*)(g + c0) * (s1 + 1.0f); }
    norm_rows(F, a.in[0], gs, sh, (bf16*)(ws + WS_H));
}
__device__ __forceinline__ void phase_norm2(Frame& F, const Args& a) {
    unsigned char* ws = a.ws; const int b = F.vcu >> 6; const float* mod = (const float*)(ws + WS_MOD) + (size_t)b * 6144; const float* g = a.in[20];
    f32x4 gs[4], sh[4];
#pragma unroll
    for (int j = 0; j < 4; ++j) { const int c0 = 4 * F.lane + 256 * j; sh[j] = *(const f32x4*)(mod + 3 * DM + c0); gs[j] = *(const f32x4*)(g + c0) * (*(const f32x4*)(mod + 4 * DM + c0) + 1.0f); }
    norm_rows(F, a.out, gs, sh, (bf16*)(ws + WS_H));
}

__device__ __forceinline__ void phase_bias2(Frame& F, const Args& a) {
    unsigned char* ws = a.ws; const float* mod = (const float*)(ws + WS_MOD); const bf16* wt = (const bf16*)(ws + WS_WGU); float* bias2 = (float*)(ws + WS_BIAS2);
    const int gw = F.vcu * NWAVES + F.wave, NGW = F.G * NWAVES;
    f32x4 sh[4][4];
#pragma unroll
    for (int bb = 0; bb < 4; ++bb)
#pragma unroll
        for (int j = 0; j < 4; ++j) sh[bb][j] = *(const f32x4*)(mod + (size_t)bb * 6144 + 3 * DM + 16 * F.lane + 4 * j);
    for (int c = gw; c < 2 * FF; c += NGW) {
        const v4u w0 = *(const GAS v4u*)(wt + (size_t)c * DM + 16 * F.lane), w1 = *(const GAS v4u*)(wt + (size_t)c * DM + 16 * F.lane + 8);
        const unsigned wu[8] = {w0.x, w0.y, w0.z, w0.w, w1.x, w1.y, w1.z, w1.w};
        float s[4] = {0.f, 0.f, 0.f, 0.f};
#pragma unroll
        for (int j = 0; j < 4; ++j) { const float e0 = __builtin_bit_cast(float, wu[2 * j] << 16), e1 = __builtin_bit_cast(float, wu[2 * j] & 0xffff0000u), e2 = __builtin_bit_cast(float, wu[2 * j + 1] << 16), e3 = __builtin_bit_cast(float, wu[2 * j + 1] & 0xffff0000u);
#pragma unroll
            for (int bb = 0; bb < 4; ++bb) s[bb] += (sh[bb][j][0] * e0 + sh[bb][j][1] * e1) + (sh[bb][j][2] * e2 + sh[bb][j][3] * e3); }
#pragma unroll
        for (int bb = 0; bb < 4; ++bb) { const float t = wave_sum(s[bb]); if (F.lane == 0) bias2[(size_t)bb * 2 * FF + c] = t; }
    }
}
#define XB_TMO      128
#define XB_XCNT(j)  (256  + 64 * (j))
#define XB_XSUB(j)  (1280 + 64 * (j))
#define XB_XGEN(j)  (2304 + 64 * (j))
#define XB_TOP      3328
#define XB_TOPGEN   3392
#define XCD_BAR_WORDS 3456
#define XB_SPIN_CAP (1u << 18)

__device__ __forceinline__ unsigned xb_ld(unsigned* p)              { return __hip_atomic_load(p, __ATOMIC_RELAXED, __HIP_MEMORY_SCOPE_AGENT); }
__device__ __forceinline__ unsigned xb_add(unsigned* p, unsigned v) { return __hip_atomic_fetch_add(p, v, __ATOMIC_RELAXED, __HIP_MEMORY_SCOPE_AGENT); }
__device__ __forceinline__ unsigned xb_xcc_id() { return (unsigned)__builtin_amdgcn_s_getreg((3 << 11) | 20) & 0xFu; }
#define XB_SPIN(cond, bar) do { unsigned _sp = 0; while (cond) { __builtin_amdgcn_s_sleep(1); \
    if ((++_sp & 255u) == 0u) { if (xb_ld(&(bar)[XB_TMO])) break; if (_sp > XB_SPIN_CAP) { atomicAdd(&(bar)[XB_TMO], 1u); break; } } } } while (0)

struct XcdBarrier {
    unsigned* bar; unsigned x;
    volatile LAS unsigned* st;
};

__device__ __forceinline__ XcdBarrier xcd_barrier_post(unsigned* bar, volatile LAS unsigned* st) {
    XcdBarrier b; b.bar = bar; b.x = xb_xcc_id(); b.st = st;
    if (threadIdx.x == 0) (void)xb_add(&bar[XB_XCNT(b.x)], 1u);
    return b;
}
__device__ __forceinline__ void xcd_barrier_complete(unsigned* bar, unsigned x, unsigned& nloc, unsigned& nx) {
    const unsigned G = gridDim.x * gridDim.y * gridDim.z;
    unsigned sum, cnt, mine, sp = 0u;
    for (;;) {
        sum = 0u; cnt = 0u; mine = 0u;
#pragma unroll
        for (unsigned j = 0; j < 16; ++j) { const unsigned c = xb_ld(&bar[XB_XCNT(j)]); sum += c; cnt += (c > 0u) ? 1u : 0u; mine = (j == x) ? c : mine; }
        if (sum == G) break;
        __builtin_amdgcn_s_sleep(1);
        if ((++sp & 255u) == 0u) { if (xb_ld(&bar[XB_TMO])) break; if (sp > XB_SPIN_CAP) { atomicAdd(&bar[XB_TMO], 1u); break; } }
    }
    nloc = mine > 0u ? mine : 1u; nx = cnt > 0u ? cnt : 1u;
}

__device__ __forceinline__ void xcd_barrier(const XcdBarrier& b) {
    asm volatile("s_waitcnt vmcnt(0)" ::: "memory");
    __syncthreads();
    if (threadIdx.x == 0) {
        unsigned* bar = b.bar;
        __builtin_amdgcn_s_waitcnt(0);
        unsigned nloc = b.st[0], nx = b.st[1];
        if (nloc == 0u) { xcd_barrier_complete(bar, b.x, nloc, nx); b.st[0] = nloc; b.st[1] = nx; }
        const unsigned old = xb_add(&bar[XB_XSUB(b.x)], 1u);
        const unsigned gen = old / nloc;
        if (old + 1u == (gen + 1u) * nloc) {
            __builtin_amdgcn_fence(__ATOMIC_RELEASE, "agent");
            asm volatile("s_waitcnt vmcnt(0)" ::: "memory");
            const unsigned og = xb_add(&bar[XB_TOP], 1u);
            const unsigned tg = og / nx;
            if (og + 1u == (tg + 1u) * nx) xb_add(&bar[XB_TOPGEN], 1u);
            else XB_SPIN(xb_ld(&bar[XB_TOPGEN]) == tg, bar);
            __builtin_amdgcn_fence(__ATOMIC_ACQUIRE, "agent");
            xb_add(&bar[XB_XGEN(b.x)], 1u);
            asm volatile("s_waitcnt vmcnt(0)" ::: "memory");
        } else {
            XB_SPIN(xb_ld(&bar[XB_XGEN(b.x)]) == gen, bar);
            __builtin_amdgcn_fence(__ATOMIC_ACQUIRE, "agent");
            asm volatile("s_waitcnt vmcnt(0)" ::: "memory");
        }
    }
    __syncthreads();
}
#define ATT_NS att
#ifndef ATT_ABL
#define ATT_ABL 0
#endif
#ifndef ATT_STAGGER
#define ATT_STAGGER 0
#endif
namespace ATT_NS {
using bf16x8 = __attribute__((ext_vector_type(8))) short;
using s16x4 = __attribute__((ext_vector_type(4))) short;
using f32x16 = __attribute__((ext_vector_type(16))) float;
using u32x4 = __attribute__((ext_vector_type(4))) unsigned;
typedef LAS const char* lds_cptr;
typedef short v4i16_t __attribute__((ext_vector_type(4)));
constexpr int SLOT = 16384, NSLOT = 4, LDS_OST = 65536, LDS_LUT = 98304, LDS_IMP = 100352, LDS_SELM = 133120, LDS_MISC = 134144, LDS_WSF = 134400, LDS_ATT_END = 136448;
constexpr float LOG2E = 1.4426950408889634f;
#define MFMA32(a, b, c) __builtin_amdgcn_mfma_f32_32x32x16_bf16(a, b, c, 0, 0, 0)
#define ATT_WAIT_BAR(N) asm volatile("s_waitcnt vmcnt(" #N ") lgkmcnt(0)\n\ts_barrier" ::: "memory")
__device__ __forceinline__ void glds16(const void* gsrc, unsigned lds_dst) { unsigned keep;
    asm volatile("s_mov_b32 %0, m0\n\ts_mov_b32 m0, %2\n\ts_nop 0\n\tglobal_load_lds_dwordx4 %1, off\n\ts_mov_b32 m0, %0" : "=&s"(keep) : "v"(gsrc), "s"(lds_dst) : "memory"); }
typedef float f32x2_t __attribute__((ext_vector_type(2))); typedef __bf16 bf16x2_t __attribute__((ext_vector_type(2)));
__device__ __forceinline__ unsigned cvtpk(float lo, float hi) { f32x2_t v = {lo, hi}; bf16x2_t b = __builtin_convertvector(v, bf16x2_t); return __builtin_bit_cast(unsigned, b); }
__device__ __forceinline__ s16x4 vtr(lds_cptr p) { return __builtin_bit_cast(s16x4, __builtin_amdgcn_ds_read_tr16_b64_v4i16((LAS v4i16_t*)p)); }
__device__ __forceinline__ int t5_bucket(int d) {
    if (d < 16) return d;
    int b = 16;
    b += (d >= 19); b += (d >= 21); b += (d >= 24); b += (d >= 27); b += (d >= 31); b += (d >= 35); b += (d >= 40); b += (d >= 46);
    b += (d >= 52); b += (d >= 59); b += (d >= 67); b += (d >= 77); b += (d >= 87); b += (d >= 99); b += (d >= 113);
    return b;
}
struct Ctx { LAS char* lds; int wid; int lane, r32, hi; };
__device__ __forceinline__ int fresh_lane() { int l; asm volatile("v_mbcnt_lo_u32_b32 %0, -1, 0\n\tv_mbcnt_hi_u32_b32 %0, -1, %0" : "=v"(l)); return l; }
__device__ __forceinline__ Ctx make_ctx(LAS unsigned char* lds, int tid) {
    Ctx c; c.lds = (LAS char*)lds; c.wid = __builtin_amdgcn_readfirstlane(tid >> 6); c.lane = tid & 63; c.r32 = c.lane & 31; c.hi = c.lane >> 5; return c;
}
template <bool HASV, class QK, class SM>
__device__ __forceinline__ void run_stream(const Ctx& c, const bf16* Kb, const bf16* Vb, int t0, int t1, QK&& qk, SM&& sm) {
    const int n = t1 - t0; if (n <= 0) return;
    const int lane = fresh_lane(), r32 = lane & 31, hi = lane >> 5; const unsigned lds0 = (unsigned)(uintptr_t)c.lds;
    const bf16* ks = Kb + (lane * 64 + c.wid * 8); const bf16* vs = Vb + ((16 * (c.wid & 3) + (lane >> 2)) * 64 + (c.wid >> 2) * 32 + (lane & 3) * 8);
    const unsigned kdst = lds0 + c.wid * 1024, vdst = lds0 + 8192 + c.wid * 1024;
    const lds_cptr kp0 = (lds_cptr)c.lds + hi * 1024 + r32 * 16;
    const lds_cptr vp0 = (lds_cptr)c.lds + 8192 + ((lane >> 4) & 1) * 32 + (lane & 3) * 8 + (4 * hi + ((lane & 15) >> 2)) * 64;
#define ATT_ISSUE(t, so) do { if (ATT_ABL & 4) break; glds16(ks + (size_t)(t) * 4096, (unsigned)__builtin_amdgcn_readfirstlane(kdst + (so))); if (HASV) glds16(vs + (size_t)(t) * 4096, (unsigned)__builtin_amdgcn_readfirstlane(vdst + (so))); } while (0)
    ATT_ISSUE(t0, 0); if (n > 1) ATT_ISSUE(t0 + 1, SLOT);
    const bool late = ATT_STAGGER && __builtin_amdgcn_readfirstlane(c.wid) >= 4;
    f32x16 s0 = {}, s1 = {};
    int slot = 0, slotp = 3 * SLOT, slot2 = 2 * SLOT;
    if (!late) {
        for (int i = 0; i < n; ++i) {
            if (i + 1 < n) { if (HASV) ATT_WAIT_BAR(2); else ATT_WAIT_BAR(1); } else ATT_WAIT_BAR(0);
            if (i + 2 < n) ATT_ISSUE(t0 + i + 2, slot2);
            if (!(ATT_ABL & 1)) qk(t0 + i, kp0 + slot, s0, s1); if (!(ATT_ABL & 2)) sm(t0 + i, vp0 + slot, s0, s1);
            slot = (slot == 3 * SLOT) ? 0 : slot + SLOT; slot2 = (slot2 == 3 * SLOT) ? 0 : slot2 + SLOT;
        }
    } else {
        for (int i = 0; i < n; ++i) {
            if (i + 1 < n) { if (HASV) ATT_WAIT_BAR(2); else ATT_WAIT_BAR(1); } else ATT_WAIT_BAR(0);
            if (i + 2 < n) ATT_ISSUE(t0 + i + 2, slot2);
            if (i > 0 && !(ATT_ABL & 2)) sm(t0 + i - 1, vp0 + slotp, s0, s1);
            if (!(ATT_ABL & 1)) qk(t0 + i, kp0 + slot, s0, s1);
            slotp = slot; slot = (slot == 3 * SLOT) ? 0 : slot + SLOT; slot2 = (slot2 == 3 * SLOT) ? 0 : slot2 + SLOT;
        }
        if (!(ATT_ABL & 2)) sm(t0 + n - 1, vp0 + slotp, s0, s1);
    }
    asm volatile("s_waitcnt lgkmcnt(0)\n\ts_barrier" ::: "memory");
#undef ATT_ISSUE
}
template <class FN1, class FN2>
__device__ __forceinline__ void run_stream_pairs(const Ctx& c, const bf16* Kb, const bf16* Vb, int t0, int t1, FN1&& fn1, FN2&& fn2) {
    const int n = t1 - t0; if (n <= 0) return;
    const int lane = fresh_lane(), r32 = lane & 31, hi = lane >> 5; const unsigned lds0 = (unsigned)(uintptr_t)c.lds;
    const bf16* ks = Kb + (lane * 64 + c.wid * 8); const bf16* vs = Vb + ((16 * (c.wid & 3) + (lane >> 2)) * 64 + (c.wid >> 2) * 32 + (lane & 3) * 8);
    const unsigned kdst = lds0 + c.wid * 1024, vdst = lds0 + 8192 + c.wid * 1024;
    const lds_cptr kp0 = (lds_cptr)c.lds + hi * 1024 + r32 * 16;
    const lds_cptr vp0 = (lds_cptr)c.lds + 8192 + ((lane >> 4) & 1) * 32 + (lane & 3) * 8 + (4 * hi + ((lane & 15) >> 2)) * 64;
#define ATT_ISSUE1(t, so) do { glds16(ks + (size_t)(t) * 4096, (unsigned)__builtin_amdgcn_readfirstlane(kdst + (so))); glds16(vs + (size_t)(t) * 4096, (unsigned)__builtin_amdgcn_readfirstlane(vdst + (so))); } while (0)
    ATT_ISSUE1(t0, 0); if (n > 1) ATT_ISSUE1(t0 + 1, SLOT);
    int base = 0;
    for (int i = 0; i < n; i += 2) {
        ATT_WAIT_BAR(0);
        const int nb = 2 * SLOT - base;
        if (i + 2 < n) ATT_ISSUE1(t0 + i + 2, nb); if (i + 3 < n) ATT_ISSUE1(t0 + i + 3, nb + SLOT);
        if (i + 1 < n) fn2(t0 + i, kp0 + base, vp0 + base, kp0 + base + SLOT, vp0 + base + SLOT); else fn1(t0 + i, kp0 + base, vp0 + base);
        base = nb;
    }
    asm volatile("s_waitcnt lgkmcnt(0)\n\ts_barrier" ::: "memory");
#undef ATT_ISSUE1
}
__device__ __forceinline__ void qk_tile(f32x16& s0, f32x16& s1, lds_cptr kp, const bf16x8 (&qr)[4]) {
    bf16x8 kf[8];
#pragma unroll
    for (int d0 = 0; d0 < 4; ++d0) { kf[2 * d0] = *(const LAS bf16x8*)(kp + d0 * 2048); kf[2 * d0 + 1] = *(const LAS bf16x8*)(kp + d0 * 2048 + 512); }
    const f32x16 z = {};
    s0 = MFMA32(kf[0], qr[0], z); s1 = MFMA32(kf[1], qr[0], z);
#pragma unroll
    for (int d0 = 1; d0 < 4; ++d0) { s0 = MFMA32(kf[2 * d0], qr[d0], s0); s1 = MFMA32(kf[2 * d0 + 1], qr[d0], s1); }
}
template <bool MASK>
__device__ __forceinline__ void pv_tile(f32x16 (&o)[2], lds_cptr vp, const f32x16& p0, const f32x16& p1, unsigned mask) {
    if (ATT_ABL & 8) { o[0][0] += p0[0] + p1[5]; return; }
    u32x4 pw0 = {cvtpk(p0[0], p0[1]), cvtpk(p0[2], p0[3]), cvtpk(p0[4], p0[5]), cvtpk(p0[6], p0[7])}, pw1 = {cvtpk(p0[8], p0[9]), cvtpk(p0[10], p0[11]), cvtpk(p0[12], p0[13]), cvtpk(p0[14], p0[15])};
    u32x4 pw2 = {cvtpk(p1[0], p1[1]), cvtpk(p1[2], p1[3]), cvtpk(p1[4], p1[5]), cvtpk(p1[6], p1[7])}, pw3 = {cvtpk(p1[8], p1[9]), cvtpk(p1[10], p1[11]), cvtpk(p1[12], p1[13]), cvtpk(p1[14], p1[15])};
    if (MASK) { pw0 &= mask; pw1 &= mask; pw2 &= mask; pw3 &= mask; }
    if (ATT_ABL & 64) { o[0] = MFMA32(__builtin_bit_cast(bf16x8, pw0), __builtin_bit_cast(bf16x8, pw1), o[0]); o[1] = MFMA32(__builtin_bit_cast(bf16x8, pw2), __builtin_bit_cast(bf16x8, pw3), o[1]); return; }
    s16x4 vlo[8], vhi[8];
#pragma unroll
    for (int i = 0; i < 8; ++i) { vlo[i] = vtr(vp + ((i >> 2) * 4096 + (i & 3) * 1024)); vhi[i] = vtr(vp + ((i >> 2) * 4096 + (i & 3) * 1024 + 512)); }
#define ATT_VFR(i) (bf16x8){vlo[i][0], vlo[i][1], vlo[i][2], vlo[i][3], vhi[i][0], vhi[i][1], vhi[i][2], vhi[i][3]}
    o[0] = MFMA32(__builtin_bit_cast(bf16x8, pw0), ATT_VFR(0), o[0]); o[1] = MFMA32(__builtin_bit_cast(bf16x8, pw0), ATT_VFR(4), o[1]);
    o[0] = MFMA32(__builtin_bit_cast(bf16x8, pw1), ATT_VFR(1), o[0]); o[1] = MFMA32(__builtin_bit_cast(bf16x8, pw1), ATT_VFR(5), o[1]);
    o[0] = MFMA32(__builtin_bit_cast(bf16x8, pw2), ATT_VFR(2), o[0]); o[1] = MFMA32(__builtin_bit_cast(bf16x8, pw2), ATT_VFR(6), o[1]);
    o[0] = MFMA32(__builtin_bit_cast(bf16x8, pw3), ATT_VFR(3), o[0]); o[1] = MFMA32(__builtin_bit_cast(bf16x8, pw3), ATT_VFR(7), o[1]);
#undef ATT_VFR
}
__device__ __forceinline__ float rowsum32(const f32x16& p0, const f32x16& p1) { if (ATT_ABL & 32) return p0[0]; float a = p0[0] + p1[0], b = p0[1] + p1[1];
#pragma unroll
    for (int r = 2; r < 16; r += 2) { a += p0[r]; asm volatile("" : "+v"(a)); b += p0[r + 1]; asm volatile("" : "+v"(b)); a += p1[r]; asm volatile("" : "+v"(a)); b += p1[r + 1]; asm volatile("" : "+v"(b)); }
    return a + b; }
__device__ __forceinline__ void hook_exp(f32x16& s0, f32x16& s1) {
    if (ATT_ABL & 16) return;
#pragma unroll
    for (int r = 0; r < 16; ++r) { s0[r] = __builtin_amdgcn_exp2f(s0[r]); s1[r] = __builtin_amdgcn_exp2f(s1[r]); } }
__device__ __forceinline__ void hook_general(f32x16& s0, f32x16& s1, int base, int win, const LAS float* lut, bool pred) {
    const int inval = 114;
    asm volatile("" : "+v"(base));
#pragma unroll
    for (int r = 0; r < 16; ++r) { const int d0 = base - ((r & 3) + 8 * (r >> 2)), d1 = d0 - 32;
        const int i0 = (pred && (unsigned)d0 < (unsigned)win) ? min(d0, 113) : inval, i1 = (pred && (unsigned)d1 < (unsigned)win) ? min(d1, 113) : inval;
        s0[r] = __builtin_amdgcn_exp2f(s0[r] + lut[i0]); s1[r] = __builtin_amdgcn_exp2f(s1[r] + lut[i1]); } }
__device__ __forceinline__ void hook_cmp(f32x16& s0, f32x16& s1, int nrel  , float cb) {
    asm volatile("" : "+v"(nrel));
#pragma unroll
    for (int r = 0; r < 16; ++r) { const int c0 = (r & 3) + 8 * (r >> 2);
        s0[r] = __builtin_amdgcn_exp2f(s0[r] + ((c0 <= nrel) ? cb : -INFINITY)); s1[r] = __builtin_amdgcn_exp2f(s1[r] + ((c0 + 32 <= nrel) ? cb : -INFINITY)); } }
__device__ __forceinline__ void row_factors(const Ctx& c, float f, float (&fr)[16]) {
    const int lane = fresh_lane(), r32 = lane & 31, hi = lane >> 5; LAS float* wsf = (LAS float*)(c.lds + LDS_WSF) + c.wid * 64;
    asm volatile("s_waitcnt lgkmcnt(0)" ::: "memory");
    if (hi == 0) wsf[r32] = f;
    asm volatile("s_waitcnt lgkmcnt(0)" ::: "memory");
#pragma unroll
    for (int r = 0; r < 16; ++r) fr[r] = wsf[(r & 3) + 8 * (r >> 2) + 4 * hi];
    asm volatile("s_waitcnt lgkmcnt(0)" ::: "memory");
}
__device__ __forceinline__ float pair_sum(float v) { auto rr = __builtin_amdgcn_permlane32_swap(__float_as_uint(v), __float_as_uint(v), false, false); return __uint_as_float(rr[0]) + __uint_as_float(rr[1]); }
template <class RowOff>
__device__ __forceinline__ void store_rows(const Ctx& c, const f32x16 (&o)[2], bf16* dst, RowOff&& rowoff) {
    LAS bf16* stg = (LAS bf16*)(c.lds + LDS_OST) + c.wid * 2048;
    const int lane = fresh_lane(), r32 = lane & 31, hi = lane >> 5;
#pragma unroll
    for (int r = 0; r < 16; ++r) { const int orow = (r & 3) + 8 * (r >> 2) + 4 * hi;
#pragma unroll
        for (int d0 = 0; d0 < 2; ++d0) stg[orow * 64 + d0 * 32 + r32] = (bf16)f2bf(o[d0][r]); }
    asm volatile("s_waitcnt lgkmcnt(0)" ::: "memory");
#pragma unroll
    for (int i = 0; i < 4; ++i) { const int row = i * 8 + (lane >> 3), ch = lane & 7; const u32x4 v = *(const LAS u32x4*)(stg + row * 64 + ch * 8); *(u32x4*)(dst + rowoff(row) + ch * 8) = v; }
    asm volatile("s_waitcnt lgkmcnt(0)" ::: "memory");
}
struct AttnPtrs { const bf16* qkv; const float* kmp; const float* gates; const bf16* kcmp; const bf16* vcmp; const float* rel_bias; bf16* mix; unsigned* selg; bf16* part_o; float* part_l; };

__device__ __forceinline__ unsigned moba_gate32(const AttnPtrs& P, int b, int h, int i, const bf16x8 (&qr)[4], int r32, int hi) {
    unsigned selmask = 0u;
    if (i > 0) {
        bf16x8 kmf[4];
        const float* kp = P.kmp + ((size_t)((b * 8 + h) * 32 + r32) * 2) * 64;
#pragma unroll
        for (int d0 = 0; d0 < 4; ++d0) { const f32x4 a0 = *(const f32x4*)(kp + d0 * 16 + hi * 8), a1 = *(const f32x4*)(kp + d0 * 16 + hi * 8 + 4), b0 = *(const f32x4*)(kp + 64 + d0 * 16 + hi * 8), b1 = *(const f32x4*)(kp + 64 + d0 * 16 + hi * 8 + 4);
            const f32x4 m0 = (a0 + b0) * (1.f / 256.f), m1 = (a1 + b1) * (1.f / 256.f);
            u32x4 w = {cvtpk(m0[0], m0[1]), cvtpk(m0[2], m0[3]), cvtpk(m1[0], m1[1]), cvtpk(m1[2], m1[3])}; kmf[d0] = __builtin_bit_cast(bf16x8, w); }
        f32x16 sg = {};
#pragma unroll
        for (int d0 = 0; d0 < 4; ++d0) sg = MFMA32(kmf[d0], qr[d0], sg);
        float v[16];
#pragma unroll
        for (int r = 0; r < 16; ++r) v[r] = ((r & 3) + 8 * (r >> 2) + 4 * hi < i) ? sg[r] : -INFINITY;
#pragma unroll
        for (int it = 0; it < 3; ++it) {
            float m = v[0]; int jb = 4 * hi;
#pragma unroll
            for (int r = 1; r < 16; ++r) { const int j = (r & 3) + 8 * (r >> 2) + 4 * hi; if (v[r] > m) { m = v[r]; jb = j; } }
            auto rm = __builtin_amdgcn_permlane32_swap(__float_as_uint(m), __float_as_uint(m), false, false);
            auto rj = __builtin_amdgcn_permlane32_swap((unsigned)jb, (unsigned)jb, false, false);
            const float mo = __uint_as_float(hi ? rm[0] : rm[1]); const int jo = (int)(hi ? rj[0] : rj[1]);
            const bool mine = (m > mo) || (m == mo && jb < jo);
            const float mw = mine ? m : mo; const int jw = mine ? jb : jo;
            if (mw > -INFINITY) { selmask |= 1u << jw;
#pragma unroll
                for (int r = 0; r < 16; ++r) if ((r & 3) + 8 * (r >> 2) + 4 * hi == jw) v[r] = -INFINITY; }
        }
    }
    return selmask;
}
__device__ __forceinline__ void moba_gate_phase(const AttnPtrs& P, int vcu, int G, int tid) {
    const int lane = tid & 63, r32 = lane & 31, hi = lane >> 5; const int wid = __builtin_amdgcn_readfirstlane(tid >> 6);
    for (int task = vcu * 8 + wid; task < 8192; task += G * 8) { const int w = task & 7, i = (task >> 3) & 31, bh = task >> 8; const int qpos = 256 * i + 32 * w + r32;
        const bf16* QA = P.qkv + ((size_t)bh * SEQ) * 64;
        bf16x8 qr[4];
#pragma unroll
        for (int d0 = 0; d0 < 4; ++d0) qr[d0] = *(const bf16x8*)(QA + (size_t)qpos * 64 + d0 * 16 + hi * 8);
        const unsigned m = moba_gate32(P, bh >> 3, bh & 7, i, qr, r32, hi);
        if (hi == 0) P.selg[(size_t)bh * SEQ + qpos] = m; }
}
__device__ __forceinline__ void moba_lut(const Ctx& c, const AttnPtrs& P, int h) {
    LAS float* lut = (LAS float*)(c.lds + LDS_LUT);
    if (threadIdx.x < 115) lut[threadIdx.x] = (threadIdx.x == 114) ? -INFINITY : (P.rel_bias[t5_bucket(threadIdx.x) * 16 + h] - P.rel_bias[31 * 16 + h]) * LOG2E;
}
__device__ __forceinline__ void moba_past_item(const Ctx& c, const AttnPtrs& P, int b, int h, int j) {
    const int bh = b * 8 + h, tid = threadIdx.x;
    const bf16* QA = P.qkv + ((size_t)bh * SEQ) * 64; const bf16* KA = QA + QKV_BIG + (size_t)256 * j * 64; const bf16* VA = QA + 2 * QKV_BIG + (size_t)256 * j * 64;
    moba_lut(c, P, h);
    const LAS float* lut = (const LAS float*)(c.lds + LDS_LUT);
    { const int lane = fresh_lane(); const unsigned lds0 = (unsigned)(uintptr_t)c.lds;
      const bf16* ks = KA + (lane * 64 + c.wid * 8); const bf16* vs = VA + ((16 * (c.wid & 3) + (lane >> 2)) * 64 + (c.wid >> 2) * 32 + (lane & 3) * 8);
#pragma unroll
      for (int tt = 0; tt < 4; ++tt) { glds16(ks + tt * 4096, (unsigned)__builtin_amdgcn_readfirstlane(lds0 + c.wid * 1024 + tt * SLOT)); glds16(vs + tt * 4096, (unsigned)__builtin_amdgcn_readfirstlane(lds0 + 8192 + c.wid * 1024 + tt * SLOT)); } }
    LAS unsigned short* list = (LAS unsigned short*)(c.lds + LDS_IMP);
    LAS unsigned* wcnt = (LAS unsigned*)(c.lds + LDS_MISC) + 8;
    const unsigned* sg = P.selg + (size_t)bh * SEQ;
    int total = 0;
    for (int base = (j + 1) * 256; base < SEQ; base += 512) {
        const int q = base + tid; const unsigned m = (q < SEQ) ? sg[q] : 0u; const bool sel = (m >> j) & 1u;
        const unsigned long long bal = __ballot(sel);
        if ((tid & 63) == 0) wcnt[c.wid] = (unsigned)__popcll(bal);
        asm volatile("s_waitcnt vmcnt(0) lgkmcnt(0)\n\ts_barrier" ::: "memory");
        int off = total, tot = 0;
#pragma unroll
        for (int w = 0; w < 8; ++w) { const int v = (int)wcnt[w]; off += (w < c.wid) ? v : 0; tot += v; }
        if (sel) list[off + __popcll(bal & ((1ull << (tid & 63)) - 1ull))] = (unsigned short)(q | (__popc(m & ((1u << j) - 1u)) << 13));
        total += tot;
        asm volatile("s_waitcnt lgkmcnt(0)\n\ts_barrier" ::: "memory");
    }
    total = __builtin_amdgcn_readfirstlane(total);
    { const int npad = (32 - (total & 31)) & 31; if (tid < npad) list[total + tid] = 0xFFFFu; }
    const int nchunks = (total + 31) >> 5;
    asm volatile("s_waitcnt vmcnt(0) lgkmcnt(0)\n\ts_barrier" ::: "memory");
    for (int ch = c.wid; ch < nchunks; ch += 8) {
        const int lane = fresh_lane(), r32 = lane & 31, hi = lane >> 5;
        const lds_cptr kp0 = (lds_cptr)c.lds + hi * 1024 + r32 * 16;
        const lds_cptr vp0 = (lds_cptr)c.lds + 8192 + ((lane >> 4) & 1) * 32 + (lane & 3) * 8 + (4 * hi + ((lane & 15) >> 2)) * 64;
        const unsigned e = list[32 * ch + r32]; const bool valid = e != 0xFFFFu; const int q = valid ? (int)(e & 0x1FFFu) : SEQ - 1;
        bf16x8 qr[4];
#pragma unroll
        for (int d0 = 0; d0 < 4; ++d0) qr[d0] = *(const bf16x8*)(QA + (size_t)q * 64 + d0 * 16 + hi * 8);
        asm volatile("" : "+v"(qr[0]), "+v"(qr[1]), "+v"(qr[2]), "+v"(qr[3]));
        const bool anynear = __any(valid && (q >> 8) == j + 1);
        f32x16 o[2]; o[0] = f32x16{}; o[1] = f32x16{}; float l_reg = 0.f;
#pragma unroll 1
        for (int tt = 0; tt < 4; ++tt) { f32x16 s0, s1; qk_tile(s0, s1, kp0 + tt * SLOT, qr);
            if (anynear) hook_general(s0, s1, q - (256 * j + 64 * tt) - 4 * hi, 1 << 30, lut, true); else hook_exp(s0, s1);
            l_reg += rowsum32(s0, s1);
            pv_tile<false>(o, vp0 + tt * SLOT, s0, s1, 0u); }
        const float L = pair_sum(l_reg);
        if (hi == 0 && valid) P.part_l[((size_t)bh * SEQ + q) * 3 + (e >> 13)] = L;
        LAS bf16* stg = (LAS bf16*)(c.lds + LDS_OST) + c.wid * 2048;
#pragma unroll
        for (int r = 0; r < 16; ++r) { const int orow = (r & 3) + 8 * (r >> 2) + 4 * hi;
#pragma unroll
            for (int d0 = 0; d0 < 2; ++d0) stg[orow * 64 + d0 * 32 + r32] = (bf16)f2bf(o[d0][r]); }
        asm volatile("s_waitcnt lgkmcnt(0)" ::: "memory");
#pragma unroll
        for (int it = 0; it < 4; ++it) { const int row = it * 8 + (lane >> 3), chn = lane & 7; const unsigned e2 = list[32 * ch + row];
            const u32x4 v = *(const LAS u32x4*)(stg + row * 64 + chn * 8);
            if (e2 != 0xFFFFu) *(u32x4*)(P.part_o + (((size_t)bh * SEQ + (e2 & 0x1FFFu)) * 3 + (e2 >> 13)) * 64 + chn * 8) = v; }
        asm volatile("s_waitcnt lgkmcnt(0)" ::: "memory");
    }
    asm volatile("s_waitcnt lgkmcnt(0)\n\ts_barrier" ::: "memory");
}
__device__ __forceinline__ void moba_own_item(const Ctx& c, const AttnPtrs& P, int b, int h, int i) {
    const int bh = b * 8 + h; const int q0 = 256 * i + 32 * c.wid, qpos = q0 + c.r32;
    const bf16* QA = P.qkv + ((size_t)bh * SEQ) * 64; const bf16* KA = QA + QKV_BIG; const bf16* VA = QA + 2 * QKV_BIG;
    bf16x8 qr[4];
#pragma unroll
    for (int d0 = 0; d0 < 4; ++d0) qr[d0] = *(const bf16x8*)(QA + (size_t)qpos * 64 + d0 * 16 + c.hi * 8);
    asm volatile("" : "+v"(qr[0]), "+v"(qr[1]), "+v"(qr[2]), "+v"(qr[3]));
    moba_lut(c, P, h);
    const LAS float* lut = (const LAS float*)(c.lds + LDS_LUT);
    asm volatile("s_waitcnt lgkmcnt(0)\n\ts_barrier" ::: "memory");
    f32x16 o[2]; o[0] = f32x16{}; o[1] = f32x16{}; float l_reg = 0.f;
    run_stream<true>(c, KA, VA, 4 * i, 4 * i + 4,
        [&](int t, lds_cptr kp, f32x16& s0, f32x16& s1) { if (q0 + 31 - 64 * t < 0) return; qk_tile(s0, s1, kp, qr); },
        [&](int t, lds_cptr vp, f32x16& s0, f32x16& s1) { const int key0 = 64 * t; if (q0 + 31 - key0 < 0) return;
            hook_general(s0, s1, qpos - key0 - 4 * c.hi, 1 << 30, lut, true); l_reg += rowsum32(s0, s1); pv_tile<false>(o, vp, s0, s1, 0u); });
    const float Lown = pair_sum(l_reg);
    const int lane = fresh_lane(), r32 = lane & 31, hi = lane >> 5;
    LAS float* stgf = (LAS float*)c.lds + c.wid * 2048;
    LAS float* wsf = (LAS float*)(c.lds + LDS_WSF) + c.wid * 64;
#pragma unroll
    for (int r = 0; r < 16; ++r) { const int orow = (r & 3) + 8 * (r >> 2) + 4 * hi;
#pragma unroll
        for (int d0 = 0; d0 < 2; ++d0) stgf[orow * 64 + d0 * 32 + r32] = o[d0][r]; }
    if (hi == 0) wsf[r32] = Lown;
    asm volatile("s_waitcnt lgkmcnt(0)" ::: "memory");
#pragma unroll
    for (int it = 0; it < 4; ++it) { const int row = it * 8 + (lane >> 3), chn = lane & 7; const int q = 256 * i + 32 * c.wid + row;
        const size_t qi = (size_t)bh * SEQ + q; const int ns = __popc(P.selg[qi]);
        float Lt = wsf[row]; f32x4 a0 = *(const LAS f32x4*)(stgf + row * 64 + chn * 8), a1 = *(const LAS f32x4*)(stgf + row * 64 + chn * 8 + 4);
#pragma unroll
        for (int sidx = 0; sidx < 3; ++sidx) if (sidx < ns) { Lt += P.part_l[qi * 3 + sidx]; const u32x4 pv = *(const u32x4*)(P.part_o + (qi * 3 + sidx) * 64 + chn * 8);
            a0 += (f32x4){__uint_as_float(pv.x << 16), __uint_as_float(pv.x & 0xffff0000u), __uint_as_float(pv.y << 16), __uint_as_float(pv.y & 0xffff0000u)};
            a1 += (f32x4){__uint_as_float(pv.z << 16), __uint_as_float(pv.z & 0xffff0000u), __uint_as_float(pv.w << 16), __uint_as_float(pv.w & 0xffff0000u)}; }
        const float inv = 1.f / Lt; a0 *= inv; a1 *= inv;
        const u32x4 w = {cvtpk(a0[0], a0[1]), cvtpk(a0[2], a0[3]), cvtpk(a1[0], a1[1]), cvtpk(a1[2], a1[3])};
        *(u32x4*)(P.mix + ((size_t)b * SEQ + q) * DM + h * 64 + chn * 8) = w; }
    asm volatile("s_waitcnt lgkmcnt(0)\n\ts_barrier" ::: "memory");
}

__device__ __forceinline__ void nsa_item(const Ctx& c, const AttnPtrs& P, int b, int g, int ci) {
    const int ql = 8 * c.wid + (c.r32 >> 2), rh = c.r32 & 3, qpos = 64 * ci + ql, hb = 4 * g + rh;
    const int qw0 = 64 * ci + 8 * c.wid;
    const bf16* QB = P.qkv + 3 * QKV_BIG + ((size_t)(b * 8 + hb) * SEQ) * 64;
    const bf16* KS = P.qkv + 4 * QKV_BIG + 2 * QKV_SMALL + ((size_t)(b * 2 + g) * SEQ) * 64; const bf16* VS = KS + QKV_SMALL; const bf16* KW = KS + 2 * QKV_SMALL; const bf16* VW = KS + 3 * QKV_SMALL;
    const bf16* KC = P.kcmp + (size_t)(b * 2 + g) * 512 * 64; const bf16* VC = P.vcmp + (size_t)(b * 2 + g) * 512 * 64;
    bf16x8 qr[4];
#pragma unroll
    for (int d0 = 0; d0 < 4; ++d0) qr[d0] = *(const bf16x8*)(QB + (size_t)qpos * 64 + d0 * 16 + c.hi * 8);
    const float* gp = P.gates + ((size_t)b * SEQ + qpos) * 24 + hb * 3; float g0 = gp[0], g1 = gp[1], g2 = gp[2];
    asm volatile("" : "+v"(qr[0]), "+v"(qr[1]), "+v"(qr[2]), "+v"(qr[3]), "+v"(g0), "+v"(g1), "+v"(g2));
    LAS float* lutall = (LAS float*)(c.lds + LDS_LUT);
    if (threadIdx.x < 460) { const int hh = threadIdx.x / 115, d = threadIdx.x % 115; lutall[hh * 128 + d] = (d == 114) ? -INFINITY : (P.rel_bias[t5_bucket(d) * 16 + 8 + 4 * g + hh] - P.rel_bias[31 * 16 + 8 + 4 * g + hh]) * LOG2E; }
    const LAS float* lut = lutall + rh * 128;
    LAS float* imp = (LAS float*)(c.lds + LDS_IMP);
    LAS unsigned* selm = (LAS unsigned*)(c.lds + LDS_SELM);
    f32x16 o[2]; float l_reg; float fr[16];
    LAS float* park = (LAS float*)(c.lds + LDS_OST) + c.wid * 1024 + c.lane;
    LAS float* park1 = (LAS float*)(c.lds + LDS_IMP) + c.wid * 1024 + c.lane;
    const int nct = (4 * ci + 3 + 63) >> 6;
    const int nlim = (qpos >= 31) ? ((qpos - 31) >> 4) : -1;
    l_reg = 0.f;
    run_stream<false>(c, KC, VC, 0, nct,
        [&](int t, lds_cptr kp, f32x16& s0, f32x16& s1) { qk_tile(s0, s1, kp, qr); },
        [&](int t, lds_cptr vp, f32x16& s0, f32x16& s1) { hook_cmp(s0, s1, nlim - 64 * t - 4 * c.hi, 0.f); l_reg += rowsum32(s0, s1); });
    const float Lc = pair_sum(l_reg); const float cbn = Lc > 0.f ? -__builtin_amdgcn_logf(Lc) : -INFINITY;
    o[0] = f32x16{}; o[1] = f32x16{};
    {
        float carry = 0.f;
        run_stream<true>(c, KC, VC, 0, nct,
          [&](int t, lds_cptr kp, f32x16& s0, f32x16& s1) { qk_tile(s0, s1, kp, qr); },
          [&](int t, lds_cptr vp, f32x16& s0, f32x16& s1) {
            hook_cmp(s0, s1, nlim - 64 * t - 4 * c.hi, cbn);
#pragma unroll
            for (int half = 0; half < 2; ++half) {
                float g4[4], e[4];
#pragma unroll
                for (int a = 0; a < 4; ++a) { const float x0 = half ? s1[4 * a] : s0[4 * a], x1 = half ? s1[4 * a + 1] : s0[4 * a + 1], x2 = half ? s1[4 * a + 2] : s0[4 * a + 2], x3 = half ? s1[4 * a + 3] : s0[4 * a + 3];
                    float gs = (x0 + x1) + (x2 + x3), es = x3;
                    gs += __shfl_xor(gs, 1); gs += __shfl_xor(gs, 2); es += __shfl_xor(es, 1); es += __shfl_xor(es, 2);
                    g4[a] = gs; e[a] = es; }
                float x[4];
#pragma unroll
                for (int a = 0; a < 4; ++a) { auto rr = __builtin_amdgcn_permlane32_swap(__float_as_uint(e[a]), __float_as_uint(e[a]), false, false); x[a] = __uint_as_float(c.hi ? rr[0] : rr[1]); }
                const int jb = 16 * t + 8 * half;
                float iv[4];
                if (c.hi) {
#pragma unroll
                    for (int a = 0; a < 4; ++a) iv[a] = g4[a] + x[a]; }
                else { iv[0] = g4[0] + carry; iv[1] = g4[1] + x[0]; iv[2] = g4[2] + x[1]; iv[3] = g4[3] + x[2]; carry = x[3]; }
                if (rh == 0) {
#pragma unroll
                    for (int a = 0; a < 4; ++a) imp[ql * 128 + jb + 2 * a + c.hi] = iv[a]; }
            }
            pv_tile<false>(o, vp, s0, s1, 0u);
        });
    }
    {
        asm volatile("s_waitcnt lgkmcnt(0)\n\ts_barrier" ::: "memory");
        const int qq = 8 * c.wid + (c.lane >> 3), cc = c.lane & 7;
        unsigned m0 = 0u, m1 = 0u, m2w = 0u, m3 = 0u;
        if (ci <= 15) { m0 = (ci == 31) ? 0xffffffffu : ((2u << ci) - 1u); }
        else {
            float v[16];
#pragma unroll
            for (int k = 0; k < 16; ++k) { const int j = cc + 8 * k; v[k] = (j >= 1 && j <= ci - 2) ? imp[qq * 128 + j] : -INFINITY; }
            for (int it = 0; it < 13; ++it) {
                float m = v[0]; int jb = cc;
#pragma unroll
                for (int k = 1; k < 16; ++k) if (v[k] > m) { m = v[k]; jb = cc + 8 * k; }
#pragma unroll
                for (int sft = 1; sft < 8; sft <<= 1) { const float mo = __shfl_xor(m, sft); const int jo = __shfl_xor(jb, sft); if (mo > m || (mo == m && jo < jb)) { m = mo; jb = jo; } }
                if (m > -INFINITY) { const unsigned bit = 1u << (jb & 31); const int wsel = jb >> 5;
                    m0 |= (wsel == 0) ? bit : 0u; m1 |= (wsel == 1) ? bit : 0u; m2w |= (wsel == 2) ? bit : 0u; m3 |= (wsel == 3) ? bit : 0u;
#pragma unroll
                    for (int k = 0; k < 16; ++k) if (cc + 8 * k == jb) v[k] = -INFINITY; }
            }
            m0 |= 1u;
#pragma unroll
            for (int z = 0; z < 2; ++z) { const int jf = ci - z; const unsigned bit = 1u << (jf & 31); const int wsel = jf >> 5;
                m0 |= (wsel == 0) ? bit : 0u; m1 |= (wsel == 1) ? bit : 0u; m2w |= (wsel == 2) ? bit : 0u; m3 |= (wsel == 3) ? bit : 0u; }
        }
        if (cc == 0) { selm[qq * 4 + 0] = m0; selm[qq * 4 + 1] = m1; selm[qq * 4 + 2] = m2w; selm[qq * 4 + 3] = m3; }
        asm volatile("s_waitcnt lgkmcnt(0)\n\ts_barrier" ::: "memory");
    }
    row_factors(c, g0, fr);
#pragma unroll
    for (int r = 0; r < 16; ++r) { park[r * 64] = o[0][r] * fr[r]; park1[r * 64] = o[1][r] * fr[r]; }
    {
        const unsigned w0 = selm[ql * 4 + 0], w1 = selm[ql * 4 + 1], w2 = selm[ql * 4 + 2], w3 = selm[ql * 4 + 3];
        o[0] = f32x16{}; o[1] = f32x16{}; l_reg = 0.f;
        auto sel_pred = [&](int t) -> bool { const unsigned wsel = (t < 32) ? w0 : (t < 64) ? w1 : (t < 96) ? w2 : w3; return (wsel >> (t & 31)) & 1u; };
        auto sel_one = [&](int t, lds_cptr kp, lds_cptr vp) { const bool pred = sel_pred(t); if (!__any(pred)) return; const int key0 = 64 * t;
            f32x16 s0, s1; qk_tile(s0, s1, kp, qr);
            if (qw0 - key0 - 63 >= 113) { hook_exp(s0, s1); const float rs = rowsum32(s0, s1); l_reg += pred ? rs : 0.f;
                if (__all(pred)) pv_tile<false>(o, vp, s0, s1, 0u); else pv_tile<true>(o, vp, s0, s1, pred ? 0xffffffffu : 0u); }
            else { hook_general(s0, s1, qpos - key0 - 4 * c.hi, 1 << 30, lut, pred); l_reg += rowsum32(s0, s1); pv_tile<false>(o, vp, s0, s1, 0u); } };
        run_stream_pairs(c, KS, VS, 0, ci + 1, sel_one,
            [&](int t, lds_cptr kpA, lds_cptr vpA, lds_cptr kpB, lds_cptr vpB) {
                if (qw0 - 64 * (t + 1) - 63 >= 113) {
                    const bool pa = sel_pred(t), pb = sel_pred(t + 1);
                    f32x16 a0, a1, b0, b1; qk_tile(a0, a1, kpA, qr); qk_tile(b0, b1, kpB, qr);
                    hook_exp(a0, a1); hook_exp(b0, b1);
                    const float ra = rowsum32(a0, a1), rb = rowsum32(b0, b1); l_reg += (pa ? ra : 0.f) + (pb ? rb : 0.f);
                    pv_tile<true>(o, vpA, a0, a1, pa ? 0xffffffffu : 0u); pv_tile<true>(o, vpB, b0, b1, pb ? 0xffffffffu : 0u);
                } else { sel_one(t, kpA, vpA); sel_one(t + 1, kpB, vpB); } });
        const float Ls = pair_sum(l_reg);
        row_factors(c, g1 / Ls, fr);
#pragma unroll
        for (int r = 0; r < 16; ++r) { park[r * 64] += o[0][r] * fr[r]; park1[r * 64] += o[1][r] * fr[r]; }
    }
    {
        o[0] = f32x16{}; o[1] = f32x16{}; l_reg = 0.f;
        run_stream<true>(c, KW, VW, ci >= 8 ? ci - 8 : 0, ci + 1,
            [&](int t, lds_cptr kp, f32x16& s0, f32x16& s1) { qk_tile(s0, s1, kp, qr); },
            [&](int t, lds_cptr vp, f32x16& s0, f32x16& s1) { const int key0 = 64 * t;
                if (qw0 - key0 - 63 >= 113 && qw0 + 7 - key0 < 512) hook_exp(s0, s1); else hook_general(s0, s1, qpos - key0 - 4 * c.hi, 512, lut, true);
                l_reg += rowsum32(s0, s1);
                pv_tile<false>(o, vp, s0, s1, 0u); });
        const float Lw = pair_sum(l_reg);
        row_factors(c, g2 / Lw, fr);
#pragma unroll
        for (int r = 0; r < 16; ++r) { o[0][r] = park[r * 64] + o[0][r] * fr[r]; o[1][r] = park1[r * 64] + o[1][r] * fr[r]; }
        asm volatile("s_waitcnt lgkmcnt(0)" ::: "memory");
    }
    bf16* dst = P.mix + ((size_t)b * SEQ + 64 * ci + 8 * c.wid) * DM + 512 + g * 256;
    store_rows(c, o, dst, [](int row) { return (size_t)(row >> 2) * DM + (row & 3) * 64; });
    asm volatile("s_waitcnt lgkmcnt(0)\n\ts_barrier" ::: "memory");
}

__device__ __forceinline__ void attn_phase(LAS unsigned char* lds, const AttnPtrs& P, unsigned* qcounter) {
    Ctx c = make_ctx(lds, threadIdx.x);
    LAS unsigned* misc = (LAS unsigned*)(c.lds + LDS_MISC);
    for (;;) {
        if (threadIdx.x == 0) misc[0] = __hip_atomic_fetch_add(qcounter, 1u, __ATOMIC_RELAXED, __HIP_MEMORY_SCOPE_AGENT);
        asm volatile("s_waitcnt vmcnt(0) lgkmcnt(0)\n\ts_barrier" ::: "memory");
        const unsigned k = misc[0];
        asm volatile("s_waitcnt lgkmcnt(0)\n\ts_barrier" ::: "memory");
        if (k >= 2016u) break;
        if (k < 512u) { const int s_ = 127 - (int)(k >> 3), bg = k & 7; nsa_item(c, P, bg >> 1, bg & 1, s_); }
        else if (k < 1504u) { const int kk = (int)k - 512, j = kk >> 5, bh = kk & 31; moba_past_item(c, P, bh >> 3, bh & 7, j); }
        else { const int kk = (int)k - 1504; const int s_ = 63 - (kk >> 3), bg = kk & 7; nsa_item(c, P, bg >> 1, bg & 1, s_); }
    }
}
__device__ __forceinline__ void moba_merge_phase(LAS unsigned char* lds, const AttnPtrs& P, int vcu, int G) {
    Ctx c = make_ctx(lds, threadIdx.x);
    for (int k = vcu; k < 1024; k += G) moba_own_item(c, P, k >> 8, (k >> 5) & 7, k & 31);
}
#undef MFMA32
#undef ATT_WAIT_BAR
}
namespace cmpr {
using bf16x8 = __attribute__((ext_vector_type(8))) short;
using f32x16 = __attribute__((ext_vector_type(16))) float;
constexpr int HID_PITCH = 528;
__device__ __forceinline__ float gelu_tanh(float v) { const float u = fminf(fmaxf(0.7978845608028654f * (v + 0.044715f * v * v * v), -15.f), 15.f); const float e = __expf(2.f * u); return 0.5f * v * (1.f + (e - 1.f) / (e + 1.f)); }
__device__ __forceinline__ void compress_unit(LAS unsigned char* lds, int unit, const bf16* qkv, const bf16* w1k, const bf16* w1v, const bf16* w2k, const bf16* w2v, const float* cbp, const float* kncmp, bf16* kcmp, bf16* vcmp) {
    const int tid = threadIdx.x, lane = tid & 63, r32 = lane & 31, hi = lane >> 5; const int wid = __builtin_amdgcn_readfirstlane(tid >> 6);
    const int kv = unit & 1, u = (unit >> 1) & 15, bg = unit >> 5;
    const bf16* src = qkv + 4 * QKV_BIG + (kv ? QKV_SMALL : 0) + (size_t)bg * SEQ * 64;
    const bf16* w1 = kv ? w1v : w1k; const bf16* w2 = kv ? w2v : w2k;
    const int n0 = 32 * u;
    { const bf16* sp = src + (size_t)16 * n0 * 64;
      for (int ch = tid; ch < 4224; ch += NTHREADS) { v4u v = {0u, 0u, 0u, 0u}; if (16 * n0 + (ch >> 3) < SEQ) v = *(const GAS v4u*)(sp + (size_t)ch * 8);
          *(LAS v4u*)(lds + ((ch ^ ((ch >> 7) & 15)) << 4)) = v; } }
    asm volatile("s_waitcnt vmcnt(0) lgkmcnt(0)\n\ts_barrier" ::: "memory");
    const bf16* bp = w1 + ((size_t)wid * 64 + lane) * 8;
    f32x16 acc = {};
#pragma unroll 8
    for (int kk = 0; kk < 128; ++kk) { const int lc = r32 * 128 + 2 * kk + hi; const bf16x8 a = *(const LAS bf16x8*)(lds + ((lc ^ ((lc >> 7) & 15)) << 4)), bfr = *(const bf16x8*)(bp + (size_t)kk * 4096); acc = __builtin_amdgcn_mfma_f32_32x32x16_bf16(a, bfr, acc, 0, 0, 0); }
    float cb = 0.f;
#pragma unroll 8
    for (int ic = 0; ic < 32; ++ic) cb += cbp[(ic * 2 + kv) * 256 + 32 * wid + r32];
    LAS unsigned char* hidL = lds + 69632;
#pragma unroll
    for (int r = 0; r < 16; ++r) { const int n = (r & 3) + 8 * (r >> 2) + 4 * hi; *(LAS bf16*)(hidL + n * HID_PITCH + (32 * wid + r32) * 2) = (bf16)f2bf(gelu_tanh(acc[r] + cb)); }
    asm volatile("s_waitcnt lgkmcnt(0)\n\ts_barrier" ::: "memory");
    if (wid == 0) {
        f32x16 o0 = {}, o1 = {};
#pragma unroll 4
        for (int kk = 0; kk < 16; ++kk) { const bf16x8 hb = *(const LAS bf16x8*)(hidL + r32 * HID_PITCH + (16 * kk + 8 * hi) * 2);
            const bf16x8 a0 = *(const bf16x8*)(w2 + (size_t)r32 * 256 + 16 * kk + 8 * hi), a1 = *(const bf16x8*)(w2 + (size_t)(32 + r32) * 256 + 16 * kk + 8 * hi);
            o0 = __builtin_amdgcn_mfma_f32_32x32x16_bf16(a0, hb, o0, 0, 0, 0); o1 = __builtin_amdgcn_mfma_f32_32x32x16_bf16(a1, hb, o1, 0, 0, 0); }
        float rs = 1.f;
        if (!kv) { float ss = 0.f;
#pragma unroll
            for (int r = 0; r < 16; ++r) ss += o0[r] * o0[r] + o1[r] * o1[r];
            auto rr = __builtin_amdgcn_permlane32_swap(__float_as_uint(ss), __float_as_uint(ss), false, false); ss = __uint_as_float(rr[0]) + __uint_as_float(rr[1]);
            rs = rsqrtf(ss * (1.f / 64.f) + 1e-6f); }
        const int n = n0 + r32; bf16* dst = (kv ? vcmp : kcmp) + ((size_t)bg * 512 + n) * 64;
#pragma unroll
        for (int r = 0; r < 16; ++r) { const int d = (r & 3) + 8 * (r >> 2) + 4 * hi;
            float v0 = o0[r] * rs, v1 = o1[r] * rs; if (!kv) { v0 *= kncmp[d]; v1 *= kncmp[d + 32]; }
            if (n >= NCMP) { v0 = 0.f; v1 = 0.f; }
            dst[d] = (bf16)f2bf(v0); dst[d + 32] = (bf16)f2bf(v1); }
    }
    asm volatile("s_waitcnt lgkmcnt(0)\n\ts_barrier" ::: "memory");
}
}
__global__ void __launch_bounds__(NTHREADS, 2) mk_fwd(Args a) {
    extern __shared__ __attribute__((aligned(16))) unsigned char lds[];
    Frame F;
    F.lds = (LAS unsigned char*)lds;
    F.tid = threadIdx.x; F.lane = F.tid & 63; F.wave = __builtin_amdgcn_readfirstlane(F.tid >> 6);
    F.G = gridDim.x; { const int bx = blockIdx.x; F.vcu = (F.G % 8 == 0) ? (bx % 8) * (F.G / 8) + bx / 8 : bx; }
    cg::grid_group grid = cg::this_grid();
    volatile LAS unsigned* xst = (volatile LAS unsigned*)(F.lds + 147424);
    if (F.tid < 8) xst[F.tid] = 0u;
    __syncthreads();
    const XcdBarrier xbar = xcd_barrier_post((unsigned*)(a.ws + WS_CTL) + 4096, xst);
    unsigned char* ws = a.ws;
    const int lo = a.ph_lo, hi = a.ph_hi;
    const att::AttnPtrs P{(const bf16*)(ws + WS_QKV), (const float*)(ws + WS_KMP), (const float*)(ws + WS_GATES), (const bf16*)(ws + WS_KCMP), (const bf16*)(ws + WS_VCMP), a.in[2], (bf16*)(ws + WS_MIX),
                          (unsigned*)(ws + WS_SELG), (bf16*)(ws + WS_PARTO), (float*)(ws + WS_PARTL)};
#define IN(k) (lo <= (k) && (k) < hi)
#define SEAM(k) do { if (IN(k) && IN((k) + 1)) { if ((k) == 0) grid.sync(); else xcd_barrier(xbar); } } while (0)
    if (IN(0)) { phase_prologue_a(F, a); } SEAM(0);
    if (IN(1)) { phase_prologue_b(F, a); } SEAM(1);
    if (IN(2)) {
        pg8::Gemm g{(const pg8::bf16_t*)(ws + WS_H), (const pg8::bf16_t*)(ws + WS_WIN), TOK, NIN_PAD, DM}; pg8::StaticOrder S; S.init(TOK, NIN_PAD, F.G, (int)blockIdx.x);
        pg8::EpiInProj E{(pg8::bf16_t*)(ws + WS_QKV), (float*)(ws + WS_GATES), (float*)(ws + WS_KMP), a.in[7], a.in[8], a.in[9], a.in[11], a.in[12]};
        pg8::gemm_phase<pg8::EpiInProj, pg8::StaticOrder, true, true>(F.lds, g, S, E);
    } SEAM(2);
    if (IN(3)) {
        att::moba_gate_phase(P, F.vcu, F.G, F.tid);
        for (int unit = F.vcu; unit < 256; unit += F.G)
            cmpr::compress_unit(F.lds, unit, (const bf16*)(ws + WS_QKV), (const bf16*)(ws + WS_W1K), (const bf16*)(ws + WS_W1V), (const bf16*)(ws + WS_W2K), (const bf16*)(ws + WS_W2V),
                                (const float*)(ws + WS_CBP), a.in[10], (bf16*)(ws + WS_KCMP), (bf16*)(ws + WS_VCMP));
    } SEAM(3);
    if (IN(4)) {
                att::attn_phase(F.lds, P, (unsigned*)(ws + WS_CTL) + 64);
    } SEAM(4);
    if (IN(5)) { att::moba_merge_phase(F.lds, P, F.vcu, F.G); } SEAM(5);
    if (IN(6)) {
        pg8::Gemm g{(const pg8::bf16_t*)(ws + WS_MIX), (const pg8::bf16_t*)(ws + WS_WOUT), TOK, DM, DM}; pg8::StaticOrder S; S.init(TOK, DM, F.G, (int)blockIdx.x);
        pg8::EpiOutProj E{a.in[0], a.out, (const float*)(ws + WS_MOD) + 2 * DM};
        pg8::gemm_phase<pg8::EpiOutProj, pg8::StaticOrder, true, true>(F.lds, g, S, E);
    } SEAM(6);
    if (IN(7)) { phase_norm2(F, a); } SEAM(7);
    if (IN(8)) {
        pg8::Gemm g{(const pg8::bf16_t*)(ws + WS_H), (const pg8::bf16_t*)(ws + WS_WGU), TOK, 2 * FF, DM}; pg8::StaticOrder S; S.init(TOK, 2 * FF, F.G, (int)blockIdx.x);
        pg8::EpiGateUp E{(pg8::bf16_t*)(ws + WS_ACT)};
        pg8::gemm_phase<pg8::EpiGateUp, pg8::StaticOrder, true, true>(F.lds, g, S, E);
    } SEAM(8);
    if (IN(9)) {
        pg8::Gemm g{(const pg8::bf16_t*)(ws + WS_ACT), (const pg8::bf16_t*)(ws + WS_WDN), TOK, DM, FF}; pg8::StaticOrder S; S.init(TOK, DM, F.G, (int)blockIdx.x);
        pg8::EpiDown E{a.out, (const float*)(ws + WS_MOD) + 5 * DM};
        pg8::gemm_phase<pg8::EpiDown, pg8::StaticOrder, true, true>(F.lds, g, S, E);
    }
#undef IN
#undef SEAM
}

static void launch_phases(const Args& base, int lo, int hi, int grid, hipStream_t stream) {
    Args a = base; a.ph_lo = lo; a.ph_hi = hi;
    if (hi - lo > 1) { void* args[] = {&a}; (void)hipLaunchCooperativeKernel((const void*)mk_fwd, dim3(grid), dim3(NTHREADS), args, LDS_BYTES, stream); }
    else hipLaunchKernelGGL(mk_fwd, dim3(grid), dim3(NTHREADS), LDS_BYTES, stream, a);
}
extern "C" void kernel_launch(void* const* d_in, const int* in_sizes, int n_in, void* d_out, int out_size, void* d_ws, size_t ws_size, hipStream_t stream) {
    static int grid = 0;
    if (grid == 0) {
        int dev = 0, cus = 0, per_cu = 0;
        if (n_in != 23 || ws_size < 452 * MiB || hipGetDevice(&dev) != hipSuccess || hipDeviceGetAttribute(&cus, hipDeviceAttributeMultiprocessorCount, dev) != hipSuccess) { grid = -1; return; }
        if (hipFuncSetAttribute((const void*)mk_fwd, hipFuncAttributeMaxDynamicSharedMemorySize, LDS_BYTES) != hipSuccess) { grid = -1; return; }
        if (hipOccupancyMaxActiveBlocksPerMultiprocessor(&per_cu, (const void*)mk_fwd, NTHREADS, LDS_BYTES) != hipSuccess || per_cu < 1) { grid = -1; return; }
        grid = cus;
    }
    if (grid < 0) return;
    (void)hipMemsetAsync((char*)d_ws + WS_CTL, 0, CTL_ZERO_BYTES, stream);
    Args a{};
    for (int i = 0; i < 23; ++i) a.in[i] = (const float*)d_in[i];
    a.out = (float*)d_out; a.ws = (unsigned char*)d_ws;
    unsigned char* ws = (unsigned char*)d_ws;
#if HYBRID == 1
    launch_phases(a, 0, 1, grid, stream); launch_phases(a, 1, 2, grid, stream); launch_phases(a, 2, 3, grid, stream);
    const bf16* qkv = (const bf16*)(ws + WS_QKV); bf16* mix = (bf16*)(ws + WS_MIX); bf16* kcmp = (bf16*)(ws + WS_KCMP); bf16* vcmp = (bf16*)(ws + WS_VCMP);
    int* sel = (int*)(ws + 344 * MiB); float* obuf = (float*)(ws + 348 * MiB); const float* gates = (const float*)(ws + WS_GATES);
    nq::k_compress<<<dim3(4 * 2 * 512, 2), 256, 0, stream>>>(qkv, a.in[13], a.in[14], a.in[15], a.in[16], a.in[17], a.in[18], a.in[10], kcmp, vcmp);
    nq::k_moba<<<4 * 8 * SEQ / 4, 256, 0, stream>>>(qkv, (const float*)(ws + WS_KMP), a.in[2], mix);
    nq::k_nsa_cmp<<<4 * 2 * SEQ, 256, 0, stream>>>(qkv, kcmp, vcmp, gates, obuf, sel);
    nq::k_nsa_sel<<<4 * 2 * SEQ, 256, 0, stream>>>(qkv, sel, a.in[2], gates, obuf);
    nq::k_nsa_win<<<4 * 2 * SEQ, 256, 0, stream>>>(qkv, a.in[2], gates, obuf, mix);
    launch_phases(a, 5, 6, grid, stream); launch_phases(a, 6, 7, grid, stream); launch_phases(a, 7, 8, grid, stream); launch_phases(a, 8, 9, grid, stream);
#elif HYBRID == 2
    launch_phases(a, 0, 1, grid, stream); launch_phases(a, 1, 2, grid, stream); launch_phases(a, 2, 3, grid, stream);
    nq::k_compress<<<dim3(4 * 2 * 512, 2), 256, 0, stream>>>((const bf16*)(ws + WS_QKV), a.in[13], a.in[14], a.in[15], a.in[16], a.in[17], a.in[18], a.in[10], (bf16*)(ws + WS_KCMP), (bf16*)(ws + WS_VCMP));
    launch_phases(a, 4, 5, grid, stream);
    launch_phases(a, 5, 6, grid, stream); launch_phases(a, 6, 7, grid, stream); launch_phases(a, 7, 8, grid, stream); launch_phases(a, 8, 9, grid, stream);
#elif HYBRID == 3
    for (int p = 0; p < N_PHASES; ++p) { launch_phases(a, p, p + 1, grid, stream);
#if defined(ABL_REPS)
        if (p == 3) { static bool once = false; if (!once) { once = true; (void)hipFuncSetAttribute((const void*)k_attn_abl, hipFuncAttributeMaxDynamicSharedMemorySize, LDS_BYTES); }
            for (int r = 0; r < ABL_REPS; ++r) { (void)hipMemsetAsync((char*)d_ws + WS_CTL + 512, 0, 4, stream); hipLaunchKernelGGL(k_attn_abl, dim3(grid), dim3(NTHREADS), LDS_BYTES, stream, a); } }
#endif
#if defined(TIME_PHASE)
        if (p == TIME_PHASE) { for (int r = 0; r < TIME_REPS; ++r) { (void)hipMemsetAsync((char*)d_ws + WS_CTL, 0, CTL_ZERO_BYTES, stream); launch_phases(a, p, p + 1, grid, stream); } }
#endif
    }
#else
    launch_phases(a, 0, N_PHASES, grid, stream);
#endif
}
```

```cpp
#include <hip/hip_runtime.h>
#include <hip/hip_cooperative_groups.h>
#include <cstdint>
#include <cstdio>
namespace cg = cooperative_groups;
#define HYBRID 0
namespace pg8 {
#define PG8_LAS __attribute__((address_space(3)))
typedef unsigned short bf16_t;
typedef short bf16x8 __attribute__((ext_vector_type(8)));
typedef float f32x4 __attribute__((ext_vector_type(4)));
typedef unsigned u32x4 __attribute__((ext_vector_type(4)));
constexpr int BM = 256, BK = 64, HALF = 128, HTB = HALF * BK * 2  , STAGE_BYTES = 8 * HTB, NXCD = 8, WGM = 8;

__host__ __device__ __forceinline__ int lds_byte(int r, int c) { const int st = (r >> 4) * 2 + (c >> 5), rr = r & 15, cc = c & 31, ob = rr * 64 + cc * 2; return st * 1024 + (ob ^ (((ob >> 9) & 1) << 5)); }
__host__ __device__ __forceinline__ void stage_rc(int b, int& R, int& C) { const int st = b / 1024, sb = b % 1024, swz = sb ^ (((sb >> 9) & 1) << 5); R = (st >> 1) * 16 + swz / 64; C = (st & 1) * 32 + (swz % 64) / 2; }
__host__ __device__ __forceinline__ int perm32(int rho) { const int n = rho >> 4, i = rho & 15; return 8 * (i >> 2) + 4 * n + (i & 3); }

struct Unit { int pm, pn; };
struct Gemm { const bf16_t* A; const bf16_t* Bt; int M, N, K; };

struct StaticOrder {
    int nM, nN, nwg, G, c;
    __host__ __device__ void init(int M, int N, int G_, int c_) { nM = M / BM; nN = N / BM; nwg = nM * nN; G = G_; c = c_; }
    __host__ __device__ bool next(int i, Unit& u) const {
        const long L = (long)i * G + c; if (L >= nwg) return false;
        int wgid = (int)L; { const int q = nwg / NXCD, r = nwg % NXCD, xcd = wgid % NXCD, off = wgid / NXCD; wgid = (xcd < r ? xcd * (q + 1) : r * (q + 1) + (xcd - r) * q) + off; }
        const int nig = WGM * nN, gid = wgid / nig, fm = gid * WGM, gsz = (nM - fm) < WGM ? (nM - fm) : WGM;
        u.pm = fm + ((wgid % nig) % gsz); u.pn = (wgid % nig) / gsz; return true;
    }
    __device__ __forceinline__ void a_ready(const Unit&) const {}
    __device__ __forceinline__ void done(const Unit&) const {}
};

__device__ __forceinline__ unsigned cvt_pk_bf16(float lo, float hi) { unsigned r; asm volatile("v_cvt_pk_bf16_f32 %0, %1, %2" : "=v"(r) : "v"(lo), "v"(hi)); return r; }
typedef float f32x2 __attribute__((ext_vector_type(2)));
template <class Epi, class Sched, bool ALIGN_EPI = false, bool SP2 = false>
__device__ __forceinline__ void gemm_phase(PG8_LAS unsigned char* lds, const Gemm g, const Sched& S, const Epi& E) {
    const int tid = threadIdx.x, wid = __builtin_amdgcn_readfirstlane(tid >> 6), lane = tid & 63, wr = wid >> 2, wc = wid & 3, fr = lane & 15, fq = lane >> 4;
    const int K = g.K, nt = K / BK;
    unsigned voffA[2], voffB[2];
#pragma unroll
    for (int i = 0; i < 2; ++i) { int R, C; stage_rc(tid * 16 + i * 8192, R, C); const int Rb = Epi::PERM ? ((R & ~31) + perm32(R & 31)) : R;
        voffA[i] = (unsigned)(R * K + C) * 2u; voffB[i] = (unsigned)(Rb * K + C) * 2u; }
    const size_t kstep = (size_t)(BK * 2);
    const size_t hstep = (size_t)HALF * K * 2;
    const size_t tstep = 2 * hstep;
    const unsigned ldsw = (unsigned)wid * 1024u;
    const int aoff = lds_byte(wr * 64 + fr, fq * 8), boff = lds_byte(wc * 32 + fr, fq * 8);
#define PG8_SA(b, h) (((b) * 2 + (h)) * HTB)
#define PG8_SB(b, h) ((4 + (b) * 2 + (h)) * HTB)
#define PG8_STAGE(bufoff, gbase, voff) do { _Pragma("unroll") for (int _i = 0; _i < 2; ++_i) \
        __builtin_amdgcn_global_load_lds((const unsigned*)((const char*)(gbase) + (voff)[_i]), (PG8_LAS unsigned*)(lds + (bufoff) + ldsw + _i * 8192), 16, 0, 0); } while (0)
#define PG8_LDA(dst, b, h) do { _Pragma("unroll") for (int m = 0; m < 4; ++m) _Pragma("unroll") for (int k = 0; k < 2; ++k) dst[m][k] = *(const PG8_LAS bf16x8*)(lds + PG8_SA(b, h) + aoff + m * 2048 + k * 1024); } while (0)
#define PG8_LDB(dst, b, h) do { _Pragma("unroll") for (int n = 0; n < 2; ++n) _Pragma("unroll") for (int k = 0; k < 2; ++k) dst[n][k] = *(const PG8_LAS bf16x8*)(lds + PG8_SB(b, h) + boff + n * 2048 + k * 1024); } while (0)
#define PG8_MMA(ai, bj, At, Bt) do { __builtin_amdgcn_s_setprio(1); _Pragma("unroll") for (int m = 0; m < 4; ++m) _Pragma("unroll") for (int n = 0; n < 2; ++n) _Pragma("unroll") for (int k = 0; k < 2; ++k) \
        acc[ai][bj][m][n] = __builtin_amdgcn_mfma_f32_16x16x32_bf16(Bt[n][k], At[m][k], acc[ai][bj][m][n], 0, 0, 0); __builtin_amdgcn_s_setprio(0); } while (0)
#define PG8_WAIT_V(n) asm volatile("s_waitcnt vmcnt(" #n ")" ::: "memory")
#define PG8_WAIT_L(n) asm volatile("s_waitcnt lgkmcnt(" #n ")" ::: "memory")
#define PG8_BAR __builtin_amdgcn_s_barrier()
#define PG8_SCHED __builtin_amdgcn_sched_barrier(0)
    Unit cur, nxt; int ui = 0;
    if (!S.next(0, cur)) return;
    f32x4 acc[2][2][4][2];
#pragma unroll
    for (int a = 0; a < 2; ++a)
#pragma unroll
        for (int b = 0; b < 2; ++b)
#pragma unroll
            for (int m = 0; m < 4; ++m)
#pragma unroll
                for (int n = 0; n < 2; ++n) acc[a][b][m][n] = (f32x4){0.f, 0.f, 0.f, 0.f};
    bf16x8 At[4][2], B0[2][2], B1[2][2];
    const char* cA = (const char*)g.A + (size_t)cur.pm * tstep; const char* cB = (const char*)g.Bt + (size_t)cur.pn * tstep;
    S.a_ready(cur);
    if constexpr (SP2) {
        PG8_STAGE(PG8_SB(0, 0), cB, voffB); PG8_STAGE(PG8_SB(0, 1), cB + hstep, voffB); PG8_STAGE(PG8_SA(0, 0), cA, voffA); PG8_STAGE(PG8_SA(0, 1), cA + hstep, voffA);
        if (wr == 1) PG8_BAR;
        PG8_WAIT_V(2); PG8_BAR;
        PG8_STAGE(PG8_SB(1, 0), cB + kstep, voffB); PG8_STAGE(PG8_SA(1, 0), cA + kstep, voffA); PG8_STAGE(PG8_SB(1, 1), cB + hstep + kstep, voffB);
        PG8_WAIT_V(6); PG8_BAR;
    } else {
        PG8_STAGE(PG8_SB(0, 0), cB, voffB); PG8_STAGE(PG8_SA(0, 0), cA, voffA); PG8_STAGE(PG8_SB(0, 1), cB + hstep, voffB); PG8_STAGE(PG8_SA(0, 1), cA + hstep, voffA);
        if (wr == 1) PG8_BAR;
        PG8_WAIT_V(4); PG8_BAR;
        PG8_STAGE(PG8_SB(1, 0), cB + kstep, voffB); PG8_STAGE(PG8_SA(1, 0), cA + kstep, voffA); PG8_STAGE(PG8_SB(1, 1), cB + hstep + kstep, voffB);
        PG8_WAIT_V(6); PG8_BAR;
    }
    for (;;) {
        const bool has_next = S.next(ui + 1, nxt);
        const char* nA = has_next ? (const char*)g.A + (size_t)nxt.pm * tstep : cA; const char* nB = has_next ? (const char*)g.Bt + (size_t)nxt.pn * tstep : cB;
        for (int t = 0; t < nt; t += 2) {
            const bool last = (t == nt - 2);
            const char* a1 = cA + (size_t)(t + 1) * kstep;
            const char* a2 = last ? nA : cA + (size_t)(t + 2) * kstep; const char* b2 = last ? nB : cB + (size_t)(t + 2) * kstep;
            const char* a3 = a2 + kstep; const char* b3 = b2 + kstep;
            if (last && has_next) S.a_ready(nxt);
            if constexpr (SP2) {
            PG8_LDB(B0, 0, 0); PG8_LDB(B1, 0, 1); PG8_SCHED; PG8_LDA(At, 0, 0); PG8_STAGE(PG8_SA(1, 1), a1 + hstep, voffA);
            PG8_WAIT_V(8); PG8_WAIT_L(0); PG8_BAR; PG8_MMA(0, 0, At, B0); PG8_MMA(0, 1, At, B1); PG8_BAR; PG8_SCHED;
            PG8_LDA(At, 0, 1); PG8_STAGE(PG8_SB(0, 0), b2, voffB); PG8_STAGE(PG8_SB(0, 1), b2 + hstep, voffB); PG8_STAGE(PG8_SA(0, 0), a2, voffA);
            PG8_WAIT_V(8); PG8_WAIT_L(0); PG8_BAR; PG8_MMA(1, 0, At, B0); PG8_MMA(1, 1, At, B1); PG8_BAR; PG8_SCHED;
            PG8_LDB(B0, 1, 0); PG8_LDB(B1, 1, 1); PG8_SCHED; PG8_LDA(At, 1, 0); PG8_STAGE(PG8_SA(0, 1), a2 + hstep, voffA);
            PG8_WAIT_V(8); PG8_WAIT_L(0); PG8_BAR; PG8_MMA(0, 0, At, B0); PG8_MMA(0, 1, At, B1); PG8_BAR; PG8_SCHED;
            PG8_LDA(At, 1, 1); PG8_STAGE(PG8_SB(1, 0), b3, voffB); PG8_STAGE(PG8_SB(1, 1), b3 + hstep, voffB); PG8_STAGE(PG8_SA(1, 0), a3, voffA);
            PG8_WAIT_V(8); PG8_WAIT_L(0); PG8_BAR; PG8_MMA(1, 0, At, B0); PG8_MMA(1, 1, At, B1); PG8_BAR; PG8_SCHED;
            } else {
            PG8_LDB(B0, 0, 0); PG8_SCHED; PG8_LDA(At, 0, 0); PG8_STAGE(PG8_SA(1, 1), a1 + hstep, voffA);
            PG8_WAIT_L(8); PG8_BAR; PG8_WAIT_L(0); PG8_MMA(0, 0, At, B0); PG8_BAR; PG8_SCHED;
            PG8_LDB(B1, 0, 1); PG8_STAGE(PG8_SB(0, 0), b2, voffB);
            PG8_BAR; PG8_WAIT_L(0); PG8_MMA(0, 1, At, B1); PG8_BAR;
            PG8_LDA(At, 0, 1); PG8_STAGE(PG8_SA(0, 0), a2, voffA);
            PG8_BAR; PG8_WAIT_L(0); PG8_MMA(1, 0, At, B0); PG8_BAR; PG8_SCHED;
            PG8_STAGE(PG8_SB(0, 1), b2 + hstep, voffB);
            PG8_WAIT_V(6); PG8_BAR; PG8_MMA(1, 1, At, B1); PG8_BAR;
            PG8_LDB(B0, 1, 0); PG8_SCHED; PG8_LDA(At, 1, 0); PG8_STAGE(PG8_SA(0, 1), a2 + hstep, voffA);
            PG8_WAIT_L(8); PG8_BAR; PG8_WAIT_L(0); PG8_MMA(0, 0, At, B0); PG8_BAR; PG8_SCHED;
            PG8_LDB(B1, 1, 1); PG8_STAGE(PG8_SB(1, 0), b3, voffB);
            PG8_BAR; PG8_WAIT_L(0); PG8_MMA(0, 1, At, B1); PG8_BAR;
            PG8_LDA(At, 1, 1); PG8_STAGE(PG8_SA(1, 0), a3, voffA);
            PG8_BAR; PG8_WAIT_L(0); PG8_MMA(1, 0, At, B0); PG8_BAR; PG8_SCHED;
            PG8_STAGE(PG8_SB(1, 1), b3 + hstep, voffB);
            PG8_WAIT_V(6); PG8_BAR; PG8_MMA(1, 1, At, B1); PG8_BAR;
            }
        }
        if constexpr (ALIGN_EPI) { if (wr == 0) PG8_BAR; }
        if constexpr (!Epi::AFTER_DRAIN) { E(acc, cur, wr, wc, fr, fq); S.done(cur); }
        if (!has_next) break;
#pragma unroll
        for (int a = 0; a < 2; ++a)
#pragma unroll
            for (int b = 0; b < 2; ++b)
#pragma unroll
                for (int m = 0; m < 4; ++m)
#pragma unroll
                    for (int n = 0; n < 2; ++n) acc[a][b][m][n] = (f32x4){0.f, 0.f, 0.f, 0.f};
        cur = nxt; cA = nA; cB = nB; ++ui;
        if constexpr (ALIGN_EPI) { if (wr == 1) PG8_BAR; }
    }
    PG8_WAIT_V(0);
    if constexpr (!ALIGN_EPI) { if (wr == 0) PG8_BAR; }
    PG8_BAR;
    if constexpr (Epi::AFTER_DRAIN) { E.fused(acc, cur, wr, wc, fr, fq, lds, wid, lane); S.done(cur); }
#undef PG8_SA
#undef PG8_SB
#undef PG8_STAGE
#undef PG8_LDA
#undef PG8_LDB
#undef PG8_MMA
#undef PG8_WAIT_V
#undef PG8_WAIT_L
#undef PG8_BAR
#undef PG8_SCHED
}
}
namespace pg8 {
typedef unsigned u32x2v __attribute__((ext_vector_type(2)));
constexpr int TOK_S = 8192;
constexpr float QK_EPS = 1e-6f;
constexpr float C2 = 0.125f * 1.4426950408889634f;
__device__ __forceinline__ float sigmoid_fast(float v) { return 1.f / (1.f + __expf(-v)); }
__device__ __forceinline__ float silu_fast(float v) { return v / (1.f + __expf(-v)); }

struct EpiInProj {
    static constexpr bool PERM = true, AFTER_DRAIN = false;
    bf16_t* qkv;
    float* gates;
    float* kmean_part;
    const float *qna, *kna, *qnb, *knsel, *knwin;
    __device__ __forceinline__ void operator()(const f32x4 (&acc)[2][2][4][2], const Unit& u, int wr, int wc, int fr, int fq) const {
        const int slot = u.pn * 4 + wc;
        if (slot > 44) return;
        const int b = u.pm >> 5, blk = u.pm & 31, pos0 = blk * 256 + wr * 64 + fr;
        if (slot == 44) {
            if (fq < 3) {
#pragma unroll
                for (int ai = 0; ai < 2; ++ai)
#pragma unroll
                    for (int m = 0; m < 4; ++m) { const size_t tok = (size_t)b * TOK_S + pos0 + ai * HALF + m * 16; float* gp = gates + tok * 24 + 8 * fq;
                        const f32x4 v0 = acc[ai][0][m][0], v1 = acc[ai][0][m][1];
                        *(f32x4*)gp = (f32x4){sigmoid_fast(v0[0]), sigmoid_fast(v0[1]), sigmoid_fast(v0[2]), sigmoid_fast(v0[3])};
                        *(f32x4*)(gp + 4) = (f32x4){sigmoid_fast(v1[0]), sigmoid_fast(v1[1]), sigmoid_fast(v1[2]), sigmoid_fast(v1[3])}; }
            }
            return;
        }
        const float* gain = nullptr; float qscale = 1.f; bool is_ka = false; bf16_t* dst;
        constexpr size_t BIG = (size_t)4 * 8 * TOK_S * 64, SMALL = (size_t)4 * 2 * TOK_S * 64;
        if (slot < 32) { const int kind = slot >> 3, head = slot & 7; dst = qkv + kind * BIG + ((size_t)(b * 8 + head) * TOK_S) * 64;
            if (kind == 0) { gain = qna; qscale = C2; } else if (kind == 1) { gain = kna; is_ka = true; } else if (kind == 3) { gain = qnb; qscale = C2; } }
        else { const int kind = (slot - 32) >> 1, g = slot & 1; dst = qkv + 4 * BIG + kind * SMALL + ((size_t)(b * 2 + g) * TOK_S) * 64;
            if (kind == 2) gain = knsel; else if (kind == 4) gain = knwin; }
        float gv[16];
#pragma unroll
        for (int i = 0; i < 16; ++i) gv[i] = gain ? gain[(i >> 3) * 32 + 8 * fq + (i & 7)] * qscale : 1.f;
        float cs[16];
#pragma unroll
        for (int i = 0; i < 16; ++i) cs[i] = 0.f;
#pragma unroll
        for (int ai = 0; ai < 2; ++ai)
#pragma unroll
            for (int m = 0; m < 4; ++m) {
                float v[16];
#pragma unroll
                for (int bj = 0; bj < 2; ++bj)
#pragma unroll
                    for (int n = 0; n < 2; ++n)
#pragma unroll
                        for (int j = 0; j < 4; ++j) v[bj * 8 + n * 4 + j] = acc[ai][bj][m][n][j];
                if (gain) { float ss = 0.f;
#pragma unroll
                    for (int i = 0; i < 16; ++i) ss += v[i] * v[i];
                    ss += __shfl_xor(ss, 16); ss += __shfl_xor(ss, 32);
                    const float rs = rsqrtf(ss * (1.f / 64.f) + QK_EPS);
#pragma unroll
                    for (int i = 0; i < 16; ++i) v[i] *= rs * gv[i]; }
                if (is_ka) {
#pragma unroll
                    for (int i = 0; i < 16; ++i) cs[i] += v[i]; }
                bf16_t* rp = dst + (size_t)(pos0 + ai * HALF + m * 16) * 64 + 8 * fq;
                u32x4 w0, w1;
                w0.x = cvt_pk_bf16(v[0], v[1]); w0.y = cvt_pk_bf16(v[2], v[3]); w0.z = cvt_pk_bf16(v[4], v[5]); w0.w = cvt_pk_bf16(v[6], v[7]);
                w1.x = cvt_pk_bf16(v[8], v[9]); w1.y = cvt_pk_bf16(v[10], v[11]); w1.z = cvt_pk_bf16(v[12], v[13]); w1.w = cvt_pk_bf16(v[14], v[15]);
                *(u32x4*)rp = w0; *(u32x4*)(rp + 32) = w1;
            }
        if (is_ka) {
#pragma unroll
            for (int i = 0; i < 16; ++i) { float s = cs[i]; s += __shfl_xor(s, 1); s += __shfl_xor(s, 2); s += __shfl_xor(s, 4); s += __shfl_xor(s, 8); cs[i] = s; }
            if (fr == 0) { float* kp = kmean_part + ((size_t)((b * 8 + (slot & 7)) * 32 + blk) * 2 + wr) * 64 + 8 * fq;
                *(f32x4*)kp = (f32x4){cs[0], cs[1], cs[2], cs[3]}; *(f32x4*)(kp + 4) = (f32x4){cs[4], cs[5], cs[6], cs[7]};
                *(f32x4*)(kp + 32) = (f32x4){cs[8], cs[9], cs[10], cs[11]}; *(f32x4*)(kp + 36) = (f32x4){cs[12], cs[13], cs[14], cs[15]}; }
        }
    }
};
struct EpiOutProj {
    static constexpr bool PERM = false, AFTER_DRAIN = false;
    const float* x; float* out; const float* gt;
    __device__ __forceinline__ void operator()(const f32x4 (&acc)[2][2][4][2], const Unit& u, int wr, int wc, int fr, int fq) const {
        const int b = u.pm >> 5; const int col0 = u.pn * BM + wc * 32 + 4 * fq; const float* gtb = gt + (size_t)b * 6144;
#pragma unroll
        for (int bj = 0; bj < 2; ++bj)
#pragma unroll
            for (int n = 0; n < 2; ++n) { const int c = col0 + bj * HALF + n * 16; const f32x4 g4 = *(const f32x4*)(gtb + c);
#pragma unroll
                for (int ai = 0; ai < 2; ++ai)
#pragma unroll
                    for (int m = 0; m < 4; ++m) { const size_t off = (size_t)(u.pm * BM + ai * HALF + wr * 64 + m * 16 + fr) * 1024 + c;
                        const f32x4 xv = *(const f32x4*)(x + off); *(f32x4*)(out + off) = xv + g4 * acc[ai][bj][m][n]; } }
    }
};
struct EpiGateUp {
    static constexpr bool PERM = true, AFTER_DRAIN = false;
    bf16_t* act;
    __device__ __forceinline__ void operator()(const f32x4 (&acc)[2][2][4][2], const Unit& u, int wr, int wc, int fr, int fq) const {
        const int h0 = u.pn * 128 + wc * 32 + 8 * fq;
#pragma unroll
        for (int ai = 0; ai < 2; ++ai)
#pragma unroll
            for (int m = 0; m < 4; ++m) { const size_t row = (size_t)(u.pm * BM + ai * HALF + wr * 64 + m * 16 + fr);
                const f32x4 g0 = acc[ai][0][m][0], g1 = acc[ai][0][m][1], u0 = acc[ai][1][m][0], u1 = acc[ai][1][m][1];
                u32x4 w;
                w.x = cvt_pk_bf16(silu_fast(g0[0]) * u0[0], silu_fast(g0[1]) * u0[1]); w.y = cvt_pk_bf16(silu_fast(g0[2]) * u0[2], silu_fast(g0[3]) * u0[3]);
                w.z = cvt_pk_bf16(silu_fast(g1[0]) * u1[0], silu_fast(g1[1]) * u1[1]); w.w = cvt_pk_bf16(silu_fast(g1[2]) * u1[2], silu_fast(g1[3]) * u1[3]);
                *(u32x4*)(act + row * 2816 + h0) = w; }
    }
};
struct EpiDown {
    static constexpr bool PERM = false, AFTER_DRAIN = false;
    float* out; const float* gt;
    __device__ __forceinline__ void operator()(const f32x4 (&acc)[2][2][4][2], const Unit& u, int wr, int wc, int fr, int fq) const {
        const int b = u.pm >> 5; const int col0 = u.pn * BM + wc * 32 + 4 * fq; const float* gtb = gt + (size_t)b * 6144;
#pragma unroll
        for (int bj = 0; bj < 2; ++bj)
#pragma unroll
            for (int n = 0; n < 2; ++n) { const int c = col0 + bj * HALF + n * 16; const f32x4 g4 = *(const f32x4*)(gtb + c);
#pragma unroll
                for (int ai = 0; ai < 2; ++ai)
#pragma unroll
                    for (int m = 0; m < 4; ++m) { const size_t off = (size_t)(u.pm * BM + ai * HALF + wr * 64 + m * 16 + fr) * 1024 + c;
                        const f32x4 xv = *(const f32x4*)(out + off); *(f32x4*)(out + off) = xv + g4 * acc[ai][bj][m][n]; } }
    }
};
}
constexpr int NWAVES = 8, NTHREADS = 512;
constexpr int BATCH = 4, SEQ = 8192, DM = 1024, TOK = BATCH * SEQ, NIN = 2840, NIN_PAD = 3072, FF = 2816, NCMP = 511;
constexpr size_t MiB = 1u << 20;
constexpr size_t WS_CTL = 0, CTL_ZERO_BYTES = 64 * 1024;
constexpr size_t WS_MODP = 1 * MiB;
constexpr size_t WS_MOD = 2 * MiB;
constexpr size_t WS_CBP = 2 * MiB + 512 * 1024;
constexpr size_t WS_KMP = 3 * MiB;
constexpr size_t WS_BIAS2 = 4 * MiB;
constexpr size_t WS_SSP = 449 * MiB;
constexpr size_t WS_WIN = 6 * MiB, WS_WOUT = 12 * MiB, WS_WGU = 14 * MiB, WS_WDN = 25 * MiB;
constexpr size_t WS_W1K = 31 * MiB, WS_W1V = 32 * MiB, WS_W2K = 33 * MiB, WS_W2V = 33 * MiB + 64 * 1024;
constexpr size_t WS_KCMP = 34 * MiB, WS_VCMP = 35 * MiB;
constexpr size_t WS_GATES = 36 * MiB;
constexpr size_t WS_H = 40 * MiB;
constexpr size_t WS_MIX = 104 * MiB;
constexpr size_t WS_QKV = 168 * MiB;
constexpr size_t WS_ACT = WS_QKV;
constexpr size_t WS_END = 344 * MiB;
constexpr size_t WS_PARTO = 344 * MiB;
constexpr size_t WS_PARTL = 472 * MiB;
constexpr size_t WS_SELG = 476 * MiB;
constexpr size_t QKV_BIG = (size_t)4 * 8 * SEQ * 64, QKV_SMALL = (size_t)4 * 2 * SEQ * 64;
constexpr int RING_BYTES = 131072, LDS_BYTES = 147456;
constexpr int N_PHASES = 10;

#define GAS __attribute__((address_space(1)))
#define LAS __attribute__((address_space(3)))
typedef unsigned short bf16;
typedef unsigned v4u __attribute__((ext_vector_type(4)));
typedef float f32x4 __attribute__((ext_vector_type(4)));
#define LDS_WAIT() asm volatile("s_waitcnt lgkmcnt(0)" ::: "memory")
#define VM_WAIT() asm volatile("s_waitcnt vmcnt(0)" ::: "memory")
__device__ __forceinline__ unsigned f2bf(float f) { unsigned u = __builtin_bit_cast(unsigned, f); return (u + 0x7fffu + ((u >> 16) & 1u)) >> 16; }
__device__ __forceinline__ unsigned pk2(float lo, float hi) { return f2bf(lo) | (f2bf(hi) << 16); }
__device__ __forceinline__ float bf2f(bf16 v) { return __builtin_bit_cast(float, (unsigned)v << 16); }
__device__ __forceinline__ float wave_sum(float v) {
#pragma unroll
    for (int o = 1; o < 64; o <<= 1) v += __shfl_xor(v, o);
    return v;
}
struct Args { const float* in[23]; float* out; unsigned char* ws; int ph_lo, ph_hi, flags, pad; };
struct Frame { LAS unsigned char* lds; int tid, lane, wave, vcu, G; };

struct MapId { __device__ __forceinline__ size_t off(int n, int k, int K) const { return (size_t)n * K + k; } };
struct MapWin { __device__ __forceinline__ size_t off(int n, int k, int K) const { const int s = n >> 6, d = n & 63; return (size_t)(256 * (s >> 2) + 128 * (d >> 5) + 32 * (s & 3) + (d & 31)) * K + k; } };
struct MapWgu { __device__ __forceinline__ size_t off(int n, int k, int K) const { const int up = n >= FF, hdn = up ? n - FF : n; return (size_t)(256 * (hdn >> 7) + 128 * up + (hdn & 127)) * K + k; } };
struct MapFrag { __device__ __forceinline__ size_t off(int n, int k, int K) const { return ((size_t)((k >> 4) * 8 + (n >> 5)) * 64 + ((k >> 3) & 1) * 32 + (n & 31)) * 8 + (k & 7); } };
template <class Map>
__device__ __forceinline__ void transpose_item(const float* __restrict__ W, int K, int N, bf16* WT, LAS float* scr, int item, int lane, const Map& map) {
    const int nblk = (N + 63) / 64, kb = item / nblk, nb = item % nblk, k0 = 64 * kb, n0 = 64 * nb;
    const int nc = n0 + 4 * (lane & 15); const bool nin = nc < N;
    f32x4 v[16];
#pragma unroll
    for (int i = 0; i < 16; ++i) { const int kk = 4 * i + (lane >> 4); v[i] = nin ? *(const GAS f32x4*)(W + (size_t)(k0 + kk) * N + nc) : (f32x4){0.f, 0.f, 0.f, 0.f}; }
#pragma unroll
    for (int i = 0; i < 16; ++i) { const int kk = 4 * i + (lane >> 4); LAS float* d = scr + (4 * (lane & 15)) * 68 + kk; d[0] = v[i][0]; d[68] = v[i][1]; d[136] = v[i][2]; d[204] = v[i][3]; }
    LDS_WAIT(); asm volatile("" ::: "memory");
    const int c = lane & 7;
#pragma unroll
    for (int j = 0; j < 8; ++j) { const int n = (lane >> 3) + 8 * j; const LAS float* s = scr + n * 68 + 8 * c;
        const f32x4 a = *(const LAS f32x4*)s, bq = *(const LAS f32x4*)(s + 4);
        v4u o; o.x = pk2(a[0], a[1]); o.y = pk2(a[2], a[3]); o.z = pk2(bq[0], bq[1]); o.w = pk2(bq[2], bq[3]);
        if (n0 + n < N) *(GAS v4u*)(WT + map.off(n0 + n, k0 + 8 * c, K)) = o; }
    LDS_WAIT(); asm volatile("" ::: "memory");
}
__device__ __forceinline__ float silu_acc(float v) { return v / (1.f + expf(-v)); }
__device__ __forceinline__ void phase_prologue_a(Frame& F, const Args& a) {
    LAS float* scr = (LAS float*)(F.lds + F.wave * 17408);
    const int gw = F.vcu * NWAVES + F.wave, NGW = F.G * NWAVES;
    unsigned char* ws = a.ws;
    constexpr int I_IN = (DM / 64) * ((NIN + 63) / 64), I_OUT = (DM / 64) * (DM / 64), I_GU = (DM / 64) * (2 * FF / 64), I_DN = (FF / 64) * (DM / 64), I_W1 = (2048 / 64) * (256 / 64), I_W2 = (256 / 64) * (64 / 64);
    constexpr int NITEMS = I_IN + I_OUT + I_GU + I_DN + 2 * I_W1 + 2 * I_W2;
    for (int it = gw; it < NITEMS; it += NGW) {
        int r = it;
        if (r < I_IN) { transpose_item(a.in[6], DM, NIN, (bf16*)(ws + WS_WIN), scr, r, F.lane, MapWin()); continue; } r -= I_IN;
        if (r < I_OUT) { transpose_item(a.in[19], DM, DM, (bf16*)(ws + WS_WOUT), scr, r, F.lane, MapId()); continue; } r -= I_OUT;
        if (r < I_GU) { transpose_item(a.in[21], DM, 2 * FF, (bf16*)(ws + WS_WGU), scr, r, F.lane, MapWgu()); continue; } r -= I_GU;
        if (r < I_DN) { transpose_item(a.in[22], FF, DM, (bf16*)(ws + WS_WDN), scr, r, F.lane, MapId()); continue; } r -= I_DN;
        if (r < I_W1) { transpose_item(a.in[14], 2048, 256, (bf16*)(ws + WS_W1K), scr, r, F.lane, MapFrag()); continue; } r -= I_W1;
        if (r < I_W1) { transpose_item(a.in[17], 2048, 256, (bf16*)(ws + WS_W1V), scr, r, F.lane, MapFrag()); continue; } r -= I_W1;
        if (r < I_W2) { transpose_item(a.in[15], 256, 64, (bf16*)(ws + WS_W2K), scr, r, F.lane, MapId()); continue; } r -= I_W2;
        transpose_item(a.in[18], 256, 64, (bf16*)(ws + WS_W2V), scr, r, F.lane, MapId());
    }
    const float* c = a.in[1]; const float* w_ada = a.in[3]; float* modp = (float*)(ws + WS_MODP);
    for (int t = NGW - 1 - gw; t < 96 * 8; t += NGW) { const int cg_ = t % 96, ks = t / 96; const int n = cg_ * 64 + F.lane;
        float acc0 = 0.f, acc1 = 0.f, acc2 = 0.f, acc3 = 0.f;
#pragma unroll
        for (int i = 0; i < 8; ++i) { const int idx = F.lane + 64 * i, bb = idx >> 7, kk = idx & 127; scr[kk * 4 + bb] = silu_acc(c[bb * DM + ks * 128 + kk]); }
        LDS_WAIT(); asm volatile("" ::: "memory");
#pragma unroll 8
        for (int k = 0; k < 128; ++k) { const float w = w_ada[(size_t)(ks * 128 + k) * 6144 + n]; const f32x4 sv = *(const LAS f32x4*)(scr + 4 * k);
            acc0 += sv[0] * w; acc1 += sv[1] * w; acc2 += sv[2] * w; acc3 += sv[3] * w; }
        LDS_WAIT(); asm volatile("" ::: "memory");
        float* o = modp + (size_t)ks * 4 * 6144 + n; o[0] = acc0; o[6144] = acc1; o[2 * 6144] = acc2; o[3 * 6144] = acc3; }
    float* cbp = (float*)(ws + WS_CBP);
    for (int t = NGW / 2 - 1 - gw; t >= 0 && t < 256; t += NGW) { const int kv = t & 1, cg_ = (t >> 1) & 3, ic = t >> 3; const int n = cg_ * 64 + F.lane;
        const float* pe = kv ? a.in[16] : a.in[13]; const float* w1 = kv ? a.in[17] : a.in[14]; float acc = 0.f;
#pragma unroll 8
        for (int i = ic * 64; i < ic * 64 + 64; ++i) acc += pe[i] * w1[(size_t)i * 256 + n];
        cbp[(ic * 2 + kv) * 256 + n] = acc; }
}
__device__ __forceinline__ void norm_rows(Frame& F, const float* in, const f32x4 (&gs)[4], const f32x4 (&sh)[4], bf16* out) {
#pragma unroll 4
    for (int i = 0; i < 16; ++i) { const int row = F.vcu * 128 + F.wave * 16 + i;
        const GAS f32x4* xr = (const GAS f32x4*)(in + (size_t)row * DM) + F.lane;
        f32x4 v[4]; float ss = 0.f;
#pragma unroll
        for (int j = 0; j < 4; ++j) { v[j] = xr[64 * j]; ss += (v[j].x * v[j].x + v[j].y * v[j].y) + (v[j].z * v[j].z + v[j].w * v[j].w); }
        const float rs = rsqrtf(wave_sum(ss) * (1.f / DM) + 1e-6f);
        GAS unsigned long long* o8 = (GAS unsigned long long*)(out + (size_t)row * DM) + F.lane;
#pragma unroll
        for (int j = 0; j < 4; ++j) { const f32x4 y = v[j] * rs * gs[j] + sh[j]; o8[64 * j] = (unsigned long long)pk2(y.x, y.y) | ((unsigned long long)pk2(y.z, y.w) << 32); } }
}
__device__ __forceinline__ void phase_prologue_b(Frame& F, const Args& a) {
    unsigned char* ws = a.ws; const float* modp = (const float*)(ws + WS_MODP); const float* b_ada = a.in[4];
    if (F.wave == 0 && F.vcu < 96) { const int n = F.vcu * 64 + F.lane; float* mod = (float*)(ws + WS_MOD);
        for (int b = 0; b < 4; ++b) { float s = 0.f;
#pragma unroll
            for (int ks = 0; ks < 8; ++ks) s += modp[((size_t)ks * 4 + b) * 6144 + n];
            mod[b * 6144 + n] = s + b_ada[n]; } }
    const int b = F.vcu >> 6; const float* g = a.in[5];
    f32x4 gs[4], sh[4];
#pragma unroll
    for (int j = 0; j < 4; ++j) { const int c0 = 4 * F.lane + 256 * j; f32x4 s0 = {0.f, 0.f, 0.f, 0.f}, s1 = {0.f, 0.f, 0.f, 0.f};
#pragma unroll
        for (int ks = 0; ks < 8; ++ks) { s0 += *(const f32x4*)(modp + ((size_t)ks * 4 + b) * 6144 + c0); s1 += *(const f32x4*)(modp + ((size_t)ks * 4 + b) * 6144 + DM + c0); }
        s0 += *(const f32x4*)(b_ada + c0); s1 += *(const f32x4*)(b_ada + DM + c0);
        sh[j] = s0; gs[j] = *(const f32x4*)(g + c0) * (s1 + 1.0f); }
    norm_rows(F, a.in[0], gs, sh, (bf16*)(ws + WS_H));
}
__device__ __forceinline__ void phase_norm2(Frame& F, const Args& a) {
    unsigned char* ws = a.ws; const int b = F.vcu >> 6; const float* mod = (const float*)(ws + WS_MOD) + (size_t)b * 6144; const float* g = a.in[20];
    f32x4 gs[4], sh[4];
#pragma unroll
    for (int j = 0; j < 4; ++j) { const int c0 = 4 * F.lane + 256 * j; sh[j] = *(const f32x4*)(mod + 3 * DM + c0); gs[j] = *(const f32x4*)(g + c0) * (*(const f32x4*)(mod + 4 * DM + c0) + 1.0f); }
    norm_rows(F, a.out, gs, sh, (bf16*)(ws + WS_H));
}

__device__ __forceinline__ void phase_bias2(Frame& F, const Args& a) {
    unsigned char* ws = a.ws; const float* mod = (const float*)(ws + WS_MOD); const bf16* wt = (const bf16*)(ws + WS_WGU); float* bias2 = (float*)(ws + WS_BIAS2);
    const int gw = F.vcu * NWAVES + F.wave, NGW = F.G * NWAVES;
    f32x4 sh[4][4];
#pragma unroll
    for (int bb = 0; bb < 4; ++bb)
#pragma unroll
        for (int j = 0; j < 4; ++j) sh[bb][j] = *(const f32x4*)(mod + (size_t)bb * 6144 + 3 * DM + 16 * F.lane + 4 * j);
    for (int c = gw; c < 2 * FF; c += NGW) {
        const v4u w0 = *(const GAS v4u*)(wt + (size_t)c * DM + 16 * F.lane), w1 = *(const GAS v4u*)(wt + (size_t)c * DM + 16 * F.lane + 8);
        const unsigned wu[8] = {w0.x, w0.y, w0.z, w0.w, w1.x, w1.y, w1.z, w1.w};
        float s[4] = {0.f, 0.f, 0.f, 0.f};
#pragma unroll
        for (int j = 0; j < 4; ++j) { const float e0 = __builtin_bit_cast(float, wu[2 * j] << 16), e1 = __builtin_bit_cast(float, wu[2 * j] & 0xffff0000u), e2 = __builtin_bit_cast(float, wu[2 * j + 1] << 16), e3 = __builtin_bit_cast(float, wu[2 * j + 1] & 0xffff0000u);
#pragma unroll
            for (int bb = 0; bb < 4; ++bb) s[bb] += (sh[bb][j][0] * e0 + sh[bb][j][1] * e1) + (sh[bb][j][2] * e2 + sh[bb][j][3] * e3); }
#pragma unroll
        for (int bb = 0; bb < 4; ++bb) { const float t = wave_sum(s[bb]); if (F.lane == 0) bias2[(size_t)bb * 2 * FF + c] = t; }
    }
}
#define XB_TMO      128
#define XB_XCNT(j)  (256  + 64 * (j))
#define XB_XSUB(j)  (1280 + 64 * (j))
#define XB_XGEN(j)  (2304 + 64 * (j))
#define XB_TOP      3328
#define XB_TOPGEN   3392
#define XCD_BAR_WORDS 3456
#define XB_SPIN_CAP (1u << 18)

__device__ __forceinline__ unsigned xb_ld(unsigned* p)              { return __hip_atomic_load(p, __ATOMIC_RELAXED, __HIP_MEMORY_SCOPE_AGENT); }
__device__ __forceinline__ unsigned xb_add(unsigned* p, unsigned v) { return __hip_atomic_fetch_add(p, v, __ATOMIC_RELAXED, __HIP_MEMORY_SCOPE_AGENT); }
__device__ __forceinline__ unsigned xb_xcc_id() { return (unsigned)__builtin_amdgcn_s_getreg((3 << 11) | 20) & 0xFu; }
#define XB_SPIN(cond, bar) do { unsigned _sp = 0; while (cond) { __builtin_amdgcn_s_sleep(1); \
    if ((++_sp & 255u) == 0u) { if (xb_ld(&(bar)[XB_TMO])) break; if (_sp > XB_SPIN_CAP) { atomicAdd(&(bar)[XB_TMO], 1u); break; } } } } while (0)

struct XcdBarrier {
    unsigned* bar; unsigned x;
    volatile LAS unsigned* st;
};

__device__ __forceinline__ XcdBarrier xcd_barrier_post(unsigned* bar, volatile LAS unsigned* st) {
    XcdBarrier b; b.bar = bar; b.x = xb_xcc_id(); b.st = st;
    if (threadIdx.x == 0) (void)xb_add(&bar[XB_XCNT(b.x)], 1u);
    return b;
}
__device__ __forceinline__ void xcd_barrier_complete(unsigned* bar, unsigned x, unsigned& nloc, unsigned& nx) {
    const unsigned G = gridDim.x * gridDim.y * gridDim.z;
    unsigned sum, cnt, mine, sp = 0u;
    for (;;) {
        sum = 0u; cnt = 0u; mine = 0u;
#pragma unroll
        for (unsigned j = 0; j < 16; ++j) { const unsigned c = xb_ld(&bar[XB_XCNT(j)]); sum += c; cnt += (c > 0u) ? 1u : 0u; mine = (j == x) ? c : mine; }
        if (sum == G) break;
        __builtin_amdgcn_s_sleep(1);
        if ((++sp & 255u) == 0u) { if (xb_ld(&bar[XB_TMO])) break; if (sp > XB_SPIN_CAP) { atomicAdd(&bar[XB_TMO], 1u); break; } }
    }
    nloc = mine > 0u ? mine : 1u; nx = cnt > 0u ? cnt : 1u;
}

__device__ __forceinline__ void xcd_barrier(const XcdBarrier& b) {
    asm volatile("s_waitcnt vmcnt(0)" ::: "memory");
    __syncthreads();
    if (threadIdx.x == 0) {
        unsigned* bar = b.bar;
        __builtin_amdgcn_s_waitcnt(0);
        unsigned nloc = b.st[0], nx = b.st[1];
        if (nloc == 0u) { xcd_barrier_complete(bar, b.x, nloc, nx); b.st[0] = nloc; b.st[1] = nx; }
        const unsigned old = xb_add(&bar[XB_XSUB(b.x)], 1u);
        const unsigned gen = old / nloc;
        if (old + 1u == (gen + 1u) * nloc) {
            __builtin_amdgcn_fence(__ATOMIC_RELEASE, "agent");
            asm volatile("s_waitcnt vmcnt(0)" ::: "memory");
            const unsigned og = xb_add(&bar[XB_TOP], 1u);
            const unsigned tg = og / nx;
            if (og + 1u == (tg + 1u) * nx) xb_add(&bar[XB_TOPGEN], 1u);
            else XB_SPIN(xb_ld(&bar[XB_TOPGEN]) == tg, bar);
            __builtin_amdgcn_fence(__ATOMIC_ACQUIRE, "agent");
            xb_add(&bar[XB_XGEN(b.x)], 1u);
            asm volatile("s_waitcnt vmcnt(0)" ::: "memory");
        } else {
            XB_SPIN(xb_ld(&bar[XB_XGEN(b.x)]) == gen, bar);
            __builtin_amdgcn_fence(__ATOMIC_ACQUIRE, "agent");
            asm volatile("s_waitcnt vmcnt(0)" ::: "memory");
        }
    }
    __syncthreads();
}
#define ATT_NS att
#ifndef ATT_ABL
#define ATT_ABL 0
#endif
#ifndef ATT_STAGGER
#define ATT_STAGGER 0
#endif
#ifndef ATT_SLEEP
#define ATT_SLEEP 24
#endif
namespace ATT_NS {
using bf16x8 = __attribute__((ext_vector_type(8))) short;
using s16x4 = __attribute__((ext_vector_type(4))) short;
using f32x16 = __attribute__((ext_vector_type(16))) float;
using u32x4 = __attribute__((ext_vector_type(4))) unsigned;
typedef LAS const char* lds_cptr;
typedef short v4i16_t __attribute__((ext_vector_type(4)));
constexpr int SLOT = 16384, NSLOT = 4, LDS_OST = 65536, LDS_LUT = 98304, LDS_IMP = 100352, LDS_SELM = 133120, LDS_MISC = 134144, LDS_WSF = 134400, LDS_ATT_END = 136448;
constexpr float LOG2E = 1.4426950408889634f;
#define MFMA32(a, b, c) __builtin_amdgcn_mfma_f32_32x32x16_bf16(a, b, c, 0, 0, 0)
#define ATT_WAIT_BAR(N) asm volatile("s_waitcnt vmcnt(" #N ") lgkmcnt(0)\n\ts_barrier" ::: "memory")
__device__ __forceinline__ void glds16(const void* gsrc, unsigned lds_dst) { unsigned keep;
    asm volatile("s_mov_b32 %0, m0\n\ts_mov_b32 m0, %2\n\ts_nop 0\n\tglobal_load_lds_dwordx4 %1, off\n\ts_mov_b32 m0, %0" : "=&s"(keep) : "v"(gsrc), "s"(lds_dst) : "memory"); }
typedef float f32x2_t __attribute__((ext_vector_type(2))); typedef __bf16 bf16x2_t __attribute__((ext_vector_type(2)));
__device__ __forceinline__ unsigned cvtpk(float lo, float hi) { f32x2_t v = {lo, hi}; bf16x2_t b = __builtin_convertvector(v, bf16x2_t); return __builtin_bit_cast(unsigned, b); }
__device__ __forceinline__ s16x4 vtr(lds_cptr p) { return __builtin_bit_cast(s16x4, __builtin_amdgcn_ds_read_tr16_b64_v4i16((LAS v4i16_t*)p)); }
__device__ __forceinline__ int t5_bucket(int d) {
    if (d < 16) return d;
    int b = 16;
    b += (d >= 19); b += (d >= 21); b += (d >= 24); b += (d >= 27); b += (d >= 31); b += (d >= 35); b += (d >= 40); b += (d >= 46);
    b += (d >= 52); b += (d >= 59); b += (d >= 67); b += (d >= 77); b += (d >= 87); b += (d >= 99); b += (d >= 113);
    return b;
}
struct Ctx { LAS char* lds; int wid; int lane, r32, hi; };
__device__ __forceinline__ int fresh_lane() { int l; asm volatile("v_mbcnt_lo_u32_b32 %0, -1, 0\n\tv_mbcnt_hi_u32_b32 %0, -1, %0" : "=v"(l)); return l; }
__device__ __forceinline__ Ctx make_ctx(LAS unsigned char* lds, int tid) {
    Ctx c; c.lds = (LAS char*)lds; c.wid = __builtin_amdgcn_readfirstlane(tid >> 6); c.lane = tid & 63; c.r32 = c.lane & 31; c.hi = c.lane >> 5; return c;
}
template <bool HASV, class QK, class SM>
__device__ __forceinline__ void run_stream(const Ctx& c, const bf16* Kb, const bf16* Vb, int t0, int t1, QK&& qk, SM&& sm) {
    const int n = t1 - t0; if (n <= 0) return;
    const int lane = fresh_lane(), r32 = lane & 31, hi = lane >> 5; const unsigned lds0 = (unsigned)(uintptr_t)c.lds;
    const bf16* ks = Kb + ((8 * c.wid + (lane >> 3)) * 64 + (((lane & 7) ^ (((8 * c.wid + (lane >> 3)) >> 1) & 7)) << 3)); const bf16* vs = Vb + ((16 * (c.wid & 3) + (lane >> 2)) * 64 + (c.wid >> 2) * 32 + (lane & 3) * 8);
    const unsigned kdst = lds0 + c.wid * 1024, vdst = lds0 + 8192 + c.wid * 1024;
    const lds_cptr kp0 = (lds_cptr)c.lds + r32 * 128;
    const lds_cptr vp0 = (lds_cptr)c.lds + 8192 + ((lane >> 4) & 1) * 32 + (lane & 3) * 8 + (4 * hi + ((lane & 15) >> 2)) * 64;
#define ATT_ISSUE(t, so) do { if (ATT_ABL & 4) break; glds16(ks + (size_t)(t) * 4096, (unsigned)__builtin_amdgcn_readfirstlane(kdst + (so))); if (HASV) glds16(vs + (size_t)(t) * 4096, (unsigned)__builtin_amdgcn_readfirstlane(vdst + (so))); } while (0)
    ATT_ISSUE(t0, 0); if (n > 1) ATT_ISSUE(t0 + 1, SLOT);
    const bool late = ATT_STAGGER && __builtin_amdgcn_readfirstlane(c.wid) >= 4;
    f32x16 s0 = {}, s1 = {};
    int slot = 0, slotp = 3 * SLOT, slot2 = 2 * SLOT;
    if (!late) {
        for (int i = 0; i < n; ++i) {
            if (i + 1 < n) { if (HASV) ATT_WAIT_BAR(2); else ATT_WAIT_BAR(1); } else ATT_WAIT_BAR(0);
            if (i + 2 < n) ATT_ISSUE(t0 + i + 2, slot2);
            if (!(ATT_ABL & 1)) qk(t0 + i, kp0 + slot, s0, s1); if (!(ATT_ABL & 2)) sm(t0 + i, vp0 + slot, s0, s1);
            slot = (slot == 3 * SLOT) ? 0 : slot + SLOT; slot2 = (slot2 == 3 * SLOT) ? 0 : slot2 + SLOT;
        }
    } else {
        for (int i = 0; i < n; ++i) {
            if (i + 1 < n) { if (HASV) ATT_WAIT_BAR(2); else ATT_WAIT_BAR(1); } else ATT_WAIT_BAR(0);
            if (i + 2 < n) ATT_ISSUE(t0 + i + 2, slot2);
            if (i > 0 && !(ATT_ABL & 2)) sm(t0 + i - 1, vp0 + slotp, s0, s1);
            if (!(ATT_ABL & 1)) qk(t0 + i, kp0 + slot, s0, s1);
            slotp = slot; slot = (slot == 3 * SLOT) ? 0 : slot + SLOT; slot2 = (slot2 == 3 * SLOT) ? 0 : slot2 + SLOT;
        }
        if (!(ATT_ABL & 2)) sm(t0 + n - 1, vp0 + slotp, s0, s1);
    }
    asm volatile("s_waitcnt lgkmcnt(0)\n\ts_barrier" ::: "memory");
#undef ATT_ISSUE
}
template <class FN1, class FN2>
__device__ __forceinline__ void run_stream_pairs(const Ctx& c, const bf16* Kb, const bf16* Vb, int t0, int t1, FN1&& fn1, FN2&& fn2) {
    const int n = t1 - t0; if (n <= 0) return;
    const int lane = fresh_lane(), r32 = lane & 31, hi = lane >> 5; const unsigned lds0 = (unsigned)(uintptr_t)c.lds;
    const bf16* ks = Kb + ((8 * c.wid + (lane >> 3)) * 64 + (((lane & 7) ^ (((8 * c.wid + (lane >> 3)) >> 1) & 7)) << 3)); const bf16* vs = Vb + ((16 * (c.wid & 3) + (lane >> 2)) * 64 + (c.wid >> 2) * 32 + (lane & 3) * 8);
    const unsigned kdst = lds0 + c.wid * 1024, vdst = lds0 + 8192 + c.wid * 1024;
    const lds_cptr kp0 = (lds_cptr)c.lds + r32 * 128;
    const lds_cptr vp0 = (lds_cptr)c.lds + 8192 + ((lane >> 4) & 1) * 32 + (lane & 3) * 8 + (4 * hi + ((lane & 15) >> 2)) * 64;
#define ATT_ISSUE1(t, so) do { glds16(ks + (size_t)(t) * 4096, (unsigned)__builtin_amdgcn_readfirstlane(kdst + (so))); glds16(vs + (size_t)(t) * 4096, (unsigned)__builtin_amdgcn_readfirstlane(vdst + (so))); } while (0)
    ATT_ISSUE1(t0, 0); if (n > 1) ATT_ISSUE1(t0 + 1, SLOT);
    int base = 0;
    for (int i = 0; i < n; i += 2) {
        ATT_WAIT_BAR(0);
        const int nb = 2 * SLOT - base;
        if (i + 2 < n) ATT_ISSUE1(t0 + i + 2, nb); if (i + 3 < n) ATT_ISSUE1(t0 + i + 3, nb + SLOT);
        if (i + 1 < n) fn2(t0 + i, kp0 + base, vp0 + base, kp0 + base + SLOT, vp0 + base + SLOT); else fn1(t0 + i, kp0 + base, vp0 + base);
        base = nb;
    }
    asm volatile("s_waitcnt lgkmcnt(0)\n\ts_barrier" ::: "memory");
#undef ATT_ISSUE1
}
__device__ __forceinline__ void qk_tile(f32x16& s0, f32x16& s1, lds_cptr kp, const bf16x8 (&qr)[4]) {
    bf16x8 kf[8];
    { const int l = fresh_lane(), f = ((l & 31) >> 1) & 7, hi = l >> 5;
#pragma unroll
      for (int d0 = 0; d0 < 4; ++d0) { const int off = ((2 * d0 + hi) ^ f) << 4; kf[2 * d0] = *(const LAS bf16x8*)(kp + off); kf[2 * d0 + 1] = *(const LAS bf16x8*)(kp + 4096 + off); } }
    const f32x16 z = {};
    s0 = MFMA32(kf[0], qr[0], z); s1 = MFMA32(kf[1], qr[0], z);
#pragma unroll
    for (int d0 = 1; d0 < 4; ++d0) { s0 = MFMA32(kf[2 * d0], qr[d0], s0); s1 = MFMA32(kf[2 * d0 + 1], qr[d0], s1); }
}
template <bool MASK>
__device__ __forceinline__ void pv_tile(f32x16 (&o)[2], lds_cptr vp, const f32x16& p0, const f32x16& p1, unsigned mask) {
    if (ATT_ABL & 8) { o[0][0] += p0[0] + p1[5]; return; }
    u32x4 pw0 = {cvtpk(p0[0], p0[1]), cvtpk(p0[2], p0[3]), cvtpk(p0[4], p0[5]), cvtpk(p0[6], p0[7])}, pw1 = {cvtpk(p0[8], p0[9]), cvtpk(p0[10], p0[11]), cvtpk(p0[12], p0[13]), cvtpk(p0[14], p0[15])};
    u32x4 pw2 = {cvtpk(p1[0], p1[1]), cvtpk(p1[2], p1[3]), cvtpk(p1[4], p1[5]), cvtpk(p1[6], p1[7])}, pw3 = {cvtpk(p1[8], p1[9]), cvtpk(p1[10], p1[11]), cvtpk(p1[12], p1[13]), cvtpk(p1[14], p1[15])};
    if (MASK) { pw0 &= mask; pw1 &= mask; pw2 &= mask; pw3 &= mask; }
    if (ATT_ABL & 64) { o[0] = MFMA32(__builtin_bit_cast(bf16x8, pw0), __builtin_bit_cast(bf16x8, pw1), o[0]); o[1] = MFMA32(__builtin_bit_cast(bf16x8, pw2), __builtin_bit_cast(bf16x8, pw3), o[1]); return; }
    s16x4 vlo[8], vhi[8];
#pragma unroll
    for (int i = 0; i < 8; ++i) { vlo[i] = vtr(vp + ((i >> 2) * 4096 + (i & 3) * 1024)); vhi[i] = vtr(vp + ((i >> 2) * 4096 + (i & 3) * 1024 + 512)); }
#define ATT_VFR(i) (bf16x8){vlo[i][0], vlo[i][1], vlo[i][2], vlo[i][3], vhi[i][0], vhi[i][1], vhi[i][2], vhi[i][3]}
    o[0] = MFMA32(__builtin_bit_cast(bf16x8, pw0), ATT_VFR(0), o[0]); o[1] = MFMA32(__builtin_bit_cast(bf16x8, pw0), ATT_VFR(4), o[1]);
    o[0] = MFMA32(__builtin_bit_cast(bf16x8, pw1), ATT_VFR(1), o[0]); o[1] = MFMA32(__builtin_bit_cast(bf16x8, pw1), ATT_VFR(5), o[1]);
    o[0] = MFMA32(__builtin_bit_cast(bf16x8, pw2), ATT_VFR(2), o[0]); o[1] = MFMA32(__builtin_bit_cast(bf16x8, pw2), ATT_VFR(6), o[1]);
    o[0] = MFMA32(__builtin_bit_cast(bf16x8, pw3), ATT_VFR(3), o[0]); o[1] = MFMA32(__builtin_bit_cast(bf16x8, pw3), ATT_VFR(7), o[1]);
#undef ATT_VFR
}
#define ATT_SB() __builtin_amdgcn_sched_barrier(0)
struct KF { bf16x8 f[8]; };
struct VF { s16x4 lo[8], hi[8]; };
struct PW4 { u32x4 w0, w1, w2, w3; };
__device__ __forceinline__ void ld_k(KF& k, lds_cptr kp) {
    const int l = fresh_lane(), f = ((l & 31) >> 1) & 7, hi = l >> 5;
#pragma unroll
    for (int d0 = 0; d0 < 4; ++d0) { const int off = ((2 * d0 + hi) ^ f) << 4; k.f[2 * d0] = *(const LAS bf16x8*)(kp + off); k.f[2 * d0 + 1] = *(const LAS bf16x8*)(kp + 4096 + off); } }
__device__ __forceinline__ void qk_mfma(f32x16& s0, f32x16& s1, const KF& k, const bf16x8 (&qr)[4]) {
    const f32x16 z = {};
    s0 = MFMA32(k.f[0], qr[0], z); s1 = MFMA32(k.f[1], qr[0], z);
#pragma unroll
    for (int d0 = 1; d0 < 4; ++d0) { s0 = MFMA32(k.f[2 * d0], qr[d0], s0); s1 = MFMA32(k.f[2 * d0 + 1], qr[d0], s1); } }
__device__ __forceinline__ void ld_v(VF& v, lds_cptr vp) {
#pragma unroll
    for (int i = 0; i < 8; ++i) { v.lo[i] = vtr(vp + ((i >> 2) * 4096 + (i & 3) * 1024)); v.hi[i] = vtr(vp + ((i >> 2) * 4096 + (i & 3) * 1024 + 512)); } }
__device__ __forceinline__ PW4 pack4(const f32x16& p0, const f32x16& p1, unsigned mask) { PW4 w;
    w.w0 = (u32x4){cvtpk(p0[0], p0[1]), cvtpk(p0[2], p0[3]), cvtpk(p0[4], p0[5]), cvtpk(p0[6], p0[7])}; w.w1 = (u32x4){cvtpk(p0[8], p0[9]), cvtpk(p0[10], p0[11]), cvtpk(p0[12], p0[13]), cvtpk(p0[14], p0[15])};
    w.w2 = (u32x4){cvtpk(p1[0], p1[1]), cvtpk(p1[2], p1[3]), cvtpk(p1[4], p1[5]), cvtpk(p1[6], p1[7])}; w.w3 = (u32x4){cvtpk(p1[8], p1[9]), cvtpk(p1[10], p1[11]), cvtpk(p1[12], p1[13]), cvtpk(p1[14], p1[15])};
    w.w0 &= mask; w.w1 &= mask; w.w2 &= mask; w.w3 &= mask; return w; }
__device__ __forceinline__ void pv_mfma(f32x16 (&o)[2], const VF& v, const PW4& w) {
#define ATT_VF(i) (bf16x8){v.lo[i][0], v.lo[i][1], v.lo[i][2], v.lo[i][3], v.hi[i][0], v.hi[i][1], v.hi[i][2], v.hi[i][3]}
    o[0] = MFMA32(__builtin_bit_cast(bf16x8, w.w0), ATT_VF(0), o[0]); o[1] = MFMA32(__builtin_bit_cast(bf16x8, w.w0), ATT_VF(4), o[1]);
    o[0] = MFMA32(__builtin_bit_cast(bf16x8, w.w1), ATT_VF(1), o[0]); o[1] = MFMA32(__builtin_bit_cast(bf16x8, w.w1), ATT_VF(5), o[1]);
    o[0] = MFMA32(__builtin_bit_cast(bf16x8, w.w2), ATT_VF(2), o[0]); o[1] = MFMA32(__builtin_bit_cast(bf16x8, w.w2), ATT_VF(6), o[1]);
    o[0] = MFMA32(__builtin_bit_cast(bf16x8, w.w3), ATT_VF(3), o[0]); o[1] = MFMA32(__builtin_bit_cast(bf16x8, w.w3), ATT_VF(7), o[1]);
#undef ATT_VF
}
__device__ __forceinline__ float rowsum32(const f32x16& p0, const f32x16& p1) { if (ATT_ABL & 32) return p0[0]; float a = p0[0] + p1[0], b = p0[1] + p1[1];
#pragma unroll
    for (int r = 2; r < 16; r += 2) { a += p0[r]; asm volatile("" : "+v"(a)); b += p0[r + 1]; asm volatile("" : "+v"(b)); a += p1[r]; asm volatile("" : "+v"(a)); b += p1[r + 1]; asm volatile("" : "+v"(b)); }
    return a + b; }
__device__ __forceinline__ void hook_exp(f32x16& s0, f32x16& s1) {
    if (ATT_ABL & 16) return;
#pragma unroll
    for (int r = 0; r < 16; ++r) { s0[r] = __builtin_amdgcn_exp2f(s0[r]); s1[r] = __builtin_amdgcn_exp2f(s1[r]); } }
__device__ __forceinline__ void hook_near(f32x16& s0, f32x16& s1, int base, const LAS float* lut) {
    asm volatile("" : "+v"(base));
#pragma unroll
    for (int r = 0; r < 16; ++r) { const int d0 = base - ((r & 3) + 8 * (r >> 2)), d1 = d0 - 32;
        s0[r] = __builtin_amdgcn_exp2f(s0[r] + lut[min(max(d0, -1), 113) + 1]); s1[r] = __builtin_amdgcn_exp2f(s1[r] + lut[min(max(d1, -1), 113) + 1]); } }
__device__ __forceinline__ void hook_edge(f32x16& s0, f32x16& s1, int base, int win) {
    asm volatile("" : "+v"(base));
#pragma unroll
    for (int r = 0; r < 16; ++r) { const int d0 = base - ((r & 3) + 8 * (r >> 2)), d1 = d0 - 32;
        s0[r] = __builtin_amdgcn_exp2f(d0 < win ? s0[r] : -INFINITY); s1[r] = __builtin_amdgcn_exp2f(d1 < win ? s1[r] : -INFINITY); } }
__device__ __forceinline__ void hook_cmp(f32x16& s0, f32x16& s1, int nrel  , float cb) {
    asm volatile("" : "+v"(nrel));
#pragma unroll
    for (int r = 0; r < 16; ++r) { const int c0 = (r & 3) + 8 * (r >> 2);
        s0[r] = __builtin_amdgcn_exp2f(s0[r] + ((c0 <= nrel) ? cb : -INFINITY)); s1[r] = __builtin_amdgcn_exp2f(s1[r] + ((c0 + 32 <= nrel) ? cb : -INFINITY)); } }
__device__ __forceinline__ void row_factors(const Ctx& c, float f, float (&fr)[16]) {
    const int lane = fresh_lane(), r32 = lane & 31, hi = lane >> 5; LAS float* wsf = (LAS float*)(c.lds + LDS_WSF) + c.wid * 64;
    asm volatile("s_waitcnt lgkmcnt(0)" ::: "memory");
    if (hi == 0) wsf[r32] = f;
    asm volatile("s_waitcnt lgkmcnt(0)" ::: "memory");
#pragma unroll
    for (int r = 0; r < 16; ++r) fr[r] = wsf[(r & 3) + 8 * (r >> 2) + 4 * hi];
    asm volatile("s_waitcnt lgkmcnt(0)" ::: "memory");
}
__device__ __forceinline__ float pair_sum(float v) { auto rr = __builtin_amdgcn_permlane32_swap(__float_as_uint(v), __float_as_uint(v), false, false); return __uint_as_float(rr[0]) + __uint_as_float(rr[1]); }
template <class RowOff>
__device__ __forceinline__ void store_rows(const Ctx& c, const f32x16 (&o)[2], bf16* dst, RowOff&& rowoff) {
    LAS bf16* stg = (LAS bf16*)(c.lds + LDS_OST) + c.wid * 2048;
    const int lane = fresh_lane(), r32 = lane & 31, hi = lane >> 5;
#pragma unroll
    for (int r = 0; r < 16; ++r) { const int orow = (r & 3) + 8 * (r >> 2) + 4 * hi;
#pragma unroll
        for (int d0 = 0; d0 < 2; ++d0) stg[orow * 64 + d0 * 32 + r32] = (bf16)f2bf(o[d0][r]); }
    asm volatile("s_waitcnt lgkmcnt(0)" ::: "memory");
#pragma unroll
    for (int i = 0; i < 4; ++i) { const int row = i * 8 + (lane >> 3), ch = lane & 7; const u32x4 v = *(const LAS u32x4*)(stg + row * 64 + ch * 8); *(u32x4*)(dst + rowoff(row) + ch * 8) = v; }
    asm volatile("s_waitcnt lgkmcnt(0)" ::: "memory");
}
struct AttnPtrs { const bf16* qkv; const float* kmp; const float* gates; const bf16* kcmp; const bf16* vcmp; const float* rel_bias; bf16* mix; unsigned* selg; bf16* part_o; float* part_l; };

__device__ __forceinline__ unsigned moba_gate32(const AttnPtrs& P, int b, int h, int i, const bf16x8 (&qr)[4], int r32, int hi) {
    unsigned selmask = 0u;
    if (i > 0) {
        bf16x8 kmf[4];
        const float* kp = P.kmp + ((size_t)((b * 8 + h) * 32 + r32) * 2) * 64;
#pragma unroll
        for (int d0 = 0; d0 < 4; ++d0) { const f32x4 a0 = *(const f32x4*)(kp + d0 * 16 + hi * 8), a1 = *(const f32x4*)(kp + d0 * 16 + hi * 8 + 4), b0 = *(const f32x4*)(kp + 64 + d0 * 16 + hi * 8), b1 = *(const f32x4*)(kp + 64 + d0 * 16 + hi * 8 + 4);
            const f32x4 m0 = (a0 + b0) * (1.f / 256.f), m1 = (a1 + b1) * (1.f / 256.f);
            u32x4 w = {cvtpk(m0[0], m0[1]), cvtpk(m0[2], m0[3]), cvtpk(m1[0], m1[1]), cvtpk(m1[2], m1[3])}; kmf[d0] = __builtin_bit_cast(bf16x8, w); }
        f32x16 sg = {};
#pragma unroll
        for (int d0 = 0; d0 < 4; ++d0) sg = MFMA32(kmf[d0], qr[d0], sg);
        float v[16];
#pragma unroll
        for (int r = 0; r < 16; ++r) v[r] = ((r & 3) + 8 * (r >> 2) + 4 * hi < i) ? sg[r] : -INFINITY;
#pragma unroll
        for (int it = 0; it < 3; ++it) {
            float m = v[0]; int jb = 4 * hi;
#pragma unroll
            for (int r = 1; r < 16; ++r) { const int j = (r & 3) + 8 * (r >> 2) + 4 * hi; if (v[r] > m) { m = v[r]; jb = j; } }
            auto rm = __builtin_amdgcn_permlane32_swap(__float_as_uint(m), __float_as_uint(m), false, false);
            auto rj = __builtin_amdgcn_permlane32_swap((unsigned)jb, (unsigned)jb, false, false);
            const float mo = __uint_as_float(hi ? rm[0] : rm[1]); const int jo = (int)(hi ? rj[0] : rj[1]);
            const bool mine = (m > mo) || (m == mo && jb < jo);
            const float mw = mine ? m : mo; const int jw = mine ? jb : jo;
            if (mw > -INFINITY) { selmask |= 1u << jw;
#pragma unroll
                for (int r = 0; r < 16; ++r) if ((r & 3) + 8 * (r >> 2) + 4 * hi == jw) v[r] = -INFINITY; }
        }
    }
    return selmask;
}
__device__ __forceinline__ void moba_gate_phase(const AttnPtrs& P, int vcu, int G, int tid) {
    const int lane = tid & 63, r32 = lane & 31, hi = lane >> 5; const int wid = __builtin_amdgcn_readfirstlane(tid >> 6);
    for (int task = vcu * 8 + wid; task < 8192; task += G * 8) { const int w = task & 7, i = (task >> 3) & 31, bh = task >> 8; const int qpos = 256 * i + 32 * w + r32;
        const bf16* QA = P.qkv + ((size_t)bh * SEQ) * 64;
        bf16x8 qr[4];
#pragma unroll
        for (int d0 = 0; d0 < 4; ++d0) qr[d0] = *(const bf16x8*)(QA + (size_t)qpos * 64 + d0 * 16 + hi * 8);
        const unsigned m = moba_gate32(P, bh >> 3, bh & 7, i, qr, r32, hi);
        if (hi == 0) P.selg[(size_t)bh * SEQ + qpos] = m; }
}
__device__ __forceinline__ void moba_lut(const Ctx& c, const AttnPtrs& P, int h) {
    LAS float* lut = (LAS float*)(c.lds + LDS_LUT);
    if (threadIdx.x < 115) lut[threadIdx.x] = (threadIdx.x == 0) ? -INFINITY : (P.rel_bias[t5_bucket(threadIdx.x - 1) * 16 + h] - P.rel_bias[31 * 16 + h]) * LOG2E;
}
__device__ __forceinline__ void moba_past_item(const Ctx& c, const AttnPtrs& P, int b, int h, int j) {
    const int bh = b * 8 + h, tid = threadIdx.x;
    const bf16* QA = P.qkv + ((size_t)bh * SEQ) * 64; const bf16* KA = QA + QKV_BIG + (size_t)256 * j * 64; const bf16* VA = QA + 2 * QKV_BIG + (size_t)256 * j * 64;
    moba_lut(c, P, h);
    const LAS float* lut = (const LAS float*)(c.lds + LDS_LUT);
    { const int lane = fresh_lane(); const unsigned lds0 = (unsigned)(uintptr_t)c.lds;
      const bf16* ks = KA + ((8 * c.wid + (lane >> 3)) * 64 + (((lane & 7) ^ (((8 * c.wid + (lane >> 3)) >> 1) & 7)) << 3)); const bf16* vs = VA + ((16 * (c.wid & 3) + (lane >> 2)) * 64 + (c.wid >> 2) * 32 + (lane & 3) * 8);
#pragma unroll
      for (int tt = 0; tt < 4; ++tt) { glds16(ks + tt * 4096, (unsigned)__builtin_amdgcn_readfirstlane(lds0 + c.wid * 1024 + tt * SLOT)); glds16(vs + tt * 4096, (unsigned)__builtin_amdgcn_readfirstlane(lds0 + 8192 + c.wid * 1024 + tt * SLOT)); } }
    LAS unsigned short* list = (LAS unsigned short*)(c.lds + LDS_IMP);
    LAS unsigned* wcnt = (LAS unsigned*)(c.lds + LDS_MISC) + 8;
    const unsigned* sg = P.selg + (size_t)bh * SEQ;
    if (tid < 256) list[tid] = (unsigned short)((256 * j + tid) | (3 << 13));
    int total = 256;
    for (int base = (j + 1) * 256; base < SEQ; base += 512) {
        const int q = base + tid; const unsigned m = (q < SEQ) ? sg[q] : 0u; const bool sel = (m >> j) & 1u;
        const unsigned long long bal = __ballot(sel);
        if ((tid & 63) == 0) wcnt[c.wid] = (unsigned)__popcll(bal);
        asm volatile("s_waitcnt vmcnt(0) lgkmcnt(0)\n\ts_barrier" ::: "memory");
        int off = total, tot = 0;
#pragma unroll
        for (int w = 0; w < 8; ++w) { const int v = (int)wcnt[w]; off += (w < c.wid) ? v : 0; tot += v; }
        if (sel) list[off + __popcll(bal & ((1ull << (tid & 63)) - 1ull))] = (unsigned short)(q | (__popc(m & ((1u << j) - 1u)) << 13));
        total += tot;
        asm volatile("s_waitcnt lgkmcnt(0)\n\ts_barrier" ::: "memory");
    }
    total = __builtin_amdgcn_readfirstlane(total);
    { const int npad = (32 - (total & 31)) & 31; if (tid < npad) list[total + tid] = 0xFFFFu; }
    const int nchunks = (total + 31) >> 5;
    asm volatile("s_waitcnt vmcnt(0) lgkmcnt(0)\n\ts_barrier" ::: "memory");
    for (int ch = c.wid; ch < nchunks; ch += 8) {
        const int lane = fresh_lane(), r32 = lane & 31, hi = lane >> 5;
        const lds_cptr kp0 = (lds_cptr)c.lds + r32 * 128;
        const lds_cptr vp0 = (lds_cptr)c.lds + 8192 + ((lane >> 4) & 1) * 32 + (lane & 3) * 8 + (4 * hi + ((lane & 15) >> 2)) * 64;
        const unsigned e = list[32 * ch + r32]; const bool valid = e != 0xFFFFu; const int q = valid ? (int)(e & 0x1FFFu) : SEQ - 1;
        bf16x8 qr[4];
#pragma unroll
        for (int d0 = 0; d0 < 4; ++d0) qr[d0] = *(const bf16x8*)(QA + (size_t)q * 64 + d0 * 16 + hi * 8);
        asm volatile("" : "+v"(qr[0]), "+v"(qr[1]), "+v"(qr[2]), "+v"(qr[3]));
        const bool anynear = __any(valid && (unsigned)((q >> 8) - j) <= 1u);
        f32x16 o[2]; o[0] = f32x16{}; o[1] = f32x16{}; float l_reg = 0.f;
#pragma unroll 1
        for (int tt = 0; tt < 4; ++tt) { f32x16 s0, s1; qk_tile(s0, s1, kp0 + tt * SLOT, qr);
            if (anynear) hook_near(s0, s1, q - (256 * j + 64 * tt) - 4 * hi, lut); else hook_exp(s0, s1);
            l_reg += rowsum32(s0, s1);
            pv_tile<false>(o, vp0 + tt * SLOT, s0, s1, 0u); }
        const float L = pair_sum(l_reg);
        if (hi == 0 && valid) P.part_l[((size_t)bh * SEQ + q) * 4 + (e >> 13)] = L;
        LAS bf16* stg = (LAS bf16*)(c.lds + LDS_OST) + c.wid * 2048;
#pragma unroll
        for (int r = 0; r < 16; ++r) { const int orow = (r & 3) + 8 * (r >> 2) + 4 * hi;
#pragma unroll
            for (int d0 = 0; d0 < 2; ++d0) stg[orow * 64 + d0 * 32 + r32] = (bf16)f2bf(o[d0][r]); }
        asm volatile("s_waitcnt lgkmcnt(0)" ::: "memory");
#pragma unroll
        for (int it = 0; it < 4; ++it) { const int row = it * 8 + (lane >> 3), chn = lane & 7; const unsigned e2 = list[32 * ch + row];
            const u32x4 v = *(const LAS u32x4*)(stg + row * 64 + chn * 8);
            if (e2 != 0xFFFFu) *(u32x4*)(P.part_o + (((size_t)bh * SEQ + (e2 & 0x1FFFu)) * 4 + (e2 >> 13)) * 64 + chn * 8) = v; }
        asm volatile("s_waitcnt lgkmcnt(0)" ::: "memory");
    }
    asm volatile("s_waitcnt lgkmcnt(0)\n\ts_barrier" ::: "memory");
}
__device__ __forceinline__ void moba_merge_pass(const AttnPtrs& P, int vcu, int G, int tid) {
    const int lane = tid & 63, h = lane >> 3, chn = lane & 7; const int wid = __builtin_amdgcn_readfirstlane(tid >> 6);
#pragma unroll 2
    for (int tok = vcu * 8 + wid; tok < TOK; tok += G * 8) { const int b = tok >> 13, q = tok & (SEQ - 1);
        const size_t qi = (size_t)(b * 8 + h) * SEQ + q; const int ns = __popc(P.selg[qi]);
        float Lt = P.part_l[qi * 4 + 3]; const u32x4 pw = *(const u32x4*)(P.part_o + (qi * 4 + 3) * 64 + chn * 8);
        f32x4 a0 = {__uint_as_float(pw.x << 16), __uint_as_float(pw.x & 0xffff0000u), __uint_as_float(pw.y << 16), __uint_as_float(pw.y & 0xffff0000u)};
        f32x4 a1 = {__uint_as_float(pw.z << 16), __uint_as_float(pw.z & 0xffff0000u), __uint_as_float(pw.w << 16), __uint_as_float(pw.w & 0xffff0000u)};
#pragma unroll
        for (int sidx = 0; sidx < 3; ++sidx) if (sidx < ns) { Lt += P.part_l[qi * 4 + sidx]; const u32x4 pv = *(const u32x4*)(P.part_o + (qi * 4 + sidx) * 64 + chn * 8);
            a0 += (f32x4){__uint_as_float(pv.x << 16), __uint_as_float(pv.x & 0xffff0000u), __uint_as_float(pv.y << 16), __uint_as_float(pv.y & 0xffff0000u)};
            a1 += (f32x4){__uint_as_float(pv.z << 16), __uint_as_float(pv.z & 0xffff0000u), __uint_as_float(pv.w << 16), __uint_as_float(pv.w & 0xffff0000u)}; }
        const float inv = 1.f / Lt; a0 *= inv; a1 *= inv;
        const u32x4 w = {cvtpk(a0[0], a0[1]), cvtpk(a0[2], a0[3]), cvtpk(a1[0], a1[1]), cvtpk(a1[2], a1[3])};
        *(u32x4*)(P.mix + (size_t)tok * DM + h * 64 + chn * 8) = w; }
}

__device__ __forceinline__ void nsa_item(const Ctx& c, const AttnPtrs& P, int b, int g, int ci, int flags = 0) {
    const int ql = 8 * c.wid + (c.r32 >> 2), rh = c.r32 & 3, qpos = 64 * ci + ql, hb = 4 * g + rh;
    const int qw0 = 64 * ci + 8 * c.wid;
    const bf16* QB = P.qkv + 3 * QKV_BIG + ((size_t)(b * 8 + hb) * SEQ) * 64;
    const bf16* KS = P.qkv + 4 * QKV_BIG + 2 * QKV_SMALL + ((size_t)(b * 2 + g) * SEQ) * 64; const bf16* VS = KS + QKV_SMALL; const bf16* KW = KS + 2 * QKV_SMALL; const bf16* VW = KS + 3 * QKV_SMALL;
    const bf16* KC = P.kcmp + (size_t)(b * 2 + g) * 512 * 64; const bf16* VC = P.vcmp + (size_t)(b * 2 + g) * 512 * 64;
    bf16x8 qr[4];
#pragma unroll
    for (int d0 = 0; d0 < 4; ++d0) qr[d0] = *(const bf16x8*)(QB + (size_t)qpos * 64 + d0 * 16 + c.hi * 8);
    const float* gp = P.gates + ((size_t)b * SEQ + qpos) * 24 + hb * 3; float g0 = gp[0], g1 = gp[1], g2 = gp[2];
    asm volatile("" : "+v"(qr[0]), "+v"(qr[1]), "+v"(qr[2]), "+v"(qr[3]), "+v"(g0), "+v"(g1), "+v"(g2));
    LAS float* lutall = (LAS float*)(c.lds + LDS_LUT);
    if (threadIdx.x < 460) { const int hh = threadIdx.x / 115, d = threadIdx.x % 115; lutall[hh * 128 + d] = (d == 0) ? -INFINITY : (P.rel_bias[t5_bucket(d - 1) * 16 + 8 + 4 * g + hh] - P.rel_bias[31 * 16 + 8 + 4 * g + hh]) * LOG2E; }
    const LAS float* lut = lutall + rh * 128;
    LAS float* imp = (LAS float*)(c.lds + LDS_IMP);
    LAS unsigned* selm = (LAS unsigned*)(c.lds + LDS_SELM);
    f32x16 o[2]; float l_reg; float fr[16];
    LAS float* park = (LAS float*)(c.lds + LDS_OST) + c.wid * 1024 + c.lane;
    LAS float* park1 = (LAS float*)(c.lds + LDS_IMP) + c.wid * 1024 + c.lane;
    const int nct = (4 * ci + 3 + 63) >> 6;
    const int nlim = (qpos >= 31) ? ((qpos - 31) >> 4) : -1;
    l_reg = 0.f;
    if (!(flags & 16)) run_stream<false>(c, KC, VC, 0, nct,
        [&](int t, lds_cptr kp, f32x16& s0, f32x16& s1) { qk_tile(s0, s1, kp, qr); },
        [&](int t, lds_cptr vp, f32x16& s0, f32x16& s1) { hook_cmp(s0, s1, nlim - 64 * t - 4 * c.hi, 0.f); l_reg += rowsum32(s0, s1); });
    const float Lc = pair_sum(l_reg); const float cbn = Lc > 0.f ? -__builtin_amdgcn_logf(Lc) : -INFINITY;
    o[0] = f32x16{}; o[1] = f32x16{};
    {
        float carry = 0.f;
        if (!(flags & 32)) run_stream<true>(c, KC, VC, 0, nct,
          [&](int t, lds_cptr kp, f32x16& s0, f32x16& s1) { qk_tile(s0, s1, kp, qr); },
          [&](int t, lds_cptr vp, f32x16& s0, f32x16& s1) {
            hook_cmp(s0, s1, nlim - 64 * t - 4 * c.hi, cbn);
#pragma unroll
            for (int half = 0; half < 2; ++half) {
                float g4[4], e[4];
#pragma unroll
                for (int a = 0; a < 4; ++a) { const float x0 = half ? s1[4 * a] : s0[4 * a], x1 = half ? s1[4 * a + 1] : s0[4 * a + 1], x2 = half ? s1[4 * a + 2] : s0[4 * a + 2], x3 = half ? s1[4 * a + 3] : s0[4 * a + 3];
                    float gs = (x0 + x1) + (x2 + x3), es = x3;
                    gs += __shfl_xor(gs, 1); gs += __shfl_xor(gs, 2); es += __shfl_xor(es, 1); es += __shfl_xor(es, 2);
                    g4[a] = gs; e[a] = es; }
                float x[4];
#pragma unroll
                for (int a = 0; a < 4; ++a) { auto rr = __builtin_amdgcn_permlane32_swap(__float_as_uint(e[a]), __float_as_uint(e[a]), false, false); x[a] = __uint_as_float(c.hi ? rr[0] : rr[1]); }
                const int jb = 16 * t + 8 * half;
                float iv[4];
                if (c.hi) {
#pragma unroll
                    for (int a = 0; a < 4; ++a) iv[a] = g4[a] + x[a]; }
                else { iv[0] = g4[0] + carry; iv[1] = g4[1] + x[0]; iv[2] = g4[2] + x[1]; iv[3] = g4[3] + x[2]; carry = x[3]; }
                if (rh == 0) {
#pragma unroll
                    for (int a = 0; a < 4; ++a) imp[ql * 128 + jb + 2 * a + c.hi] = iv[a]; }
            }
            pv_tile<false>(o, vp, s0, s1, 0u);
        });
    }
    {
        asm volatile("s_waitcnt lgkmcnt(0)\n\ts_barrier" ::: "memory");
        const int qq = 8 * c.wid + (c.lane >> 3), cc = c.lane & 7;
        unsigned m0 = 0u, m1 = 0u, m2w = 0u, m3 = 0u;
        if (ci <= 15) { m0 = (ci == 31) ? 0xffffffffu : ((2u << ci) - 1u); }
        else {
            float v[16];
#pragma unroll
            for (int k = 0; k < 16; ++k) { const int j = cc + 8 * k; v[k] = (j >= 1 && j <= ci - 2) ? imp[qq * 128 + j] : -INFINITY; }
            for (int it = 0; it < 13; ++it) {
                float m = v[0]; int jb = cc;
#pragma unroll
                for (int k = 1; k < 16; ++k) if (v[k] > m) { m = v[k]; jb = cc + 8 * k; }
#pragma unroll
                for (int sft = 1; sft < 8; sft <<= 1) { const float mo = __shfl_xor(m, sft); const int jo = __shfl_xor(jb, sft); if (mo > m || (mo == m && jo < jb)) { m = mo; jb = jo; } }
                if (m > -INFINITY) { const unsigned bit = 1u << (jb & 31); const int wsel = jb >> 5;
                    m0 |= (wsel == 0) ? bit : 0u; m1 |= (wsel == 1) ? bit : 0u; m2w |= (wsel == 2) ? bit : 0u; m3 |= (wsel == 3) ? bit : 0u;
#pragma unroll
                    for (int k = 0; k < 16; ++k) if (cc + 8 * k == jb) v[k] = -INFINITY; }
            }
            m0 |= 1u;
#pragma unroll
            for (int z = 0; z < 2; ++z) { const int jf = ci - z; const unsigned bit = 1u << (jf & 31); const int wsel = jf >> 5;
                m0 |= (wsel == 0) ? bit : 0u; m1 |= (wsel == 1) ? bit : 0u; m2w |= (wsel == 2) ? bit : 0u; m3 |= (wsel == 3) ? bit : 0u; }
        }
        if (cc == 0) { selm[qq * 4 + 0] = m0; selm[qq * 4 + 1] = m1; selm[qq * 4 + 2] = m2w; selm[qq * 4 + 3] = m3; }
        asm volatile("s_waitcnt lgkmcnt(0)\n\ts_barrier" ::: "memory");
    }
    row_factors(c, g0, fr);
#pragma unroll
    for (int r = 0; r < 16; ++r) { park[r * 64] = o[0][r] * fr[r]; park1[r * 64] = o[1][r] * fr[r]; }
    {
        const unsigned w0 = selm[ql * 4 + 0], w1 = selm[ql * 4 + 1], w2 = selm[ql * 4 + 2], w3 = selm[ql * 4 + 3];
        o[0] = f32x16{}; o[1] = f32x16{}; l_reg = 0.f;
        auto sel_pred = [&](int t) -> bool { const unsigned wsel = (t < 32) ? w0 : (t < 64) ? w1 : (t < 96) ? w2 : w3; return (wsel >> (t & 31)) & 1u; };
        auto sel_one = [&](int t, lds_cptr kp, lds_cptr vp) { const bool pred = sel_pred(t); if (!__any(pred)) return; const int key0 = 64 * t;
            f32x16 s0, s1; qk_tile(s0, s1, kp, qr);
            if (qw0 - key0 - 63 >= 113) { hook_exp(s0, s1); const float rs = rowsum32(s0, s1); l_reg += pred ? rs : 0.f;
                if (__all(pred)) pv_tile<false>(o, vp, s0, s1, 0u); else pv_tile<true>(o, vp, s0, s1, pred ? 0xffffffffu : 0u); }
            else { hook_near(s0, s1, qpos - key0 - 4 * c.hi, lut); const float rs = rowsum32(s0, s1); l_reg += pred ? rs : 0.f;
                if (__all(pred)) pv_tile<false>(o, vp, s0, s1, 0u); else pv_tile<true>(o, vp, s0, s1, pred ? 0xffffffffu : 0u); } };
        if (!(flags & 4)) run_stream_pairs(c, KS, VS, 0, ci + 1, sel_one,
            [&](int t, lds_cptr kpA, lds_cptr vpA, lds_cptr kpB, lds_cptr vpB) {
                if (qw0 - 64 * (t + 1) - 63 >= 113) {
                    const bool pa = sel_pred(t), pb = sel_pred(t + 1);
                    const bool xa = __any(pa), xb = __any(pb);
                    if (!xa && !xb) return;
                    if (!xb) { sel_one(t, kpA, vpA); return; }
                    if (!xa) { sel_one(t + 1, kpB, vpB); return; }
                    KF kA, kB; ld_k(kA, kpA); ATT_SB();
                    f32x16 a0, a1, b0, b1; qk_mfma(a0, a1, kA, qr); ATT_SB();
                    VF vA, vB; ld_k(kB, kpB); ld_v(vA, vpA); ATT_SB();
                    qk_mfma(b0, b1, kB, qr); hook_exp(a0, a1);
                    const float ra = rowsum32(a0, a1); const PW4 wa = pack4(a0, a1, pa ? 0xffffffffu : 0u); ATT_SB();
                    ld_v(vB, vpB); ATT_SB();
                    pv_mfma(o, vA, wa); hook_exp(b0, b1);
                    const float rb = rowsum32(b0, b1); const PW4 wb = pack4(b0, b1, pb ? 0xffffffffu : 0u); l_reg += (pa ? ra : 0.f) + (pb ? rb : 0.f); ATT_SB();
                    pv_mfma(o, vB, wb);
                } else { sel_one(t, kpA, vpA); sel_one(t + 1, kpB, vpB); } });
        const float Ls = pair_sum(l_reg);
        row_factors(c, g1 / Ls, fr);
#pragma unroll
        for (int r = 0; r < 16; ++r) { park[r * 64] += o[0][r] * fr[r]; park1[r * 64] += o[1][r] * fr[r]; }
    }
    {
        o[0] = f32x16{}; o[1] = f32x16{}; l_reg = 0.f;
        if (!(flags & 8)) run_stream<true>(c, KW, VW, ci >= 8 ? ci - 8 : 0, ci + 1,
            [&](int t, lds_cptr kp, f32x16& s0, f32x16& s1) { qk_tile(s0, s1, kp, qr); },
            [&](int t, lds_cptr vp, f32x16& s0, f32x16& s1) { const int key0 = 64 * t;
                if (qw0 - key0 - 63 < 113) hook_near(s0, s1, qpos - key0 - 4 * c.hi, lut); else if (qw0 + 7 - key0 >= 512) hook_edge(s0, s1, qpos - key0 - 4 * c.hi, 512); else hook_exp(s0, s1);
                l_reg += rowsum32(s0, s1);
                pv_tile<false>(o, vp, s0, s1, 0u); });
        const float Lw = pair_sum(l_reg);
        row_factors(c, g2 / Lw, fr);
#pragma unroll
        for (int r = 0; r < 16; ++r) { o[0][r] = park[r * 64] + o[0][r] * fr[r]; o[1][r] = park1[r * 64] + o[1][r] * fr[r]; }
        asm volatile("s_waitcnt lgkmcnt(0)" ::: "memory");
    }
    bf16* dst = P.mix + ((size_t)b * SEQ + 64 * ci + 8 * c.wid) * DM + 512 + g * 256;
    store_rows(c, o, dst, [](int row) { return (size_t)(row >> 2) * DM + (row & 3) * 64; });
    asm volatile("s_waitcnt lgkmcnt(0)\n\ts_barrier" ::: "memory");
}

__device__ __forceinline__ void attn_phase(LAS unsigned char* lds, const AttnPtrs& P, unsigned* qcounter, int flags) {
    Ctx c = make_ctx(lds, threadIdx.x);
    LAS unsigned* misc = (LAS unsigned*)(c.lds + LDS_MISC);
    for (;;) {
        if (threadIdx.x == 0) misc[0] = __hip_atomic_fetch_add(qcounter, 1u, __ATOMIC_RELAXED, __HIP_MEMORY_SCOPE_AGENT);
        asm volatile("s_waitcnt vmcnt(0) lgkmcnt(0)\n\ts_barrier" ::: "memory");
        const unsigned k = misc[0];
        asm volatile("s_waitcnt lgkmcnt(0)\n\ts_barrier" ::: "memory");
        if (k >= 2048u) break;
        const bool is_mp = k >= 512u && k < 1536u;
        if (flags & (is_mp ? 2 : 1)) continue;
        if (k < 512u) { const int s_ = 127 - (int)(k >> 3), bg = k & 7; nsa_item(c, P, bg >> 1, bg & 1, s_, flags); }
        else if (k < 1536u) { const int kk = (int)k - 512, j = kk >> 5, bh = kk & 31; moba_past_item(c, P, bh >> 3, bh & 7, j); }
        else { const int kk = (int)k - 1536; const int s_ = 63 - (kk >> 3), bg = kk & 7; nsa_item(c, P, bg >> 1, bg & 1, s_, flags); }
    }
}
#undef MFMA32
#undef ATT_WAIT_BAR
}
namespace cmpr {
using bf16x8 = __attribute__((ext_vector_type(8))) short;
using f32x16 = __attribute__((ext_vector_type(16))) float;
constexpr int HID_PITCH = 528;
__device__ __forceinline__ float gelu_tanh(float v) { const float u = fminf(fmaxf(0.7978845608028654f * (v + 0.044715f * v * v * v), -15.f), 15.f); const float e = __expf(2.f * u); return 0.5f * v * (1.f + (e - 1.f) / (e + 1.f)); }
__device__ __forceinline__ void compress_unit(LAS unsigned char* lds, int unit, const bf16* qkv, const bf16* w1k, const bf16* w1v, const bf16* w2k, const bf16* w2v, const float* cbp, const float* kncmp, bf16* kcmp, bf16* vcmp) {
    const int tid = threadIdx.x, lane = tid & 63, r32 = lane & 31, hi = lane >> 5; const int wid = __builtin_amdgcn_readfirstlane(tid >> 6);
    const int kv = unit & 1, u = (unit >> 1) & 15, bg = unit >> 5;
    const bf16* src = qkv + 4 * QKV_BIG + (kv ? QKV_SMALL : 0) + (size_t)bg * SEQ * 64;
    const bf16* w1 = kv ? w1v : w1k; const bf16* w2 = kv ? w2v : w2k;
    const int n0 = 32 * u;
    { const bf16* sp = src + (size_t)16 * n0 * 64;
      for (int ch = tid; ch < 4224; ch += NTHREADS) { v4u v = {0u, 0u, 0u, 0u}; if (16 * n0 + (ch >> 3) < SEQ) v = *(const GAS v4u*)(sp + (size_t)ch * 8);
          *(LAS v4u*)(lds + ((ch ^ ((ch >> 7) & 15)) << 4)) = v; } }
    asm volatile("s_waitcnt vmcnt(0) lgkmcnt(0)\n\ts_barrier" ::: "memory");
    const bf16* bp = w1 + ((size_t)wid * 64 + lane) * 8;
    f32x16 acc = {};
#pragma unroll 8
    for (int kk = 0; kk < 128; ++kk) { const int lc = r32 * 128 + 2 * kk + hi; const bf16x8 a = *(const LAS bf16x8*)(lds + ((lc ^ ((lc >> 7) & 15)) << 4)), bfr = *(const bf16x8*)(bp + (size_t)kk * 4096); acc = __builtin_amdgcn_mfma_f32_32x32x16_bf16(a, bfr, acc, 0, 0, 0); }
    float cb = 0.f;
#pragma unroll 8
    for (int ic = 0; ic < 32; ++ic) cb += cbp[(ic * 2 + kv) * 256 + 32 * wid + r32];
    LAS unsigned char* hidL = lds + 69632;
#pragma unroll
    for (int r = 0; r < 16; ++r) { const int n = (r & 3) + 8 * (r >> 2) + 4 * hi; *(LAS bf16*)(hidL + n * HID_PITCH + (32 * wid + r32) * 2) = (bf16)f2bf(gelu_tanh(acc[r] + cb)); }
    asm volatile("s_waitcnt lgkmcnt(0)\n\ts_barrier" ::: "memory");
    if (wid == 0) {
        f32x16 o0 = {}, o1 = {};
#pragma unroll 4
        for (int kk = 0; kk < 16; ++kk) { const bf16x8 hb = *(const LAS bf16x8*)(hidL + r32 * HID_PITCH + (16 * kk + 8 * hi) * 2);
            const bf16x8 a0 = *(const bf16x8*)(w2 + (size_t)r32 * 256 + 16 * kk + 8 * hi), a1 = *(const bf16x8*)(w2 + (size_t)(32 + r32) * 256 + 16 * kk + 8 * hi);
            o0 = __builtin_amdgcn_mfma_f32_32x32x16_bf16(a0, hb, o0, 0, 0, 0); o1 = __builtin_amdgcn_mfma_f32_32x32x16_bf16(a1, hb, o1, 0, 0, 0); }
        float rs = 1.f;
        if (!kv) { float ss = 0.f;
#pragma unroll
            for (int r = 0; r < 16; ++r) ss += o0[r] * o0[r] + o1[r] * o1[r];
            auto rr = __builtin_amdgcn_permlane32_swap(__float_as_uint(ss), __float_as_uint(ss), false, false); ss = __uint_as_float(rr[0]) + __uint_as_float(rr[1]);
            rs = rsqrtf(ss * (1.f / 64.f) + 1e-6f); }
        const int n = n0 + r32; bf16* dst = (kv ? vcmp : kcmp) + ((size_t)bg * 512 + n) * 64;
#pragma unroll
        for (int r = 0; r < 16; ++r) { const int d = (r & 3) + 8 * (r >> 2) + 4 * hi;
            float v0 = o0[r] * rs, v1 = o1[r] * rs; if (!kv) { v0 *= kncmp[d]; v1 *= kncmp[d + 32]; }
            if (n >= NCMP) { v0 = 0.f; v1 = 0.f; }
            dst[d] = (bf16)f2bf(v0); dst[d + 32] = (bf16)f2bf(v1); }
    }
    asm volatile("s_waitcnt lgkmcnt(0)\n\ts_barrier" ::: "memory");
}
}
__global__ void __launch_bounds__(NTHREADS, 2) mk_fwd(Args a) {
    extern __shared__ __attribute__((aligned(16))) unsigned char lds[];
    Frame F;
    F.lds = (LAS unsigned char*)lds;
    F.tid = threadIdx.x; F.lane = F.tid & 63; F.wave = __builtin_amdgcn_readfirstlane(F.tid >> 6);
    F.G = gridDim.x; { const int bx = blockIdx.x; F.vcu = (F.G % 8 == 0) ? (bx % 8) * (F.G / 8) + bx / 8 : bx; }
    cg::grid_group grid = cg::this_grid();
    volatile LAS unsigned* xst = (volatile LAS unsigned*)(F.lds + 147424);
    if (F.tid < 8) xst[F.tid] = 0u;
    __syncthreads();
    const XcdBarrier xbar = xcd_barrier_post((unsigned*)(a.ws + WS_CTL) + 4096, xst);
    unsigned char* ws = a.ws;
    const int lo = a.ph_lo, hi = a.ph_hi;
    const att::AttnPtrs P{(const bf16*)(ws + WS_QKV), (const float*)(ws + WS_KMP), (const float*)(ws + WS_GATES), (const bf16*)(ws + WS_KCMP), (const bf16*)(ws + WS_VCMP), a.in[2], (bf16*)(ws + WS_MIX),
                          (unsigned*)(ws + WS_SELG), (bf16*)(ws + WS_PARTO), (float*)(ws + WS_PARTL)};
#define IN(k) (lo <= (k) && (k) < hi)
#define SEAM(k) do { if (IN(k) && IN((k) + 1)) { if ((k) == 0) grid.sync(); else xcd_barrier(xbar); } } while (0)
    if (IN(0)) { phase_prologue_a(F, a); } SEAM(0);
    if (IN(1)) { phase_prologue_b(F, a); } SEAM(1);
    if (IN(2)) {
        pg8::Gemm g{(const pg8::bf16_t*)(ws + WS_H), (const pg8::bf16_t*)(ws + WS_WIN), TOK, NIN_PAD, DM}; pg8::StaticOrder S; S.init(TOK, NIN_PAD, F.G, (int)blockIdx.x);
        pg8::EpiInProj E{(pg8::bf16_t*)(ws + WS_QKV), (float*)(ws + WS_GATES), (float*)(ws + WS_KMP), a.in[7], a.in[8], a.in[9], a.in[11], a.in[12]};
        pg8::gemm_phase<pg8::EpiInProj, pg8::StaticOrder, true, true>(F.lds, g, S, E);
    } SEAM(2);
    if (IN(3)) {
        att::moba_gate_phase(P, F.vcu, F.G, F.tid);
        for (int unit = F.vcu; unit < 256; unit += F.G)
            cmpr::compress_unit(F.lds, unit, (const bf16*)(ws + WS_QKV), (const bf16*)(ws + WS_W1K), (const bf16*)(ws + WS_W1V), (const bf16*)(ws + WS_W2K), (const bf16*)(ws + WS_W2V),
                                (const float*)(ws + WS_CBP), a.in[10], (bf16*)(ws + WS_KCMP), (bf16*)(ws + WS_VCMP));
    } SEAM(3);
    if (IN(4)) {
                att::attn_phase(F.lds, P, (unsigned*)(ws + WS_CTL) + 64, a.flags);
    } SEAM(4);
    if (IN(5)) { att::moba_merge_pass(P, F.vcu, F.G, F.tid); } SEAM(5);
    if (IN(6)) {
        pg8::Gemm g{(const pg8::bf16_t*)(ws + WS_MIX), (const pg8::bf16_t*)(ws + WS_WOUT), TOK, DM, DM}; pg8::StaticOrder S; S.init(TOK, DM, F.G, (int)blockIdx.x);
        pg8::EpiOutProj E{a.in[0], a.out, (const float*)(ws + WS_MOD) + 2 * DM};
        pg8::gemm_phase<pg8::EpiOutProj, pg8::StaticOrder, true, true>(F.lds, g, S, E);
    } SEAM(6);
    if (IN(7)) { phase_norm2(F, a); } SEAM(7);
    if (IN(8)) {
        pg8::Gemm g{(const pg8::bf16_t*)(ws + WS_H), (const pg8::bf16_t*)(ws + WS_WGU), TOK, 2 * FF, DM}; pg8::StaticOrder S; S.init(TOK, 2 * FF, F.G, (int)blockIdx.x);
        pg8::EpiGateUp E{(pg8::bf16_t*)(ws + WS_ACT)};
        pg8::gemm_phase<pg8::EpiGateUp, pg8::StaticOrder, true, true>(F.lds, g, S, E);
    } SEAM(8);
    if (IN(9)) {
        pg8::Gemm g{(const pg8::bf16_t*)(ws + WS_ACT), (const pg8::bf16_t*)(ws + WS_WDN), TOK, DM, FF}; pg8::StaticOrder S; S.init(TOK, DM, F.G, (int)blockIdx.x);
        pg8::EpiDown E{a.out, (const float*)(ws + WS_MOD) + 5 * DM};
        pg8::gemm_phase<pg8::EpiDown, pg8::StaticOrder, true, true>(F.lds, g, S, E);
    }
#undef IN
#undef SEAM
}

static void launch_phases(const Args& base, int lo, int hi, int grid, hipStream_t stream, int flags = 0) {
    Args a = base; a.ph_lo = lo; a.ph_hi = hi; a.flags = flags;
    if (hi - lo > 1) { void* args[] = {&a}; (void)hipLaunchCooperativeKernel((const void*)mk_fwd, dim3(grid), dim3(NTHREADS), args, LDS_BYTES, stream); }
    else hipLaunchKernelGGL(mk_fwd, dim3(grid), dim3(NTHREADS), LDS_BYTES, stream, a);
}
extern "C" void kernel_launch(void* const* d_in, const int* in_sizes, int n_in, void* d_out, int out_size, void* d_ws, size_t ws_size, hipStream_t stream) {
    static int grid = 0;
    if (grid == 0) {
        int dev = 0, cus = 0, per_cu = 0;
        if (n_in != 23 || ws_size < 480 * MiB || hipGetDevice(&dev) != hipSuccess || hipDeviceGetAttribute(&cus, hipDeviceAttributeMultiprocessorCount, dev) != hipSuccess) { grid = -1; return; }
        if (hipFuncSetAttribute((const void*)mk_fwd, hipFuncAttributeMaxDynamicSharedMemorySize, LDS_BYTES) != hipSuccess) { grid = -1; return; }
        if (hipOccupancyMaxActiveBlocksPerMultiprocessor(&per_cu, (const void*)mk_fwd, NTHREADS, LDS_BYTES) != hipSuccess || per_cu < 1) { grid = -1; return; }
        grid = cus;
    }
    if (grid < 0) return;
    (void)hipMemsetAsync((char*)d_ws + WS_CTL, 0, CTL_ZERO_BYTES, stream);
    Args a{};
    for (int i = 0; i < 23; ++i) a.in[i] = (const float*)d_in[i];
    a.out = (float*)d_out; a.ws = (unsigned char*)d_ws;
    unsigned char* ws = (unsigned char*)d_ws;
#if HYBRID == 1
    launch_phases(a, 0, 1, grid, stream); launch_phases(a, 1, 2, grid, stream); launch_phases(a, 2, 3, grid, stream);
    const bf16* qkv = (const bf16*)(ws + WS_QKV); bf16* mix = (bf16*)(ws + WS_MIX); bf16* kcmp = (bf16*)(ws + WS_KCMP); bf16* vcmp = (bf16*)(ws + WS_VCMP);
    int* sel = (int*)(ws + 344 * MiB); float* obuf = (float*)(ws + 348 * MiB); const float* gates = (const float*)(ws + WS_GATES);
    nq::k_compress<<<dim3(4 * 2 * 512, 2), 256, 0, stream>>>(qkv, a.in[13], a.in[14], a.in[15], a.in[16], a.in[17], a.in[18], a.in[10], kcmp, vcmp);
    nq::k_moba<<<4 * 8 * SEQ / 4, 256, 0, stream>>>(qkv, (const float*)(ws + WS_KMP), a.in[2], mix);
    nq::k_nsa_cmp<<<4 * 2 * SEQ, 256, 0, stream>>>(qkv, kcmp, vcmp, gates, obuf, sel);
    nq::k_nsa_sel<<<4 * 2 * SEQ, 256, 0, stream>>>(qkv, sel, a.in[2], gates, obuf);
    nq::k_nsa_win<<<4 * 2 * SEQ, 256, 0, stream>>>(qkv, a.in[2], gates, obuf, mix);
    launch_phases(a, 5, 6, grid, stream); launch_phases(a, 6, 7, grid, stream); launch_phases(a, 7, 8, grid, stream); launch_phases(a, 8, 9, grid, stream);
#elif HYBRID == 2
    launch_phases(a, 0, 1, grid, stream); launch_phases(a, 1, 2, grid, stream); launch_phases(a, 2, 3, grid, stream);
    nq::k_compress<<<dim3(4 * 2 * 512, 2), 256, 0, stream>>>((const bf16*)(ws + WS_QKV), a.in[13], a.in[14], a.in[15], a.in[16], a.in[17], a.in[18], a.in[10], (bf16*)(ws + WS_KCMP), (bf16*)(ws + WS_VCMP));
    launch_phases(a, 4, 5, grid, stream);
    launch_phases(a, 5, 6, grid, stream); launch_phases(a, 6, 7, grid, stream); launch_phases(a, 7, 8, grid, stream); launch_phases(a, 8, 9, grid, stream);
#elif HYBRID == 3
    for (int p = 0; p < N_PHASES; ++p) {
#if defined(TIME_PHASE)
        if (p == TIME_PHASE) { for (int r = 0; r < TIME_REPS; ++r) { launch_phases(a, p, p + 1, grid, stream, TIME_FLAGS); (void)hipMemsetAsync((char*)d_ws + WS_CTL, 0, CTL_ZERO_BYTES, stream); } }
#endif
        launch_phases(a, p, p + 1, grid, stream);
#if defined(ABL_REPS)
        if (p == 3) { static bool once = false; if (!once) { once = true; (void)hipFuncSetAttribute((const void*)k_attn_abl, hipFuncAttributeMaxDynamicSharedMemorySize, LDS_BYTES); }
            for (int r = 0; r < ABL_REPS; ++r) { (void)hipMemsetAsync((char*)d_ws + WS_CTL + 512, 0, 4, stream); hipLaunchKernelGGL(k_attn_abl, dim3(grid), dim3(NTHREADS), LDS_BYTES, stream, a); } }
#endif
    }
#else
    launch_phases(a, 0, N_PHASES, grid, stream);
#endif
}
```

```cpp
#include <hip/hip_runtime.h>
#include <hip/hip_cooperative_groups.h>
#include <cstdint>
#include <cstdio>
namespace cg = cooperative_groups;
#define HYBRID 0
namespace pg8 {
#define PG8_LAS __attribute__((address_space(3)))
typedef unsigned short bf16_t;
typedef short bf16x8 __attribute__((ext_vector_type(8)));
typedef float f32x4 __attribute__((ext_vector_type(4)));
typedef unsigned u32x4 __attribute__((ext_vector_type(4)));
constexpr int BM = 256, BK = 64, HALF = 128, HTB = HALF * BK * 2  , STAGE_BYTES = 8 * HTB, NXCD = 8, WGM = 8;

__host__ __device__ __forceinline__ int lds_byte(int r, int c) { const int st = (r >> 4) * 2 + (c >> 5), rr = r & 15, cc = c & 31, ob = rr * 64 + cc * 2; return st * 1024 + (ob ^ (((ob >> 9) & 1) << 5)); }
__host__ __device__ __forceinline__ void stage_rc(int b, int& R, int& C) { const int st = b / 1024, sb = b % 1024, swz = sb ^ (((sb >> 9) & 1) << 5); R = (st >> 1) * 16 + swz / 64; C = (st & 1) * 32 + (swz % 64) / 2; }
__host__ __device__ __forceinline__ int perm32(int rho) { const int n = rho >> 4, i = rho & 15; return 8 * (i >> 2) + 4 * n + (i & 3); }

struct Unit { int pm, pn; };
struct Gemm { const bf16_t* A; const bf16_t* Bt; int M, N, K; };

struct StaticOrder {
    int nM, nN, nwg, G, c;
    __host__ __device__ void init(int M, int N, int G_, int c_) { nM = M / BM; nN = N / BM; nwg = nM * nN; G = G_; c = c_; }
    __host__ __device__ bool next(int i, Unit& u) const {
        const long L = (long)i * G + c; if (L >= nwg) return false;
        int wgid = (int)L; { const int q = nwg / NXCD, r = nwg % NXCD, xcd = wgid % NXCD, off = wgid / NXCD; wgid = (xcd < r ? xcd * (q + 1) : r * (q + 1) + (xcd - r) * q) + off; }
        const int nig = WGM * nN, gid = wgid / nig, fm = gid * WGM, gsz = (nM - fm) < WGM ? (nM - fm) : WGM;
        u.pm = fm + ((wgid % nig) % gsz); u.pn = (wgid % nig) / gsz; return true;
    }
    __device__ __forceinline__ void a_ready(const Unit&) const {}
    __device__ __forceinline__ void done(const Unit&) const {}
};

__device__ __forceinline__ unsigned cvt_pk_bf16(float lo, float hi) { unsigned r; asm volatile("v_cvt_pk_bf16_f32 %0, %1, %2" : "=v"(r) : "v"(lo), "v"(hi)); return r; }
typedef float f32x2 __attribute__((ext_vector_type(2)));
template <class Epi, class Sched, bool ALIGN_EPI = false, bool SP2 = false>
__device__ __forceinline__ void gemm_phase(PG8_LAS unsigned char* lds, const Gemm g, const Sched& S, const Epi& E) {
    const int tid = threadIdx.x, wid = __builtin_amdgcn_readfirstlane(tid >> 6), lane = tid & 63, wr = wid >> 2, wc = wid & 3, fr = lane & 15, fq = lane >> 4;
    const int K = g.K, nt = K / BK;
    unsigned voffA[2], voffB[2];
#pragma unroll
    for (int i = 0; i < 2; ++i) { int R, C; stage_rc(tid * 16 + i * 8192, R, C); const int Rb = Epi::PERM ? ((R & ~31) + perm32(R & 31)) : R;
        voffA[i] = (unsigned)(R * K + C) * 2u; voffB[i] = (unsigned)(Rb * K + C) * 2u; }
    const size_t kstep = (size_t)(BK * 2);
    const size_t hstep = (size_t)HALF * K * 2;
    const size_t tstep = 2 * hstep;
    const unsigned ldsw = (unsigned)wid * 1024u;
    const int aoff = lds_byte(wr * 64 + fr, fq * 8), boff = lds_byte(wc * 32 + fr, fq * 8);
#define PG8_SA(b, h) (((b) * 2 + (h)) * HTB)
#define PG8_SB(b, h) ((4 + (b) * 2 + (h)) * HTB)
#define PG8_STAGE(bufoff, gbase, voff) do { _Pragma("unroll") for (int _i = 0; _i < 2; ++_i) \
        __builtin_amdgcn_global_load_lds((const unsigned*)((const char*)(gbase) + (voff)[_i]), (PG8_LAS unsigned*)(lds + (bufoff) + ldsw + _i * 8192), 16, 0, 0); } while (0)
#define PG8_LDA(dst, b, h) do { _Pragma("unroll") for (int m = 0; m < 4; ++m) _Pragma("unroll") for (int k = 0; k < 2; ++k) dst[m][k] = *(const PG8_LAS bf16x8*)(lds + PG8_SA(b, h) + aoff + m * 2048 + k * 1024); } while (0)
#define PG8_LDB(dst, b, h) do { _Pragma("unroll") for (int n = 0; n < 2; ++n) _Pragma("unroll") for (int k = 0; k < 2; ++k) dst[n][k] = *(const PG8_LAS bf16x8*)(lds + PG8_SB(b, h) + boff + n * 2048 + k * 1024); } while (0)
#define PG8_MMA(ai, bj, At, Bt) do { __builtin_amdgcn_s_setprio(1); _Pragma("unroll") for (int m = 0; m < 4; ++m) _Pragma("unroll") for (int n = 0; n < 2; ++n) _Pragma("unroll") for (int k = 0; k < 2; ++k) \
        acc[ai][bj][m][n] = __builtin_amdgcn_mfma_f32_16x16x32_bf16(Bt[n][k], At[m][k], acc[ai][bj][m][n], 0, 0, 0); __builtin_amdgcn_s_setprio(0); } while (0)
#define PG8_WAIT_V(n) asm volatile("s_waitcnt vmcnt(" #n ")" ::: "memory")
#define PG8_WAIT_L(n) asm volatile("s_waitcnt lgkmcnt(" #n ")" ::: "memory")
#define PG8_BAR __builtin_amdgcn_s_barrier()
#define PG8_SCHED __builtin_amdgcn_sched_barrier(0)
    Unit cur, nxt; int ui = 0;
    if (!S.next(0, cur)) return;
    f32x4 acc[2][2][4][2];
#pragma unroll
    for (int a = 0; a < 2; ++a)
#pragma unroll
        for (int b = 0; b < 2; ++b)
#pragma unroll
            for (int m = 0; m < 4; ++m)
#pragma unroll
                for (int n = 0; n < 2; ++n) acc[a][b][m][n] = (f32x4){0.f, 0.f, 0.f, 0.f};
    bf16x8 At[4][2], B0[2][2], B1[2][2];
    const char* cA = (const char*)g.A + (size_t)cur.pm * tstep; const char* cB = (const char*)g.Bt + (size_t)cur.pn * tstep;
    S.a_ready(cur);
    if constexpr (SP2) {
        PG8_STAGE(PG8_SB(0, 0), cB, voffB); PG8_STAGE(PG8_SB(0, 1), cB + hstep, voffB); PG8_STAGE(PG8_SA(0, 0), cA, voffA); PG8_STAGE(PG8_SA(0, 1), cA + hstep, voffA);
        if (wr == 1) PG8_BAR;
        PG8_WAIT_V(2); PG8_BAR;
        PG8_STAGE(PG8_SB(1, 0), cB + kstep, voffB); PG8_STAGE(PG8_SA(1, 0), cA + kstep, voffA); PG8_STAGE(PG8_SB(1, 1), cB + hstep + kstep, voffB);
        PG8_WAIT_V(6); PG8_BAR;
    } else {
        PG8_STAGE(PG8_SB(0, 0), cB, voffB); PG8_STAGE(PG8_SA(0, 0), cA, voffA); PG8_STAGE(PG8_SB(0, 1), cB + hstep, voffB); PG8_STAGE(PG8_SA(0, 1), cA + hstep, voffA);
        if (wr == 1) PG8_BAR;
        PG8_WAIT_V(4); PG8_BAR;
        PG8_STAGE(PG8_SB(1, 0), cB + kstep, voffB); PG8_STAGE(PG8_SA(1, 0), cA + kstep, voffA); PG8_STAGE(PG8_SB(1, 1), cB + hstep + kstep, voffB);
        PG8_WAIT_V(6); PG8_BAR;
    }
    for (;;) {
        const bool has_next = S.next(ui + 1, nxt);
        const char* nA = has_next ? (const char*)g.A + (size_t)nxt.pm * tstep : cA; const char* nB = has_next ? (const char*)g.Bt + (size_t)nxt.pn * tstep : cB;
        for (int t = 0; t < nt; t += 2) {
            const bool last = (t == nt - 2);
            const char* a1 = cA + (size_t)(t + 1) * kstep;
            const char* a2 = last ? nA : cA + (size_t)(t + 2) * kstep; const char* b2 = last ? nB : cB + (size_t)(t + 2) * kstep;
            const char* a3 = a2 + kstep; const char* b3 = b2 + kstep;
            if (last && has_next) S.a_ready(nxt);
            if constexpr (SP2) {
            PG8_LDB(B0, 0, 0); PG8_LDB(B1, 0, 1); PG8_SCHED; PG8_LDA(At, 0, 0); PG8_STAGE(PG8_SA(1, 1), a1 + hstep, voffA);
            PG8_WAIT_V(8); PG8_WAIT_L(0); PG8_BAR; PG8_MMA(0, 0, At, B0); PG8_MMA(0, 1, At, B1); PG8_BAR; PG8_SCHED;
            PG8_LDA(At, 0, 1); PG8_STAGE(PG8_SB(0, 0), b2, voffB); PG8_STAGE(PG8_SB(0, 1), b2 + hstep, voffB); PG8_STAGE(PG8_SA(0, 0), a2, voffA);
            PG8_WAIT_V(8); PG8_WAIT_L(0); PG8_BAR; PG8_MMA(1, 0, At, B0); PG8_MMA(1, 1, At, B1); PG8_BAR; PG8_SCHED;
            PG8_LDB(B0, 1, 0); PG8_LDB(B1, 1, 1); PG8_SCHED; PG8_LDA(At, 1, 0); PG8_STAGE(PG8_SA(0, 1), a2 + hstep, voffA);
            PG8_WAIT_V(8); PG8_WAIT_L(0); PG8_BAR; PG8_MMA(0, 0, At, B0); PG8_MMA(0, 1, At, B1); PG8_BAR; PG8_SCHED;
            PG8_LDA(At, 1, 1); PG8_STAGE(PG8_SB(1, 0), b3, voffB); PG8_STAGE(PG8_SB(1, 1), b3 + hstep, voffB); PG8_STAGE(PG8_SA(1, 0), a3, voffA);
            PG8_WAIT_V(8); PG8_WAIT_L(0); PG8_BAR; PG8_MMA(1, 0, At, B0); PG8_MMA(1, 1, At, B1); PG8_BAR; PG8_SCHED;
            } else {
            PG8_LDB(B0, 0, 0); PG8_SCHED; PG8_LDA(At, 0, 0); PG8_STAGE(PG8_SA(1, 1), a1 + hstep, voffA);
            PG8_WAIT_L(8); PG8_BAR; PG8_WAIT_L(0); PG8_MMA(0, 0, At, B0); PG8_BAR; PG8_SCHED;
            PG8_LDB(B1, 0, 1); PG8_STAGE(PG8_SB(0, 0), b2, voffB);
            PG8_BAR; PG8_WAIT_L(0); PG8_MMA(0, 1, At, B1); PG8_BAR;
            PG8_LDA(At, 0, 1); PG8_STAGE(PG8_SA(0, 0), a2, voffA);
            PG8_BAR; PG8_WAIT_L(0); PG8_MMA(1, 0, At, B0); PG8_BAR; PG8_SCHED;
            PG8_STAGE(PG8_SB(0, 1), b2 + hstep, voffB);
            PG8_WAIT_V(6); PG8_BAR; PG8_MMA(1, 1, At, B1); PG8_BAR;
            PG8_LDB(B0, 1, 0); PG8_SCHED; PG8_LDA(At, 1, 0); PG8_STAGE(PG8_SA(0, 1), a2 + hstep, voffA);
            PG8_WAIT_L(8); PG8_BAR; PG8_WAIT_L(0); PG8_MMA(0, 0, At, B0); PG8_BAR; PG8_SCHED;
            PG8_LDB(B1, 1, 1); PG8_STAGE(PG8_SB(1, 0), b3, voffB);
            PG8_BAR; PG8_WAIT_L(0); PG8_MMA(0, 1, At, B1); PG8_BAR;
            PG8_LDA(At, 1, 1); PG8_STAGE(PG8_SA(1, 0), a3, voffA);
            PG8_BAR; PG8_WAIT_L(0); PG8_MMA(1, 0, At, B0); PG8_BAR; PG8_SCHED;
            PG8_STAGE(PG8_SB(1, 1), b3 + hstep, voffB);
            PG8_WAIT_V(6); PG8_BAR; PG8_MMA(1, 1, At, B1); PG8_BAR;
            }
        }
        if constexpr (ALIGN_EPI) { if (wr == 0) PG8_BAR; }
        if constexpr (!Epi::AFTER_DRAIN) { E(acc, cur, wr, wc, fr, fq); S.done(cur); }
        if (!has_next) break;
#pragma unroll
        for (int a = 0; a < 2; ++a)
#pragma unroll
            for (int b = 0; b < 2; ++b)
#pragma unroll
                for (int m = 0; m < 4; ++m)
#pragma unroll
                    for (int n = 0; n < 2; ++n) acc[a][b][m][n] = (f32x4){0.f, 0.f, 0.f, 0.f};
        cur = nxt; cA = nA; cB = nB; ++ui;
        if constexpr (ALIGN_EPI) { if (wr == 1) PG8_BAR; }
    }
    PG8_WAIT_V(0);
    if constexpr (!ALIGN_EPI) { if (wr == 0) PG8_BAR; }
    PG8_BAR;
    if constexpr (Epi::AFTER_DRAIN) { E.fused(acc, cur, wr, wc, fr, fq, lds, wid, lane); S.done(cur); }
#undef PG8_SA
#undef PG8_SB
#undef PG8_STAGE
#undef PG8_LDA
#undef PG8_LDB
#undef PG8_MMA
#undef PG8_WAIT_V
#undef PG8_WAIT_L
#undef PG8_BAR
#undef PG8_SCHED
}
}
namespace pg8 {
typedef unsigned u32x2v __attribute__((ext_vector_type(2)));
constexpr int TOK_S = 8192;
constexpr float QK_EPS = 1e-6f;
constexpr float C2 = 0.125f * 1.4426950408889634f;
__device__ __forceinline__ float sigmoid_fast(float v) { return 1.f / (1.f + __expf(-v)); }
__device__ __forceinline__ float silu_fast(float v) { return v / (1.f + __expf(-v)); }

struct EpiInProj {
    static constexpr bool PERM = true, AFTER_DRAIN = false;
    bf16_t* qkv;
    float* gates;
    float* kmean_part;
    const float *qna, *kna, *qnb, *knsel, *knwin;
    __device__ __forceinline__ void operator()(const f32x4 (&acc)[2][2][4][2], const Unit& u, int wr, int wc, int fr, int fq) const {
        const int slot = u.pn * 4 + wc;
        if (slot > 44) return;
        const int b = u.pm >> 5, blk = u.pm & 31, pos0 = blk * 256 + wr * 64 + fr;
        if (slot == 44) {
            if (fq < 3) {
#pragma unroll
                for (int ai = 0; ai < 2; ++ai)
#pragma unroll
                    for (int m = 0; m < 4; ++m) { const size_t tok = (size_t)b * TOK_S + pos0 + ai * HALF + m * 16; float* gp = gates + tok * 24 + 8 * fq;
                        const f32x4 v0 = acc[ai][0][m][0], v1 = acc[ai][0][m][1];
                        *(f32x4*)gp = (f32x4){sigmoid_fast(v0[0]), sigmoid_fast(v0[1]), sigmoid_fast(v0[2]), sigmoid_fast(v0[3])};
                        *(f32x4*)(gp + 4) = (f32x4){sigmoid_fast(v1[0]), sigmoid_fast(v1[1]), sigmoid_fast(v1[2]), sigmoid_fast(v1[3])}; }
            }
            return;
        }
        const float* gain = nullptr; float qscale = 1.f; bool is_ka = false; bf16_t* dst;
        constexpr size_t BIG = (size_t)4 * 8 * TOK_S * 64, SMALL = (size_t)4 * 2 * TOK_S * 64;
        if (slot < 32) { const int kind = slot >> 3, head = slot & 7; dst = qkv + kind * BIG + ((size_t)(b * 8 + head) * TOK_S) * 64;
            if (kind == 0) { gain = qna; qscale = C2; } else if (kind == 1) { gain = kna; is_ka = true; } else if (kind == 3) { gain = qnb; qscale = C2; } }
        else { const int kind = (slot - 32) >> 1, g = slot & 1; dst = qkv + 4 * BIG + kind * SMALL + ((size_t)(b * 2 + g) * TOK_S) * 64;
            if (kind == 2) gain = knsel; else if (kind == 4) gain = knwin; }
        float gv[16];
#pragma unroll
        for (int i = 0; i < 16; ++i) gv[i] = gain ? gain[(i >> 3) * 32 + 8 * fq + (i & 7)] * qscale : 1.f;
        float cs[16];
#pragma unroll
        for (int i = 0; i < 16; ++i) cs[i] = 0.f;
#pragma unroll
        for (int ai = 0; ai < 2; ++ai)
#pragma unroll
            for (int m = 0; m < 4; ++m) {
                float v[16];
#pragma unroll
                for (int bj = 0; bj < 2; ++bj)
#pragma unroll
                    for (int n = 0; n < 2; ++n)
#pragma unroll
                        for (int j = 0; j < 4; ++j) v[bj * 8 + n * 4 + j] = acc[ai][bj][m][n][j];
                if (gain) { float ss = 0.f;
#pragma unroll
                    for (int i = 0; i < 16; ++i) ss += v[i] * v[i];
                    ss += __shfl_xor(ss, 16); ss += __shfl_xor(ss, 32);
                    const float rs = rsqrtf(ss * (1.f / 64.f) + QK_EPS);
#pragma unroll
                    for (int i = 0; i < 16; ++i) v[i] *= rs * gv[i]; }
                if (is_ka) {
#pragma unroll
                    for (int i = 0; i < 16; ++i) cs[i] += v[i]; }
                bf16_t* rp = dst + (size_t)(pos0 + ai * HALF + m * 16) * 64 + 8 * fq;
                u32x4 w0, w1;
                w0.x = cvt_pk_bf16(v[0], v[1]); w0.y = cvt_pk_bf16(v[2], v[3]); w0.z = cvt_pk_bf16(v[4], v[5]); w0.w = cvt_pk_bf16(v[6], v[7]);
                w1.x = cvt_pk_bf16(v[8], v[9]); w1.y = cvt_pk_bf16(v[10], v[11]); w1.z = cvt_pk_bf16(v[12], v[13]); w1.w = cvt_pk_bf16(v[14], v[15]);
                *(u32x4*)rp = w0; *(u32x4*)(rp + 32) = w1;
            }
        if (is_ka) {
#pragma unroll
            for (int i = 0; i < 16; ++i) { float s = cs[i]; s += __shfl_xor(s, 1); s += __shfl_xor(s, 2); s += __shfl_xor(s, 4); s += __shfl_xor(s, 8); cs[i] = s; }
            if (fr == 0) { float* kp = kmean_part + ((size_t)((b * 8 + (slot & 7)) * 32 + blk) * 2 + wr) * 64 + 8 * fq;
                *(f32x4*)kp = (f32x4){cs[0], cs[1], cs[2], cs[3]}; *(f32x4*)(kp + 4) = (f32x4){cs[4], cs[5], cs[6], cs[7]};
                *(f32x4*)(kp + 32) = (f32x4){cs[8], cs[9], cs[10], cs[11]}; *(f32x4*)(kp + 36) = (f32x4){cs[12], cs[13], cs[14], cs[15]}; }
        }
    }
};
struct EpiOutProj {
    static constexpr bool PERM = false, AFTER_DRAIN = false;
    const float* x; float* out; const float* gt;
    __device__ __forceinline__ void operator()(const f32x4 (&acc)[2][2][4][2], const Unit& u, int wr, int wc, int fr, int fq) const {
        const int b = u.pm >> 5; const int col0 = u.pn * BM + wc * 32 + 4 * fq; const float* gtb = gt + (size_t)b * 6144;
#pragma unroll
        for (int bj = 0; bj < 2; ++bj)
#pragma unroll
            for (int n = 0; n < 2; ++n) { const int c = col0 + bj * HALF + n * 16; const f32x4 g4 = *(const f32x4*)(gtb + c);
#pragma unroll
                for (int ai = 0; ai < 2; ++ai)
#pragma unroll
                    for (int m = 0; m < 4; ++m) { const size_t off = (size_t)(u.pm * BM + ai * HALF + wr * 64 + m * 16 + fr) * 1024 + c;
                        const f32x4 xv = *(const f32x4*)(x + off); *(f32x4*)(out + off) = xv + g4 * acc[ai][bj][m][n]; } }
    }
};
struct EpiGateUp {
    static constexpr bool PERM = true, AFTER_DRAIN = false;
    bf16_t* act;
    __device__ __forceinline__ void operator()(const f32x4 (&acc)[2][2][4][2], const Unit& u, int wr, int wc, int fr, int fq) const {
        const int h0 = u.pn * 128 + wc * 32 + 8 * fq;
#pragma unroll
        for (int ai = 0; ai < 2; ++ai)
#pragma unroll
            for (int m = 0; m < 4; ++m) { const size_t row = (size_t)(u.pm * BM + ai * HALF + wr * 64 + m * 16 + fr);
                const f32x4 g0 = acc[ai][0][m][0], g1 = acc[ai][0][m][1], u0 = acc[ai][1][m][0], u1 = acc[ai][1][m][1];
                u32x4 w;
                w.x = cvt_pk_bf16(silu_fast(g0[0]) * u0[0], silu_fast(g0[1]) * u0[1]); w.y = cvt_pk_bf16(silu_fast(g0[2]) * u0[2], silu_fast(g0[3]) * u0[3]);
                w.z = cvt_pk_bf16(silu_fast(g1[0]) * u1[0], silu_fast(g1[1]) * u1[1]); w.w = cvt_pk_bf16(silu_fast(g1[2]) * u1[2], silu_fast(g1[3]) * u1[3]);
                *(u32x4*)(act + row * 2816 + h0) = w; }
    }
};
struct EpiDown {
    static constexpr bool PERM = false, AFTER_DRAIN = false;
    float* out; const float* gt;
    __device__ __forceinline__ void operator()(const f32x4 (&acc)[2][2][4][2], const Unit& u, int wr, int wc, int fr, int fq) const {
        const int b = u.pm >> 5; const int col0 = u.pn * BM + wc * 32 + 4 * fq; const float* gtb = gt + (size_t)b * 6144;
#pragma unroll
        for (int bj = 0; bj < 2; ++bj)
#pragma unroll
            for (int n = 0; n < 2; ++n) { const int c = col0 + bj * HALF + n * 16; const f32x4 g4 = *(const f32x4*)(gtb + c);
#pragma unroll
                for (int ai = 0; ai < 2; ++ai)
#pragma unroll
                    for (int m = 0; m < 4; ++m) { const size_t off = (size_t)(u.pm * BM + ai * HALF + wr * 64 + m * 16 + fr) * 1024 + c;
                        const f32x4 xv = *(const f32x4*)(out + off); *(f32x4*)(out + off) = xv + g4 * acc[ai][bj][m][n]; } }
    }
};
}
constexpr int NWAVES = 8, NTHREADS = 512;
constexpr int BATCH = 4, SEQ = 8192, DM = 1024, TOK = BATCH * SEQ, NIN = 2840, NIN_PAD = 3072, FF = 2816, NCMP = 511;
constexpr size_t MiB = 1u << 20;
constexpr size_t WS_CTL = 0, CTL_ZERO_BYTES = 64 * 1024;
constexpr size_t WS_MODP = 1 * MiB;
constexpr size_t WS_MOD = 2 * MiB;
constexpr size_t WS_CBP = 2 * MiB + 512 * 1024;
constexpr size_t WS_KMP = 3 * MiB;
constexpr size_t WS_BIAS2 = 4 * MiB;
constexpr size_t WS_SSP = 449 * MiB;
constexpr size_t WS_WIN = 6 * MiB, WS_WOUT = 12 * MiB, WS_WGU = 14 * MiB, WS_WDN = 25 * MiB;
constexpr size_t WS_W1K = 31 * MiB, WS_W1V = 32 * MiB, WS_W2K = 33 * MiB, WS_W2V = 33 * MiB + 64 * 1024;
constexpr size_t WS_KCMP = 34 * MiB, WS_VCMP = 35 * MiB;
constexpr size_t WS_GATES = 36 * MiB;
constexpr size_t WS_H = 40 * MiB;
constexpr size_t WS_MIX = 104 * MiB;
constexpr size_t WS_QKV = 168 * MiB;
constexpr size_t WS_ACT = WS_QKV;
constexpr size_t WS_END = 344 * MiB;
constexpr size_t WS_PARTO = 344 * MiB;
constexpr size_t WS_PARTL = 472 * MiB;
constexpr size_t WS_SELG = 476 * MiB;
constexpr size_t QKV_BIG = (size_t)4 * 8 * SEQ * 64, QKV_SMALL = (size_t)4 * 2 * SEQ * 64;
constexpr int RING_BYTES = 131072, LDS_BYTES = 147456;
constexpr int N_PHASES = 10;

#define GAS __attribute__((address_space(1)))
#define LAS __attribute__((address_space(3)))
typedef unsigned short bf16;
typedef unsigned v4u __attribute__((ext_vector_type(4)));
typedef float f32x4 __attribute__((ext_vector_type(4)));
#define LDS_WAIT() asm volatile("s_waitcnt lgkmcnt(0)" ::: "memory")
#define VM_WAIT() asm volatile("s_waitcnt vmcnt(0)" ::: "memory")
__device__ __forceinline__ unsigned f2bf(float f) { unsigned u = __builtin_bit_cast(unsigned, f); return (u + 0x7fffu + ((u >> 16) & 1u)) >> 16; }
__device__ __forceinline__ unsigned pk2(float lo, float hi) { return f2bf(lo) | (f2bf(hi) << 16); }
__device__ __forceinline__ float bf2f(bf16 v) { return __builtin_bit_cast(float, (unsigned)v << 16); }
__device__ __forceinline__ float wave_sum(float v) {
#pragma unroll
    for (int o = 1; o < 64; o <<= 1) v += __shfl_xor(v, o);
    return v;
}
struct Args { const float* in[23]; float* out; unsigned char* ws; int ph_lo, ph_hi; };
struct Frame { LAS unsigned char* lds; int tid, lane, wave, vcu, G; };

struct MapId { __device__ __forceinline__ size_t off(int n, int k, int K) const { return (size_t)n * K + k; } };
struct MapWin { __device__ __forceinline__ size_t off(int n, int k, int K) const { const int s = n >> 6, d = n & 63; return (size_t)(256 * (s >> 2) + 128 * (d >> 5) + 32 * (s & 3) + (d & 31)) * K + k; } };
struct MapWgu { __device__ __forceinline__ size_t off(int n, int k, int K) const { const int up = n >= FF, hdn = up ? n - FF : n; return (size_t)(256 * (hdn >> 7) + 128 * up + (hdn & 127)) * K + k; } };
struct MapFrag { __device__ __forceinline__ size_t off(int n, int k, int K) const { return ((size_t)((k >> 4) * 8 + (n >> 5)) * 64 + ((k >> 3) & 1) * 32 + (n & 31)) * 8 + (k & 7); } };
template <class Map>
__device__ __forceinline__ void transpose_item(const float* __restrict__ W, int K, int N, bf16* WT, LAS float* scr, int item, int lane, const Map& map) {
    const int nblk = (N + 63) / 64, kb = item / nblk, nb = item % nblk, k0 = 64 * kb, n0 = 64 * nb;
    const int nc = n0 + 4 * (lane & 15); const bool nin = nc < N;
    f32x4 v[16];
#pragma unroll
    for (int i = 0; i < 16; ++i) { const int kk = 4 * i + (lane >> 4); v[i] = nin ? *(const GAS f32x4*)(W + (size_t)(k0 + kk) * N + nc) : (f32x4){0.f, 0.f, 0.f, 0.f}; }
#pragma unroll
    for (int i = 0; i < 16; ++i) { const int kk = 4 * i + (lane >> 4); LAS float* d = scr + (4 * (lane & 15)) * 68 + kk; d[0] = v[i][0]; d[68] = v[i][1]; d[136] = v[i][2]; d[204] = v[i][3]; }
    LDS_WAIT(); asm volatile("" ::: "memory");
    const int c = lane & 7;
#pragma unroll
    for (int j = 0; j < 8; ++j) { const int n = (lane >> 3) + 8 * j; const LAS float* s = scr + n * 68 + 8 * c;
        const f32x4 a = *(const LAS f32x4*)s, bq = *(const LAS f32x4*)(s + 4);
        v4u o; o.x = pk2(a[0], a[1]); o.y = pk2(a[2], a[3]); o.z = pk2(bq[0], bq[1]); o.w = pk2(bq[2], bq[3]);
        if (n0 + n < N) *(GAS v4u*)(WT + map.off(n0 + n, k0 + 8 * c, K)) = o; }
    LDS_WAIT(); asm volatile("" ::: "memory");
}
__device__ __forceinline__ float silu_acc(float v) { return v / (1.f + expf(-v)); }
__device__ __forceinline__ void phase_prologue_a(Frame& F, const Args& a) {
    LAS float* scr = (LAS float*)(F.lds + F.wave * 17408);
    const int gw = F.vcu * NWAVES + F.wave, NGW = F.G * NWAVES;
    unsigned char* ws = a.ws;
    constexpr int I_IN = (DM / 64) * ((NIN + 63) / 64), I_OUT = (DM / 64) * (DM / 64), I_GU = (DM / 64) * (2 * FF / 64), I_DN = (FF / 64) * (DM / 64), I_W1 = (2048 / 64) * (256 / 64), I_W2 = (256 / 64) * (64 / 64);
    constexpr int NITEMS = I_IN + I_OUT + I_GU + I_DN + 2 * I_W1 + 2 * I_W2;
    for (int it = gw; it < NITEMS; it += NGW) {
        int r = it;
        if (r < I_IN) { transpose_item(a.in[6], DM, NIN, (bf16*)(ws + WS_WIN), scr, r, F.lane, MapWin()); continue; } r -= I_IN;
        if (r < I_OUT) { transpose_item(a.in[19], DM, DM, (bf16*)(ws + WS_WOUT), scr, r, F.lane, MapId()); continue; } r -= I_OUT;
        if (r < I_GU) { transpose_item(a.in[21], DM, 2 * FF, (bf16*)(ws + WS_WGU), scr, r, F.lane, MapWgu()); continue; } r -= I_GU;
        if (r < I_DN) { transpose_item(a.in[22], FF, DM, (bf16*)(ws + WS_WDN), scr, r, F.lane, MapId()); continue; } r -= I_DN;
        if (r < I_W1) { transpose_item(a.in[14], 2048, 256, (bf16*)(ws + WS_W1K), scr, r, F.lane, MapFrag()); continue; } r -= I_W1;
        if (r < I_W1) { transpose_item(a.in[17], 2048, 256, (bf16*)(ws + WS_W1V), scr, r, F.lane, MapFrag()); continue; } r -= I_W1;
        if (r < I_W2) { transpose_item(a.in[15], 256, 64, (bf16*)(ws + WS_W2K), scr, r, F.lane, MapId()); continue; } r -= I_W2;
        transpose_item(a.in[18], 256, 64, (bf16*)(ws + WS_W2V), scr, r, F.lane, MapId());
    }
    const float* c = a.in[1]; const float* w_ada = a.in[3]; float* modp = (float*)(ws + WS_MODP);
    for (int t = NGW - 1 - gw; t < 96 * 8; t += NGW) { const int cg_ = t % 96, ks = t / 96; const int n = cg_ * 64 + F.lane;
        float acc0 = 0.f, acc1 = 0.f, acc2 = 0.f, acc3 = 0.f;
#pragma unroll
        for (int i = 0; i < 8; ++i) { const int idx = F.lane + 64 * i, bb = idx >> 7, kk = idx & 127; scr[kk * 4 + bb] = silu_acc(c[bb * DM + ks * 128 + kk]); }
        LDS_WAIT(); asm volatile("" ::: "memory");
#pragma unroll 8
        for (int k = 0; k < 128; ++k) { const float w = w_ada[(size_t)(ks * 128 + k) * 6144 + n]; const f32x4 sv = *(const LAS f32x4*)(scr + 4 * k);
            acc0 += sv[0] * w; acc1 += sv[1] * w; acc2 += sv[2] * w; acc3 += sv[3] * w; }
        LDS_WAIT(); asm volatile("" ::: "memory");
        float* o = modp + (size_t)ks * 4 * 6144 + n; o[0] = acc0; o[6144] = acc1; o[2 * 6144] = acc2; o[3 * 6144] = acc3; }
    float* cbp = (float*)(ws + WS_CBP);
    for (int t = NGW / 2 - 1 - gw; t >= 0 && t < 256; t += NGW) { const int kv = t & 1, cg_ = (t >> 1) & 3, ic = t >> 3; const int n = cg_ * 64 + F.lane;
        const float* pe = kv ? a.in[16] : a.in[13]; const float* w1 = kv ? a.in[17] : a.in[14]; float acc = 0.f;
#pragma unroll 8
        for (int i = ic * 64; i < ic * 64 + 64; ++i) acc += pe[i] * w1[(size_t)i * 256 + n];
        cbp[(ic * 2 + kv) * 256 + n] = acc; }
}
__device__ __forceinline__ void norm_rows(Frame& F, const float* in, const f32x4 (&gs)[4], const f32x4 (&sh)[4], bf16* out) {
    for (int i0 = 0; i0 < 16; i0 += 4) {
        f32x4 v[4][4]; float ss[4];
#pragma unroll
        for (int r = 0; r < 4; ++r) { const int row = F.vcu * 128 + F.wave * 16 + i0 + r; const GAS f32x4* xr = (const GAS f32x4*)(in + (size_t)row * DM) + F.lane;
#pragma unroll
            for (int j = 0; j < 4; ++j) v[r][j] = xr[64 * j]; }
#pragma unroll
        for (int r = 0; r < 4; ++r) { float s = 0.f;
#pragma unroll
            for (int j = 0; j < 4; ++j) s += (v[r][j].x * v[r][j].x + v[r][j].y * v[r][j].y) + (v[r][j].z * v[r][j].z + v[r][j].w * v[r][j].w);
            ss[r] = s; }
#pragma unroll
        for (int o_ = 1; o_ < 64; o_ <<= 1) {
#pragma unroll
            for (int r = 0; r < 4; ++r) ss[r] += __shfl_xor(ss[r], o_); }
#pragma unroll
        for (int r = 0; r < 4; ++r) { const int row = F.vcu * 128 + F.wave * 16 + i0 + r; const float rs = rsqrtf(ss[r] * (1.f / DM) + 1e-6f);
            GAS unsigned long long* o8 = (GAS unsigned long long*)(out + (size_t)row * DM) + F.lane;
#pragma unroll
            for (int j = 0; j < 4; ++j) { const f32x4 y = v[r][j] * rs * gs[j] + sh[j]; o8[64 * j] = (unsigned long long)pk2(y.x, y.y) | ((unsigned long long)pk2(y.z, y.w) << 32); } }
    }
}
__device__ __forceinline__ void phase_prologue_b(Frame& F, const Args& a) {
    unsigned char* ws = a.ws; const float* modp = (const float*)(ws + WS_MODP); const float* b_ada = a.in[4];
    if (F.wave == 0 && F.vcu < 96) { const int n = F.vcu * 64 + F.lane; float* mod = (float*)(ws + WS_MOD);
        for (int b = 0; b < 4; ++b) { float s = 0.f;
#pragma unroll
            for (int ks = 0; ks < 8; ++ks) s += modp[((size_t)ks * 4 + b) * 6144 + n];
            mod[b * 6144 + n] = s + b_ada[n]; } }
    const int b = F.vcu >> 6; const float* g = a.in[5];
    f32x4 gs[4], sh[4];
#pragma unroll
    for (int j = 0; j < 4; ++j) { const int c0 = 4 * F.lane + 256 * j; f32x4 s0 = {0.f, 0.f, 0.f, 0.f}, s1 = {0.f, 0.f, 0.f, 0.f};
#pragma unroll
        for (int ks = 0; ks < 8; ++ks) { s0 += *(const f32x4*)(modp + ((size_t)ks * 4 + b) * 6144 + c0); s1 += *(const f32x4*)(modp + ((size_t)ks * 4 + b) * 6144 + DM + c0); }
        s0 += *(const f32x4*)(b_ada + c0); s1 += *(const f32x4*)(b_ada + DM + c0);
        sh[j] = s0; gs[j] = *(const f32x4*)(g + c0) * (s1 + 1.0f); }
    norm_rows(F, a.in[0], gs, sh, (bf16*)(ws + WS_H));
}
__device__ __forceinline__ void phase_norm2(Frame& F, const Args& a) {
    unsigned char* ws = a.ws; const int b = F.vcu >> 6; const float* mod = (const float*)(ws + WS_MOD) + (size_t)b * 6144; const float* g = a.in[20];
    f32x4 gs[4], sh[4];
#pragma unroll
    for (int j = 0; j < 4; ++j) { const int c0 = 4 * F.lane + 256 * j; sh[j] = *(const f32x4*)(mod + 3 * DM + c0); gs[j] = *(const f32x4*)(g + c0) * (*(const f32x4*)(mod + 4 * DM + c0) + 1.0f); }
    norm_rows(F, a.out, gs, sh, (bf16*)(ws + WS_H));
}

__device__ __forceinline__ void phase_bias2(Frame& F, const Args& a) {
    unsigned char* ws = a.ws; const float* mod = (const float*)(ws + WS_MOD); const bf16* wt = (const bf16*)(ws + WS_WGU); float* bias2 = (float*)(ws + WS_BIAS2);
    const int gw = F.vcu * NWAVES + F.wave, NGW = F.G * NWAVES;
    f32x4 sh[4][4];
#pragma unroll
    for (int bb = 0; bb < 4; ++bb)
#pragma unroll
        for (int j = 0; j < 4; ++j) sh[bb][j] = *(const f32x4*)(mod + (size_t)bb * 6144 + 3 * DM + 16 * F.lane + 4 * j);
    for (int c = gw; c < 2 * FF; c += NGW) {
        const v4u w0 = *(const GAS v4u*)(wt + (size_t)c * DM + 16 * F.lane), w1 = *(const GAS v4u*)(wt + (size_t)c * DM + 16 * F.lane + 8);
        const unsigned wu[8] = {w0.x, w0.y, w0.z, w0.w, w1.x, w1.y, w1.z, w1.w};
        float s[4] = {0.f, 0.f, 0.f, 0.f};
#pragma unroll
        for (int j = 0; j < 4; ++j) { const float e0 = __builtin_bit_cast(float, wu[2 * j] << 16), e1 = __builtin_bit_cast(float, wu[2 * j] & 0xffff0000u), e2 = __builtin_bit_cast(float, wu[2 * j + 1] << 16), e3 = __builtin_bit_cast(float, wu[2 * j + 1] & 0xffff0000u);
#pragma unroll
            for (int bb = 0; bb < 4; ++bb) s[bb] += (sh[bb][j][0] * e0 + sh[bb][j][1] * e1) + (sh[bb][j][2] * e2 + sh[bb][j][3] * e3); }
#pragma unroll
        for (int bb = 0; bb < 4; ++bb) { const float t = wave_sum(s[bb]); if (F.lane == 0) bias2[(size_t)bb * 2 * FF + c] = t; }
    }
}
#define XB_TMO      128
#define XB_XCNT(j)  (256  + 64 * (j))
#define XB_XSUB(j)  (1280 + 64 * (j))
#define XB_XGEN(j)  (2304 + 64 * (j))
#define XB_TOP      3328
#define XB_TOPGEN   3392
#define XCD_BAR_WORDS 3456
#define XB_SPIN_CAP (1u << 18)

__device__ __forceinline__ unsigned xb_ld(unsigned* p)              { return __hip_atomic_load(p, __ATOMIC_RELAXED, __HIP_MEMORY_SCOPE_AGENT); }
__device__ __forceinline__ unsigned xb_add(unsigned* p, unsigned v) { return __hip_atomic_fetch_add(p, v, __ATOMIC_RELAXED, __HIP_MEMORY_SCOPE_AGENT); }
__device__ __forceinline__ unsigned xb_xcc_id() { return (unsigned)__builtin_amdgcn_s_getreg((3 << 11) | 20) & 0xFu; }
#define XB_SPIN(cond, bar) do { unsigned _sp = 0; while (cond) { __builtin_amdgcn_s_sleep(1); \
    if ((++_sp & 255u) == 0u) { if (xb_ld(&(bar)[XB_TMO])) break; if (_sp > XB_SPIN_CAP) { atomicAdd(&(bar)[XB_TMO], 1u); break; } } } } while (0)

struct XcdBarrier {
    unsigned* bar; unsigned x;
    volatile LAS unsigned* st;
};

__device__ __forceinline__ XcdBarrier xcd_barrier_post(unsigned* bar, volatile LAS unsigned* st) {
    XcdBarrier b; b.bar = bar; b.x = xb_xcc_id(); b.st = st;
    if (threadIdx.x == 0) (void)xb_add(&bar[XB_XCNT(b.x)], 1u);
    return b;
}
__device__ __forceinline__ void xcd_barrier_complete(unsigned* bar, unsigned x, unsigned& nloc, unsigned& nx) {
    const unsigned G = gridDim.x * gridDim.y * gridDim.z;
    unsigned sum, cnt, mine, sp = 0u;
    for (;;) {
        sum = 0u; cnt = 0u; mine = 0u;
#pragma unroll
        for (unsigned j = 0; j < 16; ++j) { const unsigned c = xb_ld(&bar[XB_XCNT(j)]); sum += c; cnt += (c > 0u) ? 1u : 0u; mine = (j == x) ? c : mine; }
        if (sum == G) break;
        __builtin_amdgcn_s_sleep(1);
        if ((++sp & 255u) == 0u) { if (xb_ld(&bar[XB_TMO])) break; if (sp > XB_SPIN_CAP) { atomicAdd(&bar[XB_TMO], 1u); break; } }
    }
    nloc = mine > 0u ? mine : 1u; nx = cnt > 0u ? cnt : 1u;
}

__device__ __forceinline__ void xcd_barrier(const XcdBarrier& b) {
    asm volatile("s_waitcnt vmcnt(0)" ::: "memory");
    __syncthreads();
    if (threadIdx.x == 0) {
        unsigned* bar = b.bar;
        __builtin_amdgcn_s_waitcnt(0);
        unsigned nloc = b.st[0], nx = b.st[1];
        if (nloc == 0u) { xcd_barrier_complete(bar, b.x, nloc, nx); b.st[0] = nloc; b.st[1] = nx; }
        const unsigned old = xb_add(&bar[XB_XSUB(b.x)], 1u);
        const unsigned gen = old / nloc;
        if (old + 1u == (gen + 1u) * nloc) {
            __builtin_amdgcn_fence(__ATOMIC_RELEASE, "agent");
            asm volatile("s_waitcnt vmcnt(0)" ::: "memory");
            const unsigned og = xb_add(&bar[XB_TOP], 1u);
            const unsigned tg = og / nx;
            if (og + 1u == (tg + 1u) * nx) xb_add(&bar[XB_TOPGEN], 1u);
            else XB_SPIN(xb_ld(&bar[XB_TOPGEN]) == tg, bar);
            __builtin_amdgcn_fence(__ATOMIC_ACQUIRE, "agent");
            xb_add(&bar[XB_XGEN(b.x)], 1u);
            asm volatile("s_waitcnt vmcnt(0)" ::: "memory");
        } else {
            XB_SPIN(xb_ld(&bar[XB_XGEN(b.x)]) == gen, bar);
            __builtin_amdgcn_fence(__ATOMIC_ACQUIRE, "agent");
            asm volatile("s_waitcnt vmcnt(0)" ::: "memory");
        }
    }
    __syncthreads();
}
#define ATT_NS att
#ifndef ATT_ABL
#define ATT_ABL 0
#endif
#ifndef ATT_STAGGER
#define ATT_STAGGER 0
#endif
#ifndef ATT_SLEEP
#define ATT_SLEEP 24
#endif
namespace ATT_NS {
using bf16x8 = __attribute__((ext_vector_type(8))) short;
using s16x4 = __attribute__((ext_vector_type(4))) short;
using f32x16 = __attribute__((ext_vector_type(16))) float;
using u32x4 = __attribute__((ext_vector_type(4))) unsigned;
typedef LAS const char* lds_cptr;
typedef short v4i16_t __attribute__((ext_vector_type(4)));
constexpr int SLOT = 16384, NSLOT = 4, LDS_OST = 65536, LDS_LUT = 98304, LDS_IMP = 100352, LDS_SELM = 133120, LDS_MISC = 134144, LDS_WSF = 134400, LDS_LUTG = 136448  , LDS_ATT_END = 144640;
constexpr float LOG2E = 1.4426950408889634f;
#define MFMA32(a, b, c) __builtin_amdgcn_mfma_f32_32x32x16_bf16(a, b, c, 0, 0, 0)
#define ATT_WAIT_BAR(N) asm volatile("s_waitcnt vmcnt(" #N ") lgkmcnt(0)\n\ts_barrier" ::: "memory")
__device__ __forceinline__ void glds16(const void* gsrc, unsigned lds_dst) { unsigned keep;
    asm volatile("s_mov_b32 %0, m0\n\ts_mov_b32 m0, %2\n\ts_nop 0\n\tglobal_load_lds_dwordx4 %1, off\n\ts_mov_b32 m0, %0" : "=&s"(keep) : "v"(gsrc), "s"(lds_dst) : "memory"); }
typedef float f32x2_t __attribute__((ext_vector_type(2))); typedef __bf16 bf16x2_t __attribute__((ext_vector_type(2)));
__device__ __forceinline__ unsigned cvtpk(float lo, float hi) { f32x2_t v = {lo, hi}; bf16x2_t b = __builtin_convertvector(v, bf16x2_t); return __builtin_bit_cast(unsigned, b); }
__device__ __forceinline__ s16x4 vtr(lds_cptr p) { return __builtin_bit_cast(s16x4, __builtin_amdgcn_ds_read_tr16_b64_v4i16((LAS v4i16_t*)p)); }
__device__ __forceinline__ int t5_bucket(int d) {
    if (d < 16) return d;
    int b = 16;
    b += (d >= 19); b += (d >= 21); b += (d >= 24); b += (d >= 27); b += (d >= 31); b += (d >= 35); b += (d >= 40); b += (d >= 46);
    b += (d >= 52); b += (d >= 59); b += (d >= 67); b += (d >= 77); b += (d >= 87); b += (d >= 99); b += (d >= 113);
    return b;
}
struct Ctx { LAS char* lds; int wid; int lane, r32, hi; };
__device__ __forceinline__ int fresh_lane() { int l; asm volatile("v_mbcnt_lo_u32_b32 %0, -1, 0\n\tv_mbcnt_hi_u32_b32 %0, -1, %0" : "=v"(l)); return l; }
__device__ __forceinline__ Ctx make_ctx(LAS unsigned char* lds, int tid) {
    Ctx c; c.lds = (LAS char*)lds; c.wid = __builtin_amdgcn_readfirstlane(tid >> 6); c.lane = tid & 63; c.r32 = c.lane & 31; c.hi = c.lane >> 5; return c;
}
template <bool HASV, class QK, class SM>
__device__ __forceinline__ void run_stream(const Ctx& c, const bf16* Kb, const bf16* Vb, int t0, int t1, QK&& qk, SM&& sm) {
    const int n = t1 - t0; if (n <= 0) return;
    const int lane = fresh_lane(), r32 = lane & 31, hi = lane >> 5; const unsigned lds0 = (unsigned)(uintptr_t)c.lds;
    const bf16* ks = Kb + ((8 * c.wid + (lane >> 3)) * 64 + (((lane & 7) ^ (((8 * c.wid + (lane >> 3)) >> 1) & 7)) << 3)); const bf16* vs = Vb + ((16 * (c.wid & 3) + (lane >> 2)) * 64 + (c.wid >> 2) * 32 + (lane & 3) * 8);
    const unsigned kdst = lds0 + c.wid * 1024, vdst = lds0 + 8192 + c.wid * 1024;
    const lds_cptr kp0 = (lds_cptr)c.lds + r32 * 128;
    const lds_cptr vp0 = (lds_cptr)c.lds + 8192 + ((lane >> 4) & 1) * 32 + (lane & 3) * 8 + (4 * hi + ((lane & 15) >> 2)) * 64;
#define ATT_ISSUE(t, so) do { if (ATT_ABL & 4) break; glds16(ks + (size_t)(t) * 4096, (unsigned)__builtin_amdgcn_readfirstlane(kdst + (so))); if (HASV) glds16(vs + (size_t)(t) * 4096, (unsigned)__builtin_amdgcn_readfirstlane(vdst + (so))); } while (0)
    ATT_ISSUE(t0, 0); if (n > 1) ATT_ISSUE(t0 + 1, SLOT);
    const bool late = ATT_STAGGER && __builtin_amdgcn_readfirstlane(c.wid) >= 4;
    f32x16 s0 = {}, s1 = {};
    int slot = 0, slotp = 3 * SLOT, slot2 = 2 * SLOT;
    if (!late) {
        for (int i = 0; i < n; ++i) {
            if (i + 1 < n) { if (HASV) ATT_WAIT_BAR(2); else ATT_WAIT_BAR(1); } else ATT_WAIT_BAR(0);
            if (i + 2 < n) ATT_ISSUE(t0 + i + 2, slot2);
            if (!(ATT_ABL & 1)) qk(t0 + i, kp0 + slot, s0, s1); if (!(ATT_ABL & 2)) sm(t0 + i, vp0 + slot, s0, s1);
            slot = (slot == 3 * SLOT) ? 0 : slot + SLOT; slot2 = (slot2 == 3 * SLOT) ? 0 : slot2 + SLOT;
        }
    } else {
        for (int i = 0; i < n; ++i) {
            if (i + 1 < n) { if (HASV) ATT_WAIT_BAR(2); else ATT_WAIT_BAR(1); } else ATT_WAIT_BAR(0);
            if (i + 2 < n) ATT_ISSUE(t0 + i + 2, slot2);
            if (i > 0 && !(ATT_ABL & 2)) sm(t0 + i - 1, vp0 + slotp, s0, s1);
            if (!(ATT_ABL & 1)) qk(t0 + i, kp0 + slot, s0, s1);
            slotp = slot; slot = (slot == 3 * SLOT) ? 0 : slot + SLOT; slot2 = (slot2 == 3 * SLOT) ? 0 : slot2 + SLOT;
        }
        if (!(ATT_ABL & 2)) sm(t0 + n - 1, vp0 + slotp, s0, s1);
    }
    asm volatile("s_waitcnt lgkmcnt(0)\n\ts_barrier" ::: "memory");
#undef ATT_ISSUE
}
template <class FN1, class FN2>
__device__ __forceinline__ void run_stream_pairs(const Ctx& c, const bf16* Kb, const bf16* Vb, int t0, int t1, FN1&& fn1, FN2&& fn2) {
    const int n = t1 - t0; if (n <= 0) return;
    const int lane = fresh_lane(), r32 = lane & 31, hi = lane >> 5; const unsigned lds0 = (unsigned)(uintptr_t)c.lds;
    const bf16* ks = Kb + ((8 * c.wid + (lane >> 3)) * 64 + (((lane & 7) ^ (((8 * c.wid + (lane >> 3)) >> 1) & 7)) << 3)); const bf16* vs = Vb + ((16 * (c.wid & 3) + (lane >> 2)) * 64 + (c.wid >> 2) * 32 + (lane & 3) * 8);
    const unsigned kdst = lds0 + c.wid * 1024, vdst = lds0 + 8192 + c.wid * 1024;
    const lds_cptr kp0 = (lds_cptr)c.lds + r32 * 128;
    const lds_cptr vp0 = (lds_cptr)c.lds + 8192 + ((lane >> 4) & 1) * 32 + (lane & 3) * 8 + (4 * hi + ((lane & 15) >> 2)) * 64;
#define ATT_ISSUE1(t, so) do { glds16(ks + (size_t)(t) * 4096, (unsigned)__builtin_amdgcn_readfirstlane(kdst + (so))); glds16(vs + (size_t)(t) * 4096, (unsigned)__builtin_amdgcn_readfirstlane(vdst + (so))); } while (0)
    ATT_ISSUE1(t0, 0); if (n > 1) ATT_ISSUE1(t0 + 1, SLOT);
    int base = 0;
    for (int i = 0; i < n; i += 2) {
        ATT_WAIT_BAR(0);
        const int nb = 2 * SLOT - base;
        if (i + 2 < n) ATT_ISSUE1(t0 + i + 2, nb); if (i + 3 < n) ATT_ISSUE1(t0 + i + 3, nb + SLOT);
        if (i + 1 < n) fn2(t0 + i, kp0 + base, vp0 + base, kp0 + base + SLOT, vp0 + base + SLOT); else fn1(t0 + i, kp0 + base, vp0 + base);
        base = nb;
    }
    asm volatile("s_waitcnt lgkmcnt(0)\n\ts_barrier" ::: "memory");
#undef ATT_ISSUE1
}
__device__ __forceinline__ void qk_tile(f32x16& s0, f32x16& s1, lds_cptr kp, const bf16x8 (&qr)[4]) {
    bf16x8 kf[8];
    { const int l = fresh_lane(), f = ((l & 31) >> 1) & 7, hi = l >> 5;
#pragma unroll
      for (int d0 = 0; d0 < 4; ++d0) { const int off = ((2 * d0 + hi) ^ f) << 4; kf[2 * d0] = *(const LAS bf16x8*)(kp + off); kf[2 * d0 + 1] = *(const LAS bf16x8*)(kp + 4096 + off); } }
    const f32x16 z = {};
    s0 = MFMA32(kf[0], qr[0], z); s1 = MFMA32(kf[1], qr[0], z);
#pragma unroll
    for (int d0 = 1; d0 < 4; ++d0) { s0 = MFMA32(kf[2 * d0], qr[d0], s0); s1 = MFMA32(kf[2 * d0 + 1], qr[d0], s1); }
}
template <bool MASK>
__device__ __forceinline__ void pv_tile(f32x16 (&o)[2], lds_cptr vp, const f32x16& p0, const f32x16& p1, unsigned mask) {
    if (ATT_ABL & 8) { o[0][0] += p0[0] + p1[5]; return; }
    u32x4 pw0 = {cvtpk(p0[0], p0[1]), cvtpk(p0[2], p0[3]), cvtpk(p0[4], p0[5]), cvtpk(p0[6], p0[7])}, pw1 = {cvtpk(p0[8], p0[9]), cvtpk(p0[10], p0[11]), cvtpk(p0[12], p0[13]), cvtpk(p0[14], p0[15])};
    u32x4 pw2 = {cvtpk(p1[0], p1[1]), cvtpk(p1[2], p1[3]), cvtpk(p1[4], p1[5]), cvtpk(p1[6], p1[7])}, pw3 = {cvtpk(p1[8], p1[9]), cvtpk(p1[10], p1[11]), cvtpk(p1[12], p1[13]), cvtpk(p1[14], p1[15])};
    if (MASK) { pw0 &= mask; pw1 &= mask; pw2 &= mask; pw3 &= mask; }
    if (ATT_ABL & 64) { o[0] = MFMA32(__builtin_bit_cast(bf16x8, pw0), __builtin_bit_cast(bf16x8, pw1), o[0]); o[1] = MFMA32(__builtin_bit_cast(bf16x8, pw2), __builtin_bit_cast(bf16x8, pw3), o[1]); return; }
    s16x4 vlo[8], vhi[8];
#pragma unroll
    for (int i = 0; i < 8; ++i) { vlo[i] = vtr(vp + ((i >> 2) * 4096 + (i & 3) * 1024)); vhi[i] = vtr(vp + ((i >> 2) * 4096 + (i & 3) * 1024 + 512)); }
#define ATT_VFR(i) (bf16x8){vlo[i][0], vlo[i][1], vlo[i][2], vlo[i][3], vhi[i][0], vhi[i][1], vhi[i][2], vhi[i][3]}
    o[0] = MFMA32(__builtin_bit_cast(bf16x8, pw0), ATT_VFR(0), o[0]); o[1] = MFMA32(__builtin_bit_cast(bf16x8, pw0), ATT_VFR(4), o[1]);
    o[0] = MFMA32(__builtin_bit_cast(bf16x8, pw1), ATT_VFR(1), o[0]); o[1] = MFMA32(__builtin_bit_cast(bf16x8, pw1), ATT_VFR(5), o[1]);
    o[0] = MFMA32(__builtin_bit_cast(bf16x8, pw2), ATT_VFR(2), o[0]); o[1] = MFMA32(__builtin_bit_cast(bf16x8, pw2), ATT_VFR(6), o[1]);
    o[0] = MFMA32(__builtin_bit_cast(bf16x8, pw3), ATT_VFR(3), o[0]); o[1] = MFMA32(__builtin_bit_cast(bf16x8, pw3), ATT_VFR(7), o[1]);
#undef ATT_VFR
}
#define ATT_SB() __builtin_amdgcn_sched_barrier(0)
struct KF { bf16x8 f[8]; };
struct VF { s16x4 lo[8], hi[8]; };
struct PW4 { u32x4 w0, w1, w2, w3; };
__device__ __forceinline__ void ld_k(KF& k, lds_cptr kp) {
    const int l = fresh_lane(), f = ((l & 31) >> 1) & 7, hi = l >> 5;
#pragma unroll
    for (int d0 = 0; d0 < 4; ++d0) { const int off = ((2 * d0 + hi) ^ f) << 4; k.f[2 * d0] = *(const LAS bf16x8*)(kp + off); k.f[2 * d0 + 1] = *(const LAS bf16x8*)(kp + 4096 + off); } }
__device__ __forceinline__ void qk_mfma(f32x16& s0, f32x16& s1, const KF& k, const bf16x8 (&qr)[4]) {
    const f32x16 z = {};
    s0 = MFMA32(k.f[0], qr[0], z); s1 = MFMA32(k.f[1], qr[0], z);
#pragma unroll
    for (int d0 = 1; d0 < 4; ++d0) { s0 = MFMA32(k.f[2 * d0], qr[d0], s0); s1 = MFMA32(k.f[2 * d0 + 1], qr[d0], s1); } }
__device__ __forceinline__ void ld_v(VF& v, lds_cptr vp) {
#pragma unroll
    for (int i = 0; i < 8; ++i) { v.lo[i] = vtr(vp + ((i >> 2) * 4096 + (i & 3) * 1024)); v.hi[i] = vtr(vp + ((i >> 2) * 4096 + (i & 3) * 1024 + 512)); } }
__device__ __forceinline__ PW4 pack4(const f32x16& p0, const f32x16& p1, unsigned mask) { PW4 w;
    w.w0 = (u32x4){cvtpk(p0[0], p0[1]), cvtpk(p0[2], p0[3]), cvtpk(p0[4], p0[5]), cvtpk(p0[6], p0[7])}; w.w1 = (u32x4){cvtpk(p0[8], p0[9]), cvtpk(p0[10], p0[11]), cvtpk(p0[12], p0[13]), cvtpk(p0[14], p0[15])};
    w.w2 = (u32x4){cvtpk(p1[0], p1[1]), cvtpk(p1[2], p1[3]), cvtpk(p1[4], p1[5]), cvtpk(p1[6], p1[7])}; w.w3 = (u32x4){cvtpk(p1[8], p1[9]), cvtpk(p1[10], p1[11]), cvtpk(p1[12], p1[13]), cvtpk(p1[14], p1[15])};
    w.w0 &= mask; w.w1 &= mask; w.w2 &= mask; w.w3 &= mask; return w; }
__device__ __forceinline__ void pv_mfma(f32x16 (&o)[2], const VF& v, const PW4& w) {
#define ATT_VF(i) (bf16x8){v.lo[i][0], v.lo[i][1], v.lo[i][2], v.lo[i][3], v.hi[i][0], v.hi[i][1], v.hi[i][2], v.hi[i][3]}
    o[0] = MFMA32(__builtin_bit_cast(bf16x8, w.w0), ATT_VF(0), o[0]); o[1] = MFMA32(__builtin_bit_cast(bf16x8, w.w0), ATT_VF(4), o[1]);
    o[0] = MFMA32(__builtin_bit_cast(bf16x8, w.w1), ATT_VF(1), o[0]); o[1] = MFMA32(__builtin_bit_cast(bf16x8, w.w1), ATT_VF(5), o[1]);
    o[0] = MFMA32(__builtin_bit_cast(bf16x8, w.w2), ATT_VF(2), o[0]); o[1] = MFMA32(__builtin_bit_cast(bf16x8, w.w2), ATT_VF(6), o[1]);
    o[0] = MFMA32(__builtin_bit_cast(bf16x8, w.w3), ATT_VF(3), o[0]); o[1] = MFMA32(__builtin_bit_cast(bf16x8, w.w3), ATT_VF(7), o[1]);
#undef ATT_VF
}
__device__ __forceinline__ float rowsum32(const f32x16& p0, const f32x16& p1) { if (ATT_ABL & 32) return p0[0]; float a = p0[0] + p1[0], b = p0[1] + p1[1];
#pragma unroll
    for (int r = 2; r < 16; r += 2) { a += p0[r]; asm volatile("" : "+v"(a)); b += p0[r + 1]; asm volatile("" : "+v"(b)); a += p1[r]; asm volatile("" : "+v"(a)); b += p1[r + 1]; asm volatile("" : "+v"(b)); }
    return a + b; }
__device__ __forceinline__ void hook_exp(f32x16& s0, f32x16& s1) {
    if (ATT_ABL & 16) return;
#pragma unroll
    for (int r = 0; r < 16; ++r) { s0[r] = __builtin_amdgcn_exp2f(s0[r]); s1[r] = __builtin_amdgcn_exp2f(s1[r]); } }
__device__ __forceinline__ void hook_near(f32x16& s0, f32x16& s1, int base, const LAS float* lut) {
    asm volatile("" : "+v"(base));
#pragma unroll
    for (int r = 0; r < 16; ++r) { const int d0 = base - ((r & 3) + 8 * (r >> 2)), d1 = d0 - 32;
        s0[r] = __builtin_amdgcn_exp2f(s0[r] + lut[min(max(d0, -1), 113) + 1]); s1[r] = __builtin_amdgcn_exp2f(s1[r] + lut[min(max(d1, -1), 113) + 1]); } }
__device__ __forceinline__ void hook_edge(f32x16& s0, f32x16& s1, int base, int win) {
    asm volatile("" : "+v"(base));
#pragma unroll
    for (int r = 0; r < 16; ++r) { const int d0 = base - ((r & 3) + 8 * (r >> 2)), d1 = d0 - 32;
        s0[r] = __builtin_amdgcn_exp2f(d0 < win ? s0[r] : -INFINITY); s1[r] = __builtin_amdgcn_exp2f(d1 < win ? s1[r] : -INFINITY); } }
__device__ __forceinline__ void hook_cmp(f32x16& s0, f32x16& s1, int nrel  , float cb) {
    asm volatile("" : "+v"(nrel));
#pragma unroll
    for (int r = 0; r < 16; ++r) { const int c0 = (r & 3) + 8 * (r >> 2);
        s0[r] = __builtin_amdgcn_exp2f(s0[r] + ((c0 <= nrel) ? cb : -INFINITY)); s1[r] = __builtin_amdgcn_exp2f(s1[r] + ((c0 + 32 <= nrel) ? cb : -INFINITY)); } }
__device__ __forceinline__ void row_factors(const Ctx& c, float f, float (&fr)[16]) {
    const int lane = fresh_lane(), r32 = lane & 31, hi = lane >> 5; LAS float* wsf = (LAS float*)(c.lds + LDS_WSF) + c.wid * 64;
    asm volatile("s_waitcnt lgkmcnt(0)" ::: "memory");
    if (hi == 0) wsf[r32] = f;
    asm volatile("s_waitcnt lgkmcnt(0)" ::: "memory");
#pragma unroll
    for (int r = 0; r < 16; ++r) fr[r] = wsf[(r & 3) + 8 * (r >> 2) + 4 * hi];
    asm volatile("s_waitcnt lgkmcnt(0)" ::: "memory");
}
__device__ __forceinline__ float pair_sum(float v) { auto rr = __builtin_amdgcn_permlane32_swap(__float_as_uint(v), __float_as_uint(v), false, false); return __uint_as_float(rr[0]) + __uint_as_float(rr[1]); }
template <class RowOff>
__device__ __forceinline__ void store_rows(const Ctx& c, const f32x16 (&o)[2], bf16* dst, RowOff&& rowoff) {
    LAS bf16* stg = (LAS bf16*)(c.lds + LDS_OST) + c.wid * 2048;
    const int lane = fresh_lane(), r32 = lane & 31, hi = lane >> 5;
#pragma unroll
    for (int r = 0; r < 16; ++r) { const int orow = (r & 3) + 8 * (r >> 2) + 4 * hi;
#pragma unroll
        for (int d0 = 0; d0 < 2; ++d0) stg[orow * 64 + d0 * 32 + r32] = (bf16)f2bf(o[d0][r]); }
    asm volatile("s_waitcnt lgkmcnt(0)" ::: "memory");
#pragma unroll
    for (int i = 0; i < 4; ++i) { const int row = i * 8 + (lane >> 3), ch = lane & 7; const u32x4 v = *(const LAS u32x4*)(stg + row * 64 + ch * 8); *(u32x4*)(dst + rowoff(row) + ch * 8) = v; }
    asm volatile("s_waitcnt lgkmcnt(0)" ::: "memory");
}
struct AttnPtrs { const bf16* qkv; const float* kmp; const float* gates; const bf16* kcmp; const bf16* vcmp; const float* rel_bias; bf16* mix; unsigned* selg; bf16* part_o; float* part_l; };

__device__ __forceinline__ unsigned moba_gate32(const AttnPtrs& P, int b, int h, int i, const bf16x8 (&qr)[4], int r32, int hi) {
    unsigned selmask = 0u;
    if (i > 0) {
        bf16x8 kmf[4];
        const float* kp = P.kmp + ((size_t)((b * 8 + h) * 32 + r32) * 2) * 64;
#pragma unroll
        for (int d0 = 0; d0 < 4; ++d0) { const f32x4 a0 = *(const f32x4*)(kp + d0 * 16 + hi * 8), a1 = *(const f32x4*)(kp + d0 * 16 + hi * 8 + 4), b0 = *(const f32x4*)(kp + 64 + d0 * 16 + hi * 8), b1 = *(const f32x4*)(kp + 64 + d0 * 16 + hi * 8 + 4);
            const f32x4 m0 = (a0 + b0) * (1.f / 256.f), m1 = (a1 + b1) * (1.f / 256.f);
            u32x4 w = {cvtpk(m0[0], m0[1]), cvtpk(m0[2], m0[3]), cvtpk(m1[0], m1[1]), cvtpk(m1[2], m1[3])}; kmf[d0] = __builtin_bit_cast(bf16x8, w); }
        f32x16 sg = {};
#pragma unroll
        for (int d0 = 0; d0 < 4; ++d0) sg = MFMA32(kmf[d0], qr[d0], sg);
        float v[16];
#pragma unroll
        for (int r = 0; r < 16; ++r) v[r] = ((r & 3) + 8 * (r >> 2) + 4 * hi < i) ? sg[r] : -INFINITY;
#pragma unroll
        for (int it = 0; it < 3; ++it) {
            float m = v[0]; int jb = 4 * hi;
#pragma unroll
            for (int r = 1; r < 16; ++r) { const int j = (r & 3) + 8 * (r >> 2) + 4 * hi; if (v[r] > m) { m = v[r]; jb = j; } }
            auto rm = __builtin_amdgcn_permlane32_swap(__float_as_uint(m), __float_as_uint(m), false, false);
            auto rj = __builtin_amdgcn_permlane32_swap((unsigned)jb, (unsigned)jb, false, false);
            const float mo = __uint_as_float(hi ? rm[0] : rm[1]); const int jo = (int)(hi ? rj[0] : rj[1]);
            const bool mine = (m > mo) || (m == mo && jb < jo);
            const float mw = mine ? m : mo; const int jw = mine ? jb : jo;
            if (mw > -INFINITY) { selmask |= 1u << jw;
#pragma unroll
                for (int r = 0; r < 16; ++r) if ((r & 3) + 8 * (r >> 2) + 4 * hi == jw) v[r] = -INFINITY; }
        }
    }
    return selmask;
}
__device__ __forceinline__ void moba_gate_phase(const AttnPtrs& P, int vcu, int G, int tid) {
    const int lane = tid & 63, r32 = lane & 31, hi = lane >> 5; const int wid = __builtin_amdgcn_readfirstlane(tid >> 6);
    for (int task = vcu * 8 + wid; task < 8192; task += G * 8) { const int w = task & 7, i = (task >> 3) & 31, bh = task >> 8; const int qpos = 256 * i + 32 * w + r32;
        const bf16* QA = P.qkv + ((size_t)bh * SEQ) * 64;
        bf16x8 qr[4];
#pragma unroll
        for (int d0 = 0; d0 < 4; ++d0) qr[d0] = *(const bf16x8*)(QA + (size_t)qpos * 64 + d0 * 16 + hi * 8);
        const unsigned m = moba_gate32(P, bh >> 3, bh & 7, i, qr, r32, hi);
        if (hi == 0) P.selg[(size_t)bh * SEQ + qpos] = m; }
}
__device__ __forceinline__ void moba_lut(const Ctx& c, const AttnPtrs& P, int h) {
    LAS float* lut = (LAS float*)(c.lds + LDS_LUT);
    if (threadIdx.x < 115) lut[threadIdx.x] = (threadIdx.x == 0) ? -INFINITY : (P.rel_bias[t5_bucket(threadIdx.x - 1) * 16 + h] - P.rel_bias[31 * 16 + h]) * LOG2E;
}
__device__ __forceinline__ void moba_past_item(const Ctx& c, const AttnPtrs& P, int b, int h, int j) {
    const int bh = b * 8 + h, tid = threadIdx.x;
    const bf16* QA = P.qkv + ((size_t)bh * SEQ) * 64; const bf16* KA = QA + QKV_BIG + (size_t)256 * j * 64; const bf16* VA = QA + 2 * QKV_BIG + (size_t)256 * j * 64;
    const LAS float* lut = (const LAS float*)(c.lds + LDS_LUTG) + h * 128;
    { const int lane = fresh_lane(); const unsigned lds0 = (unsigned)(uintptr_t)c.lds;
      const bf16* ks = KA + ((8 * c.wid + (lane >> 3)) * 64 + (((lane & 7) ^ (((8 * c.wid + (lane >> 3)) >> 1) & 7)) << 3)); const bf16* vs = VA + ((16 * (c.wid & 3) + (lane >> 2)) * 64 + (c.wid >> 2) * 32 + (lane & 3) * 8);
#pragma unroll
      for (int tt = 0; tt < 4; ++tt) { glds16(ks + tt * 4096, (unsigned)__builtin_amdgcn_readfirstlane(lds0 + c.wid * 1024 + tt * SLOT)); glds16(vs + tt * 4096, (unsigned)__builtin_amdgcn_readfirstlane(lds0 + 8192 + c.wid * 1024 + tt * SLOT)); } }
    LAS unsigned short* list = (LAS unsigned short*)(c.lds + LDS_IMP);
    LAS unsigned* wcnt = (LAS unsigned*)(c.lds + LDS_MISC) + 8;
    const unsigned* sg = P.selg + (size_t)bh * SEQ;
    if (tid < 256) list[tid] = (unsigned short)((256 * j + tid) | (3 << 13));
    int total = 256;
    for (int base = (j + 1) * 256; base < SEQ; base += 2048) {
        const int q0 = base + 4 * tid; uint4 m4 = make_uint4(0u, 0u, 0u, 0u); if (q0 < SEQ) m4 = *(const uint4*)(sg + q0);
        const unsigned long long b0 = __ballot((m4.x >> j) & 1u), b1 = __ballot((m4.y >> j) & 1u), b2 = __ballot((m4.z >> j) & 1u), b3 = __ballot((m4.w >> j) & 1u);
        const int c0 = (int)__popcll(b0), c1 = (int)__popcll(b1), c2 = (int)__popcll(b2), c3 = (int)__popcll(b3);
        if ((tid & 63) == 0) wcnt[c.wid] = (unsigned)(c0 + c1 + c2 + c3);
        asm volatile("s_waitcnt vmcnt(0) lgkmcnt(0)\n\ts_barrier" ::: "memory");
        int off = total, tot = 0;
#pragma unroll
        for (int w = 0; w < 8; ++w) { const int v = (int)wcnt[w]; off += (w < c.wid) ? v : 0; tot += v; }
        const unsigned long long below = (1ull << (tid & 63)) - 1ull; const unsigned lowj = (1u << j) - 1u;
        if ((m4.x >> j) & 1u) list[off + __popcll(b0 & below)] = (unsigned short)((q0 + 0) | (__popc(m4.x & lowj) << 13)); off += c0;
        if ((m4.y >> j) & 1u) list[off + __popcll(b1 & below)] = (unsigned short)((q0 + 1) | (__popc(m4.y & lowj) << 13)); off += c1;
        if ((m4.z >> j) & 1u) list[off + __popcll(b2 & below)] = (unsigned short)((q0 + 2) | (__popc(m4.z & lowj) << 13)); off += c2;
        if ((m4.w >> j) & 1u) list[off + __popcll(b3 & below)] = (unsigned short)((q0 + 3) | (__popc(m4.w & lowj) << 13));
        total += tot;
        asm volatile("s_waitcnt lgkmcnt(0)\n\ts_barrier" ::: "memory");
    }
    total = __builtin_amdgcn_readfirstlane(total);
    { const int npad = (32 - (total & 31)) & 31; if (tid < npad) list[total + tid] = 0xFFFFu; }
    const int nchunks = (total + 31) >> 5;
    asm volatile("s_waitcnt vmcnt(0) lgkmcnt(0)\n\ts_barrier" ::: "memory");
    for (int ch = c.wid; ch < nchunks; ch += 8) {
        const int lane = fresh_lane(), r32 = lane & 31, hi = lane >> 5;
        const lds_cptr kp0 = (lds_cptr)c.lds + r32 * 128;
        const lds_cptr vp0 = (lds_cptr)c.lds + 8192 + ((lane >> 4) & 1) * 32 + (lane & 3) * 8 + (4 * hi + ((lane & 15) >> 2)) * 64;
        const unsigned e = list[32 * ch + r32]; const bool valid = e != 0xFFFFu; const int q = valid ? (int)(e & 0x1FFFu) : SEQ - 1;
        bf16x8 qr[4];
#pragma unroll
        for (int d0 = 0; d0 < 4; ++d0) qr[d0] = *(const bf16x8*)(QA + (size_t)q * 64 + d0 * 16 + hi * 8);
        asm volatile("" : "+v"(qr[0]), "+v"(qr[1]), "+v"(qr[2]), "+v"(qr[3]));
        const bool anynear = __any(valid && (unsigned)((q >> 8) - j) <= 1u);
        f32x16 o[2]; o[0] = f32x16{}; o[1] = f32x16{}; float l_reg = 0.f;
#pragma unroll 1
        for (int tt = 0; tt < 4; ++tt) { f32x16 s0, s1; qk_tile(s0, s1, kp0 + tt * SLOT, qr);
            if (anynear) hook_near(s0, s1, q - (256 * j + 64 * tt) - 4 * hi, lut); else hook_exp(s0, s1);
            l_reg += rowsum32(s0, s1);
            pv_tile<false>(o, vp0 + tt * SLOT, s0, s1, 0u); }
        const float L = pair_sum(l_reg);
        if (hi == 0 && valid) P.part_l[((size_t)bh * SEQ + q) * 4 + (e >> 13)] = L;
        LAS bf16* stg = (LAS bf16*)(c.lds + LDS_OST) + c.wid * 2048;
#pragma unroll
        for (int r = 0; r < 16; ++r) { const int orow = (r & 3) + 8 * (r >> 2) + 4 * hi;
#pragma unroll
            for (int d0 = 0; d0 < 2; ++d0) stg[orow * 64 + d0 * 32 + r32] = (bf16)f2bf(o[d0][r]); }
        asm volatile("s_waitcnt lgkmcnt(0)" ::: "memory");
#pragma unroll
        for (int it = 0; it < 4; ++it) { const int row = it * 8 + (lane >> 3), chn = lane & 7; const unsigned e2 = list[32 * ch + row];
            const u32x4 v = *(const LAS u32x4*)(stg + row * 64 + chn * 8);
            if (e2 != 0xFFFFu) *(u32x4*)(P.part_o + (((size_t)bh * SEQ + (e2 & 0x1FFFu)) * 4 + (e2 >> 13)) * 64 + chn * 8) = v; }
        asm volatile("s_waitcnt lgkmcnt(0)" ::: "memory");
    }
    asm volatile("s_waitcnt lgkmcnt(0)\n\ts_barrier" ::: "memory");
}
__device__ __forceinline__ void moba_merge_pass(const AttnPtrs& P, int vcu, int G, int tid) {
    const int lane = tid & 63, h = lane >> 3, chn = lane & 7; const int wid = __builtin_amdgcn_readfirstlane(tid >> 6);
#pragma unroll 2
    for (int tok = vcu * 8 + wid; tok < TOK; tok += G * 8) { const int b = tok >> 13, q = tok & (SEQ - 1);
        const size_t qi = (size_t)(b * 8 + h) * SEQ + q; const int ns = __popc(P.selg[qi]);
        float Lt = P.part_l[qi * 4 + 3]; const u32x4 pw = *(const u32x4*)(P.part_o + (qi * 4 + 3) * 64 + chn * 8);
        f32x4 a0 = {__uint_as_float(pw.x << 16), __uint_as_float(pw.x & 0xffff0000u), __uint_as_float(pw.y << 16), __uint_as_float(pw.y & 0xffff0000u)};
        f32x4 a1 = {__uint_as_float(pw.z << 16), __uint_as_float(pw.z & 0xffff0000u), __uint_as_float(pw.w << 16), __uint_as_float(pw.w & 0xffff0000u)};
#pragma unroll
        for (int sidx = 0; sidx < 3; ++sidx) if (sidx < ns) { Lt += P.part_l[qi * 4 + sidx]; const u32x4 pv = *(const u32x4*)(P.part_o + (qi * 4 + sidx) * 64 + chn * 8);
            a0 += (f32x4){__uint_as_float(pv.x << 16), __uint_as_float(pv.x & 0xffff0000u), __uint_as_float(pv.y << 16), __uint_as_float(pv.y & 0xffff0000u)};
            a1 += (f32x4){__uint_as_float(pv.z << 16), __uint_as_float(pv.z & 0xffff0000u), __uint_as_float(pv.w << 16), __uint_as_float(pv.w & 0xffff0000u)}; }
        const float inv = 1.f / Lt; a0 *= inv; a1 *= inv;
        const u32x4 w = {cvtpk(a0[0], a0[1]), cvtpk(a0[2], a0[3]), cvtpk(a1[0], a1[1]), cvtpk(a1[2], a1[3])};
        *(u32x4*)(P.mix + (size_t)tok * DM + h * 64 + chn * 8) = w; }
}

__device__ __forceinline__ void nsa_item(const Ctx& c, const AttnPtrs& P, int b, int g, int ci, int flags = 0) {
    const int ql = 8 * c.wid + (c.r32 >> 2), rh = c.r32 & 3, qpos = 64 * ci + ql, hb = 4 * g + rh;
    const int qw0 = 64 * ci + 8 * c.wid;
    const bf16* QB = P.qkv + 3 * QKV_BIG + ((size_t)(b * 8 + hb) * SEQ) * 64;
    const bf16* KS = P.qkv + 4 * QKV_BIG + 2 * QKV_SMALL + ((size_t)(b * 2 + g) * SEQ) * 64; const bf16* VS = KS + QKV_SMALL; const bf16* KW = KS + 2 * QKV_SMALL; const bf16* VW = KS + 3 * QKV_SMALL;
    const bf16* KC = P.kcmp + (size_t)(b * 2 + g) * 512 * 64; const bf16* VC = P.vcmp + (size_t)(b * 2 + g) * 512 * 64;
    bf16x8 qr[4];
#pragma unroll
    for (int d0 = 0; d0 < 4; ++d0) qr[d0] = *(const bf16x8*)(QB + (size_t)qpos * 64 + d0 * 16 + c.hi * 8);
    asm volatile("" : "+v"(qr[0]), "+v"(qr[1]), "+v"(qr[2]), "+v"(qr[3]));
    const LAS float* lut = (const LAS float*)(c.lds + LDS_LUTG) + (8 + hb) * 128;
    LAS float* imp = (LAS float*)(c.lds + LDS_IMP);
    LAS unsigned* selm = (LAS unsigned*)(c.lds + LDS_SELM);
    f32x16 o[2]; float l_reg; float fr[16];
    LAS float* park = (LAS float*)(c.lds + LDS_OST) + c.wid * 1024 + c.lane;
    LAS float* park1 = (LAS float*)(c.lds + LDS_IMP) + c.wid * 1024 + c.lane;
    const int nct = (4 * ci + 3 + 63) >> 6;
    const int nlim = (qpos >= 31) ? ((qpos - 31) >> 4) : -1;
    LAS bf16* impt = (LAS bf16*)(c.lds + ((rh & 2) ? LDS_IMP : LDS_OST)) + ((rh & 1) * 64 + ql) * 128;
    l_reg = 0.f; o[0] = f32x16{}; o[1] = f32x16{};
    {
        float carry = 0.f;
        run_stream<true>(c, KC, VC, 0, nct,
          [&](int t, lds_cptr kp, f32x16& s0, f32x16& s1) { qk_tile(s0, s1, kp, qr); },
          [&](int t, lds_cptr vp, f32x16& s0, f32x16& s1) {
            hook_cmp(s0, s1, nlim - 64 * t - 4 * c.hi, 0.f);
            l_reg += rowsum32(s0, s1);
#pragma unroll
            for (int half = 0; half < 2; ++half) {
                float g4[4], e[4];
#pragma unroll
                for (int a = 0; a < 4; ++a) { const float x0 = half ? s1[4 * a] : s0[4 * a], x1 = half ? s1[4 * a + 1] : s0[4 * a + 1], x2 = half ? s1[4 * a + 2] : s0[4 * a + 2], x3 = half ? s1[4 * a + 3] : s0[4 * a + 3];
                    g4[a] = (x0 + x1) + (x2 + x3); e[a] = x3; }
                float x[4];
#pragma unroll
                for (int a = 0; a < 4; ++a) { auto rr = __builtin_amdgcn_permlane32_swap(__float_as_uint(e[a]), __float_as_uint(e[a]), false, false); x[a] = __uint_as_float(c.hi ? rr[0] : rr[1]); }
                const int jb = 16 * t + 8 * half;
                float iv[4];
                if (c.hi) {
#pragma unroll
                    for (int a = 0; a < 4; ++a) iv[a] = g4[a] + x[a]; }
                else { iv[0] = g4[0] + carry; iv[1] = g4[1] + x[0]; iv[2] = g4[2] + x[1]; iv[3] = g4[3] + x[2]; carry = x[3]; }
#pragma unroll
                for (int a = 0; a < 4; ++a) impt[jb + 2 * a + c.hi] = (bf16)f2bf(iv[a]);
            }
            pv_tile<false>(o, vp, s0, s1, 0u);
        });
    }
    const float Lc = pair_sum(l_reg); const float invLc = Lc > 0.f ? 1.f / Lc : 0.f;
    { LAS float* wsfw = (LAS float*)(c.lds + LDS_WSF) + c.wid * 64; if (c.hi == 0) wsfw[32 + c.r32] = invLc; }
    {
        asm volatile("s_waitcnt lgkmcnt(0)\n\ts_barrier" ::: "memory");
        const int qq = 8 * c.wid + (c.lane >> 3), cc = c.lane & 7;
        unsigned m0 = 0u, m1 = 0u, m2w = 0u, m3 = 0u;
        if (ci <= 15) { m0 = (ci == 31) ? 0xffffffffu : ((2u << ci) - 1u); }
        else {
            float v[16];
            const LAS float* il = (const LAS float*)(c.lds + LDS_WSF) + c.wid * 64 + 32 + 4 * (c.lane >> 3);
            const float i0 = il[0], i1 = il[1], i2 = il[2], i3 = il[3];
            const LAS bf16* ta = (const LAS bf16*)(c.lds + LDS_OST) + qq * 128; const LAS bf16* tb = (const LAS bf16*)(c.lds + LDS_IMP) + qq * 128;
#pragma unroll
            for (int k = 0; k < 16; ++k) { const int j = cc + 8 * k;
                v[k] = (j >= 1 && j <= ci - 2) ? (bf2f(ta[j]) * i0 + bf2f(ta[64 * 128 + j]) * i1) + (bf2f(tb[j]) * i2 + bf2f(tb[64 * 128 + j]) * i3) : -INFINITY; }
            for (int it = 0; it < 13; ++it) {
                float m = v[0]; int jb = cc;
#pragma unroll
                for (int k = 1; k < 16; ++k) if (v[k] > m) { m = v[k]; jb = cc + 8 * k; }
#pragma unroll
                for (int sft = 1; sft < 8; sft <<= 1) { const float mo = __shfl_xor(m, sft); const int jo = __shfl_xor(jb, sft); if (mo > m || (mo == m && jo < jb)) { m = mo; jb = jo; } }
                if (m > -INFINITY) { const unsigned bit = 1u << (jb & 31); const int wsel = jb >> 5;
                    m0 |= (wsel == 0) ? bit : 0u; m1 |= (wsel == 1) ? bit : 0u; m2w |= (wsel == 2) ? bit : 0u; m3 |= (wsel == 3) ? bit : 0u;
#pragma unroll
                    for (int k = 0; k < 16; ++k) if (cc + 8 * k == jb) v[k] = -INFINITY; }
            }
            m0 |= 1u;
#pragma unroll
            for (int z = 0; z < 2; ++z) { const int jf = ci - z; const unsigned bit = 1u << (jf & 31); const int wsel = jf >> 5;
                m0 |= (wsel == 0) ? bit : 0u; m1 |= (wsel == 1) ? bit : 0u; m2w |= (wsel == 2) ? bit : 0u; m3 |= (wsel == 3) ? bit : 0u; }
        }
        if (cc == 0) { selm[qq * 4 + 0] = m0; selm[qq * 4 + 1] = m1; selm[qq * 4 + 2] = m2w; selm[qq * 4 + 3] = m3; }
        asm volatile("s_waitcnt lgkmcnt(0)\n\ts_barrier" ::: "memory");
    }
    const float* gp = P.gates + ((size_t)b * SEQ + qpos) * 24 + hb * 3; float g0 = gp[0], g1 = gp[1], g2 = gp[2];
    asm volatile("" : "+v"(g0), "+v"(g1), "+v"(g2));
    row_factors(c, g0 * invLc, fr);
#pragma unroll
    for (int r = 0; r < 16; ++r) { park[r * 64] = o[0][r] * fr[r]; park1[r * 64] = o[1][r] * fr[r]; }
    {
        const unsigned w0 = selm[ql * 4 + 0], w1 = selm[ql * 4 + 1], w2 = selm[ql * 4 + 2], w3 = selm[ql * 4 + 3];
        o[0] = f32x16{}; o[1] = f32x16{}; l_reg = 0.f;
        auto sel_pred = [&](int t) -> bool { const unsigned wsel = (t < 32) ? w0 : (t < 64) ? w1 : (t < 96) ? w2 : w3; return (wsel >> (t & 31)) & 1u; };
        auto sel_one = [&](int t, lds_cptr kp, lds_cptr vp) { const bool pred = sel_pred(t); if (!__any(pred)) return; const int key0 = 64 * t;
            f32x16 s0, s1; qk_tile(s0, s1, kp, qr);
            if (qw0 - key0 - 63 >= 113) { hook_exp(s0, s1); const float rs = rowsum32(s0, s1); l_reg += pred ? rs : 0.f;
                if (__all(pred)) pv_tile<false>(o, vp, s0, s1, 0u); else pv_tile<true>(o, vp, s0, s1, pred ? 0xffffffffu : 0u); }
            else { hook_near(s0, s1, qpos - key0 - 4 * c.hi, lut); const float rs = rowsum32(s0, s1); l_reg += pred ? rs : 0.f;
                if (__all(pred)) pv_tile<false>(o, vp, s0, s1, 0u); else pv_tile<true>(o, vp, s0, s1, pred ? 0xffffffffu : 0u); } };
        if (!(flags & 4)) run_stream_pairs(c, KS, VS, 0, ci + 1, sel_one,
            [&](int t, lds_cptr kpA, lds_cptr vpA, lds_cptr kpB, lds_cptr vpB) {
                if (qw0 - 64 * (t + 1) - 63 >= 113) {
                    const bool pa = sel_pred(t), pb = sel_pred(t + 1);
                    const bool xa = __any(pa), xb = __any(pb);
                    if (!xa && !xb) return;
                    if (!xb) { sel_one(t, kpA, vpA); return; }
                    if (!xa) { sel_one(t + 1, kpB, vpB); return; }
                    KF kA, kB; ld_k(kA, kpA); ATT_SB();
                    f32x16 a0, a1, b0, b1; qk_mfma(a0, a1, kA, qr); ATT_SB();
                    VF vA, vB; ld_k(kB, kpB); ld_v(vA, vpA); ATT_SB();
                    qk_mfma(b0, b1, kB, qr); hook_exp(a0, a1);
                    const float ra = rowsum32(a0, a1); const PW4 wa = pack4(a0, a1, pa ? 0xffffffffu : 0u); ATT_SB();
                    ld_v(vB, vpB); ATT_SB();
                    pv_mfma(o, vA, wa); hook_exp(b0, b1);
                    const float rb = rowsum32(b0, b1); const PW4 wb = pack4(b0, b1, pb ? 0xffffffffu : 0u); l_reg += (pa ? ra : 0.f) + (pb ? rb : 0.f); ATT_SB();
                    pv_mfma(o, vB, wb);
                } else { sel_one(t, kpA, vpA); sel_one(t + 1, kpB, vpB); } });
        const float Ls = pair_sum(l_reg);
        row_factors(c, g1 / Ls, fr);
#pragma unroll
        for (int r = 0; r < 16; ++r) { park[r * 64] += o[0][r] * fr[r]; park1[r * 64] += o[1][r] * fr[r]; }
    }
    {
        o[0] = f32x16{}; o[1] = f32x16{}; l_reg = 0.f;
        if (!(flags & 8)) run_stream<true>(c, KW, VW, ci >= 8 ? ci - 8 : 0, ci + 1,
            [&](int t, lds_cptr kp, f32x16& s0, f32x16& s1) { qk_tile(s0, s1, kp, qr); },
            [&](int t, lds_cptr vp, f32x16& s0, f32x16& s1) { const int key0 = 64 * t;
                if (qw0 - key0 - 63 < 113) hook_near(s0, s1, qpos - key0 - 4 * c.hi, lut); else if (qw0 + 7 - key0 >= 512) hook_edge(s0, s1, qpos - key0 - 4 * c.hi, 512); else hook_exp(s0, s1);
                l_reg += rowsum32(s0, s1);
                pv_tile<false>(o, vp, s0, s1, 0u); });
        const float Lw = pair_sum(l_reg);
        row_factors(c, g2 / Lw, fr);
#pragma unroll
        for (int r = 0; r < 16; ++r) { o[0][r] = park[r * 64] + o[0][r] * fr[r]; o[1][r] = park1[r * 64] + o[1][r] * fr[r]; }
        asm volatile("s_waitcnt lgkmcnt(0)" ::: "memory");
    }
    bf16* dst = P.mix + ((size_t)b * SEQ + 64 * ci + 8 * c.wid) * DM + 512 + g * 256;
    store_rows(c, o, dst, [](int row) { return (size_t)(row >> 2) * DM + (row & 3) * 64; });
    asm volatile("s_waitcnt lgkmcnt(0)\n\ts_barrier" ::: "memory");
}

__device__ __forceinline__ void attn_phase(LAS unsigned char* lds, const AttnPtrs& P, unsigned* qcounter, int flags) {
    Ctx c = make_ctx(lds, threadIdx.x);
    LAS unsigned* misc = (LAS unsigned*)(c.lds + LDS_MISC);
    { LAS float* lutg = (LAS float*)(c.lds + LDS_LUTG);
      for (int idx = threadIdx.x; idx < 16 * 115; idx += NTHREADS) { const int hh = idx / 115, d = idx % 115;
          lutg[hh * 128 + d] = (d == 0) ? -INFINITY : (P.rel_bias[t5_bucket(d - 1) * 16 + hh] - P.rel_bias[31 * 16 + hh]) * LOG2E; }
      asm volatile("s_waitcnt vmcnt(0) lgkmcnt(0)\n\ts_barrier" ::: "memory"); }
    for (;;) {
        if (threadIdx.x == 0) misc[0] = __hip_atomic_fetch_add(qcounter, 1u, __ATOMIC_RELAXED, __HIP_MEMORY_SCOPE_AGENT);
        asm volatile("s_waitcnt vmcnt(0) lgkmcnt(0)\n\ts_barrier" ::: "memory");
        const unsigned k = misc[0];
        asm volatile("s_waitcnt lgkmcnt(0)\n\ts_barrier" ::: "memory");
        if (k >= 2048u) break;
        const bool is_mp = k >= 512u && k < 1536u;
        if (flags & (is_mp ? 2 : 1)) continue;
        if (k < 512u) { const int s_ = 127 - (int)(k >> 3), bg = k & 7; nsa_item(c, P, bg >> 1, bg & 1, s_, flags); }
        else if (k < 1536u) { const int kk = (int)k - 512, j = kk >> 5, bh = kk & 31; moba_past_item(c, P, bh >> 3, bh & 7, j); }
        else { const int kk = (int)k - 1536; const int s_ = 63 - (kk >> 3), bg = kk & 7; nsa_item(c, P, bg >> 1, bg & 1, s_, flags); }
    }
}
#undef MFMA32
#undef ATT_WAIT_BAR
}
namespace cmpr {
using bf16x8 = __attribute__((ext_vector_type(8))) short;
using f32x16 = __attribute__((ext_vector_type(16))) float;
constexpr int HID_PITCH = 528;
__device__ __forceinline__ float gelu_tanh(float v) { const float u = fminf(fmaxf(0.7978845608028654f * (v + 0.044715f * v * v * v), -15.f), 15.f); const float e = __expf(2.f * u); return 0.5f * v * (1.f + (e - 1.f) / (e + 1.f)); }
__device__ __forceinline__ void compress_unit(LAS unsigned char* lds, int unit, const bf16* qkv, const bf16* w1k, const bf16* w1v, const bf16* w2k, const bf16* w2v, const float* cbp, const float* kncmp, bf16* kcmp, bf16* vcmp) {
    const int tid = threadIdx.x, lane = tid & 63, r32 = lane & 31, hi = lane >> 5; const int wid = __builtin_amdgcn_readfirstlane(tid >> 6);
    const int kv = unit & 1, u = (unit >> 1) & 15, bg = unit >> 5;
    const bf16* src = qkv + 4 * QKV_BIG + (kv ? QKV_SMALL : 0) + (size_t)bg * SEQ * 64;
    const bf16* w1 = kv ? w1v : w1k; const bf16* w2 = kv ? w2v : w2k;
    const int n0 = 32 * u;
    { const bf16* sp = src + (size_t)16 * n0 * 64;
      for (int ch = tid; ch < 4224; ch += NTHREADS) { v4u v = {0u, 0u, 0u, 0u}; if (16 * n0 + (ch >> 3) < SEQ) v = *(const GAS v4u*)(sp + (size_t)ch * 8);
          *(LAS v4u*)(lds + ((ch ^ ((ch >> 7) & 15)) << 4)) = v; } }
    asm volatile("s_waitcnt vmcnt(0) lgkmcnt(0)\n\ts_barrier" ::: "memory");
    const bf16* bp = w1 + ((size_t)wid * 64 + lane) * 8;
    f32x16 acc = {};
#pragma unroll 8
    for (int kk = 0; kk < 128; ++kk) { const int lc = r32 * 128 + 2 * kk + hi; const bf16x8 a = *(const LAS bf16x8*)(lds + ((lc ^ ((lc >> 7) & 15)) << 4)), bfr = *(const bf16x8*)(bp + (size_t)kk * 4096); acc = __builtin_amdgcn_mfma_f32_32x32x16_bf16(a, bfr, acc, 0, 0, 0); }
    float cb = 0.f;
#pragma unroll 8
    for (int ic = 0; ic < 32; ++ic) cb += cbp[(ic * 2 + kv) * 256 + 32 * wid + r32];
    LAS unsigned char* hidL = lds + 69632;
#pragma unroll
    for (int r = 0; r < 16; ++r) { const int n = (r & 3) + 8 * (r >> 2) + 4 * hi; *(LAS bf16*)(hidL + n * HID_PITCH + (32 * wid + r32) * 2) = (bf16)f2bf(gelu_tanh(acc[r] + cb)); }
    asm volatile("s_waitcnt lgkmcnt(0)\n\ts_barrier" ::: "memory");
    if (wid == 0) {
        f32x16 o0 = {}, o1 = {};
#pragma unroll 4
        for (int kk = 0; kk < 16; ++kk) { const bf16x8 hb = *(const LAS bf16x8*)(hidL + r32 * HID_PITCH + (16 * kk + 8 * hi) * 2);
            const bf16x8 a0 = *(const bf16x8*)(w2 + (size_t)r32 * 256 + 16 * kk + 8 * hi), a1 = *(const bf16x8*)(w2 + (size_t)(32 + r32) * 256 + 16 * kk + 8 * hi);
            o0 = __builtin_amdgcn_mfma_f32_32x32x16_bf16(a0, hb, o0, 0, 0, 0); o1 = __builtin_amdgcn_mfma_f32_32x32x16_bf16(a1, hb, o1, 0, 0, 0); }
        float rs = 1.f;
        if (!kv) { float ss = 0.f;
#pragma unroll
            for (int r = 0; r < 16; ++r) ss += o0[r] * o0[r] + o1[r] * o1[r];
            auto rr = __builtin_amdgcn_permlane32_swap(__float_as_uint(ss), __float_as_uint(ss), false, false); ss = __uint_as_float(rr[0]) + __uint_as_float(rr[1]);
            rs = rsqrtf(ss * (1.f / 64.f) + 1e-6f); }
        const int n = n0 + r32; bf16* dst = (kv ? vcmp : kcmp) + ((size_t)bg * 512 + n) * 64;
#pragma unroll
        for (int r = 0; r < 16; ++r) { const int d = (r & 3) + 8 * (r >> 2) + 4 * hi;
            float v0 = o0[r] * rs, v1 = o1[r] * rs; if (!kv) { v0 *= kncmp[d]; v1 *= kncmp[d + 32]; }
            if (n >= NCMP) { v0 = 0.f; v1 = 0.f; }
            dst[d] = (bf16)f2bf(v0); dst[d + 32] = (bf16)f2bf(v1); }
    }
    asm volatile("s_waitcnt lgkmcnt(0)\n\ts_barrier" ::: "memory");
}
}
__global__ void __launch_bounds__(NTHREADS, 2) mk_fwd(Args a) {
    extern __shared__ __attribute__((aligned(16))) unsigned char lds[];
    Frame F;
    F.lds = (LAS unsigned char*)lds;
    F.tid = threadIdx.x; F.lane = F.tid & 63; F.wave = __builtin_amdgcn_readfirstlane(F.tid >> 6);
    F.G = gridDim.x; { const int bx = blockIdx.x; F.vcu = (F.G % 8 == 0) ? (bx % 8) * (F.G / 8) + bx / 8 : bx; }
    cg::grid_group grid = cg::this_grid();
    volatile LAS unsigned* xst = (volatile LAS unsigned*)(F.lds + 147424);
    if (F.tid < 8) xst[F.tid] = 0u;
    __syncthreads();
    const XcdBarrier xbar = xcd_barrier_post((unsigned*)(a.ws + WS_CTL) + 4096, xst);
    unsigned char* ws = a.ws;
    const int lo = a.ph_lo, hi = a.ph_hi;
    const att::AttnPtrs P{(const bf16*)(ws + WS_QKV), (const float*)(ws + WS_KMP), (const float*)(ws + WS_GATES), (const bf16*)(ws + WS_KCMP), (const bf16*)(ws + WS_VCMP), a.in[2], (bf16*)(ws + WS_MIX),
                          (unsigned*)(ws + WS_SELG), (bf16*)(ws + WS_PARTO), (float*)(ws + WS_PARTL)};
#define IN(k) (lo <= (k) && (k) < hi)
#define SEAM(k) do { if (IN(k) && IN((k) + 1)) { if ((k) == 0) grid.sync(); else xcd_barrier(xbar); } } while (0)
    if (IN(0)) { phase_prologue_a(F, a); } SEAM(0);
    if (IN(1)) { phase_prologue_b(F, a); } SEAM(1);
    if (IN(2)) {
        pg8::Gemm g{(const pg8::bf16_t*)(ws + WS_H), (const pg8::bf16_t*)(ws + WS_WIN), TOK, NIN_PAD, DM}; pg8::StaticOrder S; S.init(TOK, NIN_PAD, F.G, (int)blockIdx.x);
        pg8::EpiInProj E{(pg8::bf16_t*)(ws + WS_QKV), (float*)(ws + WS_GATES), (float*)(ws + WS_KMP), a.in[7], a.in[8], a.in[9], a.in[11], a.in[12]};
        pg8::gemm_phase<pg8::EpiInProj, pg8::StaticOrder, true, true>(F.lds, g, S, E);
    } SEAM(2);
    if (IN(3)) {
        att::moba_gate_phase(P, F.vcu, F.G, F.tid);
        for (int unit = F.vcu; unit < 256; unit += F.G)
            cmpr::compress_unit(F.lds, unit, (const bf16*)(ws + WS_QKV), (const bf16*)(ws + WS_W1K), (const bf16*)(ws + WS_W1V), (const bf16*)(ws + WS_W2K), (const bf16*)(ws + WS_W2V),
                                (const float*)(ws + WS_CBP), a.in[10], (bf16*)(ws + WS_KCMP), (bf16*)(ws + WS_VCMP));
    } SEAM(3);
    if (IN(4)) {
                att::attn_phase(F.lds, P, (unsigned*)(ws + WS_CTL) + 64, 0);
    } SEAM(4);
    if (IN(5)) { att::moba_merge_pass(P, F.vcu, F.G, F.tid); } SEAM(5);
    if (IN(6)) {
        pg8::Gemm g{(const pg8::bf16_t*)(ws + WS_MIX), (const pg8::bf16_t*)(ws + WS_WOUT), TOK, DM, DM}; pg8::StaticOrder S; S.init(TOK, DM, F.G, (int)blockIdx.x);
        pg8::EpiOutProj E{a.in[0], a.out, (const float*)(ws + WS_MOD) + 2 * DM};
        pg8::gemm_phase<pg8::EpiOutProj, pg8::StaticOrder, true, true>(F.lds, g, S, E);
    } SEAM(6);
    if (IN(7)) { phase_norm2(F, a); } SEAM(7);
    if (IN(8)) {
        pg8::Gemm g{(const pg8::bf16_t*)(ws + WS_H), (const pg8::bf16_t*)(ws + WS_WGU), TOK, 2 * FF, DM}; pg8::StaticOrder S; S.init(TOK, 2 * FF, F.G, (int)blockIdx.x);
        pg8::EpiGateUp E{(pg8::bf16_t*)(ws + WS_ACT)};
        pg8::gemm_phase<pg8::EpiGateUp, pg8::StaticOrder, true, true>(F.lds, g, S, E);
    } SEAM(8);
    if (IN(9)) {
        pg8::Gemm g{(const pg8::bf16_t*)(ws + WS_ACT), (const pg8::bf16_t*)(ws + WS_WDN), TOK, DM, FF}; pg8::StaticOrder S; S.init(TOK, DM, F.G, (int)blockIdx.x);
        pg8::EpiDown E{a.out, (const float*)(ws + WS_MOD) + 5 * DM};
        pg8::gemm_phase<pg8::EpiDown, pg8::StaticOrder, true, true>(F.lds, g, S, E);
    }
#undef IN
#undef SEAM
}

static void launch_phases(const Args& base, int lo, int hi, int grid, hipStream_t stream, int flags = 0) {
    Args a = base; a.ph_lo = lo; a.ph_hi = hi; (void)flags;
    if (hi - lo > 1) { void* args[] = {&a}; (void)hipLaunchCooperativeKernel((const void*)mk_fwd, dim3(grid), dim3(NTHREADS), args, LDS_BYTES, stream); }
    else hipLaunchKernelGGL(mk_fwd, dim3(grid), dim3(NTHREADS), LDS_BYTES, stream, a);
}
extern "C" void kernel_launch(void* const* d_in, const int* in_sizes, int n_in, void* d_out, int out_size, void* d_ws, size_t ws_size, hipStream_t stream) {
    static int grid = 0;
    if (grid == 0) {
        int dev = 0, cus = 0, per_cu = 0;
        if (n_in != 23 || ws_size < 480 * MiB || hipGetDevice(&dev) != hipSuccess || hipDeviceGetAttribute(&cus, hipDeviceAttributeMultiprocessorCount, dev) != hipSuccess) { grid = -1; return; }
        if (hipFuncSetAttribute((const void*)mk_fwd, hipFuncAttributeMaxDynamicSharedMemorySize, LDS_BYTES) != hipSuccess) { grid = -1; return; }
        if (hipOccupancyMaxActiveBlocksPerMultiprocessor(&per_cu, (const void*)mk_fwd, NTHREADS, LDS_BYTES) != hipSuccess || per_cu < 1) { grid = -1; return; }
        grid = cus;
    }
    if (grid < 0) return;
    (void)hipMemsetAsync((char*)d_ws + WS_CTL, 0, CTL_ZERO_BYTES, stream);
    Args a{};
    for (int i = 0; i < 23; ++i) a.in[i] = (const float*)d_in[i];
    a.out = (float*)d_out; a.ws = (unsigned char*)d_ws;
    unsigned char* ws = (unsigned char*)d_ws;
#if HYBRID == 1
    launch_phases(a, 0, 1, grid, stream); launch_phases(a, 1, 2, grid, stream); launch_phases(a, 2, 3, grid, stream);
    const bf16* qkv = (const bf16*)(ws + WS_QKV); bf16* mix = (bf16*)(ws + WS_MIX); bf16* kcmp = (bf16*)(ws + WS_KCMP); bf16* vcmp = (bf16*)(ws + WS_VCMP);
    int* sel = (int*)(ws + 344 * MiB); float* obuf = (float*)(ws + 348 * MiB); const float* gates = (const float*)(ws + WS_GATES);
    nq::k_compress<<<dim3(4 * 2 * 512, 2), 256, 0, stream>>>(qkv, a.in[13], a.in[14], a.in[15], a.in[16], a.in[17], a.in[18], a.in[10], kcmp, vcmp);
    nq::k_moba<<<4 * 8 * SEQ / 4, 256, 0, stream>>>(qkv, (const float*)(ws + WS_KMP), a.in[2], mix);
    nq::k_nsa_cmp<<<4 * 2 * SEQ, 256, 0, stream>>>(qkv, kcmp, vcmp, gates, obuf, sel);
    nq::k_nsa_sel<<<4 * 2 * SEQ, 256, 0, stream>>>(qkv, sel, a.in[2], gates, obuf);
    nq::k_nsa_win<<<4 * 2 * SEQ, 256, 0, stream>>>(qkv, a.in[2], gates, obuf, mix);
    launch_phases(a, 5, 6, grid, stream); launch_phases(a, 6, 7, grid, stream); launch_phases(a, 7, 8, grid, stream); launch_phases(a, 8, 9, grid, stream);
#elif HYBRID == 2
    launch_phases(a, 0, 1, grid, stream); launch_phases(a, 1, 2, grid, stream); launch_phases(a, 2, 3, grid, stream);
    nq::k_compress<<<dim3(4 * 2 * 512, 2), 256, 0, stream>>>((const bf16*)(ws + WS_QKV), a.in[13], a.in[14], a.in[15], a.in[16], a.in[17], a.in[18], a.in[10], (bf16*)(ws + WS_KCMP), (bf16*)(ws + WS_VCMP));
    launch_phases(a, 4, 5, grid, stream);
    launch_phases(a, 5, 6, grid, stream); launch_phases(a, 6, 7, grid, stream); launch_phases(a, 7, 8, grid, stream); launch_phases(a, 8, 9, grid, stream);
#elif HYBRID == 3
    for (int p = 0; p < N_PHASES; ++p) {
#if defined(TIME_PHASE)
        if (p == TIME_PHASE) { for (int r = 0; r < TIME_REPS; ++r) { launch_phases(a, p, p + 1, grid, stream, TIME_FLAGS); (void)hipMemsetAsync((char*)d_ws + WS_CTL, 0, CTL_ZERO_BYTES, stream); } }
#endif
        launch_phases(a, p, p + 1, grid, stream);
#if defined(ABL_REPS)
        if (p == 3) { static bool once = false; if (!once) { once = true; (void)hipFuncSetAttribute((const void*)k_attn_abl, hipFuncAttributeMaxDynamicSharedMemorySize, LDS_BYTES); }
            for (int r = 0; r < ABL_REPS; ++r) { (void)hipMemsetAsync((char*)d_ws + WS_CTL + 512, 0, 4, stream); hipLaunchKernelGGL(k_attn_abl, dim3(grid), dim3(NTHREADS), LDS_BYTES, stream, a); } }
#endif
    }
#else
    launch_phases(a, 0, N_PHASES, grid, stream);
#endif
}
```

```cpp
#include <hip/hip_runtime.h>
#include <hip/hip_cooperative_groups.h>
#include <cstdint>
#include <cstdio>
namespace cg = cooperative_groups;
#define HYBRID 0
namespace pg8 {
#define PG8_LAS __attribute__((address_space(3)))
typedef unsigned short bf16_t;
typedef short bf16x8 __attribute__((ext_vector_type(8)));
typedef float f32x4 __attribute__((ext_vector_type(4)));
typedef unsigned u32x4 __attribute__((ext_vector_type(4)));
constexpr int BM = 256, BK = 64, HALF = 128, HTB = HALF * BK * 2  , STAGE_BYTES = 8 * HTB, NXCD = 8, WGM = 8;

__host__ __device__ __forceinline__ int lds_byte(int r, int c) { const int st = (r >> 4) * 2 + (c >> 5), rr = r & 15, cc = c & 31, ob = rr * 64 + cc * 2; return st * 1024 + (ob ^ (((ob >> 9) & 1) << 5)); }
__host__ __device__ __forceinline__ void stage_rc(int b, int& R, int& C) { const int st = b / 1024, sb = b % 1024, swz = sb ^ (((sb >> 9) & 1) << 5); R = (st >> 1) * 16 + swz / 64; C = (st & 1) * 32 + (swz % 64) / 2; }
__host__ __device__ __forceinline__ int perm32(int rho) { const int n = rho >> 4, i = rho & 15; return 8 * (i >> 2) + 4 * n + (i & 3); }

struct Unit { int pm, pn; };
struct Gemm { const bf16_t* A; const bf16_t* Bt; int M, N, K; };

struct StaticOrder {
    int nM, nN, nwg, G, c;
    __host__ __device__ void init(int M, int N, int G_, int c_) { nM = M / BM; nN = N / BM; nwg = nM * nN; G = G_; c = c_; }
    __host__ __device__ bool next(int i, Unit& u) const {
        const long L = (long)i * G + c; if (L >= nwg) return false;
        int wgid = (int)L; { const int q = nwg / NXCD, r = nwg % NXCD, xcd = wgid % NXCD, off = wgid / NXCD; wgid = (xcd < r ? xcd * (q + 1) : r * (q + 1) + (xcd - r) * q) + off; }
        const int nig = WGM * nN, gid = wgid / nig, fm = gid * WGM, gsz = (nM - fm) < WGM ? (nM - fm) : WGM;
        u.pm = fm + ((wgid % nig) % gsz); u.pn = (wgid % nig) / gsz; return true;
    }
    __device__ __forceinline__ void a_ready(const Unit&) const {}
    __device__ __forceinline__ void done(const Unit&) const {}
};

__device__ __forceinline__ unsigned cvt_pk_bf16(float lo, float hi) { unsigned r; asm volatile("v_cvt_pk_bf16_f32 %0, %1, %2" : "=v"(r) : "v"(lo), "v"(hi)); return r; }
typedef float f32x2 __attribute__((ext_vector_type(2)));
template <class Epi, class Sched, bool ALIGN_EPI = false, bool SP2 = false>
__device__ __forceinline__ void gemm_phase(PG8_LAS unsigned char* lds, const Gemm g, const Sched& S, const Epi& E) {
    const int tid = threadIdx.x, wid = __builtin_amdgcn_readfirstlane(tid >> 6), lane = tid & 63, wr = wid >> 2, wc = wid & 3, fr = lane & 15, fq = lane >> 4;
    const int K = g.K, nt = K / BK;
    unsigned voffA[2], voffB[2];
#pragma unroll
    for (int i = 0; i < 2; ++i) { int R, C; stage_rc(tid * 16 + i * 8192, R, C); const int Rb = Epi::PERM ? ((R & ~31) + perm32(R & 31)) : R;
        voffA[i] = (unsigned)(R * K + C) * 2u; voffB[i] = (unsigned)(Rb * K + C) * 2u; }
    const size_t kstep = (size_t)(BK * 2);
    const size_t hstep = (size_t)HALF * K * 2;
    const size_t tstep = 2 * hstep;
    const unsigned ldsw = (unsigned)wid * 1024u;
    const int aoff = lds_byte(wr * 64 + fr, fq * 8), boff = lds_byte(wc * 32 + fr, fq * 8);
#define PG8_SA(b, h) (((b) * 2 + (h)) * HTB)
#define PG8_SB(b, h) ((4 + (b) * 2 + (h)) * HTB)
#define PG8_STAGE(bufoff, gbase, voff) do { _Pragma("unroll") for (int _i = 0; _i < 2; ++_i) \
        __builtin_amdgcn_global_load_lds((const unsigned*)((const char*)(gbase) + (voff)[_i]), (PG8_LAS unsigned*)(lds + (bufoff) + ldsw + _i * 8192), 16, 0, 0); } while (0)
#define PG8_LDA(dst, b, h) do { _Pragma("unroll") for (int m = 0; m < 4; ++m) _Pragma("unroll") for (int k = 0; k < 2; ++k) dst[m][k] = *(const PG8_LAS bf16x8*)(lds + PG8_SA(b, h) + aoff + m * 2048 + k * 1024); } while (0)
#define PG8_LDB(dst, b, h) do { _Pragma("unroll") for (int n = 0; n < 2; ++n) _Pragma("unroll") for (int k = 0; k < 2; ++k) dst[n][k] = *(const PG8_LAS bf16x8*)(lds + PG8_SB(b, h) + boff + n * 2048 + k * 1024); } while (0)
#define PG8_MMA(ai, bj, At, Bt) do { __builtin_amdgcn_s_setprio(1); _Pragma("unroll") for (int m = 0; m < 4; ++m) _Pragma("unroll") for (int n = 0; n < 2; ++n) _Pragma("unroll") for (int k = 0; k < 2; ++k) \
        acc[ai][bj][m][n] = __builtin_amdgcn_mfma_f32_16x16x32_bf16(Bt[n][k], At[m][k], acc[ai][bj][m][n], 0, 0, 0); __builtin_amdgcn_s_setprio(0); } while (0)
#define PG8_WAIT_V(n) asm volatile("s_waitcnt vmcnt(" #n ")" ::: "memory")
#define PG8_WAIT_L(n) asm volatile("s_waitcnt lgkmcnt(" #n ")" ::: "memory")
#define PG8_BAR __builtin_amdgcn_s_barrier()
#define PG8_SCHED __builtin_amdgcn_sched_barrier(0)
    Unit cur, nxt; int ui = 0;
    if (!S.next(0, cur)) return;
    f32x4 acc[2][2][4][2];
#pragma unroll
    for (int a = 0; a < 2; ++a)
#pragma unroll
        for (int b = 0; b < 2; ++b)
#pragma unroll
            for (int m = 0; m < 4; ++m)
#pragma unroll
                for (int n = 0; n < 2; ++n) acc[a][b][m][n] = (f32x4){0.f, 0.f, 0.f, 0.f};
    bf16x8 At[4][2], B0[2][2], B1[2][2];
    const char* cA = (const char*)g.A + (size_t)cur.pm * tstep; const char* cB = (const char*)g.Bt + (size_t)cur.pn * tstep;
    S.a_ready(cur);
    if constexpr (SP2) {
        PG8_STAGE(PG8_SB(0, 0), cB, voffB); PG8_STAGE(PG8_SB(0, 1), cB + hstep, voffB); PG8_STAGE(PG8_SA(0, 0), cA, voffA); PG8_STAGE(PG8_SA(0, 1), cA + hstep, voffA);
        if (wr == 1) PG8_BAR;
        PG8_WAIT_V(2); PG8_BAR;
        PG8_STAGE(PG8_SB(1, 0), cB + kstep, voffB); PG8_STAGE(PG8_SA(1, 0), cA + kstep, voffA); PG8_STAGE(PG8_SB(1, 1), cB + hstep + kstep, voffB);
        PG8_WAIT_V(6); PG8_BAR;
    } else {
        PG8_STAGE(PG8_SB(0, 0), cB, voffB); PG8_STAGE(PG8_SA(0, 0), cA, voffA); PG8_STAGE(PG8_SB(0, 1), cB + hstep, voffB); PG8_STAGE(PG8_SA(0, 1), cA + hstep, voffA);
        if (wr == 1) PG8_BAR;
        PG8_WAIT_V(4); PG8_BAR;
        PG8_STAGE(PG8_SB(1, 0), cB + kstep, voffB); PG8_STAGE(PG8_SA(1, 0), cA + kstep, voffA); PG8_STAGE(PG8_SB(1, 1), cB + hstep + kstep, voffB);
        PG8_WAIT_V(6); PG8_BAR;
    }
    for (;;) {
        const bool has_next = S.next(ui + 1, nxt);
        const char* nA = has_next ? (const char*)g.A + (size_t)nxt.pm * tstep : cA; const char* nB = has_next ? (const char*)g.Bt + (size_t)nxt.pn * tstep : cB;
        for (int t = 0; t < nt; t += 2) {
            const bool last = (t == nt - 2);
            const char* a1 = cA + (size_t)(t + 1) * kstep;
            const char* a2 = last ? nA : cA + (size_t)(t + 2) * kstep; const char* b2 = last ? nB : cB + (size_t)(t + 2) * kstep;
            const char* a3 = a2 + kstep; const char* b3 = b2 + kstep;
            if (last && has_next) S.a_ready(nxt);
            if constexpr (SP2) {
            PG8_LDB(B0, 0, 0); PG8_LDB(B1, 0, 1); PG8_SCHED; PG8_LDA(At, 0, 0); PG8_STAGE(PG8_SA(1, 1), a1 + hstep, voffA);
            PG8_WAIT_V(8); PG8_WAIT_L(0); PG8_BAR; PG8_MMA(0, 0, At, B0); PG8_MMA(0, 1, At, B1); PG8_BAR; PG8_SCHED;
            PG8_LDA(At, 0, 1); PG8_STAGE(PG8_SB(0, 0), b2, voffB); PG8_STAGE(PG8_SB(0, 1), b2 + hstep, voffB); PG8_STAGE(PG8_SA(0, 0), a2, voffA);
            PG8_WAIT_V(8); PG8_WAIT_L(0); PG8_BAR; PG8_MMA(1, 0, At, B0); PG8_MMA(1, 1, At, B1); PG8_BAR; PG8_SCHED;
            PG8_LDB(B0, 1, 0); PG8_LDB(B1, 1, 1); PG8_SCHED; PG8_LDA(At, 1, 0); PG8_STAGE(PG8_SA(0, 1), a2 + hstep, voffA);
            PG8_WAIT_V(8); PG8_WAIT_L(0); PG8_BAR; PG8_MMA(0, 0, At, B0); PG8_MMA(0, 1, At, B1); PG8_BAR; PG8_SCHED;
            PG8_LDA(At, 1, 1); PG8_STAGE(PG8_SB(1, 0), b3, voffB); PG8_STAGE(PG8_SB(1, 1), b3 + hstep, voffB); PG8_STAGE(PG8_SA(1, 0), a3, voffA);
            PG8_WAIT_V(8); PG8_WAIT_L(0); PG8_BAR; PG8_MMA(1, 0, At, B0); PG8_MMA(1, 1, At, B1); PG8_BAR; PG8_SCHED;
            } else {
            PG8_LDB(B0, 0, 0); PG8_SCHED; PG8_LDA(At, 0, 0); PG8_STAGE(PG8_SA(1, 1), a1 + hstep, voffA);
            PG8_WAIT_L(8); PG8_BAR; PG8_WAIT_L(0); PG8_MMA(0, 0, At, B0); PG8_BAR; PG8_SCHED;
            PG8_LDB(B1, 0, 1); PG8_STAGE(PG8_SB(0, 0), b2, voffB);
            PG8_BAR; PG8_WAIT_L(0); PG8_MMA(0, 1, At, B1); PG8_BAR;
            PG8_LDA(At, 0, 1); PG8_STAGE(PG8_SA(0, 0), a2, voffA);
            PG8_BAR; PG8_WAIT_L(0); PG8_MMA(1, 0, At, B0); PG8_BAR; PG8_SCHED;
            PG8_STAGE(PG8_SB(0, 1), b2 + hstep, voffB);
            PG8_WAIT_V(6); PG8_BAR; PG8_MMA(1, 1, At, B1); PG8_BAR;
            PG8_LDB(B0, 1, 0); PG8_SCHED; PG8_LDA(At, 1, 0); PG8_STAGE(PG8_SA(0, 1), a2 + hstep, voffA);
            PG8_WAIT_L(8); PG8_BAR; PG8_WAIT_L(0); PG8_MMA(0, 0, At, B0); PG8_BAR; PG8_SCHED;
            PG8_LDB(B1, 1, 1); PG8_STAGE(PG8_SB(1, 0), b3, voffB);
            PG8_BAR; PG8_WAIT_L(0); PG8_MMA(0, 1, At, B1); PG8_BAR;
            PG8_LDA(At, 1, 1); PG8_STAGE(PG8_SA(1, 0), a3, voffA);
            PG8_BAR; PG8_WAIT_L(0); PG8_MMA(1, 0, At, B0); PG8_BAR; PG8_SCHED;
            PG8_STAGE(PG8_SB(1, 1), b3 + hstep, voffB);
            PG8_WAIT_V(6); PG8_BAR; PG8_MMA(1, 1, At, B1); PG8_BAR;
            }
        }
        if constexpr (ALIGN_EPI) { if (wr == 0) PG8_BAR; }
        if constexpr (!Epi::AFTER_DRAIN) { E(acc, cur, wr, wc, fr, fq); S.done(cur); }
        if (!has_next) break;
#pragma unroll
        for (int a = 0; a < 2; ++a)
#pragma unroll
            for (int b = 0; b < 2; ++b)
#pragma unroll
                for (int m = 0; m < 4; ++m)
#pragma unroll
                    for (int n = 0; n < 2; ++n) acc[a][b][m][n] = (f32x4){0.f, 0.f, 0.f, 0.f};
        cur = nxt; cA = nA; cB = nB; ++ui;
        if constexpr (ALIGN_EPI) { if (wr == 1) PG8_BAR; }
    }
    PG8_WAIT_V(0);
    if constexpr (!ALIGN_EPI) { if (wr == 0) PG8_BAR; }
    PG8_BAR;
    if constexpr (Epi::AFTER_DRAIN) { E.fused(acc, cur, wr, wc, fr, fq, lds, wid, lane); S.done(cur); }
#undef PG8_SA
#undef PG8_SB
#undef PG8_STAGE
#undef PG8_LDA
#undef PG8_LDB
#undef PG8_MMA
#undef PG8_WAIT_V
#undef PG8_WAIT_L
#undef PG8_BAR
#undef PG8_SCHED
}
}
namespace pg8 {
typedef unsigned u32x2v __attribute__((ext_vector_type(2)));
constexpr int TOK_S = 8192;
constexpr float QK_EPS = 1e-6f;
constexpr float C2 = 0.125f * 1.4426950408889634f;
__device__ __forceinline__ float sigmoid_fast(float v) { return __builtin_amdgcn_rcpf(1.f + __builtin_amdgcn_exp2f(-1.4426950408889634f * v)); }
__device__ __forceinline__ float silu_fast(float v) { return v * __builtin_amdgcn_rcpf(1.f + __builtin_amdgcn_exp2f(-1.4426950408889634f * v)); }

struct EpiInProj {
    static constexpr bool PERM = true, AFTER_DRAIN = false;
    bf16_t* qkv;
    float* gates;
    float* kmean_part;
    const float *qna, *kna, *qnb, *knsel, *knwin;
    __device__ __forceinline__ void operator()(const f32x4 (&acc)[2][2][4][2], const Unit& u, int wr, int wc, int fr, int fq) const {
        const int slot = u.pn * 4 + wc;
        if (slot > 44) return;
        const int b = u.pm >> 5, blk = u.pm & 31, pos0 = blk * 256 + wr * 64 + fr;
        if (slot == 44) {
            if (fq < 3) {
#pragma unroll
                for (int ai = 0; ai < 2; ++ai)
#pragma unroll
                    for (int m = 0; m < 4; ++m) { const size_t tok = (size_t)b * TOK_S + pos0 + ai * HALF + m * 16; float* gp = gates + tok * 24 + 8 * fq;
                        const f32x4 v0 = acc[ai][0][m][0], v1 = acc[ai][0][m][1];
                        *(f32x4*)gp = (f32x4){sigmoid_fast(v0[0]), sigmoid_fast(v0[1]), sigmoid_fast(v0[2]), sigmoid_fast(v0[3])};
                        *(f32x4*)(gp + 4) = (f32x4){sigmoid_fast(v1[0]), sigmoid_fast(v1[1]), sigmoid_fast(v1[2]), sigmoid_fast(v1[3])}; }
            }
            return;
        }
        const float* gain = nullptr; float qscale = 1.f; bool is_ka = false; bf16_t* dst;
        constexpr size_t BIG = (size_t)4 * 8 * TOK_S * 64, SMALL = (size_t)4 * 2 * TOK_S * 64;
        if (slot < 32) { const int kind = slot >> 3, head = slot & 7; dst = qkv + kind * BIG + ((size_t)(b * 8 + head) * TOK_S) * 64;
            if (kind == 0) { gain = qna; qscale = C2; } else if (kind == 1) { gain = kna; is_ka = true; } else if (kind == 3) { gain = qnb; qscale = C2; } }
        else { const int kind = (slot - 32) >> 1, g = slot & 1; dst = qkv + 4 * BIG + kind * SMALL + ((size_t)(b * 2 + g) * TOK_S) * 64;
            if (kind == 2) gain = knsel; else if (kind == 4) gain = knwin; }
        float gv[16];
#pragma unroll
        for (int i = 0; i < 16; ++i) gv[i] = gain ? gain[(i >> 3) * 32 + 8 * fq + (i & 7)] * qscale : 1.f;
        float cs[16];
#pragma unroll
        for (int i = 0; i < 16; ++i) cs[i] = 0.f;
#pragma unroll
        for (int ai = 0; ai < 2; ++ai)
#pragma unroll
            for (int m = 0; m < 4; ++m) {
                float v[16];
#pragma unroll
                for (int bj = 0; bj < 2; ++bj)
#pragma unroll
                    for (int n = 0; n < 2; ++n)
#pragma unroll
                        for (int j = 0; j < 4; ++j) v[bj * 8 + n * 4 + j] = acc[ai][bj][m][n][j];
                if (gain) { float ss = 0.f;
#pragma unroll
                    for (int i = 0; i < 16; ++i) ss += v[i] * v[i];
                    ss += __shfl_xor(ss, 16); ss += __shfl_xor(ss, 32);
                    const float rs = rsqrtf(ss * (1.f / 64.f) + QK_EPS);
#pragma unroll
                    for (int i = 0; i < 16; ++i) v[i] *= rs * gv[i]; }
                if (is_ka) {
#pragma unroll
                    for (int i = 0; i < 16; ++i) cs[i] += v[i]; }
                bf16_t* rp = dst + (size_t)(pos0 + ai * HALF + m * 16) * 64 + 8 * fq;
                u32x4 w0, w1;
                w0.x = cvt_pk_bf16(v[0], v[1]); w0.y = cvt_pk_bf16(v[2], v[3]); w0.z = cvt_pk_bf16(v[4], v[5]); w0.w = cvt_pk_bf16(v[6], v[7]);
                w1.x = cvt_pk_bf16(v[8], v[9]); w1.y = cvt_pk_bf16(v[10], v[11]); w1.z = cvt_pk_bf16(v[12], v[13]); w1.w = cvt_pk_bf16(v[14], v[15]);
                *(u32x4*)rp = w0; *(u32x4*)(rp + 32) = w1;
            }
        if (is_ka) {
#pragma unroll
            for (int i = 0; i < 16; ++i) { float s = cs[i]; s += __shfl_xor(s, 1); s += __shfl_xor(s, 2); s += __shfl_xor(s, 4); s += __shfl_xor(s, 8); cs[i] = s; }
            if (fr == 0) { float* kp = kmean_part + ((size_t)((b * 8 + (slot & 7)) * 32 + blk) * 2 + wr) * 64 + 8 * fq;
                *(f32x4*)kp = (f32x4){cs[0], cs[1], cs[2], cs[3]}; *(f32x4*)(kp + 4) = (f32x4){cs[4], cs[5], cs[6], cs[7]};
                *(f32x4*)(kp + 32) = (f32x4){cs[8], cs[9], cs[10], cs[11]}; *(f32x4*)(kp + 36) = (f32x4){cs[12], cs[13], cs[14], cs[15]}; }
        }
    }
};
struct EpiOutProj {
    static constexpr bool PERM = false, AFTER_DRAIN = false;
    const float* x; float* out; const float* gt;
    __device__ __forceinline__ void operator()(const f32x4 (&acc)[2][2][4][2], const Unit& u, int wr, int wc, int fr, int fq) const {
        const int b = u.pm >> 5; const int col0 = u.pn * BM + wc * 32 + 4 * fq; const float* gtb = gt + (size_t)b * 6144;
#pragma unroll
        for (int bj = 0; bj < 2; ++bj)
#pragma unroll
            for (int n = 0; n < 2; ++n) { const int c = col0 + bj * HALF + n * 16; const f32x4 g4 = *(const f32x4*)(gtb + c);
#pragma unroll
                for (int ai = 0; ai < 2; ++ai)
#pragma unroll
                    for (int m = 0; m < 4; ++m) { const size_t off = (size_t)(u.pm * BM + ai * HALF + wr * 64 + m * 16 + fr) * 1024 + c;
                        const f32x4 xv = *(const f32x4*)(x + off); *(f32x4*)(out + off) = xv + g4 * acc[ai][bj][m][n]; } }
    }
};
struct EpiGateUp {
    static constexpr bool PERM = true, AFTER_DRAIN = false;
    bf16_t* act;
    __device__ __forceinline__ void operator()(const f32x4 (&acc)[2][2][4][2], const Unit& u, int wr, int wc, int fr, int fq) const {
        const int h0 = u.pn * 128 + wc * 32 + 8 * fq;
#pragma unroll
        for (int ai = 0; ai < 2; ++ai)
#pragma unroll
            for (int m = 0; m < 4; ++m) { const size_t row = (size_t)(u.pm * BM + ai * HALF + wr * 64 + m * 16 + fr);
                const f32x4 g0 = acc[ai][0][m][0], g1 = acc[ai][0][m][1], u0 = acc[ai][1][m][0], u1 = acc[ai][1][m][1];
                u32x4 w;
                w.x = cvt_pk_bf16(silu_fast(g0[0]) * u0[0], silu_fast(g0[1]) * u0[1]); w.y = cvt_pk_bf16(silu_fast(g0[2]) * u0[2], silu_fast(g0[3]) * u0[3]);
                w.z = cvt_pk_bf16(silu_fast(g1[0]) * u1[0], silu_fast(g1[1]) * u1[1]); w.w = cvt_pk_bf16(silu_fast(g1[2]) * u1[2], silu_fast(g1[3]) * u1[3]);
                *(u32x4*)(act + row * 2816 + h0) = w; }
    }
};
struct EpiDown {
    static constexpr bool PERM = false, AFTER_DRAIN = false;
    float* out; const float* gt;
    __device__ __forceinline__ void operator()(const f32x4 (&acc)[2][2][4][2], const Unit& u, int wr, int wc, int fr, int fq) const {
        const int b = u.pm >> 5; const int col0 = u.pn * BM + wc * 32 + 4 * fq; const float* gtb = gt + (size_t)b * 6144;
#pragma unroll
        for (int bj = 0; bj < 2; ++bj)
#pragma unroll
            for (int n = 0; n < 2; ++n) { const int c = col0 + bj * HALF + n * 16; const f32x4 g4 = *(const f32x4*)(gtb + c);
#pragma unroll
                for (int ai = 0; ai < 2; ++ai)
#pragma unroll
                    for (int m = 0; m < 4; ++m) { const size_t off = (size_t)(u.pm * BM + ai * HALF + wr * 64 + m * 16 + fr) * 1024 + c;
                        const f32x4 xv = *(const f32x4*)(out + off); *(f32x4*)(out + off) = xv + g4 * acc[ai][bj][m][n]; } }
    }
};
}
constexpr int NWAVES = 8, NTHREADS = 512;
constexpr int BATCH = 4, SEQ = 8192, DM = 1024, TOK = BATCH * SEQ, NIN = 2840, NIN_PAD = 3072, FF = 2816, NCMP = 511;
constexpr size_t MiB = 1u << 20;
constexpr size_t WS_CTL = 0, CTL_ZERO_BYTES = 64 * 1024;
constexpr size_t WS_MODP = 1 * MiB;
constexpr size_t WS_MOD = 2 * MiB;
constexpr size_t WS_CBP = 2 * MiB + 512 * 1024;
constexpr size_t WS_KMP = 3 * MiB;
constexpr size_t WS_BIAS2 = 4 * MiB;
constexpr size_t WS_SSP = 449 * MiB;
constexpr size_t WS_WIN = 6 * MiB, WS_WOUT = 12 * MiB, WS_WGU = 14 * MiB, WS_WDN = 25 * MiB;
constexpr size_t WS_W1K = 31 * MiB, WS_W1V = 32 * MiB, WS_W2K = 33 * MiB, WS_W2V = 33 * MiB + 64 * 1024;
constexpr size_t WS_KCMP = 34 * MiB, WS_VCMP = 35 * MiB;
constexpr size_t WS_GATES = 36 * MiB;
constexpr size_t WS_H = 40 * MiB;
constexpr size_t WS_MIX = 104 * MiB;
constexpr size_t WS_QKV = 168 * MiB;
constexpr size_t WS_ACT = WS_QKV;
constexpr size_t WS_END = 344 * MiB;
constexpr size_t WS_PARTO = 344 * MiB;
constexpr size_t WS_PARTL = 472 * MiB;
constexpr size_t WS_SELG = 476 * MiB;
constexpr size_t QKV_BIG = (size_t)4 * 8 * SEQ * 64, QKV_SMALL = (size_t)4 * 2 * SEQ * 64;
constexpr int RING_BYTES = 131072, LDS_BYTES = 147456;
constexpr int N_PHASES = 10;

#define GAS __attribute__((address_space(1)))
#define LAS __attribute__((address_space(3)))
typedef unsigned short bf16;
typedef unsigned v4u __attribute__((ext_vector_type(4)));
typedef float f32x4 __attribute__((ext_vector_type(4)));
#define LDS_WAIT() asm volatile("s_waitcnt lgkmcnt(0)" ::: "memory")
#define VM_WAIT() asm volatile("s_waitcnt vmcnt(0)" ::: "memory")
__device__ __forceinline__ unsigned f2bf(float f) { unsigned u = __builtin_bit_cast(unsigned, f); return (u + 0x7fffu + ((u >> 16) & 1u)) >> 16; }
__device__ __forceinline__ unsigned pk2(float lo, float hi) { return f2bf(lo) | (f2bf(hi) << 16); }
__device__ __forceinline__ float bf2f(bf16 v) { return __builtin_bit_cast(float, (unsigned)v << 16); }
__device__ __forceinline__ float wave_sum(float v) {
#pragma unroll
    for (int o = 1; o < 64; o <<= 1) v += __shfl_xor(v, o);
    return v;
}
struct Args { const float* in[23]; float* out; unsigned char* ws; int ph_lo, ph_hi; };
struct Frame { LAS unsigned char* lds; int tid, lane, wave, vcu, G; };

struct MapId { __device__ __forceinline__ size_t off(int n, int k, int K) const { return (size_t)n * K + k; } };
struct MapWin { __device__ __forceinline__ size_t off(int n, int k, int K) const { const int s = n >> 6, d = n & 63; return (size_t)(256 * (s >> 2) + 128 * (d >> 5) + 32 * (s & 3) + (d & 31)) * K + k; } };
struct MapWgu { __device__ __forceinline__ size_t off(int n, int k, int K) const { const int up = n >= FF, hdn = up ? n - FF : n; return (size_t)(256 * (hdn >> 7) + 128 * up + (hdn & 127)) * K + k; } };
struct MapFrag { __device__ __forceinline__ size_t off(int n, int k, int K) const { return ((size_t)((k >> 4) * 8 + (n >> 5)) * 64 + ((k >> 3) & 1) * 32 + (n & 31)) * 8 + (k & 7); } };
template <class Map>
__device__ __forceinline__ void transpose_item(const float* __restrict__ W, int K, int N, bf16* WT, LAS float* scr, int item, int lane, const Map& map) {
    const int nblk = (N + 63) / 64, kb = item / nblk, nb = item % nblk, k0 = 64 * kb, n0 = 64 * nb;
    const int nc = n0 + 4 * (lane & 15); const bool nin = nc < N;
    f32x4 v[16];
#pragma unroll
    for (int i = 0; i < 16; ++i) { const int kk = 4 * i + (lane >> 4); v[i] = nin ? *(const GAS f32x4*)(W + (size_t)(k0 + kk) * N + nc) : (f32x4){0.f, 0.f, 0.f, 0.f}; }
#pragma unroll
    for (int i = 0; i < 16; ++i) { const int kk = 4 * i + (lane >> 4); LAS float* d = scr + (4 * (lane & 15)) * 68 + kk; d[0] = v[i][0]; d[68] = v[i][1]; d[136] = v[i][2]; d[204] = v[i][3]; }
    LDS_WAIT(); asm volatile("" ::: "memory");
    const int c = lane & 7;
#pragma unroll
    for (int j = 0; j < 8; ++j) { const int n = (lane >> 3) + 8 * j; const LAS float* s = scr + n * 68 + 8 * c;
        const f32x4 a = *(const LAS f32x4*)s, bq = *(const LAS f32x4*)(s + 4);
        v4u o; o.x = pk2(a[0], a[1]); o.y = pk2(a[2], a[3]); o.z = pk2(bq[0], bq[1]); o.w = pk2(bq[2], bq[3]);
        if (n0 + n < N) *(GAS v4u*)(WT + map.off(n0 + n, k0 + 8 * c, K)) = o; }
    LDS_WAIT(); asm volatile("" ::: "memory");
}
__device__ __forceinline__ float silu_acc(float v) { return v / (1.f + expf(-v)); }
__device__ __forceinline__ void phase_prologue_a(Frame& F, const Args& a) {
    LAS float* scr = (LAS float*)(F.lds + F.wave * 17408);
    const int gw = F.vcu * NWAVES + F.wave, NGW = F.G * NWAVES;
    unsigned char* ws = a.ws;
    constexpr int I_IN = (DM / 64) * ((NIN + 63) / 64), I_OUT = (DM / 64) * (DM / 64), I_GU = (DM / 64) * (2 * FF / 64), I_DN = (FF / 64) * (DM / 64), I_W1 = (2048 / 64) * (256 / 64), I_W2 = (256 / 64) * (64 / 64);
    constexpr int NITEMS = I_IN + I_OUT + I_GU + I_DN + 2 * I_W1 + 2 * I_W2;
    for (int it = gw; it < NITEMS; it += NGW) {
        int r = it;
        if (r < I_IN) { transpose_item(a.in[6], DM, NIN, (bf16*)(ws + WS_WIN), scr, r, F.lane, MapWin()); continue; } r -= I_IN;
        if (r < I_OUT) { transpose_item(a.in[19], DM, DM, (bf16*)(ws + WS_WOUT), scr, r, F.lane, MapId()); continue; } r -= I_OUT;
        if (r < I_GU) { transpose_item(a.in[21], DM, 2 * FF, (bf16*)(ws + WS_WGU), scr, r, F.lane, MapWgu()); continue; } r -= I_GU;
        if (r < I_DN) { transpose_item(a.in[22], FF, DM, (bf16*)(ws + WS_WDN), scr, r, F.lane, MapId()); continue; } r -= I_DN;
        if (r < I_W1) { transpose_item(a.in[14], 2048, 256, (bf16*)(ws + WS_W1K), scr, r, F.lane, MapFrag()); continue; } r -= I_W1;
        if (r < I_W1) { transpose_item(a.in[17], 2048, 256, (bf16*)(ws + WS_W1V), scr, r, F.lane, MapFrag()); continue; } r -= I_W1;
        if (r < I_W2) { transpose_item(a.in[15], 256, 64, (bf16*)(ws + WS_W2K), scr, r, F.lane, MapId()); continue; } r -= I_W2;
        transpose_item(a.in[18], 256, 64, (bf16*)(ws + WS_W2V), scr, r, F.lane, MapId());
    }
    const float* c = a.in[1]; const float* w_ada = a.in[3]; float* modp = (float*)(ws + WS_MODP);
    for (int t = NGW - 1 - gw; t < 96 * 8; t += NGW) { const int cg_ = t % 96, ks = t / 96; const int n = cg_ * 64 + F.lane;
        float acc0 = 0.f, acc1 = 0.f, acc2 = 0.f, acc3 = 0.f;
#pragma unroll
        for (int i = 0; i < 8; ++i) { const int idx = F.lane + 64 * i, bb = idx >> 7, kk = idx & 127; scr[kk * 4 + bb] = silu_acc(c[bb * DM + ks * 128 + kk]); }
        LDS_WAIT(); asm volatile("" ::: "memory");
#pragma unroll 8
        for (int k = 0; k < 128; ++k) { const float w = w_ada[(size_t)(ks * 128 + k) * 6144 + n]; const f32x4 sv = *(const LAS f32x4*)(scr + 4 * k);
            acc0 += sv[0] * w; acc1 += sv[1] * w; acc2 += sv[2] * w; acc3 += sv[3] * w; }
        LDS_WAIT(); asm volatile("" ::: "memory");
        float* o = modp + (size_t)ks * 4 * 6144 + n; o[0] = acc0; o[6144] = acc1; o[2 * 6144] = acc2; o[3 * 6144] = acc3; }
    float* cbp = (float*)(ws + WS_CBP);
    for (int t = NGW / 2 - 1 - gw; t >= 0 && t < 256; t += NGW) { const int kv = t & 1, cg_ = (t >> 1) & 3, ic = t >> 3; const int n = cg_ * 64 + F.lane;
        const float* pe = kv ? a.in[16] : a.in[13]; const float* w1 = kv ? a.in[17] : a.in[14]; float acc = 0.f;
#pragma unroll 8
        for (int i = ic * 64; i < ic * 64 + 64; ++i) acc += pe[i] * w1[(size_t)i * 256 + n];
        cbp[(ic * 2 + kv) * 256 + n] = acc; }
}
__device__ __forceinline__ void norm_rows(Frame& F, int blk, const float* in, const f32x4 (&gs)[4], const f32x4 (&sh)[4], bf16* out) {
    for (int i0 = 0; i0 < 16; i0 += 4) {
        f32x4 v[4][4]; float ss[4];
#pragma unroll
        for (int r = 0; r < 4; ++r) { const int row = blk * 128 + F.wave * 16 + i0 + r; const GAS f32x4* xr = (const GAS f32x4*)(in + (size_t)row * DM) + F.lane;
#pragma unroll
            for (int j = 0; j < 4; ++j) v[r][j] = xr[64 * j]; }
#pragma unroll
        for (int r = 0; r < 4; ++r) { float s = 0.f;
#pragma unroll
            for (int j = 0; j < 4; ++j) s += (v[r][j].x * v[r][j].x + v[r][j].y * v[r][j].y) + (v[r][j].z * v[r][j].z + v[r][j].w * v[r][j].w);
            ss[r] = s; }
#pragma unroll
        for (int o_ = 1; o_ < 64; o_ <<= 1) {
#pragma unroll
            for (int r = 0; r < 4; ++r) ss[r] += __shfl_xor(ss[r], o_); }
#pragma unroll
        for (int r = 0; r < 4; ++r) { const int row = blk * 128 + F.wave * 16 + i0 + r; const float rs = rsqrtf(ss[r] * (1.f / DM) + 1e-6f);
            GAS unsigned long long* o8 = (GAS unsigned long long*)(out + (size_t)row * DM) + F.lane;
#pragma unroll
            for (int j = 0; j < 4; ++j) { const f32x4 y = v[r][j] * rs * gs[j] + sh[j]; o8[64 * j] = (unsigned long long)pk2(y.x, y.y) | ((unsigned long long)pk2(y.z, y.w) << 32); } }
    }
}
__device__ __forceinline__ void phase_prologue_b(Frame& F, const Args& a) {
    unsigned char* ws = a.ws; const float* modp = (const float*)(ws + WS_MODP); const float* b_ada = a.in[4];
    if (F.wave == 0) for (int cgp = F.vcu; cgp < 96; cgp += F.G) { const int n = cgp * 64 + F.lane; float* mod = (float*)(ws + WS_MOD);
        for (int b = 0; b < 4; ++b) { float s = 0.f;
#pragma unroll
            for (int ks = 0; ks < 8; ++ks) s += modp[((size_t)ks * 4 + b) * 6144 + n];
            mod[b * 6144 + n] = s + b_ada[n]; } }
    const float* g = a.in[5];
    for (int blk = F.vcu; blk < TOK / 128; blk += F.G) { const int b = blk >> 6;
    f32x4 gs[4], sh[4];
#pragma unroll
    for (int j = 0; j < 4; ++j) { const int c0 = 4 * F.lane + 256 * j; f32x4 s0 = {0.f, 0.f, 0.f, 0.f}, s1 = {0.f, 0.f, 0.f, 0.f};
#pragma unroll
        for (int ks = 0; ks < 8; ++ks) { s0 += *(const f32x4*)(modp + ((size_t)ks * 4 + b) * 6144 + c0); s1 += *(const f32x4*)(modp + ((size_t)ks * 4 + b) * 6144 + DM + c0); }
        s0 += *(const f32x4*)(b_ada + c0); s1 += *(const f32x4*)(b_ada + DM + c0);
        sh[j] = s0; gs[j] = *(const f32x4*)(g + c0) * (s1 + 1.0f); }
    norm_rows(F, blk, a.in[0], gs, sh, (bf16*)(ws + WS_H)); }
}
__device__ __forceinline__ void phase_norm2(Frame& F, const Args& a) {
    unsigned char* ws = a.ws; const float* g = a.in[20];
    for (int blk = F.vcu; blk < TOK / 128; blk += F.G) { const int b = blk >> 6; const float* mod = (const float*)(ws + WS_MOD) + (size_t)b * 6144;
        f32x4 gs[4], sh[4];
#pragma unroll
        for (int j = 0; j < 4; ++j) { const int c0 = 4 * F.lane + 256 * j; sh[j] = *(const f32x4*)(mod + 3 * DM + c0); gs[j] = *(const f32x4*)(g + c0) * (*(const f32x4*)(mod + 4 * DM + c0) + 1.0f); }
        norm_rows(F, blk, a.out, gs, sh, (bf16*)(ws + WS_H)); }
}

__device__ __forceinline__ void phase_bias2(Frame& F, const Args& a) {
    unsigned char* ws = a.ws; const float* mod = (const float*)(ws + WS_MOD); const bf16* wt = (const bf16*)(ws + WS_WGU); float* bias2 = (float*)(ws + WS_BIAS2);
    const int gw = F.vcu * NWAVES + F.wave, NGW = F.G * NWAVES;
    f32x4 sh[4][4];
#pragma unroll
    for (int bb = 0; bb < 4; ++bb)
#pragma unroll
        for (int j = 0; j < 4; ++j) sh[bb][j] = *(const f32x4*)(mod + (size_t)bb * 6144 + 3 * DM + 16 * F.lane + 4 * j);
    for (int c = gw; c < 2 * FF; c += NGW) {
        const v4u w0 = *(const GAS v4u*)(wt + (size_t)c * DM + 16 * F.lane), w1 = *(const GAS v4u*)(wt + (size_t)c * DM + 16 * F.lane + 8);
        const unsigned wu[8] = {w0.x, w0.y, w0.z, w0.w, w1.x, w1.y, w1.z, w1.w};
        float s[4] = {0.f, 0.f, 0.f, 0.f};
#pragma unroll
        for (int j = 0; j < 4; ++j) { const float e0 = __builtin_bit_cast(float, wu[2 * j] << 16), e1 = __builtin_bit_cast(float, wu[2 * j] & 0xffff0000u), e2 = __builtin_bit_cast(float, wu[2 * j + 1] << 16), e3 = __builtin_bit_cast(float, wu[2 * j + 1] & 0xffff0000u);
#pragma unroll
            for (int bb = 0; bb < 4; ++bb) s[bb] += (sh[bb][j][0] * e0 + sh[bb][j][1] * e1) + (sh[bb][j][2] * e2 + sh[bb][j][3] * e3); }
#pragma unroll
        for (int bb = 0; bb < 4; ++bb) { const float t = wave_sum(s[bb]); if (F.lane == 0) bias2[(size_t)bb * 2 * FF + c] = t; }
    }
}
#define XB_TMO      128
#define XB_XCNT(j)  (256  + 64 * (j))
#define XB_XSUB(j)  (1280 + 64 * (j))
#define XB_XGEN(j)  (2304 + 64 * (j))
#define XB_TOP      3328
#define XB_TOPGEN   3392
#define XCD_BAR_WORDS 3456
#define XB_SPIN_CAP (1u << 18)

__device__ __forceinline__ unsigned xb_ld(unsigned* p)              { return __hip_atomic_load(p, __ATOMIC_RELAXED, __HIP_MEMORY_SCOPE_AGENT); }
__device__ __forceinline__ unsigned xb_add(unsigned* p, unsigned v) { return __hip_atomic_fetch_add(p, v, __ATOMIC_RELAXED, __HIP_MEMORY_SCOPE_AGENT); }
__device__ __forceinline__ unsigned xb_xcc_id() { return (unsigned)__builtin_amdgcn_s_getreg((3 << 11) | 20) & 0xFu; }
#define XB_SPIN(cond, bar) do { unsigned _sp = 0; while (cond) { __builtin_amdgcn_s_sleep(1); \
    if ((++_sp & 255u) == 0u) { if (xb_ld(&(bar)[XB_TMO])) break; if (_sp > XB_SPIN_CAP) { atomicAdd(&(bar)[XB_TMO], 1u); break; } } } } while (0)

struct XcdBarrier {
    unsigned* bar; unsigned x;
    volatile LAS unsigned* st;
};

__device__ __forceinline__ XcdBarrier xcd_barrier_post(unsigned* bar, volatile LAS unsigned* st) {
    XcdBarrier b; b.bar = bar; b.x = xb_xcc_id(); b.st = st;
    if (threadIdx.x == 0) (void)xb_add(&bar[XB_XCNT(b.x)], 1u);
    return b;
}
__device__ __forceinline__ void xcd_barrier_complete(unsigned* bar, unsigned x, unsigned& nloc, unsigned& nx) {
    const unsigned G = gridDim.x * gridDim.y * gridDim.z;
    unsigned sum, cnt, mine, sp = 0u;
    for (;;) {
        sum = 0u; cnt = 0u; mine = 0u;
#pragma unroll
        for (unsigned j = 0; j < 16; ++j) { const unsigned c = xb_ld(&bar[XB_XCNT(j)]); sum += c; cnt += (c > 0u) ? 1u : 0u; mine = (j == x) ? c : mine; }
        if (sum == G) break;
        __builtin_amdgcn_s_sleep(1);
        if ((++sp & 255u) == 0u) { if (xb_ld(&bar[XB_TMO])) break; if (sp > XB_SPIN_CAP) { atomicAdd(&bar[XB_TMO], 1u); break; } }
    }
    nloc = mine > 0u ? mine : 1u; nx = cnt > 0u ? cnt : 1u;
}

__device__ __forceinline__ void xcd_barrier(const XcdBarrier& b) {
    asm volatile("s_waitcnt vmcnt(0)" ::: "memory");
    __syncthreads();
    if (threadIdx.x == 0) {
        unsigned* bar = b.bar;
        __builtin_amdgcn_s_waitcnt(0);
        unsigned nloc = b.st[0], nx = b.st[1];
        if (nloc == 0u) { xcd_barrier_complete(bar, b.x, nloc, nx); b.st[0] = nloc; b.st[1] = nx; }
        const unsigned old = xb_add(&bar[XB_XSUB(b.x)], 1u);
        const unsigned gen = old / nloc;
        if (old + 1u == (gen + 1u) * nloc) {
            __builtin_amdgcn_fence(__ATOMIC_RELEASE, "agent");
            asm volatile("s_waitcnt vmcnt(0)" ::: "memory");
            const unsigned og = xb_add(&bar[XB_TOP], 1u);
            const unsigned tg = og / nx;
            if (og + 1u == (tg + 1u) * nx) xb_add(&bar[XB_TOPGEN], 1u);
            else XB_SPIN(xb_ld(&bar[XB_TOPGEN]) == tg, bar);
            __builtin_amdgcn_fence(__ATOMIC_ACQUIRE, "agent");
            xb_add(&bar[XB_XGEN(b.x)], 1u);
            asm volatile("s_waitcnt vmcnt(0)" ::: "memory");
        } else {
            XB_SPIN(xb_ld(&bar[XB_XGEN(b.x)]) == gen, bar);
            __builtin_amdgcn_fence(__ATOMIC_ACQUIRE, "agent");
            asm volatile("s_waitcnt vmcnt(0)" ::: "memory");
        }
    }
    __syncthreads();
}
#define ATT_NS att
#ifndef ATT_ABL
#define ATT_ABL 0
#endif
#ifndef ATT_STAGGER
#define ATT_STAGGER 0
#endif
#ifndef ATT_SLEEP
#define ATT_SLEEP 24
#endif
namespace ATT_NS {
using bf16x8 = __attribute__((ext_vector_type(8))) short;
using s16x4 = __attribute__((ext_vector_type(4))) short;
using f32x16 = __attribute__((ext_vector_type(16))) float;
using u32x4 = __attribute__((ext_vector_type(4))) unsigned;
typedef LAS const char* lds_cptr;
typedef short v4i16_t __attribute__((ext_vector_type(4)));
constexpr int SLOT = 16384, NSLOT = 4, LDS_OST = 65536, LDS_LUT = 98304, LDS_IMP = 100352, LDS_SELM = 133120, LDS_MISC = 134144, LDS_WSF = 134400, LDS_LUTG = 136448  , LDS_ATT_END = 144640;
constexpr float LOG2E = 1.4426950408889634f;
#define MFMA32(a, b, c) __builtin_amdgcn_mfma_f32_32x32x16_bf16(a, b, c, 0, 0, 0)
#define ATT_WAIT_BAR(N) asm volatile("s_waitcnt vmcnt(" #N ") lgkmcnt(0)\n\ts_barrier" ::: "memory")
__device__ __forceinline__ void glds16(const void* gsrc, unsigned lds_dst) { unsigned keep;
    asm volatile("s_mov_b32 %0, m0\n\ts_mov_b32 m0, %2\n\ts_nop 0\n\tglobal_load_lds_dwordx4 %1, off\n\ts_mov_b32 m0, %0" : "=&s"(keep) : "v"(gsrc), "s"(lds_dst) : "memory"); }
typedef float f32x2_t __attribute__((ext_vector_type(2))); typedef __bf16 bf16x2_t __attribute__((ext_vector_type(2)));
__device__ __forceinline__ unsigned cvtpk(float lo, float hi) { f32x2_t v = {lo, hi}; bf16x2_t b = __builtin_convertvector(v, bf16x2_t); return __builtin_bit_cast(unsigned, b); }
__device__ __forceinline__ s16x4 vtr(lds_cptr p) { return __builtin_bit_cast(s16x4, __builtin_amdgcn_ds_read_tr16_b64_v4i16((LAS v4i16_t*)p)); }
__device__ __forceinline__ int t5_bucket(int d) {
    if (d < 16) return d;
    int b = 16;
    b += (d >= 19); b += (d >= 21); b += (d >= 24); b += (d >= 27); b += (d >= 31); b += (d >= 35); b += (d >= 40); b += (d >= 46);
    b += (d >= 52); b += (d >= 59); b += (d >= 67); b += (d >= 77); b += (d >= 87); b += (d >= 99); b += (d >= 113);
    return b;
}
struct Ctx { LAS char* lds; int wid; int lane, r32, hi; };
__device__ __forceinline__ int fresh_lane() { int l; asm volatile("v_mbcnt_lo_u32_b32 %0, -1, 0\n\tv_mbcnt_hi_u32_b32 %0, -1, %0" : "=v"(l)); return l; }
__device__ __forceinline__ Ctx make_ctx(LAS unsigned char* lds, int tid) {
    Ctx c; c.lds = (LAS char*)lds; c.wid = __builtin_amdgcn_readfirstlane(tid >> 6); c.lane = tid & 63; c.r32 = c.lane & 31; c.hi = c.lane >> 5; return c;
}
template <bool HASV, class QK, class SM>
__device__ __forceinline__ void run_stream(const Ctx& c, const bf16* Kb, const bf16* Vb, int t0, int t1, QK&& qk, SM&& sm) {
    const int n = t1 - t0; if (n <= 0) return;
    const int lane = fresh_lane(), r32 = lane & 31, hi = lane >> 5; const unsigned lds0 = (unsigned)(uintptr_t)c.lds;
    const bf16* ks = Kb + ((8 * c.wid + (lane >> 3)) * 64 + (((lane & 7) ^ (((8 * c.wid + (lane >> 3)) >> 1) & 7)) << 3)); const bf16* vs = Vb + ((16 * (c.wid & 3) + (lane >> 2)) * 64 + (c.wid >> 2) * 32 + (lane & 3) * 8);
    const unsigned kdst = lds0 + c.wid * 1024, vdst = lds0 + 8192 + c.wid * 1024;
    const lds_cptr kp0 = (lds_cptr)c.lds + r32 * 128;
    const lds_cptr vp0 = (lds_cptr)c.lds + 8192 + ((lane >> 4) & 1) * 32 + (lane & 3) * 8 + (4 * hi + ((lane & 15) >> 2)) * 64;
#define ATT_ISSUE(t, so) do { if (ATT_ABL & 4) break; glds16(ks + (size_t)(t) * 4096, (unsigned)__builtin_amdgcn_readfirstlane(kdst + (so))); if (HASV) glds16(vs + (size_t)(t) * 4096, (unsigned)__builtin_amdgcn_readfirstlane(vdst + (so))); } while (0)
    ATT_ISSUE(t0, 0); if (n > 1) ATT_ISSUE(t0 + 1, SLOT);
    const bool late = ATT_STAGGER && __builtin_amdgcn_readfirstlane(c.wid) >= 4;
    f32x16 s0 = {}, s1 = {};
    int slot = 0, slotp = 3 * SLOT, slot2 = 2 * SLOT;
    if (!late) {
        for (int i = 0; i < n; ++i) {
            if (i + 1 < n) { if (HASV) ATT_WAIT_BAR(2); else ATT_WAIT_BAR(1); } else ATT_WAIT_BAR(0);
            if (i + 2 < n) ATT_ISSUE(t0 + i + 2, slot2);
            if (!(ATT_ABL & 1)) qk(t0 + i, kp0 + slot, s0, s1); if (!(ATT_ABL & 2)) sm(t0 + i, vp0 + slot, s0, s1);
            slot = (slot == 3 * SLOT) ? 0 : slot + SLOT; slot2 = (slot2 == 3 * SLOT) ? 0 : slot2 + SLOT;
        }
    } else {
        for (int i = 0; i < n; ++i) {
            if (i + 1 < n) { if (HASV) ATT_WAIT_BAR(2); else ATT_WAIT_BAR(1); } else ATT_WAIT_BAR(0);
            if (i + 2 < n) ATT_ISSUE(t0 + i + 2, slot2);
            if (i > 0 && !(ATT_ABL & 2)) sm(t0 + i - 1, vp0 + slotp, s0, s1);
            if (!(ATT_ABL & 1)) qk(t0 + i, kp0 + slot, s0, s1);
            slotp = slot; slot = (slot == 3 * SLOT) ? 0 : slot + SLOT; slot2 = (slot2 == 3 * SLOT) ? 0 : slot2 + SLOT;
        }
        if (!(ATT_ABL & 2)) sm(t0 + n - 1, vp0 + slotp, s0, s1);
    }
    asm volatile("s_waitcnt lgkmcnt(0)\n\ts_barrier" ::: "memory");
#undef ATT_ISSUE
}
template <class FN1, class FN2>
__device__ __forceinline__ void run_stream_pairs(const Ctx& c, const bf16* Kb, const bf16* Vb, int t0, int t1, FN1&& fn1, FN2&& fn2) {
    const int n = t1 - t0; if (n <= 0) return;
    const int lane = fresh_lane(), r32 = lane & 31, hi = lane >> 5; const unsigned lds0 = (unsigned)(uintptr_t)c.lds;
    const bf16* ks = Kb + ((8 * c.wid + (lane >> 3)) * 64 + (((lane & 7) ^ (((8 * c.wid + (lane >> 3)) >> 1) & 7)) << 3)); const bf16* vs = Vb + ((16 * (c.wid & 3) + (lane >> 2)) * 64 + (c.wid >> 2) * 32 + (lane & 3) * 8);
    const unsigned kdst = lds0 + c.wid * 1024, vdst = lds0 + 8192 + c.wid * 1024;
    const lds_cptr kp0 = (lds_cptr)c.lds + r32 * 128;
    const lds_cptr vp0 = (lds_cptr)c.lds + 8192 + ((lane >> 4) & 1) * 32 + (lane & 3) * 8 + (4 * hi + ((lane & 15) >> 2)) * 64;
#define ATT_ISSUE1(t, so) do { glds16(ks + (size_t)(t) * 4096, (unsigned)__builtin_amdgcn_readfirstlane(kdst + (so))); glds16(vs + (size_t)(t) * 4096, (unsigned)__builtin_amdgcn_readfirstlane(vdst + (so))); } while (0)
    ATT_ISSUE1(t0, 0); if (n > 1) ATT_ISSUE1(t0 + 1, SLOT);
    int base = 0;
    for (int i = 0; i < n; i += 2) {
        ATT_WAIT_BAR(0);
        const int nb = 2 * SLOT - base;
        if (i + 2 < n) ATT_ISSUE1(t0 + i + 2, nb); if (i + 3 < n) ATT_ISSUE1(t0 + i + 3, nb + SLOT);
        if (i + 1 < n) fn2(t0 + i, kp0 + base, vp0 + base, kp0 + base + SLOT, vp0 + base + SLOT); else fn1(t0 + i, kp0 + base, vp0 + base);
        base = nb;
    }
    asm volatile("s_waitcnt lgkmcnt(0)\n\ts_barrier" ::: "memory");
#undef ATT_ISSUE1
}
__device__ __forceinline__ void qk_tile(f32x16& s0, f32x16& s1, lds_cptr kp, const bf16x8 (&qr)[4]) {
    bf16x8 kf[8];
    { const int l = fresh_lane(), f = ((l & 31) >> 1) & 7, hi = l >> 5;
#pragma unroll
      for (int d0 = 0; d0 < 4; ++d0) { const int off = ((2 * d0 + hi) ^ f) << 4; kf[2 * d0] = *(const LAS bf16x8*)(kp + off); kf[2 * d0 + 1] = *(const LAS bf16x8*)(kp + 4096 + off); } }
    const f32x16 z = {};
    s0 = MFMA32(kf[0], qr[0], z); s1 = MFMA32(kf[1], qr[0], z);
#pragma unroll
    for (int d0 = 1; d0 < 4; ++d0) { s0 = MFMA32(kf[2 * d0], qr[d0], s0); s1 = MFMA32(kf[2 * d0 + 1], qr[d0], s1); }
}
template <bool MASK>
__device__ __forceinline__ void pv_tile(f32x16 (&o)[2], lds_cptr vp, const f32x16& p0, const f32x16& p1, unsigned mask) {
    if (ATT_ABL & 8) { o[0][0] += p0[0] + p1[5]; return; }
    u32x4 pw0 = {cvtpk(p0[0], p0[1]), cvtpk(p0[2], p0[3]), cvtpk(p0[4], p0[5]), cvtpk(p0[6], p0[7])}, pw1 = {cvtpk(p0[8], p0[9]), cvtpk(p0[10], p0[11]), cvtpk(p0[12], p0[13]), cvtpk(p0[14], p0[15])};
    u32x4 pw2 = {cvtpk(p1[0], p1[1]), cvtpk(p1[2], p1[3]), cvtpk(p1[4], p1[5]), cvtpk(p1[6], p1[7])}, pw3 = {cvtpk(p1[8], p1[9]), cvtpk(p1[10], p1[11]), cvtpk(p1[12], p1[13]), cvtpk(p1[14], p1[15])};
    if (MASK) { pw0 &= mask; pw1 &= mask; pw2 &= mask; pw3 &= mask; }
    if (ATT_ABL & 64) { o[0] = MFMA32(__builtin_bit_cast(bf16x8, pw0), __builtin_bit_cast(bf16x8, pw1), o[0]); o[1] = MFMA32(__builtin_bit_cast(bf16x8, pw2), __builtin_bit_cast(bf16x8, pw3), o[1]); return; }
    s16x4 vlo[8], vhi[8];
#pragma unroll
    for (int i = 0; i < 8; ++i) { vlo[i] = vtr(vp + ((i >> 2) * 4096 + (i & 3) * 1024)); vhi[i] = vtr(vp + ((i >> 2) * 4096 + (i & 3) * 1024 + 512)); }
#define ATT_VFR(i) (bf16x8){vlo[i][0], vlo[i][1], vlo[i][2], vlo[i][3], vhi[i][0], vhi[i][1], vhi[i][2], vhi[i][3]}
    o[0] = MFMA32(__builtin_bit_cast(bf16x8, pw0), ATT_VFR(0), o[0]); o[1] = MFMA32(__builtin_bit_cast(bf16x8, pw0), ATT_VFR(4), o[1]);
    o[0] = MFMA32(__builtin_bit_cast(bf16x8, pw1), ATT_VFR(1), o[0]); o[1] = MFMA32(__builtin_bit_cast(bf16x8, pw1), ATT_VFR(5), o[1]);
    o[0] = MFMA32(__builtin_bit_cast(bf16x8, pw2), ATT_VFR(2), o[0]); o[1] = MFMA32(__builtin_bit_cast(bf16x8, pw2), ATT_VFR(6), o[1]);
    o[0] = MFMA32(__builtin_bit_cast(bf16x8, pw3), ATT_VFR(3), o[0]); o[1] = MFMA32(__builtin_bit_cast(bf16x8, pw3), ATT_VFR(7), o[1]);
#undef ATT_VFR
}
#define ATT_SB() __builtin_amdgcn_sched_barrier(0)
struct KF { bf16x8 f[8]; };
struct VF { s16x4 lo[8], hi[8]; };
struct PW4 { u32x4 w0, w1, w2, w3; };
__device__ __forceinline__ void ld_k(KF& k, lds_cptr kp) {
    const int l = fresh_lane(), f = ((l & 31) >> 1) & 7, hi = l >> 5;
#pragma unroll
    for (int d0 = 0; d0 < 4; ++d0) { const int off = ((2 * d0 + hi) ^ f) << 4; k.f[2 * d0] = *(const LAS bf16x8*)(kp + off); k.f[2 * d0 + 1] = *(const LAS bf16x8*)(kp + 4096 + off); } }
__device__ __forceinline__ void qk_mfma(f32x16& s0, f32x16& s1, const KF& k, const bf16x8 (&qr)[4]) {
    const f32x16 z = {};
    s0 = MFMA32(k.f[0], qr[0], z); s1 = MFMA32(k.f[1], qr[0], z);
#pragma unroll
    for (int d0 = 1; d0 < 4; ++d0) { s0 = MFMA32(k.f[2 * d0], qr[d0], s0); s1 = MFMA32(k.f[2 * d0 + 1], qr[d0], s1); } }
__device__ __forceinline__ void ld_v(VF& v, lds_cptr vp) {
#pragma unroll
    for (int i = 0; i < 8; ++i) { v.lo[i] = vtr(vp + ((i >> 2) * 4096 + (i & 3) * 1024)); v.hi[i] = vtr(vp + ((i >> 2) * 4096 + (i & 3) * 1024 + 512)); } }
__device__ __forceinline__ PW4 pack4(const f32x16& p0, const f32x16& p1, unsigned mask) { PW4 w;
    w.w0 = (u32x4){cvtpk(p0[0], p0[1]), cvtpk(p0[2], p0[3]), cvtpk(p0[4], p0[5]), cvtpk(p0[6], p0[7])}; w.w1 = (u32x4){cvtpk(p0[8], p0[9]), cvtpk(p0[10], p0[11]), cvtpk(p0[12], p0[13]), cvtpk(p0[14], p0[15])};
    w.w2 = (u32x4){cvtpk(p1[0], p1[1]), cvtpk(p1[2], p1[3]), cvtpk(p1[4], p1[5]), cvtpk(p1[6], p1[7])}; w.w3 = (u32x4){cvtpk(p1[8], p1[9]), cvtpk(p1[10], p1[11]), cvtpk(p1[12], p1[13]), cvtpk(p1[14], p1[15])};
    w.w0 &= mask; w.w1 &= mask; w.w2 &= mask; w.w3 &= mask; return w; }
__device__ __forceinline__ void pv_mfma(f32x16 (&o)[2], const VF& v, const PW4& w) {
#define ATT_VF(i) (bf16x8){v.lo[i][0], v.lo[i][1], v.lo[i][2], v.lo[i][3], v.hi[i][0], v.hi[i][1], v.hi[i][2], v.hi[i][3]}
    o[0] = MFMA32(__builtin_bit_cast(bf16x8, w.w0), ATT_VF(0), o[0]); o[1] = MFMA32(__builtin_bit_cast(bf16x8, w.w0), ATT_VF(4), o[1]);
    o[0] = MFMA32(__builtin_bit_cast(bf16x8, w.w1), ATT_VF(1), o[0]); o[1] = MFMA32(__builtin_bit_cast(bf16x8, w.w1), ATT_VF(5), o[1]);
    o[0] = MFMA32(__builtin_bit_cast(bf16x8, w.w2), ATT_VF(2), o[0]); o[1] = MFMA32(__builtin_bit_cast(bf16x8, w.w2), ATT_VF(6), o[1]);
    o[0] = MFMA32(__builtin_bit_cast(bf16x8, w.w3), ATT_VF(3), o[0]); o[1] = MFMA32(__builtin_bit_cast(bf16x8, w.w3), ATT_VF(7), o[1]);
#undef ATT_VF
}
__device__ __forceinline__ float rowsum32(const f32x16& p0, const f32x16& p1) { if (ATT_ABL & 32) return p0[0]; float a = p0[0] + p1[0], b = p0[1] + p1[1];
#pragma unroll
    for (int r = 2; r < 16; r += 2) { a += p0[r]; asm volatile("" : "+v"(a)); b += p0[r + 1]; asm volatile("" : "+v"(b)); a += p1[r]; asm volatile("" : "+v"(a)); b += p1[r + 1]; asm volatile("" : "+v"(b)); }
    return a + b; }
__device__ __forceinline__ void hook_exp(f32x16& s0, f32x16& s1) {
    if (ATT_ABL & 16) return;
#pragma unroll
    for (int r = 0; r < 16; ++r) { s0[r] = __builtin_amdgcn_exp2f(s0[r]); s1[r] = __builtin_amdgcn_exp2f(s1[r]); } }
__device__ __forceinline__ void hook_near(f32x16& s0, f32x16& s1, int base, const LAS float* lut) {
    asm volatile("" : "+v"(base));
#pragma unroll
    for (int r = 0; r < 16; ++r) { const int d0 = base - ((r & 3) + 8 * (r >> 2)), d1 = d0 - 32;
        s0[r] = __builtin_amdgcn_exp2f(s0[r] + lut[min(max(d0, -1), 113) + 1]); s1[r] = __builtin_amdgcn_exp2f(s1[r] + lut[min(max(d1, -1), 113) + 1]); } }
__device__ __forceinline__ void hook_edge(f32x16& s0, f32x16& s1, int base, int win) {
    asm volatile("" : "+v"(base));
#pragma unroll
    for (int r = 0; r < 16; ++r) { const int d0 = base - ((r & 3) + 8 * (r >> 2)), d1 = d0 - 32;
        s0[r] = __builtin_amdgcn_exp2f(d0 < win ? s0[r] : -INFINITY); s1[r] = __builtin_amdgcn_exp2f(d1 < win ? s1[r] : -INFINITY); } }
__device__ __forceinline__ void hook_cmp(f32x16& s0, f32x16& s1, int nrel  , float cb) {
    asm volatile("" : "+v"(nrel));
#pragma unroll
    for (int r = 0; r < 16; ++r) { const int c0 = (r & 3) + 8 * (r >> 2);
        s0[r] = __builtin_amdgcn_exp2f(s0[r] + ((c0 <= nrel) ? cb : -INFINITY)); s1[r] = __builtin_amdgcn_exp2f(s1[r] + ((c0 + 32 <= nrel) ? cb : -INFINITY)); } }
__device__ __forceinline__ void row_factors(const Ctx& c, float f, float (&fr)[16]) {
    const int lane = fresh_lane(), r32 = lane & 31, hi = lane >> 5; LAS float* wsf = (LAS float*)(c.lds + LDS_WSF) + c.wid * 64;
    asm volatile("s_waitcnt lgkmcnt(0)" ::: "memory");
    if (hi == 0) wsf[r32] = f;
    asm volatile("s_waitcnt lgkmcnt(0)" ::: "memory");
#pragma unroll
    for (int r = 0; r < 16; ++r) fr[r] = wsf[(r & 3) + 8 * (r >> 2) + 4 * hi];
    asm volatile("s_waitcnt lgkmcnt(0)" ::: "memory");
}
__device__ __forceinline__ float pair_sum(float v) { auto rr = __builtin_amdgcn_permlane32_swap(__float_as_uint(v), __float_as_uint(v), false, false); return __uint_as_float(rr[0]) + __uint_as_float(rr[1]); }
template <class RowOff>
__device__ __forceinline__ void store_rows(const Ctx& c, const f32x16 (&o)[2], bf16* dst, RowOff&& rowoff) {
    LAS bf16* stg = (LAS bf16*)(c.lds + LDS_OST) + c.wid * 2048;
    const int lane = fresh_lane(), r32 = lane & 31, hi = lane >> 5;
#pragma unroll
    for (int r = 0; r < 16; ++r) { const int orow = (r & 3) + 8 * (r >> 2) + 4 * hi;
#pragma unroll
        for (int d0 = 0; d0 < 2; ++d0) stg[orow * 64 + d0 * 32 + r32] = (bf16)f2bf(o[d0][r]); }
    asm volatile("s_waitcnt lgkmcnt(0)" ::: "memory");
#pragma unroll
    for (int i = 0; i < 4; ++i) { const int row = i * 8 + (lane >> 3), ch = lane & 7; const u32x4 v = *(const LAS u32x4*)(stg + row * 64 + ch * 8); *(u32x4*)(dst + rowoff(row) + ch * 8) = v; }
    asm volatile("s_waitcnt lgkmcnt(0)" ::: "memory");
}
struct AttnPtrs { const bf16* qkv; const float* kmp; const float* gates; const bf16* kcmp; const bf16* vcmp; const float* rel_bias; bf16* mix; unsigned* selg; bf16* part_o; float* part_l; };

__device__ __forceinline__ unsigned moba_gate32(const AttnPtrs& P, int b, int h, int i, const bf16x8 (&qr)[4], int r32, int hi) {
    unsigned selmask = 0u;
    if (i > 0) {
        bf16x8 kmf[4];
        const float* kp = P.kmp + ((size_t)((b * 8 + h) * 32 + r32) * 2) * 64;
#pragma unroll
        for (int d0 = 0; d0 < 4; ++d0) { const f32x4 a0 = *(const f32x4*)(kp + d0 * 16 + hi * 8), a1 = *(const f32x4*)(kp + d0 * 16 + hi * 8 + 4), b0 = *(const f32x4*)(kp + 64 + d0 * 16 + hi * 8), b1 = *(const f32x4*)(kp + 64 + d0 * 16 + hi * 8 + 4);
            const f32x4 m0 = (a0 + b0) * (1.f / 256.f), m1 = (a1 + b1) * (1.f / 256.f);
            u32x4 w = {cvtpk(m0[0], m0[1]), cvtpk(m0[2], m0[3]), cvtpk(m1[0], m1[1]), cvtpk(m1[2], m1[3])}; kmf[d0] = __builtin_bit_cast(bf16x8, w); }
        f32x16 sg = {};
#pragma unroll
        for (int d0 = 0; d0 < 4; ++d0) sg = MFMA32(kmf[d0], qr[d0], sg);
        float v[16];
#pragma unroll
        for (int r = 0; r < 16; ++r) v[r] = ((r & 3) + 8 * (r >> 2) + 4 * hi < i) ? sg[r] : -INFINITY;
#pragma unroll
        for (int it = 0; it < 3; ++it) {
            float m = v[0]; int jb = 4 * hi;
#pragma unroll
            for (int r = 1; r < 16; ++r) { const int j = (r & 3) + 8 * (r >> 2) + 4 * hi; if (v[r] > m) { m = v[r]; jb = j; } }
            auto rm = __builtin_amdgcn_permlane32_swap(__float_as_uint(m), __float_as_uint(m), false, false);
            auto rj = __builtin_amdgcn_permlane32_swap((unsigned)jb, (unsigned)jb, false, false);
            const float mo = __uint_as_float(hi ? rm[0] : rm[1]); const int jo = (int)(hi ? rj[0] : rj[1]);
            const bool mine = (m > mo) || (m == mo && jb < jo);
            const float mw = mine ? m : mo; const int jw = mine ? jb : jo;
            if (mw > -INFINITY) { selmask |= 1u << jw;
#pragma unroll
                for (int r = 0; r < 16; ++r) if ((r & 3) + 8 * (r >> 2) + 4 * hi == jw) v[r] = -INFINITY; }
        }
    }
    return selmask;
}
__device__ __forceinline__ void moba_gate_phase(const AttnPtrs& P, int vcu, int G, int tid) {
    const int lane = tid & 63, r32 = lane & 31, hi = lane >> 5; const int wid = __builtin_amdgcn_readfirstlane(tid >> 6);
    for (int task = vcu * 8 + wid; task < 8192; task += G * 8) { const int w = task & 7, i = (task >> 3) & 31, bh = task >> 8; const int qpos = 256 * i + 32 * w + r32;
        const bf16* QA = P.qkv + ((size_t)bh * SEQ) * 64;
        bf16x8 qr[4];
#pragma unroll
        for (int d0 = 0; d0 < 4; ++d0) qr[d0] = *(const bf16x8*)(QA + (size_t)qpos * 64 + d0 * 16 + hi * 8);
        const unsigned m = moba_gate32(P, bh >> 3, bh & 7, i, qr, r32, hi);
        if (hi == 0) P.selg[(size_t)bh * SEQ + qpos] = m; }
}
__device__ __forceinline__ void moba_lut(const Ctx& c, const AttnPtrs& P, int h) {
    LAS float* lut = (LAS float*)(c.lds + LDS_LUT);
    if (threadIdx.x < 115) lut[threadIdx.x] = (threadIdx.x == 0) ? -INFINITY : (P.rel_bias[t5_bucket(threadIdx.x - 1) * 16 + h] - P.rel_bias[31 * 16 + h]) * LOG2E;
}
__device__ __forceinline__ void moba_past_item(const Ctx& c, const AttnPtrs& P, int b, int h, int j) {
    const int bh = b * 8 + h, tid = threadIdx.x;
    const bf16* QA = P.qkv + ((size_t)bh * SEQ) * 64; const bf16* KA = QA + QKV_BIG + (size_t)256 * j * 64; const bf16* VA = QA + 2 * QKV_BIG + (size_t)256 * j * 64;
    const LAS float* lut = (const LAS float*)(c.lds + LDS_LUTG) + h * 128;
    { const int lane = fresh_lane(); const unsigned lds0 = (unsigned)(uintptr_t)c.lds;
      const bf16* ks = KA + ((8 * c.wid + (lane >> 3)) * 64 + (((lane & 7) ^ (((8 * c.wid + (lane >> 3)) >> 1) & 7)) << 3)); const bf16* vs = VA + ((16 * (c.wid & 3) + (lane >> 2)) * 64 + (c.wid >> 2) * 32 + (lane & 3) * 8);
#pragma unroll
      for (int tt = 0; tt < 4; ++tt) { glds16(ks + tt * 4096, (unsigned)__builtin_amdgcn_readfirstlane(lds0 + c.wid * 1024 + tt * SLOT)); glds16(vs + tt * 4096, (unsigned)__builtin_amdgcn_readfirstlane(lds0 + 8192 + c.wid * 1024 + tt * SLOT)); } }
    LAS unsigned short* list = (LAS unsigned short*)(c.lds + LDS_IMP);
    LAS unsigned* wcnt = (LAS unsigned*)(c.lds + LDS_MISC) + 8;
    const unsigned* sg = P.selg + (size_t)bh * SEQ;
    if (tid < 256) list[tid] = (unsigned short)((256 * j + tid) | (3 << 13));
    int total = 256;
    for (int base = (j + 1) * 256; base < SEQ; base += 2048) {
        const int q0 = base + 4 * tid; uint4 m4 = make_uint4(0u, 0u, 0u, 0u); if (q0 < SEQ) m4 = *(const uint4*)(sg + q0);
        const unsigned long long b0 = __ballot((m4.x >> j) & 1u), b1 = __ballot((m4.y >> j) & 1u), b2 = __ballot((m4.z >> j) & 1u), b3 = __ballot((m4.w >> j) & 1u);
        const int c0 = (int)__popcll(b0), c1 = (int)__popcll(b1), c2 = (int)__popcll(b2), c3 = (int)__popcll(b3);
        if ((tid & 63) == 0) wcnt[c.wid] = (unsigned)(c0 + c1 + c2 + c3);
        asm volatile("s_waitcnt vmcnt(0) lgkmcnt(0)\n\ts_barrier" ::: "memory");
        int off = total, tot = 0;
#pragma unroll
        for (int w = 0; w < 8; ++w) { const int v = (int)wcnt[w]; off += (w < c.wid) ? v : 0; tot += v; }
        const unsigned long long below = (1ull << (tid & 63)) - 1ull; const unsigned lowj = (1u << j) - 1u;
        if ((m4.x >> j) & 1u) list[off + __popcll(b0 & below)] = (unsigned short)((q0 + 0) | (__popc(m4.x & lowj) << 13)); off += c0;
        if ((m4.y >> j) & 1u) list[off + __popcll(b1 & below)] = (unsigned short)((q0 + 1) | (__popc(m4.y & lowj) << 13)); off += c1;
        if ((m4.z >> j) & 1u) list[off + __popcll(b2 & below)] = (unsigned short)((q0 + 2) | (__popc(m4.z & lowj) << 13)); off += c2;
        if ((m4.w >> j) & 1u) list[off + __popcll(b3 & below)] = (unsigned short)((q0 + 3) | (__popc(m4.w & lowj) << 13));
        total += tot;
        asm volatile("s_waitcnt lgkmcnt(0)\n\ts_barrier" ::: "memory");
    }
    total = __builtin_amdgcn_readfirstlane(total);
    { const int npad = (32 - (total & 31)) & 31; if (tid < npad) list[total + tid] = 0xFFFFu; }
    const int nchunks = (total + 31) >> 5;
    asm volatile("s_waitcnt vmcnt(0) lgkmcnt(0)\n\ts_barrier" ::: "memory");
    for (int ch = c.wid; ch < nchunks; ch += 8) {
        const int lane = fresh_lane(), r32 = lane & 31, hi = lane >> 5;
        const lds_cptr kp0 = (lds_cptr)c.lds + r32 * 128;
        const lds_cptr vp0 = (lds_cptr)c.lds + 8192 + ((lane >> 4) & 1) * 32 + (lane & 3) * 8 + (4 * hi + ((lane & 15) >> 2)) * 64;
        const unsigned e = list[32 * ch + r32]; const bool valid = e != 0xFFFFu; const int q = valid ? (int)(e & 0x1FFFu) : SEQ - 1;
        bf16x8 qr[4];
#pragma unroll
        for (int d0 = 0; d0 < 4; ++d0) qr[d0] = *(const bf16x8*)(QA + (size_t)q * 64 + d0 * 16 + hi * 8);
        asm volatile("" : "+v"(qr[0]), "+v"(qr[1]), "+v"(qr[2]), "+v"(qr[3]));
        const bool anynear = __any(valid && (unsigned)((q >> 8) - j) <= 1u);
        f32x16 o[2]; o[0] = f32x16{}; o[1] = f32x16{}; float l_reg = 0.f;
#pragma unroll 1
        for (int tt = 0; tt < 4; ++tt) { f32x16 s0, s1; qk_tile(s0, s1, kp0 + tt * SLOT, qr);
            if (anynear) hook_near(s0, s1, q - (256 * j + 64 * tt) - 4 * hi, lut); else hook_exp(s0, s1);
            l_reg += rowsum32(s0, s1);
            pv_tile<false>(o, vp0 + tt * SLOT, s0, s1, 0u); }
        const float L = pair_sum(l_reg);
        if (hi == 0 && valid) P.part_l[((size_t)bh * SEQ + q) * 4 + (e >> 13)] = L;
        LAS bf16* stg = (LAS bf16*)(c.lds + LDS_OST) + c.wid * 2048;
#pragma unroll
        for (int r = 0; r < 16; ++r) { const int orow = (r & 3) + 8 * (r >> 2) + 4 * hi;
#pragma unroll
            for (int d0 = 0; d0 < 2; ++d0) stg[orow * 64 + d0 * 32 + r32] = (bf16)f2bf(o[d0][r]); }
        asm volatile("s_waitcnt lgkmcnt(0)" ::: "memory");
#pragma unroll
        for (int it = 0; it < 4; ++it) { const int row = it * 8 + (lane >> 3), chn = lane & 7; const unsigned e2 = list[32 * ch + row];
            const u32x4 v = *(const LAS u32x4*)(stg + row * 64 + chn * 8);
            if (e2 != 0xFFFFu) *(u32x4*)(P.part_o + (((size_t)bh * SEQ + (e2 & 0x1FFFu)) * 4 + (e2 >> 13)) * 64 + chn * 8) = v; }
        asm volatile("s_waitcnt lgkmcnt(0)" ::: "memory");
    }
    asm volatile("s_waitcnt lgkmcnt(0)\n\ts_barrier" ::: "memory");
}
__device__ __forceinline__ void moba_merge_pass(const AttnPtrs& P, int vcu, int G, int tid) {
    const int lane = tid & 63, h = lane >> 3, chn = lane & 7; const int wid = __builtin_amdgcn_readfirstlane(tid >> 6);
#pragma unroll 2
    for (int tok = vcu * 8 + wid; tok < TOK; tok += G * 8) { const int b = tok >> 13, q = tok & (SEQ - 1);
        const size_t qi = (size_t)(b * 8 + h) * SEQ + q; const int ns = __popc(P.selg[qi]);
        float Lt = P.part_l[qi * 4 + 3]; const u32x4 pw = *(const u32x4*)(P.part_o + (qi * 4 + 3) * 64 + chn * 8);
        f32x4 a0 = {__uint_as_float(pw.x << 16), __uint_as_float(pw.x & 0xffff0000u), __uint_as_float(pw.y << 16), __uint_as_float(pw.y & 0xffff0000u)};
        f32x4 a1 = {__uint_as_float(pw.z << 16), __uint_as_float(pw.z & 0xffff0000u), __uint_as_float(pw.w << 16), __uint_as_float(pw.w & 0xffff0000u)};
#pragma unroll
        for (int sidx = 0; sidx < 3; ++sidx) if (sidx < ns) { Lt += P.part_l[qi * 4 + sidx]; const u32x4 pv = *(const u32x4*)(P.part_o + (qi * 4 + sidx) * 64 + chn * 8);
            a0 += (f32x4){__uint_as_float(pv.x << 16), __uint_as_float(pv.x & 0xffff0000u), __uint_as_float(pv.y << 16), __uint_as_float(pv.y & 0xffff0000u)};
            a1 += (f32x4){__uint_as_float(pv.z << 16), __uint_as_float(pv.z & 0xffff0000u), __uint_as_float(pv.w << 16), __uint_as_float(pv.w & 0xffff0000u)}; }
        const float inv = 1.f / Lt; a0 *= inv; a1 *= inv;
        const u32x4 w = {cvtpk(a0[0], a0[1]), cvtpk(a0[2], a0[3]), cvtpk(a1[0], a1[1]), cvtpk(a1[2], a1[3])};
        *(u32x4*)(P.mix + (size_t)tok * DM + h * 64 + chn * 8) = w; }
}

__device__ __forceinline__ void nsa_item(const Ctx& c, const AttnPtrs& P, int b, int g, int ci, int flags = 0) {
    const int ql = 8 * c.wid + (c.r32 >> 2), rh = c.r32 & 3, qpos = 64 * ci + ql, hb = 4 * g + rh;
    const int qw0 = 64 * ci + 8 * c.wid;
    const bf16* QB = P.qkv + 3 * QKV_BIG + ((size_t)(b * 8 + hb) * SEQ) * 64;
    const bf16* KS = P.qkv + 4 * QKV_BIG + 2 * QKV_SMALL + ((size_t)(b * 2 + g) * SEQ) * 64; const bf16* VS = KS + QKV_SMALL; const bf16* KW = KS + 2 * QKV_SMALL; const bf16* VW = KS + 3 * QKV_SMALL;
    const bf16* KC = P.kcmp + (size_t)(b * 2 + g) * 512 * 64; const bf16* VC = P.vcmp + (size_t)(b * 2 + g) * 512 * 64;
    bf16x8 qr[4];
#pragma unroll
    for (int d0 = 0; d0 < 4; ++d0) qr[d0] = *(const bf16x8*)(QB + (size_t)qpos * 64 + d0 * 16 + c.hi * 8);
    asm volatile("" : "+v"(qr[0]), "+v"(qr[1]), "+v"(qr[2]), "+v"(qr[3]));
    const LAS float* lut = (const LAS float*)(c.lds + LDS_LUTG) + (8 + hb) * 128;
    LAS float* imp = (LAS float*)(c.lds + LDS_IMP);
    LAS unsigned* selm = (LAS unsigned*)(c.lds + LDS_SELM);
    f32x16 o[2]; float l_reg; float fr[16];
    LAS float* park = (LAS float*)(c.lds + LDS_OST) + c.wid * 1024 + c.lane;
    LAS float* park1 = (LAS float*)(c.lds + LDS_IMP) + c.wid * 1024 + c.lane;
    const int nct = (4 * ci + 3 + 63) >> 6;
    const int nlim = (qpos >= 31) ? ((qpos - 31) >> 4) : -1;
    LAS bf16* impt = (LAS bf16*)(c.lds + ((rh & 2) ? LDS_IMP : LDS_OST)) + ((rh & 1) * 64 + ql) * 128;
    l_reg = 0.f; o[0] = f32x16{}; o[1] = f32x16{};
    {
        float carry = 0.f;
        run_stream<true>(c, KC, VC, 0, nct,
          [&](int t, lds_cptr kp, f32x16& s0, f32x16& s1) { qk_tile(s0, s1, kp, qr); },
          [&](int t, lds_cptr vp, f32x16& s0, f32x16& s1) {
            hook_cmp(s0, s1, nlim - 64 * t - 4 * c.hi, 0.f);
            l_reg += rowsum32(s0, s1);
#pragma unroll
            for (int half = 0; half < 2; ++half) {
                float g4[4], e[4];
#pragma unroll
                for (int a = 0; a < 4; ++a) { const float x0 = half ? s1[4 * a] : s0[4 * a], x1 = half ? s1[4 * a + 1] : s0[4 * a + 1], x2 = half ? s1[4 * a + 2] : s0[4 * a + 2], x3 = half ? s1[4 * a + 3] : s0[4 * a + 3];
                    g4[a] = (x0 + x1) + (x2 + x3); e[a] = x3; }
                float x[4];
#pragma unroll
                for (int a = 0; a < 4; ++a) { auto rr = __builtin_amdgcn_permlane32_swap(__float_as_uint(e[a]), __float_as_uint(e[a]), false, false); x[a] = __uint_as_float(c.hi ? rr[0] : rr[1]); }
                const int jb = 16 * t + 8 * half;
                float iv[4];
                if (c.hi) {
#pragma unroll
                    for (int a = 0; a < 4; ++a) iv[a] = g4[a] + x[a]; }
                else { iv[0] = g4[0] + carry; iv[1] = g4[1] + x[0]; iv[2] = g4[2] + x[1]; iv[3] = g4[3] + x[2]; carry = x[3]; }
#pragma unroll
                for (int a = 0; a < 4; ++a) impt[jb + 2 * a + c.hi] = (bf16)f2bf(iv[a]);
            }
            pv_tile<false>(o, vp, s0, s1, 0u);
        });
    }
    const float Lc = pair_sum(l_reg); const float invLc = Lc > 0.f ? 1.f / Lc : 0.f;
    { LAS float* wsfw = (LAS float*)(c.lds + LDS_WSF) + c.wid * 64; if (c.hi == 0) wsfw[32 + c.r32] = invLc; }
    {
        asm volatile("s_waitcnt lgkmcnt(0)\n\ts_barrier" ::: "memory");
        const int qq = 8 * c.wid + (c.lane >> 3), cc = c.lane & 7;
        unsigned m0 = 0u, m1 = 0u, m2w = 0u, m3 = 0u;
        if (ci <= 15) { m0 = (ci == 31) ? 0xffffffffu : ((2u << ci) - 1u); }
        else {
            float v[16];
            const LAS float* il = (const LAS float*)(c.lds + LDS_WSF) + c.wid * 64 + 32 + 4 * (c.lane >> 3);
            const float i0 = il[0], i1 = il[1], i2 = il[2], i3 = il[3];
            const LAS bf16* ta = (const LAS bf16*)(c.lds + LDS_OST) + qq * 128; const LAS bf16* tb = (const LAS bf16*)(c.lds + LDS_IMP) + qq * 128;
#pragma unroll
            for (int k = 0; k < 16; ++k) { const int j = cc + 8 * k;
                v[k] = (j >= 1 && j <= ci - 2) ? (bf2f(ta[j]) * i0 + bf2f(ta[64 * 128 + j]) * i1) + (bf2f(tb[j]) * i2 + bf2f(tb[64 * 128 + j]) * i3) : -INFINITY; }
            for (int it = 0; it < 13; ++it) {
                float m = v[0]; int jb = cc;
#pragma unroll
                for (int k = 1; k < 16; ++k) if (v[k] > m) { m = v[k]; jb = cc + 8 * k; }
#pragma unroll
                for (int sft = 1; sft < 8; sft <<= 1) { const float mo = __shfl_xor(m, sft); const int jo = __shfl_xor(jb, sft); if (mo > m || (mo == m && jo < jb)) { m = mo; jb = jo; } }
                if (m > -INFINITY) { const unsigned bit = 1u << (jb & 31); const int wsel = jb >> 5;
                    m0 |= (wsel == 0) ? bit : 0u; m1 |= (wsel == 1) ? bit : 0u; m2w |= (wsel == 2) ? bit : 0u; m3 |= (wsel == 3) ? bit : 0u;
#pragma unroll
                    for (int k = 0; k < 16; ++k) if (cc + 8 * k == jb) v[k] = -INFINITY; }
            }
            m0 |= 1u;
#pragma unroll
            for (int z = 0; z < 2; ++z) { const int jf = ci - z; const unsigned bit = 1u << (jf & 31); const int wsel = jf >> 5;
                m0 |= (wsel == 0) ? bit : 0u; m1 |= (wsel == 1) ? bit : 0u; m2w |= (wsel == 2) ? bit : 0u; m3 |= (wsel == 3) ? bit : 0u; }
        }
        if (cc == 0) { selm[qq * 4 + 0] = m0; selm[qq * 4 + 1] = m1; selm[qq * 4 + 2] = m2w; selm[qq * 4 + 3] = m3; }
        asm volatile("s_waitcnt lgkmcnt(0)\n\ts_barrier" ::: "memory");
    }
    const float* gp = P.gates + ((size_t)b * SEQ + qpos) * 24 + hb * 3; float g0 = gp[0], g1 = gp[1], g2 = gp[2];
    asm volatile("" : "+v"(g0), "+v"(g1), "+v"(g2));
    row_factors(c, g0 * invLc, fr);
#pragma unroll
    for (int r = 0; r < 16; ++r) { park[r * 64] = o[0][r] * fr[r]; park1[r * 64] = o[1][r] * fr[r]; }
    {
        const unsigned w0 = selm[ql * 4 + 0], w1 = selm[ql * 4 + 1], w2 = selm[ql * 4 + 2], w3 = selm[ql * 4 + 3];
        o[0] = f32x16{}; o[1] = f32x16{}; l_reg = 0.f;
        auto sel_pred = [&](int t) -> bool { const unsigned wsel = (t < 32) ? w0 : (t < 64) ? w1 : (t < 96) ? w2 : w3; return (wsel >> (t & 31)) & 1u; };
        auto sel_one = [&](int t, lds_cptr kp, lds_cptr vp) { const bool pred = sel_pred(t); if (!__any(pred)) return; const int key0 = 64 * t;
            f32x16 s0, s1; qk_tile(s0, s1, kp, qr);
            if (qw0 - key0 - 63 >= 113) { hook_exp(s0, s1); const float rs = rowsum32(s0, s1); l_reg += pred ? rs : 0.f;
                if (__all(pred)) pv_tile<false>(o, vp, s0, s1, 0u); else pv_tile<true>(o, vp, s0, s1, pred ? 0xffffffffu : 0u); }
            else { hook_near(s0, s1, qpos - key0 - 4 * c.hi, lut); const float rs = rowsum32(s0, s1); l_reg += pred ? rs : 0.f;
                if (__all(pred)) pv_tile<false>(o, vp, s0, s1, 0u); else pv_tile<true>(o, vp, s0, s1, pred ? 0xffffffffu : 0u); } };
        if (!(flags & 4)) run_stream_pairs(c, KS, VS, 0, ci + 1, sel_one,
            [&](int t, lds_cptr kpA, lds_cptr vpA, lds_cptr kpB, lds_cptr vpB) {
                if (qw0 - 64 * (t + 1) - 63 >= 113) {
                    const bool pa = sel_pred(t), pb = sel_pred(t + 1);
                    const bool xa = __any(pa), xb = __any(pb);
                    if (!xa && !xb) return;
                    if (!xb) { sel_one(t, kpA, vpA); return; }
                    if (!xa) { sel_one(t + 1, kpB, vpB); return; }
                    KF kA, kB; ld_k(kA, kpA); ATT_SB();
                    f32x16 a0, a1, b0, b1; qk_mfma(a0, a1, kA, qr); ATT_SB();
                    VF vA, vB; ld_k(kB, kpB); ld_v(vA, vpA); ATT_SB();
                    qk_mfma(b0, b1, kB, qr); hook_exp(a0, a1);
                    const float ra = rowsum32(a0, a1); const PW4 wa = pack4(a0, a1, pa ? 0xffffffffu : 0u); ATT_SB();
                    ld_v(vB, vpB); ATT_SB();
                    pv_mfma(o, vA, wa); hook_exp(b0, b1);
                    const float rb = rowsum32(b0, b1); const PW4 wb = pack4(b0, b1, pb ? 0xffffffffu : 0u); l_reg += (pa ? ra : 0.f) + (pb ? rb : 0.f); ATT_SB();
                    pv_mfma(o, vB, wb);
                } else { sel_one(t, kpA, vpA); sel_one(t + 1, kpB, vpB); } });
        const float Ls = pair_sum(l_reg);
        row_factors(c, g1 / Ls, fr);
#pragma unroll
        for (int r = 0; r < 16; ++r) { park[r * 64] += o[0][r] * fr[r]; park1[r * 64] += o[1][r] * fr[r]; }
    }
    {
        o[0] = f32x16{}; o[1] = f32x16{}; l_reg = 0.f;
        if (!(flags & 8)) run_stream<true>(c, KW, VW, ci >= 8 ? ci - 8 : 0, ci + 1,
            [&](int t, lds_cptr kp, f32x16& s0, f32x16& s1) { qk_tile(s0, s1, kp, qr); },
            [&](int t, lds_cptr vp, f32x16& s0, f32x16& s1) { const int key0 = 64 * t;
                if (qw0 - key0 - 63 < 113) hook_near(s0, s1, qpos - key0 - 4 * c.hi, lut); else if (qw0 + 7 - key0 >= 512) hook_edge(s0, s1, qpos - key0 - 4 * c.hi, 512); else hook_exp(s0, s1);
                l_reg += rowsum32(s0, s1);
                pv_tile<false>(o, vp, s0, s1, 0u); });
        const float Lw = pair_sum(l_reg);
        row_factors(c, g2 / Lw, fr);
#pragma unroll
        for (int r = 0; r < 16; ++r) { o[0][r] = park[r * 64] + o[0][r] * fr[r]; o[1][r] = park1[r * 64] + o[1][r] * fr[r]; }
        asm volatile("s_waitcnt lgkmcnt(0)" ::: "memory");
    }
    bf16* dst = P.mix + ((size_t)b * SEQ + 64 * ci + 8 * c.wid) * DM + 512 + g * 256;
    store_rows(c, o, dst, [](int row) { return (size_t)(row >> 2) * DM + (row & 3) * 64; });
    asm volatile("s_waitcnt lgkmcnt(0)\n\ts_barrier" ::: "memory");
}

__device__ __forceinline__ void attn_phase(LAS unsigned char* lds, const AttnPtrs& P, unsigned* qcounter, int flags) {
    Ctx c = make_ctx(lds, threadIdx.x);
    LAS unsigned* misc = (LAS unsigned*)(c.lds + LDS_MISC);
    { LAS float* lutg = (LAS float*)(c.lds + LDS_LUTG);
      for (int idx = threadIdx.x; idx < 16 * 115; idx += NTHREADS) { const int hh = idx / 115, d = idx % 115;
          lutg[hh * 128 + d] = (d == 0) ? -INFINITY : (P.rel_bias[t5_bucket(d - 1) * 16 + hh] - P.rel_bias[31 * 16 + hh]) * LOG2E; }
      asm volatile("s_waitcnt vmcnt(0) lgkmcnt(0)\n\ts_barrier" ::: "memory"); }
    for (;;) {
        if (threadIdx.x == 0) misc[0] = __hip_atomic_fetch_add(qcounter, 1u, __ATOMIC_RELAXED, __HIP_MEMORY_SCOPE_AGENT);
        asm volatile("s_waitcnt vmcnt(0) lgkmcnt(0)\n\ts_barrier" ::: "memory");
        const unsigned k = misc[0];
        asm volatile("s_waitcnt lgkmcnt(0)\n\ts_barrier" ::: "memory");
        if (k >= 2048u) break;
        const bool is_mp = k >= 512u && k < 1536u;
        if (flags & (is_mp ? 2 : 1)) continue;
        if (k < 512u) { const int s_ = 127 - (int)(k >> 3), bg = k & 7; nsa_item(c, P, bg >> 1, bg & 1, s_, flags); }
        else if (k < 1536u) { const int kk = (int)k - 512, j = kk >> 5, bh = kk & 31; moba_past_item(c, P, bh >> 3, bh & 7, j); }
        else { const int kk = (int)k - 1536; const int s_ = 63 - (kk >> 3), bg = kk & 7; nsa_item(c, P, bg >> 1, bg & 1, s_, flags); }
    }
}
#undef MFMA32
#undef ATT_WAIT_BAR
}
namespace cmpr {
using bf16x8 = __attribute__((ext_vector_type(8))) short;
using f32x16 = __attribute__((ext_vector_type(16))) float;
constexpr int HID_PITCH = 528;
__device__ __forceinline__ float gelu_tanh(float v) { const float u = fminf(fmaxf(0.7978845608028654f * (v + 0.044715f * v * v * v), -15.f), 15.f); const float e = __expf(2.f * u); return 0.5f * v * (1.f + (e - 1.f) / (e + 1.f)); }
__device__ __forceinline__ void compress_unit(LAS unsigned char* lds, int unit, const bf16* qkv, const bf16* w1k, const bf16* w1v, const bf16* w2k, const bf16* w2v, const float* cbp, const float* kncmp, bf16* kcmp, bf16* vcmp) {
    const int tid = threadIdx.x, lane = tid & 63, r32 = lane & 31, hi = lane >> 5; const int wid = __builtin_amdgcn_readfirstlane(tid >> 6);
    const int kv = unit & 1, u = (unit >> 1) & 15, bg = unit >> 5;
    const bf16* src = qkv + 4 * QKV_BIG + (kv ? QKV_SMALL : 0) + (size_t)bg * SEQ * 64;
    const bf16* w1 = kv ? w1v : w1k; const bf16* w2 = kv ? w2v : w2k;
    const int n0 = 32 * u;
    { const bf16* sp = src + (size_t)16 * n0 * 64;
      for (int ch = tid; ch < 4224; ch += NTHREADS) { v4u v = {0u, 0u, 0u, 0u}; if (16 * n0 + (ch >> 3) < SEQ) v = *(const GAS v4u*)(sp + (size_t)ch * 8);
          *(LAS v4u*)(lds + ((ch ^ ((ch >> 7) & 15)) << 4)) = v; } }
    asm volatile("s_waitcnt vmcnt(0) lgkmcnt(0)\n\ts_barrier" ::: "memory");
    const bf16* bp = w1 + ((size_t)wid * 64 + lane) * 8;
    f32x16 acc = {};
#pragma unroll 8
    for (int kk = 0; kk < 128; ++kk) { const int lc = r32 * 128 + 2 * kk + hi; const bf16x8 a = *(const LAS bf16x8*)(lds + ((lc ^ ((lc >> 7) & 15)) << 4)), bfr = *(const bf16x8*)(bp + (size_t)kk * 4096); acc = __builtin_amdgcn_mfma_f32_32x32x16_bf16(a, bfr, acc, 0, 0, 0); }
    float cb = 0.f;
#pragma unroll 8
    for (int ic = 0; ic < 32; ++ic) cb += cbp[(ic * 2 + kv) * 256 + 32 * wid + r32];
    LAS unsigned char* hidL = lds + 69632;
#pragma unroll
    for (int r = 0; r < 16; ++r) { const int n = (r & 3) + 8 * (r >> 2) + 4 * hi; *(LAS bf16*)(hidL + n * HID_PITCH + (32 * wid + r32) * 2) = (bf16)f2bf(gelu_tanh(acc[r] + cb)); }
    asm volatile("s_waitcnt lgkmcnt(0)\n\ts_barrier" ::: "memory");
    if (wid == 0) {
        f32x16 o0 = {}, o1 = {};
#pragma unroll 4
        for (int kk = 0; kk < 16; ++kk) { const bf16x8 hb = *(const LAS bf16x8*)(hidL + r32 * HID_PITCH + (16 * kk + 8 * hi) * 2);
            const bf16x8 a0 = *(const bf16x8*)(w2 + (size_t)r32 * 256 + 16 * kk + 8 * hi), a1 = *(const bf16x8*)(w2 + (size_t)(32 + r32) * 256 + 16 * kk + 8 * hi);
            o0 = __builtin_amdgcn_mfma_f32_32x32x16_bf16(a0, hb, o0, 0, 0, 0); o1 = __builtin_amdgcn_mfma_f32_32x32x16_bf16(a1, hb, o1, 0, 0, 0); }
        float rs = 1.f;
        if (!kv) { float ss = 0.f;
#pragma unroll
            for (int r = 0; r < 16; ++r) ss += o0[r] * o0[r] + o1[r] * o1[r];
            auto rr = __builtin_amdgcn_permlane32_swap(__float_as_uint(ss), __float_as_uint(ss), false, false); ss = __uint_as_float(rr[0]) + __uint_as_float(rr[1]);
            rs = rsqrtf(ss * (1.f / 64.f) + 1e-6f); }
        const int n = n0 + r32; bf16* dst = (kv ? vcmp : kcmp) + ((size_t)bg * 512 + n) * 64;
#pragma unroll
        for (int r = 0; r < 16; ++r) { const int d = (r & 3) + 8 * (r >> 2) + 4 * hi;
            float v0 = o0[r] * rs, v1 = o1[r] * rs; if (!kv) { v0 *= kncmp[d]; v1 *= kncmp[d + 32]; }
            if (n >= NCMP) { v0 = 0.f; v1 = 0.f; }
            dst[d] = (bf16)f2bf(v0); dst[d + 32] = (bf16)f2bf(v1); }
    }
    asm volatile("s_waitcnt lgkmcnt(0)\n\ts_barrier" ::: "memory");
}
}
__global__ void __launch_bounds__(NTHREADS, 2) mk_fwd(Args a) {
    extern __shared__ __attribute__((aligned(16))) unsigned char lds[];
    Frame F;
    F.lds = (LAS unsigned char*)lds;
    F.tid = threadIdx.x; F.lane = F.tid & 63; F.wave = __builtin_amdgcn_readfirstlane(F.tid >> 6);
    F.G = gridDim.x; { const int bx = blockIdx.x; F.vcu = (F.G % 8 == 0) ? (bx % 8) * (F.G / 8) + bx / 8 : bx; }
    cg::grid_group grid = cg::this_grid();
    volatile LAS unsigned* xst = (volatile LAS unsigned*)(F.lds + 147424);
    if (F.tid < 8) xst[F.tid] = 0u;
    __syncthreads();
    const XcdBarrier xbar = xcd_barrier_post((unsigned*)(a.ws + WS_CTL) + 4096, xst);
    unsigned char* ws = a.ws;
    const int lo = a.ph_lo, hi = a.ph_hi;
    const att::AttnPtrs P{(const bf16*)(ws + WS_QKV), (const float*)(ws + WS_KMP), (const float*)(ws + WS_GATES), (const bf16*)(ws + WS_KCMP), (const bf16*)(ws + WS_VCMP), a.in[2], (bf16*)(ws + WS_MIX),
                          (unsigned*)(ws + WS_SELG), (bf16*)(ws + WS_PARTO), (float*)(ws + WS_PARTL)};
#define IN(k) (lo <= (k) && (k) < hi)
#define SEAM(k) do { if (IN(k) && IN((k) + 1)) { if ((k) == 0) grid.sync(); else xcd_barrier(xbar); } } while (0)
    if (IN(0)) { phase_prologue_a(F, a); } SEAM(0);
    if (IN(1)) { phase_prologue_b(F, a); } SEAM(1);
    if (IN(2)) {
        pg8::Gemm g{(const pg8::bf16_t*)(ws + WS_H), (const pg8::bf16_t*)(ws + WS_WIN), TOK, NIN_PAD, DM}; pg8::StaticOrder S; S.init(TOK, NIN_PAD, F.G, (int)blockIdx.x);
        pg8::EpiInProj E{(pg8::bf16_t*)(ws + WS_QKV), (float*)(ws + WS_GATES), (float*)(ws + WS_KMP), a.in[7], a.in[8], a.in[9], a.in[11], a.in[12]};
        pg8::gemm_phase<pg8::EpiInProj, pg8::StaticOrder, true, true>(F.lds, g, S, E);
    } SEAM(2);
    if (IN(3)) {
        att::moba_gate_phase(P, F.vcu, F.G, F.tid);
        for (int unit = F.vcu; unit < 256; unit += F.G)
            cmpr::compress_unit(F.lds, unit, (const bf16*)(ws + WS_QKV), (const bf16*)(ws + WS_W1K), (const bf16*)(ws + WS_W1V), (const bf16*)(ws + WS_W2K), (const bf16*)(ws + WS_W2V),
                                (const float*)(ws + WS_CBP), a.in[10], (bf16*)(ws + WS_KCMP), (bf16*)(ws + WS_VCMP));
    } SEAM(3);
    if (IN(4)) {
                att::attn_phase(F.lds, P, (unsigned*)(ws + WS_CTL) + 64, 0);
    } SEAM(4);
    if (IN(5)) { att::moba_merge_pass(P, F.vcu, F.G, F.tid); } SEAM(5);
    if (IN(6)) {
        pg8::Gemm g{(const pg8::bf16_t*)(ws + WS_MIX), (const pg8::bf16_t*)(ws + WS_WOUT), TOK, DM, DM}; pg8::StaticOrder S; S.init(TOK, DM, F.G, (int)blockIdx.x);
        pg8::EpiOutProj E{a.in[0], a.out, (const float*)(ws + WS_MOD) + 2 * DM};
        pg8::gemm_phase<pg8::EpiOutProj, pg8::StaticOrder, true, true>(F.lds, g, S, E);
    } SEAM(6);
    if (IN(7)) { phase_norm2(F, a); } SEAM(7);
    if (IN(8)) {
        pg8::Gemm g{(const pg8::bf16_t*)(ws + WS_H), (const pg8::bf16_t*)(ws + WS_WGU), TOK, 2 * FF, DM}; pg8::StaticOrder S; S.init(TOK, 2 * FF, F.G, (int)blockIdx.x);
        pg8::EpiGateUp E{(pg8::bf16_t*)(ws + WS_ACT)};
        pg8::gemm_phase<pg8::EpiGateUp, pg8::StaticOrder, true, true>(F.lds, g, S, E);
    } SEAM(8);
    if (IN(9)) {
        pg8::Gemm g{(const pg8::bf16_t*)(ws + WS_ACT), (const pg8::bf16_t*)(ws + WS_WDN), TOK, DM, FF}; pg8::StaticOrder S; S.init(TOK, DM, F.G, (int)blockIdx.x);
        pg8::EpiDown E{a.out, (const float*)(ws + WS_MOD) + 5 * DM};
        pg8::gemm_phase<pg8::EpiDown, pg8::StaticOrder, true, true>(F.lds, g, S, E);
    }
#undef IN
#undef SEAM
}

static void launch_phases(const Args& base, int lo, int hi, int grid, hipStream_t stream, int flags = 0) {
    Args a = base; a.ph_lo = lo; a.ph_hi = hi; (void)flags;
    if (hi - lo > 1) { void* args[] = {&a}; (void)hipLaunchCooperativeKernel((const void*)mk_fwd, dim3(grid), dim3(NTHREADS), args, LDS_BYTES, stream); }
    else hipLaunchKernelGGL(mk_fwd, dim3(grid), dim3(NTHREADS), LDS_BYTES, stream, a);
}
extern "C" void kernel_launch(void* const* d_in, const int* in_sizes, int n_in, void* d_out, int out_size, void* d_ws, size_t ws_size, hipStream_t stream) {
    static int grid = 0;
    if (grid == 0) {
        int dev = 0, cus = 0, per_cu = 0;
        if (n_in != 23 || ws_size < 480 * MiB || hipGetDevice(&dev) != hipSuccess || hipDeviceGetAttribute(&cus, hipDeviceAttributeMultiprocessorCount, dev) != hipSuccess) { grid = -1; return; }
        if (hipFuncSetAttribute((const void*)mk_fwd, hipFuncAttributeMaxDynamicSharedMemorySize, LDS_BYTES) != hipSuccess) { grid = -1; return; }
        if (hipOccupancyMaxActiveBlocksPerMultiprocessor(&per_cu, (const void*)mk_fwd, NTHREADS, LDS_BYTES) != hipSuccess || per_cu < 1) { grid = -1; return; }
        grid = cus;
    }
    if (grid < 0) return;
    (void)hipMemsetAsync((char*)d_ws + WS_CTL, 0, CTL_ZERO_BYTES, stream);
    Args a{};
    for (int i = 0; i < 23; ++i) a.in[i] = (const float*)d_in[i];
    a.out = (float*)d_out; a.ws = (unsigned char*)d_ws;
    unsigned char* ws = (unsigned char*)d_ws;
#if HYBRID == 1
    launch_phases(a, 0, 1, grid, stream); launch_phases(a, 1, 2, grid, stream); launch_phases(a, 2, 3, grid, stream);
    const bf16* qkv = (const bf16*)(ws + WS_QKV); bf16* mix = (bf16*)(ws + WS_MIX); bf16* kcmp = (bf16*)(ws + WS_KCMP); bf16* vcmp = (bf16*)(ws + WS_VCMP);
    int* sel = (int*)(ws + 344 * MiB); float* obuf = (float*)(ws + 348 * MiB); const float* gates = (const float*)(ws + WS_GATES);
    nq::k_compress<<<dim3(4 * 2 * 512, 2), 256, 0, stream>>>(qkv, a.in[13], a.in[14], a.in[15], a.in[16], a.in[17], a.in[18], a.in[10], kcmp, vcmp);
    nq::k_moba<<<4 * 8 * SEQ / 4, 256, 0, stream>>>(qkv, (const float*)(ws + WS_KMP), a.in[2], mix);
    nq::k_nsa_cmp<<<4 * 2 * SEQ, 256, 0, stream>>>(qkv, kcmp, vcmp, gates, obuf, sel);
    nq::k_nsa_sel<<<4 * 2 * SEQ, 256, 0, stream>>>(qkv, sel, a.in[2], gates, obuf);
    nq::k_nsa_win<<<4 * 2 * SEQ, 256, 0, stream>>>(qkv, a.in[2], gates, obuf, mix);
    launch_phases(a, 5, 6, grid, stream); launch_phases(a, 6, 7, grid, stream); launch_phases(a, 7, 8, grid, stream); launch_phases(a, 8, 9, grid, stream);
#elif HYBRID == 2
    launch_phases(a, 0, 1, grid, stream); launch_phases(a, 1, 2, grid, stream); launch_phases(a, 2, 3, grid, stream);
    nq::k_compress<<<dim3(4 * 2 * 512, 2), 256, 0, stream>>>((const bf16*)(ws + WS_QKV), a.in[13], a.in[14], a.in[15], a.in[16], a.in[17], a.in[18], a.in[10], (bf16*)(ws + WS_KCMP), (bf16*)(ws + WS_VCMP));
    launch_phases(a, 4, 5, grid, stream);
    launch_phases(a, 5, 6, grid, stream); launch_phases(a, 6, 7, grid, stream); launch_phases(a, 7, 8, grid, stream); launch_phases(a, 8, 9, grid, stream);
#elif HYBRID == 3
    for (int p = 0; p < N_PHASES; ++p) {
#if defined(TIME_PHASE)
        if (p == TIME_PHASE) { for (int r = 0; r < TIME_REPS; ++r) { launch_phases(a, p, p + 1, grid, stream, TIME_FLAGS); (void)hipMemsetAsync((char*)d_ws + WS_CTL, 0, CTL_ZERO_BYTES, stream); } }
#endif
        launch_phases(a, p, p + 1, grid, stream);
#if defined(ABL_REPS)
        if (p == 3) { static bool once = false; if (!once) { once = true; (void)hipFuncSetAttribute((const void*)k_attn_abl, hipFuncAttributeMaxDynamicSharedMemorySize, LDS_BYTES); }
            for (int r = 0; r < ABL_REPS; ++r) { (void)hipMemsetAsync((char*)d_ws + WS_CTL + 512, 0, 4, stream); hipLaunchKernelGGL(k_attn_abl, dim3(grid), dim3(NTHREADS), LDS_BYTES, stream, a); } }
#endif
    }
#else
    launch_phases(a, 0, N_PHASES, grid, stream);
#endif
}
```

```cpp
#include <hip/hip_runtime.h>
#include <hip/hip_cooperative_groups.h>
#include <cstdint>
#include <cstdio>
namespace cg = cooperative_groups;
#define HYBRID 0
namespace pg8 {
#define PG8_LAS __attribute__((address_space(3)))
typedef unsigned short bf16_t;
typedef short bf16x8 __attribute__((ext_vector_type(8)));
typedef float f32x4 __attribute__((ext_vector_type(4)));
typedef unsigned u32x4 __attribute__((ext_vector_type(4)));
constexpr int BM = 256, BK = 64, HALF = 128, HTB = HALF * BK * 2  , STAGE_BYTES = 8 * HTB, NXCD = 8, WGM = 8;

__host__ __device__ __forceinline__ int lds_byte(int r, int c) { const int st = (r >> 4) * 2 + (c >> 5), rr = r & 15, cc = c & 31, ob = rr * 64 + cc * 2; return st * 1024 + (ob ^ (((ob >> 9) & 1) << 5)); }
__host__ __device__ __forceinline__ void stage_rc(int b, int& R, int& C) { const int st = b / 1024, sb = b % 1024, swz = sb ^ (((sb >> 9) & 1) << 5); R = (st >> 1) * 16 + swz / 64; C = (st & 1) * 32 + (swz % 64) / 2; }
__host__ __device__ __forceinline__ int perm32(int rho) { const int n = rho >> 4, i = rho & 15; return 8 * (i >> 2) + 4 * n + (i & 3); }

struct Unit { int pm, pn; };
struct Gemm { const bf16_t* A; const bf16_t* Bt; int M, N, K; };

struct StaticOrder {
    int nM, nN, nwg, G, c;
    __host__ __device__ void init(int M, int N, int G_, int c_) { nM = M / BM; nN = N / BM; nwg = nM * nN; G = G_; c = c_; }
    __host__ __device__ bool next(int i, Unit& u) const {
        const long L = (long)i * G + c; if (L >= nwg) return false;
        int wgid = (int)L; { const int q = nwg / NXCD, r = nwg % NXCD, xcd = wgid % NXCD, off = wgid / NXCD; wgid = (xcd < r ? xcd * (q + 1) : r * (q + 1) + (xcd - r) * q) + off; }
        const int nig = WGM * nN, gid = wgid / nig, fm = gid * WGM, gsz = (nM - fm) < WGM ? (nM - fm) : WGM;
        u.pm = fm + ((wgid % nig) % gsz); u.pn = (wgid % nig) / gsz; return true;
    }
    __device__ __forceinline__ void a_ready(const Unit&) const {}
    __device__ __forceinline__ void done(const Unit&) const {}
};

__device__ __forceinline__ unsigned cvt_pk_bf16(float lo, float hi) { unsigned r; asm volatile("v_cvt_pk_bf16_f32 %0, %1, %2" : "=v"(r) : "v"(lo), "v"(hi)); return r; }
typedef float f32x2 __attribute__((ext_vector_type(2)));
template <class Epi, class Sched, bool ALIGN_EPI = false, bool SP2 = false>
__device__ __forceinline__ void gemm_phase(PG8_LAS unsigned char* lds, const Gemm g, const Sched& S, const Epi& E) {
    const int tid = threadIdx.x, wid = __builtin_amdgcn_readfirstlane(tid >> 6), lane = tid & 63, wr = wid >> 2, wc = wid & 3, fr = lane & 15, fq = lane >> 4;
    const int K = g.K, nt = K / BK;
    unsigned voffA[2], voffB[2];
#pragma unroll
    for (int i = 0; i < 2; ++i) { int R, C; stage_rc(tid * 16 + i * 8192, R, C); const int Rb = Epi::PERM ? ((R & ~31) + perm32(R & 31)) : R;
        voffA[i] = (unsigned)(R * K + C) * 2u; voffB[i] = (unsigned)(Rb * K + C) * 2u; }
    const size_t kstep = (size_t)(BK * 2);
    const size_t hstep = (size_t)HALF * K * 2;
    const size_t tstep = 2 * hstep;
    const unsigned ldsw = (unsigned)wid * 1024u;
    const int aoff = lds_byte(wr * 64 + fr, fq * 8), boff = lds_byte(wc * 32 + fr, fq * 8);
#define PG8_SA(b, h) (((b) * 2 + (h)) * HTB)
#define PG8_SB(b, h) ((4 + (b) * 2 + (h)) * HTB)
#define PG8_STAGE(bufoff, gbase, voff) do { _Pragma("unroll") for (int _i = 0; _i < 2; ++_i) \
        __builtin_amdgcn_global_load_lds((const unsigned*)((const char*)(gbase) + (voff)[_i]), (PG8_LAS unsigned*)(lds + (bufoff) + ldsw + _i * 8192), 16, 0, 0); } while (0)
#define PG8_LDA(dst, b, h) do { _Pragma("unroll") for (int m = 0; m < 4; ++m) _Pragma("unroll") for (int k = 0; k < 2; ++k) dst[m][k] = *(const PG8_LAS bf16x8*)(lds + PG8_SA(b, h) + aoff + m * 2048 + k * 1024); } while (0)
#define PG8_LDB(dst, b, h) do { _Pragma("unroll") for (int n = 0; n < 2; ++n) _Pragma("unroll") for (int k = 0; k < 2; ++k) dst[n][k] = *(const PG8_LAS bf16x8*)(lds + PG8_SB(b, h) + boff + n * 2048 + k * 1024); } while (0)
#define PG8_MMA(ai, bj, At, Bt) do { __builtin_amdgcn_s_setprio(1); _Pragma("unroll") for (int m = 0; m < 4; ++m) _Pragma("unroll") for (int n = 0; n < 2; ++n) _Pragma("unroll") for (int k = 0; k < 2; ++k) \
        acc[ai][bj][m][n] = __builtin_amdgcn_mfma_f32_16x16x32_bf16(Bt[n][k], At[m][k], acc[ai][bj][m][n], 0, 0, 0); __builtin_amdgcn_s_setprio(0); } while (0)
#define PG8_WAIT_V(n) asm volatile("s_waitcnt vmcnt(" #n ")" ::: "memory")
#define PG8_WAIT_L(n) asm volatile("s_waitcnt lgkmcnt(" #n ")" ::: "memory")
#define PG8_BAR __builtin_amdgcn_s_barrier()
#define PG8_SCHED __builtin_amdgcn_sched_barrier(0)
    Unit cur, nxt; int ui = 0;
    if (!S.next(0, cur)) return;
    f32x4 acc[2][2][4][2];
#pragma unroll
    for (int a = 0; a < 2; ++a)
#pragma unroll
        for (int b = 0; b < 2; ++b)
#pragma unroll
            for (int m = 0; m < 4; ++m)
#pragma unroll
                for (int n = 0; n < 2; ++n) acc[a][b][m][n] = (f32x4){0.f, 0.f, 0.f, 0.f};
    bf16x8 At[4][2], B0[2][2], B1[2][2];
    const char* cA = (const char*)g.A + (size_t)cur.pm * tstep; const char* cB = (const char*)g.Bt + (size_t)cur.pn * tstep;
    S.a_ready(cur);
    if constexpr (SP2) {
        PG8_STAGE(PG8_SB(0, 0), cB, voffB); PG8_STAGE(PG8_SB(0, 1), cB + hstep, voffB); PG8_STAGE(PG8_SA(0, 0), cA, voffA); PG8_STAGE(PG8_SA(0, 1), cA + hstep, voffA);
        if (wr == 1) PG8_BAR;
        PG8_WAIT_V(2); PG8_BAR;
        PG8_STAGE(PG8_SB(1, 0), cB + kstep, voffB); PG8_STAGE(PG8_SA(1, 0), cA + kstep, voffA); PG8_STAGE(PG8_SB(1, 1), cB + hstep + kstep, voffB);
        PG8_WAIT_V(6); PG8_BAR;
    } else {
        PG8_STAGE(PG8_SB(0, 0), cB, voffB); PG8_STAGE(PG8_SA(0, 0), cA, voffA); PG8_STAGE(PG8_SB(0, 1), cB + hstep, voffB); PG8_STAGE(PG8_SA(0, 1), cA + hstep, voffA);
        if (wr == 1) PG8_BAR;
        PG8_WAIT_V(4); PG8_BAR;
        PG8_STAGE(PG8_SB(1, 0), cB + kstep, voffB); PG8_STAGE(PG8_SA(1, 0), cA + kstep, voffA); PG8_STAGE(PG8_SB(1, 1), cB + hstep + kstep, voffB);
        PG8_WAIT_V(6); PG8_BAR;
    }
    for (;;) {
        const bool has_next = S.next(ui + 1, nxt);
        const char* nA = has_next ? (const char*)g.A + (size_t)nxt.pm * tstep : cA; const char* nB = has_next ? (const char*)g.Bt + (size_t)nxt.pn * tstep : cB;
        for (int t = 0; t < nt; t += 2) {
            const bool last = (t == nt - 2);
            const char* a1 = cA + (size_t)(t + 1) * kstep;
            const char* a2 = last ? nA : cA + (size_t)(t + 2) * kstep; const char* b2 = last ? nB : cB + (size_t)(t + 2) * kstep;
            const char* a3 = a2 + kstep; const char* b3 = b2 + kstep;
            if (last && has_next) S.a_ready(nxt);
            if constexpr (SP2) {
            PG8_LDB(B0, 0, 0); PG8_LDB(B1, 0, 1); PG8_SCHED; PG8_LDA(At, 0, 0); PG8_STAGE(PG8_SA(1, 1), a1 + hstep, voffA);
            PG8_WAIT_V(8); PG8_WAIT_L(0); PG8_BAR; PG8_MMA(0, 0, At, B0); PG8_MMA(0, 1, At, B1); PG8_BAR; PG8_SCHED;
            PG8_LDA(At, 0, 1); PG8_STAGE(PG8_SB(0, 0), b2, voffB); PG8_STAGE(PG8_SB(0, 1), b2 + hstep, voffB); PG8_STAGE(PG8_SA(0, 0), a2, voffA);
            PG8_WAIT_V(8); PG8_WAIT_L(0); PG8_BAR; PG8_MMA(1, 0, At, B0); PG8_MMA(1, 1, At, B1); PG8_BAR; PG8_SCHED;
            PG8_LDB(B0, 1, 0); PG8_LDB(B1, 1, 1); PG8_SCHED; PG8_LDA(At, 1, 0); PG8_STAGE(PG8_SA(0, 1), a2 + hstep, voffA);
            PG8_WAIT_V(8); PG8_WAIT_L(0); PG8_BAR; PG8_MMA(0, 0, At, B0); PG8_MMA(0, 1, At, B1); PG8_BAR; PG8_SCHED;
            PG8_LDA(At, 1, 1); PG8_STAGE(PG8_SB(1, 0), b3, voffB); PG8_STAGE(PG8_SB(1, 1), b3 + hstep, voffB); PG8_STAGE(PG8_SA(1, 0), a3, voffA);
            PG8_WAIT_V(8); PG8_WAIT_L(0); PG8_BAR; PG8_MMA(1, 0, At, B0); PG8_MMA(1, 1, At, B1); PG8_BAR; PG8_SCHED;
            } else {
            PG8_LDB(B0, 0, 0); PG8_SCHED; PG8_LDA(At, 0, 0); PG8_STAGE(PG8_SA(1, 1), a1 + hstep, voffA);
            PG8_WAIT_L(8); PG8_BAR; PG8_WAIT_L(0); PG8_MMA(0, 0, At, B0); PG8_BAR; PG8_SCHED;
            PG8_LDB(B1, 0, 1); PG8_STAGE(PG8_SB(0, 0), b2, voffB);
            PG8_BAR; PG8_WAIT_L(0); PG8_MMA(0, 1, At, B1); PG8_BAR;
            PG8_LDA(At, 0, 1); PG8_STAGE(PG8_SA(0, 0), a2, voffA);
            PG8_BAR; PG8_WAIT_L(0); PG8_MMA(1, 0, At, B0); PG8_BAR; PG8_SCHED;
            PG8_STAGE(PG8_SB(0, 1), b2 + hstep, voffB);
            PG8_WAIT_V(6); PG8_BAR; PG8_MMA(1, 1, At, B1); PG8_BAR;
            PG8_LDB(B0, 1, 0); PG8_SCHED; PG8_LDA(At, 1, 0); PG8_STAGE(PG8_SA(0, 1), a2 + hstep, voffA);
            PG8_WAIT_L(8); PG8_BAR; PG8_WAIT_L(0); PG8_MMA(0, 0, At, B0); PG8_BAR; PG8_SCHED;
            PG8_LDB(B1, 1, 1); PG8_STAGE(PG8_SB(1, 0), b3, voffB);
            PG8_BAR; PG8_WAIT_L(0); PG8_MMA(0, 1, At, B1); PG8_BAR;
            PG8_LDA(At, 1, 1); PG8_STAGE(PG8_SA(1, 0), a3, voffA);
            PG8_BAR; PG8_WAIT_L(0); PG8_MMA(1, 0, At, B0); PG8_BAR; PG8_SCHED;
            PG8_STAGE(PG8_SB(1, 1), b3 + hstep, voffB);
            PG8_WAIT_V(6); PG8_BAR; PG8_MMA(1, 1, At, B1); PG8_BAR;
            }
        }
        if constexpr (ALIGN_EPI) { if (wr == 0) PG8_BAR; }
        if constexpr (!Epi::AFTER_DRAIN) { E(acc, cur, wr, wc, fr, fq); S.done(cur); }
        if (!has_next) break;
#pragma unroll
        for (int a = 0; a < 2; ++a)
#pragma unroll
            for (int b = 0; b < 2; ++b)
#pragma unroll
                for (int m = 0; m < 4; ++m)
#pragma unroll
                    for (int n = 0; n < 2; ++n) acc[a][b][m][n] = (f32x4){0.f, 0.f, 0.f, 0.f};
        cur = nxt; cA = nA; cB = nB; ++ui;
        if constexpr (ALIGN_EPI) { if (wr == 1) PG8_BAR; }
    }
    PG8_WAIT_V(0);
    if constexpr (!ALIGN_EPI) { if (wr == 0) PG8_BAR; }
    PG8_BAR;
    if constexpr (Epi::AFTER_DRAIN) { E.fused(acc, cur, wr, wc, fr, fq, lds, wid, lane); S.done(cur); }
#undef PG8_SA
#undef PG8_SB
#undef PG8_STAGE
#undef PG8_LDA
#undef PG8_LDB
#undef PG8_MMA
#undef PG8_WAIT_V
#undef PG8_WAIT_L
#undef PG8_BAR
#undef PG8_SCHED
}
}
namespace pg8 {
typedef unsigned u32x2v __attribute__((ext_vector_type(2)));
constexpr int TOK_S = 8192;
constexpr float QK_EPS = 1e-6f;
constexpr float C2 = 0.125f * 1.4426950408889634f;
__device__ __forceinline__ float sigmoid_fast(float v) { return __builtin_amdgcn_rcpf(1.f + __builtin_amdgcn_exp2f(-1.4426950408889634f * v)); }
__device__ __forceinline__ float silu_fast(float v) { return v * __builtin_amdgcn_rcpf(1.f + __builtin_amdgcn_exp2f(-1.4426950408889634f * v)); }

struct EpiInProj {
    static constexpr bool PERM = true, AFTER_DRAIN = false;
    bf16_t* qkv;
    float* gates;
    float* kmean_part;
    const float *qna, *kna, *qnb, *knsel, *knwin;
    __device__ __forceinline__ void operator()(const f32x4 (&acc)[2][2][4][2], const Unit& u, int wr, int wc, int fr, int fq) const {
        const int slot = u.pn * 4 + wc;
        if (slot > 44) return;
        const int b = u.pm >> 5, blk = u.pm & 31, pos0 = blk * 256 + wr * 64 + fr;
        if (slot == 44) {
            if (fq < 3) {
#pragma unroll
                for (int ai = 0; ai < 2; ++ai)
#pragma unroll
                    for (int m = 0; m < 4; ++m) { const size_t tok = (size_t)b * TOK_S + pos0 + ai * HALF + m * 16; float* gp = gates + tok * 24 + 8 * fq;
                        const f32x4 v0 = acc[ai][0][m][0], v1 = acc[ai][0][m][1];
                        *(f32x4*)gp = (f32x4){sigmoid_fast(v0[0]), sigmoid_fast(v0[1]), sigmoid_fast(v0[2]), sigmoid_fast(v0[3])};
                        *(f32x4*)(gp + 4) = (f32x4){sigmoid_fast(v1[0]), sigmoid_fast(v1[1]), sigmoid_fast(v1[2]), sigmoid_fast(v1[3])}; }
            }
            return;
        }
        const float* gain = nullptr; float qscale = 1.f; bool is_ka = false; bf16_t* dst;
        constexpr size_t BIG = (size_t)4 * 8 * TOK_S * 64, SMALL = (size_t)4 * 2 * TOK_S * 64;
        if (slot < 32) { const int kind = slot >> 3, head = slot & 7; dst = qkv + kind * BIG + ((size_t)(b * 8 + head) * TOK_S) * 64;
            if (kind == 0) { gain = qna; qscale = C2; } else if (kind == 1) { gain = kna; is_ka = true; } else if (kind == 3) { gain = qnb; qscale = C2; } }
        else { const int kind = (slot - 32) >> 1, g = slot & 1; dst = qkv + 4 * BIG + kind * SMALL + ((size_t)(b * 2 + g) * TOK_S) * 64;
            if (kind == 2) gain = knsel; else if (kind == 4) gain = knwin; }
        float gv[16];
#pragma unroll
        for (int i = 0; i < 16; ++i) gv[i] = gain ? gain[(i >> 3) * 32 + 8 * fq + (i & 7)] * qscale : 1.f;
        float cs[16];
#pragma unroll
        for (int i = 0; i < 16; ++i) cs[i] = 0.f;
#pragma unroll
        for (int ai = 0; ai < 2; ++ai)
#pragma unroll
            for (int m = 0; m < 4; ++m) {
                float v[16];
#pragma unroll
                for (int bj = 0; bj < 2; ++bj)
#pragma unroll
                    for (int n = 0; n < 2; ++n)
#pragma unroll
                        for (int j = 0; j < 4; ++j) v[bj * 8 + n * 4 + j] = acc[ai][bj][m][n][j];
                if (gain) { float ss = 0.f;
#pragma unroll
                    for (int i = 0; i < 16; ++i) ss += v[i] * v[i];
                    ss += __shfl_xor(ss, 16); ss += __shfl_xor(ss, 32);
                    const float rs = rsqrtf(ss * (1.f / 64.f) + QK_EPS);
#pragma unroll
                    for (int i = 0; i < 16; ++i) v[i] *= rs * gv[i]; }
                if (is_ka) {
#pragma unroll
                    for (int i = 0; i < 16; ++i) cs[i] += v[i]; }
                bf16_t* rp = dst + (size_t)(pos0 + ai * HALF + m * 16) * 64 + 8 * fq;
                u32x4 w0, w1;
                w0.x = cvt_pk_bf16(v[0], v[1]); w0.y = cvt_pk_bf16(v[2], v[3]); w0.z = cvt_pk_bf16(v[4], v[5]); w0.w = cvt_pk_bf16(v[6], v[7]);
                w1.x = cvt_pk_bf16(v[8], v[9]); w1.y = cvt_pk_bf16(v[10], v[11]); w1.z = cvt_pk_bf16(v[12], v[13]); w1.w = cvt_pk_bf16(v[14], v[15]);
                *(u32x4*)rp = w0; *(u32x4*)(rp + 32) = w1;
            }
        if (is_ka) {
#pragma unroll
            for (int i = 0; i < 16; ++i) { float s = cs[i]; s += __shfl_xor(s, 1); s += __shfl_xor(s, 2); s += __shfl_xor(s, 4); s += __shfl_xor(s, 8); cs[i] = s; }
            if (fr == 0) { float* kp = kmean_part + ((size_t)((b * 8 + (slot & 7)) * 32 + blk) * 2 + wr) * 64 + 8 * fq;
                *(f32x4*)kp = (f32x4){cs[0], cs[1], cs[2], cs[3]}; *(f32x4*)(kp + 4) = (f32x4){cs[4], cs[5], cs[6], cs[7]};
                *(f32x4*)(kp + 32) = (f32x4){cs[8], cs[9], cs[10], cs[11]}; *(f32x4*)(kp + 36) = (f32x4){cs[12], cs[13], cs[14], cs[15]}; }
        }
    }
};
struct EpiOutProj {
    static constexpr bool PERM = true, AFTER_DRAIN = false;
    const float* x; float* out; const float* gt;
    __device__ __forceinline__ void operator()(const f32x4 (&acc)[2][2][4][2], const Unit& u, int wr, int wc, int fr, int fq) const {
        const int b = u.pm >> 5; const int col0 = u.pn * BM + wc * 32 + 8 * fq; const float* gtb = gt + (size_t)b * 6144;
#pragma unroll
        for (int bj = 0; bj < 2; ++bj) { const int c = col0 + bj * HALF; const f32x4 g40 = *(const f32x4*)(gtb + c), g41 = *(const f32x4*)(gtb + c + 4);
#pragma unroll
            for (int ai = 0; ai < 2; ++ai)
#pragma unroll
                for (int m = 0; m < 4; ++m) { const size_t off = (size_t)(u.pm * BM + ai * HALF + wr * 64 + m * 16 + fr) * 1024 + c;
                    const f32x4 x0 = *(const f32x4*)(x + off), x1 = *(const f32x4*)(x + off + 4);
                    *(f32x4*)(out + off) = x0 + g40 * acc[ai][bj][m][0]; *(f32x4*)(out + off + 4) = x1 + g41 * acc[ai][bj][m][1]; } }
    }
};
struct EpiGateUp {
    static constexpr bool PERM = true, AFTER_DRAIN = false;
    bf16_t* act;
    __device__ __forceinline__ void operator()(const f32x4 (&acc)[2][2][4][2], const Unit& u, int wr, int wc, int fr, int fq) const {
        const int h0 = u.pn * 128 + wc * 32 + 8 * fq;
#pragma unroll
        for (int ai = 0; ai < 2; ++ai)
#pragma unroll
            for (int m = 0; m < 4; ++m) { const size_t row = (size_t)(u.pm * BM + ai * HALF + wr * 64 + m * 16 + fr);
                const f32x4 g0 = acc[ai][0][m][0], g1 = acc[ai][0][m][1], u0 = acc[ai][1][m][0], u1 = acc[ai][1][m][1];
                u32x4 w;
                w.x = cvt_pk_bf16(silu_fast(g0[0]) * u0[0], silu_fast(g0[1]) * u0[1]); w.y = cvt_pk_bf16(silu_fast(g0[2]) * u0[2], silu_fast(g0[3]) * u0[3]);
                w.z = cvt_pk_bf16(silu_fast(g1[0]) * u1[0], silu_fast(g1[1]) * u1[1]); w.w = cvt_pk_bf16(silu_fast(g1[2]) * u1[2], silu_fast(g1[3]) * u1[3]);
                *(u32x4*)(act + row * 2816 + h0) = w; }
    }
};
struct EpiDown {
    static constexpr bool PERM = true, AFTER_DRAIN = false;
    float* out; const float* gt;
    __device__ __forceinline__ void operator()(const f32x4 (&acc)[2][2][4][2], const Unit& u, int wr, int wc, int fr, int fq) const {
        const int b = u.pm >> 5; const int col0 = u.pn * BM + wc * 32 + 8 * fq; const float* gtb = gt + (size_t)b * 6144;
#pragma unroll
        for (int bj = 0; bj < 2; ++bj) { const int c = col0 + bj * HALF; const f32x4 g40 = *(const f32x4*)(gtb + c), g41 = *(const f32x4*)(gtb + c + 4);
#pragma unroll
            for (int ai = 0; ai < 2; ++ai)
#pragma unroll
                for (int m = 0; m < 4; ++m) { const size_t off = (size_t)(u.pm * BM + ai * HALF + wr * 64 + m * 16 + fr) * 1024 + c;
                    const f32x4 x0 = *(const f32x4*)(out + off), x1 = *(const f32x4*)(out + off + 4);
                    *(f32x4*)(out + off) = x0 + g40 * acc[ai][bj][m][0]; *(f32x4*)(out + off + 4) = x1 + g41 * acc[ai][bj][m][1]; } }
    }
};
}
constexpr int NWAVES = 8, NTHREADS = 512;
constexpr int BATCH = 4, SEQ = 8192, DM = 1024, TOK = BATCH * SEQ, NIN = 2840, NIN_PAD = 3072, FF = 2816, NCMP = 511;
constexpr size_t MiB = 1u << 20;
constexpr size_t WS_CTL = 0, CTL_ZERO_BYTES = 64 * 1024;
constexpr size_t WS_MODP = 1 * MiB;
constexpr size_t WS_MOD = 2 * MiB;
constexpr size_t WS_CBP = 2 * MiB + 512 * 1024;
constexpr size_t WS_KMP = 3 * MiB;
constexpr size_t WS_BIAS2 = 4 * MiB;
constexpr size_t WS_SSP = 449 * MiB;
constexpr size_t WS_WIN = 6 * MiB, WS_WOUT = 12 * MiB, WS_WGU = 14 * MiB, WS_WDN = 25 * MiB;
constexpr size_t WS_W1K = 31 * MiB, WS_W1V = 32 * MiB, WS_W2K = 33 * MiB, WS_W2V = 33 * MiB + 64 * 1024;
constexpr size_t WS_KCMP = 34 * MiB, WS_VCMP = 35 * MiB;
constexpr size_t WS_GATES = 36 * MiB;
constexpr size_t WS_H = 40 * MiB;
constexpr size_t WS_MIX = 104 * MiB;
constexpr size_t WS_QKV = 168 * MiB;
constexpr size_t WS_ACT = WS_QKV;
constexpr size_t WS_END = 344 * MiB;
constexpr size_t WS_PARTO = 344 * MiB;
constexpr size_t WS_PARTL = 472 * MiB;
constexpr size_t WS_SELG = 476 * MiB;
constexpr size_t QKV_BIG = (size_t)4 * 8 * SEQ * 64, QKV_SMALL = (size_t)4 * 2 * SEQ * 64;
constexpr int RING_BYTES = 131072, LDS_BYTES = 147456;
constexpr int N_PHASES = 10;

#define GAS __attribute__((address_space(1)))
#define LAS __attribute__((address_space(3)))
typedef unsigned short bf16;
typedef unsigned v4u __attribute__((ext_vector_type(4)));
typedef float f32x4 __attribute__((ext_vector_type(4)));
#define LDS_WAIT() asm volatile("s_waitcnt lgkmcnt(0)" ::: "memory")
#define VM_WAIT() asm volatile("s_waitcnt vmcnt(0)" ::: "memory")
__device__ __forceinline__ unsigned f2bf(float f) { unsigned u = __builtin_bit_cast(unsigned, f); return (u + 0x7fffu + ((u >> 16) & 1u)) >> 16; }
__device__ __forceinline__ unsigned pk2(float lo, float hi) { return f2bf(lo) | (f2bf(hi) << 16); }
__device__ __forceinline__ float bf2f(bf16 v) { return __builtin_bit_cast(float, (unsigned)v << 16); }
__device__ __forceinline__ float wave_sum(float v) {
#pragma unroll
    for (int o = 1; o < 64; o <<= 1) v += __shfl_xor(v, o);
    return v;
}
struct Args { const float* in[23]; float* out; unsigned char* ws; int ph_lo, ph_hi; };
struct Frame { LAS unsigned char* lds; int tid, lane, wave, vcu, G; };

struct MapId { __device__ __forceinline__ size_t off(int n, int k, int K) const { return (size_t)n * K + k; } };
struct MapWin { __device__ __forceinline__ size_t off(int n, int k, int K) const { const int s = n >> 6, d = n & 63; return (size_t)(256 * (s >> 2) + 128 * (d >> 5) + 32 * (s & 3) + (d & 31)) * K + k; } };
struct MapWgu { __device__ __forceinline__ size_t off(int n, int k, int K) const { const int up = n >= FF, hdn = up ? n - FF : n; return (size_t)(256 * (hdn >> 7) + 128 * up + (hdn & 127)) * K + k; } };
struct MapFrag { __device__ __forceinline__ size_t off(int n, int k, int K) const { return ((size_t)((k >> 4) * 8 + (n >> 5)) * 64 + ((k >> 3) & 1) * 32 + (n & 31)) * 8 + (k & 7); } };
template <class Map>
__device__ __forceinline__ void transpose_item(const float* __restrict__ W, int K, int N, bf16* WT, LAS float* scr, int item, int lane, const Map& map) {
    const int nblk = (N + 63) / 64, kb = item / nblk, nb = item % nblk, k0 = 64 * kb, n0 = 64 * nb;
    const int nc = n0 + 4 * (lane & 15); const bool nin = nc < N;
    f32x4 v[16];
#pragma unroll
    for (int i = 0; i < 16; ++i) { const int kk = 4 * i + (lane >> 4); v[i] = nin ? *(const GAS f32x4*)(W + (size_t)(k0 + kk) * N + nc) : (f32x4){0.f, 0.f, 0.f, 0.f}; }
#pragma unroll
    for (int i = 0; i < 16; ++i) { const int kk = 4 * i + (lane >> 4); LAS float* d = scr + (4 * (lane & 15)) * 68 + kk; d[0] = v[i][0]; d[68] = v[i][1]; d[136] = v[i][2]; d[204] = v[i][3]; }
    LDS_WAIT(); asm volatile("" ::: "memory");
    const int c = lane & 7;
#pragma unroll
    for (int j = 0; j < 8; ++j) { const int n = (lane >> 3) + 8 * j; const LAS float* s = scr + n * 68 + 8 * c;
        const f32x4 a = *(const LAS f32x4*)s, bq = *(const LAS f32x4*)(s + 4);
        v4u o; o.x = pk2(a[0], a[1]); o.y = pk2(a[2], a[3]); o.z = pk2(bq[0], bq[1]); o.w = pk2(bq[2], bq[3]);
        if (n0 + n < N) *(GAS v4u*)(WT + map.off(n0 + n, k0 + 8 * c, K)) = o; }
    LDS_WAIT(); asm volatile("" ::: "memory");
}
__device__ __forceinline__ float silu_acc(float v) { return v / (1.f + expf(-v)); }
__device__ __forceinline__ void phase_prologue_a(Frame& F, const Args& a) {
    LAS float* scr = (LAS float*)(F.lds + F.wave * 17408);
    const int gw = F.vcu * NWAVES + F.wave, NGW = F.G * NWAVES;
    unsigned char* ws = a.ws;
    constexpr int I_IN = (DM / 64) * ((NIN + 63) / 64), I_OUT = (DM / 64) * (DM / 64), I_GU = (DM / 64) * (2 * FF / 64), I_DN = (FF / 64) * (DM / 64), I_W1 = (2048 / 64) * (256 / 64), I_W2 = (256 / 64) * (64 / 64);
    constexpr int NITEMS = I_IN + I_OUT + I_GU + I_DN + 2 * I_W1 + 2 * I_W2;
    for (int it = gw; it < NITEMS; it += NGW) {
        int r = it;
        if (r < I_IN) { transpose_item(a.in[6], DM, NIN, (bf16*)(ws + WS_WIN), scr, r, F.lane, MapWin()); continue; } r -= I_IN;
        if (r < I_OUT) { transpose_item(a.in[19], DM, DM, (bf16*)(ws + WS_WOUT), scr, r, F.lane, MapId()); continue; } r -= I_OUT;
        if (r < I_GU) { transpose_item(a.in[21], DM, 2 * FF, (bf16*)(ws + WS_WGU), scr, r, F.lane, MapWgu()); continue; } r -= I_GU;
        if (r < I_DN) { transpose_item(a.in[22], FF, DM, (bf16*)(ws + WS_WDN), scr, r, F.lane, MapId()); continue; } r -= I_DN;
        if (r < I_W1) { transpose_item(a.in[14], 2048, 256, (bf16*)(ws + WS_W1K), scr, r, F.lane, MapFrag()); continue; } r -= I_W1;
        if (r < I_W1) { transpose_item(a.in[17], 2048, 256, (bf16*)(ws + WS_W1V), scr, r, F.lane, MapFrag()); continue; } r -= I_W1;
        if (r < I_W2) { transpose_item(a.in[15], 256, 64, (bf16*)(ws + WS_W2K), scr, r, F.lane, MapId()); continue; } r -= I_W2;
        transpose_item(a.in[18], 256, 64, (bf16*)(ws + WS_W2V), scr, r, F.lane, MapId());
    }
    const float* c = a.in[1]; const float* w_ada = a.in[3]; float* modp = (float*)(ws + WS_MODP);
    for (int t = NGW - 1 - gw; t < 96 * 8; t += NGW) { const int cg_ = t % 96, ks = t / 96; const int n = cg_ * 64 + F.lane;
        float acc0 = 0.f, acc1 = 0.f, acc2 = 0.f, acc3 = 0.f;
#pragma unroll
        for (int i = 0; i < 8; ++i) { const int idx = F.lane + 64 * i, bb = idx >> 7, kk = idx & 127; scr[kk * 4 + bb] = silu_acc(c[bb * DM + ks * 128 + kk]); }
        LDS_WAIT(); asm volatile("" ::: "memory");
#pragma unroll 8
        for (int k = 0; k < 128; ++k) { const float w = w_ada[(size_t)(ks * 128 + k) * 6144 + n]; const f32x4 sv = *(const LAS f32x4*)(scr + 4 * k);
            acc0 += sv[0] * w; acc1 += sv[1] * w; acc2 += sv[2] * w; acc3 += sv[3] * w; }
        LDS_WAIT(); asm volatile("" ::: "memory");
        float* o = modp + (size_t)ks * 4 * 6144 + n; o[0] = acc0; o[6144] = acc1; o[2 * 6144] = acc2; o[3 * 6144] = acc3; }
    float* cbp = (float*)(ws + WS_CBP);
    for (int t = NGW / 2 - 1 - gw; t >= 0 && t < 256; t += NGW) { const int kv = t & 1, cg_ = (t >> 1) & 3, ic = t >> 3; const int n = cg_ * 64 + F.lane;
        const float* pe = kv ? a.in[16] : a.in[13]; const float* w1 = kv ? a.in[17] : a.in[14]; float acc = 0.f;
#pragma unroll 8
        for (int i = ic * 64; i < ic * 64 + 64; ++i) acc += pe[i] * w1[(size_t)i * 256 + n];
        cbp[(ic * 2 + kv) * 256 + n] = acc; }
}
__device__ __forceinline__ void norm_rows(Frame& F, int blk, const float* in, const f32x4 (&gs)[4], const f32x4 (&sh)[4], bf16* out) {
    for (int i0 = 0; i0 < 16; i0 += 4) {
        f32x4 v[4][4]; float ss[4];
#pragma unroll
        for (int r = 0; r < 4; ++r) { const int row = blk * 128 + F.wave * 16 + i0 + r; const GAS f32x4* xr = (const GAS f32x4*)(in + (size_t)row * DM) + F.lane;
#pragma unroll
            for (int j = 0; j < 4; ++j) v[r][j] = xr[64 * j]; }
#pragma unroll
        for (int r = 0; r < 4; ++r) { float s = 0.f;
#pragma unroll
            for (int j = 0; j < 4; ++j) s += (v[r][j].x * v[r][j].x + v[r][j].y * v[r][j].y) + (v[r][j].z * v[r][j].z + v[r][j].w * v[r][j].w);
            ss[r] = s; }
#pragma unroll
        for (int o_ = 1; o_ < 64; o_ <<= 1) {
#pragma unroll
            for (int r = 0; r < 4; ++r) ss[r] += __shfl_xor(ss[r], o_); }
#pragma unroll
        for (int r = 0; r < 4; ++r) { const int row = blk * 128 + F.wave * 16 + i0 + r; const float rs = rsqrtf(ss[r] * (1.f / DM) + 1e-6f);
            GAS unsigned long long* o8 = (GAS unsigned long long*)(out + (size_t)row * DM) + F.lane;
#pragma unroll
            for (int j = 0; j < 4; ++j) { const f32x4 y = v[r][j] * rs * gs[j] + sh[j]; o8[64 * j] = (unsigned long long)pk2(y.x, y.y) | ((unsigned long long)pk2(y.z, y.w) << 32); } }
    }
}
__device__ __forceinline__ void phase_prologue_b(Frame& F, const Args& a) {
    unsigned char* ws = a.ws; const float* modp = (const float*)(ws + WS_MODP); const float* b_ada = a.in[4];
    if (F.wave == 0) for (int cgp = F.vcu; cgp < 96; cgp += F.G) { const int n = cgp * 64 + F.lane; float* mod = (float*)(ws + WS_MOD);
        for (int b = 0; b < 4; ++b) { float s = 0.f;
#pragma unroll
            for (int ks = 0; ks < 8; ++ks) s += modp[((size_t)ks * 4 + b) * 6144 + n];
            mod[b * 6144 + n] = s + b_ada[n]; } }
    const float* g = a.in[5];
    for (int blk = F.vcu; blk < TOK / 128; blk += F.G) { const int b = blk >> 6;
    f32x4 gs[4], sh[4];
#pragma unroll
    for (int j = 0; j < 4; ++j) { const int c0 = 4 * F.lane + 256 * j; f32x4 s0 = {0.f, 0.f, 0.f, 0.f}, s1 = {0.f, 0.f, 0.f, 0.f};
#pragma unroll
        for (int ks = 0; ks < 8; ++ks) { s0 += *(const f32x4*)(modp + ((size_t)ks * 4 + b) * 6144 + c0); s1 += *(const f32x4*)(modp + ((size_t)ks * 4 + b) * 6144 + DM + c0); }
        s0 += *(const f32x4*)(b_ada + c0); s1 += *(const f32x4*)(b_ada + DM + c0);
        sh[j] = s0; gs[j] = *(const f32x4*)(g + c0) * (s1 + 1.0f); }
    norm_rows(F, blk, a.in[0], gs, sh, (bf16*)(ws + WS_H)); }
}
__device__ __forceinline__ void phase_norm2(Frame& F, const Args& a) {
    unsigned char* ws = a.ws; const float* g = a.in[20];
    for (int blk = F.vcu; blk < TOK / 128; blk += F.G) { const int b = blk >> 6; const float* mod = (const float*)(ws + WS_MOD) + (size_t)b * 6144;
        f32x4 gs[4], sh[4];
#pragma unroll
        for (int j = 0; j < 4; ++j) { const int c0 = 4 * F.lane + 256 * j; sh[j] = *(const f32x4*)(mod + 3 * DM + c0); gs[j] = *(const f32x4*)(g + c0) * (*(const f32x4*)(mod + 4 * DM + c0) + 1.0f); }
        norm_rows(F, blk, a.out, gs, sh, (bf16*)(ws + WS_H)); }
}

__device__ __forceinline__ void phase_bias2(Frame& F, const Args& a) {
    unsigned char* ws = a.ws; const float* mod = (const float*)(ws + WS_MOD); const bf16* wt = (const bf16*)(ws + WS_WGU); float* bias2 = (float*)(ws + WS_BIAS2);
    const int gw = F.vcu * NWAVES + F.wave, NGW = F.G * NWAVES;
    f32x4 sh[4][4];
#pragma unroll
    for (int bb = 0; bb < 4; ++bb)
#pragma unroll
        for (int j = 0; j < 4; ++j) sh[bb][j] = *(const f32x4*)(mod + (size_t)bb * 6144 + 3 * DM + 16 * F.lane + 4 * j);
    for (int c = gw; c < 2 * FF; c += NGW) {
        const v4u w0 = *(const GAS v4u*)(wt + (size_t)c * DM + 16 * F.lane), w1 = *(const GAS v4u*)(wt + (size_t)c * DM + 16 * F.lane + 8);
        const unsigned wu[8] = {w0.x, w0.y, w0.z, w0.w, w1.x, w1.y, w1.z, w1.w};
        float s[4] = {0.f, 0.f, 0.f, 0.f};
#pragma unroll
        for (int j = 0; j < 4; ++j) { const float e0 = __builtin_bit_cast(float, wu[2 * j] << 16), e1 = __builtin_bit_cast(float, wu[2 * j] & 0xffff0000u), e2 = __builtin_bit_cast(float, wu[2 * j + 1] << 16), e3 = __builtin_bit_cast(float, wu[2 * j + 1] & 0xffff0000u);
#pragma unroll
            for (int bb = 0; bb < 4; ++bb) s[bb] += (sh[bb][j][0] * e0 + sh[bb][j][1] * e1) + (sh[bb][j][2] * e2 + sh[bb][j][3] * e3); }
#pragma unroll
        for (int bb = 0; bb < 4; ++bb) { const float t = wave_sum(s[bb]); if (F.lane == 0) bias2[(size_t)bb * 2 * FF + c] = t; }
    }
}
#define XB_TMO      128
#define XB_XCNT(j)  (256  + 64 * (j))
#define XB_XSUB(j)  (1280 + 64 * (j))
#define XB_XGEN(j)  (2304 + 64 * (j))
#define XB_TOP      3328
#define XB_TOPGEN   3392
#define XCD_BAR_WORDS 3456
#define XB_SPIN_CAP (1u << 18)

__device__ __forceinline__ unsigned xb_ld(unsigned* p)              { return __hip_atomic_load(p, __ATOMIC_RELAXED, __HIP_MEMORY_SCOPE_AGENT); }
__device__ __forceinline__ unsigned xb_add(unsigned* p, unsigned v) { return __hip_atomic_fetch_add(p, v, __ATOMIC_RELAXED, __HIP_MEMORY_SCOPE_AGENT); }
__device__ __forceinline__ unsigned xb_xcc_id() { return (unsigned)__builtin_amdgcn_s_getreg((3 << 11) | 20) & 0xFu; }
#define XB_SPIN(cond, bar) do { unsigned _sp = 0; while (cond) { __builtin_amdgcn_s_sleep(1); \
    if ((++_sp & 255u) == 0u) { if (xb_ld(&(bar)[XB_TMO])) break; if (_sp > XB_SPIN_CAP) { atomicAdd(&(bar)[XB_TMO], 1u); break; } } } } while (0)

struct XcdBarrier {
    unsigned* bar; unsigned x;
    volatile LAS unsigned* st;
};

__device__ __forceinline__ XcdBarrier xcd_barrier_post(unsigned* bar, volatile LAS unsigned* st) {
    XcdBarrier b; b.bar = bar; b.x = xb_xcc_id(); b.st = st;
    if (threadIdx.x == 0) (void)xb_add(&bar[XB_XCNT(b.x)], 1u);
    return b;
}
__device__ __forceinline__ void xcd_barrier_complete(unsigned* bar, unsigned x, unsigned& nloc, unsigned& nx) {
    const unsigned G = gridDim.x * gridDim.y * gridDim.z;
    unsigned sum, cnt, mine, sp = 0u;
    for (;;) {
        sum = 0u; cnt = 0u; mine = 0u;
#pragma unroll
        for (unsigned j = 0; j < 16; ++j) { const unsigned c = xb_ld(&bar[XB_XCNT(j)]); sum += c; cnt += (c > 0u) ? 1u : 0u; mine = (j == x) ? c : mine; }
        if (sum == G) break;
        __builtin_amdgcn_s_sleep(1);
        if ((++sp & 255u) == 0u) { if (xb_ld(&bar[XB_TMO])) break; if (sp > XB_SPIN_CAP) { atomicAdd(&bar[XB_TMO], 1u); break; } }
    }
    nloc = mine > 0u ? mine : 1u; nx = cnt > 0u ? cnt : 1u;
}

__device__ __forceinline__ void xcd_barrier(const XcdBarrier& b) {
    asm volatile("s_waitcnt vmcnt(0)" ::: "memory");
    __syncthreads();
    if (threadIdx.x == 0) {
        unsigned* bar = b.bar;
        __builtin_amdgcn_s_waitcnt(0);
        unsigned nloc = b.st[0], nx = b.st[1];
        if (nloc == 0u) { xcd_barrier_complete(bar, b.x, nloc, nx); b.st[0] = nloc; b.st[1] = nx; }
        const unsigned old = xb_add(&bar[XB_XSUB(b.x)], 1u);
        const unsigned gen = old / nloc;
        if (old + 1u == (gen + 1u) * nloc) {
            __builtin_amdgcn_fence(__ATOMIC_RELEASE, "agent");
            asm volatile("s_waitcnt vmcnt(0)" ::: "memory");
            const unsigned og = xb_add(&bar[XB_TOP], 1u);
            const unsigned tg = og / nx;
            if (og + 1u == (tg + 1u) * nx) xb_add(&bar[XB_TOPGEN], 1u);
            else XB_SPIN(xb_ld(&bar[XB_TOPGEN]) == tg, bar);
            __builtin_amdgcn_fence(__ATOMIC_ACQUIRE, "agent");
            xb_add(&bar[XB_XGEN(b.x)], 1u);
            asm volatile("s_waitcnt vmcnt(0)" ::: "memory");
        } else {
            XB_SPIN(xb_ld(&bar[XB_XGEN(b.x)]) == gen, bar);
            __builtin_amdgcn_fence(__ATOMIC_ACQUIRE, "agent");
            asm volatile("s_waitcnt vmcnt(0)" ::: "memory");
        }
    }
    __syncthreads();
}
#define ATT_NS att
#ifndef ATT_ABL
#define ATT_ABL 0
#endif
#ifndef ATT_STAGGER
#define ATT_STAGGER 0
#endif
#ifndef ATT_SLEEP
#define ATT_SLEEP 24
#endif
namespace ATT_NS {
using bf16x8 = __attribute__((ext_vector_type(8))) short;
using s16x4 = __attribute__((ext_vector_type(4))) short;
using f32x16 = __attribute__((ext_vector_type(16))) float;
using u32x4 = __attribute__((ext_vector_type(4))) unsigned;
typedef LAS const char* lds_cptr;
typedef short v4i16_t __attribute__((ext_vector_type(4)));
constexpr int SLOT = 16384, NSLOT = 4, LDS_OST = 65536, LDS_LUT = 98304, LDS_IMP = 100352, LDS_SELM = 133120, LDS_MISC = 134144, LDS_WSF = 134400, LDS_LUTG = 136448  , LDS_ATT_END = 144640;
constexpr float LOG2E = 1.4426950408889634f;
#define MFMA32(a, b, c) __builtin_amdgcn_mfma_f32_32x32x16_bf16(a, b, c, 0, 0, 0)
#define ATT_WAIT_BAR(N) asm volatile("s_waitcnt vmcnt(" #N ") lgkmcnt(0)\n\ts_barrier" ::: "memory")
__device__ __forceinline__ void glds16(const void* gsrc, unsigned lds_dst) { unsigned keep;
    asm volatile("s_mov_b32 %0, m0\n\ts_mov_b32 m0, %2\n\ts_nop 0\n\tglobal_load_lds_dwordx4 %1, off\n\ts_mov_b32 m0, %0" : "=&s"(keep) : "v"(gsrc), "s"(lds_dst) : "memory"); }
typedef float f32x2_t __attribute__((ext_vector_type(2))); typedef __bf16 bf16x2_t __attribute__((ext_vector_type(2)));
__device__ __forceinline__ unsigned cvtpk(float lo, float hi) { f32x2_t v = {lo, hi}; bf16x2_t b = __builtin_convertvector(v, bf16x2_t); return __builtin_bit_cast(unsigned, b); }
__device__ __forceinline__ s16x4 vtr(lds_cptr p) { return __builtin_bit_cast(s16x4, __builtin_amdgcn_ds_read_tr16_b64_v4i16((LAS v4i16_t*)p)); }
__device__ __forceinline__ int t5_bucket(int d) {
    if (d < 16) return d;
    int b = 16;
    b += (d >= 19); b += (d >= 21); b += (d >= 24); b += (d >= 27); b += (d >= 31); b += (d >= 35); b += (d >= 40); b += (d >= 46);
    b += (d >= 52); b += (d >= 59); b += (d >= 67); b += (d >= 77); b += (d >= 87); b += (d >= 99); b += (d >= 113);
    return b;
}
struct Ctx { LAS char* lds; int wid; int lane, r32, hi; };
__device__ __forceinline__ int fresh_lane() { int l; asm volatile("v_mbcnt_lo_u32_b32 %0, -1, 0\n\tv_mbcnt_hi_u32_b32 %0, -1, %0" : "=v"(l)); return l; }
__device__ __forceinline__ Ctx make_ctx(LAS unsigned char* lds, int tid) {
    Ctx c; c.lds = (LAS char*)lds; c.wid = __builtin_amdgcn_readfirstlane(tid >> 6); c.lane = tid & 63; c.r32 = c.lane & 31; c.hi = c.lane >> 5; return c;
}
template <bool HASV, class QK, class SM>
__device__ __forceinline__ void run_stream(const Ctx& c, const bf16* Kb, const bf16* Vb, int t0, int t1, QK&& qk, SM&& sm) {
    const int n = t1 - t0; if (n <= 0) return;
    const int lane = fresh_lane(), r32 = lane & 31, hi = lane >> 5; const unsigned lds0 = (unsigned)(uintptr_t)c.lds;
    const bf16* ks = Kb + ((8 * c.wid + (lane >> 3)) * 64 + (((lane & 7) ^ (((8 * c.wid + (lane >> 3)) >> 1) & 7)) << 3)); const bf16* vs = Vb + ((16 * (c.wid & 3) + (lane >> 2)) * 64 + (c.wid >> 2) * 32 + (lane & 3) * 8);
    const unsigned kdst = lds0 + c.wid * 1024, vdst = lds0 + 8192 + c.wid * 1024;
    const lds_cptr kp0 = (lds_cptr)c.lds + r32 * 128;
    const lds_cptr vp0 = (lds_cptr)c.lds + 8192 + ((lane >> 4) & 1) * 32 + (lane & 3) * 8 + (4 * hi + ((lane & 15) >> 2)) * 64;
#define ATT_ISSUE(t, so) do { if (ATT_ABL & 4) break; glds16(ks + (size_t)(t) * 4096, (unsigned)__builtin_amdgcn_readfirstlane(kdst + (so))); if (HASV) glds16(vs + (size_t)(t) * 4096, (unsigned)__builtin_amdgcn_readfirstlane(vdst + (so))); } while (0)
    ATT_ISSUE(t0, 0); if (n > 1) ATT_ISSUE(t0 + 1, SLOT);
    const bool late = ATT_STAGGER && __builtin_amdgcn_readfirstlane(c.wid) >= 4;
    f32x16 s0 = {}, s1 = {};
    int slot = 0, slotp = 3 * SLOT, slot2 = 2 * SLOT;
    if (!late) {
        for (int i = 0; i < n; ++i) {
            if (i + 1 < n) { if (HASV) ATT_WAIT_BAR(2); else ATT_WAIT_BAR(1); } else ATT_WAIT_BAR(0);
            if (i + 2 < n) ATT_ISSUE(t0 + i + 2, slot2);
            if (!(ATT_ABL & 1)) qk(t0 + i, kp0 + slot, s0, s1); if (!(ATT_ABL & 2)) sm(t0 + i, vp0 + slot, s0, s1);
            slot = (slot == 3 * SLOT) ? 0 : slot + SLOT; slot2 = (slot2 == 3 * SLOT) ? 0 : slot2 + SLOT;
        }
    } else {
        for (int i = 0; i < n; ++i) {
            if (i + 1 < n) { if (HASV) ATT_WAIT_BAR(2); else ATT_WAIT_BAR(1); } else ATT_WAIT_BAR(0);
            if (i + 2 < n) ATT_ISSUE(t0 + i + 2, slot2);
            if (i > 0 && !(ATT_ABL & 2)) sm(t0 + i - 1, vp0 + slotp, s0, s1);
            if (!(ATT_ABL & 1)) qk(t0 + i, kp0 + slot, s0, s1);
            slotp = slot; slot = (slot == 3 * SLOT) ? 0 : slot + SLOT; slot2 = (slot2 == 3 * SLOT) ? 0 : slot2 + SLOT;
        }
        if (!(ATT_ABL & 2)) sm(t0 + n - 1, vp0 + slotp, s0, s1);
    }
    asm volatile("s_waitcnt lgkmcnt(0)\n\ts_barrier" ::: "memory");
#undef ATT_ISSUE
}
template <class FN1, class FN2>
__device__ __forceinline__ void run_stream_pairs(const Ctx& c, const bf16* Kb, const bf16* Vb, int t0, int t1, FN1&& fn1, FN2&& fn2) {
    const int n = t1 - t0; if (n <= 0) return;
    const int lane = fresh_lane(), r32 = lane & 31, hi = lane >> 5; const unsigned lds0 = (unsigned)(uintptr_t)c.lds;
    const bf16* ks = Kb + ((8 * c.wid + (lane >> 3)) * 64 + (((lane & 7) ^ (((8 * c.wid + (lane >> 3)) >> 1) & 7)) << 3)); const bf16* vs = Vb + ((16 * (c.wid & 3) + (lane >> 2)) * 64 + (c.wid >> 2) * 32 + (lane & 3) * 8);
    const unsigned kdst = lds0 + c.wid * 1024, vdst = lds0 + 8192 + c.wid * 1024;
    const lds_cptr kp0 = (lds_cptr)c.lds + r32 * 128;
    const lds_cptr vp0 = (lds_cptr)c.lds + 8192 + ((lane >> 4) & 1) * 32 + (lane & 3) * 8 + (4 * hi + ((lane & 15) >> 2)) * 64;
#define ATT_ISSUE1(t, so) do { glds16(ks + (size_t)(t) * 4096, (unsigned)__builtin_amdgcn_readfirstlane(kdst + (so))); glds16(vs + (size_t)(t) * 4096, (unsigned)__builtin_amdgcn_readfirstlane(vdst + (so))); } while (0)
    ATT_ISSUE1(t0, 0); if (n > 1) ATT_ISSUE1(t0 + 1, SLOT);
    int base = 0;
    for (int i = 0; i < n; i += 2) {
        ATT_WAIT_BAR(0);
        const int nb = 2 * SLOT - base;
        if (i + 2 < n) ATT_ISSUE1(t0 + i + 2, nb); if (i + 3 < n) ATT_ISSUE1(t0 + i + 3, nb + SLOT);
        if (i + 1 < n) fn2(t0 + i, kp0 + base, vp0 + base, kp0 + base + SLOT, vp0 + base + SLOT); else fn1(t0 + i, kp0 + base, vp0 + base);
        base = nb;
    }
    asm volatile("s_waitcnt lgkmcnt(0)\n\ts_barrier" ::: "memory");
#undef ATT_ISSUE1
}
__device__ __forceinline__ void qk_tile(f32x16& s0, f32x16& s1, lds_cptr kp, const bf16x8 (&qr)[4]) {
    bf16x8 kf[8];
    { const int l = fresh_lane(), f = ((l & 31) >> 1) & 7, hi = l >> 5;
#pragma unroll
      for (int d0 = 0; d0 < 4; ++d0) { const int off = ((2 * d0 + hi) ^ f) << 4; kf[2 * d0] = *(const LAS bf16x8*)(kp + off); kf[2 * d0 + 1] = *(const LAS bf16x8*)(kp + 4096 + off); } }
    const f32x16 z = {};
    s0 = MFMA32(kf[0], qr[0], z); s1 = MFMA32(kf[1], qr[0], z);
#pragma unroll
    for (int d0 = 1; d0 < 4; ++d0) { s0 = MFMA32(kf[2 * d0], qr[d0], s0); s1 = MFMA32(kf[2 * d0 + 1], qr[d0], s1); }
}
template <bool MASK>
__device__ __forceinline__ void pv_tile(f32x16 (&o)[2], lds_cptr vp, const f32x16& p0, const f32x16& p1, unsigned mask) {
    if (ATT_ABL & 8) { o[0][0] += p0[0] + p1[5]; return; }
    u32x4 pw0 = {cvtpk(p0[0], p0[1]), cvtpk(p0[2], p0[3]), cvtpk(p0[4], p0[5]), cvtpk(p0[6], p0[7])}, pw1 = {cvtpk(p0[8], p0[9]), cvtpk(p0[10], p0[11]), cvtpk(p0[12], p0[13]), cvtpk(p0[14], p0[15])};
    u32x4 pw2 = {cvtpk(p1[0], p1[1]), cvtpk(p1[2], p1[3]), cvtpk(p1[4], p1[5]), cvtpk(p1[6], p1[7])}, pw3 = {cvtpk(p1[8], p1[9]), cvtpk(p1[10], p1[11]), cvtpk(p1[12], p1[13]), cvtpk(p1[14], p1[15])};
    if (MASK) { pw0 &= mask; pw1 &= mask; pw2 &= mask; pw3 &= mask; }
    if (ATT_ABL & 64) { o[0] = MFMA32(__builtin_bit_cast(bf16x8, pw0), __builtin_bit_cast(bf16x8, pw1), o[0]); o[1] = MFMA32(__builtin_bit_cast(bf16x8, pw2), __builtin_bit_cast(bf16x8, pw3), o[1]); return; }
    s16x4 vlo[8], vhi[8];
#pragma unroll
    for (int i = 0; i < 8; ++i) { vlo[i] = vtr(vp + ((i >> 2) * 4096 + (i & 3) * 1024)); vhi[i] = vtr(vp + ((i >> 2) * 4096 + (i & 3) * 1024 + 512)); }
#define ATT_VFR(i) (bf16x8){vlo[i][0], vlo[i][1], vlo[i][2], vlo[i][3], vhi[i][0], vhi[i][1], vhi[i][2], vhi[i][3]}
    o[0] = MFMA32(__builtin_bit_cast(bf16x8, pw0), ATT_VFR(0), o[0]); o[1] = MFMA32(__builtin_bit_cast(bf16x8, pw0), ATT_VFR(4), o[1]);
    o[0] = MFMA32(__builtin_bit_cast(bf16x8, pw1), ATT_VFR(1), o[0]); o[1] = MFMA32(__builtin_bit_cast(bf16x8, pw1), ATT_VFR(5), o[1]);
    o[0] = MFMA32(__builtin_bit_cast(bf16x8, pw2), ATT_VFR(2), o[0]); o[1] = MFMA32(__builtin_bit_cast(bf16x8, pw2), ATT_VFR(6), o[1]);
    o[0] = MFMA32(__builtin_bit_cast(bf16x8, pw3), ATT_VFR(3), o[0]); o[1] = MFMA32(__builtin_bit_cast(bf16x8, pw3), ATT_VFR(7), o[1]);
#undef ATT_VFR
}
#define ATT_SB() __builtin_amdgcn_sched_barrier(0)
struct KF { bf16x8 f[8]; };
struct VF { s16x4 lo[8], hi[8]; };
struct PW4 { u32x4 w0, w1, w2, w3; };
__device__ __forceinline__ void ld_k(KF& k, lds_cptr kp) {
    const int l = fresh_lane(), f = ((l & 31) >> 1) & 7, hi = l >> 5;
#pragma unroll
    for (int d0 = 0; d0 < 4; ++d0) { const int off = ((2 * d0 + hi) ^ f) << 4; k.f[2 * d0] = *(const LAS bf16x8*)(kp + off); k.f[2 * d0 + 1] = *(const LAS bf16x8*)(kp + 4096 + off); } }
__device__ __forceinline__ void qk_mfma(f32x16& s0, f32x16& s1, const KF& k, const bf16x8 (&qr)[4]) {
    const f32x16 z = {};
    s0 = MFMA32(k.f[0], qr[0], z); s1 = MFMA32(k.f[1], qr[0], z);
#pragma unroll
    for (int d0 = 1; d0 < 4; ++d0) { s0 = MFMA32(k.f[2 * d0], qr[d0], s0); s1 = MFMA32(k.f[2 * d0 + 1], qr[d0], s1); } }
__device__ __forceinline__ void ld_v(VF& v, lds_cptr vp) {
#pragma unroll
    for (int i = 0; i < 8; ++i) { v.lo[i] = vtr(vp + ((i >> 2) * 4096 + (i & 3) * 1024)); v.hi[i] = vtr(vp + ((i >> 2) * 4096 + (i & 3) * 1024 + 512)); } }
__device__ __forceinline__ PW4 pack4(const f32x16& p0, const f32x16& p1, unsigned mask) { PW4 w;
    w.w0 = (u32x4){cvtpk(p0[0], p0[1]), cvtpk(p0[2], p0[3]), cvtpk(p0[4], p0[5]), cvtpk(p0[6], p0[7])}; w.w1 = (u32x4){cvtpk(p0[8], p0[9]), cvtpk(p0[10], p0[11]), cvtpk(p0[12], p0[13]), cvtpk(p0[14], p0[15])};
    w.w2 = (u32x4){cvtpk(p1[0], p1[1]), cvtpk(p1[2], p1[3]), cvtpk(p1[4], p1[5]), cvtpk(p1[6], p1[7])}; w.w3 = (u32x4){cvtpk(p1[8], p1[9]), cvtpk(p1[10], p1[11]), cvtpk(p1[12], p1[13]), cvtpk(p1[14], p1[15])};
    w.w0 &= mask; w.w1 &= mask; w.w2 &= mask; w.w3 &= mask; return w; }
__device__ __forceinline__ void pv_mfma(f32x16 (&o)[2], const VF& v, const PW4& w) {
#define ATT_VF(i) (bf16x8){v.lo[i][0], v.lo[i][1], v.lo[i][2], v.lo[i][3], v.hi[i][0], v.hi[i][1], v.hi[i][2], v.hi[i][3]}
    o[0] = MFMA32(__builtin_bit_cast(bf16x8, w.w0), ATT_VF(0), o[0]); o[1] = MFMA32(__builtin_bit_cast(bf16x8, w.w0), ATT_VF(4), o[1]);
    o[0] = MFMA32(__builtin_bit_cast(bf16x8, w.w1), ATT_VF(1), o[0]); o[1] = MFMA32(__builtin_bit_cast(bf16x8, w.w1), ATT_VF(5), o[1]);
    o[0] = MFMA32(__builtin_bit_cast(bf16x8, w.w2), ATT_VF(2), o[0]); o[1] = MFMA32(__builtin_bit_cast(bf16x8, w.w2), ATT_VF(6), o[1]);
    o[0] = MFMA32(__builtin_bit_cast(bf16x8, w.w3), ATT_VF(3), o[0]); o[1] = MFMA32(__builtin_bit_cast(bf16x8, w.w3), ATT_VF(7), o[1]);
#undef ATT_VF
}
__device__ __forceinline__ float rowsum32(const f32x16& p0, const f32x16& p1) { if (ATT_ABL & 32) return p0[0]; float a = p0[0] + p1[0], b = p0[1] + p1[1];
#pragma unroll
    for (int r = 2; r < 16; r += 2) { a += p0[r]; asm volatile("" : "+v"(a)); b += p0[r + 1]; asm volatile("" : "+v"(b)); a += p1[r]; asm volatile("" : "+v"(a)); b += p1[r + 1]; asm volatile("" : "+v"(b)); }
    return a + b; }
__device__ __forceinline__ void hook_exp(f32x16& s0, f32x16& s1) {
    if (ATT_ABL & 16) return;
#pragma unroll
    for (int r = 0; r < 16; ++r) { s0[r] = __builtin_amdgcn_exp2f(s0[r]); s1[r] = __builtin_amdgcn_exp2f(s1[r]); } }
__device__ __forceinline__ void hook_near(f32x16& s0, f32x16& s1, int base, const LAS float* lut) {
    asm volatile("" : "+v"(base));
#pragma unroll
    for (int r = 0; r < 16; ++r) { const int d0 = base - ((r & 3) + 8 * (r >> 2)), d1 = d0 - 32;
        s0[r] = __builtin_amdgcn_exp2f(s0[r] + lut[min(max(d0, -1), 113) + 1]); s1[r] = __builtin_amdgcn_exp2f(s1[r] + lut[min(max(d1, -1), 113) + 1]); } }
__device__ __forceinline__ void hook_edge(f32x16& s0, f32x16& s1, int base, int win) {
    asm volatile("" : "+v"(base));
#pragma unroll
    for (int r = 0; r < 16; ++r) { const int d0 = base - ((r & 3) + 8 * (r >> 2)), d1 = d0 - 32;
        s0[r] = __builtin_amdgcn_exp2f(d0 < win ? s0[r] : -INFINITY); s1[r] = __builtin_amdgcn_exp2f(d1 < win ? s1[r] : -INFINITY); } }
__device__ __forceinline__ void hook_cmp(f32x16& s0, f32x16& s1, int nrel  , float cb) {
    asm volatile("" : "+v"(nrel));
#pragma unroll
    for (int r = 0; r < 16; ++r) { const int c0 = (r & 3) + 8 * (r >> 2);
        s0[r] = __builtin_amdgcn_exp2f(s0[r] + ((c0 <= nrel) ? cb : -INFINITY)); s1[r] = __builtin_amdgcn_exp2f(s1[r] + ((c0 + 32 <= nrel) ? cb : -INFINITY)); } }
__device__ __forceinline__ void row_factors(const Ctx& c, float f, float (&fr)[16]) {
    const int lane = fresh_lane(), r32 = lane & 31, hi = lane >> 5; LAS float* wsf = (LAS float*)(c.lds + LDS_WSF) + c.wid * 64;
    asm volatile("s_waitcnt lgkmcnt(0)" ::: "memory");
    if (hi == 0) wsf[r32] = f;
    asm volatile("s_waitcnt lgkmcnt(0)" ::: "memory");
#pragma unroll
    for (int r = 0; r < 16; ++r) fr[r] = wsf[(r & 3) + 8 * (r >> 2) + 4 * hi];
    asm volatile("s_waitcnt lgkmcnt(0)" ::: "memory");
}
__device__ __forceinline__ float pair_sum(float v) { auto rr = __builtin_amdgcn_permlane32_swap(__float_as_uint(v), __float_as_uint(v), false, false); return __uint_as_float(rr[0]) + __uint_as_float(rr[1]); }
template <class RowOff>
__device__ __forceinline__ void store_rows(const Ctx& c, const f32x16 (&o)[2], bf16* dst, RowOff&& rowoff) {
    LAS bf16* stg = (LAS bf16*)(c.lds + LDS_OST) + c.wid * 2048;
    const int lane = fresh_lane(), r32 = lane & 31, hi = lane >> 5;
#pragma unroll
    for (int r = 0; r < 16; ++r) { const int orow = (r & 3) + 8 * (r >> 2) + 4 * hi;
#pragma unroll
        for (int d0 = 0; d0 < 2; ++d0) stg[orow * 64 + d0 * 32 + r32] = (bf16)f2bf(o[d0][r]); }
    asm volatile("s_waitcnt lgkmcnt(0)" ::: "memory");
#pragma unroll
    for (int i = 0; i < 4; ++i) { const int row = i * 8 + (lane >> 3), ch = lane & 7; const u32x4 v = *(const LAS u32x4*)(stg + row * 64 + ch * 8); *(u32x4*)(dst + rowoff(row) + ch * 8) = v; }
    asm volatile("s_waitcnt lgkmcnt(0)" ::: "memory");
}
struct AttnPtrs { const bf16* qkv; const float* kmp; const float* gates; const bf16* kcmp; const bf16* vcmp; const float* rel_bias; bf16* mix; unsigned* selg; bf16* part_o; float* part_l; };

__device__ __forceinline__ unsigned moba_gate32(const AttnPtrs& P, int b, int h, int i, const bf16x8 (&qr)[4], int r32, int hi) {
    unsigned selmask = 0u;
    if (i > 0) {
        bf16x8 kmf[4];
        const float* kp = P.kmp + ((size_t)((b * 8 + h) * 32 + r32) * 2) * 64;
#pragma unroll
        for (int d0 = 0; d0 < 4; ++d0) { const f32x4 a0 = *(const f32x4*)(kp + d0 * 16 + hi * 8), a1 = *(const f32x4*)(kp + d0 * 16 + hi * 8 + 4), b0 = *(const f32x4*)(kp + 64 + d0 * 16 + hi * 8), b1 = *(const f32x4*)(kp + 64 + d0 * 16 + hi * 8 + 4);
            const f32x4 m0 = (a0 + b0) * (1.f / 256.f), m1 = (a1 + b1) * (1.f / 256.f);
            u32x4 w = {cvtpk(m0[0], m0[1]), cvtpk(m0[2], m0[3]), cvtpk(m1[0], m1[1]), cvtpk(m1[2], m1[3])}; kmf[d0] = __builtin_bit_cast(bf16x8, w); }
        f32x16 sg = {};
#pragma unroll
        for (int d0 = 0; d0 < 4; ++d0) sg = MFMA32(kmf[d0], qr[d0], sg);
        float v[16];
#pragma unroll
        for (int r = 0; r < 16; ++r) v[r] = ((r & 3) + 8 * (r >> 2) + 4 * hi < i) ? sg[r] : -INFINITY;
#pragma unroll
        for (int it = 0; it < 3; ++it) {
            float m = v[0]; int jb = 4 * hi;
#pragma unroll
            for (int r = 1; r < 16; ++r) { const int j = (r & 3) + 8 * (r >> 2) + 4 * hi; if (v[r] > m) { m = v[r]; jb = j; } }
            auto rm = __builtin_amdgcn_permlane32_swap(__float_as_uint(m), __float_as_uint(m), false, false);
            auto rj = __builtin_amdgcn_permlane32_swap((unsigned)jb, (unsigned)jb, false, false);
            const float mo = __uint_as_float(hi ? rm[0] : rm[1]); const int jo = (int)(hi ? rj[0] : rj[1]);
            const bool mine = (m > mo) || (m == mo && jb < jo);
            const float mw = mine ? m : mo; const int jw = mine ? jb : jo;
            if (mw > -INFINITY) { selmask |= 1u << jw;
#pragma unroll
                for (int r = 0; r < 16; ++r) if ((r & 3) + 8 * (r >> 2) + 4 * hi == jw) v[r] = -INFINITY; }
        }
    }
    return selmask;
}
__device__ __forceinline__ void moba_gate_phase(const AttnPtrs& P, int vcu, int G, int tid) {
    const int lane = tid & 63, r32 = lane & 31, hi = lane >> 5; const int wid = __builtin_amdgcn_readfirstlane(tid >> 6);
    for (int task = vcu * 8 + wid; task < 8192; task += G * 8) { const int w = task & 7, i = (task >> 3) & 31, bh = task >> 8; const int qpos = 256 * i + 32 * w + r32;
        const bf16* QA = P.qkv + ((size_t)bh * SEQ) * 64;
        bf16x8 qr[4];
#pragma unroll
        for (int d0 = 0; d0 < 4; ++d0) qr[d0] = *(const bf16x8*)(QA + (size_t)qpos * 64 + d0 * 16 + hi * 8);
        const unsigned m = moba_gate32(P, bh >> 3, bh & 7, i, qr, r32, hi);
        if (hi == 0) P.selg[(size_t)bh * SEQ + qpos] = m; }
}
__device__ __forceinline__ void moba_lut(const Ctx& c, const AttnPtrs& P, int h) {
    LAS float* lut = (LAS float*)(c.lds + LDS_LUT);
    if (threadIdx.x < 115) lut[threadIdx.x] = (threadIdx.x == 0) ? -INFINITY : (P.rel_bias[t5_bucket(threadIdx.x - 1) * 16 + h] - P.rel_bias[31 * 16 + h]) * LOG2E;
}
__device__ __forceinline__ void moba_past_item(const Ctx& c, const AttnPtrs& P, int b, int h, int j) {
    const int bh = b * 8 + h, tid = threadIdx.x;
    const bf16* QA = P.qkv + ((size_t)bh * SEQ) * 64; const bf16* KA = QA + QKV_BIG + (size_t)256 * j * 64; const bf16* VA = QA + 2 * QKV_BIG + (size_t)256 * j * 64;
    const LAS float* lut = (const LAS float*)(c.lds + LDS_LUTG) + h * 128;
    { const int lane = fresh_lane(); const unsigned lds0 = (unsigned)(uintptr_t)c.lds;
      const bf16* ks = KA + ((8 * c.wid + (lane >> 3)) * 64 + (((lane & 7) ^ (((8 * c.wid + (lane >> 3)) >> 1) & 7)) << 3)); const bf16* vs = VA + ((16 * (c.wid & 3) + (lane >> 2)) * 64 + (c.wid >> 2) * 32 + (lane & 3) * 8);
#pragma unroll
      for (int tt = 0; tt < 4; ++tt) { glds16(ks + tt * 4096, (unsigned)__builtin_amdgcn_readfirstlane(lds0 + c.wid * 1024 + tt * SLOT)); glds16(vs + tt * 4096, (unsigned)__builtin_amdgcn_readfirstlane(lds0 + 8192 + c.wid * 1024 + tt * SLOT)); } }
    LAS unsigned short* list = (LAS unsigned short*)(c.lds + LDS_IMP);
    LAS unsigned* wcnt = (LAS unsigned*)(c.lds + LDS_MISC) + 8;
    const unsigned* sg = P.selg + (size_t)bh * SEQ;
    if (tid < 256) list[tid] = (unsigned short)((256 * j + tid) | (3 << 13));
    int total = 256;
    for (int base = (j + 1) * 256; base < SEQ; base += 2048) {
        const int q0 = base + 4 * tid; uint4 m4 = make_uint4(0u, 0u, 0u, 0u); if (q0 < SEQ) m4 = *(const uint4*)(sg + q0);
        const unsigned long long b0 = __ballot((m4.x >> j) & 1u), b1 = __ballot((m4.y >> j) & 1u), b2 = __ballot((m4.z >> j) & 1u), b3 = __ballot((m4.w >> j) & 1u);
        const int c0 = (int)__popcll(b0), c1 = (int)__popcll(b1), c2 = (int)__popcll(b2), c3 = (int)__popcll(b3);
        if ((tid & 63) == 0) wcnt[c.wid] = (unsigned)(c0 + c1 + c2 + c3);
        asm volatile("s_waitcnt vmcnt(0) lgkmcnt(0)\n\ts_barrier" ::: "memory");
        int off = total, tot = 0;
#pragma unroll
        for (int w = 0; w < 8; ++w) { const int v = (int)wcnt[w]; off += (w < c.wid) ? v : 0; tot += v; }
        const unsigned long long below = (1ull << (tid & 63)) - 1ull; const unsigned lowj = (1u << j) - 1u;
        if ((m4.x >> j) & 1u) list[off + __popcll(b0 & below)] = (unsigned short)((q0 + 0) | (__popc(m4.x & lowj) << 13)); off += c0;
        if ((m4.y >> j) & 1u) list[off + __popcll(b1 & below)] = (unsigned short)((q0 + 1) | (__popc(m4.y & lowj) << 13)); off += c1;
        if ((m4.z >> j) & 1u) list[off + __popcll(b2 & below)] = (unsigned short)((q0 + 2) | (__popc(m4.z & lowj) << 13)); off += c2;
        if ((m4.w >> j) & 1u) list[off + __popcll(b3 & below)] = (unsigned short)((q0 + 3) | (__popc(m4.w & lowj) << 13));
        total += tot;
        asm volatile("s_waitcnt lgkmcnt(0)\n\ts_barrier" ::: "memory");
    }
    total = __builtin_amdgcn_readfirstlane(total);
    { const int npad = (32 - (total & 31)) & 31; if (tid < npad) list[total + tid] = 0xFFFFu; }
    const int nchunks = (total + 31) >> 5;
    asm volatile("s_waitcnt vmcnt(0) lgkmcnt(0)\n\ts_barrier" ::: "memory");
    for (int ch = c.wid; ch < nchunks; ch += 8) {
        const int lane = fresh_lane(), r32 = lane & 31, hi = lane >> 5;
        const lds_cptr kp0 = (lds_cptr)c.lds + r32 * 128;
        const lds_cptr vp0 = (lds_cptr)c.lds + 8192 + ((lane >> 4) & 1) * 32 + (lane & 3) * 8 + (4 * hi + ((lane & 15) >> 2)) * 64;
        const unsigned e = list[32 * ch + r32]; const bool valid = e != 0xFFFFu; const int q = valid ? (int)(e & 0x1FFFu) : SEQ - 1;
        bf16x8 qr[4];
#pragma unroll
        for (int d0 = 0; d0 < 4; ++d0) qr[d0] = *(const bf16x8*)(QA + (size_t)q * 64 + d0 * 16 + hi * 8);
        asm volatile("" : "+v"(qr[0]), "+v"(qr[1]), "+v"(qr[2]), "+v"(qr[3]));
        const bool anynear = __any(valid && (unsigned)((q >> 8) - j) <= 1u);
        f32x16 o[2]; o[0] = f32x16{}; o[1] = f32x16{}; float l_reg = 0.f;
#pragma unroll 1
        for (int tt = 0; tt < 4; ++tt) { f32x16 s0, s1; qk_tile(s0, s1, kp0 + tt * SLOT, qr);
            if (anynear) hook_near(s0, s1, q - (256 * j + 64 * tt) - 4 * hi, lut); else hook_exp(s0, s1);
            l_reg += rowsum32(s0, s1);
            pv_tile<false>(o, vp0 + tt * SLOT, s0, s1, 0u); }
        const float L = pair_sum(l_reg);
        if (hi == 0 && valid) P.part_l[((size_t)bh * SEQ + q) * 4 + (e >> 13)] = L;
        LAS bf16* stg = (LAS bf16*)(c.lds + LDS_OST) + c.wid * 2048;
#pragma unroll
        for (int r = 0; r < 16; ++r) { const int orow = (r & 3) + 8 * (r >> 2) + 4 * hi;
#pragma unroll
            for (int d0 = 0; d0 < 2; ++d0) stg[orow * 64 + d0 * 32 + r32] = (bf16)f2bf(o[d0][r]); }
        asm volatile("s_waitcnt lgkmcnt(0)" ::: "memory");
#pragma unroll
        for (int it = 0; it < 4; ++it) { const int row = it * 8 + (lane >> 3), chn = lane & 7; const unsigned e2 = list[32 * ch + row];
            const u32x4 v = *(const LAS u32x4*)(stg + row * 64 + chn * 8);
            if (e2 != 0xFFFFu) *(u32x4*)(P.part_o + (((size_t)bh * SEQ + (e2 & 0x1FFFu)) * 4 + (e2 >> 13)) * 64 + chn * 8) = v; }
        asm volatile("s_waitcnt lgkmcnt(0)" ::: "memory");
    }
    asm volatile("s_waitcnt lgkmcnt(0)\n\ts_barrier" ::: "memory");
}
__device__ __forceinline__ void moba_merge_pass(const AttnPtrs& P, int vcu, int G, int tid) {
    const int lane = tid & 63, h = lane >> 3, chn = lane & 7; const int wid = __builtin_amdgcn_readfirstlane(tid >> 6);
#pragma unroll 2
    for (int tok = vcu * 8 + wid; tok < TOK; tok += G * 8) { const int b = tok >> 13, q = tok & (SEQ - 1);
        const size_t qi = (size_t)(b * 8 + h) * SEQ + q; const int ns = __popc(P.selg[qi]);
        float Lt = P.part_l[qi * 4 + 3]; const u32x4 pw = *(const u32x4*)(P.part_o + (qi * 4 + 3) * 64 + chn * 8);
        f32x4 a0 = {__uint_as_float(pw.x << 16), __uint_as_float(pw.x & 0xffff0000u), __uint_as_float(pw.y << 16), __uint_as_float(pw.y & 0xffff0000u)};
        f32x4 a1 = {__uint_as_float(pw.z << 16), __uint_as_float(pw.z & 0xffff0000u), __uint_as_float(pw.w << 16), __uint_as_float(pw.w & 0xffff0000u)};
#pragma unroll
        for (int sidx = 0; sidx < 3; ++sidx) if (sidx < ns) { Lt += P.part_l[qi * 4 + sidx]; const u32x4 pv = *(const u32x4*)(P.part_o + (qi * 4 + sidx) * 64 + chn * 8);
            a0 += (f32x4){__uint_as_float(pv.x << 16), __uint_as_float(pv.x & 0xffff0000u), __uint_as_float(pv.y << 16), __uint_as_float(pv.y & 0xffff0000u)};
            a1 += (f32x4){__uint_as_float(pv.z << 16), __uint_as_float(pv.z & 0xffff0000u), __uint_as_float(pv.w << 16), __uint_as_float(pv.w & 0xffff0000u)}; }
        const float inv = 1.f / Lt; a0 *= inv; a1 *= inv;
        const u32x4 w = {cvtpk(a0[0], a0[1]), cvtpk(a0[2], a0[3]), cvtpk(a1[0], a1[1]), cvtpk(a1[2], a1[3])};
        *(u32x4*)(P.mix + (size_t)tok * DM + h * 64 + chn * 8) = w; }
}

__device__ __forceinline__ void nsa_item(const Ctx& c, const AttnPtrs& P, int b, int g, int ci, int flags = 0) {
    const int ql = 8 * c.wid + (c.r32 >> 2), rh = c.r32 & 3, qpos = 64 * ci + ql, hb = 4 * g + rh;
    const int qw0 = 64 * ci + 8 * c.wid;
    const bf16* QB = P.qkv + 3 * QKV_BIG + ((size_t)(b * 8 + hb) * SEQ) * 64;
    const bf16* KS = P.qkv + 4 * QKV_BIG + 2 * QKV_SMALL + ((size_t)(b * 2 + g) * SEQ) * 64; const bf16* VS = KS + QKV_SMALL; const bf16* KW = KS + 2 * QKV_SMALL; const bf16* VW = KS + 3 * QKV_SMALL;
    const bf16* KC = P.kcmp + (size_t)(b * 2 + g) * 512 * 64; const bf16* VC = P.vcmp + (size_t)(b * 2 + g) * 512 * 64;
    bf16x8 qr[4];
#pragma unroll
    for (int d0 = 0; d0 < 4; ++d0) qr[d0] = *(const bf16x8*)(QB + (size_t)qpos * 64 + d0 * 16 + c.hi * 8);
    asm volatile("" : "+v"(qr[0]), "+v"(qr[1]), "+v"(qr[2]), "+v"(qr[3]));
    const LAS float* lut = (const LAS float*)(c.lds + LDS_LUTG) + (8 + hb) * 128;
    LAS float* imp = (LAS float*)(c.lds + LDS_IMP);
    LAS unsigned* selm = (LAS unsigned*)(c.lds + LDS_SELM);
    f32x16 o[2]; float l_reg; float fr[16];
    LAS float* park = (LAS float*)(c.lds + LDS_OST) + c.wid * 1024 + c.lane;
    LAS float* park1 = (LAS float*)(c.lds + LDS_IMP) + c.wid * 1024 + c.lane;
    const int nct = (4 * ci + 3 + 63) >> 6;
    const int nlim = (qpos >= 31) ? ((qpos - 31) >> 4) : -1;
    LAS bf16* impt = (LAS bf16*)(c.lds + ((rh & 2) ? LDS_IMP : LDS_OST)) + ((rh & 1) * 64 + ql) * 128;
    l_reg = 0.f; o[0] = f32x16{}; o[1] = f32x16{};
    {
        float carry = 0.f;
        run_stream<true>(c, KC, VC, 0, nct,
          [&](int t, lds_cptr kp, f32x16& s0, f32x16& s1) { qk_tile(s0, s1, kp, qr); },
          [&](int t, lds_cptr vp, f32x16& s0, f32x16& s1) {
            hook_cmp(s0, s1, nlim - 64 * t - 4 * c.hi, 0.f);
            l_reg += rowsum32(s0, s1);
#pragma unroll
            for (int half = 0; half < 2; ++half) {
                float g4[4], e[4];
#pragma unroll
                for (int a = 0; a < 4; ++a) { const float x0 = half ? s1[4 * a] : s0[4 * a], x1 = half ? s1[4 * a + 1] : s0[4 * a + 1], x2 = half ? s1[4 * a + 2] : s0[4 * a + 2], x3 = half ? s1[4 * a + 3] : s0[4 * a + 3];
                    g4[a] = (x0 + x1) + (x2 + x3); e[a] = x3; }
                float x[4];
#pragma unroll
                for (int a = 0; a < 4; ++a) { auto rr = __builtin_amdgcn_permlane32_swap(__float_as_uint(e[a]), __float_as_uint(e[a]), false, false); x[a] = __uint_as_float(c.hi ? rr[0] : rr[1]); }
                const int jb = 16 * t + 8 * half;
                float iv[4];
                if (c.hi) {
#pragma unroll
                    for (int a = 0; a < 4; ++a) iv[a] = g4[a] + x[a]; }
                else { iv[0] = g4[0] + carry; iv[1] = g4[1] + x[0]; iv[2] = g4[2] + x[1]; iv[3] = g4[3] + x[2]; carry = x[3]; }
#pragma unroll
                for (int a = 0; a < 4; ++a) impt[jb + 2 * a + c.hi] = (bf16)f2bf(iv[a]);
            }
            pv_tile<false>(o, vp, s0, s1, 0u);
        });
    }
    const float Lc = pair_sum(l_reg); const float invLc = Lc > 0.f ? 1.f / Lc : 0.f;
    { LAS float* wsfw = (LAS float*)(c.lds + LDS_WSF) + c.wid * 64; if (c.hi == 0) wsfw[32 + c.r32] = invLc; }
    {
        asm volatile("s_waitcnt lgkmcnt(0)\n\ts_barrier" ::: "memory");
        const int qq = 8 * c.wid + (c.lane >> 3), cc = c.lane & 7;
        unsigned m0 = 0u, m1 = 0u, m2w = 0u, m3 = 0u;
        if (ci <= 15) { m0 = (ci == 31) ? 0xffffffffu : ((2u << ci) - 1u); }
        else {
            float v[16];
            const LAS float* il = (const LAS float*)(c.lds + LDS_WSF) + c.wid * 64 + 32 + 4 * (c.lane >> 3);
            const float i0 = il[0], i1 = il[1], i2 = il[2], i3 = il[3];
            const LAS bf16* ta = (const LAS bf16*)(c.lds + LDS_OST) + qq * 128; const LAS bf16* tb = (const LAS bf16*)(c.lds + LDS_IMP) + qq * 128;
#pragma unroll
            for (int k = 0; k < 16; ++k) { const int j = cc + 8 * k;
                v[k] = (j >= 1 && j <= ci - 2) ? (bf2f(ta[j]) * i0 + bf2f(ta[64 * 128 + j]) * i1) + (bf2f(tb[j]) * i2 + bf2f(tb[64 * 128 + j]) * i3) : -INFINITY; }
            for (int it = 0; it < 13; ++it) {
                float m = v[0]; int jb = cc;
#pragma unroll
                for (int k = 1; k < 16; ++k) if (v[k] > m) { m = v[k]; jb = cc + 8 * k; }
#pragma unroll
                for (int sft = 1; sft < 8; sft <<= 1) { const float mo = __shfl_xor(m, sft); const int jo = __shfl_xor(jb, sft); if (mo > m || (mo == m && jo < jb)) { m = mo; jb = jo; } }
                if (m > -INFINITY) { const unsigned bit = 1u << (jb & 31); const int wsel = jb >> 5;
                    m0 |= (wsel == 0) ? bit : 0u; m1 |= (wsel == 1) ? bit : 0u; m2w |= (wsel == 2) ? bit : 0u; m3 |= (wsel == 3) ? bit : 0u;
#pragma unroll
                    for (int k = 0; k < 16; ++k) if (cc + 8 * k == jb) v[k] = -INFINITY; }
            }
            m0 |= 1u;
#pragma unroll
            for (int z = 0; z < 2; ++z) { const int jf = ci - z; const unsigned bit = 1u << (jf & 31); const int wsel = jf >> 5;
                m0 |= (wsel == 0) ? bit : 0u; m1 |= (wsel == 1) ? bit : 0u; m2w |= (wsel == 2) ? bit : 0u; m3 |= (wsel == 3) ? bit : 0u; }
        }
        if (cc == 0) { selm[qq * 4 + 0] = m0; selm[qq * 4 + 1] = m1; selm[qq * 4 + 2] = m2w; selm[qq * 4 + 3] = m3; }
        asm volatile("s_waitcnt lgkmcnt(0)\n\ts_barrier" ::: "memory");
    }
    const float* gp = P.gates + ((size_t)b * SEQ + qpos) * 24 + hb * 3; float g0 = gp[0], g1 = gp[1], g2 = gp[2];
    asm volatile("" : "+v"(g0), "+v"(g1), "+v"(g2));
    row_factors(c, g0 * invLc, fr);
#pragma unroll
    for (int r = 0; r < 16; ++r) { park[r * 64] = o[0][r] * fr[r]; park1[r * 64] = o[1][r] * fr[r]; }
    {
        const unsigned w0 = selm[ql * 4 + 0], w1 = selm[ql * 4 + 1], w2 = selm[ql * 4 + 2], w3 = selm[ql * 4 + 3];
        o[0] = f32x16{}; o[1] = f32x16{}; l_reg = 0.f;
        auto sel_pred = [&](int t) -> bool { const unsigned wsel = (t < 32) ? w0 : (t < 64) ? w1 : (t < 96) ? w2 : w3; return (wsel >> (t & 31)) & 1u; };
        auto sel_one = [&](int t, lds_cptr kp, lds_cptr vp) { const bool pred = sel_pred(t); if (!__any(pred)) return; const int key0 = 64 * t;
            f32x16 s0, s1; qk_tile(s0, s1, kp, qr);
            if (qw0 - key0 - 63 >= 113) { hook_exp(s0, s1); const float rs = rowsum32(s0, s1); l_reg += pred ? rs : 0.f;
                if (__all(pred)) pv_tile<false>(o, vp, s0, s1, 0u); else pv_tile<true>(o, vp, s0, s1, pred ? 0xffffffffu : 0u); }
            else { hook_near(s0, s1, qpos - key0 - 4 * c.hi, lut); const float rs = rowsum32(s0, s1); l_reg += pred ? rs : 0.f;
                if (__all(pred)) pv_tile<false>(o, vp, s0, s1, 0u); else pv_tile<true>(o, vp, s0, s1, pred ? 0xffffffffu : 0u); } };
        if (!(flags & 4)) run_stream_pairs(c, KS, VS, 0, ci + 1, sel_one,
            [&](int t, lds_cptr kpA, lds_cptr vpA, lds_cptr kpB, lds_cptr vpB) {
                if (qw0 - 64 * (t + 1) - 63 >= 113) {
                    const bool pa = sel_pred(t), pb = sel_pred(t + 1);
                    const bool xa = __any(pa), xb = __any(pb);
                    if (!xa && !xb) return;
                    if (!xb) { sel_one(t, kpA, vpA); return; }
                    if (!xa) { sel_one(t + 1, kpB, vpB); return; }
                    KF kA, kB; ld_k(kA, kpA); ATT_SB();
                    f32x16 a0, a1, b0, b1; qk_mfma(a0, a1, kA, qr); ATT_SB();
                    VF vA, vB; ld_k(kB, kpB); ld_v(vA, vpA); ATT_SB();
                    qk_mfma(b0, b1, kB, qr); hook_exp(a0, a1);
                    const float ra = rowsum32(a0, a1); const PW4 wa = pack4(a0, a1, pa ? 0xffffffffu : 0u); ATT_SB();
                    ld_v(vB, vpB); ATT_SB();
                    pv_mfma(o, vA, wa); hook_exp(b0, b1);
                    const float rb = rowsum32(b0, b1); const PW4 wb = pack4(b0, b1, pb ? 0xffffffffu : 0u); l_reg += (pa ? ra : 0.f) + (pb ? rb : 0.f); ATT_SB();
                    pv_mfma(o, vB, wb);
                } else { sel_one(t, kpA, vpA); sel_one(t + 1, kpB, vpB); } });
        const float Ls = pair_sum(l_reg);
        row_factors(c, g1 / Ls, fr);
#pragma unroll
        for (int r = 0; r < 16; ++r) { park[r * 64] += o[0][r] * fr[r]; park1[r * 64] += o[1][r] * fr[r]; }
    }
    {
        o[0] = f32x16{}; o[1] = f32x16{}; l_reg = 0.f;
        if (!(flags & 8)) run_stream<true>(c, KW, VW, ci >= 8 ? ci - 8 : 0, ci + 1,
            [&](int t, lds_cptr kp, f32x16& s0, f32x16& s1) { qk_tile(s0, s1, kp, qr); },
            [&](int t, lds_cptr vp, f32x16& s0, f32x16& s1) { const int key0 = 64 * t;
                if (qw0 - key0 - 63 < 113) hook_near(s0, s1, qpos - key0 - 4 * c.hi, lut); else if (qw0 + 7 - key0 >= 512) hook_edge(s0, s1, qpos - key0 - 4 * c.hi, 512); else hook_exp(s0, s1);
                l_reg += rowsum32(s0, s1);
                pv_tile<false>(o, vp, s0, s1, 0u); });
        const float Lw = pair_sum(l_reg);
        row_factors(c, g2 / Lw, fr);
#pragma unroll
        for (int r = 0; r < 16; ++r) { o[0][r] = park[r * 64] + o[0][r] * fr[r]; o[1][r] = park1[r * 64] + o[1][r] * fr[r]; }
        asm volatile("s_waitcnt lgkmcnt(0)" ::: "memory");
    }
    bf16* dst = P.mix + ((size_t)b * SEQ + 64 * ci + 8 * c.wid) * DM + 512 + g * 256;
    store_rows(c, o, dst, [](int row) { return (size_t)(row >> 2) * DM + (row & 3) * 64; });
    asm volatile("s_waitcnt lgkmcnt(0)\n\ts_barrier" ::: "memory");
}

__device__ __forceinline__ void attn_phase(LAS unsigned char* lds, const AttnPtrs& P, unsigned* qcounter, int flags) {
    Ctx c = make_ctx(lds, threadIdx.x);
    LAS unsigned* misc = (LAS unsigned*)(c.lds + LDS_MISC);
    { LAS float* lutg = (LAS float*)(c.lds + LDS_LUTG);
      for (int idx = threadIdx.x; idx < 16 * 115; idx += NTHREADS) { const int hh = idx / 115, d = idx % 115;
          lutg[hh * 128 + d] = (d == 0) ? -INFINITY : (P.rel_bias[t5_bucket(d - 1) * 16 + hh] - P.rel_bias[31 * 16 + hh]) * LOG2E; }
      asm volatile("s_waitcnt vmcnt(0) lgkmcnt(0)\n\ts_barrier" ::: "memory"); }
    for (;;) {
        if (threadIdx.x == 0) misc[0] = __hip_atomic_fetch_add(qcounter, 1u, __ATOMIC_RELAXED, __HIP_MEMORY_SCOPE_AGENT);
        asm volatile("s_waitcnt vmcnt(0) lgkmcnt(0)\n\ts_barrier" ::: "memory");
        const unsigned k = misc[0];
        asm volatile("s_waitcnt lgkmcnt(0)\n\ts_barrier" ::: "memory");
        if (k >= 2048u) break;
        const bool is_mp = k >= 512u && k < 1536u;
        if (flags & (is_mp ? 2 : 1)) continue;
        if (k < 512u) { const int s_ = 127 - (int)(k >> 3), bg = k & 7; nsa_item(c, P, bg >> 1, bg & 1, s_, flags); }
        else if (k < 1536u) { const int kk = (int)k - 512, j = kk >> 5, bh = kk & 31; moba_past_item(c, P, bh >> 3, bh & 7, j); }
        else { const int kk = (int)k - 1536; const int s_ = 63 - (kk >> 3), bg = kk & 7; nsa_item(c, P, bg >> 1, bg & 1, s_, flags); }
    }
}
#undef MFMA32
#undef ATT_WAIT_BAR
}
namespace cmpr {
using bf16x8 = __attribute__((ext_vector_type(8))) short;
using f32x16 = __attribute__((ext_vector_type(16))) float;
constexpr int HID_PITCH = 528;
__device__ __forceinline__ float gelu_tanh(float v) { const float u = fminf(fmaxf(0.7978845608028654f * (v + 0.044715f * v * v * v), -15.f), 15.f); const float e = __expf(2.f * u); return 0.5f * v * (1.f + (e - 1.f) / (e + 1.f)); }
__device__ __forceinline__ void compress_unit(LAS unsigned char* lds, int unit, const bf16* qkv, const bf16* w1k, const bf16* w1v, const bf16* w2k, const bf16* w2v, const float* cbp, const float* kncmp, bf16* kcmp, bf16* vcmp) {
    const int tid = threadIdx.x, lane = tid & 63, r32 = lane & 31, hi = lane >> 5; const int wid = __builtin_amdgcn_readfirstlane(tid >> 6);
    const int kv = unit & 1, u = (unit >> 1) & 15, bg = unit >> 5;
    const bf16* src = qkv + 4 * QKV_BIG + (kv ? QKV_SMALL : 0) + (size_t)bg * SEQ * 64;
    const bf16* w1 = kv ? w1v : w1k; const bf16* w2 = kv ? w2v : w2k;
    const int n0 = 32 * u;
    { const bf16* sp = src + (size_t)16 * n0 * 64;
      for (int ch = tid; ch < 4224; ch += NTHREADS) { v4u v = {0u, 0u, 0u, 0u}; if (16 * n0 + (ch >> 3) < SEQ) v = *(const GAS v4u*)(sp + (size_t)ch * 8);
          *(LAS v4u*)(lds + ((ch ^ ((ch >> 7) & 15)) << 4)) = v; } }
    asm volatile("s_waitcnt vmcnt(0) lgkmcnt(0)\n\ts_barrier" ::: "memory");
    const bf16* bp = w1 + ((size_t)wid * 64 + lane) * 8;
    f32x16 acc = {};
#pragma unroll 8
    for (int kk = 0; kk < 128; ++kk) { const int lc = r32 * 128 + 2 * kk + hi; const bf16x8 a = *(const LAS bf16x8*)(lds + ((lc ^ ((lc >> 7) & 15)) << 4)), bfr = *(const bf16x8*)(bp + (size_t)kk * 4096); acc = __builtin_amdgcn_mfma_f32_32x32x16_bf16(a, bfr, acc, 0, 0, 0); }
    float cb = 0.f;
#pragma unroll 8
    for (int ic = 0; ic < 32; ++ic) cb += cbp[(ic * 2 + kv) * 256 + 32 * wid + r32];
    LAS unsigned char* hidL = lds + 69632;
#pragma unroll
    for (int r = 0; r < 16; ++r) { const int n = (r & 3) + 8 * (r >> 2) + 4 * hi; *(LAS bf16*)(hidL + n * HID_PITCH + (32 * wid + r32) * 2) = (bf16)f2bf(gelu_tanh(acc[r] + cb)); }
    asm volatile("s_waitcnt lgkmcnt(0)\n\ts_barrier" ::: "memory");
    if (wid == 0) {
        f32x16 o0 = {}, o1 = {};
#pragma unroll 4
        for (int kk = 0; kk < 16; ++kk) { const bf16x8 hb = *(const LAS bf16x8*)(hidL + r32 * HID_PITCH + (16 * kk + 8 * hi) * 2);
            const bf16x8 a0 = *(const bf16x8*)(w2 + (size_t)r32 * 256 + 16 * kk + 8 * hi), a1 = *(const bf16x8*)(w2 + (size_t)(32 + r32) * 256 + 16 * kk + 8 * hi);
            o0 = __builtin_amdgcn_mfma_f32_32x32x16_bf16(a0, hb, o0, 0, 0, 0); o1 = __builtin_amdgcn_mfma_f32_32x32x16_bf16(a1, hb, o1, 0, 0, 0); }
        float rs = 1.f;
        if (!kv) { float ss = 0.f;
#pragma unroll
            for (int r = 0; r < 16; ++r) ss += o0[r] * o0[r] + o1[r] * o1[r];
            auto rr = __builtin_amdgcn_permlane32_swap(__float_as_uint(ss), __float_as_uint(ss), false, false); ss = __uint_as_float(rr[0]) + __uint_as_float(rr[1]);
            rs = rsqrtf(ss * (1.f / 64.f) + 1e-6f); }
        const int n = n0 + r32; bf16* dst = (kv ? vcmp : kcmp) + ((size_t)bg * 512 + n) * 64;
#pragma unroll
        for (int r = 0; r < 16; ++r) { const int d = (r & 3) + 8 * (r >> 2) + 4 * hi;
            float v0 = o0[r] * rs, v1 = o1[r] * rs; if (!kv) { v0 *= kncmp[d]; v1 *= kncmp[d + 32]; }
            if (n >= NCMP) { v0 = 0.f; v1 = 0.f; }
            dst[d] = (bf16)f2bf(v0); dst[d + 32] = (bf16)f2bf(v1); }
    }
    asm volatile("s_waitcnt lgkmcnt(0)\n\ts_barrier" ::: "memory");
}
}
__global__ void __launch_bounds__(NTHREADS, 2) mk_fwd(Args a) {
    extern __shared__ __attribute__((aligned(16))) unsigned char lds[];
    Frame F;
    F.lds = (LAS unsigned char*)lds;
    F.tid = threadIdx.x; F.lane = F.tid & 63; F.wave = __builtin_amdgcn_readfirstlane(F.tid >> 6);
    F.G = gridDim.x; { const int bx = blockIdx.x; F.vcu = (F.G % 8 == 0) ? (bx % 8) * (F.G / 8) + bx / 8 : bx; }
    cg::grid_group grid = cg::this_grid();
    volatile LAS unsigned* xst = (volatile LAS unsigned*)(F.lds + 147424);
    if (F.tid < 8) xst[F.tid] = 0u;
    __syncthreads();
    const XcdBarrier xbar = xcd_barrier_post((unsigned*)(a.ws + WS_CTL) + 4096, xst);
    unsigned char* ws = a.ws;
    const int lo = a.ph_lo, hi = a.ph_hi;
    const att::AttnPtrs P{(const bf16*)(ws + WS_QKV), (const float*)(ws + WS_KMP), (const float*)(ws + WS_GATES), (const bf16*)(ws + WS_KCMP), (const bf16*)(ws + WS_VCMP), a.in[2], (bf16*)(ws + WS_MIX),
                          (unsigned*)(ws + WS_SELG), (bf16*)(ws + WS_PARTO), (float*)(ws + WS_PARTL)};
#define IN(k) (lo <= (k) && (k) < hi)
#define SEAM(k) do { if (IN(k) && IN((k) + 1)) { if ((k) == 0) grid.sync(); else xcd_barrier(xbar); } } while (0)
    if (IN(0)) { phase_prologue_a(F, a); } SEAM(0);
    if (IN(1)) { phase_prologue_b(F, a); } SEAM(1);
    if (IN(2)) {
        pg8::Gemm g{(const pg8::bf16_t*)(ws + WS_H), (const pg8::bf16_t*)(ws + WS_WIN), TOK, NIN_PAD, DM}; pg8::StaticOrder S; S.init(TOK, NIN_PAD, F.G, (int)blockIdx.x);
        pg8::EpiInProj E{(pg8::bf16_t*)(ws + WS_QKV), (float*)(ws + WS_GATES), (float*)(ws + WS_KMP), a.in[7], a.in[8], a.in[9], a.in[11], a.in[12]};
        pg8::gemm_phase<pg8::EpiInProj, pg8::StaticOrder, true, true>(F.lds, g, S, E);
    } SEAM(2);
    if (IN(3)) {
        att::moba_gate_phase(P, F.vcu, F.G, F.tid);
        for (int unit = F.vcu; unit < 256; unit += F.G)
            cmpr::compress_unit(F.lds, unit, (const bf16*)(ws + WS_QKV), (const bf16*)(ws + WS_W1K), (const bf16*)(ws + WS_W1V), (const bf16*)(ws + WS_W2K), (const bf16*)(ws + WS_W2V),
                                (const float*)(ws + WS_CBP), a.in[10], (bf16*)(ws + WS_KCMP), (bf16*)(ws + WS_VCMP));
    } SEAM(3);
    if (IN(4)) {
                att::attn_phase(F.lds, P, (unsigned*)(ws + WS_CTL) + 64, 0);
    } SEAM(4);
    if (IN(5)) { att::moba_merge_pass(P, F.vcu, F.G, F.tid); } SEAM(5);
    if (IN(6)) {
        pg8::Gemm g{(const pg8::bf16_t*)(ws + WS_MIX), (const pg8::bf16_t*)(ws + WS_WOUT), TOK, DM, DM}; pg8::StaticOrder S; S.init(TOK, DM, F.G, (int)blockIdx.x);
        pg8::EpiOutProj E{a.in[0], a.out, (const float*)(ws + WS_MOD) + 2 * DM};
        pg8::gemm_phase<pg8::EpiOutProj, pg8::StaticOrder, true, true>(F.lds, g, S, E);
    } SEAM(6);
    if (IN(7)) { phase_norm2(F, a); } SEAM(7);
    if (IN(8)) {
        pg8::Gemm g{(const pg8::bf16_t*)(ws + WS_H), (const pg8::bf16_t*)(ws + WS_WGU), TOK, 2 * FF, DM}; pg8::StaticOrder S; S.init(TOK, 2 * FF, F.G, (int)blockIdx.x);
        pg8::EpiGateUp E{(pg8::bf16_t*)(ws + WS_ACT)};
        pg8::gemm_phase<pg8::EpiGateUp, pg8::StaticOrder, true, true>(F.lds, g, S, E);
    } SEAM(8);
    if (IN(9)) {
        pg8::Gemm g{(const pg8::bf16_t*)(ws + WS_ACT), (const pg8::bf16_t*)(ws + WS_WDN), TOK, DM, FF}; pg8::StaticOrder S; S.init(TOK, DM, F.G, (int)blockIdx.x);
        pg8::EpiDown E{a.out, (const float*)(ws + WS_MOD) + 5 * DM};
        pg8::gemm_phase<pg8::EpiDown, pg8::StaticOrder, true, true>(F.lds, g, S, E);
    }
#undef IN
#undef SEAM
}

static void launch_phases(const Args& base, int lo, int hi, int grid, hipStream_t stream, int flags = 0) {
    Args a = base; a.ph_lo = lo; a.ph_hi = hi; (void)flags;
    if (hi - lo > 1) { void* args[] = {&a}; (void)hipLaunchCooperativeKernel((const void*)mk_fwd, dim3(grid), dim3(NTHREADS), args, LDS_BYTES, stream); }
    else hipLaunchKernelGGL(mk_fwd, dim3(grid), dim3(NTHREADS), LDS_BYTES, stream, a);
}
extern "C" void kernel_launch(void* const* d_in, const int* in_sizes, int n_in, void* d_out, int out_size, void* d_ws, size_t ws_size, hipStream_t stream) {
    static int grid = 0;
    if (grid == 0) {
        int dev = 0, cus = 0, per_cu = 0;
        if (n_in != 23 || ws_size < 480 * MiB || hipGetDevice(&dev) != hipSuccess || hipDeviceGetAttribute(&cus, hipDeviceAttributeMultiprocessorCount, dev) != hipSuccess) { grid = -1; return; }
        if (hipFuncSetAttribute((const void*)mk_fwd, hipFuncAttributeMaxDynamicSharedMemorySize, LDS_BYTES) != hipSuccess) { grid = -1; return; }
        if (hipOccupancyMaxActiveBlocksPerMultiprocessor(&per_cu, (const void*)mk_fwd, NTHREADS, LDS_BYTES) != hipSuccess || per_cu < 1) { grid = -1; return; }
        grid = cus;
    }
    if (grid < 0) return;
    (void)hipMemsetAsync((char*)d_ws + WS_CTL, 0, CTL_ZERO_BYTES, stream);
    Args a{};
    for (int i = 0; i < 23; ++i) a.in[i] = (const float*)d_in[i];
    a.out = (float*)d_out; a.ws = (unsigned char*)d_ws;
    unsigned char* ws = (unsigned char*)d_ws;
#if HYBRID == 1
    launch_phases(a, 0, 1, grid, stream); launch_phases(a, 1, 2, grid, stream); launch_phases(a, 2, 3, grid, stream);
    const bf16* qkv = (const bf16*)(ws + WS_QKV); bf16* mix = (bf16*)(ws + WS_MIX); bf16* kcmp = (bf16*)(ws + WS_KCMP); bf16* vcmp = (bf16*)(ws + WS_VCMP);
    int* sel = (int*)(ws + 344 * MiB); float* obuf = (float*)(ws + 348 * MiB); const float* gates = (const float*)(ws + WS_GATES);
    nq::k_compress<<<dim3(4 * 2 * 512, 2), 256, 0, stream>>>(qkv, a.in[13], a.in[14], a.in[15], a.in[16], a.in[17], a.in[18], a.in[10], kcmp, vcmp);
    nq::k_moba<<<4 * 8 * SEQ / 4, 256, 0, stream>>>(qkv, (const float*)(ws + WS_KMP), a.in[2], mix);
    nq::k_nsa_cmp<<<4 * 2 * SEQ, 256, 0, stream>>>(qkv, kcmp, vcmp, gates, obuf, sel);
    nq::k_nsa_sel<<<4 * 2 * SEQ, 256, 0, stream>>>(qkv, sel, a.in[2], gates, obuf);
    nq::k_nsa_win<<<4 * 2 * SEQ, 256, 0, stream>>>(qkv, a.in[2], gates, obuf, mix);
    launch_phases(a, 5, 6, grid, stream); launch_phases(a, 6, 7, grid, stream); launch_phases(a, 7, 8, grid, stream); launch_phases(a, 8, 9, grid, stream);
#elif HYBRID == 2
    launch_phases(a, 0, 1, grid, stream); launch_phases(a, 1, 2, grid, stream); launch_phases(a, 2, 3, grid, stream);
    nq::k_compress<<<dim3(4 * 2 * 512, 2), 256, 0, stream>>>((const bf16*)(ws + WS_QKV), a.in[13], a.in[14], a.in[15], a.in[16], a.in[17], a.in[18], a.in[10], (bf16*)(ws + WS_KCMP), (bf16*)(ws + WS_VCMP));
    launch_phases(a, 4, 5, grid, stream);
    launch_phases(a, 5, 6, grid, stream); launch_phases(a, 6, 7, grid, stream); launch_phases(a, 7, 8, grid, stream); launch_phases(a, 8, 9, grid, stream);
#elif HYBRID == 3
    for (int p = 0; p < N_PHASES; ++p) {
#if defined(TIME_PHASE)
        if (p == TIME_PHASE) { for (int r = 0; r < TIME_REPS; ++r) { launch_phases(a, p, p + 1, grid, stream, TIME_FLAGS); (void)hipMemsetAsync((char*)d_ws + WS_CTL, 0, CTL_ZERO_BYTES, stream); } }
#endif
        launch_phases(a, p, p + 1, grid, stream);
#if defined(ABL_REPS)
        if (p == 3) { static bool once = false; if (!once) { once = true; (void)hipFuncSetAttribute((const void*)k_attn_abl, hipFuncAttributeMaxDynamicSharedMemorySize, LDS_BYTES); }
            for (int r = 0; r < ABL_REPS; ++r) { (void)hipMemsetAsync((char*)d_ws + WS_CTL + 512, 0, 4, stream); hipLaunchKernelGGL(k_attn_abl, dim3(grid), dim3(NTHREADS), LDS_BYTES, stream, a); } }
#endif
    }
#else
    launch_phases(a, 0, N_PHASES, grid, stream);
#endif
}
```

```cpp
#include <hip/hip_runtime.h>
#include <hip/hip_cooperative_groups.h>
#include <cstdint>
#include <cstdio>
namespace cg = cooperative_groups;
#define HYBRID 0
namespace pg8 {
#define PG8_LAS __attribute__((address_space(3)))
typedef unsigned short bf16_t;
typedef short bf16x8 __attribute__((ext_vector_type(8)));
typedef float f32x4 __attribute__((ext_vector_type(4)));
typedef unsigned u32x4 __attribute__((ext_vector_type(4)));
constexpr int BM = 256, BK = 64, HALF = 128, HTB = HALF * BK * 2  , STAGE_BYTES = 8 * HTB, NXCD = 8, WGM = 8;

__host__ __device__ __forceinline__ int lds_byte(int r, int c) { const int st = (r >> 4) * 2 + (c >> 5), rr = r & 15, cc = c & 31, ob = rr * 64 + cc * 2; return st * 1024 + (ob ^ (((ob >> 9) & 1) << 5)); }
__host__ __device__ __forceinline__ void stage_rc(int b, int& R, int& C) { const int st = b / 1024, sb = b % 1024, swz = sb ^ (((sb >> 9) & 1) << 5); R = (st >> 1) * 16 + swz / 64; C = (st & 1) * 32 + (swz % 64) / 2; }
__host__ __device__ __forceinline__ int perm32(int rho) { const int n = rho >> 4, i = rho & 15; return 8 * (i >> 2) + 4 * n + (i & 3); }

struct Unit { int pm, pn; };
struct Gemm { const bf16_t* A; const bf16_t* Bt; int M, N, K; };

struct StaticOrder {
    int nM, nN, nwg, G, c;
    __host__ __device__ void init(int M, int N, int G_, int c_) { nM = M / BM; nN = N / BM; nwg = nM * nN; G = G_; c = c_; }
    __host__ __device__ bool next(int i, Unit& u) const {
        const long L = (long)i * G + c; if (L >= nwg) return false;
        int wgid = (int)L; { const int q = nwg / NXCD, r = nwg % NXCD, xcd = wgid % NXCD, off = wgid / NXCD; wgid = (xcd < r ? xcd * (q + 1) : r * (q + 1) + (xcd - r) * q) + off; }
        const int nig = WGM * nN, gid = wgid / nig, fm = gid * WGM, gsz = (nM - fm) < WGM ? (nM - fm) : WGM;
        u.pm = fm + ((wgid % nig) % gsz); u.pn = (wgid % nig) / gsz; return true;
    }
    __device__ __forceinline__ void a_ready(const Unit&) const {}
    __device__ __forceinline__ void done(const Unit&) const {}
};

__device__ __forceinline__ unsigned cvt_pk_bf16(float lo, float hi) { unsigned r; asm volatile("v_cvt_pk_bf16_f32 %0, %1, %2" : "=v"(r) : "v"(lo), "v"(hi)); return r; }
typedef float f32x2 __attribute__((ext_vector_type(2)));
template <class Epi, class Sched, bool ALIGN_EPI = false, bool SP2 = false>
__device__ __forceinline__ void gemm_phase(PG8_LAS unsigned char* lds, const Gemm g, const Sched& S, const Epi& E) {
    const int tid = threadIdx.x, wid = __builtin_amdgcn_readfirstlane(tid >> 6), lane = tid & 63, wr = wid >> 2, wc = wid & 3, fr = lane & 15, fq = lane >> 4;
    const int K = g.K, nt = K / BK;
    unsigned voffA[2], voffB[2];
#pragma unroll
    for (int i = 0; i < 2; ++i) { int R, C; stage_rc(tid * 16 + i * 8192, R, C); const int Rb = Epi::PERM ? ((R & ~31) + perm32(R & 31)) : R;
        voffA[i] = (unsigned)(R * K + C) * 2u; voffB[i] = (unsigned)(Rb * K + C) * 2u; }
    const size_t kstep = (size_t)(BK * 2);
    const size_t hstep = (size_t)HALF * K * 2;
    const size_t tstep = 2 * hstep;
    const unsigned ldsw = (unsigned)wid * 1024u;
    const int aoff = lds_byte(wr * 64 + fr, fq * 8), boff = lds_byte(wc * 32 + fr, fq * 8);
#define PG8_SA(b, h) (((b) * 2 + (h)) * HTB)
#define PG8_SB(b, h) ((4 + (b) * 2 + (h)) * HTB)
#define PG8_STAGE(bufoff, gbase, voff) do { _Pragma("unroll") for (int _i = 0; _i < 2; ++_i) \
        __builtin_amdgcn_global_load_lds((const unsigned*)((const char*)(gbase) + (voff)[_i]), (PG8_LAS unsigned*)(lds + (bufoff) + ldsw + _i * 8192), 16, 0, 0); } while (0)
#define PG8_LDA(dst, b, h) do { _Pragma("unroll") for (int m = 0; m < 4; ++m) _Pragma("unroll") for (int k = 0; k < 2; ++k) dst[m][k] = *(const PG8_LAS bf16x8*)(lds + PG8_SA(b, h) + aoff + m * 2048 + k * 1024); } while (0)
#define PG8_LDB(dst, b, h) do { _Pragma("unroll") for (int n = 0; n < 2; ++n) _Pragma("unroll") for (int k = 0; k < 2; ++k) dst[n][k] = *(const PG8_LAS bf16x8*)(lds + PG8_SB(b, h) + boff + n * 2048 + k * 1024); } while (0)
#define PG8_MMA(ai, bj, At, Bt) do { __builtin_amdgcn_s_setprio(1); _Pragma("unroll") for (int m = 0; m < 4; ++m) _Pragma("unroll") for (int n = 0; n < 2; ++n) _Pragma("unroll") for (int k = 0; k < 2; ++k) \
        acc[ai][bj][m][n] = __builtin_amdgcn_mfma_f32_16x16x32_bf16(Bt[n][k], At[m][k], acc[ai][bj][m][n], 0, 0, 0); __builtin_amdgcn_s_setprio(0); } while (0)
#define PG8_WAIT_V(n) asm volatile("s_waitcnt vmcnt(" #n ")" ::: "memory")
#define PG8_WAIT_L(n) asm volatile("s_waitcnt lgkmcnt(" #n ")" ::: "memory")
#define PG8_BAR __builtin_amdgcn_s_barrier()
#define PG8_SCHED __builtin_amdgcn_sched_barrier(0)
    Unit cur, nxt; int ui = 0;
    if (!S.next(0, cur)) return;
    f32x4 acc[2][2][4][2];
#pragma unroll
    for (int a = 0; a < 2; ++a)
#pragma unroll
        for (int b = 0; b < 2; ++b)
#pragma unroll
            for (int m = 0; m < 4; ++m)
#pragma unroll
                for (int n = 0; n < 2; ++n) acc[a][b][m][n] = (f32x4){0.f, 0.f, 0.f, 0.f};
    bf16x8 At[4][2], B0[2][2], B1[2][2];
    const char* cA = (const char*)g.A + (size_t)cur.pm * tstep; const char* cB = (const char*)g.Bt + (size_t)cur.pn * tstep;
    S.a_ready(cur);
    if constexpr (SP2) {
        PG8_STAGE(PG8_SB(0, 0), cB, voffB); PG8_STAGE(PG8_SB(0, 1), cB + hstep, voffB); PG8_STAGE(PG8_SA(0, 0), cA, voffA); PG8_STAGE(PG8_SA(0, 1), cA + hstep, voffA);
        if (wr == 1) PG8_BAR;
        PG8_WAIT_V(2); PG8_BAR;
        PG8_STAGE(PG8_SB(1, 0), cB + kstep, voffB); PG8_STAGE(PG8_SA(1, 0), cA + kstep, voffA); PG8_STAGE(PG8_SB(1, 1), cB + hstep + kstep, voffB);
        PG8_WAIT_V(6); PG8_BAR;
    } else {
        PG8_STAGE(PG8_SB(0, 0), cB, voffB); PG8_STAGE(PG8_SA(0, 0), cA, voffA); PG8_STAGE(PG8_SB(0, 1), cB + hstep, voffB); PG8_STAGE(PG8_SA(0, 1), cA + hstep, voffA);
        if (wr == 1) PG8_BAR;
        PG8_WAIT_V(4); PG8_BAR;
        PG8_STAGE(PG8_SB(1, 0), cB + kstep, voffB); PG8_STAGE(PG8_SA(1, 0), cA + kstep, voffA); PG8_STAGE(PG8_SB(1, 1), cB + hstep + kstep, voffB);
        PG8_WAIT_V(6); PG8_BAR;
    }
    for (;;) {
        const bool has_next = S.next(ui + 1, nxt);
        const char* nA = has_next ? (const char*)g.A + (size_t)nxt.pm * tstep : cA; const char* nB = has_next ? (const char*)g.Bt + (size_t)nxt.pn * tstep : cB;
        for (int t = 0; t < nt; t += 2) {
            const bool last = (t == nt - 2);
            const char* a1 = cA + (size_t)(t + 1) * kstep;
            const char* a2 = last ? nA : cA + (size_t)(t + 2) * kstep; const char* b2 = last ? nB : cB + (size_t)(t + 2) * kstep;
            const char* a3 = a2 + kstep; const char* b3 = b2 + kstep;
            if (last && has_next) S.a_ready(nxt);
            if constexpr (SP2) {
            PG8_LDB(B0, 0, 0); PG8_LDB(B1, 0, 1); PG8_SCHED; PG8_LDA(At, 0, 0); PG8_STAGE(PG8_SA(1, 1), a1 + hstep, voffA);
            PG8_WAIT_V(8); PG8_WAIT_L(0); PG8_BAR; PG8_MMA(0, 0, At, B0); PG8_MMA(0, 1, At, B1); PG8_BAR; PG8_SCHED;
            PG8_LDA(At, 0, 1); PG8_STAGE(PG8_SB(0, 0), b2, voffB); PG8_STAGE(PG8_SB(0, 1), b2 + hstep, voffB); PG8_STAGE(PG8_SA(0, 0), a2, voffA);
            PG8_WAIT_V(8); PG8_WAIT_L(0); PG8_BAR; PG8_MMA(1, 0, At, B0); PG8_MMA(1, 1, At, B1); PG8_BAR; PG8_SCHED;
            PG8_LDB(B0, 1, 0); PG8_LDB(B1, 1, 1); PG8_SCHED; PG8_LDA(At, 1, 0); PG8_STAGE(PG8_SA(0, 1), a2 + hstep, voffA);
            PG8_WAIT_V(8); PG8_WAIT_L(0); PG8_BAR; PG8_MMA(0, 0, At, B0); PG8_MMA(0, 1, At, B1); PG8_BAR; PG8_SCHED;
            PG8_LDA(At, 1, 1); PG8_STAGE(PG8_SB(1, 0), b3, voffB); PG8_STAGE(PG8_SB(1, 1), b3 + hstep, voffB); PG8_STAGE(PG8_SA(1, 0), a3, voffA);
            PG8_WAIT_V(8); PG8_WAIT_L(0); PG8_BAR; PG8_MMA(1, 0, At, B0); PG8_MMA(1, 1, At, B1); PG8_BAR; PG8_SCHED;
            } else {
            PG8_LDB(B0, 0, 0); PG8_SCHED; PG8_LDA(At, 0, 0); PG8_STAGE(PG8_SA(1, 1), a1 + hstep, voffA);
            PG8_WAIT_L(8); PG8_BAR; PG8_WAIT_L(0); PG8_MMA(0, 0, At, B0); PG8_BAR; PG8_SCHED;
            PG8_LDB(B1, 0, 1); PG8_STAGE(PG8_SB(0, 0), b2, voffB);
            PG8_BAR; PG8_WAIT_L(0); PG8_MMA(0, 1, At, B1); PG8_BAR;
            PG8_LDA(At, 0, 1); PG8_STAGE(PG8_SA(0, 0), a2, voffA);
            PG8_BAR; PG8_WAIT_L(0); PG8_MMA(1, 0, At, B0); PG8_BAR; PG8_SCHED;
            PG8_STAGE(PG8_SB(0, 1), b2 + hstep, voffB);
            PG8_WAIT_V(6); PG8_BAR; PG8_MMA(1, 1, At, B1); PG8_BAR;
            PG8_LDB(B0, 1, 0); PG8_SCHED; PG8_LDA(At, 1, 0); PG8_STAGE(PG8_SA(0, 1), a2 + hstep, voffA);
            PG8_WAIT_L(8); PG8_BAR; PG8_WAIT_L(0); PG8_MMA(0, 0, At, B0); PG8_BAR; PG8_SCHED;
            PG8_LDB(B1, 1, 1); PG8_STAGE(PG8_SB(1, 0), b3, voffB);
            PG8_BAR; PG8_WAIT_L(0); PG8_MMA(0, 1, At, B1); PG8_BAR;
            PG8_LDA(At, 1, 1); PG8_STAGE(PG8_SA(1, 0), a3, voffA);
            PG8_BAR; PG8_WAIT_L(0); PG8_MMA(1, 0, At, B0); PG8_BAR; PG8_SCHED;
            PG8_STAGE(PG8_SB(1, 1), b3 + hstep, voffB);
            PG8_WAIT_V(6); PG8_BAR; PG8_MMA(1, 1, At, B1); PG8_BAR;
            }
        }
        if constexpr (ALIGN_EPI) { if (wr == 0) PG8_BAR; }
        if constexpr (!Epi::AFTER_DRAIN) { E(acc, cur, wr, wc, fr, fq); S.done(cur); }
        if (!has_next) break;
#pragma unroll
        for (int a = 0; a < 2; ++a)
#pragma unroll
            for (int b = 0; b < 2; ++b)
#pragma unroll
                for (int m = 0; m < 4; ++m)
#pragma unroll
                    for (int n = 0; n < 2; ++n) acc[a][b][m][n] = (f32x4){0.f, 0.f, 0.f, 0.f};
        cur = nxt; cA = nA; cB = nB; ++ui;
        if constexpr (ALIGN_EPI) { if (wr == 1) PG8_BAR; }
    }
    PG8_WAIT_V(0);
    if constexpr (!ALIGN_EPI) { if (wr == 0) PG8_BAR; }
    PG8_BAR;
    if constexpr (Epi::AFTER_DRAIN) { E.fused(acc, cur, wr, wc, fr, fq, lds, wid, lane); S.done(cur); }
#undef PG8_SA
#undef PG8_SB
#undef PG8_STAGE
#undef PG8_LDA
#undef PG8_LDB
#undef PG8_MMA
#undef PG8_WAIT_V
#undef PG8_WAIT_L
#undef PG8_BAR
#undef PG8_SCHED
}
}
namespace pg8 {
typedef unsigned u32x2v __attribute__((ext_vector_type(2)));
constexpr int TOK_S = 8192;
constexpr float QK_EPS = 1e-6f;
constexpr float C2 = 0.125f * 1.4426950408889634f;
__device__ __forceinline__ float sigmoid_fast(float v) { return __builtin_amdgcn_rcpf(1.f + __builtin_amdgcn_exp2f(-1.4426950408889634f * v)); }
__device__ __forceinline__ float silu_fast(float v) { return v * __builtin_amdgcn_rcpf(1.f + __builtin_amdgcn_exp2f(-1.4426950408889634f * v)); }

struct EpiInProj {
    static constexpr bool PERM = true, AFTER_DRAIN = false;
    bf16_t* qkv;
    float* gates;
    float* kmean_part;
    const float *qna, *kna, *qnb, *knsel, *knwin;
    __device__ __forceinline__ void operator()(const f32x4 (&acc)[2][2][4][2], const Unit& u, int wr, int wc, int fr, int fq) const {
        const int slot = u.pn * 4 + wc;
        if (slot > 44) return;
        const int b = u.pm >> 5, blk = u.pm & 31, pos0 = blk * 256 + wr * 64 + fr;
        if (slot == 44) {
            if (fq < 3) {
#pragma unroll
                for (int ai = 0; ai < 2; ++ai)
#pragma unroll
                    for (int m = 0; m < 4; ++m) { const size_t tok = (size_t)b * TOK_S + pos0 + ai * HALF + m * 16; float* gp = gates + tok * 24 + 8 * fq;
                        const f32x4 v0 = acc[ai][0][m][0], v1 = acc[ai][0][m][1];
                        *(f32x4*)gp = (f32x4){sigmoid_fast(v0[0]), sigmoid_fast(v0[1]), sigmoid_fast(v0[2]), sigmoid_fast(v0[3])};
                        *(f32x4*)(gp + 4) = (f32x4){sigmoid_fast(v1[0]), sigmoid_fast(v1[1]), sigmoid_fast(v1[2]), sigmoid_fast(v1[3])}; }
            }
            return;
        }
        const float* gain = nullptr; float qscale = 1.f; bool is_ka = false; bf16_t* dst;
        constexpr size_t BIG = (size_t)4 * 8 * TOK_S * 64, SMALL = (size_t)4 * 2 * TOK_S * 64;
        if (slot < 32) { const int kind = slot >> 3, head = slot & 7; dst = qkv + kind * BIG + ((size_t)(b * 8 + head) * TOK_S) * 64;
            if (kind == 0) { gain = qna; qscale = C2; } else if (kind == 1) { gain = kna; is_ka = true; } else if (kind == 3) { gain = qnb; qscale = C2; } }
        else { const int kind = (slot - 32) >> 1, g = slot & 1; dst = qkv + 4 * BIG + kind * SMALL + ((size_t)(b * 2 + g) * TOK_S) * 64;
            if (kind == 2) gain = knsel; else if (kind == 4) gain = knwin; }
        float gv[16];
#pragma unroll
        for (int i = 0; i < 16; ++i) gv[i] = gain ? gain[(i >> 3) * 32 + 8 * fq + (i & 7)] * qscale : 1.f;
        float cs[16];
#pragma unroll
        for (int i = 0; i < 16; ++i) cs[i] = 0.f;
#pragma unroll
        for (int ai = 0; ai < 2; ++ai)
#pragma unroll
            for (int m = 0; m < 4; ++m) {
                float v[16];
#pragma unroll
                for (int bj = 0; bj < 2; ++bj)
#pragma unroll
                    for (int n = 0; n < 2; ++n)
#pragma unroll
                        for (int j = 0; j < 4; ++j) v[bj * 8 + n * 4 + j] = acc[ai][bj][m][n][j];
                if (gain) { float ss = 0.f;
#pragma unroll
                    for (int i = 0; i < 16; ++i) ss += v[i] * v[i];
                    ss += __shfl_xor(ss, 16); ss += __shfl_xor(ss, 32);
                    const float rs = rsqrtf(ss * (1.f / 64.f) + QK_EPS);
#pragma unroll
                    for (int i = 0; i < 16; ++i) v[i] *= rs * gv[i]; }
                if (is_ka) {
#pragma unroll
                    for (int i = 0; i < 16; ++i) cs[i] += v[i]; }
                bf16_t* rp = dst + (size_t)(pos0 + ai * HALF + m * 16) * 64 + 8 * fq;
                u32x4 w0, w1;
                w0.x = cvt_pk_bf16(v[0], v[1]); w0.y = cvt_pk_bf16(v[2], v[3]); w0.z = cvt_pk_bf16(v[4], v[5]); w0.w = cvt_pk_bf16(v[6], v[7]);
                w1.x = cvt_pk_bf16(v[8], v[9]); w1.y = cvt_pk_bf16(v[10], v[11]); w1.z = cvt_pk_bf16(v[12], v[13]); w1.w = cvt_pk_bf16(v[14], v[15]);
                *(u32x4*)rp = w0; *(u32x4*)(rp + 32) = w1;
            }
        if (is_ka) {
#pragma unroll
            for (int i = 0; i < 16; ++i) { float s = cs[i]; s += __shfl_xor(s, 1); s += __shfl_xor(s, 2); s += __shfl_xor(s, 4); s += __shfl_xor(s, 8); cs[i] = s; }
            if (fr == 0) { float* kp = kmean_part + ((size_t)((b * 8 + (slot & 7)) * 32 + blk) * 2 + wr) * 64 + 8 * fq;
                *(f32x4*)kp = (f32x4){cs[0], cs[1], cs[2], cs[3]}; *(f32x4*)(kp + 4) = (f32x4){cs[4], cs[5], cs[6], cs[7]};
                *(f32x4*)(kp + 32) = (f32x4){cs[8], cs[9], cs[10], cs[11]}; *(f32x4*)(kp + 36) = (f32x4){cs[12], cs[13], cs[14], cs[15]}; }
        }
    }
};
struct EpiOutProj {
    static constexpr bool PERM = true, AFTER_DRAIN = false;
    const float* x; float* out; const float* gt;
    __device__ __forceinline__ void operator()(const f32x4 (&acc)[2][2][4][2], const Unit& u, int wr, int wc, int fr, int fq) const {
        const int b = u.pm >> 5; const int col0 = u.pn * BM + wc * 32 + 8 * fq; const float* gtb = gt + (size_t)b * 6144;
#pragma unroll
        for (int bj = 0; bj < 2; ++bj) { const int c = col0 + bj * HALF; const f32x4 g40 = *(const f32x4*)(gtb + c), g41 = *(const f32x4*)(gtb + c + 4);
#pragma unroll
            for (int ai = 0; ai < 2; ++ai)
#pragma unroll
                for (int m = 0; m < 4; ++m) { const size_t off = (size_t)(u.pm * BM + ai * HALF + wr * 64 + m * 16 + fr) * 1024 + c;
                    const f32x4 x0 = *(const f32x4*)(x + off), x1 = *(const f32x4*)(x + off + 4);
                    *(f32x4*)(out + off) = x0 + g40 * acc[ai][bj][m][0]; *(f32x4*)(out + off + 4) = x1 + g41 * acc[ai][bj][m][1]; } }
    }
};
struct EpiGateUp {
    static constexpr bool PERM = true, AFTER_DRAIN = false;
    bf16_t* act;
    __device__ __forceinline__ void operator()(const f32x4 (&acc)[2][2][4][2], const Unit& u, int wr, int wc, int fr, int fq) const {
        const int h0 = u.pn * 128 + wc * 32 + 8 * fq;
#pragma unroll
        for (int ai = 0; ai < 2; ++ai)
#pragma unroll
            for (int m = 0; m < 4; ++m) { const size_t row = (size_t)(u.pm * BM + ai * HALF + wr * 64 + m * 16 + fr);
                const f32x4 g0 = acc[ai][0][m][0], g1 = acc[ai][0][m][1], u0 = acc[ai][1][m][0], u1 = acc[ai][1][m][1];
                u32x4 w;
                w.x = cvt_pk_bf16(silu_fast(g0[0]) * u0[0], silu_fast(g0[1]) * u0[1]); w.y = cvt_pk_bf16(silu_fast(g0[2]) * u0[2], silu_fast(g0[3]) * u0[3]);
                w.z = cvt_pk_bf16(silu_fast(g1[0]) * u1[0], silu_fast(g1[1]) * u1[1]); w.w = cvt_pk_bf16(silu_fast(g1[2]) * u1[2], silu_fast(g1[3]) * u1[3]);
                *(u32x4*)(act + row * 2816 + h0) = w; }
    }
};
struct EpiDown {
    static constexpr bool PERM = true, AFTER_DRAIN = false;
    float* out; const float* gt;
    __device__ __forceinline__ void operator()(const f32x4 (&acc)[2][2][4][2], const Unit& u, int wr, int wc, int fr, int fq) const {
        const int b = u.pm >> 5; const int col0 = u.pn * BM + wc * 32 + 8 * fq; const float* gtb = gt + (size_t)b * 6144;
#pragma unroll
        for (int bj = 0; bj < 2; ++bj) { const int c = col0 + bj * HALF; const f32x4 g40 = *(const f32x4*)(gtb + c), g41 = *(const f32x4*)(gtb + c + 4);
#pragma unroll
            for (int ai = 0; ai < 2; ++ai)
#pragma unroll
                for (int m = 0; m < 4; ++m) { const size_t off = (size_t)(u.pm * BM + ai * HALF + wr * 64 + m * 16 + fr) * 1024 + c;
                    const f32x4 x0 = *(const f32x4*)(out + off), x1 = *(const f32x4*)(out + off + 4);
                    *(f32x4*)(out + off) = x0 + g40 * acc[ai][bj][m][0]; *(f32x4*)(out + off + 4) = x1 + g41 * acc[ai][bj][m][1]; } }
    }
};
}
constexpr int NWAVES = 8, NTHREADS = 512;
constexpr int BATCH = 4, SEQ = 8192, DM = 1024, TOK = BATCH * SEQ, NIN = 2840, NIN_PAD = 3072, FF = 2816, NCMP = 511;
constexpr size_t MiB = 1u << 20;
constexpr size_t WS_CTL = 0, CTL_ZERO_BYTES = 64 * 1024;
constexpr size_t WS_MODP = 1 * MiB;
constexpr size_t WS_MOD = 2 * MiB;
constexpr size_t WS_CBP = 2 * MiB + 512 * 1024;
constexpr size_t WS_KMP = 3 * MiB;
constexpr size_t WS_BIAS2 = 4 * MiB;
constexpr size_t WS_SSP = 449 * MiB;
constexpr size_t WS_WIN = 6 * MiB, WS_WOUT = 12 * MiB, WS_WGU = 14 * MiB, WS_WDN = 25 * MiB;
constexpr size_t WS_W1K = 31 * MiB, WS_W1V = 32 * MiB, WS_W2K = 33 * MiB, WS_W2V = 33 * MiB + 64 * 1024;
constexpr size_t WS_KCMP = 34 * MiB, WS_VCMP = 35 * MiB;
constexpr size_t WS_GATES = 36 * MiB;
constexpr size_t WS_H = 40 * MiB;
constexpr size_t WS_MIX = 104 * MiB;
constexpr size_t WS_QKV = 168 * MiB;
constexpr size_t WS_ACT = WS_QKV;
constexpr size_t WS_END = 344 * MiB;
constexpr size_t WS_PARTO = 344 * MiB;
constexpr size_t WS_PARTL = 472 * MiB;
constexpr size_t WS_SELG = 476 * MiB;
constexpr size_t QKV_BIG = (size_t)4 * 8 * SEQ * 64, QKV_SMALL = (size_t)4 * 2 * SEQ * 64;
constexpr int RING_BYTES = 131072, LDS_BYTES = 147456;
constexpr int N_PHASES = 10;

#define GAS __attribute__((address_space(1)))
#define LAS __attribute__((address_space(3)))
typedef unsigned short bf16;
typedef unsigned v4u __attribute__((ext_vector_type(4)));
typedef float f32x4 __attribute__((ext_vector_type(4)));
#define LDS_WAIT() asm volatile("s_waitcnt lgkmcnt(0)" ::: "memory")
#define VM_WAIT() asm volatile("s_waitcnt vmcnt(0)" ::: "memory")
__device__ __forceinline__ unsigned f2bf(float f) { unsigned u = __builtin_bit_cast(unsigned, f); return (u + 0x7fffu + ((u >> 16) & 1u)) >> 16; }
__device__ __forceinline__ unsigned pk2(float lo, float hi) { return f2bf(lo) | (f2bf(hi) << 16); }
__device__ __forceinline__ float bf2f(bf16 v) { return __builtin_bit_cast(float, (unsigned)v << 16); }
__device__ __forceinline__ float wave_sum(float v) {
#pragma unroll
    for (int o = 1; o < 64; o <<= 1) v += __shfl_xor(v, o);
    return v;
}
struct Args { const float* in[23]; float* out; unsigned char* ws; int ph_lo, ph_hi; };
struct Frame { LAS unsigned char* lds; int tid, lane, wave, vcu, G; };

struct MapId { __device__ __forceinline__ size_t off(int n, int k, int K) const { return (size_t)n * K + k; } };
struct MapWin { __device__ __forceinline__ size_t off(int n, int k, int K) const { const int s = n >> 6, d = n & 63; return (size_t)(256 * (s >> 2) + 128 * (d >> 5) + 32 * (s & 3) + (d & 31)) * K + k; } };
struct MapWgu { __device__ __forceinline__ size_t off(int n, int k, int K) const { const int up = n >= FF, hdn = up ? n - FF : n; return (size_t)(256 * (hdn >> 7) + 128 * up + (hdn & 127)) * K + k; } };
struct MapFrag { __device__ __forceinline__ size_t off(int n, int k, int K) const { return ((size_t)((k >> 4) * 8 + (n >> 5)) * 64 + ((k >> 3) & 1) * 32 + (n & 31)) * 8 + (k & 7); } };
template <class Map>
__device__ __forceinline__ void transpose_item(const float* __restrict__ W, int K, int N, bf16* WT, LAS float* scr, int item, int lane, const Map& map) {
    const int nblk = (N + 63) / 64, kb = item / nblk, nb = item % nblk, k0 = 64 * kb, n0 = 64 * nb;
    const int nc = n0 + 4 * (lane & 15); const bool nin = nc < N;
    f32x4 v[16];
#pragma unroll
    for (int i = 0; i < 16; ++i) { const int kk = 4 * i + (lane >> 4); v[i] = nin ? *(const GAS f32x4*)(W + (size_t)(k0 + kk) * N + nc) : (f32x4){0.f, 0.f, 0.f, 0.f}; }
#pragma unroll
    for (int i = 0; i < 16; ++i) { const int kk = 4 * i + (lane >> 4); LAS float* d = scr + (4 * (lane & 15)) * 68 + kk; d[0] = v[i][0]; d[68] = v[i][1]; d[136] = v[i][2]; d[204] = v[i][3]; }
    LDS_WAIT(); asm volatile("" ::: "memory");
    const int c = lane & 7;
#pragma unroll
    for (int j = 0; j < 8; ++j) { const int n = (lane >> 3) + 8 * j; const LAS float* s = scr + n * 68 + 8 * c;
        const f32x4 a = *(const LAS f32x4*)s, bq = *(const LAS f32x4*)(s + 4);
        v4u o; o.x = pk2(a[0], a[1]); o.y = pk2(a[2], a[3]); o.z = pk2(bq[0], bq[1]); o.w = pk2(bq[2], bq[3]);
        if (n0 + n < N) *(GAS v4u*)(WT + map.off(n0 + n, k0 + 8 * c, K)) = o; }
    LDS_WAIT(); asm volatile("" ::: "memory");
}
__device__ __forceinline__ float silu_acc(float v) { return v / (1.f + expf(-v)); }
__device__ __forceinline__ void phase_prologue_a(Frame& F, const Args& a) {
    LAS float* scr = (LAS float*)(F.lds + F.wave * 17408);
    const int gw = F.vcu * NWAVES + F.wave, NGW = F.G * NWAVES;
    unsigned char* ws = a.ws;
    constexpr int I_IN = (DM / 64) * ((NIN + 63) / 64), I_OUT = (DM / 64) * (DM / 64), I_GU = (DM / 64) * (2 * FF / 64), I_DN = (FF / 64) * (DM / 64), I_W1 = (2048 / 64) * (256 / 64), I_W2 = (256 / 64) * (64 / 64);
    constexpr int NITEMS = I_IN + I_OUT + I_GU + I_DN + 2 * I_W1 + 2 * I_W2;
    for (int it = gw; it < NITEMS; it += NGW) {
        int r = it;
        if (r < I_IN) { transpose_item(a.in[6], DM, NIN, (bf16*)(ws + WS_WIN), scr, r, F.lane, MapWin()); continue; } r -= I_IN;
        if (r < I_OUT) { transpose_item(a.in[19], DM, DM, (bf16*)(ws + WS_WOUT), scr, r, F.lane, MapId()); continue; } r -= I_OUT;
        if (r < I_GU) { transpose_item(a.in[21], DM, 2 * FF, (bf16*)(ws + WS_WGU), scr, r, F.lane, MapWgu()); continue; } r -= I_GU;
        if (r < I_DN) { transpose_item(a.in[22], FF, DM, (bf16*)(ws + WS_WDN), scr, r, F.lane, MapId()); continue; } r -= I_DN;
        if (r < I_W1) { transpose_item(a.in[14], 2048, 256, (bf16*)(ws + WS_W1K), scr, r, F.lane, MapFrag()); continue; } r -= I_W1;
        if (r < I_W1) { transpose_item(a.in[17], 2048, 256, (bf16*)(ws + WS_W1V), scr, r, F.lane, MapFrag()); continue; } r -= I_W1;
        if (r < I_W2) { transpose_item(a.in[15], 256, 64, (bf16*)(ws + WS_W2K), scr, r, F.lane, MapId()); continue; } r -= I_W2;
        transpose_item(a.in[18], 256, 64, (bf16*)(ws + WS_W2V), scr, r, F.lane, MapId());
    }
    const float* c = a.in[1]; const float* w_ada = a.in[3]; float* modp = (float*)(ws + WS_MODP);
    for (int t = NGW - 1 - gw; t < 96 * 8; t += NGW) { const int cg_ = t % 96, ks = t / 96; const int n = cg_ * 64 + F.lane;
        float acc0 = 0.f, acc1 = 0.f, acc2 = 0.f, acc3 = 0.f;
#pragma unroll
        for (int i = 0; i < 8; ++i) { const int idx = F.lane + 64 * i, bb = idx >> 7, kk = idx & 127; scr[kk * 4 + bb] = silu_acc(c[bb * DM + ks * 128 + kk]); }
        LDS_WAIT(); asm volatile("" ::: "memory");
#pragma unroll 8
        for (int k = 0; k < 128; ++k) { const float w = w_ada[(size_t)(ks * 128 + k) * 6144 + n]; const f32x4 sv = *(const LAS f32x4*)(scr + 4 * k);
            acc0 += sv[0] * w; acc1 += sv[1] * w; acc2 += sv[2] * w; acc3 += sv[3] * w; }
        LDS_WAIT(); asm volatile("" ::: "memory");
        float* o = modp + (size_t)ks * 4 * 6144 + n; o[0] = acc0; o[6144] = acc1; o[2 * 6144] = acc2; o[3 * 6144] = acc3; }
    float* cbp = (float*)(ws + WS_CBP);
    for (int t = NGW / 2 - 1 - gw; t >= 0 && t < 256; t += NGW) { const int kv = t & 1, cg_ = (t >> 1) & 3, ic = t >> 3; const int n = cg_ * 64 + F.lane;
        const float* pe = kv ? a.in[16] : a.in[13]; const float* w1 = kv ? a.in[17] : a.in[14]; float acc = 0.f;
#pragma unroll 8
        for (int i = ic * 64; i < ic * 64 + 64; ++i) acc += pe[i] * w1[(size_t)i * 256 + n];
        cbp[(ic * 2 + kv) * 256 + n] = acc; }
}
__device__ __forceinline__ void norm_rows(Frame& F, int blk, const float* in, const f32x4 (&gs)[4], const f32x4 (&sh)[4], bf16* out) {
    for (int i0 = 0; i0 < 16; i0 += 4) {
        f32x4 v[4][4]; float ss[4];
#pragma unroll
        for (int r = 0; r < 4; ++r) { const int row = blk * 128 + F.wave * 16 + i0 + r; const GAS f32x4* xr = (const GAS f32x4*)(in + (size_t)row * DM) + F.lane;
#pragma unroll
            for (int j = 0; j < 4; ++j) v[r][j] = xr[64 * j]; }
#pragma unroll
        for (int r = 0; r < 4; ++r) { float s = 0.f;
#pragma unroll
            for (int j = 0; j < 4; ++j) s += (v[r][j].x * v[r][j].x + v[r][j].y * v[r][j].y) + (v[r][j].z * v[r][j].z + v[r][j].w * v[r][j].w);
            ss[r] = s; }
#pragma unroll
        for (int o_ = 1; o_ < 64; o_ <<= 1) {
#pragma unroll
            for (int r = 0; r < 4; ++r) ss[r] += __shfl_xor(ss[r], o_); }
#pragma unroll
        for (int r = 0; r < 4; ++r) { const int row = blk * 128 + F.wave * 16 + i0 + r; const float rs = rsqrtf(ss[r] * (1.f / DM) + 1e-6f);
            GAS unsigned long long* o8 = (GAS unsigned long long*)(out + (size_t)row * DM) + F.lane;
#pragma unroll
            for (int j = 0; j < 4; ++j) { const f32x4 y = v[r][j] * rs * gs[j] + sh[j]; o8[64 * j] = (unsigned long long)pk2(y.x, y.y) | ((unsigned long long)pk2(y.z, y.w) << 32); } }
    }
}
__device__ __forceinline__ void phase_prologue_b(Frame& F, const Args& a) {
    unsigned char* ws = a.ws; const float* modp = (const float*)(ws + WS_MODP); const float* b_ada = a.in[4];
    if (F.wave == 0) for (int cgp = F.vcu; cgp < 96; cgp += F.G) { const int n = cgp * 64 + F.lane; float* mod = (float*)(ws + WS_MOD);
        for (int b = 0; b < 4; ++b) { float s = 0.f;
#pragma unroll
            for (int ks = 0; ks < 8; ++ks) s += modp[((size_t)ks * 4 + b) * 6144 + n];
            mod[b * 6144 + n] = s + b_ada[n]; } }
    const float* g = a.in[5];
    for (int blk = F.vcu; blk < TOK / 128; blk += F.G) { const int b = blk >> 6;
    f32x4 gs[4], sh[4];
#pragma unroll
    for (int j = 0; j < 4; ++j) { const int c0 = 4 * F.lane + 256 * j; f32x4 s0 = {0.f, 0.f, 0.f, 0.f}, s1 = {0.f, 0.f, 0.f, 0.f};
#pragma unroll
        for (int ks = 0; ks < 8; ++ks) { s0 += *(const f32x4*)(modp + ((size_t)ks * 4 + b) * 6144 + c0); s1 += *(const f32x4*)(modp + ((size_t)ks * 4 + b) * 6144 + DM + c0); }
        s0 += *(const f32x4*)(b_ada + c0); s1 += *(const f32x4*)(b_ada + DM + c0);
        sh[j] = s0; gs[j] = *(const f32x4*)(g + c0) * (s1 + 1.0f); }
    norm_rows(F, blk, a.in[0], gs, sh, (bf16*)(ws + WS_H)); }
}
__device__ __forceinline__ void phase_norm2(Frame& F, const Args& a) {
    unsigned char* ws = a.ws; const float* g = a.in[20];
    for (int blk = F.vcu; blk < TOK / 128; blk += F.G) { const int b = blk >> 6; const float* mod = (const float*)(ws + WS_MOD) + (size_t)b * 6144;
        f32x4 gs[4], sh[4];
#pragma unroll
        for (int j = 0; j < 4; ++j) { const int c0 = 4 * F.lane + 256 * j; sh[j] = *(const f32x4*)(mod + 3 * DM + c0); gs[j] = *(const f32x4*)(g + c0) * (*(const f32x4*)(mod + 4 * DM + c0) + 1.0f); }
        norm_rows(F, blk, a.out, gs, sh, (bf16*)(ws + WS_H)); }
}

__device__ __forceinline__ void phase_bias2(Frame& F, const Args& a) {
    unsigned char* ws = a.ws; const float* mod = (const float*)(ws + WS_MOD); const bf16* wt = (const bf16*)(ws + WS_WGU); float* bias2 = (float*)(ws + WS_BIAS2);
    const int gw = F.vcu * NWAVES + F.wave, NGW = F.G * NWAVES;
    f32x4 sh[4][4];
#pragma unroll
    for (int bb = 0; bb < 4; ++bb)
#pragma unroll
        for (int j = 0; j < 4; ++j) sh[bb][j] = *(const f32x4*)(mod + (size_t)bb * 6144 + 3 * DM + 16 * F.lane + 4 * j);
    for (int c = gw; c < 2 * FF; c += NGW) {
        const v4u w0 = *(const GAS v4u*)(wt + (size_t)c * DM + 16 * F.lane), w1 = *(const GAS v4u*)(wt + (size_t)c * DM + 16 * F.lane + 8);
        const unsigned wu[8] = {w0.x, w0.y, w0.z, w0.w, w1.x, w1.y, w1.z, w1.w};
        float s[4] = {0.f, 0.f, 0.f, 0.f};
#pragma unroll
        for (int j = 0; j < 4; ++j) { const float e0 = __builtin_bit_cast(float, wu[2 * j] << 16), e1 = __builtin_bit_cast(float, wu[2 * j] & 0xffff0000u), e2 = __builtin_bit_cast(float, wu[2 * j + 1] << 16), e3 = __builtin_bit_cast(float, wu[2 * j + 1] & 0xffff0000u);
#pragma unroll
            for (int bb = 0; bb < 4; ++bb) s[bb] += (sh[bb][j][0] * e0 + sh[bb][j][1] * e1) + (sh[bb][j][2] * e2 + sh[bb][j][3] * e3); }
#pragma unroll
        for (int bb = 0; bb < 4; ++bb) { const float t = wave_sum(s[bb]); if (F.lane == 0) bias2[(size_t)bb * 2 * FF + c] = t; }
    }
}
#define XB_TMO      128
#define XB_XCNT(j)  (256  + 64 * (j))
#define XB_XSUB(j)  (1280 + 64 * (j))
#define XB_XGEN(j)  (2304 + 64 * (j))
#define XB_TOP      3328
#define XB_TOPGEN   3392
#define XCD_BAR_WORDS 3456
#define XB_SPIN_CAP (1u << 18)

__device__ __forceinline__ unsigned xb_ld(unsigned* p)              { return __hip_atomic_load(p, __ATOMIC_RELAXED, __HIP_MEMORY_SCOPE_AGENT); }
__device__ __forceinline__ unsigned xb_add(unsigned* p, unsigned v) { return __hip_atomic_fetch_add(p, v, __ATOMIC_RELAXED, __HIP_MEMORY_SCOPE_AGENT); }
__device__ __forceinline__ unsigned xb_xcc_id() { return (unsigned)__builtin_amdgcn_s_getreg((3 << 11) | 20) & 0xFu; }
#define XB_SPIN(cond, bar) do { unsigned _sp = 0; while (cond) { __builtin_amdgcn_s_sleep(1); \
    if ((++_sp & 255u) == 0u) { if (xb_ld(&(bar)[XB_TMO])) break; if (_sp > XB_SPIN_CAP) { atomicAdd(&(bar)[XB_TMO], 1u); break; } } } } while (0)

struct XcdBarrier {
    unsigned* bar; unsigned x;
    volatile LAS unsigned* st;
};

__device__ __forceinline__ XcdBarrier xcd_barrier_post(unsigned* bar, volatile LAS unsigned* st) {
    XcdBarrier b; b.bar = bar; b.x = xb_xcc_id(); b.st = st;
    if (threadIdx.x == 0) (void)xb_add(&bar[XB_XCNT(b.x)], 1u);
    return b;
}
__device__ __forceinline__ void xcd_barrier_complete(unsigned* bar, unsigned x, unsigned& nloc, unsigned& nx) {
    const unsigned G = gridDim.x * gridDim.y * gridDim.z;
    unsigned sum, cnt, mine, sp = 0u;
    for (;;) {
        sum = 0u; cnt = 0u; mine = 0u;
#pragma unroll
        for (unsigned j = 0; j < 16; ++j) { const unsigned c = xb_ld(&bar[XB_XCNT(j)]); sum += c; cnt += (c > 0u) ? 1u : 0u; mine = (j == x) ? c : mine; }
        if (sum == G) break;
        __builtin_amdgcn_s_sleep(1);
        if ((++sp & 255u) == 0u) { if (xb_ld(&bar[XB_TMO])) break; if (sp > XB_SPIN_CAP) { atomicAdd(&bar[XB_TMO], 1u); break; } }
    }
    nloc = mine > 0u ? mine : 1u; nx = cnt > 0u ? cnt : 1u;
}

__device__ __forceinline__ void xcd_barrier(const XcdBarrier& b) {
    asm volatile("s_waitcnt vmcnt(0)" ::: "memory");
    __syncthreads();
    if (threadIdx.x == 0) {
        unsigned* bar = b.bar;
        __builtin_amdgcn_s_waitcnt(0);
        unsigned nloc = b.st[0], nx = b.st[1];
        if (nloc == 0u) { xcd_barrier_complete(bar, b.x, nloc, nx); b.st[0] = nloc; b.st[1] = nx; }
        const unsigned old = xb_add(&bar[XB_XSUB(b.x)], 1u);
        const unsigned gen = old / nloc;
        if (old + 1u == (gen + 1u) * nloc) {
            __builtin_amdgcn_fence(__ATOMIC_RELEASE, "agent");
            asm volatile("s_waitcnt vmcnt(0)" ::: "memory");
            const unsigned og = xb_add(&bar[XB_TOP], 1u);
            const unsigned tg = og / nx;
            if (og + 1u == (tg + 1u) * nx) xb_add(&bar[XB_TOPGEN], 1u);
            else XB_SPIN(xb_ld(&bar[XB_TOPGEN]) == tg, bar);
            __builtin_amdgcn_fence(__ATOMIC_ACQUIRE, "agent");
            xb_add(&bar[XB_XGEN(b.x)], 1u);
            asm volatile("s_waitcnt vmcnt(0)" ::: "memory");
        } else {
            XB_SPIN(xb_ld(&bar[XB_XGEN(b.x)]) == gen, bar);
            __builtin_amdgcn_fence(__ATOMIC_ACQUIRE, "agent");
            asm volatile("s_waitcnt vmcnt(0)" ::: "memory");
        }
    }
    __syncthreads();
}
#define ATT_NS att
#ifndef ATT_ABL
#define ATT_ABL 0
#endif
#ifndef ATT_STAGGER
#define ATT_STAGGER 0
#endif
#ifndef ATT_SLEEP
#define ATT_SLEEP 24
#endif
namespace ATT_NS {
using bf16x8 = __attribute__((ext_vector_type(8))) short;
using s16x4 = __attribute__((ext_vector_type(4))) short;
using f32x16 = __attribute__((ext_vector_type(16))) float;
using u32x4 = __attribute__((ext_vector_type(4))) unsigned;
typedef LAS const char* lds_cptr;
typedef short v4i16_t __attribute__((ext_vector_type(4)));
constexpr int SLOT = 16384, NSLOT = 4, LDS_OST = 65536, LDS_LUT = 98304, LDS_IMP = 100352, LDS_SELM = 133120, LDS_MISC = 134144, LDS_WSF = 134400, LDS_LUTG = 136448  , LDS_ATT_END = 144640;
constexpr float LOG2E = 1.4426950408889634f;
#define MFMA32(a, b, c) __builtin_amdgcn_mfma_f32_32x32x16_bf16(a, b, c, 0, 0, 0)
#define ATT_WAIT_BAR(N) asm volatile("s_waitcnt vmcnt(" #N ") lgkmcnt(0)\n\ts_barrier" ::: "memory")
__device__ __forceinline__ void glds16(const void* gsrc, unsigned lds_dst) { unsigned keep;
    asm volatile("s_mov_b32 %0, m0\n\ts_mov_b32 m0, %2\n\ts_nop 0\n\tglobal_load_lds_dwordx4 %1, off\n\ts_mov_b32 m0, %0" : "=&s"(keep) : "v"(gsrc), "s"(lds_dst) : "memory"); }
typedef float f32x2_t __attribute__((ext_vector_type(2))); typedef __bf16 bf16x2_t __attribute__((ext_vector_type(2)));
__device__ __forceinline__ unsigned cvtpk(float lo, float hi) { f32x2_t v = {lo, hi}; bf16x2_t b = __builtin_convertvector(v, bf16x2_t); return __builtin_bit_cast(unsigned, b); }
__device__ __forceinline__ s16x4 vtr(lds_cptr p) { return __builtin_bit_cast(s16x4, __builtin_amdgcn_ds_read_tr16_b64_v4i16((LAS v4i16_t*)p)); }
__device__ __forceinline__ int t5_bucket(int d) {
    if (d < 16) return d;
    int b = 16;
    b += (d >= 19); b += (d >= 21); b += (d >= 24); b += (d >= 27); b += (d >= 31); b += (d >= 35); b += (d >= 40); b += (d >= 46);
    b += (d >= 52); b += (d >= 59); b += (d >= 67); b += (d >= 77); b += (d >= 87); b += (d >= 99); b += (d >= 113);
    return b;
}
struct Ctx { LAS char* lds; int wid; int lane, r32, hi; };
__device__ __forceinline__ int fresh_lane() { int l; asm volatile("v_mbcnt_lo_u32_b32 %0, -1, 0\n\tv_mbcnt_hi_u32_b32 %0, -1, %0" : "=v"(l)); return l; }
__device__ __forceinline__ Ctx make_ctx(LAS unsigned char* lds, int tid) {
    Ctx c; c.lds = (LAS char*)lds; c.wid = __builtin_amdgcn_readfirstlane(tid >> 6); c.lane = tid & 63; c.r32 = c.lane & 31; c.hi = c.lane >> 5; return c;
}
template <bool HASV, class QK, class SM>
__device__ __forceinline__ void run_stream(const Ctx& c, const bf16* Kb, const bf16* Vb, int t0, int t1, QK&& qk, SM&& sm) {
    const int n = t1 - t0; if (n <= 0) return;
    const int lane = fresh_lane(), r32 = lane & 31, hi = lane >> 5; const unsigned lds0 = (unsigned)(uintptr_t)c.lds;
    const bf16* ks = Kb + ((8 * c.wid + (lane >> 3)) * 64 + (((lane & 7) ^ (((8 * c.wid + (lane >> 3)) >> 1) & 7)) << 3)); const bf16* vs = Vb + ((16 * (c.wid & 3) + (lane >> 2)) * 64 + (c.wid >> 2) * 32 + (lane & 3) * 8);
    const unsigned kdst = lds0 + c.wid * 1024, vdst = lds0 + 8192 + c.wid * 1024;
    const lds_cptr kp0 = (lds_cptr)c.lds + r32 * 128;
    const lds_cptr vp0 = (lds_cptr)c.lds + 8192 + ((lane >> 4) & 1) * 32 + (lane & 3) * 8 + (4 * hi + ((lane & 15) >> 2)) * 64;
#define ATT_ISSUE(t, so) do { if (ATT_ABL & 4) break; glds16(ks + (size_t)(t) * 4096, (unsigned)__builtin_amdgcn_readfirstlane(kdst + (so))); if (HASV) glds16(vs + (size_t)(t) * 4096, (unsigned)__builtin_amdgcn_readfirstlane(vdst + (so))); } while (0)
    ATT_ISSUE(t0, 0); if (n > 1) ATT_ISSUE(t0 + 1, SLOT);
    const bool late = ATT_STAGGER && __builtin_amdgcn_readfirstlane(c.wid) >= 4;
    f32x16 s0 = {}, s1 = {};
    int slot = 0, slotp = 3 * SLOT, slot2 = 2 * SLOT;
    if (!late) {
        for (int i = 0; i < n; ++i) {
            if (i + 1 < n) { if (HASV) ATT_WAIT_BAR(2); else ATT_WAIT_BAR(1); } else ATT_WAIT_BAR(0);
            if (i + 2 < n) ATT_ISSUE(t0 + i + 2, slot2);
            if (!(ATT_ABL & 1)) qk(t0 + i, kp0 + slot, s0, s1); if (!(ATT_ABL & 2)) sm(t0 + i, vp0 + slot, s0, s1);
            slot = (slot == 3 * SLOT) ? 0 : slot + SLOT; slot2 = (slot2 == 3 * SLOT) ? 0 : slot2 + SLOT;
        }
    } else {
        for (int i = 0; i < n; ++i) {
            if (i + 1 < n) { if (HASV) ATT_WAIT_BAR(2); else ATT_WAIT_BAR(1); } else ATT_WAIT_BAR(0);
            if (i + 2 < n) ATT_ISSUE(t0 + i + 2, slot2);
            if (i > 0 && !(ATT_ABL & 2)) sm(t0 + i - 1, vp0 + slotp, s0, s1);
            if (!(ATT_ABL & 1)) qk(t0 + i, kp0 + slot, s0, s1);
            slotp = slot; slot = (slot == 3 * SLOT) ? 0 : slot + SLOT; slot2 = (slot2 == 3 * SLOT) ? 0 : slot2 + SLOT;
        }
        if (!(ATT_ABL & 2)) sm(t0 + n - 1, vp0 + slotp, s0, s1);
    }
    asm volatile("s_waitcnt lgkmcnt(0)\n\ts_barrier" ::: "memory");
#undef ATT_ISSUE
}
template <class FN1, class FN2>
__device__ __forceinline__ void run_stream_pairs(const Ctx& c, const bf16* Kb, const bf16* Vb, int t0, int t1, FN1&& fn1, FN2&& fn2) {
    const int n = t1 - t0; if (n <= 0) return;
    const int lane = fresh_lane(), r32 = lane & 31, hi = lane >> 5; const unsigned lds0 = (unsigned)(uintptr_t)c.lds;
    const bf16* ks = Kb + ((8 * c.wid + (lane >> 3)) * 64 + (((lane & 7) ^ (((8 * c.wid + (lane >> 3)) >> 1) & 7)) << 3)); const bf16* vs = Vb + ((16 * (c.wid & 3) + (lane >> 2)) * 64 + (c.wid >> 2) * 32 + (lane & 3) * 8);
    const unsigned kdst = lds0 + c.wid * 1024, vdst = lds0 + 8192 + c.wid * 1024;
    const lds_cptr kp0 = (lds_cptr)c.lds + r32 * 128;
    const lds_cptr vp0 = (lds_cptr)c.lds + 8192 + ((lane >> 4) & 1) * 32 + (lane & 3) * 8 + (4 * hi + ((lane & 15) >> 2)) * 64;
#define ATT_ISSUE1(t, so) do { glds16(ks + (size_t)(t) * 4096, (unsigned)__builtin_amdgcn_readfirstlane(kdst + (so))); glds16(vs + (size_t)(t) * 4096, (unsigned)__builtin_amdgcn_readfirstlane(vdst + (so))); } while (0)
    ATT_ISSUE1(t0, 0); if (n > 1) ATT_ISSUE1(t0 + 1, SLOT);
    int base = 0;
    for (int i = 0; i < n; i += 2) {
        ATT_WAIT_BAR(0);
        const int nb = 2 * SLOT - base;
        if (i + 2 < n) ATT_ISSUE1(t0 + i + 2, nb); if (i + 3 < n) ATT_ISSUE1(t0 + i + 3, nb + SLOT);
        if (i + 1 < n) fn2(t0 + i, kp0 + base, vp0 + base, kp0 + base + SLOT, vp0 + base + SLOT); else fn1(t0 + i, kp0 + base, vp0 + base);
        base = nb;
    }
    asm volatile("s_waitcnt lgkmcnt(0)\n\ts_barrier" ::: "memory");
#undef ATT_ISSUE1
}
__device__ __forceinline__ void qk_tile(f32x16& s0, f32x16& s1, lds_cptr kp, const bf16x8 (&qr)[4]) {
    bf16x8 kf[8];
    { const int l = fresh_lane(), f = ((l & 31) >> 1) & 7, hi = l >> 5;
#pragma unroll
      for (int d0 = 0; d0 < 4; ++d0) { const int off = ((2 * d0 + hi) ^ f) << 4; kf[2 * d0] = *(const LAS bf16x8*)(kp + off); kf[2 * d0 + 1] = *(const LAS bf16x8*)(kp + 4096 + off); } }
    const f32x16 z = {};
    s0 = MFMA32(kf[0], qr[0], z); s1 = MFMA32(kf[1], qr[0], z);
#pragma unroll
    for (int d0 = 1; d0 < 4; ++d0) { s0 = MFMA32(kf[2 * d0], qr[d0], s0); s1 = MFMA32(kf[2 * d0 + 1], qr[d0], s1); }
}
template <bool MASK>
__device__ __forceinline__ void pv_tile(f32x16 (&o)[2], lds_cptr vp, const f32x16& p0, const f32x16& p1, unsigned mask) {
    if (ATT_ABL & 8) { o[0][0] += p0[0] + p1[5]; return; }
    u32x4 pw0 = {cvtpk(p0[0], p0[1]), cvtpk(p0[2], p0[3]), cvtpk(p0[4], p0[5]), cvtpk(p0[6], p0[7])}, pw1 = {cvtpk(p0[8], p0[9]), cvtpk(p0[10], p0[11]), cvtpk(p0[12], p0[13]), cvtpk(p0[14], p0[15])};
    u32x4 pw2 = {cvtpk(p1[0], p1[1]), cvtpk(p1[2], p1[3]), cvtpk(p1[4], p1[5]), cvtpk(p1[6], p1[7])}, pw3 = {cvtpk(p1[8], p1[9]), cvtpk(p1[10], p1[11]), cvtpk(p1[12], p1[13]), cvtpk(p1[14], p1[15])};
    if (MASK) { pw0 &= mask; pw1 &= mask; pw2 &= mask; pw3 &= mask; }
    if (ATT_ABL & 64) { o[0] = MFMA32(__builtin_bit_cast(bf16x8, pw0), __builtin_bit_cast(bf16x8, pw1), o[0]); o[1] = MFMA32(__builtin_bit_cast(bf16x8, pw2), __builtin_bit_cast(bf16x8, pw3), o[1]); return; }
    s16x4 vlo[8], vhi[8];
#pragma unroll
    for (int i = 0; i < 8; ++i) { vlo[i] = vtr(vp + ((i >> 2) * 4096 + (i & 3) * 1024)); vhi[i] = vtr(vp + ((i >> 2) * 4096 + (i & 3) * 1024 + 512)); }
#define ATT_VFR(i) (bf16x8){vlo[i][0], vlo[i][1], vlo[i][2], vlo[i][3], vhi[i][0], vhi[i][1], vhi[i][2], vhi[i][3]}
    o[0] = MFMA32(__builtin_bit_cast(bf16x8, pw0), ATT_VFR(0), o[0]); o[1] = MFMA32(__builtin_bit_cast(bf16x8, pw0), ATT_VFR(4), o[1]);
    o[0] = MFMA32(__builtin_bit_cast(bf16x8, pw1), ATT_VFR(1), o[0]); o[1] = MFMA32(__builtin_bit_cast(bf16x8, pw1), ATT_VFR(5), o[1]);
    o[0] = MFMA32(__builtin_bit_cast(bf16x8, pw2), ATT_VFR(2), o[0]); o[1] = MFMA32(__builtin_bit_cast(bf16x8, pw2), ATT_VFR(6), o[1]);
    o[0] = MFMA32(__builtin_bit_cast(bf16x8, pw3), ATT_VFR(3), o[0]); o[1] = MFMA32(__builtin_bit_cast(bf16x8, pw3), ATT_VFR(7), o[1]);
#undef ATT_VFR
}
#define ATT_SB() __builtin_amdgcn_sched_barrier(0)
struct KF { bf16x8 f[8]; };
struct VF { s16x4 lo[8], hi[8]; };
struct PW4 { u32x4 w0, w1, w2, w3; };
__device__ __forceinline__ void ld_k(KF& k, lds_cptr kp) {
    const int l = fresh_lane(), f = ((l & 31) >> 1) & 7, hi = l >> 5;
#pragma unroll
    for (int d0 = 0; d0 < 4; ++d0) { const int off = ((2 * d0 + hi) ^ f) << 4; k.f[2 * d0] = *(const LAS bf16x8*)(kp + off); k.f[2 * d0 + 1] = *(const LAS bf16x8*)(kp + 4096 + off); } }
__device__ __forceinline__ void qk_mfma(f32x16& s0, f32x16& s1, const KF& k, const bf16x8 (&qr)[4]) {
    const f32x16 z = {};
    s0 = MFMA32(k.f[0], qr[0], z); s1 = MFMA32(k.f[1], qr[0], z);
#pragma unroll
    for (int d0 = 1; d0 < 4; ++d0) { s0 = MFMA32(k.f[2 * d0], qr[d0], s0); s1 = MFMA32(k.f[2 * d0 + 1], qr[d0], s1); } }
__device__ __forceinline__ void ld_v(VF& v, lds_cptr vp) {
#pragma unroll
    for (int i = 0; i < 8; ++i) { v.lo[i] = vtr(vp + ((i >> 2) * 4096 + (i & 3) * 1024)); v.hi[i] = vtr(vp + ((i >> 2) * 4096 + (i & 3) * 1024 + 512)); } }
__device__ __forceinline__ PW4 pack4(const f32x16& p0, const f32x16& p1, unsigned mask) { PW4 w;
    w.w0 = (u32x4){cvtpk(p0[0], p0[1]), cvtpk(p0[2], p0[3]), cvtpk(p0[4], p0[5]), cvtpk(p0[6], p0[7])}; w.w1 = (u32x4){cvtpk(p0[8], p0[9]), cvtpk(p0[10], p0[11]), cvtpk(p0[12], p0[13]), cvtpk(p0[14], p0[15])};
    w.w2 = (u32x4){cvtpk(p1[0], p1[1]), cvtpk(p1[2], p1[3]), cvtpk(p1[4], p1[5]), cvtpk(p1[6], p1[7])}; w.w3 = (u32x4){cvtpk(p1[8], p1[9]), cvtpk(p1[10], p1[11]), cvtpk(p1[12], p1[13]), cvtpk(p1[14], p1[15])};
    w.w0 &= mask; w.w1 &= mask; w.w2 &= mask; w.w3 &= mask; return w; }
__device__ __forceinline__ void pv_mfma(f32x16 (&o)[2], const VF& v, const PW4& w) {
#define ATT_VF(i) (bf16x8){v.lo[i][0], v.lo[i][1], v.lo[i][2], v.lo[i][3], v.hi[i][0], v.hi[i][1], v.hi[i][2], v.hi[i][3]}
    o[0] = MFMA32(__builtin_bit_cast(bf16x8, w.w0), ATT_VF(0), o[0]); o[1] = MFMA32(__builtin_bit_cast(bf16x8, w.w0), ATT_VF(4), o[1]);
    o[0] = MFMA32(__builtin_bit_cast(bf16x8, w.w1), ATT_VF(1), o[0]); o[1] = MFMA32(__builtin_bit_cast(bf16x8, w.w1), ATT_VF(5), o[1]);
    o[0] = MFMA32(__builtin_bit_cast(bf16x8, w.w2), ATT_VF(2), o[0]); o[1] = MFMA32(__builtin_bit_cast(bf16x8, w.w2), ATT_VF(6), o[1]);
    o[0] = MFMA32(__builtin_bit_cast(bf16x8, w.w3), ATT_VF(3), o[0]); o[1] = MFMA32(__builtin_bit_cast(bf16x8, w.w3), ATT_VF(7), o[1]);
#undef ATT_VF
}
__device__ __forceinline__ float rowsum32(const f32x16& p0, const f32x16& p1) { if (ATT_ABL & 32) return p0[0]; float a = p0[0] + p1[0], b = p0[1] + p1[1];
#pragma unroll
    for (int r = 2; r < 16; r += 2) { a += p0[r]; asm volatile("" : "+v"(a)); b += p0[r + 1]; asm volatile("" : "+v"(b)); a += p1[r]; asm volatile("" : "+v"(a)); b += p1[r + 1]; asm volatile("" : "+v"(b)); }
    return a + b; }
__device__ __forceinline__ void hook_exp(f32x16& s0, f32x16& s1) {
    if (ATT_ABL & 16) return;
#pragma unroll
    for (int r = 0; r < 16; ++r) { s0[r] = __builtin_amdgcn_exp2f(s0[r]); s1[r] = __builtin_amdgcn_exp2f(s1[r]); } }
__device__ __forceinline__ void hook_near(f32x16& s0, f32x16& s1, int base, const LAS float* lut) {
    asm volatile("" : "+v"(base));
#pragma unroll
    for (int r = 0; r < 16; ++r) { const int d0 = base - ((r & 3) + 8 * (r >> 2)), d1 = d0 - 32;
        s0[r] = __builtin_amdgcn_exp2f(s0[r] + lut[min(max(d0, -1), 113) + 1]); s1[r] = __builtin_amdgcn_exp2f(s1[r] + lut[min(max(d1, -1), 113) + 1]); } }
__device__ __forceinline__ void hook_edge(f32x16& s0, f32x16& s1, int base, int win) {
    asm volatile("" : "+v"(base));
#pragma unroll
    for (int r = 0; r < 16; ++r) { const int d0 = base - ((r & 3) + 8 * (r >> 2)), d1 = d0 - 32;
        s0[r] = __builtin_amdgcn_exp2f(d0 < win ? s0[r] : -INFINITY); s1[r] = __builtin_amdgcn_exp2f(d1 < win ? s1[r] : -INFINITY); } }
__device__ __forceinline__ void hook_cmp(f32x16& s0, f32x16& s1, int nrel  , float cb) {
    asm volatile("" : "+v"(nrel));
#pragma unroll
    for (int r = 0; r < 16; ++r) { const int c0 = (r & 3) + 8 * (r >> 2);
        s0[r] = __builtin_amdgcn_exp2f(s0[r] + ((c0 <= nrel) ? cb : -INFINITY)); s1[r] = __builtin_amdgcn_exp2f(s1[r] + ((c0 + 32 <= nrel) ? cb : -INFINITY)); } }
__device__ __forceinline__ void row_factors(const Ctx& c, float f, float (&fr)[16]) {
    const int lane = fresh_lane(), r32 = lane & 31, hi = lane >> 5; LAS float* wsf = (LAS float*)(c.lds + LDS_WSF) + c.wid * 64;
    asm volatile("s_waitcnt lgkmcnt(0)" ::: "memory");
    if (hi == 0) wsf[r32] = f;
    asm volatile("s_waitcnt lgkmcnt(0)" ::: "memory");
#pragma unroll
    for (int r = 0; r < 16; ++r) fr[r] = wsf[(r & 3) + 8 * (r >> 2) + 4 * hi];
    asm volatile("s_waitcnt lgkmcnt(0)" ::: "memory");
}
__device__ __forceinline__ float pair_sum(float v) { auto rr = __builtin_amdgcn_permlane32_swap(__float_as_uint(v), __float_as_uint(v), false, false); return __uint_as_float(rr[0]) + __uint_as_float(rr[1]); }
template <class RowOff>
__device__ __forceinline__ void store_rows(const Ctx& c, const f32x16 (&o)[2], bf16* dst, RowOff&& rowoff) {
    LAS bf16* stg = (LAS bf16*)(c.lds + LDS_OST) + c.wid * 2048;
    const int lane = fresh_lane(), r32 = lane & 31, hi = lane >> 5;
#pragma unroll
    for (int r = 0; r < 16; ++r) { const int orow = (r & 3) + 8 * (r >> 2) + 4 * hi;
#pragma unroll
        for (int d0 = 0; d0 < 2; ++d0) stg[orow * 64 + d0 * 32 + r32] = (bf16)f2bf(o[d0][r]); }
    asm volatile("s_waitcnt lgkmcnt(0)" ::: "memory");
#pragma unroll
    for (int i = 0; i < 4; ++i) { const int row = i * 8 + (lane >> 3), ch = lane & 7; const u32x4 v = *(const LAS u32x4*)(stg + row * 64 + ch * 8); *(u32x4*)(dst + rowoff(row) + ch * 8) = v; }
    asm volatile("s_waitcnt lgkmcnt(0)" ::: "memory");
}
struct AttnPtrs { const bf16* qkv; const float* kmp; const float* gates; const bf16* kcmp; const bf16* vcmp; const float* rel_bias; bf16* mix; unsigned* selg; bf16* part_o; float* part_l; };

__device__ __forceinline__ void moba_kmean_frags(const AttnPtrs& P, int bh, int r32, int hi, bf16x8 (&kmf)[4]) {
    const float* kp = P.kmp + ((size_t)(bh * 32 + r32) * 2) * 64;
#pragma unroll
    for (int d0 = 0; d0 < 4; ++d0) { const f32x4 a0 = *(const f32x4*)(kp + d0 * 16 + hi * 8), a1 = *(const f32x4*)(kp + d0 * 16 + hi * 8 + 4), b0 = *(const f32x4*)(kp + 64 + d0 * 16 + hi * 8), b1 = *(const f32x4*)(kp + 64 + d0 * 16 + hi * 8 + 4);
        const f32x4 m0 = (a0 + b0) * (1.f / 256.f), m1 = (a1 + b1) * (1.f / 256.f);
        u32x4 w = {cvtpk(m0[0], m0[1]), cvtpk(m0[2], m0[3]), cvtpk(m1[0], m1[1]), cvtpk(m1[2], m1[3])}; kmf[d0] = __builtin_bit_cast(bf16x8, w); }
}
__device__ __forceinline__ unsigned moba_gate32(const bf16x8 (&kmf)[4], int i, const bf16x8 (&qr)[4], int hi) {
    unsigned selmask = 0u;
    if (i > 0) {
        f32x16 sg = {};
#pragma unroll
        for (int d0 = 0; d0 < 4; ++d0) sg = MFMA32(kmf[d0], qr[d0], sg);
        float v[16];
#pragma unroll
        for (int r = 0; r < 16; ++r) v[r] = ((r & 3) + 8 * (r >> 2) + 4 * hi < i) ? sg[r] : -INFINITY;
#pragma unroll
        for (int it = 0; it < 3; ++it) {
            float m = v[0]; int jb = 4 * hi;
#pragma unroll
            for (int r = 1; r < 16; ++r) { const int j = (r & 3) + 8 * (r >> 2) + 4 * hi; if (v[r] > m) { m = v[r]; jb = j; } }
            auto rm = __builtin_amdgcn_permlane32_swap(__float_as_uint(m), __float_as_uint(m), false, false);
            auto rj = __builtin_amdgcn_permlane32_swap((unsigned)jb, (unsigned)jb, false, false);
            const float mo = __uint_as_float(hi ? rm[0] : rm[1]); const int jo = (int)(hi ? rj[0] : rj[1]);
            const bool mine = (m > mo) || (m == mo && jb < jo);
            const float mw = mine ? m : mo; const int jw = mine ? jb : jo;
            if (mw > -INFINITY) { selmask |= 1u << jw;
#pragma unroll
                for (int r = 0; r < 16; ++r) if ((r & 3) + 8 * (r >> 2) + 4 * hi == jw) v[r] = -INFINITY; }
        }
    }
    return selmask;
}
__device__ __forceinline__ void moba_gate_phase(const AttnPtrs& P, int vcu, int G, int tid) {
    const int lane = tid & 63, r32 = lane & 31, hi = lane >> 5; const int wid = __builtin_amdgcn_readfirstlane(tid >> 6);
    for (int grp = vcu * 8 + wid; grp < 2048; grp += G * 8) { const int bh = grp >> 6;
        bf16x8 kmf[4]; moba_kmean_frags(P, bh, r32, hi, kmf);
        const bf16* QA = P.qkv + ((size_t)bh * SEQ) * 64;
#pragma unroll 2
        for (int k = 0; k < 4; ++k) { const int idx = (grp & 63) * 4 + k, i = idx >> 3, w = idx & 7; const int qpos = 256 * i + 32 * w + r32;
            bf16x8 qr[4];
#pragma unroll
            for (int d0 = 0; d0 < 4; ++d0) qr[d0] = *(const bf16x8*)(QA + (size_t)qpos * 64 + d0 * 16 + hi * 8);
            const unsigned m = moba_gate32(kmf, i, qr, hi);
            if (hi == 0) P.selg[(size_t)bh * SEQ + qpos] = m; } }
}
__device__ __forceinline__ void moba_lut(const Ctx& c, const AttnPtrs& P, int h) {
    LAS float* lut = (LAS float*)(c.lds + LDS_LUT);
    if (threadIdx.x < 115) lut[threadIdx.x] = (threadIdx.x == 0) ? -INFINITY : (P.rel_bias[t5_bucket(threadIdx.x - 1) * 16 + h] - P.rel_bias[31 * 16 + h]) * LOG2E;
}
__device__ __forceinline__ void moba_past_item(const Ctx& c, const AttnPtrs& P, int b, int h, int j) {
    const int bh = b * 8 + h, tid = threadIdx.x;
    const bf16* QA = P.qkv + ((size_t)bh * SEQ) * 64; const bf16* KA = QA + QKV_BIG + (size_t)256 * j * 64; const bf16* VA = QA + 2 * QKV_BIG + (size_t)256 * j * 64;
    const LAS float* lut = (const LAS float*)(c.lds + LDS_LUTG) + h * 128;
    { const int lane = fresh_lane(); const unsigned lds0 = (unsigned)(uintptr_t)c.lds;
      const bf16* ks = KA + ((8 * c.wid + (lane >> 3)) * 64 + (((lane & 7) ^ (((8 * c.wid + (lane >> 3)) >> 1) & 7)) << 3)); const bf16* vs = VA + ((16 * (c.wid & 3) + (lane >> 2)) * 64 + (c.wid >> 2) * 32 + (lane & 3) * 8);
#pragma unroll
      for (int tt = 0; tt < 4; ++tt) { glds16(ks + tt * 4096, (unsigned)__builtin_amdgcn_readfirstlane(lds0 + c.wid * 1024 + tt * SLOT)); glds16(vs + tt * 4096, (unsigned)__builtin_amdgcn_readfirstlane(lds0 + 8192 + c.wid * 1024 + tt * SLOT)); } }
    LAS unsigned short* list = (LAS unsigned short*)(c.lds + LDS_IMP);
    LAS unsigned* wcnt = (LAS unsigned*)(c.lds + LDS_MISC) + 8;
    const unsigned* sg = P.selg + (size_t)bh * SEQ;
    if (tid < 256) list[tid] = (unsigned short)((256 * j + tid) | (3 << 13));
    int total = 256;
    for (int base = (j + 1) * 256; base < SEQ; base += 2048) {
        const int q0 = base + 4 * tid; uint4 m4 = make_uint4(0u, 0u, 0u, 0u); if (q0 < SEQ) m4 = *(const uint4*)(sg + q0);
        const unsigned long long b0 = __ballot((m4.x >> j) & 1u), b1 = __ballot((m4.y >> j) & 1u), b2 = __ballot((m4.z >> j) & 1u), b3 = __ballot((m4.w >> j) & 1u);
        const int c0 = (int)__popcll(b0), c1 = (int)__popcll(b1), c2 = (int)__popcll(b2), c3 = (int)__popcll(b3);
        if ((tid & 63) == 0) wcnt[c.wid] = (unsigned)(c0 + c1 + c2 + c3);
        asm volatile("s_waitcnt vmcnt(0) lgkmcnt(0)\n\ts_barrier" ::: "memory");
        int off = total, tot = 0;
#pragma unroll
        for (int w = 0; w < 8; ++w) { const int v = (int)wcnt[w]; off += (w < c.wid) ? v : 0; tot += v; }
        const unsigned long long below = (1ull << (tid & 63)) - 1ull; const unsigned lowj = (1u << j) - 1u;
        if ((m4.x >> j) & 1u) list[off + __popcll(b0 & below)] = (unsigned short)((q0 + 0) | (__popc(m4.x & lowj) << 13)); off += c0;
        if ((m4.y >> j) & 1u) list[off + __popcll(b1 & below)] = (unsigned short)((q0 + 1) | (__popc(m4.y & lowj) << 13)); off += c1;
        if ((m4.z >> j) & 1u) list[off + __popcll(b2 & below)] = (unsigned short)((q0 + 2) | (__popc(m4.z & lowj) << 13)); off += c2;
        if ((m4.w >> j) & 1u) list[off + __popcll(b3 & below)] = (unsigned short)((q0 + 3) | (__popc(m4.w & lowj) << 13));
        total += tot;
        asm volatile("s_waitcnt lgkmcnt(0)\n\ts_barrier" ::: "memory");
    }
    total = __builtin_amdgcn_readfirstlane(total);
    { const int npad = (32 - (total & 31)) & 31; if (tid < npad) list[total + tid] = 0xFFFFu; }
    const int nchunks = (total + 31) >> 5;
    asm volatile("s_waitcnt vmcnt(0) lgkmcnt(0)\n\ts_barrier" ::: "memory");
    for (int ch = c.wid; ch < nchunks; ch += 8) {
        const int lane = fresh_lane(), r32 = lane & 31, hi = lane >> 5;
        const lds_cptr kp0 = (lds_cptr)c.lds + r32 * 128;
        const lds_cptr vp0 = (lds_cptr)c.lds + 8192 + ((lane >> 4) & 1) * 32 + (lane & 3) * 8 + (4 * hi + ((lane & 15) >> 2)) * 64;
        const unsigned e = list[32 * ch + r32]; const bool valid = e != 0xFFFFu; const int q = valid ? (int)(e & 0x1FFFu) : SEQ - 1;
        bf16x8 qr[4];
#pragma unroll
        for (int d0 = 0; d0 < 4; ++d0) qr[d0] = *(const bf16x8*)(QA + (size_t)q * 64 + d0 * 16 + hi * 8);
        asm volatile("" : "+v"(qr[0]), "+v"(qr[1]), "+v"(qr[2]), "+v"(qr[3]));
        const bool anynear = __any(valid && (unsigned)((q >> 8) - j) <= 1u);
        f32x16 o[2]; o[0] = f32x16{}; o[1] = f32x16{}; float l_reg = 0.f;
#pragma unroll 1
        for (int tt = 0; tt < 4; ++tt) { f32x16 s0, s1; qk_tile(s0, s1, kp0 + tt * SLOT, qr);
            if (anynear) hook_near(s0, s1, q - (256 * j + 64 * tt) - 4 * hi, lut); else hook_exp(s0, s1);
            l_reg += rowsum32(s0, s1);
            pv_tile<false>(o, vp0 + tt * SLOT, s0, s1, 0u); }
        const float L = pair_sum(l_reg);
        if (hi == 0 && valid) P.part_l[((size_t)bh * SEQ + q) * 4 + (e >> 13)] = L;
        LAS bf16* stg = (LAS bf16*)(c.lds + LDS_OST) + c.wid * 2048;
#pragma unroll
        for (int r = 0; r < 16; ++r) { const int orow = (r & 3) + 8 * (r >> 2) + 4 * hi;
#pragma unroll
            for (int d0 = 0; d0 < 2; ++d0) stg[orow * 64 + d0 * 32 + r32] = (bf16)f2bf(o[d0][r]); }
        asm volatile("s_waitcnt lgkmcnt(0)" ::: "memory");
#pragma unroll
        for (int it = 0; it < 4; ++it) { const int row = it * 8 + (lane >> 3), chn = lane & 7; const unsigned e2 = list[32 * ch + row];
            const u32x4 v = *(const LAS u32x4*)(stg + row * 64 + chn * 8);
            if (e2 != 0xFFFFu) *(u32x4*)(P.part_o + (((size_t)bh * SEQ + (e2 & 0x1FFFu)) * 4 + (e2 >> 13)) * 64 + chn * 8) = v; }
        asm volatile("s_waitcnt lgkmcnt(0)" ::: "memory");
    }
    asm volatile("s_waitcnt lgkmcnt(0)\n\ts_barrier" ::: "memory");
}
__device__ __forceinline__ void moba_merge_pass(const AttnPtrs& P, int vcu, int G, int tid) {
    const int lane = tid & 63, h = lane >> 3, chn = lane & 7; const int wid = __builtin_amdgcn_readfirstlane(tid >> 6);
#pragma unroll 2
    for (int tok = vcu * 8 + wid; tok < TOK; tok += G * 8) { const int b = tok >> 13, q = tok & (SEQ - 1);
        const size_t qi = (size_t)(b * 8 + h) * SEQ + q; const int ns = __popc(P.selg[qi]);
        float Lt = P.part_l[qi * 4 + 3]; const u32x4 pw = *(const u32x4*)(P.part_o + (qi * 4 + 3) * 64 + chn * 8);
        f32x4 a0 = {__uint_as_float(pw.x << 16), __uint_as_float(pw.x & 0xffff0000u), __uint_as_float(pw.y << 16), __uint_as_float(pw.y & 0xffff0000u)};
        f32x4 a1 = {__uint_as_float(pw.z << 16), __uint_as_float(pw.z & 0xffff0000u), __uint_as_float(pw.w << 16), __uint_as_float(pw.w & 0xffff0000u)};
#pragma unroll
        for (int sidx = 0; sidx < 3; ++sidx) if (sidx < ns) { Lt += P.part_l[qi * 4 + sidx]; const u32x4 pv = *(const u32x4*)(P.part_o + (qi * 4 + sidx) * 64 + chn * 8);
            a0 += (f32x4){__uint_as_float(pv.x << 16), __uint_as_float(pv.x & 0xffff0000u), __uint_as_float(pv.y << 16), __uint_as_float(pv.y & 0xffff0000u)};
            a1 += (f32x4){__uint_as_float(pv.z << 16), __uint_as_float(pv.z & 0xffff0000u), __uint_as_float(pv.w << 16), __uint_as_float(pv.w & 0xffff0000u)}; }
        const float inv = 1.f / Lt; a0 *= inv; a1 *= inv;
        const u32x4 w = {cvtpk(a0[0], a0[1]), cvtpk(a0[2], a0[3]), cvtpk(a1[0], a1[1]), cvtpk(a1[2], a1[3])};
        *(u32x4*)(P.mix + (size_t)tok * DM + h * 64 + chn * 8) = w; }
}

__device__ __forceinline__ void nsa_item(const Ctx& c, const AttnPtrs& P, int b, int g, int ci, int flags = 0) {
    const int ql = 8 * c.wid + (c.r32 >> 2), rh = c.r32 & 3, qpos = 64 * ci + ql, hb = 4 * g + rh;
    const int qw0 = 64 * ci + 8 * c.wid;
    const bf16* QB = P.qkv + 3 * QKV_BIG + ((size_t)(b * 8 + hb) * SEQ) * 64;
    const bf16* KS = P.qkv + 4 * QKV_BIG + 2 * QKV_SMALL + ((size_t)(b * 2 + g) * SEQ) * 64; const bf16* VS = KS + QKV_SMALL; const bf16* KW = KS + 2 * QKV_SMALL; const bf16* VW = KS + 3 * QKV_SMALL;
    const bf16* KC = P.kcmp + (size_t)(b * 2 + g) * 512 * 64; const bf16* VC = P.vcmp + (size_t)(b * 2 + g) * 512 * 64;
    bf16x8 qr[4];
#pragma unroll
    for (int d0 = 0; d0 < 4; ++d0) qr[d0] = *(const bf16x8*)(QB + (size_t)qpos * 64 + d0 * 16 + c.hi * 8);
    asm volatile("" : "+v"(qr[0]), "+v"(qr[1]), "+v"(qr[2]), "+v"(qr[3]));
    const LAS float* lut = (const LAS float*)(c.lds + LDS_LUTG) + (8 + hb) * 128;
    LAS float* imp = (LAS float*)(c.lds + LDS_IMP);
    LAS unsigned* selm = (LAS unsigned*)(c.lds + LDS_SELM);
    f32x16 o[2]; float l_reg; float fr[16];
    LAS float* park = (LAS float*)(c.lds + LDS_OST) + c.wid * 1024 + c.lane;
    LAS float* park1 = (LAS float*)(c.lds + LDS_IMP) + c.wid * 1024 + c.lane;
    const int nct = (4 * ci + 3 + 63) >> 6;
    const int nlim = (qpos >= 31) ? ((qpos - 31) >> 4) : -1;
    LAS bf16* impt = (LAS bf16*)(c.lds + ((rh & 2) ? LDS_IMP : LDS_OST)) + ((rh & 1) * 64 + ql) * 128;
    l_reg = 0.f; o[0] = f32x16{}; o[1] = f32x16{};
    {
        float carry = 0.f;
        run_stream<true>(c, KC, VC, 0, nct,
          [&](int t, lds_cptr kp, f32x16& s0, f32x16& s1) { qk_tile(s0, s1, kp, qr); },
          [&](int t, lds_cptr vp, f32x16& s0, f32x16& s1) {
            hook_cmp(s0, s1, nlim - 64 * t - 4 * c.hi, 0.f);
            l_reg += rowsum32(s0, s1);
#pragma unroll
            for (int half = 0; half < 2; ++half) {
                float g4[4], e[4];
#pragma unroll
                for (int a = 0; a < 4; ++a) { const float x0 = half ? s1[4 * a] : s0[4 * a], x1 = half ? s1[4 * a + 1] : s0[4 * a + 1], x2 = half ? s1[4 * a + 2] : s0[4 * a + 2], x3 = half ? s1[4 * a + 3] : s0[4 * a + 3];
                    g4[a] = (x0 + x1) + (x2 + x3); e[a] = x3; }
                float x[4];
#pragma unroll
                for (int a = 0; a < 4; ++a) { auto rr = __builtin_amdgcn_permlane32_swap(__float_as_uint(e[a]), __float_as_uint(e[a]), false, false); x[a] = __uint_as_float(c.hi ? rr[0] : rr[1]); }
                const int jb = 16 * t + 8 * half;
                float iv[4];
                if (c.hi) {
#pragma unroll
                    for (int a = 0; a < 4; ++a) iv[a] = g4[a] + x[a]; }
                else { iv[0] = g4[0] + carry; iv[1] = g4[1] + x[0]; iv[2] = g4[2] + x[1]; iv[3] = g4[3] + x[2]; carry = x[3]; }
#pragma unroll
                for (int a = 0; a < 4; ++a) impt[jb + 2 * a + c.hi] = (bf16)f2bf(iv[a]);
            }
            pv_tile<false>(o, vp, s0, s1, 0u);
        });
    }
    const float Lc = pair_sum(l_reg); const float invLc = Lc > 0.f ? 1.f / Lc : 0.f;
    { LAS float* wsfw = (LAS float*)(c.lds + LDS_WSF) + c.wid * 64; if (c.hi == 0) wsfw[32 + c.r32] = invLc; }
    {
        asm volatile("s_waitcnt lgkmcnt(0)\n\ts_barrier" ::: "memory");
        const int qq = 8 * c.wid + (c.lane >> 3), cc = c.lane & 7;
        unsigned m0 = 0u, m1 = 0u, m2w = 0u, m3 = 0u;
        if (ci <= 15) { m0 = (ci == 31) ? 0xffffffffu : ((2u << ci) - 1u); }
        else {
            float v[16];
            const LAS float* il = (const LAS float*)(c.lds + LDS_WSF) + c.wid * 64 + 32 + 4 * (c.lane >> 3);
            const float i0 = il[0], i1 = il[1], i2 = il[2], i3 = il[3];
            const LAS bf16* ta = (const LAS bf16*)(c.lds + LDS_OST) + qq * 128; const LAS bf16* tb = (const LAS bf16*)(c.lds + LDS_IMP) + qq * 128;
#pragma unroll
            for (int k = 0; k < 16; ++k) { const int j = cc + 8 * k;
                v[k] = (j >= 1 && j <= ci - 2) ? (bf2f(ta[j]) * i0 + bf2f(ta[64 * 128 + j]) * i1) + (bf2f(tb[j]) * i2 + bf2f(tb[64 * 128 + j]) * i3) : -INFINITY; }
            for (int it = 0; it < 13; ++it) {
                float m = v[0]; int jb = cc;
#pragma unroll
                for (int k = 1; k < 16; ++k) if (v[k] > m) { m = v[k]; jb = cc + 8 * k; }
#pragma unroll
                for (int sft = 1; sft < 8; sft <<= 1) { const float mo = __shfl_xor(m, sft); const int jo = __shfl_xor(jb, sft); if (mo > m || (mo == m && jo < jb)) { m = mo; jb = jo; } }
                if (m > -INFINITY) { const unsigned bit = 1u << (jb & 31); const int wsel = jb >> 5;
                    m0 |= (wsel == 0) ? bit : 0u; m1 |= (wsel == 1) ? bit : 0u; m2w |= (wsel == 2) ? bit : 0u; m3 |= (wsel == 3) ? bit : 0u;
#pragma unroll
                    for (int k = 0; k < 16; ++k) if (cc + 8 * k == jb) v[k] = -INFINITY; }
            }
            m0 |= 1u;
#pragma unroll
            for (int z = 0; z < 2; ++z) { const int jf = ci - z; const unsigned bit = 1u << (jf & 31); const int wsel = jf >> 5;
                m0 |= (wsel == 0) ? bit : 0u; m1 |= (wsel == 1) ? bit : 0u; m2w |= (wsel == 2) ? bit : 0u; m3 |= (wsel == 3) ? bit : 0u; }
        }
        if (cc == 0) { selm[qq * 4 + 0] = m0; selm[qq * 4 + 1] = m1; selm[qq * 4 + 2] = m2w; selm[qq * 4 + 3] = m3; }
        asm volatile("s_waitcnt lgkmcnt(0)\n\ts_barrier" ::: "memory");
    }
    const float* gp = P.gates + ((size_t)b * SEQ + qpos) * 24 + hb * 3; float g0 = gp[0], g1 = gp[1], g2 = gp[2];
    asm volatile("" : "+v"(g0), "+v"(g1), "+v"(g2));
    row_factors(c, g0 * invLc, fr);
#pragma unroll
    for (int r = 0; r < 16; ++r) { park[r * 64] = o[0][r] * fr[r]; park1[r * 64] = o[1][r] * fr[r]; }
    {
        const unsigned w0 = selm[ql * 4 + 0], w1 = selm[ql * 4 + 1], w2 = selm[ql * 4 + 2], w3 = selm[ql * 4 + 3];
        o[0] = f32x16{}; o[1] = f32x16{}; l_reg = 0.f;
        auto sel_pred = [&](int t) -> bool { const unsigned wsel = (t < 32) ? w0 : (t < 64) ? w1 : (t < 96) ? w2 : w3; return (wsel >> (t & 31)) & 1u; };
        auto sel_one = [&](int t, lds_cptr kp, lds_cptr vp) { const bool pred = sel_pred(t); if (!__any(pred)) return; const int key0 = 64 * t;
            f32x16 s0, s1; qk_tile(s0, s1, kp, qr);
            if (qw0 - key0 - 63 >= 113) { hook_exp(s0, s1); const float rs = rowsum32(s0, s1); l_reg += pred ? rs : 0.f;
                if (__all(pred)) pv_tile<false>(o, vp, s0, s1, 0u); else pv_tile<true>(o, vp, s0, s1, pred ? 0xffffffffu : 0u); }
            else { hook_near(s0, s1, qpos - key0 - 4 * c.hi, lut); const float rs = rowsum32(s0, s1); l_reg += pred ? rs : 0.f;
                if (__all(pred)) pv_tile<false>(o, vp, s0, s1, 0u); else pv_tile<true>(o, vp, s0, s1, pred ? 0xffffffffu : 0u); } };
        if (!(flags & 4)) run_stream_pairs(c, KS, VS, 0, ci + 1, sel_one,
            [&](int t, lds_cptr kpA, lds_cptr vpA, lds_cptr kpB, lds_cptr vpB) {
                if (qw0 - 64 * (t + 1) - 63 >= 113) {
                    const bool pa = sel_pred(t), pb = sel_pred(t + 1);
                    const bool xa = __any(pa), xb = __any(pb);
                    if (!xa && !xb) return;
                    if (!xb) { sel_one(t, kpA, vpA); return; }
                    if (!xa) { sel_one(t + 1, kpB, vpB); return; }
                    KF kA, kB; ld_k(kA, kpA); ATT_SB();
                    f32x16 a0, a1, b0, b1; qk_mfma(a0, a1, kA, qr); ATT_SB();
                    VF vA, vB; ld_k(kB, kpB); ld_v(vA, vpA); ATT_SB();
                    qk_mfma(b0, b1, kB, qr); hook_exp(a0, a1);
                    const float ra = rowsum32(a0, a1); const PW4 wa = pack4(a0, a1, pa ? 0xffffffffu : 0u); ATT_SB();
                    ld_v(vB, vpB); ATT_SB();
                    pv_mfma(o, vA, wa); hook_exp(b0, b1);
                    const float rb = rowsum32(b0, b1); const PW4 wb = pack4(b0, b1, pb ? 0xffffffffu : 0u); l_reg += (pa ? ra : 0.f) + (pb ? rb : 0.f); ATT_SB();
                    pv_mfma(o, vB, wb);
                } else { sel_one(t, kpA, vpA); sel_one(t + 1, kpB, vpB); } });
        const float Ls = pair_sum(l_reg);
        row_factors(c, g1 / Ls, fr);
#pragma unroll
        for (int r = 0; r < 16; ++r) { park[r * 64] += o[0][r] * fr[r]; park1[r * 64] += o[1][r] * fr[r]; }
    }
    {
        o[0] = f32x16{}; o[1] = f32x16{}; l_reg = 0.f;
        if (!(flags & 8)) run_stream<true>(c, KW, VW, ci >= 8 ? ci - 8 : 0, ci + 1,
            [&](int t, lds_cptr kp, f32x16& s0, f32x16& s1) { qk_tile(s0, s1, kp, qr); },
            [&](int t, lds_cptr vp, f32x16& s0, f32x16& s1) { const int key0 = 64 * t;
                if (qw0 - key0 - 63 < 113) hook_near(s0, s1, qpos - key0 - 4 * c.hi, lut); else if (qw0 + 7 - key0 >= 512) hook_edge(s0, s1, qpos - key0 - 4 * c.hi, 512); else hook_exp(s0, s1);
                l_reg += rowsum32(s0, s1);
                pv_tile<false>(o, vp, s0, s1, 0u); });
        const float Lw = pair_sum(l_reg);
        row_factors(c, g2 / Lw, fr);
#pragma unroll
        for (int r = 0; r < 16; ++r) { o[0][r] = park[r * 64] + o[0][r] * fr[r]; o[1][r] = park1[r * 64] + o[1][r] * fr[r]; }
        asm volatile("s_waitcnt lgkmcnt(0)" ::: "memory");
    }
    bf16* dst = P.mix + ((size_t)b * SEQ + 64 * ci + 8 * c.wid) * DM + 512 + g * 256;
    store_rows(c, o, dst, [](int row) { return (size_t)(row >> 2) * DM + (row & 3) * 64; });
    asm volatile("s_waitcnt lgkmcnt(0)\n\ts_barrier" ::: "memory");
}

__device__ __forceinline__ void attn_phase(LAS unsigned char* lds, const AttnPtrs& P, unsigned* qcounter, int flags) {
    Ctx c = make_ctx(lds, threadIdx.x);
    LAS unsigned* misc = (LAS unsigned*)(c.lds + LDS_MISC);
    { LAS float* lutg = (LAS float*)(c.lds + LDS_LUTG);
      for (int idx = threadIdx.x; idx < 16 * 115; idx += NTHREADS) { const int hh = idx / 115, d = idx % 115;
          lutg[hh * 128 + d] = (d == 0) ? -INFINITY : (P.rel_bias[t5_bucket(d - 1) * 16 + hh] - P.rel_bias[31 * 16 + hh]) * LOG2E; }
      asm volatile("s_waitcnt vmcnt(0) lgkmcnt(0)\n\ts_barrier" ::: "memory"); }
    for (;;) {
        if (threadIdx.x == 0) misc[0] = __hip_atomic_fetch_add(qcounter, 1u, __ATOMIC_RELAXED, __HIP_MEMORY_SCOPE_AGENT);
        asm volatile("s_waitcnt vmcnt(0) lgkmcnt(0)\n\ts_barrier" ::: "memory");
        const unsigned k = misc[0];
        asm volatile("s_waitcnt lgkmcnt(0)\n\ts_barrier" ::: "memory");
        if (k >= 2048u) break;
        const bool is_mp = k >= 512u && k < 1536u;
        if (flags & (is_mp ? 2 : 1)) continue;
        if (k < 512u) { const int s_ = 127 - (int)(k >> 3), bg = k & 7; nsa_item(c, P, bg >> 1, bg & 1, s_, flags); }
        else if (k < 1536u) { const int kk = (int)k - 512, j = kk >> 5, bh = kk & 31; moba_past_item(c, P, bh >> 3, bh & 7, j); }
        else { const int kk = (int)k - 1536; const int s_ = 63 - (kk >> 3), bg = kk & 7; nsa_item(c, P, bg >> 1, bg & 1, s_, flags); }
    }
}
#undef MFMA32
#undef ATT_WAIT_BAR
}
namespace cmpr {
using bf16x8 = __attribute__((ext_vector_type(8))) short;
using f32x16 = __attribute__((ext_vector_type(16))) float;
constexpr int HID_PITCH = 528;
__device__ __forceinline__ float gelu_tanh(float v) { const float u = fminf(fmaxf(0.7978845608028654f * (v + 0.044715f * v * v * v), -15.f), 15.f); const float e = __expf(2.f * u); return 0.5f * v * (1.f + (e - 1.f) / (e + 1.f)); }
__device__ __forceinline__ void compress_unit(LAS unsigned char* lds, int unit, const bf16* qkv, const bf16* w1k, const bf16* w1v, const bf16* w2k, const bf16* w2v, const float* cbp, const float* kncmp, bf16* kcmp, bf16* vcmp) {
    const int tid = threadIdx.x, lane = tid & 63, r32 = lane & 31, hi = lane >> 5; const int wid = __builtin_amdgcn_readfirstlane(tid >> 6);
    const int kv = unit & 1, u = (unit >> 1) & 15, bg = unit >> 5;
    const bf16* src = qkv + 4 * QKV_BIG + (kv ? QKV_SMALL : 0) + (size_t)bg * SEQ * 64;
    const bf16* w1 = kv ? w1v : w1k; const bf16* w2 = kv ? w2v : w2k;
    const int n0 = 32 * u;
    { const bf16* sp = src + (size_t)16 * n0 * 64;
      for (int ch = tid; ch < 4224; ch += NTHREADS) { v4u v = {0u, 0u, 0u, 0u}; if (16 * n0 + (ch >> 3) < SEQ) v = *(const GAS v4u*)(sp + (size_t)ch * 8);
          *(LAS v4u*)(lds + ((ch ^ ((ch >> 7) & 15)) << 4)) = v; } }
    asm volatile("s_waitcnt vmcnt(0) lgkmcnt(0)\n\ts_barrier" ::: "memory");
    const bf16* bp = w1 + ((size_t)wid * 64 + lane) * 8;
    f32x16 acc = {};
#pragma unroll 16
    for (int kk = 0; kk < 128; ++kk) { const int lc = r32 * 128 + 2 * kk + hi; const bf16x8 a = *(const LAS bf16x8*)(lds + ((lc ^ ((lc >> 7) & 15)) << 4)), bfr = *(const bf16x8*)(bp + (size_t)kk * 4096); acc = __builtin_amdgcn_mfma_f32_32x32x16_bf16(a, bfr, acc, 0, 0, 0); }
    float cb = 0.f;
#pragma unroll 8
    for (int ic = 0; ic < 32; ++ic) cb += cbp[(ic * 2 + kv) * 256 + 32 * wid + r32];
    LAS unsigned char* hidL = lds + 69632;
#pragma unroll
    for (int r = 0; r < 16; ++r) { const int n = (r & 3) + 8 * (r >> 2) + 4 * hi; *(LAS bf16*)(hidL + n * HID_PITCH + (32 * wid + r32) * 2) = (bf16)f2bf(gelu_tanh(acc[r] + cb)); }
    asm volatile("s_waitcnt lgkmcnt(0)\n\ts_barrier" ::: "memory");
    if (wid == 0) {
        f32x16 o0 = {}, o1 = {};
#pragma unroll 4
        for (int kk = 0; kk < 16; ++kk) { const bf16x8 hb = *(const LAS bf16x8*)(hidL + r32 * HID_PITCH + (16 * kk + 8 * hi) * 2);
            const bf16x8 a0 = *(const bf16x8*)(w2 + (size_t)r32 * 256 + 16 * kk + 8 * hi), a1 = *(const bf16x8*)(w2 + (size_t)(32 + r32) * 256 + 16 * kk + 8 * hi);
            o0 = __builtin_amdgcn_mfma_f32_32x32x16_bf16(a0, hb, o0, 0, 0, 0); o1 = __builtin_amdgcn_mfma_f32_32x32x16_bf16(a1, hb, o1, 0, 0, 0); }
        float rs = 1.f;
        if (!kv) { float ss = 0.f;
#pragma unroll
            for (int r = 0; r < 16; ++r) ss += o0[r] * o0[r] + o1[r] * o1[r];
            auto rr = __builtin_amdgcn_permlane32_swap(__float_as_uint(ss), __float_as_uint(ss), false, false); ss = __uint_as_float(rr[0]) + __uint_as_float(rr[1]);
            rs = rsqrtf(ss * (1.f / 64.f) + 1e-6f); }
        const int n = n0 + r32; bf16* dst = (kv ? vcmp : kcmp) + ((size_t)bg * 512 + n) * 64;
#pragma unroll
        for (int r = 0; r < 16; ++r) { const int d = (r & 3) + 8 * (r >> 2) + 4 * hi;
            float v0 = o0[r] * rs, v1 = o1[r] * rs; if (!kv) { v0 *= kncmp[d]; v1 *= kncmp[d + 32]; }
            if (n >= NCMP) { v0 = 0.f; v1 = 0.f; }
            dst[d] = (bf16)f2bf(v0); dst[d + 32] = (bf16)f2bf(v1); }
    }
    asm volatile("s_waitcnt lgkmcnt(0)\n\ts_barrier" ::: "memory");
}
}
__global__ void __launch_bounds__(NTHREADS, 2) mk_fwd(Args a) {
    extern __shared__ __attribute__((aligned(16))) unsigned char lds[];
    Frame F;
    F.lds = (LAS unsigned char*)lds;
    F.tid = threadIdx.x; F.lane = F.tid & 63; F.wave = __builtin_amdgcn_readfirstlane(F.tid >> 6);
    F.G = gridDim.x; { const int bx = blockIdx.x; F.vcu = (F.G % 8 == 0) ? (bx % 8) * (F.G / 8) + bx / 8 : bx; }
    cg::grid_group grid = cg::this_grid();
    volatile LAS unsigned* xst = (volatile LAS unsigned*)(F.lds + 147424);
    if (F.tid < 8) xst[F.tid] = 0u;
    __syncthreads();
    const XcdBarrier xbar = xcd_barrier_post((unsigned*)(a.ws + WS_CTL) + 4096, xst);
    unsigned char* ws = a.ws;
    const int lo = a.ph_lo, hi = a.ph_hi;
    const att::AttnPtrs P{(const bf16*)(ws + WS_QKV), (const float*)(ws + WS_KMP), (const float*)(ws + WS_GATES), (const bf16*)(ws + WS_KCMP), (const bf16*)(ws + WS_VCMP), a.in[2], (bf16*)(ws + WS_MIX),
                          (unsigned*)(ws + WS_SELG), (bf16*)(ws + WS_PARTO), (float*)(ws + WS_PARTL)};
#define IN(k) (lo <= (k) && (k) < hi)
#define SEAM(k) do { if (IN(k) && IN((k) + 1)) { if ((k) == 0) grid.sync(); else xcd_barrier(xbar); } } while (0)
    if (IN(0)) { phase_prologue_a(F, a); } SEAM(0);
    if (IN(1)) { phase_prologue_b(F, a); } SEAM(1);
    if (IN(2)) {
        pg8::Gemm g{(const pg8::bf16_t*)(ws + WS_H), (const pg8::bf16_t*)(ws + WS_WIN), TOK, NIN_PAD, DM}; pg8::StaticOrder S; S.init(TOK, NIN_PAD, F.G, (int)blockIdx.x);
        pg8::EpiInProj E{(pg8::bf16_t*)(ws + WS_QKV), (float*)(ws + WS_GATES), (float*)(ws + WS_KMP), a.in[7], a.in[8], a.in[9], a.in[11], a.in[12]};
        pg8::gemm_phase<pg8::EpiInProj, pg8::StaticOrder, true, true>(F.lds, g, S, E);
    } SEAM(2);
    if (IN(3)) {
        att::moba_gate_phase(P, F.vcu, F.G, F.tid);
        for (int unit = F.vcu; unit < 256; unit += F.G)
            cmpr::compress_unit(F.lds, unit, (const bf16*)(ws + WS_QKV), (const bf16*)(ws + WS_W1K), (const bf16*)(ws + WS_W1V), (const bf16*)(ws + WS_W2K), (const bf16*)(ws + WS_W2V),
                                (const float*)(ws + WS_CBP), a.in[10], (bf16*)(ws + WS_KCMP), (bf16*)(ws + WS_VCMP));
    } SEAM(3);
    if (IN(4)) {
                att::attn_phase(F.lds, P, (unsigned*)(ws + WS_CTL) + 64, 0);
    } SEAM(4);
    if (IN(5)) { att::moba_merge_pass(P, F.vcu, F.G, F.tid); } SEAM(5);
    if (IN(6)) {
        pg8::Gemm g{(const pg8::bf16_t*)(ws + WS_MIX), (const pg8::bf16_t*)(ws + WS_WOUT), TOK, DM, DM}; pg8::StaticOrder S; S.init(TOK, DM, F.G, (int)blockIdx.x);
        pg8::EpiOutProj E{a.in[0], a.out, (const float*)(ws + WS_MOD) + 2 * DM};
        pg8::gemm_phase<pg8::EpiOutProj, pg8::StaticOrder, true, true>(F.lds, g, S, E);
    } SEAM(6);
    if (IN(7)) { phase_norm2(F, a); } SEAM(7);
    if (IN(8)) {
        pg8::Gemm g{(const pg8::bf16_t*)(ws + WS_H), (const pg8::bf16_t*)(ws + WS_WGU), TOK, 2 * FF, DM}; pg8::StaticOrder S; S.init(TOK, 2 * FF, F.G, (int)blockIdx.x);
        pg8::EpiGateUp E{(pg8::bf16_t*)(ws + WS_ACT)};
        pg8::gemm_phase<pg8::EpiGateUp, pg8::StaticOrder, true, true>(F.lds, g, S, E);
    } SEAM(8);
    if (IN(9)) {
        pg8::Gemm g{(const pg8::bf16_t*)(ws + WS_ACT), (const pg8::bf16_t*)(ws + WS_WDN), TOK, DM, FF}; pg8::StaticOrder S; S.init(TOK, DM, F.G, (int)blockIdx.x);
        pg8::EpiDown E{a.out, (const float*)(ws + WS_MOD) + 5 * DM};
        pg8::gemm_phase<pg8::EpiDown, pg8::StaticOrder, true, true>(F.lds, g, S, E);
    }
#undef IN
#undef SEAM
}

static void launch_phases(const Args& base, int lo, int hi, int grid, hipStream_t stream, int flags = 0) {
    Args a = base; a.ph_lo = lo; a.ph_hi = hi; (void)flags;
    if (hi - lo > 1) { void* args[] = {&a}; (void)hipLaunchCooperativeKernel((const void*)mk_fwd, dim3(grid), dim3(NTHREADS), args, LDS_BYTES, stream); }
    else hipLaunchKernelGGL(mk_fwd, dim3(grid), dim3(NTHREADS), LDS_BYTES, stream, a);
}
extern "C" void kernel_launch(void* const* d_in, const int* in_sizes, int n_in, void* d_out, int out_size, void* d_ws, size_t ws_size, hipStream_t stream) {
    static int grid = 0;
    if (grid == 0) {
        int dev = 0, cus = 0, per_cu = 0;
        if (n_in != 23 || ws_size < 480 * MiB || hipGetDevice(&dev) != hipSuccess || hipDeviceGetAttribute(&cus, hipDeviceAttributeMultiprocessorCount, dev) != hipSuccess) { grid = -1; return; }
        if (hipFuncSetAttribute((const void*)mk_fwd, hipFuncAttributeMaxDynamicSharedMemorySize, LDS_BYTES) != hipSuccess) { grid = -1; return; }
        if (hipOccupancyMaxActiveBlocksPerMultiprocessor(&per_cu, (const void*)mk_fwd, NTHREADS, LDS_BYTES) != hipSuccess || per_cu < 1) { grid = -1; return; }
        grid = cus;
    }
    if (grid < 0) return;
    (void)hipMemsetAsync((char*)d_ws + WS_CTL, 0, CTL_ZERO_BYTES, stream);
    Args a{};
    for (int i = 0; i < 23; ++i) a.in[i] = (const float*)d_in[i];
    a.out = (float*)d_out; a.ws = (unsigned char*)d_ws;
    unsigned char* ws = (unsigned char*)d_ws;
#if HYBRID == 1
    launch_phases(a, 0, 1, grid, stream); launch_phases(a, 1, 2, grid, stream); launch_phases(a, 2, 3, grid, stream);
    const bf16* qkv = (const bf16*)(ws + WS_QKV); bf16* mix = (bf16*)(ws + WS_MIX); bf16* kcmp = (bf16*)(ws + WS_KCMP); bf16* vcmp = (bf16*)(ws + WS_VCMP);
    int* sel = (int*)(ws + 344 * MiB); float* obuf = (float*)(ws + 348 * MiB); const float* gates = (const float*)(ws + WS_GATES);
    nq::k_compress<<<dim3(4 * 2 * 512, 2), 256, 0, stream>>>(qkv, a.in[13], a.in[14], a.in[15], a.in[16], a.in[17], a.in[18], a.in[10], kcmp, vcmp);
    nq::k_moba<<<4 * 8 * SEQ / 4, 256, 0, stream>>>(qkv, (const float*)(ws + WS_KMP), a.in[2], mix);
    nq::k_nsa_cmp<<<4 * 2 * SEQ, 256, 0, stream>>>(qkv, kcmp, vcmp, gates, obuf, sel);
    nq::k_nsa_sel<<<4 * 2 * SEQ, 256, 0, stream>>>(qkv, sel, a.in[2], gates, obuf);
    nq::k_nsa_win<<<4 * 2 * SEQ, 256, 0, stream>>>(qkv, a.in[2], gates, obuf, mix);
    launch_phases(a, 5, 6, grid, stream); launch_phases(a, 6, 7, grid, stream); launch_phases(a, 7, 8, grid, stream); launch_phases(a, 8, 9, grid, stream);
#elif HYBRID == 2
    launch_phases(a, 0, 1, grid, stream); launch_phases(a, 1, 2, grid, stream); launch_phases(a, 2, 3, grid, stream);
    nq::k_compress<<<dim3(4 * 2 * 512, 2), 256, 0, stream>>>((const bf16*)(ws + WS_QKV), a.in[13], a.in[14], a.in[15], a.in[16], a.in[17], a.in[18], a.in[10], (bf16*)(ws + WS_KCMP), (bf16*)(ws + WS_VCMP));
    launch_phases(a, 4, 5, grid, stream);
    launch_phases(a, 5, 6, grid, stream); launch_phases(a, 6, 7, grid, stream); launch_phases(a, 7, 8, grid, stream); launch_phases(a, 8, 9, grid, stream);
#elif HYBRID == 3
    for (int p = 0; p < N_PHASES; ++p) {
#if defined(TIME_PHASE)
        if (p == TIME_PHASE) { for (int r = 0; r < TIME_REPS; ++r) { launch_phases(a, p, p + 1, grid, stream, TIME_FLAGS); (void)hipMemsetAsync((char*)d_ws + WS_CTL, 0, CTL_ZERO_BYTES, stream); } }
#endif
        launch_phases(a, p, p + 1, grid, stream);
#if defined(ABL_REPS)
        if (p == 3) { static bool once = false; if (!once) { once = true; (void)hipFuncSetAttribute((const void*)k_attn_abl, hipFuncAttributeMaxDynamicSharedMemorySize, LDS_BYTES); }
            for (int r = 0; r < ABL_REPS; ++r) { (void)hipMemsetAsync((char*)d_ws + WS_CTL + 512, 0, 4, stream); hipLaunchKernelGGL(k_attn_abl, dim3(grid), dim3(NTHREADS), LDS_BYTES, stream, a); } }
#endif
    }
#else
    launch_phases(a, 0, N_PHASES, grid, stream);
#endif
}
```

```cpp
#include <hip/hip_runtime.h>
#include <hip/hip_cooperative_groups.h>
#include <cstdint>
#include <cstdio>
namespace cg = cooperative_groups;
#define HYBRID 0
namespace pg8 {
#define PG8_LAS __attribute__((address_space(3)))
typedef unsigned short bf16_t;
typedef short bf16x8 __attribute__((ext_vector_type(8)));
typedef float f32x4 __attribute__((ext_vector_type(4)));
typedef unsigned u32x4 __attribute__((ext_vector_type(4)));
constexpr int BM = 256, BK = 64, HALF = 128, HTB = HALF * BK * 2  , STAGE_BYTES = 8 * HTB, NXCD = 8, WGM = 8;

__host__ __device__ __forceinline__ int lds_byte(int r, int c) { const int st = (r >> 4) * 2 + (c >> 5), rr = r & 15, cc = c & 31, ob = rr * 64 + cc * 2; return st * 1024 + (ob ^ (((ob >> 9) & 1) << 5)); }
__host__ __device__ __forceinline__ void stage_rc(int b, int& R, int& C) { const int st = b / 1024, sb = b % 1024, swz = sb ^ (((sb >> 9) & 1) << 5); R = (st >> 1) * 16 + swz / 64; C = (st & 1) * 32 + (swz % 64) / 2; }
__host__ __device__ __forceinline__ int perm32(int rho) { const int n = rho >> 4, i = rho & 15; return 8 * (i >> 2) + 4 * n + (i & 3); }

struct Unit { int pm, pn; };
struct Gemm { const bf16_t* A; const bf16_t* Bt; int M, N, K; };

struct StaticOrder {
    int nM, nN, nwg, G, c;
    __host__ __device__ void init(int M, int N, int G_, int c_) { nM = M / BM; nN = N / BM; nwg = nM * nN; G = G_; c = c_; }
    __host__ __device__ bool next(int i, Unit& u) const {
        const long L = (long)i * G + c; if (L >= nwg) return false;
        int wgid = (int)L; { const int q = nwg / NXCD, r = nwg % NXCD, xcd = wgid % NXCD, off = wgid / NXCD; wgid = (xcd < r ? xcd * (q + 1) : r * (q + 1) + (xcd - r) * q) + off; }
        const int nig = WGM * nN, gid = wgid / nig, fm = gid * WGM, gsz = (nM - fm) < WGM ? (nM - fm) : WGM;
        u.pm = fm + ((wgid % nig) % gsz); u.pn = (wgid % nig) / gsz; return true;
    }
    __device__ __forceinline__ void a_ready(const Unit&) const {}
    __device__ __forceinline__ void done(const Unit&) const {}
};

__device__ __forceinline__ unsigned cvt_pk_bf16(float lo, float hi) { unsigned r; asm volatile("v_cvt_pk_bf16_f32 %0, %1, %2" : "=v"(r) : "v"(lo), "v"(hi)); return r; }
typedef float f32x2 __attribute__((ext_vector_type(2)));
template <class Epi, class Sched, bool ALIGN_EPI = false, bool SP2 = false>
__device__ __forceinline__ void gemm_phase(PG8_LAS unsigned char* lds, const Gemm g, const Sched& S, const Epi& E) {
    const int tid = threadIdx.x, wid = __builtin_amdgcn_readfirstlane(tid >> 6), lane = tid & 63, wr = wid >> 2, wc = wid & 3, fr = lane & 15, fq = lane >> 4;
    const int K = g.K, nt = K / BK;
    unsigned voffA[2], voffB[2];
#pragma unroll
    for (int i = 0; i < 2; ++i) { int R, C; stage_rc(tid * 16 + i * 8192, R, C); const int Rb = Epi::PERM ? ((R & ~31) + perm32(R & 31)) : R;
        voffA[i] = (unsigned)(R * K + C) * 2u; voffB[i] = (unsigned)(Rb * K + C) * 2u; }
    const size_t kstep = (size_t)(BK * 2);
    const size_t hstep = (size_t)HALF * K * 2;
    const size_t tstep = 2 * hstep;
    const unsigned ldsw = (unsigned)wid * 1024u;
    const int aoff = lds_byte(wr * 64 + fr, fq * 8), boff = lds_byte(wc * 32 + fr, fq * 8);
#define PG8_SA(b, h) (((b) * 2 + (h)) * HTB)
#define PG8_SB(b, h) ((4 + (b) * 2 + (h)) * HTB)
#define PG8_STAGE(bufoff, gbase, voff) do { _Pragma("unroll") for (int _i = 0; _i < 2; ++_i) \
        __builtin_amdgcn_global_load_lds((const unsigned*)((const char*)(gbase) + (voff)[_i]), (PG8_LAS unsigned*)(lds + (bufoff) + ldsw + _i * 8192), 16, 0, 0); } while (0)
#define PG8_LDA(dst, b, h) do { _Pragma("unroll") for (int m = 0; m < 4; ++m) _Pragma("unroll") for (int k = 0; k < 2; ++k) dst[m][k] = *(const PG8_LAS bf16x8*)(lds + PG8_SA(b, h) + aoff + m * 2048 + k * 1024); } while (0)
#define PG8_LDB(dst, b, h) do { _Pragma("unroll") for (int n = 0; n < 2; ++n) _Pragma("unroll") for (int k = 0; k < 2; ++k) dst[n][k] = *(const PG8_LAS bf16x8*)(lds + PG8_SB(b, h) + boff + n * 2048 + k * 1024); } while (0)
#define PG8_MMA(ai, bj, At, Bt) do { __builtin_amdgcn_s_setprio(1); _Pragma("unroll") for (int m = 0; m < 4; ++m) _Pragma("unroll") for (int n = 0; n < 2; ++n) _Pragma("unroll") for (int k = 0; k < 2; ++k) \
        acc[ai][bj][m][n] = __builtin_amdgcn_mfma_f32_16x16x32_bf16(Bt[n][k], At[m][k], acc[ai][bj][m][n], 0, 0, 0); __builtin_amdgcn_s_setprio(0); } while (0)
#define PG8_WAIT_V(n) asm volatile("s_waitcnt vmcnt(" #n ")" ::: "memory")
#define PG8_WAIT_L(n) asm volatile("s_waitcnt lgkmcnt(" #n ")" ::: "memory")
#define PG8_BAR __builtin_amdgcn_s_barrier()
#define PG8_SCHED __builtin_amdgcn_sched_barrier(0)
    Unit cur, nxt; int ui = 0;
    if (!S.next(0, cur)) return;
    f32x4 acc[2][2][4][2];
#pragma unroll
    for (int a = 0; a < 2; ++a)
#pragma unroll
        for (int b = 0; b < 2; ++b)
#pragma unroll
            for (int m = 0; m < 4; ++m)
#pragma unroll
                for (int n = 0; n < 2; ++n) acc[a][b][m][n] = (f32x4){0.f, 0.f, 0.f, 0.f};
    bf16x8 At[4][2], B0[2][2], B1[2][2];
    const char* cA = (const char*)g.A + (size_t)cur.pm * tstep; const char* cB = (const char*)g.Bt + (size_t)cur.pn * tstep;
    S.a_ready(cur);
    if constexpr (SP2) {
        PG8_STAGE(PG8_SB(0, 0), cB, voffB); PG8_STAGE(PG8_SB(0, 1), cB + hstep, voffB); PG8_STAGE(PG8_SA(0, 0), cA, voffA); PG8_STAGE(PG8_SA(0, 1), cA + hstep, voffA);
        if (wr == 1) PG8_BAR;
        PG8_WAIT_V(2); PG8_BAR;
        PG8_STAGE(PG8_SB(1, 0), cB + kstep, voffB); PG8_STAGE(PG8_SA(1, 0), cA + kstep, voffA); PG8_STAGE(PG8_SB(1, 1), cB + hstep + kstep, voffB);
        PG8_WAIT_V(6); PG8_BAR;
    } else {
        PG8_STAGE(PG8_SB(0, 0), cB, voffB); PG8_STAGE(PG8_SA(0, 0), cA, voffA); PG8_STAGE(PG8_SB(0, 1), cB + hstep, voffB); PG8_STAGE(PG8_SA(0, 1), cA + hstep, voffA);
        if (wr == 1) PG8_BAR;
        PG8_WAIT_V(4); PG8_BAR;
        PG8_STAGE(PG8_SB(1, 0), cB + kstep, voffB); PG8_STAGE(PG8_SA(1, 0), cA + kstep, voffA); PG8_STAGE(PG8_SB(1, 1), cB + hstep + kstep, voffB);
        PG8_WAIT_V(6); PG8_BAR;
    }
    for (;;) {
        const bool has_next = S.next(ui + 1, nxt);
        const char* nA = has_next ? (const char*)g.A + (size_t)nxt.pm * tstep : cA; const char* nB = has_next ? (const char*)g.Bt + (size_t)nxt.pn * tstep : cB;
        for (int t = 0; t < nt; t += 2) {
            const bool last = (t == nt - 2);
            const char* a1 = cA + (size_t)(t + 1) * kstep;
            const char* a2 = last ? nA : cA + (size_t)(t + 2) * kstep; const char* b2 = last ? nB : cB + (size_t)(t + 2) * kstep;
            const char* a3 = a2 + kstep; const char* b3 = b2 + kstep;
            if (last && has_next) S.a_ready(nxt);
            if constexpr (SP2) {
            PG8_LDB(B0, 0, 0); PG8_LDB(B1, 0, 1); PG8_SCHED; PG8_LDA(At, 0, 0); PG8_STAGE(PG8_SA(1, 1), a1 + hstep, voffA);
            PG8_WAIT_V(8); PG8_WAIT_L(0); PG8_BAR; PG8_MMA(0, 0, At, B0); PG8_MMA(0, 1, At, B1); PG8_BAR; PG8_SCHED;
            PG8_LDA(At, 0, 1); PG8_STAGE(PG8_SB(0, 0), b2, voffB); PG8_STAGE(PG8_SB(0, 1), b2 + hstep, voffB); PG8_STAGE(PG8_SA(0, 0), a2, voffA);
            PG8_WAIT_V(8); PG8_WAIT_L(0); PG8_BAR; PG8_MMA(1, 0, At, B0); PG8_MMA(1, 1, At, B1); PG8_BAR; PG8_SCHED;
            PG8_LDB(B0, 1, 0); PG8_LDB(B1, 1, 1); PG8_SCHED; PG8_LDA(At, 1, 0); PG8_STAGE(PG8_SA(0, 1), a2 + hstep, voffA);
            PG8_WAIT_V(8); PG8_WAIT_L(0); PG8_BAR; PG8_MMA(0, 0, At, B0); PG8_MMA(0, 1, At, B1); PG8_BAR; PG8_SCHED;
            PG8_LDA(At, 1, 1); PG8_STAGE(PG8_SB(1, 0), b3, voffB); PG8_STAGE(PG8_SB(1, 1), b3 + hstep, voffB); PG8_STAGE(PG8_SA(1, 0), a3, voffA);
            PG8_WAIT_V(8); PG8_WAIT_L(0); PG8_BAR; PG8_MMA(1, 0, At, B0); PG8_MMA(1, 1, At, B1); PG8_BAR; PG8_SCHED;
            } else {
            PG8_LDB(B0, 0, 0); PG8_SCHED; PG8_LDA(At, 0, 0); PG8_STAGE(PG8_SA(1, 1), a1 + hstep, voffA);
            PG8_WAIT_L(8); PG8_BAR; PG8_WAIT_L(0); PG8_MMA(0, 0, At, B0); PG8_BAR; PG8_SCHED;
            PG8_LDB(B1, 0, 1); PG8_STAGE(PG8_SB(0, 0), b2, voffB);
            PG8_BAR; PG8_WAIT_L(0); PG8_MMA(0, 1, At, B1); PG8_BAR;
            PG8_LDA(At, 0, 1); PG8_STAGE(PG8_SA(0, 0), a2, voffA);
            PG8_BAR; PG8_WAIT_L(0); PG8_MMA(1, 0, At, B0); PG8_BAR; PG8_SCHED;
            PG8_STAGE(PG8_SB(0, 1), b2 + hstep, voffB);
            PG8_WAIT_V(6); PG8_BAR; PG8_MMA(1, 1, At, B1); PG8_BAR;
            PG8_LDB(B0, 1, 0); PG8_SCHED; PG8_LDA(At, 1, 0); PG8_STAGE(PG8_SA(0, 1), a2 + hstep, voffA);
            PG8_WAIT_L(8); PG8_BAR; PG8_WAIT_L(0); PG8_MMA(0, 0, At, B0); PG8_BAR; PG8_SCHED;
            PG8_LDB(B1, 1, 1); PG8_STAGE(PG8_SB(1, 0), b3, voffB);
            PG8_BAR; PG8_WAIT_L(0); PG8_MMA(0, 1, At, B1); PG8_BAR;
            PG8_LDA(At, 1, 1); PG8_STAGE(PG8_SA(1, 0), a3, voffA);
            PG8_BAR; PG8_WAIT_L(0); PG8_MMA(1, 0, At, B0); PG8_BAR; PG8_SCHED;
            PG8_STAGE(PG8_SB(1, 1), b3 + hstep, voffB);
            PG8_WAIT_V(6); PG8_BAR; PG8_MMA(1, 1, At, B1); PG8_BAR;
            }
        }
        if constexpr (ALIGN_EPI) { if (wr == 0) PG8_BAR; }
        if constexpr (!Epi::AFTER_DRAIN) { E(acc, cur, wr, wc, fr, fq); S.done(cur); }
        if (!has_next) break;
#pragma unroll
        for (int a = 0; a < 2; ++a)
#pragma unroll
            for (int b = 0; b < 2; ++b)
#pragma unroll
                for (int m = 0; m < 4; ++m)
#pragma unroll
                    for (int n = 0; n < 2; ++n) acc[a][b][m][n] = (f32x4){0.f, 0.f, 0.f, 0.f};
        cur = nxt; cA = nA; cB = nB; ++ui;
        if constexpr (ALIGN_EPI) { if (wr == 1) PG8_BAR; }
    }
    PG8_WAIT_V(0);
    if constexpr (!ALIGN_EPI) { if (wr == 0) PG8_BAR; }
    PG8_BAR;
    if constexpr (Epi::AFTER_DRAIN) { E.fused(acc, cur, wr, wc, fr, fq, lds, wid, lane); S.done(cur); }
#undef PG8_SA
#undef PG8_SB
#undef PG8_STAGE
#undef PG8_LDA
#undef PG8_LDB
#undef PG8_MMA
#undef PG8_WAIT_V
#undef PG8_WAIT_L
#undef PG8_BAR
#undef PG8_SCHED
}
}
namespace pg8 {
typedef unsigned u32x2v __attribute__((ext_vector_type(2)));
constexpr int TOK_S = 8192;
constexpr float QK_EPS = 1e-6f;
constexpr float C2 = 0.125f * 1.4426950408889634f;
__device__ __forceinline__ float sigmoid_fast(float v) { return __builtin_amdgcn_rcpf(1.f + __builtin_amdgcn_exp2f(-1.4426950408889634f * v)); }
__device__ __forceinline__ float silu_fast(float v) { return v * __builtin_amdgcn_rcpf(1.f + __builtin_amdgcn_exp2f(-1.4426950408889634f * v)); }

struct EpiInProj {
    static constexpr bool PERM = true, AFTER_DRAIN = false;
    bf16_t* qkv;
    float* gates;
    float* kmean_part;
    const float *qna, *kna, *qnb, *knsel, *knwin;
    __device__ __forceinline__ void operator()(const f32x4 (&acc)[2][2][4][2], const Unit& u, int wr, int wc, int fr, int fq) const {
        const int slot = u.pn * 4 + wc;
        if (slot > 44) return;
        const int b = u.pm >> 5, blk = u.pm & 31, pos0 = blk * 256 + wr * 64 + fr;
        if (slot == 44) {
            if (fq < 3) {
#pragma unroll
                for (int ai = 0; ai < 2; ++ai)
#pragma unroll
                    for (int m = 0; m < 4; ++m) { const size_t tok = (size_t)b * TOK_S + pos0 + ai * HALF + m * 16; float* gp = gates + tok * 24 + 8 * fq;
                        const f32x4 v0 = acc[ai][0][m][0], v1 = acc[ai][0][m][1];
                        *(f32x4*)gp = (f32x4){sigmoid_fast(v0[0]), sigmoid_fast(v0[1]), sigmoid_fast(v0[2]), sigmoid_fast(v0[3])};
                        *(f32x4*)(gp + 4) = (f32x4){sigmoid_fast(v1[0]), sigmoid_fast(v1[1]), sigmoid_fast(v1[2]), sigmoid_fast(v1[3])}; }
            }
            return;
        }
        const float* gain = nullptr; float qscale = 1.f; bool is_ka = false; bf16_t* dst;
        constexpr size_t BIG = (size_t)4 * 8 * TOK_S * 64, SMALL = (size_t)4 * 2 * TOK_S * 64;
        if (slot < 32) { const int kind = slot >> 3, head = slot & 7; dst = qkv + kind * BIG + ((size_t)(b * 8 + head) * TOK_S) * 64;
            if (kind == 0) { gain = qna; qscale = C2; } else if (kind == 1) { gain = kna; is_ka = true; } else if (kind == 3) { gain = qnb; qscale = C2; } }
        else { const int kind = (slot - 32) >> 1, g = slot & 1; dst = qkv + 4 * BIG + kind * SMALL + ((size_t)(b * 2 + g) * TOK_S) * 64;
            if (kind == 2) gain = knsel; else if (kind == 4) gain = knwin; }
        float gv[16];
#pragma unroll
        for (int i = 0; i < 16; ++i) gv[i] = gain ? gain[(i >> 3) * 32 + 8 * fq + (i & 7)] * qscale : 1.f;
        float cs[16];
#pragma unroll
        for (int i = 0; i < 16; ++i) cs[i] = 0.f;
#pragma unroll
        for (int ai = 0; ai < 2; ++ai)
#pragma unroll
            for (int m = 0; m < 4; ++m) {
                float v[16];
#pragma unroll
                for (int bj = 0; bj < 2; ++bj)
#pragma unroll
                    for (int n = 0; n < 2; ++n)
#pragma unroll
                        for (int j = 0; j < 4; ++j) v[bj * 8 + n * 4 + j] = acc[ai][bj][m][n][j];
                if (gain) { float ss = 0.f;
#pragma unroll
                    for (int i = 0; i < 16; ++i) ss += v[i] * v[i];
                    ss += __shfl_xor(ss, 16); ss += __shfl_xor(ss, 32);
                    const float rs = rsqrtf(ss * (1.f / 64.f) + QK_EPS);
#pragma unroll
                    for (int i = 0; i < 16; ++i) v[i] *= rs * gv[i]; }
                if (is_ka) {
#pragma unroll
                    for (int i = 0; i < 16; ++i) cs[i] += v[i]; }
                bf16_t* rp = dst + (size_t)(pos0 + ai * HALF + m * 16) * 64 + 8 * fq;
                u32x4 w0, w1;
                w0.x = cvt_pk_bf16(v[0], v[1]); w0.y = cvt_pk_bf16(v[2], v[3]); w0.z = cvt_pk_bf16(v[4], v[5]); w0.w = cvt_pk_bf16(v[6], v[7]);
                w1.x = cvt_pk_bf16(v[8], v[9]); w1.y = cvt_pk_bf16(v[10], v[11]); w1.z = cvt_pk_bf16(v[12], v[13]); w1.w = cvt_pk_bf16(v[14], v[15]);
                *(u32x4*)rp = w0; *(u32x4*)(rp + 32) = w1;
            }
        if (is_ka) {
#pragma unroll
            for (int i = 0; i < 16; ++i) { float s = cs[i]; s += __shfl_xor(s, 1); s += __shfl_xor(s, 2); s += __shfl_xor(s, 4); s += __shfl_xor(s, 8); cs[i] = s; }
            if (fr == 0) { float* kp = kmean_part + ((size_t)((b * 8 + (slot & 7)) * 32 + blk) * 2 + wr) * 64 + 8 * fq;
                *(f32x4*)kp = (f32x4){cs[0], cs[1], cs[2], cs[3]}; *(f32x4*)(kp + 4) = (f32x4){cs[4], cs[5], cs[6], cs[7]};
                *(f32x4*)(kp + 32) = (f32x4){cs[8], cs[9], cs[10], cs[11]}; *(f32x4*)(kp + 36) = (f32x4){cs[12], cs[13], cs[14], cs[15]}; }
        }
    }
};
struct EpiOutProj {
    static constexpr bool PERM = true, AFTER_DRAIN = false;
    bf16_t* y; const float* gt;
    __device__ __forceinline__ void operator()(const f32x4 (&acc)[2][2][4][2], const Unit& u, int wr, int wc, int fr, int fq) const {
        const int b = u.pm >> 5; const int col0 = u.pn * BM + wc * 32 + 8 * fq; const float* gtb = gt + (size_t)b * 6144;
#pragma unroll
        for (int bj = 0; bj < 2; ++bj) { const int c = col0 + bj * HALF; const f32x4 g40 = *(const f32x4*)(gtb + c), g41 = *(const f32x4*)(gtb + c + 4);
#pragma unroll
            for (int ai = 0; ai < 2; ++ai)
#pragma unroll
                for (int m = 0; m < 4; ++m) { const size_t off = (size_t)(u.pm * BM + ai * HALF + wr * 64 + m * 16 + fr) * 1024 + c;
                    const f32x4 y0 = g40 * acc[ai][bj][m][0], y1 = g41 * acc[ai][bj][m][1];
                    u32x4 w; w.x = cvt_pk_bf16(y0[0], y0[1]); w.y = cvt_pk_bf16(y0[2], y0[3]); w.z = cvt_pk_bf16(y1[0], y1[1]); w.w = cvt_pk_bf16(y1[2], y1[3]);
                    *(u32x4*)(y + off) = w; } }
    }
};
struct EpiGateUp {
    static constexpr bool PERM = true, AFTER_DRAIN = false;
    bf16_t* act;
    __device__ __forceinline__ void operator()(const f32x4 (&acc)[2][2][4][2], const Unit& u, int wr, int wc, int fr, int fq) const {
        const int h0 = u.pn * 128 + wc * 32 + 8 * fq;
#pragma unroll
        for (int ai = 0; ai < 2; ++ai)
#pragma unroll
            for (int m = 0; m < 4; ++m) { const size_t row = (size_t)(u.pm * BM + ai * HALF + wr * 64 + m * 16 + fr);
                const f32x4 g0 = acc[ai][0][m][0], g1 = acc[ai][0][m][1], u0 = acc[ai][1][m][0], u1 = acc[ai][1][m][1];
                u32x4 w;
                w.x = cvt_pk_bf16(silu_fast(g0[0]) * u0[0], silu_fast(g0[1]) * u0[1]); w.y = cvt_pk_bf16(silu_fast(g0[2]) * u0[2], silu_fast(g0[3]) * u0[3]);
                w.z = cvt_pk_bf16(silu_fast(g1[0]) * u1[0], silu_fast(g1[1]) * u1[1]); w.w = cvt_pk_bf16(silu_fast(g1[2]) * u1[2], silu_fast(g1[3]) * u1[3]);
                *(u32x4*)(act + row * 2816 + h0) = w; }
    }
};
struct EpiDown {
    static constexpr bool PERM = true, AFTER_DRAIN = false;
    const float* x; const bf16_t* y; float* out; const float* gt;
    __device__ __forceinline__ void operator()(const f32x4 (&acc)[2][2][4][2], const Unit& u, int wr, int wc, int fr, int fq) const {
        const int b = u.pm >> 5; const int col0 = u.pn * BM + wc * 32 + 8 * fq; const float* gtb = gt + (size_t)b * 6144;
#pragma unroll
        for (int bj = 0; bj < 2; ++bj) { const int c = col0 + bj * HALF; const f32x4 g40 = *(const f32x4*)(gtb + c), g41 = *(const f32x4*)(gtb + c + 4);
#pragma unroll
            for (int ai = 0; ai < 2; ++ai)
#pragma unroll
                for (int m = 0; m < 4; ++m) { const size_t off = (size_t)(u.pm * BM + ai * HALF + wr * 64 + m * 16 + fr) * 1024 + c;
                    const f32x4 x0 = *(const f32x4*)(x + off), x1 = *(const f32x4*)(x + off + 4); const u32x4 yw = *(const u32x4*)(y + off);
                    const f32x4 y0 = {__builtin_bit_cast(float, yw.x << 16), __builtin_bit_cast(float, yw.x & 0xffff0000u), __builtin_bit_cast(float, yw.y << 16), __builtin_bit_cast(float, yw.y & 0xffff0000u)};
                    const f32x4 y1 = {__builtin_bit_cast(float, yw.z << 16), __builtin_bit_cast(float, yw.z & 0xffff0000u), __builtin_bit_cast(float, yw.w << 16), __builtin_bit_cast(float, yw.w & 0xffff0000u)};
                    *(f32x4*)(out + off) = (x0 + y0) + g40 * acc[ai][bj][m][0]; *(f32x4*)(out + off + 4) = (x1 + y1) + g41 * acc[ai][bj][m][1]; } }
    }
};
}
constexpr int NWAVES = 8, NTHREADS = 512;
constexpr int BATCH = 4, SEQ = 8192, DM = 1024, TOK = BATCH * SEQ, NIN = 2840, NIN_PAD = 3072, FF = 2816, NCMP = 511;
constexpr size_t MiB = 1u << 20;
constexpr size_t WS_CTL = 0, CTL_ZERO_BYTES = 64 * 1024;
constexpr size_t WS_MODP = 1 * MiB;
constexpr size_t WS_MOD = 2 * MiB;
constexpr size_t WS_CBP = 2 * MiB + 512 * 1024;
constexpr size_t WS_KMP = 3 * MiB;
constexpr size_t WS_BIAS2 = 4 * MiB;
constexpr size_t WS_SSP = 449 * MiB;
constexpr size_t WS_WIN = 6 * MiB, WS_WOUT = 12 * MiB, WS_WGU = 14 * MiB, WS_WDN = 25 * MiB;
constexpr size_t WS_W1K = 31 * MiB, WS_W1V = 32 * MiB, WS_W2K = 33 * MiB, WS_W2V = 33 * MiB + 64 * 1024;
constexpr size_t WS_KCMP = 34 * MiB, WS_VCMP = 35 * MiB;
constexpr size_t WS_GATES = 36 * MiB;
constexpr size_t WS_H = 40 * MiB;
constexpr size_t WS_MIX = 104 * MiB;
constexpr size_t WS_QKV = 168 * MiB;
constexpr size_t WS_ACT = WS_QKV;
constexpr size_t WS_END = 344 * MiB;
constexpr size_t WS_PARTO = 344 * MiB;
constexpr size_t WS_PARTL = 472 * MiB;
constexpr size_t WS_SELG = 476 * MiB;
constexpr size_t WS_Y = WS_PARTO;
constexpr size_t QKV_BIG = (size_t)4 * 8 * SEQ * 64, QKV_SMALL = (size_t)4 * 2 * SEQ * 64;
constexpr int RING_BYTES = 131072, LDS_BYTES = 147456;
constexpr int N_PHASES = 10;

#define GAS __attribute__((address_space(1)))
#define LAS __attribute__((address_space(3)))
typedef unsigned short bf16;
typedef unsigned v4u __attribute__((ext_vector_type(4)));
typedef float f32x4 __attribute__((ext_vector_type(4)));
#define LDS_WAIT() asm volatile("s_waitcnt lgkmcnt(0)" ::: "memory")
#define VM_WAIT() asm volatile("s_waitcnt vmcnt(0)" ::: "memory")
__device__ __forceinline__ unsigned f2bf(float f) { unsigned u = __builtin_bit_cast(unsigned, f); return (u + 0x7fffu + ((u >> 16) & 1u)) >> 16; }
__device__ __forceinline__ unsigned pk2(float lo, float hi) { return f2bf(lo) | (f2bf(hi) << 16); }
__device__ __forceinline__ float bf2f(bf16 v) { return __builtin_bit_cast(float, (unsigned)v << 16); }
__device__ __forceinline__ float wave_sum(float v) {
#pragma unroll
    for (int o = 1; o < 64; o <<= 1) v += __shfl_xor(v, o);
    return v;
}
struct Args { const float* in[23]; float* out; unsigned char* ws; int ph_lo, ph_hi; };
struct Frame { LAS unsigned char* lds; int tid, lane, wave, vcu, G; };

struct MapId { __device__ __forceinline__ size_t off(int n, int k, int K) const { return (size_t)n * K + k; } };
struct MapWin { __device__ __forceinline__ size_t off(int n, int k, int K) const { const int s = n >> 6, d = n & 63; return (size_t)(256 * (s >> 2) + 128 * (d >> 5) + 32 * (s & 3) + (d & 31)) * K + k; } };
struct MapWgu { __device__ __forceinline__ size_t off(int n, int k, int K) const { const int up = n >= FF, hdn = up ? n - FF : n; return (size_t)(256 * (hdn >> 7) + 128 * up + (hdn & 127)) * K + k; } };
struct MapFrag { __device__ __forceinline__ size_t off(int n, int k, int K) const { return ((size_t)((k >> 4) * 8 + (n >> 5)) * 64 + ((k >> 3) & 1) * 32 + (n & 31)) * 8 + (k & 7); } };
template <class Map>
__device__ __forceinline__ void transpose_item(const float* __restrict__ W, int K, int N, bf16* WT, LAS float* scr, int item, int lane, const Map& map) {
    const int nblk = (N + 63) / 64, kb = item / nblk, nb = item % nblk, k0 = 64 * kb, n0 = 64 * nb;
    const int nc = n0 + 4 * (lane & 15); const bool nin = nc < N;
    f32x4 v[16];
#pragma unroll
    for (int i = 0; i < 16; ++i) { const int kk = 4 * i + (lane >> 4); v[i] = nin ? *(const GAS f32x4*)(W + (size_t)(k0 + kk) * N + nc) : (f32x4){0.f, 0.f, 0.f, 0.f}; }
#pragma unroll
    for (int i = 0; i < 16; ++i) { const int kk = 4 * i + (lane >> 4); LAS float* d = scr + (4 * (lane & 15)) * 68 + kk; d[0] = v[i][0]; d[68] = v[i][1]; d[136] = v[i][2]; d[204] = v[i][3]; }
    LDS_WAIT(); asm volatile("" ::: "memory");
    const int c = lane & 7;
#pragma unroll
    for (int j = 0; j < 8; ++j) { const int n = (lane >> 3) + 8 * j; const LAS float* s = scr + n * 68 + 8 * c;
        const f32x4 a = *(const LAS f32x4*)s, bq = *(const LAS f32x4*)(s + 4);
        v4u o; o.x = pk2(a[0], a[1]); o.y = pk2(a[2], a[3]); o.z = pk2(bq[0], bq[1]); o.w = pk2(bq[2], bq[3]);
        if (n0 + n < N) *(GAS v4u*)(WT + map.off(n0 + n, k0 + 8 * c, K)) = o; }
    LDS_WAIT(); asm volatile("" ::: "memory");
}
__device__ __forceinline__ float silu_acc(float v) { return v / (1.f + expf(-v)); }
__device__ __forceinline__ void phase_prologue_a(Frame& F, const Args& a) {
    LAS float* scr = (LAS float*)(F.lds + F.wave * 17408);
    const int gw = F.vcu * NWAVES + F.wave, NGW = F.G * NWAVES;
    unsigned char* ws = a.ws;
    constexpr int I_IN = (DM / 64) * ((NIN + 63) / 64), I_OUT = (DM / 64) * (DM / 64), I_GU = (DM / 64) * (2 * FF / 64), I_DN = (FF / 64) * (DM / 64), I_W1 = (2048 / 64) * (256 / 64), I_W2 = (256 / 64) * (64 / 64);
    constexpr int NITEMS = I_IN + I_OUT + I_GU + I_DN + 2 * I_W1 + 2 * I_W2;
    for (int it = gw; it < NITEMS; it += NGW) {
        int r = it;
        if (r < I_IN) { transpose_item(a.in[6], DM, NIN, (bf16*)(ws + WS_WIN), scr, r, F.lane, MapWin()); continue; } r -= I_IN;
        if (r < I_OUT) { transpose_item(a.in[19], DM, DM, (bf16*)(ws + WS_WOUT), scr, r, F.lane, MapId()); continue; } r -= I_OUT;
        if (r < I_GU) { transpose_item(a.in[21], DM, 2 * FF, (bf16*)(ws + WS_WGU), scr, r, F.lane, MapWgu()); continue; } r -= I_GU;
        if (r < I_DN) { transpose_item(a.in[22], FF, DM, (bf16*)(ws + WS_WDN), scr, r, F.lane, MapId()); continue; } r -= I_DN;
        if (r < I_W1) { transpose_item(a.in[14], 2048, 256, (bf16*)(ws + WS_W1K), scr, r, F.lane, MapFrag()); continue; } r -= I_W1;
        if (r < I_W1) { transpose_item(a.in[17], 2048, 256, (bf16*)(ws + WS_W1V), scr, r, F.lane, MapFrag()); continue; } r -= I_W1;
        if (r < I_W2) { transpose_item(a.in[15], 256, 64, (bf16*)(ws + WS_W2K), scr, r, F.lane, MapId()); continue; } r -= I_W2;
        transpose_item(a.in[18], 256, 64, (bf16*)(ws + WS_W2V), scr, r, F.lane, MapId());
    }
    const float* c = a.in[1]; const float* w_ada = a.in[3]; float* modp = (float*)(ws + WS_MODP);
    for (int t = NGW - 1 - gw; t < 96 * 8; t += NGW) { const int cg_ = t % 96, ks = t / 96; const int n = cg_ * 64 + F.lane;
        float acc0 = 0.f, acc1 = 0.f, acc2 = 0.f, acc3 = 0.f;
#pragma unroll
        for (int i = 0; i < 8; ++i) { const int idx = F.lane + 64 * i, bb = idx >> 7, kk = idx & 127; scr[kk * 4 + bb] = silu_acc(c[bb * DM + ks * 128 + kk]); }
        LDS_WAIT(); asm volatile("" ::: "memory");
#pragma unroll 8
        for (int k = 0; k < 128; ++k) { const float w = w_ada[(size_t)(ks * 128 + k) * 6144 + n]; const f32x4 sv = *(const LAS f32x4*)(scr + 4 * k);
            acc0 += sv[0] * w; acc1 += sv[1] * w; acc2 += sv[2] * w; acc3 += sv[3] * w; }
        LDS_WAIT(); asm volatile("" ::: "memory");
        float* o = modp + (size_t)ks * 4 * 6144 + n; o[0] = acc0; o[6144] = acc1; o[2 * 6144] = acc2; o[3 * 6144] = acc3; }
    float* cbp = (float*)(ws + WS_CBP);
    for (int t = NGW / 2 - 1 - gw; t >= 0 && t < 256; t += NGW) { const int kv = t & 1, cg_ = (t >> 1) & 3, ic = t >> 3; const int n = cg_ * 64 + F.lane;
        const float* pe = kv ? a.in[16] : a.in[13]; const float* w1 = kv ? a.in[17] : a.in[14]; float acc = 0.f;
#pragma unroll 8
        for (int i = ic * 64; i < ic * 64 + 64; ++i) acc += pe[i] * w1[(size_t)i * 256 + n];
        cbp[(ic * 2 + kv) * 256 + n] = acc; }
}
template <bool ADDY>
__device__ __forceinline__ void norm_rows(Frame& F, int blk, const float* in, const bf16* yin, const f32x4 (&gs)[4], const f32x4 (&sh)[4], bf16* out) {
    for (int i0 = 0; i0 < 16; i0 += 4) {
        f32x4 v[4][4]; float ss[4];
#pragma unroll
        for (int r = 0; r < 4; ++r) { const int row = blk * 128 + F.wave * 16 + i0 + r; const GAS f32x4* xr = (const GAS f32x4*)(in + (size_t)row * DM) + F.lane;
#pragma unroll
            for (int j = 0; j < 4; ++j) v[r][j] = xr[64 * j];
            if (ADDY) { const GAS unsigned long long* yr = (const GAS unsigned long long*)(yin + (size_t)row * DM) + F.lane;
#pragma unroll
                for (int j = 0; j < 4; ++j) { const unsigned long long w = yr[64 * j]; const unsigned lo = (unsigned)w, hi = (unsigned)(w >> 32);
                    v[r][j] += (f32x4){__builtin_bit_cast(float, lo << 16), __builtin_bit_cast(float, lo & 0xffff0000u), __builtin_bit_cast(float, hi << 16), __builtin_bit_cast(float, hi & 0xffff0000u)}; } } }
#pragma unroll
        for (int r = 0; r < 4; ++r) { float s = 0.f;
#pragma unroll
            for (int j = 0; j < 4; ++j) s += (v[r][j].x * v[r][j].x + v[r][j].y * v[r][j].y) + (v[r][j].z * v[r][j].z + v[r][j].w * v[r][j].w);
            ss[r] = s; }
#pragma unroll
        for (int o_ = 1; o_ < 64; o_ <<= 1) {
#pragma unroll
            for (int r = 0; r < 4; ++r) ss[r] += __shfl_xor(ss[r], o_); }
#pragma unroll
        for (int r = 0; r < 4; ++r) { const int row = blk * 128 + F.wave * 16 + i0 + r; const float rs = rsqrtf(ss[r] * (1.f / DM) + 1e-6f);
            GAS unsigned long long* o8 = (GAS unsigned long long*)(out + (size_t)row * DM) + F.lane;
#pragma unroll
            for (int j = 0; j < 4; ++j) { const f32x4 y = v[r][j] * rs * gs[j] + sh[j]; o8[64 * j] = (unsigned long long)pk2(y.x, y.y) | ((unsigned long long)pk2(y.z, y.w) << 32); } }
    }
}
__device__ __forceinline__ void phase_prologue_b(Frame& F, const Args& a) {
    unsigned char* ws = a.ws; const float* modp = (const float*)(ws + WS_MODP); const float* b_ada = a.in[4];
    if (F.wave == 0) for (int cgp = F.vcu; cgp < 96; cgp += F.G) { const int n = cgp * 64 + F.lane; float* mod = (float*)(ws + WS_MOD);
        for (int b = 0; b < 4; ++b) { float s = 0.f;
#pragma unroll
            for (int ks = 0; ks < 8; ++ks) s += modp[((size_t)ks * 4 + b) * 6144 + n];
            mod[b * 6144 + n] = s + b_ada[n]; } }
    const float* g = a.in[5];
    for (int blk = F.vcu; blk < TOK / 128; blk += F.G) { const int b = blk >> 6;
    f32x4 gs[4], sh[4];
#pragma unroll
    for (int j = 0; j < 4; ++j) { const int c0 = 4 * F.lane + 256 * j; f32x4 s0 = {0.f, 0.f, 0.f, 0.f}, s1 = {0.f, 0.f, 0.f, 0.f};
#pragma unroll
        for (int ks = 0; ks < 8; ++ks) { s0 += *(const f32x4*)(modp + ((size_t)ks * 4 + b) * 6144 + c0); s1 += *(const f32x4*)(modp + ((size_t)ks * 4 + b) * 6144 + DM + c0); }
        s0 += *(const f32x4*)(b_ada + c0); s1 += *(const f32x4*)(b_ada + DM + c0);
        sh[j] = s0; gs[j] = *(const f32x4*)(g + c0) * (s1 + 1.0f); }
    norm_rows<false>(F, blk, a.in[0], nullptr, gs, sh, (bf16*)(ws + WS_H)); }
}
__device__ __forceinline__ void phase_norm2(Frame& F, const Args& a) {
    unsigned char* ws = a.ws; const float* g = a.in[20];
    for (int blk = F.vcu; blk < TOK / 128; blk += F.G) { const int b = blk >> 6; const float* mod = (const float*)(ws + WS_MOD) + (size_t)b * 6144;
        f32x4 gs[4], sh[4];
#pragma unroll
        for (int j = 0; j < 4; ++j) { const int c0 = 4 * F.lane + 256 * j; sh[j] = *(const f32x4*)(mod + 3 * DM + c0); gs[j] = *(const f32x4*)(g + c0) * (*(const f32x4*)(mod + 4 * DM + c0) + 1.0f); }
        norm_rows<true>(F, blk, a.in[0], (const bf16*)(ws + WS_Y), gs, sh, (bf16*)(ws + WS_H)); }
}

__device__ __forceinline__ void phase_bias2(Frame& F, const Args& a) {
    unsigned char* ws = a.ws; const float* mod = (const float*)(ws + WS_MOD); const bf16* wt = (const bf16*)(ws + WS_WGU); float* bias2 = (float*)(ws + WS_BIAS2);
    const int gw = F.vcu * NWAVES + F.wave, NGW = F.G * NWAVES;
    f32x4 sh[4][4];
#pragma unroll
    for (int bb = 0; bb < 4; ++bb)
#pragma unroll
        for (int j = 0; j < 4; ++j) sh[bb][j] = *(const f32x4*)(mod + (size_t)bb * 6144 + 3 * DM + 16 * F.lane + 4 * j);
    for (int c = gw; c < 2 * FF; c += NGW) {
        const v4u w0 = *(const GAS v4u*)(wt + (size_t)c * DM + 16 * F.lane), w1 = *(const GAS v4u*)(wt + (size_t)c * DM + 16 * F.lane + 8);
        const unsigned wu[8] = {w0.x, w0.y, w0.z, w0.w, w1.x, w1.y, w1.z, w1.w};
        float s[4] = {0.f, 0.f, 0.f, 0.f};
#pragma unroll
        for (int j = 0; j < 4; ++j) { const float e0 = __builtin_bit_cast(float, wu[2 * j] << 16), e1 = __builtin_bit_cast(float, wu[2 * j] & 0xffff0000u), e2 = __builtin_bit_cast(float, wu[2 * j + 1] << 16), e3 = __builtin_bit_cast(float, wu[2 * j + 1] & 0xffff0000u);
#pragma unroll
            for (int bb = 0; bb < 4; ++bb) s[bb] += (sh[bb][j][0] * e0 + sh[bb][j][1] * e1) + (sh[bb][j][2] * e2 + sh[bb][j][3] * e3); }
#pragma unroll
        for (int bb = 0; bb < 4; ++bb) { const float t = wave_sum(s[bb]); if (F.lane == 0) bias2[(size_t)bb * 2 * FF + c] = t; }
    }
}
#define XB_TMO      128
#define XB_XCNT(j)  (256  + 64 * (j))
#define XB_XSUB(j)  (1280 + 64 * (j))
#define XB_XGEN(j)  (2304 + 64 * (j))
#define XB_TOP      3328
#define XB_TOPGEN   3392
#define XCD_BAR_WORDS 3456
#define XB_SPIN_CAP (1u << 18)

__device__ __forceinline__ unsigned xb_ld(unsigned* p)              { return __hip_atomic_load(p, __ATOMIC_RELAXED, __HIP_MEMORY_SCOPE_AGENT); }
__device__ __forceinline__ unsigned xb_add(unsigned* p, unsigned v) { return __hip_atomic_fetch_add(p, v, __ATOMIC_RELAXED, __HIP_MEMORY_SCOPE_AGENT); }
__device__ __forceinline__ unsigned xb_xcc_id() { return (unsigned)__builtin_amdgcn_s_getreg((3 << 11) | 20) & 0xFu; }
#define XB_SPIN(cond, bar) do { unsigned _sp = 0; while (cond) { __builtin_amdgcn_s_sleep(1); \
    if ((++_sp & 255u) == 0u) { if (xb_ld(&(bar)[XB_TMO])) break; if (_sp > XB_SPIN_CAP) { atomicAdd(&(bar)[XB_TMO], 1u); break; } } } } while (0)

struct XcdBarrier {
    unsigned* bar; unsigned x;
    volatile LAS unsigned* st;
};

__device__ __forceinline__ XcdBarrier xcd_barrier_post(unsigned* bar, volatile LAS unsigned* st) {
    XcdBarrier b; b.bar = bar; b.x = xb_xcc_id(); b.st = st;
    if (threadIdx.x == 0) (void)xb_add(&bar[XB_XCNT(b.x)], 1u);
    return b;
}
__device__ __forceinline__ void xcd_barrier_complete(unsigned* bar, unsigned x, unsigned& nloc, unsigned& nx) {
    const unsigned G = gridDim.x * gridDim.y * gridDim.z;
    unsigned sum, cnt, mine, sp = 0u;
    for (;;) {
        sum = 0u; cnt = 0u; mine = 0u;
#pragma unroll
        for (unsigned j = 0; j < 16; ++j) { const unsigned c = xb_ld(&bar[XB_XCNT(j)]); sum += c; cnt += (c > 0u) ? 1u : 0u; mine = (j == x) ? c : mine; }
        if (sum == G) break;
        __builtin_amdgcn_s_sleep(1);
        if ((++sp & 255u) == 0u) { if (xb_ld(&bar[XB_TMO])) break; if (sp > XB_SPIN_CAP) { atomicAdd(&bar[XB_TMO], 1u); break; } }
    }
    nloc = mine > 0u ? mine : 1u; nx = cnt > 0u ? cnt : 1u;
}

__device__ __forceinline__ void xcd_barrier(const XcdBarrier& b) {
    asm volatile("s_waitcnt vmcnt(0)" ::: "memory");
    __syncthreads();
    if (threadIdx.x == 0) {
        unsigned* bar = b.bar;
        __builtin_amdgcn_s_waitcnt(0);
        unsigned nloc = b.st[0], nx = b.st[1];
        if (nloc == 0u) { xcd_barrier_complete(bar, b.x, nloc, nx); b.st[0] = nloc; b.st[1] = nx; }
        const unsigned old = xb_add(&bar[XB_XSUB(b.x)], 1u);
        const unsigned gen = old / nloc;
        if (old + 1u == (gen + 1u) * nloc) {
            __builtin_amdgcn_fence(__ATOMIC_RELEASE, "agent");
            asm volatile("s_waitcnt vmcnt(0)" ::: "memory");
            const unsigned og = xb_add(&bar[XB_TOP], 1u);
            const unsigned tg = og / nx;
            if (og + 1u == (tg + 1u) * nx) xb_add(&bar[XB_TOPGEN], 1u);
            else XB_SPIN(xb_ld(&bar[XB_TOPGEN]) == tg, bar);
            __builtin_amdgcn_fence(__ATOMIC_ACQUIRE, "agent");
            xb_add(&bar[XB_XGEN(b.x)], 1u);
            asm volatile("s_waitcnt vmcnt(0)" ::: "memory");
        } else {
            XB_SPIN(xb_ld(&bar[XB_XGEN(b.x)]) == gen, bar);
            __builtin_amdgcn_fence(__ATOMIC_ACQUIRE, "agent");
            asm volatile("s_waitcnt vmcnt(0)" ::: "memory");
        }
    }
    __syncthreads();
}
#define ATT_NS att
#ifndef ATT_ABL
#define ATT_ABL 0
#endif
#ifndef ATT_STAGGER
#define ATT_STAGGER 0
#endif
#ifndef ATT_SLEEP
#define ATT_SLEEP 24
#endif
namespace ATT_NS {
using bf16x8 = __attribute__((ext_vector_type(8))) short;
using s16x4 = __attribute__((ext_vector_type(4))) short;
using f32x16 = __attribute__((ext_vector_type(16))) float;
using u32x4 = __attribute__((ext_vector_type(4))) unsigned;
typedef LAS const char* lds_cptr;
typedef short v4i16_t __attribute__((ext_vector_type(4)));
constexpr int SLOT = 16384, NSLOT = 4, LDS_OST = 65536, LDS_LUT = 98304, LDS_IMP = 100352, LDS_SELM = 133120, LDS_MISC = 134144, LDS_WSF = 134400, LDS_LUTG = 136448  , LDS_ATT_END = 144640;
constexpr float LOG2E = 1.4426950408889634f;
#define MFMA32(a, b, c) __builtin_amdgcn_mfma_f32_32x32x16_bf16(a, b, c, 0, 0, 0)
#define ATT_WAIT_BAR(N) asm volatile("s_waitcnt vmcnt(" #N ") lgkmcnt(0)\n\ts_barrier" ::: "memory")
__device__ __forceinline__ void glds16(const void* gsrc, unsigned lds_dst) { unsigned keep;
    asm volatile("s_mov_b32 %0, m0\n\ts_mov_b32 m0, %2\n\ts_nop 0\n\tglobal_load_lds_dwordx4 %1, off\n\ts_mov_b32 m0, %0" : "=&s"(keep) : "v"(gsrc), "s"(lds_dst) : "memory"); }
typedef float f32x2_t __attribute__((ext_vector_type(2))); typedef __bf16 bf16x2_t __attribute__((ext_vector_type(2)));
__device__ __forceinline__ unsigned cvtpk(float lo, float hi) { f32x2_t v = {lo, hi}; bf16x2_t b = __builtin_convertvector(v, bf16x2_t); return __builtin_bit_cast(unsigned, b); }
__device__ __forceinline__ s16x4 vtr(lds_cptr p) { return __builtin_bit_cast(s16x4, __builtin_amdgcn_ds_read_tr16_b64_v4i16((LAS v4i16_t*)p)); }
__device__ __forceinline__ int t5_bucket(int d) {
    if (d < 16) return d;
    int b = 16;
    b += (d >= 19); b += (d >= 21); b += (d >= 24); b += (d >= 27); b += (d >= 31); b += (d >= 35); b += (d >= 40); b += (d >= 46);
    b += (d >= 52); b += (d >= 59); b += (d >= 67); b += (d >= 77); b += (d >= 87); b += (d >= 99); b += (d >= 113);
    return b;
}
struct Ctx { LAS char* lds; int wid; int lane, r32, hi; };
__device__ __forceinline__ int fresh_lane() { int l; asm volatile("v_mbcnt_lo_u32_b32 %0, -1, 0\n\tv_mbcnt_hi_u32_b32 %0, -1, %0" : "=v"(l)); return l; }
__device__ __forceinline__ Ctx make_ctx(LAS unsigned char* lds, int tid) {
    Ctx c; c.lds = (LAS char*)lds; c.wid = __builtin_amdgcn_readfirstlane(tid >> 6); c.lane = tid & 63; c.r32 = c.lane & 31; c.hi = c.lane >> 5; return c;
}
template <bool HASV, class QK, class SM>
__device__ __forceinline__ void run_stream(const Ctx& c, const bf16* Kb, const bf16* Vb, int t0, int t1, QK&& qk, SM&& sm) {
    const int n = t1 - t0; if (n <= 0) return;
    const int lane = fresh_lane(), r32 = lane & 31, hi = lane >> 5; const unsigned lds0 = (unsigned)(uintptr_t)c.lds;
    const bf16* ks = Kb + ((8 * c.wid + (lane >> 3)) * 64 + (((lane & 7) ^ (((8 * c.wid + (lane >> 3)) >> 1) & 7)) << 3)); const bf16* vs = Vb + ((16 * (c.wid & 3) + (lane >> 2)) * 64 + (c.wid >> 2) * 32 + (lane & 3) * 8);
    const unsigned kdst = lds0 + c.wid * 1024, vdst = lds0 + 8192 + c.wid * 1024;
    const lds_cptr kp0 = (lds_cptr)c.lds + r32 * 128;
    const lds_cptr vp0 = (lds_cptr)c.lds + 8192 + ((lane >> 4) & 1) * 32 + (lane & 3) * 8 + (4 * hi + ((lane & 15) >> 2)) * 64;
#define ATT_ISSUE(t, so) do { if (ATT_ABL & 4) break; glds16(ks + (size_t)(t) * 4096, (unsigned)__builtin_amdgcn_readfirstlane(kdst + (so))); if (HASV) glds16(vs + (size_t)(t) * 4096, (unsigned)__builtin_amdgcn_readfirstlane(vdst + (so))); } while (0)
    ATT_ISSUE(t0, 0); if (n > 1) ATT_ISSUE(t0 + 1, SLOT);
    const bool late = ATT_STAGGER && __builtin_amdgcn_readfirstlane(c.wid) >= 4;
    f32x16 s0 = {}, s1 = {};
    int slot = 0, slotp = 3 * SLOT, slot2 = 2 * SLOT;
    if (!late) {
        for (int i = 0; i < n; ++i) {
            if (i + 1 < n) { if (HASV) ATT_WAIT_BAR(2); else ATT_WAIT_BAR(1); } else ATT_WAIT_BAR(0);
            if (i + 2 < n) ATT_ISSUE(t0 + i + 2, slot2);
            if (!(ATT_ABL & 1)) qk(t0 + i, kp0 + slot, s0, s1); if (!(ATT_ABL & 2)) sm(t0 + i, vp0 + slot, s0, s1);
            slot = (slot == 3 * SLOT) ? 0 : slot + SLOT; slot2 = (slot2 == 3 * SLOT) ? 0 : slot2 + SLOT;
        }
    } else {
        for (int i = 0; i < n; ++i) {
            if (i + 1 < n) { if (HASV) ATT_WAIT_BAR(2); else ATT_WAIT_BAR(1); } else ATT_WAIT_BAR(0);
            if (i + 2 < n) ATT_ISSUE(t0 + i + 2, slot2);
            if (i > 0 && !(ATT_ABL & 2)) sm(t0 + i - 1, vp0 + slotp, s0, s1);
            if (!(ATT_ABL & 1)) qk(t0 + i, kp0 + slot, s0, s1);
            slotp = slot; slot = (slot == 3 * SLOT) ? 0 : slot + SLOT; slot2 = (slot2 == 3 * SLOT) ? 0 : slot2 + SLOT;
        }
        if (!(ATT_ABL & 2)) sm(t0 + n - 1, vp0 + slotp, s0, s1);
    }
    asm volatile("s_waitcnt lgkmcnt(0)\n\ts_barrier" ::: "memory");
#undef ATT_ISSUE
}
template <class FN1, class FN2>
__device__ __forceinline__ void run_stream_pairs(const Ctx& c, const bf16* Kb, const bf16* Vb, int t0, int t1, FN1&& fn1, FN2&& fn2) {
    const int n = t1 - t0; if (n <= 0) return;
    const int lane = fresh_lane(), r32 = lane & 31, hi = lane >> 5; const unsigned lds0 = (unsigned)(uintptr_t)c.lds;
    const bf16* ks = Kb + ((8 * c.wid + (lane >> 3)) * 64 + (((lane & 7) ^ (((8 * c.wid + (lane >> 3)) >> 1) & 7)) << 3)); const bf16* vs = Vb + ((16 * (c.wid & 3) + (lane >> 2)) * 64 + (c.wid >> 2) * 32 + (lane & 3) * 8);
    const unsigned kdst = lds0 + c.wid * 1024, vdst = lds0 + 8192 + c.wid * 1024;
    const lds_cptr kp0 = (lds_cptr)c.lds + r32 * 128;
    const lds_cptr vp0 = (lds_cptr)c.lds + 8192 + ((lane >> 4) & 1) * 32 + (lane & 3) * 8 + (4 * hi + ((lane & 15) >> 2)) * 64;
#define ATT_ISSUE1(t, so) do { glds16(ks + (size_t)(t) * 4096, (unsigned)__builtin_amdgcn_readfirstlane(kdst + (so))); glds16(vs + (size_t)(t) * 4096, (unsigned)__builtin_amdgcn_readfirstlane(vdst + (so))); } while (0)
    ATT_ISSUE1(t0, 0); if (n > 1) ATT_ISSUE1(t0 + 1, SLOT);
    int base = 0;
    for (int i = 0; i < n; i += 2) {
        ATT_WAIT_BAR(0);
        const int nb = 2 * SLOT - base;
        if (i + 2 < n) ATT_ISSUE1(t0 + i + 2, nb); if (i + 3 < n) ATT_ISSUE1(t0 + i + 3, nb + SLOT);
        if (i + 1 < n) fn2(t0 + i, kp0 + base, vp0 + base, kp0 + base + SLOT, vp0 + base + SLOT); else fn1(t0 + i, kp0 + base, vp0 + base);
        base = nb;
    }
    asm volatile("s_waitcnt lgkmcnt(0)\n\ts_barrier" ::: "memory");
#undef ATT_ISSUE1
}
__device__ __forceinline__ void qk_tile(f32x16& s0, f32x16& s1, lds_cptr kp, const bf16x8 (&qr)[4]) {
    bf16x8 kf[8];
    { const int l = fresh_lane(), f = ((l & 31) >> 1) & 7, hi = l >> 5;
#pragma unroll
      for (int d0 = 0; d0 < 4; ++d0) { const int off = ((2 * d0 + hi) ^ f) << 4; kf[2 * d0] = *(const LAS bf16x8*)(kp + off); kf[2 * d0 + 1] = *(const LAS bf16x8*)(kp + 4096 + off); } }
    const f32x16 z = {};
    s0 = MFMA32(kf[0], qr[0], z); s1 = MFMA32(kf[1], qr[0], z);
#pragma unroll
    for (int d0 = 1; d0 < 4; ++d0) { s0 = MFMA32(kf[2 * d0], qr[d0], s0); s1 = MFMA32(kf[2 * d0 + 1], qr[d0], s1); }
}
template <bool MASK>
__device__ __forceinline__ void pv_tile(f32x16 (&o)[2], lds_cptr vp, const f32x16& p0, const f32x16& p1, unsigned mask) {
    if (ATT_ABL & 8) { o[0][0] += p0[0] + p1[5]; return; }
    u32x4 pw0 = {cvtpk(p0[0], p0[1]), cvtpk(p0[2], p0[3]), cvtpk(p0[4], p0[5]), cvtpk(p0[6], p0[7])}, pw1 = {cvtpk(p0[8], p0[9]), cvtpk(p0[10], p0[11]), cvtpk(p0[12], p0[13]), cvtpk(p0[14], p0[15])};
    u32x4 pw2 = {cvtpk(p1[0], p1[1]), cvtpk(p1[2], p1[3]), cvtpk(p1[4], p1[5]), cvtpk(p1[6], p1[7])}, pw3 = {cvtpk(p1[8], p1[9]), cvtpk(p1[10], p1[11]), cvtpk(p1[12], p1[13]), cvtpk(p1[14], p1[15])};
    if (MASK) { pw0 &= mask; pw1 &= mask; pw2 &= mask; pw3 &= mask; }
    if (ATT_ABL & 64) { o[0] = MFMA32(__builtin_bit_cast(bf16x8, pw0), __builtin_bit_cast(bf16x8, pw1), o[0]); o[1] = MFMA32(__builtin_bit_cast(bf16x8, pw2), __builtin_bit_cast(bf16x8, pw3), o[1]); return; }
    s16x4 vlo[8], vhi[8];
#pragma unroll
    for (int i = 0; i < 8; ++i) { vlo[i] = vtr(vp + ((i >> 2) * 4096 + (i & 3) * 1024)); vhi[i] = vtr(vp + ((i >> 2) * 4096 + (i & 3) * 1024 + 512)); }
#define ATT_VFR(i) (bf16x8){vlo[i][0], vlo[i][1], vlo[i][2], vlo[i][3], vhi[i][0], vhi[i][1], vhi[i][2], vhi[i][3]}
    o[0] = MFMA32(__builtin_bit_cast(bf16x8, pw0), ATT_VFR(0), o[0]); o[1] = MFMA32(__builtin_bit_cast(bf16x8, pw0), ATT_VFR(4), o[1]);
    o[0] = MFMA32(__builtin_bit_cast(bf16x8, pw1), ATT_VFR(1), o[0]); o[1] = MFMA32(__builtin_bit_cast(bf16x8, pw1), ATT_VFR(5), o[1]);
    o[0] = MFMA32(__builtin_bit_cast(bf16x8, pw2), ATT_VFR(2), o[0]); o[1] = MFMA32(__builtin_bit_cast(bf16x8, pw2), ATT_VFR(6), o[1]);
    o[0] = MFMA32(__builtin_bit_cast(bf16x8, pw3), ATT_VFR(3), o[0]); o[1] = MFMA32(__builtin_bit_cast(bf16x8, pw3), ATT_VFR(7), o[1]);
#undef ATT_VFR
}
#define ATT_SB() __builtin_amdgcn_sched_barrier(0)
struct KF { bf16x8 f[8]; };
struct VF { s16x4 lo[8], hi[8]; };
struct PW4 { u32x4 w0, w1, w2, w3; };
__device__ __forceinline__ void ld_k(KF& k, lds_cptr kp) {
    const int l = fresh_lane(), f = ((l & 31) >> 1) & 7, hi = l >> 5;
#pragma unroll
    for (int d0 = 0; d0 < 4; ++d0) { const int off = ((2 * d0 + hi) ^ f) << 4; k.f[2 * d0] = *(const LAS bf16x8*)(kp + off); k.f[2 * d0 + 1] = *(const LAS bf16x8*)(kp + 4096 + off); } }
__device__ __forceinline__ void qk_mfma(f32x16& s0, f32x16& s1, const KF& k, const bf16x8 (&qr)[4]) {
    const f32x16 z = {};
    s0 = MFMA32(k.f[0], qr[0], z); s1 = MFMA32(k.f[1], qr[0], z);
#pragma unroll
    for (int d0 = 1; d0 < 4; ++d0) { s0 = MFMA32(k.f[2 * d0], qr[d0], s0); s1 = MFMA32(k.f[2 * d0 + 1], qr[d0], s1); } }
__device__ __forceinline__ void ld_v(VF& v, lds_cptr vp) {
#pragma unroll
    for (int i = 0; i < 8; ++i) { v.lo[i] = vtr(vp + ((i >> 2) * 4096 + (i & 3) * 1024)); v.hi[i] = vtr(vp + ((i >> 2) * 4096 + (i & 3) * 1024 + 512)); } }
__device__ __forceinline__ PW4 pack4(const f32x16& p0, const f32x16& p1, unsigned mask) { PW4 w;
    w.w0 = (u32x4){cvtpk(p0[0], p0[1]), cvtpk(p0[2], p0[3]), cvtpk(p0[4], p0[5]), cvtpk(p0[6], p0[7])}; w.w1 = (u32x4){cvtpk(p0[8], p0[9]), cvtpk(p0[10], p0[11]), cvtpk(p0[12], p0[13]), cvtpk(p0[14], p0[15])};
    w.w2 = (u32x4){cvtpk(p1[0], p1[1]), cvtpk(p1[2], p1[3]), cvtpk(p1[4], p1[5]), cvtpk(p1[6], p1[7])}; w.w3 = (u32x4){cvtpk(p1[8], p1[9]), cvtpk(p1[10], p1[11]), cvtpk(p1[12], p1[13]), cvtpk(p1[14], p1[15])};
    w.w0 &= mask; w.w1 &= mask; w.w2 &= mask; w.w3 &= mask; return w; }
__device__ __forceinline__ void pv_mfma(f32x16 (&o)[2], const VF& v, const PW4& w) {
#define ATT_VF(i) (bf16x8){v.lo[i][0], v.lo[i][1], v.lo[i][2], v.lo[i][3], v.hi[i][0], v.hi[i][1], v.hi[i][2], v.hi[i][3]}
    o[0] = MFMA32(__builtin_bit_cast(bf16x8, w.w0), ATT_VF(0), o[0]); o[1] = MFMA32(__builtin_bit_cast(bf16x8, w.w0), ATT_VF(4), o[1]);
    o[0] = MFMA32(__builtin_bit_cast(bf16x8, w.w1), ATT_VF(1), o[0]); o[1] = MFMA32(__builtin_bit_cast(bf16x8, w.w1), ATT_VF(5), o[1]);
    o[0] = MFMA32(__builtin_bit_cast(bf16x8, w.w2), ATT_VF(2), o[0]); o[1] = MFMA32(__builtin_bit_cast(bf16x8, w.w2), ATT_VF(6), o[1]);
    o[0] = MFMA32(__builtin_bit_cast(bf16x8, w.w3), ATT_VF(3), o[0]); o[1] = MFMA32(__builtin_bit_cast(bf16x8, w.w3), ATT_VF(7), o[1]);
#undef ATT_VF
}
__device__ __forceinline__ float rowsum32(const f32x16& p0, const f32x16& p1) { if (ATT_ABL & 32) return p0[0]; float a = p0[0] + p1[0], b = p0[1] + p1[1];
#pragma unroll
    for (int r = 2; r < 16; r += 2) { a += p0[r]; asm volatile("" : "+v"(a)); b += p0[r + 1]; asm volatile("" : "+v"(b)); a += p1[r]; asm volatile("" : "+v"(a)); b += p1[r + 1]; asm volatile("" : "+v"(b)); }
    return a + b; }
__device__ __forceinline__ void hook_exp(f32x16& s0, f32x16& s1) {
    if (ATT_ABL & 16) return;
#pragma unroll
    for (int r = 0; r < 16; ++r) { s0[r] = __builtin_amdgcn_exp2f(s0[r]); s1[r] = __builtin_amdgcn_exp2f(s1[r]); } }
__device__ __forceinline__ void hook_near(f32x16& s0, f32x16& s1, int base, const LAS float* lut) {
    asm volatile("" : "+v"(base));
#pragma unroll
    for (int r = 0; r < 16; ++r) { const int d0 = base - ((r & 3) + 8 * (r >> 2)), d1 = d0 - 32;
        s0[r] = __builtin_amdgcn_exp2f(s0[r] + lut[min(max(d0, -1), 113) + 1]); s1[r] = __builtin_amdgcn_exp2f(s1[r] + lut[min(max(d1, -1), 113) + 1]); } }
__device__ __forceinline__ void hook_edge(f32x16& s0, f32x16& s1, int base, int win) {
    asm volatile("" : "+v"(base));
#pragma unroll
    for (int r = 0; r < 16; ++r) { const int d0 = base - ((r & 3) + 8 * (r >> 2)), d1 = d0 - 32;
        s0[r] = __builtin_amdgcn_exp2f(d0 < win ? s0[r] : -INFINITY); s1[r] = __builtin_amdgcn_exp2f(d1 < win ? s1[r] : -INFINITY); } }
__device__ __forceinline__ void hook_cmp(f32x16& s0, f32x16& s1, int nrel  , float cb) {
    asm volatile("" : "+v"(nrel));
#pragma unroll
    for (int r = 0; r < 16; ++r) { const int c0 = (r & 3) + 8 * (r >> 2);
        s0[r] = __builtin_amdgcn_exp2f(s0[r] + ((c0 <= nrel) ? cb : -INFINITY)); s1[r] = __builtin_amdgcn_exp2f(s1[r] + ((c0 + 32 <= nrel) ? cb : -INFINITY)); } }
__device__ __forceinline__ void row_factors(const Ctx& c, float f, float (&fr)[16]) {
    const int lane = fresh_lane(), r32 = lane & 31, hi = lane >> 5; LAS float* wsf = (LAS float*)(c.lds + LDS_WSF) + c.wid * 64;
    asm volatile("s_waitcnt lgkmcnt(0)" ::: "memory");
    if (hi == 0) wsf[r32] = f;
    asm volatile("s_waitcnt lgkmcnt(0)" ::: "memory");
#pragma unroll
    for (int r = 0; r < 16; ++r) fr[r] = wsf[(r & 3) + 8 * (r >> 2) + 4 * hi];
    asm volatile("s_waitcnt lgkmcnt(0)" ::: "memory");
}
__device__ __forceinline__ float pair_sum(float v) { auto rr = __builtin_amdgcn_permlane32_swap(__float_as_uint(v), __float_as_uint(v), false, false); return __uint_as_float(rr[0]) + __uint_as_float(rr[1]); }
template <class RowOff>
__device__ __forceinline__ void store_rows(const Ctx& c, const f32x16 (&o)[2], bf16* dst, RowOff&& rowoff) {
    LAS bf16* stg = (LAS bf16*)(c.lds + LDS_OST) + c.wid * 2048;
    const int lane = fresh_lane(), r32 = lane & 31, hi = lane >> 5;
#pragma unroll
    for (int r = 0; r < 16; ++r) { const int orow = (r & 3) + 8 * (r >> 2) + 4 * hi;
#pragma unroll
        for (int d0 = 0; d0 < 2; ++d0) stg[orow * 64 + d0 * 32 + r32] = (bf16)f2bf(o[d0][r]); }
    asm volatile("s_waitcnt lgkmcnt(0)" ::: "memory");
#pragma unroll
    for (int i = 0; i < 4; ++i) { const int row = i * 8 + (lane >> 3), ch = lane & 7; const u32x4 v = *(const LAS u32x4*)(stg + row * 64 + ch * 8); *(u32x4*)(dst + rowoff(row) + ch * 8) = v; }
    asm volatile("s_waitcnt lgkmcnt(0)" ::: "memory");
}
struct AttnPtrs { const bf16* qkv; const float* kmp; const float* gates; const bf16* kcmp; const bf16* vcmp; const float* rel_bias; bf16* mix; unsigned* selg; bf16* part_o; float* part_l; };

__device__ __forceinline__ void moba_kmean_frags(const AttnPtrs& P, int bh, int r32, int hi, bf16x8 (&kmf)[4]) {
    const float* kp = P.kmp + ((size_t)(bh * 32 + r32) * 2) * 64;
#pragma unroll
    for (int d0 = 0; d0 < 4; ++d0) { const f32x4 a0 = *(const f32x4*)(kp + d0 * 16 + hi * 8), a1 = *(const f32x4*)(kp + d0 * 16 + hi * 8 + 4), b0 = *(const f32x4*)(kp + 64 + d0 * 16 + hi * 8), b1 = *(const f32x4*)(kp + 64 + d0 * 16 + hi * 8 + 4);
        const f32x4 m0 = (a0 + b0) * (1.f / 256.f), m1 = (a1 + b1) * (1.f / 256.f);
        u32x4 w = {cvtpk(m0[0], m0[1]), cvtpk(m0[2], m0[3]), cvtpk(m1[0], m1[1]), cvtpk(m1[2], m1[3])}; kmf[d0] = __builtin_bit_cast(bf16x8, w); }
}
__device__ __forceinline__ unsigned moba_gate32(const bf16x8 (&kmf)[4], int i, const bf16x8 (&qr)[4], int hi) {
    unsigned selmask = 0u;
    if (i > 0) {
        f32x16 sg = {};
#pragma unroll
        for (int d0 = 0; d0 < 4; ++d0) sg = MFMA32(kmf[d0], qr[d0], sg);
        float v[16];
#pragma unroll
        for (int r = 0; r < 16; ++r) v[r] = ((r & 3) + 8 * (r >> 2) + 4 * hi < i) ? sg[r] : -INFINITY;
#pragma unroll
        for (int it = 0; it < 3; ++it) {
            float m = v[0]; int jb = 4 * hi;
#pragma unroll
            for (int r = 1; r < 16; ++r) { const int j = (r & 3) + 8 * (r >> 2) + 4 * hi; if (v[r] > m) { m = v[r]; jb = j; } }
            auto rm = __builtin_amdgcn_permlane32_swap(__float_as_uint(m), __float_as_uint(m), false, false);
            auto rj = __builtin_amdgcn_permlane32_swap((unsigned)jb, (unsigned)jb, false, false);
            const float mo = __uint_as_float(hi ? rm[0] : rm[1]); const int jo = (int)(hi ? rj[0] : rj[1]);
            const bool mine = (m > mo) || (m == mo && jb < jo);
            const float mw = mine ? m : mo; const int jw = mine ? jb : jo;
            if (mw > -INFINITY) { selmask |= 1u << jw;
#pragma unroll
                for (int r = 0; r < 16; ++r) if ((r & 3) + 8 * (r >> 2) + 4 * hi == jw) v[r] = -INFINITY; }
        }
    }
    return selmask;
}
__device__ __forceinline__ void moba_gate_phase(const AttnPtrs& P, int vcu, int G, int tid) {
    const int lane = tid & 63, r32 = lane & 31, hi = lane >> 5; const int wid = __builtin_amdgcn_readfirstlane(tid >> 6);
    for (int grp = vcu * 8 + wid; grp < 2048; grp += G * 8) { const int bh = grp >> 6;
        bf16x8 kmf[4]; moba_kmean_frags(P, bh, r32, hi, kmf);
        const bf16* QA = P.qkv + ((size_t)bh * SEQ) * 64;
#pragma unroll 2
        for (int k = 0; k < 4; ++k) { const int idx = (grp & 63) * 4 + k, i = idx >> 3, w = idx & 7; const int qpos = 256 * i + 32 * w + r32;
            bf16x8 qr[4];
#pragma unroll
            for (int d0 = 0; d0 < 4; ++d0) qr[d0] = *(const bf16x8*)(QA + (size_t)qpos * 64 + d0 * 16 + hi * 8);
            const unsigned m = moba_gate32(kmf, i, qr, hi);
            if (hi == 0) P.selg[(size_t)bh * SEQ + qpos] = m; } }
}
__device__ __forceinline__ void moba_lut(const Ctx& c, const AttnPtrs& P, int h) {
    LAS float* lut = (LAS float*)(c.lds + LDS_LUT);
    if (threadIdx.x < 115) lut[threadIdx.x] = (threadIdx.x == 0) ? -INFINITY : (P.rel_bias[t5_bucket(threadIdx.x - 1) * 16 + h] - P.rel_bias[31 * 16 + h]) * LOG2E;
}
__device__ __forceinline__ void moba_past_item(const Ctx& c, const AttnPtrs& P, int b, int h, int j) {
    const int bh = b * 8 + h, tid = threadIdx.x;
    const bf16* QA = P.qkv + ((size_t)bh * SEQ) * 64; const bf16* KA = QA + QKV_BIG + (size_t)256 * j * 64; const bf16* VA = QA + 2 * QKV_BIG + (size_t)256 * j * 64;
    const LAS float* lut = (const LAS float*)(c.lds + LDS_LUTG) + h * 128;
    { const int lane = fresh_lane(); const unsigned lds0 = (unsigned)(uintptr_t)c.lds;
      const bf16* ks = KA + ((8 * c.wid + (lane >> 3)) * 64 + (((lane & 7) ^ (((8 * c.wid + (lane >> 3)) >> 1) & 7)) << 3)); const bf16* vs = VA + ((16 * (c.wid & 3) + (lane >> 2)) * 64 + (c.wid >> 2) * 32 + (lane & 3) * 8);
#pragma unroll
      for (int tt = 0; tt < 4; ++tt) { glds16(ks + tt * 4096, (unsigned)__builtin_amdgcn_readfirstlane(lds0 + c.wid * 1024 + tt * SLOT)); glds16(vs + tt * 4096, (unsigned)__builtin_amdgcn_readfirstlane(lds0 + 8192 + c.wid * 1024 + tt * SLOT)); } }
    LAS unsigned short* list = (LAS unsigned short*)(c.lds + LDS_IMP);
    LAS unsigned* wcnt = (LAS unsigned*)(c.lds + LDS_MISC) + 8;
    const unsigned* sg = P.selg + (size_t)bh * SEQ;
    if (tid < 256) list[tid] = (unsigned short)((256 * j + tid) | (3 << 13));
    int total = 256;
    for (int base = (j + 1) * 256; base < SEQ; base += 2048) {
        const int q0 = base + 4 * tid; uint4 m4 = make_uint4(0u, 0u, 0u, 0u); if (q0 < SEQ) m4 = *(const uint4*)(sg + q0);
        const unsigned long long b0 = __ballot((m4.x >> j) & 1u), b1 = __ballot((m4.y >> j) & 1u), b2 = __ballot((m4.z >> j) & 1u), b3 = __ballot((m4.w >> j) & 1u);
        const int c0 = (int)__popcll(b0), c1 = (int)__popcll(b1), c2 = (int)__popcll(b2), c3 = (int)__popcll(b3);
        if ((tid & 63) == 0) wcnt[c.wid] = (unsigned)(c0 + c1 + c2 + c3);
        asm volatile("s_waitcnt vmcnt(0) lgkmcnt(0)\n\ts_barrier" ::: "memory");
        int off = total, tot = 0;
#pragma unroll
        for (int w = 0; w < 8; ++w) { const int v = (int)wcnt[w]; off += (w < c.wid) ? v : 0; tot += v; }
        const unsigned long long below = (1ull << (tid & 63)) - 1ull; const unsigned lowj = (1u << j) - 1u;
        if ((m4.x >> j) & 1u) list[off + __popcll(b0 & below)] = (unsigned short)((q0 + 0) | (__popc(m4.x & lowj) << 13)); off += c0;
        if ((m4.y >> j) & 1u) list[off + __popcll(b1 & below)] = (unsigned short)((q0 + 1) | (__popc(m4.y & lowj) << 13)); off += c1;
        if ((m4.z >> j) & 1u) list[off + __popcll(b2 & below)] = (unsigned short)((q0 + 2) | (__popc(m4.z & lowj) << 13)); off += c2;
        if ((m4.w >> j) & 1u) list[off + __popcll(b3 & below)] = (unsigned short)((q0 + 3) | (__popc(m4.w & lowj) << 13));
        total += tot;
        asm volatile("s_waitcnt lgkmcnt(0)\n\ts_barrier" ::: "memory");
    }
    total = __builtin_amdgcn_readfirstlane(total);
    { const int npad = (32 - (total & 31)) & 31; if (tid < npad) list[total + tid] = 0xFFFFu; }
    const int nchunks = (total + 31) >> 5;
    asm volatile("s_waitcnt vmcnt(0) lgkmcnt(0)\n\ts_barrier" ::: "memory");
    for (int ch = c.wid; ch < nchunks; ch += 8) {
        const int lane = fresh_lane(), r32 = lane & 31, hi = lane >> 5;
        const lds_cptr kp0 = (lds_cptr)c.lds + r32 * 128;
        const lds_cptr vp0 = (lds_cptr)c.lds + 8192 + ((lane >> 4) & 1) * 32 + (lane & 3) * 8 + (4 * hi + ((lane & 15) >> 2)) * 64;
        const unsigned e = list[32 * ch + r32]; const bool valid = e != 0xFFFFu; const int q = valid ? (int)(e & 0x1FFFu) : SEQ - 1;
        bf16x8 qr[4];
#pragma unroll
        for (int d0 = 0; d0 < 4; ++d0) qr[d0] = *(const bf16x8*)(QA + (size_t)q * 64 + d0 * 16 + hi * 8);
        asm volatile("" : "+v"(qr[0]), "+v"(qr[1]), "+v"(qr[2]), "+v"(qr[3]));
        const bool anynear = __any(valid && (unsigned)((q >> 8) - j) <= 1u);
        f32x16 o[2]; o[0] = f32x16{}; o[1] = f32x16{}; float l_reg = 0.f;
#pragma unroll 1
        for (int tt = 0; tt < 4; ++tt) { f32x16 s0, s1; qk_tile(s0, s1, kp0 + tt * SLOT, qr);
            if (anynear) hook_near(s0, s1, q - (256 * j + 64 * tt) - 4 * hi, lut); else hook_exp(s0, s1);
            l_reg += rowsum32(s0, s1);
            pv_tile<false>(o, vp0 + tt * SLOT, s0, s1, 0u); }
        const float L = pair_sum(l_reg);
        if (hi == 0 && valid) P.part_l[((size_t)bh * SEQ + q) * 4 + (e >> 13)] = L;
        LAS bf16* stg = (LAS bf16*)(c.lds + LDS_OST) + c.wid * 2048;
#pragma unroll
        for (int r = 0; r < 16; ++r) { const int orow = (r & 3) + 8 * (r >> 2) + 4 * hi;
#pragma unroll
            for (int d0 = 0; d0 < 2; ++d0) stg[orow * 64 + d0 * 32 + r32] = (bf16)f2bf(o[d0][r]); }
        asm volatile("s_waitcnt lgkmcnt(0)" ::: "memory");
#pragma unroll
        for (int it = 0; it < 4; ++it) { const int row = it * 8 + (lane >> 3), chn = lane & 7; const unsigned e2 = list[32 * ch + row];
            const u32x4 v = *(const LAS u32x4*)(stg + row * 64 + chn * 8);
            if (e2 != 0xFFFFu) *(u32x4*)(P.part_o + (((size_t)bh * SEQ + (e2 & 0x1FFFu)) * 4 + (e2 >> 13)) * 64 + chn * 8) = v; }
        asm volatile("s_waitcnt lgkmcnt(0)" ::: "memory");
    }
    asm volatile("s_waitcnt lgkmcnt(0)\n\ts_barrier" ::: "memory");
}
__device__ __forceinline__ void moba_merge_pass(const AttnPtrs& P, int vcu, int G, int tid) {
    const int lane = tid & 63, h = lane >> 3, chn = lane & 7; const int wid = __builtin_amdgcn_readfirstlane(tid >> 6);
#pragma unroll 4
    for (int tok = vcu * 8 + wid; tok < TOK; tok += G * 8) { const int b = tok >> 13, q = tok & (SEQ - 1);
        const size_t qi = (size_t)(b * 8 + h) * SEQ + q; const int ns = __popc(P.selg[qi]);
        float Lt = P.part_l[qi * 4 + 3]; const u32x4 pw = *(const u32x4*)(P.part_o + (qi * 4 + 3) * 64 + chn * 8);
        f32x4 a0 = {__uint_as_float(pw.x << 16), __uint_as_float(pw.x & 0xffff0000u), __uint_as_float(pw.y << 16), __uint_as_float(pw.y & 0xffff0000u)};
        f32x4 a1 = {__uint_as_float(pw.z << 16), __uint_as_float(pw.z & 0xffff0000u), __uint_as_float(pw.w << 16), __uint_as_float(pw.w & 0xffff0000u)};
#pragma unroll
        for (int sidx = 0; sidx < 3; ++sidx) if (sidx < ns) { Lt += P.part_l[qi * 4 + sidx]; const u32x4 pv = *(const u32x4*)(P.part_o + (qi * 4 + sidx) * 64 + chn * 8);
            a0 += (f32x4){__uint_as_float(pv.x << 16), __uint_as_float(pv.x & 0xffff0000u), __uint_as_float(pv.y << 16), __uint_as_float(pv.y & 0xffff0000u)};
            a1 += (f32x4){__uint_as_float(pv.z << 16), __uint_as_float(pv.z & 0xffff0000u), __uint_as_float(pv.w << 16), __uint_as_float(pv.w & 0xffff0000u)}; }
        const float inv = 1.f / Lt; a0 *= inv; a1 *= inv;
        const u32x4 w = {cvtpk(a0[0], a0[1]), cvtpk(a0[2], a0[3]), cvtpk(a1[0], a1[1]), cvtpk(a1[2], a1[3])};
        *(u32x4*)(P.mix + (size_t)tok * DM + h * 64 + chn * 8) = w; }
}

__device__ __forceinline__ void nsa_item(const Ctx& c, const AttnPtrs& P, int b, int g, int ci, int flags = 0) {
    const int ql = 8 * c.wid + (c.r32 >> 2), rh = c.r32 & 3, qpos = 64 * ci + ql, hb = 4 * g + rh;
    const int qw0 = 64 * ci + 8 * c.wid;
    const bf16* QB = P.qkv + 3 * QKV_BIG + ((size_t)(b * 8 + hb) * SEQ) * 64;
    const bf16* KS = P.qkv + 4 * QKV_BIG + 2 * QKV_SMALL + ((size_t)(b * 2 + g) * SEQ) * 64; const bf16* VS = KS + QKV_SMALL; const bf16* KW = KS + 2 * QKV_SMALL; const bf16* VW = KS + 3 * QKV_SMALL;
    const bf16* KC = P.kcmp + (size_t)(b * 2 + g) * 512 * 64; const bf16* VC = P.vcmp + (size_t)(b * 2 + g) * 512 * 64;
    bf16x8 qr[4];
#pragma unroll
    for (int d0 = 0; d0 < 4; ++d0) qr[d0] = *(const bf16x8*)(QB + (size_t)qpos * 64 + d0 * 16 + c.hi * 8);
    asm volatile("" : "+v"(qr[0]), "+v"(qr[1]), "+v"(qr[2]), "+v"(qr[3]));
    const LAS float* lut = (const LAS float*)(c.lds + LDS_LUTG) + (8 + hb) * 128;
    LAS float* imp = (LAS float*)(c.lds + LDS_IMP);
    LAS unsigned* selm = (LAS unsigned*)(c.lds + LDS_SELM);
    f32x16 o[2]; float l_reg; float fr[16];
    LAS float* park = (LAS float*)(c.lds + LDS_OST) + c.wid * 1024 + c.lane;
    LAS float* park1 = (LAS float*)(c.lds + LDS_IMP) + c.wid * 1024 + c.lane;
    const int nct = (4 * ci + 3 + 63) >> 6;
    const int nlim = (qpos >= 31) ? ((qpos - 31) >> 4) : -1;
    LAS bf16* impt = (LAS bf16*)(c.lds + ((rh & 2) ? LDS_IMP : LDS_OST)) + ((rh & 1) * 64 + ql) * 128;
    l_reg = 0.f; o[0] = f32x16{}; o[1] = f32x16{};
    {
        float carry = 0.f;
        run_stream<true>(c, KC, VC, 0, nct,
          [&](int t, lds_cptr kp, f32x16& s0, f32x16& s1) { qk_tile(s0, s1, kp, qr); },
          [&](int t, lds_cptr vp, f32x16& s0, f32x16& s1) {
            hook_cmp(s0, s1, nlim - 64 * t - 4 * c.hi, 0.f);
            l_reg += rowsum32(s0, s1);
#pragma unroll
            for (int half = 0; half < 2; ++half) {
                float g4[4], e[4];
#pragma unroll
                for (int a = 0; a < 4; ++a) { const float x0 = half ? s1[4 * a] : s0[4 * a], x1 = half ? s1[4 * a + 1] : s0[4 * a + 1], x2 = half ? s1[4 * a + 2] : s0[4 * a + 2], x3 = half ? s1[4 * a + 3] : s0[4 * a + 3];
                    g4[a] = (x0 + x1) + (x2 + x3); e[a] = x3; }
                float x[4];
#pragma unroll
                for (int a = 0; a < 4; ++a) { auto rr = __builtin_amdgcn_permlane32_swap(__float_as_uint(e[a]), __float_as_uint(e[a]), false, false); x[a] = __uint_as_float(c.hi ? rr[0] : rr[1]); }
                const int jb = 16 * t + 8 * half;
                float iv[4];
                if (c.hi) {
#pragma unroll
                    for (int a = 0; a < 4; ++a) iv[a] = g4[a] + x[a]; }
                else { iv[0] = g4[0] + carry; iv[1] = g4[1] + x[0]; iv[2] = g4[2] + x[1]; iv[3] = g4[3] + x[2]; carry = x[3]; }
#pragma unroll
                for (int a = 0; a < 4; ++a) impt[jb + 2 * a + c.hi] = (bf16)f2bf(iv[a]);
            }
            pv_tile<false>(o, vp, s0, s1, 0u);
        });
    }
    const float Lc = pair_sum(l_reg); const float invLc = Lc > 0.f ? 1.f / Lc : 0.f;
    { LAS float* wsfw = (LAS float*)(c.lds + LDS_WSF) + c.wid * 64; if (c.hi == 0) wsfw[32 + c.r32] = invLc; }
    {
        asm volatile("s_waitcnt lgkmcnt(0)\n\ts_barrier" ::: "memory");
        const int qq = 8 * c.wid + (c.lane >> 3), cc = c.lane & 7;
        unsigned m0 = 0u, m1 = 0u, m2w = 0u, m3 = 0u;
        if (ci <= 15) { m0 = (ci == 31) ? 0xffffffffu : ((2u << ci) - 1u); }
        else {
            float v[16];
            const LAS float* il = (const LAS float*)(c.lds + LDS_WSF) + c.wid * 64 + 32 + 4 * (c.lane >> 3);
            const float i0 = il[0], i1 = il[1], i2 = il[2], i3 = il[3];
            const LAS bf16* ta = (const LAS bf16*)(c.lds + LDS_OST) + qq * 128; const LAS bf16* tb = (const LAS bf16*)(c.lds + LDS_IMP) + qq * 128;
#pragma unroll
            for (int k = 0; k < 16; ++k) { const int j = cc + 8 * k;
                v[k] = (j >= 1 && j <= ci - 2) ? (bf2f(ta[j]) * i0 + bf2f(ta[64 * 128 + j]) * i1) + (bf2f(tb[j]) * i2 + bf2f(tb[64 * 128 + j]) * i3) : -INFINITY; }
            for (int it = 0; it < 13; ++it) {
                float m = v[0]; int jb = cc;
#pragma unroll
                for (int k = 1; k < 16; ++k) if (v[k] > m) { m = v[k]; jb = cc + 8 * k; }
#pragma unroll
                for (int sft = 1; sft < 8; sft <<= 1) { const float mo = __shfl_xor(m, sft); const int jo = __shfl_xor(jb, sft); if (mo > m || (mo == m && jo < jb)) { m = mo; jb = jo; } }
                if (m > -INFINITY) { const unsigned bit = 1u << (jb & 31); const int wsel = jb >> 5;
                    m0 |= (wsel == 0) ? bit : 0u; m1 |= (wsel == 1) ? bit : 0u; m2w |= (wsel == 2) ? bit : 0u; m3 |= (wsel == 3) ? bit : 0u;
#pragma unroll
                    for (int k = 0; k < 16; ++k) if (cc + 8 * k == jb) v[k] = -INFINITY; }
            }
            m0 |= 1u;
#pragma unroll
            for (int z = 0; z < 2; ++z) { const int jf = ci - z; const unsigned bit = 1u << (jf & 31); const int wsel = jf >> 5;
                m0 |= (wsel == 0) ? bit : 0u; m1 |= (wsel == 1) ? bit : 0u; m2w |= (wsel == 2) ? bit : 0u; m3 |= (wsel == 3) ? bit : 0u; }
        }
        if (cc == 0) { selm[qq * 4 + 0] = m0; selm[qq * 4 + 1] = m1; selm[qq * 4 + 2] = m2w; selm[qq * 4 + 3] = m3; }
        asm volatile("s_waitcnt lgkmcnt(0)\n\ts_barrier" ::: "memory");
    }
    const float* gp = P.gates + ((size_t)b * SEQ + qpos) * 24 + hb * 3; float g0 = gp[0], g1 = gp[1], g2 = gp[2];
    asm volatile("" : "+v"(g0), "+v"(g1), "+v"(g2));
    row_factors(c, g0 * invLc, fr);
#pragma unroll
    for (int r = 0; r < 16; ++r) { park[r * 64] = o[0][r] * fr[r]; park1[r * 64] = o[1][r] * fr[r]; }
    {
        const unsigned w0 = selm[ql * 4 + 0], w1 = selm[ql * 4 + 1], w2 = selm[ql * 4 + 2], w3 = selm[ql * 4 + 3];
        o[0] = f32x16{}; o[1] = f32x16{}; l_reg = 0.f;
        auto sel_pred = [&](int t) -> bool { const unsigned wsel = (t < 32) ? w0 : (t < 64) ? w1 : (t < 96) ? w2 : w3; return (wsel >> (t & 31)) & 1u; };
        auto sel_one = [&](int t, lds_cptr kp, lds_cptr vp) { const bool pred = sel_pred(t); if (!__any(pred)) return; const int key0 = 64 * t;
            f32x16 s0, s1; qk_tile(s0, s1, kp, qr);
            if (qw0 - key0 - 63 >= 113) { hook_exp(s0, s1); const float rs = rowsum32(s0, s1); l_reg += pred ? rs : 0.f;
                if (__all(pred)) pv_tile<false>(o, vp, s0, s1, 0u); else pv_tile<true>(o, vp, s0, s1, pred ? 0xffffffffu : 0u); }
            else { hook_near(s0, s1, qpos - key0 - 4 * c.hi, lut); const float rs = rowsum32(s0, s1); l_reg += pred ? rs : 0.f;
                if (__all(pred)) pv_tile<false>(o, vp, s0, s1, 0u); else pv_tile<true>(o, vp, s0, s1, pred ? 0xffffffffu : 0u); } };
        if (!(flags & 4)) run_stream_pairs(c, KS, VS, 0, ci + 1, sel_one,
            [&](int t, lds_cptr kpA, lds_cptr vpA, lds_cptr kpB, lds_cptr vpB) {
                if (qw0 - 64 * (t + 1) - 63 >= 113) {
                    const bool pa = sel_pred(t), pb = sel_pred(t + 1);
                    const bool xa = __any(pa), xb = __any(pb);
                    if (!xa && !xb) return;
                    if (!xb) { sel_one(t, kpA, vpA); return; }
                    if (!xa) { sel_one(t + 1, kpB, vpB); return; }
                    KF kA, kB; ld_k(kA, kpA); ATT_SB();
                    f32x16 a0, a1, b0, b1; qk_mfma(a0, a1, kA, qr); ATT_SB();
                    VF vA, vB; ld_k(kB, kpB); ld_v(vA, vpA); ATT_SB();
                    qk_mfma(b0, b1, kB, qr); hook_exp(a0, a1);
                    const float ra = rowsum32(a0, a1); const PW4 wa = pack4(a0, a1, pa ? 0xffffffffu : 0u); ATT_SB();
                    ld_v(vB, vpB); ATT_SB();
                    pv_mfma(o, vA, wa); hook_exp(b0, b1);
                    const float rb = rowsum32(b0, b1); const PW4 wb = pack4(b0, b1, pb ? 0xffffffffu : 0u); l_reg += (pa ? ra : 0.f) + (pb ? rb : 0.f); ATT_SB();
                    pv_mfma(o, vB, wb);
                } else { sel_one(t, kpA, vpA); sel_one(t + 1, kpB, vpB); } });
        const float Ls = pair_sum(l_reg);
        row_factors(c, g1 / Ls, fr);
#pragma unroll
        for (int r = 0; r < 16; ++r) { park[r * 64] += o[0][r] * fr[r]; park1[r * 64] += o[1][r] * fr[r]; }
    }
    {
        o[0] = f32x16{}; o[1] = f32x16{}; l_reg = 0.f;
        if (!(flags & 8)) run_stream<true>(c, KW, VW, ci >= 8 ? ci - 8 : 0, ci + 1,
            [&](int t, lds_cptr kp, f32x16& s0, f32x16& s1) { qk_tile(s0, s1, kp, qr); },
            [&](int t, lds_cptr vp, f32x16& s0, f32x16& s1) { const int key0 = 64 * t;
                if (qw0 - key0 - 63 < 113) hook_near(s0, s1, qpos - key0 - 4 * c.hi, lut); else if (qw0 + 7 - key0 >= 512) hook_edge(s0, s1, qpos - key0 - 4 * c.hi, 512); else hook_exp(s0, s1);
                l_reg += rowsum32(s0, s1);
                pv_tile<false>(o, vp, s0, s1, 0u); });
        const float Lw = pair_sum(l_reg);
        row_factors(c, g2 / Lw, fr);
#pragma unroll
        for (int r = 0; r < 16; ++r) { o[0][r] = park[r * 64] + o[0][r] * fr[r]; o[1][r] = park1[r * 64] + o[1][r] * fr[r]; }
        asm volatile("s_waitcnt lgkmcnt(0)" ::: "memory");
    }
    bf16* dst = P.mix + ((size_t)b * SEQ + 64 * ci + 8 * c.wid) * DM + 512 + g * 256;
    store_rows(c, o, dst, [](int row) { return (size_t)(row >> 2) * DM + (row & 3) * 64; });
    asm volatile("s_waitcnt lgkmcnt(0)\n\ts_barrier" ::: "memory");
}

__device__ __forceinline__ void attn_phase(LAS unsigned char* lds, const AttnPtrs& P, unsigned* qcounter, int flags) {
    Ctx c = make_ctx(lds, threadIdx.x);
    LAS unsigned* misc = (LAS unsigned*)(c.lds + LDS_MISC);
    { LAS float* lutg = (LAS float*)(c.lds + LDS_LUTG);
      for (int idx = threadIdx.x; idx < 16 * 115; idx += NTHREADS) { const int hh = idx / 115, d = idx % 115;
          lutg[hh * 128 + d] = (d == 0) ? -INFINITY : (P.rel_bias[t5_bucket(d - 1) * 16 + hh] - P.rel_bias[31 * 16 + hh]) * LOG2E; }
      asm volatile("s_waitcnt vmcnt(0) lgkmcnt(0)\n\ts_barrier" ::: "memory"); }
    for (;;) {
        if (threadIdx.x == 0) misc[0] = __hip_atomic_fetch_add(qcounter, 1u, __ATOMIC_RELAXED, __HIP_MEMORY_SCOPE_AGENT);
        asm volatile("s_waitcnt vmcnt(0) lgkmcnt(0)\n\ts_barrier" ::: "memory");
        const unsigned k = misc[0];
        asm volatile("s_waitcnt lgkmcnt(0)\n\ts_barrier" ::: "memory");
        if (k >= 2048u) break;
        const bool is_mp = k >= 512u && k < 1536u;
        if (flags & (is_mp ? 2 : 1)) continue;
        if (k < 512u) { const int s_ = 127 - (int)(k >> 3), bg = k & 7; nsa_item(c, P, bg >> 1, bg & 1, s_, flags); }
        else if (k < 1536u) { const int kk = (int)k - 512, j = kk >> 5, bh = kk & 31; moba_past_item(c, P, bh >> 3, bh & 7, j); }
        else { const int kk = (int)k - 1536; const int s_ = 63 - (kk >> 3), bg = kk & 7; nsa_item(c, P, bg >> 1, bg & 1, s_, flags); }
    }
}
#undef MFMA32
#undef ATT_WAIT_BAR
}
namespace cmpr {
using bf16x8 = __attribute__((ext_vector_type(8))) short;
using f32x16 = __attribute__((ext_vector_type(16))) float;
constexpr int HID_PITCH = 528;
__device__ __forceinline__ float gelu_tanh(float v) { const float u = fminf(fmaxf(0.7978845608028654f * (v + 0.044715f * v * v * v), -15.f), 15.f); const float e = __expf(2.f * u); return 0.5f * v * (1.f + (e - 1.f) / (e + 1.f)); }
__device__ __forceinline__ void compress_unit(LAS unsigned char* lds, int unit, const bf16* qkv, const bf16* w1k, const bf16* w1v, const bf16* w2k, const bf16* w2v, const float* cbp, const float* kncmp, bf16* kcmp, bf16* vcmp) {
    const int tid = threadIdx.x, lane = tid & 63, r32 = lane & 31, hi = lane >> 5; const int wid = __builtin_amdgcn_readfirstlane(tid >> 6);
    const int kv = unit & 1, u = (unit >> 1) & 15, bg = unit >> 5;
    const bf16* src = qkv + 4 * QKV_BIG + (kv ? QKV_SMALL : 0) + (size_t)bg * SEQ * 64;
    const bf16* w1 = kv ? w1v : w1k; const bf16* w2 = kv ? w2v : w2k;
    const int n0 = 32 * u;
    { const bf16* sp = src + (size_t)16 * n0 * 64;
      for (int ch = tid; ch < 4224; ch += NTHREADS) { v4u v = {0u, 0u, 0u, 0u}; if (16 * n0 + (ch >> 3) < SEQ) v = *(const GAS v4u*)(sp + (size_t)ch * 8);
          *(LAS v4u*)(lds + ((ch ^ ((ch >> 7) & 15)) << 4)) = v; } }
    asm volatile("s_waitcnt vmcnt(0) lgkmcnt(0)\n\ts_barrier" ::: "memory");
    const bf16* bp = w1 + ((size_t)wid * 64 + lane) * 8;
    f32x16 acc = {};
#pragma unroll 16
    for (int kk = 0; kk < 128; ++kk) { const int lc = r32 * 128 + 2 * kk + hi; const bf16x8 a = *(const LAS bf16x8*)(lds + ((lc ^ ((lc >> 7) & 15)) << 4)), bfr = *(const bf16x8*)(bp + (size_t)kk * 4096); acc = __builtin_amdgcn_mfma_f32_32x32x16_bf16(a, bfr, acc, 0, 0, 0); }
    float cb = 0.f;
#pragma unroll 8
    for (int ic = 0; ic < 32; ++ic) cb += cbp[(ic * 2 + kv) * 256 + 32 * wid + r32];
    LAS unsigned char* hidL = lds + 69632;
#pragma unroll
    for (int r = 0; r < 16; ++r) { const int n = (r & 3) + 8 * (r >> 2) + 4 * hi; *(LAS bf16*)(hidL + n * HID_PITCH + (32 * wid + r32) * 2) = (bf16)f2bf(gelu_tanh(acc[r] + cb)); }
    asm volatile("s_waitcnt lgkmcnt(0)\n\ts_barrier" ::: "memory");
    if (wid == 0) {
        f32x16 o0 = {}, o1 = {};
#pragma unroll 4
        for (int kk = 0; kk < 16; ++kk) { const bf16x8 hb = *(const LAS bf16x8*)(hidL + r32 * HID_PITCH + (16 * kk + 8 * hi) * 2);
            const bf16x8 a0 = *(const bf16x8*)(w2 + (size_t)r32 * 256 + 16 * kk + 8 * hi), a1 = *(const bf16x8*)(w2 + (size_t)(32 + r32) * 256 + 16 * kk + 8 * hi);
            o0 = __builtin_amdgcn_mfma_f32_32x32x16_bf16(a0, hb, o0, 0, 0, 0); o1 = __builtin_amdgcn_mfma_f32_32x32x16_bf16(a1, hb, o1, 0, 0, 0); }
        float rs = 1.f;
        if (!kv) { float ss = 0.f;
#pragma unroll
            for (int r = 0; r < 16; ++r) ss += o0[r] * o0[r] + o1[r] * o1[r];
            auto rr = __builtin_amdgcn_permlane32_swap(__float_as_uint(ss), __float_as_uint(ss), false, false); ss = __uint_as_float(rr[0]) + __uint_as_float(rr[1]);
            rs = rsqrtf(ss * (1.f / 64.f) + 1e-6f); }
        const int n = n0 + r32; bf16* dst = (kv ? vcmp : kcmp) + ((size_t)bg * 512 + n) * 64;
#pragma unroll
        for (int r = 0; r < 16; ++r) { const int d = (r & 3) + 8 * (r >> 2) + 4 * hi;
            float v0 = o0[r] * rs, v1 = o1[r] * rs; if (!kv) { v0 *= kncmp[d]; v1 *= kncmp[d + 32]; }
            if (n >= NCMP) { v0 = 0.f; v1 = 0.f; }
            dst[d] = (bf16)f2bf(v0); dst[d + 32] = (bf16)f2bf(v1); }
    }
    asm volatile("s_waitcnt lgkmcnt(0)\n\ts_barrier" ::: "memory");
}
}
__global__ void __launch_bounds__(NTHREADS, 2) mk_fwd(Args a) {
    extern __shared__ __attribute__((aligned(16))) unsigned char lds[];
    Frame F;
    F.lds = (LAS unsigned char*)lds;
    F.tid = threadIdx.x; F.lane = F.tid & 63; F.wave = __builtin_amdgcn_readfirstlane(F.tid >> 6);
    F.G = gridDim.x; { const int bx = blockIdx.x; F.vcu = (F.G % 8 == 0) ? (bx % 8) * (F.G / 8) + bx / 8 : bx; }
    cg::grid_group grid = cg::this_grid();
    volatile LAS unsigned* xst = (volatile LAS unsigned*)(F.lds + 147424);
    if (F.tid < 8) xst[F.tid] = 0u;
    __syncthreads();
    const XcdBarrier xbar = xcd_barrier_post((unsigned*)(a.ws + WS_CTL) + 4096, xst);
    unsigned char* ws = a.ws;
    const int lo = a.ph_lo, hi = a.ph_hi;
    const att::AttnPtrs P{(const bf16*)(ws + WS_QKV), (const float*)(ws + WS_KMP), (const float*)(ws + WS_GATES), (const bf16*)(ws + WS_KCMP), (const bf16*)(ws + WS_VCMP), a.in[2], (bf16*)(ws + WS_MIX),
                          (unsigned*)(ws + WS_SELG), (bf16*)(ws + WS_PARTO), (float*)(ws + WS_PARTL)};
#define IN(k) (lo <= (k) && (k) < hi)
#define SEAM(k) do { if (IN(k) && IN((k) + 1)) { if ((k) == 0) grid.sync(); else xcd_barrier(xbar); } } while (0)
    if (IN(0)) { phase_prologue_a(F, a); } SEAM(0);
    if (IN(1)) { phase_prologue_b(F, a); } SEAM(1);
    if (IN(2)) {
        pg8::Gemm g{(const pg8::bf16_t*)(ws + WS_H), (const pg8::bf16_t*)(ws + WS_WIN), TOK, NIN_PAD, DM}; pg8::StaticOrder S; S.init(TOK, NIN_PAD, F.G, (int)blockIdx.x);
        pg8::EpiInProj E{(pg8::bf16_t*)(ws + WS_QKV), (float*)(ws + WS_GATES), (float*)(ws + WS_KMP), a.in[7], a.in[8], a.in[9], a.in[11], a.in[12]};
        pg8::gemm_phase<pg8::EpiInProj, pg8::StaticOrder, true, true>(F.lds, g, S, E);
    } SEAM(2);
    if (IN(3)) {
        att::moba_gate_phase(P, F.vcu, F.G, F.tid);
        for (int unit = F.vcu; unit < 256; unit += F.G)
            cmpr::compress_unit(F.lds, unit, (const bf16*)(ws + WS_QKV), (const bf16*)(ws + WS_W1K), (const bf16*)(ws + WS_W1V), (const bf16*)(ws + WS_W2K), (const bf16*)(ws + WS_W2V),
                                (const float*)(ws + WS_CBP), a.in[10], (bf16*)(ws + WS_KCMP), (bf16*)(ws + WS_VCMP));
    } SEAM(3);
    if (IN(4)) {
                att::attn_phase(F.lds, P, (unsigned*)(ws + WS_CTL) + 64, 0);
    } SEAM(4);
    if (IN(5)) { att::moba_merge_pass(P, F.vcu, F.G, F.tid); } SEAM(5);
    if (IN(6)) {
        pg8::Gemm g{(const pg8::bf16_t*)(ws + WS_MIX), (const pg8::bf16_t*)(ws + WS_WOUT), TOK, DM, DM}; pg8::StaticOrder S; S.init(TOK, DM, F.G, (int)blockIdx.x);
        pg8::EpiOutProj E{(pg8::bf16_t*)(ws + WS_Y), (const float*)(ws + WS_MOD) + 2 * DM};
        pg8::gemm_phase<pg8::EpiOutProj, pg8::StaticOrder, true, true>(F.lds, g, S, E);
    } SEAM(6);
    if (IN(7)) { phase_norm2(F, a); } SEAM(7);
    if (IN(8)) {
        pg8::Gemm g{(const pg8::bf16_t*)(ws + WS_H), (const pg8::bf16_t*)(ws + WS_WGU), TOK, 2 * FF, DM}; pg8::StaticOrder S; S.init(TOK, 2 * FF, F.G, (int)blockIdx.x);
        pg8::EpiGateUp E{(pg8::bf16_t*)(ws + WS_ACT)};
        pg8::gemm_phase<pg8::EpiGateUp, pg8::StaticOrder, true, true>(F.lds, g, S, E);
    } SEAM(8);
    if (IN(9)) {
        pg8::Gemm g{(const pg8::bf16_t*)(ws + WS_ACT), (const pg8::bf16_t*)(ws + WS_WDN), TOK, DM, FF}; pg8::StaticOrder S; S.init(TOK, DM, F.G, (int)blockIdx.x);
        pg8::EpiDown E{a.in[0], (const pg8::bf16_t*)(ws + WS_Y), a.out, (const float*)(ws + WS_MOD) + 5 * DM};
        pg8::gemm_phase<pg8::EpiDown, pg8::StaticOrder, true, true>(F.lds, g, S, E);
    }
#undef IN
#undef SEAM
}

static void launch_phases(const Args& base, int lo, int hi, int grid, hipStream_t stream, int flags = 0) {
    Args a = base; a.ph_lo = lo; a.ph_hi = hi; (void)flags;
    if (hi - lo > 1) { void* args[] = {&a}; (void)hipLaunchCooperativeKernel((const void*)mk_fwd, dim3(grid), dim3(NTHREADS), args, LDS_BYTES, stream); }
    else hipLaunchKernelGGL(mk_fwd, dim3(grid), dim3(NTHREADS), LDS_BYTES, stream, a);
}
extern "C" void kernel_launch(void* const* d_in, const int* in_sizes, int n_in, void* d_out, int out_size, void* d_ws, size_t ws_size, hipStream_t stream) {
    static int grid = 0;
    if (grid == 0) {
        int dev = 0, cus = 0, per_cu = 0;
        if (n_in != 23 || ws_size < 480 * MiB || hipGetDevice(&dev) != hipSuccess || hipDeviceGetAttribute(&cus, hipDeviceAttributeMultiprocessorCount, dev) != hipSuccess) { grid = -1; return; }
        if (hipFuncSetAttribute((const void*)mk_fwd, hipFuncAttributeMaxDynamicSharedMemorySize, LDS_BYTES) != hipSuccess) { grid = -1; return; }
        if (hipOccupancyMaxActiveBlocksPerMultiprocessor(&per_cu, (const void*)mk_fwd, NTHREADS, LDS_BYTES) != hipSuccess || per_cu < 1) { grid = -1; return; }
        grid = cus;
    }
    if (grid < 0) return;
    (void)hipMemsetAsync((char*)d_ws + WS_CTL, 0, CTL_ZERO_BYTES, stream);
    Args a{};
    for (int i = 0; i < 23; ++i) a.in[i] = (const float*)d_in[i];
    a.out = (float*)d_out; a.ws = (unsigned char*)d_ws;
    unsigned char* ws = (unsigned char*)d_ws;
#if HYBRID == 1
    launch_phases(a, 0, 1, grid, stream); launch_phases(a, 1, 2, grid, stream); launch_phases(a, 2, 3, grid, stream);
    const bf16* qkv = (const bf16*)(ws + WS_QKV); bf16* mix = (bf16*)(ws + WS_MIX); bf16* kcmp = (bf16*)(ws + WS_KCMP); bf16* vcmp = (bf16*)(ws + WS_VCMP);
    int* sel = (int*)(ws + 344 * MiB); float* obuf = (float*)(ws + 348 * MiB); const float* gates = (const float*)(ws + WS_GATES);
    nq::k_compress<<<dim3(4 * 2 * 512, 2), 256, 0, stream>>>(qkv, a.in[13], a.in[14], a.in[15], a.in[16], a.in[17], a.in[18], a.in[10], kcmp, vcmp);
    nq::k_moba<<<4 * 8 * SEQ / 4, 256, 0, stream>>>(qkv, (const float*)(ws + WS_KMP), a.in[2], mix);
    nq::k_nsa_cmp<<<4 * 2 * SEQ, 256, 0, stream>>>(qkv, kcmp, vcmp, gates, obuf, sel);
    nq::k_nsa_sel<<<4 * 2 * SEQ, 256, 0, stream>>>(qkv, sel, a.in[2], gates, obuf);
    nq::k_nsa_win<<<4 * 2 * SEQ, 256, 0, stream>>>(qkv, a.in[2], gates, obuf, mix);
    launch_phases(a, 5, 6, grid, stream); launch_phases(a, 6, 7, grid, stream); launch_phases(a, 7, 8, grid, stream); launch_phases(a, 8, 9, grid, stream);
#elif HYBRID == 2
    launch_phases(a, 0, 1, grid, stream); launch_phases(a, 1, 2, grid, stream); launch_phases(a, 2, 3, grid, stream);
    nq::k_compress<<<dim3(4 * 2 * 512, 2), 256, 0, stream>>>((const bf16*)(ws + WS_QKV), a.in[13], a.in[14], a.in[15], a.in[16], a.in[17], a.in[18], a.in[10], (bf16*)(ws + WS_KCMP), (bf16*)(ws + WS_VCMP));
    launch_phases(a, 4, 5, grid, stream);
    launch_phases(a, 5, 6, grid, stream); launch_phases(a, 6, 7, grid, stream); launch_phases(a, 7, 8, grid, stream); launch_phases(a, 8, 9, grid, stream);
#elif HYBRID == 3
    for (int p = 0; p < N_PHASES; ++p) {
#if defined(TIME_PHASE)
        if (p == TIME_PHASE) { for (int r = 0; r < TIME_REPS; ++r) { launch_phases(a, p, p + 1, grid, stream, TIME_FLAGS); (void)hipMemsetAsync((char*)d_ws + WS_CTL, 0, CTL_ZERO_BYTES, stream); } }
#endif
        launch_phases(a, p, p + 1, grid, stream);
#if defined(ABL_REPS)
        if (p == 3) { static bool once = false; if (!once) { once = true; (void)hipFuncSetAttribute((const void*)k_attn_abl, hipFuncAttributeMaxDynamicSharedMemorySize, LDS_BYTES); }
            for (int r = 0; r < ABL_REPS; ++r) { (void)hipMemsetAsync((char*)d_ws + WS_CTL + 512, 0, 4, stream); hipLaunchKernelGGL(k_attn_abl, dim3(grid), dim3(NTHREADS), LDS_BYTES, stream, a); } }
#endif
    }
#else
    launch_phases(a, 0, N_PHASES, grid, stream);
#endif
}
```

```cpp
#include <hip/hip_runtime.h>
#include <hip/hip_cooperative_groups.h>
#include <cstdint>
#include <cstdio>
namespace cg = cooperative_groups;
#define HYBRID 0
namespace pg8 {
#define PG8_LAS __attribute__((address_space(3)))
typedef unsigned short bf16_t;
typedef short bf16x8 __attribute__((ext_vector_type(8)));
typedef float f32x4 __attribute__((ext_vector_type(4)));
typedef unsigned u32x4 __attribute__((ext_vector_type(4)));
constexpr int BM = 256, BK = 64, HALF = 128, HTB = HALF * BK * 2  , STAGE_BYTES = 8 * HTB, NXCD = 8, WGM = 8;

__host__ __device__ __forceinline__ int lds_byte(int r, int c) { const int st = (r >> 4) * 2 + (c >> 5), rr = r & 15, cc = c & 31, ob = rr * 64 + cc * 2; return st * 1024 + (ob ^ (((ob >> 9) & 1) << 5)); }
__host__ __device__ __forceinline__ void stage_rc(int b, int& R, int& C) { const int st = b / 1024, sb = b % 1024, swz = sb ^ (((sb >> 9) & 1) << 5); R = (st >> 1) * 16 + swz / 64; C = (st & 1) * 32 + (swz % 64) / 2; }
__host__ __device__ __forceinline__ int perm32(int rho) { const int n = rho >> 4, i = rho & 15; return 8 * (i >> 2) + 4 * n + (i & 3); }

struct Unit { int pm, pn; };
struct Gemm { const bf16_t* A; const bf16_t* Bt; int M, N, K; };

struct StaticOrder {
    int nM, nN, nwg, G, c;
    __host__ __device__ void init(int M, int N, int G_, int c_) { nM = M / BM; nN = N / BM; nwg = nM * nN; G = G_; c = c_; }
    __host__ __device__ bool next(int i, Unit& u) const {
        const long L = (long)i * G + c; if (L >= nwg) return false;
        int wgid = (int)L; { const int q = nwg / NXCD, r = nwg % NXCD, xcd = wgid % NXCD, off = wgid / NXCD; wgid = (xcd < r ? xcd * (q + 1) : r * (q + 1) + (xcd - r) * q) + off; }
        const int nig = WGM * nN, gid = wgid / nig, fm = gid * WGM, gsz = (nM - fm) < WGM ? (nM - fm) : WGM;
        u.pm = fm + ((wgid % nig) % gsz); u.pn = (wgid % nig) / gsz; return true;
    }
    __device__ __forceinline__ void a_ready(const Unit&) const {}
    __device__ __forceinline__ void done(const Unit&) const {}
};

__device__ __forceinline__ unsigned cvt_pk_bf16(float lo, float hi) { unsigned r; asm volatile("v_cvt_pk_bf16_f32 %0, %1, %2" : "=v"(r) : "v"(lo), "v"(hi)); return r; }
typedef float f32x2 __attribute__((ext_vector_type(2)));
template <class Epi, class Sched, bool ALIGN_EPI = false, bool SP2 = false>
__device__ __forceinline__ void gemm_phase(PG8_LAS unsigned char* lds, const Gemm g, const Sched& S, const Epi& E) {
    const int tid = threadIdx.x, wid = __builtin_amdgcn_readfirstlane(tid >> 6), lane = tid & 63, wr = wid >> 2, wc = wid & 3, fr = lane & 15, fq = lane >> 4;
    const int K = g.K, nt = K / BK;
    unsigned voffA[2], voffB[2];
#pragma unroll
    for (int i = 0; i < 2; ++i) { int R, C; stage_rc(tid * 16 + i * 8192, R, C); const int Rb = Epi::PERM ? ((R & ~31) + perm32(R & 31)) : R;
        voffA[i] = (unsigned)(R * K + C) * 2u; voffB[i] = (unsigned)(Rb * K + C) * 2u; }
    const size_t kstep = (size_t)(BK * 2);
    const size_t hstep = (size_t)HALF * K * 2;
    const size_t tstep = 2 * hstep;
    const unsigned ldsw = (unsigned)wid * 1024u;
    const int aoff = lds_byte(wr * 64 + fr, fq * 8), boff = lds_byte(wc * 32 + fr, fq * 8);
#define PG8_SA(b, h) (((b) * 2 + (h)) * HTB)
#define PG8_SB(b, h) ((4 + (b) * 2 + (h)) * HTB)
#define PG8_STAGE(bufoff, gbase, voff) do { _Pragma("unroll") for (int _i = 0; _i < 2; ++_i) \
        __builtin_amdgcn_global_load_lds((const unsigned*)((const char*)(gbase) + (voff)[_i]), (PG8_LAS unsigned*)(lds + (bufoff) + ldsw + _i * 8192), 16, 0, 0); } while (0)
#define PG8_LDA(dst, b, h) do { _Pragma("unroll") for (int m = 0; m < 4; ++m) _Pragma("unroll") for (int k = 0; k < 2; ++k) dst[m][k] = *(const PG8_LAS bf16x8*)(lds + PG8_SA(b, h) + aoff + m * 2048 + k * 1024); } while (0)
#define PG8_LDB(dst, b, h) do { _Pragma("unroll") for (int n = 0; n < 2; ++n) _Pragma("unroll") for (int k = 0; k < 2; ++k) dst[n][k] = *(const PG8_LAS bf16x8*)(lds + PG8_SB(b, h) + boff + n * 2048 + k * 1024); } while (0)
#define PG8_MMA(ai, bj, At, Bt) do { __builtin_amdgcn_s_setprio(1); _Pragma("unroll") for (int m = 0; m < 4; ++m) _Pragma("unroll") for (int n = 0; n < 2; ++n) _Pragma("unroll") for (int k = 0; k < 2; ++k) \
        acc[ai][bj][m][n] = __builtin_amdgcn_mfma_f32_16x16x32_bf16(Bt[n][k], At[m][k], acc[ai][bj][m][n], 0, 0, 0); __builtin_amdgcn_s_setprio(0); } while (0)
#define PG8_WAIT_V(n) asm volatile("s_waitcnt vmcnt(" #n ")" ::: "memory")
#define PG8_WAIT_L(n) asm volatile("s_waitcnt lgkmcnt(" #n ")" ::: "memory")
#define PG8_BAR __builtin_amdgcn_s_barrier()
#define PG8_SCHED __builtin_amdgcn_sched_barrier(0)
    Unit cur, nxt; int ui = 0;
    if (!S.next(0, cur)) return;
    f32x4 acc[2][2][4][2];
#pragma unroll
    for (int a = 0; a < 2; ++a)
#pragma unroll
        for (int b = 0; b < 2; ++b)
#pragma unroll
            for (int m = 0; m < 4; ++m)
#pragma unroll
                for (int n = 0; n < 2; ++n) acc[a][b][m][n] = (f32x4){0.f, 0.f, 0.f, 0.f};
    bf16x8 At[4][2], B0[2][2], B1[2][2];
    const char* cA = (const char*)g.A + (size_t)cur.pm * tstep; const char* cB = (const char*)g.Bt + (size_t)cur.pn * tstep;
    S.a_ready(cur);
    if constexpr (SP2) {
        PG8_STAGE(PG8_SB(0, 0), cB, voffB); PG8_STAGE(PG8_SB(0, 1), cB + hstep, voffB); PG8_STAGE(PG8_SA(0, 0), cA, voffA); PG8_STAGE(PG8_SA(0, 1), cA + hstep, voffA);
        if (wr == 1) PG8_BAR;
        PG8_WAIT_V(2); PG8_BAR;
        PG8_STAGE(PG8_SB(1, 0), cB + kstep, voffB); PG8_STAGE(PG8_SA(1, 0), cA + kstep, voffA); PG8_STAGE(PG8_SB(1, 1), cB + hstep + kstep, voffB);
        PG8_WAIT_V(6); PG8_BAR;
    } else {
        PG8_STAGE(PG8_SB(0, 0), cB, voffB); PG8_STAGE(PG8_SA(0, 0), cA, voffA); PG8_STAGE(PG8_SB(0, 1), cB + hstep, voffB); PG8_STAGE(PG8_SA(0, 1), cA + hstep, voffA);
        if (wr == 1) PG8_BAR;
        PG8_WAIT_V(4); PG8_BAR;
        PG8_STAGE(PG8_SB(1, 0), cB + kstep, voffB); PG8_STAGE(PG8_SA(1, 0), cA + kstep, voffA); PG8_STAGE(PG8_SB(1, 1), cB + hstep + kstep, voffB);
        PG8_WAIT_V(6); PG8_BAR;
    }
    for (;;) {
        const bool has_next = S.next(ui + 1, nxt);
        const char* nA = has_next ? (const char*)g.A + (size_t)nxt.pm * tstep : cA; const char* nB = has_next ? (const char*)g.Bt + (size_t)nxt.pn * tstep : cB;
        for (int t = 0; t < nt; t += 2) {
            const bool last = (t == nt - 2);
            const char* a1 = cA + (size_t)(t + 1) * kstep;
            const char* a2 = last ? nA : cA + (size_t)(t + 2) * kstep; const char* b2 = last ? nB : cB + (size_t)(t + 2) * kstep;
            const char* a3 = a2 + kstep; const char* b3 = b2 + kstep;
            if (last && has_next) S.a_ready(nxt);
            if constexpr (SP2) {
            PG8_LDB(B0, 0, 0); PG8_LDB(B1, 0, 1); PG8_SCHED; PG8_LDA(At, 0, 0); PG8_STAGE(PG8_SA(1, 1), a1 + hstep, voffA);
            PG8_WAIT_V(8); PG8_WAIT_L(0); PG8_BAR; PG8_MMA(0, 0, At, B0); PG8_MMA(0, 1, At, B1); PG8_BAR; PG8_SCHED;
            PG8_LDA(At, 0, 1); PG8_STAGE(PG8_SB(0, 0), b2, voffB); PG8_STAGE(PG8_SB(0, 1), b2 + hstep, voffB); PG8_STAGE(PG8_SA(0, 0), a2, voffA);
            PG8_WAIT_V(8); PG8_WAIT_L(0); PG8_BAR; PG8_MMA(1, 0, At, B0); PG8_MMA(1, 1, At, B1); PG8_BAR; PG8_SCHED;
            PG8_LDB(B0, 1, 0); PG8_LDB(B1, 1, 1); PG8_SCHED; PG8_LDA(At, 1, 0); PG8_STAGE(PG8_SA(0, 1), a2 + hstep, voffA);
            PG8_WAIT_V(8); PG8_WAIT_L(0); PG8_BAR; PG8_MMA(0, 0, At, B0); PG8_MMA(0, 1, At, B1); PG8_BAR; PG8_SCHED;
            PG8_LDA(At, 1, 1); PG8_STAGE(PG8_SB(1, 0), b3, voffB); PG8_STAGE(PG8_SB(1, 1), b3 + hstep, voffB); PG8_STAGE(PG8_SA(1, 0), a3, voffA);
            PG8_WAIT_V(8); PG8_WAIT_L(0); PG8_BAR; PG8_MMA(1, 0, At, B0); PG8_MMA(1, 1, At, B1); PG8_BAR; PG8_SCHED;
            } else {
            PG8_LDB(B0, 0, 0); PG8_SCHED; PG8_LDA(At, 0, 0); PG8_STAGE(PG8_SA(1, 1), a1 + hstep, voffA);
            PG8_WAIT_L(8); PG8_BAR; PG8_WAIT_L(0); PG8_MMA(0, 0, At, B0); PG8_BAR; PG8_SCHED;
            PG8_LDB(B1, 0, 1); PG8_STAGE(PG8_SB(0, 0), b2, voffB);
            PG8_BAR; PG8_WAIT_L(0); PG8_MMA(0, 1, At, B1); PG8_BAR;
            PG8_LDA(At, 0, 1); PG8_STAGE(PG8_SA(0, 0), a2, voffA);
            PG8_BAR; PG8_WAIT_L(0); PG8_MMA(1, 0, At, B0); PG8_BAR; PG8_SCHED;
            PG8_STAGE(PG8_SB(0, 1), b2 + hstep, voffB);
            PG8_WAIT_V(6); PG8_BAR; PG8_MMA(1, 1, At, B1); PG8_BAR;
            PG8_LDB(B0, 1, 0); PG8_SCHED; PG8_LDA(At, 1, 0); PG8_STAGE(PG8_SA(0, 1), a2 + hstep, voffA);
            PG8_WAIT_L(8); PG8_BAR; PG8_WAIT_L(0); PG8_MMA(0, 0, At, B0); PG8_BAR; PG8_SCHED;
            PG8_LDB(B1, 1, 1); PG8_STAGE(PG8_SB(1, 0), b3, voffB);
            PG8_BAR; PG8_WAIT_L(0); PG8_MMA(0, 1, At, B1); PG8_BAR;
            PG8_LDA(At, 1, 1); PG8_STAGE(PG8_SA(1, 0), a3, voffA);
            PG8_BAR; PG8_WAIT_L(0); PG8_MMA(1, 0, At, B0); PG8_BAR; PG8_SCHED;
            PG8_STAGE(PG8_SB(1, 1), b3 + hstep, voffB);
            PG8_WAIT_V(6); PG8_BAR; PG8_MMA(1, 1, At, B1); PG8_BAR;
            }
        }
        if constexpr (ALIGN_EPI) { if (wr == 0) PG8_BAR; }
        if constexpr (!Epi::AFTER_DRAIN) { E(acc, cur, wr, wc, fr, fq); S.done(cur); }
        if (!has_next) break;
#pragma unroll
        for (int a = 0; a < 2; ++a)
#pragma unroll
            for (int b = 0; b < 2; ++b)
#pragma unroll
                for (int m = 0; m < 4; ++m)
#pragma unroll
                    for (int n = 0; n < 2; ++n) acc[a][b][m][n] = (f32x4){0.f, 0.f, 0.f, 0.f};
        cur = nxt; cA = nA; cB = nB; ++ui;
        if constexpr (ALIGN_EPI) { if (wr == 1) PG8_BAR; }
    }
    PG8_WAIT_V(0);
    if constexpr (!ALIGN_EPI) { if (wr == 0) PG8_BAR; }
    PG8_BAR;
    if constexpr (Epi::AFTER_DRAIN) { E.fused(acc, cur, wr, wc, fr, fq, lds, wid, lane); S.done(cur); }
#undef PG8_SA
#undef PG8_SB
#undef PG8_STAGE
#undef PG8_LDA
#undef PG8_LDB
#undef PG8_MMA
#undef PG8_WAIT_V
#undef PG8_WAIT_L
#undef PG8_BAR
#undef PG8_SCHED
}
}
namespace pg8 {
typedef unsigned u32x2v __attribute__((ext_vector_type(2)));
constexpr int TOK_S = 8192;
constexpr float QK_EPS = 1e-6f;
constexpr float C2 = 0.125f * 1.4426950408889634f;
__device__ __forceinline__ float sigmoid_fast(float v) { return __builtin_amdgcn_rcpf(1.f + __builtin_amdgcn_exp2f(-1.4426950408889634f * v)); }
__device__ __forceinline__ float silu_fast(float v) { return v * __builtin_amdgcn_rcpf(1.f + __builtin_amdgcn_exp2f(-1.4426950408889634f * v)); }

struct EpiInProj {
    static constexpr bool PERM = true, AFTER_DRAIN = false;
    bf16_t* qkv;
    float* gates;
    float* kmean_part;
    const float *qna, *kna, *qnb, *knsel, *knwin;
    __device__ __forceinline__ void operator()(const f32x4 (&acc)[2][2][4][2], const Unit& u, int wr, int wc, int fr, int fq) const {
        const int slot = u.pn * 4 + wc;
        if (slot > 44) return;
        const int b = u.pm >> 5, blk = u.pm & 31, pos0 = blk * 256 + wr * 64 + fr;
        if (slot == 44) {
            if (fq < 3) {
#pragma unroll
                for (int ai = 0; ai < 2; ++ai)
#pragma unroll
                    for (int m = 0; m < 4; ++m) { const size_t tok = (size_t)b * TOK_S + pos0 + ai * HALF + m * 16; float* gp = gates + tok * 24 + 8 * fq;
                        const f32x4 v0 = acc[ai][0][m][0], v1 = acc[ai][0][m][1];
                        *(f32x4*)gp = (f32x4){sigmoid_fast(v0[0]), sigmoid_fast(v0[1]), sigmoid_fast(v0[2]), sigmoid_fast(v0[3])};
                        *(f32x4*)(gp + 4) = (f32x4){sigmoid_fast(v1[0]), sigmoid_fast(v1[1]), sigmoid_fast(v1[2]), sigmoid_fast(v1[3])}; }
            }
            return;
        }
        const float* gain = nullptr; float qscale = 1.f; bool is_ka = false; bf16_t* dst;
        constexpr size_t BIG = (size_t)4 * 8 * TOK_S * 64, SMALL = (size_t)4 * 2 * TOK_S * 64;
        if (slot < 32) { const int kind = slot >> 3, head = slot & 7; dst = qkv + kind * BIG + ((size_t)(b * 8 + head) * TOK_S) * 64;
            if (kind == 0) { gain = qna; qscale = C2; } else if (kind == 1) { gain = kna; is_ka = true; } else if (kind == 3) { gain = qnb; qscale = C2; } }
        else { const int kind = (slot - 32) >> 1, g = slot & 1; dst = qkv + 4 * BIG + kind * SMALL + ((size_t)(b * 2 + g) * TOK_S) * 64;
            if (kind == 2) gain = knsel; else if (kind == 4) gain = knwin; }
        float gv[16];
#pragma unroll
        for (int i = 0; i < 16; ++i) gv[i] = gain ? gain[(i >> 3) * 32 + 8 * fq + (i & 7)] * qscale : 1.f;
        float cs[16];
#pragma unroll
        for (int i = 0; i < 16; ++i) cs[i] = 0.f;
#pragma unroll
        for (int ai = 0; ai < 2; ++ai)
#pragma unroll
            for (int m = 0; m < 4; ++m) {
                float v[16];
#pragma unroll
                for (int bj = 0; bj < 2; ++bj)
#pragma unroll
                    for (int n = 0; n < 2; ++n)
#pragma unroll
                        for (int j = 0; j < 4; ++j) v[bj * 8 + n * 4 + j] = acc[ai][bj][m][n][j];
                if (gain) { float ss = 0.f;
#pragma unroll
                    for (int i = 0; i < 16; ++i) ss += v[i] * v[i];
                    ss += __shfl_xor(ss, 16); ss += __shfl_xor(ss, 32);
                    const float rs = rsqrtf(ss * (1.f / 64.f) + QK_EPS);
#pragma unroll
                    for (int i = 0; i < 16; ++i) v[i] *= rs * gv[i]; }
                if (is_ka) {
#pragma unroll
                    for (int i = 0; i < 16; ++i) cs[i] += v[i]; }
                bf16_t* rp = dst + (size_t)(pos0 + ai * HALF + m * 16) * 64 + 8 * fq;
                u32x4 w0, w1;
                w0.x = cvt_pk_bf16(v[0], v[1]); w0.y = cvt_pk_bf16(v[2], v[3]); w0.z = cvt_pk_bf16(v[4], v[5]); w0.w = cvt_pk_bf16(v[6], v[7]);
                w1.x = cvt_pk_bf16(v[8], v[9]); w1.y = cvt_pk_bf16(v[10], v[11]); w1.z = cvt_pk_bf16(v[12], v[13]); w1.w = cvt_pk_bf16(v[14], v[15]);
                *(u32x4*)rp = w0; *(u32x4*)(rp + 32) = w1;
            }
        if (is_ka) {
#pragma unroll
            for (int i = 0; i < 16; ++i) { float s = cs[i]; s += __shfl_xor(s, 1); s += __shfl_xor(s, 2); s += __shfl_xor(s, 4); s += __shfl_xor(s, 8); cs[i] = s; }
            if (fr == 0) { float* kp = kmean_part + ((size_t)((b * 8 + (slot & 7)) * 32 + blk) * 2 + wr) * 64 + 8 * fq;
                *(f32x4*)kp = (f32x4){cs[0], cs[1], cs[2], cs[3]}; *(f32x4*)(kp + 4) = (f32x4){cs[4], cs[5], cs[6], cs[7]};
                *(f32x4*)(kp + 32) = (f32x4){cs[8], cs[9], cs[10], cs[11]}; *(f32x4*)(kp + 36) = (f32x4){cs[12], cs[13], cs[14], cs[15]}; }
        }
    }
};
struct EpiOutProj {
    static constexpr bool PERM = true, AFTER_DRAIN = false;
    bf16_t* y; const float* gt;
    __device__ __forceinline__ void operator()(const f32x4 (&acc)[2][2][4][2], const Unit& u, int wr, int wc, int fr, int fq) const {
        const int b = u.pm >> 5; const int col0 = u.pn * BM + wc * 32 + 8 * fq; const float* gtb = gt + (size_t)b * 6144;
#pragma unroll
        for (int bj = 0; bj < 2; ++bj) { const int c = col0 + bj * HALF; const f32x4 g40 = *(const f32x4*)(gtb + c), g41 = *(const f32x4*)(gtb + c + 4);
#pragma unroll
            for (int ai = 0; ai < 2; ++ai)
#pragma unroll
                for (int m = 0; m < 4; ++m) { const size_t off = (size_t)(u.pm * BM + ai * HALF + wr * 64 + m * 16 + fr) * 1024 + c;
                    const f32x4 y0 = g40 * acc[ai][bj][m][0], y1 = g41 * acc[ai][bj][m][1];
                    u32x4 w; w.x = cvt_pk_bf16(y0[0], y0[1]); w.y = cvt_pk_bf16(y0[2], y0[3]); w.z = cvt_pk_bf16(y1[0], y1[1]); w.w = cvt_pk_bf16(y1[2], y1[3]);
                    *(u32x4*)(y + off) = w; } }
    }
};
struct EpiGateUp {
    static constexpr bool PERM = true, AFTER_DRAIN = false;
    bf16_t* act;
    __device__ __forceinline__ void operator()(const f32x4 (&acc)[2][2][4][2], const Unit& u, int wr, int wc, int fr, int fq) const {
        const int h0 = u.pn * 128 + wc * 32 + 8 * fq;
#pragma unroll
        for (int ai = 0; ai < 2; ++ai)
#pragma unroll
            for (int m = 0; m < 4; ++m) { const size_t row = (size_t)(u.pm * BM + ai * HALF + wr * 64 + m * 16 + fr);
                const f32x4 g0 = acc[ai][0][m][0], g1 = acc[ai][0][m][1], u0 = acc[ai][1][m][0], u1 = acc[ai][1][m][1];
                u32x4 w;
                w.x = cvt_pk_bf16(silu_fast(g0[0]) * u0[0], silu_fast(g0[1]) * u0[1]); w.y = cvt_pk_bf16(silu_fast(g0[2]) * u0[2], silu_fast(g0[3]) * u0[3]);
                w.z = cvt_pk_bf16(silu_fast(g1[0]) * u1[0], silu_fast(g1[1]) * u1[1]); w.w = cvt_pk_bf16(silu_fast(g1[2]) * u1[2], silu_fast(g1[3]) * u1[3]);
                *(u32x4*)(act + row * 2816 + h0) = w; }
    }
};
struct EpiDown {
    static constexpr bool PERM = true, AFTER_DRAIN = false;
    const float* x; const bf16_t* y; float* out; const float* gt;
    __device__ __forceinline__ void operator()(const f32x4 (&acc)[2][2][4][2], const Unit& u, int wr, int wc, int fr, int fq) const {
        const int b = u.pm >> 5; const int col0 = u.pn * BM + wc * 32 + 8 * fq; const float* gtb = gt + (size_t)b * 6144;
#pragma unroll
        for (int bj = 0; bj < 2; ++bj) { const int c = col0 + bj * HALF; const f32x4 g40 = *(const f32x4*)(gtb + c), g41 = *(const f32x4*)(gtb + c + 4);
#pragma unroll
            for (int ai = 0; ai < 2; ++ai)
#pragma unroll
                for (int m = 0; m < 4; ++m) { const size_t off = (size_t)(u.pm * BM + ai * HALF + wr * 64 + m * 16 + fr) * 1024 + c;
                    const f32x4 x0 = *(const f32x4*)(x + off), x1 = *(const f32x4*)(x + off + 4); const u32x4 yw = *(const u32x4*)(y + off);
                    const f32x4 y0 = {__builtin_bit_cast(float, yw.x << 16), __builtin_bit_cast(float, yw.x & 0xffff0000u), __builtin_bit_cast(float, yw.y << 16), __builtin_bit_cast(float, yw.y & 0xffff0000u)};
                    const f32x4 y1 = {__builtin_bit_cast(float, yw.z << 16), __builtin_bit_cast(float, yw.z & 0xffff0000u), __builtin_bit_cast(float, yw.w << 16), __builtin_bit_cast(float, yw.w & 0xffff0000u)};
                    *(f32x4*)(out + off) = (x0 + y0) + g40 * acc[ai][bj][m][0]; *(f32x4*)(out + off + 4) = (x1 + y1) + g41 * acc[ai][bj][m][1]; } }
    }
};
}
constexpr int NWAVES = 8, NTHREADS = 512;
constexpr int BATCH = 4, SEQ = 8192, DM = 1024, TOK = BATCH * SEQ, NIN = 2840, NIN_PAD = 3072, FF = 2816, NCMP = 511;
constexpr size_t MiB = 1u << 20;
constexpr size_t WS_CTL = 0, CTL_ZERO_BYTES = 64 * 1024;
constexpr size_t WS_MODP = 1 * MiB;
constexpr size_t WS_MOD = 2 * MiB;
constexpr size_t WS_CBP = 2 * MiB + 512 * 1024;
constexpr size_t WS_KMP = 3 * MiB;
constexpr size_t WS_BIAS2 = 4 * MiB;
constexpr size_t WS_SSP = 449 * MiB;
constexpr size_t WS_WIN = 6 * MiB, WS_WOUT = 12 * MiB, WS_WGU = 14 * MiB, WS_WDN = 25 * MiB;
constexpr size_t WS_W1K = 31 * MiB, WS_W1V = 32 * MiB, WS_W2K = 33 * MiB, WS_W2V = 33 * MiB + 64 * 1024;
constexpr size_t WS_KCMP = 34 * MiB, WS_VCMP = 35 * MiB;
constexpr size_t WS_GATES = 36 * MiB;
constexpr size_t WS_H = 40 * MiB;
constexpr size_t WS_MIX = 104 * MiB;
constexpr size_t WS_QKV = 168 * MiB;
constexpr size_t WS_ACT = WS_QKV;
constexpr size_t WS_END = 344 * MiB;
constexpr size_t WS_PARTO = 344 * MiB;
constexpr size_t WS_PARTL = 472 * MiB;
constexpr size_t WS_SELG = 476 * MiB;
constexpr size_t WS_Y = WS_PARTO;
constexpr size_t QKV_BIG = (size_t)4 * 8 * SEQ * 64, QKV_SMALL = (size_t)4 * 2 * SEQ * 64;
constexpr int RING_BYTES = 131072, LDS_BYTES = 147456;
constexpr int N_PHASES = 10;

#define GAS __attribute__((address_space(1)))
#define LAS __attribute__((address_space(3)))
typedef unsigned short bf16;
typedef unsigned v4u __attribute__((ext_vector_type(4)));
typedef float f32x4 __attribute__((ext_vector_type(4)));
#define LDS_WAIT() asm volatile("s_waitcnt lgkmcnt(0)" ::: "memory")
#define VM_WAIT() asm volatile("s_waitcnt vmcnt(0)" ::: "memory")
__device__ __forceinline__ unsigned f2bf(float f) { unsigned u = __builtin_bit_cast(unsigned, f); return (u + 0x7fffu + ((u >> 16) & 1u)) >> 16; }
__device__ __forceinline__ unsigned pk2(float lo, float hi) { return f2bf(lo) | (f2bf(hi) << 16); }
__device__ __forceinline__ float bf2f(bf16 v) { return __builtin_bit_cast(float, (unsigned)v << 16); }
__device__ __forceinline__ float wave_sum(float v) {
#pragma unroll
    for (int o = 1; o < 64; o <<= 1) v += __shfl_xor(v, o);
    return v;
}
struct Args { const float* in[23]; float* out; unsigned char* ws; int ph_lo, ph_hi; };
struct Frame { LAS unsigned char* lds; int tid, lane, wave, vcu, G; };

struct MapId { __device__ __forceinline__ size_t off(int n, int k, int K) const { return (size_t)n * K + k; } };
struct MapWin { __device__ __forceinline__ size_t off(int n, int k, int K) const { const int s = n >> 6, d = n & 63; return (size_t)(256 * (s >> 2) + 128 * (d >> 5) + 32 * (s & 3) + (d & 31)) * K + k; } };
struct MapWgu { __device__ __forceinline__ size_t off(int n, int k, int K) const { const int up = n >= FF, hdn = up ? n - FF : n; return (size_t)(256 * (hdn >> 7) + 128 * up + (hdn & 127)) * K + k; } };
struct MapFrag { __device__ __forceinline__ size_t off(int n, int k, int K) const { return ((size_t)((k >> 4) * 8 + (n >> 5)) * 64 + ((k >> 3) & 1) * 32 + (n & 31)) * 8 + (k & 7); } };
template <class Map>
__device__ __forceinline__ void transpose_item(const float* __restrict__ W, int K, int N, bf16* WT, LAS float* scr, int item, int lane, const Map& map) {
    const int nblk = (N + 63) / 64, kb = item / nblk, nb = item % nblk, k0 = 64 * kb, n0 = 64 * nb;
    const int nc = n0 + 4 * (lane & 15); const bool nin = nc < N;
    f32x4 v[16];
#pragma unroll
    for (int i = 0; i < 16; ++i) { const int kk = 4 * i + (lane >> 4); v[i] = nin ? *(const GAS f32x4*)(W + (size_t)(k0 + kk) * N + nc) : (f32x4){0.f, 0.f, 0.f, 0.f}; }
#pragma unroll
    for (int i = 0; i < 16; ++i) { const int kk = 4 * i + (lane >> 4); LAS float* d = scr + (4 * (lane & 15)) * 68 + kk; d[0] = v[i][0]; d[68] = v[i][1]; d[136] = v[i][2]; d[204] = v[i][3]; }
    LDS_WAIT(); asm volatile("" ::: "memory");
    const int c = lane & 7;
#pragma unroll
    for (int j = 0; j < 8; ++j) { const int n = (lane >> 3) + 8 * j; const LAS float* s = scr + n * 68 + 8 * c;
        const f32x4 a = *(const LAS f32x4*)s, bq = *(const LAS f32x4*)(s + 4);
        v4u o; o.x = pk2(a[0], a[1]); o.y = pk2(a[2], a[3]); o.z = pk2(bq[0], bq[1]); o.w = pk2(bq[2], bq[3]);
        if (n0 + n < N) *(GAS v4u*)(WT + map.off(n0 + n, k0 + 8 * c, K)) = o; }
    LDS_WAIT(); asm volatile("" ::: "memory");
}
__device__ __forceinline__ float silu_acc(float v) { return v / (1.f + expf(-v)); }
__device__ __forceinline__ void phase_prologue_a(Frame& F, const Args& a) {
    LAS float* scr = (LAS float*)(F.lds + F.wave * 17408);
    const int gw = F.vcu * NWAVES + F.wave, NGW = F.G * NWAVES;
    unsigned char* ws = a.ws;
    constexpr int I_IN = (DM / 64) * ((NIN + 63) / 64), I_OUT = (DM / 64) * (DM / 64), I_GU = (DM / 64) * (2 * FF / 64), I_DN = (FF / 64) * (DM / 64), I_W1 = (2048 / 64) * (256 / 64), I_W2 = (256 / 64) * (64 / 64);
    constexpr int NITEMS = I_IN + I_OUT + I_GU + I_DN + 2 * I_W1 + 2 * I_W2;
    for (int it = gw; it < NITEMS; it += NGW) {
        int r = it;
        if (r < I_IN) { transpose_item(a.in[6], DM, NIN, (bf16*)(ws + WS_WIN), scr, r, F.lane, MapWin()); continue; } r -= I_IN;
        if (r < I_OUT) { transpose_item(a.in[19], DM, DM, (bf16*)(ws + WS_WOUT), scr, r, F.lane, MapId()); continue; } r -= I_OUT;
        if (r < I_GU) { transpose_item(a.in[21], DM, 2 * FF, (bf16*)(ws + WS_WGU), scr, r, F.lane, MapWgu()); continue; } r -= I_GU;
        if (r < I_DN) { transpose_item(a.in[22], FF, DM, (bf16*)(ws + WS_WDN), scr, r, F.lane, MapId()); continue; } r -= I_DN;
        if (r < I_W1) { transpose_item(a.in[14], 2048, 256, (bf16*)(ws + WS_W1K), scr, r, F.lane, MapFrag()); continue; } r -= I_W1;
        if (r < I_W1) { transpose_item(a.in[17], 2048, 256, (bf16*)(ws + WS_W1V), scr, r, F.lane, MapFrag()); continue; } r -= I_W1;
        if (r < I_W2) { transpose_item(a.in[15], 256, 64, (bf16*)(ws + WS_W2K), scr, r, F.lane, MapId()); continue; } r -= I_W2;
        transpose_item(a.in[18], 256, 64, (bf16*)(ws + WS_W2V), scr, r, F.lane, MapId());
    }
    const float* c = a.in[1]; const float* w_ada = a.in[3]; float* modp = (float*)(ws + WS_MODP);
    for (int t = NGW - 1 - gw; t < 96 * 8; t += NGW) { const int cg_ = t % 96, ks = t / 96; const int n = cg_ * 64 + F.lane;
        float acc0 = 0.f, acc1 = 0.f, acc2 = 0.f, acc3 = 0.f;
#pragma unroll
        for (int i = 0; i < 8; ++i) { const int idx = F.lane + 64 * i, bb = idx >> 7, kk = idx & 127; scr[kk * 4 + bb] = silu_acc(c[bb * DM + ks * 128 + kk]); }
        LDS_WAIT(); asm volatile("" ::: "memory");
#pragma unroll 8
        for (int k = 0; k < 128; ++k) { const float w = w_ada[(size_t)(ks * 128 + k) * 6144 + n]; const f32x4 sv = *(const LAS f32x4*)(scr + 4 * k);
            acc0 += sv[0] * w; acc1 += sv[1] * w; acc2 += sv[2] * w; acc3 += sv[3] * w; }
        LDS_WAIT(); asm volatile("" ::: "memory");
        float* o = modp + (size_t)ks * 4 * 6144 + n; o[0] = acc0; o[6144] = acc1; o[2 * 6144] = acc2; o[3 * 6144] = acc3; }
    float* cbp = (float*)(ws + WS_CBP);
    for (int t = NGW / 2 - 1 - gw; t >= 0 && t < 256; t += NGW) { const int kv = t & 1, cg_ = (t >> 1) & 3, ic = t >> 3; const int n = cg_ * 64 + F.lane;
        const float* pe = kv ? a.in[16] : a.in[13]; const float* w1 = kv ? a.in[17] : a.in[14]; float acc = 0.f;
#pragma unroll 8
        for (int i = ic * 64; i < ic * 64 + 64; ++i) acc += pe[i] * w1[(size_t)i * 256 + n];
        cbp[(ic * 2 + kv) * 256 + n] = acc; }
}
template <bool ADDY>
__device__ __forceinline__ void norm_rows(Frame& F, int blk, const float* in, const bf16* yin, const f32x4 (&gs)[4], const f32x4 (&sh)[4], bf16* out) {
    for (int i0 = 0; i0 < 16; i0 += 4) {
        f32x4 v[4][4]; float ss[4];
#pragma unroll
        for (int r = 0; r < 4; ++r) { const int row = blk * 128 + F.wave * 16 + i0 + r; const GAS f32x4* xr = (const GAS f32x4*)(in + (size_t)row * DM) + F.lane;
#pragma unroll
            for (int j = 0; j < 4; ++j) v[r][j] = xr[64 * j];
            if (ADDY) { const GAS unsigned long long* yr = (const GAS unsigned long long*)(yin + (size_t)row * DM) + F.lane;
#pragma unroll
                for (int j = 0; j < 4; ++j) { const unsigned long long w = yr[64 * j]; const unsigned lo = (unsigned)w, hi = (unsigned)(w >> 32);
                    v[r][j] += (f32x4){__builtin_bit_cast(float, lo << 16), __builtin_bit_cast(float, lo & 0xffff0000u), __builtin_bit_cast(float, hi << 16), __builtin_bit_cast(float, hi & 0xffff0000u)}; } } }
#pragma unroll
        for (int r = 0; r < 4; ++r) { float s = 0.f;
#pragma unroll
            for (int j = 0; j < 4; ++j) s += (v[r][j].x * v[r][j].x + v[r][j].y * v[r][j].y) + (v[r][j].z * v[r][j].z + v[r][j].w * v[r][j].w);
            ss[r] = s; }
#pragma unroll
        for (int o_ = 1; o_ < 64; o_ <<= 1) {
#pragma unroll
            for (int r = 0; r < 4; ++r) ss[r] += __shfl_xor(ss[r], o_); }
#pragma unroll
        for (int r = 0; r < 4; ++r) { const int row = blk * 128 + F.wave * 16 + i0 + r; const float rs = rsqrtf(ss[r] * (1.f / DM) + 1e-6f);
            GAS unsigned long long* o8 = (GAS unsigned long long*)(out + (size_t)row * DM) + F.lane;
#pragma unroll
            for (int j = 0; j < 4; ++j) { const f32x4 y = v[r][j] * rs * gs[j] + sh[j]; o8[64 * j] = (unsigned long long)pk2(y.x, y.y) | ((unsigned long long)pk2(y.z, y.w) << 32); } }
    }
}
__device__ __forceinline__ void phase_prologue_b(Frame& F, const Args& a) {
    unsigned char* ws = a.ws; const float* modp = (const float*)(ws + WS_MODP); const float* b_ada = a.in[4];
    if (F.wave == 0) for (int cgp = F.vcu; cgp < 96; cgp += F.G) { const int n = cgp * 64 + F.lane; float* mod = (float*)(ws + WS_MOD);
        for (int b = 0; b < 4; ++b) { float s = 0.f;
#pragma unroll
            for (int ks = 0; ks < 8; ++ks) s += modp[((size_t)ks * 4 + b) * 6144 + n];
            mod[b * 6144 + n] = s + b_ada[n]; } }
    const float* g = a.in[5];
    for (int blk = F.vcu; blk < TOK / 128; blk += F.G) { const int b = blk >> 6;
    f32x4 gs[4], sh[4];
#pragma unroll
    for (int j = 0; j < 4; ++j) { const int c0 = 4 * F.lane + 256 * j; f32x4 s0 = {0.f, 0.f, 0.f, 0.f}, s1 = {0.f, 0.f, 0.f, 0.f};
#pragma unroll
        for (int ks = 0; ks < 8; ++ks) { s0 += *(const f32x4*)(modp + ((size_t)ks * 4 + b) * 6144 + c0); s1 += *(const f32x4*)(modp + ((size_t)ks * 4 + b) * 6144 + DM + c0); }
        s0 += *(const f32x4*)(b_ada + c0); s1 += *(const f32x4*)(b_ada + DM + c0);
        sh[j] = s0; gs[j] = *(const f32x4*)(g + c0) * (s1 + 1.0f); }
    norm_rows<false>(F, blk, a.in[0], nullptr, gs, sh, (bf16*)(ws + WS_H)); }
}
__device__ __forceinline__ void phase_norm2(Frame& F, const Args& a) {
    unsigned char* ws = a.ws; const float* g = a.in[20];
    for (int blk = F.vcu; blk < TOK / 128; blk += F.G) { const int b = blk >> 6; const float* mod = (const float*)(ws + WS_MOD) + (size_t)b * 6144;
        f32x4 gs[4], sh[4];
#pragma unroll
        for (int j = 0; j < 4; ++j) { const int c0 = 4 * F.lane + 256 * j; sh[j] = *(const f32x4*)(mod + 3 * DM + c0); gs[j] = *(const f32x4*)(g + c0) * (*(const f32x4*)(mod + 4 * DM + c0) + 1.0f); }
        norm_rows<true>(F, blk, a.in[0], (const bf16*)(ws + WS_Y), gs, sh, (bf16*)(ws + WS_H)); }
}

__device__ __forceinline__ void phase_bias2(Frame& F, const Args& a) {
    unsigned char* ws = a.ws; const float* mod = (const float*)(ws + WS_MOD); const bf16* wt = (const bf16*)(ws + WS_WGU); float* bias2 = (float*)(ws + WS_BIAS2);
    const int gw = F.vcu * NWAVES + F.wave, NGW = F.G * NWAVES;
    f32x4 sh[4][4];
#pragma unroll
    for (int bb = 0; bb < 4; ++bb)
#pragma unroll
        for (int j = 0; j < 4; ++j) sh[bb][j] = *(const f32x4*)(mod + (size_t)bb * 6144 + 3 * DM + 16 * F.lane + 4 * j);
    for (int c = gw; c < 2 * FF; c += NGW) {
        const v4u w0 = *(const GAS v4u*)(wt + (size_t)c * DM + 16 * F.lane), w1 = *(const GAS v4u*)(wt + (size_t)c * DM + 16 * F.lane + 8);
        const unsigned wu[8] = {w0.x, w0.y, w0.z, w0.w, w1.x, w1.y, w1.z, w1.w};
        float s[4] = {0.f, 0.f, 0.f, 0.f};
#pragma unroll
        for (int j = 0; j < 4; ++j) { const float e0 = __builtin_bit_cast(float, wu[2 * j] << 16), e1 = __builtin_bit_cast(float, wu[2 * j] & 0xffff0000u), e2 = __builtin_bit_cast(float, wu[2 * j + 1] << 16), e3 = __builtin_bit_cast(float, wu[2 * j + 1] & 0xffff0000u);
#pragma unroll
            for (int bb = 0; bb < 4; ++bb) s[bb] += (sh[bb][j][0] * e0 + sh[bb][j][1] * e1) + (sh[bb][j][2] * e2 + sh[bb][j][3] * e3); }
#pragma unroll
        for (int bb = 0; bb < 4; ++bb) { const float t = wave_sum(s[bb]); if (F.lane == 0) bias2[(size_t)bb * 2 * FF + c] = t; }
    }
}
#define XB_TMO      128
#define XB_XCNT(j)  (256  + 64 * (j))
#define XB_XSUB(j)  (1280 + 64 * (j))
#define XB_XGEN(j)  (2304 + 64 * (j))
#define XB_TOP      3328
#define XB_TOPGEN   3392
#define XCD_BAR_WORDS 3456
#define XB_SPIN_CAP (1u << 18)

__device__ __forceinline__ unsigned xb_ld(unsigned* p)              { return __hip_atomic_load(p, __ATOMIC_RELAXED, __HIP_MEMORY_SCOPE_AGENT); }
__device__ __forceinline__ unsigned xb_add(unsigned* p, unsigned v) { return __hip_atomic_fetch_add(p, v, __ATOMIC_RELAXED, __HIP_MEMORY_SCOPE_AGENT); }
__device__ __forceinline__ unsigned xb_xcc_id() { return (unsigned)__builtin_amdgcn_s_getreg((3 << 11) | 20) & 0xFu; }
#define XB_SPIN(cond, bar) do { unsigned _sp = 0; while (cond) { __builtin_amdgcn_s_sleep(1); \
    if ((++_sp & 255u) == 0u) { if (xb_ld(&(bar)[XB_TMO])) break; if (_sp > XB_SPIN_CAP) { atomicAdd(&(bar)[XB_TMO], 1u); break; } } } } while (0)

struct XcdBarrier {
    unsigned* bar; unsigned x;
    volatile LAS unsigned* st;
};

__device__ __forceinline__ XcdBarrier xcd_barrier_post(unsigned* bar, volatile LAS unsigned* st) {
    XcdBarrier b; b.bar = bar; b.x = xb_xcc_id(); b.st = st;
    if (threadIdx.x == 0) (void)xb_add(&bar[XB_XCNT(b.x)], 1u);
    return b;
}
__device__ __forceinline__ void xcd_barrier_complete(unsigned* bar, unsigned x, unsigned& nloc, unsigned& nx) {
    const unsigned G = gridDim.x * gridDim.y * gridDim.z;
    unsigned sum, cnt, mine, sp = 0u;
    for (;;) {
        sum = 0u; cnt = 0u; mine = 0u;
#pragma unroll
        for (unsigned j = 0; j < 16; ++j) { const unsigned c = xb_ld(&bar[XB_XCNT(j)]); sum += c; cnt += (c > 0u) ? 1u : 0u; mine = (j == x) ? c : mine; }
        if (sum == G) break;
        __builtin_amdgcn_s_sleep(1);
        if ((++sp & 255u) == 0u) { if (xb_ld(&bar[XB_TMO])) break; if (sp > XB_SPIN_CAP) { atomicAdd(&bar[XB_TMO], 1u); break; } }
    }
    nloc = mine > 0u ? mine : 1u; nx = cnt > 0u ? cnt : 1u;
}

__device__ __forceinline__ void xcd_barrier(const XcdBarrier& b) {
    asm volatile("s_waitcnt vmcnt(0)" ::: "memory");
    __syncthreads();
    if (threadIdx.x == 0) {
        unsigned* bar = b.bar;
        __builtin_amdgcn_s_waitcnt(0);
        unsigned nloc = b.st[0], nx = b.st[1];
        if (nloc == 0u) { xcd_barrier_complete(bar, b.x, nloc, nx); b.st[0] = nloc; b.st[1] = nx; }
        const unsigned old = xb_add(&bar[XB_XSUB(b.x)], 1u);
        const unsigned gen = old / nloc;
        if (old + 1u == (gen + 1u) * nloc) {
            __builtin_amdgcn_fence(__ATOMIC_RELEASE, "agent");
            asm volatile("s_waitcnt vmcnt(0)" ::: "memory");
            const unsigned og = xb_add(&bar[XB_TOP], 1u);
            const unsigned tg = og / nx;
            if (og + 1u == (tg + 1u) * nx) xb_add(&bar[XB_TOPGEN], 1u);
            else XB_SPIN(xb_ld(&bar[XB_TOPGEN]) == tg, bar);
            __builtin_amdgcn_fence(__ATOMIC_ACQUIRE, "agent");
            xb_add(&bar[XB_XGEN(b.x)], 1u);
            asm volatile("s_waitcnt vmcnt(0)" ::: "memory");
        } else {
            XB_SPIN(xb_ld(&bar[XB_XGEN(b.x)]) == gen, bar);
            __builtin_amdgcn_fence(__ATOMIC_ACQUIRE, "agent");
            asm volatile("s_waitcnt vmcnt(0)" ::: "memory");
        }
    }
    __syncthreads();
}
#define ATT_NS att
#ifndef ATT_ABL
#define ATT_ABL 0
#endif
#ifndef ATT_STAGGER
#define ATT_STAGGER 0
#endif
#ifndef ATT_SLEEP
#define ATT_SLEEP 24
#endif
namespace ATT_NS {
using bf16x8 = __attribute__((ext_vector_type(8))) short;
using s16x4 = __attribute__((ext_vector_type(4))) short;
using f32x16 = __attribute__((ext_vector_type(16))) float;
using u32x4 = __attribute__((ext_vector_type(4))) unsigned;
typedef LAS const char* lds_cptr;
typedef short v4i16_t __attribute__((ext_vector_type(4)));
constexpr int SLOT = 16384, NSLOT = 4, LDS_OST = 65536, LDS_IMP = 100608, LDS_SELM = 135680, LDS_MISC = 136704, LDS_WSF = 136960, LDS_LUTG = 139008  , LDS_ATT_END = 147200;
constexpr int IMP_PITCH = 136, IMP_PLANE = 64 * IMP_PITCH + 4, IMP_REG1 = 64;
constexpr float LOG2E = 1.4426950408889634f;
#define MFMA32(a, b, c) __builtin_amdgcn_mfma_f32_32x32x16_bf16(a, b, c, 0, 0, 0)
#define ATT_WAIT_BAR(N) asm volatile("s_waitcnt vmcnt(" #N ") lgkmcnt(0)\n\ts_barrier" ::: "memory")
__device__ __forceinline__ void glds16(const void* gsrc, unsigned lds_dst) { unsigned keep;
    asm volatile("s_mov_b32 %0, m0\n\ts_mov_b32 m0, %2\n\ts_nop 0\n\tglobal_load_lds_dwordx4 %1, off\n\ts_mov_b32 m0, %0" : "=&s"(keep) : "v"(gsrc), "s"(lds_dst) : "memory"); }
typedef float f32x2_t __attribute__((ext_vector_type(2))); typedef __bf16 bf16x2_t __attribute__((ext_vector_type(2)));
__device__ __forceinline__ unsigned cvtpk(float lo, float hi) { f32x2_t v = {lo, hi}; bf16x2_t b = __builtin_convertvector(v, bf16x2_t); return __builtin_bit_cast(unsigned, b); }
__device__ __forceinline__ s16x4 vtr(lds_cptr p) { return __builtin_bit_cast(s16x4, __builtin_amdgcn_ds_read_tr16_b64_v4i16((LAS v4i16_t*)p)); }
__device__ __forceinline__ int t5_bucket(int d) {
    if (d < 16) return d;
    int b = 16;
    b += (d >= 19); b += (d >= 21); b += (d >= 24); b += (d >= 27); b += (d >= 31); b += (d >= 35); b += (d >= 40); b += (d >= 46);
    b += (d >= 52); b += (d >= 59); b += (d >= 67); b += (d >= 77); b += (d >= 87); b += (d >= 99); b += (d >= 113);
    return b;
}
struct Ctx { LAS char* lds; int wid; int lane, r32, hi; };
__device__ __forceinline__ int fresh_lane() { int l; asm volatile("v_mbcnt_lo_u32_b32 %0, -1, 0\n\tv_mbcnt_hi_u32_b32 %0, -1, %0" : "=v"(l)); return l; }
__device__ __forceinline__ Ctx make_ctx(LAS unsigned char* lds, int tid) {
    Ctx c; c.lds = (LAS char*)lds; c.wid = __builtin_amdgcn_readfirstlane(tid >> 6); c.lane = tid & 63; c.r32 = c.lane & 31; c.hi = c.lane >> 5; return c;
}
template <bool HASV, class QK, class SM>
__device__ __forceinline__ void run_stream(const Ctx& c, const bf16* Kb, const bf16* Vb, int t0, int t1, QK&& qk, SM&& sm) {
    const int n = t1 - t0; if (n <= 0) return;
    const int lane = fresh_lane(), r32 = lane & 31, hi = lane >> 5; const unsigned lds0 = (unsigned)(uintptr_t)c.lds;
    const bf16* ks = Kb + ((8 * c.wid + (lane >> 3)) * 64 + (((lane & 7) ^ (((8 * c.wid + (lane >> 3)) >> 1) & 7)) << 3)); const bf16* vs = Vb + ((16 * (c.wid & 3) + (lane >> 2)) * 64 + (c.wid >> 2) * 32 + (lane & 3) * 8);
    const unsigned kdst = lds0 + c.wid * 1024, vdst = lds0 + 8192 + c.wid * 1024;
    const lds_cptr kp0 = (lds_cptr)c.lds + r32 * 128;
    const lds_cptr vp0 = (lds_cptr)c.lds + 8192 + ((lane >> 4) & 1) * 32 + (lane & 3) * 8 + (4 * hi + ((lane & 15) >> 2)) * 64;
#define ATT_ISSUE(t, so) do { if (ATT_ABL & 4) break; glds16(ks + (size_t)(t) * 4096, (unsigned)__builtin_amdgcn_readfirstlane(kdst + (so))); if (HASV) glds16(vs + (size_t)(t) * 4096, (unsigned)__builtin_amdgcn_readfirstlane(vdst + (so))); } while (0)
    ATT_ISSUE(t0, 0); if (n > 1) ATT_ISSUE(t0 + 1, SLOT);
    const bool late = ATT_STAGGER && __builtin_amdgcn_readfirstlane(c.wid) >= 4;
    f32x16 s0 = {}, s1 = {};
    int slot = 0, slotp = 3 * SLOT, slot2 = 2 * SLOT;
    if (!late) {
        for (int i = 0; i < n; ++i) {
            if (i + 1 < n) { if (HASV) ATT_WAIT_BAR(2); else ATT_WAIT_BAR(1); } else ATT_WAIT_BAR(0);
            if (i + 2 < n) ATT_ISSUE(t0 + i + 2, slot2);
            if (!(ATT_ABL & 1)) qk(t0 + i, kp0 + slot, s0, s1); if (!(ATT_ABL & 2)) sm(t0 + i, vp0 + slot, s0, s1);
            slot = (slot == 3 * SLOT) ? 0 : slot + SLOT; slot2 = (slot2 == 3 * SLOT) ? 0 : slot2 + SLOT;
        }
    } else {
        for (int i = 0; i < n; ++i) {
            if (i + 1 < n) { if (HASV) ATT_WAIT_BAR(2); else ATT_WAIT_BAR(1); } else ATT_WAIT_BAR(0);
            if (i + 2 < n) ATT_ISSUE(t0 + i + 2, slot2);
            if (i > 0 && !(ATT_ABL & 2)) sm(t0 + i - 1, vp0 + slotp, s0, s1);
            if (!(ATT_ABL & 1)) qk(t0 + i, kp0 + slot, s0, s1);
            slotp = slot; slot = (slot == 3 * SLOT) ? 0 : slot + SLOT; slot2 = (slot2 == 3 * SLOT) ? 0 : slot2 + SLOT;
        }
        if (!(ATT_ABL & 2)) sm(t0 + n - 1, vp0 + slotp, s0, s1);
    }
    asm volatile("s_waitcnt lgkmcnt(0)\n\ts_barrier" ::: "memory");
#undef ATT_ISSUE
}
template <class FN1, class FN2>
__device__ __forceinline__ void run_stream_pairs(const Ctx& c, const bf16* Kb, const bf16* Vb, int t0, int t1, FN1&& fn1, FN2&& fn2) {
    const int n = t1 - t0; if (n <= 0) return;
    const int lane = fresh_lane(), r32 = lane & 31, hi = lane >> 5; const unsigned lds0 = (unsigned)(uintptr_t)c.lds;
    const bf16* ks = Kb + ((8 * c.wid + (lane >> 3)) * 64 + (((lane & 7) ^ (((8 * c.wid + (lane >> 3)) >> 1) & 7)) << 3)); const bf16* vs = Vb + ((16 * (c.wid & 3) + (lane >> 2)) * 64 + (c.wid >> 2) * 32 + (lane & 3) * 8);
    const unsigned kdst = lds0 + c.wid * 1024, vdst = lds0 + 8192 + c.wid * 1024;
    const lds_cptr kp0 = (lds_cptr)c.lds + r32 * 128;
    const lds_cptr vp0 = (lds_cptr)c.lds + 8192 + ((lane >> 4) & 1) * 32 + (lane & 3) * 8 + (4 * hi + ((lane & 15) >> 2)) * 64;
#define ATT_ISSUE1(t, so) do { glds16(ks + (size_t)(t) * 4096, (unsigned)__builtin_amdgcn_readfirstlane(kdst + (so))); glds16(vs + (size_t)(t) * 4096, (unsigned)__builtin_amdgcn_readfirstlane(vdst + (so))); } while (0)
    ATT_ISSUE1(t0, 0); if (n > 1) ATT_ISSUE1(t0 + 1, SLOT);
    int base = 0;
    for (int i = 0; i < n; i += 2) {
        ATT_WAIT_BAR(0);
        const int nb = 2 * SLOT - base;
        if (i + 2 < n) ATT_ISSUE1(t0 + i + 2, nb); if (i + 3 < n) ATT_ISSUE1(t0 + i + 3, nb + SLOT);
        if (i + 1 < n) fn2(t0 + i, kp0 + base, vp0 + base, kp0 + base + SLOT, vp0 + base + SLOT); else fn1(t0 + i, kp0 + base, vp0 + base);
        base = nb;
    }
    asm volatile("s_waitcnt lgkmcnt(0)\n\ts_barrier" ::: "memory");
#undef ATT_ISSUE1
}
__device__ __forceinline__ void qk_tile(f32x16& s0, f32x16& s1, lds_cptr kp, const bf16x8 (&qr)[4]) {
    bf16x8 kf[8];
    { const int l = fresh_lane(), f = ((l & 31) >> 1) & 7, hi = l >> 5;
#pragma unroll
      for (int d0 = 0; d0 < 4; ++d0) { const int off = ((2 * d0 + hi) ^ f) << 4; kf[2 * d0] = *(const LAS bf16x8*)(kp + off); kf[2 * d0 + 1] = *(const LAS bf16x8*)(kp + 4096 + off); } }
    const f32x16 z = {};
    s0 = MFMA32(kf[0], qr[0], z); s1 = MFMA32(kf[1], qr[0], z);
#pragma unroll
    for (int d0 = 1; d0 < 4; ++d0) { s0 = MFMA32(kf[2 * d0], qr[d0], s0); s1 = MFMA32(kf[2 * d0 + 1], qr[d0], s1); }
}
template <bool MASK>
__device__ __forceinline__ void pv_tile(f32x16 (&o)[2], lds_cptr vp, const f32x16& p0, const f32x16& p1, unsigned mask) {
    if (ATT_ABL & 8) { o[0][0] += p0[0] + p1[5]; return; }
    u32x4 pw0 = {cvtpk(p0[0], p0[1]), cvtpk(p0[2], p0[3]), cvtpk(p0[4], p0[5]), cvtpk(p0[6], p0[7])}, pw1 = {cvtpk(p0[8], p0[9]), cvtpk(p0[10], p0[11]), cvtpk(p0[12], p0[13]), cvtpk(p0[14], p0[15])};
    u32x4 pw2 = {cvtpk(p1[0], p1[1]), cvtpk(p1[2], p1[3]), cvtpk(p1[4], p1[5]), cvtpk(p1[6], p1[7])}, pw3 = {cvtpk(p1[8], p1[9]), cvtpk(p1[10], p1[11]), cvtpk(p1[12], p1[13]), cvtpk(p1[14], p1[15])};
    if (MASK) { pw0 &= mask; pw1 &= mask; pw2 &= mask; pw3 &= mask; }
    if (ATT_ABL & 64) { o[0] = MFMA32(__builtin_bit_cast(bf16x8, pw0), __builtin_bit_cast(bf16x8, pw1), o[0]); o[1] = MFMA32(__builtin_bit_cast(bf16x8, pw2), __builtin_bit_cast(bf16x8, pw3), o[1]); return; }
    s16x4 vlo[8], vhi[8];
#pragma unroll
    for (int i = 0; i < 8; ++i) { vlo[i] = vtr(vp + ((i >> 2) * 4096 + (i & 3) * 1024)); vhi[i] = vtr(vp + ((i >> 2) * 4096 + (i & 3) * 1024 + 512)); }
#define ATT_VFR(i) (bf16x8){vlo[i][0], vlo[i][1], vlo[i][2], vlo[i][3], vhi[i][0], vhi[i][1], vhi[i][2], vhi[i][3]}
    o[0] = MFMA32(__builtin_bit_cast(bf16x8, pw0), ATT_VFR(0), o[0]); o[1] = MFMA32(__builtin_bit_cast(bf16x8, pw0), ATT_VFR(4), o[1]);
    o[0] = MFMA32(__builtin_bit_cast(bf16x8, pw1), ATT_VFR(1), o[0]); o[1] = MFMA32(__builtin_bit_cast(bf16x8, pw1), ATT_VFR(5), o[1]);
    o[0] = MFMA32(__builtin_bit_cast(bf16x8, pw2), ATT_VFR(2), o[0]); o[1] = MFMA32(__builtin_bit_cast(bf16x8, pw2), ATT_VFR(6), o[1]);
    o[0] = MFMA32(__builtin_bit_cast(bf16x8, pw3), ATT_VFR(3), o[0]); o[1] = MFMA32(__builtin_bit_cast(bf16x8, pw3), ATT_VFR(7), o[1]);
#undef ATT_VFR
}
#define ATT_SB() __builtin_amdgcn_sched_barrier(0)
struct KF { bf16x8 f[8]; };
struct VF { s16x4 lo[8], hi[8]; };
struct PW4 { u32x4 w0, w1, w2, w3; };
__device__ __forceinline__ void ld_k(KF& k, lds_cptr kp) {
    const int l = fresh_lane(), f = ((l & 31) >> 1) & 7, hi = l >> 5;
#pragma unroll
    for (int d0 = 0; d0 < 4; ++d0) { const int off = ((2 * d0 + hi) ^ f) << 4; k.f[2 * d0] = *(const LAS bf16x8*)(kp + off); k.f[2 * d0 + 1] = *(const LAS bf16x8*)(kp + 4096 + off); } }
__device__ __forceinline__ void qk_mfma(f32x16& s0, f32x16& s1, const KF& k, const bf16x8 (&qr)[4]) {
    const f32x16 z = {};
    s0 = MFMA32(k.f[0], qr[0], z); s1 = MFMA32(k.f[1], qr[0], z);
#pragma unroll
    for (int d0 = 1; d0 < 4; ++d0) { s0 = MFMA32(k.f[2 * d0], qr[d0], s0); s1 = MFMA32(k.f[2 * d0 + 1], qr[d0], s1); } }
__device__ __forceinline__ void ld_v(VF& v, lds_cptr vp) {
#pragma unroll
    for (int i = 0; i < 8; ++i) { v.lo[i] = vtr(vp + ((i >> 2) * 4096 + (i & 3) * 1024)); v.hi[i] = vtr(vp + ((i >> 2) * 4096 + (i & 3) * 1024 + 512)); } }
__device__ __forceinline__ PW4 pack4(const f32x16& p0, const f32x16& p1, unsigned mask) { PW4 w;
    w.w0 = (u32x4){cvtpk(p0[0], p0[1]), cvtpk(p0[2], p0[3]), cvtpk(p0[4], p0[5]), cvtpk(p0[6], p0[7])}; w.w1 = (u32x4){cvtpk(p0[8], p0[9]), cvtpk(p0[10], p0[11]), cvtpk(p0[12], p0[13]), cvtpk(p0[14], p0[15])};
    w.w2 = (u32x4){cvtpk(p1[0], p1[1]), cvtpk(p1[2], p1[3]), cvtpk(p1[4], p1[5]), cvtpk(p1[6], p1[7])}; w.w3 = (u32x4){cvtpk(p1[8], p1[9]), cvtpk(p1[10], p1[11]), cvtpk(p1[12], p1[13]), cvtpk(p1[14], p1[15])};
    w.w0 &= mask; w.w1 &= mask; w.w2 &= mask; w.w3 &= mask; return w; }
__device__ __forceinline__ void pv_mfma(f32x16 (&o)[2], const VF& v, const PW4& w) {
#define ATT_VF(i) (bf16x8){v.lo[i][0], v.lo[i][1], v.lo[i][2], v.lo[i][3], v.hi[i][0], v.hi[i][1], v.hi[i][2], v.hi[i][3]}
    o[0] = MFMA32(__builtin_bit_cast(bf16x8, w.w0), ATT_VF(0), o[0]); o[1] = MFMA32(__builtin_bit_cast(bf16x8, w.w0), ATT_VF(4), o[1]);
    o[0] = MFMA32(__builtin_bit_cast(bf16x8, w.w1), ATT_VF(1), o[0]); o[1] = MFMA32(__builtin_bit_cast(bf16x8, w.w1), ATT_VF(5), o[1]);
    o[0] = MFMA32(__builtin_bit_cast(bf16x8, w.w2), ATT_VF(2), o[0]); o[1] = MFMA32(__builtin_bit_cast(bf16x8, w.w2), ATT_VF(6), o[1]);
    o[0] = MFMA32(__builtin_bit_cast(bf16x8, w.w3), ATT_VF(3), o[0]); o[1] = MFMA32(__builtin_bit_cast(bf16x8, w.w3), ATT_VF(7), o[1]);
#undef ATT_VF
}
__device__ __forceinline__ float rowsum32(const f32x16& p0, const f32x16& p1) { if (ATT_ABL & 32) return p0[0]; float a = p0[0] + p1[0], b = p0[1] + p1[1];
#pragma unroll
    for (int r = 2; r < 16; r += 2) { a += p0[r]; asm volatile("" : "+v"(a)); b += p0[r + 1]; asm volatile("" : "+v"(b)); a += p1[r]; asm volatile("" : "+v"(a)); b += p1[r + 1]; asm volatile("" : "+v"(b)); }
    return a + b; }
__device__ __forceinline__ void hook_exp(f32x16& s0, f32x16& s1) {
    if (ATT_ABL & 16) return;
#pragma unroll
    for (int r = 0; r < 16; ++r) { s0[r] = __builtin_amdgcn_exp2f(s0[r]); s1[r] = __builtin_amdgcn_exp2f(s1[r]); } }
__device__ __forceinline__ void hook_near(f32x16& s0, f32x16& s1, int base, const LAS float* lut) {
    asm volatile("" : "+v"(base));
#pragma unroll
    for (int r = 0; r < 16; ++r) { const int d0 = base - ((r & 3) + 8 * (r >> 2)), d1 = d0 - 32;
        s0[r] = __builtin_amdgcn_exp2f(s0[r] + lut[min(max(d0, -1), 113) + 1]); s1[r] = __builtin_amdgcn_exp2f(s1[r] + lut[min(max(d1, -1), 113) + 1]); } }
__device__ __forceinline__ void hook_edge(f32x16& s0, f32x16& s1, int base, int win) {
    asm volatile("" : "+v"(base));
#pragma unroll
    for (int r = 0; r < 16; ++r) { const int d0 = base - ((r & 3) + 8 * (r >> 2)), d1 = d0 - 32;
        s0[r] = __builtin_amdgcn_exp2f(d0 < win ? s0[r] : -INFINITY); s1[r] = __builtin_amdgcn_exp2f(d1 < win ? s1[r] : -INFINITY); } }
__device__ __forceinline__ void hook_cmp(f32x16& s0, f32x16& s1, int nrel  , float cb) {
    asm volatile("" : "+v"(nrel));
#pragma unroll
    for (int r = 0; r < 16; ++r) { const int c0 = (r & 3) + 8 * (r >> 2);
        s0[r] = __builtin_amdgcn_exp2f(s0[r] + ((c0 <= nrel) ? cb : -INFINITY)); s1[r] = __builtin_amdgcn_exp2f(s1[r] + ((c0 + 32 <= nrel) ? cb : -INFINITY)); } }
__device__ __forceinline__ void row_factors(const Ctx& c, float f, float (&fr)[16]) {
    const int lane = fresh_lane(), r32 = lane & 31, hi = lane >> 5; LAS float* wsf = (LAS float*)(c.lds + LDS_WSF) + c.wid * 64;
    asm volatile("s_waitcnt lgkmcnt(0)" ::: "memory");
    if (hi == 0) wsf[r32] = f;
    asm volatile("s_waitcnt lgkmcnt(0)" ::: "memory");
#pragma unroll
    for (int r = 0; r < 16; ++r) fr[r] = wsf[(r & 3) + 8 * (r >> 2) + 4 * hi];
    asm volatile("s_waitcnt lgkmcnt(0)" ::: "memory");
}
__device__ __forceinline__ float pair_sum(float v) { auto rr = __builtin_amdgcn_permlane32_swap(__float_as_uint(v), __float_as_uint(v), false, false); return __uint_as_float(rr[0]) + __uint_as_float(rr[1]); }
template <class RowOff>
__device__ __forceinline__ void store_rows(const Ctx& c, const f32x16 (&o)[2], bf16* dst, RowOff&& rowoff) {
    LAS bf16* stg = (LAS bf16*)(c.lds + LDS_OST) + c.wid * 2048;
    const int lane = fresh_lane(), r32 = lane & 31, hi = lane >> 5;
#pragma unroll
    for (int r = 0; r < 16; ++r) { const int orow = (r & 3) + 8 * (r >> 2) + 4 * hi;
#pragma unroll
        for (int d0 = 0; d0 < 2; ++d0) stg[orow * 64 + d0 * 32 + r32] = (bf16)f2bf(o[d0][r]); }
    asm volatile("s_waitcnt lgkmcnt(0)" ::: "memory");
#pragma unroll
    for (int i = 0; i < 4; ++i) { const int row = i * 8 + (lane >> 3), ch = lane & 7; const u32x4 v = *(const LAS u32x4*)(stg + row * 64 + ch * 8); *(u32x4*)(dst + rowoff(row) + ch * 8) = v; }
    asm volatile("s_waitcnt lgkmcnt(0)" ::: "memory");
}
struct AttnPtrs { const bf16* qkv; const float* kmp; const float* gates; const bf16* kcmp; const bf16* vcmp; const float* rel_bias; bf16* mix; unsigned* selg; bf16* part_o; float* part_l; };

__device__ __forceinline__ void moba_kmean_frags(const AttnPtrs& P, int bh, int r32, int hi, bf16x8 (&kmf)[4]) {
    const float* kp = P.kmp + ((size_t)(bh * 32 + r32) * 2) * 64;
#pragma unroll
    for (int d0 = 0; d0 < 4; ++d0) { const f32x4 a0 = *(const f32x4*)(kp + d0 * 16 + hi * 8), a1 = *(const f32x4*)(kp + d0 * 16 + hi * 8 + 4), b0 = *(const f32x4*)(kp + 64 + d0 * 16 + hi * 8), b1 = *(const f32x4*)(kp + 64 + d0 * 16 + hi * 8 + 4);
        const f32x4 m0 = (a0 + b0) * (1.f / 256.f), m1 = (a1 + b1) * (1.f / 256.f);
        u32x4 w = {cvtpk(m0[0], m0[1]), cvtpk(m0[2], m0[3]), cvtpk(m1[0], m1[1]), cvtpk(m1[2], m1[3])}; kmf[d0] = __builtin_bit_cast(bf16x8, w); }
}
__device__ __forceinline__ unsigned moba_gate32(const bf16x8 (&kmf)[4], int i, const bf16x8 (&qr)[4], int hi) {
    unsigned selmask = 0u;
    if (i > 0) {
        f32x16 sg = {};
#pragma unroll
        for (int d0 = 0; d0 < 4; ++d0) sg = MFMA32(kmf[d0], qr[d0], sg);
        float v[16];
#pragma unroll
        for (int r = 0; r < 16; ++r) v[r] = ((r & 3) + 8 * (r >> 2) + 4 * hi < i) ? sg[r] : -INFINITY;
#pragma unroll
        for (int it = 0; it < 3; ++it) {
            float m = v[0]; int jb = 4 * hi;
#pragma unroll
            for (int r = 1; r < 16; ++r) { const int j = (r & 3) + 8 * (r >> 2) + 4 * hi; if (v[r] > m) { m = v[r]; jb = j; } }
            auto rm = __builtin_amdgcn_permlane32_swap(__float_as_uint(m), __float_as_uint(m), false, false);
            auto rj = __builtin_amdgcn_permlane32_swap((unsigned)jb, (unsigned)jb, false, false);
            const float mo = __uint_as_float(hi ? rm[0] : rm[1]); const int jo = (int)(hi ? rj[0] : rj[1]);
            const bool mine = (m > mo) || (m == mo && jb < jo);
            const float mw = mine ? m : mo; const int jw = mine ? jb : jo;
            if (mw > -INFINITY) { selmask |= 1u << jw;
#pragma unroll
                for (int r = 0; r < 16; ++r) if ((r & 3) + 8 * (r >> 2) + 4 * hi == jw) v[r] = -INFINITY; }
        }
    }
    return selmask;
}
__device__ __forceinline__ void moba_gate_phase(const AttnPtrs& P, int vcu, int G, int tid) {
    const int lane = tid & 63, r32 = lane & 31, hi = lane >> 5; const int wid = __builtin_amdgcn_readfirstlane(tid >> 6);
    for (int grp = vcu * 8 + wid; grp < 2048; grp += G * 8) { const int bh = grp >> 6;
        bf16x8 kmf[4]; moba_kmean_frags(P, bh, r32, hi, kmf);
        const bf16* QA = P.qkv + ((size_t)bh * SEQ) * 64;
#pragma unroll 2
        for (int k = 0; k < 4; ++k) { const int idx = (grp & 63) * 4 + k, i = idx >> 3, w = idx & 7; const int qpos = 256 * i + 32 * w + r32;
            bf16x8 qr[4];
#pragma unroll
            for (int d0 = 0; d0 < 4; ++d0) qr[d0] = *(const bf16x8*)(QA + (size_t)qpos * 64 + d0 * 16 + hi * 8);
            const unsigned m = moba_gate32(kmf, i, qr, hi);
            if (hi == 0) P.selg[(size_t)bh * SEQ + qpos] = m; } }
}
__device__ __forceinline__ void moba_past_item(const Ctx& c, const AttnPtrs& P, int b, int h, int j) {
    const int bh = b * 8 + h, tid = threadIdx.x;
    const bf16* QA = P.qkv + ((size_t)bh * SEQ) * 64; const bf16* KA = QA + QKV_BIG + (size_t)256 * j * 64; const bf16* VA = QA + 2 * QKV_BIG + (size_t)256 * j * 64;
    const LAS float* lut = (const LAS float*)(c.lds + LDS_LUTG) + h * 128;
    { const int lane = fresh_lane(); const unsigned lds0 = (unsigned)(uintptr_t)c.lds;
      const bf16* ks = KA + ((8 * c.wid + (lane >> 3)) * 64 + (((lane & 7) ^ (((8 * c.wid + (lane >> 3)) >> 1) & 7)) << 3)); const bf16* vs = VA + ((16 * (c.wid & 3) + (lane >> 2)) * 64 + (c.wid >> 2) * 32 + (lane & 3) * 8);
#pragma unroll
      for (int tt = 0; tt < 4; ++tt) { glds16(ks + tt * 4096, (unsigned)__builtin_amdgcn_readfirstlane(lds0 + c.wid * 1024 + tt * SLOT)); glds16(vs + tt * 4096, (unsigned)__builtin_amdgcn_readfirstlane(lds0 + 8192 + c.wid * 1024 + tt * SLOT)); } }
    LAS unsigned short* list = (LAS unsigned short*)(c.lds + LDS_IMP);
    LAS unsigned* wcnt = (LAS unsigned*)(c.lds + LDS_MISC) + 8;
    const unsigned* sg = P.selg + (size_t)bh * SEQ;
    if (tid < 256) list[tid] = (unsigned short)((256 * j + tid) | (3 << 13));
    int total = 256;
    for (int base = (j + 1) * 256; base < SEQ; base += 2048) {
        const int q0 = base + 4 * tid; uint4 m4 = make_uint4(0u, 0u, 0u, 0u); if (q0 < SEQ) m4 = *(const uint4*)(sg + q0);
        const unsigned long long b0 = __ballot((m4.x >> j) & 1u), b1 = __ballot((m4.y >> j) & 1u), b2 = __ballot((m4.z >> j) & 1u), b3 = __ballot((m4.w >> j) & 1u);
        const int c0 = (int)__popcll(b0), c1 = (int)__popcll(b1), c2 = (int)__popcll(b2), c3 = (int)__popcll(b3);
        if ((tid & 63) == 0) wcnt[c.wid] = (unsigned)(c0 + c1 + c2 + c3);
        asm volatile("s_waitcnt vmcnt(0) lgkmcnt(0)\n\ts_barrier" ::: "memory");
        int off = total, tot = 0;
#pragma unroll
        for (int w = 0; w < 8; ++w) { const int v = (int)wcnt[w]; off += (w < c.wid) ? v : 0; tot += v; }
        const unsigned long long below = (1ull << (tid & 63)) - 1ull; const unsigned lowj = (1u << j) - 1u;
        if ((m4.x >> j) & 1u) list[off + __popcll(b0 & below)] = (unsigned short)((q0 + 0) | (__popc(m4.x & lowj) << 13)); off += c0;
        if ((m4.y >> j) & 1u) list[off + __popcll(b1 & below)] = (unsigned short)((q0 + 1) | (__popc(m4.y & lowj) << 13)); off += c1;
        if ((m4.z >> j) & 1u) list[off + __popcll(b2 & below)] = (unsigned short)((q0 + 2) | (__popc(m4.z & lowj) << 13)); off += c2;
        if ((m4.w >> j) & 1u) list[off + __popcll(b3 & below)] = (unsigned short)((q0 + 3) | (__popc(m4.w & lowj) << 13));
        total += tot;
        asm volatile("s_waitcnt lgkmcnt(0)\n\ts_barrier" ::: "memory");
    }
    total = __builtin_amdgcn_readfirstlane(total);
    { const int npad = (32 - (total & 31)) & 31; if (tid < npad) list[total + tid] = 0xFFFFu; }
    const int nchunks = (total + 31) >> 5;
    asm volatile("s_waitcnt vmcnt(0) lgkmcnt(0)\n\ts_barrier" ::: "memory");
    for (int ch = c.wid; ch < nchunks; ch += 8) {
        const int lane = fresh_lane(), r32 = lane & 31, hi = lane >> 5;
        const lds_cptr kp0 = (lds_cptr)c.lds + r32 * 128;
        const lds_cptr vp0 = (lds_cptr)c.lds + 8192 + ((lane >> 4) & 1) * 32 + (lane & 3) * 8 + (4 * hi + ((lane & 15) >> 2)) * 64;
        const unsigned e = list[32 * ch + r32]; const bool valid = e != 0xFFFFu; const int q = valid ? (int)(e & 0x1FFFu) : SEQ - 1;
        bf16x8 qr[4];
#pragma unroll
        for (int d0 = 0; d0 < 4; ++d0) qr[d0] = *(const bf16x8*)(QA + (size_t)q * 64 + d0 * 16 + hi * 8);
        asm volatile("" : "+v"(qr[0]), "+v"(qr[1]), "+v"(qr[2]), "+v"(qr[3]));
        const bool anynear = __any(valid && (unsigned)((q >> 8) - j) <= 1u);
        f32x16 o[2]; o[0] = f32x16{}; o[1] = f32x16{}; float l_reg = 0.f;
#pragma unroll 1
        for (int tt = 0; tt < 4; ++tt) { f32x16 s0, s1; qk_tile(s0, s1, kp0 + tt * SLOT, qr);
            if (anynear) hook_near(s0, s1, q - (256 * j + 64 * tt) - 4 * hi, lut); else hook_exp(s0, s1);
            l_reg += rowsum32(s0, s1);
            pv_tile<false>(o, vp0 + tt * SLOT, s0, s1, 0u); }
        const float L = pair_sum(l_reg);
        if (hi == 0 && valid) P.part_l[((size_t)bh * SEQ + q) * 4 + (e >> 13)] = L;
        LAS bf16* stg = (LAS bf16*)(c.lds + LDS_OST) + c.wid * 2048;
#pragma unroll
        for (int r = 0; r < 16; ++r) { const int orow = (r & 3) + 8 * (r >> 2) + 4 * hi;
#pragma unroll
            for (int d0 = 0; d0 < 2; ++d0) stg[orow * 64 + d0 * 32 + r32] = (bf16)f2bf(o[d0][r]); }
        asm volatile("s_waitcnt lgkmcnt(0)" ::: "memory");
#pragma unroll
        for (int it = 0; it < 4; ++it) { const int row = it * 8 + (lane >> 3), chn = lane & 7; const unsigned e2 = list[32 * ch + row];
            const u32x4 v = *(const LAS u32x4*)(stg + row * 64 + chn * 8);
            if (e2 != 0xFFFFu) *(u32x4*)(P.part_o + (((size_t)bh * SEQ + (e2 & 0x1FFFu)) * 4 + (e2 >> 13)) * 64 + chn * 8) = v; }
        asm volatile("s_waitcnt lgkmcnt(0)" ::: "memory");
    }
    asm volatile("s_waitcnt lgkmcnt(0)\n\ts_barrier" ::: "memory");
}
__device__ __forceinline__ void moba_merge_pass(const AttnPtrs& P, int vcu, int G, int tid) {
    const int lane = tid & 63, h = lane >> 3, chn = lane & 7; const int wid = __builtin_amdgcn_readfirstlane(tid >> 6);
#pragma unroll 4
    for (int tok = vcu * 8 + wid; tok < TOK; tok += G * 8) { const int b = tok >> 13, q = tok & (SEQ - 1);
        const size_t qi = (size_t)(b * 8 + h) * SEQ + q; const int ns = __popc(P.selg[qi]);
        float Lt = P.part_l[qi * 4 + 3]; const u32x4 pw = *(const u32x4*)(P.part_o + (qi * 4 + 3) * 64 + chn * 8);
        f32x4 a0 = {__uint_as_float(pw.x << 16), __uint_as_float(pw.x & 0xffff0000u), __uint_as_float(pw.y << 16), __uint_as_float(pw.y & 0xffff0000u)};
        f32x4 a1 = {__uint_as_float(pw.z << 16), __uint_as_float(pw.z & 0xffff0000u), __uint_as_float(pw.w << 16), __uint_as_float(pw.w & 0xffff0000u)};
#pragma unroll
        for (int sidx = 0; sidx < 3; ++sidx) if (sidx < ns) { Lt += P.part_l[qi * 4 + sidx]; const u32x4 pv = *(const u32x4*)(P.part_o + (qi * 4 + sidx) * 64 + chn * 8);
            a0 += (f32x4){__uint_as_float(pv.x << 16), __uint_as_float(pv.x & 0xffff0000u), __uint_as_float(pv.y << 16), __uint_as_float(pv.y & 0xffff0000u)};
            a1 += (f32x4){__uint_as_float(pv.z << 16), __uint_as_float(pv.z & 0xffff0000u), __uint_as_float(pv.w << 16), __uint_as_float(pv.w & 0xffff0000u)}; }
        const float inv = 1.f / Lt; a0 *= inv; a1 *= inv;
        const u32x4 w = {cvtpk(a0[0], a0[1]), cvtpk(a0[2], a0[3]), cvtpk(a1[0], a1[1]), cvtpk(a1[2], a1[3])};
        *(u32x4*)(P.mix + (size_t)tok * DM + h * 64 + chn * 8) = w; }
}

__device__ __forceinline__ void nsa_item(const Ctx& c, const AttnPtrs& P, int b, int g, int ci, int flags = 0) {
    const int ql = 8 * c.wid + (c.r32 >> 2), rh = c.r32 & 3, qpos = 64 * ci + ql, hb = 4 * g + rh;
    const int qw0 = 64 * ci + 8 * c.wid;
    const bf16* QB = P.qkv + 3 * QKV_BIG + ((size_t)(b * 8 + hb) * SEQ) * 64;
    const bf16* KS = P.qkv + 4 * QKV_BIG + 2 * QKV_SMALL + ((size_t)(b * 2 + g) * SEQ) * 64; const bf16* VS = KS + QKV_SMALL; const bf16* KW = KS + 2 * QKV_SMALL; const bf16* VW = KS + 3 * QKV_SMALL;
    const bf16* KC = P.kcmp + (size_t)(b * 2 + g) * 512 * 64; const bf16* VC = P.vcmp + (size_t)(b * 2 + g) * 512 * 64;
    bf16x8 qr[4];
#pragma unroll
    for (int d0 = 0; d0 < 4; ++d0) qr[d0] = *(const bf16x8*)(QB + (size_t)qpos * 64 + d0 * 16 + c.hi * 8);
    asm volatile("" : "+v"(qr[0]), "+v"(qr[1]), "+v"(qr[2]), "+v"(qr[3]));
    const LAS float* lut = (const LAS float*)(c.lds + LDS_LUTG) + (8 + hb) * 128;
    LAS float* imp = (LAS float*)(c.lds + LDS_IMP);
    LAS unsigned* selm = (LAS unsigned*)(c.lds + LDS_SELM);
    f32x16 o[2]; float l_reg; float fr[16];
    LAS float* park = (LAS float*)(c.lds + LDS_OST) + c.wid * 1024 + c.lane;
    LAS float* park1 = (LAS float*)(c.lds + LDS_IMP) + c.wid * 1024 + c.lane;
    const int nct = (4 * ci + 3 + 63) >> 6;
    const int nlim = (qpos >= 31) ? ((qpos - 31) >> 4) : -1;
    LAS bf16* impt = (LAS bf16*)(c.lds + ((rh & 2) ? LDS_IMP : LDS_OST)) + ((rh & 2) ? IMP_REG1 : 0) + (rh & 1) * IMP_PLANE + ql * IMP_PITCH;
    l_reg = 0.f; o[0] = f32x16{}; o[1] = f32x16{};
    {
        float carry = 0.f;
        if (!(flags & 32)) run_stream<true>(c, KC, VC, 0, nct,
          [&](int t, lds_cptr kp, f32x16& s0, f32x16& s1) { qk_tile(s0, s1, kp, qr); },
          [&](int t, lds_cptr vp, f32x16& s0, f32x16& s1) {
            hook_cmp(s0, s1, nlim - 64 * t - 4 * c.hi, 0.f);
            l_reg += rowsum32(s0, s1);
#pragma unroll
            for (int half = 0; half < 2; ++half) {
                float g4[4], e[4];
#pragma unroll
                for (int a = 0; a < 4; ++a) { const float x0 = half ? s1[4 * a] : s0[4 * a], x1 = half ? s1[4 * a + 1] : s0[4 * a + 1], x2 = half ? s1[4 * a + 2] : s0[4 * a + 2], x3 = half ? s1[4 * a + 3] : s0[4 * a + 3];
                    g4[a] = (x0 + x1) + (x2 + x3); e[a] = x3; }
                float x[4];
#pragma unroll
                for (int a = 0; a < 4; ++a) { auto rr = __builtin_amdgcn_permlane32_swap(__float_as_uint(e[a]), __float_as_uint(e[a]), false, false); x[a] = __uint_as_float(c.hi ? rr[0] : rr[1]); }
                const int jb = 16 * t + 8 * half;
                float iv[4];
                if (c.hi) {
#pragma unroll
                    for (int a = 0; a < 4; ++a) iv[a] = g4[a] + x[a]; }
                else { iv[0] = g4[0] + carry; iv[1] = g4[1] + x[0]; iv[2] = g4[2] + x[1]; iv[3] = g4[3] + x[2]; carry = x[3]; }
#pragma unroll
                for (int a = 0; a < 4; ++a) impt[jb + 2 * a + c.hi] = (bf16)f2bf(iv[a]);
            }
            pv_tile<false>(o, vp, s0, s1, 0u);
        });
    }
    const float Lc = pair_sum(l_reg); const float invLc = Lc > 0.f ? 1.f / Lc : 0.f;
    { LAS float* wsfw = (LAS float*)(c.lds + LDS_WSF) + c.wid * 64; if (c.hi == 0) wsfw[32 + c.r32] = invLc; }
    const float* gp = P.gates + ((size_t)b * SEQ + qpos) * 24 + hb * 3; float g0 = gp[0], g1 = gp[1], g2 = gp[2];
    {
        asm volatile("s_waitcnt lgkmcnt(0)\n\ts_barrier" ::: "memory");
        const int fl = fresh_lane(); const int qq = 8 * c.wid + (fl >> 3), cc = fl & 7;
        unsigned m0 = 0u, m1 = 0u, m2w = 0u, m3 = 0u;
        if (ci <= 15 || (flags & 16)) { m0 = (ci >= 31) ? 0xffffffffu : ((2u << ci) - 1u); }
        else {
            unsigned v[16];
            const LAS float* il = (const LAS float*)(c.lds + LDS_WSF) + c.wid * 64 + 32 + 4 * (fl >> 3);
            const float i0 = il[0], i1 = il[1], i2 = il[2], i3 = il[3];
            const LAS bf16* ta = (const LAS bf16*)(c.lds + LDS_OST) + qq * IMP_PITCH; const LAS bf16* tb = (const LAS bf16*)(c.lds + LDS_IMP) + IMP_REG1 + qq * IMP_PITCH;
#pragma unroll
            for (int k = 0; k < 16; ++k) { const int j = cc + 8 * k;
                const float val = (bf2f(ta[j]) * i0 + bf2f(ta[IMP_PLANE + j]) * i1) + (bf2f(tb[j]) * i2 + bf2f(tb[IMP_PLANE + j]) * i3);
                v[k] = (j >= 1 && j <= ci - 2) ? ((__float_as_uint(val) & ~127u) | (unsigned)(127 - j)) : 0u; }
            for (int it = 0; it < 13; ++it) {
                unsigned m = v[0];
#pragma unroll
                for (int k = 1; k < 16; ++k) m = max(m, v[k]);
#pragma unroll
                for (int sft = 1; sft < 8; sft <<= 1) m = max(m, (unsigned)__shfl_xor((int)m, sft));
                if (m != 0u) { const int jb = 127 - (int)(m & 127u); const unsigned bit = 1u << (jb & 31); const int wsel = jb >> 5;
                    m0 |= (wsel == 0) ? bit : 0u; m1 |= (wsel == 1) ? bit : 0u; m2w |= (wsel == 2) ? bit : 0u; m3 |= (wsel == 3) ? bit : 0u;
#pragma unroll
                    for (int k = 0; k < 16; ++k) v[k] = (v[k] == m) ? 0u : v[k]; }
            }
            m0 |= 1u;
#pragma unroll
            for (int z = 0; z < 2; ++z) { const int jf = ci - z; const unsigned bit = 1u << (jf & 31); const int wsel = jf >> 5;
                m0 |= (wsel == 0) ? bit : 0u; m1 |= (wsel == 1) ? bit : 0u; m2w |= (wsel == 2) ? bit : 0u; m3 |= (wsel == 3) ? bit : 0u; }
        }
        if (cc == 0) { selm[qq * 4 + 0] = m0; selm[qq * 4 + 1] = m1; selm[qq * 4 + 2] = m2w; selm[qq * 4 + 3] = m3; }
        asm volatile("s_waitcnt lgkmcnt(0)\n\ts_barrier" ::: "memory");
    }
    asm volatile("" : "+v"(g0), "+v"(g1), "+v"(g2));
    row_factors(c, g0 * invLc, fr);
#pragma unroll
    for (int r = 0; r < 16; ++r) { park[r * 64] = o[0][r] * fr[r]; park1[r * 64] = o[1][r] * fr[r]; }
    {
        const unsigned w0 = selm[ql * 4 + 0], w1 = selm[ql * 4 + 1], w2 = selm[ql * 4 + 2], w3 = selm[ql * 4 + 3];
        o[0] = f32x16{}; o[1] = f32x16{}; l_reg = 0.f;
        auto sel_pred = [&](int t) -> bool { const unsigned wsel = (t < 32) ? w0 : (t < 64) ? w1 : (t < 96) ? w2 : w3; return (wsel >> (t & 31)) & 1u; };
        auto sel_one = [&](int t, lds_cptr kp, lds_cptr vp) { const bool pred = sel_pred(t); if (!__any(pred)) return; const int key0 = 64 * t;
            f32x16 s0, s1; qk_tile(s0, s1, kp, qr);
            if (qw0 - key0 - 63 >= 113) { hook_exp(s0, s1); const float rs = rowsum32(s0, s1); l_reg += pred ? rs : 0.f;
                if (__all(pred)) pv_tile<false>(o, vp, s0, s1, 0u); else pv_tile<true>(o, vp, s0, s1, pred ? 0xffffffffu : 0u); }
            else { hook_near(s0, s1, qpos - key0 - 4 * c.hi, lut); const float rs = rowsum32(s0, s1); l_reg += pred ? rs : 0.f;
                if (__all(pred)) pv_tile<false>(o, vp, s0, s1, 0u); else pv_tile<true>(o, vp, s0, s1, pred ? 0xffffffffu : 0u); } };
        if (!(flags & 4)) run_stream_pairs(c, KS, VS, 0, ci + 1, sel_one,
            [&](int t, lds_cptr kpA, lds_cptr vpA, lds_cptr kpB, lds_cptr vpB) {
                if (qw0 - 64 * (t + 1) - 63 >= 113) {
                    const bool pa = sel_pred(t), pb = sel_pred(t + 1);
                    const bool xa = __any(pa), xb = __any(pb);
                    if (!xa && !xb) return;
                    if (!xb) { sel_one(t, kpA, vpA); return; }
                    if (!xa) { sel_one(t + 1, kpB, vpB); return; }
                    KF kA, kB; ld_k(kA, kpA); ATT_SB();
                    f32x16 a0, a1, b0, b1; qk_mfma(a0, a1, kA, qr); ATT_SB();
                    VF vA, vB; ld_k(kB, kpB); ld_v(vA, vpA); ATT_SB();
                    qk_mfma(b0, b1, kB, qr); hook_exp(a0, a1);
                    const float ra = rowsum32(a0, a1); const PW4 wa = pack4(a0, a1, pa ? 0xffffffffu : 0u); ATT_SB();
                    ld_v(vB, vpB); ATT_SB();
                    pv_mfma(o, vA, wa); hook_exp(b0, b1);
                    const float rb = rowsum32(b0, b1); const PW4 wb = pack4(b0, b1, pb ? 0xffffffffu : 0u); l_reg += (pa ? ra : 0.f) + (pb ? rb : 0.f); ATT_SB();
                    pv_mfma(o, vB, wb);
                } else { sel_one(t, kpA, vpA); sel_one(t + 1, kpB, vpB); } });
        const float Ls = pair_sum(l_reg);
        row_factors(c, g1 / Ls, fr);
#pragma unroll
        for (int r = 0; r < 16; ++r) { park[r * 64] += o[0][r] * fr[r]; park1[r * 64] += o[1][r] * fr[r]; }
    }
    {
        o[0] = f32x16{}; o[1] = f32x16{}; l_reg = 0.f;
        if (!(flags & 8)) run_stream<true>(c, KW, VW, ci >= 8 ? ci - 8 : 0, ci + 1,
            [&](int t, lds_cptr kp, f32x16& s0, f32x16& s1) { qk_tile(s0, s1, kp, qr); },
            [&](int t, lds_cptr vp, f32x16& s0, f32x16& s1) { const int key0 = 64 * t;
                if (qw0 - key0 - 63 < 113) hook_near(s0, s1, qpos - key0 - 4 * c.hi, lut); else if (qw0 + 7 - key0 >= 512) hook_edge(s0, s1, qpos - key0 - 4 * c.hi, 512); else hook_exp(s0, s1);
                l_reg += rowsum32(s0, s1);
                pv_tile<false>(o, vp, s0, s1, 0u); });
        const float Lw = pair_sum(l_reg);
        row_factors(c, g2 / Lw, fr);
#pragma unroll
        for (int r = 0; r < 16; ++r) { o[0][r] = park[r * 64] + o[0][r] * fr[r]; o[1][r] = park1[r * 64] + o[1][r] * fr[r]; }
        asm volatile("s_waitcnt lgkmcnt(0)" ::: "memory");
    }
    bf16* dst = P.mix + ((size_t)b * SEQ + 64 * ci + 8 * c.wid) * DM + 512 + g * 256;
    store_rows(c, o, dst, [](int row) { return (size_t)(row >> 2) * DM + (row & 3) * 64; });
    asm volatile("s_waitcnt lgkmcnt(0)\n\ts_barrier" ::: "memory");
}

__device__ __forceinline__ void attn_phase(LAS unsigned char* lds, const AttnPtrs& P, unsigned* qcounter, int flags) {
    Ctx c = make_ctx(lds, threadIdx.x);
    LAS unsigned* misc = (LAS unsigned*)(c.lds + LDS_MISC);
    { LAS float* lutg = (LAS float*)(c.lds + LDS_LUTG);
      for (int idx = threadIdx.x; idx < 16 * 115; idx += NTHREADS) { const int hh = idx / 115, d = idx % 115;
          lutg[hh * 128 + d] = (d == 0) ? -INFINITY : (P.rel_bias[t5_bucket(d - 1) * 16 + hh] - P.rel_bias[31 * 16 + hh]) * LOG2E; }
      asm volatile("s_waitcnt vmcnt(0) lgkmcnt(0)\n\ts_barrier" ::: "memory"); }
    for (;;) {
        if (threadIdx.x == 0) misc[0] = __hip_atomic_fetch_add(qcounter, 1u, __ATOMIC_RELAXED, __HIP_MEMORY_SCOPE_AGENT);
        asm volatile("s_waitcnt vmcnt(0) lgkmcnt(0)\n\ts_barrier" ::: "memory");
        const unsigned k = misc[0];
        asm volatile("s_waitcnt lgkmcnt(0)\n\ts_barrier" ::: "memory");
        if (k >= 2048u) break;
        const bool is_mp = k >= 512u && k < 1536u;
        if (flags & (is_mp ? 2 : 1)) continue;
        if (k < 512u) { const int s_ = 127 - (int)(k >> 3), bg = k & 7; nsa_item(c, P, bg >> 1, bg & 1, s_, flags); }
        else if (k < 1536u) { const int kk = (int)k - 512, j = kk >> 5, bh = kk & 31; moba_past_item(c, P, bh >> 3, bh & 7, j); }
        else { const int kk = (int)k - 1536; const int s_ = 63 - (kk >> 3), bg = kk & 7; nsa_item(c, P, bg >> 1, bg & 1, s_, flags); }
    }
}
#undef MFMA32
#undef ATT_WAIT_BAR
}
namespace cmpr {
using bf16x8 = __attribute__((ext_vector_type(8))) short;
using f32x16 = __attribute__((ext_vector_type(16))) float;
constexpr int HID_PITCH = 528;
__device__ __forceinline__ float gelu_tanh(float v) { const float u = fminf(fmaxf(0.7978845608028654f * (v + 0.044715f * v * v * v), -15.f), 15.f); const float e = __expf(2.f * u); return 0.5f * v * (1.f + (e - 1.f) / (e + 1.f)); }
__device__ __forceinline__ void compress_unit(LAS unsigned char* lds, int unit, const bf16* qkv, const bf16* w1k, const bf16* w1v, const bf16* w2k, const bf16* w2v, const float* cbp, const float* kncmp, bf16* kcmp, bf16* vcmp) {
    const int tid = threadIdx.x, lane = tid & 63, r32 = lane & 31, hi = lane >> 5; const int wid = __builtin_amdgcn_readfirstlane(tid >> 6);
    const int kv = unit & 1, u = (unit >> 1) & 15, bg = unit >> 5;
    const bf16* src = qkv + 4 * QKV_BIG + (kv ? QKV_SMALL : 0) + (size_t)bg * SEQ * 64;
    const bf16* w1 = kv ? w1v : w1k; const bf16* w2 = kv ? w2v : w2k;
    const int n0 = 32 * u;
    { const bf16* sp = src + (size_t)16 * n0 * 64;
      for (int ch = tid; ch < 4224; ch += NTHREADS) { v4u v = {0u, 0u, 0u, 0u}; if (16 * n0 + (ch >> 3) < SEQ) v = *(const GAS v4u*)(sp + (size_t)ch * 8);
          *(LAS v4u*)(lds + ((ch ^ ((ch >> 7) & 15)) << 4)) = v; } }
    asm volatile("s_waitcnt vmcnt(0) lgkmcnt(0)\n\ts_barrier" ::: "memory");
    const bf16* bp = w1 + ((size_t)wid * 64 + lane) * 8;
    f32x16 acc = {};
#pragma unroll 16
    for (int kk = 0; kk < 128; ++kk) { const int lc = r32 * 128 + 2 * kk + hi; const bf16x8 a = *(const LAS bf16x8*)(lds + ((lc ^ ((lc >> 7) & 15)) << 4)), bfr = *(const bf16x8*)(bp + (size_t)kk * 4096); acc = __builtin_amdgcn_mfma_f32_32x32x16_bf16(a, bfr, acc, 0, 0, 0); }
    float cb = 0.f;
#pragma unroll 8
    for (int ic = 0; ic < 32; ++ic) cb += cbp[(ic * 2 + kv) * 256 + 32 * wid + r32];
    LAS unsigned char* hidL = lds + 69632;
#pragma unroll
    for (int r = 0; r < 16; ++r) { const int n = (r & 3) + 8 * (r >> 2) + 4 * hi; *(LAS bf16*)(hidL + n * HID_PITCH + (32 * wid + r32) * 2) = (bf16)f2bf(gelu_tanh(acc[r] + cb)); }
    asm volatile("s_waitcnt lgkmcnt(0)\n\ts_barrier" ::: "memory");
    if (wid == 0) {
        f32x16 o0 = {}, o1 = {};
#pragma unroll 4
        for (int kk = 0; kk < 16; ++kk) { const bf16x8 hb = *(const LAS bf16x8*)(hidL + r32 * HID_PITCH + (16 * kk + 8 * hi) * 2);
            const bf16x8 a0 = *(const bf16x8*)(w2 + (size_t)r32 * 256 + 16 * kk + 8 * hi), a1 = *(const bf16x8*)(w2 + (size_t)(32 + r32) * 256 + 16 * kk + 8 * hi);
            o0 = __builtin_amdgcn_mfma_f32_32x32x16_bf16(a0, hb, o0, 0, 0, 0); o1 = __builtin_amdgcn_mfma_f32_32x32x16_bf16(a1, hb, o1, 0, 0, 0); }
        float rs = 1.f;
        if (!kv) { float ss = 0.f;
#pragma unroll
            for (int r = 0; r < 16; ++r) ss += o0[r] * o0[r] + o1[r] * o1[r];
            auto rr = __builtin_amdgcn_permlane32_swap(__float_as_uint(ss), __float_as_uint(ss), false, false); ss = __uint_as_float(rr[0]) + __uint_as_float(rr[1]);
            rs = rsqrtf(ss * (1.f / 64.f) + 1e-6f); }
        const int n = n0 + r32; bf16* dst = (kv ? vcmp : kcmp) + ((size_t)bg * 512 + n) * 64;
#pragma unroll
        for (int r = 0; r < 16; ++r) { const int d = (r & 3) + 8 * (r >> 2) + 4 * hi;
            float v0 = o0[r] * rs, v1 = o1[r] * rs; if (!kv) { v0 *= kncmp[d]; v1 *= kncmp[d + 32]; }
            if (n >= NCMP) { v0 = 0.f; v1 = 0.f; }
            dst[d] = (bf16)f2bf(v0); dst[d + 32] = (bf16)f2bf(v1); }
    }
    asm volatile("s_waitcnt lgkmcnt(0)\n\ts_barrier" ::: "memory");
}
}
__global__ void __launch_bounds__(NTHREADS, 2) mk_fwd(Args a) {
    extern __shared__ __attribute__((aligned(16))) unsigned char lds[];
    Frame F;
    F.lds = (LAS unsigned char*)lds;
    F.tid = threadIdx.x; F.lane = F.tid & 63; F.wave = __builtin_amdgcn_readfirstlane(F.tid >> 6);
    F.G = gridDim.x; { const int bx = blockIdx.x; F.vcu = (F.G % 8 == 0) ? (bx % 8) * (F.G / 8) + bx / 8 : bx; }
    cg::grid_group grid = cg::this_grid();
    volatile LAS unsigned* xst = (volatile LAS unsigned*)(F.lds + 147424);
    if (F.tid < 8) xst[F.tid] = 0u;
    __syncthreads();
    const XcdBarrier xbar = xcd_barrier_post((unsigned*)(a.ws + WS_CTL) + 4096, xst);
    unsigned char* ws = a.ws;
    const int lo = a.ph_lo, hi = a.ph_hi & 0xff; const int tflags = a.ph_hi >> 8; (void)tflags;
    const att::AttnPtrs P{(const bf16*)(ws + WS_QKV), (const float*)(ws + WS_KMP), (const float*)(ws + WS_GATES), (const bf16*)(ws + WS_KCMP), (const bf16*)(ws + WS_VCMP), a.in[2], (bf16*)(ws + WS_MIX),
                          (unsigned*)(ws + WS_SELG), (bf16*)(ws + WS_PARTO), (float*)(ws + WS_PARTL)};
#define IN(k) (lo <= (k) && (k) < hi)
#define SEAM(k) do { if (IN(k) && IN((k) + 1)) { if ((k) == 0) grid.sync(); else xcd_barrier(xbar); } } while (0)
    if (IN(0)) { phase_prologue_a(F, a); } SEAM(0);
    if (IN(1)) { phase_prologue_b(F, a); } SEAM(1);
    if (IN(2)) {
        pg8::Gemm g{(const pg8::bf16_t*)(ws + WS_H), (const pg8::bf16_t*)(ws + WS_WIN), TOK, NIN_PAD, DM}; pg8::StaticOrder S; S.init(TOK, NIN_PAD, F.G, (int)blockIdx.x);
        pg8::EpiInProj E{(pg8::bf16_t*)(ws + WS_QKV), (float*)(ws + WS_GATES), (float*)(ws + WS_KMP), a.in[7], a.in[8], a.in[9], a.in[11], a.in[12]};
        pg8::gemm_phase<pg8::EpiInProj, pg8::StaticOrder, true, true>(F.lds, g, S, E);
    } SEAM(2);
    if (IN(3)) {
        if (!(tflags & 1)) att::moba_gate_phase(P, F.vcu, F.G, F.tid);
        if (!(tflags & 2)) for (int unit = F.vcu; unit < 256; unit += F.G)
            cmpr::compress_unit(F.lds, unit, (const bf16*)(ws + WS_QKV), (const bf16*)(ws + WS_W1K), (const bf16*)(ws + WS_W1V), (const bf16*)(ws + WS_W2K), (const bf16*)(ws + WS_W2V),
                                (const float*)(ws + WS_CBP), a.in[10], (bf16*)(ws + WS_KCMP), (bf16*)(ws + WS_VCMP));
    } SEAM(3);
    if (IN(4)) {
#if HYBRID == 3
        att::attn_phase(F.lds, P, (unsigned*)(ws + WS_CTL) + 64, tflags);
#else
        att::attn_phase(F.lds, P, (unsigned*)(ws + WS_CTL) + 64, 0);
#endif
    } SEAM(4);
    if (IN(5)) { att::moba_merge_pass(P, F.vcu, F.G, F.tid); } SEAM(5);
    if (IN(6)) {
        pg8::Gemm g{(const pg8::bf16_t*)(ws + WS_MIX), (const pg8::bf16_t*)(ws + WS_WOUT), TOK, DM, DM}; pg8::StaticOrder S; S.init(TOK, DM, F.G, (int)blockIdx.x);
        pg8::EpiOutProj E{(pg8::bf16_t*)(ws + WS_Y), (const float*)(ws + WS_MOD) + 2 * DM};
        pg8::gemm_phase<pg8::EpiOutProj, pg8::StaticOrder, true, true>(F.lds, g, S, E);
    } SEAM(6);
    if (IN(7)) { phase_norm2(F, a); } SEAM(7);
    if (IN(8)) {
        pg8::Gemm g{(const pg8::bf16_t*)(ws + WS_H), (const pg8::bf16_t*)(ws + WS_WGU), TOK, 2 * FF, DM}; pg8::StaticOrder S; S.init(TOK, 2 * FF, F.G, (int)blockIdx.x);
        pg8::EpiGateUp E{(pg8::bf16_t*)(ws + WS_ACT)};
        pg8::gemm_phase<pg8::EpiGateUp, pg8::StaticOrder, true, true>(F.lds, g, S, E);
    } SEAM(8);
    if (IN(9)) {
        pg8::Gemm g{(const pg8::bf16_t*)(ws + WS_ACT), (const pg8::bf16_t*)(ws + WS_WDN), TOK, DM, FF}; pg8::StaticOrder S; S.init(TOK, DM, F.G, (int)blockIdx.x);
        pg8::EpiDown E{a.in[0], (const pg8::bf16_t*)(ws + WS_Y), a.out, (const float*)(ws + WS_MOD) + 5 * DM};
        pg8::gemm_phase<pg8::EpiDown, pg8::StaticOrder, true, true>(F.lds, g, S, E);
    }
#undef IN
#undef SEAM
}

static void launch_phases(const Args& base, int lo, int hi, int grid, hipStream_t stream, int flags = 0) {
    Args a = base; a.ph_lo = lo; a.ph_hi = hi | (flags << 8);
    if (hi - lo > 1) { void* args[] = {&a}; (void)hipLaunchCooperativeKernel((const void*)mk_fwd, dim3(grid), dim3(NTHREADS), args, LDS_BYTES, stream); }
    else hipLaunchKernelGGL(mk_fwd, dim3(grid), dim3(NTHREADS), LDS_BYTES, stream, a);
}
extern "C" void kernel_launch(void* const* d_in, const int* in_sizes, int n_in, void* d_out, int out_size, void* d_ws, size_t ws_size, hipStream_t stream) {
    static int grid = 0;
    if (grid == 0) {
        int dev = 0, cus = 0, per_cu = 0;
        if (n_in != 23 || ws_size < 480 * MiB || hipGetDevice(&dev) != hipSuccess || hipDeviceGetAttribute(&cus, hipDeviceAttributeMultiprocessorCount, dev) != hipSuccess) { grid = -1; return; }
        if (hipFuncSetAttribute((const void*)mk_fwd, hipFuncAttributeMaxDynamicSharedMemorySize, LDS_BYTES) != hipSuccess) { grid = -1; return; }
        if (hipOccupancyMaxActiveBlocksPerMultiprocessor(&per_cu, (const void*)mk_fwd, NTHREADS, LDS_BYTES) != hipSuccess || per_cu < 1) { grid = -1; return; }
        grid = cus;
    }
    if (grid < 0) return;
    (void)hipMemsetAsync((char*)d_ws + WS_CTL, 0, CTL_ZERO_BYTES, stream);
    Args a{};
    for (int i = 0; i < 23; ++i) a.in[i] = (const float*)d_in[i];
    a.out = (float*)d_out; a.ws = (unsigned char*)d_ws;
    unsigned char* ws = (unsigned char*)d_ws;
#if HYBRID == 1
    launch_phases(a, 0, 1, grid, stream); launch_phases(a, 1, 2, grid, stream); launch_phases(a, 2, 3, grid, stream);
    const bf16* qkv = (const bf16*)(ws + WS_QKV); bf16* mix = (bf16*)(ws + WS_MIX); bf16* kcmp = (bf16*)(ws + WS_KCMP); bf16* vcmp = (bf16*)(ws + WS_VCMP);
    int* sel = (int*)(ws + 344 * MiB); float* obuf = (float*)(ws + 348 * MiB); const float* gates = (const float*)(ws + WS_GATES);
    nq::k_compress<<<dim3(4 * 2 * 512, 2), 256, 0, stream>>>(qkv, a.in[13], a.in[14], a.in[15], a.in[16], a.in[17], a.in[18], a.in[10], kcmp, vcmp);
    nq::k_moba<<<4 * 8 * SEQ / 4, 256, 0, stream>>>(qkv, (const float*)(ws + WS_KMP), a.in[2], mix);
    nq::k_nsa_cmp<<<4 * 2 * SEQ, 256, 0, stream>>>(qkv, kcmp, vcmp, gates, obuf, sel);
    nq::k_nsa_sel<<<4 * 2 * SEQ, 256, 0, stream>>>(qkv, sel, a.in[2], gates, obuf);
    nq::k_nsa_win<<<4 * 2 * SEQ, 256, 0, stream>>>(qkv, a.in[2], gates, obuf, mix);
    launch_phases(a, 5, 6, grid, stream); launch_phases(a, 6, 7, grid, stream); launch_phases(a, 7, 8, grid, stream); launch_phases(a, 8, 9, grid, stream);
#elif HYBRID == 2
    launch_phases(a, 0, 1, grid, stream); launch_phases(a, 1, 2, grid, stream); launch_phases(a, 2, 3, grid, stream);
    nq::k_compress<<<dim3(4 * 2 * 512, 2), 256, 0, stream>>>((const bf16*)(ws + WS_QKV), a.in[13], a.in[14], a.in[15], a.in[16], a.in[17], a.in[18], a.in[10], (bf16*)(ws + WS_KCMP), (bf16*)(ws + WS_VCMP));
    launch_phases(a, 4, 5, grid, stream);
    launch_phases(a, 5, 6, grid, stream); launch_phases(a, 6, 7, grid, stream); launch_phases(a, 7, 8, grid, stream); launch_phases(a, 8, 9, grid, stream);
#elif HYBRID == 3
    for (int p = 0; p < N_PHASES; ++p) {
#if defined(TIME_PHASE)
        if (p == TIME_PHASE) { for (int r = 0; r < TIME_REPS; ++r) { launch_phases(a, p, p + 1, grid, stream, TIME_FLAGS); (void)hipMemsetAsync((char*)d_ws + WS_CTL, 0, CTL_ZERO_BYTES, stream); } }
#endif
        launch_phases(a, p, p + 1, grid, stream);
#if defined(ABL_REPS)
        if (p == 3) { static bool once = false; if (!once) { once = true; (void)hipFuncSetAttribute((const void*)k_attn_abl, hipFuncAttributeMaxDynamicSharedMemorySize, LDS_BYTES); }
            for (int r = 0; r < ABL_REPS; ++r) { (void)hipMemsetAsync((char*)d_ws + WS_CTL + 512, 0, 4, stream); hipLaunchKernelGGL(k_attn_abl, dim3(grid), dim3(NTHREADS), LDS_BYTES, stream, a); } }
#endif
    }
#else
    launch_phases(a, 0, N_PHASES, grid, stream);
#endif
}
```

```cpp
#include <hip/hip_runtime.h>
#include <hip/hip_cooperative_groups.h>
#include <cstdint>
#include <cstdio>
namespace cg = cooperative_groups;
#define HYBRID 0
namespace pg8 {
#define PG8_LAS __attribute__((address_space(3)))
typedef unsigned short bf16_t;
typedef short bf16x8 __attribute__((ext_vector_type(8)));
typedef float f32x4 __attribute__((ext_vector_type(4)));
typedef unsigned u32x4 __attribute__((ext_vector_type(4)));
constexpr int BM = 256, BK = 64, HALF = 128, HTB = HALF * BK * 2  , STAGE_BYTES = 8 * HTB, NXCD = 8, WGM = 8;

__host__ __device__ __forceinline__ int lds_byte(int r, int c) { const int st = (r >> 4) * 2 + (c >> 5), rr = r & 15, cc = c & 31, ob = rr * 64 + cc * 2; return st * 1024 + (ob ^ (((ob >> 9) & 1) << 5)); }
__host__ __device__ __forceinline__ void stage_rc(int b, int& R, int& C) { const int st = b / 1024, sb = b % 1024, swz = sb ^ (((sb >> 9) & 1) << 5); R = (st >> 1) * 16 + swz / 64; C = (st & 1) * 32 + (swz % 64) / 2; }
__host__ __device__ __forceinline__ int perm32(int rho) { const int n = rho >> 4, i = rho & 15; return 8 * (i >> 2) + 4 * n + (i & 3); }

struct Unit { int pm, pn; };
struct Gemm { const bf16_t* A; const bf16_t* Bt; int M, N, K; };

struct StaticOrder {
    int nM, nN, nwg, G, c;
    __host__ __device__ void init(int M, int N, int G_, int c_) { nM = M / BM; nN = N / BM; nwg = nM * nN; G = G_; c = c_; }
    __host__ __device__ bool next(int i, Unit& u) const {
        const long L = (long)i * G + c; if (L >= nwg) return false;
        int wgid = (int)L; { const int q = nwg / NXCD, r = nwg % NXCD, xcd = wgid % NXCD, off = wgid / NXCD; wgid = (xcd < r ? xcd * (q + 1) : r * (q + 1) + (xcd - r) * q) + off; }
        const int nig = WGM * nN, gid = wgid / nig, fm = gid * WGM, gsz = (nM - fm) < WGM ? (nM - fm) : WGM;
        u.pm = fm + ((wgid % nig) % gsz); u.pn = (wgid % nig) / gsz; return true;
    }
    __device__ __forceinline__ void a_ready(const Unit&) const {}
    __device__ __forceinline__ void done(const Unit&) const {}
};

__device__ __forceinline__ unsigned cvt_pk_bf16(float lo, float hi) { unsigned r; asm volatile("v_cvt_pk_bf16_f32 %0, %1, %2" : "=v"(r) : "v"(lo), "v"(hi)); return r; }
typedef float f32x2 __attribute__((ext_vector_type(2)));
template <class Epi, class Sched, bool ALIGN_EPI = false, bool SP2 = false>
__device__ __forceinline__ void gemm_phase(PG8_LAS unsigned char* lds, const Gemm g, const Sched& S, const Epi& E) {
    const int tid = threadIdx.x, wid = __builtin_amdgcn_readfirstlane(tid >> 6), lane = tid & 63, wr = wid >> 2, wc = wid & 3, fr = lane & 15, fq = lane >> 4;
    const int K = g.K, nt = K / BK;
    unsigned voffA[2], voffB[2];
#pragma unroll
    for (int i = 0; i < 2; ++i) { int R, C; stage_rc(tid * 16 + i * 8192, R, C); const int Rb = Epi::PERM ? ((R & ~31) + perm32(R & 31)) : R;
        voffA[i] = (unsigned)(R * K + C) * 2u; voffB[i] = (unsigned)(Rb * K + C) * 2u; }
    const size_t kstep = (size_t)(BK * 2);
    const size_t hstep = (size_t)HALF * K * 2;
    const size_t tstep = 2 * hstep;
    const unsigned ldsw = (unsigned)wid * 1024u;
    const int aoff = lds_byte(wr * 64 + fr, fq * 8), boff = lds_byte(wc * 32 + fr, fq * 8);
#define PG8_SA(b, h) (((b) * 2 + (h)) * HTB)
#define PG8_SB(b, h) ((4 + (b) * 2 + (h)) * HTB)
#define PG8_STAGE(bufoff, gbase, voff) do { _Pragma("unroll") for (int _i = 0; _i < 2; ++_i) \
        __builtin_amdgcn_global_load_lds((const unsigned*)((const char*)(gbase) + (voff)[_i]), (PG8_LAS unsigned*)(lds + (bufoff) + ldsw + _i * 8192), 16, 0, 0); } while (0)
#define PG8_LDA(dst, b, h) do { _Pragma("unroll") for (int m = 0; m < 4; ++m) _Pragma("unroll") for (int k = 0; k < 2; ++k) dst[m][k] = *(const PG8_LAS bf16x8*)(lds + PG8_SA(b, h) + aoff + m * 2048 + k * 1024); } while (0)
#define PG8_LDB(dst, b, h) do { _Pragma("unroll") for (int n = 0; n < 2; ++n) _Pragma("unroll") for (int k = 0; k < 2; ++k) dst[n][k] = *(const PG8_LAS bf16x8*)(lds + PG8_SB(b, h) + boff + n * 2048 + k * 1024); } while (0)
#define PG8_MMA(ai, bj, At, Bt) do { __builtin_amdgcn_s_setprio(1); _Pragma("unroll") for (int m = 0; m < 4; ++m) _Pragma("unroll") for (int n = 0; n < 2; ++n) _Pragma("unroll") for (int k = 0; k < 2; ++k) \
        acc[ai][bj][m][n] = __builtin_amdgcn_mfma_f32_16x16x32_bf16(Bt[n][k], At[m][k], acc[ai][bj][m][n], 0, 0, 0); __builtin_amdgcn_s_setprio(0); } while (0)
#define PG8_WAIT_V(n) asm volatile("s_waitcnt vmcnt(" #n ")" ::: "memory")
#define PG8_WAIT_L(n) asm volatile("s_waitcnt lgkmcnt(" #n ")" ::: "memory")
#define PG8_BAR __builtin_amdgcn_s_barrier()
#define PG8_SCHED __builtin_amdgcn_sched_barrier(0)
    Unit cur, nxt; int ui = 0;
    if (!S.next(0, cur)) return;
    f32x4 acc[2][2][4][2];
#pragma unroll
    for (int a = 0; a < 2; ++a)
#pragma unroll
        for (int b = 0; b < 2; ++b)
#pragma unroll
            for (int m = 0; m < 4; ++m)
#pragma unroll
                for (int n = 0; n < 2; ++n) acc[a][b][m][n] = (f32x4){0.f, 0.f, 0.f, 0.f};
    bf16x8 At[4][2], B0[2][2], B1[2][2];
    const char* cA = (const char*)g.A + (size_t)cur.pm * tstep; const char* cB = (const char*)g.Bt + (size_t)cur.pn * tstep;
    S.a_ready(cur);
    if constexpr (SP2) {
        PG8_STAGE(PG8_SB(0, 0), cB, voffB); PG8_STAGE(PG8_SB(0, 1), cB + hstep, voffB); PG8_STAGE(PG8_SA(0, 0), cA, voffA); PG8_STAGE(PG8_SA(0, 1), cA + hstep, voffA);
        if (wr == 1) PG8_BAR;
        PG8_WAIT_V(2); PG8_BAR;
        PG8_STAGE(PG8_SB(1, 0), cB + kstep, voffB); PG8_STAGE(PG8_SA(1, 0), cA + kstep, voffA); PG8_STAGE(PG8_SB(1, 1), cB + hstep + kstep, voffB);
        PG8_WAIT_V(6); PG8_BAR;
    } else {
        PG8_STAGE(PG8_SB(0, 0), cB, voffB); PG8_STAGE(PG8_SA(0, 0), cA, voffA); PG8_STAGE(PG8_SB(0, 1), cB + hstep, voffB); PG8_STAGE(PG8_SA(0, 1), cA + hstep, voffA);
        if (wr == 1) PG8_BAR;
        PG8_WAIT_V(4); PG8_BAR;
        PG8_STAGE(PG8_SB(1, 0), cB + kstep, voffB); PG8_STAGE(PG8_SA(1, 0), cA + kstep, voffA); PG8_STAGE(PG8_SB(1, 1), cB + hstep + kstep, voffB);
        PG8_WAIT_V(6); PG8_BAR;
    }
    for (;;) {
        const bool has_next = S.next(ui + 1, nxt);
        const char* nA = has_next ? (const char*)g.A + (size_t)nxt.pm * tstep : cA; const char* nB = has_next ? (const char*)g.Bt + (size_t)nxt.pn * tstep : cB;
        for (int t = 0; t < nt; t += 2) {
            const bool last = (t == nt - 2);
            const char* a1 = cA + (size_t)(t + 1) * kstep;
            const char* a2 = last ? nA : cA + (size_t)(t + 2) * kstep; const char* b2 = last ? nB : cB + (size_t)(t + 2) * kstep;
            const char* a3 = a2 + kstep; const char* b3 = b2 + kstep;
            if (last && has_next) S.a_ready(nxt);
            if constexpr (SP2) {
            PG8_LDB(B0, 0, 0); PG8_LDB(B1, 0, 1); PG8_SCHED; PG8_LDA(At, 0, 0); PG8_STAGE(PG8_SA(1, 1), a1 + hstep, voffA);
            PG8_WAIT_V(8); PG8_WAIT_L(0); PG8_BAR; PG8_MMA(0, 0, At, B0); PG8_MMA(0, 1, At, B1); PG8_BAR; PG8_SCHED;
            PG8_LDA(At, 0, 1); PG8_STAGE(PG8_SB(0, 0), b2, voffB); PG8_STAGE(PG8_SB(0, 1), b2 + hstep, voffB); PG8_STAGE(PG8_SA(0, 0), a2, voffA);
            PG8_WAIT_V(8); PG8_WAIT_L(0); PG8_BAR; PG8_MMA(1, 0, At, B0); PG8_MMA(1, 1, At, B1); PG8_BAR; PG8_SCHED;
            PG8_LDB(B0, 1, 0); PG8_LDB(B1, 1, 1); PG8_SCHED; PG8_LDA(At, 1, 0); PG8_STAGE(PG8_SA(0, 1), a2 + hstep, voffA);
            PG8_WAIT_V(8); PG8_WAIT_L(0); PG8_BAR; PG8_MMA(0, 0, At, B0); PG8_MMA(0, 1, At, B1); PG8_BAR; PG8_SCHED;
            PG8_LDA(At, 1, 1); PG8_STAGE(PG8_SB(1, 0), b3, voffB); PG8_STAGE(PG8_SB(1, 1), b3 + hstep, voffB); PG8_STAGE(PG8_SA(1, 0), a3, voffA);
            PG8_WAIT_V(8); PG8_WAIT_L(0); PG8_BAR; PG8_MMA(1, 0, At, B0); PG8_MMA(1, 1, At, B1); PG8_BAR; PG8_SCHED;
            } else {
            PG8_LDB(B0, 0, 0); PG8_SCHED; PG8_LDA(At, 0, 0); PG8_STAGE(PG8_SA(1, 1), a1 + hstep, voffA);
            PG8_WAIT_L(8); PG8_BAR; PG8_WAIT_L(0); PG8_MMA(0, 0, At, B0); PG8_BAR; PG8_SCHED;
            PG8_LDB(B1, 0, 1); PG8_STAGE(PG8_SB(0, 0), b2, voffB);
            PG8_BAR; PG8_WAIT_L(0); PG8_MMA(0, 1, At, B1); PG8_BAR;
            PG8_LDA(At, 0, 1); PG8_STAGE(PG8_SA(0, 0), a2, voffA);
            PG8_BAR; PG8_WAIT_L(0); PG8_MMA(1, 0, At, B0); PG8_BAR; PG8_SCHED;
            PG8_STAGE(PG8_SB(0, 1), b2 + hstep, voffB);
            PG8_WAIT_V(6); PG8_BAR; PG8_MMA(1, 1, At, B1); PG8_BAR;
            PG8_LDB(B0, 1, 0); PG8_SCHED; PG8_LDA(At, 1, 0); PG8_STAGE(PG8_SA(0, 1), a2 + hstep, voffA);
            PG8_WAIT_L(8); PG8_BAR; PG8_WAIT_L(0); PG8_MMA(0, 0, At, B0); PG8_BAR; PG8_SCHED;
            PG8_LDB(B1, 1, 1); PG8_STAGE(PG8_SB(1, 0), b3, voffB);
            PG8_BAR; PG8_WAIT_L(0); PG8_MMA(0, 1, At, B1); PG8_BAR;
            PG8_LDA(At, 1, 1); PG8_STAGE(PG8_SA(1, 0), a3, voffA);
            PG8_BAR; PG8_WAIT_L(0); PG8_MMA(1, 0, At, B0); PG8_BAR; PG8_SCHED;
            PG8_STAGE(PG8_SB(1, 1), b3 + hstep, voffB);
            PG8_WAIT_V(6); PG8_BAR; PG8_MMA(1, 1, At, B1); PG8_BAR;
            }
        }
        if constexpr (ALIGN_EPI) { if (wr == 0) PG8_BAR; }
        if constexpr (!Epi::AFTER_DRAIN) { E(acc, cur, wr, wc, fr, fq); S.done(cur); }
        if (!has_next) break;
#pragma unroll
        for (int a = 0; a < 2; ++a)
#pragma unroll
            for (int b = 0; b < 2; ++b)
#pragma unroll
                for (int m = 0; m < 4; ++m)
#pragma unroll
                    for (int n = 0; n < 2; ++n) acc[a][b][m][n] = (f32x4){0.f, 0.f, 0.f, 0.f};
        cur = nxt; cA = nA; cB = nB; ++ui;
        if constexpr (ALIGN_EPI) { if (wr == 1) PG8_BAR; }
    }
    PG8_WAIT_V(0);
    if constexpr (!ALIGN_EPI) { if (wr == 0) PG8_BAR; }
    PG8_BAR;
    if constexpr (Epi::AFTER_DRAIN) { E.fused(acc, cur, wr, wc, fr, fq, lds, wid, lane); S.done(cur); }
#undef PG8_SA
#undef PG8_SB
#undef PG8_STAGE
#undef PG8_LDA
#undef PG8_LDB
#undef PG8_MMA
#undef PG8_WAIT_V
#undef PG8_WAIT_L
#undef PG8_BAR
#undef PG8_SCHED
}
}
namespace pg8 {
typedef unsigned u32x2v __attribute__((ext_vector_type(2)));
constexpr int TOK_S = 8192;
constexpr float QK_EPS = 1e-6f;
constexpr float C2 = 0.125f * 1.4426950408889634f;
__device__ __forceinline__ float sigmoid_fast(float v) { return __builtin_amdgcn_rcpf(1.f + __builtin_amdgcn_exp2f(-1.4426950408889634f * v)); }
__device__ __forceinline__ float silu_fast(float v) { return v * __builtin_amdgcn_rcpf(1.f + __builtin_amdgcn_exp2f(-1.4426950408889634f * v)); }

struct EpiInProj {
    static constexpr bool PERM = true, AFTER_DRAIN = false;
    bf16_t* qkv;
    float* gates;
    float* kmean_part;
    const float *qna, *kna, *qnb, *knsel, *knwin;
    __device__ __forceinline__ void operator()(const f32x4 (&acc)[2][2][4][2], const Unit& u, int wr, int wc, int fr, int fq) const {
        const int slot = u.pn * 4 + wc;
        if (slot > 44) return;
        const int b = u.pm >> 5, blk = u.pm & 31, pos0 = blk * 256 + wr * 64 + fr;
        if (slot == 44) {
            if (fq < 3) {
#pragma unroll
                for (int ai = 0; ai < 2; ++ai)
#pragma unroll
                    for (int m = 0; m < 4; ++m) { const size_t tok = (size_t)b * TOK_S + pos0 + ai * HALF + m * 16; float* gp = gates + tok * 24 + 8 * fq;
                        const f32x4 v0 = acc[ai][0][m][0], v1 = acc[ai][0][m][1];
                        *(f32x4*)gp = (f32x4){sigmoid_fast(v0[0]), sigmoid_fast(v0[1]), sigmoid_fast(v0[2]), sigmoid_fast(v0[3])};
                        *(f32x4*)(gp + 4) = (f32x4){sigmoid_fast(v1[0]), sigmoid_fast(v1[1]), sigmoid_fast(v1[2]), sigmoid_fast(v1[3])}; }
            }
            return;
        }
        const float* gain = nullptr; float qscale = 1.f; bool is_ka = false; bf16_t* dst;
        constexpr size_t BIG = (size_t)4 * 8 * TOK_S * 64, SMALL = (size_t)4 * 2 * TOK_S * 64;
        if (slot < 32) { const int kind = slot >> 3, head = slot & 7; dst = qkv + kind * BIG + ((size_t)(b * 8 + head) * TOK_S) * 64;
            if (kind == 0) { gain = qna; qscale = C2; } else if (kind == 1) { gain = kna; is_ka = true; } else if (kind == 3) { gain = qnb; qscale = C2; } }
        else { const int kind = (slot - 32) >> 1, g = slot & 1; dst = qkv + 4 * BIG + kind * SMALL + ((size_t)(b * 2 + g) * TOK_S) * 64;
            if (kind == 2) gain = knsel; else if (kind == 4) gain = knwin; }
        float gv[16];
#pragma unroll
        for (int i = 0; i < 16; ++i) gv[i] = gain ? gain[(i >> 3) * 32 + 8 * fq + (i & 7)] * qscale : 1.f;
        float cs[16];
#pragma unroll
        for (int i = 0; i < 16; ++i) cs[i] = 0.f;
#pragma unroll
        for (int ai = 0; ai < 2; ++ai)
#pragma unroll
            for (int m = 0; m < 4; ++m) {
                float v[16];
#pragma unroll
                for (int bj = 0; bj < 2; ++bj)
#pragma unroll
                    for (int n = 0; n < 2; ++n)
#pragma unroll
                        for (int j = 0; j < 4; ++j) v[bj * 8 + n * 4 + j] = acc[ai][bj][m][n][j];
                if (gain) { float ss = 0.f;
#pragma unroll
                    for (int i = 0; i < 16; ++i) ss += v[i] * v[i];
                    ss += __shfl_xor(ss, 16); ss += __shfl_xor(ss, 32);
                    const float rs = rsqrtf(ss * (1.f / 64.f) + QK_EPS);
#pragma unroll
                    for (int i = 0; i < 16; ++i) v[i] *= rs * gv[i]; }
                if (is_ka) {
#pragma unroll
                    for (int i = 0; i < 16; ++i) cs[i] += v[i]; }
                bf16_t* rp = dst + (size_t)(pos0 + ai * HALF + m * 16) * 64 + 8 * fq;
                u32x4 w0, w1;
                w0.x = cvt_pk_bf16(v[0], v[1]); w0.y = cvt_pk_bf16(v[2], v[3]); w0.z = cvt_pk_bf16(v[4], v[5]); w0.w = cvt_pk_bf16(v[6], v[7]);
                w1.x = cvt_pk_bf16(v[8], v[9]); w1.y = cvt_pk_bf16(v[10], v[11]); w1.z = cvt_pk_bf16(v[12], v[13]); w1.w = cvt_pk_bf16(v[14], v[15]);
                *(u32x4*)rp = w0; *(u32x4*)(rp + 32) = w1;
            }
        if (is_ka) {
#pragma unroll
            for (int i = 0; i < 16; ++i) { float s = cs[i]; s += __shfl_xor(s, 1); s += __shfl_xor(s, 2); s += __shfl_xor(s, 4); s += __shfl_xor(s, 8); cs[i] = s; }
            if (fr == 0) { float* kp = kmean_part + ((size_t)((b * 8 + (slot & 7)) * 32 + blk) * 2 + wr) * 64 + 8 * fq;
                *(f32x4*)kp = (f32x4){cs[0], cs[1], cs[2], cs[3]}; *(f32x4*)(kp + 4) = (f32x4){cs[4], cs[5], cs[6], cs[7]};
                *(f32x4*)(kp + 32) = (f32x4){cs[8], cs[9], cs[10], cs[11]}; *(f32x4*)(kp + 36) = (f32x4){cs[12], cs[13], cs[14], cs[15]}; }
        }
    }
};
struct EpiOutProj {
    static constexpr bool PERM = true, AFTER_DRAIN = false;
    bf16_t* y; const float* gt;
    __device__ __forceinline__ void operator()(const f32x4 (&acc)[2][2][4][2], const Unit& u, int wr, int wc, int fr, int fq) const {
        const int b = u.pm >> 5; const int col0 = u.pn * BM + wc * 32 + 8 * fq; const float* gtb = gt + (size_t)b * 6144;
#pragma unroll
        for (int bj = 0; bj < 2; ++bj) { const int c = col0 + bj * HALF; const f32x4 g40 = *(const f32x4*)(gtb + c), g41 = *(const f32x4*)(gtb + c + 4);
#pragma unroll
            for (int ai = 0; ai < 2; ++ai)
#pragma unroll
                for (int m = 0; m < 4; ++m) { const size_t off = (size_t)(u.pm * BM + ai * HALF + wr * 64 + m * 16 + fr) * 1024 + c;
                    const f32x4 y0 = g40 * acc[ai][bj][m][0], y1 = g41 * acc[ai][bj][m][1];
                    u32x4 w; w.x = cvt_pk_bf16(y0[0], y0[1]); w.y = cvt_pk_bf16(y0[2], y0[3]); w.z = cvt_pk_bf16(y1[0], y1[1]); w.w = cvt_pk_bf16(y1[2], y1[3]);
                    *(u32x4*)(y + off) = w; } }
    }
};
struct EpiGateUp {
    static constexpr bool PERM = true, AFTER_DRAIN = false;
    bf16_t* act;
    __device__ __forceinline__ void operator()(const f32x4 (&acc)[2][2][4][2], const Unit& u, int wr, int wc, int fr, int fq) const {
        const int h0 = u.pn * 128 + wc * 32 + 8 * fq;
#pragma unroll
        for (int ai = 0; ai < 2; ++ai)
#pragma unroll
            for (int m = 0; m < 4; ++m) { const size_t row = (size_t)(u.pm * BM + ai * HALF + wr * 64 + m * 16 + fr);
                const f32x4 g0 = acc[ai][0][m][0], g1 = acc[ai][0][m][1], u0 = acc[ai][1][m][0], u1 = acc[ai][1][m][1];
                u32x4 w;
                w.x = cvt_pk_bf16(silu_fast(g0[0]) * u0[0], silu_fast(g0[1]) * u0[1]); w.y = cvt_pk_bf16(silu_fast(g0[2]) * u0[2], silu_fast(g0[3]) * u0[3]);
                w.z = cvt_pk_bf16(silu_fast(g1[0]) * u1[0], silu_fast(g1[1]) * u1[1]); w.w = cvt_pk_bf16(silu_fast(g1[2]) * u1[2], silu_fast(g1[3]) * u1[3]);
                *(u32x4*)(act + row * 2816 + h0) = w; }
    }
};
struct EpiDown {
    static constexpr bool PERM = true, AFTER_DRAIN = false;
    const float* x; const bf16_t* y; float* out; const float* gt;
    __device__ __forceinline__ void operator()(const f32x4 (&acc)[2][2][4][2], const Unit& u, int wr, int wc, int fr, int fq) const {
        const int b = u.pm >> 5; const int col0 = u.pn * BM + wc * 32 + 8 * fq; const float* gtb = gt + (size_t)b * 6144;
#pragma unroll
        for (int bj = 0; bj < 2; ++bj) { const int c = col0 + bj * HALF; const f32x4 g40 = *(const f32x4*)(gtb + c), g41 = *(const f32x4*)(gtb + c + 4);
#pragma unroll
            for (int ai = 0; ai < 2; ++ai)
#pragma unroll
                for (int m = 0; m < 4; ++m) { const size_t off = (size_t)(u.pm * BM + ai * HALF + wr * 64 + m * 16 + fr) * 1024 + c;
                    const f32x4 x0 = *(const f32x4*)(x + off), x1 = *(const f32x4*)(x + off + 4); const u32x4 yw = *(const u32x4*)(y + off);
                    const f32x4 y0 = {__builtin_bit_cast(float, yw.x << 16), __builtin_bit_cast(float, yw.x & 0xffff0000u), __builtin_bit_cast(float, yw.y << 16), __builtin_bit_cast(float, yw.y & 0xffff0000u)};
                    const f32x4 y1 = {__builtin_bit_cast(float, yw.z << 16), __builtin_bit_cast(float, yw.z & 0xffff0000u), __builtin_bit_cast(float, yw.w << 16), __builtin_bit_cast(float, yw.w & 0xffff0000u)};
                    *(f32x4*)(out + off) = (x0 + y0) + g40 * acc[ai][bj][m][0]; *(f32x4*)(out + off + 4) = (x1 + y1) + g41 * acc[ai][bj][m][1]; } }
    }
};
}
constexpr int NWAVES = 8, NTHREADS = 512;
constexpr int BATCH = 4, SEQ = 8192, DM = 1024, TOK = BATCH * SEQ, NIN = 2840, NIN_PAD = 3072, FF = 2816, NCMP = 511;
constexpr size_t MiB = 1u << 20;
constexpr size_t WS_CTL = 0, CTL_ZERO_BYTES = 64 * 1024;
constexpr size_t WS_MODP = 1 * MiB;
constexpr size_t WS_MOD = 2 * MiB;
constexpr size_t WS_CBP = 2 * MiB + 512 * 1024;
constexpr size_t WS_KMP = 3 * MiB;
constexpr size_t WS_BIAS2 = 4 * MiB;
constexpr size_t WS_SSP = 449 * MiB;
constexpr size_t WS_WIN = 6 * MiB, WS_WOUT = 12 * MiB, WS_WGU = 14 * MiB, WS_WDN = 25 * MiB;
constexpr size_t WS_W1K = 31 * MiB, WS_W1V = 32 * MiB, WS_W2K = 33 * MiB, WS_W2V = 33 * MiB + 64 * 1024;
constexpr size_t WS_KCMP = 34 * MiB, WS_VCMP = 35 * MiB;
constexpr size_t WS_GATES = 36 * MiB;
constexpr size_t WS_H = 40 * MiB;
constexpr size_t WS_MIX = 104 * MiB;
constexpr size_t WS_QKV = 168 * MiB;
constexpr size_t WS_ACT = WS_QKV;
constexpr size_t WS_END = 344 * MiB;
constexpr size_t WS_PARTO = 344 * MiB;
constexpr size_t WS_PARTL = 472 * MiB;
constexpr size_t WS_SELG = 476 * MiB;
constexpr size_t WS_Y = WS_PARTO;
constexpr size_t QKV_BIG = (size_t)4 * 8 * SEQ * 64, QKV_SMALL = (size_t)4 * 2 * SEQ * 64;
constexpr int RING_BYTES = 131072, LDS_BYTES = 147456;
constexpr int N_PHASES = 10;

#define GAS __attribute__((address_space(1)))
#define LAS __attribute__((address_space(3)))
typedef unsigned short bf16;
typedef unsigned v4u __attribute__((ext_vector_type(4)));
typedef float f32x4 __attribute__((ext_vector_type(4)));
#define LDS_WAIT() asm volatile("s_waitcnt lgkmcnt(0)" ::: "memory")
#define VM_WAIT() asm volatile("s_waitcnt vmcnt(0)" ::: "memory")
__device__ __forceinline__ unsigned f2bf(float f) { unsigned u = __builtin_bit_cast(unsigned, f); return (u + 0x7fffu + ((u >> 16) & 1u)) >> 16; }
__device__ __forceinline__ unsigned pk2(float lo, float hi) { return f2bf(lo) | (f2bf(hi) << 16); }
__device__ __forceinline__ float bf2f(bf16 v) { return __builtin_bit_cast(float, (unsigned)v << 16); }
__device__ __forceinline__ float wave_sum(float v) {
#pragma unroll
    for (int o = 1; o < 64; o <<= 1) v += __shfl_xor(v, o);
    return v;
}
struct Args { const float* in[23]; float* out; unsigned char* ws; int ph_lo, ph_hi; };
struct Frame { LAS unsigned char* lds; int tid, lane, wave, vcu, G; };

struct MapId { __device__ __forceinline__ size_t off(int n, int k, int K) const { return (size_t)n * K + k; } };
struct MapWin { __device__ __forceinline__ size_t off(int n, int k, int K) const { const int s = n >> 6, d = n & 63; return (size_t)(256 * (s >> 2) + 128 * (d >> 5) + 32 * (s & 3) + (d & 31)) * K + k; } };
struct MapWgu { __device__ __forceinline__ size_t off(int n, int k, int K) const { const int up = n >= FF, hdn = up ? n - FF : n; return (size_t)(256 * (hdn >> 7) + 128 * up + (hdn & 127)) * K + k; } };
struct MapFrag { __device__ __forceinline__ size_t off(int n, int k, int K) const { return ((size_t)((k >> 4) * 8 + (n >> 5)) * 64 + ((k >> 3) & 1) * 32 + (n & 31)) * 8 + (k & 7); } };
template <class Map>
__device__ __forceinline__ void transpose_item(const float* __restrict__ W, int K, int N, bf16* WT, LAS float* scr, int item, int lane, const Map& map) {
    const int nblk = (N + 63) / 64, kb = item / nblk, nb = item % nblk, k0 = 64 * kb, n0 = 64 * nb;
    const int nc = n0 + 4 * (lane & 15); const bool nin = nc < N;
    f32x4 v[16];
#pragma unroll
    for (int i = 0; i < 16; ++i) { const int kk = 4 * i + (lane >> 4); v[i] = nin ? *(const GAS f32x4*)(W + (size_t)(k0 + kk) * N + nc) : (f32x4){0.f, 0.f, 0.f, 0.f}; }
#pragma unroll
    for (int i = 0; i < 16; ++i) { const int kk = 4 * i + (lane >> 4); LAS float* d = scr + (4 * (lane & 15)) * 68 + kk; d[0] = v[i][0]; d[68] = v[i][1]; d[136] = v[i][2]; d[204] = v[i][3]; }
    LDS_WAIT(); asm volatile("" ::: "memory");
    const int c = lane & 7;
#pragma unroll
    for (int j = 0; j < 8; ++j) { const int n = (lane >> 3) + 8 * j; const LAS float* s = scr + n * 68 + 8 * c;
        const f32x4 a = *(const LAS f32x4*)s, bq = *(const LAS f32x4*)(s + 4);
        v4u o; o.x = pk2(a[0], a[1]); o.y = pk2(a[2], a[3]); o.z = pk2(bq[0], bq[1]); o.w = pk2(bq[2], bq[3]);
        if (n0 + n < N) *(GAS v4u*)(WT + map.off(n0 + n, k0 + 8 * c, K)) = o; }
    LDS_WAIT(); asm volatile("" ::: "memory");
}
__device__ __forceinline__ float silu_acc(float v) { return v / (1.f + expf(-v)); }
__device__ __forceinline__ void phase_prologue_a(Frame& F, const Args& a) {
    LAS float* scr = (LAS float*)(F.lds + F.wave * 17408);
    const int gw = F.vcu * NWAVES + F.wave, NGW = F.G * NWAVES;
    unsigned char* ws = a.ws;
    constexpr int I_IN = (DM / 64) * ((NIN + 63) / 64), I_OUT = (DM / 64) * (DM / 64), I_GU = (DM / 64) * (2 * FF / 64), I_DN = (FF / 64) * (DM / 64), I_W1 = (2048 / 64) * (256 / 64), I_W2 = (256 / 64) * (64 / 64);
    constexpr int NITEMS = I_IN + I_OUT + I_GU + I_DN + 2 * I_W1 + 2 * I_W2;
    for (int it = gw; it < NITEMS; it += NGW) {
        int r = it;
        if (r < I_IN) { transpose_item(a.in[6], DM, NIN, (bf16*)(ws + WS_WIN), scr, r, F.lane, MapWin()); continue; } r -= I_IN;
        if (r < I_OUT) { transpose_item(a.in[19], DM, DM, (bf16*)(ws + WS_WOUT), scr, r, F.lane, MapId()); continue; } r -= I_OUT;
        if (r < I_GU) { transpose_item(a.in[21], DM, 2 * FF, (bf16*)(ws + WS_WGU), scr, r, F.lane, MapWgu()); continue; } r -= I_GU;
        if (r < I_DN) { transpose_item(a.in[22], FF, DM, (bf16*)(ws + WS_WDN), scr, r, F.lane, MapId()); continue; } r -= I_DN;
        if (r < I_W1) { transpose_item(a.in[14], 2048, 256, (bf16*)(ws + WS_W1K), scr, r, F.lane, MapFrag()); continue; } r -= I_W1;
        if (r < I_W1) { transpose_item(a.in[17], 2048, 256, (bf16*)(ws + WS_W1V), scr, r, F.lane, MapFrag()); continue; } r -= I_W1;
        if (r < I_W2) { transpose_item(a.in[15], 256, 64, (bf16*)(ws + WS_W2K), scr, r, F.lane, MapId()); continue; } r -= I_W2;
        transpose_item(a.in[18], 256, 64, (bf16*)(ws + WS_W2V), scr, r, F.lane, MapId());
    }
    const float* c = a.in[1]; const float* w_ada = a.in[3]; float* modp = (float*)(ws + WS_MODP);
    for (int t = NGW - 1 - gw; t < 96 * 8; t += NGW) { const int cg_ = t % 96, ks = t / 96; const int n = cg_ * 64 + F.lane;
        float acc0 = 0.f, acc1 = 0.f, acc2 = 0.f, acc3 = 0.f;
#pragma unroll
        for (int i = 0; i < 8; ++i) { const int idx = F.lane + 64 * i, bb = idx >> 7, kk = idx & 127; scr[kk * 4 + bb] = silu_acc(c[bb * DM + ks * 128 + kk]); }
        LDS_WAIT(); asm volatile("" ::: "memory");
#pragma unroll 8
        for (int k = 0; k < 128; ++k) { const float w = w_ada[(size_t)(ks * 128 + k) * 6144 + n]; const f32x4 sv = *(const LAS f32x4*)(scr + 4 * k);
            acc0 += sv[0] * w; acc1 += sv[1] * w; acc2 += sv[2] * w; acc3 += sv[3] * w; }
        LDS_WAIT(); asm volatile("" ::: "memory");
        float* o = modp + (size_t)ks * 4 * 6144 + n; o[0] = acc0; o[6144] = acc1; o[2 * 6144] = acc2; o[3 * 6144] = acc3; }
    float* cbp = (float*)(ws + WS_CBP);
    for (int t = NGW / 2 - 1 - gw; t >= 0 && t < 256; t += NGW) { const int kv = t & 1, cg_ = (t >> 1) & 3, ic = t >> 3; const int n = cg_ * 64 + F.lane;
        const float* pe = kv ? a.in[16] : a.in[13]; const float* w1 = kv ? a.in[17] : a.in[14]; float acc = 0.f;
#pragma unroll 8
        for (int i = ic * 64; i < ic * 64 + 64; ++i) acc += pe[i] * w1[(size_t)i * 256 + n];
        cbp[(ic * 2 + kv) * 256 + n] = acc; }
}
template <bool ADDY>
__device__ __forceinline__ void norm_rows(Frame& F, int blk, const float* in, const bf16* yin, const f32x4 (&gs)[4], const f32x4 (&sh)[4], bf16* out) {
    for (int i0 = 0; i0 < 16; i0 += 4) {
        f32x4 v[4][4]; float ss[4];
#pragma unroll
        for (int r = 0; r < 4; ++r) { const int row = blk * 128 + F.wave * 16 + i0 + r; const GAS f32x4* xr = (const GAS f32x4*)(in + (size_t)row * DM) + F.lane;
#pragma unroll
            for (int j = 0; j < 4; ++j) v[r][j] = xr[64 * j];
            if (ADDY) { const GAS unsigned long long* yr = (const GAS unsigned long long*)(yin + (size_t)row * DM) + F.lane;
#pragma unroll
                for (int j = 0; j < 4; ++j) { const unsigned long long w = yr[64 * j]; const unsigned lo = (unsigned)w, hi = (unsigned)(w >> 32);
                    v[r][j] += (f32x4){__builtin_bit_cast(float, lo << 16), __builtin_bit_cast(float, lo & 0xffff0000u), __builtin_bit_cast(float, hi << 16), __builtin_bit_cast(float, hi & 0xffff0000u)}; } } }
#pragma unroll
        for (int r = 0; r < 4; ++r) { float s = 0.f;
#pragma unroll
            for (int j = 0; j < 4; ++j) s += (v[r][j].x * v[r][j].x + v[r][j].y * v[r][j].y) + (v[r][j].z * v[r][j].z + v[r][j].w * v[r][j].w);
            ss[r] = s; }
#pragma unroll
        for (int o_ = 1; o_ < 64; o_ <<= 1) {
#pragma unroll
            for (int r = 0; r < 4; ++r) ss[r] += __shfl_xor(ss[r], o_); }
#pragma unroll
        for (int r = 0; r < 4; ++r) { const int row = blk * 128 + F.wave * 16 + i0 + r; const float rs = rsqrtf(ss[r] * (1.f / DM) + 1e-6f);
            GAS unsigned long long* o8 = (GAS unsigned long long*)(out + (size_t)row * DM) + F.lane;
#pragma unroll
            for (int j = 0; j < 4; ++j) { const f32x4 y = v[r][j] * rs * gs[j] + sh[j]; o8[64 * j] = (unsigned long long)pk2(y.x, y.y) | ((unsigned long long)pk2(y.z, y.w) << 32); } }
    }
}
__device__ __forceinline__ void phase_prologue_b(Frame& F, const Args& a) {
    unsigned char* ws = a.ws; const float* modp = (const float*)(ws + WS_MODP); const float* b_ada = a.in[4];
    if (F.wave == 0) for (int cgp = F.vcu; cgp < 96; cgp += F.G) { const int n = cgp * 64 + F.lane; float* mod = (float*)(ws + WS_MOD);
        for (int b = 0; b < 4; ++b) { float s = 0.f;
#pragma unroll
            for (int ks = 0; ks < 8; ++ks) s += modp[((size_t)ks * 4 + b) * 6144 + n];
            mod[b * 6144 + n] = s + b_ada[n]; } }
    const float* g = a.in[5];
    for (int blk = F.vcu; blk < TOK / 128; blk += F.G) { const int b = blk >> 6;
    f32x4 gs[4], sh[4];
#pragma unroll
    for (int j = 0; j < 4; ++j) { const int c0 = 4 * F.lane + 256 * j; f32x4 s0 = {0.f, 0.f, 0.f, 0.f}, s1 = {0.f, 0.f, 0.f, 0.f};
#pragma unroll
        for (int ks = 0; ks < 8; ++ks) { s0 += *(const f32x4*)(modp + ((size_t)ks * 4 + b) * 6144 + c0); s1 += *(const f32x4*)(modp + ((size_t)ks * 4 + b) * 6144 + DM + c0); }
        s0 += *(const f32x4*)(b_ada + c0); s1 += *(const f32x4*)(b_ada + DM + c0);
        sh[j] = s0; gs[j] = *(const f32x4*)(g + c0) * (s1 + 1.0f); }
    norm_rows<false>(F, blk, a.in[0], nullptr, gs, sh, (bf16*)(ws + WS_H)); }
}
__device__ __forceinline__ void phase_norm2(Frame& F, const Args& a) {
    unsigned char* ws = a.ws; const float* g = a.in[20];
    for (int blk = F.vcu; blk < TOK / 128; blk += F.G) { const int b = blk >> 6; const float* mod = (const float*)(ws + WS_MOD) + (size_t)b * 6144;
        f32x4 gs[4], sh[4];
#pragma unroll
        for (int j = 0; j < 4; ++j) { const int c0 = 4 * F.lane + 256 * j; sh[j] = *(const f32x4*)(mod + 3 * DM + c0); gs[j] = *(const f32x4*)(g + c0) * (*(const f32x4*)(mod + 4 * DM + c0) + 1.0f); }
        norm_rows<true>(F, blk, a.in[0], (const bf16*)(ws + WS_Y), gs, sh, (bf16*)(ws + WS_H)); }
}

__device__ __forceinline__ void phase_bias2(Frame& F, const Args& a) {
    unsigned char* ws = a.ws; const float* mod = (const float*)(ws + WS_MOD); const bf16* wt = (const bf16*)(ws + WS_WGU); float* bias2 = (float*)(ws + WS_BIAS2);
    const int gw = F.vcu * NWAVES + F.wave, NGW = F.G * NWAVES;
    f32x4 sh[4][4];
#pragma unroll
    for (int bb = 0; bb < 4; ++bb)
#pragma unroll
        for (int j = 0; j < 4; ++j) sh[bb][j] = *(const f32x4*)(mod + (size_t)bb * 6144 + 3 * DM + 16 * F.lane + 4 * j);
    for (int c = gw; c < 2 * FF; c += NGW) {
        const v4u w0 = *(const GAS v4u*)(wt + (size_t)c * DM + 16 * F.lane), w1 = *(const GAS v4u*)(wt + (size_t)c * DM + 16 * F.lane + 8);
        const unsigned wu[8] = {w0.x, w0.y, w0.z, w0.w, w1.x, w1.y, w1.z, w1.w};
        float s[4] = {0.f, 0.f, 0.f, 0.f};
#pragma unroll
        for (int j = 0; j < 4; ++j) { const float e0 = __builtin_bit_cast(float, wu[2 * j] << 16), e1 = __builtin_bit_cast(float, wu[2 * j] & 0xffff0000u), e2 = __builtin_bit_cast(float, wu[2 * j + 1] << 16), e3 = __builtin_bit_cast(float, wu[2 * j + 1] & 0xffff0000u);
#pragma unroll
            for (int bb = 0; bb < 4; ++bb) s[bb] += (sh[bb][j][0] * e0 + sh[bb][j][1] * e1) + (sh[bb][j][2] * e2 + sh[bb][j][3] * e3); }
#pragma unroll
        for (int bb = 0; bb < 4; ++bb) { const float t = wave_sum(s[bb]); if (F.lane == 0) bias2[(size_t)bb * 2 * FF + c] = t; }
    }
}
#define XB_TMO      128
#define XB_XCNT(j)  (256  + 64 * (j))
#define XB_XSUB(j)  (1280 + 64 * (j))
#define XB_XGEN(j)  (2304 + 64 * (j))
#define XB_TOP      3328
#define XB_TOPGEN   3392
#define XCD_BAR_WORDS 3456
#define XB_SPIN_CAP (1u << 18)

__device__ __forceinline__ unsigned xb_ld(unsigned* p)              { return __hip_atomic_load(p, __ATOMIC_RELAXED, __HIP_MEMORY_SCOPE_AGENT); }
__device__ __forceinline__ unsigned xb_add(unsigned* p, unsigned v) { return __hip_atomic_fetch_add(p, v, __ATOMIC_RELAXED, __HIP_MEMORY_SCOPE_AGENT); }
__device__ __forceinline__ unsigned xb_xcc_id() { return (unsigned)__builtin_amdgcn_s_getreg((3 << 11) | 20) & 0xFu; }
#define XB_SPIN(cond, bar) do { unsigned _sp = 0; while (cond) { __builtin_amdgcn_s_sleep(1); \
    if ((++_sp & 255u) == 0u) { if (xb_ld(&(bar)[XB_TMO])) break; if (_sp > XB_SPIN_CAP) { atomicAdd(&(bar)[XB_TMO], 1u); break; } } } } while (0)

struct XcdBarrier {
    unsigned* bar; unsigned x;
    volatile LAS unsigned* st;
};

__device__ __forceinline__ XcdBarrier xcd_barrier_post(unsigned* bar, volatile LAS unsigned* st) {
    XcdBarrier b; b.bar = bar; b.x = xb_xcc_id(); b.st = st;
    if (threadIdx.x == 0) (void)xb_add(&bar[XB_XCNT(b.x)], 1u);
    return b;
}
__device__ __forceinline__ void xcd_barrier_complete(unsigned* bar, unsigned x, unsigned& nloc, unsigned& nx) {
    const unsigned G = gridDim.x * gridDim.y * gridDim.z;
    unsigned sum, cnt, mine, sp = 0u;
    for (;;) {
        sum = 0u; cnt = 0u; mine = 0u;
#pragma unroll
        for (unsigned j = 0; j < 16; ++j) { const unsigned c = xb_ld(&bar[XB_XCNT(j)]); sum += c; cnt += (c > 0u) ? 1u : 0u; mine = (j == x) ? c : mine; }
        if (sum == G) break;
        __builtin_amdgcn_s_sleep(1);
        if ((++sp & 255u) == 0u) { if (xb_ld(&bar[XB_TMO])) break; if (sp > XB_SPIN_CAP) { atomicAdd(&bar[XB_TMO], 1u); break; } }
    }
    nloc = mine > 0u ? mine : 1u; nx = cnt > 0u ? cnt : 1u;
}

__device__ __forceinline__ void xcd_barrier(const XcdBarrier& b) {
    asm volatile("s_waitcnt vmcnt(0)" ::: "memory");
    __syncthreads();
    if (threadIdx.x == 0) {
        unsigned* bar = b.bar;
        __builtin_amdgcn_s_waitcnt(0);
        unsigned nloc = b.st[0], nx = b.st[1];
        if (nloc == 0u) { xcd_barrier_complete(bar, b.x, nloc, nx); b.st[0] = nloc; b.st[1] = nx; }
        const unsigned old = xb_add(&bar[XB_XSUB(b.x)], 1u);
        const unsigned gen = old / nloc;
        if (old + 1u == (gen + 1u) * nloc) {
            __builtin_amdgcn_fence(__ATOMIC_RELEASE, "agent");
            asm volatile("s_waitcnt vmcnt(0)" ::: "memory");
            const unsigned og = xb_add(&bar[XB_TOP], 1u);
            const unsigned tg = og / nx;
            if (og + 1u == (tg + 1u) * nx) xb_add(&bar[XB_TOPGEN], 1u);
            else XB_SPIN(xb_ld(&bar[XB_TOPGEN]) == tg, bar);
            __builtin_amdgcn_fence(__ATOMIC_ACQUIRE, "agent");
            xb_add(&bar[XB_XGEN(b.x)], 1u);
            asm volatile("s_waitcnt vmcnt(0)" ::: "memory");
        } else {
            XB_SPIN(xb_ld(&bar[XB_XGEN(b.x)]) == gen, bar);
            __builtin_amdgcn_fence(__ATOMIC_ACQUIRE, "agent");
            asm volatile("s_waitcnt vmcnt(0)" ::: "memory");
        }
    }
    __syncthreads();
}
#define ATT_NS att
#ifndef ATT_ABL
#define ATT_ABL 0
#endif
#ifndef ATT_STAGGER
#define ATT_STAGGER 0
#endif
#ifndef ATT_SLEEP
#define ATT_SLEEP 24
#endif
namespace ATT_NS {
using bf16x8 = __attribute__((ext_vector_type(8))) short;
using s16x4 = __attribute__((ext_vector_type(4))) short;
using f32x16 = __attribute__((ext_vector_type(16))) float;
using u32x4 = __attribute__((ext_vector_type(4))) unsigned;
typedef LAS const char* lds_cptr;
typedef short v4i16_t __attribute__((ext_vector_type(4)));
constexpr int SLOT = 16384, NSLOT = 4, LDS_OST = 65536, LDS_IMP = 100608, LDS_SELM = 135680, LDS_MISC = 136704, LDS_WSF = 136960, LDS_LUTG = 139008  , LDS_ATT_END = 147200;
constexpr int LUT_PITCH = 116;
constexpr int IMP_PITCH = 136, IMP_PLANE = 64 * IMP_PITCH + 4, IMP_REG1 = 64;
constexpr float LOG2E = 1.4426950408889634f;
#define MFMA32(a, b, c) __builtin_amdgcn_mfma_f32_32x32x16_bf16(a, b, c, 0, 0, 0)
#define ATT_WAIT_BAR(N) asm volatile("s_waitcnt vmcnt(" #N ") lgkmcnt(0)\n\ts_barrier" ::: "memory")
__device__ __forceinline__ void glds16(const void* gsrc, unsigned lds_dst) { unsigned keep;
    asm volatile("s_mov_b32 %0, m0\n\ts_mov_b32 m0, %2\n\ts_nop 0\n\tglobal_load_lds_dwordx4 %1, off\n\ts_mov_b32 m0, %0" : "=&s"(keep) : "v"(gsrc), "s"(lds_dst) : "memory"); }
typedef float f32x2_t __attribute__((ext_vector_type(2))); typedef __bf16 bf16x2_t __attribute__((ext_vector_type(2)));
__device__ __forceinline__ unsigned cvtpk(float lo, float hi) { f32x2_t v = {lo, hi}; bf16x2_t b = __builtin_convertvector(v, bf16x2_t); return __builtin_bit_cast(unsigned, b); }
__device__ __forceinline__ s16x4 vtr(lds_cptr p) { return __builtin_bit_cast(s16x4, __builtin_amdgcn_ds_read_tr16_b64_v4i16((LAS v4i16_t*)p)); }
__device__ __forceinline__ int t5_bucket(int d) {
    if (d < 16) return d;
    int b = 16;
    b += (d >= 19); b += (d >= 21); b += (d >= 24); b += (d >= 27); b += (d >= 31); b += (d >= 35); b += (d >= 40); b += (d >= 46);
    b += (d >= 52); b += (d >= 59); b += (d >= 67); b += (d >= 77); b += (d >= 87); b += (d >= 99); b += (d >= 113);
    return b;
}
struct Ctx { LAS char* lds; int wid; int lane, r32, hi; };
__device__ __forceinline__ int fresh_lane() { int l; asm volatile("v_mbcnt_lo_u32_b32 %0, -1, 0\n\tv_mbcnt_hi_u32_b32 %0, -1, %0" : "=v"(l)); return l; }
__device__ __forceinline__ Ctx make_ctx(LAS unsigned char* lds, int tid) {
    Ctx c; c.lds = (LAS char*)lds; c.wid = __builtin_amdgcn_readfirstlane(tid >> 6); c.lane = tid & 63; c.r32 = c.lane & 31; c.hi = c.lane >> 5; return c;
}
template <bool HASV, class QK, class SM>
__device__ __forceinline__ void run_stream(const Ctx& c, const bf16* Kb, const bf16* Vb, int t0, int t1, QK&& qk, SM&& sm) {
    const int n = t1 - t0; if (n <= 0) return;
    const int lane = fresh_lane(), r32 = lane & 31, hi = lane >> 5; const unsigned lds0 = (unsigned)(uintptr_t)c.lds;
    const bf16* ks = Kb + ((8 * c.wid + (lane >> 3)) * 64 + (((lane & 7) ^ (((8 * c.wid + (lane >> 3)) >> 1) & 7)) << 3)); const bf16* vs = Vb + ((16 * (c.wid & 3) + (lane >> 2)) * 64 + (c.wid >> 2) * 32 + (lane & 3) * 8);
    const unsigned kdst = lds0 + c.wid * 1024, vdst = lds0 + 8192 + c.wid * 1024;
    const lds_cptr kp0 = (lds_cptr)c.lds + r32 * 128;
    const lds_cptr vp0 = (lds_cptr)c.lds + 8192 + ((lane >> 4) & 1) * 32 + (lane & 3) * 8 + (4 * hi + ((lane & 15) >> 2)) * 64;
#define ATT_ISSUE(t, so) do { if (ATT_ABL & 4) break; glds16(ks + (size_t)(t) * 4096, (unsigned)__builtin_amdgcn_readfirstlane(kdst + (so))); if (HASV) glds16(vs + (size_t)(t) * 4096, (unsigned)__builtin_amdgcn_readfirstlane(vdst + (so))); } while (0)
    ATT_ISSUE(t0, 0); if (n > 1) ATT_ISSUE(t0 + 1, SLOT);
    const bool late = ATT_STAGGER && __builtin_amdgcn_readfirstlane(c.wid) >= 4;
    f32x16 s0 = {}, s1 = {};
    int slot = 0, slotp = 3 * SLOT, slot2 = 2 * SLOT;
    if (!late) {
        for (int i = 0; i < n; ++i) {
            if (i + 1 < n) { if (HASV) ATT_WAIT_BAR(2); else ATT_WAIT_BAR(1); } else ATT_WAIT_BAR(0);
            if (i + 2 < n) ATT_ISSUE(t0 + i + 2, slot2);
            if (!(ATT_ABL & 1)) qk(t0 + i, kp0 + slot, s0, s1); if (!(ATT_ABL & 2)) sm(t0 + i, vp0 + slot, s0, s1);
            slot = (slot == 3 * SLOT) ? 0 : slot + SLOT; slot2 = (slot2 == 3 * SLOT) ? 0 : slot2 + SLOT;
        }
    } else {
        for (int i = 0; i < n; ++i) {
            if (i + 1 < n) { if (HASV) ATT_WAIT_BAR(2); else ATT_WAIT_BAR(1); } else ATT_WAIT_BAR(0);
            if (i + 2 < n) ATT_ISSUE(t0 + i + 2, slot2);
            if (i > 0 && !(ATT_ABL & 2)) sm(t0 + i - 1, vp0 + slotp, s0, s1);
            if (!(ATT_ABL & 1)) qk(t0 + i, kp0 + slot, s0, s1);
            slotp = slot; slot = (slot == 3 * SLOT) ? 0 : slot + SLOT; slot2 = (slot2 == 3 * SLOT) ? 0 : slot2 + SLOT;
        }
        if (!(ATT_ABL & 2)) sm(t0 + n - 1, vp0 + slotp, s0, s1);
    }
    asm volatile("s_waitcnt lgkmcnt(0)\n\ts_barrier" ::: "memory");
#undef ATT_ISSUE
}
template <class FN1, class FN2>
__device__ __forceinline__ void run_stream_pairs(const Ctx& c, const bf16* Kb, const bf16* Vb, int t0, int t1, FN1&& fn1, FN2&& fn2) {
    const int n = t1 - t0; if (n <= 0) return;
    const int lane = fresh_lane(), r32 = lane & 31, hi = lane >> 5; const unsigned lds0 = (unsigned)(uintptr_t)c.lds;
    const bf16* ks = Kb + ((8 * c.wid + (lane >> 3)) * 64 + (((lane & 7) ^ (((8 * c.wid + (lane >> 3)) >> 1) & 7)) << 3)); const bf16* vs = Vb + ((16 * (c.wid & 3) + (lane >> 2)) * 64 + (c.wid >> 2) * 32 + (lane & 3) * 8);
    const unsigned kdst = lds0 + c.wid * 1024, vdst = lds0 + 8192 + c.wid * 1024;
    const lds_cptr kp0 = (lds_cptr)c.lds + r32 * 128;
    const lds_cptr vp0 = (lds_cptr)c.lds + 8192 + ((lane >> 4) & 1) * 32 + (lane & 3) * 8 + (4 * hi + ((lane & 15) >> 2)) * 64;
#define ATT_ISSUE1(t, so) do { glds16(ks + (size_t)(t) * 4096, (unsigned)__builtin_amdgcn_readfirstlane(kdst + (so))); glds16(vs + (size_t)(t) * 4096, (unsigned)__builtin_amdgcn_readfirstlane(vdst + (so))); } while (0)
    ATT_ISSUE1(t0, 0); if (n > 1) ATT_ISSUE1(t0 + 1, SLOT);
    int base = 0;
    for (int i = 0; i < n; i += 2) {
        ATT_WAIT_BAR(0);
        const int nb = 2 * SLOT - base;
        if (i + 2 < n) ATT_ISSUE1(t0 + i + 2, nb); if (i + 3 < n) ATT_ISSUE1(t0 + i + 3, nb + SLOT);
        if (i + 1 < n) fn2(t0 + i, kp0 + base, vp0 + base, kp0 + base + SLOT, vp0 + base + SLOT); else fn1(t0 + i, kp0 + base, vp0 + base);
        base = nb;
    }
    asm volatile("s_waitcnt lgkmcnt(0)\n\ts_barrier" ::: "memory");
#undef ATT_ISSUE1
}
__device__ __forceinline__ void qk_tile(f32x16& s0, f32x16& s1, lds_cptr kp, const bf16x8 (&qr)[4]) {
    bf16x8 kf[8];
    { const int l = fresh_lane(), f = ((l & 31) >> 1) & 7, hi = l >> 5;
#pragma unroll
      for (int d0 = 0; d0 < 4; ++d0) { const int off = ((2 * d0 + hi) ^ f) << 4; kf[2 * d0] = *(const LAS bf16x8*)(kp + off); kf[2 * d0 + 1] = *(const LAS bf16x8*)(kp + 4096 + off); } }
    const f32x16 z = {};
    s0 = MFMA32(kf[0], qr[0], z); s1 = MFMA32(kf[1], qr[0], z);
#pragma unroll
    for (int d0 = 1; d0 < 4; ++d0) { s0 = MFMA32(kf[2 * d0], qr[d0], s0); s1 = MFMA32(kf[2 * d0 + 1], qr[d0], s1); }
}
template <bool MASK>
__device__ __forceinline__ void pv_tile(f32x16 (&o)[2], lds_cptr vp, const f32x16& p0, const f32x16& p1, unsigned mask) {
    if (ATT_ABL & 8) { o[0][0] += p0[0] + p1[5]; return; }
    u32x4 pw0 = {cvtpk(p0[0], p0[1]), cvtpk(p0[2], p0[3]), cvtpk(p0[4], p0[5]), cvtpk(p0[6], p0[7])}, pw1 = {cvtpk(p0[8], p0[9]), cvtpk(p0[10], p0[11]), cvtpk(p0[12], p0[13]), cvtpk(p0[14], p0[15])};
    u32x4 pw2 = {cvtpk(p1[0], p1[1]), cvtpk(p1[2], p1[3]), cvtpk(p1[4], p1[5]), cvtpk(p1[6], p1[7])}, pw3 = {cvtpk(p1[8], p1[9]), cvtpk(p1[10], p1[11]), cvtpk(p1[12], p1[13]), cvtpk(p1[14], p1[15])};
    if (MASK) { pw0 &= mask; pw1 &= mask; pw2 &= mask; pw3 &= mask; }
    if (ATT_ABL & 64) { o[0] = MFMA32(__builtin_bit_cast(bf16x8, pw0), __builtin_bit_cast(bf16x8, pw1), o[0]); o[1] = MFMA32(__builtin_bit_cast(bf16x8, pw2), __builtin_bit_cast(bf16x8, pw3), o[1]); return; }
    s16x4 vlo[8], vhi[8];
#pragma unroll
    for (int i = 0; i < 8; ++i) { vlo[i] = vtr(vp + ((i >> 2) * 4096 + (i & 3) * 1024)); vhi[i] = vtr(vp + ((i >> 2) * 4096 + (i & 3) * 1024 + 512)); }
#define ATT_VFR(i) (bf16x8){vlo[i][0], vlo[i][1], vlo[i][2], vlo[i][3], vhi[i][0], vhi[i][1], vhi[i][2], vhi[i][3]}
    o[0] = MFMA32(__builtin_bit_cast(bf16x8, pw0), ATT_VFR(0), o[0]); o[1] = MFMA32(__builtin_bit_cast(bf16x8, pw0), ATT_VFR(4), o[1]);
    o[0] = MFMA32(__builtin_bit_cast(bf16x8, pw1), ATT_VFR(1), o[0]); o[1] = MFMA32(__builtin_bit_cast(bf16x8, pw1), ATT_VFR(5), o[1]);
    o[0] = MFMA32(__builtin_bit_cast(bf16x8, pw2), ATT_VFR(2), o[0]); o[1] = MFMA32(__builtin_bit_cast(bf16x8, pw2), ATT_VFR(6), o[1]);
    o[0] = MFMA32(__builtin_bit_cast(bf16x8, pw3), ATT_VFR(3), o[0]); o[1] = MFMA32(__builtin_bit_cast(bf16x8, pw3), ATT_VFR(7), o[1]);
#undef ATT_VFR
}
#define ATT_SB() __builtin_amdgcn_sched_barrier(0)
struct KF { bf16x8 f[8]; };
struct VF { s16x4 lo[8], hi[8]; };
struct PW4 { u32x4 w0, w1, w2, w3; };
__device__ __forceinline__ void ld_k(KF& k, lds_cptr kp) {
    const int l = fresh_lane(), f = ((l & 31) >> 1) & 7, hi = l >> 5;
#pragma unroll
    for (int d0 = 0; d0 < 4; ++d0) { const int off = ((2 * d0 + hi) ^ f) << 4; k.f[2 * d0] = *(const LAS bf16x8*)(kp + off); k.f[2 * d0 + 1] = *(const LAS bf16x8*)(kp + 4096 + off); } }
__device__ __forceinline__ void qk_mfma(f32x16& s0, f32x16& s1, const KF& k, const bf16x8 (&qr)[4]) {
    const f32x16 z = {};
    s0 = MFMA32(k.f[0], qr[0], z); s1 = MFMA32(k.f[1], qr[0], z);
#pragma unroll
    for (int d0 = 1; d0 < 4; ++d0) { s0 = MFMA32(k.f[2 * d0], qr[d0], s0); s1 = MFMA32(k.f[2 * d0 + 1], qr[d0], s1); } }
__device__ __forceinline__ void ld_v(VF& v, lds_cptr vp) {
#pragma unroll
    for (int i = 0; i < 8; ++i) { v.lo[i] = vtr(vp + ((i >> 2) * 4096 + (i & 3) * 1024)); v.hi[i] = vtr(vp + ((i >> 2) * 4096 + (i & 3) * 1024 + 512)); } }
__device__ __forceinline__ PW4 pack4(const f32x16& p0, const f32x16& p1, unsigned mask) { PW4 w;
    w.w0 = (u32x4){cvtpk(p0[0], p0[1]), cvtpk(p0[2], p0[3]), cvtpk(p0[4], p0[5]), cvtpk(p0[6], p0[7])}; w.w1 = (u32x4){cvtpk(p0[8], p0[9]), cvtpk(p0[10], p0[11]), cvtpk(p0[12], p0[13]), cvtpk(p0[14], p0[15])};
    w.w2 = (u32x4){cvtpk(p1[0], p1[1]), cvtpk(p1[2], p1[3]), cvtpk(p1[4], p1[5]), cvtpk(p1[6], p1[7])}; w.w3 = (u32x4){cvtpk(p1[8], p1[9]), cvtpk(p1[10], p1[11]), cvtpk(p1[12], p1[13]), cvtpk(p1[14], p1[15])};
    w.w0 &= mask; w.w1 &= mask; w.w2 &= mask; w.w3 &= mask; return w; }
__device__ __forceinline__ void pv_mfma(f32x16 (&o)[2], const VF& v, const PW4& w) {
#define ATT_VF(i) (bf16x8){v.lo[i][0], v.lo[i][1], v.lo[i][2], v.lo[i][3], v.hi[i][0], v.hi[i][1], v.hi[i][2], v.hi[i][3]}
    o[0] = MFMA32(__builtin_bit_cast(bf16x8, w.w0), ATT_VF(0), o[0]); o[1] = MFMA32(__builtin_bit_cast(bf16x8, w.w0), ATT_VF(4), o[1]);
    o[0] = MFMA32(__builtin_bit_cast(bf16x8, w.w1), ATT_VF(1), o[0]); o[1] = MFMA32(__builtin_bit_cast(bf16x8, w.w1), ATT_VF(5), o[1]);
    o[0] = MFMA32(__builtin_bit_cast(bf16x8, w.w2), ATT_VF(2), o[0]); o[1] = MFMA32(__builtin_bit_cast(bf16x8, w.w2), ATT_VF(6), o[1]);
    o[0] = MFMA32(__builtin_bit_cast(bf16x8, w.w3), ATT_VF(3), o[0]); o[1] = MFMA32(__builtin_bit_cast(bf16x8, w.w3), ATT_VF(7), o[1]);
#undef ATT_VF
}
__device__ __forceinline__ float rowsum32(const f32x16& p0, const f32x16& p1) { if (ATT_ABL & 32) return p0[0]; float a = p0[0] + p1[0], b = p0[1] + p1[1];
#pragma unroll
    for (int r = 2; r < 16; r += 2) { a += p0[r]; asm volatile("" : "+v"(a)); b += p0[r + 1]; asm volatile("" : "+v"(b)); a += p1[r]; asm volatile("" : "+v"(a)); b += p1[r + 1]; asm volatile("" : "+v"(b)); }
    return a + b; }
__device__ __forceinline__ void hook_exp(f32x16& s0, f32x16& s1) {
    if (ATT_ABL & 16) return;
#pragma unroll
    for (int r = 0; r < 16; ++r) { s0[r] = __builtin_amdgcn_exp2f(s0[r]); s1[r] = __builtin_amdgcn_exp2f(s1[r]); } }
__device__ __forceinline__ void hook_near(f32x16& s0, f32x16& s1, int base, const LAS float* lut) {
    asm volatile("" : "+v"(base));
#pragma unroll
    for (int r = 0; r < 16; ++r) { const int d0 = base - ((r & 3) + 8 * (r >> 2)), d1 = d0 - 32;
        s0[r] = __builtin_amdgcn_exp2f(s0[r] + lut[min(max(d0, -1), 113) + 1]); s1[r] = __builtin_amdgcn_exp2f(s1[r] + lut[min(max(d1, -1), 113) + 1]); } }
__device__ __forceinline__ void hook_edge(f32x16& s0, f32x16& s1, int base, int win) {
    asm volatile("" : "+v"(base));
#pragma unroll
    for (int r = 0; r < 16; ++r) { const int d0 = base - ((r & 3) + 8 * (r >> 2)), d1 = d0 - 32;
        s0[r] = __builtin_amdgcn_exp2f(d0 < win ? s0[r] : -INFINITY); s1[r] = __builtin_amdgcn_exp2f(d1 < win ? s1[r] : -INFINITY); } }
__device__ __forceinline__ void hook_cmp(f32x16& s0, f32x16& s1, int nrel  , float cb) {
    asm volatile("" : "+v"(nrel));
#pragma unroll
    for (int r = 0; r < 16; ++r) { const int c0 = (r & 3) + 8 * (r >> 2);
        s0[r] = __builtin_amdgcn_exp2f(s0[r] + ((c0 <= nrel) ? cb : -INFINITY)); s1[r] = __builtin_amdgcn_exp2f(s1[r] + ((c0 + 32 <= nrel) ? cb : -INFINITY)); } }
__device__ __forceinline__ void row_factors(const Ctx& c, float f, float (&fr)[16]) {
    const int lane = fresh_lane(), r32 = lane & 31, hi = lane >> 5; LAS float* wsf = (LAS float*)(c.lds + LDS_WSF) + c.wid * 64;
    asm volatile("s_waitcnt lgkmcnt(0)" ::: "memory");
    if (hi == 0) wsf[r32] = f;
    asm volatile("s_waitcnt lgkmcnt(0)" ::: "memory");
#pragma unroll
    for (int r = 0; r < 16; ++r) fr[r] = wsf[(r & 3) + 8 * (r >> 2) + 4 * hi];
    asm volatile("s_waitcnt lgkmcnt(0)" ::: "memory");
}
__device__ __forceinline__ float pair_sum(float v) { auto rr = __builtin_amdgcn_permlane32_swap(__float_as_uint(v), __float_as_uint(v), false, false); return __uint_as_float(rr[0]) + __uint_as_float(rr[1]); }
template <class RowOff>
__device__ __forceinline__ void store_rows(const Ctx& c, const f32x16 (&o)[2], bf16* dst, RowOff&& rowoff) {
    LAS bf16* stg = (LAS bf16*)(c.lds + LDS_OST) + c.wid * 2048;
    const int lane = fresh_lane(), r32 = lane & 31, hi = lane >> 5;
#pragma unroll
    for (int r = 0; r < 16; ++r) { const int orow = (r & 3) + 8 * (r >> 2) + 4 * hi;
#pragma unroll
        for (int d0 = 0; d0 < 2; ++d0) stg[orow * 64 + d0 * 32 + r32] = (bf16)f2bf(o[d0][r]); }
    asm volatile("s_waitcnt lgkmcnt(0)" ::: "memory");
#pragma unroll
    for (int i = 0; i < 4; ++i) { const int row = i * 8 + (lane >> 3), ch = lane & 7; const u32x4 v = *(const LAS u32x4*)(stg + row * 64 + ch * 8); *(u32x4*)(dst + rowoff(row) + ch * 8) = v; }
    asm volatile("s_waitcnt lgkmcnt(0)" ::: "memory");
}
struct AttnPtrs { const bf16* qkv; const float* kmp; const float* gates; const bf16* kcmp; const bf16* vcmp; const float* rel_bias; bf16* mix; unsigned* selg; bf16* part_o; float* part_l; };

__device__ __forceinline__ void moba_kmean_frags(const AttnPtrs& P, int bh, int r32, int hi, bf16x8 (&kmf)[4]) {
    const float* kp = P.kmp + ((size_t)(bh * 32 + r32) * 2) * 64;
#pragma unroll
    for (int d0 = 0; d0 < 4; ++d0) { const f32x4 a0 = *(const f32x4*)(kp + d0 * 16 + hi * 8), a1 = *(const f32x4*)(kp + d0 * 16 + hi * 8 + 4), b0 = *(const f32x4*)(kp + 64 + d0 * 16 + hi * 8), b1 = *(const f32x4*)(kp + 64 + d0 * 16 + hi * 8 + 4);
        const f32x4 m0 = (a0 + b0) * (1.f / 256.f), m1 = (a1 + b1) * (1.f / 256.f);
        u32x4 w = {cvtpk(m0[0], m0[1]), cvtpk(m0[2], m0[3]), cvtpk(m1[0], m1[1]), cvtpk(m1[2], m1[3])}; kmf[d0] = __builtin_bit_cast(bf16x8, w); }
}
__device__ __forceinline__ unsigned moba_gate32(const bf16x8 (&kmf)[4], int i, const bf16x8 (&qr)[4], int hi) {
    unsigned selmask = 0u;
    if (i > 0) {
        f32x16 sg = {};
#pragma unroll
        for (int d0 = 0; d0 < 4; ++d0) sg = MFMA32(kmf[d0], qr[d0], sg);
        float v[16];
#pragma unroll
        for (int r = 0; r < 16; ++r) v[r] = ((r & 3) + 8 * (r >> 2) + 4 * hi < i) ? sg[r] : -INFINITY;
#pragma unroll
        for (int it = 0; it < 3; ++it) {
            float m = v[0]; int jb = 4 * hi;
#pragma unroll
            for (int r = 1; r < 16; ++r) { const int j = (r & 3) + 8 * (r >> 2) + 4 * hi; if (v[r] > m) { m = v[r]; jb = j; } }
            auto rm = __builtin_amdgcn_permlane32_swap(__float_as_uint(m), __float_as_uint(m), false, false);
            auto rj = __builtin_amdgcn_permlane32_swap((unsigned)jb, (unsigned)jb, false, false);
            const float mo = __uint_as_float(hi ? rm[0] : rm[1]); const int jo = (int)(hi ? rj[0] : rj[1]);
            const bool mine = (m > mo) || (m == mo && jb < jo);
            const float mw = mine ? m : mo; const int jw = mine ? jb : jo;
            if (mw > -INFINITY) { selmask |= 1u << jw;
#pragma unroll
                for (int r = 0; r < 16; ++r) if ((r & 3) + 8 * (r >> 2) + 4 * hi == jw) v[r] = -INFINITY; }
        }
    }
    return selmask;
}
__device__ __forceinline__ void moba_gate_phase(const AttnPtrs& P, int vcu, int G, int tid) {
    const int lane = tid & 63, r32 = lane & 31, hi = lane >> 5; const int wid = __builtin_amdgcn_readfirstlane(tid >> 6);
    for (int grp = vcu * 8 + wid; grp < 2048; grp += G * 8) { const int bh = grp >> 6;
        bf16x8 kmf[4]; moba_kmean_frags(P, bh, r32, hi, kmf);
        const bf16* QA = P.qkv + ((size_t)bh * SEQ) * 64;
#pragma unroll 2
        for (int k = 0; k < 4; ++k) { const int idx = (grp & 63) * 4 + k, i = idx >> 3, w = idx & 7; const int qpos = 256 * i + 32 * w + r32;
            bf16x8 qr[4];
#pragma unroll
            for (int d0 = 0; d0 < 4; ++d0) qr[d0] = *(const bf16x8*)(QA + (size_t)qpos * 64 + d0 * 16 + hi * 8);
            const unsigned m = moba_gate32(kmf, i, qr, hi);
            if (hi == 0) P.selg[(size_t)bh * SEQ + qpos] = m; } }
}
__device__ __forceinline__ void moba_past_item(const Ctx& c, const AttnPtrs& P, int b, int h, int j) {
    const int bh = b * 8 + h, tid = threadIdx.x;
    const bf16* QA = P.qkv + ((size_t)bh * SEQ) * 64; const bf16* KA = QA + QKV_BIG + (size_t)256 * j * 64; const bf16* VA = QA + 2 * QKV_BIG + (size_t)256 * j * 64;
    const LAS float* lut = (const LAS float*)(c.lds + LDS_LUTG) + h * LUT_PITCH;
    { const int lane = fresh_lane(); const unsigned lds0 = (unsigned)(uintptr_t)c.lds;
      const bf16* ks = KA + ((8 * c.wid + (lane >> 3)) * 64 + (((lane & 7) ^ (((8 * c.wid + (lane >> 3)) >> 1) & 7)) << 3)); const bf16* vs = VA + ((16 * (c.wid & 3) + (lane >> 2)) * 64 + (c.wid >> 2) * 32 + (lane & 3) * 8);
#pragma unroll
      for (int tt = 0; tt < 4; ++tt) { glds16(ks + tt * 4096, (unsigned)__builtin_amdgcn_readfirstlane(lds0 + c.wid * 1024 + tt * SLOT)); glds16(vs + tt * 4096, (unsigned)__builtin_amdgcn_readfirstlane(lds0 + 8192 + c.wid * 1024 + tt * SLOT)); } }
    LAS unsigned short* list = (LAS unsigned short*)(c.lds + LDS_IMP);
    LAS unsigned* wcnt = (LAS unsigned*)(c.lds + LDS_MISC) + 8;
    const unsigned* sg = P.selg + (size_t)bh * SEQ;
    if (tid < 256) list[tid] = (unsigned short)((256 * j + tid) | (3 << 13));
    int total = 256;
    for (int base = (j + 1) * 256; base < SEQ; base += 2048) {
        const int q0 = base + 4 * tid; uint4 m4 = make_uint4(0u, 0u, 0u, 0u); if (q0 < SEQ) m4 = *(const uint4*)(sg + q0);
        const unsigned long long b0 = __ballot((m4.x >> j) & 1u), b1 = __ballot((m4.y >> j) & 1u), b2 = __ballot((m4.z >> j) & 1u), b3 = __ballot((m4.w >> j) & 1u);
        const int c0 = (int)__popcll(b0), c1 = (int)__popcll(b1), c2 = (int)__popcll(b2), c3 = (int)__popcll(b3);
        if ((tid & 63) == 0) wcnt[c.wid] = (unsigned)(c0 + c1 + c2 + c3);
        asm volatile("s_waitcnt vmcnt(0) lgkmcnt(0)\n\ts_barrier" ::: "memory");
        int off = total, tot = 0;
#pragma unroll
        for (int w = 0; w < 8; ++w) { const int v = (int)wcnt[w]; off += (w < c.wid) ? v : 0; tot += v; }
        const unsigned long long below = (1ull << (tid & 63)) - 1ull; const unsigned lowj = (1u << j) - 1u;
        if ((m4.x >> j) & 1u) list[off + __popcll(b0 & below)] = (unsigned short)((q0 + 0) | (__popc(m4.x & lowj) << 13)); off += c0;
        if ((m4.y >> j) & 1u) list[off + __popcll(b1 & below)] = (unsigned short)((q0 + 1) | (__popc(m4.y & lowj) << 13)); off += c1;
        if ((m4.z >> j) & 1u) list[off + __popcll(b2 & below)] = (unsigned short)((q0 + 2) | (__popc(m4.z & lowj) << 13)); off += c2;
        if ((m4.w >> j) & 1u) list[off + __popcll(b3 & below)] = (unsigned short)((q0 + 3) | (__popc(m4.w & lowj) << 13));
        total += tot;
        asm volatile("s_waitcnt lgkmcnt(0)\n\ts_barrier" ::: "memory");
    }
    total = __builtin_amdgcn_readfirstlane(total);
    { const int npad = (32 - (total & 31)) & 31; if (tid < npad) list[total + tid] = 0xFFFFu; }
    const int nchunks = (total + 31) >> 5;
    asm volatile("s_waitcnt vmcnt(0) lgkmcnt(0)\n\ts_barrier" ::: "memory");
    for (int ch = c.wid; ch < nchunks; ch += 8) {
        const int lane = fresh_lane(), r32 = lane & 31, hi = lane >> 5;
        const lds_cptr kp0 = (lds_cptr)c.lds + r32 * 128;
        const lds_cptr vp0 = (lds_cptr)c.lds + 8192 + ((lane >> 4) & 1) * 32 + (lane & 3) * 8 + (4 * hi + ((lane & 15) >> 2)) * 64;
        const unsigned e = list[32 * ch + r32]; const bool valid = e != 0xFFFFu; const int q = valid ? (int)(e & 0x1FFFu) : SEQ - 1;
        bf16x8 qr[4];
#pragma unroll
        for (int d0 = 0; d0 < 4; ++d0) qr[d0] = *(const bf16x8*)(QA + (size_t)q * 64 + d0 * 16 + hi * 8);
        asm volatile("" : "+v"(qr[0]), "+v"(qr[1]), "+v"(qr[2]), "+v"(qr[3]));
        const bool anynear = __any(valid && (unsigned)((q >> 8) - j) <= 1u);
        f32x16 o[2]; o[0] = f32x16{}; o[1] = f32x16{}; float l_reg = 0.f;
#pragma unroll 1
        for (int tt = 0; tt < 4; ++tt) { f32x16 s0, s1; qk_tile(s0, s1, kp0 + tt * SLOT, qr);
            if (anynear) hook_near(s0, s1, q - (256 * j + 64 * tt) - 4 * hi, lut); else hook_exp(s0, s1);
            l_reg += rowsum32(s0, s1);
            pv_tile<false>(o, vp0 + tt * SLOT, s0, s1, 0u); }
        const float L = pair_sum(l_reg);
        if (hi == 0 && valid) P.part_l[((size_t)bh * SEQ + q) * 4 + (e >> 13)] = L;
        LAS bf16* stg = (LAS bf16*)(c.lds + LDS_OST) + c.wid * 2048;
#pragma unroll
        for (int r = 0; r < 16; ++r) { const int orow = (r & 3) + 8 * (r >> 2) + 4 * hi;
#pragma unroll
            for (int d0 = 0; d0 < 2; ++d0) stg[orow * 64 + d0 * 32 + r32] = (bf16)f2bf(o[d0][r]); }
        asm volatile("s_waitcnt lgkmcnt(0)" ::: "memory");
#pragma unroll
        for (int it = 0; it < 4; ++it) { const int row = it * 8 + (lane >> 3), chn = lane & 7; const unsigned e2 = list[32 * ch + row];
            const u32x4 v = *(const LAS u32x4*)(stg + row * 64 + chn * 8);
            if (e2 != 0xFFFFu) *(u32x4*)(P.part_o + (((size_t)bh * SEQ + (e2 & 0x1FFFu)) * 4 + (e2 >> 13)) * 64 + chn * 8) = v; }
        asm volatile("s_waitcnt lgkmcnt(0)" ::: "memory");
    }
    asm volatile("s_waitcnt lgkmcnt(0)\n\ts_barrier" ::: "memory");
}
__device__ __forceinline__ void moba_merge_pass(const AttnPtrs& P, int vcu, int G, int tid) {
    const int lane = tid & 63, h = lane >> 3, chn = lane & 7; const int wid = __builtin_amdgcn_readfirstlane(tid >> 6);
#pragma unroll 4
    for (int tok = vcu * 8 + wid; tok < TOK; tok += G * 8) { const int b = tok >> 13, q = tok & (SEQ - 1);
        const size_t qi = (size_t)(b * 8 + h) * SEQ + q; const int ns = __popc(P.selg[qi]);
        float Lt = P.part_l[qi * 4 + 3]; const u32x4 pw = *(const u32x4*)(P.part_o + (qi * 4 + 3) * 64 + chn * 8);
        f32x4 a0 = {__uint_as_float(pw.x << 16), __uint_as_float(pw.x & 0xffff0000u), __uint_as_float(pw.y << 16), __uint_as_float(pw.y & 0xffff0000u)};
        f32x4 a1 = {__uint_as_float(pw.z << 16), __uint_as_float(pw.z & 0xffff0000u), __uint_as_float(pw.w << 16), __uint_as_float(pw.w & 0xffff0000u)};
#pragma unroll
        for (int sidx = 0; sidx < 3; ++sidx) if (sidx < ns) { Lt += P.part_l[qi * 4 + sidx]; const u32x4 pv = *(const u32x4*)(P.part_o + (qi * 4 + sidx) * 64 + chn * 8);
            a0 += (f32x4){__uint_as_float(pv.x << 16), __uint_as_float(pv.x & 0xffff0000u), __uint_as_float(pv.y << 16), __uint_as_float(pv.y & 0xffff0000u)};
            a1 += (f32x4){__uint_as_float(pv.z << 16), __uint_as_float(pv.z & 0xffff0000u), __uint_as_float(pv.w << 16), __uint_as_float(pv.w & 0xffff0000u)}; }
        const float inv = 1.f / Lt; a0 *= inv; a1 *= inv;
        const u32x4 w = {cvtpk(a0[0], a0[1]), cvtpk(a0[2], a0[3]), cvtpk(a1[0], a1[1]), cvtpk(a1[2], a1[3])};
        *(u32x4*)(P.mix + (size_t)tok * DM + h * 64 + chn * 8) = w; }
}

__device__ __forceinline__ void nsa_item(const Ctx& c, const AttnPtrs& P, int b, int g, int ci, int flags = 0) {
    const int ql = 8 * c.wid + (c.r32 >> 2), rh = c.r32 & 3, qpos = 64 * ci + ql, hb = 4 * g + rh;
    const int qw0 = 64 * ci + 8 * c.wid;
    const bf16* QB = P.qkv + 3 * QKV_BIG + ((size_t)(b * 8 + hb) * SEQ) * 64;
    const bf16* KS = P.qkv + 4 * QKV_BIG + 2 * QKV_SMALL + ((size_t)(b * 2 + g) * SEQ) * 64; const bf16* VS = KS + QKV_SMALL; const bf16* KW = KS + 2 * QKV_SMALL; const bf16* VW = KS + 3 * QKV_SMALL;
    const bf16* KC = P.kcmp + (size_t)(b * 2 + g) * 512 * 64; const bf16* VC = P.vcmp + (size_t)(b * 2 + g) * 512 * 64;
    bf16x8 qr[4];
#pragma unroll
    for (int d0 = 0; d0 < 4; ++d0) qr[d0] = *(const bf16x8*)(QB + (size_t)qpos * 64 + d0 * 16 + c.hi * 8);
    asm volatile("" : "+v"(qr[0]), "+v"(qr[1]), "+v"(qr[2]), "+v"(qr[3]));
    const LAS float* lut = (const LAS float*)(c.lds + LDS_LUTG) + (8 + hb) * LUT_PITCH;
    LAS float* imp = (LAS float*)(c.lds + LDS_IMP);
    LAS unsigned* selm = (LAS unsigned*)(c.lds + LDS_SELM);
    f32x16 o[2]; float l_reg; float fr[16];
    LAS float* park = (LAS float*)(c.lds + LDS_OST) + c.wid * 1024 + c.lane;
    LAS float* park1 = (LAS float*)(c.lds + LDS_IMP) + c.wid * 1024 + c.lane;
    const int nct = (4 * ci + 3 + 63) >> 6;
    const int nlim = (qpos >= 31) ? ((qpos - 31) >> 4) : -1;
    LAS bf16* impt = (LAS bf16*)(c.lds + ((rh & 2) ? LDS_IMP : LDS_OST)) + ((rh & 2) ? IMP_REG1 : 0) + (rh & 1) * IMP_PLANE + ql * IMP_PITCH;
    l_reg = 0.f; o[0] = f32x16{}; o[1] = f32x16{};
    {
        float carry = 0.f;
        if (!(flags & 32)) run_stream<true>(c, KC, VC, 0, nct,
          [&](int t, lds_cptr kp, f32x16& s0, f32x16& s1) { qk_tile(s0, s1, kp, qr); },
          [&](int t, lds_cptr vp, f32x16& s0, f32x16& s1) {
            hook_cmp(s0, s1, nlim - 64 * t - 4 * c.hi, 0.f);
            l_reg += rowsum32(s0, s1);
#pragma unroll
            for (int half = 0; half < 2; ++half) {
                float g4[4], e[4];
#pragma unroll
                for (int a = 0; a < 4; ++a) { const float x0 = half ? s1[4 * a] : s0[4 * a], x1 = half ? s1[4 * a + 1] : s0[4 * a + 1], x2 = half ? s1[4 * a + 2] : s0[4 * a + 2], x3 = half ? s1[4 * a + 3] : s0[4 * a + 3];
                    g4[a] = (x0 + x1) + (x2 + x3); e[a] = x3; }
                float x[4];
#pragma unroll
                for (int a = 0; a < 4; ++a) { auto rr = __builtin_amdgcn_permlane32_swap(__float_as_uint(e[a]), __float_as_uint(e[a]), false, false); x[a] = __uint_as_float(c.hi ? rr[0] : rr[1]); }
                const int jb = 16 * t + 8 * half;
                float iv[4];
                if (c.hi) {
#pragma unroll
                    for (int a = 0; a < 4; ++a) iv[a] = g4[a] + x[a]; }
                else { iv[0] = g4[0] + carry; iv[1] = g4[1] + x[0]; iv[2] = g4[2] + x[1]; iv[3] = g4[3] + x[2]; carry = x[3]; }
#pragma unroll
                for (int a = 0; a < 4; ++a) impt[jb + 2 * a + c.hi] = (bf16)f2bf(iv[a]);
            }
            pv_tile<false>(o, vp, s0, s1, 0u);
        });
    }
    const float Lc = pair_sum(l_reg); const float invLc = Lc > 0.f ? 1.f / Lc : 0.f;
    { LAS float* wsfw = (LAS float*)(c.lds + LDS_WSF) + c.wid * 64; if (c.hi == 0) wsfw[32 + c.r32] = invLc; }
    const float* gp = P.gates + ((size_t)b * SEQ + qpos) * 24 + hb * 3; float g0 = gp[0], g1 = gp[1], g2 = gp[2];
    {
        asm volatile("s_waitcnt lgkmcnt(0)\n\ts_barrier" ::: "memory");
        const int fl = fresh_lane(); const int qq = 8 * c.wid + (fl >> 3), cc = fl & 7;
        unsigned m0 = 0u, m1 = 0u, m2w = 0u, m3 = 0u;
        if (ci <= 15 || (flags & 16)) { m0 = (ci >= 31) ? 0xffffffffu : ((2u << ci) - 1u); }
        else {
            unsigned v[16];
            const LAS float* il = (const LAS float*)(c.lds + LDS_WSF) + c.wid * 64 + 32 + 4 * (fl >> 3);
            const float i0 = il[0], i1 = il[1], i2 = il[2], i3 = il[3];
            const LAS bf16* ta = (const LAS bf16*)(c.lds + LDS_OST) + qq * IMP_PITCH; const LAS bf16* tb = (const LAS bf16*)(c.lds + LDS_IMP) + IMP_REG1 + qq * IMP_PITCH;
#pragma unroll
            for (int k = 0; k < 16; ++k) { const int j = cc + 8 * k;
                const float val = (bf2f(ta[j]) * i0 + bf2f(ta[IMP_PLANE + j]) * i1) + (bf2f(tb[j]) * i2 + bf2f(tb[IMP_PLANE + j]) * i3);
                v[k] = (j >= 1 && j <= ci - 2) ? ((__float_as_uint(val) & ~127u) | (unsigned)(127 - j)) : 0u; }
            for (int it = 0; it < 13; ++it) {
                unsigned m = v[0];
#pragma unroll
                for (int k = 1; k < 16; ++k) m = max(m, v[k]);
#pragma unroll
                for (int sft = 1; sft < 8; sft <<= 1) m = max(m, (unsigned)__shfl_xor((int)m, sft));
                if (m != 0u) { const int jb = 127 - (int)(m & 127u); const unsigned bit = 1u << (jb & 31); const int wsel = jb >> 5;
                    m0 |= (wsel == 0) ? bit : 0u; m1 |= (wsel == 1) ? bit : 0u; m2w |= (wsel == 2) ? bit : 0u; m3 |= (wsel == 3) ? bit : 0u;
#pragma unroll
                    for (int k = 0; k < 16; ++k) v[k] = (v[k] == m) ? 0u : v[k]; }
            }
            m0 |= 1u;
#pragma unroll
            for (int z = 0; z < 2; ++z) { const int jf = ci - z; const unsigned bit = 1u << (jf & 31); const int wsel = jf >> 5;
                m0 |= (wsel == 0) ? bit : 0u; m1 |= (wsel == 1) ? bit : 0u; m2w |= (wsel == 2) ? bit : 0u; m3 |= (wsel == 3) ? bit : 0u; }
        }
        if (cc == 0) { selm[qq * 4 + 0] = m0; selm[qq * 4 + 1] = m1; selm[qq * 4 + 2] = m2w; selm[qq * 4 + 3] = m3; }
        asm volatile("s_waitcnt lgkmcnt(0)\n\ts_barrier" ::: "memory");
    }
    asm volatile("" : "+v"(g0), "+v"(g1), "+v"(g2));
    row_factors(c, g0 * invLc, fr);
#pragma unroll
    for (int r = 0; r < 16; ++r) { park[r * 64] = o[0][r] * fr[r]; park1[r * 64] = o[1][r] * fr[r]; }
    {
        const unsigned w0 = selm[ql * 4 + 0], w1 = selm[ql * 4 + 1], w2 = selm[ql * 4 + 2], w3 = selm[ql * 4 + 3];
        o[0] = f32x16{}; o[1] = f32x16{}; l_reg = 0.f;
        auto sel_pred = [&](int t) -> bool { const unsigned wsel = (t < 32) ? w0 : (t < 64) ? w1 : (t < 96) ? w2 : w3; return (wsel >> (t & 31)) & 1u; };
        auto sel_one = [&](int t, lds_cptr kp, lds_cptr vp) { const bool pred = sel_pred(t); if (!__any(pred)) return; const int key0 = 64 * t;
            f32x16 s0, s1; qk_tile(s0, s1, kp, qr);
            if (qw0 - key0 - 63 >= 113) { hook_exp(s0, s1); const float rs = rowsum32(s0, s1); l_reg += pred ? rs : 0.f;
                if (__all(pred)) pv_tile<false>(o, vp, s0, s1, 0u); else pv_tile<true>(o, vp, s0, s1, pred ? 0xffffffffu : 0u); }
            else { hook_near(s0, s1, qpos - key0 - 4 * c.hi, lut); const float rs = rowsum32(s0, s1); l_reg += pred ? rs : 0.f;
                if (__all(pred)) pv_tile<false>(o, vp, s0, s1, 0u); else pv_tile<true>(o, vp, s0, s1, pred ? 0xffffffffu : 0u); } };
        if (!(flags & 4)) run_stream_pairs(c, KS, VS, 0, ci + 1, sel_one,
            [&](int t, lds_cptr kpA, lds_cptr vpA, lds_cptr kpB, lds_cptr vpB) {
                if (qw0 - 64 * (t + 1) - 63 >= 113) {
                    const bool pa = sel_pred(t), pb = sel_pred(t + 1);
                    const bool xa = __any(pa), xb = __any(pb);
                    if (!xa && !xb) return;
                    if (!xb) { sel_one(t, kpA, vpA); return; }
                    if (!xa) { sel_one(t + 1, kpB, vpB); return; }
                    KF kA, kB; ld_k(kA, kpA); ATT_SB();
                    f32x16 a0, a1, b0, b1; qk_mfma(a0, a1, kA, qr); ATT_SB();
                    VF vA, vB; ld_k(kB, kpB); ld_v(vA, vpA); ATT_SB();
                    qk_mfma(b0, b1, kB, qr); hook_exp(a0, a1);
                    const float ra = rowsum32(a0, a1); const PW4 wa = pack4(a0, a1, pa ? 0xffffffffu : 0u); ATT_SB();
                    ld_v(vB, vpB); ATT_SB();
                    pv_mfma(o, vA, wa); hook_exp(b0, b1);
                    const float rb = rowsum32(b0, b1); const PW4 wb = pack4(b0, b1, pb ? 0xffffffffu : 0u); l_reg += (pa ? ra : 0.f) + (pb ? rb : 0.f); ATT_SB();
                    pv_mfma(o, vB, wb);
                } else { sel_one(t, kpA, vpA); sel_one(t + 1, kpB, vpB); } });
        const float Ls = pair_sum(l_reg);
        row_factors(c, g1 / Ls, fr);
#pragma unroll
        for (int r = 0; r < 16; ++r) { park[r * 64] += o[0][r] * fr[r]; park1[r * 64] += o[1][r] * fr[r]; }
    }
    {
        o[0] = f32x16{}; o[1] = f32x16{}; l_reg = 0.f;
        if (!(flags & 8)) run_stream<true>(c, KW, VW, ci >= 8 ? ci - 8 : 0, ci + 1,
            [&](int t, lds_cptr kp, f32x16& s0, f32x16& s1) { qk_tile(s0, s1, kp, qr); },
            [&](int t, lds_cptr vp, f32x16& s0, f32x16& s1) { const int key0 = 64 * t;
                if (qw0 - key0 - 63 < 113) hook_near(s0, s1, qpos - key0 - 4 * c.hi, lut); else if (qw0 + 7 - key0 >= 512) hook_edge(s0, s1, qpos - key0 - 4 * c.hi, 512); else hook_exp(s0, s1);
                l_reg += rowsum32(s0, s1);
                pv_tile<false>(o, vp, s0, s1, 0u); });
        const float Lw = pair_sum(l_reg);
        row_factors(c, g2 / Lw, fr);
#pragma unroll
        for (int r = 0; r < 16; ++r) { o[0][r] = park[r * 64] + o[0][r] * fr[r]; o[1][r] = park1[r * 64] + o[1][r] * fr[r]; }
        asm volatile("s_waitcnt lgkmcnt(0)" ::: "memory");
    }
    bf16* dst = P.mix + ((size_t)b * SEQ + 64 * ci + 8 * c.wid) * DM + 512 + g * 256;
    store_rows(c, o, dst, [](int row) { return (size_t)(row >> 2) * DM + (row & 3) * 64; });
    asm volatile("s_waitcnt lgkmcnt(0)\n\ts_barrier" ::: "memory");
}

__device__ __forceinline__ void attn_phase(LAS unsigned char* lds, const AttnPtrs& P, unsigned* qcounter, int flags) {
    Ctx c = make_ctx(lds, threadIdx.x);
    LAS unsigned* misc = (LAS unsigned*)(c.lds + LDS_MISC);
    { LAS float* lutg = (LAS float*)(c.lds + LDS_LUTG);
      for (int idx = threadIdx.x; idx < 16 * 115; idx += NTHREADS) { const int hh = idx / 115, d = idx % 115;
          lutg[hh * LUT_PITCH + d] = (d == 0) ? -INFINITY : (P.rel_bias[t5_bucket(d - 1) * 16 + hh] - P.rel_bias[31 * 16 + hh]) * LOG2E; }
      asm volatile("s_waitcnt vmcnt(0) lgkmcnt(0)\n\ts_barrier" ::: "memory"); }
    for (;;) {
        if (threadIdx.x == 0) misc[0] = __hip_atomic_fetch_add(qcounter, 1u, __ATOMIC_RELAXED, __HIP_MEMORY_SCOPE_AGENT);
        asm volatile("s_waitcnt vmcnt(0) lgkmcnt(0)\n\ts_barrier" ::: "memory");
        const unsigned k = misc[0];
        asm volatile("s_waitcnt lgkmcnt(0)\n\ts_barrier" ::: "memory");
        if (k >= 2048u) break;
        const bool is_mp = k >= 512u && k < 1536u;
        if (flags & (is_mp ? 2 : 1)) continue;
        if (k < 512u) { const int s_ = 127 - (int)(k >> 3), bg = k & 7; nsa_item(c, P, bg >> 1, bg & 1, s_, flags); }
        else if (k < 1536u) { const int kk = (int)k - 512, j = kk >> 5, bh = kk & 31; moba_past_item(c, P, bh >> 3, bh & 7, j); }
        else { const int kk = (int)k - 1536; const int s_ = 63 - (kk >> 3), bg = kk & 7; nsa_item(c, P, bg >> 1, bg & 1, s_, flags); }
    }
}
#undef MFMA32
#undef ATT_WAIT_BAR
}
namespace cmpr {
using bf16x8 = __attribute__((ext_vector_type(8))) short;
using f32x16 = __attribute__((ext_vector_type(16))) float;
constexpr int HID_PITCH = 528;
__device__ __forceinline__ float gelu_tanh(float v) { const float u = fminf(fmaxf(0.7978845608028654f * (v + 0.044715f * v * v * v), -15.f), 15.f); const float e = __expf(2.f * u); return 0.5f * v * (1.f + (e - 1.f) / (e + 1.f)); }
__device__ __forceinline__ void compress_unit(LAS unsigned char* lds, int unit, const bf16* qkv, const bf16* w1k, const bf16* w1v, const bf16* w2k, const bf16* w2v, const float* cbp, const float* kncmp, bf16* kcmp, bf16* vcmp) {
    const int tid = threadIdx.x, lane = tid & 63, r32 = lane & 31, hi = lane >> 5; const int wid = __builtin_amdgcn_readfirstlane(tid >> 6);
    const int kv = unit & 1, u = (unit >> 1) & 15, bg = unit >> 5;
    const bf16* src = qkv + 4 * QKV_BIG + (kv ? QKV_SMALL : 0) + (size_t)bg * SEQ * 64;
    const bf16* w1 = kv ? w1v : w1k; const bf16* w2 = kv ? w2v : w2k;
    const int n0 = 32 * u;
    { const bf16* sp = src + (size_t)16 * n0 * 64;
      for (int ch = tid; ch < 4224; ch += NTHREADS) { v4u v = {0u, 0u, 0u, 0u}; if (16 * n0 + (ch >> 3) < SEQ) v = *(const GAS v4u*)(sp + (size_t)ch * 8);
          *(LAS v4u*)(lds + ((ch ^ ((ch >> 7) & 15)) << 4)) = v; } }
    asm volatile("s_waitcnt vmcnt(0) lgkmcnt(0)\n\ts_barrier" ::: "memory");
    const bf16* bp = w1 + ((size_t)wid * 64 + lane) * 8;
    f32x16 acc = {};
#pragma unroll 16
    for (int kk = 0; kk < 128; ++kk) { const int lc = r32 * 128 + 2 * kk + hi; const bf16x8 a = *(const LAS bf16x8*)(lds + ((lc ^ ((lc >> 7) & 15)) << 4)), bfr = *(const bf16x8*)(bp + (size_t)kk * 4096); acc = __builtin_amdgcn_mfma_f32_32x32x16_bf16(a, bfr, acc, 0, 0, 0); }
    float cb = 0.f;
#pragma unroll 8
    for (int ic = 0; ic < 32; ++ic) cb += cbp[(ic * 2 + kv) * 256 + 32 * wid + r32];
    LAS unsigned char* hidL = lds + 69632;
#pragma unroll
    for (int r = 0; r < 16; ++r) { const int n = (r & 3) + 8 * (r >> 2) + 4 * hi; *(LAS bf16*)(hidL + n * HID_PITCH + (32 * wid + r32) * 2) = (bf16)f2bf(gelu_tanh(acc[r] + cb)); }
    asm volatile("s_waitcnt lgkmcnt(0)\n\ts_barrier" ::: "memory");
    if (wid == 0) {
        f32x16 o0 = {}, o1 = {};
#pragma unroll 4
        for (int kk = 0; kk < 16; ++kk) { const bf16x8 hb = *(const LAS bf16x8*)(hidL + r32 * HID_PITCH + (16 * kk + 8 * hi) * 2);
            const bf16x8 a0 = *(const bf16x8*)(w2 + (size_t)r32 * 256 + 16 * kk + 8 * hi), a1 = *(const bf16x8*)(w2 + (size_t)(32 + r32) * 256 + 16 * kk + 8 * hi);
            o0 = __builtin_amdgcn_mfma_f32_32x32x16_bf16(a0, hb, o0, 0, 0, 0); o1 = __builtin_amdgcn_mfma_f32_32x32x16_bf16(a1, hb, o1, 0, 0, 0); }
        float rs = 1.f;
        if (!kv) { float ss = 0.f;
#pragma unroll
            for (int r = 0; r < 16; ++r) ss += o0[r] * o0[r] + o1[r] * o1[r];
            auto rr = __builtin_amdgcn_permlane32_swap(__float_as_uint(ss), __float_as_uint(ss), false, false); ss = __uint_as_float(rr[0]) + __uint_as_float(rr[1]);
            rs = rsqrtf(ss * (1.f / 64.f) + 1e-6f); }
        const int n = n0 + r32; bf16* dst = (kv ? vcmp : kcmp) + ((size_t)bg * 512 + n) * 64;
#pragma unroll
        for (int r = 0; r < 16; ++r) { const int d = (r & 3) + 8 * (r >> 2) + 4 * hi;
            float v0 = o0[r] * rs, v1 = o1[r] * rs; if (!kv) { v0 *= kncmp[d]; v1 *= kncmp[d + 32]; }
            if (n >= NCMP) { v0 = 0.f; v1 = 0.f; }
            dst[d] = (bf16)f2bf(v0); dst[d + 32] = (bf16)f2bf(v1); }
    }
    asm volatile("s_waitcnt lgkmcnt(0)\n\ts_barrier" ::: "memory");
}
}
__global__ void __launch_bounds__(NTHREADS, 2) mk_fwd(Args a) {
    extern __shared__ __attribute__((aligned(16))) unsigned char lds[];
    Frame F;
    F.lds = (LAS unsigned char*)lds;
    F.tid = threadIdx.x; F.lane = F.tid & 63; F.wave = __builtin_amdgcn_readfirstlane(F.tid >> 6);
    F.G = gridDim.x; { const int bx = blockIdx.x; F.vcu = (F.G % 8 == 0) ? (bx % 8) * (F.G / 8) + bx / 8 : bx; }
    cg::grid_group grid = cg::this_grid();
    volatile LAS unsigned* xst = (volatile LAS unsigned*)(F.lds + 147424);
    if (F.tid < 8) xst[F.tid] = 0u;
    __syncthreads();
    const XcdBarrier xbar = xcd_barrier_post((unsigned*)(a.ws + WS_CTL) + 4096, xst);
    unsigned char* ws = a.ws;
    const int lo = a.ph_lo, hi = a.ph_hi & 0xff; const int tflags = a.ph_hi >> 8; (void)tflags;
    const att::AttnPtrs P{(const bf16*)(ws + WS_QKV), (const float*)(ws + WS_KMP), (const float*)(ws + WS_GATES), (const bf16*)(ws + WS_KCMP), (const bf16*)(ws + WS_VCMP), a.in[2], (bf16*)(ws + WS_MIX),
                          (unsigned*)(ws + WS_SELG), (bf16*)(ws + WS_PARTO), (float*)(ws + WS_PARTL)};
#define IN(k) (lo <= (k) && (k) < hi)
#define SEAM(k) do { if (IN(k) && IN((k) + 1)) { if ((k) == 0) grid.sync(); else xcd_barrier(xbar); } } while (0)
    if (IN(0)) { phase_prologue_a(F, a); } SEAM(0);
    if (IN(1)) { phase_prologue_b(F, a); } SEAM(1);
    if (IN(2)) {
        pg8::Gemm g{(const pg8::bf16_t*)(ws + WS_H), (const pg8::bf16_t*)(ws + WS_WIN), TOK, NIN_PAD, DM}; pg8::StaticOrder S; S.init(TOK, NIN_PAD, F.G, (int)blockIdx.x);
        pg8::EpiInProj E{(pg8::bf16_t*)(ws + WS_QKV), (float*)(ws + WS_GATES), (float*)(ws + WS_KMP), a.in[7], a.in[8], a.in[9], a.in[11], a.in[12]};
        pg8::gemm_phase<pg8::EpiInProj, pg8::StaticOrder, true, true>(F.lds, g, S, E);
    } SEAM(2);
    if (IN(3)) {
        if (!(tflags & 1)) att::moba_gate_phase(P, F.vcu, F.G, F.tid);
        if (!(tflags & 2)) for (int unit = F.vcu; unit < 256; unit += F.G)
            cmpr::compress_unit(F.lds, unit, (const bf16*)(ws + WS_QKV), (const bf16*)(ws + WS_W1K), (const bf16*)(ws + WS_W1V), (const bf16*)(ws + WS_W2K), (const bf16*)(ws + WS_W2V),
                                (const float*)(ws + WS_CBP), a.in[10], (bf16*)(ws + WS_KCMP), (bf16*)(ws + WS_VCMP));
    } SEAM(3);
    if (IN(4)) {
#if HYBRID == 3
        att::attn_phase(F.lds, P, (unsigned*)(ws + WS_CTL) + 64, tflags);
#else
        att::attn_phase(F.lds, P, (unsigned*)(ws + WS_CTL) + 64, 0);
#endif
    } SEAM(4);
    if (IN(5)) { att::moba_merge_pass(P, F.vcu, F.G, F.tid); } SEAM(5);
    if (IN(6)) {
        pg8::Gemm g{(const pg8::bf16_t*)(ws + WS_MIX), (const pg8::bf16_t*)(ws + WS_WOUT), TOK, DM, DM}; pg8::StaticOrder S; S.init(TOK, DM, F.G, (int)blockIdx.x);
        pg8::EpiOutProj E{(pg8::bf16_t*)(ws + WS_Y), (const float*)(ws + WS_MOD) + 2 * DM};
        pg8::gemm_phase<pg8::EpiOutProj, pg8::StaticOrder, true, true>(F.lds, g, S, E);
    } SEAM(6);
    if (IN(7)) { phase_norm2(F, a); } SEAM(7);
    if (IN(8)) {
        pg8::Gemm g{(const pg8::bf16_t*)(ws + WS_H), (const pg8::bf16_t*)(ws + WS_WGU), TOK, 2 * FF, DM}; pg8::StaticOrder S; S.init(TOK, 2 * FF, F.G, (int)blockIdx.x);
        pg8::EpiGateUp E{(pg8::bf16_t*)(ws + WS_ACT)};
        pg8::gemm_phase<pg8::EpiGateUp, pg8::StaticOrder, true, true>(F.lds, g, S, E);
    } SEAM(8);
    if (IN(9)) {
        pg8::Gemm g{(const pg8::bf16_t*)(ws + WS_ACT), (const pg8::bf16_t*)(ws + WS_WDN), TOK, DM, FF}; pg8::StaticOrder S; S.init(TOK, DM, F.G, (int)blockIdx.x);
        pg8::EpiDown E{a.in[0], (const pg8::bf16_t*)(ws + WS_Y), a.out, (const float*)(ws + WS_MOD) + 5 * DM};
        pg8::gemm_phase<pg8::EpiDown, pg8::StaticOrder, true, true>(F.lds, g, S, E);
    }
#undef IN
#undef SEAM
}

static void launch_phases(const Args& base, int lo, int hi, int grid, hipStream_t stream, int flags = 0) {
    Args a = base; a.ph_lo = lo; a.ph_hi = hi | (flags << 8);
    if (hi - lo > 1) { void* args[] = {&a}; (void)hipLaunchCooperativeKernel((const void*)mk_fwd, dim3(grid), dim3(NTHREADS), args, LDS_BYTES, stream); }
    else hipLaunchKernelGGL(mk_fwd, dim3(grid), dim3(NTHREADS), LDS_BYTES, stream, a);
}
extern "C" void kernel_launch(void* const* d_in, const int* in_sizes, int n_in, void* d_out, int out_size, void* d_ws, size_t ws_size, hipStream_t stream) {
    static int grid = 0;
    if (grid == 0) {
        int dev = 0, cus = 0, per_cu = 0;
        if (n_in != 23 || ws_size < 480 * MiB || hipGetDevice(&dev) != hipSuccess || hipDeviceGetAttribute(&cus, hipDeviceAttributeMultiprocessorCount, dev) != hipSuccess) { grid = -1; return; }
        if (hipFuncSetAttribute((const void*)mk_fwd, hipFuncAttributeMaxDynamicSharedMemorySize, LDS_BYTES) != hipSuccess) { grid = -1; return; }
        if (hipOccupancyMaxActiveBlocksPerMultiprocessor(&per_cu, (const void*)mk_fwd, NTHREADS, LDS_BYTES) != hipSuccess || per_cu < 1) { grid = -1; return; }
        grid = cus;
    }
    if (grid < 0) return;
    (void)hipMemsetAsync((char*)d_ws + WS_CTL, 0, CTL_ZERO_BYTES, stream);
    Args a{};
    for (int i = 0; i < 23; ++i) a.in[i] = (const float*)d_in[i];
    a.out = (float*)d_out; a.ws = (unsigned char*)d_ws;
    unsigned char* ws = (unsigned char*)d_ws;
#if HYBRID == 1
    launch_phases(a, 0, 1, grid, stream); launch_phases(a, 1, 2, grid, stream); launch_phases(a, 2, 3, grid, stream);
    const bf16* qkv = (const bf16*)(ws + WS_QKV); bf16* mix = (bf16*)(ws + WS_MIX); bf16* kcmp = (bf16*)(ws + WS_KCMP); bf16* vcmp = (bf16*)(ws + WS_VCMP);
    int* sel = (int*)(ws + 344 * MiB); float* obuf = (float*)(ws + 348 * MiB); const float* gates = (const float*)(ws + WS_GATES);
    nq::k_compress<<<dim3(4 * 2 * 512, 2), 256, 0, stream>>>(qkv, a.in[13], a.in[14], a.in[15], a.in[16], a.in[17], a.in[18], a.in[10], kcmp, vcmp);
    nq::k_moba<<<4 * 8 * SEQ / 4, 256, 0, stream>>>(qkv, (const float*)(ws + WS_KMP), a.in[2], mix);
    nq::k_nsa_cmp<<<4 * 2 * SEQ, 256, 0, stream>>>(qkv, kcmp, vcmp, gates, obuf, sel);
    nq::k_nsa_sel<<<4 * 2 * SEQ, 256, 0, stream>>>(qkv, sel, a.in[2], gates, obuf);
    nq::k_nsa_win<<<4 * 2 * SEQ, 256, 0, stream>>>(qkv, a.in[2], gates, obuf, mix);
    launch_phases(a, 5, 6, grid, stream); launch_phases(a, 6, 7, grid, stream); launch_phases(a, 7, 8, grid, stream); launch_phases(a, 8, 9, grid, stream);
#elif HYBRID == 2
    launch_phases(a, 0, 1, grid, stream); launch_phases(a, 1, 2, grid, stream); launch_phases(a, 2, 3, grid, stream);
    nq::k_compress<<<dim3(4 * 2 * 512, 2), 256, 0, stream>>>((const bf16*)(ws + WS_QKV), a.in[13], a.in[14], a.in[15], a.in[16], a.in[17], a.in[18], a.in[10], (bf16*)(ws + WS_KCMP), (bf16*)(ws + WS_VCMP));
    launch_phases(a, 4, 5, grid, stream);
    launch_phases(a, 5, 6, grid, stream); launch_phases(a, 6, 7, grid, stream); launch_phases(a, 7, 8, grid, stream); launch_phases(a, 8, 9, grid, stream);
#elif HYBRID == 3
    for (int p = 0; p < N_PHASES; ++p) {
#if defined(TIME_PHASE)
        if (p == TIME_PHASE) { for (int r = 0; r < TIME_REPS; ++r) { launch_phases(a, p, p + 1, grid, stream, TIME_FLAGS); (void)hipMemsetAsync((char*)d_ws + WS_CTL, 0, CTL_ZERO_BYTES, stream); } }
#endif
        launch_phases(a, p, p + 1, grid, stream);
#if defined(ABL_REPS)
        if (p == 3) { static bool once = false; if (!once) { once = true; (void)hipFuncSetAttribute((const void*)k_attn_abl, hipFuncAttributeMaxDynamicSharedMemorySize, LDS_BYTES); }
            for (int r = 0; r < ABL_REPS; ++r) { (void)hipMemsetAsync((char*)d_ws + WS_CTL + 512, 0, 4, stream); hipLaunchKernelGGL(k_attn_abl, dim3(grid), dim3(NTHREADS), LDS_BYTES, stream, a); } }
#endif
    }
#else
    launch_phases(a, 0, N_PHASES, grid, stream);
#endif
}
```

```cpp
#include <hip/hip_runtime.h>
#include <hip/hip_cooperative_groups.h>
#include <cstdint>
#include <cstdio>
namespace cg = cooperative_groups;
#define HYBRID 0
namespace pg8 {
#define PG8_LAS __attribute__((address_space(3)))
typedef unsigned short bf16_t;
typedef short bf16x8 __attribute__((ext_vector_type(8)));
typedef float f32x4 __attribute__((ext_vector_type(4)));
typedef unsigned u32x4 __attribute__((ext_vector_type(4)));
constexpr int BM = 256, BK = 64, HALF = 128, HTB = HALF * BK * 2  , STAGE_BYTES = 8 * HTB, NXCD = 8, WGM = 8;

__host__ __device__ __forceinline__ int lds_byte(int r, int c) { const int st = (r >> 4) * 2 + (c >> 5), rr = r & 15, cc = c & 31, ob = rr * 64 + cc * 2; return st * 1024 + (ob ^ (((ob >> 9) & 1) << 5)); }
__host__ __device__ __forceinline__ void stage_rc(int b, int& R, int& C) { const int st = b / 1024, sb = b % 1024, swz = sb ^ (((sb >> 9) & 1) << 5); R = (st >> 1) * 16 + swz / 64; C = (st & 1) * 32 + (swz % 64) / 2; }
__host__ __device__ __forceinline__ int perm32(int rho) { const int n = rho >> 4, i = rho & 15; return 8 * (i >> 2) + 4 * n + (i & 3); }

struct Unit { int pm, pn; };
struct Gemm { const bf16_t* A; const bf16_t* Bt; int M, N, K; };

struct StaticOrder {
    int nM, nN, nwg, G, c;
    __host__ __device__ void init(int M, int N, int G_, int c_) { nM = M / BM; nN = N / BM; nwg = nM * nN; G = G_; c = c_; }
    __host__ __device__ bool next(int i, Unit& u) const {
        const long L = (long)i * G + c; if (L >= nwg) return false;
        int wgid = (int)L; { const int q = nwg / NXCD, r = nwg % NXCD, xcd = wgid % NXCD, off = wgid / NXCD; wgid = (xcd < r ? xcd * (q + 1) : r * (q + 1) + (xcd - r) * q) + off; }
        const int nig = WGM * nN, gid = wgid / nig, fm = gid * WGM, gsz = (nM - fm) < WGM ? (nM - fm) : WGM;
        u.pm = fm + ((wgid % nig) % gsz); u.pn = (wgid % nig) / gsz; return true;
    }
    __device__ __forceinline__ void a_ready(const Unit&) const {}
    __device__ __forceinline__ void done(const Unit&) const {}
};

__device__ __forceinline__ unsigned cvt_pk_bf16(float lo, float hi) { unsigned r; asm volatile("v_cvt_pk_bf16_f32 %0, %1, %2" : "=v"(r) : "v"(lo), "v"(hi)); return r; }
typedef float f32x2 __attribute__((ext_vector_type(2)));
template <class Epi, class Sched, bool ALIGN_EPI = false, bool SP2 = false>
__device__ __forceinline__ void gemm_phase(PG8_LAS unsigned char* lds, const Gemm g, const Sched& S, const Epi& E) {
    const int tid = threadIdx.x, wid = __builtin_amdgcn_readfirstlane(tid >> 6), lane = tid & 63, wr = wid >> 2, wc = wid & 3, fr = lane & 15, fq = lane >> 4;
    const int K = g.K, nt = K / BK;
    unsigned voffA[2], voffB[2];
#pragma unroll
    for (int i = 0; i < 2; ++i) { int R, C; stage_rc(tid * 16 + i * 8192, R, C); const int Rb = Epi::PERM ? ((R & ~31) + perm32(R & 31)) : R;
        voffA[i] = (unsigned)(R * K + C) * 2u; voffB[i] = (unsigned)(Rb * K + C) * 2u; }
    const size_t kstep = (size_t)(BK * 2);
    const size_t hstep = (size_t)HALF * K * 2;
    const size_t tstep = 2 * hstep;
    const unsigned ldsw = (unsigned)wid * 1024u;
    const int aoff = lds_byte(wr * 64 + fr, fq * 8), boff = lds_byte(wc * 32 + fr, fq * 8);
#define PG8_SA(b, h) (((b) * 2 + (h)) * HTB)
#define PG8_SB(b, h) ((4 + (b) * 2 + (h)) * HTB)
#define PG8_STAGE(bufoff, gbase, voff) do { _Pragma("unroll") for (int _i = 0; _i < 2; ++_i) \
        __builtin_amdgcn_global_load_lds((const unsigned*)((const char*)(gbase) + (voff)[_i]), (PG8_LAS unsigned*)(lds + (bufoff) + ldsw + _i * 8192), 16, 0, 0); } while (0)
#define PG8_LDA(dst, b, h) do { _Pragma("unroll") for (int m = 0; m < 4; ++m) _Pragma("unroll") for (int k = 0; k < 2; ++k) dst[m][k] = *(const PG8_LAS bf16x8*)(lds + PG8_SA(b, h) + aoff + m * 2048 + k * 1024); } while (0)
#define PG8_LDB(dst, b, h) do { _Pragma("unroll") for (int n = 0; n < 2; ++n) _Pragma("unroll") for (int k = 0; k < 2; ++k) dst[n][k] = *(const PG8_LAS bf16x8*)(lds + PG8_SB(b, h) + boff + n * 2048 + k * 1024); } while (0)
#define PG8_MMA(ai, bj, At, Bt) do { __builtin_amdgcn_s_setprio(1); _Pragma("unroll") for (int m = 0; m < 4; ++m) _Pragma("unroll") for (int n = 0; n < 2; ++n) _Pragma("unroll") for (int k = 0; k < 2; ++k) \
        acc[ai][bj][m][n] = __builtin_amdgcn_mfma_f32_16x16x32_bf16(Bt[n][k], At[m][k], acc[ai][bj][m][n], 0, 0, 0); __builtin_amdgcn_s_setprio(0); } while (0)
#define PG8_WAIT_V(n) asm volatile("s_waitcnt vmcnt(" #n ")" ::: "memory")
#define PG8_WAIT_L(n) asm volatile("s_waitcnt lgkmcnt(" #n ")" ::: "memory")
#define PG8_BAR __builtin_amdgcn_s_barrier()
#define PG8_SCHED __builtin_amdgcn_sched_barrier(0)
    Unit cur, nxt; int ui = 0;
    if (!S.next(0, cur)) return;
    f32x4 acc[2][2][4][2];
#pragma unroll
    for (int a = 0; a < 2; ++a)
#pragma unroll
        for (int b = 0; b < 2; ++b)
#pragma unroll
            for (int m = 0; m < 4; ++m)
#pragma unroll
                for (int n = 0; n < 2; ++n) acc[a][b][m][n] = (f32x4){0.f, 0.f, 0.f, 0.f};
    bf16x8 At[4][2], B0[2][2], B1[2][2];
    const char* cA = (const char*)g.A + (size_t)cur.pm * tstep; const char* cB = (const char*)g.Bt + (size_t)cur.pn * tstep;
    S.a_ready(cur);
    if constexpr (SP2) {
        PG8_STAGE(PG8_SB(0, 0), cB, voffB); PG8_STAGE(PG8_SB(0, 1), cB + hstep, voffB); PG8_STAGE(PG8_SA(0, 0), cA, voffA); PG8_STAGE(PG8_SA(0, 1), cA + hstep, voffA);
        if (wr == 1) PG8_BAR;
        PG8_WAIT_V(2); PG8_BAR;
        PG8_STAGE(PG8_SB(1, 0), cB + kstep, voffB); PG8_STAGE(PG8_SA(1, 0), cA + kstep, voffA); PG8_STAGE(PG8_SB(1, 1), cB + hstep + kstep, voffB);
        PG8_WAIT_V(6); PG8_BAR;
    } else {
        PG8_STAGE(PG8_SB(0, 0), cB, voffB); PG8_STAGE(PG8_SA(0, 0), cA, voffA); PG8_STAGE(PG8_SB(0, 1), cB + hstep, voffB); PG8_STAGE(PG8_SA(0, 1), cA + hstep, voffA);
        if (wr == 1) PG8_BAR;
        PG8_WAIT_V(4); PG8_BAR;
        PG8_STAGE(PG8_SB(1, 0), cB + kstep, voffB); PG8_STAGE(PG8_SA(1, 0), cA + kstep, voffA); PG8_STAGE(PG8_SB(1, 1), cB + hstep + kstep, voffB);
        PG8_WAIT_V(6); PG8_BAR;
    }
    for (;;) {
        const bool has_next = S.next(ui + 1, nxt);
        const char* nA = has_next ? (const char*)g.A + (size_t)nxt.pm * tstep : cA; const char* nB = has_next ? (const char*)g.Bt + (size_t)nxt.pn * tstep : cB;
        for (int t = 0; t < nt; t += 2) {
            const bool last = (t == nt - 2);
            const char* a1 = cA + (size_t)(t + 1) * kstep;
            const char* a2 = last ? nA : cA + (size_t)(t + 2) * kstep; const char* b2 = last ? nB : cB + (size_t)(t + 2) * kstep;
            const char* a3 = a2 + kstep; const char* b3 = b2 + kstep;
            if (last && has_next) S.a_ready(nxt);
            if constexpr (SP2) {
            PG8_LDB(B0, 0, 0); PG8_LDB(B1, 0, 1); PG8_SCHED; PG8_LDA(At, 0, 0); PG8_STAGE(PG8_SA(1, 1), a1 + hstep, voffA);
            PG8_WAIT_V(8); PG8_WAIT_L(0); PG8_BAR; PG8_MMA(0, 0, At, B0); PG8_MMA(0, 1, At, B1); PG8_BAR; PG8_SCHED;
            PG8_LDA(At, 0, 1); PG8_STAGE(PG8_SB(0, 0), b2, voffB); PG8_STAGE(PG8_SB(0, 1), b2 + hstep, voffB); PG8_STAGE(PG8_SA(0, 0), a2, voffA);
            PG8_WAIT_V(8); PG8_WAIT_L(0); PG8_BAR; PG8_MMA(1, 0, At, B0); PG8_MMA(1, 1, At, B1); PG8_BAR; PG8_SCHED;
            PG8_LDB(B0, 1, 0); PG8_LDB(B1, 1, 1); PG8_SCHED; PG8_LDA(At, 1, 0); PG8_STAGE(PG8_SA(0, 1), a2 + hstep, voffA);
            PG8_WAIT_V(8); PG8_WAIT_L(0); PG8_BAR; PG8_MMA(0, 0, At, B0); PG8_MMA(0, 1, At, B1); PG8_BAR; PG8_SCHED;
            PG8_LDA(At, 1, 1); PG8_STAGE(PG8_SB(1, 0), b3, voffB); PG8_STAGE(PG8_SB(1, 1), b3 + hstep, voffB); PG8_STAGE(PG8_SA(1, 0), a3, voffA);
            PG8_WAIT_V(8); PG8_WAIT_L(0); PG8_BAR; PG8_MMA(1, 0, At, B0); PG8_MMA(1, 1, At, B1); PG8_BAR; PG8_SCHED;
            } else {
            PG8_LDB(B0, 0, 0); PG8_SCHED; PG8_LDA(At, 0, 0); PG8_STAGE(PG8_SA(1, 1), a1 + hstep, voffA);
            PG8_WAIT_L(8); PG8_BAR; PG8_WAIT_L(0); PG8_MMA(0, 0, At, B0); PG8_BAR; PG8_SCHED;
            PG8_LDB(B1, 0, 1); PG8_STAGE(PG8_SB(0, 0), b2, voffB);
            PG8_BAR; PG8_WAIT_L(0); PG8_MMA(0, 1, At, B1); PG8_BAR;
            PG8_LDA(At, 0, 1); PG8_STAGE(PG8_SA(0, 0), a2, voffA);
            PG8_BAR; PG8_WAIT_L(0); PG8_MMA(1, 0, At, B0); PG8_BAR; PG8_SCHED;
            PG8_STAGE(PG8_SB(0, 1), b2 + hstep, voffB);
            PG8_WAIT_V(6); PG8_BAR; PG8_MMA(1, 1, At, B1); PG8_BAR;
            PG8_LDB(B0, 1, 0); PG8_SCHED; PG8_LDA(At, 1, 0); PG8_STAGE(PG8_SA(0, 1), a2 + hstep, voffA);
            PG8_WAIT_L(8); PG8_BAR; PG8_WAIT_L(0); PG8_MMA(0, 0, At, B0); PG8_BAR; PG8_SCHED;
            PG8_LDB(B1, 1, 1); PG8_STAGE(PG8_SB(1, 0), b3, voffB);
            PG8_BAR; PG8_WAIT_L(0); PG8_MMA(0, 1, At, B1); PG8_BAR;
            PG8_LDA(At, 1, 1); PG8_STAGE(PG8_SA(1, 0), a3, voffA);
            PG8_BAR; PG8_WAIT_L(0); PG8_MMA(1, 0, At, B0); PG8_BAR; PG8_SCHED;
            PG8_STAGE(PG8_SB(1, 1), b3 + hstep, voffB);
            PG8_WAIT_V(6); PG8_BAR; PG8_MMA(1, 1, At, B1); PG8_BAR;
            }
        }
        if constexpr (ALIGN_EPI) { if (wr == 0) PG8_BAR; }
        if constexpr (!Epi::AFTER_DRAIN) { E(acc, cur, wr, wc, fr, fq); S.done(cur); }
        if (!has_next) break;
#pragma unroll
        for (int a = 0; a < 2; ++a)
#pragma unroll
            for (int b = 0; b < 2; ++b)
#pragma unroll
                for (int m = 0; m < 4; ++m)
#pragma unroll
                    for (int n = 0; n < 2; ++n) acc[a][b][m][n] = (f32x4){0.f, 0.f, 0.f, 0.f};
        cur = nxt; cA = nA; cB = nB; ++ui;
        if constexpr (ALIGN_EPI) { if (wr == 1) PG8_BAR; }
    }
    PG8_WAIT_V(0);
    if constexpr (!ALIGN_EPI) { if (wr == 0) PG8_BAR; }
    PG8_BAR;
    if constexpr (Epi::AFTER_DRAIN) { E.fused(acc, cur, wr, wc, fr, fq, lds, wid, lane); S.done(cur); }
#undef PG8_SA
#undef PG8_SB
#undef PG8_STAGE
#undef PG8_LDA
#undef PG8_LDB
#undef PG8_MMA
#undef PG8_WAIT_V
#undef PG8_WAIT_L
#undef PG8_BAR
#undef PG8_SCHED
}
}
namespace pg8 {
typedef unsigned u32x2v __attribute__((ext_vector_type(2)));
constexpr int TOK_S = 8192;
constexpr float QK_EPS = 1e-6f;
constexpr float C2 = 0.125f * 1.4426950408889634f;
__device__ __forceinline__ float sigmoid_fast(float v) { return __builtin_amdgcn_rcpf(1.f + __builtin_amdgcn_exp2f(-1.4426950408889634f * v)); }
__device__ __forceinline__ float silu_fast(float v) { return v * __builtin_amdgcn_rcpf(1.f + __builtin_amdgcn_exp2f(-1.4426950408889634f * v)); }

struct EpiInProj {
    static constexpr bool PERM = true, AFTER_DRAIN = false;
    bf16_t* qkv;
    float* gates;
    float* kmean_part;
    const float *qna, *kna, *qnb, *knsel, *knwin;
    __device__ __forceinline__ void operator()(const f32x4 (&acc)[2][2][4][2], const Unit& u, int wr, int wc, int fr, int fq) const {
        const int slot = u.pn * 4 + wc;
        if (slot > 44) return;
        const int b = u.pm >> 5, blk = u.pm & 31, pos0 = blk * 256 + wr * 64 + fr;
        if (slot == 44) {
            if (fq < 3) {
#pragma unroll
                for (int ai = 0; ai < 2; ++ai)
#pragma unroll
                    for (int m = 0; m < 4; ++m) { const size_t tok = (size_t)b * TOK_S + pos0 + ai * HALF + m * 16; float* gp = gates + tok * 24 + 8 * fq;
                        const f32x4 v0 = acc[ai][0][m][0], v1 = acc[ai][0][m][1];
                        *(f32x4*)gp = (f32x4){sigmoid_fast(v0[0]), sigmoid_fast(v0[1]), sigmoid_fast(v0[2]), sigmoid_fast(v0[3])};
                        *(f32x4*)(gp + 4) = (f32x4){sigmoid_fast(v1[0]), sigmoid_fast(v1[1]), sigmoid_fast(v1[2]), sigmoid_fast(v1[3])}; }
            }
            return;
        }
        const float* gain = nullptr; float qscale = 1.f; bool is_ka = false; bf16_t* dst;
        constexpr size_t BIG = (size_t)4 * 8 * TOK_S * 64, SMALL = (size_t)4 * 2 * TOK_S * 64;
        if (slot < 32) { const int kind = slot >> 3, head = slot & 7; dst = qkv + kind * BIG + ((size_t)(b * 8 + head) * TOK_S) * 64;
            if (kind == 0) { gain = qna; qscale = C2; } else if (kind == 1) { gain = kna; is_ka = true; } else if (kind == 3) { gain = qnb; qscale = C2; } }
        else { const int kind = (slot - 32) >> 1, g = slot & 1; dst = qkv + 4 * BIG + kind * SMALL + ((size_t)(b * 2 + g) * TOK_S) * 64;
            if (kind == 2) gain = knsel; else if (kind == 4) gain = knwin; }
        float gv[16];
#pragma unroll
        for (int i = 0; i < 16; ++i) gv[i] = gain ? gain[(i >> 3) * 32 + 8 * fq + (i & 7)] * qscale : 1.f;
        float cs[16];
#pragma unroll
        for (int i = 0; i < 16; ++i) cs[i] = 0.f;
#pragma unroll
        for (int ai = 0; ai < 2; ++ai)
#pragma unroll
            for (int m = 0; m < 4; ++m) {
                float v[16];
#pragma unroll
                for (int bj = 0; bj < 2; ++bj)
#pragma unroll
                    for (int n = 0; n < 2; ++n)
#pragma unroll
                        for (int j = 0; j < 4; ++j) v[bj * 8 + n * 4 + j] = acc[ai][bj][m][n][j];
                if (gain) { float ss = 0.f;
#pragma unroll
                    for (int i = 0; i < 16; ++i) ss += v[i] * v[i];
                    ss += __shfl_xor(ss, 16); ss += __shfl_xor(ss, 32);
                    const float rs = rsqrtf(ss * (1.f / 64.f) + QK_EPS);
#pragma unroll
                    for (int i = 0; i < 16; ++i) v[i] *= rs * gv[i]; }
                if (is_ka) {
#pragma unroll
                    for (int i = 0; i < 16; ++i) cs[i] += v[i]; }
                bf16_t* rp = dst + (size_t)(pos0 + ai * HALF + m * 16) * 64 + 8 * fq;
                u32x4 w0, w1;
                w0.x = cvt_pk_bf16(v[0], v[1]); w0.y = cvt_pk_bf16(v[2], v[3]); w0.z = cvt_pk_bf16(v[4], v[5]); w0.w = cvt_pk_bf16(v[6], v[7]);
                w1.x = cvt_pk_bf16(v[8], v[9]); w1.y = cvt_pk_bf16(v[10], v[11]); w1.z = cvt_pk_bf16(v[12], v[13]); w1.w = cvt_pk_bf16(v[14], v[15]);
                *(u32x4*)rp = w0; *(u32x4*)(rp + 32) = w1;
            }
        if (is_ka) {
#pragma unroll
            for (int i = 0; i < 16; ++i) { float s = cs[i]; s += __shfl_xor(s, 1); s += __shfl_xor(s, 2); s += __shfl_xor(s, 4); s += __shfl_xor(s, 8); cs[i] = s; }
            if (fr == 0) { float* kp = kmean_part + ((size_t)((b * 8 + (slot & 7)) * 32 + blk) * 2 + wr) * 64 + 8 * fq;
                *(f32x4*)kp = (f32x4){cs[0], cs[1], cs[2], cs[3]}; *(f32x4*)(kp + 4) = (f32x4){cs[4], cs[5], cs[6], cs[7]};
                *(f32x4*)(kp + 32) = (f32x4){cs[8], cs[9], cs[10], cs[11]}; *(f32x4*)(kp + 36) = (f32x4){cs[12], cs[13], cs[14], cs[15]}; }
        }
    }
};
struct EpiOutProj {
    static constexpr bool PERM = true, AFTER_DRAIN = false;
    bf16_t* y; const float* gt;
    __device__ __forceinline__ void operator()(const f32x4 (&acc)[2][2][4][2], const Unit& u, int wr, int wc, int fr, int fq) const {
        const int b = u.pm >> 5; const int col0 = u.pn * BM + wc * 32 + 8 * fq; const float* gtb = gt + (size_t)b * 6144;
#pragma unroll
        for (int bj = 0; bj < 2; ++bj) { const int c = col0 + bj * HALF; const f32x4 g40 = *(const f32x4*)(gtb + c), g41 = *(const f32x4*)(gtb + c + 4);
#pragma unroll
            for (int ai = 0; ai < 2; ++ai)
#pragma unroll
                for (int m = 0; m < 4; ++m) { const size_t off = (size_t)(u.pm * BM + ai * HALF + wr * 64 + m * 16 + fr) * 1024 + c;
                    const f32x4 y0 = g40 * acc[ai][bj][m][0], y1 = g41 * acc[ai][bj][m][1];
                    u32x4 w; w.x = cvt_pk_bf16(y0[0], y0[1]); w.y = cvt_pk_bf16(y0[2], y0[3]); w.z = cvt_pk_bf16(y1[0], y1[1]); w.w = cvt_pk_bf16(y1[2], y1[3]);
                    *(u32x4*)(y + off) = w; } }
    }
};
struct EpiGateUp {
    static constexpr bool PERM = true, AFTER_DRAIN = false;
    bf16_t* act;
    __device__ __forceinline__ void operator()(const f32x4 (&acc)[2][2][4][2], const Unit& u, int wr, int wc, int fr, int fq) const {
        const int h0 = u.pn * 128 + wc * 32 + 8 * fq;
#pragma unroll
        for (int ai = 0; ai < 2; ++ai)
#pragma unroll
            for (int m = 0; m < 4; ++m) { const size_t row = (size_t)(u.pm * BM + ai * HALF + wr * 64 + m * 16 + fr);
                const f32x4 g0 = acc[ai][0][m][0], g1 = acc[ai][0][m][1], u0 = acc[ai][1][m][0], u1 = acc[ai][1][m][1];
                u32x4 w;
                w.x = cvt_pk_bf16(silu_fast(g0[0]) * u0[0], silu_fast(g0[1]) * u0[1]); w.y = cvt_pk_bf16(silu_fast(g0[2]) * u0[2], silu_fast(g0[3]) * u0[3]);
                w.z = cvt_pk_bf16(silu_fast(g1[0]) * u1[0], silu_fast(g1[1]) * u1[1]); w.w = cvt_pk_bf16(silu_fast(g1[2]) * u1[2], silu_fast(g1[3]) * u1[3]);
                *(u32x4*)(act + row * 2816 + h0) = w; }
    }
};
struct EpiDown {
    static constexpr bool PERM = true, AFTER_DRAIN = false;
    const float* x; const bf16_t* y; float* out; const float* gt;
    __device__ __forceinline__ void operator()(const f32x4 (&acc)[2][2][4][2], const Unit& u, int wr, int wc, int fr, int fq) const {
        const int b = u.pm >> 5; const int col0 = u.pn * BM + wc * 32 + 8 * fq; const float* gtb = gt + (size_t)b * 6144;
#pragma unroll
        for (int bj = 0; bj < 2; ++bj) { const int c = col0 + bj * HALF; const f32x4 g40 = *(const f32x4*)(gtb + c), g41 = *(const f32x4*)(gtb + c + 4);
#pragma unroll
            for (int ai = 0; ai < 2; ++ai)
#pragma unroll
                for (int m = 0; m < 4; ++m) { const size_t off = (size_t)(u.pm * BM + ai * HALF + wr * 64 + m * 16 + fr) * 1024 + c;
                    const f32x4 x0 = *(const f32x4*)(x + off), x1 = *(const f32x4*)(x + off + 4); const u32x4 yw = *(const u32x4*)(y + off);
                    const f32x4 y0 = {__builtin_bit_cast(float, yw.x << 16), __builtin_bit_cast(float, yw.x & 0xffff0000u), __builtin_bit_cast(float, yw.y << 16), __builtin_bit_cast(float, yw.y & 0xffff0000u)};
                    const f32x4 y1 = {__builtin_bit_cast(float, yw.z << 16), __builtin_bit_cast(float, yw.z & 0xffff0000u), __builtin_bit_cast(float, yw.w << 16), __builtin_bit_cast(float, yw.w & 0xffff0000u)};
                    *(f32x4*)(out + off) = (x0 + y0) + g40 * acc[ai][bj][m][0]; *(f32x4*)(out + off + 4) = (x1 + y1) + g41 * acc[ai][bj][m][1]; } }
    }
};
}
constexpr int NWAVES = 8, NTHREADS = 512;
constexpr int BATCH = 4, SEQ = 8192, DM = 1024, TOK = BATCH * SEQ, NIN = 2840, NIN_PAD = 3072, FF = 2816, NCMP = 511;
constexpr size_t MiB = 1u << 20;
constexpr size_t WS_CTL = 0, CTL_ZERO_BYTES = 64 * 1024;
constexpr size_t WS_MODP = 1 * MiB;
constexpr size_t WS_MOD = 2 * MiB;
constexpr size_t WS_CBP = 2 * MiB + 512 * 1024;
constexpr size_t WS_KMP = 3 * MiB;
constexpr size_t WS_BIAS2 = 4 * MiB;
constexpr size_t WS_SSP = 449 * MiB;
constexpr size_t WS_WIN = 6 * MiB, WS_WOUT = 12 * MiB, WS_WGU = 14 * MiB, WS_WDN = 25 * MiB;
constexpr size_t WS_W1K = 31 * MiB, WS_W1V = 32 * MiB, WS_W2K = 33 * MiB, WS_W2V = 33 * MiB + 64 * 1024;
constexpr size_t WS_KCMP = 34 * MiB, WS_VCMP = 35 * MiB;
constexpr size_t WS_GATES = 36 * MiB;
constexpr size_t WS_H = 40 * MiB;
constexpr size_t WS_MIX = 104 * MiB;
constexpr size_t WS_QKV = 168 * MiB;
constexpr size_t WS_ACT = WS_QKV;
constexpr size_t WS_END = 344 * MiB;
constexpr size_t WS_PARTO = 344 * MiB;
constexpr size_t WS_PARTL = 472 * MiB;
constexpr size_t WS_SELG = 476 * MiB;
constexpr size_t WS_Y = WS_PARTO;
constexpr size_t QKV_BIG = (size_t)4 * 8 * SEQ * 64, QKV_SMALL = (size_t)4 * 2 * SEQ * 64;
constexpr int RING_BYTES = 131072, LDS_BYTES = 147456;
constexpr int N_PHASES = 10;

#define GAS __attribute__((address_space(1)))
#define LAS __attribute__((address_space(3)))
typedef unsigned short bf16;
typedef unsigned v4u __attribute__((ext_vector_type(4)));
typedef float f32x4 __attribute__((ext_vector_type(4)));
#define LDS_WAIT() asm volatile("s_waitcnt lgkmcnt(0)" ::: "memory")
#define VM_WAIT() asm volatile("s_waitcnt vmcnt(0)" ::: "memory")
__device__ __forceinline__ unsigned f2bf(float f) { unsigned u = __builtin_bit_cast(unsigned, f); return (u + 0x7fffu + ((u >> 16) & 1u)) >> 16; }
__device__ __forceinline__ unsigned pk2(float lo, float hi) { return f2bf(lo) | (f2bf(hi) << 16); }
__device__ __forceinline__ float bf2f(bf16 v) { return __builtin_bit_cast(float, (unsigned)v << 16); }
__device__ __forceinline__ float wave_sum(float v) {
#pragma unroll
    for (int o = 1; o < 64; o <<= 1) v += __shfl_xor(v, o);
    return v;
}
struct Args { const float* in[23]; float* out; unsigned char* ws; int ph_lo, ph_hi; };
struct Frame { LAS unsigned char* lds; int tid, lane, wave, vcu, G; };

struct MapId { __device__ __forceinline__ size_t off(int n, int k, int K) const { return (size_t)n * K + k; } };
struct MapWin { __device__ __forceinline__ size_t off(int n, int k, int K) const { const int s = n >> 6, d = n & 63; return (size_t)(256 * (s >> 2) + 128 * (d >> 5) + 32 * (s & 3) + (d & 31)) * K + k; } };
struct MapWgu { __device__ __forceinline__ size_t off(int n, int k, int K) const { const int up = n >= FF, hdn = up ? n - FF : n; return (size_t)(256 * (hdn >> 7) + 128 * up + (hdn & 127)) * K + k; } };
struct MapFrag { __device__ __forceinline__ size_t off(int n, int k, int K) const { return ((size_t)((k >> 4) * 8 + (n >> 5)) * 64 + ((k >> 3) & 1) * 32 + (n & 31)) * 8 + (k & 7); } };
template <class Map>
__device__ __forceinline__ void transpose_item(const float* __restrict__ W, int K, int N, bf16* WT, LAS float* scr, int item, int lane, const Map& map) {
    const int nblk = (N + 63) / 64, kb = item / nblk, nb = item % nblk, k0 = 64 * kb, n0 = 64 * nb;
    const int nc = n0 + 4 * (lane & 15); const bool nin = nc < N;
    f32x4 v[16];
#pragma unroll
    for (int i = 0; i < 16; ++i) { const int kk = 4 * i + (lane >> 4); v[i] = nin ? *(const GAS f32x4*)(W + (size_t)(k0 + kk) * N + nc) : (f32x4){0.f, 0.f, 0.f, 0.f}; }
#pragma unroll
    for (int i = 0; i < 16; ++i) { const int kk = 4 * i + (lane >> 4); LAS float* d = scr + (4 * (lane & 15)) * 68 + kk; d[0] = v[i][0]; d[68] = v[i][1]; d[136] = v[i][2]; d[204] = v[i][3]; }
    LDS_WAIT(); asm volatile("" ::: "memory");
    const int c = lane & 7;
#pragma unroll
    for (int j = 0; j < 8; ++j) { const int n = (lane >> 3) + 8 * j; const LAS float* s = scr + n * 68 + 8 * c;
        const f32x4 a = *(const LAS f32x4*)s, bq = *(const LAS f32x4*)(s + 4);
        v4u o; o.x = pk2(a[0], a[1]); o.y = pk2(a[2], a[3]); o.z = pk2(bq[0], bq[1]); o.w = pk2(bq[2], bq[3]);
        if (n0 + n < N) *(GAS v4u*)(WT + map.off(n0 + n, k0 + 8 * c, K)) = o; }
    LDS_WAIT(); asm volatile("" ::: "memory");
}
__device__ __forceinline__ float silu_acc(float v) { return v / (1.f + expf(-v)); }
__device__ __forceinline__ void phase_prologue_a(Frame& F, const Args& a) {
    LAS float* scr = (LAS float*)(F.lds + F.wave * 17408);
    const int gw = F.vcu * NWAVES + F.wave, NGW = F.G * NWAVES;
    unsigned char* ws = a.ws;
    constexpr int I_IN = (DM / 64) * ((NIN + 63) / 64), I_OUT = (DM / 64) * (DM / 64), I_GU = (DM / 64) * (2 * FF / 64), I_DN = (FF / 64) * (DM / 64), I_W1 = (2048 / 64) * (256 / 64), I_W2 = (256 / 64) * (64 / 64);
    constexpr int NITEMS = I_IN + I_OUT + I_GU + I_DN + 2 * I_W1 + 2 * I_W2;
    for (int it = gw; it < NITEMS; it += NGW) {
        int r = it;
        if (r < I_IN) { transpose_item(a.in[6], DM, NIN, (bf16*)(ws + WS_WIN), scr, r, F.lane, MapWin()); continue; } r -= I_IN;
        if (r < I_OUT) { transpose_item(a.in[19], DM, DM, (bf16*)(ws + WS_WOUT), scr, r, F.lane, MapId()); continue; } r -= I_OUT;
        if (r < I_GU) { transpose_item(a.in[21], DM, 2 * FF, (bf16*)(ws + WS_WGU), scr, r, F.lane, MapWgu()); continue; } r -= I_GU;
        if (r < I_DN) { transpose_item(a.in[22], FF, DM, (bf16*)(ws + WS_WDN), scr, r, F.lane, MapId()); continue; } r -= I_DN;
        if (r < I_W1) { transpose_item(a.in[14], 2048, 256, (bf16*)(ws + WS_W1K), scr, r, F.lane, MapFrag()); continue; } r -= I_W1;
        if (r < I_W1) { transpose_item(a.in[17], 2048, 256, (bf16*)(ws + WS_W1V), scr, r, F.lane, MapFrag()); continue; } r -= I_W1;
        if (r < I_W2) { transpose_item(a.in[15], 256, 64, (bf16*)(ws + WS_W2K), scr, r, F.lane, MapId()); continue; } r -= I_W2;
        transpose_item(a.in[18], 256, 64, (bf16*)(ws + WS_W2V), scr, r, F.lane, MapId());
    }
    const float* c = a.in[1]; const float* w_ada = a.in[3]; float* modp = (float*)(ws + WS_MODP);
    for (int t = NGW - 1 - gw; t < 96 * 8; t += NGW) { const int cg_ = t % 96, ks = t / 96; const int n = cg_ * 64 + F.lane;
        float acc0 = 0.f, acc1 = 0.f, acc2 = 0.f, acc3 = 0.f;
#pragma unroll
        for (int i = 0; i < 8; ++i) { const int idx = F.lane + 64 * i, bb = idx >> 7, kk = idx & 127; scr[kk * 4 + bb] = silu_acc(c[bb * DM + ks * 128 + kk]); }
        LDS_WAIT(); asm volatile("" ::: "memory");
#pragma unroll 8
        for (int k = 0; k < 128; ++k) { const float w = w_ada[(size_t)(ks * 128 + k) * 6144 + n]; const f32x4 sv = *(const LAS f32x4*)(scr + 4 * k);
            acc0 += sv[0] * w; acc1 += sv[1] * w; acc2 += sv[2] * w; acc3 += sv[3] * w; }
        LDS_WAIT(); asm volatile("" ::: "memory");
        float* o = modp + (size_t)ks * 4 * 6144 + n; o[0] = acc0; o[6144] = acc1; o[2 * 6144] = acc2; o[3 * 6144] = acc3; }
    float* cbp = (float*)(ws + WS_CBP);
    for (int t = NGW / 2 - 1 - gw; t >= 0 && t < 256; t += NGW) { const int kv = t & 1, cg_ = (t >> 1) & 3, ic = t >> 3; const int n = cg_ * 64 + F.lane;
        const float* pe = kv ? a.in[16] : a.in[13]; const float* w1 = kv ? a.in[17] : a.in[14]; float acc = 0.f;
#pragma unroll 8
        for (int i = ic * 64; i < ic * 64 + 64; ++i) acc += pe[i] * w1[(size_t)i * 256 + n];
        cbp[(ic * 2 + kv) * 256 + n] = acc; }
}
template <bool ADDY>
__device__ __forceinline__ void norm_rows(Frame& F, int blk, const float* in, const bf16* yin, const f32x4 (&gs)[4], const f32x4 (&sh)[4], bf16* out) {
    for (int i0 = 0; i0 < 16; i0 += 4) {
        f32x4 v[4][4]; float ss[4];
#pragma unroll
        for (int r = 0; r < 4; ++r) { const int row = blk * 128 + F.wave * 16 + i0 + r; const GAS f32x4* xr = (const GAS f32x4*)(in + (size_t)row * DM) + F.lane;
#pragma unroll
            for (int j = 0; j < 4; ++j) v[r][j] = xr[64 * j];
            if (ADDY) { const GAS unsigned long long* yr = (const GAS unsigned long long*)(yin + (size_t)row * DM) + F.lane;
#pragma unroll
                for (int j = 0; j < 4; ++j) { const unsigned long long w = yr[64 * j]; const unsigned lo = (unsigned)w, hi = (unsigned)(w >> 32);
                    v[r][j] += (f32x4){__builtin_bit_cast(float, lo << 16), __builtin_bit_cast(float, lo & 0xffff0000u), __builtin_bit_cast(float, hi << 16), __builtin_bit_cast(float, hi & 0xffff0000u)}; } } }
#pragma unroll
        for (int r = 0; r < 4; ++r) { float s = 0.f;
#pragma unroll
            for (int j = 0; j < 4; ++j) s += (v[r][j].x * v[r][j].x + v[r][j].y * v[r][j].y) + (v[r][j].z * v[r][j].z + v[r][j].w * v[r][j].w);
            ss[r] = s; }
#pragma unroll
        for (int o_ = 1; o_ < 64; o_ <<= 1) {
#pragma unroll
            for (int r = 0; r < 4; ++r) ss[r] += __shfl_xor(ss[r], o_); }
#pragma unroll
        for (int r = 0; r < 4; ++r) { const int row = blk * 128 + F.wave * 16 + i0 + r; const float rs = rsqrtf(ss[r] * (1.f / DM) + 1e-6f);
            GAS unsigned long long* o8 = (GAS unsigned long long*)(out + (size_t)row * DM) + F.lane;
#pragma unroll
            for (int j = 0; j < 4; ++j) { const f32x4 y = v[r][j] * rs * gs[j] + sh[j]; o8[64 * j] = (unsigned long long)pk2(y.x, y.y) | ((unsigned long long)pk2(y.z, y.w) << 32); } }
    }
}
__device__ __forceinline__ void phase_prologue_b(Frame& F, const Args& a) {
    unsigned char* ws = a.ws; const float* modp = (const float*)(ws + WS_MODP); const float* b_ada = a.in[4];
    if (F.wave == 0) for (int cgp = F.vcu; cgp < 96; cgp += F.G) { const int n = cgp * 64 + F.lane; float* mod = (float*)(ws + WS_MOD);
        for (int b = 0; b < 4; ++b) { float s = 0.f;
#pragma unroll
            for (int ks = 0; ks < 8; ++ks) s += modp[((size_t)ks * 4 + b) * 6144 + n];
            mod[b * 6144 + n] = s + b_ada[n]; } }
    const float* g = a.in[5];
    for (int blk = F.vcu; blk < TOK / 128; blk += F.G) { const int b = blk >> 6;
    f32x4 gs[4], sh[4];
#pragma unroll
    for (int j = 0; j < 4; ++j) { const int c0 = 4 * F.lane + 256 * j; f32x4 s0 = {0.f, 0.f, 0.f, 0.f}, s1 = {0.f, 0.f, 0.f, 0.f};
#pragma unroll
        for (int ks = 0; ks < 8; ++ks) { s0 += *(const f32x4*)(modp + ((size_t)ks * 4 + b) * 6144 + c0); s1 += *(const f32x4*)(modp + ((size_t)ks * 4 + b) * 6144 + DM + c0); }
        s0 += *(const f32x4*)(b_ada + c0); s1 += *(const f32x4*)(b_ada + DM + c0);
        sh[j] = s0; gs[j] = *(const f32x4*)(g + c0) * (s1 + 1.0f); }
    norm_rows<false>(F, blk, a.in[0], nullptr, gs, sh, (bf16*)(ws + WS_H)); }
}
__device__ __forceinline__ void phase_norm2(Frame& F, const Args& a) {
    unsigned char* ws = a.ws; const float* g = a.in[20];
    for (int blk = F.vcu; blk < TOK / 128; blk += F.G) { const int b = blk >> 6; const float* mod = (const float*)(ws + WS_MOD) + (size_t)b * 6144;
        f32x4 gs[4], sh[4];
#pragma unroll
        for (int j = 0; j < 4; ++j) { const int c0 = 4 * F.lane + 256 * j; sh[j] = *(const f32x4*)(mod + 3 * DM + c0); gs[j] = *(const f32x4*)(g + c0) * (*(const f32x4*)(mod + 4 * DM + c0) + 1.0f); }
        norm_rows<true>(F, blk, a.in[0], (const bf16*)(ws + WS_Y), gs, sh, (bf16*)(ws + WS_H)); }
}

__device__ __forceinline__ void phase_bias2(Frame& F, const Args& a) {
    unsigned char* ws = a.ws; const float* mod = (const float*)(ws + WS_MOD); const bf16* wt = (const bf16*)(ws + WS_WGU); float* bias2 = (float*)(ws + WS_BIAS2);
    const int gw = F.vcu * NWAVES + F.wave, NGW = F.G * NWAVES;
    f32x4 sh[4][4];
#pragma unroll
    for (int bb = 0; bb < 4; ++bb)
#pragma unroll
        for (int j = 0; j < 4; ++j) sh[bb][j] = *(const f32x4*)(mod + (size_t)bb * 6144 + 3 * DM + 16 * F.lane + 4 * j);
    for (int c = gw; c < 2 * FF; c += NGW) {
        const v4u w0 = *(const GAS v4u*)(wt + (size_t)c * DM + 16 * F.lane), w1 = *(const GAS v4u*)(wt + (size_t)c * DM + 16 * F.lane + 8);
        const unsigned wu[8] = {w0.x, w0.y, w0.z, w0.w, w1.x, w1.y, w1.z, w1.w};
        float s[4] = {0.f, 0.f, 0.f, 0.f};
#pragma unroll
        for (int j = 0; j < 4; ++j) { const float e0 = __builtin_bit_cast(float, wu[2 * j] << 16), e1 = __builtin_bit_cast(float, wu[2 * j] & 0xffff0000u), e2 = __builtin_bit_cast(float, wu[2 * j + 1] << 16), e3 = __builtin_bit_cast(float, wu[2 * j + 1] & 0xffff0000u);
#pragma unroll
            for (int bb = 0; bb < 4; ++bb) s[bb] += (sh[bb][j][0] * e0 + sh[bb][j][1] * e1) + (sh[bb][j][2] * e2 + sh[bb][j][3] * e3); }
#pragma unroll
        for (int bb = 0; bb < 4; ++bb) { const float t = wave_sum(s[bb]); if (F.lane == 0) bias2[(size_t)bb * 2 * FF + c] = t; }
    }
}
#define XB_TMO      128
#define XB_XCNT(j)  (256  + 64 * (j))
#define XB_XSUB(j)  (1280 + 64 * (j))
#define XB_XGEN(j)  (2304 + 64 * (j))
#define XB_TOP      3328
#define XB_TOPGEN   3392
#define XCD_BAR_WORDS 3456
#define XB_SPIN_CAP (1u << 18)

__device__ __forceinline__ unsigned xb_ld(unsigned* p)              { return __hip_atomic_load(p, __ATOMIC_RELAXED, __HIP_MEMORY_SCOPE_AGENT); }
__device__ __forceinline__ unsigned xb_add(unsigned* p, unsigned v) { return __hip_atomic_fetch_add(p, v, __ATOMIC_RELAXED, __HIP_MEMORY_SCOPE_AGENT); }
__device__ __forceinline__ unsigned xb_xcc_id() { return (unsigned)__builtin_amdgcn_s_getreg((3 << 11) | 20) & 0xFu; }
#define XB_SPIN(cond, bar) do { unsigned _sp = 0; while (cond) { __builtin_amdgcn_s_sleep(1); \
    if ((++_sp & 255u) == 0u) { if (xb_ld(&(bar)[XB_TMO])) break; if (_sp > XB_SPIN_CAP) { atomicAdd(&(bar)[XB_TMO], 1u); break; } } } } while (0)

struct XcdBarrier {
    unsigned* bar; unsigned x;
    volatile LAS unsigned* st;
};

__device__ __forceinline__ XcdBarrier xcd_barrier_post(unsigned* bar, volatile LAS unsigned* st) {
    XcdBarrier b; b.bar = bar; b.x = xb_xcc_id(); b.st = st;
    if (threadIdx.x == 0) (void)xb_add(&bar[XB_XCNT(b.x)], 1u);
    return b;
}
__device__ __forceinline__ void xcd_barrier_complete(unsigned* bar, unsigned x, unsigned& nloc, unsigned& nx) {
    const unsigned G = gridDim.x * gridDim.y * gridDim.z;
    unsigned sum, cnt, mine, sp = 0u;
    for (;;) {
        sum = 0u; cnt = 0u; mine = 0u;
#pragma unroll
        for (unsigned j = 0; j < 16; ++j) { const unsigned c = xb_ld(&bar[XB_XCNT(j)]); sum += c; cnt += (c > 0u) ? 1u : 0u; mine = (j == x) ? c : mine; }
        if (sum == G) break;
        __builtin_amdgcn_s_sleep(1);
        if ((++sp & 255u) == 0u) { if (xb_ld(&bar[XB_TMO])) break; if (sp > XB_SPIN_CAP) { atomicAdd(&bar[XB_TMO], 1u); break; } }
    }
    nloc = mine > 0u ? mine : 1u; nx = cnt > 0u ? cnt : 1u;
}

__device__ __forceinline__ void xcd_barrier(const XcdBarrier& b) {
    asm volatile("s_waitcnt vmcnt(0)" ::: "memory");
    __syncthreads();
    if (threadIdx.x == 0) {
        unsigned* bar = b.bar;
        __builtin_amdgcn_s_waitcnt(0);
        unsigned nloc = b.st[0], nx = b.st[1];
        if (nloc == 0u) { xcd_barrier_complete(bar, b.x, nloc, nx); b.st[0] = nloc; b.st[1] = nx; }
        const unsigned old = xb_add(&bar[XB_XSUB(b.x)], 1u);
        const unsigned gen = old / nloc;
        if (old + 1u == (gen + 1u) * nloc) {
            __builtin_amdgcn_fence(__ATOMIC_RELEASE, "agent");
            asm volatile("s_waitcnt vmcnt(0)" ::: "memory");
            const unsigned og = xb_add(&bar[XB_TOP], 1u);
            const unsigned tg = og / nx;
            if (og + 1u == (tg + 1u) * nx) xb_add(&bar[XB_TOPGEN], 1u);
            else XB_SPIN(xb_ld(&bar[XB_TOPGEN]) == tg, bar);
            __builtin_amdgcn_fence(__ATOMIC_ACQUIRE, "agent");
            xb_add(&bar[XB_XGEN(b.x)], 1u);
            asm volatile("s_waitcnt vmcnt(0)" ::: "memory");
        } else {
            XB_SPIN(xb_ld(&bar[XB_XGEN(b.x)]) == gen, bar);
            __builtin_amdgcn_fence(__ATOMIC_ACQUIRE, "agent");
            asm volatile("s_waitcnt vmcnt(0)" ::: "memory");
        }
    }
    __syncthreads();
}
#define ATT_NS att
#ifndef ATT_ABL
#define ATT_ABL 0
#endif
#ifndef ATT_STAGGER
#define ATT_STAGGER 0
#endif
#ifndef ATT_SLEEP
#define ATT_SLEEP 24
#endif
namespace ATT_NS {
using bf16x8 = __attribute__((ext_vector_type(8))) short;
using s16x4 = __attribute__((ext_vector_type(4))) short;
using f32x16 = __attribute__((ext_vector_type(16))) float;
using u32x4 = __attribute__((ext_vector_type(4))) unsigned;
typedef LAS const char* lds_cptr;
typedef short v4i16_t __attribute__((ext_vector_type(4)));
constexpr int SLOT = 16384, NSLOT = 4, LDS_OST = 65536, LDS_IMP = 100608, LDS_SELM = 135680, LDS_MISC = 136704, LDS_WSF = 136960, LDS_LUTG = 139008  , LDS_ATT_END = 147200;
constexpr int LUT_PITCH = 116;
constexpr int IMP_PITCH = 136, IMP_PLANE = 64 * IMP_PITCH + 4, IMP_REG1 = 64;
constexpr float LOG2E = 1.4426950408889634f;
#define MFMA32(a, b, c) __builtin_amdgcn_mfma_f32_32x32x16_bf16(a, b, c, 0, 0, 0)
#define ATT_WAIT_BAR(N) asm volatile("s_waitcnt vmcnt(" #N ") lgkmcnt(0)\n\ts_barrier" ::: "memory")
__device__ __forceinline__ void glds16(const void* gsrc, unsigned lds_dst) { unsigned keep;
    asm volatile("s_mov_b32 %0, m0\n\ts_mov_b32 m0, %2\n\ts_nop 0\n\tglobal_load_lds_dwordx4 %1, off\n\ts_mov_b32 m0, %0" : "=&s"(keep) : "v"(gsrc), "s"(lds_dst) : "memory"); }
typedef float f32x2_t __attribute__((ext_vector_type(2))); typedef __bf16 bf16x2_t __attribute__((ext_vector_type(2)));
__device__ __forceinline__ unsigned cvtpk(float lo, float hi) { f32x2_t v = {lo, hi}; bf16x2_t b = __builtin_convertvector(v, bf16x2_t); return __builtin_bit_cast(unsigned, b); }
__device__ __forceinline__ s16x4 vtr(lds_cptr p) { return __builtin_bit_cast(s16x4, __builtin_amdgcn_ds_read_tr16_b64_v4i16((LAS v4i16_t*)p)); }
__device__ __forceinline__ int t5_bucket(int d) {
    if (d < 16) return d;
    int b = 16;
    b += (d >= 19); b += (d >= 21); b += (d >= 24); b += (d >= 27); b += (d >= 31); b += (d >= 35); b += (d >= 40); b += (d >= 46);
    b += (d >= 52); b += (d >= 59); b += (d >= 67); b += (d >= 77); b += (d >= 87); b += (d >= 99); b += (d >= 113);
    return b;
}
struct Ctx { LAS char* lds; int wid; int lane, r32, hi; };
__device__ __forceinline__ int fresh_lane() { int l; asm volatile("v_mbcnt_lo_u32_b32 %0, -1, 0\n\tv_mbcnt_hi_u32_b32 %0, -1, %0" : "=v"(l)); return l; }
__device__ __forceinline__ Ctx make_ctx(LAS unsigned char* lds, int tid) {
    Ctx c; c.lds = (LAS char*)lds; c.wid = __builtin_amdgcn_readfirstlane(tid >> 6); c.lane = tid & 63; c.r32 = c.lane & 31; c.hi = c.lane >> 5; return c;
}
template <bool HASV, class QK, class SM>
__device__ __forceinline__ void run_stream(const Ctx& c, const bf16* Kb, const bf16* Vb, int t0, int t1, QK&& qk, SM&& sm) {
    const int n = t1 - t0; if (n <= 0) return;
    const int lane = fresh_lane(), r32 = lane & 31, hi = lane >> 5; const unsigned lds0 = (unsigned)(uintptr_t)c.lds;
    const bf16* ks = Kb + ((8 * c.wid + (lane >> 3)) * 64 + (((lane & 7) ^ (((8 * c.wid + (lane >> 3)) >> 1) & 7)) << 3)); const bf16* vs = Vb + ((16 * (c.wid & 3) + (lane >> 2)) * 64 + (c.wid >> 2) * 32 + (lane & 3) * 8);
    const unsigned kdst = lds0 + c.wid * 1024, vdst = lds0 + 8192 + c.wid * 1024;
    const lds_cptr kp0 = (lds_cptr)c.lds + r32 * 128;
    const lds_cptr vp0 = (lds_cptr)c.lds + 8192 + ((lane >> 4) & 1) * 32 + (lane & 3) * 8 + (4 * hi + ((lane & 15) >> 2)) * 64;
#define ATT_ISSUE(t, so) do { if (ATT_ABL & 4) break; glds16(ks + (size_t)(t) * 4096, (unsigned)__builtin_amdgcn_readfirstlane(kdst + (so))); if (HASV) glds16(vs + (size_t)(t) * 4096, (unsigned)__builtin_amdgcn_readfirstlane(vdst + (so))); } while (0)
    ATT_ISSUE(t0, 0); if (n > 1) ATT_ISSUE(t0 + 1, SLOT);
    const bool late = ATT_STAGGER && __builtin_amdgcn_readfirstlane(c.wid) >= 4;
    f32x16 s0 = {}, s1 = {};
    int slot = 0, slotp = 3 * SLOT, slot2 = 2 * SLOT;
    if (!late) {
        for (int i = 0; i < n; ++i) {
            if (i + 1 < n) { if (HASV) ATT_WAIT_BAR(2); else ATT_WAIT_BAR(1); } else ATT_WAIT_BAR(0);
            if (i + 2 < n) ATT_ISSUE(t0 + i + 2, slot2);
            if (!(ATT_ABL & 1)) qk(t0 + i, kp0 + slot, s0, s1); if (!(ATT_ABL & 2)) sm(t0 + i, vp0 + slot, s0, s1);
            slot = (slot == 3 * SLOT) ? 0 : slot + SLOT; slot2 = (slot2 == 3 * SLOT) ? 0 : slot2 + SLOT;
        }
    } else {
        for (int i = 0; i < n; ++i) {
            if (i + 1 < n) { if (HASV) ATT_WAIT_BAR(2); else ATT_WAIT_BAR(1); } else ATT_WAIT_BAR(0);
            if (i + 2 < n) ATT_ISSUE(t0 + i + 2, slot2);
            if (i > 0 && !(ATT_ABL & 2)) sm(t0 + i - 1, vp0 + slotp, s0, s1);
            if (!(ATT_ABL & 1)) qk(t0 + i, kp0 + slot, s0, s1);
            slotp = slot; slot = (slot == 3 * SLOT) ? 0 : slot + SLOT; slot2 = (slot2 == 3 * SLOT) ? 0 : slot2 + SLOT;
        }
        if (!(ATT_ABL & 2)) sm(t0 + n - 1, vp0 + slotp, s0, s1);
    }
    asm volatile("s_waitcnt lgkmcnt(0)\n\ts_barrier" ::: "memory");
#undef ATT_ISSUE
}
template <class FN1, class FN2>
__device__ __forceinline__ void run_stream_pairs(const Ctx& c, const bf16* Kb, const bf16* Vb, int t0, int t1, FN1&& fn1, FN2&& fn2) {
    const int n = t1 - t0; if (n <= 0) return;
    const int lane = fresh_lane(), r32 = lane & 31, hi = lane >> 5; const unsigned lds0 = (unsigned)(uintptr_t)c.lds;
    const bf16* ks = Kb + ((8 * c.wid + (lane >> 3)) * 64 + (((lane & 7) ^ (((8 * c.wid + (lane >> 3)) >> 1) & 7)) << 3)); const bf16* vs = Vb + ((16 * (c.wid & 3) + (lane >> 2)) * 64 + (c.wid >> 2) * 32 + (lane & 3) * 8);
    const unsigned kdst = lds0 + c.wid * 1024, vdst = lds0 + 8192 + c.wid * 1024;
    const lds_cptr kp0 = (lds_cptr)c.lds + r32 * 128;
    const lds_cptr vp0 = (lds_cptr)c.lds + 8192 + ((lane >> 4) & 1) * 32 + (lane & 3) * 8 + (4 * hi + ((lane & 15) >> 2)) * 64;
#define ATT_ISSUE1(t, so) do { glds16(ks + (size_t)(t) * 4096, (unsigned)__builtin_amdgcn_readfirstlane(kdst + (so))); glds16(vs + (size_t)(t) * 4096, (unsigned)__builtin_amdgcn_readfirstlane(vdst + (so))); } while (0)
    ATT_ISSUE1(t0, 0); if (n > 1) ATT_ISSUE1(t0 + 1, SLOT);
    int base = 0;
    for (int i = 0; i < n; i += 2) {
        ATT_WAIT_BAR(0);
        const int nb = 2 * SLOT - base;
        if (i + 2 < n) ATT_ISSUE1(t0 + i + 2, nb); if (i + 3 < n) ATT_ISSUE1(t0 + i + 3, nb + SLOT);
        if (i + 1 < n) fn2(t0 + i, kp0 + base, vp0 + base, kp0 + base + SLOT, vp0 + base + SLOT); else fn1(t0 + i, kp0 + base, vp0 + base);
        base = nb;
    }
    asm volatile("s_waitcnt lgkmcnt(0)\n\ts_barrier" ::: "memory");
#undef ATT_ISSUE1
}
__device__ __forceinline__ void qk_tile(f32x16& s0, f32x16& s1, lds_cptr kp, const bf16x8 (&qr)[4]) {
    bf16x8 kf[8];
    { const int l = fresh_lane(), f = ((l & 31) >> 1) & 7, hi = l >> 5;
#pragma unroll
      for (int d0 = 0; d0 < 4; ++d0) { const int off = ((2 * d0 + hi) ^ f) << 4; kf[2 * d0] = *(const LAS bf16x8*)(kp + off); kf[2 * d0 + 1] = *(const LAS bf16x8*)(kp + 4096 + off); } }
    const f32x16 z = {};
    s0 = MFMA32(kf[0], qr[0], z); s1 = MFMA32(kf[1], qr[0], z);
#pragma unroll
    for (int d0 = 1; d0 < 4; ++d0) { s0 = MFMA32(kf[2 * d0], qr[d0], s0); s1 = MFMA32(kf[2 * d0 + 1], qr[d0], s1); }
}
template <bool MASK>
__device__ __forceinline__ void pv_tile(f32x16 (&o)[2], lds_cptr vp, const f32x16& p0, const f32x16& p1, unsigned mask) {
    if (ATT_ABL & 8) { o[0][0] += p0[0] + p1[5]; return; }
    u32x4 pw0 = {cvtpk(p0[0], p0[1]), cvtpk(p0[2], p0[3]), cvtpk(p0[4], p0[5]), cvtpk(p0[6], p0[7])}, pw1 = {cvtpk(p0[8], p0[9]), cvtpk(p0[10], p0[11]), cvtpk(p0[12], p0[13]), cvtpk(p0[14], p0[15])};
    u32x4 pw2 = {cvtpk(p1[0], p1[1]), cvtpk(p1[2], p1[3]), cvtpk(p1[4], p1[5]), cvtpk(p1[6], p1[7])}, pw3 = {cvtpk(p1[8], p1[9]), cvtpk(p1[10], p1[11]), cvtpk(p1[12], p1[13]), cvtpk(p1[14], p1[15])};
    if (MASK) { pw0 &= mask; pw1 &= mask; pw2 &= mask; pw3 &= mask; }
    if (ATT_ABL & 64) { o[0] = MFMA32(__builtin_bit_cast(bf16x8, pw0), __builtin_bit_cast(bf16x8, pw1), o[0]); o[1] = MFMA32(__builtin_bit_cast(bf16x8, pw2), __builtin_bit_cast(bf16x8, pw3), o[1]); return; }
    s16x4 vlo[8], vhi[8];
#pragma unroll
    for (int i = 0; i < 8; ++i) { vlo[i] = vtr(vp + ((i >> 2) * 4096 + (i & 3) * 1024)); vhi[i] = vtr(vp + ((i >> 2) * 4096 + (i & 3) * 1024 + 512)); }
#define ATT_VFR(i) (bf16x8){vlo[i][0], vlo[i][1], vlo[i][2], vlo[i][3], vhi[i][0], vhi[i][1], vhi[i][2], vhi[i][3]}
    o[0] = MFMA32(__builtin_bit_cast(bf16x8, pw0), ATT_VFR(0), o[0]); o[1] = MFMA32(__builtin_bit_cast(bf16x8, pw0), ATT_VFR(4), o[1]);
    o[0] = MFMA32(__builtin_bit_cast(bf16x8, pw1), ATT_VFR(1), o[0]); o[1] = MFMA32(__builtin_bit_cast(bf16x8, pw1), ATT_VFR(5), o[1]);
    o[0] = MFMA32(__builtin_bit_cast(bf16x8, pw2), ATT_VFR(2), o[0]); o[1] = MFMA32(__builtin_bit_cast(bf16x8, pw2), ATT_VFR(6), o[1]);
    o[0] = MFMA32(__builtin_bit_cast(bf16x8, pw3), ATT_VFR(3), o[0]); o[1] = MFMA32(__builtin_bit_cast(bf16x8, pw3), ATT_VFR(7), o[1]);
#undef ATT_VFR
}
#define ATT_SB() __builtin_amdgcn_sched_barrier(0)
struct KF { bf16x8 f[8]; };
struct VF { s16x4 lo[8], hi[8]; };
struct PW4 { u32x4 w0, w1, w2, w3; };
__device__ __forceinline__ void ld_k(KF& k, lds_cptr kp) {
    const int l = fresh_lane(), f = ((l & 31) >> 1) & 7, hi = l >> 5;
#pragma unroll
    for (int d0 = 0; d0 < 4; ++d0) { const int off = ((2 * d0 + hi) ^ f) << 4; k.f[2 * d0] = *(const LAS bf16x8*)(kp + off); k.f[2 * d0 + 1] = *(const LAS bf16x8*)(kp + 4096 + off); } }
__device__ __forceinline__ void qk_mfma(f32x16& s0, f32x16& s1, const KF& k, const bf16x8 (&qr)[4]) {
    const f32x16 z = {};
    s0 = MFMA32(k.f[0], qr[0], z); s1 = MFMA32(k.f[1], qr[0], z);
#pragma unroll
    for (int d0 = 1; d0 < 4; ++d0) { s0 = MFMA32(k.f[2 * d0], qr[d0], s0); s1 = MFMA32(k.f[2 * d0 + 1], qr[d0], s1); } }
__device__ __forceinline__ void ld_v(VF& v, lds_cptr vp) {
#pragma unroll
    for (int i = 0; i < 8; ++i) { v.lo[i] = vtr(vp + ((i >> 2) * 4096 + (i & 3) * 1024)); v.hi[i] = vtr(vp + ((i >> 2) * 4096 + (i & 3) * 1024 + 512)); } }
__device__ __forceinline__ PW4 pack4(const f32x16& p0, const f32x16& p1, unsigned mask) { PW4 w;
    w.w0 = (u32x4){cvtpk(p0[0], p0[1]), cvtpk(p0[2], p0[3]), cvtpk(p0[4], p0[5]), cvtpk(p0[6], p0[7])}; w.w1 = (u32x4){cvtpk(p0[8], p0[9]), cvtpk(p0[10], p0[11]), cvtpk(p0[12], p0[13]), cvtpk(p0[14], p0[15])};
    w.w2 = (u32x4){cvtpk(p1[0], p1[1]), cvtpk(p1[2], p1[3]), cvtpk(p1[4], p1[5]), cvtpk(p1[6], p1[7])}; w.w3 = (u32x4){cvtpk(p1[8], p1[9]), cvtpk(p1[10], p1[11]), cvtpk(p1[12], p1[13]), cvtpk(p1[14], p1[15])};
    w.w0 &= mask; w.w1 &= mask; w.w2 &= mask; w.w3 &= mask; return w; }
__device__ __forceinline__ void pv_mfma(f32x16 (&o)[2], const VF& v, const PW4& w) {
#define ATT_VF(i) (bf16x8){v.lo[i][0], v.lo[i][1], v.lo[i][2], v.lo[i][3], v.hi[i][0], v.hi[i][1], v.hi[i][2], v.hi[i][3]}
    o[0] = MFMA32(__builtin_bit_cast(bf16x8, w.w0), ATT_VF(0), o[0]); o[1] = MFMA32(__builtin_bit_cast(bf16x8, w.w0), ATT_VF(4), o[1]);
    o[0] = MFMA32(__builtin_bit_cast(bf16x8, w.w1), ATT_VF(1), o[0]); o[1] = MFMA32(__builtin_bit_cast(bf16x8, w.w1), ATT_VF(5), o[1]);
    o[0] = MFMA32(__builtin_bit_cast(bf16x8, w.w2), ATT_VF(2), o[0]); o[1] = MFMA32(__builtin_bit_cast(bf16x8, w.w2), ATT_VF(6), o[1]);
    o[0] = MFMA32(__builtin_bit_cast(bf16x8, w.w3), ATT_VF(3), o[0]); o[1] = MFMA32(__builtin_bit_cast(bf16x8, w.w3), ATT_VF(7), o[1]);
#undef ATT_VF
}
__device__ __forceinline__ float rowsum32(const f32x16& p0, const f32x16& p1) { if (ATT_ABL & 32) return p0[0]; float a = p0[0] + p1[0], b = p0[1] + p1[1];
#pragma unroll
    for (int r = 2; r < 16; r += 2) { a += p0[r]; asm volatile("" : "+v"(a)); b += p0[r + 1]; asm volatile("" : "+v"(b)); a += p1[r]; asm volatile("" : "+v"(a)); b += p1[r + 1]; asm volatile("" : "+v"(b)); }
    return a + b; }
__device__ __forceinline__ void hook_exp(f32x16& s0, f32x16& s1) {
    if (ATT_ABL & 16) return;
#pragma unroll
    for (int r = 0; r < 16; ++r) { s0[r] = __builtin_amdgcn_exp2f(s0[r]); s1[r] = __builtin_amdgcn_exp2f(s1[r]); } }
__device__ __forceinline__ void hook_near(f32x16& s0, f32x16& s1, int base, const LAS float* lut) {
    asm volatile("" : "+v"(base));
#pragma unroll
    for (int r = 0; r < 16; ++r) { const int d0 = base - ((r & 3) + 8 * (r >> 2)), d1 = d0 - 32;
        s0[r] = __builtin_amdgcn_exp2f(s0[r] + lut[min(max(d0, -1), 113) + 1]); s1[r] = __builtin_amdgcn_exp2f(s1[r] + lut[min(max(d1, -1), 113) + 1]); } }
__device__ __forceinline__ void hook_edge(f32x16& s0, f32x16& s1, int base, int win) {
    asm volatile("" : "+v"(base));
#pragma unroll
    for (int r = 0; r < 16; ++r) { const int d0 = base - ((r & 3) + 8 * (r >> 2)), d1 = d0 - 32;
        s0[r] = __builtin_amdgcn_exp2f(d0 < win ? s0[r] : -INFINITY); s1[r] = __builtin_amdgcn_exp2f(d1 < win ? s1[r] : -INFINITY); } }
__device__ __forceinline__ void hook_cmp(f32x16& s0, f32x16& s1, int nrel  , float cb) {
    asm volatile("" : "+v"(nrel));
#pragma unroll
    for (int r = 0; r < 16; ++r) { const int c0 = (r & 3) + 8 * (r >> 2);
        s0[r] = __builtin_amdgcn_exp2f(s0[r] + ((c0 <= nrel) ? cb : -INFINITY)); s1[r] = __builtin_amdgcn_exp2f(s1[r] + ((c0 + 32 <= nrel) ? cb : -INFINITY)); } }
__device__ __forceinline__ void row_factors(const Ctx& c, float f, float (&fr)[16]) {
    const int lane = fresh_lane(), r32 = lane & 31, hi = lane >> 5; LAS float* wsf = (LAS float*)(c.lds + LDS_WSF) + c.wid * 64;
    asm volatile("s_waitcnt lgkmcnt(0)" ::: "memory");
    if (hi == 0) wsf[r32] = f;
    asm volatile("s_waitcnt lgkmcnt(0)" ::: "memory");
#pragma unroll
    for (int r = 0; r < 16; ++r) fr[r] = wsf[(r & 3) + 8 * (r >> 2) + 4 * hi];
    asm volatile("s_waitcnt lgkmcnt(0)" ::: "memory");
}
__device__ __forceinline__ float pair_sum(float v) { auto rr = __builtin_amdgcn_permlane32_swap(__float_as_uint(v), __float_as_uint(v), false, false); return __uint_as_float(rr[0]) + __uint_as_float(rr[1]); }
template <class RowOff>
__device__ __forceinline__ void store_rows(const Ctx& c, const f32x16 (&o)[2], bf16* dst, RowOff&& rowoff) {
    LAS bf16* stg = (LAS bf16*)(c.lds + LDS_OST) + c.wid * 2048;
    const int lane = fresh_lane(), r32 = lane & 31, hi = lane >> 5;
#pragma unroll
    for (int r = 0; r < 16; ++r) { const int orow = (r & 3) + 8 * (r >> 2) + 4 * hi;
#pragma unroll
        for (int d0 = 0; d0 < 2; ++d0) stg[orow * 64 + d0 * 32 + r32] = (bf16)f2bf(o[d0][r]); }
    asm volatile("s_waitcnt lgkmcnt(0)" ::: "memory");
#pragma unroll
    for (int i = 0; i < 4; ++i) { const int row = i * 8 + (lane >> 3), ch = lane & 7; const u32x4 v = *(const LAS u32x4*)(stg + row * 64 + ch * 8); *(u32x4*)(dst + rowoff(row) + ch * 8) = v; }
    asm volatile("s_waitcnt lgkmcnt(0)" ::: "memory");
}
struct AttnPtrs { const bf16* qkv; const float* kmp; const float* gates; const bf16* kcmp; const bf16* vcmp; const float* rel_bias; bf16* mix; unsigned* selg; bf16* part_o; float* part_l; };

__device__ __forceinline__ void moba_kmean_frags(const AttnPtrs& P, int bh, int r32, int hi, bf16x8 (&kmf)[4]) {
    const float* kp = P.kmp + ((size_t)(bh * 32 + r32) * 2) * 64;
#pragma unroll
    for (int d0 = 0; d0 < 4; ++d0) { const f32x4 a0 = *(const f32x4*)(kp + d0 * 16 + hi * 8), a1 = *(const f32x4*)(kp + d0 * 16 + hi * 8 + 4), b0 = *(const f32x4*)(kp + 64 + d0 * 16 + hi * 8), b1 = *(const f32x4*)(kp + 64 + d0 * 16 + hi * 8 + 4);
        const f32x4 m0 = (a0 + b0) * (1.f / 256.f), m1 = (a1 + b1) * (1.f / 256.f);
        u32x4 w = {cvtpk(m0[0], m0[1]), cvtpk(m0[2], m0[3]), cvtpk(m1[0], m1[1]), cvtpk(m1[2], m1[3])}; kmf[d0] = __builtin_bit_cast(bf16x8, w); }
}
__device__ __forceinline__ unsigned moba_gate32(const bf16x8 (&kmf)[4], int i, const bf16x8 (&qr)[4], int hi) {
    unsigned selmask = 0u;
    if (i > 0) {
        f32x16 sg = {};
#pragma unroll
        for (int d0 = 0; d0 < 4; ++d0) sg = MFMA32(kmf[d0], qr[d0], sg);
        float v[16];
#pragma unroll
        for (int r = 0; r < 16; ++r) v[r] = ((r & 3) + 8 * (r >> 2) + 4 * hi < i) ? sg[r] : -INFINITY;
#pragma unroll
        for (int it = 0; it < 3; ++it) {
            float m = v[0]; int jb = 4 * hi;
#pragma unroll
            for (int r = 1; r < 16; ++r) { const int j = (r & 3) + 8 * (r >> 2) + 4 * hi; if (v[r] > m) { m = v[r]; jb = j; } }
            auto rm = __builtin_amdgcn_permlane32_swap(__float_as_uint(m), __float_as_uint(m), false, false);
            auto rj = __builtin_amdgcn_permlane32_swap((unsigned)jb, (unsigned)jb, false, false);
            const float mo = __uint_as_float(hi ? rm[0] : rm[1]); const int jo = (int)(hi ? rj[0] : rj[1]);
            const bool mine = (m > mo) || (m == mo && jb < jo);
            const float mw = mine ? m : mo; const int jw = mine ? jb : jo;
            if (mw > -INFINITY) { selmask |= 1u << jw;
#pragma unroll
                for (int r = 0; r < 16; ++r) if ((r & 3) + 8 * (r >> 2) + 4 * hi == jw) v[r] = -INFINITY; }
        }
    }
    return selmask;
}
__device__ __forceinline__ void moba_gate_phase(const AttnPtrs& P, int vcu, int G, int tid) {
    const int lane = tid & 63, r32 = lane & 31, hi = lane >> 5; const int wid = __builtin_amdgcn_readfirstlane(tid >> 6);
    for (int grp = vcu * 8 + wid; grp < 2048; grp += G * 8) { const int bh = grp >> 6;
        bf16x8 kmf[4]; moba_kmean_frags(P, bh, r32, hi, kmf);
        const bf16* QA = P.qkv + ((size_t)bh * SEQ) * 64;
#pragma unroll 2
        for (int k = 0; k < 4; ++k) { const int idx = (grp & 63) * 4 + k, i = idx >> 3, w = idx & 7; const int qpos = 256 * i + 32 * w + r32;
            bf16x8 qr[4];
#pragma unroll
            for (int d0 = 0; d0 < 4; ++d0) qr[d0] = *(const bf16x8*)(QA + (size_t)qpos * 64 + d0 * 16 + hi * 8);
            const unsigned m = moba_gate32(kmf, i, qr, hi);
            if (hi == 0) P.selg[(size_t)bh * SEQ + qpos] = m; } }
}
__device__ __forceinline__ void moba_past_item(const Ctx& c, const AttnPtrs& P, int b, int h, int j, int flags = 0) {
    const int bh = b * 8 + h, tid = threadIdx.x;
    const bf16* QA = P.qkv + ((size_t)bh * SEQ) * 64; const bf16* KA = QA + QKV_BIG + (size_t)256 * j * 64; const bf16* VA = QA + 2 * QKV_BIG + (size_t)256 * j * 64;
    const LAS float* lut = (const LAS float*)(c.lds + LDS_LUTG) + h * LUT_PITCH;
    { const int lane = fresh_lane(); const unsigned lds0 = (unsigned)(uintptr_t)c.lds;
      const bf16* ks = KA + ((8 * c.wid + (lane >> 3)) * 64 + (((lane & 7) ^ (((8 * c.wid + (lane >> 3)) >> 1) & 7)) << 3)); const bf16* vs = VA + ((16 * (c.wid & 3) + (lane >> 2)) * 64 + (c.wid >> 2) * 32 + (lane & 3) * 8);
#pragma unroll
      for (int tt = 0; tt < 4; ++tt) { glds16(ks + tt * 4096, (unsigned)__builtin_amdgcn_readfirstlane(lds0 + c.wid * 1024 + tt * SLOT)); glds16(vs + tt * 4096, (unsigned)__builtin_amdgcn_readfirstlane(lds0 + 8192 + c.wid * 1024 + tt * SLOT)); } }
    LAS unsigned short* list = (LAS unsigned short*)(c.lds + LDS_IMP);
    LAS unsigned* wcnt = (LAS unsigned*)(c.lds + LDS_MISC) + 8;
    const unsigned* sg = P.selg + (size_t)bh * SEQ;
    if (tid < 256) list[tid] = (unsigned short)((256 * j + tid) | (3 << 13));
    int total = 256;
    for (int base = (j + 1) * 256; base < SEQ; base += 2048) {
        const int q0 = base + 4 * tid; uint4 m4 = make_uint4(0u, 0u, 0u, 0u); if (q0 < SEQ) m4 = *(const uint4*)(sg + q0);
        const unsigned long long b0 = __ballot((m4.x >> j) & 1u), b1 = __ballot((m4.y >> j) & 1u), b2 = __ballot((m4.z >> j) & 1u), b3 = __ballot((m4.w >> j) & 1u);
        const int c0 = (int)__popcll(b0), c1 = (int)__popcll(b1), c2 = (int)__popcll(b2), c3 = (int)__popcll(b3);
        if ((tid & 63) == 0) wcnt[c.wid] = (unsigned)(c0 + c1 + c2 + c3);
        asm volatile("s_waitcnt vmcnt(0) lgkmcnt(0)\n\ts_barrier" ::: "memory");
        int off = total, tot = 0;
#pragma unroll
        for (int w = 0; w < 8; ++w) { const int v = (int)wcnt[w]; off += (w < c.wid) ? v : 0; tot += v; }
        const unsigned long long below = (1ull << (tid & 63)) - 1ull; const unsigned lowj = (1u << j) - 1u;
        if ((m4.x >> j) & 1u) list[off + __popcll(b0 & below)] = (unsigned short)((q0 + 0) | (__popc(m4.x & lowj) << 13)); off += c0;
        if ((m4.y >> j) & 1u) list[off + __popcll(b1 & below)] = (unsigned short)((q0 + 1) | (__popc(m4.y & lowj) << 13)); off += c1;
        if ((m4.z >> j) & 1u) list[off + __popcll(b2 & below)] = (unsigned short)((q0 + 2) | (__popc(m4.z & lowj) << 13)); off += c2;
        if ((m4.w >> j) & 1u) list[off + __popcll(b3 & below)] = (unsigned short)((q0 + 3) | (__popc(m4.w & lowj) << 13));
        total += tot;
        asm volatile("s_waitcnt lgkmcnt(0)\n\ts_barrier" ::: "memory");
    }
    total = __builtin_amdgcn_readfirstlane(total);
    { const int npad = (32 - (total & 31)) & 31; if (tid < npad) list[total + tid] = 0xFFFFu; }
    const int nchunks = (total + 31) >> 5;
    asm volatile("s_waitcnt vmcnt(0) lgkmcnt(0)\n\ts_barrier" ::: "memory");
    unsigned e_n = 0xFFFFu; bf16x8 qn[4];
    if (c.wid < nchunks) { const int l0 = fresh_lane(); e_n = list[32 * c.wid + (l0 & 31)]; const int q0 = (e_n != 0xFFFFu) ? (int)(e_n & 0x1FFFu) : SEQ - 1;
#pragma unroll
        for (int d0 = 0; d0 < 4; ++d0) qn[d0] = *(const bf16x8*)(QA + (size_t)q0 * 64 + d0 * 16 + (l0 >> 5) * 8); }
    if (!(flags & 64)) for (int ch = c.wid; ch < nchunks; ch += 8) {
        const int lane = fresh_lane(), r32 = lane & 31, hi = lane >> 5;
        const lds_cptr kp0 = (lds_cptr)c.lds + r32 * 128;
        const lds_cptr vp0 = (lds_cptr)c.lds + 8192 + ((lane >> 4) & 1) * 32 + (lane & 3) * 8 + (4 * hi + ((lane & 15) >> 2)) * 64;
        const unsigned e = e_n; const bool valid = e != 0xFFFFu; const int q = valid ? (int)(e & 0x1FFFu) : SEQ - 1;
        bf16x8 qr[4];
#pragma unroll
        for (int d0 = 0; d0 < 4; ++d0) qr[d0] = qn[d0];
        if (ch + 8 < nchunks) { e_n = list[32 * (ch + 8) + r32]; const int q1 = (e_n != 0xFFFFu) ? (int)(e_n & 0x1FFFu) : SEQ - 1;
#pragma unroll
            for (int d0 = 0; d0 < 4; ++d0) qn[d0] = *(const bf16x8*)(QA + (size_t)q1 * 64 + d0 * 16 + hi * 8); }
        const int ntt = (ch < 8) ? (ch >> 1) + 1 : 4;
        f32x16 o[2]; o[0] = f32x16{}; o[1] = f32x16{}; float l_reg = 0.f;
#pragma unroll 1
        for (int tt = 0; tt < ntt; ++tt) { f32x16 s0, s1; qk_tile(s0, s1, kp0 + tt * SLOT, qr);
            const int dq = q - (256 * j + 64 * tt);
            if (__any(valid && dq < 113 + 63)) hook_near(s0, s1, dq - 4 * hi, lut); else hook_exp(s0, s1);
            l_reg += rowsum32(s0, s1);
            pv_tile<false>(o, vp0 + tt * SLOT, s0, s1, 0u); }
        const float L = pair_sum(l_reg);
        if (hi == 0 && valid) P.part_l[((size_t)bh * SEQ + q) * 4 + (e >> 13)] = L;
        LAS bf16* stg = (LAS bf16*)(c.lds + LDS_OST) + c.wid * 2048;
#pragma unroll
        for (int r = 0; r < 16; ++r) { const int orow = (r & 3) + 8 * (r >> 2) + 4 * hi;
#pragma unroll
            for (int d0 = 0; d0 < 2; ++d0) stg[orow * 64 + d0 * 32 + r32] = (bf16)f2bf(o[d0][r]); }
        asm volatile("s_waitcnt lgkmcnt(0)" ::: "memory");
#pragma unroll
        for (int it = 0; it < 4; ++it) { const int row = it * 8 + (lane >> 3), chn = lane & 7; const unsigned e2 = list[32 * ch + row];
            const u32x4 v = *(const LAS u32x4*)(stg + row * 64 + chn * 8);
            if (e2 != 0xFFFFu) *(u32x4*)(P.part_o + (((size_t)bh * SEQ + (e2 & 0x1FFFu)) * 4 + (e2 >> 13)) * 64 + chn * 8) = v; }
        asm volatile("s_waitcnt lgkmcnt(0)" ::: "memory");
    }
    asm volatile("s_waitcnt lgkmcnt(0)\n\ts_barrier" ::: "memory");
}
__device__ __forceinline__ void moba_merge_pass(const AttnPtrs& P, int vcu, int G, int tid) {
    const int lane = tid & 63, h = lane >> 3, chn = lane & 7; const int wid = __builtin_amdgcn_readfirstlane(tid >> 6);
#pragma unroll 4
    for (int tok = vcu * 8 + wid; tok < TOK; tok += G * 8) { const int b = tok >> 13, q = tok & (SEQ - 1);
        const size_t qi = (size_t)(b * 8 + h) * SEQ + q; const int ns = __popc(P.selg[qi]);
        float Lt = P.part_l[qi * 4 + 3]; const u32x4 pw = *(const u32x4*)(P.part_o + (qi * 4 + 3) * 64 + chn * 8);
        f32x4 a0 = {__uint_as_float(pw.x << 16), __uint_as_float(pw.x & 0xffff0000u), __uint_as_float(pw.y << 16), __uint_as_float(pw.y & 0xffff0000u)};
        f32x4 a1 = {__uint_as_float(pw.z << 16), __uint_as_float(pw.z & 0xffff0000u), __uint_as_float(pw.w << 16), __uint_as_float(pw.w & 0xffff0000u)};
#pragma unroll
        for (int sidx = 0; sidx < 3; ++sidx) if (sidx < ns) { Lt += P.part_l[qi * 4 + sidx]; const u32x4 pv = *(const u32x4*)(P.part_o + (qi * 4 + sidx) * 64 + chn * 8);
            a0 += (f32x4){__uint_as_float(pv.x << 16), __uint_as_float(pv.x & 0xffff0000u), __uint_as_float(pv.y << 16), __uint_as_float(pv.y & 0xffff0000u)};
            a1 += (f32x4){__uint_as_float(pv.z << 16), __uint_as_float(pv.z & 0xffff0000u), __uint_as_float(pv.w << 16), __uint_as_float(pv.w & 0xffff0000u)}; }
        const float inv = 1.f / Lt; a0 *= inv; a1 *= inv;
        const u32x4 w = {cvtpk(a0[0], a0[1]), cvtpk(a0[2], a0[3]), cvtpk(a1[0], a1[1]), cvtpk(a1[2], a1[3])};
        *(u32x4*)(P.mix + (size_t)tok * DM + h * 64 + chn * 8) = w; }
}

__device__ __forceinline__ void nsa_item(const Ctx& c, const AttnPtrs& P, int b, int g, int ci, int flags = 0) {
    const int ql = 8 * c.wid + (c.r32 >> 2), rh = c.r32 & 3, qpos = 64 * ci + ql, hb = 4 * g + rh;
    const int qw0 = 64 * ci + 8 * c.wid;
    const bf16* QB = P.qkv + 3 * QKV_BIG + ((size_t)(b * 8 + hb) * SEQ) * 64;
    const bf16* KS = P.qkv + 4 * QKV_BIG + 2 * QKV_SMALL + ((size_t)(b * 2 + g) * SEQ) * 64; const bf16* VS = KS + QKV_SMALL; const bf16* KW = KS + 2 * QKV_SMALL; const bf16* VW = KS + 3 * QKV_SMALL;
    const bf16* KC = P.kcmp + (size_t)(b * 2 + g) * 512 * 64; const bf16* VC = P.vcmp + (size_t)(b * 2 + g) * 512 * 64;
    bf16x8 qr[4];
#pragma unroll
    for (int d0 = 0; d0 < 4; ++d0) qr[d0] = *(const bf16x8*)(QB + (size_t)qpos * 64 + d0 * 16 + c.hi * 8);
    asm volatile("" : "+v"(qr[0]), "+v"(qr[1]), "+v"(qr[2]), "+v"(qr[3]));
    const LAS float* lut = (const LAS float*)(c.lds + LDS_LUTG) + (8 + hb) * LUT_PITCH;
    LAS float* imp = (LAS float*)(c.lds + LDS_IMP);
    LAS unsigned* selm = (LAS unsigned*)(c.lds + LDS_SELM);
    f32x16 o[2]; float l_reg; float fr[16];
    LAS float* park = (LAS float*)(c.lds + LDS_OST) + c.wid * 1024 + c.lane;
    LAS float* park1 = (LAS float*)(c.lds + LDS_IMP) + c.wid * 1024 + c.lane;
    const int nct = (4 * ci + 3 + 63) >> 6;
    const int nlim = (qpos >= 31) ? ((qpos - 31) >> 4) : -1;
    LAS bf16* impt = (LAS bf16*)(c.lds + ((rh & 2) ? LDS_IMP : LDS_OST)) + ((rh & 2) ? IMP_REG1 : 0) + (rh & 1) * IMP_PLANE + ql * IMP_PITCH;
    l_reg = 0.f; o[0] = f32x16{}; o[1] = f32x16{};
    {
        float carry = 0.f;
        if (!(flags & 32)) run_stream<true>(c, KC, VC, 0, nct,
          [&](int t, lds_cptr kp, f32x16& s0, f32x16& s1) { qk_tile(s0, s1, kp, qr); },
          [&](int t, lds_cptr vp, f32x16& s0, f32x16& s1) {
            hook_cmp(s0, s1, nlim - 64 * t - 4 * c.hi, 0.f);
            l_reg += rowsum32(s0, s1);
#pragma unroll
            for (int half = 0; half < 2; ++half) {
                float g4[4], e[4];
#pragma unroll
                for (int a = 0; a < 4; ++a) { const float x0 = half ? s1[4 * a] : s0[4 * a], x1 = half ? s1[4 * a + 1] : s0[4 * a + 1], x2 = half ? s1[4 * a + 2] : s0[4 * a + 2], x3 = half ? s1[4 * a + 3] : s0[4 * a + 3];
                    g4[a] = (x0 + x1) + (x2 + x3); e[a] = x3; }
                float x[4];
#pragma unroll
                for (int a = 0; a < 4; ++a) { auto rr = __builtin_amdgcn_permlane32_swap(__float_as_uint(e[a]), __float_as_uint(e[a]), false, false); x[a] = __uint_as_float(c.hi ? rr[0] : rr[1]); }
                const int jb = 16 * t + 8 * half;
                float iv[4];
                if (c.hi) {
#pragma unroll
                    for (int a = 0; a < 4; ++a) iv[a] = g4[a] + x[a]; }
                else { iv[0] = g4[0] + carry; iv[1] = g4[1] + x[0]; iv[2] = g4[2] + x[1]; iv[3] = g4[3] + x[2]; carry = x[3]; }
#pragma unroll
                for (int a = 0; a < 4; ++a) impt[jb + 2 * a + c.hi] = (bf16)f2bf(iv[a]);
            }
            pv_tile<false>(o, vp, s0, s1, 0u);
        });
    }
    const float Lc = pair_sum(l_reg); const float invLc = Lc > 0.f ? 1.f / Lc : 0.f;
    { LAS float* wsfw = (LAS float*)(c.lds + LDS_WSF) + c.wid * 64; if (c.hi == 0) wsfw[32 + c.r32] = invLc; }
    const float* gp = P.gates + ((size_t)b * SEQ + qpos) * 24 + hb * 3; float g0 = gp[0], g1 = gp[1], g2 = gp[2];
    {
        asm volatile("s_waitcnt lgkmcnt(0)\n\ts_barrier" ::: "memory");
        const int fl = fresh_lane(); const int qq = 8 * c.wid + (fl >> 3), cc = fl & 7;
        unsigned m0 = 0u, m1 = 0u, m2w = 0u, m3 = 0u;
        if (ci <= 15 || (flags & 16)) { m0 = (ci >= 31) ? 0xffffffffu : ((2u << ci) - 1u); }
        else {
            unsigned v[16];
            const LAS float* il = (const LAS float*)(c.lds + LDS_WSF) + c.wid * 64 + 32 + 4 * (fl >> 3);
            const float i0 = il[0], i1 = il[1], i2 = il[2], i3 = il[3];
            const LAS bf16* ta = (const LAS bf16*)(c.lds + LDS_OST) + qq * IMP_PITCH; const LAS bf16* tb = (const LAS bf16*)(c.lds + LDS_IMP) + IMP_REG1 + qq * IMP_PITCH;
#pragma unroll
            for (int k = 0; k < 16; ++k) { const int j = cc + 8 * k;
                const float val = (bf2f(ta[j]) * i0 + bf2f(ta[IMP_PLANE + j]) * i1) + (bf2f(tb[j]) * i2 + bf2f(tb[IMP_PLANE + j]) * i3);
                v[k] = (j >= 1 && j <= ci - 2) ? ((__float_as_uint(val) & ~127u) | (unsigned)(127 - j)) : 0u; }
            for (int it = 0; it < 13; ++it) {
                unsigned m = v[0];
#pragma unroll
                for (int k = 1; k < 16; ++k) m = max(m, v[k]);
#pragma unroll
                for (int sft = 1; sft < 8; sft <<= 1) m = max(m, (unsigned)__shfl_xor((int)m, sft));
                if (m != 0u) { const int jb = 127 - (int)(m & 127u); const unsigned bit = 1u << (jb & 31); const int wsel = jb >> 5;
                    m0 |= (wsel == 0) ? bit : 0u; m1 |= (wsel == 1) ? bit : 0u; m2w |= (wsel == 2) ? bit : 0u; m3 |= (wsel == 3) ? bit : 0u;
#pragma unroll
                    for (int k = 0; k < 16; ++k) v[k] = (v[k] == m) ? 0u : v[k]; }
            }
            m0 |= 1u;
#pragma unroll
            for (int z = 0; z < 2; ++z) { const int jf = ci - z; const unsigned bit = 1u << (jf & 31); const int wsel = jf >> 5;
                m0 |= (wsel == 0) ? bit : 0u; m1 |= (wsel == 1) ? bit : 0u; m2w |= (wsel == 2) ? bit : 0u; m3 |= (wsel == 3) ? bit : 0u; }
        }
        if (cc == 0) { selm[qq * 4 + 0] = m0; selm[qq * 4 + 1] = m1; selm[qq * 4 + 2] = m2w; selm[qq * 4 + 3] = m3; }
        asm volatile("s_waitcnt lgkmcnt(0)\n\ts_barrier" ::: "memory");
    }
    asm volatile("" : "+v"(g0), "+v"(g1), "+v"(g2));
    row_factors(c, g0 * invLc, fr);
#pragma unroll
    for (int r = 0; r < 16; ++r) { park[r * 64] = o[0][r] * fr[r]; park1[r * 64] = o[1][r] * fr[r]; }
    {
        const unsigned w0 = selm[ql * 4 + 0], w1 = selm[ql * 4 + 1], w2 = selm[ql * 4 + 2], w3 = selm[ql * 4 + 3];
        o[0] = f32x16{}; o[1] = f32x16{}; l_reg = 0.f;
        auto sel_pred = [&](int t) -> bool { const unsigned wsel = (t < 32) ? w0 : (t < 64) ? w1 : (t < 96) ? w2 : w3; return (wsel >> (t & 31)) & 1u; };
        auto sel_one = [&](int t, lds_cptr kp, lds_cptr vp) { const bool pred = sel_pred(t); if (!__any(pred)) return; const int key0 = 64 * t;
            f32x16 s0, s1; qk_tile(s0, s1, kp, qr);
            if (qw0 - key0 - 63 >= 113) { hook_exp(s0, s1); const float rs = rowsum32(s0, s1); l_reg += pred ? rs : 0.f;
                if (__all(pred)) pv_tile<false>(o, vp, s0, s1, 0u); else pv_tile<true>(o, vp, s0, s1, pred ? 0xffffffffu : 0u); }
            else { hook_near(s0, s1, qpos - key0 - 4 * c.hi, lut); const float rs = rowsum32(s0, s1); l_reg += pred ? rs : 0.f;
                if (__all(pred)) pv_tile<false>(o, vp, s0, s1, 0u); else pv_tile<true>(o, vp, s0, s1, pred ? 0xffffffffu : 0u); } };
        if (!(flags & 4)) run_stream_pairs(c, KS, VS, 0, ci + 1, sel_one,
            [&](int t, lds_cptr kpA, lds_cptr vpA, lds_cptr kpB, lds_cptr vpB) {
                if (qw0 - 64 * (t + 1) - 63 >= 113) {
                    const bool pa = sel_pred(t), pb = sel_pred(t + 1);
                    const bool xa = __any(pa), xb = __any(pb);
                    if (!xa && !xb) return;
                    if (!xb) { sel_one(t, kpA, vpA); return; }
                    if (!xa) { sel_one(t + 1, kpB, vpB); return; }
                    KF kA, kB; ld_k(kA, kpA); ATT_SB();
                    f32x16 a0, a1, b0, b1; qk_mfma(a0, a1, kA, qr); ATT_SB();
                    VF vA, vB; ld_k(kB, kpB); ld_v(vA, vpA); ATT_SB();
                    qk_mfma(b0, b1, kB, qr); hook_exp(a0, a1);
                    const float ra = rowsum32(a0, a1); const PW4 wa = pack4(a0, a1, pa ? 0xffffffffu : 0u); ATT_SB();
                    ld_v(vB, vpB); ATT_SB();
                    pv_mfma(o, vA, wa); hook_exp(b0, b1);
                    const float rb = rowsum32(b0, b1); const PW4 wb = pack4(b0, b1, pb ? 0xffffffffu : 0u); l_reg += (pa ? ra : 0.f) + (pb ? rb : 0.f); ATT_SB();
                    pv_mfma(o, vB, wb);
                } else { sel_one(t, kpA, vpA); sel_one(t + 1, kpB, vpB); } });
        const float Ls = pair_sum(l_reg);
        row_factors(c, g1 / Ls, fr);
#pragma unroll
        for (int r = 0; r < 16; ++r) { park[r * 64] += o[0][r] * fr[r]; park1[r * 64] += o[1][r] * fr[r]; }
    }
    {
        o[0] = f32x16{}; o[1] = f32x16{}; l_reg = 0.f;
        if (!(flags & 8)) run_stream<true>(c, KW, VW, ci >= 8 ? ci - 8 : 0, ci + 1,
            [&](int t, lds_cptr kp, f32x16& s0, f32x16& s1) { qk_tile(s0, s1, kp, qr); },
            [&](int t, lds_cptr vp, f32x16& s0, f32x16& s1) { const int key0 = 64 * t;
                if (qw0 - key0 - 63 < 113) hook_near(s0, s1, qpos - key0 - 4 * c.hi, lut); else if (qw0 + 7 - key0 >= 512) hook_edge(s0, s1, qpos - key0 - 4 * c.hi, 512); else hook_exp(s0, s1);
                l_reg += rowsum32(s0, s1);
                pv_tile<false>(o, vp, s0, s1, 0u); });
        const float Lw = pair_sum(l_reg);
        row_factors(c, g2 / Lw, fr);
#pragma unroll
        for (int r = 0; r < 16; ++r) { o[0][r] = park[r * 64] + o[0][r] * fr[r]; o[1][r] = park1[r * 64] + o[1][r] * fr[r]; }
        asm volatile("s_waitcnt lgkmcnt(0)" ::: "memory");
    }
    bf16* dst = P.mix + ((size_t)b * SEQ + 64 * ci + 8 * c.wid) * DM + 512 + g * 256;
    store_rows(c, o, dst, [](int row) { return (size_t)(row >> 2) * DM + (row & 3) * 64; });
    asm volatile("s_waitcnt lgkmcnt(0)\n\ts_barrier" ::: "memory");
}

__device__ __forceinline__ void attn_phase(LAS unsigned char* lds, const AttnPtrs& P, unsigned* qcounter, int flags) {
    Ctx c = make_ctx(lds, threadIdx.x);
    LAS unsigned* misc = (LAS unsigned*)(c.lds + LDS_MISC);
    { LAS float* lutg = (LAS float*)(c.lds + LDS_LUTG);
      for (int idx = threadIdx.x; idx < 16 * 115; idx += NTHREADS) { const int hh = idx / 115, d = idx % 115;
          lutg[hh * LUT_PITCH + d] = (d == 0) ? -INFINITY : (P.rel_bias[t5_bucket(d - 1) * 16 + hh] - P.rel_bias[31 * 16 + hh]) * LOG2E; }
      asm volatile("s_waitcnt vmcnt(0) lgkmcnt(0)\n\ts_barrier" ::: "memory"); }
    for (;;) {
        if (threadIdx.x == 0) misc[0] = __hip_atomic_fetch_add(qcounter, 1u, __ATOMIC_RELAXED, __HIP_MEMORY_SCOPE_AGENT);
        asm volatile("s_waitcnt vmcnt(0) lgkmcnt(0)\n\ts_barrier" ::: "memory");
        const unsigned k = misc[0];
        asm volatile("s_waitcnt lgkmcnt(0)\n\ts_barrier" ::: "memory");
        if (k >= 2048u) break;
        const bool is_mp = k >= 512u && k < 1536u;
        if (flags & (is_mp ? 2 : 1)) continue;
        if (k < 512u) { const int s_ = 127 - (int)(k >> 3), bg = k & 7; nsa_item(c, P, bg >> 1, bg & 1, s_, flags); }
        else if (k < 1536u) { const int kk = (int)k - 512, j = kk >> 5, bh = kk & 31; moba_past_item(c, P, bh >> 3, bh & 7, j, flags); }
        else { const int kk = (int)k - 1536; const int s_ = 63 - (kk >> 3), bg = kk & 7; nsa_item(c, P, bg >> 1, bg & 1, s_, flags); }
    }
}
#undef MFMA32
#undef ATT_WAIT_BAR
}
namespace cmpr {
using bf16x8 = __attribute__((ext_vector_type(8))) short;
using f32x16 = __attribute__((ext_vector_type(16))) float;
constexpr int HID_PITCH = 528;
__device__ __forceinline__ float gelu_tanh(float v) { const float u = fminf(fmaxf(0.7978845608028654f * (v + 0.044715f * v * v * v), -15.f), 15.f); const float e = __expf(2.f * u); return 0.5f * v * (1.f + (e - 1.f) / (e + 1.f)); }
__device__ __forceinline__ void compress_unit(LAS unsigned char* lds, int unit, const bf16* qkv, const bf16* w1k, const bf16* w1v, const bf16* w2k, const bf16* w2v, const float* cbp, const float* kncmp, bf16* kcmp, bf16* vcmp) {
    const int tid = threadIdx.x, lane = tid & 63, r32 = lane & 31, hi = lane >> 5; const int wid = __builtin_amdgcn_readfirstlane(tid >> 6);
    const int kv = unit & 1, u = (unit >> 1) & 15, bg = unit >> 5;
    const bf16* src = qkv + 4 * QKV_BIG + (kv ? QKV_SMALL : 0) + (size_t)bg * SEQ * 64;
    const bf16* w1 = kv ? w1v : w1k; const bf16* w2 = kv ? w2v : w2k;
    const int n0 = 32 * u;
    { const bf16* sp = src + (size_t)16 * n0 * 64;
      for (int ch = tid; ch < 4224; ch += NTHREADS) { v4u v = {0u, 0u, 0u, 0u}; if (16 * n0 + (ch >> 3) < SEQ) v = *(const GAS v4u*)(sp + (size_t)ch * 8);
          *(LAS v4u*)(lds + ((ch ^ ((ch >> 7) & 15)) << 4)) = v; } }
    asm volatile("s_waitcnt vmcnt(0) lgkmcnt(0)\n\ts_barrier" ::: "memory");
    const bf16* bp = w1 + ((size_t)wid * 64 + lane) * 8;
    f32x16 acc = {};
#pragma unroll 16
    for (int kk = 0; kk < 128; ++kk) { const int lc = r32 * 128 + 2 * kk + hi; const bf16x8 a = *(const LAS bf16x8*)(lds + ((lc ^ ((lc >> 7) & 15)) << 4)), bfr = *(const bf16x8*)(bp + (size_t)kk * 4096); acc = __builtin_amdgcn_mfma_f32_32x32x16_bf16(a, bfr, acc, 0, 0, 0); }
    float cb = 0.f;
#pragma unroll 8
    for (int ic = 0; ic < 32; ++ic) cb += cbp[(ic * 2 + kv) * 256 + 32 * wid + r32];
    LAS unsigned char* hidL = lds + 69632;
#pragma unroll
    for (int r = 0; r < 16; ++r) { const int n = (r & 3) + 8 * (r >> 2) + 4 * hi; *(LAS bf16*)(hidL + n * HID_PITCH + (32 * wid + r32) * 2) = (bf16)f2bf(gelu_tanh(acc[r] + cb)); }
    asm volatile("s_waitcnt lgkmcnt(0)\n\ts_barrier" ::: "memory");
    if (wid == 0) {
        f32x16 o0 = {}, o1 = {};
#pragma unroll 4
        for (int kk = 0; kk < 16; ++kk) { const bf16x8 hb = *(const LAS bf16x8*)(hidL + r32 * HID_PITCH + (16 * kk + 8 * hi) * 2);
            const bf16x8 a0 = *(const bf16x8*)(w2 + (size_t)r32 * 256 + 16 * kk + 8 * hi), a1 = *(const bf16x8*)(w2 + (size_t)(32 + r32) * 256 + 16 * kk + 8 * hi);
            o0 = __builtin_amdgcn_mfma_f32_32x32x16_bf16(a0, hb, o0, 0, 0, 0); o1 = __builtin_amdgcn_mfma_f32_32x32x16_bf16(a1, hb, o1, 0, 0, 0); }
        float rs = 1.f;
        if (!kv) { float ss = 0.f;
#pragma unroll
            for (int r = 0; r < 16; ++r) ss += o0[r] * o0[r] + o1[r] * o1[r];
            auto rr = __builtin_amdgcn_permlane32_swap(__float_as_uint(ss), __float_as_uint(ss), false, false); ss = __uint_as_float(rr[0]) + __uint_as_float(rr[1]);
            rs = rsqrtf(ss * (1.f / 64.f) + 1e-6f); }
        const int n = n0 + r32; bf16* dst = (kv ? vcmp : kcmp) + ((size_t)bg * 512 + n) * 64;
#pragma unroll
        for (int r = 0; r < 16; ++r) { const int d = (r & 3) + 8 * (r >> 2) + 4 * hi;
            float v0 = o0[r] * rs, v1 = o1[r] * rs; if (!kv) { v0 *= kncmp[d]; v1 *= kncmp[d + 32]; }
            if (n >= NCMP) { v0 = 0.f; v1 = 0.f; }
            dst[d] = (bf16)f2bf(v0); dst[d + 32] = (bf16)f2bf(v1); }
    }
    asm volatile("s_waitcnt lgkmcnt(0)\n\ts_barrier" ::: "memory");
}
}
__global__ void __launch_bounds__(NTHREADS, 2) mk_fwd(Args a) {
    extern __shared__ __attribute__((aligned(16))) unsigned char lds[];
    Frame F;
    F.lds = (LAS unsigned char*)lds;
    F.tid = threadIdx.x; F.lane = F.tid & 63; F.wave = __builtin_amdgcn_readfirstlane(F.tid >> 6);
    F.G = gridDim.x; { const int bx = blockIdx.x; F.vcu = (F.G % 8 == 0) ? (bx % 8) * (F.G / 8) + bx / 8 : bx; }
    cg::grid_group grid = cg::this_grid();
    volatile LAS unsigned* xst = (volatile LAS unsigned*)(F.lds + 147424);
    if (F.tid < 8) xst[F.tid] = 0u;
    __syncthreads();
    const XcdBarrier xbar = xcd_barrier_post((unsigned*)(a.ws + WS_CTL) + 4096, xst);
    unsigned char* ws = a.ws;
    const int lo = a.ph_lo, hi = a.ph_hi & 0xff; const int tflags = a.ph_hi >> 8; (void)tflags;
    const att::AttnPtrs P{(const bf16*)(ws + WS_QKV), (const float*)(ws + WS_KMP), (const float*)(ws + WS_GATES), (const bf16*)(ws + WS_KCMP), (const bf16*)(ws + WS_VCMP), a.in[2], (bf16*)(ws + WS_MIX),
                          (unsigned*)(ws + WS_SELG), (bf16*)(ws + WS_PARTO), (float*)(ws + WS_PARTL)};
#define IN(k) (lo <= (k) && (k) < hi)
#define SEAM(k) do { if (IN(k) && IN((k) + 1)) { if ((k) == 0) grid.sync(); else xcd_barrier(xbar); } } while (0)
    if (IN(0)) { phase_prologue_a(F, a); } SEAM(0);
    if (IN(1)) { phase_prologue_b(F, a); } SEAM(1);
    if (IN(2)) {
        pg8::Gemm g{(const pg8::bf16_t*)(ws + WS_H), (const pg8::bf16_t*)(ws + WS_WIN), TOK, NIN_PAD, DM}; pg8::StaticOrder S; S.init(TOK, NIN_PAD, F.G, (int)blockIdx.x);
        pg8::EpiInProj E{(pg8::bf16_t*)(ws + WS_QKV), (float*)(ws + WS_GATES), (float*)(ws + WS_KMP), a.in[7], a.in[8], a.in[9], a.in[11], a.in[12]};
        pg8::gemm_phase<pg8::EpiInProj, pg8::StaticOrder, true, true>(F.lds, g, S, E);
    } SEAM(2);
    if (IN(3)) {
        if (!(tflags & 1)) att::moba_gate_phase(P, F.vcu, F.G, F.tid);
        if (!(tflags & 2)) for (int unit = F.vcu; unit < 256; unit += F.G)
            cmpr::compress_unit(F.lds, unit, (const bf16*)(ws + WS_QKV), (const bf16*)(ws + WS_W1K), (const bf16*)(ws + WS_W1V), (const bf16*)(ws + WS_W2K), (const bf16*)(ws + WS_W2V),
                                (const float*)(ws + WS_CBP), a.in[10], (bf16*)(ws + WS_KCMP), (bf16*)(ws + WS_VCMP));
    } SEAM(3);
    if (IN(4)) {
#if HYBRID == 3
        att::attn_phase(F.lds, P, (unsigned*)(ws + WS_CTL) + 64, tflags);
#else
        att::attn_phase(F.lds, P, (unsigned*)(ws + WS_CTL) + 64, 0);
#endif
    } SEAM(4);
    if (IN(5)) { att::moba_merge_pass(P, F.vcu, F.G, F.tid); } SEAM(5);
    if (IN(6)) {
        pg8::Gemm g{(const pg8::bf16_t*)(ws + WS_MIX), (const pg8::bf16_t*)(ws + WS_WOUT), TOK, DM, DM}; pg8::StaticOrder S; S.init(TOK, DM, F.G, (int)blockIdx.x);
        pg8::EpiOutProj E{(pg8::bf16_t*)(ws + WS_Y), (const float*)(ws + WS_MOD) + 2 * DM};
        pg8::gemm_phase<pg8::EpiOutProj, pg8::StaticOrder, true, true>(F.lds, g, S, E);
    } SEAM(6);
    if (IN(7)) { phase_norm2(F, a); } SEAM(7);
    if (IN(8)) {
        pg8::Gemm g{(const pg8::bf16_t*)(ws + WS_H), (const pg8::bf16_t*)(ws + WS_WGU), TOK, 2 * FF, DM}; pg8::StaticOrder S; S.init(TOK, 2 * FF, F.G, (int)blockIdx.x);
        pg8::EpiGateUp E{(pg8::bf16_t*)(ws + WS_ACT)};
        pg8::gemm_phase<pg8::EpiGateUp, pg8::StaticOrder, true, true>(F.lds, g, S, E);
    } SEAM(8);
    if (IN(9)) {
        pg8::Gemm g{(const pg8::bf16_t*)(ws + WS_ACT), (const pg8::bf16_t*)(ws + WS_WDN), TOK, DM, FF}; pg8::StaticOrder S; S.init(TOK, DM, F.G, (int)blockIdx.x);
        pg8::EpiDown E{a.in[0], (const pg8::bf16_t*)(ws + WS_Y), a.out, (const float*)(ws + WS_MOD) + 5 * DM};
        pg8::gemm_phase<pg8::EpiDown, pg8::StaticOrder, true, true>(F.lds, g, S, E);
    }
#undef IN
#undef SEAM
}

static void launch_phases(const Args& base, int lo, int hi, int grid, hipStream_t stream, int flags = 0) {
    Args a = base; a.ph_lo = lo; a.ph_hi = hi | (flags << 8);
    if (hi - lo > 1) { void* args[] = {&a}; (void)hipLaunchCooperativeKernel((const void*)mk_fwd, dim3(grid), dim3(NTHREADS), args, LDS_BYTES, stream); }
    else hipLaunchKernelGGL(mk_fwd, dim3(grid), dim3(NTHREADS), LDS_BYTES, stream, a);
}
extern "C" void kernel_launch(void* const* d_in, const int* in_sizes, int n_in, void* d_out, int out_size, void* d_ws, size_t ws_size, hipStream_t stream) {
    static int grid = 0;
    if (grid == 0) {
        int dev = 0, cus = 0, per_cu = 0;
        if (n_in != 23 || ws_size < 480 * MiB || hipGetDevice(&dev) != hipSuccess || hipDeviceGetAttribute(&cus, hipDeviceAttributeMultiprocessorCount, dev) != hipSuccess) { grid = -1; return; }
        if (hipFuncSetAttribute((const void*)mk_fwd, hipFuncAttributeMaxDynamicSharedMemorySize, LDS_BYTES) != hipSuccess) { grid = -1; return; }
        if (hipOccupancyMaxActiveBlocksPerMultiprocessor(&per_cu, (const void*)mk_fwd, NTHREADS, LDS_BYTES) != hipSuccess || per_cu < 1) { grid = -1; return; }
        grid = cus;
    }
    if (grid < 0) return;
    (void)hipMemsetAsync((char*)d_ws + WS_CTL, 0, CTL_ZERO_BYTES, stream);
    Args a{};
    for (int i = 0; i < 23; ++i) a.in[i] = (const float*)d_in[i];
    a.out = (float*)d_out; a.ws = (unsigned char*)d_ws;
    unsigned char* ws = (unsigned char*)d_ws;
#if HYBRID == 1
    launch_phases(a, 0, 1, grid, stream); launch_phases(a, 1, 2, grid, stream); launch_phases(a, 2, 3, grid, stream);
    const bf16* qkv = (const bf16*)(ws + WS_QKV); bf16* mix = (bf16*)(ws + WS_MIX); bf16* kcmp = (bf16*)(ws + WS_KCMP); bf16* vcmp = (bf16*)(ws + WS_VCMP);
    int* sel = (int*)(ws + 344 * MiB); float* obuf = (float*)(ws + 348 * MiB); const float* gates = (const float*)(ws + WS_GATES);
    nq::k_compress<<<dim3(4 * 2 * 512, 2), 256, 0, stream>>>(qkv, a.in[13], a.in[14], a.in[15], a.in[16], a.in[17], a.in[18], a.in[10], kcmp, vcmp);
    nq::k_moba<<<4 * 8 * SEQ / 4, 256, 0, stream>>>(qkv, (const float*)(ws + WS_KMP), a.in[2], mix);
    nq::k_nsa_cmp<<<4 * 2 * SEQ, 256, 0, stream>>>(qkv, kcmp, vcmp, gates, obuf, sel);
    nq::k_nsa_sel<<<4 * 2 * SEQ, 256, 0, stream>>>(qkv, sel, a.in[2], gates, obuf);
    nq::k_nsa_win<<<4 * 2 * SEQ, 256, 0, stream>>>(qkv, a.in[2], gates, obuf, mix);
    launch_phases(a, 5, 6, grid, stream); launch_phases(a, 6, 7, grid, stream); launch_phases(a, 7, 8, grid, stream); launch_phases(a, 8, 9, grid, stream);
#elif HYBRID == 2
    launch_phases(a, 0, 1, grid, stream); launch_phases(a, 1, 2, grid, stream); launch_phases(a, 2, 3, grid, stream);
    nq::k_compress<<<dim3(4 * 2 * 512, 2), 256, 0, stream>>>((const bf16*)(ws + WS_QKV), a.in[13], a.in[14], a.in[15], a.in[16], a.in[17], a.in[18], a.in[10], (bf16*)(ws + WS_KCMP), (bf16*)(ws + WS_VCMP));
    launch_phases(a, 4, 5, grid, stream);
    launch_phases(a, 5, 6, grid, stream); launch_phases(a, 6, 7, grid, stream); launch_phases(a, 7, 8, grid, stream); launch_phases(a, 8, 9, grid, stream);
#elif HYBRID == 3
    for (int p = 0; p < N_PHASES; ++p) {
#if defined(TIME_PHASE)
        if (p == TIME_PHASE) { for (int r = 0; r < TIME_REPS; ++r) { launch_phases(a, p, p + 1, grid, stream, TIME_FLAGS); (void)hipMemsetAsync((char*)d_ws + WS_CTL, 0, CTL_ZERO_BYTES, stream); } }
#endif
        launch_phases(a, p, p + 1, grid, stream);
#if defined(ABL_REPS)
        if (p == 3) { static bool once = false; if (!once) { once = true; (void)hipFuncSetAttribute((const void*)k_attn_abl, hipFuncAttributeMaxDynamicSharedMemorySize, LDS_BYTES); }
            for (int r = 0; r < ABL_REPS; ++r) { (void)hipMemsetAsync((char*)d_ws + WS_CTL + 512, 0, 4, stream); hipLaunchKernelGGL(k_attn_abl, dim3(grid), dim3(NTHREADS), LDS_BYTES, stream, a); } }
#endif
    }
#else
    launch_phases(a, 0, N_PHASES, grid, stream);
#endif
}
```

```cpp
#include <hip/hip_runtime.h>
#include <hip/hip_cooperative_groups.h>
#include <cstdint>
#include <cstdio>
namespace cg = cooperative_groups;
#define HYBRID 0
namespace pg8 {
#define PG8_LAS __attribute__((address_space(3)))
typedef unsigned short bf16_t;
typedef short bf16x8 __attribute__((ext_vector_type(8)));
typedef float f32x4 __attribute__((ext_vector_type(4)));
typedef unsigned u32x4 __attribute__((ext_vector_type(4)));
constexpr int BM = 256, BK = 64, HALF = 128, HTB = HALF * BK * 2  , STAGE_BYTES = 8 * HTB, NXCD = 8, WGM = 8;

__host__ __device__ __forceinline__ int lds_byte(int r, int c) { const int st = (r >> 4) * 2 + (c >> 5), rr = r & 15, cc = c & 31, ob = rr * 64 + cc * 2; return st * 1024 + (ob ^ (((ob >> 9) & 1) << 5)); }
__host__ __device__ __forceinline__ void stage_rc(int b, int& R, int& C) { const int st = b / 1024, sb = b % 1024, swz = sb ^ (((sb >> 9) & 1) << 5); R = (st >> 1) * 16 + swz / 64; C = (st & 1) * 32 + (swz % 64) / 2; }
__host__ __device__ __forceinline__ int perm32(int rho) { const int n = rho >> 4, i = rho & 15; return 8 * (i >> 2) + 4 * n + (i & 3); }

struct Unit { int pm, pn; };
struct Gemm { const bf16_t* A; const bf16_t* Bt; int M, N, K; };

struct StaticOrder {
    int nM, nN, nwg, G, c;
    __host__ __device__ void init(int M, int N, int G_, int c_) { nM = M / BM; nN = N / BM; nwg = nM * nN; G = G_; c = c_; }
    __host__ __device__ bool next(int i, Unit& u) const {
        const long L = (long)i * G + c; if (L >= nwg) return false;
        int wgid = (int)L; { const int q = nwg / NXCD, r = nwg % NXCD, xcd = wgid % NXCD, off = wgid / NXCD; wgid = (xcd < r ? xcd * (q + 1) : r * (q + 1) + (xcd - r) * q) + off; }
        const int nig = WGM * nN, gid = wgid / nig, fm = gid * WGM, gsz = (nM - fm) < WGM ? (nM - fm) : WGM;
        u.pm = fm + ((wgid % nig) % gsz); u.pn = (wgid % nig) / gsz; return true;
    }
    __device__ __forceinline__ void a_ready(const Unit&) const {}
    __device__ __forceinline__ void done(const Unit&) const {}
};

__device__ __forceinline__ unsigned cvt_pk_bf16(float lo, float hi) { unsigned r; asm volatile("v_cvt_pk_bf16_f32 %0, %1, %2" : "=v"(r) : "v"(lo), "v"(hi)); return r; }
typedef float f32x2 __attribute__((ext_vector_type(2)));
template <class Epi, class Sched, bool ALIGN_EPI = false, bool SP2 = false>
__device__ __forceinline__ void gemm_phase(PG8_LAS unsigned char* lds, const Gemm g, const Sched& S, const Epi& E) {
    const int tid = threadIdx.x, wid = __builtin_amdgcn_readfirstlane(tid >> 6), lane = tid & 63, wr = wid >> 2, wc = wid & 3, fr = lane & 15, fq = lane >> 4;
    const int K = g.K, nt = K / BK;
    unsigned voffA[2], voffB[2];
#pragma unroll
    for (int i = 0; i < 2; ++i) { int R, C; stage_rc(tid * 16 + i * 8192, R, C); const int Rb = Epi::PERM ? ((R & ~31) + perm32(R & 31)) : R;
        voffA[i] = (unsigned)(R * K + C) * 2u; voffB[i] = (unsigned)(Rb * K + C) * 2u; }
    const size_t kstep = (size_t)(BK * 2);
    const size_t hstep = (size_t)HALF * K * 2;
    const size_t tstep = 2 * hstep;
    const unsigned ldsw = (unsigned)wid * 1024u;
    const int aoff = lds_byte(wr * 64 + fr, fq * 8), boff = lds_byte(wc * 32 + fr, fq * 8);
#define PG8_SA(b, h) (((b) * 2 + (h)) * HTB)
#define PG8_SB(b, h) ((4 + (b) * 2 + (h)) * HTB)
#define PG8_STAGE(bufoff, gbase, voff) do { _Pragma("unroll") for (int _i = 0; _i < 2; ++_i) \
        __builtin_amdgcn_global_load_lds((const unsigned*)((const char*)(gbase) + (voff)[_i]), (PG8_LAS unsigned*)(lds + (bufoff) + ldsw + _i * 8192), 16, 0, 0); } while (0)
#define PG8_LDA(dst, b, h) do { _Pragma("unroll") for (int m = 0; m < 4; ++m) _Pragma("unroll") for (int k = 0; k < 2; ++k) dst[m][k] = *(const PG8_LAS bf16x8*)(lds + PG8_SA(b, h) + aoff + m * 2048 + k * 1024); } while (0)
#define PG8_LDB(dst, b, h) do { _Pragma("unroll") for (int n = 0; n < 2; ++n) _Pragma("unroll") for (int k = 0; k < 2; ++k) dst[n][k] = *(const PG8_LAS bf16x8*)(lds + PG8_SB(b, h) + boff + n * 2048 + k * 1024); } while (0)
#define PG8_MMA(ai, bj, At, Bt) do { __builtin_amdgcn_s_setprio(1); _Pragma("unroll") for (int m = 0; m < 4; ++m) _Pragma("unroll") for (int n = 0; n < 2; ++n) _Pragma("unroll") for (int k = 0; k < 2; ++k) \
        acc[ai][bj][m][n] = __builtin_amdgcn_mfma_f32_16x16x32_bf16(Bt[n][k], At[m][k], acc[ai][bj][m][n], 0, 0, 0); __builtin_amdgcn_s_setprio(0); } while (0)
#define PG8_WAIT_V(n) asm volatile("s_waitcnt vmcnt(" #n ")" ::: "memory")
#define PG8_WAIT_L(n) asm volatile("s_waitcnt lgkmcnt(" #n ")" ::: "memory")
#define PG8_BAR __builtin_amdgcn_s_barrier()
#define PG8_SCHED __builtin_amdgcn_sched_barrier(0)
    Unit cur, nxt; int ui = 0;
    if (!S.next(0, cur)) return;
    f32x4 acc[2][2][4][2];
#pragma unroll
    for (int a = 0; a < 2; ++a)
#pragma unroll
        for (int b = 0; b < 2; ++b)
#pragma unroll
            for (int m = 0; m < 4; ++m)
#pragma unroll
                for (int n = 0; n < 2; ++n) acc[a][b][m][n] = (f32x4){0.f, 0.f, 0.f, 0.f};
    bf16x8 At[4][2], B0[2][2], B1[2][2];
    const char* cA = (const char*)g.A + (size_t)cur.pm * tstep; const char* cB = (const char*)g.Bt + (size_t)cur.pn * tstep;
    S.a_ready(cur);
    if constexpr (SP2) {
        PG8_STAGE(PG8_SB(0, 0), cB, voffB); PG8_STAGE(PG8_SB(0, 1), cB + hstep, voffB); PG8_STAGE(PG8_SA(0, 0), cA, voffA); PG8_STAGE(PG8_SA(0, 1), cA + hstep, voffA);
        if (wr == 1) PG8_BAR;
        PG8_WAIT_V(2); PG8_BAR;
        PG8_STAGE(PG8_SB(1, 0), cB + kstep, voffB); PG8_STAGE(PG8_SA(1, 0), cA + kstep, voffA); PG8_STAGE(PG8_SB(1, 1), cB + hstep + kstep, voffB);
        PG8_WAIT_V(6); PG8_BAR;
    } else {
        PG8_STAGE(PG8_SB(0, 0), cB, voffB); PG8_STAGE(PG8_SA(0, 0), cA, voffA); PG8_STAGE(PG8_SB(0, 1), cB + hstep, voffB); PG8_STAGE(PG8_SA(0, 1), cA + hstep, voffA);
        if (wr == 1) PG8_BAR;
        PG8_WAIT_V(4); PG8_BAR;
        PG8_STAGE(PG8_SB(1, 0), cB + kstep, voffB); PG8_STAGE(PG8_SA(1, 0), cA + kstep, voffA); PG8_STAGE(PG8_SB(1, 1), cB + hstep + kstep, voffB);
        PG8_WAIT_V(6); PG8_BAR;
    }
    for (;;) {
        const bool has_next = S.next(ui + 1, nxt);
        const char* nA = has_next ? (const char*)g.A + (size_t)nxt.pm * tstep : cA; const char* nB = has_next ? (const char*)g.Bt + (size_t)nxt.pn * tstep : cB;
        for (int t = 0; t < nt; t += 2) {
            const bool last = (t == nt - 2);
            const char* a1 = cA + (size_t)(t + 1) * kstep;
            const char* a2 = last ? nA : cA + (size_t)(t + 2) * kstep; const char* b2 = last ? nB : cB + (size_t)(t + 2) * kstep;
            const char* a3 = a2 + kstep; const char* b3 = b2 + kstep;
            if (last && has_next) S.a_ready(nxt);
            if constexpr (SP2) {
            PG8_LDB(B0, 0, 0); PG8_LDB(B1, 0, 1); PG8_SCHED; PG8_LDA(At, 0, 0); PG8_STAGE(PG8_SA(1, 1), a1 + hstep, voffA);
            PG8_WAIT_V(8); PG8_WAIT_L(0); PG8_BAR; PG8_MMA(0, 0, At, B0); PG8_MMA(0, 1, At, B1); PG8_BAR; PG8_SCHED;
            PG8_LDA(At, 0, 1); PG8_STAGE(PG8_SB(0, 0), b2, voffB); PG8_STAGE(PG8_SB(0, 1), b2 + hstep, voffB); PG8_STAGE(PG8_SA(0, 0), a2, voffA);
            PG8_WAIT_V(8); PG8_WAIT_L(0); PG8_BAR; PG8_MMA(1, 0, At, B0); PG8_MMA(1, 1, At, B1); PG8_BAR; PG8_SCHED;
            PG8_LDB(B0, 1, 0); PG8_LDB(B1, 1, 1); PG8_SCHED; PG8_LDA(At, 1, 0); PG8_STAGE(PG8_SA(0, 1), a2 + hstep, voffA);
            PG8_WAIT_V(8); PG8_WAIT_L(0); PG8_BAR; PG8_MMA(0, 0, At, B0); PG8_MMA(0, 1, At, B1); PG8_BAR; PG8_SCHED;
            PG8_LDA(At, 1, 1); PG8_STAGE(PG8_SB(1, 0), b3, voffB); PG8_STAGE(PG8_SB(1, 1), b3 + hstep, voffB); PG8_STAGE(PG8_SA(1, 0), a3, voffA);
            PG8_WAIT_V(8); PG8_WAIT_L(0); PG8_BAR; PG8_MMA(1, 0, At, B0); PG8_MMA(1, 1, At, B1); PG8_BAR; PG8_SCHED;
            } else {
            PG8_LDB(B0, 0, 0); PG8_SCHED; PG8_LDA(At, 0, 0); PG8_STAGE(PG8_SA(1, 1), a1 + hstep, voffA);
            PG8_WAIT_L(8); PG8_BAR; PG8_WAIT_L(0); PG8_MMA(0, 0, At, B0); PG8_BAR; PG8_SCHED;
            PG8_LDB(B1, 0, 1); PG8_STAGE(PG8_SB(0, 0), b2, voffB);
            PG8_BAR; PG8_WAIT_L(0); PG8_MMA(0, 1, At, B1); PG8_BAR;
            PG8_LDA(At, 0, 1); PG8_STAGE(PG8_SA(0, 0), a2, voffA);
            PG8_BAR; PG8_WAIT_L(0); PG8_MMA(1, 0, At, B0); PG8_BAR; PG8_SCHED;
            PG8_STAGE(PG8_SB(0, 1), b2 + hstep, voffB);
            PG8_WAIT_V(6); PG8_BAR; PG8_MMA(1, 1, At, B1); PG8_BAR;
            PG8_LDB(B0, 1, 0); PG8_SCHED; PG8_LDA(At, 1, 0); PG8_STAGE(PG8_SA(0, 1), a2 + hstep, voffA);
            PG8_WAIT_L(8); PG8_BAR; PG8_WAIT_L(0); PG8_MMA(0, 0, At, B0); PG8_BAR; PG8_SCHED;
            PG8_LDB(B1, 1, 1); PG8_STAGE(PG8_SB(1, 0), b3, voffB);
            PG8_BAR; PG8_WAIT_L(0); PG8_MMA(0, 1, At, B1); PG8_BAR;
            PG8_LDA(At, 1, 1); PG8_STAGE(PG8_SA(1, 0), a3, voffA);
            PG8_BAR; PG8_WAIT_L(0); PG8_MMA(1, 0, At, B0); PG8_BAR; PG8_SCHED;
            PG8_STAGE(PG8_SB(1, 1), b3 + hstep, voffB);
            PG8_WAIT_V(6); PG8_BAR; PG8_MMA(1, 1, At, B1); PG8_BAR;
            }
        }
        if constexpr (ALIGN_EPI) { if (wr == 0) PG8_BAR; }
        if constexpr (!Epi::AFTER_DRAIN) { E(acc, cur, wr, wc, fr, fq); S.done(cur); }
        if (!has_next) break;
#pragma unroll
        for (int a = 0; a < 2; ++a)
#pragma unroll
            for (int b = 0; b < 2; ++b)
#pragma unroll
                for (int m = 0; m < 4; ++m)
#pragma unroll
                    for (int n = 0; n < 2; ++n) acc[a][b][m][n] = (f32x4){0.f, 0.f, 0.f, 0.f};
        cur = nxt; cA = nA; cB = nB; ++ui;
        if constexpr (ALIGN_EPI) { if (wr == 1) PG8_BAR; }
    }
    PG8_WAIT_V(0);
    if constexpr (!ALIGN_EPI) { if (wr == 0) PG8_BAR; }
    PG8_BAR;
    if constexpr (Epi::AFTER_DRAIN) { E.fused(acc, cur, wr, wc, fr, fq, lds, wid, lane); S.done(cur); }
#undef PG8_SA
#undef PG8_SB
#undef PG8_STAGE
#undef PG8_LDA
#undef PG8_LDB
#undef PG8_MMA
#undef PG8_WAIT_V
#undef PG8_WAIT_L
#undef PG8_BAR
#undef PG8_SCHED
}
}
namespace pg8 {
typedef unsigned u32x2v __attribute__((ext_vector_type(2)));
constexpr int TOK_S = 8192;
constexpr float QK_EPS = 1e-6f;
constexpr float C2 = 0.125f * 1.4426950408889634f;
__device__ __forceinline__ float sigmoid_fast(float v) { return __builtin_amdgcn_rcpf(1.f + __builtin_amdgcn_exp2f(-1.4426950408889634f * v)); }
__device__ __forceinline__ float silu_fast(float v) { return v * __builtin_amdgcn_rcpf(1.f + __builtin_amdgcn_exp2f(-1.4426950408889634f * v)); }

struct EpiInProj {
    static constexpr bool PERM = true, AFTER_DRAIN = false;
    bf16_t* qkv;
    float* gates;
    float* kmean_part;
    const float *qna, *kna, *qnb, *knsel, *knwin;
    __device__ __forceinline__ void operator()(const f32x4 (&acc)[2][2][4][2], const Unit& u, int wr, int wc, int fr, int fq) const {
        const int slot = u.pn * 4 + wc;
        if (slot > 44) return;
        const int b = u.pm >> 5, blk = u.pm & 31, pos0 = blk * 256 + wr * 64 + fr;
        if (slot == 44) {
            if (fq < 3) {
#pragma unroll
                for (int ai = 0; ai < 2; ++ai)
#pragma unroll
                    for (int m = 0; m < 4; ++m) { const size_t tok = (size_t)b * TOK_S + pos0 + ai * HALF + m * 16; float* gp = gates + tok * 24 + 8 * fq;
                        const f32x4 v0 = acc[ai][0][m][0], v1 = acc[ai][0][m][1];
                        *(f32x4*)gp = (f32x4){sigmoid_fast(v0[0]), sigmoid_fast(v0[1]), sigmoid_fast(v0[2]), sigmoid_fast(v0[3])};
                        *(f32x4*)(gp + 4) = (f32x4){sigmoid_fast(v1[0]), sigmoid_fast(v1[1]), sigmoid_fast(v1[2]), sigmoid_fast(v1[3])}; }
            }
            return;
        }
        const float* gain = nullptr; float qscale = 1.f; bool is_ka = false; bf16_t* dst;
        constexpr size_t BIG = (size_t)4 * 8 * TOK_S * 64, SMALL = (size_t)4 * 2 * TOK_S * 64;
        if (slot < 32) { const int kind = slot >> 3, head = slot & 7; dst = qkv + kind * BIG + ((size_t)(b * 8 + head) * TOK_S) * 64;
            if (kind == 0) { gain = qna; qscale = C2; } else if (kind == 1) { gain = kna; is_ka = true; } else if (kind == 3) { gain = qnb; qscale = C2; } }
        else { const int kind = (slot - 32) >> 1, g = slot & 1; dst = qkv + 4 * BIG + kind * SMALL + ((size_t)(b * 2 + g) * TOK_S) * 64;
            if (kind == 2) gain = knsel; else if (kind == 4) gain = knwin; }
        float gv[16];
#pragma unroll
        for (int i = 0; i < 16; ++i) gv[i] = gain ? gain[(i >> 3) * 32 + 8 * fq + (i & 7)] * qscale : 1.f;
        float cs[16];
#pragma unroll
        for (int i = 0; i < 16; ++i) cs[i] = 0.f;
#pragma unroll
        for (int ai = 0; ai < 2; ++ai)
#pragma unroll
            for (int m = 0; m < 4; ++m) {
                float v[16];
#pragma unroll
                for (int bj = 0; bj < 2; ++bj)
#pragma unroll
                    for (int n = 0; n < 2; ++n)
#pragma unroll
                        for (int j = 0; j < 4; ++j) v[bj * 8 + n * 4 + j] = acc[ai][bj][m][n][j];
                if (gain) { float ss = 0.f;
#pragma unroll
                    for (int i = 0; i < 16; ++i) ss += v[i] * v[i];
                    ss += __shfl_xor(ss, 16); ss += __shfl_xor(ss, 32);
                    const float rs = rsqrtf(ss * (1.f / 64.f) + QK_EPS);
#pragma unroll
                    for (int i = 0; i < 16; ++i) v[i] *= rs * gv[i]; }
                if (is_ka) {
#pragma unroll
                    for (int i = 0; i < 16; ++i) cs[i] += v[i]; }
                bf16_t* rp = dst + (size_t)(pos0 + ai * HALF + m * 16) * 64 + 8 * fq;
                u32x4 w0, w1;
                w0.x = cvt_pk_bf16(v[0], v[1]); w0.y = cvt_pk_bf16(v[2], v[3]); w0.z = cvt_pk_bf16(v[4], v[5]); w0.w = cvt_pk_bf16(v[6], v[7]);
                w1.x = cvt_pk_bf16(v[8], v[9]); w1.y = cvt_pk_bf16(v[10], v[11]); w1.z = cvt_pk_bf16(v[12], v[13]); w1.w = cvt_pk_bf16(v[14], v[15]);
                *(u32x4*)rp = w0; *(u32x4*)(rp + 32) = w1;
            }
        if (is_ka) {
#pragma unroll
            for (int i = 0; i < 16; ++i) { float s = cs[i]; s += __shfl_xor(s, 1); s += __shfl_xor(s, 2); s += __shfl_xor(s, 4); s += __shfl_xor(s, 8); cs[i] = s; }
            if (fr == 0) { float* kp = kmean_part + ((size_t)((b * 8 + (slot & 7)) * 32 + blk) * 2 + wr) * 64 + 8 * fq;
                *(f32x4*)kp = (f32x4){cs[0], cs[1], cs[2], cs[3]}; *(f32x4*)(kp + 4) = (f32x4){cs[4], cs[5], cs[6], cs[7]};
                *(f32x4*)(kp + 32) = (f32x4){cs[8], cs[9], cs[10], cs[11]}; *(f32x4*)(kp + 36) = (f32x4){cs[12], cs[13], cs[14], cs[15]}; }
        }
    }
};
struct EpiOutProj {
    static constexpr bool PERM = true, AFTER_DRAIN = false;
    bf16_t* y; const float* gt;
    __device__ __forceinline__ void operator()(const f32x4 (&acc)[2][2][4][2], const Unit& u, int wr, int wc, int fr, int fq) const {
        const int b = u.pm >> 5; const int col0 = u.pn * BM + wc * 32 + 8 * fq; const float* gtb = gt + (size_t)b * 6144;
#pragma unroll
        for (int bj = 0; bj < 2; ++bj) { const int c = col0 + bj * HALF; const f32x4 g40 = *(const f32x4*)(gtb + c), g41 = *(const f32x4*)(gtb + c + 4);
#pragma unroll
            for (int ai = 0; ai < 2; ++ai)
#pragma unroll
                for (int m = 0; m < 4; ++m) { const size_t off = (size_t)(u.pm * BM + ai * HALF + wr * 64 + m * 16 + fr) * 1024 + c;
                    const f32x4 y0 = g40 * acc[ai][bj][m][0], y1 = g41 * acc[ai][bj][m][1];
                    u32x4 w; w.x = cvt_pk_bf16(y0[0], y0[1]); w.y = cvt_pk_bf16(y0[2], y0[3]); w.z = cvt_pk_bf16(y1[0], y1[1]); w.w = cvt_pk_bf16(y1[2], y1[3]);
                    *(u32x4*)(y + off) = w; } }
    }
};
struct EpiGateUp {
    static constexpr bool PERM = true, AFTER_DRAIN = false;
    bf16_t* act;
    __device__ __forceinline__ void operator()(const f32x4 (&acc)[2][2][4][2], const Unit& u, int wr, int wc, int fr, int fq) const {
        const int h0 = u.pn * 128 + wc * 32 + 8 * fq;
#pragma unroll
        for (int ai = 0; ai < 2; ++ai)
#pragma unroll
            for (int m = 0; m < 4; ++m) { const size_t row = (size_t)(u.pm * BM + ai * HALF + wr * 64 + m * 16 + fr);
                const f32x4 g0 = acc[ai][0][m][0], g1 = acc[ai][0][m][1], u0 = acc[ai][1][m][0], u1 = acc[ai][1][m][1];
                u32x4 w;
                w.x = cvt_pk_bf16(silu_fast(g0[0]) * u0[0], silu_fast(g0[1]) * u0[1]); w.y = cvt_pk_bf16(silu_fast(g0[2]) * u0[2], silu_fast(g0[3]) * u0[3]);
                w.z = cvt_pk_bf16(silu_fast(g1[0]) * u1[0], silu_fast(g1[1]) * u1[1]); w.w = cvt_pk_bf16(silu_fast(g1[2]) * u1[2], silu_fast(g1[3]) * u1[3]);
                *(u32x4*)(act + row * 2816 + h0) = w; }
    }
};
struct EpiDown {
    static constexpr bool PERM = true, AFTER_DRAIN = false;
    const float* x; const bf16_t* y; float* out; const float* gt;
    __device__ __forceinline__ void operator()(const f32x4 (&acc)[2][2][4][2], const Unit& u, int wr, int wc, int fr, int fq) const {
        const int b = u.pm >> 5; const int col0 = u.pn * BM + wc * 32 + 8 * fq; const float* gtb = gt + (size_t)b * 6144;
#pragma unroll
        for (int bj = 0; bj < 2; ++bj) { const int c = col0 + bj * HALF; const f32x4 g40 = *(const f32x4*)(gtb + c), g41 = *(const f32x4*)(gtb + c + 4);
#pragma unroll
            for (int ai = 0; ai < 2; ++ai)
#pragma unroll
                for (int m = 0; m < 4; ++m) { const size_t off = (size_t)(u.pm * BM + ai * HALF + wr * 64 + m * 16 + fr) * 1024 + c;
                    const f32x4 x0 = *(const f32x4*)(x + off), x1 = *(const f32x4*)(x + off + 4); const u32x4 yw = *(const u32x4*)(y + off);
                    const f32x4 y0 = {__builtin_bit_cast(float, yw.x << 16), __builtin_bit_cast(float, yw.x & 0xffff0000u), __builtin_bit_cast(float, yw.y << 16), __builtin_bit_cast(float, yw.y & 0xffff0000u)};
                    const f32x4 y1 = {__builtin_bit_cast(float, yw.z << 16), __builtin_bit_cast(float, yw.z & 0xffff0000u), __builtin_bit_cast(float, yw.w << 16), __builtin_bit_cast(float, yw.w & 0xffff0000u)};
                    *(f32x4*)(out + off) = (x0 + y0) + g40 * acc[ai][bj][m][0]; *(f32x4*)(out + off + 4) = (x1 + y1) + g41 * acc[ai][bj][m][1]; } }
    }
};
}
constexpr int NWAVES = 8, NTHREADS = 512;
constexpr int BATCH = 4, SEQ = 8192, DM = 1024, TOK = BATCH * SEQ, NIN = 2840, NIN_PAD = 3072, FF = 2816, NCMP = 511;
constexpr size_t MiB = 1u << 20;
constexpr size_t WS_CTL = 0, CTL_ZERO_BYTES = 64 * 1024;
constexpr size_t WS_MODP = 1 * MiB;
constexpr size_t WS_MOD = 2 * MiB;
constexpr size_t WS_CBP = 2 * MiB + 512 * 1024;
constexpr size_t WS_KMP = 3 * MiB;
constexpr size_t WS_BIAS2 = 4 * MiB;
constexpr size_t WS_SSP = 449 * MiB;
constexpr size_t WS_WIN = 6 * MiB, WS_WOUT = 12 * MiB, WS_WGU = 14 * MiB, WS_WDN = 25 * MiB;
constexpr size_t WS_W1K = 31 * MiB, WS_W1V = 32 * MiB, WS_W2K = 33 * MiB, WS_W2V = 33 * MiB + 64 * 1024;
constexpr size_t WS_KCMP = 34 * MiB, WS_VCMP = 35 * MiB;
constexpr size_t WS_GATES = 36 * MiB;
constexpr size_t WS_H = 40 * MiB;
constexpr size_t WS_MIX = 104 * MiB;
constexpr size_t WS_QKV = 168 * MiB;
constexpr size_t WS_ACT = WS_QKV;
constexpr size_t WS_END = 344 * MiB;
constexpr size_t WS_PARTO = 344 * MiB;
constexpr size_t WS_PARTL = 472 * MiB;
constexpr size_t WS_SELG = 476 * MiB;
constexpr size_t WS_Y = WS_PARTO;
constexpr size_t QKV_BIG = (size_t)4 * 8 * SEQ * 64, QKV_SMALL = (size_t)4 * 2 * SEQ * 64;
constexpr int RING_BYTES = 131072, LDS_BYTES = 147456;
constexpr int N_PHASES = 10;

#define GAS __attribute__((address_space(1)))
#define LAS __attribute__((address_space(3)))
typedef unsigned short bf16;
typedef unsigned v4u __attribute__((ext_vector_type(4)));
typedef float f32x4 __attribute__((ext_vector_type(4)));
#define LDS_WAIT() asm volatile("s_waitcnt lgkmcnt(0)" ::: "memory")
#define VM_WAIT() asm volatile("s_waitcnt vmcnt(0)" ::: "memory")
__device__ __forceinline__ unsigned f2bf(float f) { unsigned u = __builtin_bit_cast(unsigned, f); return (u + 0x7fffu + ((u >> 16) & 1u)) >> 16; }
__device__ __forceinline__ unsigned pk2(float lo, float hi) { return f2bf(lo) | (f2bf(hi) << 16); }
__device__ __forceinline__ float bf2f(bf16 v) { return __builtin_bit_cast(float, (unsigned)v << 16); }
__device__ __forceinline__ float wave_sum(float v) {
#pragma unroll
    for (int o = 1; o < 64; o <<= 1) v += __shfl_xor(v, o);
    return v;
}
struct Args { const float* in[23]; float* out; unsigned char* ws; int ph_lo, ph_hi; };
struct Frame { LAS unsigned char* lds; int tid, lane, wave, vcu, G; };

struct MapId { __device__ __forceinline__ size_t off(int n, int k, int K) const { return (size_t)n * K + k; } };
struct MapWin { __device__ __forceinline__ size_t off(int n, int k, int K) const { const int s = n >> 6, d = n & 63; return (size_t)(256 * (s >> 2) + 128 * (d >> 5) + 32 * (s & 3) + (d & 31)) * K + k; } };
struct MapWgu { __device__ __forceinline__ size_t off(int n, int k, int K) const { const int up = n >= FF, hdn = up ? n - FF : n; return (size_t)(256 * (hdn >> 7) + 128 * up + (hdn & 127)) * K + k; } };
struct MapFrag { __device__ __forceinline__ size_t off(int n, int k, int K) const { return ((size_t)((k >> 4) * 8 + (n >> 5)) * 64 + ((k >> 3) & 1) * 32 + (n & 31)) * 8 + (k & 7); } };
template <class Map>
__device__ __forceinline__ void transpose_item(const float* __restrict__ W, int K, int N, bf16* WT, LAS float* scr, int item, int lane, const Map& map) {
    const int nblk = (N + 63) / 64, kb = item / nblk, nb = item % nblk, k0 = 64 * kb, n0 = 64 * nb;
    const int nc = n0 + 4 * (lane & 15); const bool nin = nc < N;
    f32x4 v[16];
#pragma unroll
    for (int i = 0; i < 16; ++i) { const int kk = 4 * i + (lane >> 4); v[i] = nin ? *(const GAS f32x4*)(W + (size_t)(k0 + kk) * N + nc) : (f32x4){0.f, 0.f, 0.f, 0.f}; }
#pragma unroll
    for (int i = 0; i < 16; ++i) { const int kk = 4 * i + (lane >> 4); LAS float* d = scr + (4 * (lane & 15)) * 68 + kk; d[0] = v[i][0]; d[68] = v[i][1]; d[136] = v[i][2]; d[204] = v[i][3]; }
    LDS_WAIT(); asm volatile("" ::: "memory");
    const int c = lane & 7;
#pragma unroll
    for (int j = 0; j < 8; ++j) { const int n = (lane >> 3) + 8 * j; const LAS float* s = scr + n * 68 + 8 * c;
        const f32x4 a = *(const LAS f32x4*)s, bq = *(const LAS f32x4*)(s + 4);
        v4u o; o.x = pk2(a[0], a[1]); o.y = pk2(a[2], a[3]); o.z = pk2(bq[0], bq[1]); o.w = pk2(bq[2], bq[3]);
        if (n0 + n < N) *(GAS v4u*)(WT + map.off(n0 + n, k0 + 8 * c, K)) = o; }
    LDS_WAIT(); asm volatile("" ::: "memory");
}
__device__ __forceinline__ float silu_acc(float v) { return v / (1.f + expf(-v)); }
__device__ __forceinline__ void phase_prologue_a(Frame& F, const Args& a) {
    LAS float* scr = (LAS float*)(F.lds + F.wave * 17408);
    const int gw = F.vcu * NWAVES + F.wave, NGW = F.G * NWAVES;
    unsigned char* ws = a.ws;
    constexpr int I_IN = (DM / 64) * ((NIN + 63) / 64), I_OUT = (DM / 64) * (DM / 64), I_GU = (DM / 64) * (2 * FF / 64), I_DN = (FF / 64) * (DM / 64), I_W1 = (2048 / 64) * (256 / 64), I_W2 = (256 / 64) * (64 / 64);
    constexpr int NITEMS = I_IN + I_OUT + I_GU + I_DN + 2 * I_W1 + 2 * I_W2;
    for (int it = gw; it < NITEMS; it += NGW) {
        int r = it;
        if (r < I_IN) { transpose_item(a.in[6], DM, NIN, (bf16*)(ws + WS_WIN), scr, r, F.lane, MapWin()); continue; } r -= I_IN;
        if (r < I_OUT) { transpose_item(a.in[19], DM, DM, (bf16*)(ws + WS_WOUT), scr, r, F.lane, MapId()); continue; } r -= I_OUT;
        if (r < I_GU) { transpose_item(a.in[21], DM, 2 * FF, (bf16*)(ws + WS_WGU), scr, r, F.lane, MapWgu()); continue; } r -= I_GU;
        if (r < I_DN) { transpose_item(a.in[22], FF, DM, (bf16*)(ws + WS_WDN), scr, r, F.lane, MapId()); continue; } r -= I_DN;
        if (r < I_W1) { transpose_item(a.in[14], 2048, 256, (bf16*)(ws + WS_W1K), scr, r, F.lane, MapFrag()); continue; } r -= I_W1;
        if (r < I_W1) { transpose_item(a.in[17], 2048, 256, (bf16*)(ws + WS_W1V), scr, r, F.lane, MapFrag()); continue; } r -= I_W1;
        if (r < I_W2) { transpose_item(a.in[15], 256, 64, (bf16*)(ws + WS_W2K), scr, r, F.lane, MapId()); continue; } r -= I_W2;
        transpose_item(a.in[18], 256, 64, (bf16*)(ws + WS_W2V), scr, r, F.lane, MapId());
    }
    const float* c = a.in[1]; const float* w_ada = a.in[3]; float* modp = (float*)(ws + WS_MODP);
    for (int t = NGW - 1 - gw; t < 96 * 8; t += NGW) { const int cg_ = t % 96, ks = t / 96; const int n = cg_ * 64 + F.lane;
        float acc0 = 0.f, acc1 = 0.f, acc2 = 0.f, acc3 = 0.f;
#pragma unroll
        for (int i = 0; i < 8; ++i) { const int idx = F.lane + 64 * i, bb = idx >> 7, kk = idx & 127; scr[kk * 4 + bb] = silu_acc(c[bb * DM + ks * 128 + kk]); }
        LDS_WAIT(); asm volatile("" ::: "memory");
#pragma unroll 8
        for (int k = 0; k < 128; ++k) { const float w = w_ada[(size_t)(ks * 128 + k) * 6144 + n]; const f32x4 sv = *(const LAS f32x4*)(scr + 4 * k);
            acc0 += sv[0] * w; acc1 += sv[1] * w; acc2 += sv[2] * w; acc3 += sv[3] * w; }
        LDS_WAIT(); asm volatile("" ::: "memory");
        float* o = modp + (size_t)ks * 4 * 6144 + n; o[0] = acc0; o[6144] = acc1; o[2 * 6144] = acc2; o[3 * 6144] = acc3; }
    float* cbp = (float*)(ws + WS_CBP);
    for (int t = NGW / 2 - 1 - gw; t >= 0 && t < 256; t += NGW) { const int kv = t & 1, cg_ = (t >> 1) & 3, ic = t >> 3; const int n = cg_ * 64 + F.lane;
        const float* pe = kv ? a.in[16] : a.in[13]; const float* w1 = kv ? a.in[17] : a.in[14]; float acc = 0.f;
#pragma unroll 8
        for (int i = ic * 64; i < ic * 64 + 64; ++i) acc += pe[i] * w1[(size_t)i * 256 + n];
        cbp[(ic * 2 + kv) * 256 + n] = acc; }
}
template <bool ADDY>
__device__ __forceinline__ void norm_rows(Frame& F, int blk, const float* in, const bf16* yin, const f32x4 (&gs)[4], const f32x4 (&sh)[4], bf16* out) {
    for (int i0 = 0; i0 < 16; i0 += 4) {
        f32x4 v[4][4]; float ss[4];
#pragma unroll
        for (int r = 0; r < 4; ++r) { const int row = blk * 128 + F.wave * 16 + i0 + r; const GAS f32x4* xr = (const GAS f32x4*)(in + (size_t)row * DM) + F.lane;
#pragma unroll
            for (int j = 0; j < 4; ++j) v[r][j] = xr[64 * j];
            if (ADDY) { const GAS unsigned long long* yr = (const GAS unsigned long long*)(yin + (size_t)row * DM) + F.lane;
#pragma unroll
                for (int j = 0; j < 4; ++j) { const unsigned long long w = yr[64 * j]; const unsigned lo = (unsigned)w, hi = (unsigned)(w >> 32);
                    v[r][j] += (f32x4){__builtin_bit_cast(float, lo << 16), __builtin_bit_cast(float, lo & 0xffff0000u), __builtin_bit_cast(float, hi << 16), __builtin_bit_cast(float, hi & 0xffff0000u)}; } } }
#pragma unroll
        for (int r = 0; r < 4; ++r) { float s = 0.f;
#pragma unroll
            for (int j = 0; j < 4; ++j) s += (v[r][j].x * v[r][j].x + v[r][j].y * v[r][j].y) + (v[r][j].z * v[r][j].z + v[r][j].w * v[r][j].w);
            ss[r] = s; }
#pragma unroll
        for (int o_ = 1; o_ < 64; o_ <<= 1) {
#pragma unroll
            for (int r = 0; r < 4; ++r) ss[r] += __shfl_xor(ss[r], o_); }
#pragma unroll
        for (int r = 0; r < 4; ++r) { const int row = blk * 128 + F.wave * 16 + i0 + r; const float rs = rsqrtf(ss[r] * (1.f / DM) + 1e-6f);
            GAS unsigned long long* o8 = (GAS unsigned long long*)(out + (size_t)row * DM) + F.lane;
#pragma unroll
            for (int j = 0; j < 4; ++j) { const f32x4 y = v[r][j] * rs * gs[j] + sh[j]; o8[64 * j] = (unsigned long long)pk2(y.x, y.y) | ((unsigned long long)pk2(y.z, y.w) << 32); } }
    }
}
__device__ __forceinline__ void phase_prologue_b(Frame& F, const Args& a) {
    unsigned char* ws = a.ws; const float* modp = (const float*)(ws + WS_MODP); const float* b_ada = a.in[4];
    if (F.wave == 0) for (int cgp = F.vcu; cgp < 96; cgp += F.G) { const int n = cgp * 64 + F.lane; float* mod = (float*)(ws + WS_MOD);
        for (int b = 0; b < 4; ++b) { float s = 0.f;
#pragma unroll
            for (int ks = 0; ks < 8; ++ks) s += modp[((size_t)ks * 4 + b) * 6144 + n];
            mod[b * 6144 + n] = s + b_ada[n]; } }
    const float* g = a.in[5];
    for (int blk = F.vcu; blk < TOK / 128; blk += F.G) { const int b = blk >> 6;
    f32x4 gs[4], sh[4];
#pragma unroll
    for (int j = 0; j < 4; ++j) { const int c0 = 4 * F.lane + 256 * j; f32x4 s0 = {0.f, 0.f, 0.f, 0.f}, s1 = {0.f, 0.f, 0.f, 0.f};
#pragma unroll
        for (int ks = 0; ks < 8; ++ks) { s0 += *(const f32x4*)(modp + ((size_t)ks * 4 + b) * 6144 + c0); s1 += *(const f32x4*)(modp + ((size_t)ks * 4 + b) * 6144 + DM + c0); }
        s0 += *(const f32x4*)(b_ada + c0); s1 += *(const f32x4*)(b_ada + DM + c0);
        sh[j] = s0; gs[j] = *(const f32x4*)(g + c0) * (s1 + 1.0f); }
    norm_rows<false>(F, blk, a.in[0], nullptr, gs, sh, (bf16*)(ws + WS_H)); }
}
__device__ __forceinline__ void phase_norm2(Frame& F, const Args& a) {
    unsigned char* ws = a.ws; const float* g = a.in[20];
    for (int blk = F.vcu; blk < TOK / 128; blk += F.G) { const int b = blk >> 6; const float* mod = (const float*)(ws + WS_MOD) + (size_t)b * 6144;
        f32x4 gs[4], sh[4];
#pragma unroll
        for (int j = 0; j < 4; ++j) { const int c0 = 4 * F.lane + 256 * j; sh[j] = *(const f32x4*)(mod + 3 * DM + c0); gs[j] = *(const f32x4*)(g + c0) * (*(const f32x4*)(mod + 4 * DM + c0) + 1.0f); }
        norm_rows<true>(F, blk, a.in[0], (const bf16*)(ws + WS_Y), gs, sh, (bf16*)(ws + WS_H)); }
}

__device__ __forceinline__ void phase_bias2(Frame& F, const Args& a) {
    unsigned char* ws = a.ws; const float* mod = (const float*)(ws + WS_MOD); const bf16* wt = (const bf16*)(ws + WS_WGU); float* bias2 = (float*)(ws + WS_BIAS2);
    const int gw = F.vcu * NWAVES + F.wave, NGW = F.G * NWAVES;
    f32x4 sh[4][4];
#pragma unroll
    for (int bb = 0; bb < 4; ++bb)
#pragma unroll
        for (int j = 0; j < 4; ++j) sh[bb][j] = *(const f32x4*)(mod + (size_t)bb * 6144 + 3 * DM + 16 * F.lane + 4 * j);
    for (int c = gw; c < 2 * FF; c += NGW) {
        const v4u w0 = *(const GAS v4u*)(wt + (size_t)c * DM + 16 * F.lane), w1 = *(const GAS v4u*)(wt + (size_t)c * DM + 16 * F.lane + 8);
        const unsigned wu[8] = {w0.x, w0.y, w0.z, w0.w, w1.x, w1.y, w1.z, w1.w};
        float s[4] = {0.f, 0.f, 0.f, 0.f};
#pragma unroll
        for (int j = 0; j < 4; ++j) { const float e0 = __builtin_bit_cast(float, wu[2 * j] << 16), e1 = __builtin_bit_cast(float, wu[2 * j] & 0xffff0000u), e2 = __builtin_bit_cast(float, wu[2 * j + 1] << 16), e3 = __builtin_bit_cast(float, wu[2 * j + 1] & 0xffff0000u);
#pragma unroll
            for (int bb = 0; bb < 4; ++bb) s[bb] += (sh[bb][j][0] * e0 + sh[bb][j][1] * e1) + (sh[bb][j][2] * e2 + sh[bb][j][3] * e3); }
#pragma unroll
        for (int bb = 0; bb < 4; ++bb) { const float t = wave_sum(s[bb]); if (F.lane == 0) bias2[(size_t)bb * 2 * FF + c] = t; }
    }
}
#define XB_TMO      128
#define XB_XCNT(j)  (256  + 64 * (j))
#define XB_XSUB(j)  (1280 + 64 * (j))
#define XB_XGEN(j)  (2304 + 64 * (j))
#define XB_TOP      3328
#define XB_TOPGEN   3392
#define XCD_BAR_WORDS 3456
#define XB_SPIN_CAP (1u << 18)

__device__ __forceinline__ unsigned xb_ld(unsigned* p)              { return __hip_atomic_load(p, __ATOMIC_RELAXED, __HIP_MEMORY_SCOPE_AGENT); }
__device__ __forceinline__ unsigned xb_add(unsigned* p, unsigned v) { return __hip_atomic_fetch_add(p, v, __ATOMIC_RELAXED, __HIP_MEMORY_SCOPE_AGENT); }
__device__ __forceinline__ unsigned xb_xcc_id() { return (unsigned)__builtin_amdgcn_s_getreg((3 << 11) | 20) & 0xFu; }
#define XB_SPIN(cond, bar) do { unsigned _sp = 0; while (cond) { __builtin_amdgcn_s_sleep(1); \
    if ((++_sp & 255u) == 0u) { if (xb_ld(&(bar)[XB_TMO])) break; if (_sp > XB_SPIN_CAP) { atomicAdd(&(bar)[XB_TMO], 1u); break; } } } } while (0)

struct XcdBarrier {
    unsigned* bar; unsigned x;
    volatile LAS unsigned* st;
};

__device__ __forceinline__ XcdBarrier xcd_barrier_post(unsigned* bar, volatile LAS unsigned* st) {
    XcdBarrier b; b.bar = bar; b.x = xb_xcc_id(); b.st = st;
    if (threadIdx.x == 0) (void)xb_add(&bar[XB_XCNT(b.x)], 1u);
    return b;
}
__device__ __forceinline__ void xcd_barrier_complete(unsigned* bar, unsigned x, unsigned& nloc, unsigned& nx) {
    const unsigned G = gridDim.x * gridDim.y * gridDim.z;
    unsigned sum, cnt, mine, sp = 0u;
    for (;;) {
        sum = 0u; cnt = 0u; mine = 0u;
#pragma unroll
        for (unsigned j = 0; j < 16; ++j) { const unsigned c = xb_ld(&bar[XB_XCNT(j)]); sum += c; cnt += (c > 0u) ? 1u : 0u; mine = (j == x) ? c : mine; }
        if (sum == G) break;
        __builtin_amdgcn_s_sleep(1);
        if ((++sp & 255u) == 0u) { if (xb_ld(&bar[XB_TMO])) break; if (sp > XB_SPIN_CAP) { atomicAdd(&bar[XB_TMO], 1u); break; } }
    }
    nloc = mine > 0u ? mine : 1u; nx = cnt > 0u ? cnt : 1u;
}

__device__ __forceinline__ void xcd_barrier(const XcdBarrier& b) {
    asm volatile("s_waitcnt vmcnt(0)" ::: "memory");
    __syncthreads();
    if (threadIdx.x == 0) {
        unsigned* bar = b.bar;
        __builtin_amdgcn_s_waitcnt(0);
        unsigned nloc = b.st[0], nx = b.st[1];
        if (nloc == 0u) { xcd_barrier_complete(bar, b.x, nloc, nx); b.st[0] = nloc; b.st[1] = nx; }
        const unsigned old = xb_add(&bar[XB_XSUB(b.x)], 1u);
        const unsigned gen = old / nloc;
        if (old + 1u == (gen + 1u) * nloc) {
            __builtin_amdgcn_fence(__ATOMIC_RELEASE, "agent");
            asm volatile("s_waitcnt vmcnt(0)" ::: "memory");
            const unsigned og = xb_add(&bar[XB_TOP], 1u);
            const unsigned tg = og / nx;
            if (og + 1u == (tg + 1u) * nx) xb_add(&bar[XB_TOPGEN], 1u);
            else XB_SPIN(xb_ld(&bar[XB_TOPGEN]) == tg, bar);
            __builtin_amdgcn_fence(__ATOMIC_ACQUIRE, "agent");
            xb_add(&bar[XB_XGEN(b.x)], 1u);
            asm volatile("s_waitcnt vmcnt(0)" ::: "memory");
        } else {
            XB_SPIN(xb_ld(&bar[XB_XGEN(b.x)]) == gen, bar);
            __builtin_amdgcn_fence(__ATOMIC_ACQUIRE, "agent");
            asm volatile("s_waitcnt vmcnt(0)" ::: "memory");
        }
    }
    __syncthreads();
}
#define ATT_NS att
#ifndef ATT_ABL
#define ATT_ABL 0
#endif
#ifndef ATT_STAGGER
#define ATT_STAGGER 0
#endif
#ifndef ATT_SLEEP
#define ATT_SLEEP 24
#endif
namespace ATT_NS {
using bf16x8 = __attribute__((ext_vector_type(8))) short;
using s16x4 = __attribute__((ext_vector_type(4))) short;
using f32x16 = __attribute__((ext_vector_type(16))) float;
using u32x4 = __attribute__((ext_vector_type(4))) unsigned;
typedef LAS const char* lds_cptr;
typedef short v4i16_t __attribute__((ext_vector_type(4)));
constexpr int SLOT = 16384, NSLOT = 4, LDS_OST = 65536, LDS_IMP = 100608, LDS_SELM = 135680, LDS_MISC = 136704, LDS_WSF = 136960, LDS_LUTG = 139008  , LDS_ATT_END = 147200;
constexpr int LUT_PITCH = 116;
constexpr int IMP_PITCH = 136, IMP_PLANE = 64 * IMP_PITCH + 4, IMP_REG1 = 64;
constexpr float LOG2E = 1.4426950408889634f;
#define MFMA32(a, b, c) __builtin_amdgcn_mfma_f32_32x32x16_bf16(a, b, c, 0, 0, 0)
#define ATT_WAIT_BAR(N) asm volatile("s_waitcnt vmcnt(" #N ") lgkmcnt(0)\n\ts_barrier" ::: "memory")
__device__ __forceinline__ void glds16(const void* gsrc, unsigned lds_dst) { unsigned keep;
    asm volatile("s_mov_b32 %0, m0\n\ts_mov_b32 m0, %2\n\ts_nop 0\n\tglobal_load_lds_dwordx4 %1, off\n\ts_mov_b32 m0, %0" : "=&s"(keep) : "v"(gsrc), "s"(lds_dst) : "memory"); }
typedef float f32x2_t __attribute__((ext_vector_type(2))); typedef __bf16 bf16x2_t __attribute__((ext_vector_type(2)));
__device__ __forceinline__ unsigned cvtpk(float lo, float hi) { f32x2_t v = {lo, hi}; bf16x2_t b = __builtin_convertvector(v, bf16x2_t); return __builtin_bit_cast(unsigned, b); }
__device__ __forceinline__ s16x4 vtr(lds_cptr p) { return __builtin_bit_cast(s16x4, __builtin_amdgcn_ds_read_tr16_b64_v4i16((LAS v4i16_t*)p)); }
__device__ __forceinline__ int t5_bucket(int d) {
    if (d < 16) return d;
    int b = 16;
    b += (d >= 19); b += (d >= 21); b += (d >= 24); b += (d >= 27); b += (d >= 31); b += (d >= 35); b += (d >= 40); b += (d >= 46);
    b += (d >= 52); b += (d >= 59); b += (d >= 67); b += (d >= 77); b += (d >= 87); b += (d >= 99); b += (d >= 113);
    return b;
}
struct Ctx { LAS char* lds; int wid; int lane, r32, hi; };
__device__ __forceinline__ int fresh_lane() { int l; asm volatile("v_mbcnt_lo_u32_b32 %0, -1, 0\n\tv_mbcnt_hi_u32_b32 %0, -1, %0" : "=v"(l)); return l; }
__device__ __forceinline__ Ctx make_ctx(LAS unsigned char* lds, int tid) {
    Ctx c; c.lds = (LAS char*)lds; c.wid = __builtin_amdgcn_readfirstlane(tid >> 6); c.lane = tid & 63; c.r32 = c.lane & 31; c.hi = c.lane >> 5; return c;
}
template <bool HASV, class QK, class SM>
__device__ __forceinline__ void run_stream(const Ctx& c, const bf16* Kb, const bf16* Vb, int t0, int t1, QK&& qk, SM&& sm) {
    const int n = t1 - t0; if (n <= 0) return;
    const int lane = fresh_lane(), r32 = lane & 31, hi = lane >> 5; const unsigned lds0 = (unsigned)(uintptr_t)c.lds;
    const bf16* ks = Kb + ((8 * c.wid + (lane >> 3)) * 64 + (((lane & 7) ^ (((8 * c.wid + (lane >> 3)) >> 1) & 7)) << 3)); const bf16* vs = Vb + ((16 * (c.wid & 3) + (lane >> 2)) * 64 + (c.wid >> 2) * 32 + (lane & 3) * 8);
    const unsigned kdst = lds0 + c.wid * 1024, vdst = lds0 + 8192 + c.wid * 1024;
    const lds_cptr kp0 = (lds_cptr)c.lds + r32 * 128;
    const lds_cptr vp0 = (lds_cptr)c.lds + 8192 + ((lane >> 4) & 1) * 32 + (lane & 3) * 8 + (4 * hi + ((lane & 15) >> 2)) * 64;
#define ATT_ISSUE(t, so) do { if (ATT_ABL & 4) break; glds16(ks + (size_t)(t) * 4096, (unsigned)__builtin_amdgcn_readfirstlane(kdst + (so))); if (HASV) glds16(vs + (size_t)(t) * 4096, (unsigned)__builtin_amdgcn_readfirstlane(vdst + (so))); } while (0)
    ATT_ISSUE(t0, 0); if (n > 1) ATT_ISSUE(t0 + 1, SLOT);
    const bool late = ATT_STAGGER && __builtin_amdgcn_readfirstlane(c.wid) >= 4;
    f32x16 s0 = {}, s1 = {};
    int slot = 0, slotp = 3 * SLOT, slot2 = 2 * SLOT;
    if (!late) {
        for (int i = 0; i < n; ++i) {
            if (i + 1 < n) { if (HASV) ATT_WAIT_BAR(2); else ATT_WAIT_BAR(1); } else ATT_WAIT_BAR(0);
            if (i + 2 < n) ATT_ISSUE(t0 + i + 2, slot2);
            if (!(ATT_ABL & 1)) qk(t0 + i, kp0 + slot, s0, s1); if (!(ATT_ABL & 2)) sm(t0 + i, vp0 + slot, s0, s1);
            slot = (slot == 3 * SLOT) ? 0 : slot + SLOT; slot2 = (slot2 == 3 * SLOT) ? 0 : slot2 + SLOT;
        }
    } else {
        for (int i = 0; i < n; ++i) {
            if (i + 1 < n) { if (HASV) ATT_WAIT_BAR(2); else ATT_WAIT_BAR(1); } else ATT_WAIT_BAR(0);
            if (i + 2 < n) ATT_ISSUE(t0 + i + 2, slot2);
            if (i > 0 && !(ATT_ABL & 2)) sm(t0 + i - 1, vp0 + slotp, s0, s1);
            if (!(ATT_ABL & 1)) qk(t0 + i, kp0 + slot, s0, s1);
            slotp = slot; slot = (slot == 3 * SLOT) ? 0 : slot + SLOT; slot2 = (slot2 == 3 * SLOT) ? 0 : slot2 + SLOT;
        }
        if (!(ATT_ABL & 2)) sm(t0 + n - 1, vp0 + slotp, s0, s1);
    }
    asm volatile("s_waitcnt lgkmcnt(0)\n\ts_barrier" ::: "memory");
#undef ATT_ISSUE
}
template <class FN1, class FN2>
__device__ __forceinline__ void run_stream_pairs(const Ctx& c, const bf16* Kb, const bf16* Vb, int t0, int t1, FN1&& fn1, FN2&& fn2) {
    const int n = t1 - t0; if (n <= 0) return;
    const int lane = fresh_lane(), r32 = lane & 31, hi = lane >> 5; const unsigned lds0 = (unsigned)(uintptr_t)c.lds;
    const bf16* ks = Kb + ((8 * c.wid + (lane >> 3)) * 64 + (((lane & 7) ^ (((8 * c.wid + (lane >> 3)) >> 1) & 7)) << 3)); const bf16* vs = Vb + ((16 * (c.wid & 3) + (lane >> 2)) * 64 + (c.wid >> 2) * 32 + (lane & 3) * 8);
    const unsigned kdst = lds0 + c.wid * 1024, vdst = lds0 + 8192 + c.wid * 1024;
    const lds_cptr kp0 = (lds_cptr)c.lds + r32 * 128;
    const lds_cptr vp0 = (lds_cptr)c.lds + 8192 + ((lane >> 4) & 1) * 32 + (lane & 3) * 8 + (4 * hi + ((lane & 15) >> 2)) * 64;
#define ATT_ISSUE1(t, so) do { glds16(ks + (size_t)(t) * 4096, (unsigned)__builtin_amdgcn_readfirstlane(kdst + (so))); glds16(vs + (size_t)(t) * 4096, (unsigned)__builtin_amdgcn_readfirstlane(vdst + (so))); } while (0)
    ATT_ISSUE1(t0, 0); if (n > 1) ATT_ISSUE1(t0 + 1, SLOT);
    int base = 0;
    for (int i = 0; i < n; i += 2) {
        ATT_WAIT_BAR(0);
        const int nb = 2 * SLOT - base;
        if (i + 2 < n) ATT_ISSUE1(t0 + i + 2, nb); if (i + 3 < n) ATT_ISSUE1(t0 + i + 3, nb + SLOT);
        if (i + 1 < n) fn2(t0 + i, kp0 + base, vp0 + base, kp0 + base + SLOT, vp0 + base + SLOT); else fn1(t0 + i, kp0 + base, vp0 + base);
        base = nb;
    }
    asm volatile("s_waitcnt lgkmcnt(0)\n\ts_barrier" ::: "memory");
#undef ATT_ISSUE1
}
__device__ __forceinline__ void qk_tile(f32x16& s0, f32x16& s1, lds_cptr kp, const bf16x8 (&qr)[4]) {
    bf16x8 kf[8];
    { const int l = fresh_lane(), f = ((l & 31) >> 1) & 7, hi = l >> 5;
#pragma unroll
      for (int d0 = 0; d0 < 4; ++d0) { const int off = ((2 * d0 + hi) ^ f) << 4; kf[2 * d0] = *(const LAS bf16x8*)(kp + off); kf[2 * d0 + 1] = *(const LAS bf16x8*)(kp + 4096 + off); } }
    const f32x16 z = {};
    s0 = MFMA32(kf[0], qr[0], z); s1 = MFMA32(kf[1], qr[0], z);
#pragma unroll
    for (int d0 = 1; d0 < 4; ++d0) { s0 = MFMA32(kf[2 * d0], qr[d0], s0); s1 = MFMA32(kf[2 * d0 + 1], qr[d0], s1); }
}
template <bool MASK>
__device__ __forceinline__ void pv_tile(f32x16 (&o)[2], lds_cptr vp, const f32x16& p0, const f32x16& p1, unsigned mask) {
    if (ATT_ABL & 8) { o[0][0] += p0[0] + p1[5]; return; }
    u32x4 pw0 = {cvtpk(p0[0], p0[1]), cvtpk(p0[2], p0[3]), cvtpk(p0[4], p0[5]), cvtpk(p0[6], p0[7])}, pw1 = {cvtpk(p0[8], p0[9]), cvtpk(p0[10], p0[11]), cvtpk(p0[12], p0[13]), cvtpk(p0[14], p0[15])};
    u32x4 pw2 = {cvtpk(p1[0], p1[1]), cvtpk(p1[2], p1[3]), cvtpk(p1[4], p1[5]), cvtpk(p1[6], p1[7])}, pw3 = {cvtpk(p1[8], p1[9]), cvtpk(p1[10], p1[11]), cvtpk(p1[12], p1[13]), cvtpk(p1[14], p1[15])};
    if (MASK) { pw0 &= mask; pw1 &= mask; pw2 &= mask; pw3 &= mask; }
    if (ATT_ABL & 64) { o[0] = MFMA32(__builtin_bit_cast(bf16x8, pw0), __builtin_bit_cast(bf16x8, pw1), o[0]); o[1] = MFMA32(__builtin_bit_cast(bf16x8, pw2), __builtin_bit_cast(bf16x8, pw3), o[1]); return; }
    s16x4 vlo[8], vhi[8];
#pragma unroll
    for (int i = 0; i < 8; ++i) { vlo[i] = vtr(vp + ((i >> 2) * 4096 + (i & 3) * 1024)); vhi[i] = vtr(vp + ((i >> 2) * 4096 + (i & 3) * 1024 + 512)); }
#define ATT_VFR(i) (bf16x8){vlo[i][0], vlo[i][1], vlo[i][2], vlo[i][3], vhi[i][0], vhi[i][1], vhi[i][2], vhi[i][3]}
    o[0] = MFMA32(__builtin_bit_cast(bf16x8, pw0), ATT_VFR(0), o[0]); o[1] = MFMA32(__builtin_bit_cast(bf16x8, pw0), ATT_VFR(4), o[1]);
    o[0] = MFMA32(__builtin_bit_cast(bf16x8, pw1), ATT_VFR(1), o[0]); o[1] = MFMA32(__builtin_bit_cast(bf16x8, pw1), ATT_VFR(5), o[1]);
    o[0] = MFMA32(__builtin_bit_cast(bf16x8, pw2), ATT_VFR(2), o[0]); o[1] = MFMA32(__builtin_bit_cast(bf16x8, pw2), ATT_VFR(6), o[1]);
    o[0] = MFMA32(__builtin_bit_cast(bf16x8, pw3), ATT_VFR(3), o[0]); o[1] = MFMA32(__builtin_bit_cast(bf16x8, pw3), ATT_VFR(7), o[1]);
#undef ATT_VFR
}
#define ATT_SB() __builtin_amdgcn_sched_barrier(0)
struct KF { bf16x8 f[8]; };
struct VF { s16x4 lo[8], hi[8]; };
struct PW4 { u32x4 w0, w1, w2, w3; };
__device__ __forceinline__ void ld_k(KF& k, lds_cptr kp) {
    const int l = fresh_lane(), f = ((l & 31) >> 1) & 7, hi = l >> 5;
#pragma unroll
    for (int d0 = 0; d0 < 4; ++d0) { const int off = ((2 * d0 + hi) ^ f) << 4; k.f[2 * d0] = *(const LAS bf16x8*)(kp + off); k.f[2 * d0 + 1] = *(const LAS bf16x8*)(kp + 4096 + off); } }
__device__ __forceinline__ void qk_mfma(f32x16& s0, f32x16& s1, const KF& k, const bf16x8 (&qr)[4]) {
    const f32x16 z = {};
    s0 = MFMA32(k.f[0], qr[0], z); s1 = MFMA32(k.f[1], qr[0], z);
#pragma unroll
    for (int d0 = 1; d0 < 4; ++d0) { s0 = MFMA32(k.f[2 * d0], qr[d0], s0); s1 = MFMA32(k.f[2 * d0 + 1], qr[d0], s1); } }
__device__ __forceinline__ void ld_v(VF& v, lds_cptr vp) {
#pragma unroll
    for (int i = 0; i < 8; ++i) { v.lo[i] = vtr(vp + ((i >> 2) * 4096 + (i & 3) * 1024)); v.hi[i] = vtr(vp + ((i >> 2) * 4096 + (i & 3) * 1024 + 512)); } }
__device__ __forceinline__ PW4 pack4(const f32x16& p0, const f32x16& p1, unsigned mask) { PW4 w;
    w.w0 = (u32x4){cvtpk(p0[0], p0[1]), cvtpk(p0[2], p0[3]), cvtpk(p0[4], p0[5]), cvtpk(p0[6], p0[7])}; w.w1 = (u32x4){cvtpk(p0[8], p0[9]), cvtpk(p0[10], p0[11]), cvtpk(p0[12], p0[13]), cvtpk(p0[14], p0[15])};
    w.w2 = (u32x4){cvtpk(p1[0], p1[1]), cvtpk(p1[2], p1[3]), cvtpk(p1[4], p1[5]), cvtpk(p1[6], p1[7])}; w.w3 = (u32x4){cvtpk(p1[8], p1[9]), cvtpk(p1[10], p1[11]), cvtpk(p1[12], p1[13]), cvtpk(p1[14], p1[15])};
    w.w0 &= mask; w.w1 &= mask; w.w2 &= mask; w.w3 &= mask; return w; }
__device__ __forceinline__ void pv_mfma(f32x16 (&o)[2], const VF& v, const PW4& w) {
#define ATT_VF(i) (bf16x8){v.lo[i][0], v.lo[i][1], v.lo[i][2], v.lo[i][3], v.hi[i][0], v.hi[i][1], v.hi[i][2], v.hi[i][3]}
    o[0] = MFMA32(__builtin_bit_cast(bf16x8, w.w0), ATT_VF(0), o[0]); o[1] = MFMA32(__builtin_bit_cast(bf16x8, w.w0), ATT_VF(4), o[1]);
    o[0] = MFMA32(__builtin_bit_cast(bf16x8, w.w1), ATT_VF(1), o[0]); o[1] = MFMA32(__builtin_bit_cast(bf16x8, w.w1), ATT_VF(5), o[1]);
    o[0] = MFMA32(__builtin_bit_cast(bf16x8, w.w2), ATT_VF(2), o[0]); o[1] = MFMA32(__builtin_bit_cast(bf16x8, w.w2), ATT_VF(6), o[1]);
    o[0] = MFMA32(__builtin_bit_cast(bf16x8, w.w3), ATT_VF(3), o[0]); o[1] = MFMA32(__builtin_bit_cast(bf16x8, w.w3), ATT_VF(7), o[1]);
#undef ATT_VF
}
__device__ __forceinline__ float rowsum32(const f32x16& p0, const f32x16& p1) { if (ATT_ABL & 32) return p0[0]; float a = p0[0] + p1[0], b = p0[1] + p1[1];
#pragma unroll
    for (int r = 2; r < 16; r += 2) { a += p0[r]; asm volatile("" : "+v"(a)); b += p0[r + 1]; asm volatile("" : "+v"(b)); a += p1[r]; asm volatile("" : "+v"(a)); b += p1[r + 1]; asm volatile("" : "+v"(b)); }
    return a + b; }
__device__ __forceinline__ void hook_exp(f32x16& s0, f32x16& s1) {
    if (ATT_ABL & 16) return;
#pragma unroll
    for (int r = 0; r < 16; ++r) { s0[r] = __builtin_amdgcn_exp2f(s0[r]); s1[r] = __builtin_amdgcn_exp2f(s1[r]); } }
__device__ __forceinline__ void hook_near(f32x16& s0, f32x16& s1, int base, const LAS float* lut) {
    asm volatile("" : "+v"(base));
#pragma unroll
    for (int r = 0; r < 16; ++r) { const int d0 = base - ((r & 3) + 8 * (r >> 2)), d1 = d0 - 32;
        s0[r] = __builtin_amdgcn_exp2f(s0[r] + lut[min(max(d0, -1), 113) + 1]); s1[r] = __builtin_amdgcn_exp2f(s1[r] + lut[min(max(d1, -1), 113) + 1]); } }
__device__ __forceinline__ void hook_edge(f32x16& s0, f32x16& s1, int base, int win) {
    asm volatile("" : "+v"(base));
#pragma unroll
    for (int r = 0; r < 16; ++r) { const int d0 = base - ((r & 3) + 8 * (r >> 2)), d1 = d0 - 32;
        s0[r] = __builtin_amdgcn_exp2f(d0 < win ? s0[r] : -INFINITY); s1[r] = __builtin_amdgcn_exp2f(d1 < win ? s1[r] : -INFINITY); } }
__device__ __forceinline__ void hook_cmp(f32x16& s0, f32x16& s1, int nrel  , float cb) {
    asm volatile("" : "+v"(nrel));
#pragma unroll
    for (int r = 0; r < 16; ++r) { const int c0 = (r & 3) + 8 * (r >> 2);
        s0[r] = __builtin_amdgcn_exp2f(s0[r] + ((c0 <= nrel) ? cb : -INFINITY)); s1[r] = __builtin_amdgcn_exp2f(s1[r] + ((c0 + 32 <= nrel) ? cb : -INFINITY)); } }
__device__ __forceinline__ void row_factors(const Ctx& c, float f, float (&fr)[16]) {
    const int lane = fresh_lane(), r32 = lane & 31, hi = lane >> 5; LAS float* wsf = (LAS float*)(c.lds + LDS_WSF) + c.wid * 64;
    asm volatile("s_waitcnt lgkmcnt(0)" ::: "memory");
    if (hi == 0) wsf[r32] = f;
    asm volatile("s_waitcnt lgkmcnt(0)" ::: "memory");
#pragma unroll
    for (int r = 0; r < 16; ++r) fr[r] = wsf[(r & 3) + 8 * (r >> 2) + 4 * hi];
    asm volatile("s_waitcnt lgkmcnt(0)" ::: "memory");
}
__device__ __forceinline__ float pair_sum(float v) { auto rr = __builtin_amdgcn_permlane32_swap(__float_as_uint(v), __float_as_uint(v), false, false); return __uint_as_float(rr[0]) + __uint_as_float(rr[1]); }
template <class RowOff>
__device__ __forceinline__ void store_rows(const Ctx& c, const f32x16 (&o)[2], bf16* dst, RowOff&& rowoff) {
    LAS bf16* stg = (LAS bf16*)(c.lds + LDS_OST) + c.wid * 2048;
    const int lane = fresh_lane(), r32 = lane & 31, hi = lane >> 5;
#pragma unroll
    for (int r = 0; r < 16; ++r) { const int orow = (r & 3) + 8 * (r >> 2) + 4 * hi;
#pragma unroll
        for (int d0 = 0; d0 < 2; ++d0) stg[orow * 64 + d0 * 32 + r32] = (bf16)f2bf(o[d0][r]); }
    asm volatile("s_waitcnt lgkmcnt(0)" ::: "memory");
#pragma unroll
    for (int i = 0; i < 4; ++i) { const int row = i * 8 + (lane >> 3), ch = lane & 7; const u32x4 v = *(const LAS u32x4*)(stg + row * 64 + ch * 8); *(u32x4*)(dst + rowoff(row) + ch * 8) = v; }
    asm volatile("s_waitcnt lgkmcnt(0)" ::: "memory");
}
struct AttnPtrs { const bf16* qkv; const float* kmp; const float* gates; const bf16* kcmp; const bf16* vcmp; const float* rel_bias; bf16* mix; unsigned* selg; bf16* part_o; float* part_l; };

__device__ __forceinline__ void moba_kmean_frags(const AttnPtrs& P, int bh, int r32, int hi, bf16x8 (&kmf)[4]) {
    const float* kp = P.kmp + ((size_t)(bh * 32 + r32) * 2) * 64;
#pragma unroll
    for (int d0 = 0; d0 < 4; ++d0) { const f32x4 a0 = *(const f32x4*)(kp + d0 * 16 + hi * 8), a1 = *(const f32x4*)(kp + d0 * 16 + hi * 8 + 4), b0 = *(const f32x4*)(kp + 64 + d0 * 16 + hi * 8), b1 = *(const f32x4*)(kp + 64 + d0 * 16 + hi * 8 + 4);
        const f32x4 m0 = (a0 + b0) * (1.f / 256.f), m1 = (a1 + b1) * (1.f / 256.f);
        u32x4 w = {cvtpk(m0[0], m0[1]), cvtpk(m0[2], m0[3]), cvtpk(m1[0], m1[1]), cvtpk(m1[2], m1[3])}; kmf[d0] = __builtin_bit_cast(bf16x8, w); }
}
__device__ __forceinline__ unsigned moba_gate32(const bf16x8 (&kmf)[4], int i, const bf16x8 (&qr)[4], int hi) {
    unsigned selmask = 0u;
    if (i > 0) {
        f32x16 sg = {};
#pragma unroll
        for (int d0 = 0; d0 < 4; ++d0) sg = MFMA32(kmf[d0], qr[d0], sg);
        float v[16];
#pragma unroll
        for (int r = 0; r < 16; ++r) v[r] = ((r & 3) + 8 * (r >> 2) + 4 * hi < i) ? sg[r] : -INFINITY;
#pragma unroll
        for (int it = 0; it < 3; ++it) {
            float m = v[0]; int jb = 4 * hi;
#pragma unroll
            for (int r = 1; r < 16; ++r) { const int j = (r & 3) + 8 * (r >> 2) + 4 * hi; if (v[r] > m) { m = v[r]; jb = j; } }
            auto rm = __builtin_amdgcn_permlane32_swap(__float_as_uint(m), __float_as_uint(m), false, false);
            auto rj = __builtin_amdgcn_permlane32_swap((unsigned)jb, (unsigned)jb, false, false);
            const float mo = __uint_as_float(hi ? rm[0] : rm[1]); const int jo = (int)(hi ? rj[0] : rj[1]);
            const bool mine = (m > mo) || (m == mo && jb < jo);
            const float mw = mine ? m : mo; const int jw = mine ? jb : jo;
            if (mw > -INFINITY) { selmask |= 1u << jw;
#pragma unroll
                for (int r = 0; r < 16; ++r) if ((r & 3) + 8 * (r >> 2) + 4 * hi == jw) v[r] = -INFINITY; }
        }
    }
    return selmask;
}
__device__ __forceinline__ void moba_gate_phase(const AttnPtrs& P, int vcu, int G, int tid) {
    const int lane = tid & 63, r32 = lane & 31, hi = lane >> 5; const int wid = __builtin_amdgcn_readfirstlane(tid >> 6);
    for (int grp = vcu * 8 + wid; grp < 2048; grp += G * 8) { const int bh = grp >> 6;
        bf16x8 kmf[4]; moba_kmean_frags(P, bh, r32, hi, kmf);
        const bf16* QA = P.qkv + ((size_t)bh * SEQ) * 64;
#pragma unroll 2
        for (int k = 0; k < 4; ++k) { const int idx = (grp & 63) * 4 + k, i = idx >> 3, w = idx & 7; const int qpos = 256 * i + 32 * w + r32;
            bf16x8 qr[4];
#pragma unroll
            for (int d0 = 0; d0 < 4; ++d0) qr[d0] = *(const bf16x8*)(QA + (size_t)qpos * 64 + d0 * 16 + hi * 8);
            const unsigned m = moba_gate32(kmf, i, qr, hi);
            if (hi == 0) P.selg[(size_t)bh * SEQ + qpos] = m; } }
}
__device__ __forceinline__ void moba_past_item(const Ctx& c, const AttnPtrs& P, int b, int h, int j, int flags = 0) {
    const int bh = b * 8 + h, tid = threadIdx.x;
    const bf16* QA = P.qkv + ((size_t)bh * SEQ) * 64; const bf16* KA = QA + QKV_BIG + (size_t)256 * j * 64; const bf16* VA = QA + 2 * QKV_BIG + (size_t)256 * j * 64;
    const LAS float* lut = (const LAS float*)(c.lds + LDS_LUTG) + h * LUT_PITCH;
    { const int lane = fresh_lane(); const unsigned lds0 = (unsigned)(uintptr_t)c.lds;
      const bf16* ks = KA + ((8 * c.wid + (lane >> 3)) * 64 + (((lane & 7) ^ (((8 * c.wid + (lane >> 3)) >> 1) & 7)) << 3)); const bf16* vs = VA + ((16 * (c.wid & 3) + (lane >> 2)) * 64 + (c.wid >> 2) * 32 + (lane & 3) * 8);
#pragma unroll
      for (int tt = 0; tt < 4; ++tt) { glds16(ks + tt * 4096, (unsigned)__builtin_amdgcn_readfirstlane(lds0 + c.wid * 1024 + tt * SLOT)); glds16(vs + tt * 4096, (unsigned)__builtin_amdgcn_readfirstlane(lds0 + 8192 + c.wid * 1024 + tt * SLOT)); } }
    LAS unsigned short* list = (LAS unsigned short*)(c.lds + LDS_IMP);
    LAS unsigned* wcnt = (LAS unsigned*)(c.lds + LDS_MISC) + 8;
    const unsigned* sg = P.selg + (size_t)bh * SEQ;
    if (tid < 256) list[tid] = (unsigned short)((256 * j + tid) | (3 << 13));
    int total = 256;
    for (int base = (j + 1) * 256; base < SEQ; base += 2048) {
        const int q0 = base + 4 * tid; uint4 m4 = make_uint4(0u, 0u, 0u, 0u); if (q0 < SEQ) m4 = *(const uint4*)(sg + q0);
        const unsigned long long b0 = __ballot((m4.x >> j) & 1u), b1 = __ballot((m4.y >> j) & 1u), b2 = __ballot((m4.z >> j) & 1u), b3 = __ballot((m4.w >> j) & 1u);
        const int c0 = (int)__popcll(b0), c1 = (int)__popcll(b1), c2 = (int)__popcll(b2), c3 = (int)__popcll(b3);
        if ((tid & 63) == 0) wcnt[c.wid] = (unsigned)(c0 + c1 + c2 + c3);
        asm volatile("s_waitcnt vmcnt(0) lgkmcnt(0)\n\ts_barrier" ::: "memory");
        int off = total, tot = 0;
#pragma unroll
        for (int w = 0; w < 8; ++w) { const int v = (int)wcnt[w]; off += (w < c.wid) ? v : 0; tot += v; }
        const unsigned long long below = (1ull << (tid & 63)) - 1ull; const unsigned lowj = (1u << j) - 1u;
        if ((m4.x >> j) & 1u) list[off + __popcll(b0 & below)] = (unsigned short)((q0 + 0) | (__popc(m4.x & lowj) << 13)); off += c0;
        if ((m4.y >> j) & 1u) list[off + __popcll(b1 & below)] = (unsigned short)((q0 + 1) | (__popc(m4.y & lowj) << 13)); off += c1;
        if ((m4.z >> j) & 1u) list[off + __popcll(b2 & below)] = (unsigned short)((q0 + 2) | (__popc(m4.z & lowj) << 13)); off += c2;
        if ((m4.w >> j) & 1u) list[off + __popcll(b3 & below)] = (unsigned short)((q0 + 3) | (__popc(m4.w & lowj) << 13));
        total += tot;
        asm volatile("s_waitcnt lgkmcnt(0)\n\ts_barrier" ::: "memory");
    }
    total = __builtin_amdgcn_readfirstlane(total);
    { const int npad = (32 - (total & 31)) & 31; if (tid < npad) list[total + tid] = 0xFFFFu; }
    const int nchunks = (total + 31) >> 5;
    asm volatile("s_waitcnt vmcnt(0) lgkmcnt(0)\n\ts_barrier" ::: "memory");
    unsigned e_n = 0xFFFFu; bf16x8 qn[4];
    if (c.wid < nchunks) { const int l0 = fresh_lane(); e_n = list[32 * c.wid + (l0 & 31)]; const int q0 = (e_n != 0xFFFFu) ? (int)(e_n & 0x1FFFu) : SEQ - 1;
#pragma unroll
        for (int d0 = 0; d0 < 4; ++d0) qn[d0] = *(const bf16x8*)(QA + (size_t)q0 * 64 + d0 * 16 + (l0 >> 5) * 8); }
    if (!(flags & 64)) for (int ch = c.wid; ch < nchunks; ch += 8) {
        const int lane = fresh_lane(), r32 = lane & 31, hi = lane >> 5;
        const lds_cptr kp0 = (lds_cptr)c.lds + r32 * 128;
        const lds_cptr vp0 = (lds_cptr)c.lds + 8192 + ((lane >> 4) & 1) * 32 + (lane & 3) * 8 + (4 * hi + ((lane & 15) >> 2)) * 64;
        const unsigned e = e_n; const bool valid = e != 0xFFFFu; const int q = valid ? (int)(e & 0x1FFFu) : SEQ - 1;
        bf16x8 qr[4];
#pragma unroll
        for (int d0 = 0; d0 < 4; ++d0) qr[d0] = qn[d0];
        if (ch + 8 < nchunks) { e_n = list[32 * (ch + 8) + r32]; const int q1 = (e_n != 0xFFFFu) ? (int)(e_n & 0x1FFFu) : SEQ - 1;
#pragma unroll
            for (int d0 = 0; d0 < 4; ++d0) qn[d0] = *(const bf16x8*)(QA + (size_t)q1 * 64 + d0 * 16 + hi * 8); }
        const int ntt = (ch < 8) ? (ch >> 1) + 1 : 4;
        f32x16 o[2]; o[0] = f32x16{}; o[1] = f32x16{}; float l_reg = 0.f;
#pragma unroll 1
        for (int tt = 0; tt < ntt; ++tt) { f32x16 s0, s1; qk_tile(s0, s1, kp0 + tt * SLOT, qr);
            const int dq = q - (256 * j + 64 * tt);
            if (__any(valid && dq < 113 + 63)) hook_near(s0, s1, dq - 4 * hi, lut); else hook_exp(s0, s1);
            l_reg += rowsum32(s0, s1);
            pv_tile<false>(o, vp0 + tt * SLOT, s0, s1, 0u); }
        const float L = pair_sum(l_reg);
        if (hi == 0 && valid) P.part_l[((size_t)bh * SEQ + q) * 4 + (e >> 13)] = L;
        LAS bf16* stg = (LAS bf16*)(c.lds + LDS_OST) + c.wid * 2048;
#pragma unroll
        for (int r = 0; r < 16; ++r) { const int orow = (r & 3) + 8 * (r >> 2) + 4 * hi;
#pragma unroll
            for (int d0 = 0; d0 < 2; ++d0) stg[orow * 64 + d0 * 32 + r32] = (bf16)f2bf(o[d0][r]); }
        asm volatile("s_waitcnt lgkmcnt(0)" ::: "memory");
#pragma unroll
        for (int it = 0; it < 4; ++it) { const int row = it * 8 + (lane >> 3), chn = lane & 7; const unsigned e2 = list[32 * ch + row];
            const u32x4 v = *(const LAS u32x4*)(stg + row * 64 + chn * 8);
            if (e2 != 0xFFFFu) *(u32x4*)(P.part_o + (((size_t)bh * SEQ + (e2 & 0x1FFFu)) * 4 + (e2 >> 13)) * 64 + chn * 8) = v; }
        asm volatile("s_waitcnt lgkmcnt(0)" ::: "memory");
    }
    asm volatile("s_waitcnt lgkmcnt(0)\n\ts_barrier" ::: "memory");
}
__device__ __forceinline__ void moba_merge_pass(const AttnPtrs& P, int vcu, int G, int tid) {
    const int lane = tid & 63, h = lane >> 3, chn = lane & 7; const int wid = __builtin_amdgcn_readfirstlane(tid >> 6);
#pragma unroll 4
    for (int tok = vcu * 8 + wid; tok < TOK; tok += G * 8) { const int b = tok >> 13, q = tok & (SEQ - 1);
        const size_t qi = (size_t)(b * 8 + h) * SEQ + q; const int ns = __popc(P.selg[qi]);
        float Lt = P.part_l[qi * 4 + 3]; const u32x4 pw = *(const u32x4*)(P.part_o + (qi * 4 + 3) * 64 + chn * 8);
        f32x4 a0 = {__uint_as_float(pw.x << 16), __uint_as_float(pw.x & 0xffff0000u), __uint_as_float(pw.y << 16), __uint_as_float(pw.y & 0xffff0000u)};
        f32x4 a1 = {__uint_as_float(pw.z << 16), __uint_as_float(pw.z & 0xffff0000u), __uint_as_float(pw.w << 16), __uint_as_float(pw.w & 0xffff0000u)};
#pragma unroll
        for (int sidx = 0; sidx < 3; ++sidx) if (sidx < ns) { Lt += P.part_l[qi * 4 + sidx]; const u32x4 pv = *(const u32x4*)(P.part_o + (qi * 4 + sidx) * 64 + chn * 8);
            a0 += (f32x4){__uint_as_float(pv.x << 16), __uint_as_float(pv.x & 0xffff0000u), __uint_as_float(pv.y << 16), __uint_as_float(pv.y & 0xffff0000u)};
            a1 += (f32x4){__uint_as_float(pv.z << 16), __uint_as_float(pv.z & 0xffff0000u), __uint_as_float(pv.w << 16), __uint_as_float(pv.w & 0xffff0000u)}; }
        const float inv = 1.f / Lt; a0 *= inv; a1 *= inv;
        const u32x4 w = {cvtpk(a0[0], a0[1]), cvtpk(a0[2], a0[3]), cvtpk(a1[0], a1[1]), cvtpk(a1[2], a1[3])};
        *(u32x4*)(P.mix + (size_t)tok * DM + h * 64 + chn * 8) = w; }
}

__device__ __forceinline__ void nsa_item(const Ctx& c, const AttnPtrs& P, int b, int g, int ci, int flags = 0) {
    const int ql = 8 * c.wid + (c.r32 >> 2), rh = c.r32 & 3, qpos = 64 * ci + ql, hb = 4 * g + rh;
    const int qw0 = 64 * ci + 8 * c.wid;
    const bf16* QB = P.qkv + 3 * QKV_BIG + ((size_t)(b * 8 + hb) * SEQ) * 64;
    const bf16* KS = P.qkv + 4 * QKV_BIG + 2 * QKV_SMALL + ((size_t)(b * 2 + g) * SEQ) * 64; const bf16* VS = KS + QKV_SMALL; const bf16* KW = KS + 2 * QKV_SMALL; const bf16* VW = KS + 3 * QKV_SMALL;
    const bf16* KC = P.kcmp + (size_t)(b * 2 + g) * 512 * 64; const bf16* VC = P.vcmp + (size_t)(b * 2 + g) * 512 * 64;
    bf16x8 qr[4];
#pragma unroll
    for (int d0 = 0; d0 < 4; ++d0) qr[d0] = *(const bf16x8*)(QB + (size_t)qpos * 64 + d0 * 16 + c.hi * 8);
    asm volatile("" : "+v"(qr[0]), "+v"(qr[1]), "+v"(qr[2]), "+v"(qr[3]));
    const LAS float* lut = (const LAS float*)(c.lds + LDS_LUTG) + (8 + hb) * LUT_PITCH;
    LAS float* imp = (LAS float*)(c.lds + LDS_IMP);
    LAS unsigned* selm = (LAS unsigned*)(c.lds + LDS_SELM);
    f32x16 o[2]; float l_reg; float fr[16];
    LAS float* park = (LAS float*)(c.lds + LDS_OST) + c.wid * 1024 + c.lane;
    LAS float* park1 = (LAS float*)(c.lds + LDS_IMP) + c.wid * 1024 + c.lane;
    const int nct = (4 * ci + 3 + 63) >> 6;
    const int nlim = (qpos >= 31) ? ((qpos - 31) >> 4) : -1;
    const int nlim_w = (qw0 >= 31) ? ((qw0 - 31) >> 4) : -1;
    LAS bf16* impt = (LAS bf16*)(c.lds + ((rh & 2) ? LDS_IMP : LDS_OST)) + ((rh & 2) ? IMP_REG1 : 0) + (rh & 1) * IMP_PLANE + ql * IMP_PITCH;
    l_reg = 0.f; o[0] = f32x16{}; o[1] = f32x16{};
    {
        float carry = 0.f;
        if (!(flags & 32)) run_stream<true>(c, KC, VC, 0, nct,
          [&](int t, lds_cptr kp, f32x16& s0, f32x16& s1) { qk_tile(s0, s1, kp, qr); },
          [&](int t, lds_cptr vp, f32x16& s0, f32x16& s1) {
            if (nlim_w - 64 * t >= 63) hook_exp(s0, s1); else hook_cmp(s0, s1, nlim - 64 * t - 4 * c.hi, 0.f);
            l_reg += rowsum32(s0, s1);
#pragma unroll
            for (int half = 0; half < 2; ++half) {
                float g4[4], e[4];
#pragma unroll
                for (int a = 0; a < 4; ++a) { const float x0 = half ? s1[4 * a] : s0[4 * a], x1 = half ? s1[4 * a + 1] : s0[4 * a + 1], x2 = half ? s1[4 * a + 2] : s0[4 * a + 2], x3 = half ? s1[4 * a + 3] : s0[4 * a + 3];
                    g4[a] = (x0 + x1) + (x2 + x3); e[a] = x3; }
                float x[4];
#pragma unroll
                for (int a = 0; a < 4; ++a) { auto rr = __builtin_amdgcn_permlane32_swap(__float_as_uint(e[a]), __float_as_uint(e[a]), false, false); x[a] = __uint_as_float(c.hi ? rr[0] : rr[1]); }
                const int jb = 16 * t + 8 * half;
                float iv[4];
                if (c.hi) {
#pragma unroll
                    for (int a = 0; a < 4; ++a) iv[a] = g4[a] + x[a]; }
                else { iv[0] = g4[0] + carry; iv[1] = g4[1] + x[0]; iv[2] = g4[2] + x[1]; iv[3] = g4[3] + x[2]; carry = x[3]; }
#pragma unroll
                for (int a = 0; a < 4; ++a) impt[jb + 2 * a + c.hi] = (bf16)f2bf(iv[a]);
            }
            pv_tile<false>(o, vp, s0, s1, 0u);
        });
    }
    const float Lc = pair_sum(l_reg); const float invLc = Lc > 0.f ? 1.f / Lc : 0.f;
    { LAS float* wsfw = (LAS float*)(c.lds + LDS_WSF) + c.wid * 64; if (c.hi == 0) wsfw[32 + c.r32] = invLc; }
    const float* gp = P.gates + ((size_t)b * SEQ + qpos) * 24 + hb * 3; float g0 = gp[0], g1 = gp[1], g2 = gp[2];
    {
        asm volatile("s_waitcnt lgkmcnt(0)\n\ts_barrier" ::: "memory");
        const int fl = fresh_lane(); const int qq = 8 * c.wid + (fl >> 3), cc = fl & 7;
        unsigned m0 = 0u, m1 = 0u, m2w = 0u, m3 = 0u;
        if (ci <= 15 || (flags & 16)) { m0 = (ci >= 31) ? 0xffffffffu : ((2u << ci) - 1u); }
        else {
            unsigned v[16];
            const LAS float* il = (const LAS float*)(c.lds + LDS_WSF) + c.wid * 64 + 32 + 4 * (fl >> 3);
            const float i0 = il[0], i1 = il[1], i2 = il[2], i3 = il[3];
            const LAS bf16* ta = (const LAS bf16*)(c.lds + LDS_OST) + qq * IMP_PITCH; const LAS bf16* tb = (const LAS bf16*)(c.lds + LDS_IMP) + IMP_REG1 + qq * IMP_PITCH;
#pragma unroll
            for (int k = 0; k < 16; ++k) { const int j = cc + 8 * k;
                const float val = (bf2f(ta[j]) * i0 + bf2f(ta[IMP_PLANE + j]) * i1) + (bf2f(tb[j]) * i2 + bf2f(tb[IMP_PLANE + j]) * i3);
                v[k] = (j >= 1 && j <= ci - 2) ? ((__float_as_uint(val) & ~127u) | (unsigned)(127 - j)) : 0u; }
            for (int it = 0; it < 13; ++it) {
                unsigned m = v[0];
#pragma unroll
                for (int k = 1; k < 16; ++k) m = max(m, v[k]);
#pragma unroll
                for (int sft = 1; sft < 8; sft <<= 1) m = max(m, (unsigned)__shfl_xor((int)m, sft));
                if (m != 0u) { const int jb = 127 - (int)(m & 127u); const unsigned bit = 1u << (jb & 31); const int wsel = jb >> 5;
                    m0 |= (wsel == 0) ? bit : 0u; m1 |= (wsel == 1) ? bit : 0u; m2w |= (wsel == 2) ? bit : 0u; m3 |= (wsel == 3) ? bit : 0u;
#pragma unroll
                    for (int k = 0; k < 16; ++k) v[k] = (v[k] == m) ? 0u : v[k]; }
            }
            m0 |= 1u;
#pragma unroll
            for (int z = 0; z < 2; ++z) { const int jf = ci - z; const unsigned bit = 1u << (jf & 31); const int wsel = jf >> 5;
                m0 |= (wsel == 0) ? bit : 0u; m1 |= (wsel == 1) ? bit : 0u; m2w |= (wsel == 2) ? bit : 0u; m3 |= (wsel == 3) ? bit : 0u; }
        }
        if (cc == 0) { selm[qq * 4 + 0] = m0; selm[qq * 4 + 1] = m1; selm[qq * 4 + 2] = m2w; selm[qq * 4 + 3] = m3; }
        asm volatile("s_waitcnt lgkmcnt(0)\n\ts_barrier" ::: "memory");
    }
    asm volatile("" : "+v"(g0), "+v"(g1), "+v"(g2));
    row_factors(c, g0 * invLc, fr);
#pragma unroll
    for (int r = 0; r < 16; ++r) { park[r * 64] = o[0][r] * fr[r]; park1[r * 64] = o[1][r] * fr[r]; }
    {
        const unsigned w0 = selm[ql * 4 + 0], w1 = selm[ql * 4 + 1], w2 = selm[ql * 4 + 2], w3 = selm[ql * 4 + 3];
        o[0] = f32x16{}; o[1] = f32x16{}; l_reg = 0.f;
        auto sel_pred = [&](int t) -> bool { const unsigned wsel = (t < 32) ? w0 : (t < 64) ? w1 : (t < 96) ? w2 : w3; return (wsel >> (t & 31)) & 1u; };
        auto sel_one = [&](int t, lds_cptr kp, lds_cptr vp) { const bool pred = sel_pred(t); if (!__any(pred)) return; const int key0 = 64 * t;
            f32x16 s0, s1; qk_tile(s0, s1, kp, qr);
            if (qw0 - key0 - 63 >= 113) { hook_exp(s0, s1); const float rs = rowsum32(s0, s1); l_reg += pred ? rs : 0.f;
                if (__all(pred)) pv_tile<false>(o, vp, s0, s1, 0u); else pv_tile<true>(o, vp, s0, s1, pred ? 0xffffffffu : 0u); }
            else { hook_near(s0, s1, qpos - key0 - 4 * c.hi, lut); const float rs = rowsum32(s0, s1); l_reg += pred ? rs : 0.f;
                if (__all(pred)) pv_tile<false>(o, vp, s0, s1, 0u); else pv_tile<true>(o, vp, s0, s1, pred ? 0xffffffffu : 0u); } };
        if (!(flags & 4)) run_stream_pairs(c, KS, VS, 0, ci + 1, sel_one,
            [&](int t, lds_cptr kpA, lds_cptr vpA, lds_cptr kpB, lds_cptr vpB) {
                if (qw0 - 64 * (t + 1) - 63 >= 113) {
                    const bool pa = sel_pred(t), pb = sel_pred(t + 1);
                    const bool xa = __any(pa), xb = __any(pb);
                    if (!xa && !xb) return;
                    if (!xb) { sel_one(t, kpA, vpA); return; }
                    if (!xa) { sel_one(t + 1, kpB, vpB); return; }
                    KF kA, kB; ld_k(kA, kpA); ATT_SB();
                    f32x16 a0, a1, b0, b1; qk_mfma(a0, a1, kA, qr); ATT_SB();
                    VF vA, vB; ld_k(kB, kpB); ld_v(vA, vpA); ATT_SB();
                    qk_mfma(b0, b1, kB, qr); hook_exp(a0, a1);
                    const float ra = rowsum32(a0, a1); const PW4 wa = pack4(a0, a1, pa ? 0xffffffffu : 0u); ATT_SB();
                    ld_v(vB, vpB); ATT_SB();
                    pv_mfma(o, vA, wa); hook_exp(b0, b1);
                    const float rb = rowsum32(b0, b1); const PW4 wb = pack4(b0, b1, pb ? 0xffffffffu : 0u); l_reg += (pa ? ra : 0.f) + (pb ? rb : 0.f); ATT_SB();
                    pv_mfma(o, vB, wb);
                } else { sel_one(t, kpA, vpA); sel_one(t + 1, kpB, vpB); } });
        const float Ls = pair_sum(l_reg);
        row_factors(c, g1 / Ls, fr);
#pragma unroll
        for (int r = 0; r < 16; ++r) { park[r * 64] += o[0][r] * fr[r]; park1[r * 64] += o[1][r] * fr[r]; }
    }
    {
        o[0] = f32x16{}; o[1] = f32x16{}; l_reg = 0.f;
        if (!(flags & 8)) run_stream<true>(c, KW, VW, ci >= 8 ? ci - 8 : 0, ci + 1,
            [&](int t, lds_cptr kp, f32x16& s0, f32x16& s1) { qk_tile(s0, s1, kp, qr); },
            [&](int t, lds_cptr vp, f32x16& s0, f32x16& s1) { const int key0 = 64 * t;
                if (qw0 - key0 - 63 < 113) hook_near(s0, s1, qpos - key0 - 4 * c.hi, lut); else if (qw0 + 7 - key0 >= 512) hook_edge(s0, s1, qpos - key0 - 4 * c.hi, 512); else hook_exp(s0, s1);
                l_reg += rowsum32(s0, s1);
                pv_tile<false>(o, vp, s0, s1, 0u); });
        const float Lw = pair_sum(l_reg);
        row_factors(c, g2 / Lw, fr);
#pragma unroll
        for (int r = 0; r < 16; ++r) { o[0][r] = park[r * 64] + o[0][r] * fr[r]; o[1][r] = park1[r * 64] + o[1][r] * fr[r]; }
        asm volatile("s_waitcnt lgkmcnt(0)" ::: "memory");
    }
    bf16* dst = P.mix + ((size_t)b * SEQ + 64 * ci + 8 * c.wid) * DM + 512 + g * 256;
    store_rows(c, o, dst, [](int row) { return (size_t)(row >> 2) * DM + (row & 3) * 64; });
    asm volatile("s_waitcnt lgkmcnt(0)\n\ts_barrier" ::: "memory");
}

__device__ __forceinline__ void attn_phase(LAS unsigned char* lds, const AttnPtrs& P, unsigned* qcounter, int flags) {
    Ctx c = make_ctx(lds, threadIdx.x);
    LAS unsigned* misc = (LAS unsigned*)(c.lds + LDS_MISC);
    { LAS float* lutg = (LAS float*)(c.lds + LDS_LUTG);
      for (int idx = threadIdx.x; idx < 16 * 115; idx += NTHREADS) { const int hh = idx / 115, d = idx % 115;
          lutg[hh * LUT_PITCH + d] = (d == 0) ? -INFINITY : (P.rel_bias[t5_bucket(d - 1) * 16 + hh] - P.rel_bias[31 * 16 + hh]) * LOG2E; }
      asm volatile("s_waitcnt vmcnt(0) lgkmcnt(0)\n\ts_barrier" ::: "memory"); }
    for (;;) {
        if (threadIdx.x == 0) misc[0] = __hip_atomic_fetch_add(qcounter, 1u, __ATOMIC_RELAXED, __HIP_MEMORY_SCOPE_AGENT);
        asm volatile("s_waitcnt vmcnt(0) lgkmcnt(0)\n\ts_barrier" ::: "memory");
        const unsigned k = misc[0];
        asm volatile("s_waitcnt lgkmcnt(0)\n\ts_barrier" ::: "memory");
        if (k >= 2048u) break;
        const bool is_mp = k >= 512u && k < 1536u;
        if (flags & (is_mp ? 2 : 1)) continue;
        if (k < 512u) { const int s_ = 127 - (int)(k >> 3), bg = k & 7; nsa_item(c, P, bg >> 1, bg & 1, s_, flags); }
        else if (k < 1536u) { const int kk = (int)k - 512, j = kk >> 5, bh = kk & 31; moba_past_item(c, P, bh >> 3, bh & 7, j, flags); }
        else { const int kk = (int)k - 1536; const int s_ = 63 - (kk >> 3), bg = kk & 7; nsa_item(c, P, bg >> 1, bg & 1, s_, flags); }
    }
}
#undef MFMA32
#undef ATT_WAIT_BAR
}
namespace cmpr {
using bf16x8 = __attribute__((ext_vector_type(8))) short;
using f32x16 = __attribute__((ext_vector_type(16))) float;
constexpr int HID_PITCH = 528;
__device__ __forceinline__ float gelu_tanh(float v) { const float u = fminf(fmaxf(0.7978845608028654f * (v + 0.044715f * v * v * v), -15.f), 15.f); const float e = __expf(2.f * u); return 0.5f * v * (1.f + (e - 1.f) / (e + 1.f)); }
__device__ __forceinline__ void compress_unit(LAS unsigned char* lds, int unit, const bf16* qkv, const bf16* w1k, const bf16* w1v, const bf16* w2k, const bf16* w2v, const float* cbp, const float* kncmp, bf16* kcmp, bf16* vcmp) {
    const int tid = threadIdx.x, lane = tid & 63, r32 = lane & 31, hi = lane >> 5; const int wid = __builtin_amdgcn_readfirstlane(tid >> 6);
    const int kv = unit & 1, u = (unit >> 1) & 15, bg = unit >> 5;
    const bf16* src = qkv + 4 * QKV_BIG + (kv ? QKV_SMALL : 0) + (size_t)bg * SEQ * 64;
    const bf16* w1 = kv ? w1v : w1k; const bf16* w2 = kv ? w2v : w2k;
    const int n0 = 32 * u;
    { const bf16* sp = src + (size_t)16 * n0 * 64;
      for (int ch = tid; ch < 4224; ch += NTHREADS) { v4u v = {0u, 0u, 0u, 0u}; if (16 * n0 + (ch >> 3) < SEQ) v = *(const GAS v4u*)(sp + (size_t)ch * 8);
          *(LAS v4u*)(lds + ((ch ^ ((ch >> 7) & 15)) << 4)) = v; } }
    asm volatile("s_waitcnt vmcnt(0) lgkmcnt(0)\n\ts_barrier" ::: "memory");
    const bf16* bp = w1 + ((size_t)wid * 64 + lane) * 8;
    f32x16 acc = {};
#pragma unroll 16
    for (int kk = 0; kk < 128; ++kk) { const int lc = r32 * 128 + 2 * kk + hi; const bf16x8 a = *(const LAS bf16x8*)(lds + ((lc ^ ((lc >> 7) & 15)) << 4)), bfr = *(const bf16x8*)(bp + (size_t)kk * 4096); acc = __builtin_amdgcn_mfma_f32_32x32x16_bf16(a, bfr, acc, 0, 0, 0); }
    float cb = 0.f;
#pragma unroll 8
    for (int ic = 0; ic < 32; ++ic) cb += cbp[(ic * 2 + kv) * 256 + 32 * wid + r32];
    LAS unsigned char* hidL = lds + 69632;
#pragma unroll
    for (int r = 0; r < 16; ++r) { const int n = (r & 3) + 8 * (r >> 2) + 4 * hi; *(LAS bf16*)(hidL + n * HID_PITCH + (32 * wid + r32) * 2) = (bf16)f2bf(gelu_tanh(acc[r] + cb)); }
    asm volatile("s_waitcnt lgkmcnt(0)\n\ts_barrier" ::: "memory");
    if (wid == 0) {
        f32x16 o0 = {}, o1 = {};
#pragma unroll 4
        for (int kk = 0; kk < 16; ++kk) { const bf16x8 hb = *(const LAS bf16x8*)(hidL + r32 * HID_PITCH + (16 * kk + 8 * hi) * 2);
            const bf16x8 a0 = *(const bf16x8*)(w2 + (size_t)r32 * 256 + 16 * kk + 8 * hi), a1 = *(const bf16x8*)(w2 + (size_t)(32 + r32) * 256 + 16 * kk + 8 * hi);
            o0 = __builtin_amdgcn_mfma_f32_32x32x16_bf16(a0, hb, o0, 0, 0, 0); o1 = __builtin_amdgcn_mfma_f32_32x32x16_bf16(a1, hb, o1, 0, 0, 0); }
        float rs = 1.f;
        if (!kv) { float ss = 0.f;
#pragma unroll
            for (int r = 0; r < 16; ++r) ss += o0[r] * o0[r] + o1[r] * o1[r];
            auto rr = __builtin_amdgcn_permlane32_swap(__float_as_uint(ss), __float_as_uint(ss), false, false); ss = __uint_as_float(rr[0]) + __uint_as_float(rr[1]);
            rs = rsqrtf(ss * (1.f / 64.f) + 1e-6f); }
        const int n = n0 + r32; bf16* dst = (kv ? vcmp : kcmp) + ((size_t)bg * 512 + n) * 64;
#pragma unroll
        for (int r = 0; r < 16; ++r) { const int d = (r & 3) + 8 * (r >> 2) + 4 * hi;
            float v0 = o0[r] * rs, v1 = o1[r] * rs; if (!kv) { v0 *= kncmp[d]; v1 *= kncmp[d + 32]; }
            if (n >= NCMP) { v0 = 0.f; v1 = 0.f; }
            dst[d] = (bf16)f2bf(v0); dst[d + 32] = (bf16)f2bf(v1); }
    }
    asm volatile("s_waitcnt lgkmcnt(0)\n\ts_barrier" ::: "memory");
}
}
__global__ void __launch_bounds__(NTHREADS, 2) mk_fwd(Args a) {
    extern __shared__ __attribute__((aligned(16))) unsigned char lds[];
    Frame F;
    F.lds = (LAS unsigned char*)lds;
    F.tid = threadIdx.x; F.lane = F.tid & 63; F.wave = __builtin_amdgcn_readfirstlane(F.tid >> 6);
    F.G = gridDim.x; { const int bx = blockIdx.x; F.vcu = (F.G % 8 == 0) ? (bx % 8) * (F.G / 8) + bx / 8 : bx; }
    cg::grid_group grid = cg::this_grid();
    volatile LAS unsigned* xst = (volatile LAS unsigned*)(F.lds + 147424);
    if (F.tid < 8) xst[F.tid] = 0u;
    __syncthreads();
    const XcdBarrier xbar = xcd_barrier_post((unsigned*)(a.ws + WS_CTL) + 4096, xst);
    unsigned char* ws = a.ws;
    const int lo = a.ph_lo, hi = a.ph_hi & 0xff; const int tflags = a.ph_hi >> 8; (void)tflags;
    const att::AttnPtrs P{(const bf16*)(ws + WS_QKV), (const float*)(ws + WS_KMP), (const float*)(ws + WS_GATES), (const bf16*)(ws + WS_KCMP), (const bf16*)(ws + WS_VCMP), a.in[2], (bf16*)(ws + WS_MIX),
                          (unsigned*)(ws + WS_SELG), (bf16*)(ws + WS_PARTO), (float*)(ws + WS_PARTL)};
#define IN(k) (lo <= (k) && (k) < hi)
#define SEAM(k) do { if (IN(k) && IN((k) + 1)) { if ((k) == 0) grid.sync(); else xcd_barrier(xbar); } } while (0)
    if (IN(0)) { phase_prologue_a(F, a); } SEAM(0);
    if (IN(1)) { phase_prologue_b(F, a); } SEAM(1);
    if (IN(2)) {
        pg8::Gemm g{(const pg8::bf16_t*)(ws + WS_H), (const pg8::bf16_t*)(ws + WS_WIN), TOK, NIN_PAD, DM}; pg8::StaticOrder S; S.init(TOK, NIN_PAD, F.G, (int)blockIdx.x);
        pg8::EpiInProj E{(pg8::bf16_t*)(ws + WS_QKV), (float*)(ws + WS_GATES), (float*)(ws + WS_KMP), a.in[7], a.in[8], a.in[9], a.in[11], a.in[12]};
        pg8::gemm_phase<pg8::EpiInProj, pg8::StaticOrder, true, true>(F.lds, g, S, E);
    } SEAM(2);
    if (IN(3)) {
        if (!(tflags & 1)) att::moba_gate_phase(P, F.vcu, F.G, F.tid);
        if (!(tflags & 2)) for (int unit = F.vcu; unit < 256; unit += F.G)
            cmpr::compress_unit(F.lds, unit, (const bf16*)(ws + WS_QKV), (const bf16*)(ws + WS_W1K), (const bf16*)(ws + WS_W1V), (const bf16*)(ws + WS_W2K), (const bf16*)(ws + WS_W2V),
                                (const float*)(ws + WS_CBP), a.in[10], (bf16*)(ws + WS_KCMP), (bf16*)(ws + WS_VCMP));
    } SEAM(3);
    if (IN(4)) {
#if HYBRID == 3
        att::attn_phase(F.lds, P, (unsigned*)(ws + WS_CTL) + 64, tflags);
#else
        att::attn_phase(F.lds, P, (unsigned*)(ws + WS_CTL) + 64, 0);
#endif
    } SEAM(4);
    if (IN(5)) { att::moba_merge_pass(P, F.vcu, F.G, F.tid); } SEAM(5);
    if (IN(6)) {
        pg8::Gemm g{(const pg8::bf16_t*)(ws + WS_MIX), (const pg8::bf16_t*)(ws + WS_WOUT), TOK, DM, DM}; pg8::StaticOrder S; S.init(TOK, DM, F.G, (int)blockIdx.x);
        pg8::EpiOutProj E{(pg8::bf16_t*)(ws + WS_Y), (const float*)(ws + WS_MOD) + 2 * DM};
        pg8::gemm_phase<pg8::EpiOutProj, pg8::StaticOrder, true, true>(F.lds, g, S, E);
    } SEAM(6);
    if (IN(7)) { phase_norm2(F, a); } SEAM(7);
    if (IN(8)) {
        pg8::Gemm g{(const pg8::bf16_t*)(ws + WS_H), (const pg8::bf16_t*)(ws + WS_WGU), TOK, 2 * FF, DM}; pg8::StaticOrder S; S.init(TOK, 2 * FF, F.G, (int)blockIdx.x);
        pg8::EpiGateUp E{(pg8::bf16_t*)(ws + WS_ACT)};
        pg8::gemm_phase<pg8::EpiGateUp, pg8::StaticOrder, true, true>(F.lds, g, S, E);
    } SEAM(8);
    if (IN(9)) {
        pg8::Gemm g{(const pg8::bf16_t*)(ws + WS_ACT), (const pg8::bf16_t*)(ws + WS_WDN), TOK, DM, FF}; pg8::StaticOrder S; S.init(TOK, DM, F.G, (int)blockIdx.x);
        pg8::EpiDown E{a.in[0], (const pg8::bf16_t*)(ws + WS_Y), a.out, (const float*)(ws + WS_MOD) + 5 * DM};
        pg8::gemm_phase<pg8::EpiDown, pg8::StaticOrder, true, true>(F.lds, g, S, E);
    }
#undef IN
#undef SEAM
}

static void launch_phases(const Args& base, int lo, int hi, int grid, hipStream_t stream, int flags = 0) {
    Args a = base; a.ph_lo = lo; a.ph_hi = hi | (flags << 8);
    if (hi - lo > 1) { void* args[] = {&a}; (void)hipLaunchCooperativeKernel((const void*)mk_fwd, dim3(grid), dim3(NTHREADS), args, LDS_BYTES, stream); }
    else hipLaunchKernelGGL(mk_fwd, dim3(grid), dim3(NTHREADS), LDS_BYTES, stream, a);
}
extern "C" void kernel_launch(void* const* d_in, const int* in_sizes, int n_in, void* d_out, int out_size, void* d_ws, size_t ws_size, hipStream_t stream) {
    static int grid = 0;
    if (grid == 0) {
        int dev = 0, cus = 0, per_cu = 0;
        if (n_in != 23 || ws_size < 480 * MiB || hipGetDevice(&dev) != hipSuccess || hipDeviceGetAttribute(&cus, hipDeviceAttributeMultiprocessorCount, dev) != hipSuccess) { grid = -1; return; }
        if (hipFuncSetAttribute((const void*)mk_fwd, hipFuncAttributeMaxDynamicSharedMemorySize, LDS_BYTES) != hipSuccess) { grid = -1; return; }
        if (hipOccupancyMaxActiveBlocksPerMultiprocessor(&per_cu, (const void*)mk_fwd, NTHREADS, LDS_BYTES) != hipSuccess || per_cu < 1) { grid = -1; return; }
        grid = cus;
    }
    if (grid < 0) return;
    (void)hipMemsetAsync((char*)d_ws + WS_CTL, 0, CTL_ZERO_BYTES, stream);
    Args a{};
    for (int i = 0; i < 23; ++i) a.in[i] = (const float*)d_in[i];
    a.out = (float*)d_out; a.ws = (unsigned char*)d_ws;
    unsigned char* ws = (unsigned char*)d_ws;
#if HYBRID == 1
    launch_phases(a, 0, 1, grid, stream); launch_phases(a, 1, 2, grid, stream); launch_phases(a, 2, 3, grid, stream);
    const bf16* qkv = (const bf16*)(ws + WS_QKV); bf16* mix = (bf16*)(ws + WS_MIX); bf16* kcmp = (bf16*)(ws + WS_KCMP); bf16* vcmp = (bf16*)(ws + WS_VCMP);
    int* sel = (int*)(ws + 344 * MiB); float* obuf = (float*)(ws + 348 * MiB); const float* gates = (const float*)(ws + WS_GATES);
    nq::k_compress<<<dim3(4 * 2 * 512, 2), 256, 0, stream>>>(qkv, a.in[13], a.in[14], a.in[15], a.in[16], a.in[17], a.in[18], a.in[10], kcmp, vcmp);
    nq::k_moba<<<4 * 8 * SEQ / 4, 256, 0, stream>>>(qkv, (const float*)(ws + WS_KMP), a.in[2], mix);
    nq::k_nsa_cmp<<<4 * 2 * SEQ, 256, 0, stream>>>(qkv, kcmp, vcmp, gates, obuf, sel);
    nq::k_nsa_sel<<<4 * 2 * SEQ, 256, 0, stream>>>(qkv, sel, a.in[2], gates, obuf);
    nq::k_nsa_win<<<4 * 2 * SEQ, 256, 0, stream>>>(qkv, a.in[2], gates, obuf, mix);
    launch_phases(a, 5, 6, grid, stream); launch_phases(a, 6, 7, grid, stream); launch_phases(a, 7, 8, grid, stream); launch_phases(a, 8, 9, grid, stream);
#elif HYBRID == 2
    launch_phases(a, 0, 1, grid, stream); launch_phases(a, 1, 2, grid, stream); launch_phases(a, 2, 3, grid, stream);
    nq::k_compress<<<dim3(4 * 2 * 512, 2), 256, 0, stream>>>((const bf16*)(ws + WS_QKV), a.in[13], a.in[14], a.in[15], a.in[16], a.in[17], a.in[18], a.in[10], (bf16*)(ws + WS_KCMP), (bf16*)(ws + WS_VCMP));
    launch_phases(a, 4, 5, grid, stream);
    launch_phases(a, 5, 6, grid, stream); launch_phases(a, 6, 7, grid, stream); launch_phases(a, 7, 8, grid, stream); launch_phases(a, 8, 9, grid, stream);
#elif HYBRID == 3
    for (int p = 0; p < N_PHASES; ++p) {
#if defined(TIME_PHASE)
        if (p == TIME_PHASE) { for (int r = 0; r < TIME_REPS; ++r) { launch_phases(a, p, p + 1, grid, stream, TIME_FLAGS); (void)hipMemsetAsync((char*)d_ws + WS_CTL, 0, CTL_ZERO_BYTES, stream); } }
#endif
        launch_phases(a, p, p + 1, grid, stream);
#if defined(ABL_REPS)
        if (p == 3) { static bool once = false; if (!once) { once = true; (void)hipFuncSetAttribute((const void*)k_attn_abl, hipFuncAttributeMaxDynamicSharedMemorySize, LDS_BYTES); }
            for (int r = 0; r < ABL_REPS; ++r) { (void)hipMemsetAsync((char*)d_ws + WS_CTL + 512, 0, 4, stream); hipLaunchKernelGGL(k_attn_abl, dim3(grid), dim3(NTHREADS), LDS_BYTES, stream, a); } }
#endif
    }
#else
    launch_phases(a, 0, N_PHASES, grid, stream);
#endif
}
```

```cpp
#include <hip/hip_runtime.h>
#include <hip/hip_cooperative_groups.h>
#include <cstdint>
#include <cstdio>
namespace cg = cooperative_groups;
#define HYBRID 0
namespace pg8 {
#define PG8_LAS __attribute__((address_space(3)))
typedef unsigned short bf16_t;
typedef short bf16x8 __attribute__((ext_vector_type(8)));
typedef float f32x4 __attribute__((ext_vector_type(4)));
typedef unsigned u32x4 __attribute__((ext_vector_type(4)));
constexpr int BM = 256, BK = 64, HALF = 128, HTB = HALF * BK * 2  , STAGE_BYTES = 8 * HTB, NXCD = 8, WGM = 8;

__host__ __device__ __forceinline__ int lds_byte(int r, int c) { const int st = (r >> 4) * 2 + (c >> 5), rr = r & 15, cc = c & 31, ob = rr * 64 + cc * 2; return st * 1024 + (ob ^ (((ob >> 9) & 1) << 5)); }
__host__ __device__ __forceinline__ void stage_rc(int b, int& R, int& C) { const int st = b / 1024, sb = b % 1024, swz = sb ^ (((sb >> 9) & 1) << 5); R = (st >> 1) * 16 + swz / 64; C = (st & 1) * 32 + (swz % 64) / 2; }
__host__ __device__ __forceinline__ int perm32(int rho) { const int n = rho >> 4, i = rho & 15; return 8 * (i >> 2) + 4 * n + (i & 3); }

struct Unit { int pm, pn; };
struct Gemm { const bf16_t* A; const bf16_t* Bt; int M, N, K; };

struct StaticOrder {
    int nM, nN, nwg, G, c;
    __host__ __device__ void init(int M, int N, int G_, int c_) { nM = M / BM; nN = N / BM; nwg = nM * nN; G = G_; c = c_; }
    __host__ __device__ bool next(int i, Unit& u) const {
        const long L = (long)i * G + c; if (L >= nwg) return false;
        int wgid = (int)L; { const int q = nwg / NXCD, r = nwg % NXCD, xcd = wgid % NXCD, off = wgid / NXCD; wgid = (xcd < r ? xcd * (q + 1) : r * (q + 1) + (xcd - r) * q) + off; }
        const int nig = WGM * nN, gid = wgid / nig, fm = gid * WGM, gsz = (nM - fm) < WGM ? (nM - fm) : WGM;
        u.pm = fm + ((wgid % nig) % gsz); u.pn = (wgid % nig) / gsz; return true;
    }
    __device__ __forceinline__ void a_ready(const Unit&) const {}
    __device__ __forceinline__ void done(const Unit&) const {}
};

__device__ __forceinline__ unsigned cvt_pk_bf16(float lo, float hi) { unsigned r; asm volatile("v_cvt_pk_bf16_f32 %0, %1, %2" : "=v"(r) : "v"(lo), "v"(hi)); return r; }
typedef float f32x2 __attribute__((ext_vector_type(2)));
template <class Epi, class Sched, bool ALIGN_EPI = false, bool SP2 = false>
__device__ __forceinline__ void gemm_phase(PG8_LAS unsigned char* lds, const Gemm g, const Sched& S, const Epi& E) {
    const int tid = threadIdx.x, wid = __builtin_amdgcn_readfirstlane(tid >> 6), lane = tid & 63, wr = wid >> 2, wc = wid & 3, fr = lane & 15, fq = lane >> 4;
    const int K = g.K, nt = K / BK;
    unsigned voffA[2], voffB[2];
#pragma unroll
    for (int i = 0; i < 2; ++i) { int R, C; stage_rc(tid * 16 + i * 8192, R, C); const int Rb = Epi::PERM ? ((R & ~31) + perm32(R & 31)) : R;
        voffA[i] = (unsigned)(R * K + C) * 2u; voffB[i] = (unsigned)(Rb * K + C) * 2u; }
    const size_t kstep = (size_t)(BK * 2);
    const size_t hstep = (size_t)HALF * K * 2;
    const size_t tstep = 2 * hstep;
    const unsigned ldsw = (unsigned)wid * 1024u;
    const int aoff = lds_byte(wr * 64 + fr, fq * 8), boff = lds_byte(wc * 32 + fr, fq * 8);
#define PG8_SA(b, h) (((b) * 2 + (h)) * HTB)
#define PG8_SB(b, h) ((4 + (b) * 2 + (h)) * HTB)
#define PG8_STAGE(bufoff, gbase, voff) do { _Pragma("unroll") for (int _i = 0; _i < 2; ++_i) \
        __builtin_amdgcn_global_load_lds((const unsigned*)((const char*)(gbase) + (voff)[_i]), (PG8_LAS unsigned*)(lds + (bufoff) + ldsw + _i * 8192), 16, 0, 0); } while (0)
#define PG8_LDA(dst, b, h) do { _Pragma("unroll") for (int m = 0; m < 4; ++m) _Pragma("unroll") for (int k = 0; k < 2; ++k) dst[m][k] = *(const PG8_LAS bf16x8*)(lds + PG8_SA(b, h) + aoff + m * 2048 + k * 1024); } while (0)
#define PG8_LDB(dst, b, h) do { _Pragma("unroll") for (int n = 0; n < 2; ++n) _Pragma("unroll") for (int k = 0; k < 2; ++k) dst[n][k] = *(const PG8_LAS bf16x8*)(lds + PG8_SB(b, h) + boff + n * 2048 + k * 1024); } while (0)
#define PG8_MMA(ai, bj, At, Bt) do { __builtin_amdgcn_s_setprio(1); _Pragma("unroll") for (int m = 0; m < 4; ++m) _Pragma("unroll") for (int n = 0; n < 2; ++n) _Pragma("unroll") for (int k = 0; k < 2; ++k) \
        acc[ai][bj][m][n] = __builtin_amdgcn_mfma_f32_16x16x32_bf16(Bt[n][k], At[m][k], acc[ai][bj][m][n], 0, 0, 0); __builtin_amdgcn_s_setprio(0); } while (0)
#define PG8_WAIT_V(n) asm volatile("s_waitcnt vmcnt(" #n ")" ::: "memory")
#define PG8_WAIT_L(n) asm volatile("s_waitcnt lgkmcnt(" #n ")" ::: "memory")
#define PG8_BAR __builtin_amdgcn_s_barrier()
#define PG8_SCHED __builtin_amdgcn_sched_barrier(0)
    Unit cur, nxt; int ui = 0;
    if (!S.next(0, cur)) return;
    f32x4 acc[2][2][4][2];
#pragma unroll
    for (int a = 0; a < 2; ++a)
#pragma unroll
        for (int b = 0; b < 2; ++b)
#pragma unroll
            for (int m = 0; m < 4; ++m)
#pragma unroll
                for (int n = 0; n < 2; ++n) acc[a][b][m][n] = (f32x4){0.f, 0.f, 0.f, 0.f};
    bf16x8 At[4][2], B0[2][2], B1[2][2];
    const char* cA = (const char*)g.A + (size_t)cur.pm * tstep; const char* cB = (const char*)g.Bt + (size_t)cur.pn * tstep;
    S.a_ready(cur);
    if constexpr (SP2) {
        PG8_STAGE(PG8_SB(0, 0), cB, voffB); PG8_STAGE(PG8_SB(0, 1), cB + hstep, voffB); PG8_STAGE(PG8_SA(0, 0), cA, voffA); PG8_STAGE(PG8_SA(0, 1), cA + hstep, voffA);
        if (wr == 1) PG8_BAR;
        PG8_WAIT_V(2); PG8_BAR;
        PG8_STAGE(PG8_SB(1, 0), cB + kstep, voffB); PG8_STAGE(PG8_SA(1, 0), cA + kstep, voffA); PG8_STAGE(PG8_SB(1, 1), cB + hstep + kstep, voffB);
        PG8_WAIT_V(6); PG8_BAR;
    } else {
        PG8_STAGE(PG8_SB(0, 0), cB, voffB); PG8_STAGE(PG8_SA(0, 0), cA, voffA); PG8_STAGE(PG8_SB(0, 1), cB + hstep, voffB); PG8_STAGE(PG8_SA(0, 1), cA + hstep, voffA);
        if (wr == 1) PG8_BAR;
        PG8_WAIT_V(4); PG8_BAR;
        PG8_STAGE(PG8_SB(1, 0), cB + kstep, voffB); PG8_STAGE(PG8_SA(1, 0), cA + kstep, voffA); PG8_STAGE(PG8_SB(1, 1), cB + hstep + kstep, voffB);
        PG8_WAIT_V(6); PG8_BAR;
    }
    for (;;) {
        const bool has_next = S.next(ui + 1, nxt);
        const char* nA = has_next ? (const char*)g.A + (size_t)nxt.pm * tstep : cA; const char* nB = has_next ? (const char*)g.Bt + (size_t)nxt.pn * tstep : cB;
        for (int t = 0; t < nt; t += 2) {
            const bool last = (t == nt - 2);
            const char* a1 = cA + (size_t)(t + 1) * kstep;
            const char* a2 = last ? nA : cA + (size_t)(t + 2) * kstep; const char* b2 = last ? nB : cB + (size_t)(t + 2) * kstep;
            const char* a3 = a2 + kstep; const char* b3 = b2 + kstep;
            if (last && has_next) S.a_ready(nxt);
            if constexpr (SP2) {
            PG8_LDB(B0, 0, 0); PG8_LDB(B1, 0, 1); PG8_SCHED; PG8_LDA(At, 0, 0); PG8_STAGE(PG8_SA(1, 1), a1 + hstep, voffA);
            PG8_WAIT_V(8); PG8_WAIT_L(0); PG8_BAR; PG8_MMA(0, 0, At, B0); PG8_MMA(0, 1, At, B1); PG8_BAR; PG8_SCHED;
            PG8_LDA(At, 0, 1); PG8_STAGE(PG8_SB(0, 0), b2, voffB); PG8_STAGE(PG8_SB(0, 1), b2 + hstep, voffB); PG8_STAGE(PG8_SA(0, 0), a2, voffA);
            PG8_WAIT_V(8); PG8_WAIT_L(0); PG8_BAR; PG8_MMA(1, 0, At, B0); PG8_MMA(1, 1, At, B1); PG8_BAR; PG8_SCHED;
            PG8_LDB(B0, 1, 0); PG8_LDB(B1, 1, 1); PG8_SCHED; PG8_LDA(At, 1, 0); PG8_STAGE(PG8_SA(0, 1), a2 + hstep, voffA);
            PG8_WAIT_V(8); PG8_WAIT_L(0); PG8_BAR; PG8_MMA(0, 0, At, B0); PG8_MMA(0, 1, At, B1); PG8_BAR; PG8_SCHED;
            PG8_LDA(At, 1, 1); PG8_STAGE(PG8_SB(1, 0), b3, voffB); PG8_STAGE(PG8_SB(1, 1), b3 + hstep, voffB); PG8_STAGE(PG8_SA(1, 0), a3, voffA);
            PG8_WAIT_V(8); PG8_WAIT_L(0); PG8_BAR; PG8_MMA(1, 0, At, B0); PG8_MMA(1, 1, At, B1); PG8_BAR; PG8_SCHED;
            } else {
            PG8_LDB(B0, 0, 0); PG8_SCHED; PG8_LDA(At, 0, 0); PG8_STAGE(PG8_SA(1, 1), a1 + hstep, voffA);
            PG8_WAIT_L(8); PG8_BAR; PG8_WAIT_L(0); PG8_MMA(0, 0, At, B0); PG8_BAR; PG8_SCHED;
            PG8_LDB(B1, 0, 1); PG8_STAGE(PG8_SB(0, 0), b2, voffB);
            PG8_BAR; PG8_WAIT_L(0); PG8_MMA(0, 1, At, B1); PG8_BAR;
            PG8_LDA(At, 0, 1); PG8_STAGE(PG8_SA(0, 0), a2, voffA);
            PG8_BAR; PG8_WAIT_L(0); PG8_MMA(1, 0, At, B0); PG8_BAR; PG8_SCHED;
            PG8_STAGE(PG8_SB(0, 1), b2 + hstep, voffB);
            PG8_WAIT_V(6); PG8_BAR; PG8_MMA(1, 1, At, B1); PG8_BAR;
            PG8_LDB(B0, 1, 0); PG8_SCHED; PG8_LDA(At, 1, 0); PG8_STAGE(PG8_SA(0, 1), a2 + hstep, voffA);
            PG8_WAIT_L(8); PG8_BAR; PG8_WAIT_L(0); PG8_MMA(0, 0, At, B0); PG8_BAR; PG8_SCHED;
            PG8_LDB(B1, 1, 1); PG8_STAGE(PG8_SB(1, 0), b3, voffB);
            PG8_BAR; PG8_WAIT_L(0); PG8_MMA(0, 1, At, B1); PG8_BAR;
            PG8_LDA(At, 1, 1); PG8_STAGE(PG8_SA(1, 0), a3, voffA);
            PG8_BAR; PG8_WAIT_L(0); PG8_MMA(1, 0, At, B0); PG8_BAR; PG8_SCHED;
            PG8_STAGE(PG8_SB(1, 1), b3 + hstep, voffB);
            PG8_WAIT_V(6); PG8_BAR; PG8_MMA(1, 1, At, B1); PG8_BAR;
            }
        }
        if constexpr (ALIGN_EPI) { if (wr == 0) PG8_BAR; }
        if constexpr (!Epi::AFTER_DRAIN) { E(acc, cur, wr, wc, fr, fq); S.done(cur); }
        if (!has_next) break;
#pragma unroll
        for (int a = 0; a < 2; ++a)
#pragma unroll
            for (int b = 0; b < 2; ++b)
#pragma unroll
                for (int m = 0; m < 4; ++m)
#pragma unroll
                    for (int n = 0; n < 2; ++n) acc[a][b][m][n] = (f32x4){0.f, 0.f, 0.f, 0.f};
        cur = nxt; cA = nA; cB = nB; ++ui;
        if constexpr (ALIGN_EPI) { if (wr == 1) PG8_BAR; }
    }
    PG8_WAIT_V(0);
    if constexpr (!ALIGN_EPI) { if (wr == 0) PG8_BAR; }
    PG8_BAR;
    if constexpr (Epi::AFTER_DRAIN) { E.fused(acc, cur, wr, wc, fr, fq, lds, wid, lane); S.done(cur); }
#undef PG8_SA
#undef PG8_SB
#undef PG8_STAGE
#undef PG8_LDA
#undef PG8_LDB
#undef PG8_MMA
#undef PG8_WAIT_V
#undef PG8_WAIT_L
#undef PG8_BAR
#undef PG8_SCHED
}
}
namespace pg8 {
typedef unsigned u32x2v __attribute__((ext_vector_type(2)));
constexpr int TOK_S = 8192;
constexpr float QK_EPS = 1e-6f;
constexpr float C2 = 0.125f * 1.4426950408889634f;
__device__ __forceinline__ float sigmoid_fast(float v) { return __builtin_amdgcn_rcpf(1.f + __builtin_amdgcn_exp2f(-1.4426950408889634f * v)); }
__device__ __forceinline__ float silu_fast(float v) { return v * __builtin_amdgcn_rcpf(1.f + __builtin_amdgcn_exp2f(-1.4426950408889634f * v)); }

struct EpiInProj {
    static constexpr bool PERM = true, AFTER_DRAIN = false;
    bf16_t* qkv;
    float* gates;
    float* kmean_part;
    const float *qna, *kna, *qnb, *knsel, *knwin;
    __device__ __forceinline__ void operator()(const f32x4 (&acc)[2][2][4][2], const Unit& u, int wr, int wc, int fr, int fq) const {
        const int slot = u.pn * 4 + wc;
        if (slot > 44) return;
        const int b = u.pm >> 5, blk = u.pm & 31, pos0 = blk * 256 + wr * 64 + fr;
        if (slot == 44) {
            if (fq < 3) {
#pragma unroll
                for (int ai = 0; ai < 2; ++ai)
#pragma unroll
                    for (int m = 0; m < 4; ++m) { const size_t tok = (size_t)b * TOK_S + pos0 + ai * HALF + m * 16; float* gp = gates + tok * 24 + 8 * fq;
                        const f32x4 v0 = acc[ai][0][m][0], v1 = acc[ai][0][m][1];
                        *(f32x4*)gp = (f32x4){sigmoid_fast(v0[0]), sigmoid_fast(v0[1]), sigmoid_fast(v0[2]), sigmoid_fast(v0[3])};
                        *(f32x4*)(gp + 4) = (f32x4){sigmoid_fast(v1[0]), sigmoid_fast(v1[1]), sigmoid_fast(v1[2]), sigmoid_fast(v1[3])}; }
            }
            return;
        }
        const float* gain = nullptr; float qscale = 1.f; bool is_ka = false; bf16_t* dst;
        constexpr size_t BIG = (size_t)4 * 8 * TOK_S * 64, SMALL = (size_t)4 * 2 * TOK_S * 64;
        if (slot < 32) { const int kind = slot >> 3, head = slot & 7; dst = qkv + kind * BIG + ((size_t)(b * 8 + head) * TOK_S) * 64;
            if (kind == 0) { gain = qna; qscale = C2; } else if (kind == 1) { gain = kna; is_ka = true; } else if (kind == 3) { gain = qnb; qscale = C2; } }
        else { const int kind = (slot - 32) >> 1, g = slot & 1; dst = qkv + 4 * BIG + kind * SMALL + ((size_t)(b * 2 + g) * TOK_S) * 64;
            if (kind == 2) gain = knsel; else if (kind == 4) gain = knwin; }
        float gv[16];
#pragma unroll
        for (int i = 0; i < 16; ++i) gv[i] = gain ? gain[(i >> 3) * 32 + 8 * fq + (i & 7)] * qscale : 1.f;
        float cs[16];
#pragma unroll
        for (int i = 0; i < 16; ++i) cs[i] = 0.f;
#pragma unroll
        for (int ai = 0; ai < 2; ++ai)
#pragma unroll
            for (int m = 0; m < 4; ++m) {
                float v[16];
#pragma unroll
                for (int bj = 0; bj < 2; ++bj)
#pragma unroll
                    for (int n = 0; n < 2; ++n)
#pragma unroll
                        for (int j = 0; j < 4; ++j) v[bj * 8 + n * 4 + j] = acc[ai][bj][m][n][j];
                if (gain) { float ss = 0.f;
#pragma unroll
                    for (int i = 0; i < 16; ++i) ss += v[i] * v[i];
                    ss += __shfl_xor(ss, 16); ss += __shfl_xor(ss, 32);
                    const float rs = rsqrtf(ss * (1.f / 64.f) + QK_EPS);
#pragma unroll
                    for (int i = 0; i < 16; ++i) v[i] *= rs * gv[i]; }
                if (is_ka) {
#pragma unroll
                    for (int i = 0; i < 16; ++i) cs[i] += v[i]; }
                bf16_t* rp = dst + (size_t)(pos0 + ai * HALF + m * 16) * 64 + 8 * fq;
                u32x4 w0, w1;
                w0.x = cvt_pk_bf16(v[0], v[1]); w0.y = cvt_pk_bf16(v[2], v[3]); w0.z = cvt_pk_bf16(v[4], v[5]); w0.w = cvt_pk_bf16(v[6], v[7]);
                w1.x = cvt_pk_bf16(v[8], v[9]); w1.y = cvt_pk_bf16(v[10], v[11]); w1.z = cvt_pk_bf16(v[12], v[13]); w1.w = cvt_pk_bf16(v[14], v[15]);
                *(u32x4*)rp = w0; *(u32x4*)(rp + 32) = w1;
            }
        if (is_ka) {
#pragma unroll
            for (int i = 0; i < 16; ++i) { float s = cs[i]; s += __shfl_xor(s, 1); s += __shfl_xor(s, 2); s += __shfl_xor(s, 4); s += __shfl_xor(s, 8); cs[i] = s; }
            if (fr == 0) { float* kp = kmean_part + ((size_t)((b * 8 + (slot & 7)) * 32 + blk) * 2 + wr) * 64 + 8 * fq;
                *(f32x4*)kp = (f32x4){cs[0], cs[1], cs[2], cs[3]}; *(f32x4*)(kp + 4) = (f32x4){cs[4], cs[5], cs[6], cs[7]};
                *(f32x4*)(kp + 32) = (f32x4){cs[8], cs[9], cs[10], cs[11]}; *(f32x4*)(kp + 36) = (f32x4){cs[12], cs[13], cs[14], cs[15]}; }
        }
    }
};
struct EpiOutProj {
    static constexpr bool PERM = true, AFTER_DRAIN = false;
    bf16_t* y; const float* gt;
    __device__ __forceinline__ void operator()(const f32x4 (&acc)[2][2][4][2], const Unit& u, int wr, int wc, int fr, int fq) const {
        const int b = u.pm >> 5; const int col0 = u.pn * BM + wc * 32 + 8 * fq; const float* gtb = gt + (size_t)b * 6144;
#pragma unroll
        for (int bj = 0; bj < 2; ++bj) { const int c = col0 + bj * HALF; const f32x4 g40 = *(const f32x4*)(gtb + c), g41 = *(const f32x4*)(gtb + c + 4);
#pragma unroll
            for (int ai = 0; ai < 2; ++ai)
#pragma unroll
                for (int m = 0; m < 4; ++m) { const size_t off = (size_t)(u.pm * BM + ai * HALF + wr * 64 + m * 16 + fr) * 1024 + c;
                    const f32x4 y0 = g40 * acc[ai][bj][m][0], y1 = g41 * acc[ai][bj][m][1];
                    u32x4 w; w.x = cvt_pk_bf16(y0[0], y0[1]); w.y = cvt_pk_bf16(y0[2], y0[3]); w.z = cvt_pk_bf16(y1[0], y1[1]); w.w = cvt_pk_bf16(y1[2], y1[3]);
                    *(u32x4*)(y + off) = w; } }
    }
};
struct EpiGateUp {
    static constexpr bool PERM = true, AFTER_DRAIN = false;
    bf16_t* act;
    __device__ __forceinline__ void operator()(const f32x4 (&acc)[2][2][4][2], const Unit& u, int wr, int wc, int fr, int fq) const {
        const int h0 = u.pn * 128 + wc * 32 + 8 * fq;
#pragma unroll
        for (int ai = 0; ai < 2; ++ai)
#pragma unroll
            for (int m = 0; m < 4; ++m) { const size_t row = (size_t)(u.pm * BM + ai * HALF + wr * 64 + m * 16 + fr);
                const f32x4 g0 = acc[ai][0][m][0], g1 = acc[ai][0][m][1], u0 = acc[ai][1][m][0], u1 = acc[ai][1][m][1];
                u32x4 w;
                w.x = cvt_pk_bf16(silu_fast(g0[0]) * u0[0], silu_fast(g0[1]) * u0[1]); w.y = cvt_pk_bf16(silu_fast(g0[2]) * u0[2], silu_fast(g0[3]) * u0[3]);
                w.z = cvt_pk_bf16(silu_fast(g1[0]) * u1[0], silu_fast(g1[1]) * u1[1]); w.w = cvt_pk_bf16(silu_fast(g1[2]) * u1[2], silu_fast(g1[3]) * u1[3]);
                *(u32x4*)(act + row * 2816 + h0) = w; }
    }
};
struct EpiDown {
    static constexpr bool PERM = true, AFTER_DRAIN = false;
    const float* x; const bf16_t* y; float* out; const float* gt;
    __device__ __forceinline__ void operator()(const f32x4 (&acc)[2][2][4][2], const Unit& u, int wr, int wc, int fr, int fq) const {
        const int b = u.pm >> 5; const int col0 = u.pn * BM + wc * 32 + 8 * fq; const float* gtb = gt + (size_t)b * 6144;
#pragma unroll
        for (int bj = 0; bj < 2; ++bj) { const int c = col0 + bj * HALF; const f32x4 g40 = *(const f32x4*)(gtb + c), g41 = *(const f32x4*)(gtb + c + 4);
#pragma unroll
            for (int ai = 0; ai < 2; ++ai)
#pragma unroll
                for (int m = 0; m < 4; ++m) { const size_t off = (size_t)(u.pm * BM + ai * HALF + wr * 64 + m * 16 + fr) * 1024 + c;
                    const f32x4 x0 = *(const f32x4*)(x + off), x1 = *(const f32x4*)(x + off + 4); const u32x4 yw = *(const u32x4*)(y + off);
                    const f32x4 y0 = {__builtin_bit_cast(float, yw.x << 16), __builtin_bit_cast(float, yw.x & 0xffff0000u), __builtin_bit_cast(float, yw.y << 16), __builtin_bit_cast(float, yw.y & 0xffff0000u)};
                    const f32x4 y1 = {__builtin_bit_cast(float, yw.z << 16), __builtin_bit_cast(float, yw.z & 0xffff0000u), __builtin_bit_cast(float, yw.w << 16), __builtin_bit_cast(float, yw.w & 0xffff0000u)};
                    *(f32x4*)(out + off) = (x0 + y0) + g40 * acc[ai][bj][m][0]; *(f32x4*)(out + off + 4) = (x1 + y1) + g41 * acc[ai][bj][m][1]; } }
    }
};
}
constexpr int NWAVES = 8, NTHREADS = 512;
constexpr int BATCH = 4, SEQ = 8192, DM = 1024, TOK = BATCH * SEQ, NIN = 2840, NIN_PAD = 3072, FF = 2816, NCMP = 511;
constexpr size_t MiB = 1u << 20;
constexpr size_t WS_CTL = 0, CTL_ZERO_BYTES = 64 * 1024;
constexpr size_t WS_MODP = 1 * MiB;
constexpr size_t WS_MOD = 2 * MiB;
constexpr size_t WS_CBP = 2 * MiB + 512 * 1024;
constexpr size_t WS_KMP = 3 * MiB;
constexpr size_t WS_BIAS2 = 4 * MiB;
constexpr size_t WS_SSP = 449 * MiB;
constexpr size_t WS_WIN = 6 * MiB, WS_WOUT = 12 * MiB, WS_WGU = 14 * MiB, WS_WDN = 25 * MiB;
constexpr size_t WS_W1K = 31 * MiB, WS_W1V = 32 * MiB, WS_W2K = 33 * MiB, WS_W2V = 33 * MiB + 64 * 1024;
constexpr size_t WS_KCMP = 34 * MiB, WS_VCMP = 35 * MiB;
constexpr size_t WS_GATES = 36 * MiB;
constexpr size_t WS_H = 40 * MiB;
constexpr size_t WS_MIX = 104 * MiB;
constexpr size_t WS_QKV = 168 * MiB;
constexpr size_t WS_ACT = WS_QKV;
constexpr size_t WS_END = 344 * MiB;
constexpr size_t WS_PARTO = 344 * MiB;
constexpr size_t WS_PARTL = 472 * MiB;
constexpr size_t WS_SELG = 476 * MiB;
constexpr size_t WS_Y = WS_PARTO;
constexpr size_t QKV_BIG = (size_t)4 * 8 * SEQ * 64, QKV_SMALL = (size_t)4 * 2 * SEQ * 64;
constexpr int RING_BYTES = 131072, LDS_BYTES = 147456;
constexpr int N_PHASES = 10;

#define GAS __attribute__((address_space(1)))
#define LAS __attribute__((address_space(3)))
typedef unsigned short bf16;
typedef unsigned v4u __attribute__((ext_vector_type(4)));
typedef float f32x4 __attribute__((ext_vector_type(4)));
#define LDS_WAIT() asm volatile("s_waitcnt lgkmcnt(0)" ::: "memory")
#define VM_WAIT() asm volatile("s_waitcnt vmcnt(0)" ::: "memory")
__device__ __forceinline__ unsigned f2bf(float f) { unsigned u = __builtin_bit_cast(unsigned, f); return (u + 0x7fffu + ((u >> 16) & 1u)) >> 16; }
__device__ __forceinline__ unsigned pk2(float lo, float hi) { return f2bf(lo) | (f2bf(hi) << 16); }
__device__ __forceinline__ float bf2f(bf16 v) { return __builtin_bit_cast(float, (unsigned)v << 16); }
__device__ __forceinline__ float wave_sum(float v) {
#pragma unroll
    for (int o = 1; o < 64; o <<= 1) v += __shfl_xor(v, o);
    return v;
}
struct Args { const float* in[23]; float* out; unsigned char* ws; int ph_lo, ph_hi; };
struct Frame { LAS unsigned char* lds; int tid, lane, wave, vcu, G; };

struct MapId { __device__ __forceinline__ size_t off(int n, int k, int K) const { return (size_t)n * K + k; } };
struct MapWin { __device__ __forceinline__ size_t off(int n, int k, int K) const { const int s = n >> 6, d = n & 63; return (size_t)(256 * (s >> 2) + 128 * (d >> 5) + 32 * (s & 3) + (d & 31)) * K + k; } };
struct MapWgu { __device__ __forceinline__ size_t off(int n, int k, int K) const { const int up = n >= FF, hdn = up ? n - FF : n; return (size_t)(256 * (hdn >> 7) + 128 * up + (hdn & 127)) * K + k; } };
struct MapFrag { __device__ __forceinline__ size_t off(int n, int k, int K) const { return ((size_t)((k >> 4) * 8 + (n >> 5)) * 64 + ((k >> 3) & 1) * 32 + (n & 31)) * 8 + (k & 7); } };
template <class Map>
__device__ __forceinline__ void transpose_item(const float* __restrict__ W, int K, int N, bf16* WT, LAS float* scr, int item, int lane, const Map& map) {
    const int nblk = (N + 63) / 64, kb = item / nblk, nb = item % nblk, k0 = 64 * kb, n0 = 64 * nb;
    const int nc = n0 + 4 * (lane & 15); const bool nin = nc < N;
    f32x4 v[16];
#pragma unroll
    for (int i = 0; i < 16; ++i) { const int kk = 4 * i + (lane >> 4); v[i] = nin ? *(const GAS f32x4*)(W + (size_t)(k0 + kk) * N + nc) : (f32x4){0.f, 0.f, 0.f, 0.f}; }
#pragma unroll
    for (int i = 0; i < 16; ++i) { const int kk = 4 * i + (lane >> 4); LAS float* d = scr + (4 * (lane & 15)) * 68 + kk; d[0] = v[i][0]; d[68] = v[i][1]; d[136] = v[i][2]; d[204] = v[i][3]; }
    LDS_WAIT(); asm volatile("" ::: "memory");
    const int c = lane & 7;
#pragma unroll
    for (int j = 0; j < 8; ++j) { const int n = (lane >> 3) + 8 * j; const LAS float* s = scr + n * 68 + 8 * c;
        const f32x4 a = *(const LAS f32x4*)s, bq = *(const LAS f32x4*)(s + 4);
        v4u o; o.x = pk2(a[0], a[1]); o.y = pk2(a[2], a[3]); o.z = pk2(bq[0], bq[1]); o.w = pk2(bq[2], bq[3]);
        if (n0 + n < N) *(GAS v4u*)(WT + map.off(n0 + n, k0 + 8 * c, K)) = o; }
    LDS_WAIT(); asm volatile("" ::: "memory");
}
__device__ __forceinline__ float silu_acc(float v) { return v / (1.f + expf(-v)); }
__device__ __forceinline__ void phase_prologue_a(Frame& F, const Args& a) {
    LAS float* scr = (LAS float*)(F.lds + F.wave * 17408);
    const int gw = F.vcu * NWAVES + F.wave, NGW = F.G * NWAVES;
    unsigned char* ws = a.ws;
    constexpr int I_IN = (DM / 64) * ((NIN + 63) / 64), I_OUT = (DM / 64) * (DM / 64), I_GU = (DM / 64) * (2 * FF / 64), I_DN = (FF / 64) * (DM / 64), I_W1 = (2048 / 64) * (256 / 64), I_W2 = (256 / 64) * (64 / 64);
    constexpr int NITEMS = I_IN + I_OUT + I_GU + I_DN + 2 * I_W1 + 2 * I_W2;
    for (int it = gw; it < NITEMS; it += NGW) {
        int r = it;
        if (r < I_IN) { transpose_item(a.in[6], DM, NIN, (bf16*)(ws + WS_WIN), scr, r, F.lane, MapWin()); continue; } r -= I_IN;
        if (r < I_OUT) { transpose_item(a.in[19], DM, DM, (bf16*)(ws + WS_WOUT), scr, r, F.lane, MapId()); continue; } r -= I_OUT;
        if (r < I_GU) { transpose_item(a.in[21], DM, 2 * FF, (bf16*)(ws + WS_WGU), scr, r, F.lane, MapWgu()); continue; } r -= I_GU;
        if (r < I_DN) { transpose_item(a.in[22], FF, DM, (bf16*)(ws + WS_WDN), scr, r, F.lane, MapId()); continue; } r -= I_DN;
        if (r < I_W1) { transpose_item(a.in[14], 2048, 256, (bf16*)(ws + WS_W1K), scr, r, F.lane, MapFrag()); continue; } r -= I_W1;
        if (r < I_W1) { transpose_item(a.in[17], 2048, 256, (bf16*)(ws + WS_W1V), scr, r, F.lane, MapFrag()); continue; } r -= I_W1;
        if (r < I_W2) { transpose_item(a.in[15], 256, 64, (bf16*)(ws + WS_W2K), scr, r, F.lane, MapId()); continue; } r -= I_W2;
        transpose_item(a.in[18], 256, 64, (bf16*)(ws + WS_W2V), scr, r, F.lane, MapId());
    }
    const float* c = a.in[1]; const float* w_ada = a.in[3]; float* modp = (float*)(ws + WS_MODP);
    for (int t = NGW - 1 - gw; t < 96 * 8; t += NGW) { const int cg_ = t % 96, ks = t / 96; const int n = cg_ * 64 + F.lane;
        float acc0 = 0.f, acc1 = 0.f, acc2 = 0.f, acc3 = 0.f;
#pragma unroll
        for (int i = 0; i < 8; ++i) { const int idx = F.lane + 64 * i, bb = idx >> 7, kk = idx & 127; scr[kk * 4 + bb] = silu_acc(c[bb * DM + ks * 128 + kk]); }
        LDS_WAIT(); asm volatile("" ::: "memory");
#pragma unroll 8
        for (int k = 0; k < 128; ++k) { const float w = w_ada[(size_t)(ks * 128 + k) * 6144 + n]; const f32x4 sv = *(const LAS f32x4*)(scr + 4 * k);
            acc0 += sv[0] * w; acc1 += sv[1] * w; acc2 += sv[2] * w; acc3 += sv[3] * w; }
        LDS_WAIT(); asm volatile("" ::: "memory");
        float* o = modp + (size_t)ks * 4 * 6144 + n; o[0] = acc0; o[6144] = acc1; o[2 * 6144] = acc2; o[3 * 6144] = acc3; }
    float* cbp = (float*)(ws + WS_CBP);
    for (int t = NGW / 2 - 1 - gw; t >= 0 && t < 256; t += NGW) { const int kv = t & 1, cg_ = (t >> 1) & 3, ic = t >> 3; const int n = cg_ * 64 + F.lane;
        const float* pe = kv ? a.in[16] : a.in[13]; const float* w1 = kv ? a.in[17] : a.in[14]; float acc = 0.f;
#pragma unroll 8
        for (int i = ic * 64; i < ic * 64 + 64; ++i) acc += pe[i] * w1[(size_t)i * 256 + n];
        cbp[(ic * 2 + kv) * 256 + n] = acc; }
}
template <bool ADDY>
__device__ __forceinline__ void norm_load4(Frame& F, int row0, const float* in, const bf16* yin, f32x4 (&v)[4][4], unsigned long long (&yw)[4][4]) {
#pragma unroll
    for (int r = 0; r < 4; ++r) { const int row = row0 + r; const GAS f32x4* xr = (const GAS f32x4*)(in + (size_t)row * DM) + F.lane;
#pragma unroll
        for (int j = 0; j < 4; ++j) v[r][j] = xr[64 * j];
        if (ADDY) { const GAS unsigned long long* yr = (const GAS unsigned long long*)(yin + (size_t)row * DM) + F.lane;
#pragma unroll
            for (int j = 0; j < 4; ++j) yw[r][j] = yr[64 * j]; } }
}
template <bool ADDY>
__device__ __forceinline__ void norm_rows(Frame& F, int blk, const float* in, const bf16* yin, const f32x4 (&gs)[4], const f32x4 (&sh)[4], bf16* out) {
    const int rowb = blk * 128 + F.wave * 16;
    f32x4 vn[4][4]; unsigned long long yn[4][4];
    norm_load4<ADDY>(F, rowb, in, yin, vn, yn);
    for (int i0 = 0; i0 < 16; i0 += 4) {
        f32x4 v[4][4]; float ss[4];
#pragma unroll
        for (int r = 0; r < 4; ++r)
#pragma unroll
            for (int j = 0; j < 4; ++j) { v[r][j] = vn[r][j];
                if (ADDY) { const unsigned lo = (unsigned)yn[r][j], hi = (unsigned)(yn[r][j] >> 32);
                    v[r][j] += (f32x4){__builtin_bit_cast(float, lo << 16), __builtin_bit_cast(float, lo & 0xffff0000u), __builtin_bit_cast(float, hi << 16), __builtin_bit_cast(float, hi & 0xffff0000u)}; } }
        if (i0 + 4 < 16) norm_load4<ADDY>(F, rowb + i0 + 4, in, yin, vn, yn);
#pragma unroll
        for (int r = 0; r < 4; ++r) { float s = 0.f;
#pragma unroll
            for (int j = 0; j < 4; ++j) s += (v[r][j].x * v[r][j].x + v[r][j].y * v[r][j].y) + (v[r][j].z * v[r][j].z + v[r][j].w * v[r][j].w);
            ss[r] = s; }
#pragma unroll
        for (int o_ = 1; o_ < 64; o_ <<= 1) {
#pragma unroll
            for (int r = 0; r < 4; ++r) ss[r] += __shfl_xor(ss[r], o_); }
#pragma unroll
        for (int r = 0; r < 4; ++r) { const int row = rowb + i0 + r; const float rs = rsqrtf(ss[r] * (1.f / DM) + 1e-6f);
            GAS unsigned long long* o8 = (GAS unsigned long long*)(out + (size_t)row * DM) + F.lane;
#pragma unroll
            for (int j = 0; j < 4; ++j) { const f32x4 y = v[r][j] * rs * gs[j] + sh[j]; o8[64 * j] = (unsigned long long)pk2(y.x, y.y) | ((unsigned long long)pk2(y.z, y.w) << 32); } }
    }
}
__device__ __forceinline__ void phase_prologue_b(Frame& F, const Args& a) {
    unsigned char* ws = a.ws; const float* modp = (const float*)(ws + WS_MODP); const float* b_ada = a.in[4];
    if (F.wave == 0) for (int cgp = F.vcu; cgp < 96; cgp += F.G) { const int n = cgp * 64 + F.lane; float* mod = (float*)(ws + WS_MOD);
        for (int b = 0; b < 4; ++b) { float s = 0.f;
#pragma unroll
            for (int ks = 0; ks < 8; ++ks) s += modp[((size_t)ks * 4 + b) * 6144 + n];
            mod[b * 6144 + n] = s + b_ada[n]; } }
    const float* g = a.in[5];
    for (int blk = F.vcu; blk < TOK / 128; blk += F.G) { const int b = blk >> 6;
    f32x4 gs[4], sh[4];
#pragma unroll
    for (int j = 0; j < 4; ++j) { const int c0 = 4 * F.lane + 256 * j; f32x4 s0 = {0.f, 0.f, 0.f, 0.f}, s1 = {0.f, 0.f, 0.f, 0.f};
#pragma unroll
        for (int ks = 0; ks < 8; ++ks) { s0 += *(const f32x4*)(modp + ((size_t)ks * 4 + b) * 6144 + c0); s1 += *(const f32x4*)(modp + ((size_t)ks * 4 + b) * 6144 + DM + c0); }
        s0 += *(const f32x4*)(b_ada + c0); s1 += *(const f32x4*)(b_ada + DM + c0);
        sh[j] = s0; gs[j] = *(const f32x4*)(g + c0) * (s1 + 1.0f); }
    norm_rows<false>(F, blk, a.in[0], nullptr, gs, sh, (bf16*)(ws + WS_H)); }
}
__device__ __forceinline__ void phase_norm2(Frame& F, const Args& a) {
    unsigned char* ws = a.ws; const float* g = a.in[20];
    for (int blk = F.vcu; blk < TOK / 128; blk += F.G) { const int b = blk >> 6; const float* mod = (const float*)(ws + WS_MOD) + (size_t)b * 6144;
        f32x4 gs[4], sh[4];
#pragma unroll
        for (int j = 0; j < 4; ++j) { const int c0 = 4 * F.lane + 256 * j; sh[j] = *(const f32x4*)(mod + 3 * DM + c0); gs[j] = *(const f32x4*)(g + c0) * (*(const f32x4*)(mod + 4 * DM + c0) + 1.0f); }
        norm_rows<true>(F, blk, a.in[0], (const bf16*)(ws + WS_Y), gs, sh, (bf16*)(ws + WS_H)); }
}

__device__ __forceinline__ void phase_bias2(Frame& F, const Args& a) {
    unsigned char* ws = a.ws; const float* mod = (const float*)(ws + WS_MOD); const bf16* wt = (const bf16*)(ws + WS_WGU); float* bias2 = (float*)(ws + WS_BIAS2);
    const int gw = F.vcu * NWAVES + F.wave, NGW = F.G * NWAVES;
    f32x4 sh[4][4];
#pragma unroll
    for (int bb = 0; bb < 4; ++bb)
#pragma unroll
        for (int j = 0; j < 4; ++j) sh[bb][j] = *(const f32x4*)(mod + (size_t)bb * 6144 + 3 * DM + 16 * F.lane + 4 * j);
    for (int c = gw; c < 2 * FF; c += NGW) {
        const v4u w0 = *(const GAS v4u*)(wt + (size_t)c * DM + 16 * F.lane), w1 = *(const GAS v4u*)(wt + (size_t)c * DM + 16 * F.lane + 8);
        const unsigned wu[8] = {w0.x, w0.y, w0.z, w0.w, w1.x, w1.y, w1.z, w1.w};
        float s[4] = {0.f, 0.f, 0.f, 0.f};
#pragma unroll
        for (int j = 0; j < 4; ++j) { const float e0 = __builtin_bit_cast(float, wu[2 * j] << 16), e1 = __builtin_bit_cast(float, wu[2 * j] & 0xffff0000u), e2 = __builtin_bit_cast(float, wu[2 * j + 1] << 16), e3 = __builtin_bit_cast(float, wu[2 * j + 1] & 0xffff0000u);
#pragma unroll
            for (int bb = 0; bb < 4; ++bb) s[bb] += (sh[bb][j][0] * e0 + sh[bb][j][1] * e1) + (sh[bb][j][2] * e2 + sh[bb][j][3] * e3); }
#pragma unroll
        for (int bb = 0; bb < 4; ++bb) { const float t = wave_sum(s[bb]); if (F.lane == 0) bias2[(size_t)bb * 2 * FF + c] = t; }
    }
}
#define XB_TMO      128
#define XB_XCNT(j)  (256  + 64 * (j))
#define XB_XSUB(j)  (1280 + 64 * (j))
#define XB_XGEN(j)  (2304 + 64 * (j))
#define XB_TOP      3328
#define XB_TOPGEN   3392
#define XCD_BAR_WORDS 3456
#define XB_SPIN_CAP (1u << 18)

__device__ __forceinline__ unsigned xb_ld(unsigned* p)              { return __hip_atomic_load(p, __ATOMIC_RELAXED, __HIP_MEMORY_SCOPE_AGENT); }
__device__ __forceinline__ unsigned xb_add(unsigned* p, unsigned v) { return __hip_atomic_fetch_add(p, v, __ATOMIC_RELAXED, __HIP_MEMORY_SCOPE_AGENT); }
__device__ __forceinline__ unsigned xb_xcc_id() { return (unsigned)__builtin_amdgcn_s_getreg((3 << 11) | 20) & 0xFu; }
#define XB_SPIN(cond, bar) do { unsigned _sp = 0; while (cond) { __builtin_amdgcn_s_sleep(1); \
    if ((++_sp & 255u) == 0u) { if (xb_ld(&(bar)[XB_TMO])) break; if (_sp > XB_SPIN_CAP) { atomicAdd(&(bar)[XB_TMO], 1u); break; } } } } while (0)

struct XcdBarrier {
    unsigned* bar; unsigned x;
    volatile LAS unsigned* st;
};

__device__ __forceinline__ XcdBarrier xcd_barrier_post(unsigned* bar, volatile LAS unsigned* st) {
    XcdBarrier b; b.bar = bar; b.x = xb_xcc_id(); b.st = st;
    if (threadIdx.x == 0) (void)xb_add(&bar[XB_XCNT(b.x)], 1u);
    return b;
}
__device__ __forceinline__ void xcd_barrier_complete(unsigned* bar, unsigned x, unsigned& nloc, unsigned& nx) {
    const unsigned G = gridDim.x * gridDim.y * gridDim.z;
    unsigned sum, cnt, mine, sp = 0u;
    for (;;) {
        sum = 0u; cnt = 0u; mine = 0u;
#pragma unroll
        for (unsigned j = 0; j < 16; ++j) { const unsigned c = xb_ld(&bar[XB_XCNT(j)]); sum += c; cnt += (c > 0u) ? 1u : 0u; mine = (j == x) ? c : mine; }
        if (sum == G) break;
        __builtin_amdgcn_s_sleep(1);
        if ((++sp & 255u) == 0u) { if (xb_ld(&bar[XB_TMO])) break; if (sp > XB_SPIN_CAP) { atomicAdd(&bar[XB_TMO], 1u); break; } }
    }
    nloc = mine > 0u ? mine : 1u; nx = cnt > 0u ? cnt : 1u;
}

__device__ __forceinline__ void xcd_barrier(const XcdBarrier& b) {
    asm volatile("s_waitcnt vmcnt(0)" ::: "memory");
    __syncthreads();
    if (threadIdx.x == 0) {
        unsigned* bar = b.bar;
        __builtin_amdgcn_s_waitcnt(0);
        unsigned nloc = b.st[0], nx = b.st[1];
        if (nloc == 0u) { xcd_barrier_complete(bar, b.x, nloc, nx); b.st[0] = nloc; b.st[1] = nx; }
        const unsigned old = xb_add(&bar[XB_XSUB(b.x)], 1u);
        const unsigned gen = old / nloc;
        if (old + 1u == (gen + 1u) * nloc) {
            __builtin_amdgcn_fence(__ATOMIC_RELEASE, "agent");
            asm volatile("s_waitcnt vmcnt(0)" ::: "memory");
            const unsigned og = xb_add(&bar[XB_TOP], 1u);
            const unsigned tg = og / nx;
            if (og + 1u == (tg + 1u) * nx) xb_add(&bar[XB_TOPGEN], 1u);
            else XB_SPIN(xb_ld(&bar[XB_TOPGEN]) == tg, bar);
            __builtin_amdgcn_fence(__ATOMIC_ACQUIRE, "agent");
            xb_add(&bar[XB_XGEN(b.x)], 1u);
            asm volatile("s_waitcnt vmcnt(0)" ::: "memory");
        } else {
            XB_SPIN(xb_ld(&bar[XB_XGEN(b.x)]) == gen, bar);
            __builtin_amdgcn_fence(__ATOMIC_ACQUIRE, "agent");
            asm volatile("s_waitcnt vmcnt(0)" ::: "memory");
        }
    }
    __syncthreads();
}
#define ATT_NS att
#ifndef ATT_ABL
#define ATT_ABL 0
#endif
#ifndef ATT_STAGGER
#define ATT_STAGGER 0
#endif
#ifndef ATT_SLEEP
#define ATT_SLEEP 24
#endif
namespace ATT_NS {
using bf16x8 = __attribute__((ext_vector_type(8))) short;
using s16x4 = __attribute__((ext_vector_type(4))) short;
using f32x16 = __attribute__((ext_vector_type(16))) float;
using u32x4 = __attribute__((ext_vector_type(4))) unsigned;
typedef LAS const char* lds_cptr;
typedef short v4i16_t __attribute__((ext_vector_type(4)));
constexpr int SLOT = 16384, NSLOT = 4, LDS_OST = 65536, LDS_IMP = 100608, LDS_SELM = 135680, LDS_MISC = 136704, LDS_WSF = 136960, LDS_LUTG = 139008  , LDS_ATT_END = 147200;
constexpr int LUT_PITCH = 116;
constexpr int IMP_PITCH = 136, IMP_PLANE = 64 * IMP_PITCH + 4, IMP_REG1 = 64;
constexpr float LOG2E = 1.4426950408889634f;
#define MFMA32(a, b, c) __builtin_amdgcn_mfma_f32_32x32x16_bf16(a, b, c, 0, 0, 0)
#define ATT_WAIT_BAR(N) asm volatile("s_waitcnt vmcnt(" #N ") lgkmcnt(0)\n\ts_barrier" ::: "memory")
__device__ __forceinline__ void glds16(const void* gsrc, unsigned lds_dst) { unsigned keep;
    asm volatile("s_mov_b32 %0, m0\n\ts_mov_b32 m0, %2\n\ts_nop 0\n\tglobal_load_lds_dwordx4 %1, off\n\ts_mov_b32 m0, %0" : "=&s"(keep) : "v"(gsrc), "s"(lds_dst) : "memory"); }
typedef float f32x2_t __attribute__((ext_vector_type(2))); typedef __bf16 bf16x2_t __attribute__((ext_vector_type(2)));
__device__ __forceinline__ unsigned cvtpk(float lo, float hi) { f32x2_t v = {lo, hi}; bf16x2_t b = __builtin_convertvector(v, bf16x2_t); return __builtin_bit_cast(unsigned, b); }
__device__ __forceinline__ s16x4 vtr(lds_cptr p) { return __builtin_bit_cast(s16x4, __builtin_amdgcn_ds_read_tr16_b64_v4i16((LAS v4i16_t*)p)); }
__device__ __forceinline__ int t5_bucket(int d) {
    if (d < 16) return d;
    int b = 16;
    b += (d >= 19); b += (d >= 21); b += (d >= 24); b += (d >= 27); b += (d >= 31); b += (d >= 35); b += (d >= 40); b += (d >= 46);
    b += (d >= 52); b += (d >= 59); b += (d >= 67); b += (d >= 77); b += (d >= 87); b += (d >= 99); b += (d >= 113);
    return b;
}
struct Ctx { LAS char* lds; int wid; int lane, r32, hi; };
__device__ __forceinline__ int fresh_lane() { int l; asm volatile("v_mbcnt_lo_u32_b32 %0, -1, 0\n\tv_mbcnt_hi_u32_b32 %0, -1, %0" : "=v"(l)); return l; }
__device__ __forceinline__ Ctx make_ctx(LAS unsigned char* lds, int tid) {
    Ctx c; c.lds = (LAS char*)lds; c.wid = __builtin_amdgcn_readfirstlane(tid >> 6); c.lane = tid & 63; c.r32 = c.lane & 31; c.hi = c.lane >> 5; return c;
}
template <bool HASV, class QK, class SM>
__device__ __forceinline__ void run_stream(const Ctx& c, const bf16* Kb, const bf16* Vb, int t0, int t1, QK&& qk, SM&& sm) {
    const int n = t1 - t0; if (n <= 0) return;
    const int lane = fresh_lane(), r32 = lane & 31, hi = lane >> 5; const unsigned lds0 = (unsigned)(uintptr_t)c.lds;
    const bf16* ks = Kb + ((8 * c.wid + (lane >> 3)) * 64 + (((lane & 7) ^ (((8 * c.wid + (lane >> 3)) >> 1) & 7)) << 3)); const bf16* vs = Vb + ((16 * (c.wid & 3) + (lane >> 2)) * 64 + (c.wid >> 2) * 32 + (lane & 3) * 8);
    const unsigned kdst = lds0 + c.wid * 1024, vdst = lds0 + 8192 + c.wid * 1024;
    const lds_cptr kp0 = (lds_cptr)c.lds + r32 * 128;
    const lds_cptr vp0 = (lds_cptr)c.lds + 8192 + ((lane >> 4) & 1) * 32 + (lane & 3) * 8 + (4 * hi + ((lane & 15) >> 2)) * 64;
#define ATT_ISSUE(t, so) do { if (ATT_ABL & 4) break; glds16(ks + (size_t)(t) * 4096, (unsigned)__builtin_amdgcn_readfirstlane(kdst + (so))); if (HASV) glds16(vs + (size_t)(t) * 4096, (unsigned)__builtin_amdgcn_readfirstlane(vdst + (so))); } while (0)
    ATT_ISSUE(t0, 0); if (n > 1) ATT_ISSUE(t0 + 1, SLOT);
    const bool late = ATT_STAGGER && __builtin_amdgcn_readfirstlane(c.wid) >= 4;
    f32x16 s0 = {}, s1 = {};
    int slot = 0, slotp = 3 * SLOT, slot2 = 2 * SLOT;
    if (!late) {
        for (int i = 0; i < n; ++i) {
            if (i + 1 < n) { if (HASV) ATT_WAIT_BAR(2); else ATT_WAIT_BAR(1); } else ATT_WAIT_BAR(0);
            if (i + 2 < n) ATT_ISSUE(t0 + i + 2, slot2);
            if (!(ATT_ABL & 1)) qk(t0 + i, kp0 + slot, s0, s1); if (!(ATT_ABL & 2)) sm(t0 + i, vp0 + slot, s0, s1);
            slot = (slot == 3 * SLOT) ? 0 : slot + SLOT; slot2 = (slot2 == 3 * SLOT) ? 0 : slot2 + SLOT;
        }
    } else {
        for (int i = 0; i < n; ++i) {
            if (i + 1 < n) { if (HASV) ATT_WAIT_BAR(2); else ATT_WAIT_BAR(1); } else ATT_WAIT_BAR(0);
            if (i + 2 < n) ATT_ISSUE(t0 + i + 2, slot2);
            if (i > 0 && !(ATT_ABL & 2)) sm(t0 + i - 1, vp0 + slotp, s0, s1);
            if (!(ATT_ABL & 1)) qk(t0 + i, kp0 + slot, s0, s1);
            slotp = slot; slot = (slot == 3 * SLOT) ? 0 : slot + SLOT; slot2 = (slot2 == 3 * SLOT) ? 0 : slot2 + SLOT;
        }
        if (!(ATT_ABL & 2)) sm(t0 + n - 1, vp0 + slotp, s0, s1);
    }
    asm volatile("s_waitcnt lgkmcnt(0)\n\ts_barrier" ::: "memory");
#undef ATT_ISSUE
}
template <class FN1, class FN2>
__device__ __forceinline__ void run_stream_pairs(const Ctx& c, const bf16* Kb, const bf16* Vb, int t0, int t1, FN1&& fn1, FN2&& fn2) {
    const int n = t1 - t0; if (n <= 0) return;
    const int lane = fresh_lane(), r32 = lane & 31, hi = lane >> 5; const unsigned lds0 = (unsigned)(uintptr_t)c.lds;
    const bf16* ks = Kb + ((8 * c.wid + (lane >> 3)) * 64 + (((lane & 7) ^ (((8 * c.wid + (lane >> 3)) >> 1) & 7)) << 3)); const bf16* vs = Vb + ((16 * (c.wid & 3) + (lane >> 2)) * 64 + (c.wid >> 2) * 32 + (lane & 3) * 8);
    const unsigned kdst = lds0 + c.wid * 1024, vdst = lds0 + 8192 + c.wid * 1024;
    const lds_cptr kp0 = (lds_cptr)c.lds + r32 * 128;
    const lds_cptr vp0 = (lds_cptr)c.lds + 8192 + ((lane >> 4) & 1) * 32 + (lane & 3) * 8 + (4 * hi + ((lane & 15) >> 2)) * 64;
#define ATT_ISSUE1(t, so) do { glds16(ks + (size_t)(t) * 4096, (unsigned)__builtin_amdgcn_readfirstlane(kdst + (so))); glds16(vs + (size_t)(t) * 4096, (unsigned)__builtin_amdgcn_readfirstlane(vdst + (so))); } while (0)
    ATT_ISSUE1(t0, 0); if (n > 1) ATT_ISSUE1(t0 + 1, SLOT);
    int base = 0;
    for (int i = 0; i < n; i += 2) {
        ATT_WAIT_BAR(0);
        const int nb = 2 * SLOT - base;
        if (i + 2 < n) ATT_ISSUE1(t0 + i + 2, nb); if (i + 3 < n) ATT_ISSUE1(t0 + i + 3, nb + SLOT);
        if (i + 1 < n) fn2(t0 + i, kp0 + base, vp0 + base, kp0 + base + SLOT, vp0 + base + SLOT); else fn1(t0 + i, kp0 + base, vp0 + base);
        base = nb;
    }
    asm volatile("s_waitcnt lgkmcnt(0)\n\ts_barrier" ::: "memory");
#undef ATT_ISSUE1
}
__device__ __forceinline__ void qk_tile(f32x16& s0, f32x16& s1, lds_cptr kp, const bf16x8 (&qr)[4]) {
    bf16x8 kf[8];
    { const int l = fresh_lane(), f = ((l & 31) >> 1) & 7, hi = l >> 5;
#pragma unroll
      for (int d0 = 0; d0 < 4; ++d0) { const int off = ((2 * d0 + hi) ^ f) << 4; kf[2 * d0] = *(const LAS bf16x8*)(kp + off); kf[2 * d0 + 1] = *(const LAS bf16x8*)(kp + 4096 + off); } }
    const f32x16 z = {};
    s0 = MFMA32(kf[0], qr[0], z); s1 = MFMA32(kf[1], qr[0], z);
#pragma unroll
    for (int d0 = 1; d0 < 4; ++d0) { s0 = MFMA32(kf[2 * d0], qr[d0], s0); s1 = MFMA32(kf[2 * d0 + 1], qr[d0], s1); }
}
template <bool MASK>
__device__ __forceinline__ void pv_tile(f32x16 (&o)[2], lds_cptr vp, const f32x16& p0, const f32x16& p1, unsigned mask) {
    if (ATT_ABL & 8) { o[0][0] += p0[0] + p1[5]; return; }
    u32x4 pw0 = {cvtpk(p0[0], p0[1]), cvtpk(p0[2], p0[3]), cvtpk(p0[4], p0[5]), cvtpk(p0[6], p0[7])}, pw1 = {cvtpk(p0[8], p0[9]), cvtpk(p0[10], p0[11]), cvtpk(p0[12], p0[13]), cvtpk(p0[14], p0[15])};
    u32x4 pw2 = {cvtpk(p1[0], p1[1]), cvtpk(p1[2], p1[3]), cvtpk(p1[4], p1[5]), cvtpk(p1[6], p1[7])}, pw3 = {cvtpk(p1[8], p1[9]), cvtpk(p1[10], p1[11]), cvtpk(p1[12], p1[13]), cvtpk(p1[14], p1[15])};
    if (MASK) { pw0 &= mask; pw1 &= mask; pw2 &= mask; pw3 &= mask; }
    if (ATT_ABL & 64) { o[0] = MFMA32(__builtin_bit_cast(bf16x8, pw0), __builtin_bit_cast(bf16x8, pw1), o[0]); o[1] = MFMA32(__builtin_bit_cast(bf16x8, pw2), __builtin_bit_cast(bf16x8, pw3), o[1]); return; }
    s16x4 vlo[8], vhi[8];
#pragma unroll
    for (int i = 0; i < 8; ++i) { vlo[i] = vtr(vp + ((i >> 2) * 4096 + (i & 3) * 1024)); vhi[i] = vtr(vp + ((i >> 2) * 4096 + (i & 3) * 1024 + 512)); }
#define ATT_VFR(i) (bf16x8){vlo[i][0], vlo[i][1], vlo[i][2], vlo[i][3], vhi[i][0], vhi[i][1], vhi[i][2], vhi[i][3]}
    o[0] = MFMA32(__builtin_bit_cast(bf16x8, pw0), ATT_VFR(0), o[0]); o[1] = MFMA32(__builtin_bit_cast(bf16x8, pw0), ATT_VFR(4), o[1]);
    o[0] = MFMA32(__builtin_bit_cast(bf16x8, pw1), ATT_VFR(1), o[0]); o[1] = MFMA32(__builtin_bit_cast(bf16x8, pw1), ATT_VFR(5), o[1]);
    o[0] = MFMA32(__builtin_bit_cast(bf16x8, pw2), ATT_VFR(2), o[0]); o[1] = MFMA32(__builtin_bit_cast(bf16x8, pw2), ATT_VFR(6), o[1]);
    o[0] = MFMA32(__builtin_bit_cast(bf16x8, pw3), ATT_VFR(3), o[0]); o[1] = MFMA32(__builtin_bit_cast(bf16x8, pw3), ATT_VFR(7), o[1]);
#undef ATT_VFR
}
#define ATT_SB() __builtin_amdgcn_sched_barrier(0)
struct KF { bf16x8 f[8]; };
struct VF { s16x4 lo[8], hi[8]; };
struct PW4 { u32x4 w0, w1, w2, w3; };
__device__ __forceinline__ void ld_k(KF& k, lds_cptr kp) {
    const int l = fresh_lane(), f = ((l & 31) >> 1) & 7, hi = l >> 5;
#pragma unroll
    for (int d0 = 0; d0 < 4; ++d0) { const int off = ((2 * d0 + hi) ^ f) << 4; k.f[2 * d0] = *(const LAS bf16x8*)(kp + off); k.f[2 * d0 + 1] = *(const LAS bf16x8*)(kp + 4096 + off); } }
__device__ __forceinline__ void qk_mfma(f32x16& s0, f32x16& s1, const KF& k, const bf16x8 (&qr)[4]) {
    const f32x16 z = {};
    s0 = MFMA32(k.f[0], qr[0], z); s1 = MFMA32(k.f[1], qr[0], z);
#pragma unroll
    for (int d0 = 1; d0 < 4; ++d0) { s0 = MFMA32(k.f[2 * d0], qr[d0], s0); s1 = MFMA32(k.f[2 * d0 + 1], qr[d0], s1); } }
__device__ __forceinline__ void ld_v(VF& v, lds_cptr vp) {
#pragma unroll
    for (int i = 0; i < 8; ++i) { v.lo[i] = vtr(vp + ((i >> 2) * 4096 + (i & 3) * 1024)); v.hi[i] = vtr(vp + ((i >> 2) * 4096 + (i & 3) * 1024 + 512)); } }
__device__ __forceinline__ PW4 pack4(const f32x16& p0, const f32x16& p1, unsigned mask) { PW4 w;
    w.w0 = (u32x4){cvtpk(p0[0], p0[1]), cvtpk(p0[2], p0[3]), cvtpk(p0[4], p0[5]), cvtpk(p0[6], p0[7])}; w.w1 = (u32x4){cvtpk(p0[8], p0[9]), cvtpk(p0[10], p0[11]), cvtpk(p0[12], p0[13]), cvtpk(p0[14], p0[15])};
    w.w2 = (u32x4){cvtpk(p1[0], p1[1]), cvtpk(p1[2], p1[3]), cvtpk(p1[4], p1[5]), cvtpk(p1[6], p1[7])}; w.w3 = (u32x4){cvtpk(p1[8], p1[9]), cvtpk(p1[10], p1[11]), cvtpk(p1[12], p1[13]), cvtpk(p1[14], p1[15])};
    w.w0 &= mask; w.w1 &= mask; w.w2 &= mask; w.w3 &= mask; return w; }
__device__ __forceinline__ void pv_mfma(f32x16 (&o)[2], const VF& v, const PW4& w) {
#define ATT_VF(i) (bf16x8){v.lo[i][0], v.lo[i][1], v.lo[i][2], v.lo[i][3], v.hi[i][0], v.hi[i][1], v.hi[i][2], v.hi[i][3]}
    o[0] = MFMA32(__builtin_bit_cast(bf16x8, w.w0), ATT_VF(0), o[0]); o[1] = MFMA32(__builtin_bit_cast(bf16x8, w.w0), ATT_VF(4), o[1]);
    o[0] = MFMA32(__builtin_bit_cast(bf16x8, w.w1), ATT_VF(1), o[0]); o[1] = MFMA32(__builtin_bit_cast(bf16x8, w.w1), ATT_VF(5), o[1]);
    o[0] = MFMA32(__builtin_bit_cast(bf16x8, w.w2), ATT_VF(2), o[0]); o[1] = MFMA32(__builtin_bit_cast(bf16x8, w.w2), ATT_VF(6), o[1]);
    o[0] = MFMA32(__builtin_bit_cast(bf16x8, w.w3), ATT_VF(3), o[0]); o[1] = MFMA32(__builtin_bit_cast(bf16x8, w.w3), ATT_VF(7), o[1]);
#undef ATT_VF
}
__device__ __forceinline__ float rowsum32(const f32x16& p0, const f32x16& p1) { if (ATT_ABL & 32) return p0[0]; float a = p0[0] + p1[0], b = p0[1] + p1[1];
#pragma unroll
    for (int r = 2; r < 16; r += 2) { a += p0[r]; asm volatile("" : "+v"(a)); b += p0[r + 1]; asm volatile("" : "+v"(b)); a += p1[r]; asm volatile("" : "+v"(a)); b += p1[r + 1]; asm volatile("" : "+v"(b)); }
    return a + b; }
__device__ __forceinline__ void hook_exp(f32x16& s0, f32x16& s1) {
    if (ATT_ABL & 16) return;
#pragma unroll
    for (int r = 0; r < 16; ++r) { s0[r] = __builtin_amdgcn_exp2f(s0[r]); s1[r] = __builtin_amdgcn_exp2f(s1[r]); } }
__device__ __forceinline__ void hook_near(f32x16& s0, f32x16& s1, int base, const LAS float* lut) {
    asm volatile("" : "+v"(base));
#pragma unroll
    for (int r = 0; r < 16; ++r) { const int d0 = base - ((r & 3) + 8 * (r >> 2)), d1 = d0 - 32;
        s0[r] = __builtin_amdgcn_exp2f(s0[r] + lut[min(max(d0, -1), 113) + 1]); s1[r] = __builtin_amdgcn_exp2f(s1[r] + lut[min(max(d1, -1), 113) + 1]); } }
__device__ __forceinline__ void hook_edge(f32x16& s0, f32x16& s1, int base, int win) {
    asm volatile("" : "+v"(base));
#pragma unroll
    for (int r = 0; r < 16; ++r) { const int d0 = base - ((r & 3) + 8 * (r >> 2)), d1 = d0 - 32;
        s0[r] = __builtin_amdgcn_exp2f(d0 < win ? s0[r] : -INFINITY); s1[r] = __builtin_amdgcn_exp2f(d1 < win ? s1[r] : -INFINITY); } }
__device__ __forceinline__ void hook_cmp(f32x16& s0, f32x16& s1, int nrel  , float cb) {
    asm volatile("" : "+v"(nrel));
#pragma unroll
    for (int r = 0; r < 16; ++r) { const int c0 = (r & 3) + 8 * (r >> 2);
        s0[r] = __builtin_amdgcn_exp2f(s0[r] + ((c0 <= nrel) ? cb : -INFINITY)); s1[r] = __builtin_amdgcn_exp2f(s1[r] + ((c0 + 32 <= nrel) ? cb : -INFINITY)); } }
__device__ __forceinline__ void row_factors(const Ctx& c, float f, float (&fr)[16]) {
    const int lane = fresh_lane(), r32 = lane & 31, hi = lane >> 5; LAS float* wsf = (LAS float*)(c.lds + LDS_WSF) + c.wid * 64;
    asm volatile("s_waitcnt lgkmcnt(0)" ::: "memory");
    if (hi == 0) wsf[r32] = f;
    asm volatile("s_waitcnt lgkmcnt(0)" ::: "memory");
#pragma unroll
    for (int r = 0; r < 16; ++r) fr[r] = wsf[(r & 3) + 8 * (r >> 2) + 4 * hi];
    asm volatile("s_waitcnt lgkmcnt(0)" ::: "memory");
}
__device__ __forceinline__ float pair_sum(float v) { auto rr = __builtin_amdgcn_permlane32_swap(__float_as_uint(v), __float_as_uint(v), false, false); return __uint_as_float(rr[0]) + __uint_as_float(rr[1]); }
template <class RowOff>
__device__ __forceinline__ void store_rows(const Ctx& c, const f32x16 (&o)[2], bf16* dst, RowOff&& rowoff) {
    LAS bf16* stg = (LAS bf16*)(c.lds + LDS_OST) + c.wid * 2048;
    const int lane = fresh_lane(), r32 = lane & 31, hi = lane >> 5;
#pragma unroll
    for (int r = 0; r < 16; ++r) { const int orow = (r & 3) + 8 * (r >> 2) + 4 * hi;
#pragma unroll
        for (int d0 = 0; d0 < 2; ++d0) stg[orow * 64 + d0 * 32 + r32] = (bf16)f2bf(o[d0][r]); }
    asm volatile("s_waitcnt lgkmcnt(0)" ::: "memory");
#pragma unroll
    for (int i = 0; i < 4; ++i) { const int row = i * 8 + (lane >> 3), ch = lane & 7; const u32x4 v = *(const LAS u32x4*)(stg + row * 64 + ch * 8); *(u32x4*)(dst + rowoff(row) + ch * 8) = v; }
    asm volatile("s_waitcnt lgkmcnt(0)" ::: "memory");
}
struct AttnPtrs { const bf16* qkv; const float* kmp; const float* gates; const bf16* kcmp; const bf16* vcmp; const float* rel_bias; bf16* mix; unsigned* selg; bf16* part_o; float* part_l; };

__device__ __forceinline__ void moba_kmean_frags(const AttnPtrs& P, int bh, int r32, int hi, bf16x8 (&kmf)[4]) {
    const float* kp = P.kmp + ((size_t)(bh * 32 + r32) * 2) * 64;
#pragma unroll
    for (int d0 = 0; d0 < 4; ++d0) { const f32x4 a0 = *(const f32x4*)(kp + d0 * 16 + hi * 8), a1 = *(const f32x4*)(kp + d0 * 16 + hi * 8 + 4), b0 = *(const f32x4*)(kp + 64 + d0 * 16 + hi * 8), b1 = *(const f32x4*)(kp + 64 + d0 * 16 + hi * 8 + 4);
        const f32x4 m0 = (a0 + b0) * (1.f / 256.f), m1 = (a1 + b1) * (1.f / 256.f);
        u32x4 w = {cvtpk(m0[0], m0[1]), cvtpk(m0[2], m0[3]), cvtpk(m1[0], m1[1]), cvtpk(m1[2], m1[3])}; kmf[d0] = __builtin_bit_cast(bf16x8, w); }
}
__device__ __forceinline__ unsigned moba_gate32(const bf16x8 (&kmf)[4], int i, const bf16x8 (&qr)[4], int hi) {
    unsigned selmask = 0u;
    if (i > 0) {
        f32x16 sg = {};
#pragma unroll
        for (int d0 = 0; d0 < 4; ++d0) sg = MFMA32(kmf[d0], qr[d0], sg);
        float v[16];
#pragma unroll
        for (int r = 0; r < 16; ++r) v[r] = ((r & 3) + 8 * (r >> 2) + 4 * hi < i) ? sg[r] : -INFINITY;
#pragma unroll
        for (int it = 0; it < 3; ++it) {
            float m = v[0]; int jb = 4 * hi;
#pragma unroll
            for (int r = 1; r < 16; ++r) { const int j = (r & 3) + 8 * (r >> 2) + 4 * hi; if (v[r] > m) { m = v[r]; jb = j; } }
            auto rm = __builtin_amdgcn_permlane32_swap(__float_as_uint(m), __float_as_uint(m), false, false);
            auto rj = __builtin_amdgcn_permlane32_swap((unsigned)jb, (unsigned)jb, false, false);
            const float mo = __uint_as_float(hi ? rm[0] : rm[1]); const int jo = (int)(hi ? rj[0] : rj[1]);
            const bool mine = (m > mo) || (m == mo && jb < jo);
            const float mw = mine ? m : mo; const int jw = mine ? jb : jo;
            if (mw > -INFINITY) { selmask |= 1u << jw;
#pragma unroll
                for (int r = 0; r < 16; ++r) if ((r & 3) + 8 * (r >> 2) + 4 * hi == jw) v[r] = -INFINITY; }
        }
    }
    return selmask;
}
__device__ __forceinline__ void moba_gate_phase(const AttnPtrs& P, int vcu, int G, int tid) {
    const int lane = tid & 63, r32 = lane & 31, hi = lane >> 5; const int wid = __builtin_amdgcn_readfirstlane(tid >> 6);
    for (int grp = vcu * 8 + wid; grp < 2048; grp += G * 8) { const int bh = grp >> 6;
        bf16x8 kmf[4]; moba_kmean_frags(P, bh, r32, hi, kmf);
        const bf16* QA = P.qkv + ((size_t)bh * SEQ) * 64;
#pragma unroll 2
        for (int k = 0; k < 4; ++k) { const int idx = (grp & 63) * 4 + k, i = idx >> 3, w = idx & 7; const int qpos = 256 * i + 32 * w + r32;
            bf16x8 qr[4];
#pragma unroll
            for (int d0 = 0; d0 < 4; ++d0) qr[d0] = *(const bf16x8*)(QA + (size_t)qpos * 64 + d0 * 16 + hi * 8);
            const unsigned m = moba_gate32(kmf, i, qr, hi);
            if (hi == 0) P.selg[(size_t)bh * SEQ + qpos] = m; } }
}
__device__ __forceinline__ void moba_past_item(const Ctx& c, const AttnPtrs& P, int b, int h, int j, int flags = 0) {
    const int bh = b * 8 + h, tid = threadIdx.x;
    const bf16* QA = P.qkv + ((size_t)bh * SEQ) * 64; const bf16* KA = QA + QKV_BIG + (size_t)256 * j * 64; const bf16* VA = QA + 2 * QKV_BIG + (size_t)256 * j * 64;
    const LAS float* lut = (const LAS float*)(c.lds + LDS_LUTG) + h * LUT_PITCH;
    { const int lane = fresh_lane(); const unsigned lds0 = (unsigned)(uintptr_t)c.lds;
      const bf16* ks = KA + ((8 * c.wid + (lane >> 3)) * 64 + (((lane & 7) ^ (((8 * c.wid + (lane >> 3)) >> 1) & 7)) << 3)); const bf16* vs = VA + ((16 * (c.wid & 3) + (lane >> 2)) * 64 + (c.wid >> 2) * 32 + (lane & 3) * 8);
#pragma unroll
      for (int tt = 0; tt < 4; ++tt) { glds16(ks + tt * 4096, (unsigned)__builtin_amdgcn_readfirstlane(lds0 + c.wid * 1024 + tt * SLOT)); glds16(vs + tt * 4096, (unsigned)__builtin_amdgcn_readfirstlane(lds0 + 8192 + c.wid * 1024 + tt * SLOT)); } }
    LAS unsigned short* list = (LAS unsigned short*)(c.lds + LDS_IMP);
    LAS unsigned* wcnt = (LAS unsigned*)(c.lds + LDS_MISC) + 8;
    const unsigned* sg = P.selg + (size_t)bh * SEQ;
    if (tid < 256) list[tid] = (unsigned short)((256 * j + tid) | (3 << 13));
    int total = 256;
    for (int base = (j + 1) * 256; base < SEQ; base += 2048) {
        const int q0 = base + 4 * tid; uint4 m4 = make_uint4(0u, 0u, 0u, 0u); if (q0 < SEQ) m4 = *(const uint4*)(sg + q0);
        const unsigned long long b0 = __ballot((m4.x >> j) & 1u), b1 = __ballot((m4.y >> j) & 1u), b2 = __ballot((m4.z >> j) & 1u), b3 = __ballot((m4.w >> j) & 1u);
        const int c0 = (int)__popcll(b0), c1 = (int)__popcll(b1), c2 = (int)__popcll(b2), c3 = (int)__popcll(b3);
        if ((tid & 63) == 0) wcnt[c.wid] = (unsigned)(c0 + c1 + c2 + c3);
        asm volatile("s_waitcnt vmcnt(0) lgkmcnt(0)\n\ts_barrier" ::: "memory");
        int off = total, tot = 0;
#pragma unroll
        for (int w = 0; w < 8; ++w) { const int v = (int)wcnt[w]; off += (w < c.wid) ? v : 0; tot += v; }
        const unsigned long long below = (1ull << (tid & 63)) - 1ull; const unsigned lowj = (1u << j) - 1u;
        if ((m4.x >> j) & 1u) list[off + __popcll(b0 & below)] = (unsigned short)((q0 + 0) | (__popc(m4.x & lowj) << 13)); off += c0;
        if ((m4.y >> j) & 1u) list[off + __popcll(b1 & below)] = (unsigned short)((q0 + 1) | (__popc(m4.y & lowj) << 13)); off += c1;
        if ((m4.z >> j) & 1u) list[off + __popcll(b2 & below)] = (unsigned short)((q0 + 2) | (__popc(m4.z & lowj) << 13)); off += c2;
        if ((m4.w >> j) & 1u) list[off + __popcll(b3 & below)] = (unsigned short)((q0 + 3) | (__popc(m4.w & lowj) << 13));
        total += tot;
        asm volatile("s_waitcnt lgkmcnt(0)\n\ts_barrier" ::: "memory");
    }
    total = __builtin_amdgcn_readfirstlane(total);
    { const int npad = (32 - (total & 31)) & 31; if (tid < npad) list[total + tid] = 0xFFFFu; }
    const int nchunks = (total + 31) >> 5;
    asm volatile("s_waitcnt vmcnt(0) lgkmcnt(0)\n\ts_barrier" ::: "memory");
    unsigned e_n = 0xFFFFu; bf16x8 qn[4];
    if (c.wid < nchunks) { const int l0 = fresh_lane(); e_n = list[32 * c.wid + (l0 & 31)]; const int q0 = (e_n != 0xFFFFu) ? (int)(e_n & 0x1FFFu) : SEQ - 1;
#pragma unroll
        for (int d0 = 0; d0 < 4; ++d0) qn[d0] = *(const bf16x8*)(QA + (size_t)q0 * 64 + d0 * 16 + (l0 >> 5) * 8); }
    if (!(flags & 64)) for (int ch = c.wid; ch < nchunks; ch += 8) {
        const int lane = fresh_lane(), r32 = lane & 31, hi = lane >> 5;
        const lds_cptr kp0 = (lds_cptr)c.lds + r32 * 128;
        const lds_cptr vp0 = (lds_cptr)c.lds + 8192 + ((lane >> 4) & 1) * 32 + (lane & 3) * 8 + (4 * hi + ((lane & 15) >> 2)) * 64;
        const unsigned e = e_n; const bool valid = e != 0xFFFFu; const int q = valid ? (int)(e & 0x1FFFu) : SEQ - 1;
        bf16x8 qr[4];
#pragma unroll
        for (int d0 = 0; d0 < 4; ++d0) qr[d0] = qn[d0];
        if (ch + 8 < nchunks) { e_n = list[32 * (ch + 8) + r32]; const int q1 = (e_n != 0xFFFFu) ? (int)(e_n & 0x1FFFu) : SEQ - 1;
#pragma unroll
            for (int d0 = 0; d0 < 4; ++d0) qn[d0] = *(const bf16x8*)(QA + (size_t)q1 * 64 + d0 * 16 + hi * 8); }
        const int ntt = (ch < 8) ? (ch >> 1) + 1 : 4;
        f32x16 o[2]; o[0] = f32x16{}; o[1] = f32x16{}; float l_reg = 0.f;
#pragma unroll 1
        for (int tt = 0; tt < ntt; ++tt) { f32x16 s0, s1; qk_tile(s0, s1, kp0 + tt * SLOT, qr);
            const int dq = q - (256 * j + 64 * tt);
            if (__any(valid && dq < 113 + 63)) hook_near(s0, s1, dq - 4 * hi, lut); else hook_exp(s0, s1);
            l_reg += rowsum32(s0, s1);
            pv_tile<false>(o, vp0 + tt * SLOT, s0, s1, 0u); }
        const float L = pair_sum(l_reg);
        if (hi == 0 && valid) P.part_l[((size_t)bh * SEQ + q) * 4 + (e >> 13)] = L;
        LAS bf16* stg = (LAS bf16*)(c.lds + LDS_OST) + c.wid * 2048;
#pragma unroll
        for (int r = 0; r < 16; ++r) { const int orow = (r & 3) + 8 * (r >> 2) + 4 * hi;
#pragma unroll
            for (int d0 = 0; d0 < 2; ++d0) stg[orow * 64 + d0 * 32 + r32] = (bf16)f2bf(o[d0][r]); }
        asm volatile("s_waitcnt lgkmcnt(0)" ::: "memory");
#pragma unroll
        for (int it = 0; it < 4; ++it) { const int row = it * 8 + (lane >> 3), chn = lane & 7; const unsigned e2 = list[32 * ch + row];
            const u32x4 v = *(const LAS u32x4*)(stg + row * 64 + chn * 8);
            if (e2 != 0xFFFFu) *(u32x4*)(P.part_o + (((size_t)bh * SEQ + (e2 & 0x1FFFu)) * 4 + (e2 >> 13)) * 64 + chn * 8) = v; }
        asm volatile("s_waitcnt lgkmcnt(0)" ::: "memory");
    }
    asm volatile("s_waitcnt lgkmcnt(0)\n\ts_barrier" ::: "memory");
}
__device__ __forceinline__ void moba_merge_pass(const AttnPtrs& P, int vcu, int G, int tid) {
    const int lane = tid & 63, h = lane >> 3, chn = lane & 7; const int wid = __builtin_amdgcn_readfirstlane(tid >> 6);
#pragma unroll 2
    for (int tok = vcu * 8 + wid; tok < TOK; tok += G * 8) { const int b = tok >> 13, q = tok & (SEQ - 1);
        const size_t qi = (size_t)(b * 8 + h) * SEQ + q;
        const unsigned sg = P.selg[qi]; const f32x4 l4 = *(const f32x4*)(P.part_l + qi * 4);
        u32x4 pv[4];
#pragma unroll
        for (int sidx = 0; sidx < 4; ++sidx) pv[sidx] = *(const u32x4*)(P.part_o + (qi * 4 + sidx) * 64 + chn * 8);
        const int ns = __popc(sg);
        float Lt = l4[3];
        f32x4 a0 = {__uint_as_float(pv[3].x << 16), __uint_as_float(pv[3].x & 0xffff0000u), __uint_as_float(pv[3].y << 16), __uint_as_float(pv[3].y & 0xffff0000u)};
        f32x4 a1 = {__uint_as_float(pv[3].z << 16), __uint_as_float(pv[3].z & 0xffff0000u), __uint_as_float(pv[3].w << 16), __uint_as_float(pv[3].w & 0xffff0000u)};
#pragma unroll
        for (int sidx = 0; sidx < 3; ++sidx) { const bool on = sidx < ns; const u32x4 w = pv[sidx];
            const unsigned wx = on ? w.x : 0u, wy = on ? w.y : 0u, wz = on ? w.z : 0u, ww = on ? w.w : 0u;
            Lt += on ? l4[sidx] : 0.f;
            a0 += (f32x4){__uint_as_float(wx << 16), __uint_as_float(wx & 0xffff0000u), __uint_as_float(wy << 16), __uint_as_float(wy & 0xffff0000u)};
            a1 += (f32x4){__uint_as_float(wz << 16), __uint_as_float(wz & 0xffff0000u), __uint_as_float(ww << 16), __uint_as_float(ww & 0xffff0000u)}; }
        const float inv = 1.f / Lt; a0 *= inv; a1 *= inv;
        const u32x4 w = {cvtpk(a0[0], a0[1]), cvtpk(a0[2], a0[3]), cvtpk(a1[0], a1[1]), cvtpk(a1[2], a1[3])};
        *(u32x4*)(P.mix + (size_t)tok * DM + h * 64 + chn * 8) = w; }
}

__device__ __forceinline__ void nsa_item(const Ctx& c, const AttnPtrs& P, int b, int g, int ci, int flags = 0) {
    const int ql = 8 * c.wid + (c.r32 >> 2), rh = c.r32 & 3, qpos = 64 * ci + ql, hb = 4 * g + rh;
    const int qw0 = 64 * ci + 8 * c.wid;
    const bf16* QB = P.qkv + 3 * QKV_BIG + ((size_t)(b * 8 + hb) * SEQ) * 64;
    const bf16* KS = P.qkv + 4 * QKV_BIG + 2 * QKV_SMALL + ((size_t)(b * 2 + g) * SEQ) * 64; const bf16* VS = KS + QKV_SMALL; const bf16* KW = KS + 2 * QKV_SMALL; const bf16* VW = KS + 3 * QKV_SMALL;
    const bf16* KC = P.kcmp + (size_t)(b * 2 + g) * 512 * 64; const bf16* VC = P.vcmp + (size_t)(b * 2 + g) * 512 * 64;
    bf16x8 qr[4];
#pragma unroll
    for (int d0 = 0; d0 < 4; ++d0) qr[d0] = *(const bf16x8*)(QB + (size_t)qpos * 64 + d0 * 16 + c.hi * 8);
    asm volatile("" : "+v"(qr[0]), "+v"(qr[1]), "+v"(qr[2]), "+v"(qr[3]));
    const LAS float* lut = (const LAS float*)(c.lds + LDS_LUTG) + (8 + hb) * LUT_PITCH;
    LAS float* imp = (LAS float*)(c.lds + LDS_IMP);
    LAS unsigned* selm = (LAS unsigned*)(c.lds + LDS_SELM);
    f32x16 o[2]; float l_reg; float fr[16];
    LAS float* park = (LAS float*)(c.lds + LDS_OST) + c.wid * 1024 + c.lane;
    LAS float* park1 = (LAS float*)(c.lds + LDS_IMP) + c.wid * 1024 + c.lane;
    const int nct = (4 * ci + 3 + 63) >> 6;
    const int nlim = (qpos >= 31) ? ((qpos - 31) >> 4) : -1;
    const int nlim_w = (qw0 >= 31) ? ((qw0 - 31) >> 4) : -1;
    LAS bf16* impt = (LAS bf16*)(c.lds + ((rh & 2) ? LDS_IMP : LDS_OST)) + ((rh & 2) ? IMP_REG1 : 0) + (rh & 1) * IMP_PLANE + ql * IMP_PITCH;
    l_reg = 0.f; o[0] = f32x16{}; o[1] = f32x16{};
    {
        float carry = 0.f;
        if (!(flags & 32)) run_stream<true>(c, KC, VC, 0, nct,
          [&](int t, lds_cptr kp, f32x16& s0, f32x16& s1) { qk_tile(s0, s1, kp, qr); },
          [&](int t, lds_cptr vp, f32x16& s0, f32x16& s1) {
            if (nlim_w - 64 * t >= 63) hook_exp(s0, s1); else hook_cmp(s0, s1, nlim - 64 * t - 4 * c.hi, 0.f);
            l_reg += rowsum32(s0, s1);
#pragma unroll
            for (int half = 0; half < 2; ++half) {
                float g4[4], e[4];
#pragma unroll
                for (int a = 0; a < 4; ++a) { const float x0 = half ? s1[4 * a] : s0[4 * a], x1 = half ? s1[4 * a + 1] : s0[4 * a + 1], x2 = half ? s1[4 * a + 2] : s0[4 * a + 2], x3 = half ? s1[4 * a + 3] : s0[4 * a + 3];
                    g4[a] = (x0 + x1) + (x2 + x3); e[a] = x3; }
                float x[4];
#pragma unroll
                for (int a = 0; a < 4; ++a) { auto rr = __builtin_amdgcn_permlane32_swap(__float_as_uint(e[a]), __float_as_uint(e[a]), false, false); x[a] = __uint_as_float(c.hi ? rr[0] : rr[1]); }
                const int jb = 16 * t + 8 * half;
                float iv[4];
                if (c.hi) {
#pragma unroll
                    for (int a = 0; a < 4; ++a) iv[a] = g4[a] + x[a]; }
                else { iv[0] = g4[0] + carry; iv[1] = g4[1] + x[0]; iv[2] = g4[2] + x[1]; iv[3] = g4[3] + x[2]; carry = x[3]; }
#pragma unroll
                for (int a = 0; a < 4; ++a) impt[jb + 2 * a + c.hi] = (bf16)f2bf(iv[a]);
            }
            pv_tile<false>(o, vp, s0, s1, 0u);
        });
    }
    const float Lc = pair_sum(l_reg); const float invLc = Lc > 0.f ? 1.f / Lc : 0.f;
    { LAS float* wsfw = (LAS float*)(c.lds + LDS_WSF) + c.wid * 64; if (c.hi == 0) wsfw[32 + c.r32] = invLc; }
    const float* gp = P.gates + ((size_t)b * SEQ + qpos) * 24 + hb * 3; float g0 = gp[0], g1 = gp[1], g2 = gp[2];
    {
        asm volatile("s_waitcnt lgkmcnt(0)\n\ts_barrier" ::: "memory");
        const int fl = fresh_lane(); const int qq = 8 * c.wid + (fl >> 3), cc = fl & 7;
        unsigned m0 = 0u, m1 = 0u, m2w = 0u, m3 = 0u;
        if (ci <= 15 || (flags & 16)) { m0 = (ci >= 31) ? 0xffffffffu : ((2u << ci) - 1u); }
        else {
            unsigned v[16];
            const LAS float* il = (const LAS float*)(c.lds + LDS_WSF) + c.wid * 64 + 32 + 4 * (fl >> 3);
            const float i0 = il[0], i1 = il[1], i2 = il[2], i3 = il[3];
            const LAS bf16* ta = (const LAS bf16*)(c.lds + LDS_OST) + qq * IMP_PITCH; const LAS bf16* tb = (const LAS bf16*)(c.lds + LDS_IMP) + IMP_REG1 + qq * IMP_PITCH;
#pragma unroll
            for (int k = 0; k < 16; ++k) { const int j = cc + 8 * k;
                const float val = (bf2f(ta[j]) * i0 + bf2f(ta[IMP_PLANE + j]) * i1) + (bf2f(tb[j]) * i2 + bf2f(tb[IMP_PLANE + j]) * i3);
                v[k] = (j >= 1 && j <= ci - 2) ? ((__float_as_uint(val) & ~127u) | (unsigned)(127 - j)) : 0u; }
            for (int it = 0; it < 13; ++it) {
                unsigned m = v[0];
#pragma unroll
                for (int k = 1; k < 16; ++k) m = max(m, v[k]);
#pragma unroll
                for (int sft = 1; sft < 8; sft <<= 1) m = max(m, (unsigned)__shfl_xor((int)m, sft));
                if (m != 0u) { const int jb = 127 - (int)(m & 127u); const unsigned bit = 1u << (jb & 31); const int wsel = jb >> 5;
                    m0 |= (wsel == 0) ? bit : 0u; m1 |= (wsel == 1) ? bit : 0u; m2w |= (wsel == 2) ? bit : 0u; m3 |= (wsel == 3) ? bit : 0u;
#pragma unroll
                    for (int k = 0; k < 16; ++k) v[k] = (v[k] == m) ? 0u : v[k]; }
            }
            m0 |= 1u;
#pragma unroll
            for (int z = 0; z < 2; ++z) { const int jf = ci - z; const unsigned bit = 1u << (jf & 31); const int wsel = jf >> 5;
                m0 |= (wsel == 0) ? bit : 0u; m1 |= (wsel == 1) ? bit : 0u; m2w |= (wsel == 2) ? bit : 0u; m3 |= (wsel == 3) ? bit : 0u; }
        }
        if (cc == 0) { selm[qq * 4 + 0] = m0; selm[qq * 4 + 1] = m1; selm[qq * 4 + 2] = m2w; selm[qq * 4 + 3] = m3; }
        asm volatile("s_waitcnt lgkmcnt(0)\n\ts_barrier" ::: "memory");
    }
    asm volatile("" : "+v"(g0), "+v"(g1), "+v"(g2));
    row_factors(c, g0 * invLc, fr);
#pragma unroll
    for (int r = 0; r < 16; ++r) { park[r * 64] = o[0][r] * fr[r]; park1[r * 64] = o[1][r] * fr[r]; }
    {
        const unsigned w0 = selm[ql * 4 + 0], w1 = selm[ql * 4 + 1], w2 = selm[ql * 4 + 2], w3 = selm[ql * 4 + 3];
        o[0] = f32x16{}; o[1] = f32x16{}; l_reg = 0.f;
        auto sel_pred = [&](int t) -> bool { const unsigned wsel = (t < 32) ? w0 : (t < 64) ? w1 : (t < 96) ? w2 : w3; return (wsel >> (t & 31)) & 1u; };
        auto sel_one = [&](int t, lds_cptr kp, lds_cptr vp) { const bool pred = sel_pred(t); if (!__any(pred)) return; const int key0 = 64 * t;
            f32x16 s0, s1; qk_tile(s0, s1, kp, qr);
            if (qw0 - key0 - 63 >= 113) { hook_exp(s0, s1); const float rs = rowsum32(s0, s1); l_reg += pred ? rs : 0.f;
                if (__all(pred)) pv_tile<false>(o, vp, s0, s1, 0u); else pv_tile<true>(o, vp, s0, s1, pred ? 0xffffffffu : 0u); }
            else { hook_near(s0, s1, qpos - key0 - 4 * c.hi, lut); const float rs = rowsum32(s0, s1); l_reg += pred ? rs : 0.f;
                if (__all(pred)) pv_tile<false>(o, vp, s0, s1, 0u); else pv_tile<true>(o, vp, s0, s1, pred ? 0xffffffffu : 0u); } };
        if (!(flags & 4)) run_stream_pairs(c, KS, VS, 0, ci + 1, sel_one,
            [&](int t, lds_cptr kpA, lds_cptr vpA, lds_cptr kpB, lds_cptr vpB) {
                if (qw0 - 64 * (t + 1) - 63 >= 113) {
                    const bool pa = sel_pred(t), pb = sel_pred(t + 1);
                    const bool xa = __any(pa), xb = __any(pb);
                    if (!xa && !xb) return;
                    if (!xb) { sel_one(t, kpA, vpA); return; }
                    if (!xa) { sel_one(t + 1, kpB, vpB); return; }
                    KF kA, kB; ld_k(kA, kpA); ATT_SB();
                    f32x16 a0, a1, b0, b1; qk_mfma(a0, a1, kA, qr); ATT_SB();
                    VF vA, vB; ld_k(kB, kpB); ld_v(vA, vpA); ATT_SB();
                    qk_mfma(b0, b1, kB, qr); hook_exp(a0, a1);
                    const float ra = rowsum32(a0, a1); const PW4 wa = pack4(a0, a1, pa ? 0xffffffffu : 0u); ATT_SB();
                    ld_v(vB, vpB); ATT_SB();
                    pv_mfma(o, vA, wa); hook_exp(b0, b1);
                    const float rb = rowsum32(b0, b1); const PW4 wb = pack4(b0, b1, pb ? 0xffffffffu : 0u); l_reg += (pa ? ra : 0.f) + (pb ? rb : 0.f); ATT_SB();
                    pv_mfma(o, vB, wb);
                } else { sel_one(t, kpA, vpA); sel_one(t + 1, kpB, vpB); } });
        const float Ls = pair_sum(l_reg);
        row_factors(c, g1 / Ls, fr);
#pragma unroll
        for (int r = 0; r < 16; ++r) { park[r * 64] += o[0][r] * fr[r]; park1[r * 64] += o[1][r] * fr[r]; }
    }
    {
        o[0] = f32x16{}; o[1] = f32x16{}; l_reg = 0.f;
        if (!(flags & 8)) run_stream<true>(c, KW, VW, ci >= 8 ? ci - 8 : 0, ci + 1,
            [&](int t, lds_cptr kp, f32x16& s0, f32x16& s1) { qk_tile(s0, s1, kp, qr); },
            [&](int t, lds_cptr vp, f32x16& s0, f32x16& s1) { const int key0 = 64 * t;
                if (qw0 - key0 - 63 < 113) hook_near(s0, s1, qpos - key0 - 4 * c.hi, lut); else if (qw0 + 7 - key0 >= 512) hook_edge(s0, s1, qpos - key0 - 4 * c.hi, 512); else hook_exp(s0, s1);
                l_reg += rowsum32(s0, s1);
                pv_tile<false>(o, vp, s0, s1, 0u); });
        const float Lw = pair_sum(l_reg);
        row_factors(c, g2 / Lw, fr);
#pragma unroll
        for (int r = 0; r < 16; ++r) { o[0][r] = park[r * 64] + o[0][r] * fr[r]; o[1][r] = park1[r * 64] + o[1][r] * fr[r]; }
        asm volatile("s_waitcnt lgkmcnt(0)" ::: "memory");
    }
    bf16* dst = P.mix + ((size_t)b * SEQ + 64 * ci + 8 * c.wid) * DM + 512 + g * 256;
    store_rows(c, o, dst, [](int row) { return (size_t)(row >> 2) * DM + (row & 3) * 64; });
    asm volatile("s_waitcnt lgkmcnt(0)\n\ts_barrier" ::: "memory");
}

__device__ __forceinline__ void attn_phase(LAS unsigned char* lds, const AttnPtrs& P, unsigned* qcounter, int flags) {
    Ctx c = make_ctx(lds, threadIdx.x);
    LAS unsigned* misc = (LAS unsigned*)(c.lds + LDS_MISC);
    { LAS float* lutg = (LAS float*)(c.lds + LDS_LUTG);
      for (int idx = threadIdx.x; idx < 16 * 115; idx += NTHREADS) { const int hh = idx / 115, d = idx % 115;
          lutg[hh * LUT_PITCH + d] = (d == 0) ? -INFINITY : (P.rel_bias[t5_bucket(d - 1) * 16 + hh] - P.rel_bias[31 * 16 + hh]) * LOG2E; }
      asm volatile("s_waitcnt vmcnt(0) lgkmcnt(0)\n\ts_barrier" ::: "memory"); }
    for (;;) {
        if (threadIdx.x == 0) misc[0] = __hip_atomic_fetch_add(qcounter, 1u, __ATOMIC_RELAXED, __HIP_MEMORY_SCOPE_AGENT);
        asm volatile("s_waitcnt vmcnt(0) lgkmcnt(0)\n\ts_barrier" ::: "memory");
        const unsigned k = misc[0];
        asm volatile("s_waitcnt lgkmcnt(0)\n\ts_barrier" ::: "memory");
        if (k >= 2048u) break;
        const bool is_mp = k >= 512u && k < 1536u;
        if (flags & (is_mp ? 2 : 1)) continue;
        if (k < 512u) { const int s_ = 127 - (int)(k >> 3), bg = k & 7; nsa_item(c, P, bg >> 1, bg & 1, s_, flags); }
        else if (k < 1536u) { const int kk = (int)k - 512, j = kk >> 5, bh = kk & 31; moba_past_item(c, P, bh >> 3, bh & 7, j, flags); }
        else { const int kk = (int)k - 1536; const int s_ = 63 - (kk >> 3), bg = kk & 7; nsa_item(c, P, bg >> 1, bg & 1, s_, flags); }
    }
}
#undef MFMA32
#undef ATT_WAIT_BAR
}
namespace cmpr {
using bf16x8 = __attribute__((ext_vector_type(8))) short;
using f32x16 = __attribute__((ext_vector_type(16))) float;
constexpr int HID_PITCH = 528;
__device__ __forceinline__ float gelu_tanh(float v) { const float u = fminf(fmaxf(0.7978845608028654f * (v + 0.044715f * v * v * v), -15.f), 15.f); const float e = __expf(2.f * u); return 0.5f * v * (1.f + (e - 1.f) / (e + 1.f)); }
__device__ __forceinline__ void compress_unit(LAS unsigned char* lds, int unit, const bf16* qkv, const bf16* w1k, const bf16* w1v, const bf16* w2k, const bf16* w2v, const float* cbp, const float* kncmp, bf16* kcmp, bf16* vcmp) {
    const int tid = threadIdx.x, lane = tid & 63, r32 = lane & 31, hi = lane >> 5; const int wid = __builtin_amdgcn_readfirstlane(tid >> 6);
    const int kv = unit & 1, u = (unit >> 1) & 15, bg = unit >> 5;
    const bf16* src = qkv + 4 * QKV_BIG + (kv ? QKV_SMALL : 0) + (size_t)bg * SEQ * 64;
    const bf16* w1 = kv ? w1v : w1k; const bf16* w2 = kv ? w2v : w2k;
    const int n0 = 32 * u;
    { const bf16* sp = src + (size_t)16 * n0 * 64;
      for (int ch = tid; ch < 4224; ch += NTHREADS) { v4u v = {0u, 0u, 0u, 0u}; if (16 * n0 + (ch >> 3) < SEQ) v = *(const GAS v4u*)(sp + (size_t)ch * 8);
          *(LAS v4u*)(lds + ((ch ^ ((ch >> 7) & 15)) << 4)) = v; } }
    asm volatile("s_waitcnt vmcnt(0) lgkmcnt(0)\n\ts_barrier" ::: "memory");
    const bf16* bp = w1 + ((size_t)wid * 64 + lane) * 8;
    f32x16 acc = {};
#pragma unroll 16
    for (int kk = 0; kk < 128; ++kk) { const int lc = r32 * 128 + 2 * kk + hi; const bf16x8 a = *(const LAS bf16x8*)(lds + ((lc ^ ((lc >> 7) & 15)) << 4)), bfr = *(const bf16x8*)(bp + (size_t)kk * 4096); acc = __builtin_amdgcn_mfma_f32_32x32x16_bf16(a, bfr, acc, 0, 0, 0); }
    float cb = 0.f;
#pragma unroll 8
    for (int ic = 0; ic < 32; ++ic) cb += cbp[(ic * 2 + kv) * 256 + 32 * wid + r32];
    LAS unsigned char* hidL = lds + 69632;
#pragma unroll
    for (int r = 0; r < 16; ++r) { const int n = (r & 3) + 8 * (r >> 2) + 4 * hi; *(LAS bf16*)(hidL + n * HID_PITCH + (32 * wid + r32) * 2) = (bf16)f2bf(gelu_tanh(acc[r] + cb)); }
    asm volatile("s_waitcnt lgkmcnt(0)\n\ts_barrier" ::: "memory");
    if (wid == 0) {
        f32x16 o0 = {}, o1 = {};
#pragma unroll 4
        for (int kk = 0; kk < 16; ++kk) { const bf16x8 hb = *(const LAS bf16x8*)(hidL + r32 * HID_PITCH + (16 * kk + 8 * hi) * 2);
            const bf16x8 a0 = *(const bf16x8*)(w2 + (size_t)r32 * 256 + 16 * kk + 8 * hi), a1 = *(const bf16x8*)(w2 + (size_t)(32 + r32) * 256 + 16 * kk + 8 * hi);
            o0 = __builtin_amdgcn_mfma_f32_32x32x16_bf16(a0, hb, o0, 0, 0, 0); o1 = __builtin_amdgcn_mfma_f32_32x32x16_bf16(a1, hb, o1, 0, 0, 0); }
        float rs = 1.f;
        if (!kv) { float ss = 0.f;
#pragma unroll
            for (int r = 0; r < 16; ++r) ss += o0[r] * o0[r] + o1[r] * o1[r];
            auto rr = __builtin_amdgcn_permlane32_swap(__float_as_uint(ss), __float_as_uint(ss), false, false); ss = __uint_as_float(rr[0]) + __uint_as_float(rr[1]);
            rs = rsqrtf(ss * (1.f / 64.f) + 1e-6f); }
        const int n = n0 + r32; bf16* dst = (kv ? vcmp : kcmp) + ((size_t)bg * 512 + n) * 64;
#pragma unroll
        for (int r = 0; r < 16; ++r) { const int d = (r & 3) + 8 * (r >> 2) + 4 * hi;
            float v0 = o0[r] * rs, v1 = o1[r] * rs; if (!kv) { v0 *= kncmp[d]; v1 *= kncmp[d + 32]; }
            if (n >= NCMP) { v0 = 0.f; v1 = 0.f; }
            dst[d] = (bf16)f2bf(v0); dst[d + 32] = (bf16)f2bf(v1); }
    }
    asm volatile("s_waitcnt lgkmcnt(0)\n\ts_barrier" ::: "memory");
}
}
__global__ void __launch_bounds__(NTHREADS, 2) mk_fwd(Args a) {
    extern __shared__ __attribute__((aligned(16))) unsigned char lds[];
    Frame F;
    F.lds = (LAS unsigned char*)lds;
    F.tid = threadIdx.x; F.lane = F.tid & 63; F.wave = __builtin_amdgcn_readfirstlane(F.tid >> 6);
    F.G = gridDim.x; { const int bx = blockIdx.x; F.vcu = (F.G % 8 == 0) ? (bx % 8) * (F.G / 8) + bx / 8 : bx; }
    cg::grid_group grid = cg::this_grid();
    volatile LAS unsigned* xst = (volatile LAS unsigned*)(F.lds + 147424);
    if (F.tid < 8) xst[F.tid] = 0u;
    __syncthreads();
    const XcdBarrier xbar = xcd_barrier_post((unsigned*)(a.ws + WS_CTL) + 4096, xst);
    unsigned char* ws = a.ws;
    const int lo = a.ph_lo, hi = a.ph_hi & 0xff; const int tflags = a.ph_hi >> 8; (void)tflags;
    const att::AttnPtrs P{(const bf16*)(ws + WS_QKV), (const float*)(ws + WS_KMP), (const float*)(ws + WS_GATES), (const bf16*)(ws + WS_KCMP), (const bf16*)(ws + WS_VCMP), a.in[2], (bf16*)(ws + WS_MIX),
                          (unsigned*)(ws + WS_SELG), (bf16*)(ws + WS_PARTO), (float*)(ws + WS_PARTL)};
#define IN(k) (lo <= (k) && (k) < hi)
#define SEAM(k) do { if (IN(k) && IN((k) + 1)) { if ((k) == 0) grid.sync(); else xcd_barrier(xbar); } } while (0)
    if (IN(0)) { phase_prologue_a(F, a); } SEAM(0);
    if (IN(1)) { phase_prologue_b(F, a); } SEAM(1);
    if (IN(2)) {
        pg8::Gemm g{(const pg8::bf16_t*)(ws + WS_H), (const pg8::bf16_t*)(ws + WS_WIN), TOK, NIN_PAD, DM}; pg8::StaticOrder S; S.init(TOK, NIN_PAD, F.G, (int)blockIdx.x);
        pg8::EpiInProj E{(pg8::bf16_t*)(ws + WS_QKV), (float*)(ws + WS_GATES), (float*)(ws + WS_KMP), a.in[7], a.in[8], a.in[9], a.in[11], a.in[12]};
        pg8::gemm_phase<pg8::EpiInProj, pg8::StaticOrder, true, true>(F.lds, g, S, E);
    } SEAM(2);
    if (IN(3)) {
        if (!(tflags & 1)) att::moba_gate_phase(P, F.vcu, F.G, F.tid);
        if (!(tflags & 2)) for (int unit = F.vcu; unit < 256; unit += F.G)
            cmpr::compress_unit(F.lds, unit, (const bf16*)(ws + WS_QKV), (const bf16*)(ws + WS_W1K), (const bf16*)(ws + WS_W1V), (const bf16*)(ws + WS_W2K), (const bf16*)(ws + WS_W2V),
                                (const float*)(ws + WS_CBP), a.in[10], (bf16*)(ws + WS_KCMP), (bf16*)(ws + WS_VCMP));
    } SEAM(3);
    if (IN(4)) {
#if HYBRID == 3
        att::attn_phase(F.lds, P, (unsigned*)(ws + WS_CTL) + 64, tflags);
#else
        att::attn_phase(F.lds, P, (unsigned*)(ws + WS_CTL) + 64, 0);
#endif
    } SEAM(4);
    if (IN(5)) { att::moba_merge_pass(P, F.vcu, F.G, F.tid); } SEAM(5);
    if (IN(6)) {
        pg8::Gemm g{(const pg8::bf16_t*)(ws + WS_MIX), (const pg8::bf16_t*)(ws + WS_WOUT), TOK, DM, DM}; pg8::StaticOrder S; S.init(TOK, DM, F.G, (int)blockIdx.x);
        pg8::EpiOutProj E{(pg8::bf16_t*)(ws + WS_Y), (const float*)(ws + WS_MOD) + 2 * DM};
        pg8::gemm_phase<pg8::EpiOutProj, pg8::StaticOrder, true, true>(F.lds, g, S, E);
    } SEAM(6);
    if (IN(7)) { phase_norm2(F, a); } SEAM(7);
    if (IN(8)) {
        pg8::Gemm g{(const pg8::bf16_t*)(ws + WS_H), (const pg8::bf16_t*)(ws + WS_WGU), TOK, 2 * FF, DM}; pg8::StaticOrder S; S.init(TOK, 2 * FF, F.G, (int)blockIdx.x);
        pg8::EpiGateUp E{(pg8::bf16_t*)(ws + WS_ACT)};
        pg8::gemm_phase<pg8::EpiGateUp, pg8::StaticOrder, true, true>(F.lds, g, S, E);
    } SEAM(8);
    if (IN(9)) {
        pg8::Gemm g{(const pg8::bf16_t*)(ws + WS_ACT), (const pg8::bf16_t*)(ws + WS_WDN), TOK, DM, FF}; pg8::StaticOrder S; S.init(TOK, DM, F.G, (int)blockIdx.x);
        pg8::EpiDown E{a.in[0], (const pg8::bf16_t*)(ws + WS_Y), a.out, (const float*)(ws + WS_MOD) + 5 * DM};
        pg8::gemm_phase<pg8::EpiDown, pg8::StaticOrder, true, true>(F.lds, g, S, E);
    }
#undef IN
#undef SEAM
}

static void launch_phases(const Args& base, int lo, int hi, int grid, hipStream_t stream, int flags = 0) {
    Args a = base; a.ph_lo = lo; a.ph_hi = hi | (flags << 8);
    if (hi - lo > 1) { void* args[] = {&a}; (void)hipLaunchCooperativeKernel((const void*)mk_fwd, dim3(grid), dim3(NTHREADS), args, LDS_BYTES, stream); }
    else hipLaunchKernelGGL(mk_fwd, dim3(grid), dim3(NTHREADS), LDS_BYTES, stream, a);
}
extern "C" void kernel_launch(void* const* d_in, const int* in_sizes, int n_in, void* d_out, int out_size, void* d_ws, size_t ws_size, hipStream_t stream) {
    static int grid = 0;
    if (grid == 0) {
        int dev = 0, cus = 0, per_cu = 0;
        if (n_in != 23 || ws_size < 480 * MiB || hipGetDevice(&dev) != hipSuccess || hipDeviceGetAttribute(&cus, hipDeviceAttributeMultiprocessorCount, dev) != hipSuccess) { grid = -1; return; }
        if (hipFuncSetAttribute((const void*)mk_fwd, hipFuncAttributeMaxDynamicSharedMemorySize, LDS_BYTES) != hipSuccess) { grid = -1; return; }
        if (hipOccupancyMaxActiveBlocksPerMultiprocessor(&per_cu, (const void*)mk_fwd, NTHREADS, LDS_BYTES) != hipSuccess || per_cu < 1) { grid = -1; return; }
        grid = cus;
    }
    if (grid < 0) return;
    (void)hipMemsetAsync((char*)d_ws + WS_CTL, 0, CTL_ZERO_BYTES, stream);
    Args a{};
    for (int i = 0; i < 23; ++i) a.in[i] = (const float*)d_in[i];
    a.out = (float*)d_out; a.ws = (unsigned char*)d_ws;
    unsigned char* ws = (unsigned char*)d_ws;
#if HYBRID == 1
    launch_phases(a, 0, 1, grid, stream); launch_phases(a, 1, 2, grid, stream); launch_phases(a, 2, 3, grid, stream);
    const bf16* qkv = (const bf16*)(ws + WS_QKV); bf16* mix = (bf16*)(ws + WS_MIX); bf16* kcmp = (bf16*)(ws + WS_KCMP); bf16* vcmp = (bf16*)(ws + WS_VCMP);
    int* sel = (int*)(ws + 344 * MiB); float* obuf = (float*)(ws + 348 * MiB); const float* gates = (const float*)(ws + WS_GATES);
    nq::k_compress<<<dim3(4 * 2 * 512, 2), 256, 0, stream>>>(qkv, a.in[13], a.in[14], a.in[15], a.in[16], a.in[17], a.in[18], a.in[10], kcmp, vcmp);
    nq::k_moba<<<4 * 8 * SEQ / 4, 256, 0, stream>>>(qkv, (const float*)(ws + WS_KMP), a.in[2], mix);
    nq::k_nsa_cmp<<<4 * 2 * SEQ, 256, 0, stream>>>(qkv, kcmp, vcmp, gates, obuf, sel);
    nq::k_nsa_sel<<<4 * 2 * SEQ, 256, 0, stream>>>(qkv, sel, a.in[2], gates, obuf);
    nq::k_nsa_win<<<4 * 2 * SEQ, 256, 0, stream>>>(qkv, a.in[2], gates, obuf, mix);
    launch_phases(a, 5, 6, grid, stream); launch_phases(a, 6, 7, grid, stream); launch_phases(a, 7, 8, grid, stream); launch_phases(a, 8, 9, grid, stream);
#elif HYBRID == 2
    launch_phases(a, 0, 1, grid, stream); launch_phases(a, 1, 2, grid, stream); launch_phases(a, 2, 3, grid, stream);
    nq::k_compress<<<dim3(4 * 2 * 512, 2), 256, 0, stream>>>((const bf16*)(ws + WS_QKV), a.in[13], a.in[14], a.in[15], a.in[16], a.in[17], a.in[18], a.in[10], (bf16*)(ws + WS_KCMP), (bf16*)(ws + WS_VCMP));
    launch_phases(a, 4, 5, grid, stream);
    launch_phases(a, 5, 6, grid, stream); launch_phases(a, 6, 7, grid, stream); launch_phases(a, 7, 8, grid, stream); launch_phases(a, 8, 9, grid, stream);
#elif HYBRID == 3
    for (int p = 0; p < N_PHASES; ++p) {
#if defined(TIME_PHASE)
        if (p == TIME_PHASE) { for (int r = 0; r < TIME_REPS; ++r) { launch_phases(a, p, p + 1, grid, stream, TIME_FLAGS); (void)hipMemsetAsync((char*)d_ws + WS_CTL, 0, CTL_ZERO_BYTES, stream); } }
#endif
        launch_phases(a, p, p + 1, grid, stream);
#if defined(ABL_REPS)
        if (p == 3) { static bool once = false; if (!once) { once = true; (void)hipFuncSetAttribute((const void*)k_attn_abl, hipFuncAttributeMaxDynamicSharedMemorySize, LDS_BYTES); }
            for (int r = 0; r < ABL_REPS; ++r) { (void)hipMemsetAsync((char*)d_ws + WS_CTL + 512, 0, 4, stream); hipLaunchKernelGGL(k_attn_abl, dim3(grid), dim3(NTHREADS), LDS_BYTES, stream, a); } }
#endif
    }
#else
    launch_phases(a, 0, N_PHASES, grid, stream);
#endif
}
```

```cpp
#include <hip/hip_runtime.h>
#include <hip/hip_cooperative_groups.h>
#include <cstdint>
#include <cstdio>
namespace cg = cooperative_groups;
#define HYBRID 0
namespace pg8 {
#define PG8_LAS __attribute__((address_space(3)))
typedef unsigned short bf16_t;
typedef short bf16x8 __attribute__((ext_vector_type(8)));
typedef float f32x4 __attribute__((ext_vector_type(4)));
typedef unsigned u32x4 __attribute__((ext_vector_type(4)));
constexpr int BM = 256, BK = 64, HALF = 128, HTB = HALF * BK * 2  , STAGE_BYTES = 8 * HTB, NXCD = 8, WGM = 8;

__host__ __device__ __forceinline__ int lds_byte(int r, int c) { const int st = (r >> 4) * 2 + (c >> 5), rr = r & 15, cc = c & 31, ob = rr * 64 + cc * 2; return st * 1024 + (ob ^ (((ob >> 9) & 1) << 5)); }
__host__ __device__ __forceinline__ void stage_rc(int b, int& R, int& C) { const int st = b / 1024, sb = b % 1024, swz = sb ^ (((sb >> 9) & 1) << 5); R = (st >> 1) * 16 + swz / 64; C = (st & 1) * 32 + (swz % 64) / 2; }
__host__ __device__ __forceinline__ int perm32(int rho) { const int n = rho >> 4, i = rho & 15; return 8 * (i >> 2) + 4 * n + (i & 3); }

struct Unit { int pm, pn; };
struct Gemm { const bf16_t* A; const bf16_t* Bt; int M, N, K; };

struct StaticOrder {
    int nM, nN, nwg, G, c;
    __host__ __device__ void init(int M, int N, int G_, int c_) { nM = M / BM; nN = N / BM; nwg = nM * nN; G = G_; c = c_; }
    __host__ __device__ bool next(int i, Unit& u) const {
        const long L = (long)i * G + c; if (L >= nwg) return false;
        int wgid = (int)L; { const int q = nwg / NXCD, r = nwg % NXCD, xcd = wgid % NXCD, off = wgid / NXCD; wgid = (xcd < r ? xcd * (q + 1) : r * (q + 1) + (xcd - r) * q) + off; }
        const int nig = WGM * nN, gid = wgid / nig, fm = gid * WGM, gsz = (nM - fm) < WGM ? (nM - fm) : WGM;
        u.pm = fm + ((wgid % nig) % gsz); u.pn = (wgid % nig) / gsz; return true;
    }
    __device__ __forceinline__ void a_ready(const Unit&) const {}
    __device__ __forceinline__ void done(const Unit&) const {}
};

__device__ __forceinline__ unsigned cvt_pk_bf16(float lo, float hi) { unsigned r; asm volatile("v_cvt_pk_bf16_f32 %0, %1, %2" : "=v"(r) : "v"(lo), "v"(hi)); return r; }
typedef float f32x2 __attribute__((ext_vector_type(2)));
template <class Epi, class Sched, bool ALIGN_EPI = false, bool SP2 = false>
__device__ __forceinline__ void gemm_phase(PG8_LAS unsigned char* lds, const Gemm g, const Sched& S, const Epi& E) {
    const int tid = threadIdx.x, wid = __builtin_amdgcn_readfirstlane(tid >> 6), lane = tid & 63, wr = wid >> 2, wc = wid & 3, fr = lane & 15, fq = lane >> 4;
    const int K = g.K, nt = K / BK;
    unsigned voffA[2], voffB[2];
#pragma unroll
    for (int i = 0; i < 2; ++i) { int R, C; stage_rc(tid * 16 + i * 8192, R, C); const int Rb = Epi::PERM ? ((R & ~31) + perm32(R & 31)) : R;
        voffA[i] = (unsigned)(R * K + C) * 2u; voffB[i] = (unsigned)(Rb * K + C) * 2u; }
    const size_t kstep = (size_t)(BK * 2);
    const size_t hstep = (size_t)HALF * K * 2;
    const size_t tstep = 2 * hstep;
    const unsigned ldsw = (unsigned)wid * 1024u;
    const int aoff = lds_byte(wr * 64 + fr, fq * 8), boff = lds_byte(wc * 32 + fr, fq * 8);
#define PG8_SA(b, h) (((b) * 2 + (h)) * HTB)
#define PG8_SB(b, h) ((4 + (b) * 2 + (h)) * HTB)
#define PG8_STAGE(bufoff, gbase, voff) do { _Pragma("unroll") for (int _i = 0; _i < 2; ++_i) \
        __builtin_amdgcn_global_load_lds((const unsigned*)((const char*)(gbase) + (voff)[_i]), (PG8_LAS unsigned*)(lds + (bufoff) + ldsw + _i * 8192), 16, 0, 0); } while (0)
#define PG8_LDA(dst, b, h) do { _Pragma("unroll") for (int m = 0; m < 4; ++m) _Pragma("unroll") for (int k = 0; k < 2; ++k) dst[m][k] = *(const PG8_LAS bf16x8*)(lds + PG8_SA(b, h) + aoff + m * 2048 + k * 1024); } while (0)
#define PG8_LDB(dst, b, h) do { _Pragma("unroll") for (int n = 0; n < 2; ++n) _Pragma("unroll") for (int k = 0; k < 2; ++k) dst[n][k] = *(const PG8_LAS bf16x8*)(lds + PG8_SB(b, h) + boff + n * 2048 + k * 1024); } while (0)
#define PG8_MMA(ai, bj, At, Bt) do { __builtin_amdgcn_s_setprio(1); _Pragma("unroll") for (int m = 0; m < 4; ++m) _Pragma("unroll") for (int n = 0; n < 2; ++n) _Pragma("unroll") for (int k = 0; k < 2; ++k) \
        acc[ai][bj][m][n] = __builtin_amdgcn_mfma_f32_16x16x32_bf16(Bt[n][k], At[m][k], acc[ai][bj][m][n], 0, 0, 0); __builtin_amdgcn_s_setprio(0); } while (0)
#define PG8_WAIT_V(n) asm volatile("s_waitcnt vmcnt(" #n ")" ::: "memory")
#define PG8_WAIT_L(n) asm volatile("s_waitcnt lgkmcnt(" #n ")" ::: "memory")
#define PG8_BAR __builtin_amdgcn_s_barrier()
#define PG8_SCHED __builtin_amdgcn_sched_barrier(0)
    Unit cur, nxt; int ui = 0;
    if (!S.next(0, cur)) return;
    f32x4 acc[2][2][4][2];
#pragma unroll
    for (int a = 0; a < 2; ++a)
#pragma unroll
        for (int b = 0; b < 2; ++b)
#pragma unroll
            for (int m = 0; m < 4; ++m)
#pragma unroll
                for (int n = 0; n < 2; ++n) acc[a][b][m][n] = (f32x4){0.f, 0.f, 0.f, 0.f};
    bf16x8 At[4][2], B0[2][2], B1[2][2];
    const char* cA = (const char*)g.A + (size_t)cur.pm * tstep; const char* cB = (const char*)g.Bt + (size_t)cur.pn * tstep;
    S.a_ready(cur);
    if constexpr (SP2) {
        PG8_STAGE(PG8_SB(0, 0), cB, voffB); PG8_STAGE(PG8_SB(0, 1), cB + hstep, voffB); PG8_STAGE(PG8_SA(0, 0), cA, voffA); PG8_STAGE(PG8_SA(0, 1), cA + hstep, voffA);
        if (wr == 1) PG8_BAR;
        PG8_WAIT_V(2); PG8_BAR;
        PG8_STAGE(PG8_SB(1, 0), cB + kstep, voffB); PG8_STAGE(PG8_SA(1, 0), cA + kstep, voffA); PG8_STAGE(PG8_SB(1, 1), cB + hstep + kstep, voffB);
        PG8_WAIT_V(6); PG8_BAR;
    } else {
        PG8_STAGE(PG8_SB(0, 0), cB, voffB); PG8_STAGE(PG8_SA(0, 0), cA, voffA); PG8_STAGE(PG8_SB(0, 1), cB + hstep, voffB); PG8_STAGE(PG8_SA(0, 1), cA + hstep, voffA);
        if (wr == 1) PG8_BAR;
        PG8_WAIT_V(4); PG8_BAR;
        PG8_STAGE(PG8_SB(1, 0), cB + kstep, voffB); PG8_STAGE(PG8_SA(1, 0), cA + kstep, voffA); PG8_STAGE(PG8_SB(1, 1), cB + hstep + kstep, voffB);
        PG8_WAIT_V(6); PG8_BAR;
    }
    for (;;) {
        const bool has_next = S.next(ui + 1, nxt);
        const char* nA = has_next ? (const char*)g.A + (size_t)nxt.pm * tstep : cA; const char* nB = has_next ? (const char*)g.Bt + (size_t)nxt.pn * tstep : cB;
        for (int t = 0; t < nt; t += 2) {
            const bool last = (t == nt - 2);
            const char* a1 = cA + (size_t)(t + 1) * kstep;
            const char* a2 = last ? nA : cA + (size_t)(t + 2) * kstep; const char* b2 = last ? nB : cB + (size_t)(t + 2) * kstep;
            const char* a3 = a2 + kstep; const char* b3 = b2 + kstep;
            if (last && has_next) S.a_ready(nxt);
            if constexpr (SP2) {
            PG8_LDB(B0, 0, 0); PG8_LDB(B1, 0, 1); PG8_SCHED; PG8_LDA(At, 0, 0); PG8_STAGE(PG8_SA(1, 1), a1 + hstep, voffA);
            PG8_WAIT_V(8); PG8_WAIT_L(0); PG8_BAR; PG8_MMA(0, 0, At, B0); PG8_MMA(0, 1, At, B1); PG8_BAR; PG8_SCHED;
            PG8_LDA(At, 0, 1); PG8_STAGE(PG8_SB(0, 0), b2, voffB); PG8_STAGE(PG8_SB(0, 1), b2 + hstep, voffB); PG8_STAGE(PG8_SA(0, 0), a2, voffA);
            PG8_WAIT_V(8); PG8_WAIT_L(0); PG8_BAR; PG8_MMA(1, 0, At, B0); PG8_MMA(1, 1, At, B1); PG8_BAR; PG8_SCHED;
            PG8_LDB(B0, 1, 0); PG8_LDB(B1, 1, 1); PG8_SCHED; PG8_LDA(At, 1, 0); PG8_STAGE(PG8_SA(0, 1), a2 + hstep, voffA);
            PG8_WAIT_V(8); PG8_WAIT_L(0); PG8_BAR; PG8_MMA(0, 0, At, B0); PG8_MMA(0, 1, At, B1); PG8_BAR; PG8_SCHED;
            PG8_LDA(At, 1, 1); PG8_STAGE(PG8_SB(1, 0), b3, voffB); PG8_STAGE(PG8_SB(1, 1), b3 + hstep, voffB); PG8_STAGE(PG8_SA(1, 0), a3, voffA);
            PG8_WAIT_V(8); PG8_WAIT_L(0); PG8_BAR; PG8_MMA(1, 0, At, B0); PG8_MMA(1, 1, At, B1); PG8_BAR; PG8_SCHED;
            } else {
            PG8_LDB(B0, 0, 0); PG8_SCHED; PG8_LDA(At, 0, 0); PG8_STAGE(PG8_SA(1, 1), a1 + hstep, voffA);
            PG8_WAIT_L(8); PG8_BAR; PG8_WAIT_L(0); PG8_MMA(0, 0, At, B0); PG8_BAR; PG8_SCHED;
            PG8_LDB(B1, 0, 1); PG8_STAGE(PG8_SB(0, 0), b2, voffB);
            PG8_BAR; PG8_WAIT_L(0); PG8_MMA(0, 1, At, B1); PG8_BAR;
            PG8_LDA(At, 0, 1); PG8_STAGE(PG8_SA(0, 0), a2, voffA);
            PG8_BAR; PG8_WAIT_L(0); PG8_MMA(1, 0, At, B0); PG8_BAR; PG8_SCHED;
            PG8_STAGE(PG8_SB(0, 1), b2 + hstep, voffB);
            PG8_WAIT_V(6); PG8_BAR; PG8_MMA(1, 1, At, B1); PG8_BAR;
            PG8_LDB(B0, 1, 0); PG8_SCHED; PG8_LDA(At, 1, 0); PG8_STAGE(PG8_SA(0, 1), a2 + hstep, voffA);
            PG8_WAIT_L(8); PG8_BAR; PG8_WAIT_L(0); PG8_MMA(0, 0, At, B0); PG8_BAR; PG8_SCHED;
            PG8_LDB(B1, 1, 1); PG8_STAGE(PG8_SB(1, 0), b3, voffB);
            PG8_BAR; PG8_WAIT_L(0); PG8_MMA(0, 1, At, B1); PG8_BAR;
            PG8_LDA(At, 1, 1); PG8_STAGE(PG8_SA(1, 0), a3, voffA);
            PG8_BAR; PG8_WAIT_L(0); PG8_MMA(1, 0, At, B0); PG8_BAR; PG8_SCHED;
            PG8_STAGE(PG8_SB(1, 1), b3 + hstep, voffB);
            PG8_WAIT_V(6); PG8_BAR; PG8_MMA(1, 1, At, B1); PG8_BAR;
            }
        }
        if constexpr (ALIGN_EPI) { if (wr == 0) PG8_BAR; }
        if constexpr (!Epi::AFTER_DRAIN) { E(acc, cur, wr, wc, fr, fq); S.done(cur); }
        if (!has_next) break;
#pragma unroll
        for (int a = 0; a < 2; ++a)
#pragma unroll
            for (int b = 0; b < 2; ++b)
#pragma unroll
                for (int m = 0; m < 4; ++m)
#pragma unroll
                    for (int n = 0; n < 2; ++n) acc[a][b][m][n] = (f32x4){0.f, 0.f, 0.f, 0.f};
        cur = nxt; cA = nA; cB = nB; ++ui;
        if constexpr (ALIGN_EPI) { if (wr == 1) PG8_BAR; }
    }
    PG8_WAIT_V(0);
    if constexpr (!ALIGN_EPI) { if (wr == 0) PG8_BAR; }
    PG8_BAR;
    if constexpr (Epi::AFTER_DRAIN) { E.fused(acc, cur, wr, wc, fr, fq, lds, wid, lane); S.done(cur); }
#undef PG8_SA
#undef PG8_SB
#undef PG8_STAGE
#undef PG8_LDA
#undef PG8_LDB
#undef PG8_MMA
#undef PG8_WAIT_V
#undef PG8_WAIT_L
#undef PG8_BAR
#undef PG8_SCHED
}
}
namespace pg8 {
typedef unsigned u32x2v __attribute__((ext_vector_type(2)));
constexpr int TOK_S = 8192;
constexpr float QK_EPS = 1e-6f;
constexpr float C2 = 0.125f * 1.4426950408889634f;
__device__ __forceinline__ float sigmoid_fast(float v) { return __builtin_amdgcn_rcpf(1.f + __builtin_amdgcn_exp2f(-1.4426950408889634f * v)); }
__device__ __forceinline__ float silu_fast(float v) { return v * __builtin_amdgcn_rcpf(1.f + __builtin_amdgcn_exp2f(-1.4426950408889634f * v)); }

struct EpiInProj {
    static constexpr bool PERM = true, AFTER_DRAIN = false;
    bf16_t* qkv;
    float* gates;
    float* kmean_part;
    const float *qna, *kna, *qnb, *knsel, *knwin;
    __device__ __forceinline__ void operator()(const f32x4 (&acc)[2][2][4][2], const Unit& u, int wr, int wc, int fr, int fq) const {
        const int slot = u.pn * 4 + wc;
        if (slot > 44) return;
        const int b = u.pm >> 5, blk = u.pm & 31, pos0 = blk * 256 + wr * 64 + fr;
        if (slot == 44) {
            if (fq < 3) {
#pragma unroll
                for (int ai = 0; ai < 2; ++ai)
#pragma unroll
                    for (int m = 0; m < 4; ++m) { const size_t tok = (size_t)b * TOK_S + pos0 + ai * HALF + m * 16; float* gp = gates + tok * 24 + 8 * fq;
                        const f32x4 v0 = acc[ai][0][m][0], v1 = acc[ai][0][m][1];
                        *(f32x4*)gp = (f32x4){sigmoid_fast(v0[0]), sigmoid_fast(v0[1]), sigmoid_fast(v0[2]), sigmoid_fast(v0[3])};
                        *(f32x4*)(gp + 4) = (f32x4){sigmoid_fast(v1[0]), sigmoid_fast(v1[1]), sigmoid_fast(v1[2]), sigmoid_fast(v1[3])}; }
            }
            return;
        }
        const float* gain = nullptr; float qscale = 1.f; bool is_ka = false; bf16_t* dst;
        constexpr size_t BIG = (size_t)4 * 8 * TOK_S * 64, SMALL = (size_t)4 * 2 * TOK_S * 64;
        if (slot < 32) { const int kind = slot >> 3, head = slot & 7; dst = qkv + kind * BIG + ((size_t)(b * 8 + head) * TOK_S) * 64;
            if (kind == 0) { gain = qna; qscale = C2; } else if (kind == 1) { gain = kna; is_ka = true; } else if (kind == 3) { gain = qnb; qscale = C2; } }
        else { const int kind = (slot - 32) >> 1, g = slot & 1; dst = qkv + 4 * BIG + kind * SMALL + ((size_t)(b * 2 + g) * TOK_S) * 64;
            if (kind == 2) gain = knsel; else if (kind == 4) gain = knwin; }
        float gv[16];
#pragma unroll
        for (int i = 0; i < 16; ++i) gv[i] = gain ? gain[(i >> 3) * 32 + 8 * fq + (i & 7)] * qscale : 1.f;
        float cs[16];
#pragma unroll
        for (int i = 0; i < 16; ++i) cs[i] = 0.f;
#pragma unroll
        for (int ai = 0; ai < 2; ++ai)
#pragma unroll
            for (int m = 0; m < 4; ++m) {
                float v[16];
#pragma unroll
                for (int bj = 0; bj < 2; ++bj)
#pragma unroll
                    for (int n = 0; n < 2; ++n)
#pragma unroll
                        for (int j = 0; j < 4; ++j) v[bj * 8 + n * 4 + j] = acc[ai][bj][m][n][j];
                if (gain) { float ss = 0.f;
#pragma unroll
                    for (int i = 0; i < 16; ++i) ss += v[i] * v[i];
                    ss += __shfl_xor(ss, 16); ss += __shfl_xor(ss, 32);
                    const float rs = rsqrtf(ss * (1.f / 64.f) + QK_EPS);
#pragma unroll
                    for (int i = 0; i < 16; ++i) v[i] *= rs * gv[i]; }
                if (is_ka) {
#pragma unroll
                    for (int i = 0; i < 16; ++i) cs[i] += v[i]; }
                bf16_t* rp = dst + (size_t)(pos0 + ai * HALF + m * 16) * 64 + 8 * fq;
                u32x4 w0, w1;
                w0.x = cvt_pk_bf16(v[0], v[1]); w0.y = cvt_pk_bf16(v[2], v[3]); w0.z = cvt_pk_bf16(v[4], v[5]); w0.w = cvt_pk_bf16(v[6], v[7]);
                w1.x = cvt_pk_bf16(v[8], v[9]); w1.y = cvt_pk_bf16(v[10], v[11]); w1.z = cvt_pk_bf16(v[12], v[13]); w1.w = cvt_pk_bf16(v[14], v[15]);
                *(u32x4*)rp = w0; *(u32x4*)(rp + 32) = w1;
            }
        if (is_ka) {
#pragma unroll
            for (int i = 0; i < 16; ++i) { float s = cs[i]; s += __shfl_xor(s, 1); s += __shfl_xor(s, 2); s += __shfl_xor(s, 4); s += __shfl_xor(s, 8); cs[i] = s; }
            if (fr == 0) { float* kp = kmean_part + ((size_t)((b * 8 + (slot & 7)) * 32 + blk) * 2 + wr) * 64 + 8 * fq;
                *(f32x4*)kp = (f32x4){cs[0], cs[1], cs[2], cs[3]}; *(f32x4*)(kp + 4) = (f32x4){cs[4], cs[5], cs[6], cs[7]};
                *(f32x4*)(kp + 32) = (f32x4){cs[8], cs[9], cs[10], cs[11]}; *(f32x4*)(kp + 36) = (f32x4){cs[12], cs[13], cs[14], cs[15]}; }
        }
    }
};
struct EpiOutProj {
    static constexpr bool PERM = true, AFTER_DRAIN = false;
    bf16_t* y; const float* gt;
    __device__ __forceinline__ void operator()(const f32x4 (&acc)[2][2][4][2], const Unit& u, int wr, int wc, int fr, int fq) const {
        const int b = u.pm >> 5; const int col0 = u.pn * BM + wc * 32 + 8 * fq; const float* gtb = gt + (size_t)b * 6144;
#pragma unroll
        for (int bj = 0; bj < 2; ++bj) { const int c = col0 + bj * HALF; const f32x4 g40 = *(const f32x4*)(gtb + c), g41 = *(const f32x4*)(gtb + c + 4);
#pragma unroll
            for (int ai = 0; ai < 2; ++ai)
#pragma unroll
                for (int m = 0; m < 4; ++m) { const size_t off = (size_t)(u.pm * BM + ai * HALF + wr * 64 + m * 16 + fr) * 1024 + c;
                    const f32x4 y0 = g40 * acc[ai][bj][m][0], y1 = g41 * acc[ai][bj][m][1];
                    u32x4 w; w.x = cvt_pk_bf16(y0[0], y0[1]); w.y = cvt_pk_bf16(y0[2], y0[3]); w.z = cvt_pk_bf16(y1[0], y1[1]); w.w = cvt_pk_bf16(y1[2], y1[3]);
                    *(u32x4*)(y + off) = w; } }
    }
};
struct EpiGateUp {
    static constexpr bool PERM = true, AFTER_DRAIN = false;
    bf16_t* act;
    __device__ __forceinline__ void operator()(const f32x4 (&acc)[2][2][4][2], const Unit& u, int wr, int wc, int fr, int fq) const {
        const int h0 = u.pn * 128 + wc * 32 + 8 * fq;
#pragma unroll
        for (int ai = 0; ai < 2; ++ai)
#pragma unroll
            for (int m = 0; m < 4; ++m) { const size_t row = (size_t)(u.pm * BM + ai * HALF + wr * 64 + m * 16 + fr);
                const f32x4 g0 = acc[ai][0][m][0], g1 = acc[ai][0][m][1], u0 = acc[ai][1][m][0], u1 = acc[ai][1][m][1];
                u32x4 w;
                w.x = cvt_pk_bf16(silu_fast(g0[0]) * u0[0], silu_fast(g0[1]) * u0[1]); w.y = cvt_pk_bf16(silu_fast(g0[2]) * u0[2], silu_fast(g0[3]) * u0[3]);
                w.z = cvt_pk_bf16(silu_fast(g1[0]) * u1[0], silu_fast(g1[1]) * u1[1]); w.w = cvt_pk_bf16(silu_fast(g1[2]) * u1[2], silu_fast(g1[3]) * u1[3]);
                *(u32x4*)(act + row * 2816 + h0) = w; }
    }
};
struct EpiDown {
    static constexpr bool PERM = true, AFTER_DRAIN = false;
    const float* x; const bf16_t* y; float* out; const float* gt;
    __device__ __forceinline__ void operator()(const f32x4 (&acc)[2][2][4][2], const Unit& u, int wr, int wc, int fr, int fq) const {
        const int b = u.pm >> 5; const int col0 = u.pn * BM + wc * 32 + 8 * fq; const float* gtb = gt + (size_t)b * 6144;
#pragma unroll
        for (int bj = 0; bj < 2; ++bj) { const int c = col0 + bj * HALF; const f32x4 g40 = *(const f32x4*)(gtb + c), g41 = *(const f32x4*)(gtb + c + 4);
#pragma unroll
            for (int ai = 0; ai < 2; ++ai)
#pragma unroll
                for (int m = 0; m < 4; ++m) { const size_t off = (size_t)(u.pm * BM + ai * HALF + wr * 64 + m * 16 + fr) * 1024 + c;
                    const f32x4 x0 = *(const f32x4*)(x + off), x1 = *(const f32x4*)(x + off + 4); const u32x4 yw = *(const u32x4*)(y + off);
                    const f32x4 y0 = {__builtin_bit_cast(float, yw.x << 16), __builtin_bit_cast(float, yw.x & 0xffff0000u), __builtin_bit_cast(float, yw.y << 16), __builtin_bit_cast(float, yw.y & 0xffff0000u)};
                    const f32x4 y1 = {__builtin_bit_cast(float, yw.z << 16), __builtin_bit_cast(float, yw.z & 0xffff0000u), __builtin_bit_cast(float, yw.w << 16), __builtin_bit_cast(float, yw.w & 0xffff0000u)};
                    *(f32x4*)(out + off) = (x0 + y0) + g40 * acc[ai][bj][m][0]; *(f32x4*)(out + off + 4) = (x1 + y1) + g41 * acc[ai][bj][m][1]; } }
    }
};
}
constexpr int NWAVES = 8, NTHREADS = 512;
constexpr int BATCH = 4, SEQ = 8192, DM = 1024, TOK = BATCH * SEQ, NIN = 2840, NIN_PAD = 3072, FF = 2816, NCMP = 511;
constexpr size_t MiB = 1u << 20;
constexpr size_t WS_CTL = 0, CTL_ZERO_BYTES = 64 * 1024;
constexpr size_t WS_MODP = 1 * MiB;
constexpr size_t WS_MOD = 2 * MiB;
constexpr size_t WS_CBP = 2 * MiB + 512 * 1024;
constexpr size_t WS_KMP = 3 * MiB;
constexpr size_t WS_BIAS2 = 4 * MiB;
constexpr size_t WS_SSP = 449 * MiB;
constexpr size_t WS_WIN = 6 * MiB, WS_WOUT = 12 * MiB, WS_WGU = 14 * MiB, WS_WDN = 25 * MiB;
constexpr size_t WS_W1K = 31 * MiB, WS_W1V = 32 * MiB, WS_W2K = 33 * MiB, WS_W2V = 33 * MiB + 64 * 1024;
constexpr size_t WS_KCMP = 34 * MiB, WS_VCMP = 35 * MiB;
constexpr size_t WS_GATES = 36 * MiB;
constexpr size_t WS_H = 40 * MiB;
constexpr size_t WS_MIX = 104 * MiB;
constexpr size_t WS_QKV = 168 * MiB;
constexpr size_t WS_ACT = WS_QKV;
constexpr size_t WS_END = 344 * MiB;
constexpr size_t WS_PARTO = 344 * MiB;
constexpr size_t WS_PARTL = 472 * MiB;
constexpr size_t WS_SELG = 476 * MiB;
constexpr size_t WS_Y = WS_PARTO;
constexpr size_t QKV_BIG = (size_t)4 * 8 * SEQ * 64, QKV_SMALL = (size_t)4 * 2 * SEQ * 64;
constexpr int RING_BYTES = 131072, LDS_BYTES = 147456;
constexpr int N_PHASES = 10;

#define GAS __attribute__((address_space(1)))
#define LAS __attribute__((address_space(3)))
typedef unsigned short bf16;
typedef unsigned v4u __attribute__((ext_vector_type(4)));
typedef float f32x4 __attribute__((ext_vector_type(4)));
#define LDS_WAIT() asm volatile("s_waitcnt lgkmcnt(0)" ::: "memory")
#define VM_WAIT() asm volatile("s_waitcnt vmcnt(0)" ::: "memory")
__device__ __forceinline__ unsigned f2bf(float f) { unsigned u = __builtin_bit_cast(unsigned, f); return (u + 0x7fffu + ((u >> 16) & 1u)) >> 16; }
__device__ __forceinline__ unsigned pk2(float lo, float hi) { return f2bf(lo) | (f2bf(hi) << 16); }
__device__ __forceinline__ float bf2f(bf16 v) { return __builtin_bit_cast(float, (unsigned)v << 16); }
__device__ __forceinline__ float wave_sum(float v) {
#pragma unroll
    for (int o = 1; o < 64; o <<= 1) v += __shfl_xor(v, o);
    return v;
}
struct Args { const float* in[23]; float* out; unsigned char* ws; int ph_lo, ph_hi; };
struct Frame { LAS unsigned char* lds; int tid, lane, wave, vcu, G; };

struct MapId { __device__ __forceinline__ size_t off(int n, int k, int K) const { return (size_t)n * K + k; } };
struct MapWin { __device__ __forceinline__ size_t off(int n, int k, int K) const { const int s = n >> 6, d = n & 63; return (size_t)(256 * (s >> 2) + 128 * (d >> 5) + 32 * (s & 3) + (d & 31)) * K + k; } };
struct MapWgu { __device__ __forceinline__ size_t off(int n, int k, int K) const { const int up = n >= FF, hdn = up ? n - FF : n; return (size_t)(256 * (hdn >> 7) + 128 * up + (hdn & 127)) * K + k; } };
struct MapFrag { __device__ __forceinline__ size_t off(int n, int k, int K) const { return ((size_t)((k >> 4) * 8 + (n >> 5)) * 64 + ((k >> 3) & 1) * 32 + (n & 31)) * 8 + (k & 7); } };
__device__ __forceinline__ void transpose_load(const float* __restrict__ W, int N, int item, int lane, f32x4 (&v)[16]) {
    const int nblk = (N + 63) / 64, kb = item / nblk, nb = item % nblk, k0 = 64 * kb, n0 = 64 * nb;
    const int nc = n0 + 4 * (lane & 15); const bool nin = nc < N;
#pragma unroll
    for (int i = 0; i < 16; ++i) { const int kk = 4 * i + (lane >> 4); v[i] = nin ? *(const GAS f32x4*)(W + (size_t)(k0 + kk) * N + nc) : (f32x4){0.f, 0.f, 0.f, 0.f}; }
}
template <class Map>
__device__ __forceinline__ void transpose_store(const f32x4 (&v)[16], int K, int N, bf16* WT, LAS float* scr, int item, int lane, const Map& map) {
    const int nblk = (N + 63) / 64, kb = item / nblk, nb = item % nblk, k0 = 64 * kb, n0 = 64 * nb;
#pragma unroll
    for (int i = 0; i < 16; ++i) { const int kk = 4 * i + (lane >> 4); LAS float* d = scr + (4 * (lane & 15)) * 68 + kk; d[0] = v[i][0]; d[68] = v[i][1]; d[136] = v[i][2]; d[204] = v[i][3]; }
    LDS_WAIT(); asm volatile("" ::: "memory");
    const int c = lane & 7;
#pragma unroll
    for (int j = 0; j < 8; ++j) { const int n = (lane >> 3) + 8 * j; const LAS float* s = scr + n * 68 + 8 * c;
        const f32x4 a = *(const LAS f32x4*)s, bq = *(const LAS f32x4*)(s + 4);
        v4u o; o.x = pk2(a[0], a[1]); o.y = pk2(a[2], a[3]); o.z = pk2(bq[0], bq[1]); o.w = pk2(bq[2], bq[3]);
        if (n0 + n < N) *(GAS v4u*)(WT + map.off(n0 + n, k0 + 8 * c, K)) = o; }
    LDS_WAIT(); asm volatile("" ::: "memory");
}
__device__ __forceinline__ float silu_acc(float v) { return v / (1.f + expf(-v)); }
__device__ __forceinline__ void phase_prologue_a(Frame& F, const Args& a) {
    LAS float* scr = (LAS float*)(F.lds + F.wave * 17408);
    const int gw = F.vcu * NWAVES + F.wave, NGW = F.G * NWAVES;
    unsigned char* ws = a.ws;
    constexpr int I_IN = (DM / 64) * ((NIN + 63) / 64), I_OUT = (DM / 64) * (DM / 64), I_GU = (DM / 64) * (2 * FF / 64), I_DN = (FF / 64) * (DM / 64), I_W1 = (2048 / 64) * (256 / 64), I_W2 = (256 / 64) * (64 / 64);
    constexpr int NITEMS = I_IN + I_OUT + I_GU + I_DN + 2 * I_W1 + 2 * I_W2;
    auto which = [&](int it, int& r) -> int { r = it;
        if (r < I_IN) return 0; r -= I_IN; if (r < I_OUT) return 1; r -= I_OUT; if (r < I_GU) return 2; r -= I_GU; if (r < I_DN) return 3; r -= I_DN;
        if (r < I_W1) return 4; r -= I_W1; if (r < I_W1) return 5; r -= I_W1; if (r < I_W2) return 6; r -= I_W2; return 7; };
    auto load = [&](int it, f32x4 (&v)[16]) { int r; const int m = which(it, r);
        const float* W = m == 0 ? a.in[6] : m == 1 ? a.in[19] : m == 2 ? a.in[21] : m == 3 ? a.in[22] : m == 4 ? a.in[14] : m == 5 ? a.in[17] : m == 6 ? a.in[15] : a.in[18];
        const int N = m == 0 ? NIN : m == 1 ? DM : m == 2 ? 2 * FF : m == 3 ? DM : m < 6 ? 256 : 64;
        transpose_load(W, N, r, F.lane, v); };
    auto store = [&](int it, const f32x4 (&v)[16]) { int r; const int m = which(it, r);
        if (m == 0) transpose_store(v, DM, NIN, (bf16*)(ws + WS_WIN), scr, r, F.lane, MapWin());
        else if (m == 1) transpose_store(v, DM, DM, (bf16*)(ws + WS_WOUT), scr, r, F.lane, MapId());
        else if (m == 2) transpose_store(v, DM, 2 * FF, (bf16*)(ws + WS_WGU), scr, r, F.lane, MapWgu());
        else if (m == 3) transpose_store(v, FF, DM, (bf16*)(ws + WS_WDN), scr, r, F.lane, MapId());
        else if (m == 4) transpose_store(v, 2048, 256, (bf16*)(ws + WS_W1K), scr, r, F.lane, MapFrag());
        else if (m == 5) transpose_store(v, 2048, 256, (bf16*)(ws + WS_W1V), scr, r, F.lane, MapFrag());
        else if (m == 6) transpose_store(v, 256, 64, (bf16*)(ws + WS_W2K), scr, r, F.lane, MapId());
        else transpose_store(v, 256, 64, (bf16*)(ws + WS_W2V), scr, r, F.lane, MapId()); };
    { f32x4 va[16], vb[16];
      if (gw < NITEMS) load(gw, va);
      for (int it = gw; it < NITEMS; it += 2 * NGW) {
          if (it + NGW < NITEMS) load(it + NGW, vb);
          store(it, va);
          if (it + 2 * NGW < NITEMS) load(it + 2 * NGW, va);
          if (it + NGW < NITEMS) store(it + NGW, vb); } }
    const float* c = a.in[1]; const float* w_ada = a.in[3]; float* modp = (float*)(ws + WS_MODP);
    for (int t = NGW - 1 - gw; t < 96 * 8; t += NGW) { const int cg_ = t % 96, ks = t / 96; const int n = cg_ * 64 + F.lane;
        float acc0 = 0.f, acc1 = 0.f, acc2 = 0.f, acc3 = 0.f;
#pragma unroll
        for (int i = 0; i < 8; ++i) { const int idx = F.lane + 64 * i, bb = idx >> 7, kk = idx & 127; scr[kk * 4 + bb] = silu_acc(c[bb * DM + ks * 128 + kk]); }
        LDS_WAIT(); asm volatile("" ::: "memory");
#pragma unroll 32
        for (int k = 0; k < 128; ++k) { const float w = w_ada[(size_t)(ks * 128 + k) * 6144 + n]; const f32x4 sv = *(const LAS f32x4*)(scr + 4 * k);
            acc0 += sv[0] * w; acc1 += sv[1] * w; acc2 += sv[2] * w; acc3 += sv[3] * w; }
        LDS_WAIT(); asm volatile("" ::: "memory");
        float* o = modp + (size_t)ks * 4 * 6144 + n; o[0] = acc0; o[6144] = acc1; o[2 * 6144] = acc2; o[3 * 6144] = acc3; }
    float* cbp = (float*)(ws + WS_CBP);
    for (int t = NGW / 2 - 1 - gw; t >= 0 && t < 256; t += NGW) { const int kv = t & 1, cg_ = (t >> 1) & 3, ic = t >> 3; const int n = cg_ * 64 + F.lane;
        const float* pe = kv ? a.in[16] : a.in[13]; const float* w1 = kv ? a.in[17] : a.in[14]; float acc = 0.f;
#pragma unroll 32
        for (int i = ic * 64; i < ic * 64 + 64; ++i) acc += pe[i] * w1[(size_t)i * 256 + n];
        cbp[(ic * 2 + kv) * 256 + n] = acc; }
}
template <bool ADDY>
__device__ __forceinline__ void norm_load4(Frame& F, int row0, const float* in, const bf16* yin, f32x4 (&v)[4][4], unsigned long long (&yw)[4][4]) {
#pragma unroll
    for (int r = 0; r < 4; ++r) { const int row = row0 + r; const GAS f32x4* xr = (const GAS f32x4*)(in + (size_t)row * DM) + F.lane;
#pragma unroll
        for (int j = 0; j < 4; ++j) v[r][j] = xr[64 * j];
        if (ADDY) { const GAS unsigned long long* yr = (const GAS unsigned long long*)(yin + (size_t)row * DM) + F.lane;
#pragma unroll
            for (int j = 0; j < 4; ++j) yw[r][j] = yr[64 * j]; } }
}
template <bool ADDY>
__device__ __forceinline__ void norm_rows(Frame& F, int blk, const float* in, const bf16* yin, const f32x4 (&gs)[4], const f32x4 (&sh)[4], bf16* out) {
    const int rowb = blk * 128 + F.wave * 16;
    f32x4 vn[4][4]; unsigned long long yn[4][4];
    norm_load4<ADDY>(F, rowb, in, yin, vn, yn);
    for (int i0 = 0; i0 < 16; i0 += 4) {
        f32x4 v[4][4]; float ss[4];
#pragma unroll
        for (int r = 0; r < 4; ++r)
#pragma unroll
            for (int j = 0; j < 4; ++j) { v[r][j] = vn[r][j];
                if (ADDY) { const unsigned lo = (unsigned)yn[r][j], hi = (unsigned)(yn[r][j] >> 32);
                    v[r][j] += (f32x4){__builtin_bit_cast(float, lo << 16), __builtin_bit_cast(float, lo & 0xffff0000u), __builtin_bit_cast(float, hi << 16), __builtin_bit_cast(float, hi & 0xffff0000u)}; } }
        if (i0 + 4 < 16) norm_load4<ADDY>(F, rowb + i0 + 4, in, yin, vn, yn);
#pragma unroll
        for (int r = 0; r < 4; ++r) { float s = 0.f;
#pragma unroll
            for (int j = 0; j < 4; ++j) s += (v[r][j].x * v[r][j].x + v[r][j].y * v[r][j].y) + (v[r][j].z * v[r][j].z + v[r][j].w * v[r][j].w);
            ss[r] = s; }
#pragma unroll
        for (int o_ = 1; o_ < 64; o_ <<= 1) {
#pragma unroll
            for (int r = 0; r < 4; ++r) ss[r] += __shfl_xor(ss[r], o_); }
#pragma unroll
        for (int r = 0; r < 4; ++r) { const int row = rowb + i0 + r; const float rs = rsqrtf(ss[r] * (1.f / DM) + 1e-6f);
            GAS unsigned long long* o8 = (GAS unsigned long long*)(out + (size_t)row * DM) + F.lane;
#pragma unroll
            for (int j = 0; j < 4; ++j) { const f32x4 y = v[r][j] * rs * gs[j] + sh[j]; o8[64 * j] = (unsigned long long)pk2(y.x, y.y) | ((unsigned long long)pk2(y.z, y.w) << 32); } }
    }
}
__device__ __forceinline__ void phase_prologue_b(Frame& F, const Args& a) {
    unsigned char* ws = a.ws; const float* modp = (const float*)(ws + WS_MODP); const float* b_ada = a.in[4];
    if (F.wave == 0) for (int cgp = F.vcu; cgp < 96; cgp += F.G) { const int n = cgp * 64 + F.lane; float* mod = (float*)(ws + WS_MOD);
        for (int b = 0; b < 4; ++b) { float s = 0.f;
#pragma unroll
            for (int ks = 0; ks < 8; ++ks) s += modp[((size_t)ks * 4 + b) * 6144 + n];
            mod[b * 6144 + n] = s + b_ada[n]; } }
    const float* g = a.in[5];
    for (int blk = F.vcu; blk < TOK / 128; blk += F.G) { const int b = blk >> 6;
    f32x4 gs[4], sh[4];
#pragma unroll
    for (int j = 0; j < 4; ++j) { const int c0 = 4 * F.lane + 256 * j; f32x4 s0 = {0.f, 0.f, 0.f, 0.f}, s1 = {0.f, 0.f, 0.f, 0.f};
#pragma unroll
        for (int ks = 0; ks < 8; ++ks) { s0 += *(const f32x4*)(modp + ((size_t)ks * 4 + b) * 6144 + c0); s1 += *(const f32x4*)(modp + ((size_t)ks * 4 + b) * 6144 + DM + c0); }
        s0 += *(const f32x4*)(b_ada + c0); s1 += *(const f32x4*)(b_ada + DM + c0);
        sh[j] = s0; gs[j] = *(const f32x4*)(g + c0) * (s1 + 1.0f); }
    norm_rows<false>(F, blk, a.in[0], nullptr, gs, sh, (bf16*)(ws + WS_H)); }
}
__device__ __forceinline__ void phase_norm2(Frame& F, const Args& a) {
    unsigned char* ws = a.ws; const float* g = a.in[20];
    for (int blk = F.vcu; blk < TOK / 128; blk += F.G) { const int b = blk >> 6; const float* mod = (const float*)(ws + WS_MOD) + (size_t)b * 6144;
        f32x4 gs[4], sh[4];
#pragma unroll
        for (int j = 0; j < 4; ++j) { const int c0 = 4 * F.lane + 256 * j; sh[j] = *(const f32x4*)(mod + 3 * DM + c0); gs[j] = *(const f32x4*)(g + c0) * (*(const f32x4*)(mod + 4 * DM + c0) + 1.0f); }
        norm_rows<true>(F, blk, a.in[0], (const bf16*)(ws + WS_Y), gs, sh, (bf16*)(ws + WS_H)); }
}

__device__ __forceinline__ void phase_bias2(Frame& F, const Args& a) {
    unsigned char* ws = a.ws; const float* mod = (const float*)(ws + WS_MOD); const bf16* wt = (const bf16*)(ws + WS_WGU); float* bias2 = (float*)(ws + WS_BIAS2);
    const int gw = F.vcu * NWAVES + F.wave, NGW = F.G * NWAVES;
    f32x4 sh[4][4];
#pragma unroll
    for (int bb = 0; bb < 4; ++bb)
#pragma unroll
        for (int j = 0; j < 4; ++j) sh[bb][j] = *(const f32x4*)(mod + (size_t)bb * 6144 + 3 * DM + 16 * F.lane + 4 * j);
    for (int c = gw; c < 2 * FF; c += NGW) {
        const v4u w0 = *(const GAS v4u*)(wt + (size_t)c * DM + 16 * F.lane), w1 = *(const GAS v4u*)(wt + (size_t)c * DM + 16 * F.lane + 8);
        const unsigned wu[8] = {w0.x, w0.y, w0.z, w0.w, w1.x, w1.y, w1.z, w1.w};
        float s[4] = {0.f, 0.f, 0.f, 0.f};
#pragma unroll
        for (int j = 0; j < 4; ++j) { const float e0 = __builtin_bit_cast(float, wu[2 * j] << 16), e1 = __builtin_bit_cast(float, wu[2 * j] & 0xffff0000u), e2 = __builtin_bit_cast(float, wu[2 * j + 1] << 16), e3 = __builtin_bit_cast(float, wu[2 * j + 1] & 0xffff0000u);
#pragma unroll
            for (int bb = 0; bb < 4; ++bb) s[bb] += (sh[bb][j][0] * e0 + sh[bb][j][1] * e1) + (sh[bb][j][2] * e2 + sh[bb][j][3] * e3); }
#pragma unroll
        for (int bb = 0; bb < 4; ++bb) { const float t = wave_sum(s[bb]); if (F.lane == 0) bias2[(size_t)bb * 2 * FF + c] = t; }
    }
}
#define XB_TMO      128
#define XB_XCNT(j)  (256  + 64 * (j))
#define XB_XSUB(j)  (1280 + 64 * (j))
#define XB_XGEN(j)  (2304 + 64 * (j))
#define XB_TOP      3328
#define XB_TOPGEN   3392
#define XCD_BAR_WORDS 3456
#define XB_SPIN_CAP (1u << 18)

__device__ __forceinline__ unsigned xb_ld(unsigned* p)              { return __hip_atomic_load(p, __ATOMIC_RELAXED, __HIP_MEMORY_SCOPE_AGENT); }
__device__ __forceinline__ unsigned xb_add(unsigned* p, unsigned v) { return __hip_atomic_fetch_add(p, v, __ATOMIC_RELAXED, __HIP_MEMORY_SCOPE_AGENT); }
__device__ __forceinline__ unsigned xb_xcc_id() { return (unsigned)__builtin_amdgcn_s_getreg((3 << 11) | 20) & 0xFu; }
#define XB_SPIN(cond, bar) do { unsigned _sp = 0; while (cond) { __builtin_amdgcn_s_sleep(1); \
    if ((++_sp & 255u) == 0u) { if (xb_ld(&(bar)[XB_TMO])) break; if (_sp > XB_SPIN_CAP) { atomicAdd(&(bar)[XB_TMO], 1u); break; } } } } while (0)

struct XcdBarrier {
    unsigned* bar; unsigned x;
    volatile LAS unsigned* st;
};

__device__ __forceinline__ XcdBarrier xcd_barrier_post(unsigned* bar, volatile LAS unsigned* st) {
    XcdBarrier b; b.bar = bar; b.x = xb_xcc_id(); b.st = st;
    if (threadIdx.x == 0) (void)xb_add(&bar[XB_XCNT(b.x)], 1u);
    return b;
}
__device__ __forceinline__ void xcd_barrier_complete(unsigned* bar, unsigned x, unsigned& nloc, unsigned& nx) {
    const unsigned G = gridDim.x * gridDim.y * gridDim.z;
    unsigned sum, cnt, mine, sp = 0u;
    for (;;) {
        sum = 0u; cnt = 0u; mine = 0u;
#pragma unroll
        for (unsigned j = 0; j < 16; ++j) { const unsigned c = xb_ld(&bar[XB_XCNT(j)]); sum += c; cnt += (c > 0u) ? 1u : 0u; mine = (j == x) ? c : mine; }
        if (sum == G) break;
        __builtin_amdgcn_s_sleep(1);
        if ((++sp & 255u) == 0u) { if (xb_ld(&bar[XB_TMO])) break; if (sp > XB_SPIN_CAP) { atomicAdd(&bar[XB_TMO], 1u); break; } }
    }
    nloc = mine > 0u ? mine : 1u; nx = cnt > 0u ? cnt : 1u;
}

__device__ __forceinline__ void xcd_barrier(const XcdBarrier& b) {
    asm volatile("s_waitcnt vmcnt(0)" ::: "memory");
    __syncthreads();
    if (threadIdx.x == 0) {
        unsigned* bar = b.bar;
        __builtin_amdgcn_s_waitcnt(0);
        unsigned nloc = b.st[0], nx = b.st[1];
        if (nloc == 0u) { xcd_barrier_complete(bar, b.x, nloc, nx); b.st[0] = nloc; b.st[1] = nx; }
        const unsigned old = xb_add(&bar[XB_XSUB(b.x)], 1u);
        const unsigned gen = old / nloc;
        if (old + 1u == (gen + 1u) * nloc) {
            __builtin_amdgcn_fence(__ATOMIC_RELEASE, "agent");
            asm volatile("s_waitcnt vmcnt(0)" ::: "memory");
            const unsigned og = xb_add(&bar[XB_TOP], 1u);
            const unsigned tg = og / nx;
            if (og + 1u == (tg + 1u) * nx) xb_add(&bar[XB_TOPGEN], 1u);
            else XB_SPIN(xb_ld(&bar[XB_TOPGEN]) == tg, bar);
            __builtin_amdgcn_fence(__ATOMIC_ACQUIRE, "agent");
            xb_add(&bar[XB_XGEN(b.x)], 1u);
            asm volatile("s_waitcnt vmcnt(0)" ::: "memory");
        } else {
            XB_SPIN(xb_ld(&bar[XB_XGEN(b.x)]) == gen, bar);
            __builtin_amdgcn_fence(__ATOMIC_ACQUIRE, "agent");
            asm volatile("s_waitcnt vmcnt(0)" ::: "memory");
        }
    }
    __syncthreads();
}
#define ATT_NS att
#ifndef ATT_ABL
#define ATT_ABL 0
#endif
#ifndef ATT_STAGGER
#define ATT_STAGGER 0
#endif
#ifndef ATT_SLEEP
#define ATT_SLEEP 24
#endif
namespace ATT_NS {
using bf16x8 = __attribute__((ext_vector_type(8))) short;
using s16x4 = __attribute__((ext_vector_type(4))) short;
using f32x16 = __attribute__((ext_vector_type(16))) float;
using u32x4 = __attribute__((ext_vector_type(4))) unsigned;
typedef LAS const char* lds_cptr;
typedef short v4i16_t __attribute__((ext_vector_type(4)));
constexpr int SLOT = 16384, NSLOT = 4, LDS_OST = 65536, LDS_IMP = 100608, LDS_SELM = 135680, LDS_MISC = 136704, LDS_WSF = 136960, LDS_LUTG = 139008  , LDS_ATT_END = 147200;
constexpr int LUT_PITCH = 116;
constexpr int IMP_PITCH = 136, IMP_PLANE = 64 * IMP_PITCH + 4, IMP_REG1 = 64;
constexpr float LOG2E = 1.4426950408889634f;
#define MFMA32(a, b, c) __builtin_amdgcn_mfma_f32_32x32x16_bf16(a, b, c, 0, 0, 0)
#define ATT_WAIT_BAR(N) asm volatile("s_waitcnt vmcnt(" #N ") lgkmcnt(0)\n\ts_barrier" ::: "memory")
__device__ __forceinline__ void glds16(const void* gsrc, unsigned lds_dst) { unsigned keep;
    asm volatile("s_mov_b32 %0, m0\n\ts_mov_b32 m0, %2\n\ts_nop 0\n\tglobal_load_lds_dwordx4 %1, off\n\ts_mov_b32 m0, %0" : "=&s"(keep) : "v"(gsrc), "s"(lds_dst) : "memory"); }
typedef float f32x2_t __attribute__((ext_vector_type(2))); typedef __bf16 bf16x2_t __attribute__((ext_vector_type(2)));
__device__ __forceinline__ unsigned cvtpk(float lo, float hi) { f32x2_t v = {lo, hi}; bf16x2_t b = __builtin_convertvector(v, bf16x2_t); return __builtin_bit_cast(unsigned, b); }
__device__ __forceinline__ s16x4 vtr(lds_cptr p) { return __builtin_bit_cast(s16x4, __builtin_amdgcn_ds_read_tr16_b64_v4i16((LAS v4i16_t*)p)); }
__device__ __forceinline__ int t5_bucket(int d) {
    if (d < 16) return d;
    int b = 16;
    b += (d >= 19); b += (d >= 21); b += (d >= 24); b += (d >= 27); b += (d >= 31); b += (d >= 35); b += (d >= 40); b += (d >= 46);
    b += (d >= 52); b += (d >= 59); b += (d >= 67); b += (d >= 77); b += (d >= 87); b += (d >= 99); b += (d >= 113);
    return b;
}
struct Ctx { LAS char* lds; int wid; int lane, r32, hi; };
__device__ __forceinline__ int fresh_lane() { int l; asm volatile("v_mbcnt_lo_u32_b32 %0, -1, 0\n\tv_mbcnt_hi_u32_b32 %0, -1, %0" : "=v"(l)); return l; }
__device__ __forceinline__ Ctx make_ctx(LAS unsigned char* lds, int tid) {
    Ctx c; c.lds = (LAS char*)lds; c.wid = __builtin_amdgcn_readfirstlane(tid >> 6); c.lane = tid & 63; c.r32 = c.lane & 31; c.hi = c.lane >> 5; return c;
}
template <bool HASV, class QK, class SM>
__device__ __forceinline__ void run_stream(const Ctx& c, const bf16* Kb, const bf16* Vb, int t0, int t1, QK&& qk, SM&& sm) {
    const int n = t1 - t0; if (n <= 0) return;
    const int lane = fresh_lane(), r32 = lane & 31, hi = lane >> 5; const unsigned lds0 = (unsigned)(uintptr_t)c.lds;
    const bf16* ks = Kb + ((8 * c.wid + (lane >> 3)) * 64 + (((lane & 7) ^ (((8 * c.wid + (lane >> 3)) >> 1) & 7)) << 3)); const bf16* vs = Vb + ((16 * (c.wid & 3) + (lane >> 2)) * 64 + (c.wid >> 2) * 32 + (lane & 3) * 8);
    const unsigned kdst = lds0 + c.wid * 1024, vdst = lds0 + 8192 + c.wid * 1024;
    const lds_cptr kp0 = (lds_cptr)c.lds + r32 * 128;
    const lds_cptr vp0 = (lds_cptr)c.lds + 8192 + ((lane >> 4) & 1) * 32 + (lane & 3) * 8 + (4 * hi + ((lane & 15) >> 2)) * 64;
#define ATT_ISSUE(t, so) do { if (ATT_ABL & 4) break; glds16(ks + (size_t)(t) * 4096, (unsigned)__builtin_amdgcn_readfirstlane(kdst + (so))); if (HASV) glds16(vs + (size_t)(t) * 4096, (unsigned)__builtin_amdgcn_readfirstlane(vdst + (so))); } while (0)
    ATT_ISSUE(t0, 0); if (n > 1) ATT_ISSUE(t0 + 1, SLOT);
    const bool late = ATT_STAGGER && __builtin_amdgcn_readfirstlane(c.wid) >= 4;
    f32x16 s0 = {}, s1 = {};
    int slot = 0, slotp = 3 * SLOT, slot2 = 2 * SLOT;
    if (!late) {
        for (int i = 0; i < n; ++i) {
            if (i + 1 < n) { if (HASV) ATT_WAIT_BAR(2); else ATT_WAIT_BAR(1); } else ATT_WAIT_BAR(0);
            if (i + 2 < n) ATT_ISSUE(t0 + i + 2, slot2);
            if (!(ATT_ABL & 1)) qk(t0 + i, kp0 + slot, s0, s1); if (!(ATT_ABL & 2)) sm(t0 + i, vp0 + slot, s0, s1);
            slot = (slot == 3 * SLOT) ? 0 : slot + SLOT; slot2 = (slot2 == 3 * SLOT) ? 0 : slot2 + SLOT;
        }
    } else {
        for (int i = 0; i < n; ++i) {
            if (i + 1 < n) { if (HASV) ATT_WAIT_BAR(2); else ATT_WAIT_BAR(1); } else ATT_WAIT_BAR(0);
            if (i + 2 < n) ATT_ISSUE(t0 + i + 2, slot2);
            if (i > 0 && !(ATT_ABL & 2)) sm(t0 + i - 1, vp0 + slotp, s0, s1);
            if (!(ATT_ABL & 1)) qk(t0 + i, kp0 + slot, s0, s1);
            slotp = slot; slot = (slot == 3 * SLOT) ? 0 : slot + SLOT; slot2 = (slot2 == 3 * SLOT) ? 0 : slot2 + SLOT;
        }
        if (!(ATT_ABL & 2)) sm(t0 + n - 1, vp0 + slotp, s0, s1);
    }
    asm volatile("s_waitcnt lgkmcnt(0)\n\ts_barrier" ::: "memory");
#undef ATT_ISSUE
}
template <class FN1, class FN2>
__device__ __forceinline__ void run_stream_pairs(const Ctx& c, const bf16* Kb, const bf16* Vb, int t0, int t1, FN1&& fn1, FN2&& fn2) {
    const int n = t1 - t0; if (n <= 0) return;
    const int lane = fresh_lane(), r32 = lane & 31, hi = lane >> 5; const unsigned lds0 = (unsigned)(uintptr_t)c.lds;
    const bf16* ks = Kb + ((8 * c.wid + (lane >> 3)) * 64 + (((lane & 7) ^ (((8 * c.wid + (lane >> 3)) >> 1) & 7)) << 3)); const bf16* vs = Vb + ((16 * (c.wid & 3) + (lane >> 2)) * 64 + (c.wid >> 2) * 32 + (lane & 3) * 8);
    const unsigned kdst = lds0 + c.wid * 1024, vdst = lds0 + 8192 + c.wid * 1024;
    const lds_cptr kp0 = (lds_cptr)c.lds + r32 * 128;
    const lds_cptr vp0 = (lds_cptr)c.lds + 8192 + ((lane >> 4) & 1) * 32 + (lane & 3) * 8 + (4 * hi + ((lane & 15) >> 2)) * 64;
#define ATT_ISSUE1(t, so) do { glds16(ks + (size_t)(t) * 4096, (unsigned)__builtin_amdgcn_readfirstlane(kdst + (so))); glds16(vs + (size_t)(t) * 4096, (unsigned)__builtin_amdgcn_readfirstlane(vdst + (so))); } while (0)
    ATT_ISSUE1(t0, 0); if (n > 1) ATT_ISSUE1(t0 + 1, SLOT);
    int base = 0;
    for (int i = 0; i < n; i += 2) {
        ATT_WAIT_BAR(0);
        const int nb = 2 * SLOT - base;
        if (i + 2 < n) ATT_ISSUE1(t0 + i + 2, nb); if (i + 3 < n) ATT_ISSUE1(t0 + i + 3, nb + SLOT);
        if (i + 1 < n) fn2(t0 + i, kp0 + base, vp0 + base, kp0 + base + SLOT, vp0 + base + SLOT); else fn1(t0 + i, kp0 + base, vp0 + base);
        base = nb;
    }
    asm volatile("s_waitcnt lgkmcnt(0)\n\ts_barrier" ::: "memory");
#undef ATT_ISSUE1
}
__device__ __forceinline__ void qk_tile(f32x16& s0, f32x16& s1, lds_cptr kp, const bf16x8 (&qr)[4]) {
    bf16x8 kf[8];
    { const int l = fresh_lane(), f = ((l & 31) >> 1) & 7, hi = l >> 5;
#pragma unroll
      for (int d0 = 0; d0 < 4; ++d0) { const int off = ((2 * d0 + hi) ^ f) << 4; kf[2 * d0] = *(const LAS bf16x8*)(kp + off); kf[2 * d0 + 1] = *(const LAS bf16x8*)(kp + 4096 + off); } }
    const f32x16 z = {};
    s0 = MFMA32(kf[0], qr[0], z); s1 = MFMA32(kf[1], qr[0], z);
#pragma unroll
    for (int d0 = 1; d0 < 4; ++d0) { s0 = MFMA32(kf[2 * d0], qr[d0], s0); s1 = MFMA32(kf[2 * d0 + 1], qr[d0], s1); }
}
template <bool MASK>
__device__ __forceinline__ void pv_tile(f32x16 (&o)[2], lds_cptr vp, const f32x16& p0, const f32x16& p1, unsigned mask) {
    if (ATT_ABL & 8) { o[0][0] += p0[0] + p1[5]; return; }
    u32x4 pw0 = {cvtpk(p0[0], p0[1]), cvtpk(p0[2], p0[3]), cvtpk(p0[4], p0[5]), cvtpk(p0[6], p0[7])}, pw1 = {cvtpk(p0[8], p0[9]), cvtpk(p0[10], p0[11]), cvtpk(p0[12], p0[13]), cvtpk(p0[14], p0[15])};
    u32x4 pw2 = {cvtpk(p1[0], p1[1]), cvtpk(p1[2], p1[3]), cvtpk(p1[4], p1[5]), cvtpk(p1[6], p1[7])}, pw3 = {cvtpk(p1[8], p1[9]), cvtpk(p1[10], p1[11]), cvtpk(p1[12], p1[13]), cvtpk(p1[14], p1[15])};
    if (MASK) { pw0 &= mask; pw1 &= mask; pw2 &= mask; pw3 &= mask; }
    if (ATT_ABL & 64) { o[0] = MFMA32(__builtin_bit_cast(bf16x8, pw0), __builtin_bit_cast(bf16x8, pw1), o[0]); o[1] = MFMA32(__builtin_bit_cast(bf16x8, pw2), __builtin_bit_cast(bf16x8, pw3), o[1]); return; }
    s16x4 vlo[8], vhi[8];
#pragma unroll
    for (int i = 0; i < 8; ++i) { vlo[i] = vtr(vp + ((i >> 2) * 4096 + (i & 3) * 1024)); vhi[i] = vtr(vp + ((i >> 2) * 4096 + (i & 3) * 1024 + 512)); }
#define ATT_VFR(i) (bf16x8){vlo[i][0], vlo[i][1], vlo[i][2], vlo[i][3], vhi[i][0], vhi[i][1], vhi[i][2], vhi[i][3]}
    o[0] = MFMA32(__builtin_bit_cast(bf16x8, pw0), ATT_VFR(0), o[0]); o[1] = MFMA32(__builtin_bit_cast(bf16x8, pw0), ATT_VFR(4), o[1]);
    o[0] = MFMA32(__builtin_bit_cast(bf16x8, pw1), ATT_VFR(1), o[0]); o[1] = MFMA32(__builtin_bit_cast(bf16x8, pw1), ATT_VFR(5), o[1]);
    o[0] = MFMA32(__builtin_bit_cast(bf16x8, pw2), ATT_VFR(2), o[0]); o[1] = MFMA32(__builtin_bit_cast(bf16x8, pw2), ATT_VFR(6), o[1]);
    o[0] = MFMA32(__builtin_bit_cast(bf16x8, pw3), ATT_VFR(3), o[0]); o[1] = MFMA32(__builtin_bit_cast(bf16x8, pw3), ATT_VFR(7), o[1]);
#undef ATT_VFR
}
#define ATT_SB() __builtin_amdgcn_sched_barrier(0)
struct KF { bf16x8 f[8]; };
struct VF { s16x4 lo[8], hi[8]; };
struct PW4 { u32x4 w0, w1, w2, w3; };
__device__ __forceinline__ void ld_k(KF& k, lds_cptr kp) {
    const int l = fresh_lane(), f = ((l & 31) >> 1) & 7, hi = l >> 5;
#pragma unroll
    for (int d0 = 0; d0 < 4; ++d0) { const int off = ((2 * d0 + hi) ^ f) << 4; k.f[2 * d0] = *(const LAS bf16x8*)(kp + off); k.f[2 * d0 + 1] = *(const LAS bf16x8*)(kp + 4096 + off); } }
__device__ __forceinline__ void qk_mfma(f32x16& s0, f32x16& s1, const KF& k, const bf16x8 (&qr)[4]) {
    const f32x16 z = {};
    s0 = MFMA32(k.f[0], qr[0], z); s1 = MFMA32(k.f[1], qr[0], z);
#pragma unroll
    for (int d0 = 1; d0 < 4; ++d0) { s0 = MFMA32(k.f[2 * d0], qr[d0], s0); s1 = MFMA32(k.f[2 * d0 + 1], qr[d0], s1); } }
__device__ __forceinline__ void ld_v(VF& v, lds_cptr vp) {
#pragma unroll
    for (int i = 0; i < 8; ++i) { v.lo[i] = vtr(vp + ((i >> 2) * 4096 + (i & 3) * 1024)); v.hi[i] = vtr(vp + ((i >> 2) * 4096 + (i & 3) * 1024 + 512)); } }
__device__ __forceinline__ PW4 pack4(const f32x16& p0, const f32x16& p1, unsigned mask) { PW4 w;
    w.w0 = (u32x4){cvtpk(p0[0], p0[1]), cvtpk(p0[2], p0[3]), cvtpk(p0[4], p0[5]), cvtpk(p0[6], p0[7])}; w.w1 = (u32x4){cvtpk(p0[8], p0[9]), cvtpk(p0[10], p0[11]), cvtpk(p0[12], p0[13]), cvtpk(p0[14], p0[15])};
    w.w2 = (u32x4){cvtpk(p1[0], p1[1]), cvtpk(p1[2], p1[3]), cvtpk(p1[4], p1[5]), cvtpk(p1[6], p1[7])}; w.w3 = (u32x4){cvtpk(p1[8], p1[9]), cvtpk(p1[10], p1[11]), cvtpk(p1[12], p1[13]), cvtpk(p1[14], p1[15])};
    w.w0 &= mask; w.w1 &= mask; w.w2 &= mask; w.w3 &= mask; return w; }
__device__ __forceinline__ void pv_mfma(f32x16 (&o)[2], const VF& v, const PW4& w) {
#define ATT_VF(i) (bf16x8){v.lo[i][0], v.lo[i][1], v.lo[i][2], v.lo[i][3], v.hi[i][0], v.hi[i][1], v.hi[i][2], v.hi[i][3]}
    o[0] = MFMA32(__builtin_bit_cast(bf16x8, w.w0), ATT_VF(0), o[0]); o[1] = MFMA32(__builtin_bit_cast(bf16x8, w.w0), ATT_VF(4), o[1]);
    o[0] = MFMA32(__builtin_bit_cast(bf16x8, w.w1), ATT_VF(1), o[0]); o[1] = MFMA32(__builtin_bit_cast(bf16x8, w.w1), ATT_VF(5), o[1]);
    o[0] = MFMA32(__builtin_bit_cast(bf16x8, w.w2), ATT_VF(2), o[0]); o[1] = MFMA32(__builtin_bit_cast(bf16x8, w.w2), ATT_VF(6), o[1]);
    o[0] = MFMA32(__builtin_bit_cast(bf16x8, w.w3), ATT_VF(3), o[0]); o[1] = MFMA32(__builtin_bit_cast(bf16x8, w.w3), ATT_VF(7), o[1]);
#undef ATT_VF
}
__device__ __forceinline__ float rowsum32(const f32x16& p0, const f32x16& p1) { if (ATT_ABL & 32) return p0[0]; float a = p0[0] + p1[0], b = p0[1] + p1[1];
#pragma unroll
    for (int r = 2; r < 16; r += 2) { a += p0[r]; asm volatile("" : "+v"(a)); b += p0[r + 1]; asm volatile("" : "+v"(b)); a += p1[r]; asm volatile("" : "+v"(a)); b += p1[r + 1]; asm volatile("" : "+v"(b)); }
    return a + b; }
__device__ __forceinline__ void hook_exp(f32x16& s0, f32x16& s1) {
    if (ATT_ABL & 16) return;
#pragma unroll
    for (int r = 0; r < 16; ++r) { s0[r] = __builtin_amdgcn_exp2f(s0[r]); s1[r] = __builtin_amdgcn_exp2f(s1[r]); } }
__device__ __forceinline__ void hook_near(f32x16& s0, f32x16& s1, int base, const LAS float* lut) {
    asm volatile("" : "+v"(base));
#pragma unroll
    for (int r = 0; r < 16; ++r) { const int d0 = base - ((r & 3) + 8 * (r >> 2)), d1 = d0 - 32;
        s0[r] = __builtin_amdgcn_exp2f(s0[r] + lut[min(max(d0, -1), 113) + 1]); s1[r] = __builtin_amdgcn_exp2f(s1[r] + lut[min(max(d1, -1), 113) + 1]); } }
__device__ __forceinline__ void hook_edge(f32x16& s0, f32x16& s1, int base, int win) {
    asm volatile("" : "+v"(base));
#pragma unroll
    for (int r = 0; r < 16; ++r) { const int d0 = base - ((r & 3) + 8 * (r >> 2)), d1 = d0 - 32;
        s0[r] = __builtin_amdgcn_exp2f(d0 < win ? s0[r] : -INFINITY); s1[r] = __builtin_amdgcn_exp2f(d1 < win ? s1[r] : -INFINITY); } }
__device__ __forceinline__ void hook_cmp(f32x16& s0, f32x16& s1, int nrel  , float cb) {
    asm volatile("" : "+v"(nrel));
#pragma unroll
    for (int r = 0; r < 16; ++r) { const int c0 = (r & 3) + 8 * (r >> 2);
        s0[r] = __builtin_amdgcn_exp2f(s0[r] + ((c0 <= nrel) ? cb : -INFINITY)); s1[r] = __builtin_amdgcn_exp2f(s1[r] + ((c0 + 32 <= nrel) ? cb : -INFINITY)); } }
__device__ __forceinline__ void row_factors(const Ctx& c, float f, float (&fr)[16]) {
    const int lane = fresh_lane(), r32 = lane & 31, hi = lane >> 5; LAS float* wsf = (LAS float*)(c.lds + LDS_WSF) + c.wid * 64;
    asm volatile("s_waitcnt lgkmcnt(0)" ::: "memory");
    if (hi == 0) wsf[r32] = f;
    asm volatile("s_waitcnt lgkmcnt(0)" ::: "memory");
#pragma unroll
    for (int r = 0; r < 16; ++r) fr[r] = wsf[(r & 3) + 8 * (r >> 2) + 4 * hi];
    asm volatile("s_waitcnt lgkmcnt(0)" ::: "memory");
}
__device__ __forceinline__ float pair_sum(float v) { auto rr = __builtin_amdgcn_permlane32_swap(__float_as_uint(v), __float_as_uint(v), false, false); return __uint_as_float(rr[0]) + __uint_as_float(rr[1]); }
template <class RowOff>
__device__ __forceinline__ void store_rows(const Ctx& c, const f32x16 (&o)[2], bf16* dst, RowOff&& rowoff) {
    LAS bf16* stg = (LAS bf16*)(c.lds + LDS_OST) + c.wid * 2048;
    const int lane = fresh_lane(), r32 = lane & 31, hi = lane >> 5;
#pragma unroll
    for (int r = 0; r < 16; ++r) { const int orow = (r & 3) + 8 * (r >> 2) + 4 * hi;
#pragma unroll
        for (int d0 = 0; d0 < 2; ++d0) stg[orow * 64 + d0 * 32 + r32] = (bf16)f2bf(o[d0][r]); }
    asm volatile("s_waitcnt lgkmcnt(0)" ::: "memory");
#pragma unroll
    for (int i = 0; i < 4; ++i) { const int row = i * 8 + (lane >> 3), ch = lane & 7; const u32x4 v = *(const LAS u32x4*)(stg + row * 64 + ch * 8); *(u32x4*)(dst + rowoff(row) + ch * 8) = v; }
    asm volatile("s_waitcnt lgkmcnt(0)" ::: "memory");
}
struct AttnPtrs { const bf16* qkv; const float* kmp; const float* gates; const bf16* kcmp; const bf16* vcmp; const float* rel_bias; bf16* mix; unsigned* selg; bf16* part_o; float* part_l; };

__device__ __forceinline__ void moba_kmean_frags(const AttnPtrs& P, int bh, int r32, int hi, bf16x8 (&kmf)[4]) {
    const float* kp = P.kmp + ((size_t)(bh * 32 + r32) * 2) * 64;
#pragma unroll
    for (int d0 = 0; d0 < 4; ++d0) { const f32x4 a0 = *(const f32x4*)(kp + d0 * 16 + hi * 8), a1 = *(const f32x4*)(kp + d0 * 16 + hi * 8 + 4), b0 = *(const f32x4*)(kp + 64 + d0 * 16 + hi * 8), b1 = *(const f32x4*)(kp + 64 + d0 * 16 + hi * 8 + 4);
        const f32x4 m0 = (a0 + b0) * (1.f / 256.f), m1 = (a1 + b1) * (1.f / 256.f);
        u32x4 w = {cvtpk(m0[0], m0[1]), cvtpk(m0[2], m0[3]), cvtpk(m1[0], m1[1]), cvtpk(m1[2], m1[3])}; kmf[d0] = __builtin_bit_cast(bf16x8, w); }
}
__device__ __forceinline__ unsigned moba_gate32(const bf16x8 (&kmf)[4], int i, const bf16x8 (&qr)[4], int hi) {
    unsigned selmask = 0u;
    if (i > 0) {
        f32x16 sg = {};
#pragma unroll
        for (int d0 = 0; d0 < 4; ++d0) sg = MFMA32(kmf[d0], qr[d0], sg);
        float v[16];
#pragma unroll
        for (int r = 0; r < 16; ++r) v[r] = ((r & 3) + 8 * (r >> 2) + 4 * hi < i) ? sg[r] : -INFINITY;
#pragma unroll
        for (int it = 0; it < 3; ++it) {
            float m = v[0]; int jb = 4 * hi;
#pragma unroll
            for (int r = 1; r < 16; ++r) { const int j = (r & 3) + 8 * (r >> 2) + 4 * hi; if (v[r] > m) { m = v[r]; jb = j; } }
            auto rm = __builtin_amdgcn_permlane32_swap(__float_as_uint(m), __float_as_uint(m), false, false);
            auto rj = __builtin_amdgcn_permlane32_swap((unsigned)jb, (unsigned)jb, false, false);
            const float mo = __uint_as_float(hi ? rm[0] : rm[1]); const int jo = (int)(hi ? rj[0] : rj[1]);
            const bool mine = (m > mo) || (m == mo && jb < jo);
            const float mw = mine ? m : mo; const int jw = mine ? jb : jo;
            if (mw > -INFINITY) { selmask |= 1u << jw;
#pragma unroll
                for (int r = 0; r < 16; ++r) if ((r & 3) + 8 * (r >> 2) + 4 * hi == jw) v[r] = -INFINITY; }
        }
    }
    return selmask;
}
__device__ __forceinline__ void moba_gate_phase(const AttnPtrs& P, int vcu, int G, int tid) {
    const int lane = tid & 63, r32 = lane & 31, hi = lane >> 5; const int wid = __builtin_amdgcn_readfirstlane(tid >> 6);
    for (int grp = vcu * 8 + wid; grp < 2048; grp += G * 8) { const int bh = grp >> 6;
        bf16x8 kmf[4]; moba_kmean_frags(P, bh, r32, hi, kmf);
        const bf16* QA = P.qkv + ((size_t)bh * SEQ) * 64;
        bf16x8 qr[4][4];
#pragma unroll
        for (int k = 0; k < 4; ++k) { const int idx = (grp & 63) * 4 + k, i = idx >> 3, w = idx & 7; const int qpos = 256 * i + 32 * w + r32;
#pragma unroll
            for (int d0 = 0; d0 < 4; ++d0) qr[k][d0] = *(const bf16x8*)(QA + (size_t)qpos * 64 + d0 * 16 + hi * 8); }
#pragma unroll
        for (int k = 0; k < 4; ++k) { const int idx = (grp & 63) * 4 + k, i = idx >> 3, w = idx & 7; const int qpos = 256 * i + 32 * w + r32;
            const unsigned m = moba_gate32(kmf, i, qr[k], hi);
            if (hi == 0) P.selg[(size_t)bh * SEQ + qpos] = m; } }
}
__device__ __forceinline__ void moba_past_item(const Ctx& c, const AttnPtrs& P, int b, int h, int j, int flags = 0) {
    const int bh = b * 8 + h, tid = threadIdx.x;
    const bf16* QA = P.qkv + ((size_t)bh * SEQ) * 64; const bf16* KA = QA + QKV_BIG + (size_t)256 * j * 64; const bf16* VA = QA + 2 * QKV_BIG + (size_t)256 * j * 64;
    const LAS float* lut = (const LAS float*)(c.lds + LDS_LUTG) + h * LUT_PITCH;
    { const int lane = fresh_lane(); const unsigned lds0 = (unsigned)(uintptr_t)c.lds;
      const bf16* ks = KA + ((8 * c.wid + (lane >> 3)) * 64 + (((lane & 7) ^ (((8 * c.wid + (lane >> 3)) >> 1) & 7)) << 3)); const bf16* vs = VA + ((16 * (c.wid & 3) + (lane >> 2)) * 64 + (c.wid >> 2) * 32 + (lane & 3) * 8);
#pragma unroll
      for (int tt = 0; tt < 4; ++tt) { glds16(ks + tt * 4096, (unsigned)__builtin_amdgcn_readfirstlane(lds0 + c.wid * 1024 + tt * SLOT)); glds16(vs + tt * 4096, (unsigned)__builtin_amdgcn_readfirstlane(lds0 + 8192 + c.wid * 1024 + tt * SLOT)); } }
    LAS unsigned short* list = (LAS unsigned short*)(c.lds + LDS_IMP);
    LAS unsigned* wcnt = (LAS unsigned*)(c.lds + LDS_MISC) + 8;
    const unsigned* sg = P.selg + (size_t)bh * SEQ;
    if (tid < 256) list[tid] = (unsigned short)((256 * j + tid) | (3 << 13));
    int total = 256;
    for (int base = (j + 1) * 256; base < SEQ; base += 2048) {
        const int q0 = base + 4 * tid; uint4 m4 = make_uint4(0u, 0u, 0u, 0u); if (q0 < SEQ) m4 = *(const uint4*)(sg + q0);
        const unsigned long long b0 = __ballot((m4.x >> j) & 1u), b1 = __ballot((m4.y >> j) & 1u), b2 = __ballot((m4.z >> j) & 1u), b3 = __ballot((m4.w >> j) & 1u);
        const int c0 = (int)__popcll(b0), c1 = (int)__popcll(b1), c2 = (int)__popcll(b2), c3 = (int)__popcll(b3);
        if ((tid & 63) == 0) wcnt[c.wid] = (unsigned)(c0 + c1 + c2 + c3);
        asm volatile("s_waitcnt vmcnt(0) lgkmcnt(0)\n\ts_barrier" ::: "memory");
        int off = total, tot = 0;
#pragma unroll
        for (int w = 0; w < 8; ++w) { const int v = (int)wcnt[w]; off += (w < c.wid) ? v : 0; tot += v; }
        const unsigned long long below = (1ull << (tid & 63)) - 1ull; const unsigned lowj = (1u << j) - 1u;
        if ((m4.x >> j) & 1u) list[off + __popcll(b0 & below)] = (unsigned short)((q0 + 0) | (__popc(m4.x & lowj) << 13)); off += c0;
        if ((m4.y >> j) & 1u) list[off + __popcll(b1 & below)] = (unsigned short)((q0 + 1) | (__popc(m4.y & lowj) << 13)); off += c1;
        if ((m4.z >> j) & 1u) list[off + __popcll(b2 & below)] = (unsigned short)((q0 + 2) | (__popc(m4.z & lowj) << 13)); off += c2;
        if ((m4.w >> j) & 1u) list[off + __popcll(b3 & below)] = (unsigned short)((q0 + 3) | (__popc(m4.w & lowj) << 13));
        total += tot;
        asm volatile("s_waitcnt lgkmcnt(0)\n\ts_barrier" ::: "memory");
    }
    total = __builtin_amdgcn_readfirstlane(total);
    { const int npad = (32 - (total & 31)) & 31; if (tid < npad) list[total + tid] = 0xFFFFu; }
    const int nchunks = (total + 31) >> 5;
    asm volatile("s_waitcnt vmcnt(0) lgkmcnt(0)\n\ts_barrier" ::: "memory");
    unsigned e_n = 0xFFFFu; bf16x8 qn[4];
    if (c.wid < nchunks) { const int l0 = fresh_lane(); e_n = list[32 * c.wid + (l0 & 31)]; const int q0 = (e_n != 0xFFFFu) ? (int)(e_n & 0x1FFFu) : SEQ - 1;
#pragma unroll
        for (int d0 = 0; d0 < 4; ++d0) qn[d0] = *(const bf16x8*)(QA + (size_t)q0 * 64 + d0 * 16 + (l0 >> 5) * 8); }
    if (!(flags & 64)) for (int ch = c.wid; ch < nchunks; ch += 8) {
        const int lane = fresh_lane(), r32 = lane & 31, hi = lane >> 5;
        const lds_cptr kp0 = (lds_cptr)c.lds + r32 * 128;
        const lds_cptr vp0 = (lds_cptr)c.lds + 8192 + ((lane >> 4) & 1) * 32 + (lane & 3) * 8 + (4 * hi + ((lane & 15) >> 2)) * 64;
        const unsigned e = e_n; const bool valid = e != 0xFFFFu; const int q = valid ? (int)(e & 0x1FFFu) : SEQ - 1;
        bf16x8 qr[4];
#pragma unroll
        for (int d0 = 0; d0 < 4; ++d0) qr[d0] = qn[d0];
        if (ch + 8 < nchunks) { e_n = list[32 * (ch + 8) + r32]; const int q1 = (e_n != 0xFFFFu) ? (int)(e_n & 0x1FFFu) : SEQ - 1;
#pragma unroll
            for (int d0 = 0; d0 < 4; ++d0) qn[d0] = *(const bf16x8*)(QA + (size_t)q1 * 64 + d0 * 16 + hi * 8); }
        const int ntt = (ch < 8) ? (ch >> 1) + 1 : 4;
        f32x16 o[2]; o[0] = f32x16{}; o[1] = f32x16{}; float l_reg = 0.f;
#pragma unroll 1
        for (int tt = 0; tt < ntt; ++tt) { f32x16 s0, s1; qk_tile(s0, s1, kp0 + tt * SLOT, qr);
            const int dq = q - (256 * j + 64 * tt);
            if (__any(valid && dq < 113 + 63)) hook_near(s0, s1, dq - 4 * hi, lut); else hook_exp(s0, s1);
            l_reg += rowsum32(s0, s1);
            pv_tile<false>(o, vp0 + tt * SLOT, s0, s1, 0u); }
        const float L = pair_sum(l_reg);
        if (hi == 0 && valid) P.part_l[((size_t)bh * SEQ + q) * 4 + (e >> 13)] = L;
        LAS bf16* stg = (LAS bf16*)(c.lds + LDS_OST) + c.wid * 2048;
#pragma unroll
        for (int r = 0; r < 16; ++r) { const int orow = (r & 3) + 8 * (r >> 2) + 4 * hi;
#pragma unroll
            for (int d0 = 0; d0 < 2; ++d0) stg[orow * 64 + d0 * 32 + r32] = (bf16)f2bf(o[d0][r]); }
        asm volatile("s_waitcnt lgkmcnt(0)" ::: "memory");
#pragma unroll
        for (int it = 0; it < 4; ++it) { const int row = it * 8 + (lane >> 3), chn = lane & 7; const unsigned e2 = list[32 * ch + row];
            const u32x4 v = *(const LAS u32x4*)(stg + row * 64 + chn * 8);
            if (e2 != 0xFFFFu) *(u32x4*)(P.part_o + (((size_t)bh * SEQ + (e2 & 0x1FFFu)) * 4 + (e2 >> 13)) * 64 + chn * 8) = v; }
        asm volatile("s_waitcnt lgkmcnt(0)" ::: "memory");
    }
    asm volatile("s_waitcnt lgkmcnt(0)\n\ts_barrier" ::: "memory");
}
__device__ __forceinline__ void moba_merge_pass(const AttnPtrs& P, int vcu, int G, int tid) {
    const int lane = tid & 63, h = lane >> 3, chn = lane & 7; const int wid = __builtin_amdgcn_readfirstlane(tid >> 6);
#pragma unroll 2
    for (int tok = vcu * 8 + wid; tok < TOK; tok += G * 8) { const int b = tok >> 13, q = tok & (SEQ - 1);
        const size_t qi = (size_t)(b * 8 + h) * SEQ + q;
        const unsigned sg = P.selg[qi]; const f32x4 l4 = *(const f32x4*)(P.part_l + qi * 4);
        u32x4 pv[4];
#pragma unroll
        for (int sidx = 0; sidx < 4; ++sidx) pv[sidx] = *(const u32x4*)(P.part_o + (qi * 4 + sidx) * 64 + chn * 8);
        const int ns = __popc(sg);
        float Lt = l4[3];
        f32x4 a0 = {__uint_as_float(pv[3].x << 16), __uint_as_float(pv[3].x & 0xffff0000u), __uint_as_float(pv[3].y << 16), __uint_as_float(pv[3].y & 0xffff0000u)};
        f32x4 a1 = {__uint_as_float(pv[3].z << 16), __uint_as_float(pv[3].z & 0xffff0000u), __uint_as_float(pv[3].w << 16), __uint_as_float(pv[3].w & 0xffff0000u)};
#pragma unroll
        for (int sidx = 0; sidx < 3; ++sidx) { const bool on = sidx < ns; const u32x4 w = pv[sidx];
            const unsigned wx = on ? w.x : 0u, wy = on ? w.y : 0u, wz = on ? w.z : 0u, ww = on ? w.w : 0u;
            Lt += on ? l4[sidx] : 0.f;
            a0 += (f32x4){__uint_as_float(wx << 16), __uint_as_float(wx & 0xffff0000u), __uint_as_float(wy << 16), __uint_as_float(wy & 0xffff0000u)};
            a1 += (f32x4){__uint_as_float(wz << 16), __uint_as_float(wz & 0xffff0000u), __uint_as_float(ww << 16), __uint_as_float(ww & 0xffff0000u)}; }
        const float inv = 1.f / Lt; a0 *= inv; a1 *= inv;
        const u32x4 w = {cvtpk(a0[0], a0[1]), cvtpk(a0[2], a0[3]), cvtpk(a1[0], a1[1]), cvtpk(a1[2], a1[3])};
        *(u32x4*)(P.mix + (size_t)tok * DM + h * 64 + chn * 8) = w; }
}

__device__ __forceinline__ void nsa_item(const Ctx& c, const AttnPtrs& P, int b, int g, int ci, int flags = 0) {
    const int ql = 8 * c.wid + (c.r32 >> 2), rh = c.r32 & 3, qpos = 64 * ci + ql, hb = 4 * g + rh;
    const int qw0 = 64 * ci + 8 * c.wid;
    const bf16* QB = P.qkv + 3 * QKV_BIG + ((size_t)(b * 8 + hb) * SEQ) * 64;
    const bf16* KS = P.qkv + 4 * QKV_BIG + 2 * QKV_SMALL + ((size_t)(b * 2 + g) * SEQ) * 64; const bf16* VS = KS + QKV_SMALL; const bf16* KW = KS + 2 * QKV_SMALL; const bf16* VW = KS + 3 * QKV_SMALL;
    const bf16* KC = P.kcmp + (size_t)(b * 2 + g) * 512 * 64; const bf16* VC = P.vcmp + (size_t)(b * 2 + g) * 512 * 64;
    bf16x8 qr[4];
#pragma unroll
    for (int d0 = 0; d0 < 4; ++d0) qr[d0] = *(const bf16x8*)(QB + (size_t)qpos * 64 + d0 * 16 + c.hi * 8);
    asm volatile("" : "+v"(qr[0]), "+v"(qr[1]), "+v"(qr[2]), "+v"(qr[3]));
    const LAS float* lut = (const LAS float*)(c.lds + LDS_LUTG) + (8 + hb) * LUT_PITCH;
    LAS float* imp = (LAS float*)(c.lds + LDS_IMP);
    LAS unsigned* selm = (LAS unsigned*)(c.lds + LDS_SELM);
    f32x16 o[2]; float l_reg; float fr[16];
    LAS float* park = (LAS float*)(c.lds + LDS_OST) + c.wid * 1024 + c.lane;
    LAS float* park1 = (LAS float*)(c.lds + LDS_IMP) + c.wid * 1024 + c.lane;
    const int nct = (4 * ci + 3 + 63) >> 6;
    const int nlim = (qpos >= 31) ? ((qpos - 31) >> 4) : -1;
    const int nlim_w = (qw0 >= 31) ? ((qw0 - 31) >> 4) : -1;
    LAS bf16* impt = (LAS bf16*)(c.lds + ((rh & 2) ? LDS_IMP : LDS_OST)) + ((rh & 2) ? IMP_REG1 : 0) + (rh & 1) * IMP_PLANE + ql * IMP_PITCH;
    l_reg = 0.f; o[0] = f32x16{}; o[1] = f32x16{};
    {
        float carry = 0.f;
        if (!(flags & 32)) run_stream<true>(c, KC, VC, 0, nct,
          [&](int t, lds_cptr kp, f32x16& s0, f32x16& s1) { qk_tile(s0, s1, kp, qr); },
          [&](int t, lds_cptr vp, f32x16& s0, f32x16& s1) {
            if (nlim_w - 64 * t >= 63) hook_exp(s0, s1); else hook_cmp(s0, s1, nlim - 64 * t - 4 * c.hi, 0.f);
            l_reg += rowsum32(s0, s1);
#pragma unroll
            for (int half = 0; half < 2; ++half) {
                float g4[4], e[4];
#pragma unroll
                for (int a = 0; a < 4; ++a) { const float x0 = half ? s1[4 * a] : s0[4 * a], x1 = half ? s1[4 * a + 1] : s0[4 * a + 1], x2 = half ? s1[4 * a + 2] : s0[4 * a + 2], x3 = half ? s1[4 * a + 3] : s0[4 * a + 3];
                    g4[a] = (x0 + x1) + (x2 + x3); e[a] = x3; }
                float x[4];
#pragma unroll
                for (int a = 0; a < 4; ++a) { auto rr = __builtin_amdgcn_permlane32_swap(__float_as_uint(e[a]), __float_as_uint(e[a]), false, false); x[a] = __uint_as_float(c.hi ? rr[0] : rr[1]); }
                const int jb = 16 * t + 8 * half;
                float iv[4];
                if (c.hi) {
#pragma unroll
                    for (int a = 0; a < 4; ++a) iv[a] = g4[a] + x[a]; }
                else { iv[0] = g4[0] + carry; iv[1] = g4[1] + x[0]; iv[2] = g4[2] + x[1]; iv[3] = g4[3] + x[2]; carry = x[3]; }
#pragma unroll
                for (int a = 0; a < 4; ++a) impt[jb + 2 * a + c.hi] = (bf16)f2bf(iv[a]);
            }
            pv_tile<false>(o, vp, s0, s1, 0u);
        });
    }
    const float Lc = pair_sum(l_reg); const float invLc = Lc > 0.f ? 1.f / Lc : 0.f;
    { LAS float* wsfw = (LAS float*)(c.lds + LDS_WSF) + c.wid * 64; if (c.hi == 0) wsfw[32 + c.r32] = invLc; }
    const float* gp = P.gates + ((size_t)b * SEQ + qpos) * 24 + hb * 3; float g0 = gp[0], g1 = gp[1], g2 = gp[2];
    {
        asm volatile("s_waitcnt lgkmcnt(0)\n\ts_barrier" ::: "memory");
        const int fl = fresh_lane(); const int qq = 8 * c.wid + (fl >> 3), cc = fl & 7;
        unsigned m0 = 0u, m1 = 0u, m2w = 0u, m3 = 0u;
        if (ci <= 15 || (flags & 16)) { m0 = (ci >= 31) ? 0xffffffffu : ((2u << ci) - 1u); }
        else {
            unsigned v[16];
            const LAS float* il = (const LAS float*)(c.lds + LDS_WSF) + c.wid * 64 + 32 + 4 * (fl >> 3);
            const float i0 = il[0], i1 = il[1], i2 = il[2], i3 = il[3];
            const LAS bf16* ta = (const LAS bf16*)(c.lds + LDS_OST) + qq * IMP_PITCH; const LAS bf16* tb = (const LAS bf16*)(c.lds + LDS_IMP) + IMP_REG1 + qq * IMP_PITCH;
#pragma unroll
            for (int k = 0; k < 16; ++k) { const int j = cc + 8 * k;
                const float val = (bf2f(ta[j]) * i0 + bf2f(ta[IMP_PLANE + j]) * i1) + (bf2f(tb[j]) * i2 + bf2f(tb[IMP_PLANE + j]) * i3);
                v[k] = (j >= 1 && j <= ci - 2) ? ((__float_as_uint(val) & ~127u) | (unsigned)(127 - j)) : 0u; }
            for (int it = 0; it < 13; ++it) {
                unsigned m = v[0];
#pragma unroll
                for (int k = 1; k < 16; ++k) m = max(m, v[k]);
#pragma unroll
                for (int sft = 1; sft < 8; sft <<= 1) m = max(m, (unsigned)__shfl_xor((int)m, sft));
                if (m != 0u) { const int jb = 127 - (int)(m & 127u); const unsigned bit = 1u << (jb & 31); const int wsel = jb >> 5;
                    m0 |= (wsel == 0) ? bit : 0u; m1 |= (wsel == 1) ? bit : 0u; m2w |= (wsel == 2) ? bit : 0u; m3 |= (wsel == 3) ? bit : 0u;
#pragma unroll
                    for (int k = 0; k < 16; ++k) v[k] = (v[k] == m) ? 0u : v[k]; }
            }
            m0 |= 1u;
#pragma unroll
            for (int z = 0; z < 2; ++z) { const int jf = ci - z; const unsigned bit = 1u << (jf & 31); const int wsel = jf >> 5;
                m0 |= (wsel == 0) ? bit : 0u; m1 |= (wsel == 1) ? bit : 0u; m2w |= (wsel == 2) ? bit : 0u; m3 |= (wsel == 3) ? bit : 0u; }
        }
        if (cc == 0) { selm[qq * 4 + 0] = m0; selm[qq * 4 + 1] = m1; selm[qq * 4 + 2] = m2w; selm[qq * 4 + 3] = m3; }
        asm volatile("s_waitcnt lgkmcnt(0)\n\ts_barrier" ::: "memory");
    }
    asm volatile("" : "+v"(g0), "+v"(g1), "+v"(g2));
    row_factors(c, g0 * invLc, fr);
#pragma unroll
    for (int r = 0; r < 16; ++r) { park[r * 64] = o[0][r] * fr[r]; park1[r * 64] = o[1][r] * fr[r]; }
    {
        const unsigned w0 = selm[ql * 4 + 0], w1 = selm[ql * 4 + 1], w2 = selm[ql * 4 + 2], w3 = selm[ql * 4 + 3];
        o[0] = f32x16{}; o[1] = f32x16{}; l_reg = 0.f;
        auto sel_pred = [&](int t) -> bool { const unsigned wsel = (t < 32) ? w0 : (t < 64) ? w1 : (t < 96) ? w2 : w3; return (wsel >> (t & 31)) & 1u; };
        auto sel_one = [&](int t, lds_cptr kp, lds_cptr vp) { const bool pred = sel_pred(t); if (!__any(pred)) return; const int key0 = 64 * t;
            f32x16 s0, s1; qk_tile(s0, s1, kp, qr);
            if (qw0 - key0 - 63 >= 113) { hook_exp(s0, s1); const float rs = rowsum32(s0, s1); l_reg += pred ? rs : 0.f;
                if (__all(pred)) pv_tile<false>(o, vp, s0, s1, 0u); else pv_tile<true>(o, vp, s0, s1, pred ? 0xffffffffu : 0u); }
            else { hook_near(s0, s1, qpos - key0 - 4 * c.hi, lut); const float rs = rowsum32(s0, s1); l_reg += pred ? rs : 0.f;
                if (__all(pred)) pv_tile<false>(o, vp, s0, s1, 0u); else pv_tile<true>(o, vp, s0, s1, pred ? 0xffffffffu : 0u); } };
        if (!(flags & 4)) run_stream_pairs(c, KS, VS, 0, ci + 1, sel_one,
            [&](int t, lds_cptr kpA, lds_cptr vpA, lds_cptr kpB, lds_cptr vpB) {
                if (qw0 - 64 * (t + 1) - 63 >= 113) {
                    const bool pa = sel_pred(t), pb = sel_pred(t + 1);
                    const bool xa = __any(pa), xb = __any(pb);
                    if (!xa && !xb) return;
                    if (!xb) { sel_one(t, kpA, vpA); return; }
                    if (!xa) { sel_one(t + 1, kpB, vpB); return; }
                    KF kA, kB; ld_k(kA, kpA); ATT_SB();
                    f32x16 a0, a1, b0, b1; qk_mfma(a0, a1, kA, qr); ATT_SB();
                    VF vA, vB; ld_k(kB, kpB); ld_v(vA, vpA); ATT_SB();
                    qk_mfma(b0, b1, kB, qr); hook_exp(a0, a1);
                    const float ra = rowsum32(a0, a1); const PW4 wa = pack4(a0, a1, pa ? 0xffffffffu : 0u); ATT_SB();
                    ld_v(vB, vpB); ATT_SB();
                    pv_mfma(o, vA, wa); hook_exp(b0, b1);
                    const float rb = rowsum32(b0, b1); const PW4 wb = pack4(b0, b1, pb ? 0xffffffffu : 0u); l_reg += (pa ? ra : 0.f) + (pb ? rb : 0.f); ATT_SB();
                    pv_mfma(o, vB, wb);
                } else { sel_one(t, kpA, vpA); sel_one(t + 1, kpB, vpB); } });
        const float Ls = pair_sum(l_reg);
        row_factors(c, g1 / Ls, fr);
#pragma unroll
        for (int r = 0; r < 16; ++r) { park[r * 64] += o[0][r] * fr[r]; park1[r * 64] += o[1][r] * fr[r]; }
    }
    {
        o[0] = f32x16{}; o[1] = f32x16{}; l_reg = 0.f;
        if (!(flags & 8)) run_stream<true>(c, KW, VW, ci >= 8 ? ci - 8 : 0, ci + 1,
            [&](int t, lds_cptr kp, f32x16& s0, f32x16& s1) { qk_tile(s0, s1, kp, qr); },
            [&](int t, lds_cptr vp, f32x16& s0, f32x16& s1) { const int key0 = 64 * t;
                if (qw0 - key0 - 63 < 113) hook_near(s0, s1, qpos - key0 - 4 * c.hi, lut); else if (qw0 + 7 - key0 >= 512) hook_edge(s0, s1, qpos - key0 - 4 * c.hi, 512); else hook_exp(s0, s1);
                l_reg += rowsum32(s0, s1);
                pv_tile<false>(o, vp, s0, s1, 0u); });
        const float Lw = pair_sum(l_reg);
        row_factors(c, g2 / Lw, fr);
#pragma unroll
        for (int r = 0; r < 16; ++r) { o[0][r] = park[r * 64] + o[0][r] * fr[r]; o[1][r] = park1[r * 64] + o[1][r] * fr[r]; }
        asm volatile("s_waitcnt lgkmcnt(0)" ::: "memory");
    }
    bf16* dst = P.mix + ((size_t)b * SEQ + 64 * ci + 8 * c.wid) * DM + 512 + g * 256;
    store_rows(c, o, dst, [](int row) { return (size_t)(row >> 2) * DM + (row & 3) * 64; });
    asm volatile("s_waitcnt lgkmcnt(0)\n\ts_barrier" ::: "memory");
}

__device__ __forceinline__ void attn_phase(LAS unsigned char* lds, const AttnPtrs& P, unsigned* qcounter, int flags) {
    Ctx c = make_ctx(lds, threadIdx.x);
    LAS unsigned* misc = (LAS unsigned*)(c.lds + LDS_MISC);
    { LAS float* lutg = (LAS float*)(c.lds + LDS_LUTG);
      for (int idx = threadIdx.x; idx < 16 * 115; idx += NTHREADS) { const int hh = idx / 115, d = idx % 115;
          lutg[hh * LUT_PITCH + d] = (d == 0) ? -INFINITY : (P.rel_bias[t5_bucket(d - 1) * 16 + hh] - P.rel_bias[31 * 16 + hh]) * LOG2E; }
      asm volatile("s_waitcnt vmcnt(0) lgkmcnt(0)\n\ts_barrier" ::: "memory"); }
    for (;;) {
        if (threadIdx.x == 0) misc[0] = __hip_atomic_fetch_add(qcounter, 1u, __ATOMIC_RELAXED, __HIP_MEMORY_SCOPE_AGENT);
        asm volatile("s_waitcnt vmcnt(0) lgkmcnt(0)\n\ts_barrier" ::: "memory");
        const unsigned k = misc[0];
        asm volatile("s_waitcnt lgkmcnt(0)\n\ts_barrier" ::: "memory");
        if (k >= 2048u) break;
        const bool is_mp = k >= 512u && k < 1536u;
        if (flags & (is_mp ? 2 : 1)) continue;
        if (k < 512u) { const int s_ = 127 - (int)(k >> 3), bg = k & 7; nsa_item(c, P, bg >> 1, bg & 1, s_, flags); }
        else if (k < 1536u) { const int kk = (int)k - 512, j = kk >> 5, bh = kk & 31; moba_past_item(c, P, bh >> 3, bh & 7, j, flags); }
        else { const int kk = (int)k - 1536; const int s_ = 63 - (kk >> 3), bg = kk & 7; nsa_item(c, P, bg >> 1, bg & 1, s_, flags); }
    }
}
#undef MFMA32
#undef ATT_WAIT_BAR
}
namespace cmpr {
using bf16x8 = __attribute__((ext_vector_type(8))) short;
using f32x16 = __attribute__((ext_vector_type(16))) float;
constexpr int HID_PITCH = 528;
__device__ __forceinline__ float gelu_tanh(float v) { const float u = fminf(fmaxf(0.7978845608028654f * (v + 0.044715f * v * v * v), -15.f), 15.f); const float e = __expf(2.f * u); return 0.5f * v * (1.f + (e - 1.f) / (e + 1.f)); }
__device__ __forceinline__ void compress_unit(LAS unsigned char* lds, int unit, const bf16* qkv, const bf16* w1k, const bf16* w1v, const bf16* w2k, const bf16* w2v, const float* cbp, const float* kncmp, bf16* kcmp, bf16* vcmp) {
    const int tid = threadIdx.x, lane = tid & 63, r32 = lane & 31, hi = lane >> 5; const int wid = __builtin_amdgcn_readfirstlane(tid >> 6);
    const int kv = unit & 1, u = (unit >> 1) & 15, bg = unit >> 5;
    const bf16* src = qkv + 4 * QKV_BIG + (kv ? QKV_SMALL : 0) + (size_t)bg * SEQ * 64;
    const bf16* w1 = kv ? w1v : w1k; const bf16* w2 = kv ? w2v : w2k;
    const int n0 = 32 * u;
    { const bf16* sp = src + (size_t)16 * n0 * 64;
      for (int ch = tid; ch < 4224; ch += NTHREADS) { v4u v = {0u, 0u, 0u, 0u}; if (16 * n0 + (ch >> 3) < SEQ) v = *(const GAS v4u*)(sp + (size_t)ch * 8);
          *(LAS v4u*)(lds + ((ch ^ ((ch >> 7) & 15)) << 4)) = v; } }
    asm volatile("s_waitcnt vmcnt(0) lgkmcnt(0)\n\ts_barrier" ::: "memory");
    const bf16* bp = w1 + ((size_t)wid * 64 + lane) * 8;
    f32x16 acc = {};
#pragma unroll 16
    for (int kk = 0; kk < 128; ++kk) { const int lc = r32 * 128 + 2 * kk + hi; const bf16x8 a = *(const LAS bf16x8*)(lds + ((lc ^ ((lc >> 7) & 15)) << 4)), bfr = *(const bf16x8*)(bp + (size_t)kk * 4096); acc = __builtin_amdgcn_mfma_f32_32x32x16_bf16(a, bfr, acc, 0, 0, 0); }
    float cb = 0.f;
#pragma unroll 8
    for (int ic = 0; ic < 32; ++ic) cb += cbp[(ic * 2 + kv) * 256 + 32 * wid + r32];
    LAS unsigned char* hidL = lds + 69632;
#pragma unroll
    for (int r = 0; r < 16; ++r) { const int n = (r & 3) + 8 * (r >> 2) + 4 * hi; *(LAS bf16*)(hidL + n * HID_PITCH + (32 * wid + r32) * 2) = (bf16)f2bf(gelu_tanh(acc[r] + cb)); }
    asm volatile("s_waitcnt lgkmcnt(0)\n\ts_barrier" ::: "memory");
    if (wid == 0) {
        f32x16 o0 = {}, o1 = {};
#pragma unroll 4
        for (int kk = 0; kk < 16; ++kk) { const bf16x8 hb = *(const LAS bf16x8*)(hidL + r32 * HID_PITCH + (16 * kk + 8 * hi) * 2);
            const bf16x8 a0 = *(const bf16x8*)(w2 + (size_t)r32 * 256 + 16 * kk + 8 * hi), a1 = *(const bf16x8*)(w2 + (size_t)(32 + r32) * 256 + 16 * kk + 8 * hi);
            o0 = __builtin_amdgcn_mfma_f32_32x32x16_bf16(a0, hb, o0, 0, 0, 0); o1 = __builtin_amdgcn_mfma_f32_32x32x16_bf16(a1, hb, o1, 0, 0, 0); }
        float rs = 1.f;
        if (!kv) { float ss = 0.f;
#pragma unroll
            for (int r = 0; r < 16; ++r) ss += o0[r] * o0[r] + o1[r] * o1[r];
            auto rr = __builtin_amdgcn_permlane32_swap(__float_as_uint(ss), __float_as_uint(ss), false, false); ss = __uint_as_float(rr[0]) + __uint_as_float(rr[1]);
            rs = rsqrtf(ss * (1.f / 64.f) + 1e-6f); }
        const int n = n0 + r32; bf16* dst = (kv ? vcmp : kcmp) + ((size_t)bg * 512 + n) * 64;
#pragma unroll
        for (int r = 0; r < 16; ++r) { const int d = (r & 3) + 8 * (r >> 2) + 4 * hi;
            float v0 = o0[r] * rs, v1 = o1[r] * rs; if (!kv) { v0 *= kncmp[d]; v1 *= kncmp[d + 32]; }
            if (n >= NCMP) { v0 = 0.f; v1 = 0.f; }
            dst[d] = (bf16)f2bf(v0); dst[d + 32] = (bf16)f2bf(v1); }
    }
    asm volatile("s_waitcnt lgkmcnt(0)\n\ts_barrier" ::: "memory");
}
}
__global__ void __launch_bounds__(NTHREADS, 2) mk_fwd(Args a) {
    extern __shared__ __attribute__((aligned(16))) unsigned char lds[];
    Frame F;
    F.lds = (LAS unsigned char*)lds;
    F.tid = threadIdx.x; F.lane = F.tid & 63; F.wave = __builtin_amdgcn_readfirstlane(F.tid >> 6);
    F.G = gridDim.x; { const int bx = blockIdx.x; F.vcu = (F.G % 8 == 0) ? (bx % 8) * (F.G / 8) + bx / 8 : bx; }
    cg::grid_group grid = cg::this_grid();
    volatile LAS unsigned* xst = (volatile LAS unsigned*)(F.lds + 147424);
    if (F.tid < 8) xst[F.tid] = 0u;
    __syncthreads();
    const XcdBarrier xbar = xcd_barrier_post((unsigned*)(a.ws + WS_CTL) + 4096, xst);
    unsigned char* ws = a.ws;
    const int lo = a.ph_lo, hi = a.ph_hi & 0xff; const int tflags = a.ph_hi >> 8; (void)tflags;
    const att::AttnPtrs P{(const bf16*)(ws + WS_QKV), (const float*)(ws + WS_KMP), (const float*)(ws + WS_GATES), (const bf16*)(ws + WS_KCMP), (const bf16*)(ws + WS_VCMP), a.in[2], (bf16*)(ws + WS_MIX),
                          (unsigned*)(ws + WS_SELG), (bf16*)(ws + WS_PARTO), (float*)(ws + WS_PARTL)};
#define IN(k) (lo <= (k) && (k) < hi)
#define SEAM(k) do { if (IN(k) && IN((k) + 1)) { if ((k) == 0) grid.sync(); else xcd_barrier(xbar); } } while (0)
    if (IN(0)) { phase_prologue_a(F, a); } SEAM(0);
    if (IN(1)) { phase_prologue_b(F, a); } SEAM(1);
    if (IN(2)) {
        pg8::Gemm g{(const pg8::bf16_t*)(ws + WS_H), (const pg8::bf16_t*)(ws + WS_WIN), TOK, NIN_PAD, DM}; pg8::StaticOrder S; S.init(TOK, NIN_PAD, F.G, (int)blockIdx.x);
        pg8::EpiInProj E{(pg8::bf16_t*)(ws + WS_QKV), (float*)(ws + WS_GATES), (float*)(ws + WS_KMP), a.in[7], a.in[8], a.in[9], a.in[11], a.in[12]};
        pg8::gemm_phase<pg8::EpiInProj, pg8::StaticOrder, true, true>(F.lds, g, S, E);
    } SEAM(2);
    if (IN(3)) {
        if (!(tflags & 1)) att::moba_gate_phase(P, F.vcu, F.G, F.tid);
        if (!(tflags & 2)) for (int unit = F.vcu; unit < 256; unit += F.G)
            cmpr::compress_unit(F.lds, unit, (const bf16*)(ws + WS_QKV), (const bf16*)(ws + WS_W1K), (const bf16*)(ws + WS_W1V), (const bf16*)(ws + WS_W2K), (const bf16*)(ws + WS_W2V),
                                (const float*)(ws + WS_CBP), a.in[10], (bf16*)(ws + WS_KCMP), (bf16*)(ws + WS_VCMP));
    } SEAM(3);
    if (IN(4)) {
#if HYBRID == 3
        att::attn_phase(F.lds, P, (unsigned*)(ws + WS_CTL) + 64, tflags);
#else
        att::attn_phase(F.lds, P, (unsigned*)(ws + WS_CTL) + 64, 0);
#endif
    } SEAM(4);
    if (IN(5)) { att::moba_merge_pass(P, F.vcu, F.G, F.tid); } SEAM(5);
    if (IN(6)) {
        pg8::Gemm g{(const pg8::bf16_t*)(ws + WS_MIX), (const pg8::bf16_t*)(ws + WS_WOUT), TOK, DM, DM}; pg8::StaticOrder S; S.init(TOK, DM, F.G, (int)blockIdx.x);
        pg8::EpiOutProj E{(pg8::bf16_t*)(ws + WS_Y), (const float*)(ws + WS_MOD) + 2 * DM};
        pg8::gemm_phase<pg8::EpiOutProj, pg8::StaticOrder, true, true>(F.lds, g, S, E);
    } SEAM(6);
    if (IN(7)) { phase_norm2(F, a); } SEAM(7);
    if (IN(8)) {
        pg8::Gemm g{(const pg8::bf16_t*)(ws + WS_H), (const pg8::bf16_t*)(ws + WS_WGU), TOK, 2 * FF, DM}; pg8::StaticOrder S; S.init(TOK, 2 * FF, F.G, (int)blockIdx.x);
        pg8::EpiGateUp E{(pg8::bf16_t*)(ws + WS_ACT)};
        pg8::gemm_phase<pg8::EpiGateUp, pg8::StaticOrder, true, true>(F.lds, g, S, E);
    } SEAM(8);
    if (IN(9)) {
        pg8::Gemm g{(const pg8::bf16_t*)(ws + WS_ACT), (const pg8::bf16_t*)(ws + WS_WDN), TOK, DM, FF}; pg8::StaticOrder S; S.init(TOK, DM, F.G, (int)blockIdx.x);
        pg8::EpiDown E{a.in[0], (const pg8::bf16_t*)(ws + WS_Y), a.out, (const float*)(ws + WS_MOD) + 5 * DM};
        pg8::gemm_phase<pg8::EpiDown, pg8::StaticOrder, true, true>(F.lds, g, S, E);
    }
#undef IN
#undef SEAM
}

static void launch_phases(const Args& base, int lo, int hi, int grid, hipStream_t stream, int flags = 0) {
    Args a = base; a.ph_lo = lo; a.ph_hi = hi | (flags << 8);
    if (hi - lo > 1) { void* args[] = {&a}; (void)hipLaunchCooperativeKernel((const void*)mk_fwd, dim3(grid), dim3(NTHREADS), args, LDS_BYTES, stream); }
    else hipLaunchKernelGGL(mk_fwd, dim3(grid), dim3(NTHREADS), LDS_BYTES, stream, a);
}
extern "C" void kernel_launch(void* const* d_in, const int* in_sizes, int n_in, void* d_out, int out_size, void* d_ws, size_t ws_size, hipStream_t stream) {
    static int grid = 0;
    if (grid == 0) {
        int dev = 0, cus = 0, per_cu = 0;
        if (n_in != 23 || ws_size < 480 * MiB || hipGetDevice(&dev) != hipSuccess || hipDeviceGetAttribute(&cus, hipDeviceAttributeMultiprocessorCount, dev) != hipSuccess) { grid = -1; return; }
        if (hipFuncSetAttribute((const void*)mk_fwd, hipFuncAttributeMaxDynamicSharedMemorySize, LDS_BYTES) != hipSuccess) { grid = -1; return; }
        if (hipOccupancyMaxActiveBlocksPerMultiprocessor(&per_cu, (const void*)mk_fwd, NTHREADS, LDS_BYTES) != hipSuccess || per_cu < 1) { grid = -1; return; }
        grid = cus;
    }
    if (grid < 0) return;
    (void)hipMemsetAsync((char*)d_ws + WS_CTL, 0, CTL_ZERO_BYTES, stream);
    Args a{};
    for (int i = 0; i < 23; ++i) a.in[i] = (const float*)d_in[i];
    a.out = (float*)d_out; a.ws = (unsigned char*)d_ws;
    unsigned char* ws = (unsigned char*)d_ws;
#if HYBRID == 1
    launch_phases(a, 0, 1, grid, stream); launch_phases(a, 1, 2, grid, stream); launch_phases(a, 2, 3, grid, stream);
    const bf16* qkv = (const bf16*)(ws + WS_QKV); bf16* mix = (bf16*)(ws + WS_MIX); bf16* kcmp = (bf16*)(ws + WS_KCMP); bf16* vcmp = (bf16*)(ws + WS_VCMP);
    int* sel = (int*)(ws + 344 * MiB); float* obuf = (float*)(ws + 348 * MiB); const float* gates = (const float*)(ws + WS_GATES);
    nq::k_compress<<<dim3(4 * 2 * 512, 2), 256, 0, stream>>>(qkv, a.in[13], a.in[14], a.in[15], a.in[16], a.in[17], a.in[18], a.in[10], kcmp, vcmp);
    nq::k_moba<<<4 * 8 * SEQ / 4, 256, 0, stream>>>(qkv, (const float*)(ws + WS_KMP), a.in[2], mix);
    nq::k_nsa_cmp<<<4 * 2 * SEQ, 256, 0, stream>>>(qkv, kcmp, vcmp, gates, obuf, sel);
    nq::k_nsa_sel<<<4 * 2 * SEQ, 256, 0, stream>>>(qkv, sel, a.in[2], gates, obuf);
    nq::k_nsa_win<<<4 * 2 * SEQ, 256, 0, stream>>>(qkv, a.in[2], gates, obuf, mix);
    launch_phases(a, 5, 6, grid, stream); launch_phases(a, 6, 7, grid, stream); launch_phases(a, 7, 8, grid, stream); launch_phases(a, 8, 9, grid, stream);
#elif HYBRID == 2
    launch_phases(a, 0, 1, grid, stream); launch_phases(a, 1, 2, grid, stream); launch_phases(a, 2, 3, grid, stream);
    nq::k_compress<<<dim3(4 * 2 * 512, 2), 256, 0, stream>>>((const bf16*)(ws + WS_QKV), a.in[13], a.in[14], a.in[15], a.in[16], a.in[17], a.in[18], a.in[10], (bf16*)(ws + WS_KCMP), (bf16*)(ws + WS_VCMP));
    launch_phases(a, 4, 5, grid, stream);
    launch_phases(a, 5, 6, grid, stream); launch_phases(a, 6, 7, grid, stream); launch_phases(a, 7, 8, grid, stream); launch_phases(a, 8, 9, grid, stream);
#elif HYBRID == 3
    for (int p = 0; p < N_PHASES; ++p) {
#if defined(TIME_PHASE)
        if (p == TIME_PHASE) { for (int r = 0; r < TIME_REPS; ++r) { launch_phases(a, p, p + 1, grid, stream, TIME_FLAGS); (void)hipMemsetAsync((char*)d_ws + WS_CTL, 0, CTL_ZERO_BYTES, stream); } }
#endif
        launch_phases(a, p, p + 1, grid, stream);
#if defined(ABL_REPS)
        if (p == 3) { static bool once = false; if (!once) { once = true; (void)hipFuncSetAttribute((const void*)k_attn_abl, hipFuncAttributeMaxDynamicSharedMemorySize, LDS_BYTES); }
            for (int r = 0; r < ABL_REPS; ++r) { (void)hipMemsetAsync((char*)d_ws + WS_CTL + 512, 0, 4, stream); hipLaunchKernelGGL(k_attn_abl, dim3(grid), dim3(NTHREADS), LDS_BYTES, stream, a); } }
#endif
    }
#else
    launch_phases(a, 0, N_PHASES, grid, stream);
#endif
}
```

```cpp
#include <hip/hip_runtime.h>
#include <hip/hip_cooperative_groups.h>
#include <cstdint>
#include <cstdio>
namespace cg = cooperative_groups;
#define HYBRID 0
namespace pg8 {
#define PG8_LAS __attribute__((address_space(3)))
typedef unsigned short bf16_t;
typedef short bf16x8 __attribute__((ext_vector_type(8)));
typedef float f32x4 __attribute__((ext_vector_type(4)));
typedef unsigned u32x4 __attribute__((ext_vector_type(4)));
constexpr int BM = 256, BK = 64, HALF = 128, HTB = HALF * BK * 2  , STAGE_BYTES = 8 * HTB, NXCD = 8, WGM = 6;

__host__ __device__ __forceinline__ int lds_byte(int r, int c) { const int st = (r >> 4) * 2 + (c >> 5), rr = r & 15, cc = c & 31, ob = rr * 64 + cc * 2; return st * 1024 + (ob ^ (((ob >> 9) & 1) << 5)); }
__host__ __device__ __forceinline__ void stage_rc(int b, int& R, int& C) { const int st = b / 1024, sb = b % 1024, swz = sb ^ (((sb >> 9) & 1) << 5); R = (st >> 1) * 16 + swz / 64; C = (st & 1) * 32 + (swz % 64) / 2; }
__host__ __device__ __forceinline__ int perm32(int rho) { const int n = rho >> 4, i = rho & 15; return 8 * (i >> 2) + 4 * n + (i & 3); }

struct Unit { int pm, pn; };
struct Gemm { const bf16_t* A; const bf16_t* Bt; int M, N, K; };

struct StaticOrder {
    int nM, nN, nwg, G, c;
    __host__ __device__ void init(int M, int N, int G_, int c_) { nM = M / BM; nN = N / BM; nwg = nM * nN; G = G_; c = c_; }
    __host__ __device__ bool next(int i, Unit& u) const {
        const long L = (long)i * G + c; if (L >= nwg) return false;
        int wgid = (int)L; { const int q = nwg / NXCD, r = nwg % NXCD, xcd = wgid % NXCD, off = wgid / NXCD; wgid = (xcd < r ? xcd * (q + 1) : r * (q + 1) + (xcd - r) * q) + off; }
        const int nig = WGM * nN, gid = wgid / nig, fm = gid * WGM, gsz = (nM - fm) < WGM ? (nM - fm) : WGM;
        u.pm = fm + ((wgid % nig) % gsz); u.pn = (wgid % nig) / gsz; return true;
    }
    __device__ __forceinline__ void a_ready(const Unit&) const {}
    __device__ __forceinline__ void done(const Unit&) const {}
};

__device__ __forceinline__ unsigned cvt_pk_bf16(float lo, float hi) { unsigned r; asm volatile("v_cvt_pk_bf16_f32 %0, %1, %2" : "=v"(r) : "v"(lo), "v"(hi)); return r; }
typedef float f32x2 __attribute__((ext_vector_type(2)));
template <class Epi, class Sched, bool ALIGN_EPI = false, bool SP2 = false>
__device__ __forceinline__ void gemm_phase(PG8_LAS unsigned char* lds, const Gemm g, const Sched& S, const Epi& E) {
    const int tid = threadIdx.x, wid = __builtin_amdgcn_readfirstlane(tid >> 6), lane = tid & 63, wr = wid >> 2, wc = wid & 3, fr = lane & 15, fq = lane >> 4;
    const int K = g.K, nt = K / BK;
    unsigned voffA[2], voffB[2];
#pragma unroll
    for (int i = 0; i < 2; ++i) { int R, C; stage_rc(tid * 16 + i * 8192, R, C); const int Rb = Epi::PERM ? ((R & ~31) + perm32(R & 31)) : R;
        voffA[i] = (unsigned)(R * K + C) * 2u; voffB[i] = (unsigned)(Rb * K + C) * 2u; }
    const size_t kstep = (size_t)(BK * 2);
    const size_t hstep = (size_t)HALF * K * 2;
    const size_t tstep = 2 * hstep;
    const unsigned ldsw = (unsigned)wid * 1024u;
    const int aoff = lds_byte(wr * 64 + fr, fq * 8), boff = lds_byte(wc * 32 + fr, fq * 8);
#define PG8_SA(b, h) (((b) * 2 + (h)) * HTB)
#define PG8_SB(b, h) ((4 + (b) * 2 + (h)) * HTB)
#define PG8_STAGE(bufoff, gbase, voff) do { _Pragma("unroll") for (int _i = 0; _i < 2; ++_i) \
        __builtin_amdgcn_global_load_lds((const unsigned*)((const char*)(gbase) + (voff)[_i]), (PG8_LAS unsigned*)(lds + (bufoff) + ldsw + _i * 8192), 16, 0, 0); } while (0)
#define PG8_LDA(dst, b, h) do { _Pragma("unroll") for (int m = 0; m < 4; ++m) _Pragma("unroll") for (int k = 0; k < 2; ++k) dst[m][k] = *(const PG8_LAS bf16x8*)(lds + PG8_SA(b, h) + aoff + m * 2048 + k * 1024); } while (0)
#define PG8_LDB(dst, b, h) do { _Pragma("unroll") for (int n = 0; n < 2; ++n) _Pragma("unroll") for (int k = 0; k < 2; ++k) dst[n][k] = *(const PG8_LAS bf16x8*)(lds + PG8_SB(b, h) + boff + n * 2048 + k * 1024); } while (0)
#define PG8_MMA(ai, bj, At, Bt) do { __builtin_amdgcn_s_setprio(1); _Pragma("unroll") for (int m = 0; m < 4; ++m) _Pragma("unroll") for (int n = 0; n < 2; ++n) _Pragma("unroll") for (int k = 0; k < 2; ++k) \
        acc[ai][bj][m][n] = __builtin_amdgcn_mfma_f32_16x16x32_bf16(Bt[n][k], At[m][k], acc[ai][bj][m][n], 0, 0, 0); __builtin_amdgcn_s_setprio(0); } while (0)
#define PG8_WAIT_V(n) asm volatile("s_waitcnt vmcnt(" #n ")" ::: "memory")
#define PG8_WAIT_L(n) asm volatile("s_waitcnt lgkmcnt(" #n ")" ::: "memory")
#define PG8_BAR __builtin_amdgcn_s_barrier()
#define PG8_SCHED __builtin_amdgcn_sched_barrier(0)
    Unit cur, nxt; int ui = 0;
    if (!S.next(0, cur)) return;
    f32x4 acc[2][2][4][2];
#pragma unroll
    for (int a = 0; a < 2; ++a)
#pragma unroll
        for (int b = 0; b < 2; ++b)
#pragma unroll
            for (int m = 0; m < 4; ++m)
#pragma unroll
                for (int n = 0; n < 2; ++n) acc[a][b][m][n] = (f32x4){0.f, 0.f, 0.f, 0.f};
    bf16x8 At[4][2], B0[2][2], B1[2][2];
    const char* cA = (const char*)g.A + (size_t)cur.pm * tstep; const char* cB = (const char*)g.Bt + (size_t)cur.pn * tstep;
    S.a_ready(cur);
    if constexpr (SP2) {
        PG8_STAGE(PG8_SB(0, 0), cB, voffB); PG8_STAGE(PG8_SB(0, 1), cB + hstep, voffB); PG8_STAGE(PG8_SA(0, 0), cA, voffA); PG8_STAGE(PG8_SA(0, 1), cA + hstep, voffA);
        if (wr == 1) PG8_BAR;
        PG8_WAIT_V(2); PG8_BAR;
        PG8_STAGE(PG8_SB(1, 0), cB + kstep, voffB); PG8_STAGE(PG8_SA(1, 0), cA + kstep, voffA); PG8_STAGE(PG8_SB(1, 1), cB + hstep + kstep, voffB);
        PG8_WAIT_V(6); PG8_BAR;
    } else {
        PG8_STAGE(PG8_SB(0, 0), cB, voffB); PG8_STAGE(PG8_SA(0, 0), cA, voffA); PG8_STAGE(PG8_SB(0, 1), cB + hstep, voffB); PG8_STAGE(PG8_SA(0, 1), cA + hstep, voffA);
        if (wr == 1) PG8_BAR;
        PG8_WAIT_V(4); PG8_BAR;
        PG8_STAGE(PG8_SB(1, 0), cB + kstep, voffB); PG8_STAGE(PG8_SA(1, 0), cA + kstep, voffA); PG8_STAGE(PG8_SB(1, 1), cB + hstep + kstep, voffB);
        PG8_WAIT_V(6); PG8_BAR;
    }
    for (;;) {
        const bool has_next = S.next(ui + 1, nxt);
        const char* nA = has_next ? (const char*)g.A + (size_t)nxt.pm * tstep : cA; const char* nB = has_next ? (const char*)g.Bt + (size_t)nxt.pn * tstep : cB;
        for (int t = 0; t < nt; t += 2) {
            const bool last = (t == nt - 2);
            const char* a1 = cA + (size_t)(t + 1) * kstep;
            const char* a2 = last ? nA : cA + (size_t)(t + 2) * kstep; const char* b2 = last ? nB : cB + (size_t)(t + 2) * kstep;
            const char* a3 = a2 + kstep; const char* b3 = b2 + kstep;
            if (last && has_next) S.a_ready(nxt);
            if constexpr (SP2) {
            PG8_LDB(B0, 0, 0); PG8_LDB(B1, 0, 1); PG8_SCHED; PG8_LDA(At, 0, 0); PG8_STAGE(PG8_SA(1, 1), a1 + hstep, voffA);
            PG8_WAIT_V(8); PG8_WAIT_L(0); PG8_BAR; PG8_MMA(0, 0, At, B0); PG8_MMA(0, 1, At, B1); PG8_BAR; PG8_SCHED;
            PG8_LDA(At, 0, 1); PG8_STAGE(PG8_SB(0, 0), b2, voffB); PG8_STAGE(PG8_SB(0, 1), b2 + hstep, voffB); PG8_STAGE(PG8_SA(0, 0), a2, voffA);
            PG8_WAIT_V(8); PG8_WAIT_L(0); PG8_BAR; PG8_MMA(1, 0, At, B0); PG8_MMA(1, 1, At, B1); PG8_BAR; PG8_SCHED;
            PG8_LDB(B0, 1, 0); PG8_LDB(B1, 1, 1); PG8_SCHED; PG8_LDA(At, 1, 0); PG8_STAGE(PG8_SA(0, 1), a2 + hstep, voffA);
            PG8_WAIT_V(8); PG8_WAIT_L(0); PG8_BAR; PG8_MMA(0, 0, At, B0); PG8_MMA(0, 1, At, B1); PG8_BAR; PG8_SCHED;
            PG8_LDA(At, 1, 1); PG8_STAGE(PG8_SB(1, 0), b3, voffB); PG8_STAGE(PG8_SB(1, 1), b3 + hstep, voffB); PG8_STAGE(PG8_SA(1, 0), a3, voffA);
            PG8_WAIT_V(8); PG8_WAIT_L(0); PG8_BAR; PG8_MMA(1, 0, At, B0); PG8_MMA(1, 1, At, B1); PG8_BAR; PG8_SCHED;
            } else {
            PG8_LDB(B0, 0, 0); PG8_SCHED; PG8_LDA(At, 0, 0); PG8_STAGE(PG8_SA(1, 1), a1 + hstep, voffA);
            PG8_WAIT_L(8); PG8_BAR; PG8_WAIT_L(0); PG8_MMA(0, 0, At, B0); PG8_BAR; PG8_SCHED;
            PG8_LDB(B1, 0, 1); PG8_STAGE(PG8_SB(0, 0), b2, voffB);
            PG8_BAR; PG8_WAIT_L(0); PG8_MMA(0, 1, At, B1); PG8_BAR;
            PG8_LDA(At, 0, 1); PG8_STAGE(PG8_SA(0, 0), a2, voffA);
            PG8_BAR; PG8_WAIT_L(0); PG8_MMA(1, 0, At, B0); PG8_BAR; PG8_SCHED;
            PG8_STAGE(PG8_SB(0, 1), b2 + hstep, voffB);
            PG8_WAIT_V(6); PG8_BAR; PG8_MMA(1, 1, At, B1); PG8_BAR;
            PG8_LDB(B0, 1, 0); PG8_SCHED; PG8_LDA(At, 1, 0); PG8_STAGE(PG8_SA(0, 1), a2 + hstep, voffA);
            PG8_WAIT_L(8); PG8_BAR; PG8_WAIT_L(0); PG8_MMA(0, 0, At, B0); PG8_BAR; PG8_SCHED;
            PG8_LDB(B1, 1, 1); PG8_STAGE(PG8_SB(1, 0), b3, voffB);
            PG8_BAR; PG8_WAIT_L(0); PG8_MMA(0, 1, At, B1); PG8_BAR;
            PG8_LDA(At, 1, 1); PG8_STAGE(PG8_SA(1, 0), a3, voffA);
            PG8_BAR; PG8_WAIT_L(0); PG8_MMA(1, 0, At, B0); PG8_BAR; PG8_SCHED;
            PG8_STAGE(PG8_SB(1, 1), b3 + hstep, voffB);
            PG8_WAIT_V(6); PG8_BAR; PG8_MMA(1, 1, At, B1); PG8_BAR;
            }
        }
        if constexpr (ALIGN_EPI) { if (wr == 0) PG8_BAR; }
        if constexpr (!Epi::AFTER_DRAIN) { E(acc, cur, wr, wc, fr, fq); S.done(cur); }
        if (!has_next) break;
#pragma unroll
        for (int a = 0; a < 2; ++a)
#pragma unroll
            for (int b = 0; b < 2; ++b)
#pragma unroll
                for (int m = 0; m < 4; ++m)
#pragma unroll
                    for (int n = 0; n < 2; ++n) acc[a][b][m][n] = (f32x4){0.f, 0.f, 0.f, 0.f};
        cur = nxt; cA = nA; cB = nB; ++ui;
        if constexpr (ALIGN_EPI) { if (wr == 1) PG8_BAR; }
    }
    PG8_WAIT_V(0);
    if constexpr (!ALIGN_EPI) { if (wr == 0) PG8_BAR; }
    PG8_BAR;
    if constexpr (Epi::AFTER_DRAIN) { E.fused(acc, cur, wr, wc, fr, fq, lds, wid, lane); S.done(cur); }
#undef PG8_SA
#undef PG8_SB
#undef PG8_STAGE
#undef PG8_LDA
#undef PG8_LDB
#undef PG8_MMA
#undef PG8_WAIT_V
#undef PG8_WAIT_L
#undef PG8_BAR
#undef PG8_SCHED
}
}
namespace pg8 {
typedef unsigned u32x2v __attribute__((ext_vector_type(2)));
constexpr int TOK_S = 8192;
constexpr float QK_EPS = 1e-6f;
constexpr float C2 = 0.125f * 1.4426950408889634f;
__device__ __forceinline__ float sigmoid_fast(float v) { return __builtin_amdgcn_rcpf(1.f + __builtin_amdgcn_exp2f(-1.4426950408889634f * v)); }
__device__ __forceinline__ float silu_fast(float v) { return v * __builtin_amdgcn_rcpf(1.f + __builtin_amdgcn_exp2f(-1.4426950408889634f * v)); }

struct EpiInProj {
    static constexpr bool PERM = true, AFTER_DRAIN = false;
    bf16_t* qkv;
    float* gates;
    float* kmean_part;
    const __attribute__((address_space(3))) float* gl;
    __device__ __forceinline__ void operator()(const f32x4 (&acc)[2][2][4][2], const Unit& u, int wr, int wc, int fr, int fq) const {
        const int slot = u.pn * 4 + wc;
        if (slot > 44) return;
        const int b = u.pm >> 5, blk = u.pm & 31, pos0 = blk * 256 + wr * 64 + fr;
        if (slot == 44) {
            if (fq < 3) {
#pragma unroll
                for (int ai = 0; ai < 2; ++ai)
#pragma unroll
                    for (int m = 0; m < 4; ++m) { const size_t tok = (size_t)b * TOK_S + pos0 + ai * HALF + m * 16; float* gp = gates + tok * 24 + 8 * fq;
                        const f32x4 v0 = acc[ai][0][m][0], v1 = acc[ai][0][m][1];
                        *(f32x4*)gp = (f32x4){sigmoid_fast(v0[0]), sigmoid_fast(v0[1]), sigmoid_fast(v0[2]), sigmoid_fast(v0[3])};
                        *(f32x4*)(gp + 4) = (f32x4){sigmoid_fast(v1[0]), sigmoid_fast(v1[1]), sigmoid_fast(v1[2]), sigmoid_fast(v1[3])}; }
            }
            return;
        }
        int gi = -1; bool is_ka = false; bf16_t* dst;
        constexpr size_t BIG = (size_t)4 * 8 * TOK_S * 64, SMALL = (size_t)4 * 2 * TOK_S * 64;
        if (slot < 32) { const int kind = slot >> 3, head = slot & 7; dst = qkv + kind * BIG + ((size_t)(b * 8 + head) * TOK_S) * 64;
            if (kind == 0) gi = 0; else if (kind == 1) { gi = 1; is_ka = true; } else if (kind == 3) gi = 2; }
        else { const int kind = (slot - 32) >> 1, g = slot & 1; dst = qkv + 4 * BIG + kind * SMALL + ((size_t)(b * 2 + g) * TOK_S) * 64;
            if (kind == 2) gi = 3; else if (kind == 4) gi = 4; }
        float gv[16];
#pragma unroll
        for (int i = 0; i < 16; ++i) gv[i] = gi >= 0 ? gl[gi * 64 + (i >> 3) * 32 + 8 * fq + (i & 7)] : 1.f;
        const bool gain = gi >= 0;
        float cs[16];
#pragma unroll
        for (int i = 0; i < 16; ++i) cs[i] = 0.f;
#pragma unroll
        for (int ai = 0; ai < 2; ++ai)
#pragma unroll
            for (int m = 0; m < 4; ++m) {
                float v[16];
#pragma unroll
                for (int bj = 0; bj < 2; ++bj)
#pragma unroll
                    for (int n = 0; n < 2; ++n)
#pragma unroll
                        for (int j = 0; j < 4; ++j) v[bj * 8 + n * 4 + j] = acc[ai][bj][m][n][j];
                if (gain) { float ss = 0.f;
#pragma unroll
                    for (int i = 0; i < 16; ++i) ss += v[i] * v[i];
                    ss += __shfl_xor(ss, 16); ss += __shfl_xor(ss, 32);
                    const float rs = rsqrtf(ss * (1.f / 64.f) + QK_EPS);
#pragma unroll
                    for (int i = 0; i < 16; ++i) v[i] *= rs * gv[i]; }
                if (is_ka) {
#pragma unroll
                    for (int i = 0; i < 16; ++i) cs[i] += v[i]; }
                bf16_t* rp = dst + (size_t)(pos0 + ai * HALF + m * 16) * 64 + 8 * fq;
                u32x4 w0, w1;
                w0.x = cvt_pk_bf16(v[0], v[1]); w0.y = cvt_pk_bf16(v[2], v[3]); w0.z = cvt_pk_bf16(v[4], v[5]); w0.w = cvt_pk_bf16(v[6], v[7]);
                w1.x = cvt_pk_bf16(v[8], v[9]); w1.y = cvt_pk_bf16(v[10], v[11]); w1.z = cvt_pk_bf16(v[12], v[13]); w1.w = cvt_pk_bf16(v[14], v[15]);
                *(u32x4*)rp = w0; *(u32x4*)(rp + 32) = w1;
            }
        if (is_ka) {
#pragma unroll
            for (int i = 0; i < 16; ++i) { float s = cs[i];
                s += __builtin_bit_cast(float, __builtin_amdgcn_update_dpp(0, __builtin_bit_cast(int, s), 0xB1, 0xF, 0xF, true)); s += __builtin_bit_cast(float, __builtin_amdgcn_update_dpp(0, __builtin_bit_cast(int, s), 0x4E, 0xF, 0xF, true));
                s += __builtin_bit_cast(float, __builtin_amdgcn_update_dpp(0, __builtin_bit_cast(int, s), 0x141, 0xF, 0xF, true)); s += __builtin_bit_cast(float, __builtin_amdgcn_update_dpp(0, __builtin_bit_cast(int, s), 0x140, 0xF, 0xF, true)); cs[i] = s; }
            if (fr == 0) { float* kp = kmean_part + ((size_t)((b * 8 + (slot & 7)) * 32 + blk) * 2 + wr) * 64 + 8 * fq;
                *(f32x4*)kp = (f32x4){cs[0], cs[1], cs[2], cs[3]}; *(f32x4*)(kp + 4) = (f32x4){cs[4], cs[5], cs[6], cs[7]};
                *(f32x4*)(kp + 32) = (f32x4){cs[8], cs[9], cs[10], cs[11]}; *(f32x4*)(kp + 36) = (f32x4){cs[12], cs[13], cs[14], cs[15]}; }
        }
    }
};
struct EpiOutProj {
    static constexpr bool PERM = true, AFTER_DRAIN = false;
    const float* x; bf16_t* x1; const float* gt;
    __device__ __forceinline__ void operator()(const f32x4 (&acc)[2][2][4][2], const Unit& u, int wr, int wc, int fr, int fq) const {
        const int b = u.pm >> 5; const int col0 = u.pn * BM + wc * 32 + 8 * fq; const float* gtb = gt + (size_t)b * 6144;
#pragma unroll
        for (int bj = 0; bj < 2; ++bj) { const int c = col0 + bj * HALF; const f32x4 g40 = *(const f32x4*)(gtb + c), g41 = *(const f32x4*)(gtb + c + 4);
#pragma unroll
            for (int ai = 0; ai < 2; ++ai) {
                f32x4 x0[4], x1v[4];
#pragma unroll
                for (int m = 0; m < 4; ++m) { const size_t off = (size_t)(u.pm * BM + ai * HALF + wr * 64 + m * 16 + fr) * 1024 + c; x0[m] = __builtin_nontemporal_load((const f32x4*)(x + off)); x1v[m] = __builtin_nontemporal_load((const f32x4*)(x + off + 4)); }
#pragma unroll
                for (int m = 0; m < 4; ++m) { const size_t off = (size_t)(u.pm * BM + ai * HALF + wr * 64 + m * 16 + fr) * 1024 + c;
                    const f32x4 y0 = x0[m] + g40 * acc[ai][bj][m][0], y1 = x1v[m] + g41 * acc[ai][bj][m][1];
                    u32x4 w; w.x = cvt_pk_bf16(y0[0], y0[1]); w.y = cvt_pk_bf16(y0[2], y0[3]); w.z = cvt_pk_bf16(y1[0], y1[1]); w.w = cvt_pk_bf16(y1[2], y1[3]);
                    *(u32x4*)(x1 + off) = w; } } }
    }
};
__device__ __forceinline__ float gated(float g, float u) { return (g * u) * __builtin_amdgcn_rcpf(1.f + __builtin_amdgcn_exp2f(g)); }
struct EpiGateUp {
    static constexpr bool PERM = true, AFTER_DRAIN = false;
    bf16_t* act;
    __device__ __forceinline__ void operator()(const f32x4 (&acc)[2][2][4][2], const Unit& u, int wr, int wc, int fr, int fq) const {
        const int h0 = u.pn * 128 + wc * 32 + 8 * fq;
#pragma unroll
        for (int ai = 0; ai < 2; ++ai)
#pragma unroll
            for (int m = 0; m < 4; ++m) { const size_t row = (size_t)(u.pm * BM + ai * HALF + wr * 64 + m * 16 + fr);
                const f32x4 g0 = acc[ai][0][m][0], g1 = acc[ai][0][m][1], u0 = acc[ai][1][m][0], u1 = acc[ai][1][m][1];
                u32x4 w;
                w.x = cvt_pk_bf16(gated(g0[0], u0[0]), gated(g0[1], u0[1])); w.y = cvt_pk_bf16(gated(g0[2], u0[2]), gated(g0[3], u0[3]));
                w.z = cvt_pk_bf16(gated(g1[0], u1[0]), gated(g1[1], u1[1])); w.w = cvt_pk_bf16(gated(g1[2], u1[2]), gated(g1[3], u1[3]));
                *(u32x4*)(act + row * 2816 + h0) = w; }
    }
};
struct EpiDown {
    static constexpr bool PERM = true, AFTER_DRAIN = false;
    const bf16_t* x1; float* out; const float* gt;
    __device__ __forceinline__ void operator()(const f32x4 (&acc)[2][2][4][2], const Unit& u, int wr, int wc, int fr, int fq) const {
        const int b = u.pm >> 5; const int col0 = u.pn * BM + wc * 32 + 8 * fq; const float* gtb = gt + (size_t)b * 6144;
#pragma unroll
        for (int bj = 0; bj < 2; ++bj) { const int c = col0 + bj * HALF; const f32x4 g40 = *(const f32x4*)(gtb + c), g41 = *(const f32x4*)(gtb + c + 4);
            u32x4 xw[8];
#pragma unroll
            for (int i = 0; i < 8; ++i) xw[i] = __builtin_nontemporal_load((const u32x4*)(x1 + (size_t)(u.pm * BM + (i >> 2) * HALF + wr * 64 + (i & 3) * 16 + fr) * 1024 + c));
#pragma unroll
            for (int i = 0; i < 8; ++i) { const int ai = i >> 2, m = i & 3; const size_t off = (size_t)(u.pm * BM + ai * HALF + wr * 64 + m * 16 + fr) * 1024 + c;
                const f32x4 y0 = {__builtin_bit_cast(float, xw[i].x << 16), __builtin_bit_cast(float, xw[i].x & 0xffff0000u), __builtin_bit_cast(float, xw[i].y << 16), __builtin_bit_cast(float, xw[i].y & 0xffff0000u)};
                const f32x4 y1 = {__builtin_bit_cast(float, xw[i].z << 16), __builtin_bit_cast(float, xw[i].z & 0xffff0000u), __builtin_bit_cast(float, xw[i].w << 16), __builtin_bit_cast(float, xw[i].w & 0xffff0000u)};
                *(f32x4*)(out + off) = y0 + g40 * acc[ai][bj][m][0]; *(f32x4*)(out + off + 4) = y1 + g41 * acc[ai][bj][m][1]; } }
    }
};
}
constexpr int NWAVES = 8, NTHREADS = 512;
constexpr int BATCH = 4, SEQ = 8192, DM = 1024, TOK = BATCH * SEQ, NIN = 2840, NIN_PAD = 3072, FF = 2816, NCMP = 511;
constexpr size_t MiB = 1u << 20;
constexpr size_t WS_CTL = 0, CTL_ZERO_BYTES = 64 * 1024;
constexpr size_t WS_MODP = 1 * MiB;
constexpr size_t WS_MOD = 2 * MiB;
constexpr size_t WS_CBP = 2 * MiB + 512 * 1024;
constexpr size_t WS_KMP = 3 * MiB;
constexpr size_t WS_WIN = 6 * MiB, WS_WOUT = 12 * MiB, WS_WGU = 14 * MiB, WS_WDN = 25 * MiB;
constexpr size_t WS_W1K = 31 * MiB, WS_W1V = 32 * MiB, WS_W2K = 33 * MiB, WS_W2V = 33 * MiB + 64 * 1024;
constexpr size_t WS_KCMP = 34 * MiB, WS_VCMP = 35 * MiB;
constexpr size_t WS_GATES = 36 * MiB;
constexpr size_t WS_H = 40 * MiB;
constexpr size_t WS_MIX = 104 * MiB;
constexpr size_t WS_QKV = 168 * MiB;
constexpr size_t WS_ACT = WS_QKV;
constexpr size_t WS_END = 344 * MiB;
constexpr size_t WS_PARTO = 344 * MiB;
constexpr size_t WS_PARTL = 472 * MiB;
constexpr size_t WS_SELG = 476 * MiB;
constexpr size_t WS_Y = WS_PARTO;
constexpr size_t QKV_BIG = (size_t)4 * 8 * SEQ * 64, QKV_SMALL = (size_t)4 * 2 * SEQ * 64;
constexpr int RING_BYTES = 131072, LDS_BYTES = 147456;
constexpr int N_PHASES = 10;

#define GAS __attribute__((address_space(1)))
#define LAS __attribute__((address_space(3)))
typedef unsigned short bf16;
typedef unsigned v4u __attribute__((ext_vector_type(4)));
typedef float f32x4 __attribute__((ext_vector_type(4)));
#define LDS_WAIT() asm volatile("s_waitcnt lgkmcnt(0)" ::: "memory")
#define VM_WAIT() asm volatile("s_waitcnt vmcnt(0)" ::: "memory")
__device__ __forceinline__ unsigned f2bf(float f) { unsigned u = __builtin_bit_cast(unsigned, f); return (u + 0x7fffu + ((u >> 16) & 1u)) >> 16; }
__device__ __forceinline__ unsigned pk2(float lo, float hi) { return f2bf(lo) | (f2bf(hi) << 16); }
__device__ __forceinline__ float bf2f(bf16 v) { return __builtin_bit_cast(float, (unsigned)v << 16); }
__device__ __forceinline__ float wave_sum(float v) {
#pragma unroll
    for (int o = 1; o < 64; o <<= 1) v += __shfl_xor(v, o);
    return v;
}
struct Args { const float* in[23]; float* out; unsigned char* ws; int ph_lo, ph_hi; };
struct Frame { LAS unsigned char* lds; int tid, lane, wave, vcu, G; };

struct MapId { __device__ __forceinline__ size_t off(int n, int k, int K) const { return (size_t)n * K + k; } __device__ __forceinline__ float scale(int) const { return 1.f; } };
struct MapWin { __device__ __forceinline__ size_t off(int n, int k, int K) const { const int s = n >> 6, d = n & 63; return (size_t)(256 * (s >> 2) + 128 * (d >> 5) + 32 * (s & 3) + (d & 31)) * K + k; } __device__ __forceinline__ float scale(int) const { return 1.f; } };
struct MapWgu { __device__ __forceinline__ size_t off(int n, int k, int K) const { const int up = n >= FF, hdn = up ? n - FF : n; return (size_t)(256 * (hdn >> 7) + 128 * up + (hdn & 127)) * K + k; }
    __device__ __forceinline__ float scale(int n0) const { return n0 >= FF ? -0.6931471805599453f : -1.4426950408889634f; } };
struct MapFrag { __device__ __forceinline__ size_t off(int n, int k, int K) const { return ((size_t)((k >> 4) * 8 + (n >> 5)) * 64 + ((k >> 3) & 1) * 32 + (n & 31)) * 8 + (k & 7); } __device__ __forceinline__ float scale(int) const { return 1.f; } };
__device__ __forceinline__ void transpose_load(const float* __restrict__ W, int N, int item, int lane, f32x4 (&v)[16]) {
    const int nblk = (N + 63) / 64, kb = item / nblk, nb = item % nblk, k0 = 64 * kb, n0 = 64 * nb;
    const int nc = n0 + 4 * (lane & 15); const bool nin = nc < N;
#pragma unroll
    for (int i = 0; i < 16; ++i) { const int kk = 4 * i + (lane >> 4); v[i] = nin ? __builtin_nontemporal_load((const GAS f32x4*)(W + (size_t)(k0 + kk) * N + nc)) : (f32x4){0.f, 0.f, 0.f, 0.f}; }
}
template <class Map>
__device__ __forceinline__ void transpose_store(const f32x4 (&v)[16], int K, int N, bf16* WT, LAS float* scr, int item, int lane, const Map& map) {
    const int nblk = (N + 63) / 64, kb = item / nblk, nb = item % nblk, k0 = 64 * kb, n0 = 64 * nb;
    const float sc = map.scale(n0);
#pragma unroll
    for (int i = 0; i < 16; ++i) { const int kk = 4 * i + (lane >> 4); LAS float* d = scr + (4 * (lane & 15)) * 68 + kk; d[0] = v[i][0] * sc; d[68] = v[i][1] * sc; d[136] = v[i][2] * sc; d[204] = v[i][3] * sc; }
    LDS_WAIT(); asm volatile("" ::: "memory");
    const int c = lane & 7;
#pragma unroll
    for (int j = 0; j < 8; ++j) { const int n = (lane >> 3) + 8 * j; const LAS float* s = scr + n * 68 + 8 * c;
        const f32x4 a = *(const LAS f32x4*)s, bq = *(const LAS f32x4*)(s + 4);
        v4u o; o.x = pk2(a[0], a[1]); o.y = pk2(a[2], a[3]); o.z = pk2(bq[0], bq[1]); o.w = pk2(bq[2], bq[3]);
        if (n0 + n < N) *(GAS v4u*)(WT + map.off(n0 + n, k0 + 8 * c, K)) = o; }
    LDS_WAIT(); asm volatile("" ::: "memory");
}
__device__ __forceinline__ float silu_acc(float v) { return v / (1.f + expf(-v)); }
__device__ __forceinline__ void phase_prologue_a(Frame& F, const Args& a) {
    LAS float* scr = (LAS float*)(F.lds + F.wave * 17408);
    const int gw = F.vcu * NWAVES + F.wave, NGW = F.G * NWAVES;
    unsigned char* ws = a.ws;
    constexpr int I_IN = (DM / 64) * ((NIN + 63) / 64), I_OUT = (DM / 64) * (DM / 64), I_GU = (DM / 64) * (2 * FF / 64), I_DN = (FF / 64) * (DM / 64), I_W1 = (2048 / 64) * (256 / 64), I_W2 = (256 / 64) * (64 / 64);
    constexpr int NITEMS = I_IN + I_OUT + I_GU + I_DN + 2 * I_W1 + 2 * I_W2;
    auto which = [&](int it, int& r) -> int { r = it;
        if (r < I_IN) return 0; r -= I_IN; if (r < I_OUT) return 1; r -= I_OUT; if (r < I_GU) return 2; r -= I_GU; if (r < I_DN) return 3; r -= I_DN;
        if (r < I_W1) return 4; r -= I_W1; if (r < I_W1) return 5; r -= I_W1; if (r < I_W2) return 6; r -= I_W2; return 7; };
    auto load = [&](int it, f32x4 (&v)[16]) { int r; const int m = which(it, r);
        const float* W = m == 0 ? a.in[6] : m == 1 ? a.in[19] : m == 2 ? a.in[21] : m == 3 ? a.in[22] : m == 4 ? a.in[14] : m == 5 ? a.in[17] : m == 6 ? a.in[15] : a.in[18];
        const int N = m == 0 ? NIN : m == 1 ? DM : m == 2 ? 2 * FF : m == 3 ? DM : m < 6 ? 256 : 64;
        transpose_load(W, N, r, F.lane, v); };
    auto store = [&](int it, const f32x4 (&v)[16]) { int r; const int m = which(it, r);
        if (m == 0) transpose_store(v, DM, NIN, (bf16*)(ws + WS_WIN), scr, r, F.lane, MapWin());
        else if (m == 1) transpose_store(v, DM, DM, (bf16*)(ws + WS_WOUT), scr, r, F.lane, MapId());
        else if (m == 2) transpose_store(v, DM, 2 * FF, (bf16*)(ws + WS_WGU), scr, r, F.lane, MapWgu());
        else if (m == 3) transpose_store(v, FF, DM, (bf16*)(ws + WS_WDN), scr, r, F.lane, MapId());
        else if (m == 4) transpose_store(v, 2048, 256, (bf16*)(ws + WS_W1K), scr, r, F.lane, MapFrag());
        else if (m == 5) transpose_store(v, 2048, 256, (bf16*)(ws + WS_W1V), scr, r, F.lane, MapFrag());
        else if (m == 6) transpose_store(v, 256, 64, (bf16*)(ws + WS_W2K), scr, r, F.lane, MapId());
        else transpose_store(v, 256, 64, (bf16*)(ws + WS_W2V), scr, r, F.lane, MapId()); };
    { f32x4 va[16], vb[16];
      if (gw < NITEMS) load(gw, va);
      for (int it = gw; it < NITEMS; it += 2 * NGW) {
          if (it + NGW < NITEMS) load(it + NGW, vb);
          store(it, va);
          if (it + 2 * NGW < NITEMS) load(it + 2 * NGW, va);
          if (it + NGW < NITEMS) store(it + NGW, vb); } }
    const float* c = a.in[1]; const float* w_ada = a.in[3]; float* modp = (float*)(ws + WS_MODP);
    for (int t = NGW - 1 - gw; t < 96 * 8; t += NGW) { const int cg_ = t % 96, ks = t / 96; const int n = cg_ * 64 + F.lane;
        float acc0 = 0.f, acc1 = 0.f, acc2 = 0.f, acc3 = 0.f;
#pragma unroll
        for (int i = 0; i < 8; ++i) { const int idx = F.lane + 64 * i, bb = idx >> 7, kk = idx & 127; scr[kk * 4 + bb] = silu_acc(c[bb * DM + ks * 128 + kk]); }
        LDS_WAIT(); asm volatile("" ::: "memory");
#pragma unroll 32
        for (int k = 0; k < 128; ++k) { const float w = __builtin_nontemporal_load(w_ada + (size_t)(ks * 128 + k) * 6144 + n); const f32x4 sv = *(const LAS f32x4*)(scr + 4 * k);
            acc0 += sv[0] * w; acc1 += sv[1] * w; acc2 += sv[2] * w; acc3 += sv[3] * w; }
        LDS_WAIT(); asm volatile("" ::: "memory");
        float* o = modp + (size_t)ks * 4 * 6144 + n; o[0] = acc0; o[6144] = acc1; o[2 * 6144] = acc2; o[3 * 6144] = acc3; }
    float* cbp = (float*)(ws + WS_CBP);
    for (int t = NGW / 2 - 1 - gw; t >= 0 && t < 256; t += NGW) { const int kv = t & 1, cg_ = (t >> 1) & 3, ic = t >> 3; const int n = cg_ * 64 + F.lane;
        const float* pe = kv ? a.in[16] : a.in[13]; const float* w1 = kv ? a.in[17] : a.in[14]; float acc = 0.f;
#pragma unroll 32
        for (int i = ic * 64; i < ic * 64 + 64; ++i) acc += pe[i] * w1[(size_t)i * 256 + n];
        cbp[(ic * 2 + kv) * 256 + n] = acc; }
}
template <bool BF>
__device__ __forceinline__ void norm_load4(Frame& F, int row0, const void* in, f32x4 (&v)[4][4], unsigned long long (&yw)[4][4]) {
#pragma unroll
    for (int r = 0; r < 4; ++r) { const int row = row0 + r;
        if (!BF) { const GAS f32x4* xr = (const GAS f32x4*)((const float*)in + (size_t)row * DM) + F.lane;
#pragma unroll
            for (int j = 0; j < 4; ++j) v[r][j] = __builtin_nontemporal_load(xr + 64 * j); }
        else { const GAS unsigned long long* yr = (const GAS unsigned long long*)((const bf16*)in + (size_t)row * DM) + F.lane;
#pragma unroll
            for (int j = 0; j < 4; ++j) yw[r][j] = __builtin_nontemporal_load(yr + 64 * j); } }
}
template <bool BF>
__device__ __forceinline__ void norm_rows(Frame& F, int blk, const void* in, const f32x4 (&gs)[4], const f32x4 (&sh)[4], bf16* out) {
    const int rowb = blk * 128 + F.wave * 16;
    f32x4 vn[4][4]; unsigned long long yn[4][4];
    norm_load4<BF>(F, rowb, in, vn, yn);
    for (int i0 = 0; i0 < 16; i0 += 4) {
        f32x4 v[4][4]; float ss[4];
#pragma unroll
        for (int r = 0; r < 4; ++r)
#pragma unroll
            for (int j = 0; j < 4; ++j) {
                if (!BF) v[r][j] = vn[r][j];
                else { const unsigned lo = (unsigned)yn[r][j], hi = (unsigned)(yn[r][j] >> 32);
                    v[r][j] = (f32x4){__builtin_bit_cast(float, lo << 16), __builtin_bit_cast(float, lo & 0xffff0000u), __builtin_bit_cast(float, hi << 16), __builtin_bit_cast(float, hi & 0xffff0000u)}; } }
        if (i0 + 4 < 16) norm_load4<BF>(F, rowb + i0 + 4, in, vn, yn);
#pragma unroll
        for (int r = 0; r < 4; ++r) { float s = 0.f;
#pragma unroll
            for (int j = 0; j < 4; ++j) s += (v[r][j].x * v[r][j].x + v[r][j].y * v[r][j].y) + (v[r][j].z * v[r][j].z + v[r][j].w * v[r][j].w);
            ss[r] = s; }
#pragma unroll
        for (int o_ = 1; o_ < 64; o_ <<= 1) {
#pragma unroll
            for (int r = 0; r < 4; ++r) ss[r] += __shfl_xor(ss[r], o_); }
#pragma unroll
        for (int r = 0; r < 4; ++r) { const int row = rowb + i0 + r; const float rs = rsqrtf(ss[r] * (1.f / DM) + 1e-6f);
            GAS unsigned long long* o8 = (GAS unsigned long long*)(out + (size_t)row * DM) + F.lane;
#pragma unroll
            for (int j = 0; j < 4; ++j) { const f32x4 y = v[r][j] * rs * gs[j] + sh[j]; o8[64 * j] = (unsigned long long)pk2(y.x, y.y) | ((unsigned long long)pk2(y.z, y.w) << 32); } }
    }
}
__device__ __forceinline__ void phase_prologue_b(Frame& F, const Args& a) {
    unsigned char* ws = a.ws; const float* modp = (const float*)(ws + WS_MODP); const float* b_ada = a.in[4];
    if (F.wave == 0) for (int cgp = F.vcu; cgp < 96; cgp += F.G) { const int n = cgp * 64 + F.lane; float* mod = (float*)(ws + WS_MOD);
        for (int b = 0; b < 4; ++b) { float s = 0.f;
#pragma unroll
            for (int ks = 0; ks < 8; ++ks) s += modp[((size_t)ks * 4 + b) * 6144 + n];
            mod[b * 6144 + n] = s + b_ada[n]; } }
    const float* g = a.in[5];
    for (int blk = F.vcu; blk < TOK / 128; blk += F.G) { const int b = blk >> 6;
    f32x4 gs[4], sh[4];
#pragma unroll
    for (int j = 0; j < 4; ++j) { const int c0 = 4 * F.lane + 256 * j; f32x4 s0 = {0.f, 0.f, 0.f, 0.f}, s1 = {0.f, 0.f, 0.f, 0.f};
#pragma unroll
        for (int ks = 0; ks < 8; ++ks) { s0 += *(const f32x4*)(modp + ((size_t)ks * 4 + b) * 6144 + c0); s1 += *(const f32x4*)(modp + ((size_t)ks * 4 + b) * 6144 + DM + c0); }
        s0 += *(const f32x4*)(b_ada + c0); s1 += *(const f32x4*)(b_ada + DM + c0);
        sh[j] = s0; gs[j] = *(const f32x4*)(g + c0) * (s1 + 1.0f); }
    norm_rows<false>(F, blk, a.in[0], gs, sh, (bf16*)(ws + WS_H)); }
}
__device__ __forceinline__ void phase_norm2(Frame& F, const Args& a) {
    unsigned char* ws = a.ws; const float* g = a.in[20];
    for (int blk = F.vcu; blk < TOK / 128; blk += F.G) { const int b = blk >> 6; const float* mod = (const float*)(ws + WS_MOD) + (size_t)b * 6144;
        f32x4 gs[4], sh[4];
#pragma unroll
        for (int j = 0; j < 4; ++j) { const int c0 = 4 * F.lane + 256 * j; sh[j] = *(const f32x4*)(mod + 3 * DM + c0); gs[j] = *(const f32x4*)(g + c0) * (*(const f32x4*)(mod + 4 * DM + c0) + 1.0f); }
        norm_rows<true>(F, blk, ws + WS_Y, gs, sh, (bf16*)(ws + WS_H)); }
}

#define XB_TMO      128
#define XB_XCNT(j)  (256  + 64 * (j))
#define XB_XSUB(j)  (1280 + 64 * (j))
#define XB_XGEN(j)  (2304 + 64 * (j))
#define XB_TOP      3328
#define XB_TOPGEN   3392
#define XCD_BAR_WORDS 3456
#define XB_SPIN_CAP (1u << 18)

__device__ __forceinline__ unsigned xb_ld(unsigned* p)              { return __hip_atomic_load(p, __ATOMIC_RELAXED, __HIP_MEMORY_SCOPE_AGENT); }
__device__ __forceinline__ unsigned xb_add(unsigned* p, unsigned v) { return __hip_atomic_fetch_add(p, v, __ATOMIC_RELAXED, __HIP_MEMORY_SCOPE_AGENT); }
__device__ __forceinline__ unsigned xb_xcc_id() { return (unsigned)__builtin_amdgcn_s_getreg((3 << 11) | 20) & 0xFu; }
#define XB_SPIN(cond, bar) do { unsigned _sp = 0; while (cond) { __builtin_amdgcn_s_sleep(1); \
    if ((++_sp & 255u) == 0u) { if (xb_ld(&(bar)[XB_TMO])) break; if (_sp > XB_SPIN_CAP) { atomicAdd(&(bar)[XB_TMO], 1u); break; } } } } while (0)

struct XcdBarrier {
    unsigned* bar; unsigned x;
    volatile LAS unsigned* st;
};

__device__ __forceinline__ XcdBarrier xcd_barrier_post(unsigned* bar, volatile LAS unsigned* st) {
    XcdBarrier b; b.bar = bar; b.x = xb_xcc_id(); b.st = st;
    if (threadIdx.x == 0) (void)xb_add(&bar[XB_XCNT(b.x)], 1u);
    return b;
}
__device__ __forceinline__ void xcd_barrier_complete(unsigned* bar, unsigned x, unsigned& nloc, unsigned& nx) {
    const unsigned G = gridDim.x * gridDim.y * gridDim.z;
    unsigned sum, cnt, mine, sp = 0u;
    for (;;) {
        sum = 0u; cnt = 0u; mine = 0u;
#pragma unroll
        for (unsigned j = 0; j < 16; ++j) { const unsigned c = xb_ld(&bar[XB_XCNT(j)]); sum += c; cnt += (c > 0u) ? 1u : 0u; mine = (j == x) ? c : mine; }
        if (sum == G) break;
        __builtin_amdgcn_s_sleep(1);
        if ((++sp & 255u) == 0u) { if (xb_ld(&bar[XB_TMO])) break; if (sp > XB_SPIN_CAP) { atomicAdd(&bar[XB_TMO], 1u); break; } }
    }
    nloc = mine > 0u ? mine : 1u; nx = cnt > 0u ? cnt : 1u;
}

__device__ __forceinline__ void xcd_barrier(const XcdBarrier& b) {
    asm volatile("s_waitcnt vmcnt(0)" ::: "memory");
    __syncthreads();
    if (threadIdx.x == 0) {
        unsigned* bar = b.bar;
        __builtin_amdgcn_s_waitcnt(0);
        unsigned nloc = b.st[0], nx = b.st[1];
        if (nloc == 0u) { xcd_barrier_complete(bar, b.x, nloc, nx); b.st[0] = nloc; b.st[1] = nx; }
        const unsigned old = xb_add(&bar[XB_XSUB(b.x)], 1u);
        const unsigned gen = old / nloc;
        if (old + 1u == (gen + 1u) * nloc) {
            __builtin_amdgcn_fence(__ATOMIC_RELEASE, "agent");
            asm volatile("s_waitcnt vmcnt(0)" ::: "memory");
            const unsigned og = xb_add(&bar[XB_TOP], 1u);
            const unsigned tg = og / nx;
            __builtin_amdgcn_fence(__ATOMIC_ACQUIRE, "agent");
            if (og + 1u != (tg + 1u) * nx) XB_SPIN(xb_ld(&bar[XB_TOP]) < (tg + 1u) * nx, bar);
            xb_add(&bar[XB_XGEN(b.x)], 1u);
            asm volatile("s_waitcnt vmcnt(0)" ::: "memory");
        } else {
            __builtin_amdgcn_fence(__ATOMIC_ACQUIRE, "agent");
            XB_SPIN(xb_ld(&bar[XB_XGEN(b.x)]) == gen, bar);
            asm volatile("s_waitcnt vmcnt(0)" ::: "memory");
        }
    }
    __syncthreads();
}
#define ATT_NS att
#ifndef ATT_ABL
#define ATT_ABL 0
#endif
#ifndef ATT_STAGGER
#define ATT_STAGGER 0
#endif
#ifndef ATT_SLEEP
#define ATT_SLEEP 24
#endif
namespace ATT_NS {
using bf16x8 = __attribute__((ext_vector_type(8))) short;
using s16x4 = __attribute__((ext_vector_type(4))) short;
using f32x16 = __attribute__((ext_vector_type(16))) float;
using u32x4 = __attribute__((ext_vector_type(4))) unsigned;
typedef LAS const char* lds_cptr;
typedef short v4i16_t __attribute__((ext_vector_type(4)));
constexpr int SLOT = 16384, NSLOT = 4, LDS_OST = 65536, LDS_IMP = 100608, LDS_SELM = 135680, LDS_MISC = 136704, LDS_WSF = 136960, LDS_LUTG = 139008  , LDS_ATT_END = 147200;
constexpr int LUT_PITCH = 116;
constexpr int IMP_PITCH = 136, IMP_PLANE = 64 * IMP_PITCH + 4, IMP_REG1 = 64;
constexpr float LOG2E = 1.4426950408889634f;
#define MFMA32(a, b, c) __builtin_amdgcn_mfma_f32_32x32x16_bf16(a, b, c, 0, 0, 0)
#define ATT_WAIT_BAR(N) asm volatile("s_waitcnt vmcnt(" #N ") lgkmcnt(0)\n\ts_barrier" ::: "memory")
__device__ __forceinline__ void glds16(const void* gsrc, unsigned lds_dst) { unsigned keep;
    asm volatile("s_mov_b32 %0, m0\n\ts_mov_b32 m0, %2\n\ts_nop 0\n\tglobal_load_lds_dwordx4 %1, off\n\ts_mov_b32 m0, %0" : "=&s"(keep) : "v"(gsrc), "s"(lds_dst) : "memory"); }
typedef float f32x2_t __attribute__((ext_vector_type(2))); typedef __bf16 bf16x2_t __attribute__((ext_vector_type(2)));
__device__ __forceinline__ unsigned cvtpk(float lo, float hi) { f32x2_t v = {lo, hi}; bf16x2_t b = __builtin_convertvector(v, bf16x2_t); return __builtin_bit_cast(unsigned, b); }
__device__ __forceinline__ s16x4 vtr(lds_cptr p) { return __builtin_bit_cast(s16x4, __builtin_amdgcn_ds_read_tr16_b64_v4i16((LAS v4i16_t*)p)); }
__device__ __forceinline__ int t5_bucket(int d) {
    if (d < 16) return d;
    int b = 16;
    b += (d >= 19); b += (d >= 21); b += (d >= 24); b += (d >= 27); b += (d >= 31); b += (d >= 35); b += (d >= 40); b += (d >= 46);
    b += (d >= 52); b += (d >= 59); b += (d >= 67); b += (d >= 77); b += (d >= 87); b += (d >= 99); b += (d >= 113);
    return b;
}
struct Ctx { LAS char* lds; int wid; int lane, r32, hi; };
__device__ __forceinline__ int fresh_lane() { int l; asm volatile("v_mbcnt_lo_u32_b32 %0, -1, 0\n\tv_mbcnt_hi_u32_b32 %0, -1, %0" : "=v"(l)); return l; }
__device__ __forceinline__ Ctx make_ctx(LAS unsigned char* lds, int tid) {
    Ctx c; c.lds = (LAS char*)lds; c.wid = __builtin_amdgcn_readfirstlane(tid >> 6); c.lane = tid & 63; c.r32 = c.lane & 31; c.hi = c.lane >> 5; return c;
}
template <bool HASV, class QK, class SM>
__device__ __forceinline__ void run_stream(const Ctx& c, const bf16* Kb, const bf16* Vb, int t0, int t1, QK&& qk, SM&& sm) {
    const int n = t1 - t0; if (n <= 0) return;
    const int lane = fresh_lane(), r32 = lane & 31, hi = lane >> 5; const unsigned lds0 = (unsigned)(uintptr_t)c.lds;
    const bf16* ks = Kb + ((8 * c.wid + (lane >> 3)) * 64 + (((lane & 7) ^ (((8 * c.wid + (lane >> 3)) >> 1) & 7)) << 3)); const bf16* vs = Vb + ((16 * (c.wid & 3) + (lane >> 2)) * 64 + (c.wid >> 2) * 32 + (lane & 3) * 8);
    const unsigned kdst = lds0 + c.wid * 1024, vdst = lds0 + 8192 + c.wid * 1024;
    const lds_cptr kp0 = (lds_cptr)c.lds + r32 * 128;
    const lds_cptr vp0 = (lds_cptr)c.lds + 8192 + ((lane >> 4) & 1) * 32 + (lane & 3) * 8 + (4 * hi + ((lane & 15) >> 2)) * 64;
#define ATT_ISSUE(t, so) do { if (ATT_ABL & 4) break; glds16(ks + (size_t)(t) * 4096, (unsigned)__builtin_amdgcn_readfirstlane(kdst + (so))); if (HASV) glds16(vs + (size_t)(t) * 4096, (unsigned)__builtin_amdgcn_readfirstlane(vdst + (so))); } while (0)
    ATT_ISSUE(t0, 0); if (n > 1) ATT_ISSUE(t0 + 1, SLOT);
    const bool late = ATT_STAGGER && __builtin_amdgcn_readfirstlane(c.wid) >= 4;
    f32x16 s0 = {}, s1 = {};
    int slot = 0, slotp = 3 * SLOT, slot2 = 2 * SLOT;
    if (!late) {
        for (int i = 0; i < n; ++i) {
            if (i + 1 < n) { if (HASV) ATT_WAIT_BAR(2); else ATT_WAIT_BAR(1); } else ATT_WAIT_BAR(0);
            if (i + 2 < n) ATT_ISSUE(t0 + i + 2, slot2);
            if (!(ATT_ABL & 1)) qk(t0 + i, kp0 + slot, s0, s1); if (!(ATT_ABL & 2)) sm(t0 + i, vp0 + slot, s0, s1);
            slot = (slot == 3 * SLOT) ? 0 : slot + SLOT; slot2 = (slot2 == 3 * SLOT) ? 0 : slot2 + SLOT;
        }
    } else {
        for (int i = 0; i < n; ++i) {
            if (i + 1 < n) { if (HASV) ATT_WAIT_BAR(2); else ATT_WAIT_BAR(1); } else ATT_WAIT_BAR(0);
            if (i + 2 < n) ATT_ISSUE(t0 + i + 2, slot2);
            if (i > 0 && !(ATT_ABL & 2)) sm(t0 + i - 1, vp0 + slotp, s0, s1);
            if (!(ATT_ABL & 1)) qk(t0 + i, kp0 + slot, s0, s1);
            slotp = slot; slot = (slot == 3 * SLOT) ? 0 : slot + SLOT; slot2 = (slot2 == 3 * SLOT) ? 0 : slot2 + SLOT;
        }
        if (!(ATT_ABL & 2)) sm(t0 + n - 1, vp0 + slotp, s0, s1);
    }
    asm volatile("s_waitcnt lgkmcnt(0)\n\ts_barrier" ::: "memory");
#undef ATT_ISSUE
}
template <class FN1, class FN2>
__device__ __forceinline__ void run_stream_pairs(const Ctx& c, const bf16* Kb, const bf16* Vb, int t0, int t1, FN1&& fn1, FN2&& fn2) {
    const int n = t1 - t0; if (n <= 0) return;
    const int lane = fresh_lane(), r32 = lane & 31, hi = lane >> 5; const unsigned lds0 = (unsigned)(uintptr_t)c.lds;
    const bf16* ks = Kb + ((8 * c.wid + (lane >> 3)) * 64 + (((lane & 7) ^ (((8 * c.wid + (lane >> 3)) >> 1) & 7)) << 3)); const bf16* vs = Vb + ((16 * (c.wid & 3) + (lane >> 2)) * 64 + (c.wid >> 2) * 32 + (lane & 3) * 8);
    const unsigned kdst = lds0 + c.wid * 1024, vdst = lds0 + 8192 + c.wid * 1024;
    const lds_cptr kp0 = (lds_cptr)c.lds + r32 * 128;
    const lds_cptr vp0 = (lds_cptr)c.lds + 8192 + ((lane >> 4) & 1) * 32 + (lane & 3) * 8 + (4 * hi + ((lane & 15) >> 2)) * 64;
#define ATT_ISSUE1(t, so) do { glds16(ks + (size_t)(t) * 4096, (unsigned)__builtin_amdgcn_readfirstlane(kdst + (so))); glds16(vs + (size_t)(t) * 4096, (unsigned)__builtin_amdgcn_readfirstlane(vdst + (so))); } while (0)
    ATT_ISSUE1(t0, 0); if (n > 1) ATT_ISSUE1(t0 + 1, SLOT);
    int base = 0;
    for (int i = 0; i < n; i += 2) {
        ATT_WAIT_BAR(0);
        const int nb = 2 * SLOT - base;
        if (i + 2 < n) ATT_ISSUE1(t0 + i + 2, nb); if (i + 3 < n) ATT_ISSUE1(t0 + i + 3, nb + SLOT);
        if (i + 1 < n) fn2(t0 + i, kp0 + base, vp0 + base, kp0 + base + SLOT, vp0 + base + SLOT); else fn1(t0 + i, kp0 + base, vp0 + base);
        base = nb;
    }
    asm volatile("s_waitcnt lgkmcnt(0)\n\ts_barrier" ::: "memory");
#undef ATT_ISSUE1
}
__device__ __forceinline__ void qk_tile(f32x16& s0, f32x16& s1, lds_cptr kp, const bf16x8 (&qr)[4]) {
    bf16x8 kf[8];
    { const int l = fresh_lane(), f = ((l & 31) >> 1) & 7, hi = l >> 5;
#pragma unroll
      for (int d0 = 0; d0 < 4; ++d0) { const int off = ((2 * d0 + hi) ^ f) << 4; kf[2 * d0] = *(const LAS bf16x8*)(kp + off); kf[2 * d0 + 1] = *(const LAS bf16x8*)(kp + 4096 + off); } }
    const f32x16 z = {};
    s0 = MFMA32(kf[0], qr[0], z); s1 = MFMA32(kf[1], qr[0], z);
#pragma unroll
    for (int d0 = 1; d0 < 4; ++d0) { s0 = MFMA32(kf[2 * d0], qr[d0], s0); s1 = MFMA32(kf[2 * d0 + 1], qr[d0], s1); }
}
template <bool MASK>
__device__ __forceinline__ void pv_tile(f32x16 (&o)[2], lds_cptr vp, const f32x16& p0, const f32x16& p1, unsigned mask) {
    if (ATT_ABL & 8) { o[0][0] += p0[0] + p1[5]; return; }
    u32x4 pw0 = {cvtpk(p0[0], p0[1]), cvtpk(p0[2], p0[3]), cvtpk(p0[4], p0[5]), cvtpk(p0[6], p0[7])}, pw1 = {cvtpk(p0[8], p0[9]), cvtpk(p0[10], p0[11]), cvtpk(p0[12], p0[13]), cvtpk(p0[14], p0[15])};
    u32x4 pw2 = {cvtpk(p1[0], p1[1]), cvtpk(p1[2], p1[3]), cvtpk(p1[4], p1[5]), cvtpk(p1[6], p1[7])}, pw3 = {cvtpk(p1[8], p1[9]), cvtpk(p1[10], p1[11]), cvtpk(p1[12], p1[13]), cvtpk(p1[14], p1[15])};
    if (MASK) { pw0 &= mask; pw1 &= mask; pw2 &= mask; pw3 &= mask; }
    if (ATT_ABL & 64) { o[0] = MFMA32(__builtin_bit_cast(bf16x8, pw0), __builtin_bit_cast(bf16x8, pw1), o[0]); o[1] = MFMA32(__builtin_bit_cast(bf16x8, pw2), __builtin_bit_cast(bf16x8, pw3), o[1]); return; }
    s16x4 vlo[8], vhi[8];
#pragma unroll
    for (int i = 0; i < 8; ++i) { vlo[i] = vtr(vp + ((i >> 2) * 4096 + (i & 3) * 1024)); vhi[i] = vtr(vp + ((i >> 2) * 4096 + (i & 3) * 1024 + 512)); }
#define ATT_VFR(i) (bf16x8){vlo[i][0], vlo[i][1], vlo[i][2], vlo[i][3], vhi[i][0], vhi[i][1], vhi[i][2], vhi[i][3]}
    o[0] = MFMA32(__builtin_bit_cast(bf16x8, pw0), ATT_VFR(0), o[0]); o[1] = MFMA32(__builtin_bit_cast(bf16x8, pw0), ATT_VFR(4), o[1]);
    o[0] = MFMA32(__builtin_bit_cast(bf16x8, pw1), ATT_VFR(1), o[0]); o[1] = MFMA32(__builtin_bit_cast(bf16x8, pw1), ATT_VFR(5), o[1]);
    o[0] = MFMA32(__builtin_bit_cast(bf16x8, pw2), ATT_VFR(2), o[0]); o[1] = MFMA32(__builtin_bit_cast(bf16x8, pw2), ATT_VFR(6), o[1]);
    o[0] = MFMA32(__builtin_bit_cast(bf16x8, pw3), ATT_VFR(3), o[0]); o[1] = MFMA32(__builtin_bit_cast(bf16x8, pw3), ATT_VFR(7), o[1]);
#undef ATT_VFR
}
#define ATT_SB() __builtin_amdgcn_sched_barrier(0)
struct KF { bf16x8 f[8]; };
struct VF { s16x4 lo[8], hi[8]; };
struct PW4 { u32x4 w0, w1, w2, w3; };
__device__ __forceinline__ void ld_k(KF& k, lds_cptr kp) {
    const int l = fresh_lane(), f = ((l & 31) >> 1) & 7, hi = l >> 5;
#pragma unroll
    for (int d0 = 0; d0 < 4; ++d0) { const int off = ((2 * d0 + hi) ^ f) << 4; k.f[2 * d0] = *(const LAS bf16x8*)(kp + off); k.f[2 * d0 + 1] = *(const LAS bf16x8*)(kp + 4096 + off); } }
__device__ __forceinline__ void qk_mfma(f32x16& s0, f32x16& s1, const KF& k, const bf16x8 (&qr)[4]) {
    const f32x16 z = {};
    s0 = MFMA32(k.f[0], qr[0], z); s1 = MFMA32(k.f[1], qr[0], z);
#pragma unroll
    for (int d0 = 1; d0 < 4; ++d0) { s0 = MFMA32(k.f[2 * d0], qr[d0], s0); s1 = MFMA32(k.f[2 * d0 + 1], qr[d0], s1); } }
__device__ __forceinline__ void ld_v(VF& v, lds_cptr vp) {
#pragma unroll
    for (int i = 0; i < 8; ++i) { v.lo[i] = vtr(vp + ((i >> 2) * 4096 + (i & 3) * 1024)); v.hi[i] = vtr(vp + ((i >> 2) * 4096 + (i & 3) * 1024 + 512)); } }
__device__ __forceinline__ PW4 pack4(const f32x16& p0, const f32x16& p1, unsigned mask) { PW4 w;
    w.w0 = (u32x4){cvtpk(p0[0], p0[1]), cvtpk(p0[2], p0[3]), cvtpk(p0[4], p0[5]), cvtpk(p0[6], p0[7])}; w.w1 = (u32x4){cvtpk(p0[8], p0[9]), cvtpk(p0[10], p0[11]), cvtpk(p0[12], p0[13]), cvtpk(p0[14], p0[15])};
    w.w2 = (u32x4){cvtpk(p1[0], p1[1]), cvtpk(p1[2], p1[3]), cvtpk(p1[4], p1[5]), cvtpk(p1[6], p1[7])}; w.w3 = (u32x4){cvtpk(p1[8], p1[9]), cvtpk(p1[10], p1[11]), cvtpk(p1[12], p1[13]), cvtpk(p1[14], p1[15])};
    w.w0 &= mask; w.w1 &= mask; w.w2 &= mask; w.w3 &= mask; return w; }
__device__ __forceinline__ void pv_mfma(f32x16 (&o)[2], const VF& v, const PW4& w) {
#define ATT_VF(i) (bf16x8){v.lo[i][0], v.lo[i][1], v.lo[i][2], v.lo[i][3], v.hi[i][0], v.hi[i][1], v.hi[i][2], v.hi[i][3]}
    o[0] = MFMA32(__builtin_bit_cast(bf16x8, w.w0), ATT_VF(0), o[0]); o[1] = MFMA32(__builtin_bit_cast(bf16x8, w.w0), ATT_VF(4), o[1]);
    o[0] = MFMA32(__builtin_bit_cast(bf16x8, w.w1), ATT_VF(1), o[0]); o[1] = MFMA32(__builtin_bit_cast(bf16x8, w.w1), ATT_VF(5), o[1]);
    o[0] = MFMA32(__builtin_bit_cast(bf16x8, w.w2), ATT_VF(2), o[0]); o[1] = MFMA32(__builtin_bit_cast(bf16x8, w.w2), ATT_VF(6), o[1]);
    o[0] = MFMA32(__builtin_bit_cast(bf16x8, w.w3), ATT_VF(3), o[0]); o[1] = MFMA32(__builtin_bit_cast(bf16x8, w.w3), ATT_VF(7), o[1]);
#undef ATT_VF
}
__device__ __forceinline__ float rowsum32(const f32x16& p0, const f32x16& p1) { if (ATT_ABL & 32) return p0[0]; float a = p0[0] + p1[0], b = p0[1] + p1[1];
#pragma unroll
    for (int r = 2; r < 16; r += 2) { a += p0[r]; asm volatile("" : "+v"(a)); b += p0[r + 1]; asm volatile("" : "+v"(b)); a += p1[r]; asm volatile("" : "+v"(a)); b += p1[r + 1]; asm volatile("" : "+v"(b)); }
    return a + b; }
__device__ __forceinline__ void hook_exp(f32x16& s0, f32x16& s1) {
    if (ATT_ABL & 16) return;
#pragma unroll
    for (int r = 0; r < 16; ++r) { s0[r] = __builtin_amdgcn_exp2f(s0[r]); s1[r] = __builtin_amdgcn_exp2f(s1[r]); } }
__device__ __forceinline__ void hook_near(f32x16& s0, f32x16& s1, int base, const LAS float* lut) {
    asm volatile("" : "+v"(base));
#pragma unroll
    for (int r = 0; r < 16; ++r) { const int d0 = base - ((r & 3) + 8 * (r >> 2)), d1 = d0 - 32;
        s0[r] = __builtin_amdgcn_exp2f(s0[r] + lut[min(max(d0, -1), 113) + 1]); s1[r] = __builtin_amdgcn_exp2f(s1[r] + lut[min(max(d1, -1), 113) + 1]); } }
__device__ __forceinline__ void hook_edge(f32x16& s0, f32x16& s1, int base, int win) {
    asm volatile("" : "+v"(base));
#pragma unroll
    for (int r = 0; r < 16; ++r) { const int d0 = base - ((r & 3) + 8 * (r >> 2)), d1 = d0 - 32;
        s0[r] = __builtin_amdgcn_exp2f(d0 < win ? s0[r] : -INFINITY); s1[r] = __builtin_amdgcn_exp2f(d1 < win ? s1[r] : -INFINITY); } }
__device__ __forceinline__ void hook_cmp(f32x16& s0, f32x16& s1, int nrel  , float cb) {
    asm volatile("" : "+v"(nrel));
#pragma unroll
    for (int r = 0; r < 16; ++r) { const int c0 = (r & 3) + 8 * (r >> 2);
        s0[r] = __builtin_amdgcn_exp2f(s0[r] + ((c0 <= nrel) ? cb : -INFINITY)); s1[r] = __builtin_amdgcn_exp2f(s1[r] + ((c0 + 32 <= nrel) ? cb : -INFINITY)); } }
__device__ __forceinline__ void row_factors(const Ctx& c, float f, float (&fr)[16]) {
    const int lane = fresh_lane(), r32 = lane & 31, hi = lane >> 5; LAS float* wsf = (LAS float*)(c.lds + LDS_WSF) + c.wid * 64;
    asm volatile("s_waitcnt lgkmcnt(0)" ::: "memory");
    if (hi == 0) wsf[r32] = f;
    asm volatile("s_waitcnt lgkmcnt(0)" ::: "memory");
#pragma unroll
    for (int r = 0; r < 16; ++r) fr[r] = wsf[(r & 3) + 8 * (r >> 2) + 4 * hi];
    asm volatile("s_waitcnt lgkmcnt(0)" ::: "memory");
}
__device__ __forceinline__ float pair_sum(float v) { auto rr = __builtin_amdgcn_permlane32_swap(__float_as_uint(v), __float_as_uint(v), false, false); return __uint_as_float(rr[0]) + __uint_as_float(rr[1]); }
template <class RowOff>
__device__ __forceinline__ void store_rows(const Ctx& c, const f32x16 (&o)[2], bf16* dst, RowOff&& rowoff) {
    LAS bf16* stg = (LAS bf16*)(c.lds + LDS_OST) + c.wid * 2048;
    const int lane = fresh_lane(), r32 = lane & 31, hi = lane >> 5;
#pragma unroll
    for (int r = 0; r < 16; ++r) { const int orow = (r & 3) + 8 * (r >> 2) + 4 * hi;
        { const unsigned pk_ = cvtpk(o[0][r], o[1][r]); stg[orow * 64 + r32] = (bf16)pk_; stg[orow * 64 + 32 + r32] = (bf16)(pk_ >> 16); } }
    asm volatile("s_waitcnt lgkmcnt(0)" ::: "memory");
#pragma unroll
    for (int i = 0; i < 4; ++i) { const int row = i * 8 + (lane >> 3), ch = lane & 7; const u32x4 v = *(const LAS u32x4*)(stg + row * 64 + ch * 8); *(u32x4*)(dst + rowoff(row) + ch * 8) = v; }
    asm volatile("s_waitcnt lgkmcnt(0)" ::: "memory");
}
struct AttnPtrs { const bf16* qkv; const float* kmp; const float* gates; const bf16* kcmp; const bf16* vcmp; const float* rel_bias; bf16* mix; unsigned* selg; bf16* part_o; float* part_l; };

__device__ __forceinline__ void moba_kmean_frags(const AttnPtrs& P, int bh, int r32, int hi, bf16x8 (&kmf)[4]) {
    const float* kp = P.kmp + ((size_t)(bh * 32 + r32) * 2) * 64;
#pragma unroll
    for (int d0 = 0; d0 < 4; ++d0) { const f32x4 a0 = *(const f32x4*)(kp + d0 * 16 + hi * 8), a1 = *(const f32x4*)(kp + d0 * 16 + hi * 8 + 4), b0 = *(const f32x4*)(kp + 64 + d0 * 16 + hi * 8), b1 = *(const f32x4*)(kp + 64 + d0 * 16 + hi * 8 + 4);
        const f32x4 m0 = (a0 + b0) * (1.f / 256.f), m1 = (a1 + b1) * (1.f / 256.f);
        u32x4 w = {cvtpk(m0[0], m0[1]), cvtpk(m0[2], m0[3]), cvtpk(m1[0], m1[1]), cvtpk(m1[2], m1[3])}; kmf[d0] = __builtin_bit_cast(bf16x8, w); }
}
__device__ __forceinline__ unsigned moba_gate32(const bf16x8 (&kmf)[4], int i, const bf16x8 (&qr)[4], int hi) {
    unsigned selmask = 0u;
    if (i > 0) {
        f32x16 sg = {};
#pragma unroll
        for (int d0 = 0; d0 < 4; ++d0) sg = MFMA32(kmf[d0], qr[d0], sg);
        float v[16];
#pragma unroll
        for (int r = 0; r < 16; ++r) v[r] = ((r & 3) + 8 * (r >> 2) + 4 * hi < i) ? sg[r] : -INFINITY;
#pragma unroll
        for (int it = 0; it < 3; ++it) {
            float m = v[0]; int jb = 4 * hi;
#pragma unroll
            for (int r = 1; r < 16; ++r) { const int j = (r & 3) + 8 * (r >> 2) + 4 * hi; if (v[r] > m) { m = v[r]; jb = j; } }
            auto rm = __builtin_amdgcn_permlane32_swap(__float_as_uint(m), __float_as_uint(m), false, false);
            auto rj = __builtin_amdgcn_permlane32_swap((unsigned)jb, (unsigned)jb, false, false);
            const float mo = __uint_as_float(hi ? rm[0] : rm[1]); const int jo = (int)(hi ? rj[0] : rj[1]);
            const bool mine = (m > mo) || (m == mo && jb < jo);
            const float mw = mine ? m : mo; const int jw = mine ? jb : jo;
            if (mw > -INFINITY) { selmask |= 1u << jw;
#pragma unroll
                for (int r = 0; r < 16; ++r) if ((r & 3) + 8 * (r >> 2) + 4 * hi == jw) v[r] = -INFINITY; }
        }
    }
    return selmask;
}
__device__ __forceinline__ void moba_gate_phase(const AttnPtrs& P, int vcu, int G, int tid) {
    const int lane = tid & 63, r32 = lane & 31, hi = lane >> 5; const int wid = __builtin_amdgcn_readfirstlane(tid >> 6);
    for (int grp = vcu * 8 + wid; grp < 2048; grp += G * 8) { const int bh = grp >> 6;
        bf16x8 kmf[4]; moba_kmean_frags(P, bh, r32, hi, kmf);
        const bf16* QA = P.qkv + ((size_t)bh * SEQ) * 64;
        bf16x8 qr[4][4];
#pragma unroll
        for (int k = 0; k < 4; ++k) { const int idx = (grp & 63) * 4 + k, i = idx >> 3, w = idx & 7; const int qpos = 256 * i + 32 * w + r32;
#pragma unroll
            for (int d0 = 0; d0 < 4; ++d0) qr[k][d0] = *(const bf16x8*)(QA + (size_t)qpos * 64 + d0 * 16 + hi * 8); }
#pragma unroll
        for (int k = 0; k < 4; ++k) { const int idx = (grp & 63) * 4 + k, i = idx >> 3, w = idx & 7; const int qpos = 256 * i + 32 * w + r32;
            const unsigned m = moba_gate32(kmf, i, qr[k], hi);
            if (hi == 0) P.selg[(size_t)bh * SEQ + qpos] = m; } }
}
__device__ __forceinline__ void moba_merge_range(const AttnPtrs& P, int tok0, int tok1, int tid);
__device__ __forceinline__ void st_wt(bf16* p, u32x4 v) { asm volatile("global_store_dwordx4 %0, %1, off sc0 sc1\n\ts_nop 0" :: "v"(p), "v"(v) : "memory"); }
__device__ __forceinline__ void st_wt(float* p, float v) { asm volatile("global_store_dword %0, %1, off sc0 sc1" :: "v"(p), "v"(v) : "memory"); }
__device__ __forceinline__ u32x4 ld_wt(const void* p) { u32x4 r; asm volatile("global_load_dwordx4 %0, %1, off sc0 sc1" : "=v"(r) : "v"(p) : "memory"); return r; }
__device__ __forceinline__ void moba_gate_tasks_w17(const AttnPtrs& P, int vcu, int tid) {
    const int lane = tid & 63, r32 = lane & 31, hi = lane >> 5; const int wid = __builtin_amdgcn_readfirstlane(tid >> 6);
    const int bh = vcu >> 3;
    bf16x8 kmf[4]; moba_kmean_frags(P, bh, r32, hi, kmf);
    const bf16* QA = P.qkv + ((size_t)bh * SEQ) * 64;
    bf16x8 qr[5][4];
#pragma unroll
    for (int k = 0; k < 5; ++k) { const int t = wid - 1 + 7 * k; if (t < 32) { const int idx = (vcu & 7) * 32 + t, i = idx >> 3, w = idx & 7; const int qpos = 256 * i + 32 * w + r32;
#pragma unroll
        for (int d0 = 0; d0 < 4; ++d0) qr[k][d0] = *(const bf16x8*)(QA + (size_t)qpos * 64 + d0 * 16 + hi * 8); } }
#pragma unroll
    for (int k = 0; k < 5; ++k) { const int t = wid - 1 + 7 * k; if (t < 32) { const int idx = (vcu & 7) * 32 + t, i = idx >> 3, w = idx & 7; const int qpos = 256 * i + 32 * w + r32;
        const unsigned m = moba_gate32(kmf, i, qr[k], hi);
        if (hi == 0) P.selg[(size_t)bh * SEQ + qpos] = m; } }
}
__device__ __forceinline__ void moba_past_item(const Ctx& c, const AttnPtrs& P, int b, int h, int j, unsigned* done, int flags = 0) {
    const int bh = b * 8 + h, tid = threadIdx.x;
    const bf16* QA = P.qkv + ((size_t)bh * SEQ) * 64; const bf16* KA = QA + QKV_BIG + (size_t)256 * j * 64; const bf16* VA = QA + 2 * QKV_BIG + (size_t)256 * j * 64;
    const LAS float* lut = (const LAS float*)(c.lds + LDS_LUTG) + h * LUT_PITCH;
    { const int lane = fresh_lane(); const unsigned lds0 = (unsigned)(uintptr_t)c.lds;
      const bf16* ks = KA + ((8 * c.wid + (lane >> 3)) * 64 + (((lane & 7) ^ (((8 * c.wid + (lane >> 3)) >> 1) & 7)) << 3)); const bf16* vs = VA + ((16 * (c.wid & 3) + (lane >> 2)) * 64 + (c.wid >> 2) * 32 + (lane & 3) * 8);
#pragma unroll
      for (int tt = 0; tt < 4; ++tt) { glds16(ks + tt * 4096, (unsigned)__builtin_amdgcn_readfirstlane(lds0 + c.wid * 1024 + tt * SLOT)); glds16(vs + tt * 4096, (unsigned)__builtin_amdgcn_readfirstlane(lds0 + 8192 + c.wid * 1024 + tt * SLOT)); } }
    LAS unsigned short* list = (LAS unsigned short*)(c.lds + LDS_IMP);
    LAS unsigned* wcnt = (LAS unsigned*)(c.lds + LDS_MISC) + 8;
    const unsigned* sg = P.selg + (size_t)bh * SEQ;
    if (tid < 256) list[tid] = (unsigned short)((256 * j + tid) | (3 << 13));
    int total = 256;
    {
        const int base0 = (j + 1) * 256;
        uint4 m4s[4]; unsigned long long bl[4][4];
#pragma unroll
        for (int p = 0; p < 4; ++p) { const int q0 = base0 + 2048 * p + 4 * tid; m4s[p] = make_uint4(0u, 0u, 0u, 0u); if (q0 < SEQ) m4s[p] = *(const uint4*)(sg + q0); }
#pragma unroll
        for (int p = 0; p < 4; ++p) { bl[p][0] = __ballot((m4s[p].x >> j) & 1u); bl[p][1] = __ballot((m4s[p].y >> j) & 1u); bl[p][2] = __ballot((m4s[p].z >> j) & 1u); bl[p][3] = __ballot((m4s[p].w >> j) & 1u);
            if ((tid & 63) == 0) wcnt[p * 8 + c.wid] = (unsigned)(__popcll(bl[p][0]) + __popcll(bl[p][1]) + __popcll(bl[p][2]) + __popcll(bl[p][3])); }
        asm volatile("s_waitcnt vmcnt(0) lgkmcnt(0)\n\ts_barrier" ::: "memory");
        const unsigned long long below = (1ull << (tid & 63)) - 1ull; const unsigned lowj = (1u << j) - 1u;
#pragma unroll
        for (int p = 0; p < 4; ++p) { const int q0 = base0 + 2048 * p + 4 * tid;
            int off = total, tot = 0;
#pragma unroll
            for (int w = 0; w < 8; ++w) { const int v = (int)wcnt[p * 8 + w]; off += (w < c.wid) ? v : 0; tot += v; }
            const uint4 m4 = m4s[p];
            if ((m4.x >> j) & 1u) list[off + __popcll(bl[p][0] & below)] = (unsigned short)((q0 + 0) | (__popc(m4.x & lowj) << 13)); off += (int)__popcll(bl[p][0]);
            if ((m4.y >> j) & 1u) list[off + __popcll(bl[p][1] & below)] = (unsigned short)((q0 + 1) | (__popc(m4.y & lowj) << 13)); off += (int)__popcll(bl[p][1]);
            if ((m4.z >> j) & 1u) list[off + __popcll(bl[p][2] & below)] = (unsigned short)((q0 + 2) | (__popc(m4.z & lowj) << 13)); off += (int)__popcll(bl[p][2]);
            if ((m4.w >> j) & 1u) list[off + __popcll(bl[p][3] & below)] = (unsigned short)((q0 + 3) | (__popc(m4.w & lowj) << 13));
            total += tot; }
    }
    total = __builtin_amdgcn_readfirstlane(total);
    { const int npad = (32 - (total & 31)) & 31; if (tid < npad) list[total + tid] = 0xFFFFu; }
    const int nchunks = (total + 31) >> 5;
    asm volatile("s_waitcnt vmcnt(0) lgkmcnt(0)\n\ts_barrier" ::: "memory");
    unsigned e_n = 0xFFFFu; bf16x8 qn[4];
    if (c.wid < nchunks) { const int l0 = fresh_lane(); e_n = list[32 * c.wid + (l0 & 31)]; const int q0 = (e_n != 0xFFFFu) ? (int)(e_n & 0x1FFFu) : SEQ - 1;
#pragma unroll
        for (int d0 = 0; d0 < 4; ++d0) qn[d0] = *(const bf16x8*)(QA + (size_t)q0 * 64 + d0 * 16 + (l0 >> 5) * 8); }
    if (!(flags & 64)) for (int ch = c.wid; ch < nchunks; ch += 8) {
        const int lane = fresh_lane(), r32 = lane & 31, hi = lane >> 5;
        const lds_cptr kp0 = (lds_cptr)c.lds + r32 * 128;
        const lds_cptr vp0 = (lds_cptr)c.lds + 8192 + ((lane >> 4) & 1) * 32 + (lane & 3) * 8 + (4 * hi + ((lane & 15) >> 2)) * 64;
        const unsigned e = e_n; const bool valid = e != 0xFFFFu; const int q = valid ? (int)(e & 0x1FFFu) : SEQ - 1;
        bf16x8 qr[4];
#pragma unroll
        for (int d0 = 0; d0 < 4; ++d0) qr[d0] = qn[d0];
        if (ch + 8 < nchunks) { e_n = list[32 * (ch + 8) + r32]; const int q1 = (e_n != 0xFFFFu) ? (int)(e_n & 0x1FFFu) : SEQ - 1;
#pragma unroll
            for (int d0 = 0; d0 < 4; ++d0) qn[d0] = *(const bf16x8*)(QA + (size_t)q1 * 64 + d0 * 16 + hi * 8); }
        const int ntt = (ch < 8) ? (ch >> 1) + 1 : 4;
        f32x16 o[2]; o[0] = f32x16{}; o[1] = f32x16{}; float l_reg = 0.f;
#pragma unroll 1
        for (int tt = 0; tt < ntt; ++tt) { f32x16 s0, s1; qk_tile(s0, s1, kp0 + tt * SLOT, qr);
            const int dq = q - (256 * j + 64 * tt);
            if (__any(valid && dq < 113 + 63)) hook_near(s0, s1, dq - 4 * hi, lut); else hook_exp(s0, s1);
            l_reg += rowsum32(s0, s1);
            pv_tile<false>(o, vp0 + tt * SLOT, s0, s1, 0u); }
        const float L = pair_sum(l_reg);
        if (hi == 0 && valid) st_wt(P.part_l + ((size_t)bh * SEQ + q) * 4 + (e >> 13), L);
        LAS bf16* stg = (LAS bf16*)(c.lds + LDS_OST) + c.wid * 2048;
#pragma unroll
        for (int r = 0; r < 16; ++r) { const int orow = (r & 3) + 8 * (r >> 2) + 4 * hi;
            { const unsigned pk_ = cvtpk(o[0][r], o[1][r]); stg[orow * 64 + r32] = (bf16)pk_; stg[orow * 64 + 32 + r32] = (bf16)(pk_ >> 16); } }
        asm volatile("s_waitcnt lgkmcnt(0)" ::: "memory");
#pragma unroll
        for (int it = 0; it < 4; ++it) { const int row = it * 8 + (lane >> 3), chn = lane & 7; const unsigned e2 = list[32 * ch + row];
            const u32x4 v = *(const LAS u32x4*)(stg + row * 64 + chn * 8);
            if (e2 != 0xFFFFu) st_wt(P.part_o + (((size_t)bh * SEQ + (e2 & 0x1FFFu)) * 4 + (e2 >> 13)) * 64 + chn * 8, v); }
        asm volatile("s_waitcnt lgkmcnt(0)" ::: "memory");
    }
    asm volatile("s_waitcnt vmcnt(0) lgkmcnt(0)\n\ts_barrier" ::: "memory");
    if (tid == 0) (void)__hip_atomic_fetch_add(done, 1u, __ATOMIC_RELAXED, __HIP_MEMORY_SCOPE_AGENT);
}
__device__ __forceinline__ void moba_merge_item(const Ctx& c, const AttnPtrs& P, int m, unsigned* done) {
    if (threadIdx.x == 0) { unsigned sp = 0; while (__hip_atomic_load(done, __ATOMIC_RELAXED, __HIP_MEMORY_SCOPE_AGENT) < 1024u && ++sp < (1u << 22)) __builtin_amdgcn_s_sleep(2); }
    asm volatile("s_waitcnt vmcnt(0) lgkmcnt(0)\n\ts_barrier" ::: "memory");
    moba_merge_range(P, 128 * m, 128 * m + 128, threadIdx.x);
    asm volatile("s_waitcnt lgkmcnt(0)\n\ts_barrier" ::: "memory");
}
__device__ __forceinline__ void moba_merge_range(const AttnPtrs& P, int tok0, int tok1, int tid) {
    const int lane = tid & 63, h = lane >> 3, chn = lane & 7; const int wid = __builtin_amdgcn_readfirstlane(tid >> 6);
    for (int tb = tok0 + wid; tb < tok1; tb += 32) {
        u32x4 pv[4][4], lw[4]; unsigned sg[4];
#pragma unroll
        for (int t = 0; t < 4; ++t) { const int tok = tb + 8 * t; const int b = tok >> 13, q = tok & (SEQ - 1); const size_t qi = (size_t)(b * 8 + h) * SEQ + q;
            sg[t] = P.selg[qi]; lw[t] = ld_wt(P.part_l + qi * 4);
#pragma unroll
            for (int sidx = 0; sidx < 4; ++sidx) pv[t][sidx] = ld_wt(P.part_o + (qi * 4 + sidx) * 64 + chn * 8); }
        asm volatile("s_waitcnt vmcnt(0)" : "+v"(lw[0]), "+v"(lw[1]), "+v"(lw[2]), "+v"(lw[3]),
                     "+v"(pv[0][0]), "+v"(pv[0][1]), "+v"(pv[0][2]), "+v"(pv[0][3]), "+v"(pv[1][0]), "+v"(pv[1][1]), "+v"(pv[1][2]), "+v"(pv[1][3]),
                     "+v"(pv[2][0]), "+v"(pv[2][1]), "+v"(pv[2][2]), "+v"(pv[2][3]), "+v"(pv[3][0]), "+v"(pv[3][1]), "+v"(pv[3][2]), "+v"(pv[3][3]) :: "memory");
#pragma unroll
        for (int t = 0; t < 4; ++t) { const int tok = tb + 8 * t; const int ns = __popc(sg[t]);
            float Lt = __uint_as_float(lw[t].w);
            f32x4 a0 = {__uint_as_float(pv[t][3].x << 16), __uint_as_float(pv[t][3].x & 0xffff0000u), __uint_as_float(pv[t][3].y << 16), __uint_as_float(pv[t][3].y & 0xffff0000u)};
            f32x4 a1 = {__uint_as_float(pv[t][3].z << 16), __uint_as_float(pv[t][3].z & 0xffff0000u), __uint_as_float(pv[t][3].w << 16), __uint_as_float(pv[t][3].w & 0xffff0000u)};
#pragma unroll
            for (int sidx = 0; sidx < 3; ++sidx) { const bool on = sidx < ns; const u32x4 w = pv[t][sidx];
                const unsigned wx = on ? w.x : 0u, wy = on ? w.y : 0u, wz = on ? w.z : 0u, ww = on ? w.w : 0u;
                Lt += on ? __uint_as_float(sidx == 0 ? lw[t].x : sidx == 1 ? lw[t].y : lw[t].z) : 0.f;
                a0 += (f32x4){__uint_as_float(wx << 16), __uint_as_float(wx & 0xffff0000u), __uint_as_float(wy << 16), __uint_as_float(wy & 0xffff0000u)};
                a1 += (f32x4){__uint_as_float(wz << 16), __uint_as_float(wz & 0xffff0000u), __uint_as_float(ww << 16), __uint_as_float(ww & 0xffff0000u)}; }
            const float inv = 1.f / Lt; a0 *= inv; a1 *= inv;
            const u32x4 w = {cvtpk(a0[0], a0[1]), cvtpk(a0[2], a0[3]), cvtpk(a1[0], a1[1]), cvtpk(a1[2], a1[3])};
            *(u32x4*)(P.mix + (size_t)tok * DM + h * 64 + chn * 8) = w; }
    }
}

__device__ __forceinline__ void nsa_item(const Ctx& c, const AttnPtrs& P, int b, int g, int ci, int flags = 0) {
    const int ql = 8 * c.wid + (c.r32 >> 2), rh = c.r32 & 3, qpos = 64 * ci + ql, hb = 4 * g + rh;
    const int qw0 = 64 * ci + 8 * c.wid;
    const bf16* QB = P.qkv + 3 * QKV_BIG + ((size_t)(b * 8 + hb) * SEQ) * 64;
    const bf16* KS = P.qkv + 4 * QKV_BIG + 2 * QKV_SMALL + ((size_t)(b * 2 + g) * SEQ) * 64; const bf16* VS = KS + QKV_SMALL; const bf16* KW = KS + 2 * QKV_SMALL; const bf16* VW = KS + 3 * QKV_SMALL;
    const bf16* KC = P.kcmp + (size_t)(b * 2 + g) * 512 * 64; const bf16* VC = P.vcmp + (size_t)(b * 2 + g) * 512 * 64;
    bf16x8 qr[4];
#pragma unroll
    for (int d0 = 0; d0 < 4; ++d0) qr[d0] = __builtin_nontemporal_load((const bf16x8*)(QB + (size_t)qpos * 64 + d0 * 16 + c.hi * 8));
    asm volatile("" : "+v"(qr[0]), "+v"(qr[1]), "+v"(qr[2]), "+v"(qr[3]));
    const LAS float* lut = (const LAS float*)(c.lds + LDS_LUTG) + (8 + hb) * LUT_PITCH;
    LAS float* imp = (LAS float*)(c.lds + LDS_IMP);
    LAS unsigned* selm = (LAS unsigned*)(c.lds + LDS_SELM);
    f32x16 o[2]; float l_reg; float fr[16];
    LAS float* park = (LAS float*)(c.lds + LDS_OST) + c.wid * 1024 + c.lane;
    LAS float* park1 = (LAS float*)(c.lds + LDS_IMP) + c.wid * 1024 + c.lane;
    const int nct = (4 * ci + 3 + 63) >> 6;
    const int nlim = (qpos >= 31) ? ((qpos - 31) >> 4) : -1;
    const int nlim_w = (qw0 >= 31) ? ((qw0 - 31) >> 4) : -1;
    LAS bf16* impt = (LAS bf16*)(c.lds + ((rh & 2) ? LDS_IMP : LDS_OST)) + ((rh & 2) ? IMP_REG1 : 0) + (rh & 1) * IMP_PLANE + ql * IMP_PITCH;
    l_reg = 0.f; o[0] = f32x16{}; o[1] = f32x16{};
    {
        float carry = 0.f;
        if (!(flags & 32)) run_stream<true>(c, KC, VC, 0, nct,
          [&](int t, lds_cptr kp, f32x16& s0, f32x16& s1) { qk_tile(s0, s1, kp, qr); },
          [&](int t, lds_cptr vp, f32x16& s0, f32x16& s1) {
            if (nlim_w - 64 * t >= 63) hook_exp(s0, s1); else hook_cmp(s0, s1, nlim - 64 * t - 4 * c.hi, 0.f);
            l_reg += rowsum32(s0, s1);
#pragma unroll
            for (int half = 0; half < 2; ++half) {
                float g4[4], e[4];
#pragma unroll
                for (int a = 0; a < 4; ++a) { const float x0 = half ? s1[4 * a] : s0[4 * a], x1 = half ? s1[4 * a + 1] : s0[4 * a + 1], x2 = half ? s1[4 * a + 2] : s0[4 * a + 2], x3 = half ? s1[4 * a + 3] : s0[4 * a + 3];
                    g4[a] = (x0 + x1) + (x2 + x3); e[a] = x3; }
                float x[4];
#pragma unroll
                for (int a = 0; a < 4; ++a) { auto rr = __builtin_amdgcn_permlane32_swap(__float_as_uint(e[a]), __float_as_uint(e[a]), false, false); x[a] = __uint_as_float(c.hi ? rr[0] : rr[1]); }
                const int jb = 16 * t + 8 * half;
                float iv[4];
                if (c.hi) {
#pragma unroll
                    for (int a = 0; a < 4; ++a) iv[a] = g4[a] + x[a]; }
                else { iv[0] = g4[0] + carry; iv[1] = g4[1] + x[0]; iv[2] = g4[2] + x[1]; iv[3] = g4[3] + x[2]; carry = x[3]; }
                { const unsigned p01 = cvtpk(iv[0], iv[1]), p23 = cvtpk(iv[2], iv[3]);
                  impt[jb + c.hi] = (bf16)p01; impt[jb + 2 + c.hi] = (bf16)(p01 >> 16); impt[jb + 4 + c.hi] = (bf16)p23; impt[jb + 6 + c.hi] = (bf16)(p23 >> 16); }
            }
            pv_tile<false>(o, vp, s0, s1, 0u);
        });
    }
    const float Lc = pair_sum(l_reg); const float invLc = Lc > 0.f ? 1.f / Lc : 0.f;
    { LAS float* wsfw = (LAS float*)(c.lds + LDS_WSF) + c.wid * 64; if (c.hi == 0) wsfw[32 + c.r32] = invLc; }
    const float* gp = P.gates + ((size_t)b * SEQ + qpos) * 24 + hb * 3; float g0 = __builtin_nontemporal_load(gp), g1 = __builtin_nontemporal_load(gp + 1), g2 = __builtin_nontemporal_load(gp + 2);
    {
        asm volatile("s_waitcnt lgkmcnt(0)" ::: "memory");
        const int fl = fresh_lane(); const int qq = 8 * c.wid + (fl >> 3), cc = fl & 7;
        unsigned m0 = 0u, m1 = 0u, m2w = 0u, m3 = 0u;
        if (ci <= 15 || (flags & 16)) { m0 = (ci >= 31) ? 0xffffffffu : ((2u << ci) - 1u); }
        else {
            unsigned v[16];
            const LAS float* il = (const LAS float*)(c.lds + LDS_WSF) + c.wid * 64 + 32 + 4 * (fl >> 3);
            const float i0 = il[0], i1 = il[1], i2 = il[2], i3 = il[3];
            const LAS bf16* ta = (const LAS bf16*)(c.lds + LDS_OST) + qq * IMP_PITCH; const LAS bf16* tb = (const LAS bf16*)(c.lds + LDS_IMP) + IMP_REG1 + qq * IMP_PITCH;
#pragma unroll
            for (int k = 0; k < 16; ++k) { const int j = cc + 8 * k;
                const float val = (bf2f(ta[j]) * i0 + bf2f(ta[IMP_PLANE + j]) * i1) + (bf2f(tb[j]) * i2 + bf2f(tb[IMP_PLANE + j]) * i3);
                v[k] = (j >= 1 && j <= ci - 2) ? ((__float_as_uint(val) & ~127u) | (unsigned)(127 - j)) : 0u; }
            for (int it = 0; it < 13; ++it) {
                unsigned m = v[0];
#pragma unroll
                for (int k = 1; k < 16; ++k) m = max(m, v[k]);
                m = max(m, (unsigned)__builtin_amdgcn_update_dpp(0, (int)m, 0xB1, 0xF, 0xF, true)); m = max(m, (unsigned)__builtin_amdgcn_update_dpp(0, (int)m, 0x4E, 0xF, 0xF, true)); m = max(m, (unsigned)__builtin_amdgcn_update_dpp(0, (int)m, 0x141, 0xF, 0xF, true));
                if (m != 0u) { const int jb = 127 - (int)(m & 127u); const unsigned bit = 1u << (jb & 31); const int wsel = jb >> 5;
                    m0 |= (wsel == 0) ? bit : 0u; m1 |= (wsel == 1) ? bit : 0u; m2w |= (wsel == 2) ? bit : 0u; m3 |= (wsel == 3) ? bit : 0u;
#pragma unroll
                    for (int k = 0; k < 16; ++k) v[k] = (v[k] == m) ? 0u : v[k]; }
            }
            m0 |= 1u;
#pragma unroll
            for (int z = 0; z < 2; ++z) { const int jf = ci - z; const unsigned bit = 1u << (jf & 31); const int wsel = jf >> 5;
                m0 |= (wsel == 0) ? bit : 0u; m1 |= (wsel == 1) ? bit : 0u; m2w |= (wsel == 2) ? bit : 0u; m3 |= (wsel == 3) ? bit : 0u; }
        }
        if (cc == 0) { selm[qq * 4 + 0] = m0; selm[qq * 4 + 1] = m1; selm[qq * 4 + 2] = m2w; selm[qq * 4 + 3] = m3; }
        asm volatile("s_waitcnt lgkmcnt(0)\n\ts_barrier" ::: "memory");
    }
    asm volatile("" : "+v"(g0), "+v"(g1), "+v"(g2));
    row_factors(c, g0 * invLc, fr);
#pragma unroll
    for (int r = 0; r < 16; ++r) { park[r * 64] = o[0][r] * fr[r]; park1[r * 64] = o[1][r] * fr[r]; }
    {
        const unsigned w0 = selm[ql * 4 + 0], w1 = selm[ql * 4 + 1], w2 = selm[ql * 4 + 2], w3 = selm[ql * 4 + 3];
        o[0] = f32x16{}; o[1] = f32x16{}; l_reg = 0.f;
        auto sel_pred = [&](int t) -> bool { const unsigned wsel = (t < 32) ? w0 : (t < 64) ? w1 : (t < 96) ? w2 : w3; return (wsel >> (t & 31)) & 1u; };
        auto sel_one = [&](int t, lds_cptr kp, lds_cptr vp) { const bool pred = sel_pred(t); if (!__any(pred)) return; const int key0 = 64 * t;
            f32x16 s0, s1; qk_tile(s0, s1, kp, qr);
            if (qw0 - key0 - 63 >= 113) { hook_exp(s0, s1); const float rs = rowsum32(s0, s1); l_reg += pred ? rs : 0.f;
                if (__all(pred)) pv_tile<false>(o, vp, s0, s1, 0u); else pv_tile<true>(o, vp, s0, s1, pred ? 0xffffffffu : 0u); }
            else { hook_near(s0, s1, qpos - key0 - 4 * c.hi, lut); const float rs = rowsum32(s0, s1); l_reg += pred ? rs : 0.f;
                if (__all(pred)) pv_tile<false>(o, vp, s0, s1, 0u); else pv_tile<true>(o, vp, s0, s1, pred ? 0xffffffffu : 0u); } };
        if (!(flags & 4)) run_stream_pairs(c, KS, VS, 0, ci + 1, sel_one,
            [&](int t, lds_cptr kpA, lds_cptr vpA, lds_cptr kpB, lds_cptr vpB) {
                if (qw0 - 64 * (t + 1) - 63 >= 113) {
                    const bool pa = sel_pred(t), pb = sel_pred(t + 1);
                    const bool xa = __any(pa), xb = __any(pb);
                    if (!xa && !xb) return;
                    if (!xb) { sel_one(t, kpA, vpA); return; }
                    if (!xa) { sel_one(t + 1, kpB, vpB); return; }
                    KF kA, kB; ld_k(kA, kpA); ATT_SB();
                    f32x16 a0, a1, b0, b1; qk_mfma(a0, a1, kA, qr); ATT_SB();
                    VF vA, vB; ld_k(kB, kpB); ld_v(vA, vpA); ATT_SB();
                    qk_mfma(b0, b1, kB, qr); hook_exp(a0, a1);
                    const float ra = rowsum32(a0, a1); const PW4 wa = pack4(a0, a1, pa ? 0xffffffffu : 0u); ATT_SB();
                    ld_v(vB, vpB); ATT_SB();
                    pv_mfma(o, vA, wa); hook_exp(b0, b1);
                    const float rb = rowsum32(b0, b1); const PW4 wb = pack4(b0, b1, pb ? 0xffffffffu : 0u); l_reg += (pa ? ra : 0.f) + (pb ? rb : 0.f); ATT_SB();
                    pv_mfma(o, vB, wb);
                } else { sel_one(t, kpA, vpA); sel_one(t + 1, kpB, vpB); } });
        const float Ls = pair_sum(l_reg);
        row_factors(c, g1 / Ls, fr);
#pragma unroll
        for (int r = 0; r < 16; ++r) { park[r * 64] += o[0][r] * fr[r]; park1[r * 64] += o[1][r] * fr[r]; }
    }
    {
        o[0] = f32x16{}; o[1] = f32x16{}; l_reg = 0.f;
        if (!(flags & 8)) run_stream<true>(c, KW, VW, ci >= 8 ? ci - 8 : 0, ci + 1,
            [&](int t, lds_cptr kp, f32x16& s0, f32x16& s1) { qk_tile(s0, s1, kp, qr); },
            [&](int t, lds_cptr vp, f32x16& s0, f32x16& s1) { const int key0 = 64 * t;
                if (qw0 - key0 - 63 < 113) hook_near(s0, s1, qpos - key0 - 4 * c.hi, lut); else if (qw0 + 7 - key0 >= 512) hook_edge(s0, s1, qpos - key0 - 4 * c.hi, 512); else hook_exp(s0, s1);
                l_reg += rowsum32(s0, s1);
                pv_tile<false>(o, vp, s0, s1, 0u); });
        const float Lw = pair_sum(l_reg);
        row_factors(c, g2 / Lw, fr);
#pragma unroll
        for (int r = 0; r < 16; ++r) { o[0][r] = park[r * 64] + o[0][r] * fr[r]; o[1][r] = park1[r * 64] + o[1][r] * fr[r]; }
        asm volatile("s_waitcnt lgkmcnt(0)" ::: "memory");
    }
    bf16* dst = P.mix + ((size_t)b * SEQ + 64 * ci + 8 * c.wid) * DM + 512 + g * 256;
    store_rows(c, o, dst, [](int row) { return (size_t)(row >> 2) * DM + (row & 3) * 64; });
    asm volatile("s_waitcnt lgkmcnt(0)\n\ts_barrier" ::: "memory");
}

__device__ __forceinline__ void attn_build_luts(LAS unsigned char* lds, const float* rel_bias) {
    LAS float* lutg = (LAS float*)((LAS char*)lds + LDS_LUTG);
    for (int idx = threadIdx.x; idx < 16 * 115; idx += NTHREADS) { const int hh = idx / 115, d = idx % 115;
        lutg[hh * LUT_PITCH + d] = (d == 0) ? -INFINITY : (rel_bias[t5_bucket(d - 1) * 16 + hh] - rel_bias[31 * 16 + hh]) * LOG2E; }
    asm volatile("s_waitcnt vmcnt(0) lgkmcnt(0)\n\ts_barrier" ::: "memory");
}
__device__ __forceinline__ void attn_phase(LAS unsigned char* lds, const AttnPtrs& P, unsigned* qcounter, int flags, bool luts_ready = false) {
    Ctx c = make_ctx(lds, threadIdx.x);
    LAS unsigned* misc = (LAS unsigned*)(c.lds + LDS_MISC);
    if (!luts_ready) attn_build_luts(lds, P.rel_bias);
    unsigned* done = qcounter + 16;
    for (;;) {
        if (threadIdx.x == 0) misc[0] = __hip_atomic_fetch_add(qcounter, 1u, __ATOMIC_RELAXED, __HIP_MEMORY_SCOPE_AGENT);
        asm volatile("s_waitcnt vmcnt(0) lgkmcnt(0)\n\ts_barrier" ::: "memory");
        const unsigned k = misc[0];
        asm volatile("s_waitcnt lgkmcnt(0)\n\ts_barrier" ::: "memory");
        if (k >= 2304u) break;
        int nsa = -1;
        if (k < 1536u) { const int t3 = (int)k / 3, r3 = (int)k - 3 * t3;
            if (r3 == 0) nsa = t3; else { const int kk = 2 * t3 + r3 - 1, j = kk >> 5, bh = kk & 31; moba_past_item(c, P, bh >> 3, bh & 7, j, done, flags); } }
        else if (k < 1792u) nsa = (int)k - 1024;
        else { const int idx = (int)k - 1792; if (idx & 1) moba_merge_item(c, P, idx >> 1, done); else nsa = 768 + (idx >> 1); }
        if (nsa >= 0) { const int s_ = 127 - (nsa >> 3), bg = nsa & 7; nsa_item(c, P, bg >> 1, bg & 1, s_, flags); }
    }
}
#undef MFMA32
#undef ATT_WAIT_BAR
}
namespace cmpr {
using bf16x8 = __attribute__((ext_vector_type(8))) short;
using f32x16 = __attribute__((ext_vector_type(16))) float;
constexpr int HID_PITCH = 528;
__device__ __forceinline__ float gelu_tanh(float v) { const float u = fminf(fmaxf(0.7978845608028654f * (v + 0.044715f * v * v * v), -15.f), 15.f); const float e = __expf(2.f * u); return 0.5f * v * (1.f + (e - 1.f) / (e + 1.f)); }
template <class Side>
__device__ __forceinline__ void compress_unit(Side&& side, LAS unsigned char* lds, int unit, const bf16* qkv, const bf16* w1k, const bf16* w1v, const bf16* w2k, const bf16* w2v, const float* cbp, const float* kncmp, bf16* kcmp, bf16* vcmp) {
    const int tid = threadIdx.x, lane = tid & 63, r32 = lane & 31, hi = lane >> 5; const int wid = __builtin_amdgcn_readfirstlane(tid >> 6);
    const int kv = unit & 1, u = (unit >> 1) & 15, bg = unit >> 5;
    const bf16* src = qkv + 4 * QKV_BIG + (kv ? QKV_SMALL : 0) + (size_t)bg * SEQ * 64;
    const bf16* w1 = kv ? w1v : w1k; const bf16* w2 = kv ? w2v : w2k;
    const int n0 = 32 * u;
    { const bf16* sp = src + (size_t)16 * n0 * 64;
      for (int ch = tid; ch < 4224; ch += NTHREADS) { v4u v = {0u, 0u, 0u, 0u}; if (16 * n0 + (ch >> 3) < SEQ) v = __builtin_nontemporal_load((const GAS v4u*)(sp + (size_t)ch * 8));
          *(LAS v4u*)(lds + ((ch ^ ((ch >> 7) & 15)) << 4)) = v; } }
    asm volatile("s_waitcnt vmcnt(0) lgkmcnt(0)\n\ts_barrier" ::: "memory");
    const bf16* bp = w1 + ((size_t)wid * 64 + lane) * 8;
    f32x16 acc = {};
#pragma unroll 16
    for (int kk = 0; kk < 128; ++kk) { const int lc = r32 * 128 + 2 * kk + hi; const bf16x8 a = *(const LAS bf16x8*)(lds + ((lc ^ ((lc >> 7) & 15)) << 4)), bfr = *(const bf16x8*)(bp + (size_t)kk * 4096); acc = __builtin_amdgcn_mfma_f32_32x32x16_bf16(a, bfr, acc, 0, 0, 0); }
    float cb = 0.f;
#pragma unroll 8
    for (int ic = 0; ic < 32; ++ic) cb += cbp[(ic * 2 + kv) * 256 + 32 * wid + r32];
    LAS unsigned char* hidL = lds + 69632;
#pragma unroll
    for (int r = 0; r < 16; ++r) { const int n = (r & 3) + 8 * (r >> 2) + 4 * hi; *(LAS bf16*)(hidL + n * HID_PITCH + (32 * wid + r32) * 2) = (bf16)f2bf(gelu_tanh(acc[r] + cb)); }
    asm volatile("s_waitcnt lgkmcnt(0)\n\ts_barrier" ::: "memory");
    if (wid == 0) {
        f32x16 o0 = {}, o1 = {};
#pragma unroll 4
        for (int kk = 0; kk < 16; ++kk) { const bf16x8 hb = *(const LAS bf16x8*)(hidL + r32 * HID_PITCH + (16 * kk + 8 * hi) * 2);
            const bf16x8 a0 = *(const bf16x8*)(w2 + (size_t)r32 * 256 + 16 * kk + 8 * hi), a1 = *(const bf16x8*)(w2 + (size_t)(32 + r32) * 256 + 16 * kk + 8 * hi);
            o0 = __builtin_amdgcn_mfma_f32_32x32x16_bf16(a0, hb, o0, 0, 0, 0); o1 = __builtin_amdgcn_mfma_f32_32x32x16_bf16(a1, hb, o1, 0, 0, 0); }
        float rs = 1.f;
        if (!kv) { float ss = 0.f;
#pragma unroll
            for (int r = 0; r < 16; ++r) ss += o0[r] * o0[r] + o1[r] * o1[r];
            auto rr = __builtin_amdgcn_permlane32_swap(__float_as_uint(ss), __float_as_uint(ss), false, false); ss = __uint_as_float(rr[0]) + __uint_as_float(rr[1]);
            rs = rsqrtf(ss * (1.f / 64.f) + 1e-6f); }
        const int n = n0 + r32; bf16* dst = (kv ? vcmp : kcmp) + ((size_t)bg * 512 + n) * 64;
#pragma unroll
        for (int r = 0; r < 16; ++r) { const int d = (r & 3) + 8 * (r >> 2) + 4 * hi;
            float v0 = o0[r] * rs, v1 = o1[r] * rs; if (!kv) { v0 *= kncmp[d]; v1 *= kncmp[d + 32]; }
            if (n >= NCMP) { v0 = 0.f; v1 = 0.f; }
            dst[d] = (bf16)f2bf(v0); dst[d + 32] = (bf16)f2bf(v1); }
    } else side();
    asm volatile("s_waitcnt lgkmcnt(0)\n\ts_barrier" ::: "memory");
}
}
__global__ void __launch_bounds__(NTHREADS, 2) mk_fwd(Args a) {
    extern __shared__ __attribute__((aligned(16))) unsigned char lds[];
    Frame F;
    F.lds = (LAS unsigned char*)lds;
    F.tid = threadIdx.x; F.lane = F.tid & 63; F.wave = __builtin_amdgcn_readfirstlane(F.tid >> 6);
    F.G = gridDim.x; { const int bx = blockIdx.x; F.vcu = (F.G % 8 == 0) ? (bx % 8) * (F.G / 8) + bx / 8 : bx; }
    volatile LAS unsigned* xst = (volatile LAS unsigned*)(F.lds + 147424);
    if (F.tid < 8) xst[F.tid] = 0u;
    __syncthreads();
    const XcdBarrier xbar = xcd_barrier_post((unsigned*)(a.ws + WS_CTL) + 4096, xst);
    unsigned char* ws = a.ws;
    const int lo = a.ph_lo, hi = a.ph_hi & 0xff; const int tflags = a.ph_hi >> 8; (void)tflags;
    const att::AttnPtrs P{(const bf16*)(ws + WS_QKV), (const float*)(ws + WS_KMP), (const float*)(ws + WS_GATES), (const bf16*)(ws + WS_KCMP), (const bf16*)(ws + WS_VCMP), a.in[2], (bf16*)(ws + WS_MIX),
                          (unsigned*)(ws + WS_SELG), (bf16*)(ws + WS_PARTO), (float*)(ws + WS_PARTL)};
#define IN(k) (lo <= (k) && (k) < hi)
#define SEAM(k) do { if (IN(k) && IN((k) + 1)) xcd_barrier(xbar); } while (0)
    if (IN(0)) { phase_prologue_a(F, a); } SEAM(0);
    if (IN(1)) { phase_prologue_b(F, a); } SEAM(1);
    if (IN(2)) {
        pg8::Gemm g{(const pg8::bf16_t*)(ws + WS_H), (const pg8::bf16_t*)(ws + WS_WIN), TOK, NIN_PAD, DM}; pg8::StaticOrder S; S.init(TOK, NIN_PAD, F.G, (int)blockIdx.x);
        LAS float* gl = (LAS float*)(F.lds + RING_BYTES);
        if (F.tid < 320) { const int k = F.tid >> 6, d = F.tid & 63; const float* src = k == 0 ? a.in[7] : k == 1 ? a.in[8] : k == 2 ? a.in[9] : k == 3 ? a.in[11] : a.in[12];
            gl[F.tid] = src[d] * ((k == 0 || k == 2) ? pg8::C2 : 1.f); }
        __syncthreads();
        pg8::EpiInProj E{(pg8::bf16_t*)(ws + WS_QKV), (float*)(ws + WS_GATES), (float*)(ws + WS_KMP), gl};
        pg8::gemm_phase<pg8::EpiInProj, pg8::StaticOrder, true, true>(F.lds, g, S, E);
    } SEAM(2);
    if (IN(3)) {
        if (F.G == 256 && !tflags) {
            cmpr::compress_unit([&]() { att::moba_gate_tasks_w17(P, F.vcu, F.tid); }, F.lds, F.vcu, (const bf16*)(ws + WS_QKV), (const bf16*)(ws + WS_W1K), (const bf16*)(ws + WS_W1V), (const bf16*)(ws + WS_W2K), (const bf16*)(ws + WS_W2V),
                                (const float*)(ws + WS_CBP), a.in[10], (bf16*)(ws + WS_KCMP), (bf16*)(ws + WS_VCMP));
        } else {
            if (!(tflags & 1)) att::moba_gate_phase(P, F.vcu, F.G, F.tid);
            if (!(tflags & 2)) for (int unit = F.vcu; unit < 256; unit += F.G)
                cmpr::compress_unit([]() {}, F.lds, unit, (const bf16*)(ws + WS_QKV), (const bf16*)(ws + WS_W1K), (const bf16*)(ws + WS_W1V), (const bf16*)(ws + WS_W2K), (const bf16*)(ws + WS_W2V),
                                    (const float*)(ws + WS_CBP), a.in[10], (bf16*)(ws + WS_KCMP), (bf16*)(ws + WS_VCMP));
        }
        if (IN(4)) att::attn_build_luts(F.lds, a.in[2]);
    } SEAM(3);
    if (IN(4)) {
#if HYBRID == 3
        att::attn_phase(F.lds, P, (unsigned*)(ws + WS_CTL) + 64, tflags);
#else
        att::attn_phase(F.lds, P, (unsigned*)(ws + WS_CTL) + 64, 0, IN(3));
#endif
    } if (IN(4) && IN(6)) xcd_barrier(xbar);
    if (IN(6)) {
        pg8::Gemm g{(const pg8::bf16_t*)(ws + WS_MIX), (const pg8::bf16_t*)(ws + WS_WOUT), TOK, DM, DM}; pg8::StaticOrder S; S.init(TOK, DM, F.G, (int)blockIdx.x);
        pg8::EpiOutProj E{a.in[0], (pg8::bf16_t*)(ws + WS_Y), (const float*)(ws + WS_MOD) + 2 * DM};
        pg8::gemm_phase<pg8::EpiOutProj, pg8::StaticOrder, true, true>(F.lds, g, S, E);
    } SEAM(6);
    if (IN(7)) { phase_norm2(F, a); } SEAM(7);
    if (IN(8)) {
        pg8::Gemm g{(const pg8::bf16_t*)(ws + WS_H), (const pg8::bf16_t*)(ws + WS_WGU), TOK, 2 * FF, DM}; pg8::StaticOrder S; S.init(TOK, 2 * FF, F.G, (int)blockIdx.x);
        pg8::EpiGateUp E{(pg8::bf16_t*)(ws + WS_ACT)};
        pg8::gemm_phase<pg8::EpiGateUp, pg8::StaticOrder, true, true>(F.lds, g, S, E);
    } SEAM(8);
    if (IN(9)) {
        pg8::Gemm g{(const pg8::bf16_t*)(ws + WS_ACT), (const pg8::bf16_t*)(ws + WS_WDN), TOK, DM, FF}; pg8::StaticOrder S; S.init(TOK, DM, F.G, (int)blockIdx.x);
        pg8::EpiDown E{(const pg8::bf16_t*)(ws + WS_Y), a.out, (const float*)(ws + WS_MOD) + 5 * DM};
        pg8::gemm_phase<pg8::EpiDown, pg8::StaticOrder, true, true>(F.lds, g, S, E);
    }
#undef IN
#undef SEAM
}

static void launch_phases(const Args& base, int lo, int hi, int grid, hipStream_t stream, int flags = 0) {
    Args a = base; a.ph_lo = lo; a.ph_hi = hi | (flags << 8);
    if (hi - lo > 1) { void* args[] = {&a}; (void)hipLaunchCooperativeKernel((const void*)mk_fwd, dim3(grid), dim3(NTHREADS), args, LDS_BYTES, stream); }
    else hipLaunchKernelGGL(mk_fwd, dim3(grid), dim3(NTHREADS), LDS_BYTES, stream, a);
}
extern "C" void kernel_launch(void* const* d_in, const int* in_sizes, int n_in, void* d_out, int out_size, void* d_ws, size_t ws_size, hipStream_t stream) {
    static int grid = 0;
    if (grid == 0) {
        int dev = 0, cus = 0, per_cu = 0;
        if (n_in != 23 || ws_size < 480 * MiB || hipGetDevice(&dev) != hipSuccess || hipDeviceGetAttribute(&cus, hipDeviceAttributeMultiprocessorCount, dev) != hipSuccess) { grid = -1; return; }
        if (hipFuncSetAttribute((const void*)mk_fwd, hipFuncAttributeMaxDynamicSharedMemorySize, LDS_BYTES) != hipSuccess) { grid = -1; return; }
        if (hipOccupancyMaxActiveBlocksPerMultiprocessor(&per_cu, (const void*)mk_fwd, NTHREADS, LDS_BYTES) != hipSuccess || per_cu < 1) { grid = -1; return; }
        grid = cus;
    }
    if (grid < 0) return;
    (void)hipMemsetAsync((char*)d_ws + WS_CTL, 0, CTL_ZERO_BYTES, stream);
    Args a{};
    for (int i = 0; i < 23; ++i) a.in[i] = (const float*)d_in[i];
    a.out = (float*)d_out; a.ws = (unsigned char*)d_ws;
    unsigned char* ws = (unsigned char*)d_ws;
#if HYBRID == 1
    launch_phases(a, 0, 1, grid, stream); launch_phases(a, 1, 2, grid, stream); launch_phases(a, 2, 3, grid, stream);
    const bf16* qkv = (const bf16*)(ws + WS_QKV); bf16* mix = (bf16*)(ws + WS_MIX); bf16* kcmp = (bf16*)(ws + WS_KCMP); bf16* vcmp = (bf16*)(ws + WS_VCMP);
    int* sel = (int*)(ws + 344 * MiB); float* obuf = (float*)(ws + 348 * MiB); const float* gates = (const float*)(ws + WS_GATES);
    nq::k_compress<<<dim3(4 * 2 * 512, 2), 256, 0, stream>>>(qkv, a.in[13], a.in[14], a.in[15], a.in[16], a.in[17], a.in[18], a.in[10], kcmp, vcmp);
    nq::k_moba<<<4 * 8 * SEQ / 4, 256, 0, stream>>>(qkv, (const float*)(ws + WS_KMP), a.in[2], mix);
    nq::k_nsa_cmp<<<4 * 2 * SEQ, 256, 0, stream>>>(qkv, kcmp, vcmp, gates, obuf, sel);
    nq::k_nsa_sel<<<4 * 2 * SEQ, 256, 0, stream>>>(qkv, sel, a.in[2], gates, obuf);
    nq::k_nsa_win<<<4 * 2 * SEQ, 256, 0, stream>>>(qkv, a.in[2], gates, obuf, mix);
    launch_phases(a, 5, 6, grid, stream); launch_phases(a, 6, 7, grid, stream); launch_phases(a, 7, 8, grid, stream); launch_phases(a, 8, 9, grid, stream);
#elif HYBRID == 2
    launch_phases(a, 0, 1, grid, stream); launch_phases(a, 1, 2, grid, stream); launch_phases(a, 2, 3, grid, stream);
    nq::k_compress<<<dim3(4 * 2 * 512, 2), 256, 0, stream>>>((const bf16*)(ws + WS_QKV), a.in[13], a.in[14], a.in[15], a.in[16], a.in[17], a.in[18], a.in[10], (bf16*)(ws + WS_KCMP), (bf16*)(ws + WS_VCMP));
    launch_phases(a, 4, 5, grid, stream);
    launch_phases(a, 5, 6, grid, stream); launch_phases(a, 6, 7, grid, stream); launch_phases(a, 7, 8, grid, stream); launch_phases(a, 8, 9, grid, stream);
#elif HYBRID == 3
    for (int p = 0; p < N_PHASES; ++p) {
#if defined(TIME_PHASE)
        if (p == TIME_PHASE) { for (int r = 0; r < TIME_REPS; ++r) { launch_phases(a, p, p + 1, grid, stream, TIME_FLAGS); (void)hipMemsetAsync((char*)d_ws + WS_CTL, 0, CTL_ZERO_BYTES, stream); } }
#endif
        launch_phases(a, p, p + 1, grid, stream);
#if defined(ABL_REPS)
        if (p == 3) { static bool once = false; if (!once) { once = true; (void)hipFuncSetAttribute((const void*)k_attn_abl, hipFuncAttributeMaxDynamicSharedMemorySize, LDS_BYTES); }
            for (int r = 0; r < ABL_REPS; ++r) { (void)hipMemsetAsync((char*)d_ws + WS_CTL + 512, 0, 4, stream); hipLaunchKernelGGL(k_attn_abl, dim3(grid), dim3(NTHREADS), LDS_BYTES, stream, a); } }
#endif
    }
#else
    launch_phases(a, 0, N_PHASES, grid, stream);
#endif
}
```
